# Optimizing an MI355X kernel written in HIP

```python
import jax
import jax.numpy as jnp
from jax import lax
import numpy as np

D_MODEL = 2048
BATCH = 4
SEQ = 4096
DEPTH = 1

RWKV_HEAD = 64
RWKV_DIM = D_MODEL
RWKV_HEADS = RWKV_DIM // RWKV_HEAD
DECAY_LORA = 96
AAA_LORA = 96
GATE_LORA = 256
GN_EPS = 64e-5
DIL_GROUPS = ((128, 1), (512, 4), (2048, 16))
N_GROUPS = len(DIL_GROUPS)
DIL_HEADS = 8
DIL_HEAD_DIM = 64
DIL_GROUP_W = DIL_HEADS * DIL_HEAD_DIM
DIL_DIM = N_GROUPS * DIL_GROUP_W
BLK = 128
ROPE_THETA = 10000.0
NEG_INF = -1e30
RWKV_COLS = 3 * RWKV_DIM + DECAY_LORA + AAA_LORA + GATE_LORA
ATTN_COLS = 3 * DIL_DIM
GATE_COLS = 2 * D_MODEL
IN_COLS = RWKV_COLS + ATTN_COLS + GATE_COLS
MEM_LEN = 256
CA_HEADS = 4
CA_HEAD_DIM = D_MODEL // CA_HEADS
N_EXPERTS = 32
TOP_K = 4
D_FF = D_MODEL
SWIGLU_LIMIT = 7.0
SWIGLU_ALPHA = 1.702
MOE_BLK = 128
LN_EPS = 1e-5
DEEPNORM_ALPHA = (2 * DEPTH) ** 0.25
DEEPNORM_BETA = (8 * DEPTH) ** -0.25

kernel_name = 'hybrid_rwkv7_dilated_attn_moe_layer'


def layer_norm(t, g, b):
    tf = t.astype(jnp.float32)
    mu = jnp.mean(tf, axis=-1, keepdims=True)
    var = jnp.mean(jnp.square(tf - mu), axis=-1, keepdims=True)
    return ((tf - mu) * lax.rsqrt(var + LN_EPS) * g + b).astype(t.dtype)


def token_shift(z, mix):
    prev = jnp.pad(z, ((0, 0), (1, 0), (0, 0)))[:, :-1]
    return z + (prev - z) * mix


def rotary(t):
    s, e = t.shape[1], t.shape[-1]
    half = e // 2
    inv = ROPE_THETA ** (-jnp.arange(half, dtype=jnp.float32) * 2.0 / e)
    ang = jnp.arange(s, dtype=jnp.float32)[:, None] * inv[None, :]
    shape = (1, s) + (1,) * (t.ndim - 3) + (half,)
    cos, sin = jnp.cos(ang).reshape(shape), jnp.sin(ang).reshape(shape)
    tf = t.astype(jnp.float32)
    t1, t2 = tf[..., :half], tf[..., half:]
    return jnp.concatenate([t1 * cos - t2 * sin, t2 * cos + t1 * sin], axis=-1).astype(t.dtype)


def rwkv7_scan(r, w, k, v, a, b):
    bsz, _, h, n = r.shape

    def step(state, inp):
        r_t, w_t, k_t, v_t, a_t, b_t = inp
        sa = jnp.einsum('bhij,bhj->bhi', state, a_t)
        state = (state * w_t[:, :, None, :] + sa[..., None] * b_t[:, :, None, :]
                 + v_t[..., None] * k_t[:, :, None, :])
        return state, jnp.einsum('bhij,bhj->bhi', state, r_t)

    xs = tuple(jnp.moveaxis(t, 1, 0) for t in (r, w, k, v, a, b))
    state0 = jnp.zeros((bsz, h, n, n), jnp.float32)
    _, ys = lax.scan(step, state0, xs)
    return jnp.moveaxis(ys, 0, 1)


def rwkv7_branch(z, w0, w_up, a0, a_up, g_up, k_k, k_a, r_k, lnx_g, lnx_b):
    bsz, s, _ = z.shape
    f32 = jnp.float32
    cut = np.cumsum([RWKV_DIM, RWKV_DIM, RWKV_DIM, DECAY_LORA, AAA_LORA]).tolist()
    r, k, v, wd, ad, gd = jnp.split(z, cut, axis=-1)
    heads = lambda t: t.reshape(bsz, s, RWKV_HEADS, RWKV_HEAD).astype(f32)
    w = -jax.nn.softplus(-(w0 + jnp.tanh(wd) @ w_up).astype(f32)) - 0.5
    decay = jnp.exp(-jnp.exp(w))
    a = jax.nn.sigmoid(a0 + ad @ a_up)
    g = jax.nn.sigmoid(gd) @ g_up
    kk = heads(k * k_k)
    kk = kk / jnp.maximum(jnp.sqrt(jnp.sum(kk * kk, axis=-1, keepdims=True)), 1e-12)
    k = k * (1.0 + (a - 1.0) * k_a)
    rh, kh, vh, ah = heads(r), heads(k), heads(v), heads(a)
    y = rwkv7_scan(rh, heads(decay), kh, vh, -kk, kk * ah)
    mu = jnp.mean(y, axis=-1, keepdims=True)
    var = jnp.mean(jnp.square(y - mu), axis=-1, keepdims=True)
    y = ((y - mu) * lax.rsqrt(var + GN_EPS)).reshape(bsz, s, RWKV_DIM) * lnx_g + lnx_b
    bonus = jnp.sum(rh * kh * r_k, axis=-1, keepdims=True) * vh
    y = y + bonus.reshape(bsz, s, RWKV_DIM)
    return y.astype(z.dtype) * g


def dilated_causal_attention(q, k, v, window, dilation):
    b, s, h, e = q.shape
    span = window // dilation
    unit = dilation * BLK
    L = -(-s // unit) * unit
    n = L // dilation
    nb = n // BLK

    def to_sub(t):
        t = jnp.pad(t, ((0, 0), (0, L - s), (0, 0), (0, 0)))
        t = t.reshape(b, n, dilation, h, e).transpose(0, 2, 1, 3, 4)
        return t.reshape(b, dilation, nb, BLK, h, e)

    def with_prev(t):
        prev = jnp.pad(t, ((0, 0), (0, 0), (1, 0), (0, 0), (0, 0), (0, 0)))[:, :, :-1]
        return jnp.concatenate([prev, t], axis=3)

    def from_sub(t):
        rest = t.shape[4:]
        t = jnp.swapaxes(t.reshape((b, dilation, n) + rest), 1, 2)
        return t.reshape((b, L) + rest)[:, :s]

    qs = to_sub(q)
    kw, vw = with_prev(to_sub(k)), with_prev(to_sub(v))
    scores = jnp.einsum('bdnqhe,bdnkhe->bdnhqk', qs, kw,
                        preferred_element_type=jnp.float32) * (e ** -0.5)
    qi = jnp.arange(BLK)[:, None] + BLK
    ki = jnp.arange(2 * BLK)[None, :]
    dist = qi - ki
    band = (dist >= 0) & (dist <= span)
    has_key = (jnp.arange(nb) > 0)[:, None, None] | (ki >= BLK)[None]
    mask = band[None] & has_key
    scores = jnp.where(mask[None, None, :, None], scores, NEG_INF)
    m = jnp.max(scores, axis=-1, keepdims=True)
    p = jnp.exp(scores - m)
    den = jnp.sum(p, axis=-1, keepdims=True)
    o = jnp.einsum('bdnhqk,bdnkhe->bdnqhe', p, vw.astype(jnp.float32))
    o = o / jnp.moveaxis(den[..., 0], 3, 4)[..., None]
    lse = jnp.moveaxis((m + jnp.log(den))[..., 0], 3, 4)
    return from_sub(o), from_sub(lse)


def hybrid_mixer(x, w_in, shift_mix, w0, w_up, a0, a_up, g_up, k_k, k_a, r_k, lnx_g, lnx_b,
                 proj_a, proj_b, w_out):
    bsz, s, _ = x.shape
    proj = x @ w_in
    y_a = rwkv7_branch(token_shift(proj[..., :RWKV_COLS], shift_mix),
                       w0, w_up, a0, a_up, g_up, k_k, k_a, r_k, lnx_g, lnx_b)
    qkv = proj[..., RWKV_COLS:RWKV_COLS + ATTN_COLS].reshape(
        bsz, s, 3, N_GROUPS, DIL_HEADS, DIL_HEAD_DIM)
    q, k, v = rotary(qkv[:, :, 0]), rotary(qkv[:, :, 1]), qkv[:, :, 2]
    outs, lses = [], []
    for gi, (window, dilation) in enumerate(DIL_GROUPS):
        o, lse = dilated_causal_attention(q[:, :, gi], k[:, :, gi], v[:, :, gi], window, dilation)
        outs.append(o)
        lses.append(lse)
    mix = jax.nn.softmax(jnp.stack(lses), axis=0)[..., None]
    y_b = jnp.sum(mix * jnp.stack(outs), axis=0).reshape(bsz, s, DIL_GROUP_W).astype(x.dtype)
    gates = jax.nn.sigmoid(proj[..., RWKV_COLS + ATTN_COLS:])
    merged = gates[..., :D_MODEL] * (y_a @ proj_a) + gates[..., D_MODEL:] * (y_b @ proj_b)
    return merged @ w_out


def memory_cross_attention(x, mem, wq, wkv, wo):
    bsz, s, d = x.shape
    q = (x @ wq).reshape(bsz, s, CA_HEADS, CA_HEAD_DIM)
    kv = (mem @ wkv).reshape(bsz, mem.shape[1], 2, CA_HEADS, CA_HEAD_DIM)
    k, v = kv[:, :, 0], kv[:, :, 1]
    scores = jnp.einsum('bshe,bmhe->bhsm', q, k,
                        preferred_element_type=jnp.float32) * (CA_HEAD_DIM ** -0.5)
    p = jax.nn.softmax(scores, axis=-1).astype(v.dtype)
    o = jnp.einsum('bhsm,bmhe->bshe', p, v).reshape(bsz, s, d)
    return o @ wo


def clamped_swiglu(h):
    glu, lin = h[..., ::2], h[..., 1::2]
    glu = jnp.minimum(glu, SWIGLU_LIMIT)
    lin = jnp.clip(lin, -SWIGLU_LIMIT, SWIGLU_LIMIT)
    return glu * jax.nn.sigmoid(SWIGLU_ALPHA * glu) * (lin + 1.0)


def moe_ffn(x, router_w, router_b, w1, b1, w2, b2):
    bsz, s, d = x.shape
    n = bsz * s
    xf = x.reshape(n, d)
    logits = jnp.dot(xf, router_w, preferred_element_type=jnp.float32) + router_b.astype(jnp.float32)
    top_val, top_idx = lax.top_k(logits, TOP_K)
    top_w = jax.nn.softmax(top_val, axis=-1)
    flat_e = top_idx.reshape(-1)
    order = jnp.argsort(flat_e)
    e_sorted = flat_e[order]
    tok_sorted = (order // TOP_K).astype(jnp.int32)
    gate_sorted = top_w.reshape(-1)[order]
    counts = jnp.bincount(flat_e, length=N_EXPERTS)
    starts = jnp.cumsum(counts) - counts
    padded = (counts + MOE_BLK - 1) // MOE_BLK * MOE_BLK
    pends = jnp.cumsum(padded)
    pstarts = pends - padded
    dest = pstarts[e_sorted] + jnp.arange(n * TOP_K) - starts[e_sorted]
    rows = n * TOP_K + N_EXPERTS * MOE_BLK
    nblk = rows // MOE_BLK
    row_tok = jnp.full((rows,), n, jnp.int32).at[dest].set(tok_sorted)
    row_gate = jnp.zeros((rows,), jnp.float32).at[dest].set(gate_sorted)
    blk_exp = jnp.minimum(jnp.searchsorted(pends, jnp.arange(nblk) * MOE_BLK, side='right'),
                          N_EXPERTS - 1)
    xpad = jnp.concatenate([xf, jnp.zeros((1, d), xf.dtype)], axis=0)

    def expert_block(args):
        tok, e = args
        h = xpad[tok] @ w1[e] + b1[e]
        return clamped_swiglu(h) @ w2[e] + b2[e]

    ys = lax.map(expert_block, (row_tok.reshape(nblk, MOE_BLK), blk_exp))
    ys = ys.reshape(rows, d) * row_gate[:, None].astype(ys.dtype)
    out = jnp.zeros((n + 1, d), ys.dtype).at[row_tok].add(ys)[:n]
    return out.reshape(bsz, s, d)


def setup_inputs(seed: int = 0) -> dict:
    key = jax.random.key(seed)
    ks = jax.random.split(key, 40)
    f32 = jnp.float32
    L = DEPTH

    def nrm(k, shape, scale):
        return jax.random.normal(k, shape, f32) * scale

    beta = DEEPNORM_BETA
    in_col_scale = jnp.concatenate([
        jnp.ones((2 * RWKV_DIM,), f32), jnp.full((RWKV_DIM,), beta, f32),
        jnp.ones((DECAY_LORA + AAA_LORA + GATE_LORA,), f32),
        jnp.ones((2 * DIL_DIM,), f32), jnp.full((DIL_DIM,), beta, f32),
        jnp.ones((GATE_COLS,), f32)])
    kv_col_scale = jnp.concatenate([jnp.ones((D_MODEL,), f32), jnp.full((D_MODEL,), beta, f32)])
    return {
        'x': nrm(ks[0], (BATCH, SEQ, D_MODEL), 1.0),
        'mem': nrm(ks[1], (BATCH, MEM_LEN, D_MODEL), 1.0),
        'w_in': nrm(ks[2], (L, D_MODEL, IN_COLS), D_MODEL ** -0.5) * in_col_scale,
        'shift_mix': jax.random.uniform(ks[3], (L, RWKV_COLS), f32, 0.2, 0.8),
        'w0': jax.random.uniform(ks[4], (L, RWKV_DIM), f32, -6.0, -1.0),
        'w_up': nrm(ks[5], (L, DECAY_LORA, RWKV_DIM), 0.1 * DECAY_LORA ** -0.5),
        'a0': nrm(ks[6], (L, RWKV_DIM), 0.1),
        'a_up': nrm(ks[7], (L, AAA_LORA, RWKV_DIM), 0.5 * AAA_LORA ** -0.5),
        'g_up': nrm(ks[8], (L, GATE_LORA, RWKV_DIM), GATE_LORA ** -0.5),
        'k_k': 0.85 + nrm(ks[9], (L, RWKV_DIM), 0.02),
        'k_a': 1.0 + nrm(ks[10], (L, RWKV_DIM), 0.02),
        'r_k': nrm(ks[11], (L, RWKV_HEADS, RWKV_HEAD), 0.1),
        'lnx_g': 1.0 + nrm(ks[12], (L, RWKV_DIM), 0.02),
        'lnx_b': nrm(ks[13], (L, RWKV_DIM), 0.02),
        'proj_a': nrm(ks[14], (L, RWKV_DIM, D_MODEL), RWKV_DIM ** -0.5),
        'proj_b': nrm(ks[15], (L, DIL_GROUP_W, D_MODEL), DIL_GROUP_W ** -0.5),
        'w_out': nrm(ks[16], (L, D_MODEL, D_MODEL), beta * D_MODEL ** -0.5),
        'ln1_g': 1.0 + nrm(ks[17], (L, D_MODEL), 0.02),
        'ln1_b': nrm(ks[18], (L, D_MODEL), 0.02),
        'ca_wq': nrm(ks[19], (L, D_MODEL, D_MODEL), D_MODEL ** -0.5),
        'ca_wkv': nrm(ks[20], (L, D_MODEL, 2 * D_MODEL), D_MODEL ** -0.5) * kv_col_scale,
        'ca_wo': nrm(ks[21], (L, D_MODEL, D_MODEL), beta * D_MODEL ** -0.5),
        'ln2_g': 1.0 + nrm(ks[22], (L, D_MODEL), 0.02),
        'ln2_b': nrm(ks[23], (L, D_MODEL), 0.02),
        'router_w': nrm(ks[24], (L, D_MODEL, N_EXPERTS), D_MODEL ** -0.5),
        'router_b': nrm(ks[25], (L, N_EXPERTS), 0.01),
        'moe_w1': nrm(ks[26], (L, N_EXPERTS, D_MODEL, 2 * D_FF), beta * D_MODEL ** -0.5),
        'moe_b1': nrm(ks[27], (L, N_EXPERTS, 2 * D_FF), 0.02),
        'moe_w2': nrm(ks[28], (L, N_EXPERTS, D_FF, D_MODEL), beta * D_FF ** -0.5),
        'moe_b2': nrm(ks[29], (L, N_EXPERTS, D_MODEL), 0.02),
        'ln3_g': 1.0 + nrm(ks[30], (L, D_MODEL), 0.02),
        'ln3_b': nrm(ks[31], (L, D_MODEL), 0.02),
    }


def reference(x, mem, w_in, shift_mix, w0, w_up, a0, a_up, g_up, k_k, k_a, r_k, lnx_g, lnx_b,
              proj_a, proj_b, w_out, ln1_g, ln1_b, ca_wq, ca_wkv, ca_wo, ln2_g, ln2_b,
              router_w, router_b, moe_w1, moe_b1, moe_w2, moe_b2, ln3_g, ln3_b):
    for l in range(DEPTH):
        h = hybrid_mixer(x, w_in[l], shift_mix[l], w0[l], w_up[l], a0[l], a_up[l], g_up[l],
                         k_k[l], k_a[l], r_k[l], lnx_g[l], lnx_b[l], proj_a[l], proj_b[l], w_out[l])
        x = layer_norm(DEEPNORM_ALPHA * x + h, ln1_g[l], ln1_b[l])
        h = memory_cross_attention(x, mem, ca_wq[l], ca_wkv[l], ca_wo[l])
        x = layer_norm(DEEPNORM_ALPHA * x + h, ln2_g[l], ln2_b[l])
        h = moe_ffn(x, router_w[l], router_b[l], moe_w1[l], moe_b1[l], moe_w2[l], moe_b2[l])
        x = layer_norm(DEEPNORM_ALPHA * x + h, ln3_g[l], ln3_b[l])
    return x
```

```cpp
#include <hip/hip_runtime.h>
#include <cstdio>
#include <cstdint>

#define LAS __attribute__((address_space(3)))
#define GAS __attribute__((address_space(1)))
typedef unsigned short bf16_t;
typedef short bf16x8 __attribute__((ext_vector_type(8)));
typedef float f32x4 __attribute__((ext_vector_type(4)));
typedef float f32x2 __attribute__((ext_vector_type(2)));
typedef float f32x16 __attribute__((ext_vector_type(16)));
typedef unsigned u32x4 __attribute__((ext_vector_type(4)));
typedef unsigned u32x2 __attribute__((ext_vector_type(2)));

#ifndef N_LAUNCH_MODE
#define N_LAUNCH_MODE 0
#endif

constexpr int M = 16384, D = 2048, SEQ = 4096, NBATCH = 4;
constexpr int RWC = 6592;
constexpr int PC = 15360;
constexpr int ATT0 = 6656, GATE0 = 11264;
constexpr int NEXP = 32, DFF = 2048, CAP = 16384;
constexpr int HROWS = 65536 + 32 * 256;
constexpr float LN_EPS = 1e-5f, GN_EPS = 64e-5f;
constexpr float DN_ALPHA = 1.189207115002721f;

__device__ __forceinline__ float bf2f(unsigned v) { return __uint_as_float(v << 16); }
__device__ __forceinline__ unsigned f2bf(float f) { unsigned u = __float_as_uint(f); return (u + 0x7fffu + ((u >> 16) & 1u)) >> 16; }
__device__ __forceinline__ unsigned pk2(float lo, float hi) { return f2bf(lo) | (f2bf(hi) << 16); }
__device__ __forceinline__ float sigmoidf_(float x) { return 1.0f / (1.0f + __expf(-x)); }
__device__ __forceinline__ float wave_sum(float v) {
#pragma unroll
    for (int o = 1; o < 64; o <<= 1) v += __shfl_xor(v, o);
    return v;
}
#define LDS_WAIT() asm volatile("s_waitcnt lgkmcnt(0)" ::: "memory")
#define VM_WAIT() asm volatile("s_waitcnt vmcnt(0)" ::: "memory")

namespace pg8 {
#define PG8_LAS __attribute__((address_space(3)))
constexpr int BM = 256, BK = 64, HALF = 128, HTB = HALF * BK * 2, STAGE_BYTES = 8 * HTB, NXCD = 8, WGM = 8;

__host__ __device__ __forceinline__ int lds_byte(int r, int c) { const int st = (r >> 4) * 2 + (c >> 5), rr = r & 15, cc = c & 31, ob = rr * 64 + cc * 2; return st * 1024 + (ob ^ (((ob >> 9) & 1) << 5)); }
__host__ __device__ __forceinline__ void stage_rc(int b, int& R, int& C) { const int st = b / 1024, sb = b % 1024, swz = sb ^ (((sb >> 9) & 1) << 5); R = (st >> 1) * 16 + swz / 64; C = (st & 1) * 32 + (swz % 64) / 2; }
__host__ __device__ __forceinline__ int perm32(int rho) { const int n = rho >> 4, i = rho & 15; return 8 * (i >> 2) + 4 * n + (i & 3); }

struct Unit { const char* A; const char* B; int orow, ocol, aux, aux2, valid; };
struct Gemm { int K, lda, ldb; };

struct StaticOrder {
    static constexpr bool GATHER = false;
    const char* A; const char* Bt; size_t ta, tb;
    int nM, nN, nwg, G, c;
    __device__ void init(const void* A_, const void* Bt_, int M_, int N_, int lda, int ldb, int G_, int c_) { A = (const char*)A_; Bt = (const char*)Bt_; ta = (size_t)BM * lda * 2; tb = (size_t)BM * ldb * 2; nM = M_ / BM; nN = N_ / BM; nwg = nM * nN; G = G_; c = c_; }
    __device__ bool next(int i, Unit& u) const {
        const long L = (long)i * G + c; if (c < 0 || L >= nwg) return false;
        int wgid = (int)L; { const int q = nwg / NXCD, r = nwg % NXCD, xcd = wgid % NXCD, off = wgid / NXCD; wgid = (xcd < r ? xcd * (q + 1) : r * (q + 1) + (xcd - r) * q) + off; }
        const int nig = WGM * nN, gid = wgid / nig, fm = gid * WGM, gsz = (nM - fm) < WGM ? (nM - fm) : WGM;
        const int pm = fm + ((wgid % nig) % gsz), pn = (wgid % nig) / gsz;
        u.A = A + (size_t)pm * ta; u.B = Bt + (size_t)pn * tb; u.orow = pm * BM; u.ocol = pn * BM; u.aux = 0; u.aux2 = 0; u.valid = BM; return true;
    }
    __device__ __forceinline__ const int* rows(const Unit&) const { return nullptr; }
};

__device__ __forceinline__ unsigned cvt_pk_bf16(float lo, float hi) { unsigned r; asm volatile("v_cvt_pk_bf16_f32 %0, %1, %2" : "=v"(r) : "v"(lo), "v"(hi)); return r; }

template <class Epi, class Sched, bool ALIGN_EPI = true>
__device__ __forceinline__ void gemm_phase(PG8_LAS unsigned char* lds, const Gemm g, const Sched& S, const Epi& E) {
    const int tid = threadIdx.x, wid = __builtin_amdgcn_readfirstlane(tid >> 6), lane = tid & 63, wr = wid >> 2, wc = wid & 3, fr = lane & 15, fq = lane >> 4;
    const int K = g.K, nt = K / BK;
    unsigned voffA[2], voffB[2]; int Rr[2], Cc[2];
#pragma unroll
    for (int i = 0; i < 2; ++i) { int R, C; stage_rc(tid * 16 + i * 8192, R, C); const int Rb = Epi::PERM ? ((R & ~31) + perm32(R & 31)) : R; Rr[i] = R; Cc[i] = C;
        voffA[i] = (unsigned)(R * g.lda + C) * 2u; voffB[i] = (unsigned)(Rb * g.ldb + C) * 2u; }
    const size_t kstep = (size_t)(BK * 2);
    const size_t hstepA = (size_t)HALF * g.lda * 2, hstepB = (size_t)HALF * g.ldb * 2;
    const unsigned ldsw = (unsigned)wid * 1024u;
    const int aoff = lds_byte(wr * 64 + fr, fq * 8), boff = lds_byte(wc * 32 + fr, fq * 8);
    unsigned vAc[2][2], vAn[2][2];
#define PG8_SA(b, h) (((b) * 2 + (h)) * HTB)
#define PG8_SB(b, h) ((4 + (b) * 2 + (h)) * HTB)
#define PG8_STAGE(bufoff, gbase, voff) do { _Pragma("unroll") for (int _i = 0; _i < 2; ++_i) \
        __builtin_amdgcn_global_load_lds((const unsigned*)((const char*)(gbase) + (voff)[_i]), (PG8_LAS unsigned*)(lds + (bufoff) + ldsw + _i * 8192), 16, 0, 0); } while (0)
#define PG8_STAGE_A(bufoff, kbase, h, nx) do { if constexpr (Sched::GATHER) { unsigned _v[2] = {(nx) ? vAn[h][0] : vAc[h][0], (nx) ? vAn[h][1] : vAc[h][1]}; PG8_STAGE(bufoff, kbase, _v); } \
        else { PG8_STAGE(bufoff, (kbase) + (h) * hstepA, voffA); } } while (0)
#define PG8_GOFF(u, v) do { const int* _rw = S.rows(u); _Pragma("unroll") for (int _h = 0; _h < 2; ++_h) _Pragma("unroll") for (int _i = 0; _i < 2; ++_i) { const int _r = Rr[_i] + _h * HALF; \
        const int _tk = _r < (u).valid ? _rw[_r] : 0; v[_h][_i] = (unsigned)(_tk * g.lda + Cc[_i]) * 2u; } } while (0)
#define PG8_LDA(dst, b, h) do { _Pragma("unroll") for (int m = 0; m < 4; ++m) _Pragma("unroll") for (int k = 0; k < 2; ++k) dst[m][k] = *(const PG8_LAS bf16x8*)(lds + PG8_SA(b, h) + aoff + m * 2048 + k * 1024); } while (0)
#define PG8_LDB(dst, b, h) do { _Pragma("unroll") for (int n = 0; n < 2; ++n) _Pragma("unroll") for (int k = 0; k < 2; ++k) dst[n][k] = *(const PG8_LAS bf16x8*)(lds + PG8_SB(b, h) + boff + n * 2048 + k * 1024); } while (0)
#define PG8_MMA(ai, bj, At, Bt) do { __builtin_amdgcn_s_setprio(1); _Pragma("unroll") for (int m = 0; m < 4; ++m) _Pragma("unroll") for (int n = 0; n < 2; ++n) _Pragma("unroll") for (int k = 0; k < 2; ++k) \
        acc[ai][bj][m][n] = __builtin_amdgcn_mfma_f32_16x16x32_bf16(Bt[n][k], At[m][k], acc[ai][bj][m][n], 0, 0, 0); __builtin_amdgcn_s_setprio(0); } while (0)
#define PG8_WAIT_V(n) asm volatile("s_waitcnt vmcnt(" #n ")" ::: "memory")
#define PG8_WAIT_L(n) asm volatile("s_waitcnt lgkmcnt(" #n ")" ::: "memory")
#define PG8_BAR __builtin_amdgcn_s_barrier()
#define PG8_SCHED __builtin_amdgcn_sched_barrier(0)
    Unit cur, nxt; int ui = 0;
    if (!S.next(0, cur)) return;
    f32x4 acc[2][2][4][2];
#pragma unroll
    for (int a = 0; a < 2; ++a)
#pragma unroll
        for (int b = 0; b < 2; ++b)
#pragma unroll
            for (int m = 0; m < 4; ++m)
#pragma unroll
                for (int n = 0; n < 2; ++n) acc[a][b][m][n] = (f32x4){0.f, 0.f, 0.f, 0.f};
    bf16x8 At[4][2], B0[2][2], B1[2][2];
    const char* cA = cur.A; const char* cB = cur.B;
    if constexpr (Sched::GATHER) { PG8_GOFF(cur, vAc); PG8_WAIT_V(0); }
    PG8_STAGE(PG8_SB(0, 0), cB, voffB); PG8_STAGE(PG8_SB(0, 1), cB + hstepB, voffB); PG8_STAGE_A(PG8_SA(0, 0), cA, 0, false); PG8_STAGE_A(PG8_SA(0, 1), cA, 1, false);
    if (wr == 1) PG8_BAR;
    PG8_WAIT_V(2); PG8_BAR;
    PG8_STAGE(PG8_SB(1, 0), cB + kstep, voffB); PG8_STAGE_A(PG8_SA(1, 0), cA + kstep, 0, false); PG8_STAGE(PG8_SB(1, 1), cB + hstepB + kstep, voffB);
    PG8_WAIT_V(6); PG8_BAR;
    for (;;) {
        const bool has_next = S.next(ui + 1, nxt);
        const char* nA = has_next ? nxt.A : cA; const char* nB = has_next ? nxt.B : cB;
        if constexpr (Sched::GATHER) { if (has_next) { PG8_GOFF(nxt, vAn); } else {
#pragma unroll
            for (int h = 0; h < 2; ++h)
#pragma unroll
                for (int i = 0; i < 2; ++i) vAn[h][i] = vAc[h][i]; } }
#pragma nounroll
        for (int t = 0; t < nt; t += 2) {
            const bool last = (t == nt - 2);
            const char* a1 = cA + (size_t)(t + 1) * kstep;
            const char* a2 = last ? nA : cA + (size_t)(t + 2) * kstep; const char* b2 = last ? nB : cB + (size_t)(t + 2) * kstep;
            const char* a3 = a2 + kstep; const char* b3 = b2 + kstep;
            PG8_LDB(B0, 0, 0); PG8_LDB(B1, 0, 1); PG8_SCHED; PG8_LDA(At, 0, 0); PG8_STAGE_A(PG8_SA(1, 1), a1, 1, false);
            PG8_WAIT_V(8); PG8_WAIT_L(0); PG8_BAR; PG8_MMA(0, 0, At, B0); PG8_MMA(0, 1, At, B1); PG8_BAR; PG8_SCHED;
            PG8_LDA(At, 0, 1); PG8_STAGE(PG8_SB(0, 0), b2, voffB); PG8_STAGE(PG8_SB(0, 1), b2 + hstepB, voffB); PG8_STAGE_A(PG8_SA(0, 0), a2, 0, last);
            PG8_WAIT_V(8); PG8_WAIT_L(0); PG8_BAR; PG8_MMA(1, 0, At, B0); PG8_MMA(1, 1, At, B1); PG8_BAR; PG8_SCHED;
            PG8_LDB(B0, 1, 0); PG8_LDB(B1, 1, 1); PG8_SCHED; PG8_LDA(At, 1, 0); PG8_STAGE_A(PG8_SA(0, 1), a2, 1, last);
            PG8_WAIT_V(8); PG8_WAIT_L(0); PG8_BAR; PG8_MMA(0, 0, At, B0); PG8_MMA(0, 1, At, B1); PG8_BAR; PG8_SCHED;
            PG8_LDA(At, 1, 1); PG8_STAGE(PG8_SB(1, 0), b3, voffB); PG8_STAGE(PG8_SB(1, 1), b3 + hstepB, voffB); PG8_STAGE_A(PG8_SA(1, 0), a3, 0, last);
            PG8_WAIT_V(8); PG8_WAIT_L(0); PG8_BAR; PG8_MMA(1, 0, At, B0); PG8_MMA(1, 1, At, B1); PG8_BAR; PG8_SCHED;
        }
        if constexpr (ALIGN_EPI) { if (wr == 0) PG8_BAR; }
        if constexpr (!Epi::AFTER_DRAIN) { E(acc, cur, wr, wc, fr, fq); }
        if (!has_next) break;
#pragma unroll
        for (int a = 0; a < 2; ++a)
#pragma unroll
            for (int b = 0; b < 2; ++b)
#pragma unroll
                for (int m = 0; m < 4; ++m)
#pragma unroll
                    for (int n = 0; n < 2; ++n) acc[a][b][m][n] = (f32x4){0.f, 0.f, 0.f, 0.f};
        cur = nxt; cA = nA; cB = nB; ++ui;
        if constexpr (Sched::GATHER) {
#pragma unroll
            for (int h = 0; h < 2; ++h)
#pragma unroll
                for (int i = 0; i < 2; ++i) vAc[h][i] = vAn[h][i]; }
        if constexpr (ALIGN_EPI) { if (wr == 1) PG8_BAR; }
    }
    PG8_WAIT_V(0);
    if constexpr (!ALIGN_EPI) { if (wr == 0) PG8_BAR; }
    PG8_BAR;
    if constexpr (Epi::AFTER_DRAIN) { E.fused(acc, cur, wr, wc, fr, fq, lds, wid, lane); }
#undef PG8_SA
#undef PG8_SB
#undef PG8_STAGE
#undef PG8_STAGE_A
#undef PG8_GOFF
#undef PG8_LDA
#undef PG8_LDB
#undef PG8_MMA
#undef PG8_WAIT_V
#undef PG8_WAIT_L
#undef PG8_BAR
#undef PG8_SCHED
}

#define EPI_LOOP_AI_M for (int ai = 0; ai < 2; ++ai) _Pragma("unroll") for (int m = 0; m < 4; ++m)

struct EpiF32 {
    static constexpr bool PERM = false, AFTER_DRAIN = false;
    float* C; int ldc; const float* bias; int bstride; const float* res; float alpha;
    __device__ __forceinline__ void operator()(const f32x4 (&acc)[2][2][4][2], const Unit& u, int wr, int wc, int fr, int fq) const {
        const int row0 = u.orow + wr * 64 + fr, col0 = u.ocol + wc * 32 + 4 * fq;
        f32x4 bv[2][2];
#pragma unroll
        for (int bj = 0; bj < 2; ++bj)
#pragma unroll
            for (int n = 0; n < 2; ++n) bv[bj][n] = bias ? *(const f32x4*)(bias + (size_t)u.aux * bstride + col0 + bj * HALF + n * 16) : (f32x4){0.f, 0.f, 0.f, 0.f};
#pragma unroll
        EPI_LOOP_AI_M { const size_t off = (size_t)(row0 + ai * HALF + m * 16) * ldc + col0;
#pragma unroll
            for (int bj = 0; bj < 2; ++bj)
#pragma unroll
                for (int n = 0; n < 2; ++n) { f32x4 v = acc[ai][bj][m][n] + bv[bj][n];
                    if (res) { const f32x4 rv = *(const f32x4*)(res + off + bj * HALF + n * 16); v = v + rv * alpha; }
                    *(f32x4*)(C + off + bj * HALF + n * 16) = v; }
            asm volatile("" ::: "memory"); }
    }
};
struct EpiBf16 {
    static constexpr bool PERM = true, AFTER_DRAIN = false;
    bf16_t* O; int ldc; float scale;
    __device__ __forceinline__ void operator()(const f32x4 (&acc)[2][2][4][2], const Unit& u, int wr, int wc, int fr, int fq) const {
        const int row0 = u.orow + wr * 64 + fr, col0 = u.ocol + wc * 32 + 8 * fq;
#pragma unroll
        EPI_LOOP_AI_M { bf16_t* rowp = O + (size_t)(row0 + ai * HALF + m * 16) * ldc + col0;
#pragma unroll
            for (int bj = 0; bj < 2; ++bj) { const f32x4 v0 = acc[ai][bj][m][0] * scale, v1 = acc[ai][bj][m][1] * scale;
                u32x4 w; w.x = cvt_pk_bf16(v0[0], v0[1]); w.y = cvt_pk_bf16(v0[2], v0[3]); w.z = cvt_pk_bf16(v1[0], v1[1]); w.w = cvt_pk_bf16(v1[2], v1[3]);
                *(u32x4*)(rowp + bj * HALF) = w; } }
    }
};
struct EpiKV {
    static constexpr bool PERM = true, AFTER_DRAIN = false;
    bf16_t* KB; bf16_t* VT;
    __device__ __forceinline__ void operator()(const f32x4 (&acc)[2][2][4][2], const Unit& u, int wr, int wc, int fr, int fq) const {
        const int row0 = u.orow + wr * 64 + fr, col0 = u.ocol + wc * 32 + 8 * fq;
#pragma unroll
        EPI_LOOP_AI_M { const int row = row0 + ai * HALF + m * 16;
#pragma unroll
            for (int bj = 0; bj < 2; ++bj) { const f32x4 v0 = acc[ai][bj][m][0], v1 = acc[ai][bj][m][1]; const int col = col0 + bj * HALF;
                if (u.ocol < 2048) { u32x4 w; w.x = cvt_pk_bf16(v0[0], v0[1]); w.y = cvt_pk_bf16(v0[2], v0[3]); w.z = cvt_pk_bf16(v1[0], v1[1]); w.w = cvt_pk_bf16(v1[2], v1[3]);
                    *(u32x4*)(KB + (size_t)row * 2048 + col) = w; }
                else { const int b = row >> 8, key = row & 255, c = col - 2048, h = c >> 9, d = c & 511; bf16_t* p = VT + ((size_t)((b * 4 + h) * 512 + d)) * 256 + key;
#pragma unroll
                    for (int j = 0; j < 4; ++j) { p[(size_t)j * 256] = (bf16_t)f2bf(v0[j]); p[(size_t)(4 + j) * 256] = (bf16_t)f2bf(v1[j]); } } } }
    }
};
struct EpiDecay {
    static constexpr bool PERM = false, AFTER_DRAIN = false;
    float* DEC; const float* w0;
    __device__ __forceinline__ void operator()(const f32x4 (&acc)[2][2][4][2], const Unit& u, int wr, int wc, int fr, int fq) const {
        const int row0 = u.orow + wr * 64 + fr, col0 = u.ocol + wc * 32 + 4 * fq;
        f32x4 bv[2][2];
#pragma unroll
        for (int bj = 0; bj < 2; ++bj)
#pragma unroll
            for (int n = 0; n < 2; ++n) bv[bj][n] = *(const f32x4*)(w0 + col0 + bj * HALF + n * 16);
#pragma unroll
        EPI_LOOP_AI_M { const size_t off = (size_t)(row0 + ai * HALF + m * 16) * D + col0;
#pragma unroll
            for (int bj = 0; bj < 2; ++bj)
#pragma unroll
                for (int n = 0; n < 2; ++n) { const f32x4 x = acc[ai][bj][m][n] + bv[bj][n]; f32x4 o;
#pragma unroll
                    for (int j = 0; j < 4; ++j) o[j] = __expf(-0.6065306597126334f * sigmoidf_(x[j]));
                    *(f32x4*)(DEC + off + bj * HALF + n * 16) = o; } }
    }
};
struct EpiIclr {
    static constexpr bool PERM = false, AFTER_DRAIN = false;
    const float* a0; const float* k_k; const float* k_a; const float* KZ; const float* KNORM; float* KP; float* AN; float* BB;
    __device__ __forceinline__ void operator()(const f32x4 (&acc)[2][2][4][2], const Unit& u, int wr, int wc, int fr, int fq) const {
        const int row0 = u.orow + wr * 64 + fr, col0 = u.ocol + wc * 32 + 4 * fq;
#pragma unroll
        for (int bj = 0; bj < 2; ++bj)
#pragma unroll
            for (int n = 0; n < 2; ++n) { const int col = col0 + bj * HALF + n * 16;
                const f32x4 a0v = *(const f32x4*)(a0 + col), kkv = *(const f32x4*)(k_k + col), kav = *(const f32x4*)(k_a + col);
#pragma unroll
                EPI_LOOP_AI_M { const int row = row0 + ai * HALF + m * 16; const size_t off = (size_t)row * D + col;
                    const f32x4 kz = *(const f32x4*)(KZ + off); const float nr = KNORM[(size_t)row * 32 + (col >> 6)]; const float inv = 1.0f / fmaxf(nr, 1e-12f);
                    const f32x4 x = acc[ai][bj][m][n] + a0v; f32x4 kp, an, bb;
#pragma unroll
                    for (int j = 0; j < 4; ++j) { const float a = sigmoidf_(x[j]); const float kk = kz[j] * kkv[j] * inv; kp[j] = kz[j] * (1.0f + (a - 1.0f) * kav[j]); bb[j] = kk * a; an[j] = -kk; }
                    *(f32x4*)(KP + off) = kp; *(f32x4*)(AN + off) = an; *(f32x4*)(BB + off) = bb; }
                asm volatile("" ::: "memory"); }
    }
};
struct EpiGateA {
    static constexpr bool PERM = false, AFTER_DRAIN = false;
    const bf16_t* PROJ; float* TMP;
    __device__ __forceinline__ void operator()(const f32x4 (&acc)[2][2][4][2], const Unit& u, int wr, int wc, int fr, int fq) const {
        const int row0 = u.orow + wr * 64 + fr, col0 = u.ocol + wc * 32 + 4 * fq;
#pragma unroll
        EPI_LOOP_AI_M { const int row = row0 + ai * HALF + m * 16;
#pragma unroll
            for (int bj = 0; bj < 2; ++bj)
#pragma unroll
                for (int n = 0; n < 2; ++n) { const int col = col0 + bj * HALF + n * 16; const u32x2 gv = *(const u32x2*)(PROJ + (size_t)row * PC + GATE0 + col);
                    const f32x4 a = acc[ai][bj][m][n]; f32x4 o;
                    o[0] = a[0] * sigmoidf_(bf2f(gv.x & 0xffffu)); o[1] = a[1] * sigmoidf_(bf2f(gv.x >> 16)); o[2] = a[2] * sigmoidf_(bf2f(gv.y & 0xffffu)); o[3] = a[3] * sigmoidf_(bf2f(gv.y >> 16));
                    *(f32x4*)(TMP + (size_t)row * D + col) = o; } }
    }
};
struct EpiGateB {
    static constexpr bool PERM = true, AFTER_DRAIN = false;
    const bf16_t* PROJ; const float* TMP; bf16_t* MERGED;
    __device__ __forceinline__ void operator()(const f32x4 (&acc)[2][2][4][2], const Unit& u, int wr, int wc, int fr, int fq) const {
        const int row0 = u.orow + wr * 64 + fr, col0 = u.ocol + wc * 32 + 8 * fq;
#pragma unroll
        EPI_LOOP_AI_M { const int row = row0 + ai * HALF + m * 16;
#pragma unroll
            for (int bj = 0; bj < 2; ++bj) { const int col = col0 + bj * HALF; const u32x4 gv = *(const u32x4*)(PROJ + (size_t)row * PC + GATE0 + 2048 + col);
                const f32x4 t0 = *(const f32x4*)(TMP + (size_t)row * D + col), t1 = *(const f32x4*)(TMP + (size_t)row * D + col + 4);
                const f32x4 a0 = acc[ai][bj][m][0], a1 = acc[ai][bj][m][1]; f32x4 o0, o1;
                o0[0] = t0[0] + a0[0] * sigmoidf_(bf2f(gv.x & 0xffffu)); o0[1] = t0[1] + a0[1] * sigmoidf_(bf2f(gv.x >> 16)); o0[2] = t0[2] + a0[2] * sigmoidf_(bf2f(gv.y & 0xffffu)); o0[3] = t0[3] + a0[3] * sigmoidf_(bf2f(gv.y >> 16));
                o1[0] = t1[0] + a1[0] * sigmoidf_(bf2f(gv.z & 0xffffu)); o1[1] = t1[1] + a1[1] * sigmoidf_(bf2f(gv.z >> 16)); o1[2] = t1[2] + a1[2] * sigmoidf_(bf2f(gv.w & 0xffffu)); o1[3] = t1[3] + a1[3] * sigmoidf_(bf2f(gv.w >> 16));
                u32x4 w; w.x = cvt_pk_bf16(o0[0], o0[1]); w.y = cvt_pk_bf16(o0[2], o0[3]); w.z = cvt_pk_bf16(o1[0], o1[1]); w.w = cvt_pk_bf16(o1[2], o1[3]);
                *(u32x4*)(MERGED + (size_t)row * D + col) = w; }
            asm volatile("" ::: "memory"); }
    }
};
struct EpiSwiglu {
    static constexpr bool PERM = true, AFTER_DRAIN = false;
    const float* b1; bf16_t* H;
    __device__ __forceinline__ float sw(float g, float l) const { g = fminf(g, 7.0f); l = fminf(fmaxf(l, -7.0f), 7.0f); return g * sigmoidf_(1.702f * g) * (l + 1.0f); }
    __device__ __forceinline__ void operator()(const f32x4 (&acc)[2][2][4][2], const Unit& u, int wr, int wc, int fr, int fq) const {
        const int row0 = u.orow + wr * 64 + fr, col0 = u.ocol + wc * 32 + 8 * fq;
        f32x4 bv[2][2];
#pragma unroll
        for (int bj = 0; bj < 2; ++bj)
#pragma unroll
            for (int n = 0; n < 2; ++n) bv[bj][n] = *(const f32x4*)(b1 + (size_t)u.aux * 4096 + col0 + bj * HALF + 4 * n);
#pragma unroll
        EPI_LOOP_AI_M { const int row = row0 + ai * HALF + m * 16;
#pragma unroll
            for (int bj = 0; bj < 2; ++bj) { const f32x4 v0 = acc[ai][bj][m][0] + bv[bj][0], v1 = acc[ai][bj][m][1] + bv[bj][1];
                u32x2 w; w.x = cvt_pk_bf16(sw(v0[0], v0[1]), sw(v0[2], v0[3])); w.y = cvt_pk_bf16(sw(v1[0], v1[1]), sw(v1[2], v1[3]));
                *(u32x2*)(H + (size_t)row * DFF + ((col0 + bj * HALF) >> 1)) = w; } }
    }
};
struct EpiSoftmax {
    static constexpr bool PERM = true, AFTER_DRAIN = true;
    bf16_t* PP;
    __device__ __forceinline__ void fused(f32x4 (&acc)[2][2][4][2], const Unit& u, int wr, int wc, int fr, int fq, PG8_LAS unsigned char* lds, int wid, int lane) const {
        PG8_LAS float* P1 = (PG8_LAS float*)lds;
        PG8_LAS float* P2 = (PG8_LAS float*)(lds + 4096);
        float mx[2][4];
#pragma unroll
        EPI_LOOP_AI_M { float v = -3.0e38f;
#pragma unroll
            for (int bj = 0; bj < 2; ++bj)
#pragma unroll
                for (int n = 0; n < 2; ++n) { const f32x4 x = acc[ai][bj][m][n]; v = fmaxf(v, fmaxf(fmaxf(x[0], x[1]), fmaxf(x[2], x[3]))); }
            v = fmaxf(v, __shfl_xor(v, 16)); v = fmaxf(v, __shfl_xor(v, 32));
            if (fq == 0) P1[(ai * HALF + wr * 64 + m * 16 + fr) * 4 + wc] = v; }
        asm volatile("s_waitcnt lgkmcnt(0)" ::: "memory"); __builtin_amdgcn_s_barrier(); asm volatile("" ::: "memory");
#pragma unroll
        EPI_LOOP_AI_M { const f32x4 t = *(const PG8_LAS f32x4*)(P1 + (ai * HALF + wr * 64 + m * 16 + fr) * 4); mx[ai][m] = fmaxf(fmaxf(t[0], t[1]), fmaxf(t[2], t[3])); }
#pragma unroll
        EPI_LOOP_AI_M { float s = 0.f;
#pragma unroll
            for (int bj = 0; bj < 2; ++bj)
#pragma unroll
                for (int n = 0; n < 2; ++n) { f32x4 x = acc[ai][bj][m][n];
#pragma unroll
                    for (int j = 0; j < 4; ++j) { x[j] = __expf(x[j] - mx[ai][m]); s += x[j]; }
                    acc[ai][bj][m][n] = x; }
            s += __shfl_xor(s, 16); s += __shfl_xor(s, 32);
            if (fq == 0) P2[(ai * HALF + wr * 64 + m * 16 + fr) * 4 + wc] = s; }
        asm volatile("s_waitcnt lgkmcnt(0)" ::: "memory"); __builtin_amdgcn_s_barrier(); asm volatile("" ::: "memory");
        const int row0 = u.orow + wr * 64 + fr, col0 = wc * 32 + 8 * fq;
#pragma unroll
        EPI_LOOP_AI_M { const f32x4 t = *(const PG8_LAS f32x4*)(P2 + (ai * HALF + wr * 64 + m * 16 + fr) * 4); const float inv = 1.0f / ((t[0] + t[1]) + (t[2] + t[3]));
            bf16_t* rowp = PP + (size_t)(row0 + ai * HALF + m * 16) * 256 + col0;
#pragma unroll
            for (int bj = 0; bj < 2; ++bj) { const f32x4 v0 = acc[ai][bj][m][0] * inv, v1 = acc[ai][bj][m][1] * inv;
                u32x4 w; w.x = cvt_pk_bf16(v0[0], v0[1]); w.y = cvt_pk_bf16(v0[2], v0[3]); w.z = cvt_pk_bf16(v1[0], v1[1]); w.w = cvt_pk_bf16(v1[2], v1[3]);
                *(u32x4*)(rowp + bj * HALF) = w; } }
        asm volatile("s_waitcnt lgkmcnt(0)" ::: "memory"); __builtin_amdgcn_s_barrier(); asm volatile("" ::: "memory");
    }
};
}

constexpr size_t MiB = 1u << 20;
constexpr size_t al256(size_t x) { return (x + 255) & ~(size_t)255; }
constexpr size_t WS_CTL = 0, CTL_ZERO_BYTES = 1 * MiB;
constexpr size_t WS_WIN = 1 * MiB;
constexpr size_t WS_WUP = WS_WIN + (size_t)PC * D * 2;
constexpr size_t WS_AUP = WS_WUP + (size_t)D * 256 * 2;
constexpr size_t WS_GUP = WS_AUP + (size_t)D * 256 * 2;
constexpr size_t WS_PA = WS_GUP + (size_t)D * 256 * 2;
constexpr size_t WS_PB = WS_PA + (size_t)D * D * 2;
constexpr size_t WS_WOUT = WS_PB + (size_t)D * 512 * 2;
constexpr size_t WS_WQ = WS_WOUT + (size_t)D * D * 2;
constexpr size_t WS_WKV = WS_WQ + (size_t)D * D * 2;
constexpr size_t WS_WO = WS_WKV + (size_t)2 * D * D * 2;
constexpr size_t WS_W1 = WS_WO + (size_t)D * D * 2;
constexpr size_t WS_W2 = WS_W1 + (size_t)NEXP * 4096 * D * 2;
constexpr size_t WS_XB = WS_W2 + (size_t)NEXP * D * DFF * 2;
constexpr size_t WS_MEMB = WS_XB + (size_t)M * D * 2;
constexpr size_t WS_ROT = WS_MEMB + (size_t)1024 * D * 2;
constexpr size_t WS_KB = WS_ROT + (size_t)2 * SEQ * 32 * 4;
constexpr size_t WS_VT = WS_KB + (size_t)1024 * D * 2;
constexpr size_t WS_YA = WS_VT + (size_t)1024 * D * 2;
constexpr size_t WS_YB = WS_YA + (size_t)M * D * 2;
constexpr size_t WS_TMP = WS_YB + (size_t)M * 512 * 2;
constexpr size_t WS_MERGED = WS_TMP + (size_t)M * D * 4;
constexpr size_t WS_E = WS_MERGED + (size_t)M * D * 2;
constexpr size_t WS_PROJ = WS_E;
constexpr size_t WS_RZ = WS_PROJ + (size_t)M * PC * 2;
constexpr size_t WS_KZ = WS_RZ + (size_t)M * D * 4;
constexpr size_t WS_VZ = WS_KZ + (size_t)M * D * 4;
constexpr size_t WS_DEC = WS_VZ + (size_t)M * D * 4;
constexpr size_t WS_KP = WS_DEC + (size_t)M * D * 4;
constexpr size_t WS_AN = WS_KP + (size_t)M * D * 4;
constexpr size_t WS_BB = WS_AN + (size_t)M * D * 4;
constexpr size_t WS_GG = WS_BB + (size_t)M * D * 4;
constexpr size_t WS_YS = WS_GG + (size_t)M * D * 4;
constexpr size_t WS_AO = WS_YS + (size_t)M * D * 4;
constexpr size_t WS_LSE = WS_AO + (size_t)3 * M * 512 * 4;
constexpr size_t WS_QR = WS_LSE + (size_t)3 * M * 8 * 4;
constexpr size_t WS_KR = WS_QR + (size_t)M * 1536 * 2;
constexpr size_t WS_LIN = WS_KR + (size_t)M * 1536 * 2;
constexpr size_t WS_KNORM = WS_LIN + (size_t)M * 768 * 2;
constexpr size_t WS_E_END = WS_KNORM + (size_t)M * 32 * 4;
constexpr size_t WS_T1 = WS_E;
constexpr size_t WS_X1 = WS_T1 + (size_t)M * D * 4;
constexpr size_t WS_X1B = WS_X1 + (size_t)M * D * 4;
constexpr size_t WS_Q = WS_X1B + (size_t)M * D * 2;
constexpr size_t WS_PP = WS_Q + (size_t)M * D * 2;
constexpr size_t WS_OC = WS_PP + (size_t)16 * SEQ * 256 * 2;
constexpr size_t WS_T2 = WS_OC + (size_t)M * D * 2;
constexpr size_t WS_X2 = WS_T2 + (size_t)M * D * 4;
constexpr size_t WS_X2B = WS_X2 + (size_t)M * D * 4;
constexpr size_t WS_LIST = WS_X2B + (size_t)M * D * 2;
constexpr size_t WS_ROWI = WS_LIST + (size_t)NEXP * CAP * 4;
constexpr size_t WS_TOPW = WS_ROWI + (size_t)M * 4 * 4;
constexpr size_t WS_H = WS_TOPW + (size_t)M * 4 * 4;
constexpr size_t WS_Y = WS_H + (size_t)HROWS * DFF * 2;
constexpr size_t WS_L_END = WS_Y + (size_t)HROWS * D * 4;
constexpr size_t WS_END = (WS_E_END > WS_L_END ? WS_E_END : WS_L_END);
constexpr int CW_TMO = 0, CW_CNT = 64  , CW_BAR = 4096;

constexpr int RING_BYTES = 131072, MISC_OFF = RING_BYTES, LDS_BYTES = 147456;

#define XB_TMO      128
#define XB_XCNT(j)  (256  + 64 * (j))
#define XB_XSUB(j)  (1280 + 64 * (j))
#define XB_XGEN(j)  (2304 + 64 * (j))
#define XB_TOP      3328
#define XB_TOPGEN   3392
#define XCD_BAR_WORDS 3456
#define XB_SPIN_CAP (1u << 18)
__device__ __forceinline__ unsigned xb_ld(unsigned* p)              { return __hip_atomic_load(p, __ATOMIC_RELAXED, __HIP_MEMORY_SCOPE_AGENT); }
__device__ __forceinline__ unsigned xb_add(unsigned* p, unsigned v) { return __hip_atomic_fetch_add(p, v, __ATOMIC_RELAXED, __HIP_MEMORY_SCOPE_AGENT); }
__device__ __forceinline__ unsigned xb_xcc_id() { return (unsigned)__builtin_amdgcn_s_getreg((3 << 11) | 20) & 0xFu; }
#define XB_SPIN(cond, bar) do { unsigned _sp = 0; while (cond) { __builtin_amdgcn_s_sleep(1); \
    if ((++_sp & 255u) == 0u) { if (xb_ld(&(bar)[XB_TMO])) break; if (_sp > XB_SPIN_CAP) { atomicAdd(&(bar)[XB_TMO], 1u); break; } } } } while (0)
struct XcdBarrier { unsigned* bar; unsigned x; volatile LAS unsigned* st; };
__device__ __forceinline__ XcdBarrier xcd_barrier_post(unsigned* bar, volatile LAS unsigned* st) {
    XcdBarrier b; b.bar = bar; b.x = xb_xcc_id(); b.st = st;
    if (threadIdx.x == 0) (void)xb_add(&bar[XB_XCNT(b.x)], 1u);
    return b;
}
__device__ __forceinline__ void xcd_barrier_complete(unsigned* bar, unsigned x, unsigned& nloc, unsigned& nx) {
    const unsigned G = gridDim.x * gridDim.y * gridDim.z;
    unsigned sum, cnt, mine, sp = 0u;
    for (;;) {
        sum = 0u; cnt = 0u; mine = 0u;
#pragma unroll
        for (unsigned j = 0; j < 16; ++j) { const unsigned c = xb_ld(&bar[XB_XCNT(j)]); sum += c; cnt += (c > 0u) ? 1u : 0u; mine = (j == x) ? c : mine; }
        if (sum == G) break;
        __builtin_amdgcn_s_sleep(1);
        if ((++sp & 255u) == 0u) { if (xb_ld(&bar[XB_TMO])) break; if (sp > XB_SPIN_CAP) { atomicAdd(&bar[XB_TMO], 1u); break; } }
    }
    nloc = mine > 0u ? mine : 1u; nx = cnt > 0u ? cnt : 1u;
}
__device__ __forceinline__ void xcd_barrier(const XcdBarrier& b) {
    asm volatile("s_waitcnt vmcnt(0)" ::: "memory");
    __syncthreads();
    if (threadIdx.x == 0) {
        unsigned* bar = b.bar;
        __builtin_amdgcn_s_waitcnt(0);
        unsigned nloc = b.st[0], nx = b.st[1];
        if (nloc == 0u) { xcd_barrier_complete(bar, b.x, nloc, nx); b.st[0] = nloc; b.st[1] = nx; }
        const unsigned old = xb_add(&bar[XB_XSUB(b.x)], 1u);
        const unsigned gen = old / nloc;
        if (old + 1u == (gen + 1u) * nloc) {
            __builtin_amdgcn_fence(__ATOMIC_RELEASE, "agent");
            asm volatile("s_waitcnt vmcnt(0)" ::: "memory");
            const unsigned og = xb_add(&bar[XB_TOP], 1u);
            const unsigned tg = og / nx;
            if (og + 1u == (tg + 1u) * nx) xb_add(&bar[XB_TOPGEN], 1u);
            else XB_SPIN(xb_ld(&bar[XB_TOPGEN]) == tg, bar);
            __builtin_amdgcn_fence(__ATOMIC_ACQUIRE, "agent");
            xb_add(&bar[XB_XGEN(b.x)], 1u);
            asm volatile("s_waitcnt vmcnt(0)" ::: "memory");
        } else {
            XB_SPIN(xb_ld(&bar[XB_XGEN(b.x)]) == gen, bar);
            __builtin_amdgcn_fence(__ATOMIC_ACQUIRE, "agent");
            asm volatile("s_waitcnt vmcnt(0)" ::: "memory");
        }
    }
    __syncthreads();
}

struct Params {
    const float* in[32];
    float* out; unsigned char* ws;
    int ph_lo, ph_hi;
};
enum { I_X = 0, I_MEM, I_WIN, I_MIX, I_W0, I_WUP, I_A0, I_AUP, I_GUP, I_KK, I_KA, I_RK, I_LNXG, I_LNXB, I_PA, I_PB, I_WOUT, I_LN1G, I_LN1B, I_WQ, I_WKV, I_WO, I_LN2G, I_LN2B,
       I_RW, I_RB, I_W1, I_B1, I_W2, I_B2, I_LN3G, I_LN3B };

struct ScoreOrder {
    static constexpr bool GATHER = false;
    const char* Q; const char* KB; int G, c;
    __device__ bool next(int i, pg8::Unit& u) const {
        const int L = i * G + c; if (L >= 256) return false;
        const int bh = L >> 4, pm = L & 15, b = bh >> 2, h = bh & 3;
        u.A = Q + ((size_t)(b * SEQ + 256 * pm) * D + h * 512) * 2; u.B = KB + ((size_t)(b * 256) * D + h * 512) * 2;
        u.orow = bh * SEQ + 256 * pm; u.ocol = 0; u.aux = 0; u.aux2 = 0; u.valid = 256; return true;
    }
    __device__ __forceinline__ const int* rows(const pg8::Unit&) const { return nullptr; }
};
struct PvOrder {
    static constexpr bool GATHER = false;
    const char* PP; const char* VT; int G, c;
    __device__ bool next(int i, pg8::Unit& u) const {
        const int L = i * G + c; if (L >= 512) return false;
        const int bh = L >> 5, pm = (L >> 1) & 15, pn = L & 1, b = bh >> 2, h = bh & 3;
        u.A = PP + ((size_t)(bh * SEQ + 256 * pm) * 256) * 2; u.B = VT + ((size_t)(bh * 512 + 256 * pn) * 256) * 2;
        u.orow = b * SEQ + 256 * pm; u.ocol = h * 512 + 256 * pn; u.aux = 0; u.aux2 = 0; u.valid = 256; return true;
    }
    __device__ __forceinline__ const int* rows(const pg8::Unit&) const { return nullptr; }
};
template <bool GATHER_, int NT  > struct MoeOrder {
    static constexpr bool GATHER = GATHER_;
    const LAS int* tab; const char* A; const char* W; const int* list; size_t wexp  ; int ldb; int G, c;
    __device__ bool next(int i, pg8::Unit& u) const {
        constexpr int RPR = 256 / NT;
        const int rt = i * RPR + (c % RPR), pn = c / RPR, T = tab[64];
        if (c >= 256 || rt >= T) return false;
        int e = 0;
        for (int j = 1; j < NEXP; ++j) e = (rt >= tab[32 + j]) ? j : e;
        const int lt = rt - tab[32 + e];
        u.aux = e; u.aux2 = lt; u.valid = min(256, tab[e] - 256 * lt); u.orow = 256 * rt; u.ocol = 256 * pn;
        u.B = W + (size_t)e * wexp + (size_t)(256 * pn) * ldb * 2;
        u.A = GATHER_ ? A : A + (size_t)(256 * rt) * DFF * 2;
        return true;
    }
    __device__ __forceinline__ const int* rows(const pg8::Unit& u) const { return list + (size_t)u.aux * CAP + 256 * u.aux2; }
};

struct Ctx { int tid, lane, wave, vcu, G; LAS unsigned char* lds; unsigned char* ws; };

__device__ __forceinline__ void tr_item(const float* W, int ldw, int Ksrc, int sc0, bf16_t* WT, int ldt, int n0, int k0, LAS float* scr, int lane) {
#pragma unroll 8
    for (int i = 0; i < 32; ++i) { const int kk = 2 * i + (lane >> 5); float v = 0.f; if (sc0 >= 0 && (k0 + kk) < Ksrc) v = W[(size_t)(k0 + kk) * ldw + sc0 + (lane & 31)]; scr[kk * 33 + (lane & 31)] = v; }
    LDS_WAIT(); asm volatile("" ::: "memory");
    const int c = lane & 7;
#pragma unroll
    for (int j = 0; j < 4; ++j) { const int n = (lane >> 3) + 8 * j; const LAS float* s = scr + (8 * c) * 33 + n;
        u32x4 o; o.x = pk2(s[0 * 33], s[1 * 33]); o.y = pk2(s[2 * 33], s[3 * 33]); o.z = pk2(s[4 * 33], s[5 * 33]); o.w = pk2(s[6 * 33], s[7 * 33]);
        *(u32x4*)(WT + (size_t)(n0 + n) * ldt + k0 + 8 * c) = o; }
    LDS_WAIT(); asm volatile("" ::: "memory");
}
__device__ __forceinline__ void tr_job(const float* W, int N, int Ksrc, int Kdst, bf16_t* WT, int item, LAS float* scr, int lane) {
    const int nblk = N / 32, kb = item / nblk, nb = item % nblk;
    tr_item(W, N, Ksrc, 32 * nb, WT, Kdst, 32 * nb, 64 * kb, scr, lane);
}
__device__ __forceinline__ void p0_prologue(const Params& p, const Ctx& c) {
    LAS float* scr = (LAS float*)(c.lds + c.wave * 16384);
    const int gw = c.vcu * 8 + c.wave, NGW = c.G * 8;
    unsigned char* ws = c.ws;
    constexpr int I_WINJ = 32 * 480, I_LORA = 4 * 64, I_SQ = 32 * 64, I_PBJ = 8 * 64, I_KVJ = 32 * 128, I_W1E = 32 * 128, I_W2E = 32 * 64;
    constexpr int NITEMS = I_WINJ + 3 * I_LORA + 4 * I_SQ + I_PBJ + I_KVJ + NEXP * I_W1E + NEXP * I_W2E;
    for (int it = gw; it < NITEMS; it += NGW) {
        int r = it;
        if (r < I_WINJ) { const int kb = r / 480, nb = r % 480; const int sc0 = nb < 206 ? 32 * nb : (nb < 208 ? -1 : 32 * nb - 64);
            tr_item(p.in[I_WIN], 15296, D, sc0, (bf16_t*)(ws + WS_WIN), D, 32 * nb, 64 * kb, scr, c.lane); continue; } r -= I_WINJ;
        if (r < I_LORA) { tr_job(p.in[I_WUP], D, 96, 256, (bf16_t*)(ws + WS_WUP), r, scr, c.lane); continue; } r -= I_LORA;
        if (r < I_LORA) { tr_job(p.in[I_AUP], D, 96, 256, (bf16_t*)(ws + WS_AUP), r, scr, c.lane); continue; } r -= I_LORA;
        if (r < I_LORA) { tr_job(p.in[I_GUP], D, 256, 256, (bf16_t*)(ws + WS_GUP), r, scr, c.lane); continue; } r -= I_LORA;
        if (r < I_SQ) { tr_job(p.in[I_PA], D, D, D, (bf16_t*)(ws + WS_PA), r, scr, c.lane); continue; } r -= I_SQ;
        if (r < I_PBJ) { tr_job(p.in[I_PB], D, 512, 512, (bf16_t*)(ws + WS_PB), r, scr, c.lane); continue; } r -= I_PBJ;
        if (r < I_SQ) { tr_job(p.in[I_WOUT], D, D, D, (bf16_t*)(ws + WS_WOUT), r, scr, c.lane); continue; } r -= I_SQ;
        if (r < I_SQ) { tr_job(p.in[I_WQ], D, D, D, (bf16_t*)(ws + WS_WQ), r, scr, c.lane); continue; } r -= I_SQ;
        if (r < I_KVJ) { tr_job(p.in[I_WKV], 2 * D, D, D, (bf16_t*)(ws + WS_WKV), r, scr, c.lane); continue; } r -= I_KVJ;
        if (r < I_SQ) { tr_job(p.in[I_WO], D, D, D, (bf16_t*)(ws + WS_WO), r, scr, c.lane); continue; } r -= I_SQ;
        if (r < NEXP * I_W1E) { const int e = r / I_W1E; tr_job(p.in[I_W1] + (size_t)e * D * 4096, 4096, D, D, (bf16_t*)(ws + WS_W1) + (size_t)e * 4096 * D, r % I_W1E, scr, c.lane); continue; } r -= NEXP * I_W1E;
        { const int e = r / I_W2E; tr_job(p.in[I_W2] + (size_t)e * DFF * D, D, DFF, DFF, (bf16_t*)(ws + WS_W2) + (size_t)e * D * DFF, r % I_W2E, scr, c.lane); }
    }
    const size_t gt = (size_t)c.vcu * 512 + c.tid, NT = (size_t)c.G * 512;
    for (size_t i = gt; i < (size_t)M * D / 8; i += NT) { const f32x4 a = ((const f32x4*)p.in[I_X])[2 * i], b = ((const f32x4*)p.in[I_X])[2 * i + 1];
        u32x4 o; o.x = pk2(a[0], a[1]); o.y = pk2(a[2], a[3]); o.z = pk2(b[0], b[1]); o.w = pk2(b[2], b[3]); ((u32x4*)(ws + WS_XB))[i] = o; }
    for (size_t i = gt; i < (size_t)1024 * D / 8; i += NT) { const f32x4 a = ((const f32x4*)p.in[I_MEM])[2 * i], b = ((const f32x4*)p.in[I_MEM])[2 * i + 1];
        u32x4 o; o.x = pk2(a[0], a[1]); o.y = pk2(a[2], a[3]); o.z = pk2(b[0], b[1]); o.w = pk2(b[2], b[3]); ((u32x4*)(ws + WS_MEMB))[i] = o; }
    float* rc = (float*)(ws + WS_ROT); float* rs = rc + SEQ * 32;
    for (size_t i = gt; i < (size_t)SEQ * 32; i += NT) { const int pos = (int)(i >> 5), j = (int)(i & 31);
        const double inv = exp(-(double)j * (9.210340371976184 / 32.0)); const double ang = (double)pos * inv; rc[i] = (float)cos(ang); rs[i] = (float)sin(ang); }
}

__device__ __forceinline__ void p2_prep(const Params& p, const Ctx& c) {
    unsigned char* ws = c.ws;
    const bf16_t* PROJ = (const bf16_t*)(ws + WS_PROJ);
    const float* mix = p.in[I_MIX]; const float* k_k = p.in[I_KK];
    float* RZ = (float*)(ws + WS_RZ); float* KZ = (float*)(ws + WS_KZ); float* VZ = (float*)(ws + WS_VZ);
    bf16_t* LIN = (bf16_t*)(ws + WS_LIN); float* KNORM = (float*)(ws + WS_KNORM);
    bf16_t* QR = (bf16_t*)(ws + WS_QR); bf16_t* KR = (bf16_t*)(ws + WS_KR);
    const float* rc = (const float*)(ws + WS_ROT); const float* rs = rc + SEQ * 32;
    for (int t = c.vcu; t < M; t += c.G) {
        const int pos = t & (SEQ - 1);
        const bf16_t* cur = PROJ + (size_t)t * PC;
        for (int ch = c.tid; ch < 824; ch += 512) {
            const u32x4 cv = *(const u32x4*)(cur + 8 * ch); u32x4 pv = (u32x4){0u, 0u, 0u, 0u}; if (pos > 0) pv = *(const u32x4*)(cur - PC + 8 * ch);
            const f32x4 m0 = *(const f32x4*)(mix + 8 * ch), m1 = *(const f32x4*)(mix + 8 * ch + 4);
            float z[8];
            { const unsigned cw[4] = {cv.x, cv.y, cv.z, cv.w}, pw[4] = {pv.x, pv.y, pv.z, pv.w};
              const float mm[8] = {m0[0], m0[1], m0[2], m0[3], m1[0], m1[1], m1[2], m1[3]};
#pragma unroll
              for (int j = 0; j < 4; ++j) { const float c0 = bf2f(cw[j] & 0xffffu), c1 = bf2f(cw[j] >> 16), q0 = bf2f(pw[j] & 0xffffu), q1 = bf2f(pw[j] >> 16);
                  z[2 * j] = c0 + (q0 - c0) * mm[2 * j]; z[2 * j + 1] = c1 + (q1 - c1) * mm[2 * j + 1]; } }
            if (ch < 768) {
                float* dst = (ch < 256 ? RZ : (ch < 512 ? KZ : VZ)) + (size_t)t * D + 8 * (ch & 255);
                *(f32x4*)dst = (f32x4){z[0], z[1], z[2], z[3]}; *(f32x4*)(dst + 4) = (f32x4){z[4], z[5], z[6], z[7]};
                if (ch >= 256 && ch < 512) {
                    const int col = 8 * (ch - 256); const f32x4 k0 = *(const f32x4*)(k_k + col), k1 = *(const f32x4*)(k_k + col + 4);
                    float s = 0.f;
#pragma unroll
                    for (int j = 0; j < 4; ++j) { const float a = z[j] * k0[j], b = z[4 + j] * k1[j]; s += a * a + b * b; }
                    s += __shfl_xor(s, 1); s += __shfl_xor(s, 2); s += __shfl_xor(s, 4);
                    if ((ch & 7) == 0) KNORM[(size_t)t * 32 + ((ch - 256) >> 3)] = sqrtf(s);
                }
            } else {
                float o[8]; int dcol;
                if (ch < 780) { dcol = 8 * (ch - 768);
#pragma unroll
                    for (int j = 0; j < 8; ++j) o[j] = tanhf(z[j]); }
                else if (ch < 792) { dcol = 256 + 8 * (ch - 780);
#pragma unroll
                    for (int j = 0; j < 8; ++j) o[j] = z[j]; }
                else { dcol = 512 + 8 * (ch - 792);
#pragma unroll
                    for (int j = 0; j < 8; ++j) o[j] = sigmoidf_(z[j]); }
                u32x4 w; w.x = pk2(o[0], o[1]); w.y = pk2(o[2], o[3]); w.z = pk2(o[4], o[5]); w.w = pk2(o[6], o[7]);
                *(u32x4*)(LIN + (size_t)t * 768 + dcol) = w;
            }
        }
        if (c.tid < 40) { const int dcol = (c.tid < 20) ? 96 + 8 * c.tid : 352 + 8 * (c.tid - 20); *(u32x4*)(LIN + (size_t)t * 768 + dcol) = (u32x4){0u, 0u, 0u, 0u}; }
        if (c.tid >= 64 && c.tid < 64 + 192) { const int w = c.tid - 64, which = w / 96, hh = (w % 96) >> 2, e0 = (w & 3) * 8;
            const bf16_t* src = cur + ATT0 + which * 1536 + hh * 64 + e0;
            const u32x4 a = *(const u32x4*)src, b = *(const u32x4*)(src + 32);
            const f32x4 c0 = *(const f32x4*)(rc + pos * 32 + e0), c1 = *(const f32x4*)(rc + pos * 32 + e0 + 4), s0 = *(const f32x4*)(rs + pos * 32 + e0), s1 = *(const f32x4*)(rs + pos * 32 + e0 + 4);
            const unsigned aw[4] = {a.x, a.y, a.z, a.w}, bw[4] = {b.x, b.y, b.z, b.w}; float o1[8], o2[8];
#pragma unroll
            for (int j = 0; j < 8; ++j) { const float t1 = bf2f((aw[j >> 1] >> (16 * (j & 1))) & 0xffffu), t2 = bf2f((bw[j >> 1] >> (16 * (j & 1))) & 0xffffu);
                const float cs = j < 4 ? c0[j & 3] : c1[j & 3], sn = j < 4 ? s0[j & 3] : s1[j & 3]; o1[j] = t1 * cs - t2 * sn; o2[j] = t2 * cs + t1 * sn; }
            bf16_t* dst = (which ? KR : QR) + (size_t)t * 1536 + hh * 64 + e0;
            u32x4 w1; w1.x = pk2(o1[0], o1[1]); w1.y = pk2(o1[2], o1[3]); w1.z = pk2(o1[4], o1[5]); w1.w = pk2(o1[6], o1[7]);
            u32x4 w2; w2.x = pk2(o2[0], o2[1]); w2.y = pk2(o2[2], o2[3]); w2.z = pk2(o2[4], o2[5]); w2.w = pk2(o2[6], o2[7]);
            *(u32x4*)dst = w1; *(u32x4*)(dst + 32) = w2; }
    }
}

__device__ __forceinline__ float quad_sum(float x) {
    x += __builtin_bit_cast(float, __builtin_amdgcn_update_dpp(0, __builtin_bit_cast(int, x), 0xB1, 0xF, 0xF, true));
    x += __builtin_bit_cast(float, __builtin_amdgcn_update_dpp(0, __builtin_bit_cast(int, x), 0x4E, 0xF, 0xF, true));
    return x;
}
__device__ __forceinline__ void p4_scan(const Ctx& c, int bh) {
    constexpr int TS = 16;
    unsigned char* ws = c.ws;
    const float* src[6] = {(const float*)(ws + WS_RZ), (const float*)(ws + WS_DEC), (const float*)(ws + WS_KP), (const float*)(ws + WS_VZ), (const float*)(ws + WS_AN), (const float*)(ws + WS_BB)};
    float* YS = (float*)(ws + WS_YS);
    LAS float* buf = (LAS float*)c.lds;
    const int b = bh >> 5, h = bh & 31, tid = c.tid;
    const size_t base = (size_t)b * SEQ * D + h * 64;
    const int i = (tid >> 2) & 63, q = tid & 3;
    float S[16];
#pragma unroll
    for (int j = 0; j < 16; ++j) S[j] = 0.f;
    f32x4 pre[6];
#define SCAN_ISSUE(T0) do { _Pragma("unroll") for (int j = 0; j < 6; ++j) { const int e4 = tid + 256 * j, s_ = e4 / 96, rem = e4 % 96, v_ = rem >> 4, c4 = rem & 15; \
            const float* sp = v_ == 0 ? src[0] : v_ == 1 ? src[1] : v_ == 2 ? src[2] : v_ == 3 ? src[3] : v_ == 4 ? src[4] : src[5]; \
            pre[j] = *(const f32x4*)(sp + base + (size_t)((T0) + s_) * D + c4 * 4); } } while (0)
    if (tid < 256) SCAN_ISSUE(0);
    for (int t0 = 0; t0 < SEQ; t0 += TS) {
        __syncthreads();
        if (tid < 256) {
#pragma unroll
            for (int j = 0; j < 6; ++j) { const int e4 = tid + 256 * j; *(LAS f32x4*)(buf + 4 * e4) = pre[j]; }
        }
        __syncthreads();
        if (tid < 256) {
            if (t0 + TS < SEQ) SCAN_ISSUE(t0 + TS);
            for (int s = 0; s < TS; ++s) {
                const LAS float* st = buf + s * 384;
                f32x4 av[4], bv[4], wv[4], kv[4], rv[4];
#pragma unroll
                for (int j = 0; j < 4; ++j) { av[j] = *(const LAS f32x4*)(st + 4 * 64 + 16 * q + 4 * j); wv[j] = *(const LAS f32x4*)(st + 1 * 64 + 16 * q + 4 * j);
                    bv[j] = *(const LAS f32x4*)(st + 5 * 64 + 16 * q + 4 * j); kv[j] = *(const LAS f32x4*)(st + 2 * 64 + 16 * q + 4 * j); rv[j] = *(const LAS f32x4*)(st + 0 * 64 + 16 * q + 4 * j); }
                const float vi = st[3 * 64 + i];
                float sa = 0.f;
#pragma unroll
                for (int j = 0; j < 16; ++j) sa += S[j] * av[j >> 2][j & 3];
                sa = quad_sum(sa);
                float y = 0.f;
#pragma unroll
                for (int j = 0; j < 16; ++j) { S[j] = S[j] * wv[j >> 2][j & 3] + sa * bv[j >> 2][j & 3] + vi * kv[j >> 2][j & 3]; y += S[j] * rv[j >> 2][j & 3]; }
                y = quad_sum(y);
                if (q == 0) YS[base + (size_t)(t0 + s) * D + i] = y;
            }
        }
    }
    __syncthreads();
#undef SCAN_ISSUE
}

__device__ __forceinline__ void p4_attn_task(const Ctx& c, int task) {
    unsigned char* ws = c.ws;
    const bf16_t* QR = (const bf16_t*)(ws + WS_QR); const bf16_t* KR = (const bf16_t*)(ws + WS_KR); const bf16_t* PROJ = (const bf16_t*)(ws + WS_PROJ);
    float* AO = (float*)(ws + WS_AO); float* LSE = (float*)(ws + WS_LSE);
    constexpr int VP = 280;
    LAS bf16_t* Vt = (LAS bf16_t*)c.lds;
    const int combo = task & 31, hh = (task >> 5) % 24, b = task / (32 * 24);
    const int g = hh >> 3, h = hh & 7;
    const int dil = g == 0 ? 1 : (g == 1 ? 4 : 16);
    const int res = combo % dil, blk = combo / dil;
    const int tid = c.tid, lane = c.lane, w = c.wave;
    __syncthreads();
    {
        const int ki = tid >> 1, dh = tid & 1; const int pk = (blk - 1) * 128 + ki;
        u32x4 v[4];
        if (pk >= 0) { const bf16_t* sp = PROJ + ((size_t)b * SEQ + (size_t)pk * dil + res) * PC + ATT0 + 2 * 1536 + hh * 64 + 32 * dh;
#pragma unroll
            for (int j = 0; j < 4; ++j) v[j] = *(const u32x4*)(sp + 8 * j); }
        else {
#pragma unroll
            for (int j = 0; j < 4; ++j) v[j] = (u32x4){0u, 0u, 0u, 0u}; }
#pragma unroll
        for (int j = 0; j < 4; ++j) { const unsigned wv[4] = {v[j].x, v[j].y, v[j].z, v[j].w};
#pragma unroll
            for (int e = 0; e < 8; ++e) Vt[(32 * dh + 8 * j + e) * VP + ki] = (bf16_t)((wv[e >> 1] >> (16 * (e & 1))) & 0xffffu); }
        if (tid < 64) {
#pragma unroll
            for (int e = 0; e < 24; ++e) Vt[tid * VP + 256 + e] = 0; }
    }
    __syncthreads();
    const int qq = lane & 15, g4 = lane >> 4;
    const int r0 = 16 * w;
    const size_t qtok = (size_t)b * SEQ + (size_t)(blk * 128 + r0 + qq) * dil + res;
    bf16x8 qf[2];
#pragma unroll
    for (int ks = 0; ks < 2; ++ks) qf[ks] = *(const bf16x8*)(QR + qtok * 1536 + hh * 64 + 32 * ks + 8 * g4);
    f32x4 sc[10];
#pragma unroll
    for (int kt = 0; kt < 9; ++kt) {
        const int ki = 16 * (w + kt) + qq; const int pk = (blk - 1) * 128 + ki;
        f32x4 a = (f32x4){0.f, 0.f, 0.f, 0.f};
#pragma unroll
        for (int ks = 0; ks < 2; ++ks) { bf16x8 kf = (bf16x8){0, 0, 0, 0, 0, 0, 0, 0};
            if (pk >= 0) kf = *(const bf16x8*)(KR + ((size_t)b * SEQ + (size_t)pk * dil + res) * 1536 + hh * 64 + 32 * ks + 8 * g4);
            a = __builtin_amdgcn_mfma_f32_16x16x32_bf16(kf, qf[ks], a, 0, 0, 0); }
        sc[kt] = a;
    }
    const int r = r0 + qq;
    float mx = -3.0e38f;
#pragma unroll
    for (int kt = 0; kt < 9; ++kt)
#pragma unroll
        for (int j = 0; j < 4; ++j) { const int ki = 16 * (w + kt) + 4 * g4 + j; const bool ok = (ki >= r) && (ki <= r + 128) && (blk > 0 || ki >= 128);
            const float s = ok ? sc[kt][j] * 0.125f : -1.0e30f; sc[kt][j] = s; mx = fmaxf(mx, s); }
    mx = fmaxf(mx, __shfl_xor(mx, 16)); mx = fmaxf(mx, __shfl_xor(mx, 32));
    float den = 0.f;
#pragma unroll
    for (int kt = 0; kt < 9; ++kt)
#pragma unroll
        for (int j = 0; j < 4; ++j) { const float pexp = __expf(sc[kt][j] - mx); sc[kt][j] = pexp; den += pexp; }
    den += __shfl_xor(den, 16); den += __shfl_xor(den, 32);
    sc[9] = (f32x4){0.f, 0.f, 0.f, 0.f};
    f32x4 oacc[4];
#pragma unroll
    for (int dt = 0; dt < 4; ++dt) oacc[dt] = (f32x4){0.f, 0.f, 0.f, 0.f};
#pragma unroll
    for (int cidx = 0; cidx < 5; ++cidx) {
        const f32x4 p0 = sc[2 * cidx], p1 = sc[2 * cidx + 1];
        u32x4 pw; pw.x = pk2(p0[0], p0[1]); pw.y = pk2(p0[2], p0[3]); pw.z = pk2(p1[0], p1[1]); pw.w = pk2(p1[2], p1[3]);
        const bf16x8 pf = __builtin_bit_cast(bf16x8, pw);
        const int kbase = 16 * (w + 2 * cidx) + 4 * g4;
#pragma unroll
        for (int dt = 0; dt < 4; ++dt) { const LAS bf16_t* vp = Vt + (16 * dt + qq) * VP + kbase;
            const u32x2 lo = *(const LAS u32x2*)vp, hi = *(const LAS u32x2*)(vp + 16);
            u32x4 vw; vw.x = lo.x; vw.y = lo.y; vw.z = hi.x; vw.w = hi.y;
            oacc[dt] = __builtin_amdgcn_mfma_f32_16x16x32_bf16(__builtin_bit_cast(bf16x8, vw), pf, oacc[dt], 0, 0, 0); }
    }
    const float inv = 1.0f / den;
    const size_t tok = qtok;
#pragma unroll
    for (int dt = 0; dt < 4; ++dt) *(f32x4*)(AO + ((size_t)g * M + tok) * 512 + h * 64 + 16 * dt + 4 * g4) = oacc[dt] * inv;
    if (g4 == 0) LSE[((size_t)g * M + tok) * 8 + h] = mx + __logf(den);
}

__device__ __forceinline__ void p5_post(const Params& p, const Ctx& c) {
    unsigned char* ws = c.ws;
    const float* YS = (const float*)(ws + WS_YS); const float* RZ = (const float*)(ws + WS_RZ); const float* KP = (const float*)(ws + WS_KP); const float* VZ = (const float*)(ws + WS_VZ);
    const float* GG = (const float*)(ws + WS_GG); const float* AO = (const float*)(ws + WS_AO); const float* LSE = (const float*)(ws + WS_LSE);
    bf16_t* YA = (bf16_t*)(ws + WS_YA); bf16_t* YB = (bf16_t*)(ws + WS_YB);
    const float* lg = p.in[I_LNXG]; const float* lb = p.in[I_LNXB]; const float* rk = p.in[I_RK];
    const int gw = c.vcu * 8 + c.wave, NGW = c.G * 8, lane = c.lane;
    for (int it = gw; it < M * 32; it += NGW) {
        const size_t o = (size_t)it * 64 + lane; const int col = (it & 31) * 64 + lane;
        const float y = YS[o]; const float mu = wave_sum(y) * (1.0f / 64.0f); const float dlt = y - mu; const float var = wave_sum(dlt * dlt) * (1.0f / 64.0f);
        const float yn = dlt * rsqrtf(var + GN_EPS) * lg[col] + lb[col];
        const float v = VZ[o]; const float bonus = wave_sum(RZ[o] * KP[o] * rk[col]) * v;
        YA[o] = (bf16_t)f2bf((yn + bonus) * GG[o]);
    }
    for (int it = gw; it < M * 8; it += NGW) {
        const int t = it >> 3, h = it & 7;
        const float l0 = LSE[((size_t)0 * M + t) * 8 + h], l1 = LSE[((size_t)1 * M + t) * 8 + h], l2 = LSE[((size_t)2 * M + t) * 8 + h];
        const float mxl = fmaxf(l0, fmaxf(l1, l2)); const float e0 = __expf(l0 - mxl), e1 = __expf(l1 - mxl), e2 = __expf(l2 - mxl); const float inv = 1.0f / (e0 + e1 + e2);
        const size_t o = (size_t)t * 512 + h * 64 + lane;
        const float v = (e0 * AO[o] + e1 * AO[(size_t)M * 512 + o] + e2 * AO[(size_t)2 * M * 512 + o]) * inv;
        YB[o] = (bf16_t)f2bf(v);
    }
}

__device__ __forceinline__ void ln_rows(const Ctx& c, const float* in, const float* gam, const float* bet, float* outf, bf16_t* outb) {
    const int gw = c.vcu * 8 + c.wave, NGW = c.G * 8, lane = c.lane;
    for (int m = gw; m < M; m += NGW) {
        const f32x4* xr = (const f32x4*)(in + (size_t)m * D) + lane;
        f32x4 v[8]; float s = 0.f;
#pragma unroll
        for (int j = 0; j < 8; ++j) { v[j] = xr[64 * j]; s += (v[j][0] + v[j][1]) + (v[j][2] + v[j][3]); }
        const float mean = wave_sum(s) * (1.0f / D); float s2 = 0.f;
#pragma unroll
        for (int j = 0; j < 8; ++j) { v[j] = v[j] - mean; s2 += (v[j][0] * v[j][0] + v[j][1] * v[j][1]) + (v[j][2] * v[j][2] + v[j][3] * v[j][3]); }
        const float rstd = rsqrtf(wave_sum(s2) * (1.0f / D) + LN_EPS);
#pragma unroll
        for (int j = 0; j < 8; ++j) { const int col = 4 * lane + 256 * j; const f32x4 gv = *(const f32x4*)(gam + col), bv = *(const f32x4*)(bet + col);
            const f32x4 o = v[j] * rstd * gv + bv;
            *(f32x4*)(outf + (size_t)m * D + col) = o;
            if (outb) { u32x2 w; w.x = pk2(o[0], o[1]); w.y = pk2(o[2], o[3]); *(u32x2*)(outb + (size_t)m * D + col) = w; } }
    }
}

__device__ __forceinline__ void p15_router(const Params& p, const Ctx& c) {
    unsigned char* ws = c.ws;
    const float* X2 = (const float*)(ws + WS_X2); const float* RW = p.in[I_RW]; const float* RB = p.in[I_RB];
    unsigned* cnt = (unsigned*)(ws + WS_CTL) + CW_CNT; int* LIST = (int*)(ws + WS_LIST); int* ROWI = (int*)(ws + WS_ROWI); float* TOPW = (float*)(ws + WS_TOPW);
    LAS float* scr = (LAS float*)(c.lds + c.wave * 8192);
    const int gw = c.vcu * 8 + c.wave, NGW = c.G * 8, lane = c.lane, li = lane & 31, lk = lane >> 5;
    for (int tb = gw; tb < M / 32; tb += NGW) {
        const int t0 = tb * 32;
        f32x16 acc;
#pragma unroll
        for (int j = 0; j < 16; ++j) acc[j] = 0.f;
        const float* xa = X2 + (size_t)(t0 + li) * D + 4 * lk;
        const float* wb = RW + (size_t)(4 * lk) * 32 + li;
        for (int kb = 0; kb < D / 8; ++kb) {
            const f32x4 a = *(const f32x4*)(xa + 8 * kb);
            const float b0 = wb[(size_t)(8 * kb + 0) * 32], b1 = wb[(size_t)(8 * kb + 1) * 32], b2 = wb[(size_t)(8 * kb + 2) * 32], b3 = wb[(size_t)(8 * kb + 3) * 32];
            acc = __builtin_amdgcn_mfma_f32_32x32x2f32(a[0], b0, acc, 0, 0, 0);
            acc = __builtin_amdgcn_mfma_f32_32x32x2f32(a[1], b1, acc, 0, 0, 0);
            acc = __builtin_amdgcn_mfma_f32_32x32x2f32(a[2], b2, acc, 0, 0, 0);
            acc = __builtin_amdgcn_mfma_f32_32x32x2f32(a[3], b3, acc, 0, 0, 0);
        }
        const float bias = RB[li];
#pragma unroll
        for (int rg = 0; rg < 16; ++rg) { const int row = (rg & 3) + 8 * (rg >> 2) + 4 * lk; scr[row * 33 + li] = acc[rg] + bias; }
        LDS_WAIT(); asm volatile("" ::: "memory");
        if (lane < 32) {
            float lv[32];
#pragma unroll
            for (int e = 0; e < 32; ++e) lv[e] = scr[lane * 33 + e];
            int id[4]; float tv[4];
#pragma unroll
            for (int k = 0; k < 4; ++k) { float best = -3.0e38f; int bi = 0;
#pragma unroll
                for (int e = 0; e < 32; ++e) { const bool tk = lv[e] > best; best = tk ? lv[e] : best; bi = tk ? e : bi; }
                id[k] = bi; tv[k] = best;
#pragma unroll
                for (int e = 0; e < 32; ++e) lv[e] = (e == bi) ? -3.0e38f : lv[e]; }
            const float e1 = __expf(tv[1] - tv[0]), e2 = __expf(tv[2] - tv[0]), e3 = __expf(tv[3] - tv[0]); const float inv = 1.0f / (1.0f + e1 + e2 + e3);
            const float wv[4] = {inv, e1 * inv, e2 * inv, e3 * inv};
            const int t = t0 + lane;
#pragma unroll
            for (int k = 0; k < 4; ++k) { const unsigned slot = __hip_atomic_fetch_add(cnt + id[k], 1u, __ATOMIC_RELAXED, __HIP_MEMORY_SCOPE_AGENT);
                LIST[(size_t)id[k] * CAP + slot] = t; ROWI[(size_t)t * 4 + k] = id[k] * CAP + (int)slot; TOPW[(size_t)t * 4 + k] = wv[k]; }
        }
        LDS_WAIT(); asm volatile("" ::: "memory");
    }
}

__device__ __forceinline__ void moe_table(const Ctx& c, LAS int* tab) {
    if (c.tid == 0) { unsigned* cnt = (unsigned*)(c.ws + WS_CTL) + CW_CNT; int ts = 0;
        for (int e = 0; e < NEXP; ++e) { const int n = (int)__hip_atomic_load(cnt + e, __ATOMIC_RELAXED, __HIP_MEMORY_SCOPE_AGENT); tab[e] = n; tab[32 + e] = ts; ts += (n + 255) >> 8; }
        tab[64] = ts; }
    __syncthreads();
}

__device__ __forceinline__ void p18_combine(const Params& p, const Ctx& c, const LAS int* tab) {
    unsigned char* ws = c.ws;
    const float* X2 = (const float*)(ws + WS_X2); const float* Y = (const float*)(ws + WS_Y); const int* ROWI = (const int*)(ws + WS_ROWI); const float* TOPW = (const float*)(ws + WS_TOPW);
    const float* gam = p.in[I_LN3G]; const float* bet = p.in[I_LN3B];
    const int gw = c.vcu * 8 + c.wave, NGW = c.G * 8, lane = c.lane;
    for (int m = gw; m < M; m += NGW) {
        f32x4 v[8];
        const f32x4* xr = (const f32x4*)(X2 + (size_t)m * D) + lane;
#pragma unroll
        for (int j = 0; j < 8; ++j) v[j] = xr[64 * j] * DN_ALPHA;
#pragma unroll
        for (int k = 0; k < 4; ++k) { const int ri = ROWI[(size_t)m * 4 + k]; const float gt = TOPW[(size_t)m * 4 + k]; const int e = ri >> 14, slot = ri & (CAP - 1);
            const f32x4* yr = (const f32x4*)(Y + ((size_t)tab[32 + e] * 256 + slot) * D) + lane;
#pragma unroll
            for (int j = 0; j < 8; ++j) v[j] = v[j] + yr[64 * j] * gt; }
        float s = 0.f;
#pragma unroll
        for (int j = 0; j < 8; ++j) s += (v[j][0] + v[j][1]) + (v[j][2] + v[j][3]);
        const float mean = wave_sum(s) * (1.0f / D); float s2 = 0.f;
#pragma unroll
        for (int j = 0; j < 8; ++j) { v[j] = v[j] - mean; s2 += (v[j][0] * v[j][0] + v[j][1] * v[j][1]) + (v[j][2] * v[j][2] + v[j][3] * v[j][3]); }
        const float rstd = rsqrtf(wave_sum(s2) * (1.0f / D) + LN_EPS);
#pragma unroll
        for (int j = 0; j < 8; ++j) { const int col = 4 * lane + 256 * j; const f32x4 gv = *(const f32x4*)(gam + col), bv = *(const f32x4*)(bet + col);
            *(f32x4*)(p.out + (size_t)m * D + col) = v[j] * rstd * gv + bv; }
    }
}

constexpr int NPHASE = 19;
__global__ void __launch_bounds__(512, 2) fwd(Params p) {
    extern __shared__ __attribute__((aligned(16))) unsigned char lds_raw[];
    LAS unsigned char* lds = (LAS unsigned char*)lds_raw;
    Ctx c; c.tid = threadIdx.x; c.lane = c.tid & 63; c.wave = __builtin_amdgcn_readfirstlane(c.tid >> 6); c.G = gridDim.x;
    { const int bx = blockIdx.x; c.vcu = (c.G % 8 == 0) ? (bx % 8) * (c.G / 8) + bx / 8 : bx; }
    c.lds = lds; c.ws = p.ws;
    unsigned char* ws = p.ws;
    volatile LAS unsigned* MISC = (volatile LAS unsigned*)(lds + MISC_OFF);
    LAS int* tab = (LAS int*)(lds + MISC_OFF + 1024);
    if (c.tid < 64) MISC[c.tid] = 0u;
    __syncthreads();
    unsigned* ctl = (unsigned*)(ws + WS_CTL);
    XcdBarrier bar; bar.bar = ctl + CW_BAR; bar.x = 0; bar.st = MISC + 8;
    if (N_LAUNCH_MODE == 1) bar = xcd_barrier_post(ctl + CW_BAR, MISC + 8);
    const int lo = p.ph_lo, hi = p.ph_hi, bx = blockIdx.x;
#ifndef PHMASK
#define PHMASK 0xFFFFFFFFu
#endif
#define IN(k) (((PHMASK >> (k)) & 1u) && lo <= (k) && (k) < hi)
#define SEAM(k) do { if (N_LAUNCH_MODE == 1 && IN((k) + 1)) xcd_barrier(bar); } while (0)

    if (IN(0)) { p0_prologue(p, c); SEAM(0); }

    if (IN(1)) {
        pg8::StaticOrder S; S.init(ws + WS_XB, ws + WS_WIN, M, PC, D, D, c.G, bx);
        pg8::EpiBf16 E{(bf16_t*)(ws + WS_PROJ), PC, 1.0f};
        pg8::gemm_phase<pg8::EpiBf16, pg8::StaticOrder>(lds, pg8::Gemm{D, D, D}, S, E);
        SEAM(1);
    }
    if (IN(2)) { p2_prep(p, c); SEAM(2); }

    if (IN(3)) {
#ifndef P3M
#define P3M 15
#endif
        if (P3M & 1) { pg8::StaticOrder S; S.init(ws + WS_LIN, ws + WS_WUP, M, D, 768, 256, c.G, bx);
          pg8::EpiDecay E{(float*)(ws + WS_DEC), p.in[I_W0]};
          pg8::gemm_phase<pg8::EpiDecay, pg8::StaticOrder>(lds, pg8::Gemm{256, 768, 256}, S, E); }
        if (P3M & 2) { pg8::StaticOrder S; S.init(ws + WS_LIN + 512, ws + WS_AUP, M, D, 768, 256, c.G, bx);
          pg8::EpiIclr E{p.in[I_A0], p.in[I_KK], p.in[I_KA], (const float*)(ws + WS_KZ), (const float*)(ws + WS_KNORM), (float*)(ws + WS_KP), (float*)(ws + WS_AN), (float*)(ws + WS_BB)};
          pg8::gemm_phase<pg8::EpiIclr, pg8::StaticOrder>(lds, pg8::Gemm{256, 768, 256}, S, E); }
        if (P3M & 4) { pg8::StaticOrder S; S.init(ws + WS_LIN + 1024, ws + WS_GUP, M, D, 768, 256, c.G, bx);
          pg8::EpiF32 E{(float*)(ws + WS_GG), D, nullptr, 0, nullptr, 0.f};
          pg8::gemm_phase<pg8::EpiF32, pg8::StaticOrder>(lds, pg8::Gemm{256, 768, 256}, S, E); }
        if (P3M & 8) { pg8::StaticOrder S; S.init(ws + WS_MEMB, ws + WS_WKV, 1024, 2 * D, D, D, c.G, bx);
          pg8::EpiKV E{(bf16_t*)(ws + WS_KB), (bf16_t*)(ws + WS_VT)};
          pg8::gemm_phase<pg8::EpiKV, pg8::StaticOrder>(lds, pg8::Gemm{D, D, D}, S, E); }
        SEAM(3);
    }
    if (IN(4)) {
        if (c.G >= 256) { if (c.vcu < 128) p4_scan(c, c.vcu); else for (int t = c.vcu - 128; t < 3072; t += c.G - 128) p4_attn_task(c, t); }
        else { for (int bh = c.vcu; bh < 128; bh += c.G) p4_scan(c, bh); for (int t = c.vcu; t < 3072; t += c.G) p4_attn_task(c, t); }
        SEAM(4);
    }
    if (IN(5)) { p5_post(p, c); SEAM(5); }

    if (IN(6)) {
        pg8::StaticOrder S; S.init(ws + WS_YA, ws + WS_PA, M, D, D, D, c.G, bx);
        pg8::EpiGateA E{(const bf16_t*)(ws + WS_PROJ), (float*)(ws + WS_TMP)};
        pg8::gemm_phase<pg8::EpiGateA, pg8::StaticOrder>(lds, pg8::Gemm{D, D, D}, S, E);
        SEAM(6);
    }
    if (IN(7)) {
        pg8::StaticOrder S; S.init(ws + WS_YB, ws + WS_PB, M, D, 512, 512, c.G, bx);
        pg8::EpiGateB E{(const bf16_t*)(ws + WS_PROJ), (const float*)(ws + WS_TMP), (bf16_t*)(ws + WS_MERGED)};
        pg8::gemm_phase<pg8::EpiGateB, pg8::StaticOrder>(lds, pg8::Gemm{512, 512, 512}, S, E);
        SEAM(7);
    }
    if (IN(8)) {
        pg8::StaticOrder S; S.init(ws + WS_MERGED, ws + WS_WOUT, M, D, D, D, c.G, bx);
        pg8::EpiF32 E{(float*)(ws + WS_T1), D, nullptr, 0, p.in[I_X], DN_ALPHA};
        pg8::gemm_phase<pg8::EpiF32, pg8::StaticOrder>(lds, pg8::Gemm{D, D, D}, S, E);
        SEAM(8);
    }
    if (IN(9)) { ln_rows(c, (const float*)(ws + WS_T1), p.in[I_LN1G], p.in[I_LN1B], (float*)(ws + WS_X1), (bf16_t*)(ws + WS_X1B)); SEAM(9); }

    if (IN(10)) {
        pg8::StaticOrder S; S.init(ws + WS_X1B, ws + WS_WQ, M, D, D, D, c.G, bx);
        pg8::EpiBf16 E{(bf16_t*)(ws + WS_Q), D, 0.04419417382415922f};
        pg8::gemm_phase<pg8::EpiBf16, pg8::StaticOrder>(lds, pg8::Gemm{D, D, D}, S, E);
        SEAM(10);
    }
    if (IN(11)) {
        ScoreOrder S{(const char*)(ws + WS_Q), (const char*)(ws + WS_KB), c.G, bx};
        pg8::EpiSoftmax E{(bf16_t*)(ws + WS_PP)};
        pg8::gemm_phase<pg8::EpiSoftmax, ScoreOrder, false>(lds, pg8::Gemm{512, D, D}, S, E);
        SEAM(11);
    }
    if (IN(12)) {
        PvOrder S{(const char*)(ws + WS_PP), (const char*)(ws + WS_VT), c.G, bx};
        pg8::EpiBf16 E{(bf16_t*)(ws + WS_OC), D, 1.0f};
        pg8::gemm_phase<pg8::EpiBf16, PvOrder>(lds, pg8::Gemm{256, 256, 256}, S, E);
        SEAM(12);
    }
    if (IN(13)) {
        pg8::StaticOrder S; S.init(ws + WS_OC, ws + WS_WO, M, D, D, D, c.G, bx);
        pg8::EpiF32 E{(float*)(ws + WS_T2), D, nullptr, 0, (const float*)(ws + WS_X1), DN_ALPHA};
        pg8::gemm_phase<pg8::EpiF32, pg8::StaticOrder>(lds, pg8::Gemm{D, D, D}, S, E);
        SEAM(13);
    }
    if (IN(14)) { ln_rows(c, (const float*)(ws + WS_T2), p.in[I_LN2G], p.in[I_LN2B], (float*)(ws + WS_X2), (bf16_t*)(ws + WS_X2B)); SEAM(14); }
    if (IN(15)) { p15_router(p, c); SEAM(15); }

    if (IN(16)) {
        moe_table(c, tab);
        MoeOrder<true, 16> S{tab, (const char*)(ws + WS_X2B), (const char*)(ws + WS_W1), (const int*)(ws + WS_LIST), (size_t)4096 * D * 2, D, c.G, bx};
        pg8::EpiSwiglu E{p.in[I_B1], (bf16_t*)(ws + WS_H)};
        pg8::gemm_phase<pg8::EpiSwiglu, MoeOrder<true, 16>>(lds, pg8::Gemm{D, D, D}, S, E);
        SEAM(16);
    }
    if (IN(17)) {
        moe_table(c, tab);
        MoeOrder<false, 8> S{tab, (const char*)(ws + WS_H), (const char*)(ws + WS_W2), (const int*)(ws + WS_LIST), (size_t)D * DFF * 2, DFF, c.G, bx};
        pg8::EpiF32 E{(float*)(ws + WS_Y), D, p.in[I_B2], D, nullptr, 0.f};
        pg8::gemm_phase<pg8::EpiF32, MoeOrder<false, 8>>(lds, pg8::Gemm{DFF, DFF, DFF}, S, E);
        SEAM(17);
    }
    if (IN(18)) { moe_table(c, tab); p18_combine(p, c, tab); }
#undef IN
#undef SEAM
}

extern "C" void kernel_launch(void* const* d_in, const int* in_sizes, int n_in, void* d_out, int out_size, void* d_ws, size_t ws_size, hipStream_t stream) {
    static int grid = 0;
    if (grid == 0) {
        if (n_in != 32 || out_size != M * D || ws_size < WS_END) { fprintf(stderr, "kernel_launch: expected 32 inputs, %d outputs, >= %zu bytes of workspace; got %d, %d, %zu\n", M * D, (size_t)WS_END, n_in, out_size, ws_size); grid = -1; return; }
        int dev = 0, cus = 0, per_cu = 0;
        if (hipGetDevice(&dev) != hipSuccess || hipDeviceGetAttribute(&cus, hipDeviceAttributeMultiprocessorCount, dev) != hipSuccess) { grid = -1; return; }
        if (hipFuncSetAttribute((const void*)fwd, hipFuncAttributeMaxDynamicSharedMemorySize, LDS_BYTES) != hipSuccess) { fprintf(stderr, "kernel_launch: hipFuncSetAttribute failed\n"); grid = -1; return; }
        if (hipOccupancyMaxActiveBlocksPerMultiprocessor(&per_cu, (const void*)fwd, 512, LDS_BYTES) != hipSuccess || per_cu < 1) fprintf(stderr, "kernel_launch: occupancy query reports %d\n", per_cu);
        (void)hipGetLastError();
        grid = cus;
        if (grid != 256) fprintf(stderr, "kernel_launch: %d CUs; this kernel is built for 256\n", grid);
    }
    if (grid < 0) return;
    (void)hipMemsetAsync((char*)d_ws + WS_CTL, 0, CTL_ZERO_BYTES, stream);
    Params p{};
    for (int i = 0; i < 32; ++i) p.in[i] = (const float*)d_in[i];
    p.out = (float*)d_out; p.ws = (unsigned char*)d_ws;
    if (N_LAUNCH_MODE == 1) { p.ph_lo = 0; p.ph_hi = NPHASE; hipLaunchKernelGGL(fwd, dim3(grid), dim3(512), LDS_BYTES, stream, p); }
    else for (int k = 0; k < NPHASE; ++k) { p.ph_lo = k; p.ph_hi = k + 1; hipLaunchKernelGGL(fwd, dim3(grid), dim3(512), LDS_BYTES, stream, p); }
}
```

```cpp
#include <hip/hip_runtime.h>
#include <cstdio>
#include <cstdint>

#define LAS __attribute__((address_space(3)))
#define GAS __attribute__((address_space(1)))
typedef unsigned short bf16_t;
typedef short bf16x8 __attribute__((ext_vector_type(8)));
typedef float f32x4 __attribute__((ext_vector_type(4)));
typedef float f32x2 __attribute__((ext_vector_type(2)));
typedef float f32x16 __attribute__((ext_vector_type(16)));
typedef unsigned u32x4 __attribute__((ext_vector_type(4)));
typedef unsigned u32x2 __attribute__((ext_vector_type(2)));

#ifndef N_LAUNCH_MODE
#define N_LAUNCH_MODE 1
#endif

constexpr int M = 16384, D = 2048, SEQ = 4096, NBATCH = 4;
constexpr int RWC = 6592;
constexpr int PC = 15360;
constexpr int ATT0 = 6656, GATE0 = 11264;
constexpr int NEXP = 32, DFF = 2048, CAP = 16384;
constexpr int HROWS = 65536 + 32 * 256;
constexpr float LN_EPS = 1e-5f, GN_EPS = 64e-5f;
constexpr float DN_ALPHA = 1.189207115002721f;

__device__ __forceinline__ float bf2f(unsigned v) { return __uint_as_float(v << 16); }
__device__ __forceinline__ unsigned f2bf(float f) { unsigned u = __float_as_uint(f); return (u + 0x7fffu + ((u >> 16) & 1u)) >> 16; }
__device__ __forceinline__ unsigned pk2(float lo, float hi) { return f2bf(lo) | (f2bf(hi) << 16); }
__device__ __forceinline__ float sigmoidf_(float x) { return 1.0f / (1.0f + __expf(-x)); }
__device__ __forceinline__ float wave_sum(float v) {
#pragma unroll
    for (int o = 1; o < 64; o <<= 1) v += __shfl_xor(v, o);
    return v;
}
#define LDS_WAIT() asm volatile("s_waitcnt lgkmcnt(0)" ::: "memory")
#define VM_WAIT() asm volatile("s_waitcnt vmcnt(0)" ::: "memory")

namespace pg8 {
#define PG8_LAS __attribute__((address_space(3)))
constexpr int BM = 256, BK = 64, HALF = 128, HTB = HALF * BK * 2, STAGE_BYTES = 8 * HTB, NXCD = 8, WGM = 8;

__host__ __device__ __forceinline__ int lds_byte(int r, int c) { const int st = (r >> 4) * 2 + (c >> 5), rr = r & 15, cc = c & 31, ob = rr * 64 + cc * 2; return st * 1024 + (ob ^ (((ob >> 9) & 1) << 5)); }
__host__ __device__ __forceinline__ void stage_rc(int b, int& R, int& C) { const int st = b / 1024, sb = b % 1024, swz = sb ^ (((sb >> 9) & 1) << 5); R = (st >> 1) * 16 + swz / 64; C = (st & 1) * 32 + (swz % 64) / 2; }
__host__ __device__ __forceinline__ int perm32(int rho) { const int n = rho >> 4, i = rho & 15; return 8 * (i >> 2) + 4 * n + (i & 3); }

struct Unit { const char* A; const char* B; int orow, ocol, aux, aux2, valid; };
struct Gemm { int K, lda, ldb; };

struct StaticOrder {
    static constexpr bool GATHER = false;
    const char* A; const char* Bt; size_t ta, tb;
    int nM, nN, nwg, G, c;
    __device__ void init(const void* A_, const void* Bt_, int M_, int N_, int lda, int ldb, int G_, int c_) { A = (const char*)A_; Bt = (const char*)Bt_; ta = (size_t)BM * lda * 2; tb = (size_t)BM * ldb * 2; nM = M_ / BM; nN = N_ / BM; nwg = nM * nN; G = G_; c = c_; }
    __device__ bool next(int i, Unit& u) const {
        const long L = (long)i * G + c; if (c < 0 || L >= nwg) return false;
        int wgid = (int)L; { const int q = nwg / NXCD, r = nwg % NXCD, xcd = wgid % NXCD, off = wgid / NXCD; wgid = (xcd < r ? xcd * (q + 1) : r * (q + 1) + (xcd - r) * q) + off; }
        const int nig = WGM * nN, gid = wgid / nig, fm = gid * WGM, gsz = (nM - fm) < WGM ? (nM - fm) : WGM;
        const int pm = fm + ((wgid % nig) % gsz), pn = (wgid % nig) / gsz;
        u.A = A + (size_t)pm * ta; u.B = Bt + (size_t)pn * tb; u.orow = pm * BM; u.ocol = pn * BM; u.aux = 0; u.aux2 = 0; u.valid = BM; return true;
    }
    __device__ __forceinline__ const int* rows(const Unit&) const { return nullptr; }
};

__device__ __forceinline__ unsigned cvt_pk_bf16(float lo, float hi) { unsigned r; asm volatile("v_cvt_pk_bf16_f32 %0, %1, %2" : "=v"(r) : "v"(lo), "v"(hi)); return r; }

template <class Epi, class Sched, bool ALIGN_EPI = true>
__device__ __forceinline__ void gemm_phase(PG8_LAS unsigned char* lds, const Gemm g, const Sched& S, const Epi& E) {
    const int tid = threadIdx.x, wid = __builtin_amdgcn_readfirstlane(tid >> 6), lane = tid & 63, wr = wid >> 2, wc = wid & 3, fr = lane & 15, fq = lane >> 4;
    const int K = g.K, nt = K / BK;
    unsigned voffA[2], voffB[2]; int Rr[2], Cc[2];
#pragma unroll
    for (int i = 0; i < 2; ++i) { int R, C; stage_rc(tid * 16 + i * 8192, R, C); const int Rb = Epi::PERM ? ((R & ~31) + perm32(R & 31)) : R; Rr[i] = R; Cc[i] = C;
        voffA[i] = (unsigned)(R * g.lda + C) * 2u; voffB[i] = (unsigned)(Rb * g.ldb + C) * 2u; }
    const size_t kstep = (size_t)(BK * 2);
    const size_t hstepA = (size_t)HALF * g.lda * 2, hstepB = (size_t)HALF * g.ldb * 2;
    const unsigned ldsw = (unsigned)wid * 1024u;
    const int aoff = lds_byte(wr * 64 + fr, fq * 8), boff = lds_byte(wc * 32 + fr, fq * 8);
    unsigned vAc[2][2], vAn[2][2];
#define PG8_SA(b, h) (((b) * 2 + (h)) * HTB)
#define PG8_SB(b, h) ((4 + (b) * 2 + (h)) * HTB)
#define PG8_STAGE(bufoff, gbase, voff) do { _Pragma("unroll") for (int _i = 0; _i < 2; ++_i) \
        __builtin_amdgcn_global_load_lds((const unsigned*)((const char*)(gbase) + (voff)[_i]), (PG8_LAS unsigned*)(lds + (bufoff) + ldsw + _i * 8192), 16, 0, 0); } while (0)
#define PG8_STAGE_A(bufoff, kbase, h, nx) do { if constexpr (Sched::GATHER) { unsigned _v[2] = {(nx) ? vAn[h][0] : vAc[h][0], (nx) ? vAn[h][1] : vAc[h][1]}; PG8_STAGE(bufoff, kbase, _v); } \
        else { PG8_STAGE(bufoff, (kbase) + (h) * hstepA, voffA); } } while (0)
#define PG8_GOFF(u, v) do { const int* _rw = S.rows(u); _Pragma("unroll") for (int _h = 0; _h < 2; ++_h) _Pragma("unroll") for (int _i = 0; _i < 2; ++_i) { const int _r = Rr[_i] + _h * HALF; \
        const int _tk = _r < (u).valid ? _rw[_r] : 0; v[_h][_i] = (unsigned)(_tk * g.lda + Cc[_i]) * 2u; } } while (0)
#define PG8_LDA(dst, b, h) do { _Pragma("unroll") for (int m = 0; m < 4; ++m) _Pragma("unroll") for (int k = 0; k < 2; ++k) dst[m][k] = *(const PG8_LAS bf16x8*)(lds + PG8_SA(b, h) + aoff + m * 2048 + k * 1024); } while (0)
#define PG8_LDB(dst, b, h) do { _Pragma("unroll") for (int n = 0; n < 2; ++n) _Pragma("unroll") for (int k = 0; k < 2; ++k) dst[n][k] = *(const PG8_LAS bf16x8*)(lds + PG8_SB(b, h) + boff + n * 2048 + k * 1024); } while (0)
#define PG8_MMA(ai, bj, At, Bt) do { __builtin_amdgcn_s_setprio(1); _Pragma("unroll") for (int m = 0; m < 4; ++m) _Pragma("unroll") for (int n = 0; n < 2; ++n) _Pragma("unroll") for (int k = 0; k < 2; ++k) \
        acc[ai][bj][m][n] = __builtin_amdgcn_mfma_f32_16x16x32_bf16(Bt[n][k], At[m][k], acc[ai][bj][m][n], 0, 0, 0); __builtin_amdgcn_s_setprio(0); } while (0)
#define PG8_WAIT_V(n) asm volatile("s_waitcnt vmcnt(" #n ")" ::: "memory")
#define PG8_WAIT_L(n) asm volatile("s_waitcnt lgkmcnt(" #n ")" ::: "memory")
#define PG8_BAR __builtin_amdgcn_s_barrier()
#define PG8_SCHED __builtin_amdgcn_sched_barrier(0)
    Unit cur, nxt; int ui = 0;
    if (!S.next(0, cur)) return;
    f32x4 acc[2][2][4][2];
#pragma unroll
    for (int a = 0; a < 2; ++a)
#pragma unroll
        for (int b = 0; b < 2; ++b)
#pragma unroll
            for (int m = 0; m < 4; ++m)
#pragma unroll
                for (int n = 0; n < 2; ++n) acc[a][b][m][n] = (f32x4){0.f, 0.f, 0.f, 0.f};
    bf16x8 At[4][2], B0[2][2], B1[2][2];
    const char* cA = cur.A; const char* cB = cur.B;
    if constexpr (Sched::GATHER) { PG8_GOFF(cur, vAc); PG8_WAIT_V(0); }
    PG8_STAGE(PG8_SB(0, 0), cB, voffB); PG8_STAGE(PG8_SB(0, 1), cB + hstepB, voffB); PG8_STAGE_A(PG8_SA(0, 0), cA, 0, false); PG8_STAGE_A(PG8_SA(0, 1), cA, 1, false);
    if (wr == 1) PG8_BAR;
    PG8_WAIT_V(2); PG8_BAR;
    PG8_STAGE(PG8_SB(1, 0), cB + kstep, voffB); PG8_STAGE_A(PG8_SA(1, 0), cA + kstep, 0, false); PG8_STAGE(PG8_SB(1, 1), cB + hstepB + kstep, voffB);
    PG8_WAIT_V(6); PG8_BAR;
    for (;;) {
        const bool has_next = S.next(ui + 1, nxt);
        const char* nA = has_next ? nxt.A : cA; const char* nB = has_next ? nxt.B : cB;
        if constexpr (Sched::GATHER) { if (has_next) { PG8_GOFF(nxt, vAn); } else {
#pragma unroll
            for (int h = 0; h < 2; ++h)
#pragma unroll
                for (int i = 0; i < 2; ++i) vAn[h][i] = vAc[h][i]; } }
#pragma nounroll
        for (int t = 0; t < nt; t += 2) {
            const bool last = (t == nt - 2);
            const char* a1 = cA + (size_t)(t + 1) * kstep;
            const char* a2 = last ? nA : cA + (size_t)(t + 2) * kstep; const char* b2 = last ? nB : cB + (size_t)(t + 2) * kstep;
            const char* a3 = a2 + kstep; const char* b3 = b2 + kstep;
            PG8_LDB(B0, 0, 0); PG8_LDB(B1, 0, 1); PG8_SCHED; PG8_LDA(At, 0, 0); PG8_STAGE_A(PG8_SA(1, 1), a1, 1, false);
            PG8_WAIT_V(8); PG8_WAIT_L(0); PG8_BAR; PG8_MMA(0, 0, At, B0); PG8_MMA(0, 1, At, B1); PG8_BAR; PG8_SCHED;
            PG8_LDA(At, 0, 1); PG8_STAGE(PG8_SB(0, 0), b2, voffB); PG8_STAGE(PG8_SB(0, 1), b2 + hstepB, voffB); PG8_STAGE_A(PG8_SA(0, 0), a2, 0, last);
            PG8_WAIT_V(8); PG8_WAIT_L(0); PG8_BAR; PG8_MMA(1, 0, At, B0); PG8_MMA(1, 1, At, B1); PG8_BAR; PG8_SCHED;
            PG8_LDB(B0, 1, 0); PG8_LDB(B1, 1, 1); PG8_SCHED; PG8_LDA(At, 1, 0); PG8_STAGE_A(PG8_SA(0, 1), a2, 1, last);
            PG8_WAIT_V(8); PG8_WAIT_L(0); PG8_BAR; PG8_MMA(0, 0, At, B0); PG8_MMA(0, 1, At, B1); PG8_BAR; PG8_SCHED;
            PG8_LDA(At, 1, 1); PG8_STAGE(PG8_SB(1, 0), b3, voffB); PG8_STAGE(PG8_SB(1, 1), b3 + hstepB, voffB); PG8_STAGE_A(PG8_SA(1, 0), a3, 0, last);
            PG8_WAIT_V(8); PG8_WAIT_L(0); PG8_BAR; PG8_MMA(1, 0, At, B0); PG8_MMA(1, 1, At, B1); PG8_BAR; PG8_SCHED;
        }
        if constexpr (ALIGN_EPI) { if (wr == 0) PG8_BAR; }
        if constexpr (!Epi::AFTER_DRAIN) { E(acc, cur, wr, wc, fr, fq); }
        if (!has_next) break;
#pragma unroll
        for (int a = 0; a < 2; ++a)
#pragma unroll
            for (int b = 0; b < 2; ++b)
#pragma unroll
                for (int m = 0; m < 4; ++m)
#pragma unroll
                    for (int n = 0; n < 2; ++n) acc[a][b][m][n] = (f32x4){0.f, 0.f, 0.f, 0.f};
        cur = nxt; cA = nA; cB = nB; ++ui;
        if constexpr (Sched::GATHER) {
#pragma unroll
            for (int h = 0; h < 2; ++h)
#pragma unroll
                for (int i = 0; i < 2; ++i) vAc[h][i] = vAn[h][i]; }
        if constexpr (ALIGN_EPI) { if (wr == 1) PG8_BAR; }
    }
    PG8_WAIT_V(0);
    if constexpr (!ALIGN_EPI) { if (wr == 0) PG8_BAR; }
    PG8_BAR;
    if constexpr (Epi::AFTER_DRAIN) { E.fused(acc, cur, wr, wc, fr, fq, lds, wid, lane); }
#undef PG8_SA
#undef PG8_SB
#undef PG8_STAGE
#undef PG8_STAGE_A
#undef PG8_GOFF
#undef PG8_LDA
#undef PG8_LDB
#undef PG8_MMA
#undef PG8_WAIT_V
#undef PG8_WAIT_L
#undef PG8_BAR
#undef PG8_SCHED
}

#define EPI_LOOP_AI_M for (int ai = 0; ai < 2; ++ai) _Pragma("unroll") for (int m = 0; m < 4; ++m)

struct EpiF32 {
    static constexpr bool PERM = false, AFTER_DRAIN = false;
    float* C; int ldc; const float* bias; int bstride; const float* res; float alpha;
    __device__ __forceinline__ void operator()(const f32x4 (&acc)[2][2][4][2], const Unit& u, int wr, int wc, int fr, int fq) const {
        const int row0 = u.orow + wr * 64 + fr, col0 = u.ocol + wc * 32 + 4 * fq;
        f32x4 bv[2][2];
#pragma unroll
        for (int bj = 0; bj < 2; ++bj)
#pragma unroll
            for (int n = 0; n < 2; ++n) bv[bj][n] = bias ? *(const f32x4*)(bias + (size_t)u.aux * bstride + col0 + bj * HALF + n * 16) : (f32x4){0.f, 0.f, 0.f, 0.f};
#pragma unroll
        EPI_LOOP_AI_M { const size_t off = (size_t)(row0 + ai * HALF + m * 16) * ldc + col0;
#pragma unroll
            for (int bj = 0; bj < 2; ++bj)
#pragma unroll
                for (int n = 0; n < 2; ++n) { f32x4 v = acc[ai][bj][m][n] + bv[bj][n];
                    if (res) { const f32x4 rv = *(const f32x4*)(res + off + bj * HALF + n * 16); v = v + rv * alpha; }
                    *(f32x4*)(C + off + bj * HALF + n * 16) = v; }
            asm volatile("" ::: "memory"); }
    }
};
struct EpiBf16 {
    static constexpr bool PERM = true, AFTER_DRAIN = false;
    bf16_t* O; int ldc; float scale;
    __device__ __forceinline__ void operator()(const f32x4 (&acc)[2][2][4][2], const Unit& u, int wr, int wc, int fr, int fq) const {
        const int row0 = u.orow + wr * 64 + fr, col0 = u.ocol + wc * 32 + 8 * fq;
#pragma unroll
        EPI_LOOP_AI_M { bf16_t* rowp = O + (size_t)(row0 + ai * HALF + m * 16) * ldc + col0;
#pragma unroll
            for (int bj = 0; bj < 2; ++bj) { const f32x4 v0 = acc[ai][bj][m][0] * scale, v1 = acc[ai][bj][m][1] * scale;
                u32x4 w; w.x = cvt_pk_bf16(v0[0], v0[1]); w.y = cvt_pk_bf16(v0[2], v0[3]); w.z = cvt_pk_bf16(v1[0], v1[1]); w.w = cvt_pk_bf16(v1[2], v1[3]);
                *(u32x4*)(rowp + bj * HALF) = w; } }
    }
};
struct EpiKV {
    static constexpr bool PERM = true, AFTER_DRAIN = false;
    bf16_t* KB; bf16_t* VT;
    __device__ __forceinline__ void operator()(const f32x4 (&acc)[2][2][4][2], const Unit& u, int wr, int wc, int fr, int fq) const {
        const int row0 = u.orow + wr * 64 + fr, col0 = u.ocol + wc * 32 + 8 * fq;
#pragma unroll
        EPI_LOOP_AI_M { const int row = row0 + ai * HALF + m * 16;
#pragma unroll
            for (int bj = 0; bj < 2; ++bj) { const f32x4 v0 = acc[ai][bj][m][0], v1 = acc[ai][bj][m][1]; const int col = col0 + bj * HALF;
                if (u.ocol < 2048) { u32x4 w; w.x = cvt_pk_bf16(v0[0], v0[1]); w.y = cvt_pk_bf16(v0[2], v0[3]); w.z = cvt_pk_bf16(v1[0], v1[1]); w.w = cvt_pk_bf16(v1[2], v1[3]);
                    *(u32x4*)(KB + (size_t)row * 2048 + col) = w; }
                else { const int b = row >> 8, key = row & 255, c = col - 2048, h = c >> 9, d = c & 511; bf16_t* p = VT + ((size_t)((b * 4 + h) * 512 + d)) * 256 + key;
#pragma unroll
                    for (int j = 0; j < 4; ++j) { p[(size_t)j * 256] = (bf16_t)f2bf(v0[j]); p[(size_t)(4 + j) * 256] = (bf16_t)f2bf(v1[j]); } } } }
    }
};
struct EpiDecay {
    static constexpr bool PERM = false, AFTER_DRAIN = false;
    float* DEC; const float* w0;
    __device__ __forceinline__ void operator()(const f32x4 (&acc)[2][2][4][2], const Unit& u, int wr, int wc, int fr, int fq) const {
        const int row0 = u.orow + wr * 64 + fr, col0 = u.ocol + wc * 32 + 4 * fq;
        f32x4 bv[2][2];
#pragma unroll
        for (int bj = 0; bj < 2; ++bj)
#pragma unroll
            for (int n = 0; n < 2; ++n) bv[bj][n] = *(const f32x4*)(w0 + col0 + bj * HALF + n * 16);
#pragma unroll
        EPI_LOOP_AI_M { const size_t off = (size_t)(row0 + ai * HALF + m * 16) * D + col0;
#pragma unroll
            for (int bj = 0; bj < 2; ++bj)
#pragma unroll
                for (int n = 0; n < 2; ++n) { const f32x4 x = acc[ai][bj][m][n] + bv[bj][n]; f32x4 o;
#pragma unroll
                    for (int j = 0; j < 4; ++j) o[j] = __expf(-0.6065306597126334f * sigmoidf_(x[j]));
                    *(f32x4*)(DEC + off + bj * HALF + n * 16) = o; } }
    }
};
struct EpiIclr {
    static constexpr bool PERM = false, AFTER_DRAIN = false;
    const float* a0; const float* k_k; const float* k_a; const float* KZ; const float* KNORM; float* KP; float* AN; float* BB;
    __device__ __forceinline__ void operator()(const f32x4 (&acc)[2][2][4][2], const Unit& u, int wr, int wc, int fr, int fq) const {
        const int row0 = u.orow + wr * 64 + fr, col0 = u.ocol + wc * 32 + 4 * fq;
#pragma unroll
        for (int bj = 0; bj < 2; ++bj)
#pragma unroll
            for (int n = 0; n < 2; ++n) { const int col = col0 + bj * HALF + n * 16;
                const f32x4 a0v = *(const f32x4*)(a0 + col), kkv = *(const f32x4*)(k_k + col), kav = *(const f32x4*)(k_a + col);
#pragma unroll
                EPI_LOOP_AI_M { const int row = row0 + ai * HALF + m * 16; const size_t off = (size_t)row * D + col;
                    const f32x4 kz = *(const f32x4*)(KZ + off); const float nr = KNORM[(size_t)row * 32 + (col >> 6)]; const float inv = 1.0f / fmaxf(nr, 1e-12f);
                    const f32x4 x = acc[ai][bj][m][n] + a0v; f32x4 kp, an, bb;
#pragma unroll
                    for (int j = 0; j < 4; ++j) { const float a = sigmoidf_(x[j]); const float kk = kz[j] * kkv[j] * inv; kp[j] = kz[j] * (1.0f + (a - 1.0f) * kav[j]); bb[j] = kk * a; an[j] = -kk; }
                    *(f32x4*)(KP + off) = kp; *(f32x4*)(AN + off) = an; *(f32x4*)(BB + off) = bb; }
                asm volatile("" ::: "memory"); }
    }
};
struct EpiGateA {
    static constexpr bool PERM = false, AFTER_DRAIN = false;
    const bf16_t* PROJ; float* TMP;
    __device__ __forceinline__ void operator()(const f32x4 (&acc)[2][2][4][2], const Unit& u, int wr, int wc, int fr, int fq) const {
        const int row0 = u.orow + wr * 64 + fr, col0 = u.ocol + wc * 32 + 4 * fq;
#pragma unroll
        EPI_LOOP_AI_M { const int row = row0 + ai * HALF + m * 16;
#pragma unroll
            for (int bj = 0; bj < 2; ++bj)
#pragma unroll
                for (int n = 0; n < 2; ++n) { const int col = col0 + bj * HALF + n * 16; const u32x2 gv = *(const u32x2*)(PROJ + (size_t)row * PC + GATE0 + col);
                    const f32x4 a = acc[ai][bj][m][n]; f32x4 o;
                    o[0] = a[0] * sigmoidf_(bf2f(gv.x & 0xffffu)); o[1] = a[1] * sigmoidf_(bf2f(gv.x >> 16)); o[2] = a[2] * sigmoidf_(bf2f(gv.y & 0xffffu)); o[3] = a[3] * sigmoidf_(bf2f(gv.y >> 16));
                    *(f32x4*)(TMP + (size_t)row * D + col) = o; } }
    }
};
struct EpiGateB {
    static constexpr bool PERM = true, AFTER_DRAIN = false;
    const bf16_t* PROJ; const float* TMP; bf16_t* MERGED;
    __device__ __forceinline__ void operator()(const f32x4 (&acc)[2][2][4][2], const Unit& u, int wr, int wc, int fr, int fq) const {
        const int row0 = u.orow + wr * 64 + fr, col0 = u.ocol + wc * 32 + 8 * fq;
#pragma unroll
        EPI_LOOP_AI_M { const int row = row0 + ai * HALF + m * 16;
#pragma unroll
            for (int bj = 0; bj < 2; ++bj) { const int col = col0 + bj * HALF; const u32x4 gv = *(const u32x4*)(PROJ + (size_t)row * PC + GATE0 + 2048 + col);
                const f32x4 t0 = *(const f32x4*)(TMP + (size_t)row * D + col), t1 = *(const f32x4*)(TMP + (size_t)row * D + col + 4);
                const f32x4 a0 = acc[ai][bj][m][0], a1 = acc[ai][bj][m][1]; f32x4 o0, o1;
                o0[0] = t0[0] + a0[0] * sigmoidf_(bf2f(gv.x & 0xffffu)); o0[1] = t0[1] + a0[1] * sigmoidf_(bf2f(gv.x >> 16)); o0[2] = t0[2] + a0[2] * sigmoidf_(bf2f(gv.y & 0xffffu)); o0[3] = t0[3] + a0[3] * sigmoidf_(bf2f(gv.y >> 16));
                o1[0] = t1[0] + a1[0] * sigmoidf_(bf2f(gv.z & 0xffffu)); o1[1] = t1[1] + a1[1] * sigmoidf_(bf2f(gv.z >> 16)); o1[2] = t1[2] + a1[2] * sigmoidf_(bf2f(gv.w & 0xffffu)); o1[3] = t1[3] + a1[3] * sigmoidf_(bf2f(gv.w >> 16));
                u32x4 w; w.x = cvt_pk_bf16(o0[0], o0[1]); w.y = cvt_pk_bf16(o0[2], o0[3]); w.z = cvt_pk_bf16(o1[0], o1[1]); w.w = cvt_pk_bf16(o1[2], o1[3]);
                *(u32x4*)(MERGED + (size_t)row * D + col) = w; }
            asm volatile("" ::: "memory"); }
    }
};
struct EpiSwiglu {
    static constexpr bool PERM = true, AFTER_DRAIN = false;
    const float* b1; bf16_t* H;
    __device__ __forceinline__ float sw(float g, float l) const { g = fminf(g, 7.0f); l = fminf(fmaxf(l, -7.0f), 7.0f); return g * sigmoidf_(1.702f * g) * (l + 1.0f); }
    __device__ __forceinline__ void operator()(const f32x4 (&acc)[2][2][4][2], const Unit& u, int wr, int wc, int fr, int fq) const {
        const int row0 = u.orow + wr * 64 + fr, col0 = u.ocol + wc * 32 + 8 * fq;
        f32x4 bv[2][2];
#pragma unroll
        for (int bj = 0; bj < 2; ++bj)
#pragma unroll
            for (int n = 0; n < 2; ++n) bv[bj][n] = *(const f32x4*)(b1 + (size_t)u.aux * 4096 + col0 + bj * HALF + 4 * n);
#pragma unroll
        EPI_LOOP_AI_M { const int row = row0 + ai * HALF + m * 16;
#pragma unroll
            for (int bj = 0; bj < 2; ++bj) { const f32x4 v0 = acc[ai][bj][m][0] + bv[bj][0], v1 = acc[ai][bj][m][1] + bv[bj][1];
                u32x2 w; w.x = cvt_pk_bf16(sw(v0[0], v0[1]), sw(v0[2], v0[3])); w.y = cvt_pk_bf16(sw(v1[0], v1[1]), sw(v1[2], v1[3]));
                *(u32x2*)(H + (size_t)row * DFF + ((col0 + bj * HALF) >> 1)) = w; } }
    }
};
struct EpiSoftmax {
    static constexpr bool PERM = true, AFTER_DRAIN = true;
    bf16_t* PP;
    __device__ __forceinline__ void fused(f32x4 (&acc)[2][2][4][2], const Unit& u, int wr, int wc, int fr, int fq, PG8_LAS unsigned char* lds, int wid, int lane) const {
        PG8_LAS float* P1 = (PG8_LAS float*)lds;
        PG8_LAS float* P2 = (PG8_LAS float*)(lds + 4096);
        float mx[2][4];
#pragma unroll
        EPI_LOOP_AI_M { float v = -3.0e38f;
#pragma unroll
            for (int bj = 0; bj < 2; ++bj)
#pragma unroll
                for (int n = 0; n < 2; ++n) { const f32x4 x = acc[ai][bj][m][n]; v = fmaxf(v, fmaxf(fmaxf(x[0], x[1]), fmaxf(x[2], x[3]))); }
            v = fmaxf(v, __shfl_xor(v, 16)); v = fmaxf(v, __shfl_xor(v, 32));
            if (fq == 0) P1[(ai * HALF + wr * 64 + m * 16 + fr) * 4 + wc] = v; }
        asm volatile("s_waitcnt lgkmcnt(0)" ::: "memory"); __builtin_amdgcn_s_barrier(); asm volatile("" ::: "memory");
#pragma unroll
        EPI_LOOP_AI_M { const f32x4 t = *(const PG8_LAS f32x4*)(P1 + (ai * HALF + wr * 64 + m * 16 + fr) * 4); mx[ai][m] = fmaxf(fmaxf(t[0], t[1]), fmaxf(t[2], t[3])); }
#pragma unroll
        EPI_LOOP_AI_M { float s = 0.f;
#pragma unroll
            for (int bj = 0; bj < 2; ++bj)
#pragma unroll
                for (int n = 0; n < 2; ++n) { f32x4 x = acc[ai][bj][m][n];
#pragma unroll
                    for (int j = 0; j < 4; ++j) { x[j] = __expf(x[j] - mx[ai][m]); s += x[j]; }
                    acc[ai][bj][m][n] = x; }
            s += __shfl_xor(s, 16); s += __shfl_xor(s, 32);
            if (fq == 0) P2[(ai * HALF + wr * 64 + m * 16 + fr) * 4 + wc] = s; }
        asm volatile("s_waitcnt lgkmcnt(0)" ::: "memory"); __builtin_amdgcn_s_barrier(); asm volatile("" ::: "memory");
        const int row0 = u.orow + wr * 64 + fr, col0 = wc * 32 + 8 * fq;
#pragma unroll
        EPI_LOOP_AI_M { const f32x4 t = *(const PG8_LAS f32x4*)(P2 + (ai * HALF + wr * 64 + m * 16 + fr) * 4); const float inv = 1.0f / ((t[0] + t[1]) + (t[2] + t[3]));
            bf16_t* rowp = PP + (size_t)(row0 + ai * HALF + m * 16) * 256 + col0;
#pragma unroll
            for (int bj = 0; bj < 2; ++bj) { const f32x4 v0 = acc[ai][bj][m][0] * inv, v1 = acc[ai][bj][m][1] * inv;
                u32x4 w; w.x = cvt_pk_bf16(v0[0], v0[1]); w.y = cvt_pk_bf16(v0[2], v0[3]); w.z = cvt_pk_bf16(v1[0], v1[1]); w.w = cvt_pk_bf16(v1[2], v1[3]);
                *(u32x4*)(rowp + bj * HALF) = w; } }
        asm volatile("s_waitcnt lgkmcnt(0)" ::: "memory"); __builtin_amdgcn_s_barrier(); asm volatile("" ::: "memory");
    }
};
}

constexpr size_t MiB = 1u << 20;
constexpr size_t al256(size_t x) { return (x + 255) & ~(size_t)255; }
constexpr size_t WS_CTL = 0, CTL_ZERO_BYTES = 1 * MiB;
constexpr size_t WS_WIN = 1 * MiB;
constexpr size_t WS_WUP = WS_WIN + (size_t)PC * D * 2;
constexpr size_t WS_AUP = WS_WUP + (size_t)D * 256 * 2;
constexpr size_t WS_GUP = WS_AUP + (size_t)D * 256 * 2;
constexpr size_t WS_PA = WS_GUP + (size_t)D * 256 * 2;
constexpr size_t WS_PB = WS_PA + (size_t)D * D * 2;
constexpr size_t WS_WOUT = WS_PB + (size_t)D * 512 * 2;
constexpr size_t WS_WQ = WS_WOUT + (size_t)D * D * 2;
constexpr size_t WS_WKV = WS_WQ + (size_t)D * D * 2;
constexpr size_t WS_WO = WS_WKV + (size_t)2 * D * D * 2;
constexpr size_t WS_W1 = WS_WO + (size_t)D * D * 2;
constexpr size_t WS_W2 = WS_W1 + (size_t)NEXP * 4096 * D * 2;
constexpr size_t WS_XB = WS_W2 + (size_t)NEXP * D * DFF * 2;
constexpr size_t WS_MEMB = WS_XB + (size_t)M * D * 2;
constexpr size_t WS_ROT = WS_MEMB + (size_t)1024 * D * 2;
constexpr size_t WS_KB = WS_ROT + (size_t)2 * SEQ * 32 * 4;
constexpr size_t WS_VT = WS_KB + (size_t)1024 * D * 2;
constexpr size_t WS_YA = WS_VT + (size_t)1024 * D * 2;
constexpr size_t WS_YB = WS_YA + (size_t)M * D * 2;
constexpr size_t WS_TMP = WS_YB + (size_t)M * 512 * 2;
constexpr size_t WS_MERGED = WS_TMP + (size_t)M * D * 4;
constexpr size_t WS_E = WS_MERGED + (size_t)M * D * 2;
constexpr size_t WS_PROJ = WS_E;
constexpr size_t WS_RZ = WS_PROJ + (size_t)M * PC * 2;
constexpr size_t WS_KZ = WS_RZ + (size_t)M * D * 4;
constexpr size_t WS_VZ = WS_KZ + (size_t)M * D * 4;
constexpr size_t WS_DEC = WS_VZ + (size_t)M * D * 4;
constexpr size_t WS_KP = WS_DEC + (size_t)M * D * 4;
constexpr size_t WS_AN = WS_KP + (size_t)M * D * 4;
constexpr size_t WS_BB = WS_AN + (size_t)M * D * 4;
constexpr size_t WS_GG = WS_BB + (size_t)M * D * 4;
constexpr size_t WS_YS = WS_GG + (size_t)M * D * 4;
constexpr size_t WS_AO = WS_YS + (size_t)M * D * 4;
constexpr size_t WS_LSE = WS_AO + (size_t)3 * M * 512 * 4;
constexpr size_t WS_QR = WS_LSE + (size_t)3 * M * 8 * 4;
constexpr size_t WS_KR = WS_QR + (size_t)M * 1536 * 2;
constexpr size_t WS_LIN = WS_KR + (size_t)M * 1536 * 2;
constexpr size_t WS_KNORM = WS_LIN + (size_t)M * 768 * 2;
constexpr size_t WS_E_END = WS_KNORM + (size_t)M * 32 * 4;
constexpr size_t WS_T1 = WS_E;
constexpr size_t WS_X1 = WS_T1 + (size_t)M * D * 4;
constexpr size_t WS_X1B = WS_X1 + (size_t)M * D * 4;
constexpr size_t WS_Q = WS_X1B + (size_t)M * D * 2;
constexpr size_t WS_PP = WS_Q + (size_t)M * D * 2;
constexpr size_t WS_OC = WS_PP + (size_t)16 * SEQ * 256 * 2;
constexpr size_t WS_T2 = WS_OC + (size_t)M * D * 2;
constexpr size_t WS_X2 = WS_T2 + (size_t)M * D * 4;
constexpr size_t WS_X2B = WS_X2 + (size_t)M * D * 4;
constexpr size_t WS_LIST = WS_X2B + (size_t)M * D * 2;
constexpr size_t WS_ROWI = WS_LIST + (size_t)NEXP * CAP * 4;
constexpr size_t WS_TOPW = WS_ROWI + (size_t)M * 4 * 4;
constexpr size_t WS_H = WS_TOPW + (size_t)M * 4 * 4;
constexpr size_t WS_Y = WS_H + (size_t)HROWS * DFF * 2;
constexpr size_t WS_L_END = WS_Y + (size_t)HROWS * D * 4;
constexpr size_t WS_END = (WS_E_END > WS_L_END ? WS_E_END : WS_L_END);
constexpr int CW_TMO = 0, CW_CNT = 64  , CW_BAR = 4096;

constexpr int RING_BYTES = 131072, MISC_OFF = RING_BYTES, LDS_BYTES = 147456;

#define XB_TMO      128
#define XB_XCNT(j)  (256  + 64 * (j))
#define XB_XSUB(j)  (1280 + 64 * (j))
#define XB_XGEN(j)  (2304 + 64 * (j))
#define XB_TOP      3328
#define XB_TOPGEN   3392
#define XCD_BAR_WORDS 3456
#define XB_SPIN_CAP (1u << 18)
__device__ __forceinline__ unsigned xb_ld(unsigned* p)              { return __hip_atomic_load(p, __ATOMIC_RELAXED, __HIP_MEMORY_SCOPE_AGENT); }
__device__ __forceinline__ unsigned xb_add(unsigned* p, unsigned v) { return __hip_atomic_fetch_add(p, v, __ATOMIC_RELAXED, __HIP_MEMORY_SCOPE_AGENT); }
__device__ __forceinline__ unsigned xb_xcc_id() { return (unsigned)__builtin_amdgcn_s_getreg((3 << 11) | 20) & 0xFu; }
#define XB_SPIN(cond, bar) do { unsigned _sp = 0; while (cond) { __builtin_amdgcn_s_sleep(1); \
    if ((++_sp & 255u) == 0u) { if (xb_ld(&(bar)[XB_TMO])) break; if (_sp > XB_SPIN_CAP) { atomicAdd(&(bar)[XB_TMO], 1u); break; } } } } while (0)
struct XcdBarrier { unsigned* bar; unsigned x; volatile LAS unsigned* st; };
__device__ __forceinline__ XcdBarrier xcd_barrier_post(unsigned* bar, volatile LAS unsigned* st) {
    XcdBarrier b; b.bar = bar; b.x = xb_xcc_id(); b.st = st;
    if (threadIdx.x == 0) (void)xb_add(&bar[XB_XCNT(b.x)], 1u);
    return b;
}
__device__ __forceinline__ void xcd_barrier_complete(unsigned* bar, unsigned x, unsigned& nloc, unsigned& nx) {
    const unsigned G = gridDim.x * gridDim.y * gridDim.z;
    unsigned sum, cnt, mine, sp = 0u;
    for (;;) {
        sum = 0u; cnt = 0u; mine = 0u;
#pragma unroll
        for (unsigned j = 0; j < 16; ++j) { const unsigned c = xb_ld(&bar[XB_XCNT(j)]); sum += c; cnt += (c > 0u) ? 1u : 0u; mine = (j == x) ? c : mine; }
        if (sum == G) break;
        __builtin_amdgcn_s_sleep(1);
        if ((++sp & 255u) == 0u) { if (xb_ld(&bar[XB_TMO])) break; if (sp > XB_SPIN_CAP) { atomicAdd(&bar[XB_TMO], 1u); break; } }
    }
    nloc = mine > 0u ? mine : 1u; nx = cnt > 0u ? cnt : 1u;
}
__device__ __forceinline__ void xcd_barrier(const XcdBarrier& b) {
    asm volatile("s_waitcnt vmcnt(0)" ::: "memory");
    __syncthreads();
    if (threadIdx.x == 0) {
        unsigned* bar = b.bar;
        __builtin_amdgcn_s_waitcnt(0);
        unsigned nloc = b.st[0], nx = b.st[1];
        if (nloc == 0u) { xcd_barrier_complete(bar, b.x, nloc, nx); b.st[0] = nloc; b.st[1] = nx; }
        const unsigned old = xb_add(&bar[XB_XSUB(b.x)], 1u);
        const unsigned gen = old / nloc;
        if (old + 1u == (gen + 1u) * nloc) {
            __builtin_amdgcn_fence(__ATOMIC_RELEASE, "agent");
            asm volatile("s_waitcnt vmcnt(0)" ::: "memory");
            const unsigned og = xb_add(&bar[XB_TOP], 1u);
            const unsigned tg = og / nx;
            if (og + 1u == (tg + 1u) * nx) xb_add(&bar[XB_TOPGEN], 1u);
            else XB_SPIN(xb_ld(&bar[XB_TOPGEN]) == tg, bar);
            __builtin_amdgcn_fence(__ATOMIC_ACQUIRE, "agent");
            xb_add(&bar[XB_XGEN(b.x)], 1u);
            asm volatile("s_waitcnt vmcnt(0)" ::: "memory");
        } else {
            XB_SPIN(xb_ld(&bar[XB_XGEN(b.x)]) == gen, bar);
            __builtin_amdgcn_fence(__ATOMIC_ACQUIRE, "agent");
            asm volatile("s_waitcnt vmcnt(0)" ::: "memory");
        }
    }
    __syncthreads();
}

struct Params {
    const float* in[32];
    float* out; unsigned char* ws;
    int ph_lo, ph_hi;
};
enum { I_X = 0, I_MEM, I_WIN, I_MIX, I_W0, I_WUP, I_A0, I_AUP, I_GUP, I_KK, I_KA, I_RK, I_LNXG, I_LNXB, I_PA, I_PB, I_WOUT, I_LN1G, I_LN1B, I_WQ, I_WKV, I_WO, I_LN2G, I_LN2B,
       I_RW, I_RB, I_W1, I_B1, I_W2, I_B2, I_LN3G, I_LN3B };

struct ScoreOrder {
    static constexpr bool GATHER = false;
    const char* Q; const char* KB; int G, c;
    __device__ bool next(int i, pg8::Unit& u) const {
        const int L = i * G + c; if (L >= 256) return false;
        const int bh = L >> 4, pm = L & 15, b = bh >> 2, h = bh & 3;
        u.A = Q + ((size_t)(b * SEQ + 256 * pm) * D + h * 512) * 2; u.B = KB + ((size_t)(b * 256) * D + h * 512) * 2;
        u.orow = bh * SEQ + 256 * pm; u.ocol = 0; u.aux = 0; u.aux2 = 0; u.valid = 256; return true;
    }
    __device__ __forceinline__ const int* rows(const pg8::Unit&) const { return nullptr; }
};
struct PvOrder {
    static constexpr bool GATHER = false;
    const char* PP; const char* VT; int G, c;
    __device__ bool next(int i, pg8::Unit& u) const {
        const int L = i * G + c; if (L >= 512) return false;
        const int bh = L >> 5, pm = (L >> 1) & 15, pn = L & 1, b = bh >> 2, h = bh & 3;
        u.A = PP + ((size_t)(bh * SEQ + 256 * pm) * 256) * 2; u.B = VT + ((size_t)(bh * 512 + 256 * pn) * 256) * 2;
        u.orow = b * SEQ + 256 * pm; u.ocol = h * 512 + 256 * pn; u.aux = 0; u.aux2 = 0; u.valid = 256; return true;
    }
    __device__ __forceinline__ const int* rows(const pg8::Unit&) const { return nullptr; }
};
template <bool GATHER_, int NT  > struct MoeOrder {
    static constexpr bool GATHER = GATHER_;
    const LAS int* tab; const char* A; const char* W; const int* list; size_t wexp  ; int ldb; int G, c;
    __device__ bool next(int i, pg8::Unit& u) const {
        constexpr int RPR = 256 / NT;
        const int rt = i * RPR + (c % RPR), pn = c / RPR, T = tab[64];
        if (c >= 256 || rt >= T) return false;
        int e = 0;
        for (int j = 1; j < NEXP; ++j) e = (rt >= tab[32 + j]) ? j : e;
        const int lt = rt - tab[32 + e];
        u.aux = e; u.aux2 = lt; u.valid = min(256, tab[e] - 256 * lt); u.orow = 256 * rt; u.ocol = 256 * pn;
        u.B = W + (size_t)e * wexp + (size_t)(256 * pn) * ldb * 2;
        u.A = GATHER_ ? A : A + (size_t)(256 * rt) * DFF * 2;
        return true;
    }
    __device__ __forceinline__ const int* rows(const pg8::Unit& u) const { return list + (size_t)u.aux * CAP + 256 * u.aux2; }
};

struct Ctx { int tid, lane, wave, vcu, G; LAS unsigned char* lds; unsigned char* ws; };

__device__ __forceinline__ void tr_item(const float* W, int ldw, int Ksrc, int sc0, bf16_t* WT, int ldt, int n0, int k0, LAS float* scr, int lane) {
#pragma unroll 8
    for (int i = 0; i < 32; ++i) { const int kk = 2 * i + (lane >> 5); float v = 0.f; if (sc0 >= 0 && (k0 + kk) < Ksrc) v = W[(size_t)(k0 + kk) * ldw + sc0 + (lane & 31)]; scr[kk * 33 + (lane & 31)] = v; }
    LDS_WAIT(); asm volatile("" ::: "memory");
    const int c = lane & 7;
#pragma unroll
    for (int j = 0; j < 4; ++j) { const int n = (lane >> 3) + 8 * j; const LAS float* s = scr + (8 * c) * 33 + n;
        u32x4 o; o.x = pk2(s[0 * 33], s[1 * 33]); o.y = pk2(s[2 * 33], s[3 * 33]); o.z = pk2(s[4 * 33], s[5 * 33]); o.w = pk2(s[6 * 33], s[7 * 33]);
        *(u32x4*)(WT + (size_t)(n0 + n) * ldt + k0 + 8 * c) = o; }
    LDS_WAIT(); asm volatile("" ::: "memory");
}
__device__ __forceinline__ void tr_job(const float* W, int N, int Ksrc, int Kdst, bf16_t* WT, int item, LAS float* scr, int lane) {
    const int nblk = N / 32, kb = item / nblk, nb = item % nblk;
    tr_item(W, N, Ksrc, 32 * nb, WT, Kdst, 32 * nb, 64 * kb, scr, lane);
}
__device__ __forceinline__ void p0_prologue(const Params& p, const Ctx& c) {
    LAS float* scr = (LAS float*)(c.lds + c.wave * 16384);
    const int gw = c.vcu * 8 + c.wave, NGW = c.G * 8;
    unsigned char* ws = c.ws;
    constexpr int I_WINJ = 32 * 480, I_LORA = 4 * 64, I_SQ = 32 * 64, I_PBJ = 8 * 64, I_KVJ = 32 * 128, I_W1E = 32 * 128, I_W2E = 32 * 64;
    constexpr int NITEMS = I_WINJ + 3 * I_LORA + 4 * I_SQ + I_PBJ + I_KVJ + NEXP * I_W1E + NEXP * I_W2E;
    for (int it = gw; it < NITEMS; it += NGW) {
        int r = it;
        if (r < I_WINJ) { const int kb = r / 480, nb = r % 480; const int sc0 = nb < 206 ? 32 * nb : (nb < 208 ? -1 : 32 * nb - 64);
            tr_item(p.in[I_WIN], 15296, D, sc0, (bf16_t*)(ws + WS_WIN), D, 32 * nb, 64 * kb, scr, c.lane); continue; } r -= I_WINJ;
        if (r < I_LORA) { tr_job(p.in[I_WUP], D, 96, 256, (bf16_t*)(ws + WS_WUP), r, scr, c.lane); continue; } r -= I_LORA;
        if (r < I_LORA) { tr_job(p.in[I_AUP], D, 96, 256, (bf16_t*)(ws + WS_AUP), r, scr, c.lane); continue; } r -= I_LORA;
        if (r < I_LORA) { tr_job(p.in[I_GUP], D, 256, 256, (bf16_t*)(ws + WS_GUP), r, scr, c.lane); continue; } r -= I_LORA;
        if (r < I_SQ) { tr_job(p.in[I_PA], D, D, D, (bf16_t*)(ws + WS_PA), r, scr, c.lane); continue; } r -= I_SQ;
        if (r < I_PBJ) { tr_job(p.in[I_PB], D, 512, 512, (bf16_t*)(ws + WS_PB), r, scr, c.lane); continue; } r -= I_PBJ;
        if (r < I_SQ) { tr_job(p.in[I_WOUT], D, D, D, (bf16_t*)(ws + WS_WOUT), r, scr, c.lane); continue; } r -= I_SQ;
        if (r < I_SQ) { tr_job(p.in[I_WQ], D, D, D, (bf16_t*)(ws + WS_WQ), r, scr, c.lane); continue; } r -= I_SQ;
        if (r < I_KVJ) { tr_job(p.in[I_WKV], 2 * D, D, D, (bf16_t*)(ws + WS_WKV), r, scr, c.lane); continue; } r -= I_KVJ;
        if (r < I_SQ) { tr_job(p.in[I_WO], D, D, D, (bf16_t*)(ws + WS_WO), r, scr, c.lane); continue; } r -= I_SQ;
        if (r < NEXP * I_W1E) { const int e = r / I_W1E; tr_job(p.in[I_W1] + (size_t)e * D * 4096, 4096, D, D, (bf16_t*)(ws + WS_W1) + (size_t)e * 4096 * D, r % I_W1E, scr, c.lane); continue; } r -= NEXP * I_W1E;
        { const int e = r / I_W2E; tr_job(p.in[I_W2] + (size_t)e * DFF * D, D, DFF, DFF, (bf16_t*)(ws + WS_W2) + (size_t)e * D * DFF, r % I_W2E, scr, c.lane); }
    }
    const size_t gt = (size_t)c.vcu * 512 + c.tid, NT = (size_t)c.G * 512;
    for (size_t i = gt; i < (size_t)M * D / 8; i += NT) { const f32x4 a = ((const f32x4*)p.in[I_X])[2 * i], b = ((const f32x4*)p.in[I_X])[2 * i + 1];
        u32x4 o; o.x = pk2(a[0], a[1]); o.y = pk2(a[2], a[3]); o.z = pk2(b[0], b[1]); o.w = pk2(b[2], b[3]); ((u32x4*)(ws + WS_XB))[i] = o; }
    for (size_t i = gt; i < (size_t)1024 * D / 8; i += NT) { const f32x4 a = ((const f32x4*)p.in[I_MEM])[2 * i], b = ((const f32x4*)p.in[I_MEM])[2 * i + 1];
        u32x4 o; o.x = pk2(a[0], a[1]); o.y = pk2(a[2], a[3]); o.z = pk2(b[0], b[1]); o.w = pk2(b[2], b[3]); ((u32x4*)(ws + WS_MEMB))[i] = o; }
    float* rc = (float*)(ws + WS_ROT); float* rs = rc + SEQ * 32;
    for (size_t i = gt; i < (size_t)SEQ * 32; i += NT) { const int pos = (int)(i >> 5), j = (int)(i & 31);
        const double inv = exp(-(double)j * (9.210340371976184 / 32.0)); const double ang = (double)pos * inv; rc[i] = (float)cos(ang); rs[i] = (float)sin(ang); }
}

__device__ __forceinline__ void p2_prep(const Params& p, const Ctx& c) {
    unsigned char* ws = c.ws;
    const bf16_t* PROJ = (const bf16_t*)(ws + WS_PROJ);
    const float* mix = p.in[I_MIX]; const float* k_k = p.in[I_KK];
    float* RZ = (float*)(ws + WS_RZ); float* KZ = (float*)(ws + WS_KZ); float* VZ = (float*)(ws + WS_VZ);
    bf16_t* LIN = (bf16_t*)(ws + WS_LIN); float* KNORM = (float*)(ws + WS_KNORM);
    bf16_t* QR = (bf16_t*)(ws + WS_QR); bf16_t* KR = (bf16_t*)(ws + WS_KR);
    const float* rc = (const float*)(ws + WS_ROT); const float* rs = rc + SEQ * 32;
    for (int t = c.vcu; t < M; t += c.G) {
        const int pos = t & (SEQ - 1);
        const bf16_t* cur = PROJ + (size_t)t * PC;
        for (int ch = c.tid; ch < 824; ch += 512) {
            const u32x4 cv = *(const u32x4*)(cur + 8 * ch); u32x4 pv = (u32x4){0u, 0u, 0u, 0u}; if (pos > 0) pv = *(const u32x4*)(cur - PC + 8 * ch);
            const f32x4 m0 = *(const f32x4*)(mix + 8 * ch), m1 = *(const f32x4*)(mix + 8 * ch + 4);
            float z[8];
            { const unsigned cw[4] = {cv.x, cv.y, cv.z, cv.w}, pw[4] = {pv.x, pv.y, pv.z, pv.w};
              const float mm[8] = {m0[0], m0[1], m0[2], m0[3], m1[0], m1[1], m1[2], m1[3]};
#pragma unroll
              for (int j = 0; j < 4; ++j) { const float c0 = bf2f(cw[j] & 0xffffu), c1 = bf2f(cw[j] >> 16), q0 = bf2f(pw[j] & 0xffffu), q1 = bf2f(pw[j] >> 16);
                  z[2 * j] = c0 + (q0 - c0) * mm[2 * j]; z[2 * j + 1] = c1 + (q1 - c1) * mm[2 * j + 1]; } }
            if (ch < 768) {
                float* dst = (ch < 256 ? RZ : (ch < 512 ? KZ : VZ)) + (size_t)t * D + 8 * (ch & 255);
                *(f32x4*)dst = (f32x4){z[0], z[1], z[2], z[3]}; *(f32x4*)(dst + 4) = (f32x4){z[4], z[5], z[6], z[7]};
                if (ch >= 256 && ch < 512) {
                    const int col = 8 * (ch - 256); const f32x4 k0 = *(const f32x4*)(k_k + col), k1 = *(const f32x4*)(k_k + col + 4);
                    float s = 0.f;
#pragma unroll
                    for (int j = 0; j < 4; ++j) { const float a = z[j] * k0[j], b = z[4 + j] * k1[j]; s += a * a + b * b; }
                    s += __shfl_xor(s, 1); s += __shfl_xor(s, 2); s += __shfl_xor(s, 4);
                    if ((ch & 7) == 0) KNORM[(size_t)t * 32 + ((ch - 256) >> 3)] = sqrtf(s);
                }
            } else {
                float o[8]; int dcol;
                if (ch < 780) { dcol = 8 * (ch - 768);
#pragma unroll
                    for (int j = 0; j < 8; ++j) o[j] = tanhf(z[j]); }
                else if (ch < 792) { dcol = 256 + 8 * (ch - 780);
#pragma unroll
                    for (int j = 0; j < 8; ++j) o[j] = z[j]; }
                else { dcol = 512 + 8 * (ch - 792);
#pragma unroll
                    for (int j = 0; j < 8; ++j) o[j] = sigmoidf_(z[j]); }
                u32x4 w; w.x = pk2(o[0], o[1]); w.y = pk2(o[2], o[3]); w.z = pk2(o[4], o[5]); w.w = pk2(o[6], o[7]);
                *(u32x4*)(LIN + (size_t)t * 768 + dcol) = w;
            }
        }
        if (c.tid < 40) { const int dcol = (c.tid < 20) ? 96 + 8 * c.tid : 352 + 8 * (c.tid - 20); *(u32x4*)(LIN + (size_t)t * 768 + dcol) = (u32x4){0u, 0u, 0u, 0u}; }
        if (c.tid >= 64 && c.tid < 64 + 192) { const int w = c.tid - 64, which = w / 96, hh = (w % 96) >> 2, e0 = (w & 3) * 8;
            const bf16_t* src = cur + ATT0 + which * 1536 + hh * 64 + e0;
            const u32x4 a = *(const u32x4*)src, b = *(const u32x4*)(src + 32);
            const f32x4 c0 = *(const f32x4*)(rc + pos * 32 + e0), c1 = *(const f32x4*)(rc + pos * 32 + e0 + 4), s0 = *(const f32x4*)(rs + pos * 32 + e0), s1 = *(const f32x4*)(rs + pos * 32 + e0 + 4);
            const unsigned aw[4] = {a.x, a.y, a.z, a.w}, bw[4] = {b.x, b.y, b.z, b.w}; float o1[8], o2[8];
#pragma unroll
            for (int j = 0; j < 8; ++j) { const float t1 = bf2f((aw[j >> 1] >> (16 * (j & 1))) & 0xffffu), t2 = bf2f((bw[j >> 1] >> (16 * (j & 1))) & 0xffffu);
                const float cs = j < 4 ? c0[j & 3] : c1[j & 3], sn = j < 4 ? s0[j & 3] : s1[j & 3]; o1[j] = t1 * cs - t2 * sn; o2[j] = t2 * cs + t1 * sn; }
            bf16_t* dst = (which ? KR : QR) + (size_t)t * 1536 + hh * 64 + e0;
            u32x4 w1; w1.x = pk2(o1[0], o1[1]); w1.y = pk2(o1[2], o1[3]); w1.z = pk2(o1[4], o1[5]); w1.w = pk2(o1[6], o1[7]);
            u32x4 w2; w2.x = pk2(o2[0], o2[1]); w2.y = pk2(o2[2], o2[3]); w2.z = pk2(o2[4], o2[5]); w2.w = pk2(o2[6], o2[7]);
            *(u32x4*)dst = w1; *(u32x4*)(dst + 32) = w2; }
    }
}

__device__ __forceinline__ float quad_sum(float x) {
    x += __builtin_bit_cast(float, __builtin_amdgcn_update_dpp(0, __builtin_bit_cast(int, x), 0xB1, 0xF, 0xF, true));
    x += __builtin_bit_cast(float, __builtin_amdgcn_update_dpp(0, __builtin_bit_cast(int, x), 0x4E, 0xF, 0xF, true));
    return x;
}
__device__ __forceinline__ void p4_scan(const Ctx& c, int bh) {
    constexpr int TS = 16;
    unsigned char* ws = c.ws;
    const float* src[6] = {(const float*)(ws + WS_RZ), (const float*)(ws + WS_DEC), (const float*)(ws + WS_KP), (const float*)(ws + WS_VZ), (const float*)(ws + WS_AN), (const float*)(ws + WS_BB)};
    float* YS = (float*)(ws + WS_YS);
    LAS float* buf = (LAS float*)c.lds;
    const int b = bh >> 5, h = bh & 31, tid = c.tid;
    const size_t base = (size_t)b * SEQ * D + h * 64;
    const int i = (tid >> 2) & 63, q = tid & 3;
    float S[16];
#pragma unroll
    for (int j = 0; j < 16; ++j) S[j] = 0.f;
    f32x4 pre[6];
#define SCAN_ISSUE(T0) do { _Pragma("unroll") for (int j = 0; j < 6; ++j) { const int e4 = tid + 256 * j, s_ = e4 / 96, rem = e4 % 96, v_ = rem >> 4, c4 = rem & 15; \
            const float* sp = v_ == 0 ? src[0] : v_ == 1 ? src[1] : v_ == 2 ? src[2] : v_ == 3 ? src[3] : v_ == 4 ? src[4] : src[5]; \
            pre[j] = *(const f32x4*)(sp + base + (size_t)((T0) + s_) * D + c4 * 4); } } while (0)
    if (tid < 256) SCAN_ISSUE(0);
    for (int t0 = 0; t0 < SEQ; t0 += TS) {
        __syncthreads();
        if (tid < 256) {
#pragma unroll
            for (int j = 0; j < 6; ++j) { const int e4 = tid + 256 * j; *(LAS f32x4*)(buf + 4 * e4) = pre[j]; }
        }
        __syncthreads();
        if (tid < 256) {
            if (t0 + TS < SEQ) SCAN_ISSUE(t0 + TS);
            for (int s = 0; s < TS; ++s) {
                const LAS float* st = buf + s * 384;
                f32x4 av[4], bv[4], wv[4], kv[4], rv[4];
#pragma unroll
                for (int j = 0; j < 4; ++j) { av[j] = *(const LAS f32x4*)(st + 4 * 64 + 16 * q + 4 * j); wv[j] = *(const LAS f32x4*)(st + 1 * 64 + 16 * q + 4 * j);
                    bv[j] = *(const LAS f32x4*)(st + 5 * 64 + 16 * q + 4 * j); kv[j] = *(const LAS f32x4*)(st + 2 * 64 + 16 * q + 4 * j); rv[j] = *(const LAS f32x4*)(st + 0 * 64 + 16 * q + 4 * j); }
                const float vi = st[3 * 64 + i];
                float sa = 0.f;
#pragma unroll
                for (int j = 0; j < 16; ++j) sa += S[j] * av[j >> 2][j & 3];
                sa = quad_sum(sa);
                float y = 0.f;
#pragma unroll
                for (int j = 0; j < 16; ++j) { S[j] = S[j] * wv[j >> 2][j & 3] + sa * bv[j >> 2][j & 3] + vi * kv[j >> 2][j & 3]; y += S[j] * rv[j >> 2][j & 3]; }
                y = quad_sum(y);
                if (q == 0) YS[base + (size_t)(t0 + s) * D + i] = y;
            }
        }
    }
    __syncthreads();
#undef SCAN_ISSUE
}

__device__ __forceinline__ void p4_attn_task(const Ctx& c, int task) {
    unsigned char* ws = c.ws;
    const bf16_t* QR = (const bf16_t*)(ws + WS_QR); const bf16_t* KR = (const bf16_t*)(ws + WS_KR); const bf16_t* PROJ = (const bf16_t*)(ws + WS_PROJ);
    float* AO = (float*)(ws + WS_AO); float* LSE = (float*)(ws + WS_LSE);
    constexpr int VP = 280;
    LAS bf16_t* Vt = (LAS bf16_t*)c.lds;
    const int combo = task & 31, hh = (task >> 5) % 24, b = task / (32 * 24);
    const int g = hh >> 3, h = hh & 7;
    const int dil = g == 0 ? 1 : (g == 1 ? 4 : 16);
    const int res = combo % dil, blk = combo / dil;
    const int tid = c.tid, lane = c.lane, w = c.wave;
    __syncthreads();
    {
        const int ki = tid >> 1, dh = tid & 1; const int pk = (blk - 1) * 128 + ki;
        u32x4 v[4];
        if (pk >= 0) { const bf16_t* sp = PROJ + ((size_t)b * SEQ + (size_t)pk * dil + res) * PC + ATT0 + 2 * 1536 + hh * 64 + 32 * dh;
#pragma unroll
            for (int j = 0; j < 4; ++j) v[j] = *(const u32x4*)(sp + 8 * j); }
        else {
#pragma unroll
            for (int j = 0; j < 4; ++j) v[j] = (u32x4){0u, 0u, 0u, 0u}; }
#pragma unroll
        for (int j = 0; j < 4; ++j) { const unsigned wv[4] = {v[j].x, v[j].y, v[j].z, v[j].w};
#pragma unroll
            for (int e = 0; e < 8; ++e) Vt[(32 * dh + 8 * j + e) * VP + ki] = (bf16_t)((wv[e >> 1] >> (16 * (e & 1))) & 0xffffu); }
        if (tid < 64) {
#pragma unroll
            for (int e = 0; e < 24; ++e) Vt[tid * VP + 256 + e] = 0; }
    }
    __syncthreads();
    const int qq = lane & 15, g4 = lane >> 4;
    const int r0 = 16 * w;
    const size_t qtok = (size_t)b * SEQ + (size_t)(blk * 128 + r0 + qq) * dil + res;
    bf16x8 qf[2];
#pragma unroll
    for (int ks = 0; ks < 2; ++ks) qf[ks] = *(const bf16x8*)(QR + qtok * 1536 + hh * 64 + 32 * ks + 8 * g4);
    f32x4 sc[10];
#pragma unroll
    for (int kt = 0; kt < 9; ++kt) {
        const int ki = 16 * (w + kt) + qq; const int pk = (blk - 1) * 128 + ki;
        f32x4 a = (f32x4){0.f, 0.f, 0.f, 0.f};
#pragma unroll
        for (int ks = 0; ks < 2; ++ks) { bf16x8 kf = (bf16x8){0, 0, 0, 0, 0, 0, 0, 0};
            if (pk >= 0) kf = *(const bf16x8*)(KR + ((size_t)b * SEQ + (size_t)pk * dil + res) * 1536 + hh * 64 + 32 * ks + 8 * g4);
            a = __builtin_amdgcn_mfma_f32_16x16x32_bf16(kf, qf[ks], a, 0, 0, 0); }
        sc[kt] = a;
    }
    const int r = r0 + qq;
    float mx = -3.0e38f;
#pragma unroll
    for (int kt = 0; kt < 9; ++kt)
#pragma unroll
        for (int j = 0; j < 4; ++j) { const int ki = 16 * (w + kt) + 4 * g4 + j; const bool ok = (ki >= r) && (ki <= r + 128) && (blk > 0 || ki >= 128);
            const float s = ok ? sc[kt][j] * 0.125f : -1.0e30f; sc[kt][j] = s; mx = fmaxf(mx, s); }
    mx = fmaxf(mx, __shfl_xor(mx, 16)); mx = fmaxf(mx, __shfl_xor(mx, 32));
    float den = 0.f;
#pragma unroll
    for (int kt = 0; kt < 9; ++kt)
#pragma unroll
        for (int j = 0; j < 4; ++j) { const float pexp = __expf(sc[kt][j] - mx); sc[kt][j] = pexp; den += pexp; }
    den += __shfl_xor(den, 16); den += __shfl_xor(den, 32);
    sc[9] = (f32x4){0.f, 0.f, 0.f, 0.f};
    f32x4 oacc[4];
#pragma unroll
    for (int dt = 0; dt < 4; ++dt) oacc[dt] = (f32x4){0.f, 0.f, 0.f, 0.f};
#pragma unroll
    for (int cidx = 0; cidx < 5; ++cidx) {
        const f32x4 p0 = sc[2 * cidx], p1 = sc[2 * cidx + 1];
        u32x4 pw; pw.x = pk2(p0[0], p0[1]); pw.y = pk2(p0[2], p0[3]); pw.z = pk2(p1[0], p1[1]); pw.w = pk2(p1[2], p1[3]);
        const bf16x8 pf = __builtin_bit_cast(bf16x8, pw);
        const int kbase = 16 * (w + 2 * cidx) + 4 * g4;
#pragma unroll
        for (int dt = 0; dt < 4; ++dt) { const LAS bf16_t* vp = Vt + (16 * dt + qq) * VP + kbase;
            const u32x2 lo = *(const LAS u32x2*)vp, hi = *(const LAS u32x2*)(vp + 16);
            u32x4 vw; vw.x = lo.x; vw.y = lo.y; vw.z = hi.x; vw.w = hi.y;
            oacc[dt] = __builtin_amdgcn_mfma_f32_16x16x32_bf16(__builtin_bit_cast(bf16x8, vw), pf, oacc[dt], 0, 0, 0); }
    }
    const float inv = 1.0f / den;
    const size_t tok = qtok;
#pragma unroll
    for (int dt = 0; dt < 4; ++dt) *(f32x4*)(AO + ((size_t)g * M + tok) * 512 + h * 64 + 16 * dt + 4 * g4) = oacc[dt] * inv;
    if (g4 == 0) LSE[((size_t)g * M + tok) * 8 + h] = mx + __logf(den);
}

__device__ __forceinline__ void p5_post(const Params& p, const Ctx& c) {
    unsigned char* ws = c.ws;
    const float* YS = (const float*)(ws + WS_YS); const float* RZ = (const float*)(ws + WS_RZ); const float* KP = (const float*)(ws + WS_KP); const float* VZ = (const float*)(ws + WS_VZ);
    const float* GG = (const float*)(ws + WS_GG); const float* AO = (const float*)(ws + WS_AO); const float* LSE = (const float*)(ws + WS_LSE);
    bf16_t* YA = (bf16_t*)(ws + WS_YA); bf16_t* YB = (bf16_t*)(ws + WS_YB);
    const float* lg = p.in[I_LNXG]; const float* lb = p.in[I_LNXB]; const float* rk = p.in[I_RK];
    const int gw = c.vcu * 8 + c.wave, NGW = c.G * 8, lane = c.lane;
    for (int it = gw; it < M * 32; it += NGW) {
        const size_t o = (size_t)it * 64 + lane; const int col = (it & 31) * 64 + lane;
        const float y = YS[o]; const float mu = wave_sum(y) * (1.0f / 64.0f); const float dlt = y - mu; const float var = wave_sum(dlt * dlt) * (1.0f / 64.0f);
        const float yn = dlt * rsqrtf(var + GN_EPS) * lg[col] + lb[col];
        const float v = VZ[o]; const float bonus = wave_sum(RZ[o] * KP[o] * rk[col]) * v;
        YA[o] = (bf16_t)f2bf((yn + bonus) * GG[o]);
    }
    for (int it = gw; it < M * 8; it += NGW) {
        const int t = it >> 3, h = it & 7;
        const float l0 = LSE[((size_t)0 * M + t) * 8 + h], l1 = LSE[((size_t)1 * M + t) * 8 + h], l2 = LSE[((size_t)2 * M + t) * 8 + h];
        const float mxl = fmaxf(l0, fmaxf(l1, l2)); const float e0 = __expf(l0 - mxl), e1 = __expf(l1 - mxl), e2 = __expf(l2 - mxl); const float inv = 1.0f / (e0 + e1 + e2);
        const size_t o = (size_t)t * 512 + h * 64 + lane;
        const float v = (e0 * AO[o] + e1 * AO[(size_t)M * 512 + o] + e2 * AO[(size_t)2 * M * 512 + o]) * inv;
        YB[o] = (bf16_t)f2bf(v);
    }
}

__device__ __forceinline__ void ln_rows(const Ctx& c, const float* in, const float* gam, const float* bet, float* outf, bf16_t* outb) {
    const int gw = c.vcu * 8 + c.wave, NGW = c.G * 8, lane = c.lane;
    for (int m = gw; m < M; m += NGW) {
        const f32x4* xr = (const f32x4*)(in + (size_t)m * D) + lane;
        f32x4 v[8]; float s = 0.f;
#pragma unroll
        for (int j = 0; j < 8; ++j) { v[j] = xr[64 * j]; s += (v[j][0] + v[j][1]) + (v[j][2] + v[j][3]); }
        const float mean = wave_sum(s) * (1.0f / D); float s2 = 0.f;
#pragma unroll
        for (int j = 0; j < 8; ++j) { v[j] = v[j] - mean; s2 += (v[j][0] * v[j][0] + v[j][1] * v[j][1]) + (v[j][2] * v[j][2] + v[j][3] * v[j][3]); }
        const float rstd = rsqrtf(wave_sum(s2) * (1.0f / D) + LN_EPS);
#pragma unroll
        for (int j = 0; j < 8; ++j) { const int col = 4 * lane + 256 * j; const f32x4 gv = *(const f32x4*)(gam + col), bv = *(const f32x4*)(bet + col);
            const f32x4 o = v[j] * rstd * gv + bv;
            *(f32x4*)(outf + (size_t)m * D + col) = o;
            if (outb) { u32x2 w; w.x = pk2(o[0], o[1]); w.y = pk2(o[2], o[3]); *(u32x2*)(outb + (size_t)m * D + col) = w; } }
    }
}

__device__ __forceinline__ void p15_router(const Params& p, const Ctx& c) {
    unsigned char* ws = c.ws;
    const float* X2 = (const float*)(ws + WS_X2); const float* RW = p.in[I_RW]; const float* RB = p.in[I_RB];
    unsigned* cnt = (unsigned*)(ws + WS_CTL) + CW_CNT; int* LIST = (int*)(ws + WS_LIST); int* ROWI = (int*)(ws + WS_ROWI); float* TOPW = (float*)(ws + WS_TOPW);
    LAS float* scr = (LAS float*)(c.lds + c.wave * 8192);
    const int gw = c.vcu * 8 + c.wave, NGW = c.G * 8, lane = c.lane, li = lane & 31, lk = lane >> 5;
    for (int tb = gw; tb < M / 32; tb += NGW) {
        const int t0 = tb * 32;
        f32x16 acc;
#pragma unroll
        for (int j = 0; j < 16; ++j) acc[j] = 0.f;
        const float* xa = X2 + (size_t)(t0 + li) * D + 4 * lk;
        const float* wb = RW + (size_t)(4 * lk) * 32 + li;
        for (int kb = 0; kb < D / 8; ++kb) {
            const f32x4 a = *(const f32x4*)(xa + 8 * kb);
            const float b0 = wb[(size_t)(8 * kb + 0) * 32], b1 = wb[(size_t)(8 * kb + 1) * 32], b2 = wb[(size_t)(8 * kb + 2) * 32], b3 = wb[(size_t)(8 * kb + 3) * 32];
            acc = __builtin_amdgcn_mfma_f32_32x32x2f32(a[0], b0, acc, 0, 0, 0);
            acc = __builtin_amdgcn_mfma_f32_32x32x2f32(a[1], b1, acc, 0, 0, 0);
            acc = __builtin_amdgcn_mfma_f32_32x32x2f32(a[2], b2, acc, 0, 0, 0);
            acc = __builtin_amdgcn_mfma_f32_32x32x2f32(a[3], b3, acc, 0, 0, 0);
        }
        const float bias = RB[li];
#pragma unroll
        for (int rg = 0; rg < 16; ++rg) { const int row = (rg & 3) + 8 * (rg >> 2) + 4 * lk; scr[row * 33 + li] = acc[rg] + bias; }
        LDS_WAIT(); asm volatile("" ::: "memory");
        if (lane < 32) {
            float lv[32];
#pragma unroll
            for (int e = 0; e < 32; ++e) lv[e] = scr[lane * 33 + e];
            int id[4]; float tv[4];
#pragma unroll
            for (int k = 0; k < 4; ++k) { float best = -3.0e38f; int bi = 0;
#pragma unroll
                for (int e = 0; e < 32; ++e) { const bool tk = lv[e] > best; best = tk ? lv[e] : best; bi = tk ? e : bi; }
                id[k] = bi; tv[k] = best;
#pragma unroll
                for (int e = 0; e < 32; ++e) lv[e] = (e == bi) ? -3.0e38f : lv[e]; }
            const float e1 = __expf(tv[1] - tv[0]), e2 = __expf(tv[2] - tv[0]), e3 = __expf(tv[3] - tv[0]); const float inv = 1.0f / (1.0f + e1 + e2 + e3);
            const float wv[4] = {inv, e1 * inv, e2 * inv, e3 * inv};
            const int t = t0 + lane;
#pragma unroll
            for (int k = 0; k < 4; ++k) { const unsigned slot = __hip_atomic_fetch_add(cnt + id[k], 1u, __ATOMIC_RELAXED, __HIP_MEMORY_SCOPE_AGENT);
                LIST[(size_t)id[k] * CAP + slot] = t; ROWI[(size_t)t * 4 + k] = id[k] * CAP + (int)slot; TOPW[(size_t)t * 4 + k] = wv[k]; }
        }
        LDS_WAIT(); asm volatile("" ::: "memory");
    }
}

__device__ __forceinline__ void moe_table(const Ctx& c, LAS int* tab) {
    if (c.tid == 0) { unsigned* cnt = (unsigned*)(c.ws + WS_CTL) + CW_CNT; int ts = 0;
        for (int e = 0; e < NEXP; ++e) { const int n = (int)__hip_atomic_load(cnt + e, __ATOMIC_RELAXED, __HIP_MEMORY_SCOPE_AGENT); tab[e] = n; tab[32 + e] = ts; ts += (n + 255) >> 8; }
        tab[64] = ts; }
    __syncthreads();
}

__device__ __forceinline__ void p18_combine(const Params& p, const Ctx& c, const LAS int* tab) {
    unsigned char* ws = c.ws;
    const float* X2 = (const float*)(ws + WS_X2); const float* Y = (const float*)(ws + WS_Y); const int* ROWI = (const int*)(ws + WS_ROWI); const float* TOPW = (const float*)(ws + WS_TOPW);
    const float* gam = p.in[I_LN3G]; const float* bet = p.in[I_LN3B];
    const int gw = c.vcu * 8 + c.wave, NGW = c.G * 8, lane = c.lane;
    for (int m = gw; m < M; m += NGW) {
        f32x4 v[8];
        const f32x4* xr = (const f32x4*)(X2 + (size_t)m * D) + lane;
#pragma unroll
        for (int j = 0; j < 8; ++j) v[j] = xr[64 * j] * DN_ALPHA;
#pragma unroll
        for (int k = 0; k < 4; ++k) { const int ri = ROWI[(size_t)m * 4 + k]; const float gt = TOPW[(size_t)m * 4 + k]; const int e = ri >> 14, slot = ri & (CAP - 1);
            const f32x4* yr = (const f32x4*)(Y + ((size_t)tab[32 + e] * 256 + slot) * D) + lane;
#pragma unroll
            for (int j = 0; j < 8; ++j) v[j] = v[j] + yr[64 * j] * gt; }
        float s = 0.f;
#pragma unroll
        for (int j = 0; j < 8; ++j) s += (v[j][0] + v[j][1]) + (v[j][2] + v[j][3]);
        const float mean = wave_sum(s) * (1.0f / D); float s2 = 0.f;
#pragma unroll
        for (int j = 0; j < 8; ++j) { v[j] = v[j] - mean; s2 += (v[j][0] * v[j][0] + v[j][1] * v[j][1]) + (v[j][2] * v[j][2] + v[j][3] * v[j][3]); }
        const float rstd = rsqrtf(wave_sum(s2) * (1.0f / D) + LN_EPS);
#pragma unroll
        for (int j = 0; j < 8; ++j) { const int col = 4 * lane + 256 * j; const f32x4 gv = *(const f32x4*)(gam + col), bv = *(const f32x4*)(bet + col);
            *(f32x4*)(p.out + (size_t)m * D + col) = v[j] * rstd * gv + bv; }
    }
}

constexpr int NPHASE = 19;
__global__ void __launch_bounds__(512, 2) fwd(Params p) {
    extern __shared__ __attribute__((aligned(16))) unsigned char lds_raw[];
    LAS unsigned char* lds = (LAS unsigned char*)lds_raw;
    Ctx c; c.tid = threadIdx.x; c.lane = c.tid & 63; c.wave = __builtin_amdgcn_readfirstlane(c.tid >> 6); c.G = gridDim.x;
    { const int bx = blockIdx.x; c.vcu = (c.G % 8 == 0) ? (bx % 8) * (c.G / 8) + bx / 8 : bx; }
    c.lds = lds; c.ws = p.ws;
    unsigned char* ws = p.ws;
    volatile LAS unsigned* MISC = (volatile LAS unsigned*)(lds + MISC_OFF);
    LAS int* tab = (LAS int*)(lds + MISC_OFF + 1024);
    if (c.tid < 64) MISC[c.tid] = 0u;
    __syncthreads();
    unsigned* ctl = (unsigned*)(ws + WS_CTL);
    XcdBarrier bar; bar.bar = ctl + CW_BAR; bar.x = 0; bar.st = MISC + 8;
    if (N_LAUNCH_MODE == 1) bar = xcd_barrier_post(ctl + CW_BAR, MISC + 8);
    const int lo = p.ph_lo, hi = p.ph_hi, bx = blockIdx.x;
#ifndef PHMASK
#define PHMASK 0xFFFFFFFFu
#endif
#define IN(k) (((PHMASK >> (k)) & 1u) && lo <= (k) && (k) < hi)
#define SEAM(k) do { if (N_LAUNCH_MODE == 1 && IN((k) + 1)) xcd_barrier(bar); } while (0)

    if (IN(0)) { p0_prologue(p, c); SEAM(0); }

    if (IN(1)) {
        pg8::StaticOrder S; S.init(ws + WS_XB, ws + WS_WIN, M, PC, D, D, c.G, bx);
        pg8::EpiBf16 E{(bf16_t*)(ws + WS_PROJ), PC, 1.0f};
        pg8::gemm_phase<pg8::EpiBf16, pg8::StaticOrder>(lds, pg8::Gemm{D, D, D}, S, E);
        SEAM(1);
    }
    if (IN(2)) { p2_prep(p, c); SEAM(2); }

    if (IN(3)) {
#ifndef P3M
#define P3M 15
#endif
        if (P3M & 1) { pg8::StaticOrder S; S.init(ws + WS_LIN, ws + WS_WUP, M, D, 768, 256, c.G, bx);
          pg8::EpiDecay E{(float*)(ws + WS_DEC), p.in[I_W0]};
          pg8::gemm_phase<pg8::EpiDecay, pg8::StaticOrder>(lds, pg8::Gemm{256, 768, 256}, S, E); }
        if (P3M & 2) { pg8::StaticOrder S; S.init(ws + WS_LIN + 512, ws + WS_AUP, M, D, 768, 256, c.G, bx);
          pg8::EpiIclr E{p.in[I_A0], p.in[I_KK], p.in[I_KA], (const float*)(ws + WS_KZ), (const float*)(ws + WS_KNORM), (float*)(ws + WS_KP), (float*)(ws + WS_AN), (float*)(ws + WS_BB)};
          pg8::gemm_phase<pg8::EpiIclr, pg8::StaticOrder>(lds, pg8::Gemm{256, 768, 256}, S, E); }
        if (P3M & 4) { pg8::StaticOrder S; S.init(ws + WS_LIN + 1024, ws + WS_GUP, M, D, 768, 256, c.G, bx);
          pg8::EpiF32 E{(float*)(ws + WS_GG), D, nullptr, 0, nullptr, 0.f};
          pg8::gemm_phase<pg8::EpiF32, pg8::StaticOrder>(lds, pg8::Gemm{256, 768, 256}, S, E); }
        if (P3M & 8) { pg8::StaticOrder S; S.init(ws + WS_MEMB, ws + WS_WKV, 1024, 2 * D, D, D, c.G, bx);
          pg8::EpiKV E{(bf16_t*)(ws + WS_KB), (bf16_t*)(ws + WS_VT)};
          pg8::gemm_phase<pg8::EpiKV, pg8::StaticOrder>(lds, pg8::Gemm{D, D, D}, S, E); }
        SEAM(3);
    }
    if (IN(4)) {
        if (c.G >= 256) { if (c.vcu < 128) p4_scan(c, c.vcu); else for (int t = c.vcu - 128; t < 3072; t += c.G - 128) p4_attn_task(c, t); }
        else { for (int bh = c.vcu; bh < 128; bh += c.G) p4_scan(c, bh); for (int t = c.vcu; t < 3072; t += c.G) p4_attn_task(c, t); }
        SEAM(4);
    }
    if (IN(5)) { p5_post(p, c); SEAM(5); }

    if (IN(6)) {
        pg8::StaticOrder S; S.init(ws + WS_YA, ws + WS_PA, M, D, D, D, c.G, bx);
        pg8::EpiGateA E{(const bf16_t*)(ws + WS_PROJ), (float*)(ws + WS_TMP)};
        pg8::gemm_phase<pg8::EpiGateA, pg8::StaticOrder>(lds, pg8::Gemm{D, D, D}, S, E);
        SEAM(6);
    }
    if (IN(7)) {
        pg8::StaticOrder S; S.init(ws + WS_YB, ws + WS_PB, M, D, 512, 512, c.G, bx);
        pg8::EpiGateB E{(const bf16_t*)(ws + WS_PROJ), (const float*)(ws + WS_TMP), (bf16_t*)(ws + WS_MERGED)};
        pg8::gemm_phase<pg8::EpiGateB, pg8::StaticOrder>(lds, pg8::Gemm{512, 512, 512}, S, E);
        SEAM(7);
    }
    if (IN(8)) {
        pg8::StaticOrder S; S.init(ws + WS_MERGED, ws + WS_WOUT, M, D, D, D, c.G, bx);
        pg8::EpiF32 E{(float*)(ws + WS_T1), D, nullptr, 0, p.in[I_X], DN_ALPHA};
        pg8::gemm_phase<pg8::EpiF32, pg8::StaticOrder>(lds, pg8::Gemm{D, D, D}, S, E);
        SEAM(8);
    }
    if (IN(9)) { ln_rows(c, (const float*)(ws + WS_T1), p.in[I_LN1G], p.in[I_LN1B], (float*)(ws + WS_X1), (bf16_t*)(ws + WS_X1B)); SEAM(9); }

    if (IN(10)) {
        pg8::StaticOrder S; S.init(ws + WS_X1B, ws + WS_WQ, M, D, D, D, c.G, bx);
        pg8::EpiBf16 E{(bf16_t*)(ws + WS_Q), D, 0.04419417382415922f};
        pg8::gemm_phase<pg8::EpiBf16, pg8::StaticOrder>(lds, pg8::Gemm{D, D, D}, S, E);
        SEAM(10);
    }
    if (IN(11)) {
        ScoreOrder S{(const char*)(ws + WS_Q), (const char*)(ws + WS_KB), c.G, bx};
        pg8::EpiSoftmax E{(bf16_t*)(ws + WS_PP)};
        pg8::gemm_phase<pg8::EpiSoftmax, ScoreOrder, false>(lds, pg8::Gemm{512, D, D}, S, E);
        SEAM(11);
    }
    if (IN(12)) {
        PvOrder S{(const char*)(ws + WS_PP), (const char*)(ws + WS_VT), c.G, bx};
        pg8::EpiBf16 E{(bf16_t*)(ws + WS_OC), D, 1.0f};
        pg8::gemm_phase<pg8::EpiBf16, PvOrder>(lds, pg8::Gemm{256, 256, 256}, S, E);
        SEAM(12);
    }
    if (IN(13)) {
        pg8::StaticOrder S; S.init(ws + WS_OC, ws + WS_WO, M, D, D, D, c.G, bx);
        pg8::EpiF32 E{(float*)(ws + WS_T2), D, nullptr, 0, (const float*)(ws + WS_X1), DN_ALPHA};
        pg8::gemm_phase<pg8::EpiF32, pg8::StaticOrder>(lds, pg8::Gemm{D, D, D}, S, E);
        SEAM(13);
    }
    if (IN(14)) { ln_rows(c, (const float*)(ws + WS_T2), p.in[I_LN2G], p.in[I_LN2B], (float*)(ws + WS_X2), (bf16_t*)(ws + WS_X2B)); SEAM(14); }
    if (IN(15)) { p15_router(p, c); SEAM(15); }

    if (IN(16)) {
        moe_table(c, tab);
        MoeOrder<true, 16> S{tab, (const char*)(ws + WS_X2B), (const char*)(ws + WS_W1), (const int*)(ws + WS_LIST), (size_t)4096 * D * 2, D, c.G, bx};
        pg8::EpiSwiglu E{p.in[I_B1], (bf16_t*)(ws + WS_H)};
        pg8::gemm_phase<pg8::EpiSwiglu, MoeOrder<true, 16>>(lds, pg8::Gemm{D, D, D}, S, E);
        SEAM(16);
    }
    if (IN(17)) {
        moe_table(c, tab);
        MoeOrder<false, 8> S{tab, (const char*)(ws + WS_H), (const char*)(ws + WS_W2), (const int*)(ws + WS_LIST), (size_t)D * DFF * 2, DFF, c.G, bx};
        pg8::EpiF32 E{(float*)(ws + WS_Y), D, p.in[I_B2], D, nullptr, 0.f};
        pg8::gemm_phase<pg8::EpiF32, MoeOrder<false, 8>>(lds, pg8::Gemm{DFF, DFF, DFF}, S, E);
        SEAM(17);
    }
    if (IN(18)) { moe_table(c, tab); p18_combine(p, c, tab); }
#undef IN
#undef SEAM
}

extern "C" void kernel_launch(void* const* d_in, const int* in_sizes, int n_in, void* d_out, int out_size, void* d_ws, size_t ws_size, hipStream_t stream) {
    static int grid = 0;
    if (grid == 0) {
        if (n_in != 32 || out_size != M * D || ws_size < WS_END) { fprintf(stderr, "kernel_launch: expected 32 inputs, %d outputs, >= %zu bytes of workspace; got %d, %d, %zu\n", M * D, (size_t)WS_END, n_in, out_size, ws_size); grid = -1; return; }
        int dev = 0, cus = 0, per_cu = 0;
        if (hipGetDevice(&dev) != hipSuccess || hipDeviceGetAttribute(&cus, hipDeviceAttributeMultiprocessorCount, dev) != hipSuccess) { grid = -1; return; }
        if (hipFuncSetAttribute((const void*)fwd, hipFuncAttributeMaxDynamicSharedMemorySize, LDS_BYTES) != hipSuccess) { fprintf(stderr, "kernel_launch: hipFuncSetAttribute failed\n"); grid = -1; return; }
        if (hipOccupancyMaxActiveBlocksPerMultiprocessor(&per_cu, (const void*)fwd, 512, LDS_BYTES) != hipSuccess || per_cu < 1) fprintf(stderr, "kernel_launch: occupancy query reports %d\n", per_cu);
        (void)hipGetLastError();
        grid = cus;
        if (grid != 256) fprintf(stderr, "kernel_launch: %d CUs; this kernel is built for 256\n", grid);
    }
    if (grid < 0) return;
    (void)hipMemsetAsync((char*)d_ws + WS_CTL, 0, CTL_ZERO_BYTES, stream);
    Params p{};
    for (int i = 0; i < 32; ++i) p.in[i] = (const float*)d_in[i];
    p.out = (float*)d_out; p.ws = (unsigned char*)d_ws;
    if (N_LAUNCH_MODE == 1) { p.ph_lo = 0; p.ph_hi = NPHASE; hipLaunchKernelGGL(fwd, dim3(grid), dim3(512), LDS_BYTES, stream, p); }
    else for (int k = 0; k < NPHASE; ++k) { p.ph_lo = k; p.ph_hi = k + 1; hipLaunchKernelGGL(fwd, dim3(grid), dim3(512), LDS_BYTES, stream, p); }
}
```

```cpp
#include <hip/hip_runtime.h>
#include <cstdio>
#include <cstdint>

#define LAS __attribute__((address_space(3)))
#define GAS __attribute__((address_space(1)))
typedef unsigned short bf16_t;
typedef short bf16x8 __attribute__((ext_vector_type(8)));
typedef float f32x4 __attribute__((ext_vector_type(4)));
typedef float f32x2 __attribute__((ext_vector_type(2)));
typedef float f32x16 __attribute__((ext_vector_type(16)));
typedef unsigned u32x4 __attribute__((ext_vector_type(4)));
typedef unsigned u32x2 __attribute__((ext_vector_type(2)));

#ifndef N_LAUNCH_MODE
#define N_LAUNCH_MODE 1
#endif

constexpr int M = 16384, D = 2048, SEQ = 4096, NBATCH = 4;
constexpr int RWC = 6592;
constexpr int PC = 15360;
constexpr int ATT0 = 6656, GATE0 = 11264;
constexpr int NEXP = 32, DFF = 2048, CAP = 16384;
constexpr int HROWS = 65536 + 32 * 256;
constexpr float LN_EPS = 1e-5f, GN_EPS = 64e-5f;
constexpr float DN_ALPHA = 1.189207115002721f;

__device__ __forceinline__ float bf2f(unsigned v) { return __uint_as_float(v << 16); }
__device__ __forceinline__ unsigned f2bf(float f) { unsigned u = __float_as_uint(f); return (u + 0x7fffu + ((u >> 16) & 1u)) >> 16; }
__device__ __forceinline__ unsigned pk2(float lo, float hi) { return f2bf(lo) | (f2bf(hi) << 16); }
__device__ __forceinline__ float sigmoidf_(float x) { return 1.0f / (1.0f + __expf(-x)); }
__device__ __forceinline__ float wave_sum(float v) {
#pragma unroll
    for (int o = 1; o < 64; o <<= 1) v += __shfl_xor(v, o);
    return v;
}
#define LDS_WAIT() asm volatile("s_waitcnt lgkmcnt(0)" ::: "memory")
#define VM_WAIT() asm volatile("s_waitcnt vmcnt(0)" ::: "memory")

namespace pg8 {
#define PG8_LAS __attribute__((address_space(3)))
constexpr int BM = 256, BK = 64, HALF = 128, HTB = HALF * BK * 2, STAGE_BYTES = 8 * HTB, NXCD = 8, WGM = 8;

__host__ __device__ __forceinline__ int lds_byte(int r, int c) { const int st = (r >> 4) * 2 + (c >> 5), rr = r & 15, cc = c & 31, ob = rr * 64 + cc * 2; return st * 1024 + (ob ^ (((ob >> 9) & 1) << 5)); }
__host__ __device__ __forceinline__ void stage_rc(int b, int& R, int& C) { const int st = b / 1024, sb = b % 1024, swz = sb ^ (((sb >> 9) & 1) << 5); R = (st >> 1) * 16 + swz / 64; C = (st & 1) * 32 + (swz % 64) / 2; }
__host__ __device__ __forceinline__ int perm32(int rho) { const int n = rho >> 4, i = rho & 15; return 8 * (i >> 2) + 4 * n + (i & 3); }

struct Unit { const char* A; const char* B; int orow, ocol, aux, aux2, valid; };
struct Gemm { int K, lda, ldb; };

struct StaticOrder {
    static constexpr bool GATHER = false;
    const char* A; const char* Bt; size_t ta, tb;
    int nM, nN, nwg, G, c;
    __device__ void init(const void* A_, const void* Bt_, int M_, int N_, int lda, int ldb, int G_, int c_) { A = (const char*)A_; Bt = (const char*)Bt_; ta = (size_t)BM * lda * 2; tb = (size_t)BM * ldb * 2; nM = M_ / BM; nN = N_ / BM; nwg = nM * nN; G = G_; c = c_; }
    __device__ bool next(int i, Unit& u) const {
        const long L = (long)i * G + c; if (c < 0 || L >= nwg) return false;
        int wgid = (int)L; { const int q = nwg / NXCD, r = nwg % NXCD, xcd = wgid % NXCD, off = wgid / NXCD; wgid = (xcd < r ? xcd * (q + 1) : r * (q + 1) + (xcd - r) * q) + off; }
        const int nig = WGM * nN, gid = wgid / nig, fm = gid * WGM, gsz = (nM - fm) < WGM ? (nM - fm) : WGM;
        const int pm = fm + ((wgid % nig) % gsz), pn = (wgid % nig) / gsz;
        u.A = A + (size_t)pm * ta; u.B = Bt + (size_t)pn * tb; u.orow = pm * BM; u.ocol = pn * BM; u.aux = 0; u.aux2 = 0; u.valid = BM; return true;
    }
    __device__ __forceinline__ const int* rows(const Unit&) const { return nullptr; }
};

__device__ __forceinline__ unsigned cvt_pk_bf16(float lo, float hi) { unsigned r; asm volatile("v_cvt_pk_bf16_f32 %0, %1, %2" : "=v"(r) : "v"(lo), "v"(hi)); return r; }

template <class Epi, class Sched, bool ALIGN_EPI = true>
__device__ __forceinline__ void gemm_phase(PG8_LAS unsigned char* lds, const Gemm g, const Sched& S, const Epi& E) {
    const int tid = threadIdx.x, wid = __builtin_amdgcn_readfirstlane(tid >> 6), lane = tid & 63, wr = wid >> 2, wc = wid & 3, fr = lane & 15, fq = lane >> 4;
    const int K = g.K, nt = K / BK;
    unsigned voffA[2], voffB[2]; int Rr[2], Cc[2];
#pragma unroll
    for (int i = 0; i < 2; ++i) { int R, C; stage_rc(tid * 16 + i * 8192, R, C); const int Rb = Epi::PERM ? ((R & ~31) + perm32(R & 31)) : R; Rr[i] = R; Cc[i] = C;
        voffA[i] = (unsigned)(R * g.lda + C) * 2u; voffB[i] = (unsigned)(Rb * g.ldb + C) * 2u; }
    const size_t kstep = (size_t)(BK * 2);
    const size_t hstepA = (size_t)HALF * g.lda * 2, hstepB = (size_t)HALF * g.ldb * 2;
    const unsigned ldsw = (unsigned)wid * 1024u;
    const int aoff = lds_byte(wr * 64 + fr, fq * 8), boff = lds_byte(wc * 32 + fr, fq * 8);
    unsigned vAc[2][2], vAn[2][2];
#define PG8_SA(b, h) (((b) * 2 + (h)) * HTB)
#define PG8_SB(b, h) ((4 + (b) * 2 + (h)) * HTB)
#define PG8_STAGE(bufoff, gbase, voff) do { _Pragma("unroll") for (int _i = 0; _i < 2; ++_i) \
        __builtin_amdgcn_global_load_lds((const unsigned*)((const char*)(gbase) + (voff)[_i]), (PG8_LAS unsigned*)(lds + (bufoff) + ldsw + _i * 8192), 16, 0, 0); } while (0)
#define PG8_STAGE_A(bufoff, kbase, h, nx) do { if constexpr (Sched::GATHER) { unsigned _v[2] = {(nx) ? vAn[h][0] : vAc[h][0], (nx) ? vAn[h][1] : vAc[h][1]}; PG8_STAGE(bufoff, kbase, _v); } \
        else { PG8_STAGE(bufoff, (kbase) + (h) * hstepA, voffA); } } while (0)
#define PG8_GOFF(u, v) do { const int* _rw = S.rows(u); _Pragma("unroll") for (int _h = 0; _h < 2; ++_h) _Pragma("unroll") for (int _i = 0; _i < 2; ++_i) { const int _r = Rr[_i] + _h * HALF; \
        const int _tk = _r < (u).valid ? _rw[_r] : 0; v[_h][_i] = (unsigned)(_tk * g.lda + Cc[_i]) * 2u; } } while (0)
#define PG8_LDA(dst, b, h) do { _Pragma("unroll") for (int m = 0; m < 4; ++m) _Pragma("unroll") for (int k = 0; k < 2; ++k) dst[m][k] = *(const PG8_LAS bf16x8*)(lds + PG8_SA(b, h) + aoff + m * 2048 + k * 1024); } while (0)
#define PG8_LDB(dst, b, h) do { _Pragma("unroll") for (int n = 0; n < 2; ++n) _Pragma("unroll") for (int k = 0; k < 2; ++k) dst[n][k] = *(const PG8_LAS bf16x8*)(lds + PG8_SB(b, h) + boff + n * 2048 + k * 1024); } while (0)
#define PG8_MMA(ai, bj, At, Bt) do { __builtin_amdgcn_s_setprio(1); _Pragma("unroll") for (int m = 0; m < 4; ++m) _Pragma("unroll") for (int n = 0; n < 2; ++n) _Pragma("unroll") for (int k = 0; k < 2; ++k) \
        acc[ai][bj][m][n] = __builtin_amdgcn_mfma_f32_16x16x32_bf16(Bt[n][k], At[m][k], acc[ai][bj][m][n], 0, 0, 0); __builtin_amdgcn_s_setprio(0); } while (0)
#define PG8_WAIT_V(n) asm volatile("s_waitcnt vmcnt(" #n ")" ::: "memory")
#define PG8_WAIT_L(n) asm volatile("s_waitcnt lgkmcnt(" #n ")" ::: "memory")
#define PG8_BAR __builtin_amdgcn_s_barrier()
#define PG8_SCHED __builtin_amdgcn_sched_barrier(0)
    Unit cur, nxt; int ui = 0;
    if (!S.next(0, cur)) return;
    f32x4 acc[2][2][4][2];
#pragma unroll
    for (int a = 0; a < 2; ++a)
#pragma unroll
        for (int b = 0; b < 2; ++b)
#pragma unroll
            for (int m = 0; m < 4; ++m)
#pragma unroll
                for (int n = 0; n < 2; ++n) acc[a][b][m][n] = (f32x4){0.f, 0.f, 0.f, 0.f};
    bf16x8 At[4][2], B0[2][2], B1[2][2];
    const char* cA = cur.A; const char* cB = cur.B;
    if constexpr (Sched::GATHER) { PG8_GOFF(cur, vAc); PG8_WAIT_V(0); }
    PG8_STAGE(PG8_SB(0, 0), cB, voffB); PG8_STAGE(PG8_SB(0, 1), cB + hstepB, voffB); PG8_STAGE_A(PG8_SA(0, 0), cA, 0, false); PG8_STAGE_A(PG8_SA(0, 1), cA, 1, false);
    if (wr == 1) PG8_BAR;
    PG8_WAIT_V(2); PG8_BAR;
    PG8_STAGE(PG8_SB(1, 0), cB + kstep, voffB); PG8_STAGE_A(PG8_SA(1, 0), cA + kstep, 0, false); PG8_STAGE(PG8_SB(1, 1), cB + hstepB + kstep, voffB);
    PG8_WAIT_V(6); PG8_BAR;
    for (;;) {
        const bool has_next = S.next(ui + 1, nxt);
        const char* nA = has_next ? nxt.A : cA; const char* nB = has_next ? nxt.B : cB;
        if constexpr (Sched::GATHER) { if (has_next) { PG8_GOFF(nxt, vAn); } else {
#pragma unroll
            for (int h = 0; h < 2; ++h)
#pragma unroll
                for (int i = 0; i < 2; ++i) vAn[h][i] = vAc[h][i]; } }
#pragma nounroll
        for (int t = 0; t < nt; t += 2) {
            const bool last = (t == nt - 2);
            const char* a1 = cA + (size_t)(t + 1) * kstep;
            const char* a2 = last ? nA : cA + (size_t)(t + 2) * kstep; const char* b2 = last ? nB : cB + (size_t)(t + 2) * kstep;
            const char* a3 = a2 + kstep; const char* b3 = b2 + kstep;
            PG8_LDB(B0, 0, 0); PG8_LDB(B1, 0, 1); PG8_SCHED; PG8_LDA(At, 0, 0); PG8_STAGE_A(PG8_SA(1, 1), a1, 1, false);
            PG8_WAIT_V(8); PG8_WAIT_L(0); PG8_BAR; PG8_MMA(0, 0, At, B0); PG8_MMA(0, 1, At, B1); PG8_BAR; PG8_SCHED;
            PG8_LDA(At, 0, 1); PG8_STAGE(PG8_SB(0, 0), b2, voffB); PG8_STAGE(PG8_SB(0, 1), b2 + hstepB, voffB); PG8_STAGE_A(PG8_SA(0, 0), a2, 0, last);
            PG8_WAIT_V(8); PG8_WAIT_L(0); PG8_BAR; PG8_MMA(1, 0, At, B0); PG8_MMA(1, 1, At, B1); PG8_BAR; PG8_SCHED;
            PG8_LDB(B0, 1, 0); PG8_LDB(B1, 1, 1); PG8_SCHED; PG8_LDA(At, 1, 0); PG8_STAGE_A(PG8_SA(0, 1), a2, 1, last);
            PG8_WAIT_V(8); PG8_WAIT_L(0); PG8_BAR; PG8_MMA(0, 0, At, B0); PG8_MMA(0, 1, At, B1); PG8_BAR; PG8_SCHED;
            PG8_LDA(At, 1, 1); PG8_STAGE(PG8_SB(1, 0), b3, voffB); PG8_STAGE(PG8_SB(1, 1), b3 + hstepB, voffB); PG8_STAGE_A(PG8_SA(1, 0), a3, 0, last);
            PG8_WAIT_V(8); PG8_WAIT_L(0); PG8_BAR; PG8_MMA(1, 0, At, B0); PG8_MMA(1, 1, At, B1); PG8_BAR; PG8_SCHED;
        }
        if constexpr (ALIGN_EPI) { if (wr == 0) PG8_BAR; }
        if constexpr (!Epi::AFTER_DRAIN) { E(acc, cur, wr, wc, fr, fq); }
        if (!has_next) break;
#pragma unroll
        for (int a = 0; a < 2; ++a)
#pragma unroll
            for (int b = 0; b < 2; ++b)
#pragma unroll
                for (int m = 0; m < 4; ++m)
#pragma unroll
                    for (int n = 0; n < 2; ++n) acc[a][b][m][n] = (f32x4){0.f, 0.f, 0.f, 0.f};
        cur = nxt; cA = nA; cB = nB; ++ui;
        if constexpr (Sched::GATHER) {
#pragma unroll
            for (int h = 0; h < 2; ++h)
#pragma unroll
                for (int i = 0; i < 2; ++i) vAc[h][i] = vAn[h][i]; }
        if constexpr (ALIGN_EPI) { if (wr == 1) PG8_BAR; }
    }
    PG8_WAIT_V(0);
    if constexpr (!ALIGN_EPI) { if (wr == 0) PG8_BAR; }
    PG8_BAR;
    if constexpr (Epi::AFTER_DRAIN) { E.fused(acc, cur, wr, wc, fr, fq, lds, wid, lane); }
#undef PG8_SA
#undef PG8_SB
#undef PG8_STAGE
#undef PG8_STAGE_A
#undef PG8_GOFF
#undef PG8_LDA
#undef PG8_LDB
#undef PG8_MMA
#undef PG8_WAIT_V
#undef PG8_WAIT_L
#undef PG8_BAR
#undef PG8_SCHED
}

#define EPI_LOOP_AI_M for (int ai = 0; ai < 2; ++ai) _Pragma("unroll") for (int m = 0; m < 4; ++m)

struct EpiF32 {
    static constexpr bool PERM = false, AFTER_DRAIN = false;
    float* C; int ldc; const float* bias; int bstride; const float* res; float alpha;
    __device__ __forceinline__ void operator()(const f32x4 (&acc)[2][2][4][2], const Unit& u, int wr, int wc, int fr, int fq) const {
        const int row0 = u.orow + wr * 64 + fr, col0 = u.ocol + wc * 32 + 4 * fq;
        f32x4 bv[2][2];
#pragma unroll
        for (int bj = 0; bj < 2; ++bj)
#pragma unroll
            for (int n = 0; n < 2; ++n) bv[bj][n] = bias ? *(const f32x4*)(bias + (size_t)u.aux * bstride + col0 + bj * HALF + n * 16) : (f32x4){0.f, 0.f, 0.f, 0.f};
#pragma unroll
        EPI_LOOP_AI_M { const size_t off = (size_t)(row0 + ai * HALF + m * 16) * ldc + col0;
#pragma unroll
            for (int bj = 0; bj < 2; ++bj)
#pragma unroll
                for (int n = 0; n < 2; ++n) { f32x4 v = acc[ai][bj][m][n] + bv[bj][n];
                    if (res) { const f32x4 rv = *(const f32x4*)(res + off + bj * HALF + n * 16); v = v + rv * alpha; }
                    *(f32x4*)(C + off + bj * HALF + n * 16) = v; }
            asm volatile("" ::: "memory"); }
    }
};
struct EpiBf16 {
    static constexpr bool PERM = true, AFTER_DRAIN = false;
    bf16_t* O; int ldc; float scale;
    __device__ __forceinline__ void operator()(const f32x4 (&acc)[2][2][4][2], const Unit& u, int wr, int wc, int fr, int fq) const {
        const int row0 = u.orow + wr * 64 + fr, col0 = u.ocol + wc * 32 + 8 * fq;
#pragma unroll
        EPI_LOOP_AI_M { bf16_t* rowp = O + (size_t)(row0 + ai * HALF + m * 16) * ldc + col0;
#pragma unroll
            for (int bj = 0; bj < 2; ++bj) { const f32x4 v0 = acc[ai][bj][m][0] * scale, v1 = acc[ai][bj][m][1] * scale;
                u32x4 w; w.x = cvt_pk_bf16(v0[0], v0[1]); w.y = cvt_pk_bf16(v0[2], v0[3]); w.z = cvt_pk_bf16(v1[0], v1[1]); w.w = cvt_pk_bf16(v1[2], v1[3]);
                *(u32x4*)(rowp + bj * HALF) = w; } }
    }
};
struct EpiKV {
    static constexpr bool PERM = true, AFTER_DRAIN = false;
    bf16_t* KB; bf16_t* VT;
    __device__ __forceinline__ void operator()(const f32x4 (&acc)[2][2][4][2], const Unit& u, int wr, int wc, int fr, int fq) const {
        const int row0 = u.orow + wr * 64 + fr, col0 = u.ocol + wc * 32 + 8 * fq;
#pragma unroll
        EPI_LOOP_AI_M { const int row = row0 + ai * HALF + m * 16;
#pragma unroll
            for (int bj = 0; bj < 2; ++bj) { const f32x4 v0 = acc[ai][bj][m][0], v1 = acc[ai][bj][m][1]; const int col = col0 + bj * HALF;
                if (u.ocol < 2048) { u32x4 w; w.x = cvt_pk_bf16(v0[0], v0[1]); w.y = cvt_pk_bf16(v0[2], v0[3]); w.z = cvt_pk_bf16(v1[0], v1[1]); w.w = cvt_pk_bf16(v1[2], v1[3]);
                    *(u32x4*)(KB + (size_t)row * 2048 + col) = w; }
                else { const int b = row >> 8, key = row & 255, c = col - 2048, h = c >> 9, d = c & 511; bf16_t* p = VT + ((size_t)((b * 4 + h) * 512 + d)) * 256 + key;
#pragma unroll
                    for (int j = 0; j < 4; ++j) { p[(size_t)j * 256] = (bf16_t)f2bf(v0[j]); p[(size_t)(4 + j) * 256] = (bf16_t)f2bf(v1[j]); } } } }
    }
};
struct EpiDecay {
    static constexpr bool PERM = false, AFTER_DRAIN = false;
    float* DEC; const float* w0;
    __device__ __forceinline__ void operator()(const f32x4 (&acc)[2][2][4][2], const Unit& u, int wr, int wc, int fr, int fq) const {
        const int row0 = u.orow + wr * 64 + fr, col0 = u.ocol + wc * 32 + 4 * fq;
        f32x4 bv[2][2];
#pragma unroll
        for (int bj = 0; bj < 2; ++bj)
#pragma unroll
            for (int n = 0; n < 2; ++n) bv[bj][n] = *(const f32x4*)(w0 + col0 + bj * HALF + n * 16);
#pragma unroll
        EPI_LOOP_AI_M { const size_t off = (size_t)(row0 + ai * HALF + m * 16) * D + col0;
#pragma unroll
            for (int bj = 0; bj < 2; ++bj)
#pragma unroll
                for (int n = 0; n < 2; ++n) { const f32x4 x = acc[ai][bj][m][n] + bv[bj][n]; f32x4 o;
#pragma unroll
                    for (int j = 0; j < 4; ++j) o[j] = __expf(-0.6065306597126334f * sigmoidf_(x[j]));
                    *(f32x4*)(DEC + off + bj * HALF + n * 16) = o; } }
    }
};
struct EpiIclr {
    static constexpr bool PERM = false, AFTER_DRAIN = false;
    const float* a0; const float* k_k; const float* k_a; const float* KZ; const float* KNORM; float* KP; float* AN; float* BB;
    __device__ __forceinline__ void operator()(const f32x4 (&acc)[2][2][4][2], const Unit& u, int wr, int wc, int fr, int fq) const {
        const int row0 = u.orow + wr * 64 + fr, col0 = u.ocol + wc * 32 + 4 * fq;
#pragma unroll
        for (int bj = 0; bj < 2; ++bj)
#pragma unroll
            for (int n = 0; n < 2; ++n) { const int col = col0 + bj * HALF + n * 16;
                const f32x4 a0v = *(const f32x4*)(a0 + col), kkv = *(const f32x4*)(k_k + col), kav = *(const f32x4*)(k_a + col);
#pragma unroll
                EPI_LOOP_AI_M { const int row = row0 + ai * HALF + m * 16; const size_t off = (size_t)row * D + col;
                    const f32x4 kz = *(const f32x4*)(KZ + off); const float nr = KNORM[(size_t)row * 32 + (col >> 6)]; const float inv = 1.0f / fmaxf(nr, 1e-12f);
                    const f32x4 x = acc[ai][bj][m][n] + a0v; f32x4 kp, an, bb;
#pragma unroll
                    for (int j = 0; j < 4; ++j) { const float a = sigmoidf_(x[j]); const float kk = kz[j] * kkv[j] * inv; kp[j] = kz[j] * (1.0f + (a - 1.0f) * kav[j]); bb[j] = kk * a; an[j] = -kk; }
                    *(f32x4*)(KP + off) = kp; *(f32x4*)(AN + off) = an; *(f32x4*)(BB + off) = bb; }
                asm volatile("" ::: "memory"); }
    }
};
struct EpiGateA {
    static constexpr bool PERM = false, AFTER_DRAIN = false;
    const bf16_t* PROJ; float* TMP;
    __device__ __forceinline__ void operator()(const f32x4 (&acc)[2][2][4][2], const Unit& u, int wr, int wc, int fr, int fq) const {
        const int row0 = u.orow + wr * 64 + fr, col0 = u.ocol + wc * 32 + 4 * fq;
#pragma unroll
        EPI_LOOP_AI_M { const int row = row0 + ai * HALF + m * 16;
#pragma unroll
            for (int bj = 0; bj < 2; ++bj)
#pragma unroll
                for (int n = 0; n < 2; ++n) { const int col = col0 + bj * HALF + n * 16; const u32x2 gv = *(const u32x2*)(PROJ + (size_t)row * PC + GATE0 + col);
                    const f32x4 a = acc[ai][bj][m][n]; f32x4 o;
                    o[0] = a[0] * sigmoidf_(bf2f(gv.x & 0xffffu)); o[1] = a[1] * sigmoidf_(bf2f(gv.x >> 16)); o[2] = a[2] * sigmoidf_(bf2f(gv.y & 0xffffu)); o[3] = a[3] * sigmoidf_(bf2f(gv.y >> 16));
                    *(f32x4*)(TMP + (size_t)row * D + col) = o; } }
    }
};
struct EpiGateB {
    static constexpr bool PERM = true, AFTER_DRAIN = false;
    const bf16_t* PROJ; const float* TMP; bf16_t* MERGED;
    __device__ __forceinline__ void operator()(const f32x4 (&acc)[2][2][4][2], const Unit& u, int wr, int wc, int fr, int fq) const {
        const int row0 = u.orow + wr * 64 + fr, col0 = u.ocol + wc * 32 + 8 * fq;
#pragma unroll
        EPI_LOOP_AI_M { const int row = row0 + ai * HALF + m * 16;
#pragma unroll
            for (int bj = 0; bj < 2; ++bj) { const int col = col0 + bj * HALF; const u32x4 gv = *(const u32x4*)(PROJ + (size_t)row * PC + GATE0 + 2048 + col);
                const f32x4 t0 = *(const f32x4*)(TMP + (size_t)row * D + col), t1 = *(const f32x4*)(TMP + (size_t)row * D + col + 4);
                const f32x4 a0 = acc[ai][bj][m][0], a1 = acc[ai][bj][m][1]; f32x4 o0, o1;
                o0[0] = t0[0] + a0[0] * sigmoidf_(bf2f(gv.x & 0xffffu)); o0[1] = t0[1] + a0[1] * sigmoidf_(bf2f(gv.x >> 16)); o0[2] = t0[2] + a0[2] * sigmoidf_(bf2f(gv.y & 0xffffu)); o0[3] = t0[3] + a0[3] * sigmoidf_(bf2f(gv.y >> 16));
                o1[0] = t1[0] + a1[0] * sigmoidf_(bf2f(gv.z & 0xffffu)); o1[1] = t1[1] + a1[1] * sigmoidf_(bf2f(gv.z >> 16)); o1[2] = t1[2] + a1[2] * sigmoidf_(bf2f(gv.w & 0xffffu)); o1[3] = t1[3] + a1[3] * sigmoidf_(bf2f(gv.w >> 16));
                u32x4 w; w.x = cvt_pk_bf16(o0[0], o0[1]); w.y = cvt_pk_bf16(o0[2], o0[3]); w.z = cvt_pk_bf16(o1[0], o1[1]); w.w = cvt_pk_bf16(o1[2], o1[3]);
                *(u32x4*)(MERGED + (size_t)row * D + col) = w; }
            asm volatile("" ::: "memory"); }
    }
};
struct EpiSwiglu {
    static constexpr bool PERM = true, AFTER_DRAIN = false;
    const float* b1; bf16_t* H;
    __device__ __forceinline__ float sw(float g, float l) const { g = fminf(g, 7.0f); l = fminf(fmaxf(l, -7.0f), 7.0f); return g * sigmoidf_(1.702f * g) * (l + 1.0f); }
    __device__ __forceinline__ void operator()(const f32x4 (&acc)[2][2][4][2], const Unit& u, int wr, int wc, int fr, int fq) const {
        const int row0 = u.orow + wr * 64 + fr, col0 = u.ocol + wc * 32 + 8 * fq;
        f32x4 bv[2][2];
#pragma unroll
        for (int bj = 0; bj < 2; ++bj)
#pragma unroll
            for (int n = 0; n < 2; ++n) bv[bj][n] = *(const f32x4*)(b1 + (size_t)u.aux * 4096 + col0 + bj * HALF + 4 * n);
#pragma unroll
        EPI_LOOP_AI_M { const int row = row0 + ai * HALF + m * 16;
#pragma unroll
            for (int bj = 0; bj < 2; ++bj) { const f32x4 v0 = acc[ai][bj][m][0] + bv[bj][0], v1 = acc[ai][bj][m][1] + bv[bj][1];
                u32x2 w; w.x = cvt_pk_bf16(sw(v0[0], v0[1]), sw(v0[2], v0[3])); w.y = cvt_pk_bf16(sw(v1[0], v1[1]), sw(v1[2], v1[3]));
                *(u32x2*)(H + (size_t)row * DFF + ((col0 + bj * HALF) >> 1)) = w; } }
    }
};
struct EpiSoftmax {
    static constexpr bool PERM = true, AFTER_DRAIN = true;
    bf16_t* PP;
    __device__ __forceinline__ void fused(f32x4 (&acc)[2][2][4][2], const Unit& u, int wr, int wc, int fr, int fq, PG8_LAS unsigned char* lds, int wid, int lane) const {
        PG8_LAS float* P1 = (PG8_LAS float*)lds;
        PG8_LAS float* P2 = (PG8_LAS float*)(lds + 4096);
        float mx[2][4];
#pragma unroll
        EPI_LOOP_AI_M { float v = -3.0e38f;
#pragma unroll
            for (int bj = 0; bj < 2; ++bj)
#pragma unroll
                for (int n = 0; n < 2; ++n) { const f32x4 x = acc[ai][bj][m][n]; v = fmaxf(v, fmaxf(fmaxf(x[0], x[1]), fmaxf(x[2], x[3]))); }
            v = fmaxf(v, __shfl_xor(v, 16)); v = fmaxf(v, __shfl_xor(v, 32));
            if (fq == 0) P1[(ai * HALF + wr * 64 + m * 16 + fr) * 4 + wc] = v; }
        asm volatile("s_waitcnt lgkmcnt(0)" ::: "memory"); __builtin_amdgcn_s_barrier(); asm volatile("" ::: "memory");
#pragma unroll
        EPI_LOOP_AI_M { const f32x4 t = *(const PG8_LAS f32x4*)(P1 + (ai * HALF + wr * 64 + m * 16 + fr) * 4); mx[ai][m] = fmaxf(fmaxf(t[0], t[1]), fmaxf(t[2], t[3])); }
#pragma unroll
        EPI_LOOP_AI_M { float s = 0.f;
#pragma unroll
            for (int bj = 0; bj < 2; ++bj)
#pragma unroll
                for (int n = 0; n < 2; ++n) { f32x4 x = acc[ai][bj][m][n];
#pragma unroll
                    for (int j = 0; j < 4; ++j) { x[j] = __expf(x[j] - mx[ai][m]); s += x[j]; }
                    acc[ai][bj][m][n] = x; }
            s += __shfl_xor(s, 16); s += __shfl_xor(s, 32);
            if (fq == 0) P2[(ai * HALF + wr * 64 + m * 16 + fr) * 4 + wc] = s; }
        asm volatile("s_waitcnt lgkmcnt(0)" ::: "memory"); __builtin_amdgcn_s_barrier(); asm volatile("" ::: "memory");
        const int row0 = u.orow + wr * 64 + fr, col0 = wc * 32 + 8 * fq;
#pragma unroll
        EPI_LOOP_AI_M { const f32x4 t = *(const PG8_LAS f32x4*)(P2 + (ai * HALF + wr * 64 + m * 16 + fr) * 4); const float inv = 1.0f / ((t[0] + t[1]) + (t[2] + t[3]));
            bf16_t* rowp = PP + (size_t)(row0 + ai * HALF + m * 16) * 256 + col0;
#pragma unroll
            for (int bj = 0; bj < 2; ++bj) { const f32x4 v0 = acc[ai][bj][m][0] * inv, v1 = acc[ai][bj][m][1] * inv;
                u32x4 w; w.x = cvt_pk_bf16(v0[0], v0[1]); w.y = cvt_pk_bf16(v0[2], v0[3]); w.z = cvt_pk_bf16(v1[0], v1[1]); w.w = cvt_pk_bf16(v1[2], v1[3]);
                *(u32x4*)(rowp + bj * HALF) = w; } }
        asm volatile("s_waitcnt lgkmcnt(0)" ::: "memory"); __builtin_amdgcn_s_barrier(); asm volatile("" ::: "memory");
    }
};
}

constexpr size_t MiB = 1u << 20;
constexpr size_t al256(size_t x) { return (x + 255) & ~(size_t)255; }
constexpr size_t WS_CTL = 0, CTL_ZERO_BYTES = 1 * MiB;
constexpr size_t WS_WIN = 1 * MiB;
constexpr size_t WS_WUP = WS_WIN + (size_t)PC * D * 2;
constexpr size_t WS_AUP = WS_WUP + (size_t)D * 256 * 2;
constexpr size_t WS_GUP = WS_AUP + (size_t)D * 256 * 2;
constexpr size_t WS_PA = WS_GUP + (size_t)D * 256 * 2;
constexpr size_t WS_PB = WS_PA + (size_t)D * D * 2;
constexpr size_t WS_WOUT = WS_PB + (size_t)D * 512 * 2;
constexpr size_t WS_WQ = WS_WOUT + (size_t)D * D * 2;
constexpr size_t WS_WKV = WS_WQ + (size_t)D * D * 2;
constexpr size_t WS_WO = WS_WKV + (size_t)2 * D * D * 2;
constexpr size_t WS_W1 = WS_WO + (size_t)D * D * 2;
constexpr size_t WS_W2 = WS_W1 + (size_t)NEXP * 4096 * D * 2;
constexpr size_t WS_XB = WS_W2 + (size_t)NEXP * D * DFF * 2;
constexpr size_t WS_MEMB = WS_XB + (size_t)M * D * 2;
constexpr size_t WS_ROT = WS_MEMB + (size_t)1024 * D * 2;
constexpr size_t WS_KB = WS_ROT + (size_t)2 * SEQ * 32 * 4;
constexpr size_t WS_VT = WS_KB + (size_t)1024 * D * 2;
constexpr size_t WS_YA = WS_VT + (size_t)1024 * D * 2;
constexpr size_t WS_YB = WS_YA + (size_t)M * D * 2;
constexpr size_t WS_TMP = WS_YB + (size_t)M * 512 * 2;
constexpr size_t WS_MERGED = WS_TMP + (size_t)M * D * 4;
constexpr size_t WS_E = WS_MERGED + (size_t)M * D * 2;
constexpr size_t WS_PROJ = WS_E;
constexpr size_t WS_RZ = WS_PROJ + (size_t)M * PC * 2;
constexpr size_t WS_KZ = WS_RZ + (size_t)M * D * 4;
constexpr size_t WS_VZ = WS_KZ + (size_t)M * D * 4;
constexpr size_t WS_DEC = WS_VZ + (size_t)M * D * 4;
constexpr size_t WS_KP = WS_DEC + (size_t)M * D * 4;
constexpr size_t WS_AN = WS_KP + (size_t)M * D * 4;
constexpr size_t WS_BB = WS_AN + (size_t)M * D * 4;
constexpr size_t WS_GG = WS_BB + (size_t)M * D * 4;
constexpr size_t WS_YS = WS_GG + (size_t)M * D * 4;
constexpr size_t WS_AO = WS_YS + (size_t)M * D * 4;
constexpr size_t WS_LSE = WS_AO + (size_t)3 * M * 512 * 4;
constexpr size_t WS_QR = WS_LSE + (size_t)3 * M * 8 * 4;
constexpr size_t WS_KR = WS_QR + (size_t)M * 1536 * 2;
constexpr size_t WS_LIN = WS_KR + (size_t)M * 1536 * 2;
constexpr size_t WS_KNORM = WS_LIN + (size_t)M * 768 * 2;
constexpr size_t WS_E_END = WS_KNORM + (size_t)M * 32 * 4;
constexpr size_t WS_T1 = WS_E;
constexpr size_t WS_X1 = WS_T1 + (size_t)M * D * 4;
constexpr size_t WS_X1B = WS_X1 + (size_t)M * D * 4;
constexpr size_t WS_Q = WS_X1B + (size_t)M * D * 2;
constexpr size_t WS_PP = WS_Q + (size_t)M * D * 2;
constexpr size_t WS_OC = WS_PP + (size_t)16 * SEQ * 256 * 2;
constexpr size_t WS_T2 = WS_OC + (size_t)M * D * 2;
constexpr size_t WS_X2 = WS_T2 + (size_t)M * D * 4;
constexpr size_t WS_X2B = WS_X2 + (size_t)M * D * 4;
constexpr size_t WS_LIST = WS_X2B + (size_t)M * D * 2;
constexpr size_t WS_ROWI = WS_LIST + (size_t)NEXP * CAP * 4;
constexpr size_t WS_TOPW = WS_ROWI + (size_t)M * 4 * 4;
constexpr size_t WS_H = WS_TOPW + (size_t)M * 4 * 4;
constexpr size_t WS_Y = WS_H + (size_t)HROWS * DFF * 2;
constexpr size_t WS_L_END = WS_Y + (size_t)HROWS * D * 4;
constexpr size_t WS_END = (WS_E_END > WS_L_END ? WS_E_END : WS_L_END);
constexpr int CW_TMO = 0, CW_CNT = 64  , CW_Q = 128  , CW_BAR = 4096;

constexpr int RING_BYTES = 131072, MISC_OFF = RING_BYTES, LDS_BYTES = 147456;

#define XB_TMO      128
#define XB_XCNT(j)  (256  + 64 * (j))
#define XB_XSUB(j)  (1280 + 64 * (j))
#define XB_XGEN(j)  (2304 + 64 * (j))
#define XB_TOP      3328
#define XB_TOPGEN   3392
#define XCD_BAR_WORDS 3456
#define XB_SPIN_CAP (1u << 18)
__device__ __forceinline__ unsigned xb_ld(unsigned* p)              { return __hip_atomic_load(p, __ATOMIC_RELAXED, __HIP_MEMORY_SCOPE_AGENT); }
__device__ __forceinline__ unsigned xb_add(unsigned* p, unsigned v) { return __hip_atomic_fetch_add(p, v, __ATOMIC_RELAXED, __HIP_MEMORY_SCOPE_AGENT); }
__device__ __forceinline__ unsigned xb_xcc_id() { return (unsigned)__builtin_amdgcn_s_getreg((3 << 11) | 20) & 0xFu; }
#define XB_SPIN(cond, bar) do { unsigned _sp = 0; while (cond) { __builtin_amdgcn_s_sleep(1); \
    if ((++_sp & 255u) == 0u) { if (xb_ld(&(bar)[XB_TMO])) break; if (_sp > XB_SPIN_CAP) { atomicAdd(&(bar)[XB_TMO], 1u); break; } } } } while (0)
struct XcdBarrier { unsigned* bar; unsigned x; volatile LAS unsigned* st; };
__device__ __forceinline__ XcdBarrier xcd_barrier_post(unsigned* bar, volatile LAS unsigned* st) {
    XcdBarrier b; b.bar = bar; b.x = xb_xcc_id(); b.st = st;
    if (threadIdx.x == 0) (void)xb_add(&bar[XB_XCNT(b.x)], 1u);
    return b;
}
__device__ __forceinline__ void xcd_barrier_complete(unsigned* bar, unsigned x, unsigned& nloc, unsigned& nx) {
    const unsigned G = gridDim.x * gridDim.y * gridDim.z;
    unsigned sum, cnt, mine, sp = 0u;
    for (;;) {
        sum = 0u; cnt = 0u; mine = 0u;
#pragma unroll
        for (unsigned j = 0; j < 16; ++j) { const unsigned c = xb_ld(&bar[XB_XCNT(j)]); sum += c; cnt += (c > 0u) ? 1u : 0u; mine = (j == x) ? c : mine; }
        if (sum == G) break;
        __builtin_amdgcn_s_sleep(1);
        if ((++sp & 255u) == 0u) { if (xb_ld(&bar[XB_TMO])) break; if (sp > XB_SPIN_CAP) { atomicAdd(&bar[XB_TMO], 1u); break; } }
    }
    nloc = mine > 0u ? mine : 1u; nx = cnt > 0u ? cnt : 1u;
}
__device__ __forceinline__ void xcd_barrier(const XcdBarrier& b) {
    asm volatile("s_waitcnt vmcnt(0)" ::: "memory");
    __syncthreads();
    if (threadIdx.x == 0) {
        unsigned* bar = b.bar;
        __builtin_amdgcn_s_waitcnt(0);
        unsigned nloc = b.st[0], nx = b.st[1];
        if (nloc == 0u) { xcd_barrier_complete(bar, b.x, nloc, nx); b.st[0] = nloc; b.st[1] = nx; }
        const unsigned old = xb_add(&bar[XB_XSUB(b.x)], 1u);
        const unsigned gen = old / nloc;
        if (old + 1u == (gen + 1u) * nloc) {
            __builtin_amdgcn_fence(__ATOMIC_RELEASE, "agent");
            asm volatile("s_waitcnt vmcnt(0)" ::: "memory");
            const unsigned og = xb_add(&bar[XB_TOP], 1u);
            const unsigned tg = og / nx;
            if (og + 1u == (tg + 1u) * nx) xb_add(&bar[XB_TOPGEN], 1u);
            else XB_SPIN(xb_ld(&bar[XB_TOPGEN]) == tg, bar);
            __builtin_amdgcn_fence(__ATOMIC_ACQUIRE, "agent");
            xb_add(&bar[XB_XGEN(b.x)], 1u);
            asm volatile("s_waitcnt vmcnt(0)" ::: "memory");
        } else {
            XB_SPIN(xb_ld(&bar[XB_XGEN(b.x)]) == gen, bar);
            __builtin_amdgcn_fence(__ATOMIC_ACQUIRE, "agent");
            asm volatile("s_waitcnt vmcnt(0)" ::: "memory");
        }
    }
    __syncthreads();
}

struct Params {
    const float* in[32];
    float* out; unsigned char* ws;
    int ph_lo, ph_hi, li, pad;
};
enum { I_X = 0, I_MEM, I_WIN, I_MIX, I_W0, I_WUP, I_A0, I_AUP, I_GUP, I_KK, I_KA, I_RK, I_LNXG, I_LNXB, I_PA, I_PB, I_WOUT, I_LN1G, I_LN1B, I_WQ, I_WKV, I_WO, I_LN2G, I_LN2B,
       I_RW, I_RB, I_W1, I_B1, I_W2, I_B2, I_LN3G, I_LN3B };

struct ScoreOrder {
    static constexpr bool GATHER = false;
    const char* Q; const char* KB; int G, c;
    __device__ bool next(int i, pg8::Unit& u) const {
        const int L = i * G + c; if (L >= 256) return false;
        const int bh = L >> 4, pm = L & 15, b = bh >> 2, h = bh & 3;
        u.A = Q + ((size_t)(b * SEQ + 256 * pm) * D + h * 512) * 2; u.B = KB + ((size_t)(b * 256) * D + h * 512) * 2;
        u.orow = bh * SEQ + 256 * pm; u.ocol = 0; u.aux = 0; u.aux2 = 0; u.valid = 256; return true;
    }
    __device__ __forceinline__ const int* rows(const pg8::Unit&) const { return nullptr; }
};
struct PvOrder {
    static constexpr bool GATHER = false;
    const char* PP; const char* VT; int G, c;
    __device__ bool next(int i, pg8::Unit& u) const {
        const int L = i * G + c; if (L >= 512) return false;
        const int bh = L >> 5, pm = (L >> 1) & 15, pn = L & 1, b = bh >> 2, h = bh & 3;
        u.A = PP + ((size_t)(bh * SEQ + 256 * pm) * 256) * 2; u.B = VT + ((size_t)(bh * 512 + 256 * pn) * 256) * 2;
        u.orow = b * SEQ + 256 * pm; u.ocol = h * 512 + 256 * pn; u.aux = 0; u.aux2 = 0; u.valid = 256; return true;
    }
    __device__ __forceinline__ const int* rows(const pg8::Unit&) const { return nullptr; }
};
template <bool GATHER_, int NT  > struct MoeOrder {
    static constexpr bool GATHER = GATHER_;
    const LAS int* tab; const char* A; const char* W; const int* list; size_t wexp  ; int ldb; int G, c;
    __device__ bool next(int i, pg8::Unit& u) const {
        constexpr int RPR = 256 / NT;
        const int rt = i * RPR + (c % RPR), pn = c / RPR, T = tab[64];
        if (c >= 256 || rt >= T) return false;
        int e = 0;
        for (int j = 1; j < NEXP; ++j) e = (rt >= tab[32 + j]) ? j : e;
        const int lt = rt - tab[32 + e];
        u.aux = e; u.aux2 = lt; u.valid = min(256, tab[e] - 256 * lt); u.orow = 256 * rt; u.ocol = 256 * pn;
        u.B = W + (size_t)e * wexp + (size_t)(256 * pn) * ldb * 2;
        u.A = GATHER_ ? A : A + (size_t)(256 * rt) * DFF * 2;
        return true;
    }
    __device__ __forceinline__ const int* rows(const pg8::Unit& u) const { return list + (size_t)u.aux * CAP + 256 * u.aux2; }
};

struct Ctx { int tid, lane, wave, vcu, G; LAS unsigned char* lds; unsigned char* ws; };

__device__ __forceinline__ void tr_item(const float* W, int ldw, int Ksrc, int sc0, bf16_t* WT, int ldt, int n0, int k0, LAS float* scr, int lane) {
#pragma unroll 8
    for (int i = 0; i < 32; ++i) { const int kk = 2 * i + (lane >> 5); float v = 0.f; if (sc0 >= 0 && (k0 + kk) < Ksrc) v = W[(size_t)(k0 + kk) * ldw + sc0 + (lane & 31)]; scr[kk * 33 + (lane & 31)] = v; }
    LDS_WAIT(); asm volatile("" ::: "memory");
    const int c = lane & 7;
#pragma unroll
    for (int j = 0; j < 4; ++j) { const int n = (lane >> 3) + 8 * j; const LAS float* s = scr + (8 * c) * 33 + n;
        u32x4 o; o.x = pk2(s[0 * 33], s[1 * 33]); o.y = pk2(s[2 * 33], s[3 * 33]); o.z = pk2(s[4 * 33], s[5 * 33]); o.w = pk2(s[6 * 33], s[7 * 33]);
        *(u32x4*)(WT + (size_t)(n0 + n) * ldt + k0 + 8 * c) = o; }
    LDS_WAIT(); asm volatile("" ::: "memory");
}
__device__ __forceinline__ void tr_job(const float* W, int N, int Ksrc, int Kdst, bf16_t* WT, int item, LAS float* scr, int lane) {
    const int nblk = N / 32, kb = item / nblk, nb = item % nblk;
    tr_item(W, N, Ksrc, 32 * nb, WT, Kdst, 32 * nb, 64 * kb, scr, lane);
}
__device__ __forceinline__ void p0_prologue(const Params& p, const Ctx& c) {
    LAS float* scr = (LAS float*)(c.lds + c.wave * 16384);
    const int gw = c.vcu * 8 + c.wave, NGW = c.G * 8;
    unsigned char* ws = c.ws;
    constexpr int I_WINJ = 32 * 480, I_LORA = 4 * 64, I_SQ = 32 * 64, I_PBJ = 8 * 64, I_KVJ = 32 * 128, I_W1E = 32 * 128, I_W2E = 32 * 64;
    constexpr int NITEMS = I_WINJ + 3 * I_LORA + 4 * I_SQ + I_PBJ + I_KVJ;
    for (int it = gw; it < NITEMS; it += NGW) {
        int r = it;
        if (r < I_WINJ) { const int kb = r / 480, nb = r % 480; const int sc0 = nb < 206 ? 32 * nb : (nb < 208 ? -1 : 32 * nb - 64);
            tr_item(p.in[I_WIN], 15296, D, sc0, (bf16_t*)(ws + WS_WIN), D, 32 * nb, 64 * kb, scr, c.lane); continue; } r -= I_WINJ;
        if (r < I_LORA) { tr_job(p.in[I_WUP], D, 96, 256, (bf16_t*)(ws + WS_WUP), r, scr, c.lane); continue; } r -= I_LORA;
        if (r < I_LORA) { tr_job(p.in[I_AUP], D, 96, 256, (bf16_t*)(ws + WS_AUP), r, scr, c.lane); continue; } r -= I_LORA;
        if (r < I_LORA) { tr_job(p.in[I_GUP], D, 256, 256, (bf16_t*)(ws + WS_GUP), r, scr, c.lane); continue; } r -= I_LORA;
        if (r < I_SQ) { tr_job(p.in[I_PA], D, D, D, (bf16_t*)(ws + WS_PA), r, scr, c.lane); continue; } r -= I_SQ;
        if (r < I_PBJ) { tr_job(p.in[I_PB], D, 512, 512, (bf16_t*)(ws + WS_PB), r, scr, c.lane); continue; } r -= I_PBJ;
        if (r < I_SQ) { tr_job(p.in[I_WOUT], D, D, D, (bf16_t*)(ws + WS_WOUT), r, scr, c.lane); continue; } r -= I_SQ;
        if (r < I_SQ) { tr_job(p.in[I_WQ], D, D, D, (bf16_t*)(ws + WS_WQ), r, scr, c.lane); continue; } r -= I_SQ;
        if (r < I_KVJ) { tr_job(p.in[I_WKV], 2 * D, D, D, (bf16_t*)(ws + WS_WKV), r, scr, c.lane); continue; } r -= I_KVJ;
        { tr_job(p.in[I_WO], D, D, D, (bf16_t*)(ws + WS_WO), r, scr, c.lane); }
    }
    const size_t gt = (size_t)c.vcu * 512 + c.tid, NT = (size_t)c.G * 512;
    for (size_t i = gt; i < (size_t)M * D / 8; i += NT) { const f32x4 a = ((const f32x4*)p.in[I_X])[2 * i], b = ((const f32x4*)p.in[I_X])[2 * i + 1];
        u32x4 o; o.x = pk2(a[0], a[1]); o.y = pk2(a[2], a[3]); o.z = pk2(b[0], b[1]); o.w = pk2(b[2], b[3]); ((u32x4*)(ws + WS_XB))[i] = o; }
    for (size_t i = gt; i < (size_t)1024 * D / 8; i += NT) { const f32x4 a = ((const f32x4*)p.in[I_MEM])[2 * i], b = ((const f32x4*)p.in[I_MEM])[2 * i + 1];
        u32x4 o; o.x = pk2(a[0], a[1]); o.y = pk2(a[2], a[3]); o.z = pk2(b[0], b[1]); o.w = pk2(b[2], b[3]); ((u32x4*)(ws + WS_MEMB))[i] = o; }
    float* rc = (float*)(ws + WS_ROT); float* rs = rc + SEQ * 32;
    for (size_t i = gt; i < (size_t)SEQ * 32; i += NT) { const int pos = (int)(i >> 5), j = (int)(i & 31);
        const double inv = exp(-(double)j * (9.210340371976184 / 32.0)); const double ang = (double)pos * inv; rc[i] = (float)cos(ang); rs[i] = (float)sin(ang); }
}

constexpr int MOE_W1E = 32 * 128, MOE_W2E = 32 * 64, MOE_CONV_GROUPS = (NEXP * MOE_W1E + NEXP * MOE_W2E) / 8;
__device__ __forceinline__ void conv_group(const Params& p, const Ctx& c, int gi) {
    LAS float* scr = (LAS float*)(c.lds + c.wave * 16384);
    unsigned char* ws = c.ws;
    int r = gi * 8 + c.wave;
    if (r < NEXP * MOE_W1E) { const int e = r / MOE_W1E; tr_job(p.in[I_W1] + (size_t)e * D * 4096, 4096, D, D, (bf16_t*)(ws + WS_W1) + (size_t)e * 4096 * D, r % MOE_W1E, scr, c.lane); }
    else { r -= NEXP * MOE_W1E; const int e = r / MOE_W2E; tr_job(p.in[I_W2] + (size_t)e * DFF * D, D, DFF, DFF, (bf16_t*)(ws + WS_W2) + (size_t)e * D * DFF, r % MOE_W2E, scr, c.lane); }
}

__device__ __forceinline__ void p2_prep(const Params& p, const Ctx& c) {
    unsigned char* ws = c.ws;
    const bf16_t* PROJ = (const bf16_t*)(ws + WS_PROJ);
    const float* mix = p.in[I_MIX]; const float* k_k = p.in[I_KK];
    float* RZ = (float*)(ws + WS_RZ); float* KZ = (float*)(ws + WS_KZ); float* VZ = (float*)(ws + WS_VZ);
    bf16_t* LIN = (bf16_t*)(ws + WS_LIN); float* KNORM = (float*)(ws + WS_KNORM);
    bf16_t* QR = (bf16_t*)(ws + WS_QR); bf16_t* KR = (bf16_t*)(ws + WS_KR);
    const float* rc = (const float*)(ws + WS_ROT); const float* rs = rc + SEQ * 32;
    for (int t = c.vcu; t < M; t += c.G) {
        const int pos = t & (SEQ - 1);
        const bf16_t* cur = PROJ + (size_t)t * PC;
        for (int ch = c.tid; ch < 824; ch += 512) {
            const u32x4 cv = *(const u32x4*)(cur + 8 * ch); u32x4 pv = (u32x4){0u, 0u, 0u, 0u}; if (pos > 0) pv = *(const u32x4*)(cur - PC + 8 * ch);
            const f32x4 m0 = *(const f32x4*)(mix + 8 * ch), m1 = *(const f32x4*)(mix + 8 * ch + 4);
            float z[8];
            { const unsigned cw[4] = {cv.x, cv.y, cv.z, cv.w}, pw[4] = {pv.x, pv.y, pv.z, pv.w};
              const float mm[8] = {m0[0], m0[1], m0[2], m0[3], m1[0], m1[1], m1[2], m1[3]};
#pragma unroll
              for (int j = 0; j < 4; ++j) { const float c0 = bf2f(cw[j] & 0xffffu), c1 = bf2f(cw[j] >> 16), q0 = bf2f(pw[j] & 0xffffu), q1 = bf2f(pw[j] >> 16);
                  z[2 * j] = c0 + (q0 - c0) * mm[2 * j]; z[2 * j + 1] = c1 + (q1 - c1) * mm[2 * j + 1]; } }
            if (ch < 768) {
                float* dst = (ch < 256 ? RZ : (ch < 512 ? KZ : VZ)) + (size_t)t * D + 8 * (ch & 255);
                *(f32x4*)dst = (f32x4){z[0], z[1], z[2], z[3]}; *(f32x4*)(dst + 4) = (f32x4){z[4], z[5], z[6], z[7]};
                if (ch >= 256 && ch < 512) {
                    const int col = 8 * (ch - 256); const f32x4 k0 = *(const f32x4*)(k_k + col), k1 = *(const f32x4*)(k_k + col + 4);
                    float s = 0.f;
#pragma unroll
                    for (int j = 0; j < 4; ++j) { const float a = z[j] * k0[j], b = z[4 + j] * k1[j]; s += a * a + b * b; }
                    s += __shfl_xor(s, 1); s += __shfl_xor(s, 2); s += __shfl_xor(s, 4);
                    if ((ch & 7) == 0) KNORM[(size_t)t * 32 + ((ch - 256) >> 3)] = sqrtf(s);
                }
            } else {
                float o[8]; int dcol;
                if (ch < 780) { dcol = 8 * (ch - 768);
#pragma unroll
                    for (int j = 0; j < 8; ++j) o[j] = tanhf(z[j]); }
                else if (ch < 792) { dcol = 256 + 8 * (ch - 780);
#pragma unroll
                    for (int j = 0; j < 8; ++j) o[j] = z[j]; }
                else { dcol = 512 + 8 * (ch - 792);
#pragma unroll
                    for (int j = 0; j < 8; ++j) o[j] = sigmoidf_(z[j]); }
                u32x4 w; w.x = pk2(o[0], o[1]); w.y = pk2(o[2], o[3]); w.z = pk2(o[4], o[5]); w.w = pk2(o[6], o[7]);
                *(u32x4*)(LIN + (size_t)t * 768 + dcol) = w;
            }
        }
        if (c.tid < 40) { const int dcol = (c.tid < 20) ? 96 + 8 * c.tid : 352 + 8 * (c.tid - 20); *(u32x4*)(LIN + (size_t)t * 768 + dcol) = (u32x4){0u, 0u, 0u, 0u}; }
        if (c.tid >= 64 && c.tid < 64 + 192) { const int w = c.tid - 64, which = w / 96, hh = (w % 96) >> 2, e0 = (w & 3) * 8;
            const bf16_t* src = cur + ATT0 + which * 1536 + hh * 64 + e0;
            const u32x4 a = *(const u32x4*)src, b = *(const u32x4*)(src + 32);
            const f32x4 c0 = *(const f32x4*)(rc + pos * 32 + e0), c1 = *(const f32x4*)(rc + pos * 32 + e0 + 4), s0 = *(const f32x4*)(rs + pos * 32 + e0), s1 = *(const f32x4*)(rs + pos * 32 + e0 + 4);
            const unsigned aw[4] = {a.x, a.y, a.z, a.w}, bw[4] = {b.x, b.y, b.z, b.w}; float o1[8], o2[8];
#pragma unroll
            for (int j = 0; j < 8; ++j) { const float t1 = bf2f((aw[j >> 1] >> (16 * (j & 1))) & 0xffffu), t2 = bf2f((bw[j >> 1] >> (16 * (j & 1))) & 0xffffu);
                const float cs = j < 4 ? c0[j & 3] : c1[j & 3], sn = j < 4 ? s0[j & 3] : s1[j & 3]; o1[j] = t1 * cs - t2 * sn; o2[j] = t2 * cs + t1 * sn; }
            bf16_t* dst = (which ? KR : QR) + (size_t)t * 1536 + hh * 64 + e0;
            u32x4 w1; w1.x = pk2(o1[0], o1[1]); w1.y = pk2(o1[2], o1[3]); w1.z = pk2(o1[4], o1[5]); w1.w = pk2(o1[6], o1[7]);
            u32x4 w2; w2.x = pk2(o2[0], o2[1]); w2.y = pk2(o2[2], o2[3]); w2.z = pk2(o2[4], o2[5]); w2.w = pk2(o2[6], o2[7]);
            *(u32x4*)dst = w1; *(u32x4*)(dst + 32) = w2; }
    }
}

#define DPP_ADD(x, ctrl) ((x) + __builtin_bit_cast(float, __builtin_amdgcn_update_dpp(0, __builtin_bit_cast(int, (x)), (ctrl), 0xF, 0xF, true)))
__device__ __forceinline__ float red8(float x) { x = DPP_ADD(x, 0xB1); x = DPP_ADD(x, 0x4E); x = DPP_ADD(x, 0x141); return x; }
__device__ __forceinline__ void p4_scan(const Params& p, const Ctx& c, int bh) {
    constexpr int TS = 16, CH = TS * 384;
    unsigned char* ws = c.ws;
    const float* s0 = (const float*)(ws + WS_RZ); const float* s1 = (const float*)(ws + WS_DEC); const float* s2 = (const float*)(ws + WS_KP);
    const float* s3 = (const float*)(ws + WS_VZ); const float* s4 = (const float*)(ws + WS_AN); const float* s5 = (const float*)(ws + WS_BB);
    const float* GG = (const float*)(ws + WS_GG); bf16_t* YA = (bf16_t*)(ws + WS_YA);
    LAS float* buf = (LAS float*)c.lds;
    LAS float* ybuf = (LAS float*)(c.lds + 2 * CH * 4);
    int tid_ = c.tid; asm volatile("" : "+v"(tid_));
    const int b = bh >> 5, h = bh & 31, tid = tid_, lane = tid & 63, wave = __builtin_amdgcn_readfirstlane(tid >> 6);
    const size_t base = (size_t)b * SEQ * D + h * 64;
    const int i = tid >> 3, q = tid & 7;
    const float lg = p.in[I_LNXG][h * 64 + lane], lb = p.in[I_LNXB][h * 64 + lane], rk = p.in[I_RK][h * 64 + lane];
    float S[8];
#pragma unroll
    for (int j = 0; j < 8; ++j) S[j] = 0.f;
    f32x4 pre[3]; float gpre[2], gcur[2];
#define SCAN_ISSUE(T0) do { _Pragma("unroll") for (int j = 0; j < 3; ++j) { const int e4 = tid + 512 * j, s_ = e4 / 96, rem = e4 % 96, v_ = rem >> 4, c4 = rem & 15; \
            const float* sp = v_ == 0 ? s0 : v_ == 1 ? s1 : v_ == 2 ? s2 : v_ == 3 ? s3 : v_ == 4 ? s4 : s5; \
            pre[j] = *(const f32x4*)(sp + base + (size_t)((T0) + s_) * D + c4 * 4); } \
        gpre[0] = GG[base + (size_t)((T0) + 2 * wave) * D + lane]; gpre[1] = GG[base + (size_t)((T0) + 2 * wave + 1) * D + lane]; } while (0)
#define SCAN_WRITE(CB) do { _Pragma("unroll") for (int j = 0; j < 3; ++j) { const int e4 = tid + 512 * j; *(LAS f32x4*)(buf + (CB) * CH + 4 * e4) = pre[j]; } } while (0)
    SCAN_ISSUE(0);
    SCAN_WRITE(0); gcur[0] = gpre[0]; gcur[1] = gpre[1];
    __syncthreads();
    for (int c0 = 0; c0 < SEQ / TS; ++c0) {
        const int t0 = c0 * TS, cb = c0 & 1;
        const LAS float* bc = buf + cb * CH;
        if (c0 + 1 < SEQ / TS) SCAN_ISSUE(t0 + TS);
        float yv[TS];
        f32x4 cr0, cr1, cw0, cw1, ck0, ck1, ca0, ca1, cb0, cb1; float cvi;
#define SCAN_LD(s_, R0, R1, W0, W1, K0, K1, A0, A1, B0, B1, VI) do { const LAS float* st = bc + (s_) * 384 + 8 * q; \
            R0 = *(const LAS f32x4*)(st); R1 = *(const LAS f32x4*)(st + 4); W0 = *(const LAS f32x4*)(st + 64); W1 = *(const LAS f32x4*)(st + 68); \
            K0 = *(const LAS f32x4*)(st + 128); K1 = *(const LAS f32x4*)(st + 132); A0 = *(const LAS f32x4*)(st + 256); A1 = *(const LAS f32x4*)(st + 260); \
            B0 = *(const LAS f32x4*)(st + 320); B1 = *(const LAS f32x4*)(st + 324); VI = bc[(s_) * 384 + 192 + i]; } while (0)
        SCAN_LD(0, cr0, cr1, cw0, cw1, ck0, ck1, ca0, ca1, cb0, cb1, cvi);
#pragma unroll
        for (int s = 0; s < TS; ++s) {
            f32x4 nr0, nr1, nw0, nw1, nk0, nk1, na0, na1, nb0, nb1; float nvi;
            if (s + 1 < TS) SCAN_LD(s + 1, nr0, nr1, nw0, nw1, nk0, nk1, na0, na1, nb0, nb1, nvi);
            float sa = (S[0] * ca0[0] + S[1] * ca0[1]) + (S[2] * ca0[2] + S[3] * ca0[3]) + ((S[4] * ca1[0] + S[5] * ca1[1]) + (S[6] * ca1[2] + S[7] * ca1[3]));
            sa = red8(sa);
#pragma unroll
            for (int j = 0; j < 4; ++j) { S[j] = S[j] * cw0[j] + (sa * cb0[j] + cvi * ck0[j]); S[4 + j] = S[4 + j] * cw1[j] + (sa * cb1[j] + cvi * ck1[j]); }
            float y = (S[0] * cr0[0] + S[1] * cr0[1]) + (S[2] * cr0[2] + S[3] * cr0[3]) + ((S[4] * cr1[0] + S[5] * cr1[1]) + (S[6] * cr1[2] + S[7] * cr1[3]));
            yv[s] = red8(y);
            asm volatile("" : "+v"(S[0]), "+v"(S[1]), "+v"(S[2]), "+v"(S[3]), "+v"(S[4]), "+v"(S[5]), "+v"(S[6]), "+v"(S[7]) :: "memory");
            if (s + 1 < TS) { cr0 = nr0; cr1 = nr1; cw0 = nw0; cw1 = nw1; ck0 = nk0; ck1 = nk1; ca0 = na0; ca1 = na1; cb0 = nb0; cb1 = nb1; cvi = nvi; }
        }
#undef SCAN_LD
        if (q == 0) {
#pragma unroll
            for (int s = 0; s < TS; ++s) ybuf[s * 64 + i] = yv[s]; }
        if (c0 + 1 < SEQ / TS) SCAN_WRITE(cb ^ 1);
        __syncthreads();
#pragma unroll
        for (int k = 0; k < 2; ++k) { const int s = 2 * wave + k;
            const float y = ybuf[s * 64 + lane], rr = bc[s * 384 + lane], kk = bc[s * 384 + 128 + lane], vv = bc[s * 384 + 192 + lane];
            const float mu = wave_sum(y) * (1.0f / 64.0f); const float dl = y - mu; const float var = wave_sum(dl * dl) * (1.0f / 64.0f);
            const float yn = dl * rsqrtf(var + GN_EPS) * lg + lb; const float bonus = wave_sum(rr * kk * rk) * vv;
            YA[base + (size_t)(t0 + s) * D + lane] = (bf16_t)f2bf((yn + bonus) * gcur[k]); }
        gcur[0] = gpre[0]; gcur[1] = gpre[1];
        __syncthreads();
    }
#undef SCAN_ISSUE
#undef SCAN_WRITE
}

__device__ __forceinline__ void p4_attn_task(const Ctx& c, int task) {
    unsigned char* ws = c.ws;
    const bf16_t* QR = (const bf16_t*)(ws + WS_QR); const bf16_t* KR = (const bf16_t*)(ws + WS_KR); const bf16_t* PROJ = (const bf16_t*)(ws + WS_PROJ);
    float* AO = (float*)(ws + WS_AO); float* LSE = (float*)(ws + WS_LSE);
    constexpr int VP = 280;
    LAS bf16_t* Vt = (LAS bf16_t*)c.lds;
    const int combo = task & 31, hh = (task >> 5) % 24, b = task / (32 * 24);
    const int g = hh >> 3, h = hh & 7;
    const int dil = g == 0 ? 1 : (g == 1 ? 4 : 16);
    const int res = combo % dil, blk = combo / dil;
    const int tid = c.tid, lane = c.lane, w = c.wave;
    __syncthreads();
    {
        const int ki = tid >> 1, dh = tid & 1; const int pk = (blk - 1) * 128 + ki;
        u32x4 v[4];
        if (pk >= 0) { const bf16_t* sp = PROJ + ((size_t)b * SEQ + (size_t)pk * dil + res) * PC + ATT0 + 2 * 1536 + hh * 64 + 32 * dh;
#pragma unroll
            for (int j = 0; j < 4; ++j) v[j] = *(const u32x4*)(sp + 8 * j); }
        else {
#pragma unroll
            for (int j = 0; j < 4; ++j) v[j] = (u32x4){0u, 0u, 0u, 0u}; }
#pragma unroll
        for (int j = 0; j < 4; ++j) { const unsigned wv[4] = {v[j].x, v[j].y, v[j].z, v[j].w};
#pragma unroll
            for (int e = 0; e < 8; ++e) Vt[(32 * dh + 8 * j + e) * VP + ki] = (bf16_t)((wv[e >> 1] >> (16 * (e & 1))) & 0xffffu); }
        if (tid < 64) {
#pragma unroll
            for (int e = 0; e < 24; ++e) Vt[tid * VP + 256 + e] = 0; }
    }
    __syncthreads();
    const int qq = lane & 15, g4 = lane >> 4;
    const int r0 = 16 * w;
    const size_t qtok = (size_t)b * SEQ + (size_t)(blk * 128 + r0 + qq) * dil + res;
    bf16x8 qf[2];
#pragma unroll
    for (int ks = 0; ks < 2; ++ks) qf[ks] = *(const bf16x8*)(QR + qtok * 1536 + hh * 64 + 32 * ks + 8 * g4);
    f32x4 sc[10];
#pragma unroll
    for (int kt = 0; kt < 9; ++kt) {
        const int ki = 16 * (w + kt) + qq; const int pk = (blk - 1) * 128 + ki;
        f32x4 a = (f32x4){0.f, 0.f, 0.f, 0.f};
#pragma unroll
        for (int ks = 0; ks < 2; ++ks) { bf16x8 kf = (bf16x8){0, 0, 0, 0, 0, 0, 0, 0};
            if (pk >= 0) kf = *(const bf16x8*)(KR + ((size_t)b * SEQ + (size_t)pk * dil + res) * 1536 + hh * 64 + 32 * ks + 8 * g4);
            a = __builtin_amdgcn_mfma_f32_16x16x32_bf16(kf, qf[ks], a, 0, 0, 0); }
        sc[kt] = a;
    }
    const int r = r0 + qq;
    float mx = -3.0e38f;
#pragma unroll
    for (int kt = 0; kt < 9; ++kt)
#pragma unroll
        for (int j = 0; j < 4; ++j) { const int ki = 16 * (w + kt) + 4 * g4 + j; const bool ok = (ki >= r) && (ki <= r + 128) && (blk > 0 || ki >= 128);
            const float s = ok ? sc[kt][j] * 0.125f : -1.0e30f; sc[kt][j] = s; mx = fmaxf(mx, s); }
    mx = fmaxf(mx, __shfl_xor(mx, 16)); mx = fmaxf(mx, __shfl_xor(mx, 32));
    float den = 0.f;
#pragma unroll
    for (int kt = 0; kt < 9; ++kt)
#pragma unroll
        for (int j = 0; j < 4; ++j) { const float pexp = __expf(sc[kt][j] - mx); sc[kt][j] = pexp; den += pexp; }
    den += __shfl_xor(den, 16); den += __shfl_xor(den, 32);
    sc[9] = (f32x4){0.f, 0.f, 0.f, 0.f};
    f32x4 oacc[4];
#pragma unroll
    for (int dt = 0; dt < 4; ++dt) oacc[dt] = (f32x4){0.f, 0.f, 0.f, 0.f};
#pragma unroll
    for (int cidx = 0; cidx < 5; ++cidx) {
        const f32x4 p0 = sc[2 * cidx], p1 = sc[2 * cidx + 1];
        u32x4 pw; pw.x = pk2(p0[0], p0[1]); pw.y = pk2(p0[2], p0[3]); pw.z = pk2(p1[0], p1[1]); pw.w = pk2(p1[2], p1[3]);
        const bf16x8 pf = __builtin_bit_cast(bf16x8, pw);
        const int kbase = 16 * (w + 2 * cidx) + 4 * g4;
#pragma unroll
        for (int dt = 0; dt < 4; ++dt) { const LAS bf16_t* vp = Vt + (16 * dt + qq) * VP + kbase;
            const u32x2 lo = *(const LAS u32x2*)vp, hi = *(const LAS u32x2*)(vp + 16);
            u32x4 vw; vw.x = lo.x; vw.y = lo.y; vw.z = hi.x; vw.w = hi.y;
            oacc[dt] = __builtin_amdgcn_mfma_f32_16x16x32_bf16(__builtin_bit_cast(bf16x8, vw), pf, oacc[dt], 0, 0, 0); }
    }
    const float inv = 1.0f / den;
    const size_t tok = qtok;
#pragma unroll
    for (int dt = 0; dt < 4; ++dt) *(f32x4*)(AO + ((size_t)g * M + tok) * 512 + h * 64 + 16 * dt + 4 * g4) = oacc[dt] * inv;
    if (g4 == 0) LSE[((size_t)g * M + tok) * 8 + h] = mx + __logf(den);
}

constexpr int Q_ATT = 3072, Q_TOTAL = Q_ATT + MOE_CONV_GROUPS;
__device__ __forceinline__ void p4_queue(const Params& p, const Ctx& c, volatile LAS unsigned* qslot) {
    unsigned* qc = (unsigned*)(c.ws + WS_CTL) + CW_Q;
    for (;;) {
        __syncthreads();
        if (c.tid == 0) qslot[0] = __hip_atomic_fetch_add(qc, 1u, __ATOMIC_RELAXED, __HIP_MEMORY_SCOPE_AGENT);
        __syncthreads();
        const unsigned it = qslot[0];
        if (it >= (unsigned)Q_TOTAL) break;
        if (it < (unsigned)Q_ATT) p4_attn_task(c, (int)it); else conv_group(p, c, (int)it - Q_ATT);
    }
}

__device__ __forceinline__ void p5_post(const Params& p, const Ctx& c) {
    unsigned char* ws = c.ws;
    const float* AO = (const float*)(ws + WS_AO); const float* LSE = (const float*)(ws + WS_LSE);
    bf16_t* YB = (bf16_t*)(ws + WS_YB);
    const int gw = c.vcu * 8 + c.wave, NGW = c.G * 8, lane = c.lane;
    for (int it = gw; it < M * 8; it += NGW) {
        const int t = it >> 3, h = it & 7;
        const float l0 = LSE[((size_t)0 * M + t) * 8 + h], l1 = LSE[((size_t)1 * M + t) * 8 + h], l2 = LSE[((size_t)2 * M + t) * 8 + h];
        const float mxl = fmaxf(l0, fmaxf(l1, l2)); const float e0 = __expf(l0 - mxl), e1 = __expf(l1 - mxl), e2 = __expf(l2 - mxl); const float inv = 1.0f / (e0 + e1 + e2);
        const size_t o = (size_t)t * 512 + h * 64 + lane;
        const float v = (e0 * AO[o] + e1 * AO[(size_t)M * 512 + o] + e2 * AO[(size_t)2 * M * 512 + o]) * inv;
        YB[o] = (bf16_t)f2bf(v);
    }
}

__device__ __forceinline__ void ln_rows(const Ctx& c, const float* in, const float* gam, const float* bet, float* outf, bf16_t* outb) {
    const int gw = c.vcu * 8 + c.wave, NGW = c.G * 8, lane = c.lane;
    for (int m = gw; m < M; m += NGW) {
        const f32x4* xr = (const f32x4*)(in + (size_t)m * D) + lane;
        f32x4 v[8]; float s = 0.f;
#pragma unroll
        for (int j = 0; j < 8; ++j) { v[j] = xr[64 * j]; s += (v[j][0] + v[j][1]) + (v[j][2] + v[j][3]); }
        const float mean = wave_sum(s) * (1.0f / D); float s2 = 0.f;
#pragma unroll
        for (int j = 0; j < 8; ++j) { v[j] = v[j] - mean; s2 += (v[j][0] * v[j][0] + v[j][1] * v[j][1]) + (v[j][2] * v[j][2] + v[j][3] * v[j][3]); }
        const float rstd = rsqrtf(wave_sum(s2) * (1.0f / D) + LN_EPS);
#pragma unroll
        for (int j = 0; j < 8; ++j) { const int col = 4 * lane + 256 * j; const f32x4 gv = *(const f32x4*)(gam + col), bv = *(const f32x4*)(bet + col);
            const f32x4 o = v[j] * rstd * gv + bv;
            *(f32x4*)(outf + (size_t)m * D + col) = o;
            if (outb) { u32x2 w; w.x = pk2(o[0], o[1]); w.y = pk2(o[2], o[3]); *(u32x2*)(outb + (size_t)m * D + col) = w; } }
    }
}

__device__ __forceinline__ void p15_router(const Params& p, const Ctx& c) {
    unsigned char* ws = c.ws;
    const float* X2 = (const float*)(ws + WS_X2); const float* RW = p.in[I_RW]; const float* RB = p.in[I_RB];
    unsigned* cnt = (unsigned*)(ws + WS_CTL) + CW_CNT; int* LIST = (int*)(ws + WS_LIST); int* ROWI = (int*)(ws + WS_ROWI); float* TOPW = (float*)(ws + WS_TOPW);
    LAS float* scr = (LAS float*)(c.lds + c.wave * 8192);
    const int gw = c.vcu * 8 + c.wave, NGW = c.G * 8, lane = c.lane, li = lane & 31, lk = lane >> 5;
    for (int tb = gw; tb < M / 32; tb += NGW) {
        const int t0 = tb * 32;
        f32x16 acc;
#pragma unroll
        for (int j = 0; j < 16; ++j) acc[j] = 0.f;
        const float* xa = X2 + (size_t)(t0 + li) * D + 4 * lk;
        const float* wb = RW + (size_t)(4 * lk) * 32 + li;
        for (int kb = 0; kb < D / 8; ++kb) {
            const f32x4 a = *(const f32x4*)(xa + 8 * kb);
            const float b0 = wb[(size_t)(8 * kb + 0) * 32], b1 = wb[(size_t)(8 * kb + 1) * 32], b2 = wb[(size_t)(8 * kb + 2) * 32], b3 = wb[(size_t)(8 * kb + 3) * 32];
            acc = __builtin_amdgcn_mfma_f32_32x32x2f32(a[0], b0, acc, 0, 0, 0);
            acc = __builtin_amdgcn_mfma_f32_32x32x2f32(a[1], b1, acc, 0, 0, 0);
            acc = __builtin_amdgcn_mfma_f32_32x32x2f32(a[2], b2, acc, 0, 0, 0);
            acc = __builtin_amdgcn_mfma_f32_32x32x2f32(a[3], b3, acc, 0, 0, 0);
        }
        const float bias = RB[li];
#pragma unroll
        for (int rg = 0; rg < 16; ++rg) { const int row = (rg & 3) + 8 * (rg >> 2) + 4 * lk; scr[row * 33 + li] = acc[rg] + bias; }
        LDS_WAIT(); asm volatile("" ::: "memory");
        if (lane < 32) {
            float lv[32];
#pragma unroll
            for (int e = 0; e < 32; ++e) lv[e] = scr[lane * 33 + e];
            int id[4]; float tv[4];
#pragma unroll
            for (int k = 0; k < 4; ++k) { float best = -3.0e38f; int bi = 0;
#pragma unroll
                for (int e = 0; e < 32; ++e) { const bool tk = lv[e] > best; best = tk ? lv[e] : best; bi = tk ? e : bi; }
                id[k] = bi; tv[k] = best;
#pragma unroll
                for (int e = 0; e < 32; ++e) lv[e] = (e == bi) ? -3.0e38f : lv[e]; }
            const float e1 = __expf(tv[1] - tv[0]), e2 = __expf(tv[2] - tv[0]), e3 = __expf(tv[3] - tv[0]); const float inv = 1.0f / (1.0f + e1 + e2 + e3);
            const float wv[4] = {inv, e1 * inv, e2 * inv, e3 * inv};
            const int t = t0 + lane;
#pragma unroll
            for (int k = 0; k < 4; ++k) { const unsigned slot = __hip_atomic_fetch_add(cnt + id[k], 1u, __ATOMIC_RELAXED, __HIP_MEMORY_SCOPE_AGENT);
                LIST[(size_t)id[k] * CAP + slot] = t; ROWI[(size_t)t * 4 + k] = id[k] * CAP + (int)slot; TOPW[(size_t)t * 4 + k] = wv[k]; }
        }
        LDS_WAIT(); asm volatile("" ::: "memory");
    }
}

__device__ __forceinline__ void moe_table(const Ctx& c, LAS int* tab) {
    if (c.tid == 0) { unsigned* cnt = (unsigned*)(c.ws + WS_CTL) + CW_CNT; int ts = 0;
        for (int e = 0; e < NEXP; ++e) { const int n = (int)__hip_atomic_load(cnt + e, __ATOMIC_RELAXED, __HIP_MEMORY_SCOPE_AGENT); tab[e] = n; tab[32 + e] = ts; ts += (n + 255) >> 8; }
        tab[64] = ts; }
    __syncthreads();
}

__device__ __forceinline__ void p18_combine(const Params& p, const Ctx& c, const LAS int* tab) {
    unsigned char* ws = c.ws;
    const float* X2 = (const float*)(ws + WS_X2); const float* Y = (const float*)(ws + WS_Y); const int* ROWI = (const int*)(ws + WS_ROWI); const float* TOPW = (const float*)(ws + WS_TOPW);
    const float* gam = p.in[I_LN3G]; const float* bet = p.in[I_LN3B];
    const int gw = c.vcu * 8 + c.wave, NGW = c.G * 8, lane = c.lane;
    for (int m = gw; m < M; m += NGW) {
        f32x4 v[8];
        const f32x4* xr = (const f32x4*)(X2 + (size_t)m * D) + lane;
#pragma unroll
        for (int j = 0; j < 8; ++j) v[j] = xr[64 * j] * DN_ALPHA;
#pragma unroll
        for (int k = 0; k < 4; ++k) { const int ri = ROWI[(size_t)m * 4 + k]; const float gt = TOPW[(size_t)m * 4 + k]; const int e = ri >> 14, slot = ri & (CAP - 1);
            const f32x4* yr = (const f32x4*)(Y + ((size_t)tab[32 + e] * 256 + slot) * D) + lane;
#pragma unroll
            for (int j = 0; j < 8; ++j) v[j] = v[j] + yr[64 * j] * gt; }
        float s = 0.f;
#pragma unroll
        for (int j = 0; j < 8; ++j) s += (v[j][0] + v[j][1]) + (v[j][2] + v[j][3]);
        const float mean = wave_sum(s) * (1.0f / D); float s2 = 0.f;
#pragma unroll
        for (int j = 0; j < 8; ++j) { v[j] = v[j] - mean; s2 += (v[j][0] * v[j][0] + v[j][1] * v[j][1]) + (v[j][2] * v[j][2] + v[j][3] * v[j][3]); }
        const float rstd = rsqrtf(wave_sum(s2) * (1.0f / D) + LN_EPS);
#pragma unroll
        for (int j = 0; j < 8; ++j) { const int col = 4 * lane + 256 * j; const f32x4 gv = *(const f32x4*)(gam + col), bv = *(const f32x4*)(bet + col);
            *(f32x4*)(p.out + (size_t)m * D + col) = v[j] * rstd * gv + bv; }
    }
}

constexpr int NPHASE = 19;
__global__ void __launch_bounds__(512, 2) fwd(Params p) {
    extern __shared__ __attribute__((aligned(16))) unsigned char lds_raw[];
    LAS unsigned char* lds = (LAS unsigned char*)lds_raw;
    Ctx c; c.tid = threadIdx.x; c.lane = c.tid & 63; c.wave = __builtin_amdgcn_readfirstlane(c.tid >> 6); c.G = gridDim.x;
    { const int bx = blockIdx.x; c.vcu = (c.G % 8 == 0) ? (bx % 8) * (c.G / 8) + bx / 8 : bx; }
    c.lds = lds; c.ws = p.ws;
    unsigned char* ws = p.ws;
    volatile LAS unsigned* MISC = (volatile LAS unsigned*)(lds + MISC_OFF);
    LAS int* tab = (LAS int*)(lds + MISC_OFF + 1024);
    if (c.tid < 64) MISC[c.tid] = 0u;
    __syncthreads();
    unsigned* ctl = (unsigned*)(ws + WS_CTL);
    XcdBarrier bar; bar.bar = ctl + CW_BAR + p.li * XCD_BAR_WORDS; bar.x = 0; bar.st = MISC + 8;
    if (N_LAUNCH_MODE == 1) bar = xcd_barrier_post(ctl + CW_BAR + p.li * XCD_BAR_WORDS, MISC + 8);
    const int lo = p.ph_lo, hi = p.ph_hi, bx = blockIdx.x;
#ifndef PHMASK
#define PHMASK 0xFFFFFFFFu
#endif
#define IN(k) (((PHMASK >> (k)) & 1u) && lo <= (k) && (k) < hi)
#define SEAM(k) do { if (N_LAUNCH_MODE == 1 && IN((k) + 1)) xcd_barrier(bar); } while (0)

    if (IN(0)) { p0_prologue(p, c); SEAM(0); }

    if (IN(1)) {
        pg8::StaticOrder S; S.init(ws + WS_XB, ws + WS_WIN, M, PC, D, D, c.G, bx);
        pg8::EpiBf16 E{(bf16_t*)(ws + WS_PROJ), PC, 1.0f};
        pg8::gemm_phase<pg8::EpiBf16, pg8::StaticOrder>(lds, pg8::Gemm{D, D, D}, S, E);
        SEAM(1);
    }
    if (IN(2)) { p2_prep(p, c); SEAM(2); }

    if (IN(3)) {
#ifndef P3M
#define P3M 15
#endif
        if (P3M & 1) { pg8::StaticOrder S; S.init(ws + WS_LIN, ws + WS_WUP, M, D, 768, 256, c.G, bx);
          pg8::EpiDecay E{(float*)(ws + WS_DEC), p.in[I_W0]};
          pg8::gemm_phase<pg8::EpiDecay, pg8::StaticOrder>(lds, pg8::Gemm{256, 768, 256}, S, E); }
        if (P3M & 2) { pg8::StaticOrder S; S.init(ws + WS_LIN + 512, ws + WS_AUP, M, D, 768, 256, c.G, bx);
          pg8::EpiIclr E{p.in[I_A0], p.in[I_KK], p.in[I_KA], (const float*)(ws + WS_KZ), (const float*)(ws + WS_KNORM), (float*)(ws + WS_KP), (float*)(ws + WS_AN), (float*)(ws + WS_BB)};
          pg8::gemm_phase<pg8::EpiIclr, pg8::StaticOrder>(lds, pg8::Gemm{256, 768, 256}, S, E); }
        if (P3M & 4) { pg8::StaticOrder S; S.init(ws + WS_LIN + 1024, ws + WS_GUP, M, D, 768, 256, c.G, bx);
          pg8::EpiF32 E{(float*)(ws + WS_GG), D, nullptr, 0, nullptr, 0.f};
          pg8::gemm_phase<pg8::EpiF32, pg8::StaticOrder>(lds, pg8::Gemm{256, 768, 256}, S, E); }
        if (P3M & 8) { pg8::StaticOrder S; S.init(ws + WS_MEMB, ws + WS_WKV, 1024, 2 * D, D, D, c.G, bx);
          pg8::EpiKV E{(bf16_t*)(ws + WS_KB), (bf16_t*)(ws + WS_VT)};
          pg8::gemm_phase<pg8::EpiKV, pg8::StaticOrder>(lds, pg8::Gemm{D, D, D}, S, E); }
        SEAM(3);
    }
    if (IN(4)) {
        for (int bh = c.vcu; bh < 128; bh += c.G) p4_scan(p, c, bh);
        p4_queue(p, c, MISC + 16);
        SEAM(4);
    }
    if (IN(5)) { p5_post(p, c); }

    if (IN(6)) {
        pg8::StaticOrder S; S.init(ws + WS_YA, ws + WS_PA, M, D, D, D, c.G, bx);
        pg8::EpiGateA E{(const bf16_t*)(ws + WS_PROJ), (float*)(ws + WS_TMP)};
        pg8::gemm_phase<pg8::EpiGateA, pg8::StaticOrder>(lds, pg8::Gemm{D, D, D}, S, E);
        SEAM(6);
    }
    if (IN(7)) {
        pg8::StaticOrder S; S.init(ws + WS_YB, ws + WS_PB, M, D, 512, 512, c.G, bx);
        pg8::EpiGateB E{(const bf16_t*)(ws + WS_PROJ), (const float*)(ws + WS_TMP), (bf16_t*)(ws + WS_MERGED)};
        pg8::gemm_phase<pg8::EpiGateB, pg8::StaticOrder>(lds, pg8::Gemm{512, 512, 512}, S, E);
        SEAM(7);
    }
    if (IN(8)) {
        pg8::StaticOrder S; S.init(ws + WS_MERGED, ws + WS_WOUT, M, D, D, D, c.G, bx);
        pg8::EpiF32 E{(float*)(ws + WS_T1), D, nullptr, 0, p.in[I_X], DN_ALPHA};
        pg8::gemm_phase<pg8::EpiF32, pg8::StaticOrder>(lds, pg8::Gemm{D, D, D}, S, E);
        SEAM(8);
    }
    if (IN(9)) { ln_rows(c, (const float*)(ws + WS_T1), p.in[I_LN1G], p.in[I_LN1B], (float*)(ws + WS_X1), (bf16_t*)(ws + WS_X1B)); SEAM(9); }

    if (IN(10)) {
        pg8::StaticOrder S; S.init(ws + WS_X1B, ws + WS_WQ, M, D, D, D, c.G, bx);
        pg8::EpiBf16 E{(bf16_t*)(ws + WS_Q), D, 0.04419417382415922f};
        pg8::gemm_phase<pg8::EpiBf16, pg8::StaticOrder>(lds, pg8::Gemm{D, D, D}, S, E);
        SEAM(10);
    }
    if (IN(11)) {
        ScoreOrder S{(const char*)(ws + WS_Q), (const char*)(ws + WS_KB), c.G, bx};
        pg8::EpiSoftmax E{(bf16_t*)(ws + WS_PP)};
        pg8::gemm_phase<pg8::EpiSoftmax, ScoreOrder, false>(lds, pg8::Gemm{512, D, D}, S, E);
        SEAM(11);
    }
    if (IN(12)) {
        PvOrder S{(const char*)(ws + WS_PP), (const char*)(ws + WS_VT), c.G, bx};
        pg8::EpiBf16 E{(bf16_t*)(ws + WS_OC), D, 1.0f};
        pg8::gemm_phase<pg8::EpiBf16, PvOrder>(lds, pg8::Gemm{256, 256, 256}, S, E);
        SEAM(12);
    }
    if (IN(13)) {
        pg8::StaticOrder S; S.init(ws + WS_OC, ws + WS_WO, M, D, D, D, c.G, bx);
        pg8::EpiF32 E{(float*)(ws + WS_T2), D, nullptr, 0, (const float*)(ws + WS_X1), DN_ALPHA};
        pg8::gemm_phase<pg8::EpiF32, pg8::StaticOrder>(lds, pg8::Gemm{D, D, D}, S, E);
        SEAM(13);
    }
    if (IN(14)) { ln_rows(c, (const float*)(ws + WS_T2), p.in[I_LN2G], p.in[I_LN2B], (float*)(ws + WS_X2), (bf16_t*)(ws + WS_X2B)); SEAM(14); }
    if (IN(15)) { p15_router(p, c); SEAM(15); }

    if (IN(16)) {
        moe_table(c, tab);
        MoeOrder<true, 16> S{tab, (const char*)(ws + WS_X2B), (const char*)(ws + WS_W1), (const int*)(ws + WS_LIST), (size_t)4096 * D * 2, D, c.G, bx};
        pg8::EpiSwiglu E{p.in[I_B1], (bf16_t*)(ws + WS_H)};
        pg8::gemm_phase<pg8::EpiSwiglu, MoeOrder<true, 16>>(lds, pg8::Gemm{D, D, D}, S, E);
        SEAM(16);
    }
    if (IN(17)) {
        moe_table(c, tab);
        MoeOrder<false, 8> S{tab, (const char*)(ws + WS_H), (const char*)(ws + WS_W2), (const int*)(ws + WS_LIST), (size_t)D * DFF * 2, DFF, c.G, bx};
        pg8::EpiF32 E{(float*)(ws + WS_Y), D, p.in[I_B2], D, nullptr, 0.f};
        pg8::gemm_phase<pg8::EpiF32, MoeOrder<false, 8>>(lds, pg8::Gemm{DFF, DFF, DFF}, S, E);
        SEAM(17);
    }
    if (IN(18)) { moe_table(c, tab); p18_combine(p, c, tab); }
#undef IN
#undef SEAM
}

extern "C" void kernel_launch(void* const* d_in, const int* in_sizes, int n_in, void* d_out, int out_size, void* d_ws, size_t ws_size, hipStream_t stream) {
    static int grid = 0;
    if (grid == 0) {
        if (n_in != 32 || out_size != M * D || ws_size < WS_END) { fprintf(stderr, "kernel_launch: expected 32 inputs, %d outputs, >= %zu bytes of workspace; got %d, %d, %zu\n", M * D, (size_t)WS_END, n_in, out_size, ws_size); grid = -1; return; }
        int dev = 0, cus = 0, per_cu = 0;
        if (hipGetDevice(&dev) != hipSuccess || hipDeviceGetAttribute(&cus, hipDeviceAttributeMultiprocessorCount, dev) != hipSuccess) { grid = -1; return; }
        if (hipFuncSetAttribute((const void*)fwd, hipFuncAttributeMaxDynamicSharedMemorySize, LDS_BYTES) != hipSuccess) { fprintf(stderr, "kernel_launch: hipFuncSetAttribute failed\n"); grid = -1; return; }
        if (hipOccupancyMaxActiveBlocksPerMultiprocessor(&per_cu, (const void*)fwd, 512, LDS_BYTES) != hipSuccess || per_cu < 1) fprintf(stderr, "kernel_launch: occupancy query reports %d\n", per_cu);
        (void)hipGetLastError();
        grid = cus;
        if (grid != 256) fprintf(stderr, "kernel_launch: %d CUs; this kernel is built for 256\n", grid);
    }
    if (grid < 0) return;
    (void)hipMemsetAsync((char*)d_ws + WS_CTL, 0, CTL_ZERO_BYTES, stream);
    Params p{};
    for (int i = 0; i < 32; ++i) p.in[i] = (const float*)d_in[i];
    p.out = (float*)d_out; p.ws = (unsigned char*)d_ws;
#if defined(TIMING_REPEAT_LO)
    { const int cuts[4][2] = {{0, TIMING_REPEAT_HI}, {TIMING_REPEAT_LO, TIMING_REPEAT_HI}, {TIMING_REPEAT_HI, NPHASE}, {0, 0}};
      for (int li = 0; li < 3; ++li) { if (cuts[li][0] >= cuts[li][1]) continue; p.ph_lo = cuts[li][0]; p.ph_hi = cuts[li][1]; p.li = li; hipLaunchKernelGGL(fwd, dim3(grid), dim3(512), LDS_BYTES, stream, p); } }
#else
    if (N_LAUNCH_MODE == 1) { p.ph_lo = 0; p.ph_hi = NPHASE; hipLaunchKernelGGL(fwd, dim3(grid), dim3(512), LDS_BYTES, stream, p); }
    else for (int k = 0; k < NPHASE; ++k) { p.ph_lo = k; p.ph_hi = k + 1; hipLaunchKernelGGL(fwd, dim3(grid), dim3(512), LDS_BYTES, stream, p); }
#endif
}
```

```cpp
#include <hip/hip_runtime.h>
#include <cstdio>
#include <cstdint>

#define LAS __attribute__((address_space(3)))
#define GAS __attribute__((address_space(1)))
typedef unsigned short bf16_t;
typedef short bf16x8 __attribute__((ext_vector_type(8)));
typedef float f32x4 __attribute__((ext_vector_type(4)));
typedef float f32x2 __attribute__((ext_vector_type(2)));
typedef float f32x16 __attribute__((ext_vector_type(16)));
typedef unsigned u32x4 __attribute__((ext_vector_type(4)));
typedef unsigned u32x2 __attribute__((ext_vector_type(2)));

#ifndef N_LAUNCH_MODE
#define N_LAUNCH_MODE 1
#endif

constexpr int M = 16384, D = 2048, SEQ = 4096, NBATCH = 4;
constexpr int RWC = 6592;
constexpr int PC = 15360;
constexpr int ATT0 = 6656, GATE0 = 11264;
constexpr int NEXP = 32, DFF = 2048, CAP = 16384;
constexpr int HROWS = 65536 + 32 * 256;
constexpr float LN_EPS = 1e-5f, GN_EPS = 64e-5f;
constexpr float DN_ALPHA = 1.189207115002721f;

__device__ __forceinline__ float bf2f(unsigned v) { return __uint_as_float(v << 16); }
__device__ __forceinline__ unsigned f2bf(float f) { unsigned u = __float_as_uint(f); return (u + 0x7fffu + ((u >> 16) & 1u)) >> 16; }
__device__ __forceinline__ unsigned pk2(float lo, float hi) { return f2bf(lo) | (f2bf(hi) << 16); }
__device__ __forceinline__ float sigmoidf_(float x) { return 1.0f / (1.0f + __expf(-x)); }
__device__ __forceinline__ float wave_sum(float v) {
#pragma unroll
    for (int o = 1; o < 64; o <<= 1) v += __shfl_xor(v, o);
    return v;
}
#define LDS_WAIT() asm volatile("s_waitcnt lgkmcnt(0)" ::: "memory")
#define VM_WAIT() asm volatile("s_waitcnt vmcnt(0)" ::: "memory")

namespace pg8 {
#define PG8_LAS __attribute__((address_space(3)))
constexpr int BM = 256, BK = 64, HALF = 128, HTB = HALF * BK * 2, STAGE_BYTES = 8 * HTB, NXCD = 8, WGM = 8;

__host__ __device__ __forceinline__ int lds_byte(int r, int c) { const int st = (r >> 4) * 2 + (c >> 5), rr = r & 15, cc = c & 31, ob = rr * 64 + cc * 2; return st * 1024 + (ob ^ (((ob >> 9) & 1) << 5)); }
__host__ __device__ __forceinline__ void stage_rc(int b, int& R, int& C) { const int st = b / 1024, sb = b % 1024, swz = sb ^ (((sb >> 9) & 1) << 5); R = (st >> 1) * 16 + swz / 64; C = (st & 1) * 32 + (swz % 64) / 2; }
__host__ __device__ __forceinline__ int perm32(int rho) { const int n = rho >> 4, i = rho & 15; return 8 * (i >> 2) + 4 * n + (i & 3); }

struct Unit { const char* A; const char* B; int orow, ocol, aux, aux2, valid; };
struct Gemm { int K, lda, ldb; };

struct StaticOrder {
    static constexpr bool GATHER = false;
    const char* A; const char* Bt; size_t ta, tb;
    int nM, nN, nwg, G, c;
    __device__ void init(const void* A_, const void* Bt_, int M_, int N_, int lda, int ldb, int G_, int c_) { A = (const char*)A_; Bt = (const char*)Bt_; ta = (size_t)BM * lda * 2; tb = (size_t)BM * ldb * 2; nM = M_ / BM; nN = N_ / BM; nwg = nM * nN; G = G_; c = c_; }
    __device__ bool next(int i, Unit& u) const {
        const long L = (long)i * G + c; if (c < 0 || L >= nwg) return false;
        int wgid = (int)L; { const int q = nwg / NXCD, r = nwg % NXCD, xcd = wgid % NXCD, off = wgid / NXCD; wgid = (xcd < r ? xcd * (q + 1) : r * (q + 1) + (xcd - r) * q) + off; }
        const int nig = WGM * nN, gid = wgid / nig, fm = gid * WGM, gsz = (nM - fm) < WGM ? (nM - fm) : WGM;
        const int pm = fm + ((wgid % nig) % gsz), pn = (wgid % nig) / gsz;
        u.A = A + (size_t)pm * ta; u.B = Bt + (size_t)pn * tb; u.orow = pm * BM; u.ocol = pn * BM; u.aux = 0; u.aux2 = 0; u.valid = BM; return true;
    }
    __device__ __forceinline__ const int* rows(const Unit&) const { return nullptr; }
};

__device__ __forceinline__ unsigned cvt_pk_bf16(float lo, float hi) { unsigned r; asm volatile("v_cvt_pk_bf16_f32 %0, %1, %2" : "=v"(r) : "v"(lo), "v"(hi)); return r; }

template <class Epi, class Sched, bool ALIGN_EPI = true>
__device__ __forceinline__ void gemm_phase(PG8_LAS unsigned char* lds, const Gemm g, const Sched& S, const Epi& E) {
    const int tid = threadIdx.x, wid = __builtin_amdgcn_readfirstlane(tid >> 6), lane = tid & 63, wr = wid >> 2, wc = wid & 3, fr = lane & 15, fq = lane >> 4;
    const int K = g.K, nt = K / BK;
    unsigned voffA[2], voffB[2]; int Rr[2], Cc[2];
#pragma unroll
    for (int i = 0; i < 2; ++i) { int R, C; stage_rc(tid * 16 + i * 8192, R, C); const int Rb = Epi::PERM ? ((R & ~31) + perm32(R & 31)) : R; Rr[i] = R; Cc[i] = C;
        voffA[i] = (unsigned)(R * g.lda + C) * 2u; voffB[i] = (unsigned)(Rb * g.ldb + C) * 2u; }
    const size_t kstep = (size_t)(BK * 2);
    const size_t hstepA = (size_t)HALF * g.lda * 2, hstepB = (size_t)HALF * g.ldb * 2;
    const unsigned ldsw = (unsigned)wid * 1024u;
    const int aoff = lds_byte(wr * 64 + fr, fq * 8), boff = lds_byte(wc * 32 + fr, fq * 8);
    unsigned vAc[2][2], vAn[2][2];
#define PG8_SA(b, h) (((b) * 2 + (h)) * HTB)
#define PG8_SB(b, h) ((4 + (b) * 2 + (h)) * HTB)
#define PG8_STAGE(bufoff, gbase, voff) do { _Pragma("unroll") for (int _i = 0; _i < 2; ++_i) \
        __builtin_amdgcn_global_load_lds((const unsigned*)((const char*)(gbase) + (voff)[_i]), (PG8_LAS unsigned*)(lds + (bufoff) + ldsw + _i * 8192), 16, 0, 0); } while (0)
#define PG8_STAGE_A(bufoff, kbase, h, nx) do { if constexpr (Sched::GATHER) { unsigned _v[2] = {(nx) ? vAn[h][0] : vAc[h][0], (nx) ? vAn[h][1] : vAc[h][1]}; PG8_STAGE(bufoff, kbase, _v); } \
        else { PG8_STAGE(bufoff, (kbase) + (h) * hstepA, voffA); } } while (0)
#define PG8_GOFF(u, v) do { const int* _rw = S.rows(u); _Pragma("unroll") for (int _h = 0; _h < 2; ++_h) _Pragma("unroll") for (int _i = 0; _i < 2; ++_i) { const int _r = Rr[_i] + _h * HALF; \
        const int _tk = _r < (u).valid ? _rw[_r] : 0; v[_h][_i] = (unsigned)(_tk * g.lda + Cc[_i]) * 2u; } } while (0)
#define PG8_LDA(dst, b, h) do { _Pragma("unroll") for (int m = 0; m < 4; ++m) _Pragma("unroll") for (int k = 0; k < 2; ++k) dst[m][k] = *(const PG8_LAS bf16x8*)(lds + PG8_SA(b, h) + aoff + m * 2048 + k * 1024); } while (0)
#define PG8_LDB(dst, b, h) do { _Pragma("unroll") for (int n = 0; n < 2; ++n) _Pragma("unroll") for (int k = 0; k < 2; ++k) dst[n][k] = *(const PG8_LAS bf16x8*)(lds + PG8_SB(b, h) + boff + n * 2048 + k * 1024); } while (0)
#define PG8_MMA(ai, bj, At, Bt) do { __builtin_amdgcn_s_setprio(1); _Pragma("unroll") for (int m = 0; m < 4; ++m) _Pragma("unroll") for (int n = 0; n < 2; ++n) _Pragma("unroll") for (int k = 0; k < 2; ++k) \
        acc[ai][bj][m][n] = __builtin_amdgcn_mfma_f32_16x16x32_bf16(Bt[n][k], At[m][k], acc[ai][bj][m][n], 0, 0, 0); __builtin_amdgcn_s_setprio(0); } while (0)
#define PG8_WAIT_V(n) asm volatile("s_waitcnt vmcnt(" #n ")" ::: "memory")
#define PG8_WAIT_L(n) asm volatile("s_waitcnt lgkmcnt(" #n ")" ::: "memory")
#define PG8_BAR __builtin_amdgcn_s_barrier()
#define PG8_SCHED __builtin_amdgcn_sched_barrier(0)
    Unit cur, nxt; int ui = 0;
    if (!S.next(0, cur)) return;
    f32x4 acc[2][2][4][2];
#pragma unroll
    for (int a = 0; a < 2; ++a)
#pragma unroll
        for (int b = 0; b < 2; ++b)
#pragma unroll
            for (int m = 0; m < 4; ++m)
#pragma unroll
                for (int n = 0; n < 2; ++n) acc[a][b][m][n] = (f32x4){0.f, 0.f, 0.f, 0.f};
    bf16x8 At[4][2], B0[2][2], B1[2][2];
    const char* cA = cur.A; const char* cB = cur.B;
    if constexpr (Sched::GATHER) { PG8_GOFF(cur, vAc); PG8_WAIT_V(0); }
    PG8_STAGE(PG8_SB(0, 0), cB, voffB); PG8_STAGE(PG8_SB(0, 1), cB + hstepB, voffB); PG8_STAGE_A(PG8_SA(0, 0), cA, 0, false); PG8_STAGE_A(PG8_SA(0, 1), cA, 1, false);
    if (wr == 1) PG8_BAR;
    PG8_WAIT_V(2); PG8_BAR;
    PG8_STAGE(PG8_SB(1, 0), cB + kstep, voffB); PG8_STAGE_A(PG8_SA(1, 0), cA + kstep, 0, false); PG8_STAGE(PG8_SB(1, 1), cB + hstepB + kstep, voffB);
    PG8_WAIT_V(6); PG8_BAR;
    for (;;) {
        const bool has_next = S.next(ui + 1, nxt);
        const char* nA = has_next ? nxt.A : cA; const char* nB = has_next ? nxt.B : cB;
        if constexpr (Sched::GATHER) { if (has_next) { PG8_GOFF(nxt, vAn); } else {
#pragma unroll
            for (int h = 0; h < 2; ++h)
#pragma unroll
                for (int i = 0; i < 2; ++i) vAn[h][i] = vAc[h][i]; } }
#pragma nounroll
        for (int t = 0; t < nt; t += 2) {
            const bool last = (t == nt - 2);
            const char* a1 = cA + (size_t)(t + 1) * kstep;
            const char* a2 = last ? nA : cA + (size_t)(t + 2) * kstep; const char* b2 = last ? nB : cB + (size_t)(t + 2) * kstep;
            const char* a3 = a2 + kstep; const char* b3 = b2 + kstep;
            PG8_LDB(B0, 0, 0); PG8_LDB(B1, 0, 1); PG8_SCHED; PG8_LDA(At, 0, 0); PG8_STAGE_A(PG8_SA(1, 1), a1, 1, false);
            PG8_WAIT_V(8); PG8_WAIT_L(0); PG8_BAR; PG8_MMA(0, 0, At, B0); PG8_MMA(0, 1, At, B1); PG8_BAR; PG8_SCHED;
            PG8_LDA(At, 0, 1); PG8_STAGE(PG8_SB(0, 0), b2, voffB); PG8_STAGE(PG8_SB(0, 1), b2 + hstepB, voffB); PG8_STAGE_A(PG8_SA(0, 0), a2, 0, last);
            PG8_WAIT_V(8); PG8_WAIT_L(0); PG8_BAR; PG8_MMA(1, 0, At, B0); PG8_MMA(1, 1, At, B1); PG8_BAR; PG8_SCHED;
            PG8_LDB(B0, 1, 0); PG8_LDB(B1, 1, 1); PG8_SCHED; PG8_LDA(At, 1, 0); PG8_STAGE_A(PG8_SA(0, 1), a2, 1, last);
            PG8_WAIT_V(8); PG8_WAIT_L(0); PG8_BAR; PG8_MMA(0, 0, At, B0); PG8_MMA(0, 1, At, B1); PG8_BAR; PG8_SCHED;
            PG8_LDA(At, 1, 1); PG8_STAGE(PG8_SB(1, 0), b3, voffB); PG8_STAGE(PG8_SB(1, 1), b3 + hstepB, voffB); PG8_STAGE_A(PG8_SA(1, 0), a3, 0, last);
            PG8_WAIT_V(8); PG8_WAIT_L(0); PG8_BAR; PG8_MMA(1, 0, At, B0); PG8_MMA(1, 1, At, B1); PG8_BAR; PG8_SCHED;
        }
        if constexpr (ALIGN_EPI) { if (wr == 0) PG8_BAR; }
        if constexpr (!Epi::AFTER_DRAIN) { E(acc, cur, wr, wc, fr, fq); }
        if (!has_next) break;
#pragma unroll
        for (int a = 0; a < 2; ++a)
#pragma unroll
            for (int b = 0; b < 2; ++b)
#pragma unroll
                for (int m = 0; m < 4; ++m)
#pragma unroll
                    for (int n = 0; n < 2; ++n) acc[a][b][m][n] = (f32x4){0.f, 0.f, 0.f, 0.f};
        cur = nxt; cA = nA; cB = nB; ++ui;
        if constexpr (Sched::GATHER) {
#pragma unroll
            for (int h = 0; h < 2; ++h)
#pragma unroll
                for (int i = 0; i < 2; ++i) vAc[h][i] = vAn[h][i]; }
        if constexpr (ALIGN_EPI) { if (wr == 1) PG8_BAR; }
    }
    PG8_WAIT_V(0);
    if constexpr (!ALIGN_EPI) { if (wr == 0) PG8_BAR; }
    PG8_BAR;
    if constexpr (Epi::AFTER_DRAIN) { E.fused(acc, cur, wr, wc, fr, fq, lds, wid, lane); }
#undef PG8_SA
#undef PG8_SB
#undef PG8_STAGE
#undef PG8_STAGE_A
#undef PG8_GOFF
#undef PG8_LDA
#undef PG8_LDB
#undef PG8_MMA
#undef PG8_WAIT_V
#undef PG8_WAIT_L
#undef PG8_BAR
#undef PG8_SCHED
}

#define EPI_LOOP_AI_M for (int ai = 0; ai < 2; ++ai) _Pragma("unroll") for (int m = 0; m < 4; ++m)

struct EpiF32 {
    static constexpr bool PERM = false, AFTER_DRAIN = false;
    float* C; int ldc; const float* bias; int bstride; const float* res; float alpha;
    __device__ __forceinline__ void operator()(const f32x4 (&acc)[2][2][4][2], const Unit& u, int wr, int wc, int fr, int fq) const {
        const int row0 = u.orow + wr * 64 + fr, col0 = u.ocol + wc * 32 + 4 * fq;
        f32x4 bv[2][2];
#pragma unroll
        for (int bj = 0; bj < 2; ++bj)
#pragma unroll
            for (int n = 0; n < 2; ++n) bv[bj][n] = bias ? *(const f32x4*)(bias + (size_t)u.aux * bstride + col0 + bj * HALF + n * 16) : (f32x4){0.f, 0.f, 0.f, 0.f};
#pragma unroll
        EPI_LOOP_AI_M { const size_t off = (size_t)(row0 + ai * HALF + m * 16) * ldc + col0;
#pragma unroll
            for (int bj = 0; bj < 2; ++bj)
#pragma unroll
                for (int n = 0; n < 2; ++n) { f32x4 v = acc[ai][bj][m][n] + bv[bj][n];
                    if (res) { const f32x4 rv = *(const f32x4*)(res + off + bj * HALF + n * 16); v = v + rv * alpha; }
                    *(f32x4*)(C + off + bj * HALF + n * 16) = v; }
            asm volatile("" ::: "memory"); }
    }
};
struct EpiBf16 {
    static constexpr bool PERM = true, AFTER_DRAIN = false;
    bf16_t* O; int ldc; float scale;
    __device__ __forceinline__ void operator()(const f32x4 (&acc)[2][2][4][2], const Unit& u, int wr, int wc, int fr, int fq) const {
        const int row0 = u.orow + wr * 64 + fr, col0 = u.ocol + wc * 32 + 8 * fq;
#pragma unroll
        EPI_LOOP_AI_M { bf16_t* rowp = O + (size_t)(row0 + ai * HALF + m * 16) * ldc + col0;
#pragma unroll
            for (int bj = 0; bj < 2; ++bj) { const f32x4 v0 = acc[ai][bj][m][0] * scale, v1 = acc[ai][bj][m][1] * scale;
                u32x4 w; w.x = cvt_pk_bf16(v0[0], v0[1]); w.y = cvt_pk_bf16(v0[2], v0[3]); w.z = cvt_pk_bf16(v1[0], v1[1]); w.w = cvt_pk_bf16(v1[2], v1[3]);
                *(u32x4*)(rowp + bj * HALF) = w; } }
    }
};
struct EpiKV {
    static constexpr bool PERM = true, AFTER_DRAIN = false;
    bf16_t* KB; bf16_t* VT;
    __device__ __forceinline__ void operator()(const f32x4 (&acc)[2][2][4][2], const Unit& u, int wr, int wc, int fr, int fq) const {
        const int row0 = u.orow + wr * 64 + fr, col0 = u.ocol + wc * 32 + 8 * fq;
#pragma unroll
        EPI_LOOP_AI_M { const int row = row0 + ai * HALF + m * 16;
#pragma unroll
            for (int bj = 0; bj < 2; ++bj) { const f32x4 v0 = acc[ai][bj][m][0], v1 = acc[ai][bj][m][1]; const int col = col0 + bj * HALF;
                if (u.ocol < 2048) { u32x4 w; w.x = cvt_pk_bf16(v0[0], v0[1]); w.y = cvt_pk_bf16(v0[2], v0[3]); w.z = cvt_pk_bf16(v1[0], v1[1]); w.w = cvt_pk_bf16(v1[2], v1[3]);
                    *(u32x4*)(KB + (size_t)row * 2048 + col) = w; }
                else { const int b = row >> 8, key = row & 255, c = col - 2048, h = c >> 9, d = c & 511; bf16_t* p = VT + ((size_t)((b * 4 + h) * 512 + d)) * 256 + key;
#pragma unroll
                    for (int j = 0; j < 4; ++j) { p[(size_t)j * 256] = (bf16_t)f2bf(v0[j]); p[(size_t)(4 + j) * 256] = (bf16_t)f2bf(v1[j]); } } } }
    }
};
struct EpiDecay {
    static constexpr bool PERM = false, AFTER_DRAIN = false;
    float* DEC; const float* w0;
    __device__ __forceinline__ void operator()(const f32x4 (&acc)[2][2][4][2], const Unit& u, int wr, int wc, int fr, int fq) const {
        const int row0 = u.orow + wr * 64 + fr, col0 = u.ocol + wc * 32 + 4 * fq;
        f32x4 bv[2][2];
#pragma unroll
        for (int bj = 0; bj < 2; ++bj)
#pragma unroll
            for (int n = 0; n < 2; ++n) bv[bj][n] = *(const f32x4*)(w0 + col0 + bj * HALF + n * 16);
#pragma unroll
        EPI_LOOP_AI_M { const size_t off = (size_t)(row0 + ai * HALF + m * 16) * D + col0;
#pragma unroll
            for (int bj = 0; bj < 2; ++bj)
#pragma unroll
                for (int n = 0; n < 2; ++n) { const f32x4 x = acc[ai][bj][m][n] + bv[bj][n]; f32x4 o;
#pragma unroll
                    for (int j = 0; j < 4; ++j) o[j] = __expf(-0.6065306597126334f * sigmoidf_(x[j]));
                    *(f32x4*)(DEC + off + bj * HALF + n * 16) = o; } }
    }
};
struct EpiIclr {
    static constexpr bool PERM = false, AFTER_DRAIN = false;
    const float* a0; const float* k_k; const float* k_a; const float* KZ; const float* KNORM; float* KP; float* AN; float* BB;
    __device__ __forceinline__ void operator()(const f32x4 (&acc)[2][2][4][2], const Unit& u, int wr, int wc, int fr, int fq) const {
        const int row0 = u.orow + wr * 64 + fr, col0 = u.ocol + wc * 32 + 4 * fq;
#pragma unroll
        for (int bj = 0; bj < 2; ++bj)
#pragma unroll
            for (int n = 0; n < 2; ++n) { const int col = col0 + bj * HALF + n * 16;
                const f32x4 a0v = *(const f32x4*)(a0 + col), kkv = *(const f32x4*)(k_k + col), kav = *(const f32x4*)(k_a + col);
#pragma unroll
                EPI_LOOP_AI_M { const int row = row0 + ai * HALF + m * 16; const size_t off = (size_t)row * D + col;
                    const f32x4 kz = *(const f32x4*)(KZ + off); const float nr = KNORM[(size_t)row * 32 + (col >> 6)]; const float inv = 1.0f / fmaxf(nr, 1e-12f);
                    const f32x4 x = acc[ai][bj][m][n] + a0v; f32x4 kp, an, bb;
#pragma unroll
                    for (int j = 0; j < 4; ++j) { const float a = sigmoidf_(x[j]); const float kk = kz[j] * kkv[j] * inv; kp[j] = kz[j] * (1.0f + (a - 1.0f) * kav[j]); bb[j] = kk * a; an[j] = -kk; }
                    *(f32x4*)(KP + off) = kp; *(f32x4*)(AN + off) = an; *(f32x4*)(BB + off) = bb; }
                asm volatile("" ::: "memory"); }
    }
};
struct EpiGateA {
    static constexpr bool PERM = false, AFTER_DRAIN = false;
    const bf16_t* PROJ; float* TMP;
    __device__ __forceinline__ void operator()(const f32x4 (&acc)[2][2][4][2], const Unit& u, int wr, int wc, int fr, int fq) const {
        const int row0 = u.orow + wr * 64 + fr, col0 = u.ocol + wc * 32 + 4 * fq;
#pragma unroll
        EPI_LOOP_AI_M { const int row = row0 + ai * HALF + m * 16;
#pragma unroll
            for (int bj = 0; bj < 2; ++bj)
#pragma unroll
                for (int n = 0; n < 2; ++n) { const int col = col0 + bj * HALF + n * 16; const u32x2 gv = *(const u32x2*)(PROJ + (size_t)row * PC + GATE0 + col);
                    const f32x4 a = acc[ai][bj][m][n]; f32x4 o;
                    o[0] = a[0] * sigmoidf_(bf2f(gv.x & 0xffffu)); o[1] = a[1] * sigmoidf_(bf2f(gv.x >> 16)); o[2] = a[2] * sigmoidf_(bf2f(gv.y & 0xffffu)); o[3] = a[3] * sigmoidf_(bf2f(gv.y >> 16));
                    *(f32x4*)(TMP + (size_t)row * D + col) = o; } }
    }
};
struct EpiGateB {
    static constexpr bool PERM = true, AFTER_DRAIN = false;
    const bf16_t* PROJ; const float* TMP; bf16_t* MERGED;
    __device__ __forceinline__ void operator()(const f32x4 (&acc)[2][2][4][2], const Unit& u, int wr, int wc, int fr, int fq) const {
        const int row0 = u.orow + wr * 64 + fr, col0 = u.ocol + wc * 32 + 8 * fq;
#pragma unroll
        EPI_LOOP_AI_M { const int row = row0 + ai * HALF + m * 16;
#pragma unroll
            for (int bj = 0; bj < 2; ++bj) { const int col = col0 + bj * HALF; const u32x4 gv = *(const u32x4*)(PROJ + (size_t)row * PC + GATE0 + 2048 + col);
                const f32x4 t0 = *(const f32x4*)(TMP + (size_t)row * D + col), t1 = *(const f32x4*)(TMP + (size_t)row * D + col + 4);
                const f32x4 a0 = acc[ai][bj][m][0], a1 = acc[ai][bj][m][1]; f32x4 o0, o1;
                o0[0] = t0[0] + a0[0] * sigmoidf_(bf2f(gv.x & 0xffffu)); o0[1] = t0[1] + a0[1] * sigmoidf_(bf2f(gv.x >> 16)); o0[2] = t0[2] + a0[2] * sigmoidf_(bf2f(gv.y & 0xffffu)); o0[3] = t0[3] + a0[3] * sigmoidf_(bf2f(gv.y >> 16));
                o1[0] = t1[0] + a1[0] * sigmoidf_(bf2f(gv.z & 0xffffu)); o1[1] = t1[1] + a1[1] * sigmoidf_(bf2f(gv.z >> 16)); o1[2] = t1[2] + a1[2] * sigmoidf_(bf2f(gv.w & 0xffffu)); o1[3] = t1[3] + a1[3] * sigmoidf_(bf2f(gv.w >> 16));
                u32x4 w; w.x = cvt_pk_bf16(o0[0], o0[1]); w.y = cvt_pk_bf16(o0[2], o0[3]); w.z = cvt_pk_bf16(o1[0], o1[1]); w.w = cvt_pk_bf16(o1[2], o1[3]);
                *(u32x4*)(MERGED + (size_t)row * D + col) = w; }
            asm volatile("" ::: "memory"); }
    }
};
struct EpiSwiglu {
    static constexpr bool PERM = true, AFTER_DRAIN = false;
    const float* b1; bf16_t* H;
    __device__ __forceinline__ float sw(float g, float l) const { g = fminf(g, 7.0f); l = fminf(fmaxf(l, -7.0f), 7.0f); return g * sigmoidf_(1.702f * g) * (l + 1.0f); }
    __device__ __forceinline__ void operator()(const f32x4 (&acc)[2][2][4][2], const Unit& u, int wr, int wc, int fr, int fq) const {
        const int row0 = u.orow + wr * 64 + fr, col0 = u.ocol + wc * 32 + 8 * fq;
        f32x4 bv[2][2];
#pragma unroll
        for (int bj = 0; bj < 2; ++bj)
#pragma unroll
            for (int n = 0; n < 2; ++n) bv[bj][n] = *(const f32x4*)(b1 + (size_t)u.aux * 4096 + col0 + bj * HALF + 4 * n);
#pragma unroll
        EPI_LOOP_AI_M { const int row = row0 + ai * HALF + m * 16;
#pragma unroll
            for (int bj = 0; bj < 2; ++bj) { const f32x4 v0 = acc[ai][bj][m][0] + bv[bj][0], v1 = acc[ai][bj][m][1] + bv[bj][1];
                u32x2 w; w.x = cvt_pk_bf16(sw(v0[0], v0[1]), sw(v0[2], v0[3])); w.y = cvt_pk_bf16(sw(v1[0], v1[1]), sw(v1[2], v1[3]));
                *(u32x2*)(H + (size_t)row * DFF + ((col0 + bj * HALF) >> 1)) = w; } }
    }
};
struct EpiSoftmax {
    static constexpr bool PERM = true, AFTER_DRAIN = true;
    bf16_t* PP;
    __device__ __forceinline__ void fused(f32x4 (&acc)[2][2][4][2], const Unit& u, int wr, int wc, int fr, int fq, PG8_LAS unsigned char* lds, int wid, int lane) const {
        PG8_LAS float* P1 = (PG8_LAS float*)lds;
        PG8_LAS float* P2 = (PG8_LAS float*)(lds + 4096);
        float mx[2][4];
#pragma unroll
        EPI_LOOP_AI_M { float v = -3.0e38f;
#pragma unroll
            for (int bj = 0; bj < 2; ++bj)
#pragma unroll
                for (int n = 0; n < 2; ++n) { const f32x4 x = acc[ai][bj][m][n]; v = fmaxf(v, fmaxf(fmaxf(x[0], x[1]), fmaxf(x[2], x[3]))); }
            v = fmaxf(v, __shfl_xor(v, 16)); v = fmaxf(v, __shfl_xor(v, 32));
            if (fq == 0) P1[(ai * HALF + wr * 64 + m * 16 + fr) * 4 + wc] = v; }
        asm volatile("s_waitcnt lgkmcnt(0)" ::: "memory"); __builtin_amdgcn_s_barrier(); asm volatile("" ::: "memory");
#pragma unroll
        EPI_LOOP_AI_M { const f32x4 t = *(const PG8_LAS f32x4*)(P1 + (ai * HALF + wr * 64 + m * 16 + fr) * 4); mx[ai][m] = fmaxf(fmaxf(t[0], t[1]), fmaxf(t[2], t[3])); }
#pragma unroll
        EPI_LOOP_AI_M { float s = 0.f;
#pragma unroll
            for (int bj = 0; bj < 2; ++bj)
#pragma unroll
                for (int n = 0; n < 2; ++n) { f32x4 x = acc[ai][bj][m][n];
#pragma unroll
                    for (int j = 0; j < 4; ++j) { x[j] = __expf(x[j] - mx[ai][m]); s += x[j]; }
                    acc[ai][bj][m][n] = x; }
            s += __shfl_xor(s, 16); s += __shfl_xor(s, 32);
            if (fq == 0) P2[(ai * HALF + wr * 64 + m * 16 + fr) * 4 + wc] = s; }
        asm volatile("s_waitcnt lgkmcnt(0)" ::: "memory"); __builtin_amdgcn_s_barrier(); asm volatile("" ::: "memory");
        const int row0 = u.orow + wr * 64 + fr, col0 = wc * 32 + 8 * fq;
#pragma unroll
        EPI_LOOP_AI_M { const f32x4 t = *(const PG8_LAS f32x4*)(P2 + (ai * HALF + wr * 64 + m * 16 + fr) * 4); const float inv = 1.0f / ((t[0] + t[1]) + (t[2] + t[3]));
            bf16_t* rowp = PP + (size_t)(row0 + ai * HALF + m * 16) * 256 + col0;
#pragma unroll
            for (int bj = 0; bj < 2; ++bj) { const f32x4 v0 = acc[ai][bj][m][0] * inv, v1 = acc[ai][bj][m][1] * inv;
                u32x4 w; w.x = cvt_pk_bf16(v0[0], v0[1]); w.y = cvt_pk_bf16(v0[2], v0[3]); w.z = cvt_pk_bf16(v1[0], v1[1]); w.w = cvt_pk_bf16(v1[2], v1[3]);
                *(u32x4*)(rowp + bj * HALF) = w; } }
        asm volatile("s_waitcnt lgkmcnt(0)" ::: "memory"); __builtin_amdgcn_s_barrier(); asm volatile("" ::: "memory");
    }
};
}

constexpr size_t MiB = 1u << 20;
constexpr size_t al256(size_t x) { return (x + 255) & ~(size_t)255; }
constexpr size_t WS_CTL = 0, CTL_ZERO_BYTES = 1 * MiB;
constexpr size_t WS_WIN = 1 * MiB;
constexpr size_t WS_WUP = WS_WIN + (size_t)PC * D * 2;
constexpr size_t WS_AUP = WS_WUP + (size_t)D * 256 * 2;
constexpr size_t WS_GUP = WS_AUP + (size_t)D * 256 * 2;
constexpr size_t WS_PA = WS_GUP + (size_t)D * 256 * 2;
constexpr size_t WS_PB = WS_PA + (size_t)D * D * 2;
constexpr size_t WS_WOUT = WS_PB + (size_t)D * 512 * 2;
constexpr size_t WS_WQ = WS_WOUT + (size_t)D * D * 2;
constexpr size_t WS_WKV = WS_WQ + (size_t)D * D * 2;
constexpr size_t WS_WO = WS_WKV + (size_t)2 * D * D * 2;
constexpr size_t WS_W1 = WS_WO + (size_t)D * D * 2;
constexpr size_t WS_W2 = WS_W1 + (size_t)NEXP * 4096 * D * 2;
constexpr size_t WS_XB = WS_W2 + (size_t)NEXP * D * DFF * 2;
constexpr size_t WS_MEMB = WS_XB + (size_t)M * D * 2;
constexpr size_t WS_ROT = WS_MEMB + (size_t)1024 * D * 2;
constexpr size_t WS_KB = WS_ROT + (size_t)2 * SEQ * 32 * 4;
constexpr size_t WS_VT = WS_KB + (size_t)1024 * D * 2;
constexpr size_t WS_YA = WS_VT + (size_t)1024 * D * 2;
constexpr size_t WS_YB = WS_YA + (size_t)M * D * 2;
constexpr size_t WS_TMP = WS_YB + (size_t)M * 512 * 2;
constexpr size_t WS_MERGED = WS_TMP + (size_t)M * D * 4;
constexpr size_t WS_E = WS_MERGED + (size_t)M * D * 2;
constexpr size_t WS_PROJ = WS_E;
constexpr size_t WS_RZ = WS_PROJ + (size_t)M * PC * 2;
constexpr size_t WS_KZ = WS_RZ + (size_t)M * D * 4;
constexpr size_t WS_VZ = WS_KZ + (size_t)M * D * 4;
constexpr size_t WS_DEC = WS_VZ + (size_t)M * D * 4;
constexpr size_t WS_KP = WS_DEC + (size_t)M * D * 4;
constexpr size_t WS_AN = WS_KP + (size_t)M * D * 4;
constexpr size_t WS_BB = WS_AN + (size_t)M * D * 4;
constexpr size_t WS_GG = WS_BB + (size_t)M * D * 4;
constexpr size_t WS_YS = WS_GG + (size_t)M * D * 4;
constexpr size_t WS_AO = WS_YS + (size_t)M * D * 4;
constexpr size_t WS_LSE = WS_AO + (size_t)3 * M * 512 * 4;
constexpr size_t WS_QR = WS_LSE + (size_t)3 * M * 8 * 4;
constexpr size_t WS_KR = WS_QR + (size_t)M * 1536 * 2;
constexpr size_t WS_LIN = WS_KR + (size_t)M * 1536 * 2;
constexpr size_t WS_KNORM = WS_LIN + (size_t)M * 768 * 2;
constexpr size_t WS_F = WS_KNORM + (size_t)M * 32 * 4;
constexpr size_t WS_E_END = WS_F + (size_t)128 * 128 * 96 * 96 * 2;
constexpr size_t WS_T1 = WS_E;
constexpr size_t WS_X1 = WS_T1 + (size_t)M * D * 4;
constexpr size_t WS_X1B = WS_X1 + (size_t)M * D * 4;
constexpr size_t WS_Q = WS_X1B + (size_t)M * D * 2;
constexpr size_t WS_PP = WS_Q + (size_t)M * D * 2;
constexpr size_t WS_OC = WS_PP + (size_t)16 * SEQ * 256 * 2;
constexpr size_t WS_T2 = WS_OC + (size_t)M * D * 2;
constexpr size_t WS_X2 = WS_T2 + (size_t)M * D * 4;
constexpr size_t WS_X2B = WS_X2 + (size_t)M * D * 4;
constexpr size_t WS_LIST = WS_X2B + (size_t)M * D * 2;
constexpr size_t WS_ROWI = WS_LIST + (size_t)NEXP * CAP * 4;
constexpr size_t WS_TOPW = WS_ROWI + (size_t)M * 4 * 4;
constexpr size_t WS_H = WS_TOPW + (size_t)M * 4 * 4;
constexpr size_t WS_Y = WS_H + (size_t)HROWS * DFF * 2;
constexpr size_t WS_L_END = WS_Y + (size_t)HROWS * D * 4;
constexpr size_t WS_END = (WS_E_END > WS_L_END ? WS_E_END : WS_L_END);
static_assert(WS_END <= (size_t)4090 * MiB, "workspace map exceeds 4 x largest input");
constexpr int CW_TMO = 0, CW_CNT = 64  , CW_Q = 128  , CW_BAR = 4096;

constexpr int RING_BYTES = 131072, MISC_OFF = RING_BYTES, LDS_BYTES = 147456;

#define XB_TMO      128
#define XB_XCNT(j)  (256  + 64 * (j))
#define XB_XSUB(j)  (1280 + 64 * (j))
#define XB_XGEN(j)  (2304 + 64 * (j))
#define XB_TOP      3328
#define XB_TOPGEN   3392
#define XCD_BAR_WORDS 3456
#define XB_SPIN_CAP (1u << 18)
__device__ __forceinline__ unsigned xb_ld(unsigned* p)              { return __hip_atomic_load(p, __ATOMIC_RELAXED, __HIP_MEMORY_SCOPE_AGENT); }
__device__ __forceinline__ unsigned xb_add(unsigned* p, unsigned v) { return __hip_atomic_fetch_add(p, v, __ATOMIC_RELAXED, __HIP_MEMORY_SCOPE_AGENT); }
__device__ __forceinline__ unsigned xb_xcc_id() { return (unsigned)__builtin_amdgcn_s_getreg((3 << 11) | 20) & 0xFu; }
#define XB_SPIN(cond, bar) do { unsigned _sp = 0; while (cond) { __builtin_amdgcn_s_sleep(1); \
    if ((++_sp & 255u) == 0u) { if (xb_ld(&(bar)[XB_TMO])) break; if (_sp > XB_SPIN_CAP) { atomicAdd(&(bar)[XB_TMO], 1u); break; } } } } while (0)
struct XcdBarrier { unsigned* bar; unsigned x; volatile LAS unsigned* st; };
__device__ __forceinline__ XcdBarrier xcd_barrier_post(unsigned* bar, volatile LAS unsigned* st) {
    XcdBarrier b; b.bar = bar; b.x = xb_xcc_id(); b.st = st;
    if (threadIdx.x == 0) (void)xb_add(&bar[XB_XCNT(b.x)], 1u);
    return b;
}
__device__ __forceinline__ void xcd_barrier_complete(unsigned* bar, unsigned x, unsigned& nloc, unsigned& nx) {
    const unsigned G = gridDim.x * gridDim.y * gridDim.z;
    unsigned sum, cnt, mine, sp = 0u;
    for (;;) {
        sum = 0u; cnt = 0u; mine = 0u;
#pragma unroll
        for (unsigned j = 0; j < 16; ++j) { const unsigned c = xb_ld(&bar[XB_XCNT(j)]); sum += c; cnt += (c > 0u) ? 1u : 0u; mine = (j == x) ? c : mine; }
        if (sum == G) break;
        __builtin_amdgcn_s_sleep(1);
        if ((++sp & 255u) == 0u) { if (xb_ld(&bar[XB_TMO])) break; if (sp > XB_SPIN_CAP) { atomicAdd(&bar[XB_TMO], 1u); break; } }
    }
    nloc = mine > 0u ? mine : 1u; nx = cnt > 0u ? cnt : 1u;
}
__device__ __forceinline__ void xcd_barrier(const XcdBarrier& b) {
    asm volatile("s_waitcnt vmcnt(0)" ::: "memory");
    __syncthreads();
    if (threadIdx.x == 0) {
        unsigned* bar = b.bar;
        __builtin_amdgcn_s_waitcnt(0);
        unsigned nloc = b.st[0], nx = b.st[1];
        if (nloc == 0u) { xcd_barrier_complete(bar, b.x, nloc, nx); b.st[0] = nloc; b.st[1] = nx; }
        const unsigned old = xb_add(&bar[XB_XSUB(b.x)], 1u);
        const unsigned gen = old / nloc;
        if (old + 1u == (gen + 1u) * nloc) {
            __builtin_amdgcn_fence(__ATOMIC_RELEASE, "agent");
            asm volatile("s_waitcnt vmcnt(0)" ::: "memory");
            const unsigned og = xb_add(&bar[XB_TOP], 1u);
            const unsigned tg = og / nx;
            if (og + 1u == (tg + 1u) * nx) xb_add(&bar[XB_TOPGEN], 1u);
            else XB_SPIN(xb_ld(&bar[XB_TOPGEN]) == tg, bar);
            __builtin_amdgcn_fence(__ATOMIC_ACQUIRE, "agent");
            xb_add(&bar[XB_XGEN(b.x)], 1u);
            asm volatile("s_waitcnt vmcnt(0)" ::: "memory");
        } else {
            XB_SPIN(xb_ld(&bar[XB_XGEN(b.x)]) == gen, bar);
            __builtin_amdgcn_fence(__ATOMIC_ACQUIRE, "agent");
            asm volatile("s_waitcnt vmcnt(0)" ::: "memory");
        }
    }
    __syncthreads();
}

struct Params {
    const float* in[32];
    float* out; unsigned char* ws;
    int ph_lo, ph_hi, li, pad;
};
enum { I_X = 0, I_MEM, I_WIN, I_MIX, I_W0, I_WUP, I_A0, I_AUP, I_GUP, I_KK, I_KA, I_RK, I_LNXG, I_LNXB, I_PA, I_PB, I_WOUT, I_LN1G, I_LN1B, I_WQ, I_WKV, I_WO, I_LN2G, I_LN2B,
       I_RW, I_RB, I_W1, I_B1, I_W2, I_B2, I_LN3G, I_LN3B };

struct ScoreOrder {
    static constexpr bool GATHER = false;
    const char* Q; const char* KB; int G, c;
    __device__ bool next(int i, pg8::Unit& u) const {
        const int L = i * G + c; if (L >= 256) return false;
        const int bh = L >> 4, pm = L & 15, b = bh >> 2, h = bh & 3;
        u.A = Q + ((size_t)(b * SEQ + 256 * pm) * D + h * 512) * 2; u.B = KB + ((size_t)(b * 256) * D + h * 512) * 2;
        u.orow = bh * SEQ + 256 * pm; u.ocol = 0; u.aux = 0; u.aux2 = 0; u.valid = 256; return true;
    }
    __device__ __forceinline__ const int* rows(const pg8::Unit&) const { return nullptr; }
};
struct PvOrder {
    static constexpr bool GATHER = false;
    const char* PP; const char* VT; int G, c;
    __device__ bool next(int i, pg8::Unit& u) const {
        const int L = i * G + c; if (L >= 512) return false;
        const int bh = L >> 5, pm = (L >> 1) & 15, pn = L & 1, b = bh >> 2, h = bh & 3;
        u.A = PP + ((size_t)(bh * SEQ + 256 * pm) * 256) * 2; u.B = VT + ((size_t)(bh * 512 + 256 * pn) * 256) * 2;
        u.orow = b * SEQ + 256 * pm; u.ocol = h * 512 + 256 * pn; u.aux = 0; u.aux2 = 0; u.valid = 256; return true;
    }
    __device__ __forceinline__ const int* rows(const pg8::Unit&) const { return nullptr; }
};
template <bool GATHER_, int NT  > struct MoeOrder {
    static constexpr bool GATHER = GATHER_;
    const LAS int* tab; const char* A; const char* W; const int* list; size_t wexp  ; int ldb; int G, c;
    __device__ bool next(int i, pg8::Unit& u) const {
        constexpr int RPR = 256 / NT;
        const int rt = i * RPR + (c % RPR), pn = c / RPR, T = tab[64];
        if (c >= 256 || rt >= T) return false;
        int e = 0;
        for (int j = 1; j < NEXP; ++j) e = (rt >= tab[32 + j]) ? j : e;
        const int lt = rt - tab[32 + e];
        u.aux = e; u.aux2 = lt; u.valid = min(256, tab[e] - 256 * lt); u.orow = 256 * rt; u.ocol = 256 * pn;
        u.B = W + (size_t)e * wexp + (size_t)(256 * pn) * ldb * 2;
        u.A = GATHER_ ? A : A + (size_t)(256 * rt) * DFF * 2;
        return true;
    }
    __device__ __forceinline__ const int* rows(const pg8::Unit& u) const { return list + (size_t)u.aux * CAP + 256 * u.aux2; }
};

struct Ctx { int tid, lane, wave, vcu, G; LAS unsigned char* lds; unsigned char* ws; };

__device__ __forceinline__ void tr_item(const float* W, int ldw, int Ksrc, int sc0, bf16_t* WT, int ldt, int n0, int k0, LAS float* scr, int lane) {
#pragma unroll 8
    for (int i = 0; i < 32; ++i) { const int kk = 2 * i + (lane >> 5); float v = 0.f; if (sc0 >= 0 && (k0 + kk) < Ksrc) v = W[(size_t)(k0 + kk) * ldw + sc0 + (lane & 31)]; scr[kk * 33 + (lane & 31)] = v; }
    LDS_WAIT(); asm volatile("" ::: "memory");
    const int c = lane & 7;
#pragma unroll
    for (int j = 0; j < 4; ++j) { const int n = (lane >> 3) + 8 * j; const LAS float* s = scr + (8 * c) * 33 + n;
        u32x4 o; o.x = pk2(s[0 * 33], s[1 * 33]); o.y = pk2(s[2 * 33], s[3 * 33]); o.z = pk2(s[4 * 33], s[5 * 33]); o.w = pk2(s[6 * 33], s[7 * 33]);
        *(u32x4*)(WT + (size_t)(n0 + n) * ldt + k0 + 8 * c) = o; }
    LDS_WAIT(); asm volatile("" ::: "memory");
}
__device__ __forceinline__ void tr_job(const float* W, int N, int Ksrc, int Kdst, bf16_t* WT, int item, LAS float* scr, int lane) {
    const int nblk = N / 32, kb = item / nblk, nb = item % nblk;
    tr_item(W, N, Ksrc, 32 * nb, WT, Kdst, 32 * nb, 64 * kb, scr, lane);
}
__device__ __forceinline__ void p0_prologue(const Params& p, const Ctx& c) {
    LAS float* scr = (LAS float*)(c.lds + c.wave * 16384);
    const int gw = c.vcu * 8 + c.wave, NGW = c.G * 8;
    unsigned char* ws = c.ws;
    constexpr int I_WINJ = 32 * 480, I_LORA = 4 * 64, I_SQ = 32 * 64, I_PBJ = 8 * 64, I_KVJ = 32 * 128, I_W1E = 32 * 128, I_W2E = 32 * 64;
    constexpr int NITEMS = I_WINJ + 3 * I_LORA + 4 * I_SQ + I_PBJ + I_KVJ;
    for (int it = gw; it < NITEMS; it += NGW) {
        int r = it;
        if (r < I_WINJ) { const int kb = r / 480, nb = r % 480; const int sc0 = nb < 206 ? 32 * nb : (nb < 208 ? -1 : 32 * nb - 64);
            tr_item(p.in[I_WIN], 15296, D, sc0, (bf16_t*)(ws + WS_WIN), D, 32 * nb, 64 * kb, scr, c.lane); continue; } r -= I_WINJ;
        if (r < I_LORA) { tr_job(p.in[I_WUP], D, 96, 256, (bf16_t*)(ws + WS_WUP), r, scr, c.lane); continue; } r -= I_LORA;
        if (r < I_LORA) { tr_job(p.in[I_AUP], D, 96, 256, (bf16_t*)(ws + WS_AUP), r, scr, c.lane); continue; } r -= I_LORA;
        if (r < I_LORA) { tr_job(p.in[I_GUP], D, 256, 256, (bf16_t*)(ws + WS_GUP), r, scr, c.lane); continue; } r -= I_LORA;
        if (r < I_SQ) { tr_job(p.in[I_PA], D, D, D, (bf16_t*)(ws + WS_PA), r, scr, c.lane); continue; } r -= I_SQ;
        if (r < I_PBJ) { tr_job(p.in[I_PB], D, 512, 512, (bf16_t*)(ws + WS_PB), r, scr, c.lane); continue; } r -= I_PBJ;
        if (r < I_SQ) { tr_job(p.in[I_WOUT], D, D, D, (bf16_t*)(ws + WS_WOUT), r, scr, c.lane); continue; } r -= I_SQ;
        if (r < I_SQ) { tr_job(p.in[I_WQ], D, D, D, (bf16_t*)(ws + WS_WQ), r, scr, c.lane); continue; } r -= I_SQ;
        if (r < I_KVJ) { tr_job(p.in[I_WKV], 2 * D, D, D, (bf16_t*)(ws + WS_WKV), r, scr, c.lane); continue; } r -= I_KVJ;
        { tr_job(p.in[I_WO], D, D, D, (bf16_t*)(ws + WS_WO), r, scr, c.lane); }
    }
    const size_t gt = (size_t)c.vcu * 512 + c.tid, NT = (size_t)c.G * 512;
    for (size_t i = gt; i < (size_t)M * D / 8; i += NT) { const f32x4 a = ((const f32x4*)p.in[I_X])[2 * i], b = ((const f32x4*)p.in[I_X])[2 * i + 1];
        u32x4 o; o.x = pk2(a[0], a[1]); o.y = pk2(a[2], a[3]); o.z = pk2(b[0], b[1]); o.w = pk2(b[2], b[3]); ((u32x4*)(ws + WS_XB))[i] = o; }
    for (size_t i = gt; i < (size_t)1024 * D / 8; i += NT) { const f32x4 a = ((const f32x4*)p.in[I_MEM])[2 * i], b = ((const f32x4*)p.in[I_MEM])[2 * i + 1];
        u32x4 o; o.x = pk2(a[0], a[1]); o.y = pk2(a[2], a[3]); o.z = pk2(b[0], b[1]); o.w = pk2(b[2], b[3]); ((u32x4*)(ws + WS_MEMB))[i] = o; }
    float* rc = (float*)(ws + WS_ROT); float* rs = rc + SEQ * 32;
    for (size_t i = gt; i < (size_t)SEQ * 32; i += NT) { const int pos = (int)(i >> 5), j = (int)(i & 31);
        const double inv = exp(-(double)j * (9.210340371976184 / 32.0)); const double ang = (double)pos * inv; rc[i] = (float)cos(ang); rs[i] = (float)sin(ang); }
}

constexpr int MOE_W1E = 32 * 128, MOE_W2E = 32 * 64, MOE_CONV_GROUPS = (NEXP * MOE_W1E + NEXP * MOE_W2E) / 8;
__device__ __forceinline__ void conv_group(const Params& p, const Ctx& c, int gi) {
    LAS float* scr = (LAS float*)(c.lds + c.wave * 16384);
    unsigned char* ws = c.ws;
    int r = gi * 8 + c.wave;
    if (r < NEXP * MOE_W1E) { const int e = r / MOE_W1E; tr_job(p.in[I_W1] + (size_t)e * D * 4096, 4096, D, D, (bf16_t*)(ws + WS_W1) + (size_t)e * 4096 * D, r % MOE_W1E, scr, c.lane); }
    else { r -= NEXP * MOE_W1E; const int e = r / MOE_W2E; tr_job(p.in[I_W2] + (size_t)e * DFF * D, D, DFF, DFF, (bf16_t*)(ws + WS_W2) + (size_t)e * D * DFF, r % MOE_W2E, scr, c.lane); }
}

__device__ __forceinline__ void p2_prep(const Params& p, const Ctx& c) {
    unsigned char* ws = c.ws;
    const bf16_t* PROJ = (const bf16_t*)(ws + WS_PROJ);
    const float* mix = p.in[I_MIX]; const float* k_k = p.in[I_KK];
    float* RZ = (float*)(ws + WS_RZ); float* KZ = (float*)(ws + WS_KZ); float* VZ = (float*)(ws + WS_VZ);
    bf16_t* LIN = (bf16_t*)(ws + WS_LIN); float* KNORM = (float*)(ws + WS_KNORM);
    bf16_t* QR = (bf16_t*)(ws + WS_QR); bf16_t* KR = (bf16_t*)(ws + WS_KR);
    const float* rc = (const float*)(ws + WS_ROT); const float* rs = rc + SEQ * 32;
    for (int t = c.vcu; t < M; t += c.G) {
        const int pos = t & (SEQ - 1);
        const bf16_t* cur = PROJ + (size_t)t * PC;
        for (int ch = c.tid; ch < 824; ch += 512) {
            const u32x4 cv = *(const u32x4*)(cur + 8 * ch); u32x4 pv = (u32x4){0u, 0u, 0u, 0u}; if (pos > 0) pv = *(const u32x4*)(cur - PC + 8 * ch);
            const f32x4 m0 = *(const f32x4*)(mix + 8 * ch), m1 = *(const f32x4*)(mix + 8 * ch + 4);
            float z[8];
            { const unsigned cw[4] = {cv.x, cv.y, cv.z, cv.w}, pw[4] = {pv.x, pv.y, pv.z, pv.w};
              const float mm[8] = {m0[0], m0[1], m0[2], m0[3], m1[0], m1[1], m1[2], m1[3]};
#pragma unroll
              for (int j = 0; j < 4; ++j) { const float c0 = bf2f(cw[j] & 0xffffu), c1 = bf2f(cw[j] >> 16), q0 = bf2f(pw[j] & 0xffffu), q1 = bf2f(pw[j] >> 16);
                  z[2 * j] = c0 + (q0 - c0) * mm[2 * j]; z[2 * j + 1] = c1 + (q1 - c1) * mm[2 * j + 1]; } }
            if (ch < 768) {
                float* dst = (ch < 256 ? RZ : (ch < 512 ? KZ : VZ)) + (size_t)t * D + 8 * (ch & 255);
                *(f32x4*)dst = (f32x4){z[0], z[1], z[2], z[3]}; *(f32x4*)(dst + 4) = (f32x4){z[4], z[5], z[6], z[7]};
                if (ch >= 256 && ch < 512) {
                    const int col = 8 * (ch - 256); const f32x4 k0 = *(const f32x4*)(k_k + col), k1 = *(const f32x4*)(k_k + col + 4);
                    float s = 0.f;
#pragma unroll
                    for (int j = 0; j < 4; ++j) { const float a = z[j] * k0[j], b = z[4 + j] * k1[j]; s += a * a + b * b; }
                    s += __shfl_xor(s, 1); s += __shfl_xor(s, 2); s += __shfl_xor(s, 4);
                    if ((ch & 7) == 0) KNORM[(size_t)t * 32 + ((ch - 256) >> 3)] = sqrtf(s);
                }
            } else {
                float o[8]; int dcol;
                if (ch < 780) { dcol = 8 * (ch - 768);
#pragma unroll
                    for (int j = 0; j < 8; ++j) o[j] = tanhf(z[j]); }
                else if (ch < 792) { dcol = 256 + 8 * (ch - 780);
#pragma unroll
                    for (int j = 0; j < 8; ++j) o[j] = z[j]; }
                else { dcol = 512 + 8 * (ch - 792);
#pragma unroll
                    for (int j = 0; j < 8; ++j) o[j] = sigmoidf_(z[j]); }
                u32x4 w; w.x = pk2(o[0], o[1]); w.y = pk2(o[2], o[3]); w.z = pk2(o[4], o[5]); w.w = pk2(o[6], o[7]);
                *(u32x4*)(LIN + (size_t)t * 768 + dcol) = w;
            }
        }
        if (c.tid < 40) { const int dcol = (c.tid < 20) ? 96 + 8 * c.tid : 352 + 8 * (c.tid - 20); *(u32x4*)(LIN + (size_t)t * 768 + dcol) = (u32x4){0u, 0u, 0u, 0u}; }
        if (c.tid >= 64 && c.tid < 64 + 192) { const int w = c.tid - 64, which = w / 96, hh = (w % 96) >> 2, e0 = (w & 3) * 8;
            const bf16_t* src = cur + ATT0 + which * 1536 + hh * 64 + e0;
            const u32x4 a = *(const u32x4*)src, b = *(const u32x4*)(src + 32);
            const f32x4 c0 = *(const f32x4*)(rc + pos * 32 + e0), c1 = *(const f32x4*)(rc + pos * 32 + e0 + 4), s0 = *(const f32x4*)(rs + pos * 32 + e0), s1 = *(const f32x4*)(rs + pos * 32 + e0 + 4);
            const unsigned aw[4] = {a.x, a.y, a.z, a.w}, bw[4] = {b.x, b.y, b.z, b.w}; float o1[8], o2[8];
#pragma unroll
            for (int j = 0; j < 8; ++j) { const float t1 = bf2f((aw[j >> 1] >> (16 * (j & 1))) & 0xffffu), t2 = bf2f((bw[j >> 1] >> (16 * (j & 1))) & 0xffffu);
                const float cs = j < 4 ? c0[j & 3] : c1[j & 3], sn = j < 4 ? s0[j & 3] : s1[j & 3]; o1[j] = t1 * cs - t2 * sn; o2[j] = t2 * cs + t1 * sn; }
            bf16_t* dst = (which ? KR : QR) + (size_t)t * 1536 + hh * 64 + e0;
            u32x4 w1; w1.x = pk2(o1[0], o1[1]); w1.y = pk2(o1[2], o1[3]); w1.z = pk2(o1[4], o1[5]); w1.w = pk2(o1[6], o1[7]);
            u32x4 w2; w2.x = pk2(o2[0], o2[1]); w2.y = pk2(o2[2], o2[3]); w2.z = pk2(o2[4], o2[5]); w2.w = pk2(o2[6], o2[7]);
            *(u32x4*)dst = w1; *(u32x4*)(dst + 32) = w2; }
    }
}

#define DPP_ADD(x, ctrl) ((x) + __builtin_bit_cast(float, __builtin_amdgcn_update_dpp(0, __builtin_bit_cast(int, (x)), (ctrl), 0xF, 0xF, true)))
__device__ __forceinline__ float wave_sum_dpp(float x) {
    x = DPP_ADD(x, 0xB1); x = DPP_ADD(x, 0x4E); x = DPP_ADD(x, 0x141); x = DPP_ADD(x, 0x140);
    const int xi = __builtin_bit_cast(int, x);
    return (__builtin_bit_cast(float, __builtin_amdgcn_readlane(xi, 0)) + __builtin_bit_cast(float, __builtin_amdgcn_readlane(xi, 16))) +
           (__builtin_bit_cast(float, __builtin_amdgcn_readlane(xi, 32)) + __builtin_bit_cast(float, __builtin_amdgcn_readlane(xi, 48)));
}
__device__ __forceinline__ f32x4 tile_mm(const LAS bf16_t* A, int pa, const LAS bf16_t* Bt, int pb, int ks, int fr, int fq, f32x4 acc) {
    for (int k = 0; k < ks; ++k) { const bf16x8 a = *(const LAS bf16x8*)(A + fr * pa + 32 * k + 8 * fq), b = *(const LAS bf16x8*)(Bt + fr * pb + 32 * k + 8 * fq);
        acc = __builtin_amdgcn_mfma_f32_16x16x32_bf16(a, b, acc, 0, 0, 0); }
    return acc;
}
__device__ __forceinline__ u32x2 pack4(f32x4 v) { u32x2 w; w.x = pk2(v[0], v[1]); w.y = pk2(v[2], v[3]); return w; }
constexpr int SC_C = 32, SC_NCH = SEQ / SC_C, SC_F = 96;
constexpr int PL_X1 = 0, PL_X2 = 9216, PL_AL = 18432, PL_HT = 26112, PL_ET = 33792, PL_LBT = 53760, PL_TT = 58368, PL_GI = 60928, PL_RAW = 68608, PL_TF = 109568, PL_XB = 114176, PL_END = 115264;
__device__ __forceinline__ void p4_pre(const Ctx& c) {
    unsigned char* ws = c.ws;
    const float* RZ = (const float*)(ws + WS_RZ); const float* DEC = (const float*)(ws + WS_DEC); const float* KP = (const float*)(ws + WS_KP);
    const float* AN = (const float*)(ws + WS_AN); const float* BB = (const float*)(ws + WS_BB);
    bf16_t* FG = (bf16_t*)(ws + WS_F);
    LAS bf16_t* X1 = (LAS bf16_t*)(c.lds + PL_X1); LAS bf16_t* X2 = (LAS bf16_t*)(c.lds + PL_X2); LAS bf16_t* AL = (LAS bf16_t*)(c.lds + PL_AL); LAS bf16_t* HT = (LAS bf16_t*)(c.lds + PL_HT);
    LAS bf16_t* ET = (LAS bf16_t*)(c.lds + PL_ET); LAS float* LBT = (LAS float*)(c.lds + PL_LBT); LAS bf16_t* TT = (LAS bf16_t*)(c.lds + PL_TT); LAS bf16_t* GI = (LAS bf16_t*)(c.lds + PL_GI);
    LAS float* RAW = (LAS float*)(c.lds + PL_RAW);
    LAS float* TF = (LAS float*)(c.lds + PL_TF);
    LAS float* XB = (LAS float*)(c.lds + PL_XB);
    int tid_ = c.tid; asm volatile("" : "+v"(tid_));
    const int tid = tid_, lane = tid & 63, w = __builtin_amdgcn_readfirstlane(tid >> 6), fr = lane & 15, fq = lane >> 4;
    const int ls = tid >> 4, lc4 = 4 * (tid & 15);
    f32x4 pf[5];
#define PRE_LOAD(TASK) do { const int bh_ = (TASK) >> 7, ch_ = (TASK) & (SC_NCH - 1); const size_t o_ = ((size_t)(bh_ >> 5) * SEQ + (size_t)ch_ * SC_C + ls) * D + (bh_ & 31) * 64 + lc4; \
        pf[0] = *(const f32x4*)(RZ + o_); pf[1] = *(const f32x4*)(DEC + o_); pf[2] = *(const f32x4*)(KP + o_); pf[3] = *(const f32x4*)(AN + o_); pf[4] = *(const f32x4*)(BB + o_); } while (0)
    if (c.vcu < 128 * SC_NCH) PRE_LOAD(c.vcu);
    for (int task = c.vcu; task < 128 * SC_NCH; task += c.G) {
#pragma unroll
        for (int v = 0; v < 5; ++v) *(LAS f32x4*)(RAW + (v * 32 + ls) * 64 + lc4) = pf[v];
        if (task + c.G < 128 * SC_NCH) PRE_LOAD(task + c.G);
        *(LAS u32x4*)(ET + (32 + (tid >> 3)) * 104 + 8 * (tid & 7)) = (u32x4){0u, 0u, 0u, 0u};
        __syncthreads();
        float g = 1.f, gprev[4], gcur[4];
#pragma unroll
        for (int s = 0; s < SC_C; ++s) { const float wv = RAW[(32 + s) * 64 + lane]; if ((s >> 2) == w) gprev[s & 3] = g; g *= wv; if ((s >> 2) == w) gcur[s & 3] = g; }
        const float gC = g;
        f32x4 ah4, bg4, kg4;
#pragma unroll
        for (int qn = 0; qn < 4; ++qn) { const int s = 4 * w + qn;
            const float rr = RAW[(0 + s) * 64 + lane], kk = RAW[(64 + s) * 64 + lane], aa = RAW[(96 + s) * 64 + lane], bb = RAW[(128 + s) * 64 + lane]; const float ig = 1.0f / gcur[qn];
            const float ah = aa * gprev[qn], bt = bb * ig, kt = kk * ig, rh = rr * gcur[qn];
            X1[s * 72 + lane] = (bf16_t)f2bf(bt); X1[(32 + s) * 72 + lane] = (bf16_t)f2bf(kt); X2[s * 72 + lane] = (bf16_t)f2bf(ah); X2[(32 + s) * 72 + lane] = (bf16_t)f2bf(rh);
            ET[s * 104 + lane] = (bf16_t)f2bf(rh); ah4[qn] = ah; bg4[qn] = bt * gC; kg4[qn] = kt * gC; }
        *(LAS u32x2*)(AL + lane * 40 + 4 * w) = pack4(ah4); *(LAS u32x2*)(HT + (32 + lane) * 40 + 4 * w) = pack4(bg4); *(LAS u32x2*)(ET + (32 + lane) * 104 + 64 + 4 * w) = pack4(kg4);
        if (w == 0) ET[(32 + lane) * 104 + lane] = (bf16_t)f2bf(gC);
        __syncthreads();
        { const int mt = w >> 1;
#pragma unroll
          for (int u = 0; u < 2; ++u) { const int nt = 2 * (w & 1) + u;
            f32x4 acc = tile_mm(X1 + 16 * mt * 72, 72, X2 + 16 * nt * 72, 72, 2, fr, fq, (f32x4){0.f, 0.f, 0.f, 0.f});
            const int n = 16 * nt + fr, m0 = 16 * mt + 4 * fq;
            if (mt < 2) { if (nt < 2) { const int t = n; f32x4 o;
#pragma unroll
                    for (int e = 0; e < 4; ++e) o[e] = (m0 + e < t) ? acc[e] : 0.f;
                    *(LAS f32x4*)(LBT + t * 36 + m0) = o; }
                else { const int t = n - 32; f32x4 o;
#pragma unroll
                    for (int e = 0; e < 4; ++e) o[e] = (m0 + e <= t) ? acc[e] : 0.f;
                    *(LAS u32x2*)(HT + t * 40 + m0) = pack4(o); } }
            else { const int s0 = m0 - 32;
                if (nt < 2) { const int t = n;
#pragma unroll
                    for (int e = 0; e < 4; ++e) AL[(64 + s0 + e) * 40 + t] = (bf16_t)f2bf((s0 + e < t) ? acc[e] : 0.f); }
                else { const int t = n - 32; f32x4 o;
#pragma unroll
                    for (int e = 0; e < 4; ++e) o[e] = (s0 + e <= t) ? acc[e] : 0.f;
                    *(LAS u32x2*)(ET + t * 104 + 64 + s0) = pack4(o); } } } }
        __syncthreads();
        if (tid < 32) { const int hb = 16 * (tid >> 4), sl = tid & 15; float Tr[16];
#pragma unroll
            for (int t = 0; t < 16; ++t) { float a0 = (sl == t) ? 1.f : 0.f, a1 = 0.f, a2 = 0.f, a3 = 0.f;
#pragma unroll
                for (int m4 = 0; m4 < (t + 3) / 4; ++m4) { const f32x4 l = *(const LAS f32x4*)(LBT + (hb + t) * 36 + hb + 4 * m4);
                    if (4 * m4 + 0 < t) a0 += Tr[4 * m4 + 0] * l[0]; if (4 * m4 + 1 < t) a1 += Tr[4 * m4 + 1] * l[1]; if (4 * m4 + 2 < t) a2 += Tr[4 * m4 + 2] * l[2]; if (4 * m4 + 3 < t) a3 += Tr[4 * m4 + 3] * l[3]; }
                Tr[t] = (a0 + a1) + (a2 + a3); TF[(hb + sl) * 36 + hb + t] = Tr[t]; TT[(hb + t) * 40 + hb + sl] = (bf16_t)f2bf(Tr[t]);
                if (hb) TT[t * 40 + hb + sl] = 0; } }
        __syncthreads();
        if (tid < 256) { const int m = tid >> 4, tl = tid & 15; float x = 0.f;
#pragma unroll
            for (int n = 0; n < 16; ++n) x += LBT[(16 + n) * 36 + m] * TF[(16 + n) * 36 + 16 + tl];
            XB[m * 17 + tl] = x; }
        __syncthreads();
        if (tid < 256) { const int sr = tid >> 4, tl = tid & 15; float x = 0.f;
#pragma unroll
            for (int m = 0; m < 16; ++m) x += TF[sr * 36 + m] * XB[m * 17 + tl];
            TT[(16 + tl) * 40 + sr] = (bf16_t)f2bf(x); }
        __syncthreads();
        for (int id = w; id < 12; id += 8) { const int tt = id / 6, nt = id % 6;
            const f32x4 acc = tile_mm(TT + 16 * tt * 40, 40, AL + 16 * nt * 40, 40, 1, fr, fq, (f32x4){0.f, 0.f, 0.f, 0.f});
            *(LAS u32x2*)(GI + (16 * nt + fr) * 40 + 16 * tt + 4 * fq) = pack4(acc); }
        __syncthreads();
        for (int id = w; id < 36; id += 8) { const int nt = id / 6, mt = id % 6;
            const f32x4 acc = tile_mm(GI + 16 * nt * 40, 40, HT + 16 * mt * 40, 40, 1, fr, fq, (f32x4){0.f, 0.f, 0.f, 0.f});
            LAS u32x2* ep = (LAS u32x2*)(ET + (16 * mt + fr) * 104 + 16 * nt + 4 * fq); const u32x2 ev = *ep;
            f32x4 o; o[0] = acc[0] + bf2f(ev.x & 0xffffu); o[1] = acc[1] + bf2f(ev.x >> 16); o[2] = acc[2] + bf2f(ev.y & 0xffffu); o[3] = acc[3] + bf2f(ev.y >> 16);
            *ep = pack4(o); }
        __syncthreads();
        { bf16_t* fg = FG + (size_t)task * (SC_F * SC_F);
          for (int idx = tid; idx < 96 * 12; idx += 512) { const int row = idx / 12, pc = idx % 12; *(u32x4*)(fg + row * 96 + 8 * pc) = *(const LAS u32x4*)(ET + row * 104 + 8 * pc); } }
        __syncthreads();
    }
#undef PRE_LOAD
}
constexpr int SQ_BI = 0, SQ_BI_SZ = 64 * 104 * 2, SQ_YL = 2 * SQ_BI_SZ, SQ_YL_SZ = 32 * 64 * 4;
struct SeqSet { bf16x8 af[3][3]; f32x4 vimg; float r[4], k[4], v[4], g[4]; };
__device__ __forceinline__ void p4_seq(const Params& p, const Ctx& c, int bh) {
    unsigned char* ws = c.ws;
    const float* RZ = (const float*)(ws + WS_RZ); const float* KP = (const float*)(ws + WS_KP); const float* VZ = (const float*)(ws + WS_VZ); const float* GG = (const float*)(ws + WS_GG);
    const bf16_t* FG = (const bf16_t*)(ws + WS_F) + (size_t)bh * SC_NCH * (SC_F * SC_F);
    bf16_t* YA = (bf16_t*)(ws + WS_YA);
    int tid_ = c.tid; asm volatile("" : "+v"(tid_));
    const int tid = tid_, lane = tid & 63, w = __builtin_amdgcn_readfirstlane(tid >> 6), fr = lane & 15, fq = lane >> 4;
    const int b = bh >> 5, h = bh & 31;
    const size_t base = (size_t)b * SEQ * D + h * 64;
    const int nt = w & 3, mg = w >> 2;
    const float lg = p.in[I_LNXG][h * 64 + lane], lb = p.in[I_LNXB][h * 64 + lane], rk = p.in[I_RK][h * 64 + lane];
    LAS bf16_t* BI = (LAS bf16_t*)(c.lds + SQ_BI); LAS float* YL = (LAS float*)(c.lds + SQ_YL);
    const int vs = tid >> 4, vi4 = 4 * (tid & 15);
#define SEQ_LOAD(SET, CHN) do { const bf16_t* fp = FG + (size_t)(CHN) * (SC_F * SC_F); _Pragma("unroll") for (int mi = 0; mi < 3; ++mi) _Pragma("unroll") for (int ks = 0; ks < 3; ++ks) \
            SET.af[mi][ks] = *(const bf16x8*)(fp + (16 * (3 * mg + mi) + fr) * SC_F + 32 * ks + 8 * fq); \
        SET.vimg = *(const f32x4*)(VZ + base + (size_t)((CHN) * SC_C + vs) * D + vi4); \
        _Pragma("unroll") for (int e = 0; e < 4; ++e) { const size_t o = base + (size_t)((CHN) * SC_C + 4 * w + e) * D + lane; SET.r[e] = RZ[o]; SET.k[e] = KP[o]; SET.v[e] = VZ[o]; SET.g[e] = GG[o]; } } while (0)
#define SEQ_BODY(CH, CUR, NXT, NX2) do { const int ch = (CH), cb = ch & 1; \
        const LAS bf16_t* bi = BI + cb * (64 * 104); LAS bf16_t* bo = BI + (cb ^ 1) * (64 * 104); LAS float* yl = YL + cb * (32 * 64); \
        if (ch + 2 < SC_NCH) SEQ_LOAD(NX2, ch + 2); \
        bf16x8 bfr[3]; _Pragma("unroll") for (int ks = 0; ks < 3; ++ks) bfr[ks] = *(const LAS bf16x8*)(bi + (16 * nt + fr) * 104 + 32 * ks + 8 * fq); \
        f32x4 acc[3]; _Pragma("unroll") for (int mi = 0; mi < 3; ++mi) { acc[mi] = (f32x4){0.f, 0.f, 0.f, 0.f}; \
            _Pragma("unroll") for (int ks = 0; ks < 3; ++ks) acc[mi] = __builtin_amdgcn_mfma_f32_16x16x32_bf16(CUR.af[mi][ks], bfr[ks], acc[mi], 0, 0, 0); } \
        _Pragma("unroll") for (int mi = 0; mi < 3; ++mi) { const int mt = 3 * mg + mi; \
            if (mt < 2) { _Pragma("unroll") for (int e = 0; e < 4; ++e) yl[(16 * mt + 4 * fq + e) * 64 + 16 * nt + fr] = acc[mi][e]; } \
            else *(LAS u32x2*)(bo + (16 * nt + fr) * 104 + 16 * (mt - 2) + 4 * fq) = pack4(acc[mi]); } \
        if (ch + 1 < SC_NCH) { _Pragma("unroll") for (int e = 0; e < 4; ++e) bo[(vi4 + e) * 104 + 64 + vs] = (bf16_t)f2bf(NXT.vimg[e]); } \
        __syncthreads(); \
        _Pragma("unroll") for (int e = 0; e < 4; ++e) { const int s = 4 * w + e; const float y = yl[s * 64 + lane]; \
            const float mu = wave_sum_dpp(y) * (1.0f / 64.0f); const float dl = y - mu; const float var = wave_sum_dpp(dl * dl) * (1.0f / 64.0f); \
            const float yn = dl * rsqrtf(var + GN_EPS) * lg + lb; const float bonus = wave_sum_dpp(CUR.r[e] * CUR.k[e] * rk) * CUR.v[e]; \
            YA[base + (size_t)(ch * SC_C + s) * D + lane] = (bf16_t)f2bf((yn + bonus) * CUR.g[e]); } } while (0)
    SeqSet sa, sb, sc;
    SEQ_LOAD(sa, 0); SEQ_LOAD(sb, 1);
    for (int idx = tid; idx < 64 * 8; idx += 512) *(LAS u32x4*)(BI + (idx >> 3) * 104 + 8 * (idx & 7)) = (u32x4){0u, 0u, 0u, 0u};
#pragma unroll
    for (int e = 0; e < 4; ++e) BI[(vi4 + e) * 104 + 64 + vs] = (bf16_t)f2bf(sa.vimg[e]);
    __syncthreads();
    for (int c0 = 0; c0 < SC_NCH; c0 += 3) {
        SEQ_BODY(c0, sa, sb, sc);
        if (c0 + 1 < SC_NCH) SEQ_BODY(c0 + 1, sb, sc, sa);
        if (c0 + 2 < SC_NCH) SEQ_BODY(c0 + 2, sc, sa, sb);
    }
    __syncthreads();
#undef SEQ_LOAD
#undef SEQ_BODY
}

__device__ __forceinline__ void p4_attn_task(const Ctx& c, int task) {
    unsigned char* ws = c.ws;
    const bf16_t* QR = (const bf16_t*)(ws + WS_QR); const bf16_t* KR = (const bf16_t*)(ws + WS_KR); const bf16_t* PROJ = (const bf16_t*)(ws + WS_PROJ);
    float* AO = (float*)(ws + WS_AO); float* LSE = (float*)(ws + WS_LSE);
    constexpr int VP = 280;
    LAS bf16_t* Vt = (LAS bf16_t*)c.lds;
    const int combo = task & 31, hh = (task >> 5) % 24, b = task / (32 * 24);
    const int g = hh >> 3, h = hh & 7;
    const int dil = g == 0 ? 1 : (g == 1 ? 4 : 16);
    const int res = combo % dil, blk = combo / dil;
    const int tid = c.tid, lane = c.lane, w = c.wave;
    __syncthreads();
    {
        const int ki = tid >> 1, dh = tid & 1; const int pk = (blk - 1) * 128 + ki;
        u32x4 v[4];
        if (pk >= 0) { const bf16_t* sp = PROJ + ((size_t)b * SEQ + (size_t)pk * dil + res) * PC + ATT0 + 2 * 1536 + hh * 64 + 32 * dh;
#pragma unroll
            for (int j = 0; j < 4; ++j) v[j] = *(const u32x4*)(sp + 8 * j); }
        else {
#pragma unroll
            for (int j = 0; j < 4; ++j) v[j] = (u32x4){0u, 0u, 0u, 0u}; }
#pragma unroll
        for (int j = 0; j < 4; ++j) { const unsigned wv[4] = {v[j].x, v[j].y, v[j].z, v[j].w};
#pragma unroll
            for (int e = 0; e < 8; ++e) Vt[(32 * dh + 8 * j + e) * VP + ki] = (bf16_t)((wv[e >> 1] >> (16 * (e & 1))) & 0xffffu); }
        if (tid < 64) {
#pragma unroll
            for (int e = 0; e < 24; ++e) Vt[tid * VP + 256 + e] = 0; }
    }
    __syncthreads();
    const int qq = lane & 15, g4 = lane >> 4;
    const int r0 = 16 * w;
    const size_t qtok = (size_t)b * SEQ + (size_t)(blk * 128 + r0 + qq) * dil + res;
    bf16x8 qf[2];
#pragma unroll
    for (int ks = 0; ks < 2; ++ks) qf[ks] = *(const bf16x8*)(QR + qtok * 1536 + hh * 64 + 32 * ks + 8 * g4);
    f32x4 sc[10];
#pragma unroll
    for (int kt = 0; kt < 9; ++kt) {
        const int ki = 16 * (w + kt) + qq; const int pk = (blk - 1) * 128 + ki;
        f32x4 a = (f32x4){0.f, 0.f, 0.f, 0.f};
#pragma unroll
        for (int ks = 0; ks < 2; ++ks) { bf16x8 kf = (bf16x8){0, 0, 0, 0, 0, 0, 0, 0};
            if (pk >= 0) kf = *(const bf16x8*)(KR + ((size_t)b * SEQ + (size_t)pk * dil + res) * 1536 + hh * 64 + 32 * ks + 8 * g4);
            a = __builtin_amdgcn_mfma_f32_16x16x32_bf16(kf, qf[ks], a, 0, 0, 0); }
        sc[kt] = a;
    }
    const int r = r0 + qq;
    float mx = -3.0e38f;
#pragma unroll
    for (int kt = 0; kt < 9; ++kt)
#pragma unroll
        for (int j = 0; j < 4; ++j) { const int ki = 16 * (w + kt) + 4 * g4 + j; const bool ok = (ki >= r) && (ki <= r + 128) && (blk > 0 || ki >= 128);
            const float s = ok ? sc[kt][j] * 0.125f : -1.0e30f; sc[kt][j] = s; mx = fmaxf(mx, s); }
    mx = fmaxf(mx, __shfl_xor(mx, 16)); mx = fmaxf(mx, __shfl_xor(mx, 32));
    float den = 0.f;
#pragma unroll
    for (int kt = 0; kt < 9; ++kt)
#pragma unroll
        for (int j = 0; j < 4; ++j) { const float pexp = __expf(sc[kt][j] - mx); sc[kt][j] = pexp; den += pexp; }
    den += __shfl_xor(den, 16); den += __shfl_xor(den, 32);
    sc[9] = (f32x4){0.f, 0.f, 0.f, 0.f};
    f32x4 oacc[4];
#pragma unroll
    for (int dt = 0; dt < 4; ++dt) oacc[dt] = (f32x4){0.f, 0.f, 0.f, 0.f};
#pragma unroll
    for (int cidx = 0; cidx < 5; ++cidx) {
        const f32x4 p0 = sc[2 * cidx], p1 = sc[2 * cidx + 1];
        u32x4 pw; pw.x = pk2(p0[0], p0[1]); pw.y = pk2(p0[2], p0[3]); pw.z = pk2(p1[0], p1[1]); pw.w = pk2(p1[2], p1[3]);
        const bf16x8 pf = __builtin_bit_cast(bf16x8, pw);
        const int kbase = 16 * (w + 2 * cidx) + 4 * g4;
#pragma unroll
        for (int dt = 0; dt < 4; ++dt) { const LAS bf16_t* vp = Vt + (16 * dt + qq) * VP + kbase;
            const u32x2 lo = *(const LAS u32x2*)vp, hi = *(const LAS u32x2*)(vp + 16);
            u32x4 vw; vw.x = lo.x; vw.y = lo.y; vw.z = hi.x; vw.w = hi.y;
            oacc[dt] = __builtin_amdgcn_mfma_f32_16x16x32_bf16(__builtin_bit_cast(bf16x8, vw), pf, oacc[dt], 0, 0, 0); }
    }
    const float inv = 1.0f / den;
    const size_t tok = qtok;
#pragma unroll
    for (int dt = 0; dt < 4; ++dt) *(f32x4*)(AO + ((size_t)g * M + tok) * 512 + h * 64 + 16 * dt + 4 * g4) = oacc[dt] * inv;
    if (g4 == 0) LSE[((size_t)g * M + tok) * 8 + h] = mx + __logf(den);
}

constexpr int Q_ATT = 3072, Q_TOTAL = Q_ATT + MOE_CONV_GROUPS;
__device__ __forceinline__ void p4_queue(const Params& p, const Ctx& c, volatile LAS unsigned* qslot) {
    unsigned* qc = (unsigned*)(c.ws + WS_CTL) + CW_Q;
    for (;;) {
        __syncthreads();
        if (c.tid == 0) qslot[0] = __hip_atomic_fetch_add(qc, 1u, __ATOMIC_RELAXED, __HIP_MEMORY_SCOPE_AGENT);
        __syncthreads();
        const unsigned it = qslot[0];
        if (it >= (unsigned)Q_TOTAL) break;
        if (it < (unsigned)Q_ATT) p4_attn_task(c, (int)it); else conv_group(p, c, (int)it - Q_ATT);
    }
}

__device__ __forceinline__ void p5_post(const Params& p, const Ctx& c) {
    unsigned char* ws = c.ws;
    const float* AO = (const float*)(ws + WS_AO); const float* LSE = (const float*)(ws + WS_LSE);
    bf16_t* YB = (bf16_t*)(ws + WS_YB);
    const int gw = c.vcu * 8 + c.wave, NGW = c.G * 8, lane = c.lane;
    for (int it = gw; it < M * 8; it += NGW) {
        const int t = it >> 3, h = it & 7;
        const float l0 = LSE[((size_t)0 * M + t) * 8 + h], l1 = LSE[((size_t)1 * M + t) * 8 + h], l2 = LSE[((size_t)2 * M + t) * 8 + h];
        const float mxl = fmaxf(l0, fmaxf(l1, l2)); const float e0 = __expf(l0 - mxl), e1 = __expf(l1 - mxl), e2 = __expf(l2 - mxl); const float inv = 1.0f / (e0 + e1 + e2);
        const size_t o = (size_t)t * 512 + h * 64 + lane;
        const float v = (e0 * AO[o] + e1 * AO[(size_t)M * 512 + o] + e2 * AO[(size_t)2 * M * 512 + o]) * inv;
        YB[o] = (bf16_t)f2bf(v);
    }
}

__device__ __forceinline__ void ln_rows(const Ctx& c, const float* in, const float* gam, const float* bet, float* outf, bf16_t* outb) {
    const int gw = c.vcu * 8 + c.wave, NGW = c.G * 8, lane = c.lane;
    for (int m = gw; m < M; m += NGW) {
        const f32x4* xr = (const f32x4*)(in + (size_t)m * D) + lane;
        f32x4 v[8]; float s = 0.f;
#pragma unroll
        for (int j = 0; j < 8; ++j) { v[j] = xr[64 * j]; s += (v[j][0] + v[j][1]) + (v[j][2] + v[j][3]); }
        const float mean = wave_sum(s) * (1.0f / D); float s2 = 0.f;
#pragma unroll
        for (int j = 0; j < 8; ++j) { v[j] = v[j] - mean; s2 += (v[j][0] * v[j][0] + v[j][1] * v[j][1]) + (v[j][2] * v[j][2] + v[j][3] * v[j][3]); }
        const float rstd = rsqrtf(wave_sum(s2) * (1.0f / D) + LN_EPS);
#pragma unroll
        for (int j = 0; j < 8; ++j) { const int col = 4 * lane + 256 * j; const f32x4 gv = *(const f32x4*)(gam + col), bv = *(const f32x4*)(bet + col);
            const f32x4 o = v[j] * rstd * gv + bv;
            *(f32x4*)(outf + (size_t)m * D + col) = o;
            if (outb) { u32x2 w; w.x = pk2(o[0], o[1]); w.y = pk2(o[2], o[3]); *(u32x2*)(outb + (size_t)m * D + col) = w; } }
    }
}

__device__ __forceinline__ void p15_router(const Params& p, const Ctx& c) {
    unsigned char* ws = c.ws;
    const float* X2 = (const float*)(ws + WS_X2); const float* RW = p.in[I_RW]; const float* RB = p.in[I_RB];
    unsigned* cnt = (unsigned*)(ws + WS_CTL) + CW_CNT; int* LIST = (int*)(ws + WS_LIST); int* ROWI = (int*)(ws + WS_ROWI); float* TOPW = (float*)(ws + WS_TOPW);
    LAS float* scr = (LAS float*)(c.lds + c.wave * 8192);
    const int gw = c.vcu * 8 + c.wave, NGW = c.G * 8, lane = c.lane, li = lane & 31, lk = lane >> 5;
    for (int tb = gw; tb < M / 32; tb += NGW) {
        const int t0 = tb * 32;
        f32x16 acc;
#pragma unroll
        for (int j = 0; j < 16; ++j) acc[j] = 0.f;
        const float* xa = X2 + (size_t)(t0 + li) * D + 4 * lk;
        const float* wb = RW + (size_t)(4 * lk) * 32 + li;
        for (int kb = 0; kb < D / 8; ++kb) {
            const f32x4 a = *(const f32x4*)(xa + 8 * kb);
            const float b0 = wb[(size_t)(8 * kb + 0) * 32], b1 = wb[(size_t)(8 * kb + 1) * 32], b2 = wb[(size_t)(8 * kb + 2) * 32], b3 = wb[(size_t)(8 * kb + 3) * 32];
            acc = __builtin_amdgcn_mfma_f32_32x32x2f32(a[0], b0, acc, 0, 0, 0);
            acc = __builtin_amdgcn_mfma_f32_32x32x2f32(a[1], b1, acc, 0, 0, 0);
            acc = __builtin_amdgcn_mfma_f32_32x32x2f32(a[2], b2, acc, 0, 0, 0);
            acc = __builtin_amdgcn_mfma_f32_32x32x2f32(a[3], b3, acc, 0, 0, 0);
        }
        const float bias = RB[li];
#pragma unroll
        for (int rg = 0; rg < 16; ++rg) { const int row = (rg & 3) + 8 * (rg >> 2) + 4 * lk; scr[row * 33 + li] = acc[rg] + bias; }
        LDS_WAIT(); asm volatile("" ::: "memory");
        if (lane < 32) {
            float lv[32];
#pragma unroll
            for (int e = 0; e < 32; ++e) lv[e] = scr[lane * 33 + e];
            int id[4]; float tv[4];
#pragma unroll
            for (int k = 0; k < 4; ++k) { float best = -3.0e38f; int bi = 0;
#pragma unroll
                for (int e = 0; e < 32; ++e) { const bool tk = lv[e] > best; best = tk ? lv[e] : best; bi = tk ? e : bi; }
                id[k] = bi; tv[k] = best;
#pragma unroll
                for (int e = 0; e < 32; ++e) lv[e] = (e == bi) ? -3.0e38f : lv[e]; }
            const float e1 = __expf(tv[1] - tv[0]), e2 = __expf(tv[2] - tv[0]), e3 = __expf(tv[3] - tv[0]); const float inv = 1.0f / (1.0f + e1 + e2 + e3);
            const float wv[4] = {inv, e1 * inv, e2 * inv, e3 * inv};
            const int t = t0 + lane;
#pragma unroll
            for (int k = 0; k < 4; ++k) { const unsigned slot = __hip_atomic_fetch_add(cnt + id[k], 1u, __ATOMIC_RELAXED, __HIP_MEMORY_SCOPE_AGENT);
                LIST[(size_t)id[k] * CAP + slot] = t; ROWI[(size_t)t * 4 + k] = id[k] * CAP + (int)slot; TOPW[(size_t)t * 4 + k] = wv[k]; }
        }
        LDS_WAIT(); asm volatile("" ::: "memory");
    }
}

__device__ __forceinline__ void moe_table(const Ctx& c, LAS int* tab) {
    if (c.tid == 0) { unsigned* cnt = (unsigned*)(c.ws + WS_CTL) + CW_CNT; int ts = 0;
        for (int e = 0; e < NEXP; ++e) { const int n = (int)__hip_atomic_load(cnt + e, __ATOMIC_RELAXED, __HIP_MEMORY_SCOPE_AGENT); tab[e] = n; tab[32 + e] = ts; ts += (n + 255) >> 8; }
        tab[64] = ts; }
    __syncthreads();
}

__device__ __forceinline__ void p18_combine(const Params& p, const Ctx& c, const LAS int* tab) {
    unsigned char* ws = c.ws;
    const float* X2 = (const float*)(ws + WS_X2); const float* Y = (const float*)(ws + WS_Y); const int* ROWI = (const int*)(ws + WS_ROWI); const float* TOPW = (const float*)(ws + WS_TOPW);
    const float* gam = p.in[I_LN3G]; const float* bet = p.in[I_LN3B];
    const int gw = c.vcu * 8 + c.wave, NGW = c.G * 8, lane = c.lane;
    for (int m = gw; m < M; m += NGW) {
        f32x4 v[8];
        const f32x4* xr = (const f32x4*)(X2 + (size_t)m * D) + lane;
#pragma unroll
        for (int j = 0; j < 8; ++j) v[j] = xr[64 * j] * DN_ALPHA;
#pragma unroll
        for (int k = 0; k < 4; ++k) { const int ri = ROWI[(size_t)m * 4 + k]; const float gt = TOPW[(size_t)m * 4 + k]; const int e = ri >> 14, slot = ri & (CAP - 1);
            const f32x4* yr = (const f32x4*)(Y + ((size_t)tab[32 + e] * 256 + slot) * D) + lane;
#pragma unroll
            for (int j = 0; j < 8; ++j) v[j] = v[j] + yr[64 * j] * gt; }
        float s = 0.f;
#pragma unroll
        for (int j = 0; j < 8; ++j) s += (v[j][0] + v[j][1]) + (v[j][2] + v[j][3]);
        const float mean = wave_sum(s) * (1.0f / D); float s2 = 0.f;
#pragma unroll
        for (int j = 0; j < 8; ++j) { v[j] = v[j] - mean; s2 += (v[j][0] * v[j][0] + v[j][1] * v[j][1]) + (v[j][2] * v[j][2] + v[j][3] * v[j][3]); }
        const float rstd = rsqrtf(wave_sum(s2) * (1.0f / D) + LN_EPS);
#pragma unroll
        for (int j = 0; j < 8; ++j) { const int col = 4 * lane + 256 * j; const f32x4 gv = *(const f32x4*)(gam + col), bv = *(const f32x4*)(bet + col);
            *(f32x4*)(p.out + (size_t)m * D + col) = v[j] * rstd * gv + bv; }
    }
}

constexpr int NPHASE = 19;
__global__ void __launch_bounds__(512, 2) fwd(Params p) {
    extern __shared__ __attribute__((aligned(16))) unsigned char lds_raw[];
    LAS unsigned char* lds = (LAS unsigned char*)lds_raw;
    Ctx c; c.tid = threadIdx.x; c.lane = c.tid & 63; c.wave = __builtin_amdgcn_readfirstlane(c.tid >> 6); c.G = gridDim.x;
    { const int bx = blockIdx.x; c.vcu = (c.G % 8 == 0) ? (bx % 8) * (c.G / 8) + bx / 8 : bx; }
    c.lds = lds; c.ws = p.ws;
    unsigned char* ws = p.ws;
    volatile LAS unsigned* MISC = (volatile LAS unsigned*)(lds + MISC_OFF);
    LAS int* tab = (LAS int*)(lds + MISC_OFF + 1024);
    if (c.tid < 64) MISC[c.tid] = 0u;
    __syncthreads();
    unsigned* ctl = (unsigned*)(ws + WS_CTL);
    XcdBarrier bar; bar.bar = ctl + CW_BAR + p.li * XCD_BAR_WORDS; bar.x = 0; bar.st = MISC + 8;
    if (N_LAUNCH_MODE == 1) bar = xcd_barrier_post(ctl + CW_BAR + p.li * XCD_BAR_WORDS, MISC + 8);
    const int lo = p.ph_lo, hi = p.ph_hi, bx = blockIdx.x;
#ifndef PHMASK
#define PHMASK 0xFFFFFFFFu
#endif
#define IN(k) (((PHMASK >> (k)) & 1u) && lo <= (k) && (k) < hi)
#define SEAM(k) do { if (N_LAUNCH_MODE == 1 && IN((k) + 1)) xcd_barrier(bar); } while (0)

    if (IN(0)) { p0_prologue(p, c); SEAM(0); }

    if (IN(1)) {
        pg8::StaticOrder S; S.init(ws + WS_XB, ws + WS_WIN, M, PC, D, D, c.G, bx);
        pg8::EpiBf16 E{(bf16_t*)(ws + WS_PROJ), PC, 1.0f};
        pg8::gemm_phase<pg8::EpiBf16, pg8::StaticOrder>(lds, pg8::Gemm{D, D, D}, S, E);
        SEAM(1);
    }
    if (IN(2)) { p2_prep(p, c); SEAM(2); }

    if (IN(3)) {
#ifndef P3M
#define P3M 15
#endif
        if (P3M & 1) { pg8::StaticOrder S; S.init(ws + WS_LIN, ws + WS_WUP, M, D, 768, 256, c.G, bx);
          pg8::EpiDecay E{(float*)(ws + WS_DEC), p.in[I_W0]};
          pg8::gemm_phase<pg8::EpiDecay, pg8::StaticOrder>(lds, pg8::Gemm{256, 768, 256}, S, E); }
        if (P3M & 2) { pg8::StaticOrder S; S.init(ws + WS_LIN + 512, ws + WS_AUP, M, D, 768, 256, c.G, bx);
          pg8::EpiIclr E{p.in[I_A0], p.in[I_KK], p.in[I_KA], (const float*)(ws + WS_KZ), (const float*)(ws + WS_KNORM), (float*)(ws + WS_KP), (float*)(ws + WS_AN), (float*)(ws + WS_BB)};
          pg8::gemm_phase<pg8::EpiIclr, pg8::StaticOrder>(lds, pg8::Gemm{256, 768, 256}, S, E); }
        if (P3M & 4) { pg8::StaticOrder S; S.init(ws + WS_LIN + 1024, ws + WS_GUP, M, D, 768, 256, c.G, bx);
          pg8::EpiF32 E{(float*)(ws + WS_GG), D, nullptr, 0, nullptr, 0.f};
          pg8::gemm_phase<pg8::EpiF32, pg8::StaticOrder>(lds, pg8::Gemm{256, 768, 256}, S, E); }
        if (P3M & 8) { pg8::StaticOrder S; S.init(ws + WS_MEMB, ws + WS_WKV, 1024, 2 * D, D, D, c.G, bx);
          pg8::EpiKV E{(bf16_t*)(ws + WS_KB), (bf16_t*)(ws + WS_VT)};
          pg8::gemm_phase<pg8::EpiKV, pg8::StaticOrder>(lds, pg8::Gemm{D, D, D}, S, E); }
        SEAM(3);
    }
    if (IN(4)) {
        p4_pre(c);
        xcd_barrier(bar);
        for (int bh = c.vcu; bh < 128; bh += c.G) p4_seq(p, c, bh);
        p4_queue(p, c, MISC + 16);
        SEAM(4);
    }
    if (IN(5)) { p5_post(p, c); }

    if (IN(6)) {
        pg8::StaticOrder S; S.init(ws + WS_YA, ws + WS_PA, M, D, D, D, c.G, bx);
        pg8::EpiGateA E{(const bf16_t*)(ws + WS_PROJ), (float*)(ws + WS_TMP)};
        pg8::gemm_phase<pg8::EpiGateA, pg8::StaticOrder>(lds, pg8::Gemm{D, D, D}, S, E);
        SEAM(6);
    }
    if (IN(7)) {
        pg8::StaticOrder S; S.init(ws + WS_YB, ws + WS_PB, M, D, 512, 512, c.G, bx);
        pg8::EpiGateB E{(const bf16_t*)(ws + WS_PROJ), (const float*)(ws + WS_TMP), (bf16_t*)(ws + WS_MERGED)};
        pg8::gemm_phase<pg8::EpiGateB, pg8::StaticOrder>(lds, pg8::Gemm{512, 512, 512}, S, E);
        SEAM(7);
    }
    if (IN(8)) {
        pg8::StaticOrder S; S.init(ws + WS_MERGED, ws + WS_WOUT, M, D, D, D, c.G, bx);
        pg8::EpiF32 E{(float*)(ws + WS_T1), D, nullptr, 0, p.in[I_X], DN_ALPHA};
        pg8::gemm_phase<pg8::EpiF32, pg8::StaticOrder>(lds, pg8::Gemm{D, D, D}, S, E);
        SEAM(8);
    }
    if (IN(9)) { ln_rows(c, (const float*)(ws + WS_T1), p.in[I_LN1G], p.in[I_LN1B], (float*)(ws + WS_X1), (bf16_t*)(ws + WS_X1B)); SEAM(9); }

    if (IN(10)) {
        pg8::StaticOrder S; S.init(ws + WS_X1B, ws + WS_WQ, M, D, D, D, c.G, bx);
        pg8::EpiBf16 E{(bf16_t*)(ws + WS_Q), D, 0.04419417382415922f};
        pg8::gemm_phase<pg8::EpiBf16, pg8::StaticOrder>(lds, pg8::Gemm{D, D, D}, S, E);
        SEAM(10);
    }
    if (IN(11)) {
        ScoreOrder S{(const char*)(ws + WS_Q), (const char*)(ws + WS_KB), c.G, bx};
        pg8::EpiSoftmax E{(bf16_t*)(ws + WS_PP)};
        pg8::gemm_phase<pg8::EpiSoftmax, ScoreOrder, false>(lds, pg8::Gemm{512, D, D}, S, E);
        SEAM(11);
    }
    if (IN(12)) {
        PvOrder S{(const char*)(ws + WS_PP), (const char*)(ws + WS_VT), c.G, bx};
        pg8::EpiBf16 E{(bf16_t*)(ws + WS_OC), D, 1.0f};
        pg8::gemm_phase<pg8::EpiBf16, PvOrder>(lds, pg8::Gemm{256, 256, 256}, S, E);
        SEAM(12);
    }
    if (IN(13)) {
        pg8::StaticOrder S; S.init(ws + WS_OC, ws + WS_WO, M, D, D, D, c.G, bx);
        pg8::EpiF32 E{(float*)(ws + WS_T2), D, nullptr, 0, (const float*)(ws + WS_X1), DN_ALPHA};
        pg8::gemm_phase<pg8::EpiF32, pg8::StaticOrder>(lds, pg8::Gemm{D, D, D}, S, E);
        SEAM(13);
    }
    if (IN(14)) { ln_rows(c, (const float*)(ws + WS_T2), p.in[I_LN2G], p.in[I_LN2B], (float*)(ws + WS_X2), (bf16_t*)(ws + WS_X2B)); SEAM(14); }
    if (IN(15)) { p15_router(p, c); SEAM(15); }

    if (IN(16)) {
        moe_table(c, tab);
        MoeOrder<true, 16> S{tab, (const char*)(ws + WS_X2B), (const char*)(ws + WS_W1), (const int*)(ws + WS_LIST), (size_t)4096 * D * 2, D, c.G, bx};
        pg8::EpiSwiglu E{p.in[I_B1], (bf16_t*)(ws + WS_H)};
        pg8::gemm_phase<pg8::EpiSwiglu, MoeOrder<true, 16>>(lds, pg8::Gemm{D, D, D}, S, E);
        SEAM(16);
    }
    if (IN(17)) {
        moe_table(c, tab);
        MoeOrder<false, 8> S{tab, (const char*)(ws + WS_H), (const char*)(ws + WS_W2), (const int*)(ws + WS_LIST), (size_t)D * DFF * 2, DFF, c.G, bx};
        pg8::EpiF32 E{(float*)(ws + WS_Y), D, p.in[I_B2], D, nullptr, 0.f};
        pg8::gemm_phase<pg8::EpiF32, MoeOrder<false, 8>>(lds, pg8::Gemm{DFF, DFF, DFF}, S, E);
        SEAM(17);
    }
    if (IN(18)) { moe_table(c, tab); p18_combine(p, c, tab); }
#undef IN
#undef SEAM
}

extern "C" void kernel_launch(void* const* d_in, const int* in_sizes, int n_in, void* d_out, int out_size, void* d_ws, size_t ws_size, hipStream_t stream) {
    static int grid = 0;
    if (grid == 0) {
        if (n_in != 32 || out_size != M * D || ws_size < WS_END) { fprintf(stderr, "kernel_launch: expected 32 inputs, %d outputs, >= %zu bytes of workspace; got %d, %d, %zu\n", M * D, (size_t)WS_END, n_in, out_size, ws_size); grid = -1; return; }
        int dev = 0, cus = 0, per_cu = 0;
        if (hipGetDevice(&dev) != hipSuccess || hipDeviceGetAttribute(&cus, hipDeviceAttributeMultiprocessorCount, dev) != hipSuccess) { grid = -1; return; }
        if (hipFuncSetAttribute((const void*)fwd, hipFuncAttributeMaxDynamicSharedMemorySize, LDS_BYTES) != hipSuccess) { fprintf(stderr, "kernel_launch: hipFuncSetAttribute failed\n"); grid = -1; return; }
        if (hipOccupancyMaxActiveBlocksPerMultiprocessor(&per_cu, (const void*)fwd, 512, LDS_BYTES) != hipSuccess || per_cu < 1) fprintf(stderr, "kernel_launch: occupancy query reports %d\n", per_cu);
        (void)hipGetLastError();
        grid = cus;
        if (grid != 256) fprintf(stderr, "kernel_launch: %d CUs; this kernel is built for 256\n", grid);
    }
    if (grid < 0) return;
    (void)hipMemsetAsync((char*)d_ws + WS_CTL, 0, CTL_ZERO_BYTES, stream);
    Params p{};
    for (int i = 0; i < 32; ++i) p.in[i] = (const float*)d_in[i];
    p.out = (float*)d_out; p.ws = (unsigned char*)d_ws;
#if defined(TIMING_REPEAT_LO)
    { const int cuts[4][2] = {{0, TIMING_REPEAT_HI}, {TIMING_REPEAT_LO, TIMING_REPEAT_HI}, {TIMING_REPEAT_HI, NPHASE}, {0, 0}};
      for (int li = 0; li < 3; ++li) { if (cuts[li][0] >= cuts[li][1]) continue; p.ph_lo = cuts[li][0]; p.ph_hi = cuts[li][1]; p.li = li; hipLaunchKernelGGL(fwd, dim3(grid), dim3(512), LDS_BYTES, stream, p); } }
#else
    if (N_LAUNCH_MODE == 1) { p.ph_lo = 0; p.ph_hi = NPHASE; hipLaunchKernelGGL(fwd, dim3(grid), dim3(512), LDS_BYTES, stream, p); }
    else for (int k = 0; k < NPHASE; ++k) { p.ph_lo = k; p.ph_hi = k + 1; hipLaunchKernelGGL(fwd, dim3(grid), dim3(512), LDS_BYTES, stream, p); }
#endif
}
```

```cpp
#include <hip/hip_runtime.h>
#include <cstdio>
#include <cstdint>

#define LAS __attribute__((address_space(3)))
#define GAS __attribute__((address_space(1)))
typedef unsigned short bf16_t;
typedef short bf16x8 __attribute__((ext_vector_type(8)));
typedef float f32x4 __attribute__((ext_vector_type(4)));
typedef float f32x2 __attribute__((ext_vector_type(2)));
typedef float f32x16 __attribute__((ext_vector_type(16)));
typedef unsigned u32x4 __attribute__((ext_vector_type(4)));
typedef unsigned u32x2 __attribute__((ext_vector_type(2)));

#ifndef N_LAUNCH_MODE
#define N_LAUNCH_MODE 1
#endif

constexpr int M = 16384, D = 2048, SEQ = 4096, NBATCH = 4;
constexpr int RWC = 6592;
constexpr int PC = 15360;
constexpr int ATT0 = 6656, GATE0 = 11264;
constexpr int NEXP = 32, DFF = 2048, CAP = 16384;
constexpr int HROWS = 65536 + 32 * 256;
constexpr float LN_EPS = 1e-5f, GN_EPS = 64e-5f;
constexpr float DN_ALPHA = 1.189207115002721f;

__device__ __forceinline__ float bf2f(unsigned v) { return __uint_as_float(v << 16); }
__device__ __forceinline__ unsigned f2bf(float f) { unsigned u = __float_as_uint(f); return (u + 0x7fffu + ((u >> 16) & 1u)) >> 16; }
__device__ __forceinline__ unsigned pk2(float lo, float hi) { return f2bf(lo) | (f2bf(hi) << 16); }
__device__ __forceinline__ float sigmoidf_(float x) { return 1.0f / (1.0f + __expf(-x)); }
__device__ __forceinline__ float wave_sum(float v) {
#pragma unroll
    for (int o = 1; o < 64; o <<= 1) v += __shfl_xor(v, o);
    return v;
}
#define LDS_WAIT() asm volatile("s_waitcnt lgkmcnt(0)" ::: "memory")
#define VM_WAIT() asm volatile("s_waitcnt vmcnt(0)" ::: "memory")

namespace pg8 {
#define PG8_LAS __attribute__((address_space(3)))
constexpr int BM = 256, BK = 64, HALF = 128, HTB = HALF * BK * 2, STAGE_BYTES = 8 * HTB, NXCD = 8, WGM = 8;

__host__ __device__ __forceinline__ int lds_byte(int r, int c) { const int st = (r >> 4) * 2 + (c >> 5), rr = r & 15, cc = c & 31, ob = rr * 64 + cc * 2; return st * 1024 + (ob ^ (((ob >> 9) & 1) << 5)); }
__host__ __device__ __forceinline__ void stage_rc(int b, int& R, int& C) { const int st = b / 1024, sb = b % 1024, swz = sb ^ (((sb >> 9) & 1) << 5); R = (st >> 1) * 16 + swz / 64; C = (st & 1) * 32 + (swz % 64) / 2; }
__host__ __device__ __forceinline__ int perm32(int rho) { const int n = rho >> 4, i = rho & 15; return 8 * (i >> 2) + 4 * n + (i & 3); }

struct Unit { const char* A; const char* B; int orow, ocol, aux, aux2, valid; };
struct Gemm { int K, lda, ldb; };

struct StaticOrder {
    static constexpr bool GATHER = false;
    const char* A; const char* Bt; size_t ta, tb;
    int nM, nN, nwg, G, c;
    __device__ void init(const void* A_, const void* Bt_, int M_, int N_, int lda, int ldb, int G_, int c_) { A = (const char*)A_; Bt = (const char*)Bt_; ta = (size_t)BM * lda * 2; tb = (size_t)BM * ldb * 2; nM = M_ / BM; nN = N_ / BM; nwg = nM * nN; G = G_; c = c_; }
    __device__ bool next(int i, Unit& u) const {
        const long L = (long)i * G + c; if (c < 0 || L >= nwg) return false;
        int wgid = (int)L; { const int q = nwg / NXCD, r = nwg % NXCD, xcd = wgid % NXCD, off = wgid / NXCD; wgid = (xcd < r ? xcd * (q + 1) : r * (q + 1) + (xcd - r) * q) + off; }
        const int nig = WGM * nN, gid = wgid / nig, fm = gid * WGM, gsz = (nM - fm) < WGM ? (nM - fm) : WGM;
        const int pm = fm + ((wgid % nig) % gsz), pn = (wgid % nig) / gsz;
        u.A = A + (size_t)pm * ta; u.B = Bt + (size_t)pn * tb; u.orow = pm * BM; u.ocol = pn * BM; u.aux = 0; u.aux2 = 0; u.valid = BM; return true;
    }
    __device__ __forceinline__ const int* rows(const Unit&) const { return nullptr; }
};

__device__ __forceinline__ unsigned cvt_pk_bf16(float lo, float hi) { unsigned r; asm volatile("v_cvt_pk_bf16_f32 %0, %1, %2" : "=v"(r) : "v"(lo), "v"(hi)); return r; }

template <class Epi, class Sched, bool ALIGN_EPI = true>
__device__ __forceinline__ void gemm_phase(PG8_LAS unsigned char* lds, const Gemm g, const Sched& S, const Epi& E) {
    const int tid = threadIdx.x, wid = __builtin_amdgcn_readfirstlane(tid >> 6), lane = tid & 63, wr = wid >> 2, wc = wid & 3, fr = lane & 15, fq = lane >> 4;
    const int K = g.K, nt = K / BK;
    unsigned voffA[2], voffB[2]; int Rr[2], Cc[2];
#pragma unroll
    for (int i = 0; i < 2; ++i) { int R, C; stage_rc(tid * 16 + i * 8192, R, C); const int Rb = Epi::PERM ? ((R & ~31) + perm32(R & 31)) : R; Rr[i] = R; Cc[i] = C;
        voffA[i] = (unsigned)(R * g.lda + C) * 2u; voffB[i] = (unsigned)(Rb * g.ldb + C) * 2u; }
    const size_t kstep = (size_t)(BK * 2);
    const size_t hstepA = (size_t)HALF * g.lda * 2, hstepB = (size_t)HALF * g.ldb * 2;
    const unsigned ldsw = (unsigned)wid * 1024u;
    const int aoff = lds_byte(wr * 64 + fr, fq * 8), boff = lds_byte(wc * 32 + fr, fq * 8);
    unsigned vAc[2][2], vAn[2][2];
#define PG8_SA(b, h) (((b) * 2 + (h)) * HTB)
#define PG8_SB(b, h) ((4 + (b) * 2 + (h)) * HTB)
#define PG8_STAGE(bufoff, gbase, voff) do { _Pragma("unroll") for (int _i = 0; _i < 2; ++_i) \
        __builtin_amdgcn_global_load_lds((const unsigned*)((const char*)(gbase) + (voff)[_i]), (PG8_LAS unsigned*)(lds + (bufoff) + ldsw + _i * 8192), 16, 0, 0); } while (0)
#define PG8_STAGE_A(bufoff, kbase, h, nx) do { if constexpr (Sched::GATHER) { unsigned _v[2] = {(nx) ? vAn[h][0] : vAc[h][0], (nx) ? vAn[h][1] : vAc[h][1]}; PG8_STAGE(bufoff, kbase, _v); } \
        else { PG8_STAGE(bufoff, (kbase) + (h) * hstepA, voffA); } } while (0)
#define PG8_GOFF(u, v) do { const int* _rw = S.rows(u); _Pragma("unroll") for (int _h = 0; _h < 2; ++_h) _Pragma("unroll") for (int _i = 0; _i < 2; ++_i) { const int _r = Rr[_i] + _h * HALF; \
        const int _tk = _r < (u).valid ? _rw[_r] : 0; v[_h][_i] = (unsigned)(_tk * g.lda + Cc[_i]) * 2u; } } while (0)
#define PG8_LDA(dst, b, h) do { _Pragma("unroll") for (int m = 0; m < 4; ++m) _Pragma("unroll") for (int k = 0; k < 2; ++k) dst[m][k] = *(const PG8_LAS bf16x8*)(lds + PG8_SA(b, h) + aoff + m * 2048 + k * 1024); } while (0)
#define PG8_LDB(dst, b, h) do { _Pragma("unroll") for (int n = 0; n < 2; ++n) _Pragma("unroll") for (int k = 0; k < 2; ++k) dst[n][k] = *(const PG8_LAS bf16x8*)(lds + PG8_SB(b, h) + boff + n * 2048 + k * 1024); } while (0)
#define PG8_MMA(ai, bj, At, Bt) do { __builtin_amdgcn_s_setprio(1); _Pragma("unroll") for (int m = 0; m < 4; ++m) _Pragma("unroll") for (int n = 0; n < 2; ++n) _Pragma("unroll") for (int k = 0; k < 2; ++k) \
        acc[ai][bj][m][n] = __builtin_amdgcn_mfma_f32_16x16x32_bf16(Bt[n][k], At[m][k], acc[ai][bj][m][n], 0, 0, 0); __builtin_amdgcn_s_setprio(0); } while (0)
#define PG8_WAIT_V(n) asm volatile("s_waitcnt vmcnt(" #n ")" ::: "memory")
#define PG8_WAIT_L(n) asm volatile("s_waitcnt lgkmcnt(" #n ")" ::: "memory")
#define PG8_BAR __builtin_amdgcn_s_barrier()
#define PG8_SCHED __builtin_amdgcn_sched_barrier(0)
    Unit cur, nxt; int ui = 0;
    if (!S.next(0, cur)) return;
    f32x4 acc[2][2][4][2];
#pragma unroll
    for (int a = 0; a < 2; ++a)
#pragma unroll
        for (int b = 0; b < 2; ++b)
#pragma unroll
            for (int m = 0; m < 4; ++m)
#pragma unroll
                for (int n = 0; n < 2; ++n) acc[a][b][m][n] = (f32x4){0.f, 0.f, 0.f, 0.f};
    bf16x8 At[4][2], B0[2][2], B1[2][2];
    const char* cA = cur.A; const char* cB = cur.B;
    if constexpr (Sched::GATHER) { PG8_GOFF(cur, vAc); PG8_WAIT_V(0); }
    PG8_STAGE(PG8_SB(0, 0), cB, voffB); PG8_STAGE(PG8_SB(0, 1), cB + hstepB, voffB); PG8_STAGE_A(PG8_SA(0, 0), cA, 0, false); PG8_STAGE_A(PG8_SA(0, 1), cA, 1, false);
    if (wr == 1) PG8_BAR;
    PG8_WAIT_V(2); PG8_BAR;
    PG8_STAGE(PG8_SB(1, 0), cB + kstep, voffB); PG8_STAGE_A(PG8_SA(1, 0), cA + kstep, 0, false); PG8_STAGE(PG8_SB(1, 1), cB + hstepB + kstep, voffB);
    PG8_WAIT_V(6); PG8_BAR;
    for (;;) {
        const bool has_next = S.next(ui + 1, nxt);
        const char* nA = has_next ? nxt.A : cA; const char* nB = has_next ? nxt.B : cB;
        if constexpr (Sched::GATHER) { if (has_next) { PG8_GOFF(nxt, vAn); } else {
#pragma unroll
            for (int h = 0; h < 2; ++h)
#pragma unroll
                for (int i = 0; i < 2; ++i) vAn[h][i] = vAc[h][i]; } }
#pragma nounroll
        for (int t = 0; t < nt; t += 2) {
            const bool last = (t == nt - 2);
            const char* a1 = cA + (size_t)(t + 1) * kstep;
            const char* a2 = last ? nA : cA + (size_t)(t + 2) * kstep; const char* b2 = last ? nB : cB + (size_t)(t + 2) * kstep;
            const char* a3 = a2 + kstep; const char* b3 = b2 + kstep;
            PG8_LDB(B0, 0, 0); PG8_LDB(B1, 0, 1); PG8_SCHED; PG8_LDA(At, 0, 0); PG8_STAGE_A(PG8_SA(1, 1), a1, 1, false);
            PG8_WAIT_V(8); PG8_WAIT_L(0); PG8_BAR; PG8_MMA(0, 0, At, B0); PG8_MMA(0, 1, At, B1); PG8_BAR; PG8_SCHED;
            PG8_LDA(At, 0, 1); PG8_STAGE(PG8_SB(0, 0), b2, voffB); PG8_STAGE(PG8_SB(0, 1), b2 + hstepB, voffB); PG8_STAGE_A(PG8_SA(0, 0), a2, 0, last);
            PG8_WAIT_V(8); PG8_WAIT_L(0); PG8_BAR; PG8_MMA(1, 0, At, B0); PG8_MMA(1, 1, At, B1); PG8_BAR; PG8_SCHED;
            PG8_LDB(B0, 1, 0); PG8_LDB(B1, 1, 1); PG8_SCHED; PG8_LDA(At, 1, 0); PG8_STAGE_A(PG8_SA(0, 1), a2, 1, last);
            PG8_WAIT_V(8); PG8_WAIT_L(0); PG8_BAR; PG8_MMA(0, 0, At, B0); PG8_MMA(0, 1, At, B1); PG8_BAR; PG8_SCHED;
            PG8_LDA(At, 1, 1); PG8_STAGE(PG8_SB(1, 0), b3, voffB); PG8_STAGE(PG8_SB(1, 1), b3 + hstepB, voffB); PG8_STAGE_A(PG8_SA(1, 0), a3, 0, last);
            PG8_WAIT_V(8); PG8_WAIT_L(0); PG8_BAR; PG8_MMA(1, 0, At, B0); PG8_MMA(1, 1, At, B1); PG8_BAR; PG8_SCHED;
        }
        if constexpr (ALIGN_EPI) { if (wr == 0) PG8_BAR; }
        if constexpr (!Epi::AFTER_DRAIN) { E(acc, cur, wr, wc, fr, fq); }
        if (!has_next) break;
#pragma unroll
        for (int a = 0; a < 2; ++a)
#pragma unroll
            for (int b = 0; b < 2; ++b)
#pragma unroll
                for (int m = 0; m < 4; ++m)
#pragma unroll
                    for (int n = 0; n < 2; ++n) acc[a][b][m][n] = (f32x4){0.f, 0.f, 0.f, 0.f};
        cur = nxt; cA = nA; cB = nB; ++ui;
        if constexpr (Sched::GATHER) {
#pragma unroll
            for (int h = 0; h < 2; ++h)
#pragma unroll
                for (int i = 0; i < 2; ++i) vAc[h][i] = vAn[h][i]; }
        if constexpr (ALIGN_EPI) { if (wr == 1) PG8_BAR; }
    }
    PG8_WAIT_V(0);
    if constexpr (!ALIGN_EPI) { if (wr == 0) PG8_BAR; }
    PG8_BAR;
    if constexpr (Epi::AFTER_DRAIN) { E.fused(acc, cur, wr, wc, fr, fq, lds, wid, lane); }
#undef PG8_SA
#undef PG8_SB
#undef PG8_STAGE
#undef PG8_STAGE_A
#undef PG8_GOFF
#undef PG8_LDA
#undef PG8_LDB
#undef PG8_MMA
#undef PG8_WAIT_V
#undef PG8_WAIT_L
#undef PG8_BAR
#undef PG8_SCHED
}

#define EPI_LOOP_AI_M for (int ai = 0; ai < 2; ++ai) _Pragma("unroll") for (int m = 0; m < 4; ++m)

struct EpiF32 {
    static constexpr bool PERM = false, AFTER_DRAIN = false;
    float* C; int ldc; const float* bias; int bstride; const float* res; float alpha;
    __device__ __forceinline__ void operator()(const f32x4 (&acc)[2][2][4][2], const Unit& u, int wr, int wc, int fr, int fq) const {
        const int row0 = u.orow + wr * 64 + fr, col0 = u.ocol + wc * 32 + 4 * fq;
        f32x4 bv[2][2];
#pragma unroll
        for (int bj = 0; bj < 2; ++bj)
#pragma unroll
            for (int n = 0; n < 2; ++n) bv[bj][n] = bias ? *(const f32x4*)(bias + (size_t)u.aux * bstride + col0 + bj * HALF + n * 16) : (f32x4){0.f, 0.f, 0.f, 0.f};
#pragma unroll
        EPI_LOOP_AI_M { const size_t off = (size_t)(row0 + ai * HALF + m * 16) * ldc + col0;
#pragma unroll
            for (int bj = 0; bj < 2; ++bj)
#pragma unroll
                for (int n = 0; n < 2; ++n) { f32x4 v = acc[ai][bj][m][n] + bv[bj][n];
                    if (res) { const f32x4 rv = *(const f32x4*)(res + off + bj * HALF + n * 16); v = v + rv * alpha; }
                    *(f32x4*)(C + off + bj * HALF + n * 16) = v; }
            asm volatile("" ::: "memory"); }
    }
};
struct EpiBf16 {
    static constexpr bool PERM = true, AFTER_DRAIN = false;
    bf16_t* O; int ldc; float scale;
    __device__ __forceinline__ void operator()(const f32x4 (&acc)[2][2][4][2], const Unit& u, int wr, int wc, int fr, int fq) const {
        const int row0 = u.orow + wr * 64 + fr, col0 = u.ocol + wc * 32 + 8 * fq;
#pragma unroll
        EPI_LOOP_AI_M { bf16_t* rowp = O + (size_t)(row0 + ai * HALF + m * 16) * ldc + col0;
#pragma unroll
            for (int bj = 0; bj < 2; ++bj) { const f32x4 v0 = acc[ai][bj][m][0] * scale, v1 = acc[ai][bj][m][1] * scale;
                u32x4 w; w.x = cvt_pk_bf16(v0[0], v0[1]); w.y = cvt_pk_bf16(v0[2], v0[3]); w.z = cvt_pk_bf16(v1[0], v1[1]); w.w = cvt_pk_bf16(v1[2], v1[3]);
                *(u32x4*)(rowp + bj * HALF) = w; } }
    }
};
struct EpiKV {
    static constexpr bool PERM = true, AFTER_DRAIN = false;
    bf16_t* KB; bf16_t* VT;
    __device__ __forceinline__ void operator()(const f32x4 (&acc)[2][2][4][2], const Unit& u, int wr, int wc, int fr, int fq) const {
        const int row0 = u.orow + wr * 64 + fr, col0 = u.ocol + wc * 32 + 8 * fq;
#pragma unroll
        EPI_LOOP_AI_M { const int row = row0 + ai * HALF + m * 16;
#pragma unroll
            for (int bj = 0; bj < 2; ++bj) { const f32x4 v0 = acc[ai][bj][m][0], v1 = acc[ai][bj][m][1]; const int col = col0 + bj * HALF;
                if (u.ocol < 2048) { u32x4 w; w.x = cvt_pk_bf16(v0[0], v0[1]); w.y = cvt_pk_bf16(v0[2], v0[3]); w.z = cvt_pk_bf16(v1[0], v1[1]); w.w = cvt_pk_bf16(v1[2], v1[3]);
                    *(u32x4*)(KB + (size_t)row * 2048 + col) = w; }
                else { const int b = row >> 8, key = row & 255, c = col - 2048, h = c >> 9, d = c & 511; bf16_t* p = VT + ((size_t)((b * 4 + h) * 512 + d)) * 256 + key;
#pragma unroll
                    for (int j = 0; j < 4; ++j) { p[(size_t)j * 256] = (bf16_t)f2bf(v0[j]); p[(size_t)(4 + j) * 256] = (bf16_t)f2bf(v1[j]); } } } }
    }
};
struct EpiDecay {
    static constexpr bool PERM = false, AFTER_DRAIN = false;
    float* DEC; const float* w0;
    __device__ __forceinline__ void operator()(const f32x4 (&acc)[2][2][4][2], const Unit& u, int wr, int wc, int fr, int fq) const {
        const int row0 = u.orow + wr * 64 + fr, col0 = u.ocol + wc * 32 + 4 * fq;
        f32x4 bv[2][2];
#pragma unroll
        for (int bj = 0; bj < 2; ++bj)
#pragma unroll
            for (int n = 0; n < 2; ++n) bv[bj][n] = *(const f32x4*)(w0 + col0 + bj * HALF + n * 16);
#pragma unroll
        EPI_LOOP_AI_M { const size_t off = (size_t)(row0 + ai * HALF + m * 16) * D + col0;
#pragma unroll
            for (int bj = 0; bj < 2; ++bj)
#pragma unroll
                for (int n = 0; n < 2; ++n) { const f32x4 x = acc[ai][bj][m][n] + bv[bj][n]; f32x4 o;
#pragma unroll
                    for (int j = 0; j < 4; ++j) o[j] = __expf(-0.6065306597126334f * sigmoidf_(x[j]));
                    *(f32x4*)(DEC + off + bj * HALF + n * 16) = o; } }
    }
};
struct EpiIclr {
    static constexpr bool PERM = false, AFTER_DRAIN = false;
    const float* a0; const float* k_k; const float* k_a; const float* KZ; const float* KNORM; float* KP; float* AN; float* BB;
    __device__ __forceinline__ void operator()(const f32x4 (&acc)[2][2][4][2], const Unit& u, int wr, int wc, int fr, int fq) const {
        const int row0 = u.orow + wr * 64 + fr, col0 = u.ocol + wc * 32 + 4 * fq;
#pragma unroll
        for (int bj = 0; bj < 2; ++bj)
#pragma unroll
            for (int n = 0; n < 2; ++n) { const int col = col0 + bj * HALF + n * 16;
                const f32x4 a0v = *(const f32x4*)(a0 + col), kkv = *(const f32x4*)(k_k + col), kav = *(const f32x4*)(k_a + col);
#pragma unroll
                EPI_LOOP_AI_M { const int row = row0 + ai * HALF + m * 16; const size_t off = (size_t)row * D + col;
                    const f32x4 kz = *(const f32x4*)(KZ + off); const float nr = KNORM[(size_t)row * 32 + (col >> 6)]; const float inv = 1.0f / fmaxf(nr, 1e-12f);
                    const f32x4 x = acc[ai][bj][m][n] + a0v; f32x4 kp, an, bb;
#pragma unroll
                    for (int j = 0; j < 4; ++j) { const float a = sigmoidf_(x[j]); const float kk = kz[j] * kkv[j] * inv; kp[j] = kz[j] * (1.0f + (a - 1.0f) * kav[j]); bb[j] = kk * a; an[j] = -kk; }
                    *(f32x4*)(KP + off) = kp; *(f32x4*)(AN + off) = an; *(f32x4*)(BB + off) = bb; }
                asm volatile("" ::: "memory"); }
    }
};
struct EpiGateA {
    static constexpr bool PERM = false, AFTER_DRAIN = false;
    const bf16_t* PROJ; float* TMP;
    __device__ __forceinline__ void operator()(const f32x4 (&acc)[2][2][4][2], const Unit& u, int wr, int wc, int fr, int fq) const {
        const int row0 = u.orow + wr * 64 + fr, col0 = u.ocol + wc * 32 + 4 * fq;
#pragma unroll
        EPI_LOOP_AI_M { const int row = row0 + ai * HALF + m * 16;
#pragma unroll
            for (int bj = 0; bj < 2; ++bj)
#pragma unroll
                for (int n = 0; n < 2; ++n) { const int col = col0 + bj * HALF + n * 16; const u32x2 gv = *(const u32x2*)(PROJ + (size_t)row * PC + GATE0 + col);
                    const f32x4 a = acc[ai][bj][m][n]; f32x4 o;
                    o[0] = a[0] * sigmoidf_(bf2f(gv.x & 0xffffu)); o[1] = a[1] * sigmoidf_(bf2f(gv.x >> 16)); o[2] = a[2] * sigmoidf_(bf2f(gv.y & 0xffffu)); o[3] = a[3] * sigmoidf_(bf2f(gv.y >> 16));
                    *(f32x4*)(TMP + (size_t)row * D + col) = o; } }
    }
};
struct EpiGateB {
    static constexpr bool PERM = true, AFTER_DRAIN = false;
    const bf16_t* PROJ; const float* TMP; bf16_t* MERGED;
    __device__ __forceinline__ void operator()(const f32x4 (&acc)[2][2][4][2], const Unit& u, int wr, int wc, int fr, int fq) const {
        const int row0 = u.orow + wr * 64 + fr, col0 = u.ocol + wc * 32 + 8 * fq;
#pragma unroll
        EPI_LOOP_AI_M { const int row = row0 + ai * HALF + m * 16;
#pragma unroll
            for (int bj = 0; bj < 2; ++bj) { const int col = col0 + bj * HALF; const u32x4 gv = *(const u32x4*)(PROJ + (size_t)row * PC + GATE0 + 2048 + col);
                const f32x4 t0 = *(const f32x4*)(TMP + (size_t)row * D + col), t1 = *(const f32x4*)(TMP + (size_t)row * D + col + 4);
                const f32x4 a0 = acc[ai][bj][m][0], a1 = acc[ai][bj][m][1]; f32x4 o0, o1;
                o0[0] = t0[0] + a0[0] * sigmoidf_(bf2f(gv.x & 0xffffu)); o0[1] = t0[1] + a0[1] * sigmoidf_(bf2f(gv.x >> 16)); o0[2] = t0[2] + a0[2] * sigmoidf_(bf2f(gv.y & 0xffffu)); o0[3] = t0[3] + a0[3] * sigmoidf_(bf2f(gv.y >> 16));
                o1[0] = t1[0] + a1[0] * sigmoidf_(bf2f(gv.z & 0xffffu)); o1[1] = t1[1] + a1[1] * sigmoidf_(bf2f(gv.z >> 16)); o1[2] = t1[2] + a1[2] * sigmoidf_(bf2f(gv.w & 0xffffu)); o1[3] = t1[3] + a1[3] * sigmoidf_(bf2f(gv.w >> 16));
                u32x4 w; w.x = cvt_pk_bf16(o0[0], o0[1]); w.y = cvt_pk_bf16(o0[2], o0[3]); w.z = cvt_pk_bf16(o1[0], o1[1]); w.w = cvt_pk_bf16(o1[2], o1[3]);
                *(u32x4*)(MERGED + (size_t)row * D + col) = w; }
            asm volatile("" ::: "memory"); }
    }
};
struct EpiSwiglu {
    static constexpr bool PERM = true, AFTER_DRAIN = false;
    const float* b1; bf16_t* H;
    __device__ __forceinline__ float sw(float g, float l) const { g = fminf(g, 7.0f); l = fminf(fmaxf(l, -7.0f), 7.0f); return g * sigmoidf_(1.702f * g) * (l + 1.0f); }
    __device__ __forceinline__ void operator()(const f32x4 (&acc)[2][2][4][2], const Unit& u, int wr, int wc, int fr, int fq) const {
        const int row0 = u.orow + wr * 64 + fr, col0 = u.ocol + wc * 32 + 8 * fq;
        f32x4 bv[2][2];
#pragma unroll
        for (int bj = 0; bj < 2; ++bj)
#pragma unroll
            for (int n = 0; n < 2; ++n) bv[bj][n] = *(const f32x4*)(b1 + (size_t)u.aux * 4096 + col0 + bj * HALF + 4 * n);
#pragma unroll
        EPI_LOOP_AI_M { const int row = row0 + ai * HALF + m * 16;
#pragma unroll
            for (int bj = 0; bj < 2; ++bj) { const f32x4 v0 = acc[ai][bj][m][0] + bv[bj][0], v1 = acc[ai][bj][m][1] + bv[bj][1];
                u32x2 w; w.x = cvt_pk_bf16(sw(v0[0], v0[1]), sw(v0[2], v0[3])); w.y = cvt_pk_bf16(sw(v1[0], v1[1]), sw(v1[2], v1[3]));
                *(u32x2*)(H + (size_t)row * DFF + ((col0 + bj * HALF) >> 1)) = w; } }
    }
};
struct EpiSoftmax {
    static constexpr bool PERM = true, AFTER_DRAIN = true;
    bf16_t* PP;
    __device__ __forceinline__ void fused(f32x4 (&acc)[2][2][4][2], const Unit& u, int wr, int wc, int fr, int fq, PG8_LAS unsigned char* lds, int wid, int lane) const {
        PG8_LAS float* P1 = (PG8_LAS float*)lds;
        PG8_LAS float* P2 = (PG8_LAS float*)(lds + 4096);
        float mx[2][4];
#pragma unroll
        EPI_LOOP_AI_M { float v = -3.0e38f;
#pragma unroll
            for (int bj = 0; bj < 2; ++bj)
#pragma unroll
                for (int n = 0; n < 2; ++n) { const f32x4 x = acc[ai][bj][m][n]; v = fmaxf(v, fmaxf(fmaxf(x[0], x[1]), fmaxf(x[2], x[3]))); }
            v = fmaxf(v, __shfl_xor(v, 16)); v = fmaxf(v, __shfl_xor(v, 32));
            if (fq == 0) P1[(ai * HALF + wr * 64 + m * 16 + fr) * 4 + wc] = v; }
        asm volatile("s_waitcnt lgkmcnt(0)" ::: "memory"); __builtin_amdgcn_s_barrier(); asm volatile("" ::: "memory");
#pragma unroll
        EPI_LOOP_AI_M { const f32x4 t = *(const PG8_LAS f32x4*)(P1 + (ai * HALF + wr * 64 + m * 16 + fr) * 4); mx[ai][m] = fmaxf(fmaxf(t[0], t[1]), fmaxf(t[2], t[3])); }
#pragma unroll
        EPI_LOOP_AI_M { float s = 0.f;
#pragma unroll
            for (int bj = 0; bj < 2; ++bj)
#pragma unroll
                for (int n = 0; n < 2; ++n) { f32x4 x = acc[ai][bj][m][n];
#pragma unroll
                    for (int j = 0; j < 4; ++j) { x[j] = __expf(x[j] - mx[ai][m]); s += x[j]; }
                    acc[ai][bj][m][n] = x; }
            s += __shfl_xor(s, 16); s += __shfl_xor(s, 32);
            if (fq == 0) P2[(ai * HALF + wr * 64 + m * 16 + fr) * 4 + wc] = s; }
        asm volatile("s_waitcnt lgkmcnt(0)" ::: "memory"); __builtin_amdgcn_s_barrier(); asm volatile("" ::: "memory");
        const int row0 = u.orow + wr * 64 + fr, col0 = wc * 32 + 8 * fq;
#pragma unroll
        EPI_LOOP_AI_M { const f32x4 t = *(const PG8_LAS f32x4*)(P2 + (ai * HALF + wr * 64 + m * 16 + fr) * 4); const float inv = 1.0f / ((t[0] + t[1]) + (t[2] + t[3]));
            bf16_t* rowp = PP + (size_t)(row0 + ai * HALF + m * 16) * 256 + col0;
#pragma unroll
            for (int bj = 0; bj < 2; ++bj) { const f32x4 v0 = acc[ai][bj][m][0] * inv, v1 = acc[ai][bj][m][1] * inv;
                u32x4 w; w.x = cvt_pk_bf16(v0[0], v0[1]); w.y = cvt_pk_bf16(v0[2], v0[3]); w.z = cvt_pk_bf16(v1[0], v1[1]); w.w = cvt_pk_bf16(v1[2], v1[3]);
                *(u32x4*)(rowp + bj * HALF) = w; } }
        asm volatile("s_waitcnt lgkmcnt(0)" ::: "memory"); __builtin_amdgcn_s_barrier(); asm volatile("" ::: "memory");
    }
};
}

constexpr size_t MiB = 1u << 20;
constexpr size_t al256(size_t x) { return (x + 255) & ~(size_t)255; }
constexpr size_t WS_CTL = 0, CTL_ZERO_BYTES = 1 * MiB;
constexpr size_t WS_WIN = 1 * MiB;
constexpr size_t WS_WUP = WS_WIN + (size_t)PC * D * 2;
constexpr size_t WS_AUP = WS_WUP + (size_t)D * 256 * 2;
constexpr size_t WS_GUP = WS_AUP + (size_t)D * 256 * 2;
constexpr size_t WS_PA = WS_GUP + (size_t)D * 256 * 2;
constexpr size_t WS_PB = WS_PA + (size_t)D * D * 2;
constexpr size_t WS_WOUT = WS_PB + (size_t)D * 512 * 2;
constexpr size_t WS_WQ = WS_WOUT + (size_t)D * D * 2;
constexpr size_t WS_WKV = WS_WQ + (size_t)D * D * 2;
constexpr size_t WS_WO = WS_WKV + (size_t)2 * D * D * 2;
constexpr size_t WS_W1 = WS_WO + (size_t)D * D * 2;
constexpr size_t WS_W2 = WS_W1 + (size_t)NEXP * 4096 * D * 2;
constexpr size_t WS_XB = WS_W2 + (size_t)NEXP * D * DFF * 2;
constexpr size_t WS_MEMB = WS_XB + (size_t)M * D * 2;
constexpr size_t WS_ROT = WS_MEMB + (size_t)1024 * D * 2;
constexpr size_t WS_KB = WS_ROT + (size_t)2 * SEQ * 32 * 4;
constexpr size_t WS_VT = WS_KB + (size_t)1024 * D * 2;
constexpr size_t WS_YA = WS_VT + (size_t)1024 * D * 2;
constexpr size_t WS_YB = WS_YA + (size_t)M * D * 2;
constexpr size_t WS_TMP = WS_YB + (size_t)M * 512 * 2;
constexpr size_t WS_MERGED = WS_TMP + (size_t)M * D * 4;
constexpr size_t WS_E = WS_MERGED + (size_t)M * D * 2;
constexpr size_t WS_PROJ = WS_E;
constexpr size_t WS_RZ = WS_PROJ + (size_t)M * PC * 2;
constexpr size_t WS_KZ = WS_RZ + (size_t)M * D * 4;
constexpr size_t WS_VZ = WS_KZ + (size_t)M * D * 4;
constexpr size_t WS_DEC = WS_VZ + (size_t)M * D * 4;
constexpr size_t WS_KP = WS_DEC + (size_t)M * D * 4;
constexpr size_t WS_AN = WS_KP + (size_t)M * D * 4;
constexpr size_t WS_BB = WS_AN + (size_t)M * D * 4;
constexpr size_t WS_GG = WS_BB + (size_t)M * D * 4;
constexpr size_t WS_YS = WS_GG + (size_t)M * D * 4;
constexpr size_t WS_AO = WS_YS + (size_t)M * D * 4;
constexpr size_t WS_LSE = WS_AO + (size_t)3 * M * 512 * 4;
constexpr size_t WS_QR = WS_LSE + (size_t)3 * M * 8 * 4;
constexpr size_t WS_KR = WS_QR + (size_t)M * 1536 * 2;
constexpr size_t WS_LIN = WS_KR + (size_t)M * 1536 * 2;
constexpr size_t WS_KNORM = WS_LIN + (size_t)M * 768 * 2;
constexpr size_t WS_F = WS_KNORM + (size_t)M * 32 * 4;
constexpr size_t WS_E_END = WS_F + (size_t)128 * 128 * 96 * 96 * 2;
constexpr size_t WS_T1 = WS_E;
constexpr size_t WS_X1 = WS_T1 + (size_t)M * D * 4;
constexpr size_t WS_X1B = WS_X1 + (size_t)M * D * 4;
constexpr size_t WS_Q = WS_X1B + (size_t)M * D * 2;
constexpr size_t WS_PP = WS_Q + (size_t)M * D * 2;
constexpr size_t WS_OC = WS_PP + (size_t)16 * SEQ * 256 * 2;
constexpr size_t WS_T2 = WS_OC + (size_t)M * D * 2;
constexpr size_t WS_X2 = WS_T2 + (size_t)M * D * 4;
constexpr size_t WS_X2B = WS_X2 + (size_t)M * D * 4;
constexpr size_t WS_LIST = WS_X2B + (size_t)M * D * 2;
constexpr size_t WS_ROWI = WS_LIST + (size_t)NEXP * CAP * 4;
constexpr size_t WS_TOPW = WS_ROWI + (size_t)M * 4 * 4;
constexpr size_t WS_H = WS_TOPW + (size_t)M * 4 * 4;
constexpr size_t WS_Y = WS_H + (size_t)HROWS * DFF * 2;
constexpr size_t WS_L_END = WS_Y + (size_t)HROWS * D * 4;
constexpr size_t WS_END = (WS_E_END > WS_L_END ? WS_E_END : WS_L_END);
static_assert(WS_END <= (size_t)4090 * MiB, "workspace map exceeds 4 x largest input");
constexpr int CW_TMO = 0, CW_CNT = 64  , CW_Q = 128  , CW_BAR = 4096;

constexpr int RING_BYTES = 131072, MISC_OFF = RING_BYTES, LDS_BYTES = 147456;

#define XB_TMO      128
#define XB_XCNT(j)  (256  + 64 * (j))
#define XB_XSUB(j)  (1280 + 64 * (j))
#define XB_XGEN(j)  (2304 + 64 * (j))
#define XB_TOP      3328
#define XB_TOPGEN   3392
#define XCD_BAR_WORDS 3456
#define XB_SPIN_CAP (1u << 18)
__device__ __forceinline__ unsigned xb_ld(unsigned* p)              { return __hip_atomic_load(p, __ATOMIC_RELAXED, __HIP_MEMORY_SCOPE_AGENT); }
__device__ __forceinline__ unsigned xb_add(unsigned* p, unsigned v) { return __hip_atomic_fetch_add(p, v, __ATOMIC_RELAXED, __HIP_MEMORY_SCOPE_AGENT); }
__device__ __forceinline__ unsigned xb_xcc_id() { return (unsigned)__builtin_amdgcn_s_getreg((3 << 11) | 20) & 0xFu; }
#define XB_SPIN(cond, bar) do { unsigned _sp = 0; while (cond) { __builtin_amdgcn_s_sleep(1); \
    if ((++_sp & 255u) == 0u) { if (xb_ld(&(bar)[XB_TMO])) break; if (_sp > XB_SPIN_CAP) { atomicAdd(&(bar)[XB_TMO], 1u); break; } } } } while (0)
struct XcdBarrier { unsigned* bar; unsigned x; volatile LAS unsigned* st; };
__device__ __forceinline__ XcdBarrier xcd_barrier_post(unsigned* bar, volatile LAS unsigned* st) {
    XcdBarrier b; b.bar = bar; b.x = xb_xcc_id(); b.st = st;
    if (threadIdx.x == 0) (void)xb_add(&bar[XB_XCNT(b.x)], 1u);
    return b;
}
__device__ __forceinline__ void xcd_barrier_complete(unsigned* bar, unsigned x, unsigned& nloc, unsigned& nx) {
    const unsigned G = gridDim.x * gridDim.y * gridDim.z;
    unsigned sum, cnt, mine, sp = 0u;
    for (;;) {
        sum = 0u; cnt = 0u; mine = 0u;
#pragma unroll
        for (unsigned j = 0; j < 16; ++j) { const unsigned c = xb_ld(&bar[XB_XCNT(j)]); sum += c; cnt += (c > 0u) ? 1u : 0u; mine = (j == x) ? c : mine; }
        if (sum == G) break;
        __builtin_amdgcn_s_sleep(1);
        if ((++sp & 255u) == 0u) { if (xb_ld(&bar[XB_TMO])) break; if (sp > XB_SPIN_CAP) { atomicAdd(&bar[XB_TMO], 1u); break; } }
    }
    nloc = mine > 0u ? mine : 1u; nx = cnt > 0u ? cnt : 1u;
}
__device__ __forceinline__ void xcd_barrier(const XcdBarrier& b) {
    asm volatile("s_waitcnt vmcnt(0)" ::: "memory");
    __syncthreads();
    if (threadIdx.x == 0) {
        unsigned* bar = b.bar;
        __builtin_amdgcn_s_waitcnt(0);
        unsigned nloc = b.st[0], nx = b.st[1];
        if (nloc == 0u) { xcd_barrier_complete(bar, b.x, nloc, nx); b.st[0] = nloc; b.st[1] = nx; }
        const unsigned old = xb_add(&bar[XB_XSUB(b.x)], 1u);
        const unsigned gen = old / nloc;
        if (old + 1u == (gen + 1u) * nloc) {
            __builtin_amdgcn_fence(__ATOMIC_RELEASE, "agent");
            asm volatile("s_waitcnt vmcnt(0)" ::: "memory");
            const unsigned og = xb_add(&bar[XB_TOP], 1u);
            const unsigned tg = og / nx;
            if (og + 1u == (tg + 1u) * nx) xb_add(&bar[XB_TOPGEN], 1u);
            else XB_SPIN(xb_ld(&bar[XB_TOPGEN]) == tg, bar);
            __builtin_amdgcn_fence(__ATOMIC_ACQUIRE, "agent");
            xb_add(&bar[XB_XGEN(b.x)], 1u);
            asm volatile("s_waitcnt vmcnt(0)" ::: "memory");
        } else {
            XB_SPIN(xb_ld(&bar[XB_XGEN(b.x)]) == gen, bar);
            __builtin_amdgcn_fence(__ATOMIC_ACQUIRE, "agent");
            asm volatile("s_waitcnt vmcnt(0)" ::: "memory");
        }
    }
    __syncthreads();
}

struct Params {
    const float* in[32];
    float* out; unsigned char* ws;
    int ph_lo, ph_hi, li, pad;
};
enum { I_X = 0, I_MEM, I_WIN, I_MIX, I_W0, I_WUP, I_A0, I_AUP, I_GUP, I_KK, I_KA, I_RK, I_LNXG, I_LNXB, I_PA, I_PB, I_WOUT, I_LN1G, I_LN1B, I_WQ, I_WKV, I_WO, I_LN2G, I_LN2B,
       I_RW, I_RB, I_W1, I_B1, I_W2, I_B2, I_LN3G, I_LN3B };

struct ScoreOrder {
    static constexpr bool GATHER = false;
    const char* Q; const char* KB; int G, c;
    __device__ bool next(int i, pg8::Unit& u) const {
        const int L = i * G + c; if (L >= 256) return false;
        const int bh = L >> 4, pm = L & 15, b = bh >> 2, h = bh & 3;
        u.A = Q + ((size_t)(b * SEQ + 256 * pm) * D + h * 512) * 2; u.B = KB + ((size_t)(b * 256) * D + h * 512) * 2;
        u.orow = bh * SEQ + 256 * pm; u.ocol = 0; u.aux = 0; u.aux2 = 0; u.valid = 256; return true;
    }
    __device__ __forceinline__ const int* rows(const pg8::Unit&) const { return nullptr; }
};
struct PvOrder {
    static constexpr bool GATHER = false;
    const char* PP; const char* VT; int G, c;
    __device__ bool next(int i, pg8::Unit& u) const {
        const int L = i * G + c; if (L >= 512) return false;
        const int bh = L >> 5, pm = (L >> 1) & 15, pn = L & 1, b = bh >> 2, h = bh & 3;
        u.A = PP + ((size_t)(bh * SEQ + 256 * pm) * 256) * 2; u.B = VT + ((size_t)(bh * 512 + 256 * pn) * 256) * 2;
        u.orow = b * SEQ + 256 * pm; u.ocol = h * 512 + 256 * pn; u.aux = 0; u.aux2 = 0; u.valid = 256; return true;
    }
    __device__ __forceinline__ const int* rows(const pg8::Unit&) const { return nullptr; }
};
template <bool GATHER_, int NT  > struct MoeOrder {
    static constexpr bool GATHER = GATHER_;
    const LAS int* tab; const char* A; const char* W; const int* list; size_t wexp  ; int ldb; int G, c;
    __device__ bool next(int i, pg8::Unit& u) const {
        constexpr int RPR = 256 / NT;
        const int rt = i * RPR + (c % RPR), pn = c / RPR, T = tab[64];
        if (c >= 256 || rt >= T) return false;
        int e = 0;
        for (int j = 1; j < NEXP; ++j) e = (rt >= tab[32 + j]) ? j : e;
        const int lt = rt - tab[32 + e];
        u.aux = e; u.aux2 = lt; u.valid = min(256, tab[e] - 256 * lt); u.orow = 256 * rt; u.ocol = 256 * pn;
        u.B = W + (size_t)e * wexp + (size_t)(256 * pn) * ldb * 2;
        u.A = GATHER_ ? A : A + (size_t)(256 * rt) * DFF * 2;
        return true;
    }
    __device__ __forceinline__ const int* rows(const pg8::Unit& u) const { return list + (size_t)u.aux * CAP + 256 * u.aux2; }
};

struct Ctx { int tid, lane, wave, vcu, G; LAS unsigned char* lds; unsigned char* ws; };

__device__ __forceinline__ void tr_item(const float* W, int ldw, int Ksrc, int sc0, bf16_t* WT, int ldt, int n0, int k0, LAS float* scr, int lane) {
#pragma unroll 8
    for (int i = 0; i < 32; ++i) { const int kk = 2 * i + (lane >> 5); float v = 0.f; if (sc0 >= 0 && (k0 + kk) < Ksrc) v = W[(size_t)(k0 + kk) * ldw + sc0 + (lane & 31)]; scr[kk * 33 + (lane & 31)] = v; }
    LDS_WAIT(); asm volatile("" ::: "memory");
    const int c = lane & 7;
#pragma unroll
    for (int j = 0; j < 4; ++j) { const int n = (lane >> 3) + 8 * j; const LAS float* s = scr + (8 * c) * 33 + n;
        u32x4 o; o.x = pk2(s[0 * 33], s[1 * 33]); o.y = pk2(s[2 * 33], s[3 * 33]); o.z = pk2(s[4 * 33], s[5 * 33]); o.w = pk2(s[6 * 33], s[7 * 33]);
        *(u32x4*)(WT + (size_t)(n0 + n) * ldt + k0 + 8 * c) = o; }
    LDS_WAIT(); asm volatile("" ::: "memory");
}
__device__ __forceinline__ void tr_job(const float* W, int N, int Ksrc, int Kdst, bf16_t* WT, int item, LAS float* scr, int lane) {
    const int nblk = N / 32, kb = item / nblk, nb = item % nblk;
    tr_item(W, N, Ksrc, 32 * nb, WT, Kdst, 32 * nb, 64 * kb, scr, lane);
}
__device__ __forceinline__ void p0_prologue(const Params& p, const Ctx& c) {
    LAS float* scr = (LAS float*)(c.lds + c.wave * 16384);
    const int gw = c.vcu * 8 + c.wave, NGW = c.G * 8;
    unsigned char* ws = c.ws;
    constexpr int I_WINJ = 32 * 480, I_LORA = 4 * 64, I_SQ = 32 * 64, I_PBJ = 8 * 64, I_KVJ = 32 * 128, I_W1E = 32 * 128, I_W2E = 32 * 64;
    constexpr int NITEMS = I_WINJ + 3 * I_LORA + 4 * I_SQ + I_PBJ + I_KVJ;
    for (int it = gw; it < NITEMS; it += NGW) {
        int r = it;
        if (r < I_WINJ) { const int kb = r / 480, nb = r % 480; const int sc0 = nb < 206 ? 32 * nb : (nb < 208 ? -1 : 32 * nb - 64);
            tr_item(p.in[I_WIN], 15296, D, sc0, (bf16_t*)(ws + WS_WIN), D, 32 * nb, 64 * kb, scr, c.lane); continue; } r -= I_WINJ;
        if (r < I_LORA) { tr_job(p.in[I_WUP], D, 96, 256, (bf16_t*)(ws + WS_WUP), r, scr, c.lane); continue; } r -= I_LORA;
        if (r < I_LORA) { tr_job(p.in[I_AUP], D, 96, 256, (bf16_t*)(ws + WS_AUP), r, scr, c.lane); continue; } r -= I_LORA;
        if (r < I_LORA) { tr_job(p.in[I_GUP], D, 256, 256, (bf16_t*)(ws + WS_GUP), r, scr, c.lane); continue; } r -= I_LORA;
        if (r < I_SQ) { tr_job(p.in[I_PA], D, D, D, (bf16_t*)(ws + WS_PA), r, scr, c.lane); continue; } r -= I_SQ;
        if (r < I_PBJ) { tr_job(p.in[I_PB], D, 512, 512, (bf16_t*)(ws + WS_PB), r, scr, c.lane); continue; } r -= I_PBJ;
        if (r < I_SQ) { tr_job(p.in[I_WOUT], D, D, D, (bf16_t*)(ws + WS_WOUT), r, scr, c.lane); continue; } r -= I_SQ;
        if (r < I_SQ) { tr_job(p.in[I_WQ], D, D, D, (bf16_t*)(ws + WS_WQ), r, scr, c.lane); continue; } r -= I_SQ;
        if (r < I_KVJ) { tr_job(p.in[I_WKV], 2 * D, D, D, (bf16_t*)(ws + WS_WKV), r, scr, c.lane); continue; } r -= I_KVJ;
        { tr_job(p.in[I_WO], D, D, D, (bf16_t*)(ws + WS_WO), r, scr, c.lane); }
    }
    const size_t gt = (size_t)c.vcu * 512 + c.tid, NT = (size_t)c.G * 512;
    for (size_t i = gt; i < (size_t)M * D / 8; i += NT) { const f32x4 a = ((const f32x4*)p.in[I_X])[2 * i], b = ((const f32x4*)p.in[I_X])[2 * i + 1];
        u32x4 o; o.x = pk2(a[0], a[1]); o.y = pk2(a[2], a[3]); o.z = pk2(b[0], b[1]); o.w = pk2(b[2], b[3]); ((u32x4*)(ws + WS_XB))[i] = o; }
    for (size_t i = gt; i < (size_t)1024 * D / 8; i += NT) { const f32x4 a = ((const f32x4*)p.in[I_MEM])[2 * i], b = ((const f32x4*)p.in[I_MEM])[2 * i + 1];
        u32x4 o; o.x = pk2(a[0], a[1]); o.y = pk2(a[2], a[3]); o.z = pk2(b[0], b[1]); o.w = pk2(b[2], b[3]); ((u32x4*)(ws + WS_MEMB))[i] = o; }
    float* rc = (float*)(ws + WS_ROT); float* rs = rc + SEQ * 32;
    for (size_t i = gt; i < (size_t)SEQ * 32; i += NT) { const int pos = (int)(i >> 5), j = (int)(i & 31);
        const double inv = exp(-(double)j * (9.210340371976184 / 32.0)); const double ang = (double)pos * inv; rc[i] = (float)cos(ang); rs[i] = (float)sin(ang); }
}

__device__ __forceinline__ void tr_issue(const float* W, int ldw, int n0, int k0, int lane, float (&cv)[32]) {
#pragma unroll
    for (int i = 0; i < 32; ++i) cv[i] = W[(size_t)(k0 + 2 * i + (lane >> 5)) * ldw + n0 + (lane & 31)];
}
__device__ __forceinline__ void tr_finish(const float (&cv)[32], bf16_t* WT, int ldt, int n0, int k0, LAS float* scr, int lane) {
#pragma unroll
    for (int i = 0; i < 32; ++i) scr[(2 * i + (lane >> 5)) * 33 + (lane & 31)] = cv[i];
    LDS_WAIT(); asm volatile("" ::: "memory");
    const int c = lane & 7;
#pragma unroll
    for (int j = 0; j < 4; ++j) { const int n = (lane >> 3) + 8 * j; const LAS float* sp = scr + (8 * c) * 33 + n;
        u32x4 o; o.x = pk2(sp[0 * 33], sp[1 * 33]); o.y = pk2(sp[2 * 33], sp[3 * 33]); o.z = pk2(sp[4 * 33], sp[5 * 33]); o.w = pk2(sp[6 * 33], sp[7 * 33]);
        *(u32x4*)(WT + (size_t)(n0 + n) * ldt + k0 + 8 * c) = o; }
    LDS_WAIT(); asm volatile("" ::: "memory");
}
constexpr int MOE_W1E = 32 * 128, MOE_W2E = 32 * 64, MOE_CONV_GROUPS = (NEXP * MOE_W2E) / 8;
__device__ __forceinline__ void conv_group(const Params& p, const Ctx& c, int gi) {
    LAS float* scr = (LAS float*)(c.lds + c.wave * 16384);
    unsigned char* ws = c.ws;
    const int r = gi * 8 + c.wave;
    { const int e = r / MOE_W2E; tr_job(p.in[I_W2] + (size_t)e * DFF * D, D, DFF, DFF, (bf16_t*)(ws + WS_W2) + (size_t)e * D * DFF, r % MOE_W2E, scr, c.lane); }
}

__device__ __forceinline__ void p2_prep(const Params& p, const Ctx& c) {
    unsigned char* ws = c.ws;
    const bf16_t* PROJ = (const bf16_t*)(ws + WS_PROJ);
    const float* mix = p.in[I_MIX]; const float* k_k = p.in[I_KK];
    float* RZ = (float*)(ws + WS_RZ); float* KZ = (float*)(ws + WS_KZ); float* VZ = (float*)(ws + WS_VZ);
    bf16_t* LIN = (bf16_t*)(ws + WS_LIN); float* KNORM = (float*)(ws + WS_KNORM);
    bf16_t* QR = (bf16_t*)(ws + WS_QR); bf16_t* KR = (bf16_t*)(ws + WS_KR);
    const float* rc = (const float*)(ws + WS_ROT); const float* rs = rc + SEQ * 32;
    for (int t = c.vcu; t < M; t += c.G) {
        const int pos = t & (SEQ - 1);
        const bf16_t* cur = PROJ + (size_t)t * PC;
        for (int ch = c.tid; ch < 824; ch += 512) {
            const u32x4 cv = *(const u32x4*)(cur + 8 * ch); u32x4 pv = (u32x4){0u, 0u, 0u, 0u}; if (pos > 0) pv = *(const u32x4*)(cur - PC + 8 * ch);
            const f32x4 m0 = *(const f32x4*)(mix + 8 * ch), m1 = *(const f32x4*)(mix + 8 * ch + 4);
            float z[8];
            { const unsigned cw[4] = {cv.x, cv.y, cv.z, cv.w}, pw[4] = {pv.x, pv.y, pv.z, pv.w};
              const float mm[8] = {m0[0], m0[1], m0[2], m0[3], m1[0], m1[1], m1[2], m1[3]};
#pragma unroll
              for (int j = 0; j < 4; ++j) { const float c0 = bf2f(cw[j] & 0xffffu), c1 = bf2f(cw[j] >> 16), q0 = bf2f(pw[j] & 0xffffu), q1 = bf2f(pw[j] >> 16);
                  z[2 * j] = c0 + (q0 - c0) * mm[2 * j]; z[2 * j + 1] = c1 + (q1 - c1) * mm[2 * j + 1]; } }
            if (ch < 768) {
                float* dst = (ch < 256 ? RZ : (ch < 512 ? KZ : VZ)) + (size_t)t * D + 8 * (ch & 255);
                *(f32x4*)dst = (f32x4){z[0], z[1], z[2], z[3]}; *(f32x4*)(dst + 4) = (f32x4){z[4], z[5], z[6], z[7]};
                if (ch >= 256 && ch < 512) {
                    const int col = 8 * (ch - 256); const f32x4 k0 = *(const f32x4*)(k_k + col), k1 = *(const f32x4*)(k_k + col + 4);
                    float s = 0.f;
#pragma unroll
                    for (int j = 0; j < 4; ++j) { const float a = z[j] * k0[j], b = z[4 + j] * k1[j]; s += a * a + b * b; }
                    s += __shfl_xor(s, 1); s += __shfl_xor(s, 2); s += __shfl_xor(s, 4);
                    if ((ch & 7) == 0) KNORM[(size_t)t * 32 + ((ch - 256) >> 3)] = sqrtf(s);
                }
            } else {
                float o[8]; int dcol;
                if (ch < 780) { dcol = 8 * (ch - 768);
#pragma unroll
                    for (int j = 0; j < 8; ++j) o[j] = tanhf(z[j]); }
                else if (ch < 792) { dcol = 256 + 8 * (ch - 780);
#pragma unroll
                    for (int j = 0; j < 8; ++j) o[j] = z[j]; }
                else { dcol = 512 + 8 * (ch - 792);
#pragma unroll
                    for (int j = 0; j < 8; ++j) o[j] = sigmoidf_(z[j]); }
                u32x4 w; w.x = pk2(o[0], o[1]); w.y = pk2(o[2], o[3]); w.z = pk2(o[4], o[5]); w.w = pk2(o[6], o[7]);
                *(u32x4*)(LIN + (size_t)t * 768 + dcol) = w;
            }
        }
        if (c.tid < 40) { const int dcol = (c.tid < 20) ? 96 + 8 * c.tid : 352 + 8 * (c.tid - 20); *(u32x4*)(LIN + (size_t)t * 768 + dcol) = (u32x4){0u, 0u, 0u, 0u}; }
        if (c.tid >= 64 && c.tid < 64 + 192) { const int w = c.tid - 64, which = w / 96, hh = (w % 96) >> 2, e0 = (w & 3) * 8;
            const bf16_t* src = cur + ATT0 + which * 1536 + hh * 64 + e0;
            const u32x4 a = *(const u32x4*)src, b = *(const u32x4*)(src + 32);
            const f32x4 c0 = *(const f32x4*)(rc + pos * 32 + e0), c1 = *(const f32x4*)(rc + pos * 32 + e0 + 4), s0 = *(const f32x4*)(rs + pos * 32 + e0), s1 = *(const f32x4*)(rs + pos * 32 + e0 + 4);
            const unsigned aw[4] = {a.x, a.y, a.z, a.w}, bw[4] = {b.x, b.y, b.z, b.w}; float o1[8], o2[8];
#pragma unroll
            for (int j = 0; j < 8; ++j) { const float t1 = bf2f((aw[j >> 1] >> (16 * (j & 1))) & 0xffffu), t2 = bf2f((bw[j >> 1] >> (16 * (j & 1))) & 0xffffu);
                const float cs = j < 4 ? c0[j & 3] : c1[j & 3], sn = j < 4 ? s0[j & 3] : s1[j & 3]; o1[j] = t1 * cs - t2 * sn; o2[j] = t2 * cs + t1 * sn; }
            bf16_t* dst = (which ? KR : QR) + (size_t)t * 1536 + hh * 64 + e0;
            u32x4 w1; w1.x = pk2(o1[0], o1[1]); w1.y = pk2(o1[2], o1[3]); w1.z = pk2(o1[4], o1[5]); w1.w = pk2(o1[6], o1[7]);
            u32x4 w2; w2.x = pk2(o2[0], o2[1]); w2.y = pk2(o2[2], o2[3]); w2.z = pk2(o2[4], o2[5]); w2.w = pk2(o2[6], o2[7]);
            *(u32x4*)dst = w1; *(u32x4*)(dst + 32) = w2; }
    }
}

#define DPP_ADD(x, ctrl) ((x) + __builtin_bit_cast(float, __builtin_amdgcn_update_dpp(0, __builtin_bit_cast(int, (x)), (ctrl), 0xF, 0xF, true)))
__device__ __forceinline__ float wave_sum_dpp(float x) {
    x = DPP_ADD(x, 0xB1); x = DPP_ADD(x, 0x4E); x = DPP_ADD(x, 0x141); x = DPP_ADD(x, 0x140);
    const int xi = __builtin_bit_cast(int, x);
    return (__builtin_bit_cast(float, __builtin_amdgcn_readlane(xi, 0)) + __builtin_bit_cast(float, __builtin_amdgcn_readlane(xi, 16))) +
           (__builtin_bit_cast(float, __builtin_amdgcn_readlane(xi, 32)) + __builtin_bit_cast(float, __builtin_amdgcn_readlane(xi, 48)));
}
__device__ __forceinline__ f32x4 tile_mm(const LAS bf16_t* A, int pa, const LAS bf16_t* Bt, int pb, int ks, int fr, int fq, f32x4 acc) {
    for (int k = 0; k < ks; ++k) { const bf16x8 a = *(const LAS bf16x8*)(A + fr * pa + 32 * k + 8 * fq), b = *(const LAS bf16x8*)(Bt + fr * pb + 32 * k + 8 * fq);
        acc = __builtin_amdgcn_mfma_f32_16x16x32_bf16(a, b, acc, 0, 0, 0); }
    return acc;
}
__device__ __forceinline__ u32x2 pack4(f32x4 v) { u32x2 w; w.x = pk2(v[0], v[1]); w.y = pk2(v[2], v[3]); return w; }
constexpr int SC_C = 32, SC_NCH = SEQ / SC_C, SC_F = 96;
constexpr int PL_X1 = 0, PL_X2 = 9216, PL_AL = 18432, PL_HT = 26112, PL_ET = 33792, PL_LBT = 53760, PL_TT = 58368, PL_GI = 60928, PL_RAW = 68608, PL_TF = 109568, PL_XB = 114176, PL_END = 115264;
#define LBAR() do { asm volatile("s_waitcnt lgkmcnt(0)" ::: "memory"); __builtin_amdgcn_s_barrier(); asm volatile("" ::: "memory"); } while (0)
__device__ __forceinline__ void p4_pre(const Params& p, const Ctx& c) {
    unsigned char* ws = c.ws;
    const float* RZ = (const float*)(ws + WS_RZ); const float* DEC = (const float*)(ws + WS_DEC); const float* KP = (const float*)(ws + WS_KP);
    const float* AN = (const float*)(ws + WS_AN); const float* BB = (const float*)(ws + WS_BB);
    bf16_t* FG = (bf16_t*)(ws + WS_F);
    LAS bf16_t* X1 = (LAS bf16_t*)(c.lds + PL_X1); LAS bf16_t* X2 = (LAS bf16_t*)(c.lds + PL_X2); LAS bf16_t* AL = (LAS bf16_t*)(c.lds + PL_AL); LAS bf16_t* HT = (LAS bf16_t*)(c.lds + PL_HT);
    LAS bf16_t* ET = (LAS bf16_t*)(c.lds + PL_ET); LAS float* LBT = (LAS float*)(c.lds + PL_LBT); LAS bf16_t* TT = (LAS bf16_t*)(c.lds + PL_TT); LAS bf16_t* GI = (LAS bf16_t*)(c.lds + PL_GI);
    LAS float* RAW = (LAS float*)(c.lds + PL_RAW);
    LAS float* TF = (LAS float*)(c.lds + PL_TF);
    LAS float* XB = (LAS float*)(c.lds + PL_XB);
    int tid_ = c.tid; asm volatile("" : "+v"(tid_));
    const int tid = tid_, lane = tid & 63, w = __builtin_amdgcn_readfirstlane(tid >> 6), fr = lane & 15, fq = lane >> 4;
    const int ls = tid >> 4, lc4 = 4 * (tid & 15);
    f32x4 pf[5];
#define PRE_LOAD(TASK) do { const int bh_ = (TASK) >> 7, ch_ = (TASK) & (SC_NCH - 1); const size_t o_ = ((size_t)(bh_ >> 5) * SEQ + (size_t)ch_ * SC_C + ls) * D + (bh_ & 31) * 64 + lc4; \
        pf[0] = *(const f32x4*)(RZ + o_); pf[1] = *(const f32x4*)(DEC + o_); pf[2] = *(const f32x4*)(KP + o_); pf[3] = *(const f32x4*)(AN + o_); pf[4] = *(const f32x4*)(BB + o_); } while (0)
    if (c.vcu < 128 * SC_NCH) PRE_LOAD(c.vcu);
    const bool bgconv = (c.G == 256);
    LAS float* cscr = (LAS float*)(c.lds + w * 8448);
    int tix = 0;
    for (int task = c.vcu; task < 128 * SC_NCH; task += c.G, ++tix) {
#pragma unroll
        for (int v = 0; v < 5; ++v) *(LAS f32x4*)(RAW + (v * 32 + ls) * 64 + lc4) = pf[v];
        if (task + c.G < 128 * SC_NCH) PRE_LOAD(task + c.G);
        float cv[32]; int ce = 0, cn0 = 0, ck0 = 0;
        if (bgconv) { const int item = (c.vcu * 64 + tix) * 8 + w; ce = item >> 12; const int rem = item & 4095; ck0 = 64 * (rem >> 7); cn0 = 32 * (rem & 127);
            tr_issue(p.in[I_W1] + (size_t)ce * D * 4096, 4096, cn0, ck0, lane, cv); }
        LBAR();
        *(LAS u32x4*)(ET + (32 + (tid >> 3)) * 104 + 8 * (tid & 7)) = (u32x4){0u, 0u, 0u, 0u};
        float g = 1.f, gprev[4], gcur[4];
#pragma unroll
        for (int s = 0; s < SC_C; ++s) { const float wv = RAW[(32 + s) * 64 + lane]; if ((s >> 2) == w) gprev[s & 3] = g; g *= wv; if ((s >> 2) == w) gcur[s & 3] = g; }
        const float gC = g;
        f32x4 ah4, bg4, kg4;
#pragma unroll
        for (int qn = 0; qn < 4; ++qn) { const int s = 4 * w + qn;
            const float rr = RAW[(0 + s) * 64 + lane], kk = RAW[(64 + s) * 64 + lane], aa = RAW[(96 + s) * 64 + lane], bb = RAW[(128 + s) * 64 + lane]; const float ig = 1.0f / gcur[qn];
            const float ah = aa * gprev[qn], bt = bb * ig, kt = kk * ig, rh = rr * gcur[qn];
            X1[s * 72 + lane] = (bf16_t)f2bf(bt); X1[(32 + s) * 72 + lane] = (bf16_t)f2bf(kt); X2[s * 72 + lane] = (bf16_t)f2bf(ah); X2[(32 + s) * 72 + lane] = (bf16_t)f2bf(rh);
            ET[s * 104 + lane] = (bf16_t)f2bf(rh); ah4[qn] = ah; bg4[qn] = bt * gC; kg4[qn] = kt * gC; }
        *(LAS u32x2*)(AL + lane * 40 + 4 * w) = pack4(ah4); *(LAS u32x2*)(HT + (32 + lane) * 40 + 4 * w) = pack4(bg4); *(LAS u32x2*)(ET + (32 + lane) * 104 + 64 + 4 * w) = pack4(kg4);
        LBAR();
        if (w == 0) ET[(32 + lane) * 104 + lane] = (bf16_t)f2bf(gC);
        { const int mt = w >> 1;
#pragma unroll
          for (int u = 0; u < 2; ++u) { const int nt = 2 * (w & 1) + u;
            f32x4 acc = tile_mm(X1 + 16 * mt * 72, 72, X2 + 16 * nt * 72, 72, 2, fr, fq, (f32x4){0.f, 0.f, 0.f, 0.f});
            const int n = 16 * nt + fr, m0 = 16 * mt + 4 * fq;
            if (mt < 2) { if (nt < 2) { const int t = n; f32x4 o;
#pragma unroll
                    for (int e = 0; e < 4; ++e) o[e] = (m0 + e < t) ? acc[e] : 0.f;
                    *(LAS f32x4*)(LBT + t * 36 + m0) = o; }
                else { const int t = n - 32; f32x4 o;
#pragma unroll
                    for (int e = 0; e < 4; ++e) o[e] = (m0 + e <= t) ? acc[e] : 0.f;
                    *(LAS u32x2*)(HT + t * 40 + m0) = pack4(o); } }
            else { const int s0 = m0 - 32;
                if (nt < 2) { const int t = n;
#pragma unroll
                    for (int e = 0; e < 4; ++e) AL[(64 + s0 + e) * 40 + t] = (bf16_t)f2bf((s0 + e < t) ? acc[e] : 0.f); }
                else { const int t = n - 32; f32x4 o;
#pragma unroll
                    for (int e = 0; e < 4; ++e) o[e] = (s0 + e <= t) ? acc[e] : 0.f;
                    *(LAS u32x2*)(ET + t * 104 + 64 + s0) = pack4(o); } } } }
        LBAR();
        if (tid < 32) { const int hb = 16 * (tid >> 4), sl = tid & 15; float Tr[16];
#pragma unroll
            for (int t = 0; t < 16; ++t) { float a0 = (sl == t) ? 1.f : 0.f, a1 = 0.f, a2 = 0.f, a3 = 0.f;
#pragma unroll
                for (int m4 = 0; m4 < (t + 3) / 4; ++m4) { const f32x4 l = *(const LAS f32x4*)(LBT + (hb + t) * 36 + hb + 4 * m4);
                    if (4 * m4 + 0 < t) a0 += Tr[4 * m4 + 0] * l[0]; if (4 * m4 + 1 < t) a1 += Tr[4 * m4 + 1] * l[1]; if (4 * m4 + 2 < t) a2 += Tr[4 * m4 + 2] * l[2]; if (4 * m4 + 3 < t) a3 += Tr[4 * m4 + 3] * l[3]; }
                Tr[t] = (a0 + a1) + (a2 + a3); TF[(hb + sl) * 36 + hb + t] = Tr[t]; TT[(hb + t) * 40 + hb + sl] = (bf16_t)f2bf(Tr[t]);
                if (hb) TT[t * 40 + hb + sl] = 0; } }
        LBAR();
        if (tid < 256) { const int m = tid >> 4, tl = tid & 15; float x = 0.f;
#pragma unroll
            for (int n = 0; n < 16; ++n) x += LBT[(16 + n) * 36 + m] * TF[(16 + n) * 36 + 16 + tl];
            XB[m * 17 + tl] = x; }
        LBAR();
        if (tid < 256) { const int sr = tid >> 4, tl = tid & 15; float x = 0.f;
#pragma unroll
            for (int m = 0; m < 16; ++m) x += TF[sr * 36 + m] * XB[m * 17 + tl];
            TT[(16 + tl) * 40 + sr] = (bf16_t)f2bf(x); }
        LBAR();
        for (int id = w; id < 12; id += 8) { const int tt = id / 6, nt = id % 6;
            const f32x4 acc = tile_mm(TT + 16 * tt * 40, 40, AL + 16 * nt * 40, 40, 1, fr, fq, (f32x4){0.f, 0.f, 0.f, 0.f});
            *(LAS u32x2*)(GI + (16 * nt + fr) * 40 + 16 * tt + 4 * fq) = pack4(acc); }
        LBAR();
        for (int id = w; id < 36; id += 8) { const int nt = id / 6, mt = id % 6;
            const f32x4 acc = tile_mm(GI + 16 * nt * 40, 40, HT + 16 * mt * 40, 40, 1, fr, fq, (f32x4){0.f, 0.f, 0.f, 0.f});
            LAS u32x2* ep = (LAS u32x2*)(ET + (16 * mt + fr) * 104 + 16 * nt + 4 * fq); const u32x2 ev = *ep;
            f32x4 o; o[0] = acc[0] + bf2f(ev.x & 0xffffu); o[1] = acc[1] + bf2f(ev.x >> 16); o[2] = acc[2] + bf2f(ev.y & 0xffffu); o[3] = acc[3] + bf2f(ev.y >> 16);
            *ep = pack4(o); }
        LBAR();
        { bf16_t* fg = FG + (size_t)task * (SC_F * SC_F);
          for (int idx = tid; idx < 96 * 12; idx += 512) { const int row = idx / 12, pc = idx % 12; *(u32x4*)(fg + row * 96 + 8 * pc) = *(const LAS u32x4*)(ET + row * 104 + 8 * pc); } }
        LBAR();
        if (bgconv) tr_finish(cv, (bf16_t*)(ws + WS_W1) + (size_t)ce * 4096 * D, D, cn0, ck0, cscr, lane);
    }
    if (!bgconv) {
        LBAR();
        for (int r = c.vcu * 8 + w; r < NEXP * MOE_W1E; r += c.G * 8) { const int e = r >> 12; tr_job(p.in[I_W1] + (size_t)e * D * 4096, 4096, D, D, (bf16_t*)(ws + WS_W1) + (size_t)e * 4096 * D, r & 4095, cscr, lane); }
    }
    LBAR();
#undef PRE_LOAD
}
constexpr int SQ_BI = 0, SQ_BI_SZ = 64 * 104 * 2, SQ_YL = 2 * SQ_BI_SZ, SQ_YL_SZ = 32 * 64 * 4;
struct SeqSet { bf16x8 af[3][3]; f32x4 vimg; float r[4], k[4], v[4], g[4]; };
__device__ __forceinline__ void p4_seq(const Params& p, const Ctx& c, int bh) {
    unsigned char* ws = c.ws;
    const float* RZ = (const float*)(ws + WS_RZ); const float* KP = (const float*)(ws + WS_KP); const float* VZ = (const float*)(ws + WS_VZ); const float* GG = (const float*)(ws + WS_GG);
    const bf16_t* FG = (const bf16_t*)(ws + WS_F) + (size_t)bh * SC_NCH * (SC_F * SC_F);
    bf16_t* YA = (bf16_t*)(ws + WS_YA);
    int tid_ = c.tid; asm volatile("" : "+v"(tid_));
    const int tid = tid_, lane = tid & 63, w = __builtin_amdgcn_readfirstlane(tid >> 6), fr = lane & 15, fq = lane >> 4;
    const int b = bh >> 5, h = bh & 31;
    const size_t base = (size_t)b * SEQ * D + h * 64;
    const int nt = w & 3, mg = w >> 2;
    const float lg = p.in[I_LNXG][h * 64 + lane], lb = p.in[I_LNXB][h * 64 + lane], rk = p.in[I_RK][h * 64 + lane];
    LAS bf16_t* BI = (LAS bf16_t*)(c.lds + SQ_BI); LAS float* YL = (LAS float*)(c.lds + SQ_YL);
    const int vs = tid >> 4, vi4 = 4 * (tid & 15);
#define SEQ_LOAD(SET, CHN) do { const bf16_t* fp = FG + (size_t)(CHN) * (SC_F * SC_F); _Pragma("unroll") for (int mi = 0; mi < 3; ++mi) _Pragma("unroll") for (int ks = 0; ks < 3; ++ks) \
            SET.af[mi][ks] = *(const bf16x8*)(fp + (16 * (3 * mg + mi) + fr) * SC_F + 32 * ks + 8 * fq); \
        SET.vimg = *(const f32x4*)(VZ + base + (size_t)((CHN) * SC_C + vs) * D + vi4); \
        _Pragma("unroll") for (int e = 0; e < 4; ++e) { const size_t o = base + (size_t)((CHN) * SC_C + 4 * w + e) * D + lane; SET.r[e] = RZ[o]; SET.k[e] = KP[o]; SET.v[e] = VZ[o]; SET.g[e] = GG[o]; } } while (0)
#define SEQ_BODY(CH, CUR, NXT, NX2) do { const int ch = (CH), cb = ch & 1; \
        const LAS bf16_t* bi = BI + cb * (64 * 104); LAS bf16_t* bo = BI + (cb ^ 1) * (64 * 104); LAS float* yl = YL + cb * (32 * 64); \
        if (ch + 2 < SC_NCH) SEQ_LOAD(NX2, ch + 2); \
        bf16x8 bfr[3]; _Pragma("unroll") for (int ks = 0; ks < 3; ++ks) bfr[ks] = *(const LAS bf16x8*)(bi + (16 * nt + fr) * 104 + 32 * ks + 8 * fq); \
        f32x4 acc[3]; _Pragma("unroll") for (int mi = 0; mi < 3; ++mi) { acc[mi] = (f32x4){0.f, 0.f, 0.f, 0.f}; \
            _Pragma("unroll") for (int ks = 0; ks < 3; ++ks) acc[mi] = __builtin_amdgcn_mfma_f32_16x16x32_bf16(CUR.af[mi][ks], bfr[ks], acc[mi], 0, 0, 0); } \
        _Pragma("unroll") for (int mi = 0; mi < 3; ++mi) { const int mt = 3 * mg + mi; \
            if (mt < 2) { _Pragma("unroll") for (int e = 0; e < 4; ++e) yl[(16 * mt + 4 * fq + e) * 64 + 16 * nt + fr] = acc[mi][e]; } \
            else *(LAS u32x2*)(bo + (16 * nt + fr) * 104 + 16 * (mt - 2) + 4 * fq) = pack4(acc[mi]); } \
        if (ch + 1 < SC_NCH) { _Pragma("unroll") for (int e = 0; e < 4; ++e) bo[(vi4 + e) * 104 + 64 + vs] = (bf16_t)f2bf(NXT.vimg[e]); } \
        LBAR(); \
        _Pragma("unroll") for (int e = 0; e < 4; ++e) { const int s = 4 * w + e; const float y = yl[s * 64 + lane]; \
            const float mu = wave_sum_dpp(y) * (1.0f / 64.0f); const float dl = y - mu; const float var = wave_sum_dpp(dl * dl) * (1.0f / 64.0f); \
            const float yn = dl * rsqrtf(var + GN_EPS) * lg + lb; const float bonus = wave_sum_dpp(CUR.r[e] * CUR.k[e] * rk) * CUR.v[e]; \
            YA[base + (size_t)(ch * SC_C + s) * D + lane] = (bf16_t)f2bf((yn + bonus) * CUR.g[e]); } } while (0)
    SeqSet sa, sb, sc;
    SEQ_LOAD(sa, 0); SEQ_LOAD(sb, 1);
    for (int idx = tid; idx < 64 * 8; idx += 512) *(LAS u32x4*)(BI + (idx >> 3) * 104 + 8 * (idx & 7)) = (u32x4){0u, 0u, 0u, 0u};
#pragma unroll
    for (int e = 0; e < 4; ++e) BI[(vi4 + e) * 104 + 64 + vs] = (bf16_t)f2bf(sa.vimg[e]);
    LBAR();
    for (int c0 = 0; c0 < SC_NCH; c0 += 3) {
        SEQ_BODY(c0, sa, sb, sc);
        if (c0 + 1 < SC_NCH) SEQ_BODY(c0 + 1, sb, sc, sa);
        if (c0 + 2 < SC_NCH) SEQ_BODY(c0 + 2, sc, sa, sb);
    }
    LBAR();
#undef SEQ_LOAD
#undef SEQ_BODY
}

__device__ __forceinline__ void p4_attn_task(const Ctx& c, int task) {
    unsigned char* ws = c.ws;
    const bf16_t* QR = (const bf16_t*)(ws + WS_QR); const bf16_t* KR = (const bf16_t*)(ws + WS_KR); const bf16_t* PROJ = (const bf16_t*)(ws + WS_PROJ);
    float* AO = (float*)(ws + WS_AO); float* LSE = (float*)(ws + WS_LSE);
    constexpr int VP = 280;
    LAS bf16_t* Vt = (LAS bf16_t*)c.lds;
    const int combo = task & 31, hh = (task >> 5) % 24, b = task / (32 * 24);
    const int g = hh >> 3, h = hh & 7;
    const int dil = g == 0 ? 1 : (g == 1 ? 4 : 16);
    const int res = combo % dil, blk = combo / dil;
    const int tid = c.tid, lane = c.lane, w = c.wave;
    __syncthreads();
    {
        const int ki = tid >> 1, dh = tid & 1; const int pk = (blk - 1) * 128 + ki;
        u32x4 v[4];
        if (pk >= 0) { const bf16_t* sp = PROJ + ((size_t)b * SEQ + (size_t)pk * dil + res) * PC + ATT0 + 2 * 1536 + hh * 64 + 32 * dh;
#pragma unroll
            for (int j = 0; j < 4; ++j) v[j] = *(const u32x4*)(sp + 8 * j); }
        else {
#pragma unroll
            for (int j = 0; j < 4; ++j) v[j] = (u32x4){0u, 0u, 0u, 0u}; }
#pragma unroll
        for (int j = 0; j < 4; ++j) { const unsigned wv[4] = {v[j].x, v[j].y, v[j].z, v[j].w};
#pragma unroll
            for (int e = 0; e < 8; ++e) Vt[(32 * dh + 8 * j + e) * VP + ki] = (bf16_t)((wv[e >> 1] >> (16 * (e & 1))) & 0xffffu); }
        if (tid < 64) {
#pragma unroll
            for (int e = 0; e < 24; ++e) Vt[tid * VP + 256 + e] = 0; }
    }
    __syncthreads();
    const int qq = lane & 15, g4 = lane >> 4;
    const int r0 = 16 * w;
    const size_t qtok = (size_t)b * SEQ + (size_t)(blk * 128 + r0 + qq) * dil + res;
    bf16x8 qf[2];
#pragma unroll
    for (int ks = 0; ks < 2; ++ks) qf[ks] = *(const bf16x8*)(QR + qtok * 1536 + hh * 64 + 32 * ks + 8 * g4);
    f32x4 sc[10];
#pragma unroll
    for (int kt = 0; kt < 9; ++kt) {
        const int ki = 16 * (w + kt) + qq; const int pk = (blk - 1) * 128 + ki;
        f32x4 a = (f32x4){0.f, 0.f, 0.f, 0.f};
#pragma unroll
        for (int ks = 0; ks < 2; ++ks) { bf16x8 kf = (bf16x8){0, 0, 0, 0, 0, 0, 0, 0};
            if (pk >= 0) kf = *(const bf16x8*)(KR + ((size_t)b * SEQ + (size_t)pk * dil + res) * 1536 + hh * 64 + 32 * ks + 8 * g4);
            a = __builtin_amdgcn_mfma_f32_16x16x32_bf16(kf, qf[ks], a, 0, 0, 0); }
        sc[kt] = a;
    }
    const int r = r0 + qq;
    float mx = -3.0e38f;
#pragma unroll
    for (int kt = 0; kt < 9; ++kt)
#pragma unroll
        for (int j = 0; j < 4; ++j) { const int ki = 16 * (w + kt) + 4 * g4 + j; const bool ok = (ki >= r) && (ki <= r + 128) && (blk > 0 || ki >= 128);
            const float s = ok ? sc[kt][j] * 0.125f : -1.0e30f; sc[kt][j] = s; mx = fmaxf(mx, s); }
    mx = fmaxf(mx, __shfl_xor(mx, 16)); mx = fmaxf(mx, __shfl_xor(mx, 32));
    float den = 0.f;
#pragma unroll
    for (int kt = 0; kt < 9; ++kt)
#pragma unroll
        for (int j = 0; j < 4; ++j) { const float pexp = __expf(sc[kt][j] - mx); sc[kt][j] = pexp; den += pexp; }
    den += __shfl_xor(den, 16); den += __shfl_xor(den, 32);
    sc[9] = (f32x4){0.f, 0.f, 0.f, 0.f};
    f32x4 oacc[4];
#pragma unroll
    for (int dt = 0; dt < 4; ++dt) oacc[dt] = (f32x4){0.f, 0.f, 0.f, 0.f};
#pragma unroll
    for (int cidx = 0; cidx < 5; ++cidx) {
        const f32x4 p0 = sc[2 * cidx], p1 = sc[2 * cidx + 1];
        u32x4 pw; pw.x = pk2(p0[0], p0[1]); pw.y = pk2(p0[2], p0[3]); pw.z = pk2(p1[0], p1[1]); pw.w = pk2(p1[2], p1[3]);
        const bf16x8 pf = __builtin_bit_cast(bf16x8, pw);
        const int kbase = 16 * (w + 2 * cidx) + 4 * g4;
#pragma unroll
        for (int dt = 0; dt < 4; ++dt) { const LAS bf16_t* vp = Vt + (16 * dt + qq) * VP + kbase;
            const u32x2 lo = *(const LAS u32x2*)vp, hi = *(const LAS u32x2*)(vp + 16);
            u32x4 vw; vw.x = lo.x; vw.y = lo.y; vw.z = hi.x; vw.w = hi.y;
            oacc[dt] = __builtin_amdgcn_mfma_f32_16x16x32_bf16(__builtin_bit_cast(bf16x8, vw), pf, oacc[dt], 0, 0, 0); }
    }
    const float inv = 1.0f / den;
    const size_t tok = qtok;
#pragma unroll
    for (int dt = 0; dt < 4; ++dt) *(f32x4*)(AO + ((size_t)g * M + tok) * 512 + h * 64 + 16 * dt + 4 * g4) = oacc[dt] * inv;
    if (g4 == 0) LSE[((size_t)g * M + tok) * 8 + h] = mx + __logf(den);
}

constexpr int Q_ATT = 3072, Q_TOTAL = Q_ATT + MOE_CONV_GROUPS;
__device__ __forceinline__ void p4_queue(const Params& p, const Ctx& c, volatile LAS unsigned* qslot) {
    unsigned* qc = (unsigned*)(c.ws + WS_CTL) + CW_Q;
    for (;;) {
        __syncthreads();
        if (c.tid == 0) qslot[0] = __hip_atomic_fetch_add(qc, 1u, __ATOMIC_RELAXED, __HIP_MEMORY_SCOPE_AGENT);
        __syncthreads();
        const unsigned it = qslot[0];
        if (it >= (unsigned)Q_TOTAL) break;
        if (it < (unsigned)Q_ATT) p4_attn_task(c, (int)it); else conv_group(p, c, (int)it - Q_ATT);
    }
}

__device__ __forceinline__ void p5_post(const Params& p, const Ctx& c) {
    unsigned char* ws = c.ws;
    const float* AO = (const float*)(ws + WS_AO); const float* LSE = (const float*)(ws + WS_LSE);
    bf16_t* YB = (bf16_t*)(ws + WS_YB);
    const int gw = c.vcu * 8 + c.wave, NGW = c.G * 8, lane = c.lane;
    for (int it = gw; it < M * 8; it += NGW) {
        const int t = it >> 3, h = it & 7;
        const float l0 = LSE[((size_t)0 * M + t) * 8 + h], l1 = LSE[((size_t)1 * M + t) * 8 + h], l2 = LSE[((size_t)2 * M + t) * 8 + h];
        const float mxl = fmaxf(l0, fmaxf(l1, l2)); const float e0 = __expf(l0 - mxl), e1 = __expf(l1 - mxl), e2 = __expf(l2 - mxl); const float inv = 1.0f / (e0 + e1 + e2);
        const size_t o = (size_t)t * 512 + h * 64 + lane;
        const float v = (e0 * AO[o] + e1 * AO[(size_t)M * 512 + o] + e2 * AO[(size_t)2 * M * 512 + o]) * inv;
        YB[o] = (bf16_t)f2bf(v);
    }
}

__device__ __forceinline__ void ln_rows(const Ctx& c, const float* in, const float* gam, const float* bet, float* outf, bf16_t* outb) {
    const int gw = c.vcu * 8 + c.wave, NGW = c.G * 8, lane = c.lane;
    for (int m = gw; m < M; m += NGW) {
        const f32x4* xr = (const f32x4*)(in + (size_t)m * D) + lane;
        f32x4 v[8]; float s = 0.f;
#pragma unroll
        for (int j = 0; j < 8; ++j) { v[j] = xr[64 * j]; s += (v[j][0] + v[j][1]) + (v[j][2] + v[j][3]); }
        const float mean = wave_sum(s) * (1.0f / D); float s2 = 0.f;
#pragma unroll
        for (int j = 0; j < 8; ++j) { v[j] = v[j] - mean; s2 += (v[j][0] * v[j][0] + v[j][1] * v[j][1]) + (v[j][2] * v[j][2] + v[j][3] * v[j][3]); }
        const float rstd = rsqrtf(wave_sum(s2) * (1.0f / D) + LN_EPS);
#pragma unroll
        for (int j = 0; j < 8; ++j) { const int col = 4 * lane + 256 * j; const f32x4 gv = *(const f32x4*)(gam + col), bv = *(const f32x4*)(bet + col);
            const f32x4 o = v[j] * rstd * gv + bv;
            *(f32x4*)(outf + (size_t)m * D + col) = o;
            if (outb) { u32x2 w; w.x = pk2(o[0], o[1]); w.y = pk2(o[2], o[3]); *(u32x2*)(outb + (size_t)m * D + col) = w; } }
    }
}

__device__ __forceinline__ void p15_router(const Params& p, const Ctx& c) {
    unsigned char* ws = c.ws;
    const float* X2 = (const float*)(ws + WS_X2); const float* RW = p.in[I_RW]; const float* RB = p.in[I_RB];
    unsigned* cnt = (unsigned*)(ws + WS_CTL) + CW_CNT; int* LIST = (int*)(ws + WS_LIST); int* ROWI = (int*)(ws + WS_ROWI); float* TOPW = (float*)(ws + WS_TOPW);
    LAS float* scr = (LAS float*)(c.lds + c.wave * 8192);
    const int gw = c.vcu * 8 + c.wave, NGW = c.G * 8, lane = c.lane, li = lane & 31, lk = lane >> 5;
    for (int tb = gw; tb < M / 32; tb += NGW) {
        const int t0 = tb * 32;
        f32x16 acc;
#pragma unroll
        for (int j = 0; j < 16; ++j) acc[j] = 0.f;
        const float* xa = X2 + (size_t)(t0 + li) * D + 4 * lk;
        const float* wb = RW + (size_t)(4 * lk) * 32 + li;
        for (int kb = 0; kb < D / 8; ++kb) {
            const f32x4 a = *(const f32x4*)(xa + 8 * kb);
            const float b0 = wb[(size_t)(8 * kb + 0) * 32], b1 = wb[(size_t)(8 * kb + 1) * 32], b2 = wb[(size_t)(8 * kb + 2) * 32], b3 = wb[(size_t)(8 * kb + 3) * 32];
            acc = __builtin_amdgcn_mfma_f32_32x32x2f32(a[0], b0, acc, 0, 0, 0);
            acc = __builtin_amdgcn_mfma_f32_32x32x2f32(a[1], b1, acc, 0, 0, 0);
            acc = __builtin_amdgcn_mfma_f32_32x32x2f32(a[2], b2, acc, 0, 0, 0);
            acc = __builtin_amdgcn_mfma_f32_32x32x2f32(a[3], b3, acc, 0, 0, 0);
        }
        const float bias = RB[li];
#pragma unroll
        for (int rg = 0; rg < 16; ++rg) { const int row = (rg & 3) + 8 * (rg >> 2) + 4 * lk; scr[row * 33 + li] = acc[rg] + bias; }
        LDS_WAIT(); asm volatile("" ::: "memory");
        if (lane < 32) {
            float lv[32];
#pragma unroll
            for (int e = 0; e < 32; ++e) lv[e] = scr[lane * 33 + e];
            int id[4]; float tv[4];
#pragma unroll
            for (int k = 0; k < 4; ++k) { float best = -3.0e38f; int bi = 0;
#pragma unroll
                for (int e = 0; e < 32; ++e) { const bool tk = lv[e] > best; best = tk ? lv[e] : best; bi = tk ? e : bi; }
                id[k] = bi; tv[k] = best;
#pragma unroll
                for (int e = 0; e < 32; ++e) lv[e] = (e == bi) ? -3.0e38f : lv[e]; }
            const float e1 = __expf(tv[1] - tv[0]), e2 = __expf(tv[2] - tv[0]), e3 = __expf(tv[3] - tv[0]); const float inv = 1.0f / (1.0f + e1 + e2 + e3);
            const float wv[4] = {inv, e1 * inv, e2 * inv, e3 * inv};
            const int t = t0 + lane;
#pragma unroll
            for (int k = 0; k < 4; ++k) { const unsigned slot = __hip_atomic_fetch_add(cnt + id[k], 1u, __ATOMIC_RELAXED, __HIP_MEMORY_SCOPE_AGENT);
                LIST[(size_t)id[k] * CAP + slot] = t; ROWI[(size_t)t * 4 + k] = id[k] * CAP + (int)slot; TOPW[(size_t)t * 4 + k] = wv[k]; }
        }
        LDS_WAIT(); asm volatile("" ::: "memory");
    }
}

__device__ __forceinline__ void moe_table(const Ctx& c, LAS int* tab) {
    if (c.tid == 0) { unsigned* cnt = (unsigned*)(c.ws + WS_CTL) + CW_CNT; int ts = 0;
        for (int e = 0; e < NEXP; ++e) { const int n = (int)__hip_atomic_load(cnt + e, __ATOMIC_RELAXED, __HIP_MEMORY_SCOPE_AGENT); tab[e] = n; tab[32 + e] = ts; ts += (n + 255) >> 8; }
        tab[64] = ts; }
    __syncthreads();
}

__device__ __forceinline__ void p18_combine(const Params& p, const Ctx& c, const LAS int* tab) {
    unsigned char* ws = c.ws;
    const float* X2 = (const float*)(ws + WS_X2); const float* Y = (const float*)(ws + WS_Y); const int* ROWI = (const int*)(ws + WS_ROWI); const float* TOPW = (const float*)(ws + WS_TOPW);
    const float* gam = p.in[I_LN3G]; const float* bet = p.in[I_LN3B];
    const int gw = c.vcu * 8 + c.wave, NGW = c.G * 8, lane = c.lane;
    for (int m = gw; m < M; m += NGW) {
        f32x4 v[8];
        const f32x4* xr = (const f32x4*)(X2 + (size_t)m * D) + lane;
#pragma unroll
        for (int j = 0; j < 8; ++j) v[j] = xr[64 * j] * DN_ALPHA;
#pragma unroll
        for (int k = 0; k < 4; ++k) { const int ri = ROWI[(size_t)m * 4 + k]; const float gt = TOPW[(size_t)m * 4 + k]; const int e = ri >> 14, slot = ri & (CAP - 1);
            const f32x4* yr = (const f32x4*)(Y + ((size_t)tab[32 + e] * 256 + slot) * D) + lane;
#pragma unroll
            for (int j = 0; j < 8; ++j) v[j] = v[j] + yr[64 * j] * gt; }
        float s = 0.f;
#pragma unroll
        for (int j = 0; j < 8; ++j) s += (v[j][0] + v[j][1]) + (v[j][2] + v[j][3]);
        const float mean = wave_sum(s) * (1.0f / D); float s2 = 0.f;
#pragma unroll
        for (int j = 0; j < 8; ++j) { v[j] = v[j] - mean; s2 += (v[j][0] * v[j][0] + v[j][1] * v[j][1]) + (v[j][2] * v[j][2] + v[j][3] * v[j][3]); }
        const float rstd = rsqrtf(wave_sum(s2) * (1.0f / D) + LN_EPS);
#pragma unroll
        for (int j = 0; j < 8; ++j) { const int col = 4 * lane + 256 * j; const f32x4 gv = *(const f32x4*)(gam + col), bv = *(const f32x4*)(bet + col);
            *(f32x4*)(p.out + (size_t)m * D + col) = v[j] * rstd * gv + bv; }
    }
}

constexpr int NPHASE = 19;
__global__ void __launch_bounds__(512, 2) fwd(Params p) {
    extern __shared__ __attribute__((aligned(16))) unsigned char lds_raw[];
    LAS unsigned char* lds = (LAS unsigned char*)lds_raw;
    Ctx c; c.tid = threadIdx.x; c.lane = c.tid & 63; c.wave = __builtin_amdgcn_readfirstlane(c.tid >> 6); c.G = gridDim.x;
    { const int bx = blockIdx.x; c.vcu = (c.G % 8 == 0) ? (bx % 8) * (c.G / 8) + bx / 8 : bx; }
    c.lds = lds; c.ws = p.ws;
    unsigned char* ws = p.ws;
    volatile LAS unsigned* MISC = (volatile LAS unsigned*)(lds + MISC_OFF);
    LAS int* tab = (LAS int*)(lds + MISC_OFF + 1024);
    if (c.tid < 64) MISC[c.tid] = 0u;
    __syncthreads();
    unsigned* ctl = (unsigned*)(ws + WS_CTL);
    XcdBarrier bar; bar.bar = ctl + CW_BAR + p.li * XCD_BAR_WORDS; bar.x = 0; bar.st = MISC + 8;
    if (N_LAUNCH_MODE == 1) bar = xcd_barrier_post(ctl + CW_BAR + p.li * XCD_BAR_WORDS, MISC + 8);
    const int lo = p.ph_lo, hi = p.ph_hi, bx = blockIdx.x;
#ifndef PHMASK
#define PHMASK 0xFFFFFFFFu
#endif
#define IN(k) (((PHMASK >> (k)) & 1u) && lo <= (k) && (k) < hi)
#define SEAM(k) do { if (N_LAUNCH_MODE == 1 && IN((k) + 1)) xcd_barrier(bar); } while (0)

    if (IN(0)) { p0_prologue(p, c); SEAM(0); }

    if (IN(1)) {
        pg8::StaticOrder S; S.init(ws + WS_XB, ws + WS_WIN, M, PC, D, D, c.G, bx);
        pg8::EpiBf16 E{(bf16_t*)(ws + WS_PROJ), PC, 1.0f};
        pg8::gemm_phase<pg8::EpiBf16, pg8::StaticOrder>(lds, pg8::Gemm{D, D, D}, S, E);
        SEAM(1);
    }
    if (IN(2)) { p2_prep(p, c); SEAM(2); }

    if (IN(3)) {
#ifndef P3M
#define P3M 15
#endif
        if (P3M & 1) { pg8::StaticOrder S; S.init(ws + WS_LIN, ws + WS_WUP, M, D, 768, 256, c.G, bx);
          pg8::EpiDecay E{(float*)(ws + WS_DEC), p.in[I_W0]};
          pg8::gemm_phase<pg8::EpiDecay, pg8::StaticOrder>(lds, pg8::Gemm{256, 768, 256}, S, E); }
        if (P3M & 2) { pg8::StaticOrder S; S.init(ws + WS_LIN + 512, ws + WS_AUP, M, D, 768, 256, c.G, bx);
          pg8::EpiIclr E{p.in[I_A0], p.in[I_KK], p.in[I_KA], (const float*)(ws + WS_KZ), (const float*)(ws + WS_KNORM), (float*)(ws + WS_KP), (float*)(ws + WS_AN), (float*)(ws + WS_BB)};
          pg8::gemm_phase<pg8::EpiIclr, pg8::StaticOrder>(lds, pg8::Gemm{256, 768, 256}, S, E); }
        if (P3M & 4) { pg8::StaticOrder S; S.init(ws + WS_LIN + 1024, ws + WS_GUP, M, D, 768, 256, c.G, bx);
          pg8::EpiF32 E{(float*)(ws + WS_GG), D, nullptr, 0, nullptr, 0.f};
          pg8::gemm_phase<pg8::EpiF32, pg8::StaticOrder>(lds, pg8::Gemm{256, 768, 256}, S, E); }
        if (P3M & 8) { pg8::StaticOrder S; S.init(ws + WS_MEMB, ws + WS_WKV, 1024, 2 * D, D, D, c.G, bx);
          pg8::EpiKV E{(bf16_t*)(ws + WS_KB), (bf16_t*)(ws + WS_VT)};
          pg8::gemm_phase<pg8::EpiKV, pg8::StaticOrder>(lds, pg8::Gemm{D, D, D}, S, E); }
        SEAM(3);
    }
    if (IN(4)) {
        p4_pre(p, c);
        xcd_barrier(bar);
        for (int bh = c.vcu; bh < 128; bh += c.G) p4_seq(p, c, bh);
        p4_queue(p, c, MISC + 16);
        SEAM(4);
    }
    if (IN(5)) { p5_post(p, c); }

    if (IN(6)) {
        pg8::StaticOrder S; S.init(ws + WS_YA, ws + WS_PA, M, D, D, D, c.G, bx);
        pg8::EpiGateA E{(const bf16_t*)(ws + WS_PROJ), (float*)(ws + WS_TMP)};
        pg8::gemm_phase<pg8::EpiGateA, pg8::StaticOrder>(lds, pg8::Gemm{D, D, D}, S, E);
        SEAM(6);
    }
    if (IN(7)) {
        pg8::StaticOrder S; S.init(ws + WS_YB, ws + WS_PB, M, D, 512, 512, c.G, bx);
        pg8::EpiGateB E{(const bf16_t*)(ws + WS_PROJ), (const float*)(ws + WS_TMP), (bf16_t*)(ws + WS_MERGED)};
        pg8::gemm_phase<pg8::EpiGateB, pg8::StaticOrder>(lds, pg8::Gemm{512, 512, 512}, S, E);
        SEAM(7);
    }
    if (IN(8)) {
        pg8::StaticOrder S; S.init(ws + WS_MERGED, ws + WS_WOUT, M, D, D, D, c.G, bx);
        pg8::EpiF32 E{(float*)(ws + WS_T1), D, nullptr, 0, p.in[I_X], DN_ALPHA};
        pg8::gemm_phase<pg8::EpiF32, pg8::StaticOrder>(lds, pg8::Gemm{D, D, D}, S, E);
        SEAM(8);
    }
    if (IN(9)) { ln_rows(c, (const float*)(ws + WS_T1), p.in[I_LN1G], p.in[I_LN1B], (float*)(ws + WS_X1), (bf16_t*)(ws + WS_X1B)); SEAM(9); }

    if (IN(10)) {
        pg8::StaticOrder S; S.init(ws + WS_X1B, ws + WS_WQ, M, D, D, D, c.G, bx);
        pg8::EpiBf16 E{(bf16_t*)(ws + WS_Q), D, 0.04419417382415922f};
        pg8::gemm_phase<pg8::EpiBf16, pg8::StaticOrder>(lds, pg8::Gemm{D, D, D}, S, E);
        SEAM(10);
    }
    if (IN(11)) {
        ScoreOrder S{(const char*)(ws + WS_Q), (const char*)(ws + WS_KB), c.G, bx};
        pg8::EpiSoftmax E{(bf16_t*)(ws + WS_PP)};
        pg8::gemm_phase<pg8::EpiSoftmax, ScoreOrder, false>(lds, pg8::Gemm{512, D, D}, S, E);
        SEAM(11);
    }
    if (IN(12)) {
        PvOrder S{(const char*)(ws + WS_PP), (const char*)(ws + WS_VT), c.G, bx};
        pg8::EpiBf16 E{(bf16_t*)(ws + WS_OC), D, 1.0f};
        pg8::gemm_phase<pg8::EpiBf16, PvOrder>(lds, pg8::Gemm{256, 256, 256}, S, E);
        SEAM(12);
    }
    if (IN(13)) {
        pg8::StaticOrder S; S.init(ws + WS_OC, ws + WS_WO, M, D, D, D, c.G, bx);
        pg8::EpiF32 E{(float*)(ws + WS_T2), D, nullptr, 0, (const float*)(ws + WS_X1), DN_ALPHA};
        pg8::gemm_phase<pg8::EpiF32, pg8::StaticOrder>(lds, pg8::Gemm{D, D, D}, S, E);
        SEAM(13);
    }
    if (IN(14)) { ln_rows(c, (const float*)(ws + WS_T2), p.in[I_LN2G], p.in[I_LN2B], (float*)(ws + WS_X2), (bf16_t*)(ws + WS_X2B)); SEAM(14); }
    if (IN(15)) { p15_router(p, c); SEAM(15); }

    if (IN(16)) {
        moe_table(c, tab);
        MoeOrder<true, 16> S{tab, (const char*)(ws + WS_X2B), (const char*)(ws + WS_W1), (const int*)(ws + WS_LIST), (size_t)4096 * D * 2, D, c.G, bx};
        pg8::EpiSwiglu E{p.in[I_B1], (bf16_t*)(ws + WS_H)};
        pg8::gemm_phase<pg8::EpiSwiglu, MoeOrder<true, 16>>(lds, pg8::Gemm{D, D, D}, S, E);
        SEAM(16);
    }
    if (IN(17)) {
        moe_table(c, tab);
        MoeOrder<false, 8> S{tab, (const char*)(ws + WS_H), (const char*)(ws + WS_W2), (const int*)(ws + WS_LIST), (size_t)D * DFF * 2, DFF, c.G, bx};
        pg8::EpiF32 E{(float*)(ws + WS_Y), D, p.in[I_B2], D, nullptr, 0.f};
        pg8::gemm_phase<pg8::EpiF32, MoeOrder<false, 8>>(lds, pg8::Gemm{DFF, DFF, DFF}, S, E);
        SEAM(17);
    }
    if (IN(18)) { moe_table(c, tab); p18_combine(p, c, tab); }
#undef IN
#undef SEAM
}

extern "C" void kernel_launch(void* const* d_in, const int* in_sizes, int n_in, void* d_out, int out_size, void* d_ws, size_t ws_size, hipStream_t stream) {
    static int grid = 0;
    if (grid == 0) {
        if (n_in != 32 || out_size != M * D || ws_size < WS_END) { fprintf(stderr, "kernel_launch: expected 32 inputs, %d outputs, >= %zu bytes of workspace; got %d, %d, %zu\n", M * D, (size_t)WS_END, n_in, out_size, ws_size); grid = -1; return; }
        int dev = 0, cus = 0, per_cu = 0;
        if (hipGetDevice(&dev) != hipSuccess || hipDeviceGetAttribute(&cus, hipDeviceAttributeMultiprocessorCount, dev) != hipSuccess) { grid = -1; return; }
        if (hipFuncSetAttribute((const void*)fwd, hipFuncAttributeMaxDynamicSharedMemorySize, LDS_BYTES) != hipSuccess) { fprintf(stderr, "kernel_launch: hipFuncSetAttribute failed\n"); grid = -1; return; }
        if (hipOccupancyMaxActiveBlocksPerMultiprocessor(&per_cu, (const void*)fwd, 512, LDS_BYTES) != hipSuccess || per_cu < 1) fprintf(stderr, "kernel_launch: occupancy query reports %d\n", per_cu);
        (void)hipGetLastError();
        grid = cus;
        if (grid != 256) fprintf(stderr, "kernel_launch: %d CUs; this kernel is built for 256\n", grid);
    }
    if (grid < 0) return;
    (void)hipMemsetAsync((char*)d_ws + WS_CTL, 0, CTL_ZERO_BYTES, stream);
    Params p{};
    for (int i = 0; i < 32; ++i) p.in[i] = (const float*)d_in[i];
    p.out = (float*)d_out; p.ws = (unsigned char*)d_ws;
#if defined(TIMING_REPEAT_LO)
    { const int cuts[4][2] = {{0, TIMING_REPEAT_HI}, {TIMING_REPEAT_LO, TIMING_REPEAT_HI}, {TIMING_REPEAT_HI, NPHASE}, {0, 0}};
      for (int li = 0; li < 3; ++li) { if (cuts[li][0] >= cuts[li][1]) continue; p.ph_lo = cuts[li][0]; p.ph_hi = cuts[li][1]; p.li = li; hipLaunchKernelGGL(fwd, dim3(grid), dim3(512), LDS_BYTES, stream, p); } }
#else
    if (N_LAUNCH_MODE == 1) { p.ph_lo = 0; p.ph_hi = NPHASE; hipLaunchKernelGGL(fwd, dim3(grid), dim3(512), LDS_BYTES, stream, p); }
    else for (int k = 0; k < NPHASE; ++k) { p.ph_lo = k; p.ph_hi = k + 1; hipLaunchKernelGGL(fwd, dim3(grid), dim3(512), LDS_BYTES, stream, p); }
#endif
}
```

```cpp
#include <hip/hip_runtime.h>
#include <cstdio>
#include <cstdint>

#define LAS __attribute__((address_space(3)))
#define GAS __attribute__((address_space(1)))
typedef unsigned short bf16_t;
typedef short bf16x8 __attribute__((ext_vector_type(8)));
typedef float f32x4 __attribute__((ext_vector_type(4)));
typedef float f32x2 __attribute__((ext_vector_type(2)));
typedef float f32x16 __attribute__((ext_vector_type(16)));
typedef unsigned u32x4 __attribute__((ext_vector_type(4)));
typedef unsigned u32x2 __attribute__((ext_vector_type(2)));

#ifndef N_LAUNCH_MODE
#define N_LAUNCH_MODE 1
#endif

constexpr int M = 16384, D = 2048, SEQ = 4096, NBATCH = 4;
constexpr int RWC = 6592;
constexpr int PC = 15360;
constexpr int ATT0 = 6656, GATE0 = 11264;
constexpr int NEXP = 32, DFF = 2048, CAP = 16384;
constexpr int HROWS = 65536 + 32 * 256;
constexpr float LN_EPS = 1e-5f, GN_EPS = 64e-5f;
constexpr float DN_ALPHA = 1.189207115002721f;

__device__ __forceinline__ float bf2f(unsigned v) { return __uint_as_float(v << 16); }
__device__ __forceinline__ unsigned f2bf(float f) { unsigned u = __float_as_uint(f); return (u + 0x7fffu + ((u >> 16) & 1u)) >> 16; }
__device__ __forceinline__ unsigned pk2(float lo, float hi) { return f2bf(lo) | (f2bf(hi) << 16); }
typedef int v4i __attribute__((ext_vector_type(4)));
typedef int v8i __attribute__((ext_vector_type(8)));
__device__ __forceinline__ unsigned pk4_fp8(float a, float b, float c, float d) { int r = __builtin_amdgcn_cvt_pk_fp8_f32(a, b, 0, false); r = __builtin_amdgcn_cvt_pk_fp8_f32(c, d, r, true); return (unsigned)r; }
__device__ __forceinline__ float sigmoidf_(float x) { return 1.0f / (1.0f + __expf(-x)); }
__device__ __forceinline__ float wave_sum(float v) {
#pragma unroll
    for (int o = 1; o < 64; o <<= 1) v += __shfl_xor(v, o);
    return v;
}
#define LDS_WAIT() asm volatile("s_waitcnt lgkmcnt(0)" ::: "memory")
#define VM_WAIT() asm volatile("s_waitcnt vmcnt(0)" ::: "memory")

namespace pg8 {
#define PG8_LAS __attribute__((address_space(3)))
constexpr int BM = 256, BK = 64, HALF = 128, HTB = HALF * BK * 2, STAGE_BYTES = 8 * HTB, NXCD = 8, WGM = 8;

__host__ __device__ __forceinline__ int lds_byte(int r, int c) { const int st = (r >> 4) * 2 + (c >> 5), rr = r & 15, cc = c & 31, ob = rr * 64 + cc * 2; return st * 1024 + (ob ^ (((ob >> 9) & 1) << 5)); }
__host__ __device__ __forceinline__ void stage_rc(int b, int& R, int& C) { const int st = b / 1024, sb = b % 1024, swz = sb ^ (((sb >> 9) & 1) << 5); R = (st >> 1) * 16 + swz / 64; C = (st & 1) * 32 + (swz % 64) / 2; }
__host__ __device__ __forceinline__ int perm32(int rho) { const int n = rho >> 4, i = rho & 15; return 8 * (i >> 2) + 4 * n + (i & 3); }

struct Unit { const char* A; const char* B; int orow, ocol, aux, aux2, valid; };
struct Gemm { int K, lda, ldb; };

struct StaticOrder {
    static constexpr bool GATHER = false;
    const char* A; const char* Bt; size_t ta, tb;
    int nM, nN, nwg, G, c;
    __device__ void init(const void* A_, const void* Bt_, int M_, int N_, int lda, int ldb, int G_, int c_) { A = (const char*)A_; Bt = (const char*)Bt_; ta = (size_t)BM * lda * 2; tb = (size_t)BM * ldb * 2; nM = M_ / BM; nN = N_ / BM; nwg = nM * nN; G = G_; c = c_; }
    __device__ bool next(int i, Unit& u) const {
        const long L = (long)i * G + c; if (c < 0 || L >= nwg) return false;
        int wgid = (int)L; { const int q = nwg / NXCD, r = nwg % NXCD, xcd = wgid % NXCD, off = wgid / NXCD; wgid = (xcd < r ? xcd * (q + 1) : r * (q + 1) + (xcd - r) * q) + off; }
        const int nig = WGM * nN, gid = wgid / nig, fm = gid * WGM, gsz = (nM - fm) < WGM ? (nM - fm) : WGM;
        const int pm = fm + ((wgid % nig) % gsz), pn = (wgid % nig) / gsz;
        u.A = A + (size_t)pm * ta; u.B = Bt + (size_t)pn * tb; u.orow = pm * BM; u.ocol = pn * BM; u.aux = 0; u.aux2 = 0; u.valid = BM; return true;
    }
    __device__ __forceinline__ const int* rows(const Unit&) const { return nullptr; }
};

__device__ __forceinline__ unsigned cvt_pk_bf16(float lo, float hi) { unsigned r; asm volatile("v_cvt_pk_bf16_f32 %0, %1, %2" : "=v"(r) : "v"(lo), "v"(hi)); return r; }

template <class Epi, class Sched, bool ALIGN_EPI = true, bool FP8 = false>
__device__ __forceinline__ void gemm_phase(PG8_LAS unsigned char* lds, const Gemm g, const Sched& S, const Epi& E) {
    const int tid = threadIdx.x, wid = __builtin_amdgcn_readfirstlane(tid >> 6), lane = tid & 63, wr = wid >> 2, wc = wid & 3, fr = lane & 15, fq = lane >> 4;
    constexpr int ES = FP8 ? 1 : 2;
    int sclW = 0, sclX = 0;
    if constexpr (FP8) { asm volatile("v_mov_b32 %0, 0x79797979\n\tv_mov_b32 %1, 0x7f7f7f7f" : "=v"(sclW), "=v"(sclX)); }
    const int K = g.K, nt = K * ES / (BK * 2);
    unsigned voffA[2], voffB[2]; int Rr[2], Cc[2];
#pragma unroll
    for (int i = 0; i < 2; ++i) { int R, C; stage_rc(tid * 16 + i * 8192, R, C); const int Rb = Epi::PERM ? ((R & ~31) + perm32(R & 31)) : R; Rr[i] = R; Cc[i] = C;
        voffA[i] = (unsigned)(R * g.lda * ES + C * 2); voffB[i] = (unsigned)(Rb * g.ldb * ES + C * 2); }
    const size_t kstep = (size_t)(BK * 2);
    const size_t hstepA = (size_t)HALF * g.lda * ES, hstepB = (size_t)HALF * g.ldb * ES;
    const unsigned ldsw = (unsigned)wid * 1024u;
    const int aoff = lds_byte(wr * 64 + fr, fq * 8), boff = lds_byte(wc * 32 + fr, fq * 8);
    unsigned vAc[2][2], vAn[2][2];
#define PG8_SA(b, h) (((b) * 2 + (h)) * HTB)
#define PG8_SB(b, h) ((4 + (b) * 2 + (h)) * HTB)
#define PG8_STAGE(bufoff, gbase, voff) do { _Pragma("unroll") for (int _i = 0; _i < 2; ++_i) \
        __builtin_amdgcn_global_load_lds((const unsigned*)((const char*)(gbase) + (voff)[_i]), (PG8_LAS unsigned*)(lds + (bufoff) + ldsw + _i * 8192), 16, 0, 0); } while (0)
#define PG8_STAGE_A(bufoff, kbase, h, nx) do { if constexpr (Sched::GATHER) { unsigned _v[2] = {(nx) ? vAn[h][0] : vAc[h][0], (nx) ? vAn[h][1] : vAc[h][1]}; PG8_STAGE(bufoff, kbase, _v); } \
        else { PG8_STAGE(bufoff, (kbase) + (h) * hstepA, voffA); } } while (0)
#define PG8_GOFF(u, v) do { const int* _rw = S.rows(u); _Pragma("unroll") for (int _h = 0; _h < 2; ++_h) _Pragma("unroll") for (int _i = 0; _i < 2; ++_i) { const int _r = Rr[_i] + _h * HALF; \
        const int _tk = _r < (u).valid ? _rw[_r] : 0; v[_h][_i] = (unsigned)(_tk * g.lda * ES + Cc[_i] * 2); } } while (0)
#define PG8_LDA(dst, b, h) do { _Pragma("unroll") for (int m = 0; m < 4; ++m) _Pragma("unroll") for (int k = 0; k < 2; ++k) dst[m][k] = *(const PG8_LAS bf16x8*)(lds + PG8_SA(b, h) + aoff + m * 2048 + k * 1024); } while (0)
#define PG8_LDB(dst, b, h) do { _Pragma("unroll") for (int n = 0; n < 2; ++n) _Pragma("unroll") for (int k = 0; k < 2; ++k) dst[n][k] = *(const PG8_LAS bf16x8*)(lds + PG8_SB(b, h) + boff + n * 2048 + k * 1024); } while (0)
#define PG8_MMA(ai, bj, At, Bt) do { __builtin_amdgcn_s_setprio(1); _Pragma("unroll") for (int m = 0; m < 4; ++m) _Pragma("unroll") for (int n = 0; n < 2; ++n) { \
        if constexpr (FP8) { const v4i _b0 = __builtin_bit_cast(v4i, Bt[n][0]), _b1 = __builtin_bit_cast(v4i, Bt[n][1]), _a0 = __builtin_bit_cast(v4i, At[m][0]), _a1 = __builtin_bit_cast(v4i, At[m][1]); \
            const v8i _bb = __builtin_shufflevector(_b0, _b1, 0, 1, 2, 3, 4, 5, 6, 7), _aa = __builtin_shufflevector(_a0, _a1, 0, 1, 2, 3, 4, 5, 6, 7); \
            asm volatile("v_mfma_scale_f32_16x16x128_f8f6f4 %0, %1, %2, %0, %3, %4 op_sel_hi:[0,0,0]" : "+v"(acc[ai][bj][m][n]) : "v"(_bb), "v"(_aa), "v"(sclW), "v"(sclX)); } \
        else { _Pragma("unroll") for (int k = 0; k < 2; ++k) acc[ai][bj][m][n] = __builtin_amdgcn_mfma_f32_16x16x32_bf16(Bt[n][k], At[m][k], acc[ai][bj][m][n], 0, 0, 0); } } \
        __builtin_amdgcn_s_setprio(0); } while (0)
#define PG8_WAIT_V(n) asm volatile("s_waitcnt vmcnt(" #n ")" ::: "memory")
#define PG8_WAIT_L(n) asm volatile("s_waitcnt lgkmcnt(" #n ")" ::: "memory")
#define PG8_BAR __builtin_amdgcn_s_barrier()
#define PG8_SCHED __builtin_amdgcn_sched_barrier(0)
    Unit cur, nxt; int ui = 0;
    if (!S.next(0, cur)) return;
    f32x4 acc[2][2][4][2];
#pragma unroll
    for (int a = 0; a < 2; ++a)
#pragma unroll
        for (int b = 0; b < 2; ++b)
#pragma unroll
            for (int m = 0; m < 4; ++m)
#pragma unroll
                for (int n = 0; n < 2; ++n) acc[a][b][m][n] = (f32x4){0.f, 0.f, 0.f, 0.f};
    bf16x8 At[4][2], B0[2][2], B1[2][2];
    const char* cA = cur.A; const char* cB = cur.B;
    if constexpr (Sched::GATHER) { PG8_GOFF(cur, vAc); PG8_WAIT_V(0); }
    PG8_STAGE(PG8_SB(0, 0), cB, voffB); PG8_STAGE(PG8_SB(0, 1), cB + hstepB, voffB); PG8_STAGE_A(PG8_SA(0, 0), cA, 0, false); PG8_STAGE_A(PG8_SA(0, 1), cA, 1, false);
    if (wr == 1) PG8_BAR;
    PG8_WAIT_V(2); PG8_BAR;
    PG8_STAGE(PG8_SB(1, 0), cB + kstep, voffB); PG8_STAGE_A(PG8_SA(1, 0), cA + kstep, 0, false); PG8_STAGE(PG8_SB(1, 1), cB + hstepB + kstep, voffB);
    PG8_WAIT_V(6); PG8_BAR;
    for (;;) {
        const bool has_next = S.next(ui + 1, nxt);
        const char* nA = has_next ? nxt.A : cA; const char* nB = has_next ? nxt.B : cB;
        if constexpr (Sched::GATHER) { if (has_next) { PG8_GOFF(nxt, vAn); } else {
#pragma unroll
            for (int h = 0; h < 2; ++h)
#pragma unroll
                for (int i = 0; i < 2; ++i) vAn[h][i] = vAc[h][i]; } }
#pragma nounroll
        for (int t = 0; t < nt; t += 2) {
            const bool last = (t == nt - 2);
            const char* a1 = cA + (size_t)(t + 1) * kstep;
            const char* a2 = last ? nA : cA + (size_t)(t + 2) * kstep; const char* b2 = last ? nB : cB + (size_t)(t + 2) * kstep;
            const char* a3 = a2 + kstep; const char* b3 = b2 + kstep;
            PG8_LDB(B0, 0, 0); PG8_LDB(B1, 0, 1); PG8_SCHED; PG8_LDA(At, 0, 0); PG8_STAGE_A(PG8_SA(1, 1), a1, 1, false);
            PG8_WAIT_V(8); PG8_WAIT_L(0); PG8_BAR; PG8_MMA(0, 0, At, B0); PG8_MMA(0, 1, At, B1); PG8_BAR; PG8_SCHED;
            PG8_LDA(At, 0, 1); PG8_STAGE(PG8_SB(0, 0), b2, voffB); PG8_STAGE(PG8_SB(0, 1), b2 + hstepB, voffB); PG8_STAGE_A(PG8_SA(0, 0), a2, 0, last);
            PG8_WAIT_V(8); PG8_WAIT_L(0); PG8_BAR; PG8_MMA(1, 0, At, B0); PG8_MMA(1, 1, At, B1); PG8_BAR; PG8_SCHED;
            PG8_LDB(B0, 1, 0); PG8_LDB(B1, 1, 1); PG8_SCHED; PG8_LDA(At, 1, 0); PG8_STAGE_A(PG8_SA(0, 1), a2, 1, last);
            PG8_WAIT_V(8); PG8_WAIT_L(0); PG8_BAR; PG8_MMA(0, 0, At, B0); PG8_MMA(0, 1, At, B1); PG8_BAR; PG8_SCHED;
            PG8_LDA(At, 1, 1); PG8_STAGE(PG8_SB(1, 0), b3, voffB); PG8_STAGE(PG8_SB(1, 1), b3 + hstepB, voffB); PG8_STAGE_A(PG8_SA(1, 0), a3, 0, last);
            PG8_WAIT_V(8); PG8_WAIT_L(0); PG8_BAR; PG8_MMA(1, 0, At, B0); PG8_MMA(1, 1, At, B1); PG8_BAR; PG8_SCHED;
        }
        if constexpr (ALIGN_EPI) { if (wr == 0) PG8_BAR; }
        if constexpr (FP8) asm volatile("s_nop 15\n\ts_nop 15" ::: "memory");
        if constexpr (!Epi::AFTER_DRAIN) { int l2 = lane; asm volatile("" : "+v"(l2));
            E(acc, cur, wr, wc, l2 & 15, l2 >> 4); }
        if (!has_next) break;
#pragma unroll
        for (int a = 0; a < 2; ++a)
#pragma unroll
            for (int b = 0; b < 2; ++b)
#pragma unroll
                for (int m = 0; m < 4; ++m)
#pragma unroll
                    for (int n = 0; n < 2; ++n) acc[a][b][m][n] = (f32x4){0.f, 0.f, 0.f, 0.f};
        cur = nxt; cA = nA; cB = nB; ++ui;
        if constexpr (Sched::GATHER) {
#pragma unroll
            for (int h = 0; h < 2; ++h)
#pragma unroll
                for (int i = 0; i < 2; ++i) vAc[h][i] = vAn[h][i]; }
        if constexpr (ALIGN_EPI) { if (wr == 1) PG8_BAR; }
    }
    PG8_WAIT_V(0);
    if constexpr (!ALIGN_EPI) { if (wr == 0) PG8_BAR; }
    PG8_BAR;
    if constexpr (Epi::AFTER_DRAIN) { E.fused(acc, cur, wr, wc, fr, fq, lds, wid, lane); }
#undef PG8_SA
#undef PG8_SB
#undef PG8_STAGE
#undef PG8_STAGE_A
#undef PG8_GOFF
#undef PG8_LDA
#undef PG8_LDB
#undef PG8_MMA
#undef PG8_WAIT_V
#undef PG8_WAIT_L
#undef PG8_BAR
#undef PG8_SCHED
}

#define EPI_LOOP_AI_M for (int ai = 0; ai < 2; ++ai) _Pragma("unroll") for (int m = 0; m < 4; ++m)

struct EpiF32 {
    static constexpr bool PERM = false, AFTER_DRAIN = false;
    float* C; int ldc; const float* bias; int bstride; const float* res; float alpha;
    __device__ __forceinline__ void operator()(const f32x4 (&acc)[2][2][4][2], const Unit& u, int wr, int wc, int fr, int fq) const {
        const int row0 = u.orow + wr * 64 + fr, col0 = u.ocol + wc * 32 + 4 * fq;
        f32x4 bv[2][2];
#pragma unroll
        for (int bj = 0; bj < 2; ++bj)
#pragma unroll
            for (int n = 0; n < 2; ++n) bv[bj][n] = bias ? *(const f32x4*)(bias + (size_t)u.aux * bstride + col0 + bj * HALF + n * 16) : (f32x4){0.f, 0.f, 0.f, 0.f};
#pragma unroll
        EPI_LOOP_AI_M { const size_t off = (size_t)(row0 + ai * HALF + m * 16) * ldc + col0;
#pragma unroll
            for (int bj = 0; bj < 2; ++bj)
#pragma unroll
                for (int n = 0; n < 2; ++n) { f32x4 v = acc[ai][bj][m][n] + bv[bj][n];
                    if (res) { const f32x4 rv = *(const f32x4*)(res + off + bj * HALF + n * 16); v = v + rv * alpha; }
                    *(f32x4*)(C + off + bj * HALF + n * 16) = v; }
            asm volatile("" ::: "memory"); }
    }
};
struct EpiBf16 {
    static constexpr bool PERM = true, AFTER_DRAIN = false;
    bf16_t* O; int ldc; float scale;
    __device__ __forceinline__ void operator()(const f32x4 (&acc)[2][2][4][2], const Unit& u, int wr, int wc, int fr, int fq) const {
        const int row0 = u.orow + wr * 64 + fr, col0 = u.ocol + wc * 32 + 8 * fq;
#pragma unroll
        EPI_LOOP_AI_M { bf16_t* rowp = O + (size_t)(row0 + ai * HALF + m * 16) * ldc + col0;
#pragma unroll
            for (int bj = 0; bj < 2; ++bj) { const f32x4 v0 = acc[ai][bj][m][0] * scale, v1 = acc[ai][bj][m][1] * scale;
                u32x4 w; w.x = cvt_pk_bf16(v0[0], v0[1]); w.y = cvt_pk_bf16(v0[2], v0[3]); w.z = cvt_pk_bf16(v1[0], v1[1]); w.w = cvt_pk_bf16(v1[2], v1[3]);
                *(u32x4*)(rowp + bj * HALF) = w; } }
    }
};
struct EpiKV {
    static constexpr bool PERM = true, AFTER_DRAIN = false;
    bf16_t* KB; bf16_t* VT;
    __device__ __forceinline__ void operator()(const f32x4 (&acc)[2][2][4][2], const Unit& u, int wr, int wc, int fr, int fq) const {
        const int row0 = u.orow + wr * 64 + fr, col0 = u.ocol + wc * 32 + 8 * fq;
#pragma unroll
        EPI_LOOP_AI_M { const int row = row0 + ai * HALF + m * 16;
#pragma unroll
            for (int bj = 0; bj < 2; ++bj) { const f32x4 v0 = acc[ai][bj][m][0], v1 = acc[ai][bj][m][1]; const int col = col0 + bj * HALF;
                if (u.ocol < 2048) { u32x4 w; w.x = cvt_pk_bf16(v0[0], v0[1]); w.y = cvt_pk_bf16(v0[2], v0[3]); w.z = cvt_pk_bf16(v1[0], v1[1]); w.w = cvt_pk_bf16(v1[2], v1[3]);
                    *(u32x4*)(KB + (size_t)row * 2048 + col) = w; }
                else { const int b = row >> 8, key = row & 255, c = col - 2048, h = c >> 9, d = c & 511; bf16_t* p = VT + ((size_t)((b * 4 + h) * 512 + d)) * 256 + key;
#pragma unroll
                    for (int j = 0; j < 4; ++j) { p[(size_t)j * 256] = (bf16_t)f2bf(v0[j]); p[(size_t)(4 + j) * 256] = (bf16_t)f2bf(v1[j]); } } } }
    }
};
struct EpiDecay {
    static constexpr bool PERM = false, AFTER_DRAIN = false;
    float* DEC; const float* w0;
    __device__ __forceinline__ void operator()(const f32x4 (&acc)[2][2][4][2], const Unit& u, int wr, int wc, int fr, int fq) const {
        const int row0 = u.orow + wr * 64 + fr, col0 = u.ocol + wc * 32 + 4 * fq;
        f32x4 bv[2][2];
#pragma unroll
        for (int bj = 0; bj < 2; ++bj)
#pragma unroll
            for (int n = 0; n < 2; ++n) bv[bj][n] = *(const f32x4*)(w0 + col0 + bj * HALF + n * 16);
#pragma unroll
        EPI_LOOP_AI_M { const size_t off = (size_t)(row0 + ai * HALF + m * 16) * D + col0;
#pragma unroll
            for (int bj = 0; bj < 2; ++bj)
#pragma unroll
                for (int n = 0; n < 2; ++n) { const f32x4 x = acc[ai][bj][m][n] + bv[bj][n]; f32x4 o;
#pragma unroll
                    for (int j = 0; j < 4; ++j) o[j] = __expf(-0.6065306597126334f * sigmoidf_(x[j]));
                    *(f32x4*)(DEC + off + bj * HALF + n * 16) = o; } }
    }
};
struct EpiIclr {
    static constexpr bool PERM = false, AFTER_DRAIN = false;
    const float* a0; const float* k_k; const float* k_a; const float* KZ; const float* KNORM; float* KP; float* AN; float* BB;
    __device__ __forceinline__ void operator()(const f32x4 (&acc)[2][2][4][2], const Unit& u, int wr, int wc, int fr, int fq) const {
        const int row0 = u.orow + wr * 64 + fr, col0 = u.ocol + wc * 32 + 4 * fq;
#pragma unroll
        for (int bj = 0; bj < 2; ++bj)
#pragma unroll
            for (int n = 0; n < 2; ++n) { const int col = col0 + bj * HALF + n * 16;
                const f32x4 a0v = *(const f32x4*)(a0 + col), kkv = *(const f32x4*)(k_k + col), kav = *(const f32x4*)(k_a + col);
#pragma unroll
                EPI_LOOP_AI_M { const int row = row0 + ai * HALF + m * 16; const size_t off = (size_t)row * D + col;
                    const f32x4 kz = *(const f32x4*)(KZ + off); const float nr = KNORM[(size_t)row * 32 + (col >> 6)]; const float inv = 1.0f / fmaxf(nr, 1e-12f);
                    const f32x4 x = acc[ai][bj][m][n] + a0v; f32x4 kp, an, bb;
#pragma unroll
                    for (int j = 0; j < 4; ++j) { const float a = sigmoidf_(x[j]); const float kk = kz[j] * kkv[j] * inv; kp[j] = kz[j] * (1.0f + (a - 1.0f) * kav[j]); bb[j] = kk * a; an[j] = -kk; }
                    *(f32x4*)(KP + off) = kp; *(f32x4*)(AN + off) = an; *(f32x4*)(BB + off) = bb; }
                asm volatile("" ::: "memory"); }
    }
};
struct EpiGateA {
    static constexpr bool PERM = false, AFTER_DRAIN = false;
    const bf16_t* PROJ; float* TMP;
    __device__ __forceinline__ void operator()(const f32x4 (&acc)[2][2][4][2], const Unit& u, int wr, int wc, int fr, int fq) const {
        const int row0 = u.orow + wr * 64 + fr, col0 = u.ocol + wc * 32 + 4 * fq;
#pragma unroll
        EPI_LOOP_AI_M { const int row = row0 + ai * HALF + m * 16;
#pragma unroll
            for (int bj = 0; bj < 2; ++bj)
#pragma unroll
                for (int n = 0; n < 2; ++n) { const int col = col0 + bj * HALF + n * 16; const u32x2 gv = *(const u32x2*)(PROJ + (size_t)row * PC + GATE0 + col);
                    const f32x4 a = acc[ai][bj][m][n]; f32x4 o;
                    o[0] = a[0] * sigmoidf_(bf2f(gv.x & 0xffffu)); o[1] = a[1] * sigmoidf_(bf2f(gv.x >> 16)); o[2] = a[2] * sigmoidf_(bf2f(gv.y & 0xffffu)); o[3] = a[3] * sigmoidf_(bf2f(gv.y >> 16));
                    *(f32x4*)(TMP + (size_t)row * D + col) = o; } }
    }
};
struct EpiGateB {
    static constexpr bool PERM = true, AFTER_DRAIN = false;
    const bf16_t* PROJ; const float* TMP; bf16_t* MERGED;
    __device__ __forceinline__ void operator()(const f32x4 (&acc)[2][2][4][2], const Unit& u, int wr, int wc, int fr, int fq) const {
        const int row0 = u.orow + wr * 64 + fr, col0 = u.ocol + wc * 32 + 8 * fq;
#pragma unroll
        EPI_LOOP_AI_M { const int row = row0 + ai * HALF + m * 16;
#pragma unroll
            for (int bj = 0; bj < 2; ++bj) { const int col = col0 + bj * HALF; const u32x4 gv = *(const u32x4*)(PROJ + (size_t)row * PC + GATE0 + 2048 + col);
                const f32x4 t0 = *(const f32x4*)(TMP + (size_t)row * D + col), t1 = *(const f32x4*)(TMP + (size_t)row * D + col + 4);
                const f32x4 a0 = acc[ai][bj][m][0], a1 = acc[ai][bj][m][1]; f32x4 o0, o1;
                o0[0] = t0[0] + a0[0] * sigmoidf_(bf2f(gv.x & 0xffffu)); o0[1] = t0[1] + a0[1] * sigmoidf_(bf2f(gv.x >> 16)); o0[2] = t0[2] + a0[2] * sigmoidf_(bf2f(gv.y & 0xffffu)); o0[3] = t0[3] + a0[3] * sigmoidf_(bf2f(gv.y >> 16));
                o1[0] = t1[0] + a1[0] * sigmoidf_(bf2f(gv.z & 0xffffu)); o1[1] = t1[1] + a1[1] * sigmoidf_(bf2f(gv.z >> 16)); o1[2] = t1[2] + a1[2] * sigmoidf_(bf2f(gv.w & 0xffffu)); o1[3] = t1[3] + a1[3] * sigmoidf_(bf2f(gv.w >> 16));
                u32x4 w; w.x = cvt_pk_bf16(o0[0], o0[1]); w.y = cvt_pk_bf16(o0[2], o0[3]); w.z = cvt_pk_bf16(o1[0], o1[1]); w.w = cvt_pk_bf16(o1[2], o1[3]);
                *(u32x4*)(MERGED + (size_t)row * D + col) = w; }
            asm volatile("" ::: "memory"); }
    }
};
struct EpiSwiglu {
    static constexpr bool PERM = true, AFTER_DRAIN = false;
    const float* b1; bf16_t* H;
    __device__ __forceinline__ float sw(float g, float l) const { g = fminf(g, 7.0f); l = fminf(fmaxf(l, -7.0f), 7.0f); return g * sigmoidf_(1.702f * g) * (l + 1.0f); }
    __device__ __forceinline__ void operator()(const f32x4 (&acc)[2][2][4][2], const Unit& u, int wr, int wc, int fr, int fq) const {
        const int row0 = u.orow + wr * 64 + fr, col0 = u.ocol + wc * 32 + 8 * fq;
        f32x4 bv[2][2];
#pragma unroll
        for (int bj = 0; bj < 2; ++bj)
#pragma unroll
            for (int n = 0; n < 2; ++n) bv[bj][n] = *(const f32x4*)(b1 + (size_t)u.aux * 4096 + col0 + bj * HALF + 4 * n);
#pragma unroll
        EPI_LOOP_AI_M { const int row = row0 + ai * HALF + m * 16;
#pragma unroll
            for (int bj = 0; bj < 2; ++bj) { const f32x4 v0 = acc[ai][bj][m][0] + bv[bj][0], v1 = acc[ai][bj][m][1] + bv[bj][1];
                *(unsigned*)((unsigned char*)H + (size_t)row * DFF + ((col0 + bj * HALF) >> 1)) = pk4_fp8(sw(v0[0], v0[1]), sw(v0[2], v0[3]), sw(v1[0], v1[1]), sw(v1[2], v1[3])); } }
    }
};
struct EpiSoftmax {
    static constexpr bool PERM = true, AFTER_DRAIN = true;
    bf16_t* PP;
    __device__ __forceinline__ void fused(f32x4 (&acc)[2][2][4][2], const Unit& u, int wr, int wc, int fr, int fq, PG8_LAS unsigned char* lds, int wid, int lane) const {
        PG8_LAS float* P1 = (PG8_LAS float*)lds;
        PG8_LAS float* P2 = (PG8_LAS float*)(lds + 4096);
        float mx[2][4];
#pragma unroll
        EPI_LOOP_AI_M { float v = -3.0e38f;
#pragma unroll
            for (int bj = 0; bj < 2; ++bj)
#pragma unroll
                for (int n = 0; n < 2; ++n) { const f32x4 x = acc[ai][bj][m][n]; v = fmaxf(v, fmaxf(fmaxf(x[0], x[1]), fmaxf(x[2], x[3]))); }
            v = fmaxf(v, __shfl_xor(v, 16)); v = fmaxf(v, __shfl_xor(v, 32));
            if (fq == 0) P1[(ai * HALF + wr * 64 + m * 16 + fr) * 4 + wc] = v; }
        asm volatile("s_waitcnt lgkmcnt(0)" ::: "memory"); __builtin_amdgcn_s_barrier(); asm volatile("" ::: "memory");
#pragma unroll
        EPI_LOOP_AI_M { const f32x4 t = *(const PG8_LAS f32x4*)(P1 + (ai * HALF + wr * 64 + m * 16 + fr) * 4); mx[ai][m] = fmaxf(fmaxf(t[0], t[1]), fmaxf(t[2], t[3])); }
#pragma unroll
        EPI_LOOP_AI_M { float s = 0.f;
#pragma unroll
            for (int bj = 0; bj < 2; ++bj)
#pragma unroll
                for (int n = 0; n < 2; ++n) { f32x4 x = acc[ai][bj][m][n];
#pragma unroll
                    for (int j = 0; j < 4; ++j) { x[j] = __expf(x[j] - mx[ai][m]); s += x[j]; }
                    acc[ai][bj][m][n] = x; }
            s += __shfl_xor(s, 16); s += __shfl_xor(s, 32);
            if (fq == 0) P2[(ai * HALF + wr * 64 + m * 16 + fr) * 4 + wc] = s; }
        asm volatile("s_waitcnt lgkmcnt(0)" ::: "memory"); __builtin_amdgcn_s_barrier(); asm volatile("" ::: "memory");
        const int row0 = u.orow + wr * 64 + fr, col0 = wc * 32 + 8 * fq;
#pragma unroll
        EPI_LOOP_AI_M { const f32x4 t = *(const PG8_LAS f32x4*)(P2 + (ai * HALF + wr * 64 + m * 16 + fr) * 4); const float inv = 1.0f / ((t[0] + t[1]) + (t[2] + t[3]));
            bf16_t* rowp = PP + (size_t)(row0 + ai * HALF + m * 16) * 256 + col0;
#pragma unroll
            for (int bj = 0; bj < 2; ++bj) { const f32x4 v0 = acc[ai][bj][m][0] * inv, v1 = acc[ai][bj][m][1] * inv;
                u32x4 w; w.x = cvt_pk_bf16(v0[0], v0[1]); w.y = cvt_pk_bf16(v0[2], v0[3]); w.z = cvt_pk_bf16(v1[0], v1[1]); w.w = cvt_pk_bf16(v1[2], v1[3]);
                *(u32x4*)(rowp + bj * HALF) = w; } }
        asm volatile("s_waitcnt lgkmcnt(0)" ::: "memory"); __builtin_amdgcn_s_barrier(); asm volatile("" ::: "memory");
    }
};
}

constexpr size_t MiB = 1u << 20;
constexpr size_t al256(size_t x) { return (x + 255) & ~(size_t)255; }
constexpr size_t WS_CTL = 0, CTL_ZERO_BYTES = 1 * MiB;
constexpr size_t WS_WIN = 1 * MiB;
constexpr size_t WS_WUP = WS_WIN + (size_t)PC * D * 2;
constexpr size_t WS_AUP = WS_WUP + (size_t)D * 256 * 2;
constexpr size_t WS_GUP = WS_AUP + (size_t)D * 256 * 2;
constexpr size_t WS_PA = WS_GUP + (size_t)D * 256 * 2;
constexpr size_t WS_PB = WS_PA + (size_t)D * D * 2;
constexpr size_t WS_WOUT = WS_PB + (size_t)D * 512 * 2;
constexpr size_t WS_WQ = WS_WOUT + (size_t)D * D * 2;
constexpr size_t WS_WKV = WS_WQ + (size_t)D * D * 2;
constexpr size_t WS_WO = WS_WKV + (size_t)2 * D * D * 2;
constexpr size_t WS_W1 = WS_WO + (size_t)D * D * 2;
constexpr size_t WS_W2 = WS_W1 + (size_t)NEXP * 4096 * D * 2;
constexpr size_t WS_XB = WS_W2 + (size_t)NEXP * D * DFF * 2;
constexpr size_t WS_MEMB = WS_XB + (size_t)M * D * 2;
constexpr size_t WS_ROT = WS_MEMB + (size_t)1024 * D * 2;
constexpr size_t WS_KB = WS_ROT + (size_t)2 * SEQ * 32 * 4;
constexpr size_t WS_VT = WS_KB + (size_t)1024 * D * 2;
constexpr size_t WS_YA = WS_VT + (size_t)1024 * D * 2;
constexpr size_t WS_YB = WS_YA + (size_t)M * D * 2;
constexpr size_t WS_TMP = WS_YB + (size_t)M * 512 * 2;
constexpr size_t WS_MERGED = WS_TMP + (size_t)M * D * 4;
constexpr size_t WS_E = WS_MERGED + (size_t)M * D * 2;
constexpr size_t WS_PROJ = WS_E;
constexpr size_t WS_RZ = WS_PROJ + (size_t)M * PC * 2;
constexpr size_t WS_KZ = WS_RZ + (size_t)M * D * 4;
constexpr size_t WS_VZ = WS_KZ + (size_t)M * D * 4;
constexpr size_t WS_DEC = WS_VZ + (size_t)M * D * 4;
constexpr size_t WS_KP = WS_DEC + (size_t)M * D * 4;
constexpr size_t WS_AN = WS_KP + (size_t)M * D * 4;
constexpr size_t WS_BB = WS_AN + (size_t)M * D * 4;
constexpr size_t WS_GG = WS_BB + (size_t)M * D * 4;
constexpr size_t WS_YS = WS_GG + (size_t)M * D * 4;
constexpr size_t WS_AO = WS_YS + (size_t)M * D * 4;
constexpr size_t WS_LSE = WS_AO + (size_t)3 * M * 512 * 4;
constexpr size_t WS_QR = WS_LSE + (size_t)3 * M * 8 * 4;
constexpr size_t WS_KR = WS_QR + (size_t)M * 1536 * 2;
constexpr size_t WS_LIN = WS_KR + (size_t)M * 1536 * 2;
constexpr size_t WS_KNORM = WS_LIN + (size_t)M * 768 * 2;
constexpr size_t WS_F = WS_KNORM + (size_t)M * 32 * 4;
constexpr size_t WS_E_END = WS_F + (size_t)128 * 128 * 96 * 96 * 2;
constexpr size_t WS_T1 = WS_E;
constexpr size_t WS_X1 = WS_T1 + (size_t)M * D * 4;
constexpr size_t WS_X1B = WS_X1 + (size_t)M * D * 4;
constexpr size_t WS_Q = WS_X1B + (size_t)M * D * 2;
constexpr size_t WS_PP = WS_Q + (size_t)M * D * 2;
constexpr size_t WS_OC = WS_PP + (size_t)16 * SEQ * 256 * 2;
constexpr size_t WS_T2 = WS_OC + (size_t)M * D * 2;
constexpr size_t WS_X2 = WS_T2 + (size_t)M * D * 4;
constexpr size_t WS_X2B = WS_X2 + (size_t)M * D * 4;
constexpr size_t WS_LIST = WS_X2B + (size_t)M * D * 2;
constexpr size_t WS_ROWI = WS_LIST + (size_t)NEXP * CAP * 4;
constexpr size_t WS_TOPW = WS_ROWI + (size_t)M * 4 * 4;
constexpr size_t WS_H = WS_TOPW + (size_t)M * 4 * 4;
constexpr size_t WS_Y = WS_H + (size_t)HROWS * DFF * 2;
constexpr size_t WS_L_END = WS_Y + (size_t)HROWS * D * 4;
constexpr size_t WS_END = (WS_E_END > WS_L_END ? WS_E_END : WS_L_END);
static_assert(WS_END <= (size_t)4090 * MiB, "workspace map exceeds 4 x largest input");
constexpr int CW_TMO = 0, CW_CNT = 64  , CW_Q = 128  , CW_BAR = 4096;

constexpr int RING_BYTES = 131072, MISC_OFF = RING_BYTES, LDS_BYTES = 147456;

#define XB_TMO      128
#define XB_XCNT(j)  (256  + 64 * (j))
#define XB_XSUB(j)  (1280 + 64 * (j))
#define XB_XGEN(j)  (2304 + 64 * (j))
#define XB_TOP      3328
#define XB_TOPGEN   3392
#define XCD_BAR_WORDS 3456
#define XB_SPIN_CAP (1u << 18)
__device__ __forceinline__ unsigned xb_ld(unsigned* p)              { return __hip_atomic_load(p, __ATOMIC_RELAXED, __HIP_MEMORY_SCOPE_AGENT); }
__device__ __forceinline__ unsigned xb_add(unsigned* p, unsigned v) { return __hip_atomic_fetch_add(p, v, __ATOMIC_RELAXED, __HIP_MEMORY_SCOPE_AGENT); }
__device__ __forceinline__ unsigned xb_xcc_id() { return (unsigned)__builtin_amdgcn_s_getreg((3 << 11) | 20) & 0xFu; }
#define XB_SPIN(cond, bar) do { unsigned _sp = 0; while (cond) { __builtin_amdgcn_s_sleep(1); \
    if ((++_sp & 255u) == 0u) { if (xb_ld(&(bar)[XB_TMO])) break; if (_sp > XB_SPIN_CAP) { atomicAdd(&(bar)[XB_TMO], 1u); break; } } } } while (0)
struct XcdBarrier { unsigned* bar; unsigned x; volatile LAS unsigned* st; };
__device__ __forceinline__ XcdBarrier xcd_barrier_post(unsigned* bar, volatile LAS unsigned* st) {
    XcdBarrier b; b.bar = bar; b.x = xb_xcc_id(); b.st = st;
    if (threadIdx.x == 0) (void)xb_add(&bar[XB_XCNT(b.x)], 1u);
    return b;
}
__device__ __forceinline__ void xcd_barrier_complete(unsigned* bar, unsigned x, unsigned& nloc, unsigned& nx) {
    const unsigned G = gridDim.x * gridDim.y * gridDim.z;
    unsigned sum, cnt, mine, sp = 0u;
    for (;;) {
        sum = 0u; cnt = 0u; mine = 0u;
#pragma unroll
        for (unsigned j = 0; j < 16; ++j) { const unsigned c = xb_ld(&bar[XB_XCNT(j)]); sum += c; cnt += (c > 0u) ? 1u : 0u; mine = (j == x) ? c : mine; }
        if (sum == G) break;
        __builtin_amdgcn_s_sleep(1);
        if ((++sp & 255u) == 0u) { if (xb_ld(&bar[XB_TMO])) break; if (sp > XB_SPIN_CAP) { atomicAdd(&bar[XB_TMO], 1u); break; } }
    }
    nloc = mine > 0u ? mine : 1u; nx = cnt > 0u ? cnt : 1u;
}
__device__ __forceinline__ void xcd_barrier(const XcdBarrier& b) {
    asm volatile("s_waitcnt vmcnt(0)" ::: "memory");
    __syncthreads();
    if (threadIdx.x == 0) {
        unsigned* bar = b.bar;
        __builtin_amdgcn_s_waitcnt(0);
        unsigned nloc = b.st[0], nx = b.st[1];
        if (nloc == 0u) { xcd_barrier_complete(bar, b.x, nloc, nx); b.st[0] = nloc; b.st[1] = nx; }
        const unsigned old = xb_add(&bar[XB_XSUB(b.x)], 1u);
        const unsigned gen = old / nloc;
        if (old + 1u == (gen + 1u) * nloc) {
            __builtin_amdgcn_fence(__ATOMIC_RELEASE, "agent");
            asm volatile("s_waitcnt vmcnt(0)" ::: "memory");
            const unsigned og = xb_add(&bar[XB_TOP], 1u);
            const unsigned tg = og / nx;
            if (og + 1u == (tg + 1u) * nx) xb_add(&bar[XB_TOPGEN], 1u);
            else XB_SPIN(xb_ld(&bar[XB_TOPGEN]) == tg, bar);
            __builtin_amdgcn_fence(__ATOMIC_ACQUIRE, "agent");
            xb_add(&bar[XB_XGEN(b.x)], 1u);
            asm volatile("s_waitcnt vmcnt(0)" ::: "memory");
        } else {
            XB_SPIN(xb_ld(&bar[XB_XGEN(b.x)]) == gen, bar);
            __builtin_amdgcn_fence(__ATOMIC_ACQUIRE, "agent");
            asm volatile("s_waitcnt vmcnt(0)" ::: "memory");
        }
    }
    __syncthreads();
}

struct Params {
    const float* in[32];
    float* out; unsigned char* ws;
    int ph_lo, ph_hi, li, pad;
};
enum { I_X = 0, I_MEM, I_WIN, I_MIX, I_W0, I_WUP, I_A0, I_AUP, I_GUP, I_KK, I_KA, I_RK, I_LNXG, I_LNXB, I_PA, I_PB, I_WOUT, I_LN1G, I_LN1B, I_WQ, I_WKV, I_WO, I_LN2G, I_LN2B,
       I_RW, I_RB, I_W1, I_B1, I_W2, I_B2, I_LN3G, I_LN3B };

struct ScoreOrder {
    static constexpr bool GATHER = false;
    const char* Q; const char* KB; int G, c;
    __device__ bool next(int i, pg8::Unit& u) const {
        const int L = i * G + c; if (L >= 256) return false;
        const int bh = L >> 4, pm = L & 15, b = bh >> 2, h = bh & 3;
        u.A = Q + ((size_t)(b * SEQ + 256 * pm) * D + h * 512) * 2; u.B = KB + ((size_t)(b * 256) * D + h * 512) * 2;
        u.orow = bh * SEQ + 256 * pm; u.ocol = 0; u.aux = 0; u.aux2 = 0; u.valid = 256; return true;
    }
    __device__ __forceinline__ const int* rows(const pg8::Unit&) const { return nullptr; }
};
struct PvOrder {
    static constexpr bool GATHER = false;
    const char* PP; const char* VT; int G, c;
    __device__ bool next(int i, pg8::Unit& u) const {
        const int L = i * G + c; if (L >= 512) return false;
        const int bh = L >> 5, pm = (L >> 1) & 15, pn = L & 1, b = bh >> 2, h = bh & 3;
        u.A = PP + ((size_t)(bh * SEQ + 256 * pm) * 256) * 2; u.B = VT + ((size_t)(bh * 512 + 256 * pn) * 256) * 2;
        u.orow = b * SEQ + 256 * pm; u.ocol = h * 512 + 256 * pn; u.aux = 0; u.aux2 = 0; u.valid = 256; return true;
    }
    __device__ __forceinline__ const int* rows(const pg8::Unit&) const { return nullptr; }
};
template <bool GATHER_, int NT  > struct MoeOrder {
    static constexpr bool GATHER = GATHER_;
    const LAS int* tab; const char* A; const char* W; const int* list; size_t wexp  ; int ldb; int G, c;
    __device__ bool next(int i, pg8::Unit& u) const {
        constexpr int RPR = 256 / NT;
        const int rt = i * RPR + (c % RPR), pn = c / RPR, T = __builtin_amdgcn_readfirstlane(tab[64]);
        if (c >= 256 || rt >= T) return false;
        int e = 0;
        for (int j = 1; j < NEXP; ++j) e = (rt >= __builtin_amdgcn_readfirstlane(tab[32 + j])) ? j : e;
        const int lt = rt - __builtin_amdgcn_readfirstlane(tab[32 + e]), cnt = __builtin_amdgcn_readfirstlane(tab[e]);
        u.aux = e; u.aux2 = lt; u.valid = min(256, cnt - 256 * lt); u.orow = 256 * rt; u.ocol = 256 * pn;
        u.B = W + (size_t)e * wexp + (size_t)(256 * pn) * ldb;
        u.A = GATHER_ ? A : A + (size_t)(256 * rt) * DFF;
        return true;
    }
    __device__ __forceinline__ const int* rows(const pg8::Unit& u) const { return list + (size_t)u.aux * CAP + 256 * u.aux2; }
};

struct Ctx { int tid, lane, wave, vcu, G; LAS unsigned char* lds; unsigned char* ws; };

__device__ __forceinline__ void tr_item(const float* W, int ldw, int Ksrc, int sc0, bf16_t* WT, int ldt, int n0, int k0, LAS float* scr, int lane) {
#pragma unroll 8
    for (int i = 0; i < 32; ++i) { const int kk = 2 * i + (lane >> 5); float v = 0.f; if (sc0 >= 0 && (k0 + kk) < Ksrc) v = W[(size_t)(k0 + kk) * ldw + sc0 + (lane & 31)]; scr[kk * 33 + (lane & 31)] = v; }
    LDS_WAIT(); asm volatile("" ::: "memory");
    const int c = lane & 7;
#pragma unroll
    for (int j = 0; j < 4; ++j) { const int n = (lane >> 3) + 8 * j; const LAS float* s = scr + (8 * c) * 33 + n;
        u32x4 o; o.x = pk2(s[0 * 33], s[1 * 33]); o.y = pk2(s[2 * 33], s[3 * 33]); o.z = pk2(s[4 * 33], s[5 * 33]); o.w = pk2(s[6 * 33], s[7 * 33]);
        *(u32x4*)(WT + (size_t)(n0 + n) * ldt + k0 + 8 * c) = o; }
    LDS_WAIT(); asm volatile("" ::: "memory");
}
__device__ __forceinline__ void tr_job(const float* W, int N, int Ksrc, int Kdst, bf16_t* WT, int item, LAS float* scr, int lane) {
    const int nblk = N / 32, kb = item / nblk, nb = item % nblk;
    tr_item(W, N, Ksrc, 32 * nb, WT, Kdst, 32 * nb, 64 * kb, scr, lane);
}
__device__ __forceinline__ void p0_prologue(const Params& p, const Ctx& c) {
    LAS float* scr = (LAS float*)(c.lds + c.wave * 16384);
    const int gw = c.vcu * 8 + c.wave, NGW = c.G * 8;
    unsigned char* ws = c.ws;
    constexpr int I_WINJ = 32 * 480, I_LORA = 4 * 64, I_SQ = 32 * 64, I_PBJ = 8 * 64, I_KVJ = 32 * 128, I_W1E = 32 * 128, I_W2E = 32 * 64;
    constexpr int NITEMS = I_WINJ + 3 * I_LORA + 4 * I_SQ + I_PBJ + I_KVJ;
    for (int it = gw; it < NITEMS; it += NGW) {
        int r = it;
        if (r < I_WINJ) { const int kb = r / 480, nb = r % 480; const int sc0 = nb < 206 ? 32 * nb : (nb < 208 ? -1 : 32 * nb - 64);
            tr_item(p.in[I_WIN], 15296, D, sc0, (bf16_t*)(ws + WS_WIN), D, 32 * nb, 64 * kb, scr, c.lane); continue; } r -= I_WINJ;
        if (r < I_LORA) { tr_job(p.in[I_WUP], D, 96, 256, (bf16_t*)(ws + WS_WUP), r, scr, c.lane); continue; } r -= I_LORA;
        if (r < I_LORA) { tr_job(p.in[I_AUP], D, 96, 256, (bf16_t*)(ws + WS_AUP), r, scr, c.lane); continue; } r -= I_LORA;
        if (r < I_LORA) { tr_job(p.in[I_GUP], D, 256, 256, (bf16_t*)(ws + WS_GUP), r, scr, c.lane); continue; } r -= I_LORA;
        if (r < I_SQ) { tr_job(p.in[I_PA], D, D, D, (bf16_t*)(ws + WS_PA), r, scr, c.lane); continue; } r -= I_SQ;
        if (r < I_PBJ) { tr_job(p.in[I_PB], D, 512, 512, (bf16_t*)(ws + WS_PB), r, scr, c.lane); continue; } r -= I_PBJ;
        if (r < I_SQ) { tr_job(p.in[I_WOUT], D, D, D, (bf16_t*)(ws + WS_WOUT), r, scr, c.lane); continue; } r -= I_SQ;
        if (r < I_SQ) { tr_job(p.in[I_WQ], D, D, D, (bf16_t*)(ws + WS_WQ), r, scr, c.lane); continue; } r -= I_SQ;
        if (r < I_KVJ) { tr_job(p.in[I_WKV], 2 * D, D, D, (bf16_t*)(ws + WS_WKV), r, scr, c.lane); continue; } r -= I_KVJ;
        { tr_job(p.in[I_WO], D, D, D, (bf16_t*)(ws + WS_WO), r, scr, c.lane); }
    }
    const size_t gt = (size_t)c.vcu * 512 + c.tid, NT = (size_t)c.G * 512;
    for (size_t i = gt; i < (size_t)M * D / 8; i += NT) { const f32x4 a = ((const f32x4*)p.in[I_X])[2 * i], b = ((const f32x4*)p.in[I_X])[2 * i + 1];
        u32x4 o; o.x = pk2(a[0], a[1]); o.y = pk2(a[2], a[3]); o.z = pk2(b[0], b[1]); o.w = pk2(b[2], b[3]); ((u32x4*)(ws + WS_XB))[i] = o; }
    for (size_t i = gt; i < (size_t)1024 * D / 8; i += NT) { const f32x4 a = ((const f32x4*)p.in[I_MEM])[2 * i], b = ((const f32x4*)p.in[I_MEM])[2 * i + 1];
        u32x4 o; o.x = pk2(a[0], a[1]); o.y = pk2(a[2], a[3]); o.z = pk2(b[0], b[1]); o.w = pk2(b[2], b[3]); ((u32x4*)(ws + WS_MEMB))[i] = o; }
    float* rc = (float*)(ws + WS_ROT); float* rs = rc + SEQ * 32;
    for (size_t i = gt; i < (size_t)SEQ * 32; i += NT) { const int pos = (int)(i >> 5), j = (int)(i & 31);
        const double inv = exp(-(double)j * (9.210340371976184 / 32.0)); const double ang = (double)pos * inv; rc[i] = (float)cos(ang); rs[i] = (float)sin(ang); }
}

__device__ __forceinline__ void tr_store8(unsigned char* WT8, int ldt, int n0, int k0, const LAS float* scr, int lane) {
    const int c = lane & 3;
#pragma unroll
    for (int j = 0; j < 2; ++j) { const int n = (lane >> 2) + 16 * j; const LAS float* sp = scr + (16 * c) * 33 + n; u32x4 o;
        o.x = pk4_fp8(sp[0 * 33] * 64.f, sp[1 * 33] * 64.f, sp[2 * 33] * 64.f, sp[3 * 33] * 64.f); o.y = pk4_fp8(sp[4 * 33] * 64.f, sp[5 * 33] * 64.f, sp[6 * 33] * 64.f, sp[7 * 33] * 64.f);
        o.z = pk4_fp8(sp[8 * 33] * 64.f, sp[9 * 33] * 64.f, sp[10 * 33] * 64.f, sp[11 * 33] * 64.f); o.w = pk4_fp8(sp[12 * 33] * 64.f, sp[13 * 33] * 64.f, sp[14 * 33] * 64.f, sp[15 * 33] * 64.f);
        *(u32x4*)(WT8 + (size_t)(n0 + n) * ldt + k0 + 16 * c) = o; }
}
__device__ __forceinline__ void tr_item8(const float* W, int ldw, unsigned char* WT8, int ldt, int n0, int k0, LAS float* scr, int lane) {
#pragma unroll 8
    for (int i = 0; i < 32; ++i) { const int kk = 2 * i + (lane >> 5); scr[kk * 33 + (lane & 31)] = W[(size_t)(k0 + kk) * ldw + n0 + (lane & 31)]; }
    LDS_WAIT(); asm volatile("" ::: "memory");
    tr_store8(WT8, ldt, n0, k0, scr, lane);
    LDS_WAIT(); asm volatile("" ::: "memory");
}
__device__ __forceinline__ void tr_issue(const float* W, int ldw, int n0, int k0, int lane, float (&cv)[32]) {
#pragma unroll
    for (int i = 0; i < 32; ++i) cv[i] = W[(size_t)(k0 + 2 * i + (lane >> 5)) * ldw + n0 + (lane & 31)];
}
__device__ __forceinline__ void tr_finish(const float (&cv)[32], unsigned char* WT8, int ldt, int n0, int k0, LAS float* scr, int lane) {
#pragma unroll
    for (int i = 0; i < 32; ++i) scr[(2 * i + (lane >> 5)) * 33 + (lane & 31)] = cv[i];
    LDS_WAIT(); asm volatile("" ::: "memory");
    tr_store8(WT8, ldt, n0, k0, scr, lane);
    LDS_WAIT(); asm volatile("" ::: "memory");
}
constexpr int MOE_W1E = 32 * 128, MOE_W2E = 32 * 64, MOE_CONV_GROUPS = (NEXP * MOE_W2E) / 8;
__device__ __forceinline__ void conv_group(const Params& p, const Ctx& c, int gi) {
    LAS float* scr = (LAS float*)(c.lds + c.wave * 16384);
    unsigned char* ws = c.ws;
    const int r = gi * 8 + c.wave;
    { const int e = r / MOE_W2E, it = r % MOE_W2E, kb = it >> 6, nb = it & 63; tr_item8(p.in[I_W2] + (size_t)e * DFF * D, D, ws + WS_W2 + (size_t)e * D * DFF, DFF, 32 * nb, 64 * kb, scr, c.lane); }
}

__device__ __forceinline__ void p2_prep(const Params& p, const Ctx& c) {
    unsigned char* ws = c.ws;
    const bf16_t* PROJ = (const bf16_t*)(ws + WS_PROJ);
    const float* mix = p.in[I_MIX]; const float* k_k = p.in[I_KK];
    float* RZ = (float*)(ws + WS_RZ); float* KZ = (float*)(ws + WS_KZ); float* VZ = (float*)(ws + WS_VZ);
    bf16_t* LIN = (bf16_t*)(ws + WS_LIN); float* KNORM = (float*)(ws + WS_KNORM);
    bf16_t* QR = (bf16_t*)(ws + WS_QR); bf16_t* KR = (bf16_t*)(ws + WS_KR);
    const float* rc = (const float*)(ws + WS_ROT); const float* rs = rc + SEQ * 32;
    for (int t = c.vcu; t < M; t += c.G) {
        const int pos = t & (SEQ - 1);
        const bf16_t* cur = PROJ + (size_t)t * PC;
        for (int ch = c.tid; ch < 824; ch += 512) {
            const u32x4 cv = *(const u32x4*)(cur + 8 * ch); u32x4 pv = (u32x4){0u, 0u, 0u, 0u}; if (pos > 0) pv = *(const u32x4*)(cur - PC + 8 * ch);
            const f32x4 m0 = *(const f32x4*)(mix + 8 * ch), m1 = *(const f32x4*)(mix + 8 * ch + 4);
            float z[8];
            { const unsigned cw[4] = {cv.x, cv.y, cv.z, cv.w}, pw[4] = {pv.x, pv.y, pv.z, pv.w};
              const float mm[8] = {m0[0], m0[1], m0[2], m0[3], m1[0], m1[1], m1[2], m1[3]};
#pragma unroll
              for (int j = 0; j < 4; ++j) { const float c0 = bf2f(cw[j] & 0xffffu), c1 = bf2f(cw[j] >> 16), q0 = bf2f(pw[j] & 0xffffu), q1 = bf2f(pw[j] >> 16);
                  z[2 * j] = c0 + (q0 - c0) * mm[2 * j]; z[2 * j + 1] = c1 + (q1 - c1) * mm[2 * j + 1]; } }
            if (ch < 768) {
                float* dst = (ch < 256 ? RZ : (ch < 512 ? KZ : VZ)) + (size_t)t * D + 8 * (ch & 255);
                *(f32x4*)dst = (f32x4){z[0], z[1], z[2], z[3]}; *(f32x4*)(dst + 4) = (f32x4){z[4], z[5], z[6], z[7]};
                if (ch >= 256 && ch < 512) {
                    const int col = 8 * (ch - 256); const f32x4 k0 = *(const f32x4*)(k_k + col), k1 = *(const f32x4*)(k_k + col + 4);
                    float s = 0.f;
#pragma unroll
                    for (int j = 0; j < 4; ++j) { const float a = z[j] * k0[j], b = z[4 + j] * k1[j]; s += a * a + b * b; }
                    s += __shfl_xor(s, 1); s += __shfl_xor(s, 2); s += __shfl_xor(s, 4);
                    if ((ch & 7) == 0) KNORM[(size_t)t * 32 + ((ch - 256) >> 3)] = sqrtf(s);
                }
            } else {
                float o[8]; int dcol;
                if (ch < 780) { dcol = 8 * (ch - 768);
#pragma unroll
                    for (int j = 0; j < 8; ++j) o[j] = tanhf(z[j]); }
                else if (ch < 792) { dcol = 256 + 8 * (ch - 780);
#pragma unroll
                    for (int j = 0; j < 8; ++j) o[j] = z[j]; }
                else { dcol = 512 + 8 * (ch - 792);
#pragma unroll
                    for (int j = 0; j < 8; ++j) o[j] = sigmoidf_(z[j]); }
                u32x4 w; w.x = pk2(o[0], o[1]); w.y = pk2(o[2], o[3]); w.z = pk2(o[4], o[5]); w.w = pk2(o[6], o[7]);
                *(u32x4*)(LIN + (size_t)t * 768 + dcol) = w;
            }
        }
        if (c.tid < 40) { const int dcol = (c.tid < 20) ? 96 + 8 * c.tid : 352 + 8 * (c.tid - 20); *(u32x4*)(LIN + (size_t)t * 768 + dcol) = (u32x4){0u, 0u, 0u, 0u}; }
        if (c.tid >= 64 && c.tid < 64 + 192) { const int w = c.tid - 64, which = w / 96, hh = (w % 96) >> 2, e0 = (w & 3) * 8;
            const bf16_t* src = cur + ATT0 + which * 1536 + hh * 64 + e0;
            const u32x4 a = *(const u32x4*)src, b = *(const u32x4*)(src + 32);
            const f32x4 c0 = *(const f32x4*)(rc + pos * 32 + e0), c1 = *(const f32x4*)(rc + pos * 32 + e0 + 4), s0 = *(const f32x4*)(rs + pos * 32 + e0), s1 = *(const f32x4*)(rs + pos * 32 + e0 + 4);
            const unsigned aw[4] = {a.x, a.y, a.z, a.w}, bw[4] = {b.x, b.y, b.z, b.w}; float o1[8], o2[8];
#pragma unroll
            for (int j = 0; j < 8; ++j) { const float t1 = bf2f((aw[j >> 1] >> (16 * (j & 1))) & 0xffffu), t2 = bf2f((bw[j >> 1] >> (16 * (j & 1))) & 0xffffu);
                const float cs = j < 4 ? c0[j & 3] : c1[j & 3], sn = j < 4 ? s0[j & 3] : s1[j & 3]; o1[j] = t1 * cs - t2 * sn; o2[j] = t2 * cs + t1 * sn; }
            bf16_t* dst = (which ? KR : QR) + (size_t)t * 1536 + hh * 64 + e0;
            u32x4 w1; w1.x = pk2(o1[0], o1[1]); w1.y = pk2(o1[2], o1[3]); w1.z = pk2(o1[4], o1[5]); w1.w = pk2(o1[6], o1[7]);
            u32x4 w2; w2.x = pk2(o2[0], o2[1]); w2.y = pk2(o2[2], o2[3]); w2.z = pk2(o2[4], o2[5]); w2.w = pk2(o2[6], o2[7]);
            *(u32x4*)dst = w1; *(u32x4*)(dst + 32) = w2; }
    }
}

#define DPP_ADD(x, ctrl) ((x) + __builtin_bit_cast(float, __builtin_amdgcn_update_dpp(0, __builtin_bit_cast(int, (x)), (ctrl), 0xF, 0xF, true)))
__device__ __forceinline__ float wave_sum_dpp(float x) {
    x = DPP_ADD(x, 0xB1); x = DPP_ADD(x, 0x4E); x = DPP_ADD(x, 0x141); x = DPP_ADD(x, 0x140);
    const int xi = __builtin_bit_cast(int, x);
    return (__builtin_bit_cast(float, __builtin_amdgcn_readlane(xi, 0)) + __builtin_bit_cast(float, __builtin_amdgcn_readlane(xi, 16))) +
           (__builtin_bit_cast(float, __builtin_amdgcn_readlane(xi, 32)) + __builtin_bit_cast(float, __builtin_amdgcn_readlane(xi, 48)));
}
__device__ __forceinline__ f32x4 tile_mm(const LAS bf16_t* A, int pa, const LAS bf16_t* Bt, int pb, int ks, int fr, int fq, f32x4 acc) {
    for (int k = 0; k < ks; ++k) { const bf16x8 a = *(const LAS bf16x8*)(A + fr * pa + 32 * k + 8 * fq), b = *(const LAS bf16x8*)(Bt + fr * pb + 32 * k + 8 * fq);
        acc = __builtin_amdgcn_mfma_f32_16x16x32_bf16(a, b, acc, 0, 0, 0); }
    return acc;
}
__device__ __forceinline__ u32x2 pack4(f32x4 v) { u32x2 w; w.x = pk2(v[0], v[1]); w.y = pk2(v[2], v[3]); return w; }
constexpr int SC_C = 32, SC_NCH = SEQ / SC_C, SC_F = 96;
constexpr int PL_X1 = 0, PL_X2 = 9216, PL_AL = 18432, PL_HT = 26112, PL_ET = 33792, PL_LBT = 53760, PL_TT = 58368, PL_GI = 60928, PL_RAW = 68608, PL_TF = 109568, PL_XB = 114176, PL_END = 115264;
#define LBAR() do { asm volatile("s_waitcnt lgkmcnt(0)" ::: "memory"); __builtin_amdgcn_s_barrier(); asm volatile("" ::: "memory"); } while (0)
__device__ __forceinline__ void p4_pre(const Params& p, const Ctx& c) {
    unsigned char* ws = c.ws;
    const float* RZ = (const float*)(ws + WS_RZ); const float* DEC = (const float*)(ws + WS_DEC); const float* KP = (const float*)(ws + WS_KP);
    const float* AN = (const float*)(ws + WS_AN); const float* BB = (const float*)(ws + WS_BB);
    bf16_t* FG = (bf16_t*)(ws + WS_F);
    LAS bf16_t* X1 = (LAS bf16_t*)(c.lds + PL_X1); LAS bf16_t* X2 = (LAS bf16_t*)(c.lds + PL_X2); LAS bf16_t* AL = (LAS bf16_t*)(c.lds + PL_AL); LAS bf16_t* HT = (LAS bf16_t*)(c.lds + PL_HT);
    LAS bf16_t* ET = (LAS bf16_t*)(c.lds + PL_ET); LAS float* LBT = (LAS float*)(c.lds + PL_LBT); LAS bf16_t* TT = (LAS bf16_t*)(c.lds + PL_TT); LAS bf16_t* GI = (LAS bf16_t*)(c.lds + PL_GI);
    LAS float* RAW = (LAS float*)(c.lds + PL_RAW);
    LAS float* TF = (LAS float*)(c.lds + PL_TF);
    LAS float* XB = (LAS float*)(c.lds + PL_XB);
    int tid_ = c.tid; asm volatile("" : "+v"(tid_));
    const int tid = tid_, lane = tid & 63, w = __builtin_amdgcn_readfirstlane(tid >> 6), fr = lane & 15, fq = lane >> 4;
    const int ls = tid >> 4, lc4 = 4 * (tid & 15);
    f32x4 pf[5];
#define PRE_LOAD(TASK) do { const int bh_ = (TASK) >> 7, ch_ = (TASK) & (SC_NCH - 1); const size_t o_ = ((size_t)(bh_ >> 5) * SEQ + (size_t)ch_ * SC_C + ls) * D + (bh_ & 31) * 64 + lc4; \
        pf[0] = *(const f32x4*)(RZ + o_); pf[1] = *(const f32x4*)(DEC + o_); pf[2] = *(const f32x4*)(KP + o_); pf[3] = *(const f32x4*)(AN + o_); pf[4] = *(const f32x4*)(BB + o_); } while (0)
    if (c.vcu < 128 * SC_NCH) PRE_LOAD(c.vcu);
    const bool bgconv = (c.G == 256);
    LAS float* cscr = (LAS float*)(c.lds + w * 8448);
    int tix = 0;
    for (int task = c.vcu; task < 128 * SC_NCH; task += c.G, ++tix) {
#pragma unroll
        for (int v = 0; v < 5; ++v) *(LAS f32x4*)(RAW + (v * 32 + ls) * 64 + lc4) = pf[v];
        if (task + c.G < 128 * SC_NCH) PRE_LOAD(task + c.G);
        float cv[32]; int ce = 0, cn0 = 0, ck0 = 0;
        if (bgconv) { const int item = (c.vcu * 64 + tix) * 8 + w; ce = item >> 12; const int rem = item & 4095; ck0 = 64 * (rem >> 7); cn0 = 32 * (rem & 127);
            tr_issue(p.in[I_W1] + (size_t)ce * D * 4096, 4096, cn0, ck0, lane, cv); }
        LBAR();
        *(LAS u32x4*)(ET + (32 + (tid >> 3)) * 104 + 8 * (tid & 7)) = (u32x4){0u, 0u, 0u, 0u};
        float g = 1.f, gprev[4], gcur[4];
#pragma unroll
        for (int s = 0; s < SC_C; ++s) { const float wv = RAW[(32 + s) * 64 + lane]; if ((s >> 2) == w) gprev[s & 3] = g; g *= wv; if ((s >> 2) == w) gcur[s & 3] = g; }
        const float gC = g;
        f32x4 ah4, bg4, kg4;
#pragma unroll
        for (int qn = 0; qn < 4; ++qn) { const int s = 4 * w + qn;
            const float rr = RAW[(0 + s) * 64 + lane], kk = RAW[(64 + s) * 64 + lane], aa = RAW[(96 + s) * 64 + lane], bb = RAW[(128 + s) * 64 + lane]; const float ig = 1.0f / gcur[qn];
            const float ah = aa * gprev[qn], bt = bb * ig, kt = kk * ig, rh = rr * gcur[qn];
            X1[s * 72 + lane] = (bf16_t)f2bf(bt); X1[(32 + s) * 72 + lane] = (bf16_t)f2bf(kt); X2[s * 72 + lane] = (bf16_t)f2bf(ah); X2[(32 + s) * 72 + lane] = (bf16_t)f2bf(rh);
            ET[s * 104 + lane] = (bf16_t)f2bf(rh); ah4[qn] = ah; bg4[qn] = bt * gC; kg4[qn] = kt * gC; }
        *(LAS u32x2*)(AL + lane * 40 + 4 * w) = pack4(ah4); *(LAS u32x2*)(HT + (32 + lane) * 40 + 4 * w) = pack4(bg4); *(LAS u32x2*)(ET + (32 + lane) * 104 + 64 + 4 * w) = pack4(kg4);
        LBAR();
        if (w == 0) ET[(32 + lane) * 104 + lane] = (bf16_t)f2bf(gC);
        { const int mt = w >> 1;
#pragma unroll
          for (int u = 0; u < 2; ++u) { const int nt = 2 * (w & 1) + u;
            f32x4 acc = tile_mm(X1 + 16 * mt * 72, 72, X2 + 16 * nt * 72, 72, 2, fr, fq, (f32x4){0.f, 0.f, 0.f, 0.f});
            const int n = 16 * nt + fr, m0 = 16 * mt + 4 * fq;
            if (mt < 2) { if (nt < 2) { const int t = n; f32x4 o;
#pragma unroll
                    for (int e = 0; e < 4; ++e) o[e] = (m0 + e < t) ? acc[e] : 0.f;
                    *(LAS f32x4*)(LBT + t * 36 + m0) = o; }
                else { const int t = n - 32; f32x4 o;
#pragma unroll
                    for (int e = 0; e < 4; ++e) o[e] = (m0 + e <= t) ? acc[e] : 0.f;
                    *(LAS u32x2*)(HT + t * 40 + m0) = pack4(o); } }
            else { const int s0 = m0 - 32;
                if (nt < 2) { const int t = n;
#pragma unroll
                    for (int e = 0; e < 4; ++e) AL[(64 + s0 + e) * 40 + t] = (bf16_t)f2bf((s0 + e < t) ? acc[e] : 0.f); }
                else { const int t = n - 32; f32x4 o;
#pragma unroll
                    for (int e = 0; e < 4; ++e) o[e] = (s0 + e <= t) ? acc[e] : 0.f;
                    *(LAS u32x2*)(ET + t * 104 + 64 + s0) = pack4(o); } } } }
        LBAR();
        if (tid < 32) { const int hb = 16 * (tid >> 4), sl = tid & 15; float Tr[16];
#pragma unroll
            for (int t = 0; t < 16; ++t) { float a0 = (sl == t) ? 1.f : 0.f, a1 = 0.f, a2 = 0.f, a3 = 0.f;
#pragma unroll
                for (int m4 = 0; m4 < (t + 3) / 4; ++m4) { const f32x4 l = *(const LAS f32x4*)(LBT + (hb + t) * 36 + hb + 4 * m4);
                    if (4 * m4 + 0 < t) a0 += Tr[4 * m4 + 0] * l[0]; if (4 * m4 + 1 < t) a1 += Tr[4 * m4 + 1] * l[1]; if (4 * m4 + 2 < t) a2 += Tr[4 * m4 + 2] * l[2]; if (4 * m4 + 3 < t) a3 += Tr[4 * m4 + 3] * l[3]; }
                Tr[t] = (a0 + a1) + (a2 + a3); TF[(hb + sl) * 36 + hb + t] = Tr[t]; TT[(hb + t) * 40 + hb + sl] = (bf16_t)f2bf(Tr[t]);
                if (hb) TT[t * 40 + hb + sl] = 0; } }
        LBAR();
        if (tid < 256) { const int m = tid >> 4, tl = tid & 15; float x = 0.f;
#pragma unroll
            for (int n = 0; n < 16; ++n) x += LBT[(16 + n) * 36 + m] * TF[(16 + n) * 36 + 16 + tl];
            XB[m * 17 + tl] = x; }
        LBAR();
        if (tid < 256) { const int sr = tid >> 4, tl = tid & 15; float x = 0.f;
#pragma unroll
            for (int m = 0; m < 16; ++m) x += TF[sr * 36 + m] * XB[m * 17 + tl];
            TT[(16 + tl) * 40 + sr] = (bf16_t)f2bf(x); }
        LBAR();
        for (int id = w; id < 12; id += 8) { const int tt = id / 6, nt = id % 6;
            const f32x4 acc = tile_mm(TT + 16 * tt * 40, 40, AL + 16 * nt * 40, 40, 1, fr, fq, (f32x4){0.f, 0.f, 0.f, 0.f});
            *(LAS u32x2*)(GI + (16 * nt + fr) * 40 + 16 * tt + 4 * fq) = pack4(acc); }
        LBAR();
        for (int id = w; id < 36; id += 8) { const int nt = id / 6, mt = id % 6;
            const f32x4 acc = tile_mm(GI + 16 * nt * 40, 40, HT + 16 * mt * 40, 40, 1, fr, fq, (f32x4){0.f, 0.f, 0.f, 0.f});
            LAS u32x2* ep = (LAS u32x2*)(ET + (16 * mt + fr) * 104 + 16 * nt + 4 * fq); const u32x2 ev = *ep;
            f32x4 o; o[0] = acc[0] + bf2f(ev.x & 0xffffu); o[1] = acc[1] + bf2f(ev.x >> 16); o[2] = acc[2] + bf2f(ev.y & 0xffffu); o[3] = acc[3] + bf2f(ev.y >> 16);
            *ep = pack4(o); }
        LBAR();
        { bf16_t* fg = FG + (size_t)task * (SC_F * SC_F);
          for (int idx = tid; idx < 96 * 12; idx += 512) { const int row = idx / 12, pc = idx % 12; *(u32x4*)(fg + row * 96 + 8 * pc) = *(const LAS u32x4*)(ET + row * 104 + 8 * pc); } }
        LBAR();
        if (bgconv) tr_finish(cv, ws + WS_W1 + (size_t)ce * 4096 * D, D, cn0, ck0, cscr, lane);
    }
    if (!bgconv) {
        LBAR();
        for (int r = c.vcu * 8 + w; r < NEXP * MOE_W1E; r += c.G * 8) { const int e = r >> 12, rem = r & 4095; tr_item8(p.in[I_W1] + (size_t)e * D * 4096, 4096, ws + WS_W1 + (size_t)e * 4096 * D, D, 32 * (rem & 127), 64 * (rem >> 7), cscr, lane); }
    }
    LBAR();
#undef PRE_LOAD
}
constexpr int SQ_BI = 0, SQ_BI_SZ = 64 * 104 * 2, SQ_YL = 2 * SQ_BI_SZ, SQ_YL_SZ = 32 * 64 * 4;
struct SeqSet { bf16x8 af[3][3]; f32x4 vimg; float r[4], k[4], v[4], g[4]; };
__device__ __forceinline__ void p4_seq(const Params& p, const Ctx& c, int bh) {
    unsigned char* ws = c.ws;
    const float* RZ = (const float*)(ws + WS_RZ); const float* KP = (const float*)(ws + WS_KP); const float* VZ = (const float*)(ws + WS_VZ); const float* GG = (const float*)(ws + WS_GG);
    const bf16_t* FG = (const bf16_t*)(ws + WS_F) + (size_t)bh * SC_NCH * (SC_F * SC_F);
    bf16_t* YA = (bf16_t*)(ws + WS_YA);
    int tid_ = c.tid; asm volatile("" : "+v"(tid_));
    const int tid = tid_, lane = tid & 63, w = __builtin_amdgcn_readfirstlane(tid >> 6), fr = lane & 15, fq = lane >> 4;
    const int b = bh >> 5, h = bh & 31;
    const size_t base = (size_t)b * SEQ * D + h * 64;
    const int nt = w & 3, mg = w >> 2;
    const float lg = p.in[I_LNXG][h * 64 + lane], lb = p.in[I_LNXB][h * 64 + lane], rk = p.in[I_RK][h * 64 + lane];
    LAS bf16_t* BI = (LAS bf16_t*)(c.lds + SQ_BI); LAS float* YL = (LAS float*)(c.lds + SQ_YL);
    const int vs = tid >> 4, vi4 = 4 * (tid & 15);
#define SEQ_LOAD(SET, CHN) do { const bf16_t* fp = FG + (size_t)(CHN) * (SC_F * SC_F); _Pragma("unroll") for (int mi = 0; mi < 3; ++mi) _Pragma("unroll") for (int ks = 0; ks < 3; ++ks) \
            SET.af[mi][ks] = *(const bf16x8*)(fp + (16 * (3 * mg + mi) + fr) * SC_F + 32 * ks + 8 * fq); \
        SET.vimg = *(const f32x4*)(VZ + base + (size_t)((CHN) * SC_C + vs) * D + vi4); \
        _Pragma("unroll") for (int e = 0; e < 4; ++e) { const size_t o = base + (size_t)((CHN) * SC_C + 4 * w + e) * D + lane; SET.r[e] = RZ[o]; SET.k[e] = KP[o]; SET.v[e] = VZ[o]; SET.g[e] = GG[o]; } } while (0)
#define SEQ_BODY(CH, CUR, NXT, NX2) do { const int ch = (CH), cb = ch & 1; \
        const LAS bf16_t* bi = BI + cb * (64 * 104); LAS bf16_t* bo = BI + (cb ^ 1) * (64 * 104); LAS float* yl = YL + cb * (32 * 64); \
        if (ch + 2 < SC_NCH) SEQ_LOAD(NX2, ch + 2); \
        bf16x8 bfr[3]; _Pragma("unroll") for (int ks = 0; ks < 3; ++ks) bfr[ks] = *(const LAS bf16x8*)(bi + (16 * nt + fr) * 104 + 32 * ks + 8 * fq); \
        f32x4 acc[3]; _Pragma("unroll") for (int mi = 0; mi < 3; ++mi) { acc[mi] = (f32x4){0.f, 0.f, 0.f, 0.f}; \
            _Pragma("unroll") for (int ks = 0; ks < 3; ++ks) acc[mi] = __builtin_amdgcn_mfma_f32_16x16x32_bf16(CUR.af[mi][ks], bfr[ks], acc[mi], 0, 0, 0); } \
        _Pragma("unroll") for (int mi = 0; mi < 3; ++mi) { const int mt = 3 * mg + mi; \
            if (mt < 2) { _Pragma("unroll") for (int e = 0; e < 4; ++e) yl[(16 * mt + 4 * fq + e) * 64 + 16 * nt + fr] = acc[mi][e]; } \
            else *(LAS u32x2*)(bo + (16 * nt + fr) * 104 + 16 * (mt - 2) + 4 * fq) = pack4(acc[mi]); } \
        if (ch + 1 < SC_NCH) { _Pragma("unroll") for (int e = 0; e < 4; ++e) bo[(vi4 + e) * 104 + 64 + vs] = (bf16_t)f2bf(NXT.vimg[e]); } \
        LBAR(); \
        _Pragma("unroll") for (int e = 0; e < 4; ++e) { const int s = 4 * w + e; const float y = yl[s * 64 + lane]; \
            const float mu = wave_sum_dpp(y) * (1.0f / 64.0f); const float dl = y - mu; const float var = wave_sum_dpp(dl * dl) * (1.0f / 64.0f); \
            const float yn = dl * rsqrtf(var + GN_EPS) * lg + lb; const float bonus = wave_sum_dpp(CUR.r[e] * CUR.k[e] * rk) * CUR.v[e]; \
            YA[base + (size_t)(ch * SC_C + s) * D + lane] = (bf16_t)f2bf((yn + bonus) * CUR.g[e]); } } while (0)
    SeqSet sa, sb, sc;
    SEQ_LOAD(sa, 0); SEQ_LOAD(sb, 1);
    for (int idx = tid; idx < 64 * 8; idx += 512) *(LAS u32x4*)(BI + (idx >> 3) * 104 + 8 * (idx & 7)) = (u32x4){0u, 0u, 0u, 0u};
#pragma unroll
    for (int e = 0; e < 4; ++e) BI[(vi4 + e) * 104 + 64 + vs] = (bf16_t)f2bf(sa.vimg[e]);
    LBAR();
    for (int c0 = 0; c0 < SC_NCH; c0 += 3) {
        SEQ_BODY(c0, sa, sb, sc);
        if (c0 + 1 < SC_NCH) SEQ_BODY(c0 + 1, sb, sc, sa);
        if (c0 + 2 < SC_NCH) SEQ_BODY(c0 + 2, sc, sa, sb);
    }
    LBAR();
#undef SEQ_LOAD
#undef SEQ_BODY
}

__device__ __forceinline__ void p4_attn_task(const Ctx& c, int task) {
    unsigned char* ws = c.ws;
    const bf16_t* QR = (const bf16_t*)(ws + WS_QR); const bf16_t* KR = (const bf16_t*)(ws + WS_KR); const bf16_t* PROJ = (const bf16_t*)(ws + WS_PROJ);
    float* AO = (float*)(ws + WS_AO); float* LSE = (float*)(ws + WS_LSE);
    constexpr int VP = 280;
    LAS bf16_t* Vt = (LAS bf16_t*)c.lds;
    const int combo = task & 31, hh = (task >> 5) % 24, b = task / (32 * 24);
    const int g = hh >> 3, h = hh & 7;
    const int dil = g == 0 ? 1 : (g == 1 ? 4 : 16);
    const int res = combo % dil, blk = combo / dil;
    const int tid = c.tid, lane = c.lane, w = c.wave;
    __syncthreads();
    {
        const int ki = tid >> 1, dh = tid & 1; const int pk = (blk - 1) * 128 + ki;
        u32x4 v[4];
        if (pk >= 0) { const bf16_t* sp = PROJ + ((size_t)b * SEQ + (size_t)pk * dil + res) * PC + ATT0 + 2 * 1536 + hh * 64 + 32 * dh;
#pragma unroll
            for (int j = 0; j < 4; ++j) v[j] = *(const u32x4*)(sp + 8 * j); }
        else {
#pragma unroll
            for (int j = 0; j < 4; ++j) v[j] = (u32x4){0u, 0u, 0u, 0u}; }
#pragma unroll
        for (int j = 0; j < 4; ++j) { const unsigned wv[4] = {v[j].x, v[j].y, v[j].z, v[j].w};
#pragma unroll
            for (int e = 0; e < 8; ++e) Vt[(32 * dh + 8 * j + e) * VP + ki] = (bf16_t)((wv[e >> 1] >> (16 * (e & 1))) & 0xffffu); }
        if (tid < 64) {
#pragma unroll
            for (int e = 0; e < 24; ++e) Vt[tid * VP + 256 + e] = 0; }
    }
    __syncthreads();
    const int qq = lane & 15, g4 = lane >> 4;
    const int r0 = 16 * w;
    const size_t qtok = (size_t)b * SEQ + (size_t)(blk * 128 + r0 + qq) * dil + res;
    bf16x8 qf[2];
#pragma unroll
    for (int ks = 0; ks < 2; ++ks) qf[ks] = *(const bf16x8*)(QR + qtok * 1536 + hh * 64 + 32 * ks + 8 * g4);
    f32x4 sc[10];
#pragma unroll
    for (int kt = 0; kt < 9; ++kt) {
        const int ki = 16 * (w + kt) + qq; const int pk = (blk - 1) * 128 + ki;
        f32x4 a = (f32x4){0.f, 0.f, 0.f, 0.f};
#pragma unroll
        for (int ks = 0; ks < 2; ++ks) { bf16x8 kf = (bf16x8){0, 0, 0, 0, 0, 0, 0, 0};
            if (pk >= 0) kf = *(const bf16x8*)(KR + ((size_t)b * SEQ + (size_t)pk * dil + res) * 1536 + hh * 64 + 32 * ks + 8 * g4);
            a = __builtin_amdgcn_mfma_f32_16x16x32_bf16(kf, qf[ks], a, 0, 0, 0); }
        sc[kt] = a;
    }
    const int r = r0 + qq;
    float mx = -3.0e38f;
#pragma unroll
    for (int kt = 0; kt < 9; ++kt)
#pragma unroll
        for (int j = 0; j < 4; ++j) { const int ki = 16 * (w + kt) + 4 * g4 + j; const bool ok = (ki >= r) && (ki <= r + 128) && (blk > 0 || ki >= 128);
            const float s = ok ? sc[kt][j] * 0.125f : -1.0e30f; sc[kt][j] = s; mx = fmaxf(mx, s); }
    mx = fmaxf(mx, __shfl_xor(mx, 16)); mx = fmaxf(mx, __shfl_xor(mx, 32));
    float den = 0.f;
#pragma unroll
    for (int kt = 0; kt < 9; ++kt)
#pragma unroll
        for (int j = 0; j < 4; ++j) { const float pexp = __expf(sc[kt][j] - mx); sc[kt][j] = pexp; den += pexp; }
    den += __shfl_xor(den, 16); den += __shfl_xor(den, 32);
    sc[9] = (f32x4){0.f, 0.f, 0.f, 0.f};
    f32x4 oacc[4];
#pragma unroll
    for (int dt = 0; dt < 4; ++dt) oacc[dt] = (f32x4){0.f, 0.f, 0.f, 0.f};
#pragma unroll
    for (int cidx = 0; cidx < 5; ++cidx) {
        const f32x4 p0 = sc[2 * cidx], p1 = sc[2 * cidx + 1];
        u32x4 pw; pw.x = pk2(p0[0], p0[1]); pw.y = pk2(p0[2], p0[3]); pw.z = pk2(p1[0], p1[1]); pw.w = pk2(p1[2], p1[3]);
        const bf16x8 pf = __builtin_bit_cast(bf16x8, pw);
        const int kbase = 16 * (w + 2 * cidx) + 4 * g4;
#pragma unroll
        for (int dt = 0; dt < 4; ++dt) { const LAS bf16_t* vp = Vt + (16 * dt + qq) * VP + kbase;
            const u32x2 lo = *(const LAS u32x2*)vp, hi = *(const LAS u32x2*)(vp + 16);
            u32x4 vw; vw.x = lo.x; vw.y = lo.y; vw.z = hi.x; vw.w = hi.y;
            oacc[dt] = __builtin_amdgcn_mfma_f32_16x16x32_bf16(__builtin_bit_cast(bf16x8, vw), pf, oacc[dt], 0, 0, 0); }
    }
    const float inv = 1.0f / den;
    const size_t tok = qtok;
#pragma unroll
    for (int dt = 0; dt < 4; ++dt) *(f32x4*)(AO + ((size_t)g * M + tok) * 512 + h * 64 + 16 * dt + 4 * g4) = oacc[dt] * inv;
    if (g4 == 0) LSE[((size_t)g * M + tok) * 8 + h] = mx + __logf(den);
}

constexpr int Q_ATT = 3072, Q_TOTAL = Q_ATT + MOE_CONV_GROUPS;
__device__ __forceinline__ void p4_queue(const Params& p, const Ctx& c, volatile LAS unsigned* qslot) {
    unsigned* qc = (unsigned*)(c.ws + WS_CTL) + CW_Q;
    for (;;) {
        __syncthreads();
        if (c.tid == 0) qslot[0] = __hip_atomic_fetch_add(qc, 1u, __ATOMIC_RELAXED, __HIP_MEMORY_SCOPE_AGENT);
        __syncthreads();
        const unsigned it = qslot[0];
        if (it >= (unsigned)Q_TOTAL) break;
        if (it < (unsigned)Q_ATT) p4_attn_task(c, (int)it); else conv_group(p, c, (int)it - Q_ATT);
    }
}

__device__ __forceinline__ void p5_post(const Params& p, const Ctx& c) {
    unsigned char* ws = c.ws;
    const float* AO = (const float*)(ws + WS_AO); const float* LSE = (const float*)(ws + WS_LSE);
    bf16_t* YB = (bf16_t*)(ws + WS_YB);
    const int gw = c.vcu * 8 + c.wave, NGW = c.G * 8, lane = c.lane;
    for (int it = gw; it < M * 8; it += NGW) {
        const int t = it >> 3, h = it & 7;
        const float l0 = LSE[((size_t)0 * M + t) * 8 + h], l1 = LSE[((size_t)1 * M + t) * 8 + h], l2 = LSE[((size_t)2 * M + t) * 8 + h];
        const float mxl = fmaxf(l0, fmaxf(l1, l2)); const float e0 = __expf(l0 - mxl), e1 = __expf(l1 - mxl), e2 = __expf(l2 - mxl); const float inv = 1.0f / (e0 + e1 + e2);
        const size_t o = (size_t)t * 512 + h * 64 + lane;
        const float v = (e0 * AO[o] + e1 * AO[(size_t)M * 512 + o] + e2 * AO[(size_t)2 * M * 512 + o]) * inv;
        YB[o] = (bf16_t)f2bf(v);
    }
}

__device__ __forceinline__ void ln_rows(const Ctx& c, const float* in, const float* gam, const float* bet, float* outf, bf16_t* outb, unsigned char* outq = nullptr) {
    const int gw = c.vcu * 8 + c.wave, NGW = c.G * 8, lane = c.lane;
    for (int m = gw; m < M; m += NGW) {
        const f32x4* xr = (const f32x4*)(in + (size_t)m * D) + lane;
        f32x4 v[8]; float s = 0.f;
#pragma unroll
        for (int j = 0; j < 8; ++j) { v[j] = xr[64 * j]; s += (v[j][0] + v[j][1]) + (v[j][2] + v[j][3]); }
        const float mean = wave_sum(s) * (1.0f / D); float s2 = 0.f;
#pragma unroll
        for (int j = 0; j < 8; ++j) { v[j] = v[j] - mean; s2 += (v[j][0] * v[j][0] + v[j][1] * v[j][1]) + (v[j][2] * v[j][2] + v[j][3] * v[j][3]); }
        const float rstd = rsqrtf(wave_sum(s2) * (1.0f / D) + LN_EPS);
#pragma unroll
        for (int j = 0; j < 8; ++j) { const int col = 4 * lane + 256 * j; const f32x4 gv = *(const f32x4*)(gam + col), bv = *(const f32x4*)(bet + col);
            const f32x4 o = v[j] * rstd * gv + bv;
            *(f32x4*)(outf + (size_t)m * D + col) = o;
            if (outb) { u32x2 w; w.x = pk2(o[0], o[1]); w.y = pk2(o[2], o[3]); *(u32x2*)(outb + (size_t)m * D + col) = w; }
            if (outq) *(unsigned*)(outq + (size_t)m * D + col) = pk4_fp8(o[0], o[1], o[2], o[3]); }
    }
}

__device__ __forceinline__ void p15_router(const Params& p, const Ctx& c) {
    unsigned char* ws = c.ws;
    const float* X2 = (const float*)(ws + WS_X2); const float* RW = p.in[I_RW]; const float* RB = p.in[I_RB];
    unsigned* cnt = (unsigned*)(ws + WS_CTL) + CW_CNT; int* LIST = (int*)(ws + WS_LIST); int* ROWI = (int*)(ws + WS_ROWI); float* TOPW = (float*)(ws + WS_TOPW);
    LAS float* scr = (LAS float*)(c.lds + c.wave * 8192);
    const int gw = c.vcu * 8 + c.wave, NGW = c.G * 8, lane = c.lane, li = lane & 31, lk = lane >> 5;
    for (int tb = gw; tb < M / 32; tb += NGW) {
        const int t0 = tb * 32;
        f32x16 acc;
#pragma unroll
        for (int j = 0; j < 16; ++j) acc[j] = 0.f;
        const float* xa = X2 + (size_t)(t0 + li) * D + 4 * lk;
        const float* wb = RW + (size_t)(4 * lk) * 32 + li;
        for (int kb = 0; kb < D / 8; ++kb) {
            const f32x4 a = *(const f32x4*)(xa + 8 * kb);
            const float b0 = wb[(size_t)(8 * kb + 0) * 32], b1 = wb[(size_t)(8 * kb + 1) * 32], b2 = wb[(size_t)(8 * kb + 2) * 32], b3 = wb[(size_t)(8 * kb + 3) * 32];
            acc = __builtin_amdgcn_mfma_f32_32x32x2f32(a[0], b0, acc, 0, 0, 0);
            acc = __builtin_amdgcn_mfma_f32_32x32x2f32(a[1], b1, acc, 0, 0, 0);
            acc = __builtin_amdgcn_mfma_f32_32x32x2f32(a[2], b2, acc, 0, 0, 0);
            acc = __builtin_amdgcn_mfma_f32_32x32x2f32(a[3], b3, acc, 0, 0, 0);
        }
        const float bias = RB[li];
#pragma unroll
        for (int rg = 0; rg < 16; ++rg) { const int row = (rg & 3) + 8 * (rg >> 2) + 4 * lk; scr[row * 33 + li] = acc[rg] + bias; }
        LDS_WAIT(); asm volatile("" ::: "memory");
        if (lane < 32) {
            float lv[32];
#pragma unroll
            for (int e = 0; e < 32; ++e) lv[e] = scr[lane * 33 + e];
            int id[4]; float tv[4];
#pragma unroll
            for (int k = 0; k < 4; ++k) { float best = -3.0e38f; int bi = 0;
#pragma unroll
                for (int e = 0; e < 32; ++e) { const bool tk = lv[e] > best; best = tk ? lv[e] : best; bi = tk ? e : bi; }
                id[k] = bi; tv[k] = best;
#pragma unroll
                for (int e = 0; e < 32; ++e) lv[e] = (e == bi) ? -3.0e38f : lv[e]; }
            const float e1 = __expf(tv[1] - tv[0]), e2 = __expf(tv[2] - tv[0]), e3 = __expf(tv[3] - tv[0]); const float inv = 1.0f / (1.0f + e1 + e2 + e3);
            const float wv[4] = {inv, e1 * inv, e2 * inv, e3 * inv};
            const int t = t0 + lane;
#pragma unroll
            for (int k = 0; k < 4; ++k) { const unsigned slot = __hip_atomic_fetch_add(cnt + id[k], 1u, __ATOMIC_RELAXED, __HIP_MEMORY_SCOPE_AGENT);
                LIST[(size_t)id[k] * CAP + slot] = t; ROWI[(size_t)t * 4 + k] = id[k] * CAP + (int)slot; TOPW[(size_t)t * 4 + k] = wv[k]; }
        }
        LDS_WAIT(); asm volatile("" ::: "memory");
    }
}

__device__ __forceinline__ void moe_table(const Ctx& c, LAS int* tab) {
    if (c.tid == 0) { unsigned* cnt = (unsigned*)(c.ws + WS_CTL) + CW_CNT; int ts = 0;
        for (int e = 0; e < NEXP; ++e) { const int n = (int)__hip_atomic_load(cnt + e, __ATOMIC_RELAXED, __HIP_MEMORY_SCOPE_AGENT); tab[e] = n; tab[32 + e] = ts; ts += (n + 255) >> 8; }
        tab[64] = ts; }
    __syncthreads();
}

__device__ __forceinline__ void p18_combine(const Params& p, const Ctx& c, const LAS int* tab) {
    unsigned char* ws = c.ws;
    const float* X2 = (const float*)(ws + WS_X2); const float* Y = (const float*)(ws + WS_Y); const int* ROWI = (const int*)(ws + WS_ROWI); const float* TOPW = (const float*)(ws + WS_TOPW);
    const float* gam = p.in[I_LN3G]; const float* bet = p.in[I_LN3B];
    const int gw = c.vcu * 8 + c.wave, NGW = c.G * 8, lane = c.lane;
    for (int m = gw; m < M; m += NGW) {
        f32x4 v[8];
        const f32x4* xr = (const f32x4*)(X2 + (size_t)m * D) + lane;
#pragma unroll
        for (int j = 0; j < 8; ++j) v[j] = xr[64 * j] * DN_ALPHA;
#pragma unroll
        for (int k = 0; k < 4; ++k) { const int ri = ROWI[(size_t)m * 4 + k]; const float gt = TOPW[(size_t)m * 4 + k]; const int e = ri >> 14, slot = ri & (CAP - 1);
            const f32x4* yr = (const f32x4*)(Y + ((size_t)tab[32 + e] * 256 + slot) * D) + lane;
#pragma unroll
            for (int j = 0; j < 8; ++j) v[j] = v[j] + yr[64 * j] * gt; }
        float s = 0.f;
#pragma unroll
        for (int j = 0; j < 8; ++j) s += (v[j][0] + v[j][1]) + (v[j][2] + v[j][3]);
        const float mean = wave_sum(s) * (1.0f / D); float s2 = 0.f;
#pragma unroll
        for (int j = 0; j < 8; ++j) { v[j] = v[j] - mean; s2 += (v[j][0] * v[j][0] + v[j][1] * v[j][1]) + (v[j][2] * v[j][2] + v[j][3] * v[j][3]); }
        const float rstd = rsqrtf(wave_sum(s2) * (1.0f / D) + LN_EPS);
#pragma unroll
        for (int j = 0; j < 8; ++j) { const int col = 4 * lane + 256 * j; const f32x4 gv = *(const f32x4*)(gam + col), bv = *(const f32x4*)(bet + col);
            *(f32x4*)(p.out + (size_t)m * D + col) = v[j] * rstd * gv + bv; }
    }
}

constexpr int NPHASE = 19;
__global__ void __launch_bounds__(512, 2) fwd(Params p) {
    extern __shared__ __attribute__((aligned(16))) unsigned char lds_raw[];
    LAS unsigned char* lds = (LAS unsigned char*)lds_raw;
    Ctx c; c.tid = threadIdx.x; c.lane = c.tid & 63; c.wave = __builtin_amdgcn_readfirstlane(c.tid >> 6); c.G = gridDim.x;
    { const int bx = blockIdx.x; c.vcu = (c.G % 8 == 0) ? (bx % 8) * (c.G / 8) + bx / 8 : bx; }
    c.lds = lds; c.ws = p.ws;
    unsigned char* ws = p.ws;
    volatile LAS unsigned* MISC = (volatile LAS unsigned*)(lds + MISC_OFF);
    LAS int* tab = (LAS int*)(lds + MISC_OFF + 1024);
    if (c.tid < 64) MISC[c.tid] = 0u;
    __syncthreads();
    unsigned* ctl = (unsigned*)(ws + WS_CTL);
    XcdBarrier bar; bar.bar = ctl + CW_BAR + p.li * XCD_BAR_WORDS; bar.x = 0; bar.st = MISC + 8;
    if (N_LAUNCH_MODE == 1) bar = xcd_barrier_post(ctl + CW_BAR + p.li * XCD_BAR_WORDS, MISC + 8);
    const int lo = p.ph_lo, hi = p.ph_hi, bx = blockIdx.x;
#ifndef PHMASK
#define PHMASK 0xFFFFFFFFu
#endif
#define IN(k) (((PHMASK >> (k)) & 1u) && lo <= (k) && (k) < hi)
#define SEAM(k) do { if (N_LAUNCH_MODE == 1 && IN((k) + 1)) xcd_barrier(bar); } while (0)

    if (IN(0)) { p0_prologue(p, c); SEAM(0); }

    if (IN(1)) {
        pg8::StaticOrder S; S.init(ws + WS_XB, ws + WS_WIN, M, PC, D, D, c.G, bx);
        pg8::EpiBf16 E{(bf16_t*)(ws + WS_PROJ), PC, 1.0f};
        pg8::gemm_phase<pg8::EpiBf16, pg8::StaticOrder>(lds, pg8::Gemm{D, D, D}, S, E);
        SEAM(1);
    }
    if (IN(2)) { p2_prep(p, c); SEAM(2); }

    if (IN(3)) {
#ifndef P3M
#define P3M 15
#endif
        if (P3M & 1) { pg8::StaticOrder S; S.init(ws + WS_LIN, ws + WS_WUP, M, D, 768, 256, c.G, bx);
          pg8::EpiDecay E{(float*)(ws + WS_DEC), p.in[I_W0]};
          pg8::gemm_phase<pg8::EpiDecay, pg8::StaticOrder>(lds, pg8::Gemm{256, 768, 256}, S, E); }
        if (P3M & 2) { pg8::StaticOrder S; S.init(ws + WS_LIN + 512, ws + WS_AUP, M, D, 768, 256, c.G, bx);
          pg8::EpiIclr E{p.in[I_A0], p.in[I_KK], p.in[I_KA], (const float*)(ws + WS_KZ), (const float*)(ws + WS_KNORM), (float*)(ws + WS_KP), (float*)(ws + WS_AN), (float*)(ws + WS_BB)};
          pg8::gemm_phase<pg8::EpiIclr, pg8::StaticOrder>(lds, pg8::Gemm{256, 768, 256}, S, E); }
        if (P3M & 4) { pg8::StaticOrder S; S.init(ws + WS_LIN + 1024, ws + WS_GUP, M, D, 768, 256, c.G, bx);
          pg8::EpiF32 E{(float*)(ws + WS_GG), D, nullptr, 0, nullptr, 0.f};
          pg8::gemm_phase<pg8::EpiF32, pg8::StaticOrder>(lds, pg8::Gemm{256, 768, 256}, S, E); }
        if (P3M & 8) { pg8::StaticOrder S; S.init(ws + WS_MEMB, ws + WS_WKV, 1024, 2 * D, D, D, c.G, bx);
          pg8::EpiKV E{(bf16_t*)(ws + WS_KB), (bf16_t*)(ws + WS_VT)};
          pg8::gemm_phase<pg8::EpiKV, pg8::StaticOrder>(lds, pg8::Gemm{D, D, D}, S, E); }
        SEAM(3);
    }
    if (IN(4)) {
        p4_pre(p, c);
        xcd_barrier(bar);
        for (int bh = c.vcu; bh < 128; bh += c.G) p4_seq(p, c, bh);
        p4_queue(p, c, MISC + 16);
        SEAM(4);
    }
    if (IN(5)) { p5_post(p, c); }

    if (IN(6)) {
        pg8::StaticOrder S; S.init(ws + WS_YA, ws + WS_PA, M, D, D, D, c.G, bx);
        pg8::EpiGateA E{(const bf16_t*)(ws + WS_PROJ), (float*)(ws + WS_TMP)};
        pg8::gemm_phase<pg8::EpiGateA, pg8::StaticOrder>(lds, pg8::Gemm{D, D, D}, S, E);
        SEAM(6);
    }
    if (IN(7)) {
        pg8::StaticOrder S; S.init(ws + WS_YB, ws + WS_PB, M, D, 512, 512, c.G, bx);
        pg8::EpiGateB E{(const bf16_t*)(ws + WS_PROJ), (const float*)(ws + WS_TMP), (bf16_t*)(ws + WS_MERGED)};
        pg8::gemm_phase<pg8::EpiGateB, pg8::StaticOrder>(lds, pg8::Gemm{512, 512, 512}, S, E);
        SEAM(7);
    }
    if (IN(8)) {
        pg8::StaticOrder S; S.init(ws + WS_MERGED, ws + WS_WOUT, M, D, D, D, c.G, bx);
        pg8::EpiF32 E{(float*)(ws + WS_T1), D, nullptr, 0, p.in[I_X], DN_ALPHA};
        pg8::gemm_phase<pg8::EpiF32, pg8::StaticOrder>(lds, pg8::Gemm{D, D, D}, S, E);
        SEAM(8);
    }
    if (IN(9)) { ln_rows(c, (const float*)(ws + WS_T1), p.in[I_LN1G], p.in[I_LN1B], (float*)(ws + WS_X1), (bf16_t*)(ws + WS_X1B)); SEAM(9); }

    if (IN(10)) {
        pg8::StaticOrder S; S.init(ws + WS_X1B, ws + WS_WQ, M, D, D, D, c.G, bx);
        pg8::EpiBf16 E{(bf16_t*)(ws + WS_Q), D, 0.04419417382415922f};
        pg8::gemm_phase<pg8::EpiBf16, pg8::StaticOrder>(lds, pg8::Gemm{D, D, D}, S, E);
        SEAM(10);
    }
    if (IN(11)) {
        ScoreOrder S{(const char*)(ws + WS_Q), (const char*)(ws + WS_KB), c.G, bx};
        pg8::EpiSoftmax E{(bf16_t*)(ws + WS_PP)};
        pg8::gemm_phase<pg8::EpiSoftmax, ScoreOrder, false>(lds, pg8::Gemm{512, D, D}, S, E);
        SEAM(11);
    }
    if (IN(12)) {
        PvOrder S{(const char*)(ws + WS_PP), (const char*)(ws + WS_VT), c.G, bx};
        pg8::EpiBf16 E{(bf16_t*)(ws + WS_OC), D, 1.0f};
        pg8::gemm_phase<pg8::EpiBf16, PvOrder>(lds, pg8::Gemm{256, 256, 256}, S, E);
        SEAM(12);
    }
    if (IN(13)) {
        pg8::StaticOrder S; S.init(ws + WS_OC, ws + WS_WO, M, D, D, D, c.G, bx);
        pg8::EpiF32 E{(float*)(ws + WS_T2), D, nullptr, 0, (const float*)(ws + WS_X1), DN_ALPHA};
        pg8::gemm_phase<pg8::EpiF32, pg8::StaticOrder>(lds, pg8::Gemm{D, D, D}, S, E);
        SEAM(13);
    }
    if (IN(14)) { ln_rows(c, (const float*)(ws + WS_T2), p.in[I_LN2G], p.in[I_LN2B], (float*)(ws + WS_X2), nullptr, ws + WS_X2B); SEAM(14); }
    if (IN(15)) { p15_router(p, c); SEAM(15); }

    if (IN(16)) {
        moe_table(c, tab);
        MoeOrder<true, 16> S{tab, (const char*)(ws + WS_X2B), (const char*)(ws + WS_W1), (const int*)(ws + WS_LIST), (size_t)4096 * D, D, c.G, bx};
        pg8::EpiSwiglu E{p.in[I_B1], (bf16_t*)(ws + WS_H)};
        pg8::gemm_phase<pg8::EpiSwiglu, MoeOrder<true, 16>, true, true>(lds, pg8::Gemm{D, D, D}, S, E);
        SEAM(16);
    }
    if (IN(17)) {
        moe_table(c, tab);
        MoeOrder<false, 8> S{tab, (const char*)(ws + WS_H), (const char*)(ws + WS_W2), (const int*)(ws + WS_LIST), (size_t)D * DFF, DFF, c.G, bx};
        pg8::EpiF32 E{(float*)(ws + WS_Y), D, p.in[I_B2], D, nullptr, 0.f};
        pg8::gemm_phase<pg8::EpiF32, MoeOrder<false, 8>, true, true>(lds, pg8::Gemm{DFF, DFF, DFF}, S, E);
        SEAM(17);
    }
    if (IN(18)) { moe_table(c, tab); p18_combine(p, c, tab); }
#undef IN
#undef SEAM
}

extern "C" void kernel_launch(void* const* d_in, const int* in_sizes, int n_in, void* d_out, int out_size, void* d_ws, size_t ws_size, hipStream_t stream) {
    static int grid = 0;
    if (grid == 0) {
        if (n_in != 32 || out_size != M * D || ws_size < WS_END) { fprintf(stderr, "kernel_launch: expected 32 inputs, %d outputs, >= %zu bytes of workspace; got %d, %d, %zu\n", M * D, (size_t)WS_END, n_in, out_size, ws_size); grid = -1; return; }
        int dev = 0, cus = 0, per_cu = 0;
        if (hipGetDevice(&dev) != hipSuccess || hipDeviceGetAttribute(&cus, hipDeviceAttributeMultiprocessorCount, dev) != hipSuccess) { grid = -1; return; }
        if (hipFuncSetAttribute((const void*)fwd, hipFuncAttributeMaxDynamicSharedMemorySize, LDS_BYTES) != hipSuccess) { fprintf(stderr, "kernel_launch: hipFuncSetAttribute failed\n"); grid = -1; return; }
        if (hipOccupancyMaxActiveBlocksPerMultiprocessor(&per_cu, (const void*)fwd, 512, LDS_BYTES) != hipSuccess || per_cu < 1) fprintf(stderr, "kernel_launch: occupancy query reports %d\n", per_cu);
        (void)hipGetLastError();
        grid = cus;
        if (grid != 256) fprintf(stderr, "kernel_launch: %d CUs; this kernel is built for 256\n", grid);
    }
    if (grid < 0) return;
    (void)hipMemsetAsync((char*)d_ws + WS_CTL, 0, CTL_ZERO_BYTES, stream);
    Params p{};
    for (int i = 0; i < 32; ++i) p.in[i] = (const float*)d_in[i];
    p.out = (float*)d_out; p.ws = (unsigned char*)d_ws;
#if defined(TIMING_REPEAT_LO)
    { const int cuts[4][2] = {{0, TIMING_REPEAT_HI}, {TIMING_REPEAT_LO, TIMING_REPEAT_HI}, {TIMING_REPEAT_HI, NPHASE}, {0, 0}};
      for (int li = 0; li < 3; ++li) { if (cuts[li][0] >= cuts[li][1]) continue; p.ph_lo = cuts[li][0]; p.ph_hi = cuts[li][1]; p.li = li; hipLaunchKernelGGL(fwd, dim3(grid), dim3(512), LDS_BYTES, stream, p); } }
#else
    if (N_LAUNCH_MODE == 1) { p.ph_lo = 0; p.ph_hi = NPHASE; hipLaunchKernelGGL(fwd, dim3(grid), dim3(512), LDS_BYTES, stream, p); }
    else for (int k = 0; k < NPHASE; ++k) { p.ph_lo = k; p.ph_hi = k + 1; hipLaunchKernelGGL(fwd, dim3(grid), dim3(512), LDS_BYTES, stream, p); }
#endif
}
```

```cpp
#include <hip/hip_runtime.h>
#include <cstdio>
#include <cstdint>

#define LAS __attribute__((address_space(3)))
#define GAS __attribute__((address_space(1)))
typedef unsigned short bf16_t;
typedef short bf16x8 __attribute__((ext_vector_type(8)));
typedef float f32x4 __attribute__((ext_vector_type(4)));
typedef float f32x2 __attribute__((ext_vector_type(2)));
typedef float f32x16 __attribute__((ext_vector_type(16)));
typedef unsigned u32x4 __attribute__((ext_vector_type(4)));
typedef unsigned u32x2 __attribute__((ext_vector_type(2)));

#ifndef N_LAUNCH_MODE
#define N_LAUNCH_MODE 1
#endif

constexpr int M = 16384, D = 2048, SEQ = 4096, NBATCH = 4;
constexpr int RWC = 6592;
constexpr int PC = 15360;
constexpr int ATT0 = 6656, GATE0 = 11264;
constexpr int NEXP = 32, DFF = 2048, CAP = 16384;
constexpr int HROWS = 65536 + 32 * 256;
constexpr float LN_EPS = 1e-5f, GN_EPS = 64e-5f;
constexpr float DN_ALPHA = 1.189207115002721f;

__device__ __forceinline__ float bf2f(unsigned v) { return __uint_as_float(v << 16); }
__device__ __forceinline__ unsigned f2bf(float f) { unsigned u = __float_as_uint(f); return (u + 0x7fffu + ((u >> 16) & 1u)) >> 16; }
__device__ __forceinline__ unsigned pk2(float lo, float hi) { return f2bf(lo) | (f2bf(hi) << 16); }
typedef int v4i __attribute__((ext_vector_type(4)));
typedef int v8i __attribute__((ext_vector_type(8)));
__device__ __forceinline__ unsigned pk4_fp8(float a, float b, float c, float d) { int r = __builtin_amdgcn_cvt_pk_fp8_f32(a, b, 0, false); r = __builtin_amdgcn_cvt_pk_fp8_f32(c, d, r, true); return (unsigned)r; }
__device__ __forceinline__ float sigmoidf_(float x) { return 1.0f / (1.0f + __expf(-x)); }
__device__ __forceinline__ float wave_sum(float v) {
#pragma unroll
    for (int o = 1; o < 64; o <<= 1) v += __shfl_xor(v, o);
    return v;
}
#define LDS_WAIT() asm volatile("s_waitcnt lgkmcnt(0)" ::: "memory")
#define VM_WAIT() asm volatile("s_waitcnt vmcnt(0)" ::: "memory")

namespace pg8 {
#define PG8_LAS __attribute__((address_space(3)))
constexpr int BM = 256, BK = 64, HALF = 128, HTB = HALF * BK * 2, STAGE_BYTES = 8 * HTB, NXCD = 8, WGM = 8;

__host__ __device__ __forceinline__ int lds_byte(int r, int c) { const int st = (r >> 4) * 2 + (c >> 5), rr = r & 15, cc = c & 31, ob = rr * 64 + cc * 2; return st * 1024 + (ob ^ (((ob >> 9) & 1) << 5)); }
__host__ __device__ __forceinline__ void stage_rc(int b, int& R, int& C) { const int st = b / 1024, sb = b % 1024, swz = sb ^ (((sb >> 9) & 1) << 5); R = (st >> 1) * 16 + swz / 64; C = (st & 1) * 32 + (swz % 64) / 2; }
__host__ __device__ __forceinline__ int perm32(int rho) { const int n = rho >> 4, i = rho & 15; return 8 * (i >> 2) + 4 * n + (i & 3); }

struct Unit { const char* A; const char* B; int orow, ocol, aux, aux2, valid; };
struct Gemm { int K, lda, ldb; };

struct StaticOrder {
    static constexpr bool GATHER = false;
    const char* A; const char* Bt; size_t ta, tb;
    int nM, nN, nwg, G, c;
    __device__ void init(const void* A_, const void* Bt_, int M_, int N_, int lda, int ldb, int G_, int c_) { A = (const char*)A_; Bt = (const char*)Bt_; ta = (size_t)BM * lda * 2; tb = (size_t)BM * ldb * 2; nM = M_ / BM; nN = N_ / BM; nwg = nM * nN; G = G_; c = c_; }
    __device__ bool next(int i, Unit& u) const {
        const long L = (long)i * G + c; if (c < 0 || L >= nwg) return false;
        int wgid = (int)L; { const int q = nwg / NXCD, r = nwg % NXCD, xcd = wgid % NXCD, off = wgid / NXCD; wgid = (xcd < r ? xcd * (q + 1) : r * (q + 1) + (xcd - r) * q) + off; }
        const int nig = WGM * nN, gid = wgid / nig, fm = gid * WGM, gsz = (nM - fm) < WGM ? (nM - fm) : WGM;
        const int pm = fm + ((wgid % nig) % gsz), pn = (wgid % nig) / gsz;
        u.A = A + (size_t)pm * ta; u.B = Bt + (size_t)pn * tb; u.orow = pm * BM; u.ocol = pn * BM; u.aux = 0; u.aux2 = 0; u.valid = BM; return true;
    }
    __device__ __forceinline__ const int* rows(const Unit&) const { return nullptr; }
};

__device__ __forceinline__ unsigned cvt_pk_bf16(float lo, float hi) { unsigned r; asm volatile("v_cvt_pk_bf16_f32 %0, %1, %2" : "=v"(r) : "v"(lo), "v"(hi)); return r; }

template <class Epi, class Sched, bool ALIGN_EPI = true, bool FP8 = false>
__device__ __forceinline__ void gemm_phase(PG8_LAS unsigned char* lds, const Gemm g, const Sched& S, const Epi& E) {
    const int tid = threadIdx.x, wid = __builtin_amdgcn_readfirstlane(tid >> 6), lane = tid & 63, wr = wid >> 2, wc = wid & 3, fr = lane & 15, fq = lane >> 4;
    constexpr int ES = FP8 ? 1 : 2;
    int sclW = 0, sclX = 0;
    if constexpr (FP8) { asm volatile("v_mov_b32 %0, 0x79797979\n\tv_mov_b32 %1, 0x7f7f7f7f" : "=v"(sclW), "=v"(sclX)); }
    const int K = g.K, nt = K * ES / (BK * 2);
    unsigned voffA[2], voffB[2]; int Rr[2], Cc[2];
#pragma unroll
    for (int i = 0; i < 2; ++i) { int R, C; stage_rc(tid * 16 + i * 8192, R, C); const int Rb = Epi::PERM ? ((R & ~31) + perm32(R & 31)) : R; Rr[i] = R; Cc[i] = C;
        voffA[i] = (unsigned)(R * g.lda * ES + C * 2); voffB[i] = (unsigned)(Rb * g.ldb * ES + C * 2); }
    const size_t kstep = (size_t)(BK * 2);
    const size_t hstepA = (size_t)HALF * g.lda * ES, hstepB = (size_t)HALF * g.ldb * ES;
    const unsigned ldsw = (unsigned)wid * 1024u;
    const int aoff = lds_byte(wr * 64 + fr, fq * 8), boff = lds_byte(wc * 32 + fr, fq * 8);
    unsigned vAc[2][2], vAn[2][2];
#define PG8_SA(b, h) (((b) * 2 + (h)) * HTB)
#define PG8_SB(b, h) ((4 + (b) * 2 + (h)) * HTB)
#define PG8_STAGE(bufoff, gbase, voff) do { _Pragma("unroll") for (int _i = 0; _i < 2; ++_i) \
        __builtin_amdgcn_global_load_lds((const unsigned*)((const char*)(gbase) + (voff)[_i]), (PG8_LAS unsigned*)(lds + (bufoff) + ldsw + _i * 8192), 16, 0, 0); } while (0)
#define PG8_STAGE_A(bufoff, kbase, h, nx) do { if constexpr (Sched::GATHER) { unsigned _v[2] = {(nx) ? vAn[h][0] : vAc[h][0], (nx) ? vAn[h][1] : vAc[h][1]}; PG8_STAGE(bufoff, kbase, _v); } \
        else { PG8_STAGE(bufoff, (kbase) + (h) * hstepA, voffA); } } while (0)
#define PG8_GOFF(u, v) do { const int* _rw = S.rows(u); _Pragma("unroll") for (int _h = 0; _h < 2; ++_h) _Pragma("unroll") for (int _i = 0; _i < 2; ++_i) { const int _r = Rr[_i] + _h * HALF; \
        const int _tk = _r < (u).valid ? _rw[_r] : 0; v[_h][_i] = (unsigned)(_tk * g.lda * ES + Cc[_i] * 2); } } while (0)
#define PG8_LDA(dst, b, h) do { _Pragma("unroll") for (int m = 0; m < 4; ++m) _Pragma("unroll") for (int k = 0; k < 2; ++k) dst[m][k] = *(const PG8_LAS bf16x8*)(lds + PG8_SA(b, h) + aoff + m * 2048 + k * 1024); } while (0)
#define PG8_LDB(dst, b, h) do { _Pragma("unroll") for (int n = 0; n < 2; ++n) _Pragma("unroll") for (int k = 0; k < 2; ++k) dst[n][k] = *(const PG8_LAS bf16x8*)(lds + PG8_SB(b, h) + boff + n * 2048 + k * 1024); } while (0)
#define PG8_MMA(ai, bj, At, Bt) do { __builtin_amdgcn_s_setprio(1); _Pragma("unroll") for (int m = 0; m < 4; ++m) _Pragma("unroll") for (int n = 0; n < 2; ++n) { \
        if constexpr (FP8) { const v4i _b0 = __builtin_bit_cast(v4i, Bt[n][0]), _b1 = __builtin_bit_cast(v4i, Bt[n][1]), _a0 = __builtin_bit_cast(v4i, At[m][0]), _a1 = __builtin_bit_cast(v4i, At[m][1]); \
            const v8i _bb = __builtin_shufflevector(_b0, _b1, 0, 1, 2, 3, 4, 5, 6, 7), _aa = __builtin_shufflevector(_a0, _a1, 0, 1, 2, 3, 4, 5, 6, 7); \
            asm volatile("v_mfma_scale_f32_16x16x128_f8f6f4 %0, %1, %2, %0, %3, %4 op_sel_hi:[0,0,0]" : "+v"(acc[ai][bj][m][n]) : "v"(_bb), "v"(_aa), "v"(sclW), "v"(sclX)); } \
        else { _Pragma("unroll") for (int k = 0; k < 2; ++k) acc[ai][bj][m][n] = __builtin_amdgcn_mfma_f32_16x16x32_bf16(Bt[n][k], At[m][k], acc[ai][bj][m][n], 0, 0, 0); } } \
        __builtin_amdgcn_s_setprio(0); } while (0)
#define PG8_WAIT_V(n) asm volatile("s_waitcnt vmcnt(" #n ")" ::: "memory")
#define PG8_WAIT_L(n) asm volatile("s_waitcnt lgkmcnt(" #n ")" ::: "memory")
#define PG8_BAR __builtin_amdgcn_s_barrier()
#define PG8_SCHED __builtin_amdgcn_sched_barrier(0)
    Unit cur, nxt; int ui = 0;
    if (!S.next(0, cur)) return;
    f32x4 acc[2][2][4][2];
#pragma unroll
    for (int a = 0; a < 2; ++a)
#pragma unroll
        for (int b = 0; b < 2; ++b)
#pragma unroll
            for (int m = 0; m < 4; ++m)
#pragma unroll
                for (int n = 0; n < 2; ++n) acc[a][b][m][n] = (f32x4){0.f, 0.f, 0.f, 0.f};
    bf16x8 At[4][2], B0[2][2], B1[2][2];
    const char* cA = cur.A; const char* cB = cur.B;
    if constexpr (Sched::GATHER) { PG8_GOFF(cur, vAc); PG8_WAIT_V(0); }
    PG8_STAGE(PG8_SB(0, 0), cB, voffB); PG8_STAGE(PG8_SB(0, 1), cB + hstepB, voffB); PG8_STAGE_A(PG8_SA(0, 0), cA, 0, false); PG8_STAGE_A(PG8_SA(0, 1), cA, 1, false);
    if (wr == 1) PG8_BAR;
    PG8_WAIT_V(2); PG8_BAR;
    PG8_STAGE(PG8_SB(1, 0), cB + kstep, voffB); PG8_STAGE_A(PG8_SA(1, 0), cA + kstep, 0, false); PG8_STAGE(PG8_SB(1, 1), cB + hstepB + kstep, voffB);
    PG8_WAIT_V(6); PG8_BAR;
    for (;;) {
        const bool has_next = S.next(ui + 1, nxt);
        const char* nA = has_next ? nxt.A : cA; const char* nB = has_next ? nxt.B : cB;
        if constexpr (Sched::GATHER) { if (has_next) { PG8_GOFF(nxt, vAn); } else {
#pragma unroll
            for (int h = 0; h < 2; ++h)
#pragma unroll
                for (int i = 0; i < 2; ++i) vAn[h][i] = vAc[h][i]; } }
#pragma nounroll
        for (int t = 0; t < nt; t += 2) {
            const bool last = (t == nt - 2);
            const char* a1 = cA + (size_t)(t + 1) * kstep;
            const char* a2 = last ? nA : cA + (size_t)(t + 2) * kstep; const char* b2 = last ? nB : cB + (size_t)(t + 2) * kstep;
            const char* a3 = a2 + kstep; const char* b3 = b2 + kstep;
            PG8_LDB(B0, 0, 0); PG8_LDB(B1, 0, 1); PG8_SCHED; PG8_LDA(At, 0, 0); PG8_STAGE_A(PG8_SA(1, 1), a1, 1, false);
            PG8_WAIT_V(8); PG8_WAIT_L(0); PG8_BAR; PG8_MMA(0, 0, At, B0); PG8_MMA(0, 1, At, B1); PG8_BAR; PG8_SCHED;
            PG8_LDA(At, 0, 1); PG8_STAGE(PG8_SB(0, 0), b2, voffB); PG8_STAGE(PG8_SB(0, 1), b2 + hstepB, voffB); PG8_STAGE_A(PG8_SA(0, 0), a2, 0, last);
            PG8_WAIT_V(8); PG8_WAIT_L(0); PG8_BAR; PG8_MMA(1, 0, At, B0); PG8_MMA(1, 1, At, B1); PG8_BAR; PG8_SCHED;
            PG8_LDB(B0, 1, 0); PG8_LDB(B1, 1, 1); PG8_SCHED; PG8_LDA(At, 1, 0); PG8_STAGE_A(PG8_SA(0, 1), a2, 1, last);
            PG8_WAIT_V(8); PG8_WAIT_L(0); PG8_BAR; PG8_MMA(0, 0, At, B0); PG8_MMA(0, 1, At, B1); PG8_BAR; PG8_SCHED;
            PG8_LDA(At, 1, 1); PG8_STAGE(PG8_SB(1, 0), b3, voffB); PG8_STAGE(PG8_SB(1, 1), b3 + hstepB, voffB); PG8_STAGE_A(PG8_SA(1, 0), a3, 0, last);
            PG8_WAIT_V(8); PG8_WAIT_L(0); PG8_BAR; PG8_MMA(1, 0, At, B0); PG8_MMA(1, 1, At, B1); PG8_BAR; PG8_SCHED;
        }
        if constexpr (ALIGN_EPI) { if (wr == 0) PG8_BAR; }
        if constexpr (FP8) asm volatile("s_nop 15\n\ts_nop 15" ::: "memory");
        if constexpr (!Epi::AFTER_DRAIN) { int l2 = lane; asm volatile("" : "+v"(l2));
            E(acc, cur, wr, wc, l2 & 15, l2 >> 4); }
        if (!has_next) break;
#pragma unroll
        for (int a = 0; a < 2; ++a)
#pragma unroll
            for (int b = 0; b < 2; ++b)
#pragma unroll
                for (int m = 0; m < 4; ++m)
#pragma unroll
                    for (int n = 0; n < 2; ++n) acc[a][b][m][n] = (f32x4){0.f, 0.f, 0.f, 0.f};
        cur = nxt; cA = nA; cB = nB; ++ui;
        if constexpr (Sched::GATHER) {
#pragma unroll
            for (int h = 0; h < 2; ++h)
#pragma unroll
                for (int i = 0; i < 2; ++i) vAc[h][i] = vAn[h][i]; }
        if constexpr (ALIGN_EPI) { if (wr == 1) PG8_BAR; }
    }
    PG8_WAIT_V(0);
    if constexpr (!ALIGN_EPI) { if (wr == 0) PG8_BAR; }
    PG8_BAR;
    if constexpr (Epi::AFTER_DRAIN) { E.fused(acc, cur, wr, wc, fr, fq, lds, wid, lane); }
#undef PG8_SA
#undef PG8_SB
#undef PG8_STAGE
#undef PG8_STAGE_A
#undef PG8_GOFF
#undef PG8_LDA
#undef PG8_LDB
#undef PG8_MMA
#undef PG8_WAIT_V
#undef PG8_WAIT_L
#undef PG8_BAR
#undef PG8_SCHED
}

#define EPI_LOOP_AI_M for (int ai = 0; ai < 2; ++ai) _Pragma("unroll") for (int m = 0; m < 4; ++m)

struct EpiF32 {
    static constexpr bool PERM = false, AFTER_DRAIN = false;
    float* C; int ldc; const float* bias; int bstride; const float* res; float alpha;
    __device__ __forceinline__ void operator()(const f32x4 (&acc)[2][2][4][2], const Unit& u, int wr, int wc, int fr, int fq) const {
        const int row0 = u.orow + wr * 64 + fr, col0 = u.ocol + wc * 32 + 4 * fq;
        f32x4 bv[2][2];
#pragma unroll
        for (int bj = 0; bj < 2; ++bj)
#pragma unroll
            for (int n = 0; n < 2; ++n) bv[bj][n] = bias ? *(const f32x4*)(bias + (size_t)u.aux * bstride + col0 + bj * HALF + n * 16) : (f32x4){0.f, 0.f, 0.f, 0.f};
#pragma unroll
        EPI_LOOP_AI_M { const size_t off = (size_t)(row0 + ai * HALF + m * 16) * ldc + col0;
#pragma unroll
            for (int bj = 0; bj < 2; ++bj)
#pragma unroll
                for (int n = 0; n < 2; ++n) { f32x4 v = acc[ai][bj][m][n] + bv[bj][n];
                    if (res) { const f32x4 rv = *(const f32x4*)(res + off + bj * HALF + n * 16); v = v + rv * alpha; }
                    *(f32x4*)(C + off + bj * HALF + n * 16) = v; }
            asm volatile("" ::: "memory"); }
    }
};
struct EpiBf16 {
    static constexpr bool PERM = true, AFTER_DRAIN = false;
    bf16_t* O; int ldc; float scale;
    __device__ __forceinline__ void operator()(const f32x4 (&acc)[2][2][4][2], const Unit& u, int wr, int wc, int fr, int fq) const {
        const int row0 = u.orow + wr * 64 + fr, col0 = u.ocol + wc * 32 + 8 * fq;
#pragma unroll
        EPI_LOOP_AI_M { bf16_t* rowp = O + (size_t)(row0 + ai * HALF + m * 16) * ldc + col0;
#pragma unroll
            for (int bj = 0; bj < 2; ++bj) { const f32x4 v0 = acc[ai][bj][m][0] * scale, v1 = acc[ai][bj][m][1] * scale;
                u32x4 w; w.x = cvt_pk_bf16(v0[0], v0[1]); w.y = cvt_pk_bf16(v0[2], v0[3]); w.z = cvt_pk_bf16(v1[0], v1[1]); w.w = cvt_pk_bf16(v1[2], v1[3]);
                *(u32x4*)(rowp + bj * HALF) = w; } }
    }
};
struct EpiKV {
    static constexpr bool PERM = true, AFTER_DRAIN = false;
    bf16_t* KB; bf16_t* VT;
    __device__ __forceinline__ void operator()(const f32x4 (&acc)[2][2][4][2], const Unit& u, int wr, int wc, int fr, int fq) const {
        const int row0 = u.orow + wr * 64 + fr, col0 = u.ocol + wc * 32 + 8 * fq;
#pragma unroll
        EPI_LOOP_AI_M { const int row = row0 + ai * HALF + m * 16;
#pragma unroll
            for (int bj = 0; bj < 2; ++bj) { const f32x4 v0 = acc[ai][bj][m][0], v1 = acc[ai][bj][m][1]; const int col = col0 + bj * HALF;
                if (u.ocol < 2048) { u32x4 w; w.x = cvt_pk_bf16(v0[0], v0[1]); w.y = cvt_pk_bf16(v0[2], v0[3]); w.z = cvt_pk_bf16(v1[0], v1[1]); w.w = cvt_pk_bf16(v1[2], v1[3]);
                    *(u32x4*)(KB + (size_t)row * 2048 + col) = w; }
                else { const int b = row >> 8, key = row & 255, c = col - 2048, h = c >> 9, d = c & 511; bf16_t* p = VT + ((size_t)((b * 4 + h) * 512 + d)) * 256 + key;
#pragma unroll
                    for (int j = 0; j < 4; ++j) { p[(size_t)j * 256] = (bf16_t)f2bf(v0[j]); p[(size_t)(4 + j) * 256] = (bf16_t)f2bf(v1[j]); } } } }
    }
};
struct EpiDecay {
    static constexpr bool PERM = false, AFTER_DRAIN = false;
    float* DEC; const float* w0;
    __device__ __forceinline__ void operator()(const f32x4 (&acc)[2][2][4][2], const Unit& u, int wr, int wc, int fr, int fq) const {
        const int row0 = u.orow + wr * 64 + fr, col0 = u.ocol + wc * 32 + 4 * fq;
        f32x4 bv[2][2];
#pragma unroll
        for (int bj = 0; bj < 2; ++bj)
#pragma unroll
            for (int n = 0; n < 2; ++n) bv[bj][n] = *(const f32x4*)(w0 + col0 + bj * HALF + n * 16);
#pragma unroll
        EPI_LOOP_AI_M { const size_t off = (size_t)(row0 + ai * HALF + m * 16) * D + col0;
#pragma unroll
            for (int bj = 0; bj < 2; ++bj)
#pragma unroll
                for (int n = 0; n < 2; ++n) { const f32x4 x = acc[ai][bj][m][n] + bv[bj][n]; f32x4 o;
#pragma unroll
                    for (int j = 0; j < 4; ++j) o[j] = __expf(-0.6065306597126334f * sigmoidf_(x[j]));
                    *(f32x4*)(DEC + off + bj * HALF + n * 16) = o; } }
    }
};
struct EpiIclr {
    static constexpr bool PERM = false, AFTER_DRAIN = false;
    const float* a0; const float* k_k; const float* k_a; const bf16_t* KZ; const float* KNORM; bf16_t* KP; bf16_t* AN; bf16_t* BB;
    __device__ __forceinline__ void operator()(const f32x4 (&acc)[2][2][4][2], const Unit& u, int wr, int wc, int fr, int fq) const {
        const int row0 = u.orow + wr * 64 + fr, col0 = u.ocol + wc * 32 + 4 * fq;
#pragma unroll
        for (int bj = 0; bj < 2; ++bj)
#pragma unroll
            for (int n = 0; n < 2; ++n) { const int col = col0 + bj * HALF + n * 16;
                const f32x4 a0v = *(const f32x4*)(a0 + col), kkv = *(const f32x4*)(k_k + col), kav = *(const f32x4*)(k_a + col);
#pragma unroll
                EPI_LOOP_AI_M { const int row = row0 + ai * HALF + m * 16; const size_t off = (size_t)row * D + col;
                    const u32x2 kzw = *(const u32x2*)(KZ + off); const f32x4 kz = (f32x4){bf2f(kzw.x & 0xffffu), bf2f(kzw.x >> 16), bf2f(kzw.y & 0xffffu), bf2f(kzw.y >> 16)};
                    const float nr = KNORM[(size_t)row * 32 + (col >> 6)]; const float inv = 1.0f / fmaxf(nr, 1e-12f);
                    const f32x4 x = acc[ai][bj][m][n] + a0v; f32x4 kp, an, bb;
#pragma unroll
                    for (int j = 0; j < 4; ++j) { const float a = sigmoidf_(x[j]); const float kk = kz[j] * kkv[j] * inv; kp[j] = kz[j] * (1.0f + (a - 1.0f) * kav[j]); bb[j] = kk * a; an[j] = -kk; }
                    *(u32x2*)(KP + off) = (u32x2){pk2(kp[0], kp[1]), pk2(kp[2], kp[3])}; *(u32x2*)(AN + off) = (u32x2){pk2(an[0], an[1]), pk2(an[2], an[3])}; *(u32x2*)(BB + off) = (u32x2){pk2(bb[0], bb[1]), pk2(bb[2], bb[3])}; }
                asm volatile("" ::: "memory"); }
    }
};
struct EpiGateA {
    static constexpr bool PERM = false, AFTER_DRAIN = false;
    const bf16_t* PROJ; float* TMP;
    __device__ __forceinline__ void operator()(const f32x4 (&acc)[2][2][4][2], const Unit& u, int wr, int wc, int fr, int fq) const {
        const int row0 = u.orow + wr * 64 + fr, col0 = u.ocol + wc * 32 + 4 * fq;
#pragma unroll
        EPI_LOOP_AI_M { const int row = row0 + ai * HALF + m * 16;
#pragma unroll
            for (int bj = 0; bj < 2; ++bj)
#pragma unroll
                for (int n = 0; n < 2; ++n) { const int col = col0 + bj * HALF + n * 16; const u32x2 gv = *(const u32x2*)(PROJ + (size_t)row * PC + GATE0 + col);
                    const f32x4 a = acc[ai][bj][m][n]; f32x4 o;
                    o[0] = a[0] * sigmoidf_(bf2f(gv.x & 0xffffu)); o[1] = a[1] * sigmoidf_(bf2f(gv.x >> 16)); o[2] = a[2] * sigmoidf_(bf2f(gv.y & 0xffffu)); o[3] = a[3] * sigmoidf_(bf2f(gv.y >> 16));
                    *(f32x4*)(TMP + (size_t)row * D + col) = o; } }
    }
};
struct EpiGateB {
    static constexpr bool PERM = true, AFTER_DRAIN = false;
    const bf16_t* PROJ; const float* TMP; bf16_t* MERGED;
    __device__ __forceinline__ void operator()(const f32x4 (&acc)[2][2][4][2], const Unit& u, int wr, int wc, int fr, int fq) const {
        const int row0 = u.orow + wr * 64 + fr, col0 = u.ocol + wc * 32 + 8 * fq;
#pragma unroll
        EPI_LOOP_AI_M { const int row = row0 + ai * HALF + m * 16;
#pragma unroll
            for (int bj = 0; bj < 2; ++bj) { const int col = col0 + bj * HALF; const u32x4 gv = *(const u32x4*)(PROJ + (size_t)row * PC + GATE0 + 2048 + col);
                const f32x4 t0 = *(const f32x4*)(TMP + (size_t)row * D + col), t1 = *(const f32x4*)(TMP + (size_t)row * D + col + 4);
                const f32x4 a0 = acc[ai][bj][m][0], a1 = acc[ai][bj][m][1]; f32x4 o0, o1;
                o0[0] = t0[0] + a0[0] * sigmoidf_(bf2f(gv.x & 0xffffu)); o0[1] = t0[1] + a0[1] * sigmoidf_(bf2f(gv.x >> 16)); o0[2] = t0[2] + a0[2] * sigmoidf_(bf2f(gv.y & 0xffffu)); o0[3] = t0[3] + a0[3] * sigmoidf_(bf2f(gv.y >> 16));
                o1[0] = t1[0] + a1[0] * sigmoidf_(bf2f(gv.z & 0xffffu)); o1[1] = t1[1] + a1[1] * sigmoidf_(bf2f(gv.z >> 16)); o1[2] = t1[2] + a1[2] * sigmoidf_(bf2f(gv.w & 0xffffu)); o1[3] = t1[3] + a1[3] * sigmoidf_(bf2f(gv.w >> 16));
                u32x4 w; w.x = cvt_pk_bf16(o0[0], o0[1]); w.y = cvt_pk_bf16(o0[2], o0[3]); w.z = cvt_pk_bf16(o1[0], o1[1]); w.w = cvt_pk_bf16(o1[2], o1[3]);
                *(u32x4*)(MERGED + (size_t)row * D + col) = w; }
            asm volatile("" ::: "memory"); }
    }
};
struct EpiSwiglu {
    static constexpr bool PERM = true, AFTER_DRAIN = false;
    const float* b1; bf16_t* H;
    __device__ __forceinline__ float sw(float g, float l) const { g = fminf(g, 7.0f); l = fminf(fmaxf(l, -7.0f), 7.0f); return g * sigmoidf_(1.702f * g) * (l + 1.0f); }
    __device__ __forceinline__ void operator()(const f32x4 (&acc)[2][2][4][2], const Unit& u, int wr, int wc, int fr, int fq) const {
        const int row0 = u.orow + wr * 64 + fr, col0 = u.ocol + wc * 32 + 8 * fq;
        f32x4 bv[2][2];
#pragma unroll
        for (int bj = 0; bj < 2; ++bj)
#pragma unroll
            for (int n = 0; n < 2; ++n) bv[bj][n] = *(const f32x4*)(b1 + (size_t)u.aux * 4096 + col0 + bj * HALF + 4 * n);
#pragma unroll
        EPI_LOOP_AI_M { const int row = row0 + ai * HALF + m * 16;
#pragma unroll
            for (int bj = 0; bj < 2; ++bj) { const f32x4 v0 = acc[ai][bj][m][0] + bv[bj][0], v1 = acc[ai][bj][m][1] + bv[bj][1];
                *(unsigned*)((unsigned char*)H + (size_t)row * DFF + ((col0 + bj * HALF) >> 1)) = pk4_fp8(sw(v0[0], v0[1]), sw(v0[2], v0[3]), sw(v1[0], v1[1]), sw(v1[2], v1[3])); } }
    }
};
struct EpiSoftmax {
    static constexpr bool PERM = true, AFTER_DRAIN = true;
    bf16_t* PP;
    __device__ __forceinline__ void fused(f32x4 (&acc)[2][2][4][2], const Unit& u, int wr, int wc, int fr, int fq, PG8_LAS unsigned char* lds, int wid, int lane) const {
        PG8_LAS float* P1 = (PG8_LAS float*)lds;
        PG8_LAS float* P2 = (PG8_LAS float*)(lds + 4096);
        float mx[2][4];
#pragma unroll
        EPI_LOOP_AI_M { float v = -3.0e38f;
#pragma unroll
            for (int bj = 0; bj < 2; ++bj)
#pragma unroll
                for (int n = 0; n < 2; ++n) { const f32x4 x = acc[ai][bj][m][n]; v = fmaxf(v, fmaxf(fmaxf(x[0], x[1]), fmaxf(x[2], x[3]))); }
            v = fmaxf(v, __shfl_xor(v, 16)); v = fmaxf(v, __shfl_xor(v, 32));
            if (fq == 0) P1[(ai * HALF + wr * 64 + m * 16 + fr) * 4 + wc] = v; }
        asm volatile("s_waitcnt lgkmcnt(0)" ::: "memory"); __builtin_amdgcn_s_barrier(); asm volatile("" ::: "memory");
#pragma unroll
        EPI_LOOP_AI_M { const f32x4 t = *(const PG8_LAS f32x4*)(P1 + (ai * HALF + wr * 64 + m * 16 + fr) * 4); mx[ai][m] = fmaxf(fmaxf(t[0], t[1]), fmaxf(t[2], t[3])); }
#pragma unroll
        EPI_LOOP_AI_M { float s = 0.f;
#pragma unroll
            for (int bj = 0; bj < 2; ++bj)
#pragma unroll
                for (int n = 0; n < 2; ++n) { f32x4 x = acc[ai][bj][m][n];
#pragma unroll
                    for (int j = 0; j < 4; ++j) { x[j] = __expf(x[j] - mx[ai][m]); s += x[j]; }
                    acc[ai][bj][m][n] = x; }
            s += __shfl_xor(s, 16); s += __shfl_xor(s, 32);
            if (fq == 0) P2[(ai * HALF + wr * 64 + m * 16 + fr) * 4 + wc] = s; }
        asm volatile("s_waitcnt lgkmcnt(0)" ::: "memory"); __builtin_amdgcn_s_barrier(); asm volatile("" ::: "memory");
        const int row0 = u.orow + wr * 64 + fr, col0 = wc * 32 + 8 * fq;
#pragma unroll
        EPI_LOOP_AI_M { const f32x4 t = *(const PG8_LAS f32x4*)(P2 + (ai * HALF + wr * 64 + m * 16 + fr) * 4); const float inv = 1.0f / ((t[0] + t[1]) + (t[2] + t[3]));
            bf16_t* rowp = PP + (size_t)(row0 + ai * HALF + m * 16) * 256 + col0;
#pragma unroll
            for (int bj = 0; bj < 2; ++bj) { const f32x4 v0 = acc[ai][bj][m][0] * inv, v1 = acc[ai][bj][m][1] * inv;
                u32x4 w; w.x = cvt_pk_bf16(v0[0], v0[1]); w.y = cvt_pk_bf16(v0[2], v0[3]); w.z = cvt_pk_bf16(v1[0], v1[1]); w.w = cvt_pk_bf16(v1[2], v1[3]);
                *(u32x4*)(rowp + bj * HALF) = w; } }
        asm volatile("s_waitcnt lgkmcnt(0)" ::: "memory"); __builtin_amdgcn_s_barrier(); asm volatile("" ::: "memory");
    }
};
}

constexpr size_t MiB = 1u << 20;
constexpr size_t al256(size_t x) { return (x + 255) & ~(size_t)255; }
constexpr size_t WS_CTL = 0, CTL_ZERO_BYTES = 1 * MiB;
constexpr size_t WS_WIN = 1 * MiB;
constexpr size_t WS_WUP = WS_WIN + (size_t)PC * D * 2;
constexpr size_t WS_AUP = WS_WUP + (size_t)D * 256 * 2;
constexpr size_t WS_GUP = WS_AUP + (size_t)D * 256 * 2;
constexpr size_t WS_PA = WS_GUP + (size_t)D * 256 * 2;
constexpr size_t WS_PB = WS_PA + (size_t)D * D * 2;
constexpr size_t WS_WOUT = WS_PB + (size_t)D * 512 * 2;
constexpr size_t WS_WQ = WS_WOUT + (size_t)D * D * 2;
constexpr size_t WS_WKV = WS_WQ + (size_t)D * D * 2;
constexpr size_t WS_WO = WS_WKV + (size_t)2 * D * D * 2;
constexpr size_t WS_W1 = WS_WO + (size_t)D * D * 2;
constexpr size_t WS_W2 = WS_W1 + (size_t)NEXP * 4096 * D * 2;
constexpr size_t WS_XB = WS_W2 + (size_t)NEXP * D * DFF * 2;
constexpr size_t WS_MEMB = WS_XB + (size_t)M * D * 2;
constexpr size_t WS_ROT = WS_MEMB + (size_t)1024 * D * 2;
constexpr size_t WS_KB = WS_ROT + (size_t)2 * SEQ * 32 * 4;
constexpr size_t WS_VT = WS_KB + (size_t)1024 * D * 2;
constexpr size_t WS_YA = WS_VT + (size_t)1024 * D * 2;
constexpr size_t WS_YB = WS_YA + (size_t)M * D * 2;
constexpr size_t WS_TMP = WS_YB + (size_t)M * 512 * 2;
constexpr size_t WS_MERGED = WS_TMP + (size_t)M * D * 4;
constexpr size_t WS_E = WS_MERGED + (size_t)M * D * 2;
constexpr size_t WS_PROJ = WS_E;
constexpr size_t WS_RZ = WS_PROJ + (size_t)M * PC * 2;
constexpr size_t WS_KZ = WS_RZ + (size_t)M * D * 4;
constexpr size_t WS_VZ = WS_KZ + (size_t)M * D * 4;
constexpr size_t WS_DEC = WS_VZ + (size_t)M * D * 4;
constexpr size_t WS_KP = WS_DEC + (size_t)M * D * 4;
constexpr size_t WS_AN = WS_KP + (size_t)M * D * 4;
constexpr size_t WS_BB = WS_AN + (size_t)M * D * 4;
constexpr size_t WS_GG = WS_BB + (size_t)M * D * 4;
constexpr size_t WS_YS = WS_GG + (size_t)M * D * 4;
constexpr size_t WS_AO = WS_YS + (size_t)M * D * 4;
constexpr size_t WS_LSE = WS_AO + (size_t)3 * M * 512 * 4;
constexpr size_t WS_QR = WS_LSE + (size_t)3 * M * 8 * 4;
constexpr size_t WS_KR = WS_QR + (size_t)M * 1536 * 2;
constexpr size_t WS_LIN = WS_KR + (size_t)M * 1536 * 2;
constexpr size_t WS_KNORM = WS_LIN + (size_t)M * 768 * 2;
constexpr size_t WS_F = WS_KNORM + (size_t)M * 32 * 4;
constexpr size_t WS_E_END = WS_F + (size_t)128 * 128 * 96 * 96 * 2;
constexpr size_t WS_T1 = WS_E;
constexpr size_t WS_X1 = WS_T1 + (size_t)M * D * 4;
constexpr size_t WS_X1B = WS_X1 + (size_t)M * D * 4;
constexpr size_t WS_Q = WS_X1B + (size_t)M * D * 2;
constexpr size_t WS_PP = WS_Q + (size_t)M * D * 2;
constexpr size_t WS_OC = WS_PP + (size_t)16 * SEQ * 256 * 2;
constexpr size_t WS_T2 = WS_OC + (size_t)M * D * 2;
constexpr size_t WS_X2 = WS_T2 + (size_t)M * D * 4;
constexpr size_t WS_X2B = WS_X2 + (size_t)M * D * 4;
constexpr size_t WS_LIST = WS_X2B + (size_t)M * D * 2;
constexpr size_t WS_ROWI = WS_LIST + (size_t)NEXP * CAP * 4;
constexpr size_t WS_TOPW = WS_ROWI + (size_t)M * 4 * 4;
constexpr size_t WS_H = WS_TOPW + (size_t)M * 4 * 4;
constexpr size_t WS_Y = WS_H + (size_t)HROWS * DFF * 2;
constexpr size_t WS_L_END = WS_Y + (size_t)HROWS * D * 4;
constexpr size_t WS_END = (WS_E_END > WS_L_END ? WS_E_END : WS_L_END);
static_assert(WS_END <= (size_t)4090 * MiB, "workspace map exceeds 4 x largest input");
constexpr int CW_TMO = 0, CW_CNT = 64  , CW_Q = 128  , CW_BAR = 4096;

constexpr int RING_BYTES = 131072, MISC_OFF = RING_BYTES, LDS_BYTES = 147456;

#define XB_TMO      128
#define XB_XCNT(j)  (256  + 64 * (j))
#define XB_XSUB(j)  (1280 + 64 * (j))
#define XB_XGEN(j)  (2304 + 64 * (j))
#define XB_TOP      3328
#define XB_TOPGEN   3392
#define XCD_BAR_WORDS 3456
#define XB_SPIN_CAP (1u << 18)
__device__ __forceinline__ unsigned xb_ld(unsigned* p)              { return __hip_atomic_load(p, __ATOMIC_RELAXED, __HIP_MEMORY_SCOPE_AGENT); }
__device__ __forceinline__ unsigned xb_add(unsigned* p, unsigned v) { return __hip_atomic_fetch_add(p, v, __ATOMIC_RELAXED, __HIP_MEMORY_SCOPE_AGENT); }
__device__ __forceinline__ unsigned xb_xcc_id() { return (unsigned)__builtin_amdgcn_s_getreg((3 << 11) | 20) & 0xFu; }
#define XB_SPIN(cond, bar) do { unsigned _sp = 0; while (cond) { __builtin_amdgcn_s_sleep(1); \
    if ((++_sp & 255u) == 0u) { if (xb_ld(&(bar)[XB_TMO])) break; if (_sp > XB_SPIN_CAP) { atomicAdd(&(bar)[XB_TMO], 1u); break; } } } } while (0)
struct XcdBarrier { unsigned* bar; unsigned x; volatile LAS unsigned* st; };
__device__ __forceinline__ XcdBarrier xcd_barrier_post(unsigned* bar, volatile LAS unsigned* st) {
    XcdBarrier b; b.bar = bar; b.x = xb_xcc_id(); b.st = st;
    if (threadIdx.x == 0) (void)xb_add(&bar[XB_XCNT(b.x)], 1u);
    return b;
}
__device__ __forceinline__ void xcd_barrier_complete(unsigned* bar, unsigned x, unsigned& nloc, unsigned& nx) {
    const unsigned G = gridDim.x * gridDim.y * gridDim.z;
    unsigned sum, cnt, mine, sp = 0u;
    for (;;) {
        sum = 0u; cnt = 0u; mine = 0u;
#pragma unroll
        for (unsigned j = 0; j < 16; ++j) { const unsigned c = xb_ld(&bar[XB_XCNT(j)]); sum += c; cnt += (c > 0u) ? 1u : 0u; mine = (j == x) ? c : mine; }
        if (sum == G) break;
        __builtin_amdgcn_s_sleep(1);
        if ((++sp & 255u) == 0u) { if (xb_ld(&bar[XB_TMO])) break; if (sp > XB_SPIN_CAP) { atomicAdd(&bar[XB_TMO], 1u); break; } }
    }
    nloc = mine > 0u ? mine : 1u; nx = cnt > 0u ? cnt : 1u;
}
__device__ __forceinline__ void xcd_barrier(const XcdBarrier& b) {
    asm volatile("s_waitcnt vmcnt(0)" ::: "memory");
    __syncthreads();
    if (threadIdx.x == 0) {
        unsigned* bar = b.bar;
        __builtin_amdgcn_s_waitcnt(0);
        unsigned nloc = b.st[0], nx = b.st[1];
        if (nloc == 0u) { xcd_barrier_complete(bar, b.x, nloc, nx); b.st[0] = nloc; b.st[1] = nx; }
        const unsigned old = xb_add(&bar[XB_XSUB(b.x)], 1u);
        const unsigned gen = old / nloc;
        if (old + 1u == (gen + 1u) * nloc) {
            __builtin_amdgcn_fence(__ATOMIC_RELEASE, "agent");
            asm volatile("s_waitcnt vmcnt(0)" ::: "memory");
            const unsigned og = xb_add(&bar[XB_TOP], 1u);
            const unsigned tg = og / nx;
            if (og + 1u == (tg + 1u) * nx) xb_add(&bar[XB_TOPGEN], 1u);
            else XB_SPIN(xb_ld(&bar[XB_TOPGEN]) == tg, bar);
            __builtin_amdgcn_fence(__ATOMIC_ACQUIRE, "agent");
            xb_add(&bar[XB_XGEN(b.x)], 1u);
            asm volatile("s_waitcnt vmcnt(0)" ::: "memory");
        } else {
            XB_SPIN(xb_ld(&bar[XB_XGEN(b.x)]) == gen, bar);
            __builtin_amdgcn_fence(__ATOMIC_ACQUIRE, "agent");
            asm volatile("s_waitcnt vmcnt(0)" ::: "memory");
        }
    }
    __syncthreads();
}

struct Params {
    const float* in[32];
    float* out; unsigned char* ws;
    int ph_lo, ph_hi, li, pad;
};
enum { I_X = 0, I_MEM, I_WIN, I_MIX, I_W0, I_WUP, I_A0, I_AUP, I_GUP, I_KK, I_KA, I_RK, I_LNXG, I_LNXB, I_PA, I_PB, I_WOUT, I_LN1G, I_LN1B, I_WQ, I_WKV, I_WO, I_LN2G, I_LN2B,
       I_RW, I_RB, I_W1, I_B1, I_W2, I_B2, I_LN3G, I_LN3B };

struct ScoreOrder {
    static constexpr bool GATHER = false;
    const char* Q; const char* KB; int G, c;
    __device__ bool next(int i, pg8::Unit& u) const {
        const int L = i * G + c; if (L >= 256) return false;
        const int bh = L >> 4, pm = L & 15, b = bh >> 2, h = bh & 3;
        u.A = Q + ((size_t)(b * SEQ + 256 * pm) * D + h * 512) * 2; u.B = KB + ((size_t)(b * 256) * D + h * 512) * 2;
        u.orow = bh * SEQ + 256 * pm; u.ocol = 0; u.aux = 0; u.aux2 = 0; u.valid = 256; return true;
    }
    __device__ __forceinline__ const int* rows(const pg8::Unit&) const { return nullptr; }
};
struct PvOrder {
    static constexpr bool GATHER = false;
    const char* PP; const char* VT; int G, c;
    __device__ bool next(int i, pg8::Unit& u) const {
        const int L = i * G + c; if (L >= 512) return false;
        const int bh = L >> 5, pm = (L >> 1) & 15, pn = L & 1, b = bh >> 2, h = bh & 3;
        u.A = PP + ((size_t)(bh * SEQ + 256 * pm) * 256) * 2; u.B = VT + ((size_t)(bh * 512 + 256 * pn) * 256) * 2;
        u.orow = b * SEQ + 256 * pm; u.ocol = h * 512 + 256 * pn; u.aux = 0; u.aux2 = 0; u.valid = 256; return true;
    }
    __device__ __forceinline__ const int* rows(const pg8::Unit&) const { return nullptr; }
};
template <bool GATHER_, int NT  > struct MoeOrder {
    static constexpr bool GATHER = GATHER_;
    const LAS int* tab; const char* A; const char* W; const int* list; size_t wexp  ; int ldb; int G, c;
    __device__ bool next(int i, pg8::Unit& u) const {
        constexpr int RPR = 256 / NT;
        const int rt = i * RPR + (c % RPR), pn = c / RPR, T = __builtin_amdgcn_readfirstlane(tab[64]);
        if (c >= 256 || rt >= T) return false;
        int e = 0;
        for (int j = 1; j < NEXP; ++j) e = (rt >= __builtin_amdgcn_readfirstlane(tab[32 + j])) ? j : e;
        const int lt = rt - __builtin_amdgcn_readfirstlane(tab[32 + e]), cnt = __builtin_amdgcn_readfirstlane(tab[e]);
        u.aux = e; u.aux2 = lt; u.valid = min(256, cnt - 256 * lt); u.orow = 256 * rt; u.ocol = 256 * pn;
        u.B = W + (size_t)e * wexp + (size_t)(256 * pn) * ldb;
        u.A = GATHER_ ? A : A + (size_t)(256 * rt) * DFF;
        return true;
    }
    __device__ __forceinline__ const int* rows(const pg8::Unit& u) const { return list + (size_t)u.aux * CAP + 256 * u.aux2; }
};

struct Ctx { int tid, lane, wave, vcu, G; LAS unsigned char* lds; unsigned char* ws; };

__device__ __forceinline__ void tr_item(const float* W, int ldw, int Ksrc, int sc0, bf16_t* WT, int ldt, int n0, int k0, LAS float* scr, int lane) {
#pragma unroll 8
    for (int i = 0; i < 32; ++i) { const int kk = 2 * i + (lane >> 5); float v = 0.f; if (sc0 >= 0 && (k0 + kk) < Ksrc) v = W[(size_t)(k0 + kk) * ldw + sc0 + (lane & 31)]; scr[kk * 33 + (lane & 31)] = v; }
    LDS_WAIT(); asm volatile("" ::: "memory");
    const int c = lane & 7;
#pragma unroll
    for (int j = 0; j < 4; ++j) { const int n = (lane >> 3) + 8 * j; const LAS float* s = scr + (8 * c) * 33 + n;
        u32x4 o; o.x = pk2(s[0 * 33], s[1 * 33]); o.y = pk2(s[2 * 33], s[3 * 33]); o.z = pk2(s[4 * 33], s[5 * 33]); o.w = pk2(s[6 * 33], s[7 * 33]);
        *(u32x4*)(WT + (size_t)(n0 + n) * ldt + k0 + 8 * c) = o; }
    LDS_WAIT(); asm volatile("" ::: "memory");
}
__device__ __forceinline__ void tr_job(const float* W, int N, int Ksrc, int Kdst, bf16_t* WT, int item, LAS float* scr, int lane) {
    const int nblk = N / 32, kb = item / nblk, nb = item % nblk;
    tr_item(W, N, Ksrc, 32 * nb, WT, Kdst, 32 * nb, 64 * kb, scr, lane);
}
__device__ __forceinline__ void p0_prologue(const Params& p, const Ctx& c) {
    LAS float* scr = (LAS float*)(c.lds + c.wave * 16384);
    const int gw = c.vcu * 8 + c.wave, NGW = c.G * 8;
    unsigned char* ws = c.ws;
    constexpr int I_WINJ = 32 * 480, I_LORA = 4 * 64, I_SQ = 32 * 64, I_PBJ = 8 * 64, I_KVJ = 32 * 128, I_W1E = 32 * 128, I_W2E = 32 * 64;
    constexpr int NITEMS = I_WINJ + 3 * I_LORA + 4 * I_SQ + I_PBJ + I_KVJ;
    for (int it = gw; it < NITEMS; it += NGW) {
        int r = it;
        if (r < I_WINJ) { const int kb = r / 480, nb = r % 480; const int sc0 = nb < 206 ? 32 * nb : (nb < 208 ? -1 : 32 * nb - 64);
            tr_item(p.in[I_WIN], 15296, D, sc0, (bf16_t*)(ws + WS_WIN), D, 32 * nb, 64 * kb, scr, c.lane); continue; } r -= I_WINJ;
        if (r < I_LORA) { tr_job(p.in[I_WUP], D, 96, 256, (bf16_t*)(ws + WS_WUP), r, scr, c.lane); continue; } r -= I_LORA;
        if (r < I_LORA) { tr_job(p.in[I_AUP], D, 96, 256, (bf16_t*)(ws + WS_AUP), r, scr, c.lane); continue; } r -= I_LORA;
        if (r < I_LORA) { tr_job(p.in[I_GUP], D, 256, 256, (bf16_t*)(ws + WS_GUP), r, scr, c.lane); continue; } r -= I_LORA;
        if (r < I_SQ) { tr_job(p.in[I_PA], D, D, D, (bf16_t*)(ws + WS_PA), r, scr, c.lane); continue; } r -= I_SQ;
        if (r < I_PBJ) { tr_job(p.in[I_PB], D, 512, 512, (bf16_t*)(ws + WS_PB), r, scr, c.lane); continue; } r -= I_PBJ;
        if (r < I_SQ) { tr_job(p.in[I_WOUT], D, D, D, (bf16_t*)(ws + WS_WOUT), r, scr, c.lane); continue; } r -= I_SQ;
        if (r < I_SQ) { tr_job(p.in[I_WQ], D, D, D, (bf16_t*)(ws + WS_WQ), r, scr, c.lane); continue; } r -= I_SQ;
        if (r < I_KVJ) { tr_job(p.in[I_WKV], 2 * D, D, D, (bf16_t*)(ws + WS_WKV), r, scr, c.lane); continue; } r -= I_KVJ;
        { tr_job(p.in[I_WO], D, D, D, (bf16_t*)(ws + WS_WO), r, scr, c.lane); }
    }
    const size_t gt = (size_t)c.vcu * 512 + c.tid, NT = (size_t)c.G * 512;
    for (size_t i = gt; i < (size_t)M * D / 8; i += NT) { const f32x4 a = ((const f32x4*)p.in[I_X])[2 * i], b = ((const f32x4*)p.in[I_X])[2 * i + 1];
        u32x4 o; o.x = pk2(a[0], a[1]); o.y = pk2(a[2], a[3]); o.z = pk2(b[0], b[1]); o.w = pk2(b[2], b[3]); ((u32x4*)(ws + WS_XB))[i] = o; }
    for (size_t i = gt; i < (size_t)1024 * D / 8; i += NT) { const f32x4 a = ((const f32x4*)p.in[I_MEM])[2 * i], b = ((const f32x4*)p.in[I_MEM])[2 * i + 1];
        u32x4 o; o.x = pk2(a[0], a[1]); o.y = pk2(a[2], a[3]); o.z = pk2(b[0], b[1]); o.w = pk2(b[2], b[3]); ((u32x4*)(ws + WS_MEMB))[i] = o; }
    float* rc = (float*)(ws + WS_ROT); float* rs = rc + SEQ * 32;
    for (size_t i = gt; i < (size_t)SEQ * 32; i += NT) { const int pos = (int)(i >> 5), j = (int)(i & 31);
        const double inv = exp(-(double)j * (9.210340371976184 / 32.0)); const double ang = (double)pos * inv; rc[i] = (float)cos(ang); rs[i] = (float)sin(ang); }
}

__device__ __forceinline__ void tr_store8(unsigned char* WT8, int ldt, int n0, int k0, const LAS float* scr, int lane) {
    const int c = lane & 3;
#pragma unroll
    for (int j = 0; j < 2; ++j) { const int n = (lane >> 2) + 16 * j; const LAS float* sp = scr + (16 * c) * 33 + n; u32x4 o;
        o.x = pk4_fp8(sp[0 * 33] * 64.f, sp[1 * 33] * 64.f, sp[2 * 33] * 64.f, sp[3 * 33] * 64.f); o.y = pk4_fp8(sp[4 * 33] * 64.f, sp[5 * 33] * 64.f, sp[6 * 33] * 64.f, sp[7 * 33] * 64.f);
        o.z = pk4_fp8(sp[8 * 33] * 64.f, sp[9 * 33] * 64.f, sp[10 * 33] * 64.f, sp[11 * 33] * 64.f); o.w = pk4_fp8(sp[12 * 33] * 64.f, sp[13 * 33] * 64.f, sp[14 * 33] * 64.f, sp[15 * 33] * 64.f);
        *(u32x4*)(WT8 + (size_t)(n0 + n) * ldt + k0 + 16 * c) = o; }
}
__device__ __forceinline__ void tr_item8(const float* W, int ldw, unsigned char* WT8, int ldt, int n0, int k0, LAS float* scr, int lane) {
#pragma unroll 8
    for (int i = 0; i < 32; ++i) { const int kk = 2 * i + (lane >> 5); scr[kk * 33 + (lane & 31)] = W[(size_t)(k0 + kk) * ldw + n0 + (lane & 31)]; }
    LDS_WAIT(); asm volatile("" ::: "memory");
    tr_store8(WT8, ldt, n0, k0, scr, lane);
    LDS_WAIT(); asm volatile("" ::: "memory");
}
__device__ __forceinline__ void tr_issue(const float* W, int ldw, int n0, int k0, int lane, float (&cv)[32]) {
#pragma unroll
    for (int i = 0; i < 32; ++i) cv[i] = W[(size_t)(k0 + 2 * i + (lane >> 5)) * ldw + n0 + (lane & 31)];
}
__device__ __forceinline__ void tr_finish(const float (&cv)[32], unsigned char* WT8, int ldt, int n0, int k0, LAS float* scr, int lane) {
#pragma unroll
    for (int i = 0; i < 32; ++i) scr[(2 * i + (lane >> 5)) * 33 + (lane & 31)] = cv[i];
    LDS_WAIT(); asm volatile("" ::: "memory");
    tr_store8(WT8, ldt, n0, k0, scr, lane);
    LDS_WAIT(); asm volatile("" ::: "memory");
}
constexpr int MOE_W1E = 32 * 128, MOE_W2E = 32 * 64, MOE_CONV_GROUPS = (NEXP * MOE_W2E) / 8;
__device__ __forceinline__ void conv_group(const Params& p, const Ctx& c, int gi) {
    LAS float* scr = (LAS float*)(c.lds + c.wave * 16384);
    unsigned char* ws = c.ws;
    const int r = gi * 8 + c.wave;
    { const int e = r / MOE_W2E, it = r % MOE_W2E, kb = it >> 6, nb = it & 63; tr_item8(p.in[I_W2] + (size_t)e * DFF * D, D, ws + WS_W2 + (size_t)e * D * DFF, DFF, 32 * nb, 64 * kb, scr, c.lane); }
}

__device__ __forceinline__ void p2_prep(const Params& p, const Ctx& c) {
    unsigned char* ws = c.ws;
    const bf16_t* PROJ = (const bf16_t*)(ws + WS_PROJ);
    const float* mix = p.in[I_MIX]; const float* k_k = p.in[I_KK];
    bf16_t* RZ = (bf16_t*)(ws + WS_RZ); bf16_t* KZ = (bf16_t*)(ws + WS_KZ); bf16_t* VZ = (bf16_t*)(ws + WS_VZ);
    bf16_t* LIN = (bf16_t*)(ws + WS_LIN); float* KNORM = (float*)(ws + WS_KNORM);
    bf16_t* QR = (bf16_t*)(ws + WS_QR); bf16_t* KR = (bf16_t*)(ws + WS_KR);
    const float* rc = (const float*)(ws + WS_ROT); const float* rs = rc + SEQ * 32;
    for (int t = c.vcu; t < M; t += c.G) {
        const int pos = t & (SEQ - 1);
        const bf16_t* cur = PROJ + (size_t)t * PC;
        for (int ch = c.tid; ch < 824; ch += 512) {
            const u32x4 cv = *(const u32x4*)(cur + 8 * ch); u32x4 pv = (u32x4){0u, 0u, 0u, 0u}; if (pos > 0) pv = *(const u32x4*)(cur - PC + 8 * ch);
            const f32x4 m0 = *(const f32x4*)(mix + 8 * ch), m1 = *(const f32x4*)(mix + 8 * ch + 4);
            float z[8];
            { const unsigned cw[4] = {cv.x, cv.y, cv.z, cv.w}, pw[4] = {pv.x, pv.y, pv.z, pv.w};
              const float mm[8] = {m0[0], m0[1], m0[2], m0[3], m1[0], m1[1], m1[2], m1[3]};
#pragma unroll
              for (int j = 0; j < 4; ++j) { const float c0 = bf2f(cw[j] & 0xffffu), c1 = bf2f(cw[j] >> 16), q0 = bf2f(pw[j] & 0xffffu), q1 = bf2f(pw[j] >> 16);
                  z[2 * j] = c0 + (q0 - c0) * mm[2 * j]; z[2 * j + 1] = c1 + (q1 - c1) * mm[2 * j + 1]; } }
            if (ch < 768) {
                bf16_t* dst = (ch < 256 ? RZ : (ch < 512 ? KZ : VZ)) + (size_t)t * D + 8 * (ch & 255);
                { u32x4 w8; w8.x = pk2(z[0], z[1]); w8.y = pk2(z[2], z[3]); w8.z = pk2(z[4], z[5]); w8.w = pk2(z[6], z[7]); *(u32x4*)dst = w8; }
                if (ch >= 256 && ch < 512) {
                    const int col = 8 * (ch - 256); const f32x4 k0 = *(const f32x4*)(k_k + col), k1 = *(const f32x4*)(k_k + col + 4);
                    float s = 0.f;
#pragma unroll
                    for (int j = 0; j < 4; ++j) { const float a = z[j] * k0[j], b = z[4 + j] * k1[j]; s += a * a + b * b; }
                    s += __shfl_xor(s, 1); s += __shfl_xor(s, 2); s += __shfl_xor(s, 4);
                    if ((ch & 7) == 0) KNORM[(size_t)t * 32 + ((ch - 256) >> 3)] = sqrtf(s);
                }
            } else {
                float o[8]; int dcol;
                if (ch < 780) { dcol = 8 * (ch - 768);
#pragma unroll
                    for (int j = 0; j < 8; ++j) o[j] = tanhf(z[j]); }
                else if (ch < 792) { dcol = 256 + 8 * (ch - 780);
#pragma unroll
                    for (int j = 0; j < 8; ++j) o[j] = z[j]; }
                else { dcol = 512 + 8 * (ch - 792);
#pragma unroll
                    for (int j = 0; j < 8; ++j) o[j] = sigmoidf_(z[j]); }
                u32x4 w; w.x = pk2(o[0], o[1]); w.y = pk2(o[2], o[3]); w.z = pk2(o[4], o[5]); w.w = pk2(o[6], o[7]);
                *(u32x4*)(LIN + (size_t)t * 768 + dcol) = w;
            }
        }
        if (c.tid < 40) { const int dcol = (c.tid < 20) ? 96 + 8 * c.tid : 352 + 8 * (c.tid - 20); *(u32x4*)(LIN + (size_t)t * 768 + dcol) = (u32x4){0u, 0u, 0u, 0u}; }
        if (c.tid >= 64 && c.tid < 64 + 192) { const int w = c.tid - 64, which = w / 96, hh = (w % 96) >> 2, e0 = (w & 3) * 8;
            const bf16_t* src = cur + ATT0 + which * 1536 + hh * 64 + e0;
            const u32x4 a = *(const u32x4*)src, b = *(const u32x4*)(src + 32);
            const f32x4 c0 = *(const f32x4*)(rc + pos * 32 + e0), c1 = *(const f32x4*)(rc + pos * 32 + e0 + 4), s0 = *(const f32x4*)(rs + pos * 32 + e0), s1 = *(const f32x4*)(rs + pos * 32 + e0 + 4);
            const unsigned aw[4] = {a.x, a.y, a.z, a.w}, bw[4] = {b.x, b.y, b.z, b.w}; float o1[8], o2[8];
#pragma unroll
            for (int j = 0; j < 8; ++j) { const float t1 = bf2f((aw[j >> 1] >> (16 * (j & 1))) & 0xffffu), t2 = bf2f((bw[j >> 1] >> (16 * (j & 1))) & 0xffffu);
                const float cs = j < 4 ? c0[j & 3] : c1[j & 3], sn = j < 4 ? s0[j & 3] : s1[j & 3]; o1[j] = t1 * cs - t2 * sn; o2[j] = t2 * cs + t1 * sn; }
            bf16_t* dst = (which ? KR : QR) + (size_t)t * 1536 + hh * 64 + e0;
            u32x4 w1; w1.x = pk2(o1[0], o1[1]); w1.y = pk2(o1[2], o1[3]); w1.z = pk2(o1[4], o1[5]); w1.w = pk2(o1[6], o1[7]);
            u32x4 w2; w2.x = pk2(o2[0], o2[1]); w2.y = pk2(o2[2], o2[3]); w2.z = pk2(o2[4], o2[5]); w2.w = pk2(o2[6], o2[7]);
            *(u32x4*)dst = w1; *(u32x4*)(dst + 32) = w2; }
    }
}

#define DPP_ADD(x, ctrl) ((x) + __builtin_bit_cast(float, __builtin_amdgcn_update_dpp(0, __builtin_bit_cast(int, (x)), (ctrl), 0xF, 0xF, true)))
__device__ __forceinline__ float wave_sum_dpp(float x) {
    x = DPP_ADD(x, 0xB1); x = DPP_ADD(x, 0x4E); x = DPP_ADD(x, 0x141); x = DPP_ADD(x, 0x140);
    const int xi = __builtin_bit_cast(int, x);
    return (__builtin_bit_cast(float, __builtin_amdgcn_readlane(xi, 0)) + __builtin_bit_cast(float, __builtin_amdgcn_readlane(xi, 16))) +
           (__builtin_bit_cast(float, __builtin_amdgcn_readlane(xi, 32)) + __builtin_bit_cast(float, __builtin_amdgcn_readlane(xi, 48)));
}
__device__ __forceinline__ f32x4 tile_mm(const LAS bf16_t* A, int pa, const LAS bf16_t* Bt, int pb, int ks, int fr, int fq, f32x4 acc) {
    for (int k = 0; k < ks; ++k) { const bf16x8 a = *(const LAS bf16x8*)(A + fr * pa + 32 * k + 8 * fq), b = *(const LAS bf16x8*)(Bt + fr * pb + 32 * k + 8 * fq);
        acc = __builtin_amdgcn_mfma_f32_16x16x32_bf16(a, b, acc, 0, 0, 0); }
    return acc;
}
__device__ __forceinline__ u32x2 pack4(f32x4 v) { u32x2 w; w.x = pk2(v[0], v[1]); w.y = pk2(v[2], v[3]); return w; }
constexpr int SC_C = 32, SC_NCH = SEQ / SC_C, SC_F = 96;
constexpr int PL_X1 = 0, PL_X2 = 9216, PL_AL = 18432, PL_HT = 26112, PL_ET = 33792, PL_LBT = 53760, PL_TT = 58368, PL_GI = 60928, PL_RAW = 68608, PL_TF = 109568, PL_XB = 114176, PL_END = 115264;
#define LBAR() do { asm volatile("s_waitcnt lgkmcnt(0)" ::: "memory"); __builtin_amdgcn_s_barrier(); asm volatile("" ::: "memory"); } while (0)
__device__ __forceinline__ void p4_pre(const Params& p, const Ctx& c) {
    unsigned char* ws = c.ws;
    const bf16_t* RZ = (const bf16_t*)(ws + WS_RZ); const float* DEC = (const float*)(ws + WS_DEC); const bf16_t* KP = (const bf16_t*)(ws + WS_KP);
    const bf16_t* AN = (const bf16_t*)(ws + WS_AN); const bf16_t* BB = (const bf16_t*)(ws + WS_BB);
    bf16_t* FG = (bf16_t*)(ws + WS_F); float* BON = (float*)(ws + WS_YS);
    const float* rkp = p.in[I_RK];
    LAS bf16_t* X1 = (LAS bf16_t*)(c.lds + PL_X1); LAS bf16_t* X2 = (LAS bf16_t*)(c.lds + PL_X2); LAS bf16_t* AL = (LAS bf16_t*)(c.lds + PL_AL); LAS bf16_t* HT = (LAS bf16_t*)(c.lds + PL_HT);
    LAS bf16_t* ET = (LAS bf16_t*)(c.lds + PL_ET); LAS float* LBT = (LAS float*)(c.lds + PL_LBT); LAS bf16_t* TT = (LAS bf16_t*)(c.lds + PL_TT); LAS bf16_t* GI = (LAS bf16_t*)(c.lds + PL_GI);
    LAS float* RAW = (LAS float*)(c.lds + PL_RAW);
    LAS float* TF = (LAS float*)(c.lds + PL_TF);
    LAS float* XB = (LAS float*)(c.lds + PL_XB);
    int tid_ = c.tid; asm volatile("" : "+v"(tid_));
    const int tid = tid_, lane = tid & 63, w = __builtin_amdgcn_readfirstlane(tid >> 6), fr = lane & 15, fq = lane >> 4;
    const int ls = tid >> 4, lc4 = 4 * (tid & 15);
    f32x4 pfd; u32x2 pfb[4];
#define PRE_LOAD(TASK) do { const int bh_ = (TASK) >> 7, ch_ = (TASK) & (SC_NCH - 1); const size_t o_ = ((size_t)(bh_ >> 5) * SEQ + (size_t)ch_ * SC_C + ls) * D + (bh_ & 31) * 64 + lc4; \
        pfb[0] = *(const u32x2*)(RZ + o_); pfd = *(const f32x4*)(DEC + o_); pfb[1] = *(const u32x2*)(KP + o_); pfb[2] = *(const u32x2*)(AN + o_); pfb[3] = *(const u32x2*)(BB + o_); } while (0)
#define PRE_UNPK(w_) ((f32x4){bf2f((w_).x & 0xffffu), bf2f((w_).x >> 16), bf2f((w_).y & 0xffffu), bf2f((w_).y >> 16)})
    if (c.vcu < 128 * SC_NCH) PRE_LOAD(c.vcu);
    const bool bgconv = (c.G == 256);
    LAS float* cscr = (LAS float*)(c.lds + w * 8448);
    int tix = 0;
    for (int task = c.vcu; task < 128 * SC_NCH; task += c.G, ++tix) {
        *(LAS f32x4*)(RAW + (0 * 32 + ls) * 64 + lc4) = PRE_UNPK(pfb[0]); *(LAS f32x4*)(RAW + (1 * 32 + ls) * 64 + lc4) = pfd; *(LAS f32x4*)(RAW + (2 * 32 + ls) * 64 + lc4) = PRE_UNPK(pfb[1]);
        *(LAS f32x4*)(RAW + (3 * 32 + ls) * 64 + lc4) = PRE_UNPK(pfb[2]); *(LAS f32x4*)(RAW + (4 * 32 + ls) * 64 + lc4) = PRE_UNPK(pfb[3]);
        const int bh = task >> 7, chn = task & (SC_NCH - 1); const float rkv = rkp[(bh & 31) * 64 + lane];
        float* bon = BON + ((size_t)(bh >> 5) * SEQ + (size_t)chn * SC_C) * 32 + (bh & 31);
        if (task + c.G < 128 * SC_NCH) PRE_LOAD(task + c.G);
        float cv[32]; int ce = 0, cn0 = 0, ck0 = 0;
        if (bgconv) { const int item = (c.vcu * 64 + tix) * 8 + w; ce = item >> 12; const int rem = item & 4095; ck0 = 64 * (rem >> 7); cn0 = 32 * (rem & 127);
            tr_issue(p.in[I_W1] + (size_t)ce * D * 4096, 4096, cn0, ck0, lane, cv); }
        LBAR();
        *(LAS u32x4*)(ET + (32 + (tid >> 3)) * 104 + 8 * (tid & 7)) = (u32x4){0u, 0u, 0u, 0u};
        float g = 1.f, gprev[4], gcur[4];
#pragma unroll
        for (int s = 0; s < SC_C; ++s) { const float wv = RAW[(32 + s) * 64 + lane]; if ((s >> 2) == w) gprev[s & 3] = g; g *= wv; if ((s >> 2) == w) gcur[s & 3] = g; }
        const float gC = g;
        f32x4 ah4, bg4, kg4;
#pragma unroll
        for (int qn = 0; qn < 4; ++qn) { const int s = 4 * w + qn;
            const float rr = RAW[(0 + s) * 64 + lane], kk = RAW[(64 + s) * 64 + lane], aa = RAW[(96 + s) * 64 + lane], bb = RAW[(128 + s) * 64 + lane]; const float ig = 1.0f / gcur[qn];
            const float ah = aa * gprev[qn], bt = bb * ig, kt = kk * ig, rh = rr * gcur[qn];
            X1[s * 72 + lane] = (bf16_t)f2bf(bt); X1[(32 + s) * 72 + lane] = (bf16_t)f2bf(kt); X2[s * 72 + lane] = (bf16_t)f2bf(ah); X2[(32 + s) * 72 + lane] = (bf16_t)f2bf(rh);
            ET[s * 104 + lane] = (bf16_t)f2bf(rh); ah4[qn] = ah; bg4[qn] = bt * gC; kg4[qn] = kt * gC;
            const float bsum = wave_sum_dpp(rr * kk * rkv); if (lane == 0) bon[(size_t)s * 32] = bsum; }
        *(LAS u32x2*)(AL + lane * 40 + 4 * w) = pack4(ah4); *(LAS u32x2*)(HT + (32 + lane) * 40 + 4 * w) = pack4(bg4); *(LAS u32x2*)(ET + (32 + lane) * 104 + 64 + 4 * w) = pack4(kg4);
        LBAR();
        if (w == 0) ET[(32 + lane) * 104 + lane] = (bf16_t)f2bf(gC);
        { const int mt = w >> 1;
#pragma unroll
          for (int u = 0; u < 2; ++u) { const int nt = 2 * (w & 1) + u;
            f32x4 acc = tile_mm(X1 + 16 * mt * 72, 72, X2 + 16 * nt * 72, 72, 2, fr, fq, (f32x4){0.f, 0.f, 0.f, 0.f});
            const int n = 16 * nt + fr, m0 = 16 * mt + 4 * fq;
            if (mt < 2) { if (nt < 2) { const int t = n; f32x4 o;
#pragma unroll
                    for (int e = 0; e < 4; ++e) o[e] = (m0 + e < t) ? acc[e] : 0.f;
                    *(LAS f32x4*)(LBT + t * 36 + m0) = o; }
                else { const int t = n - 32; f32x4 o;
#pragma unroll
                    for (int e = 0; e < 4; ++e) o[e] = (m0 + e <= t) ? acc[e] : 0.f;
                    *(LAS u32x2*)(HT + t * 40 + m0) = pack4(o); } }
            else { const int s0 = m0 - 32;
                if (nt < 2) { const int t = n;
#pragma unroll
                    for (int e = 0; e < 4; ++e) AL[(64 + s0 + e) * 40 + t] = (bf16_t)f2bf((s0 + e < t) ? acc[e] : 0.f); }
                else { const int t = n - 32; f32x4 o;
#pragma unroll
                    for (int e = 0; e < 4; ++e) o[e] = (s0 + e <= t) ? acc[e] : 0.f;
                    *(LAS u32x2*)(ET + t * 104 + 64 + s0) = pack4(o); } } } }
        LBAR();
        if (tid < 32) { const int hb = 16 * (tid >> 4), sl = tid & 15; float Tr[16];
#pragma unroll
            for (int t = 0; t < 16; ++t) { float a0 = (sl == t) ? 1.f : 0.f, a1 = 0.f, a2 = 0.f, a3 = 0.f;
#pragma unroll
                for (int m4 = 0; m4 < (t + 3) / 4; ++m4) { const f32x4 l = *(const LAS f32x4*)(LBT + (hb + t) * 36 + hb + 4 * m4);
                    if (4 * m4 + 0 < t) a0 += Tr[4 * m4 + 0] * l[0]; if (4 * m4 + 1 < t) a1 += Tr[4 * m4 + 1] * l[1]; if (4 * m4 + 2 < t) a2 += Tr[4 * m4 + 2] * l[2]; if (4 * m4 + 3 < t) a3 += Tr[4 * m4 + 3] * l[3]; }
                Tr[t] = (a0 + a1) + (a2 + a3); TF[(hb + sl) * 36 + hb + t] = Tr[t]; TT[(hb + t) * 40 + hb + sl] = (bf16_t)f2bf(Tr[t]);
                if (hb) TT[t * 40 + hb + sl] = 0; } }
        LBAR();
        if (tid < 256) { const int m = tid >> 4, tl = tid & 15; float x = 0.f;
#pragma unroll
            for (int n = 0; n < 16; ++n) x += LBT[(16 + n) * 36 + m] * TF[(16 + n) * 36 + 16 + tl];
            XB[m * 17 + tl] = x; }
        LBAR();
        if (tid < 256) { const int sr = tid >> 4, tl = tid & 15; float x = 0.f;
#pragma unroll
            for (int m = 0; m < 16; ++m) x += TF[sr * 36 + m] * XB[m * 17 + tl];
            TT[(16 + tl) * 40 + sr] = (bf16_t)f2bf(x); }
        LBAR();
        for (int id = w; id < 12; id += 8) { const int tt = id / 6, nt = id % 6;
            const f32x4 acc = tile_mm(TT + 16 * tt * 40, 40, AL + 16 * nt * 40, 40, 1, fr, fq, (f32x4){0.f, 0.f, 0.f, 0.f});
            *(LAS u32x2*)(GI + (16 * nt + fr) * 40 + 16 * tt + 4 * fq) = pack4(acc); }
        LBAR();
        for (int id = w; id < 36; id += 8) { const int nt = id / 6, mt = id % 6;
            const f32x4 acc = tile_mm(GI + 16 * nt * 40, 40, HT + 16 * mt * 40, 40, 1, fr, fq, (f32x4){0.f, 0.f, 0.f, 0.f});
            LAS u32x2* ep = (LAS u32x2*)(ET + (16 * mt + fr) * 104 + 16 * nt + 4 * fq); const u32x2 ev = *ep;
            f32x4 o; o[0] = acc[0] + bf2f(ev.x & 0xffffu); o[1] = acc[1] + bf2f(ev.x >> 16); o[2] = acc[2] + bf2f(ev.y & 0xffffu); o[3] = acc[3] + bf2f(ev.y >> 16);
            *ep = pack4(o); }
        LBAR();
        { bf16_t* fg = FG + (size_t)task * (SC_F * SC_F);
          for (int idx = tid; idx < 96 * 12; idx += 512) { const int row = idx / 12, pc = idx % 12; *(u32x4*)(fg + row * 96 + 8 * pc) = *(const LAS u32x4*)(ET + row * 104 + 8 * pc); } }
        LBAR();
        if (bgconv) tr_finish(cv, ws + WS_W1 + (size_t)ce * 4096 * D, D, cn0, ck0, cscr, lane);
    }
    if (!bgconv) {
        LBAR();
        for (int r = c.vcu * 8 + w; r < NEXP * MOE_W1E; r += c.G * 8) { const int e = r >> 12, rem = r & 4095; tr_item8(p.in[I_W1] + (size_t)e * D * 4096, 4096, ws + WS_W1 + (size_t)e * 4096 * D, D, 32 * (rem & 127), 64 * (rem >> 7), cscr, lane); }
    }
    LBAR();
#undef PRE_LOAD
#undef PRE_UNPK
}
constexpr int SQ_BI = 0, SQ_BI_SZ = 64 * 104 * 2, SQ_YL = 2 * SQ_BI_SZ, SQ_YL_SZ = 32 * 64 * 4;
struct SeqSet { bf16x8 af[3][3]; u32x2 vimg; float bon[4]; bf16_t g[4]; };
__device__ __forceinline__ void p4_seq(const Params& p, const Ctx& c, int bh) {
    unsigned char* ws = c.ws;
    const bf16_t* VZ = (const bf16_t*)(ws + WS_VZ); const bf16_t* GG = (const bf16_t*)(ws + WS_GG); const float* BON = (const float*)(ws + WS_YS);
    const bf16_t* FG = (const bf16_t*)(ws + WS_F) + (size_t)bh * SC_NCH * (SC_F * SC_F);
    bf16_t* YA = (bf16_t*)(ws + WS_YA);
    int tid_ = c.tid; asm volatile("" : "+v"(tid_));
    const int tid = tid_, lane = tid & 63, w = __builtin_amdgcn_readfirstlane(tid >> 6), fr = lane & 15, fq = lane >> 4;
    const int b = bh >> 5, h = bh & 31;
    const size_t base = (size_t)b * SEQ * D + h * 64;
    const int nt = w & 3, mg = w >> 2;
    const float lg = p.in[I_LNXG][h * 64 + lane], lb = p.in[I_LNXB][h * 64 + lane];
    LAS bf16_t* BI = (LAS bf16_t*)(c.lds + SQ_BI); LAS float* YL = (LAS float*)(c.lds + SQ_YL);
    const int vs = tid >> 4, vi4 = 4 * (tid & 15);
#define SEQ_LOAD(SET, CHN) do { const bf16_t* fp = FG + (size_t)(CHN) * (SC_F * SC_F); _Pragma("unroll") for (int mi = 0; mi < 3; ++mi) _Pragma("unroll") for (int ks = 0; ks < 3; ++ks) \
            SET.af[mi][ks] = *(const bf16x8*)(fp + (16 * (3 * mg + mi) + fr) * SC_F + 32 * ks + 8 * fq); \
        SET.vimg = *(const u32x2*)(VZ + base + (size_t)((CHN) * SC_C + vs) * D + vi4); \
        _Pragma("unroll") for (int e = 0; e < 4; ++e) { const size_t tk = (size_t)b * SEQ + (size_t)((CHN) * SC_C + 4 * w + e); SET.g[e] = GG[tk * D + h * 64 + lane]; SET.bon[e] = BON[tk * 32 + h]; } } while (0)
#define SEQ_BODY(CH, CUR, NXT, NX2) do { const int ch = (CH), cb = ch & 1; \
        const LAS bf16_t* bi = BI + cb * (64 * 104); LAS bf16_t* bo = BI + (cb ^ 1) * (64 * 104); LAS float* yl = YL + cb * (32 * 64); \
        if (ch + 2 < SC_NCH) SEQ_LOAD(NX2, ch + 2); \
        bf16x8 bfr[3]; _Pragma("unroll") for (int ks = 0; ks < 3; ++ks) bfr[ks] = *(const LAS bf16x8*)(bi + (16 * nt + fr) * 104 + 32 * ks + 8 * fq); \
        f32x4 acc[3]; _Pragma("unroll") for (int mi = 0; mi < 3; ++mi) { acc[mi] = (f32x4){0.f, 0.f, 0.f, 0.f}; \
            _Pragma("unroll") for (int ks = 0; ks < 3; ++ks) acc[mi] = __builtin_amdgcn_mfma_f32_16x16x32_bf16(CUR.af[mi][ks], bfr[ks], acc[mi], 0, 0, 0); } \
        _Pragma("unroll") for (int mi = 0; mi < 3; ++mi) { const int mt = 3 * mg + mi; \
            if (mt < 2) { _Pragma("unroll") for (int e = 0; e < 4; ++e) yl[(16 * mt + 4 * fq + e) * 64 + 16 * nt + fr] = acc[mi][e]; } \
            else *(LAS u32x2*)(bo + (16 * nt + fr) * 104 + 16 * (mt - 2) + 4 * fq) = pack4(acc[mi]); } \
        if (ch + 1 < SC_NCH) { bo[(vi4 + 0) * 104 + 64 + vs] = (bf16_t)(NXT.vimg.x & 0xffffu); bo[(vi4 + 1) * 104 + 64 + vs] = (bf16_t)(NXT.vimg.x >> 16); \
            bo[(vi4 + 2) * 104 + 64 + vs] = (bf16_t)(NXT.vimg.y & 0xffffu); bo[(vi4 + 3) * 104 + 64 + vs] = (bf16_t)(NXT.vimg.y >> 16); } \
        LBAR(); \
        _Pragma("unroll") for (int e = 0; e < 4; ++e) { const int s = 4 * w + e; const float y = yl[s * 64 + lane]; \
            const float mu = wave_sum_dpp(y) * (1.0f / 64.0f); const float dl = y - mu; const float var = wave_sum_dpp(dl * dl) * (1.0f / 64.0f); \
            const float yn = dl * rsqrtf(var + GN_EPS) * lg + lb; const float bonus = CUR.bon[e] * bf2f(bi[lane * 104 + 64 + s]); \
            YA[base + (size_t)(ch * SC_C + s) * D + lane] = (bf16_t)f2bf((yn + bonus) * bf2f(CUR.g[e])); } } while (0)
    SeqSet sa, sb, sc;
    SEQ_LOAD(sa, 0); SEQ_LOAD(sb, 1);
    for (int idx = tid; idx < 64 * 8; idx += 512) *(LAS u32x4*)(BI + (idx >> 3) * 104 + 8 * (idx & 7)) = (u32x4){0u, 0u, 0u, 0u};
    BI[(vi4 + 0) * 104 + 64 + vs] = (bf16_t)(sa.vimg.x & 0xffffu); BI[(vi4 + 1) * 104 + 64 + vs] = (bf16_t)(sa.vimg.x >> 16);
    BI[(vi4 + 2) * 104 + 64 + vs] = (bf16_t)(sa.vimg.y & 0xffffu); BI[(vi4 + 3) * 104 + 64 + vs] = (bf16_t)(sa.vimg.y >> 16);
    LBAR();
    for (int c0 = 0; c0 < SC_NCH; c0 += 3) {
        SEQ_BODY(c0, sa, sb, sc);
        if (c0 + 1 < SC_NCH) SEQ_BODY(c0 + 1, sb, sc, sa);
        if (c0 + 2 < SC_NCH) SEQ_BODY(c0 + 2, sc, sa, sb);
    }
    LBAR();
#undef SEQ_LOAD
#undef SEQ_BODY
}

__device__ __forceinline__ void p4_attn_task(const Ctx& c, int task) {
    unsigned char* ws = c.ws;
    const bf16_t* QR = (const bf16_t*)(ws + WS_QR); const bf16_t* KR = (const bf16_t*)(ws + WS_KR); const bf16_t* PROJ = (const bf16_t*)(ws + WS_PROJ);
    float* AO = (float*)(ws + WS_AO); float* LSE = (float*)(ws + WS_LSE);
    constexpr int VP = 280;
    LAS bf16_t* Vt = (LAS bf16_t*)c.lds;
    const int combo = task & 31, hh = (task >> 5) % 24, b = task / (32 * 24);
    const int g = hh >> 3, h = hh & 7;
    const int dil = g == 0 ? 1 : (g == 1 ? 4 : 16);
    const int res = combo % dil, blk = combo / dil;
    const int tid = c.tid, lane = c.lane, w = c.wave;
    __syncthreads();
    {
        const int ki = tid >> 1, dh = tid & 1; const int pk = (blk - 1) * 128 + ki;
        u32x4 v[4];
        if (pk >= 0) { const bf16_t* sp = PROJ + ((size_t)b * SEQ + (size_t)pk * dil + res) * PC + ATT0 + 2 * 1536 + hh * 64 + 32 * dh;
#pragma unroll
            for (int j = 0; j < 4; ++j) v[j] = *(const u32x4*)(sp + 8 * j); }
        else {
#pragma unroll
            for (int j = 0; j < 4; ++j) v[j] = (u32x4){0u, 0u, 0u, 0u}; }
#pragma unroll
        for (int j = 0; j < 4; ++j) { const unsigned wv[4] = {v[j].x, v[j].y, v[j].z, v[j].w};
#pragma unroll
            for (int e = 0; e < 8; ++e) Vt[(32 * dh + 8 * j + e) * VP + ki] = (bf16_t)((wv[e >> 1] >> (16 * (e & 1))) & 0xffffu); }
        if (tid < 64) {
#pragma unroll
            for (int e = 0; e < 24; ++e) Vt[tid * VP + 256 + e] = 0; }
    }
    __syncthreads();
    const int qq = lane & 15, g4 = lane >> 4;
    const int r0 = 16 * w;
    const size_t qtok = (size_t)b * SEQ + (size_t)(blk * 128 + r0 + qq) * dil + res;
    bf16x8 qf[2];
#pragma unroll
    for (int ks = 0; ks < 2; ++ks) qf[ks] = *(const bf16x8*)(QR + qtok * 1536 + hh * 64 + 32 * ks + 8 * g4);
    f32x4 sc[10];
#pragma unroll
    for (int kt = 0; kt < 9; ++kt) {
        const int ki = 16 * (w + kt) + qq; const int pk = (blk - 1) * 128 + ki;
        f32x4 a = (f32x4){0.f, 0.f, 0.f, 0.f};
#pragma unroll
        for (int ks = 0; ks < 2; ++ks) { bf16x8 kf = (bf16x8){0, 0, 0, 0, 0, 0, 0, 0};
            if (pk >= 0) kf = *(const bf16x8*)(KR + ((size_t)b * SEQ + (size_t)pk * dil + res) * 1536 + hh * 64 + 32 * ks + 8 * g4);
            a = __builtin_amdgcn_mfma_f32_16x16x32_bf16(kf, qf[ks], a, 0, 0, 0); }
        sc[kt] = a;
    }
    const int r = r0 + qq;
    float mx = -3.0e38f;
#pragma unroll
    for (int kt = 0; kt < 9; ++kt)
#pragma unroll
        for (int j = 0; j < 4; ++j) { const int ki = 16 * (w + kt) + 4 * g4 + j; const bool ok = (ki >= r) && (ki <= r + 128) && (blk > 0 || ki >= 128);
            const float s = ok ? sc[kt][j] * 0.125f : -1.0e30f; sc[kt][j] = s; mx = fmaxf(mx, s); }
    mx = fmaxf(mx, __shfl_xor(mx, 16)); mx = fmaxf(mx, __shfl_xor(mx, 32));
    float den = 0.f;
#pragma unroll
    for (int kt = 0; kt < 9; ++kt)
#pragma unroll
        for (int j = 0; j < 4; ++j) { const float pexp = __expf(sc[kt][j] - mx); sc[kt][j] = pexp; den += pexp; }
    den += __shfl_xor(den, 16); den += __shfl_xor(den, 32);
    sc[9] = (f32x4){0.f, 0.f, 0.f, 0.f};
    f32x4 oacc[4];
#pragma unroll
    for (int dt = 0; dt < 4; ++dt) oacc[dt] = (f32x4){0.f, 0.f, 0.f, 0.f};
#pragma unroll
    for (int cidx = 0; cidx < 5; ++cidx) {
        const f32x4 p0 = sc[2 * cidx], p1 = sc[2 * cidx + 1];
        u32x4 pw; pw.x = pk2(p0[0], p0[1]); pw.y = pk2(p0[2], p0[3]); pw.z = pk2(p1[0], p1[1]); pw.w = pk2(p1[2], p1[3]);
        const bf16x8 pf = __builtin_bit_cast(bf16x8, pw);
        const int kbase = 16 * (w + 2 * cidx) + 4 * g4;
#pragma unroll
        for (int dt = 0; dt < 4; ++dt) { const LAS bf16_t* vp = Vt + (16 * dt + qq) * VP + kbase;
            const u32x2 lo = *(const LAS u32x2*)vp, hi = *(const LAS u32x2*)(vp + 16);
            u32x4 vw; vw.x = lo.x; vw.y = lo.y; vw.z = hi.x; vw.w = hi.y;
            oacc[dt] = __builtin_amdgcn_mfma_f32_16x16x32_bf16(__builtin_bit_cast(bf16x8, vw), pf, oacc[dt], 0, 0, 0); }
    }
    const float inv = 1.0f / den;
    const size_t tok = qtok;
#pragma unroll
    for (int dt = 0; dt < 4; ++dt) *(f32x4*)(AO + ((size_t)g * M + tok) * 512 + h * 64 + 16 * dt + 4 * g4) = oacc[dt] * inv;
    if (g4 == 0) LSE[((size_t)g * M + tok) * 8 + h] = mx + __logf(den);
}

constexpr int Q_ATT = 3072, Q_TOTAL = Q_ATT + MOE_CONV_GROUPS;
__device__ __forceinline__ void p4_queue(const Params& p, const Ctx& c, volatile LAS unsigned* qslot) {
    unsigned* qc = (unsigned*)(c.ws + WS_CTL) + CW_Q;
    for (;;) {
        __syncthreads();
        if (c.tid == 0) qslot[0] = __hip_atomic_fetch_add(qc, 1u, __ATOMIC_RELAXED, __HIP_MEMORY_SCOPE_AGENT);
        __syncthreads();
        const unsigned it = qslot[0];
        if (it >= (unsigned)Q_TOTAL) break;
        if (it < (unsigned)Q_ATT) p4_attn_task(c, (int)it); else conv_group(p, c, (int)it - Q_ATT);
    }
}

__device__ __forceinline__ void p5_post(const Params& p, const Ctx& c) {
    unsigned char* ws = c.ws;
    const float* AO = (const float*)(ws + WS_AO); const float* LSE = (const float*)(ws + WS_LSE);
    bf16_t* YB = (bf16_t*)(ws + WS_YB);
    const int gw = c.vcu * 8 + c.wave, NGW = c.G * 8, lane = c.lane;
    for (int it = gw; it < M * 8; it += NGW) {
        const int t = it >> 3, h = it & 7;
        const float l0 = LSE[((size_t)0 * M + t) * 8 + h], l1 = LSE[((size_t)1 * M + t) * 8 + h], l2 = LSE[((size_t)2 * M + t) * 8 + h];
        const float mxl = fmaxf(l0, fmaxf(l1, l2)); const float e0 = __expf(l0 - mxl), e1 = __expf(l1 - mxl), e2 = __expf(l2 - mxl); const float inv = 1.0f / (e0 + e1 + e2);
        const size_t o = (size_t)t * 512 + h * 64 + lane;
        const float v = (e0 * AO[o] + e1 * AO[(size_t)M * 512 + o] + e2 * AO[(size_t)2 * M * 512 + o]) * inv;
        YB[o] = (bf16_t)f2bf(v);
    }
}

__device__ __forceinline__ void ln_rows(const Ctx& c, const float* in, const float* gam, const float* bet, float* outf, bf16_t* outb, unsigned char* outq = nullptr) {
    const int gw = c.vcu * 8 + c.wave, NGW = c.G * 8, lane = c.lane;
    for (int m = gw; m < M; m += NGW) {
        const f32x4* xr = (const f32x4*)(in + (size_t)m * D) + lane;
        f32x4 v[8]; float s = 0.f;
#pragma unroll
        for (int j = 0; j < 8; ++j) { v[j] = xr[64 * j]; s += (v[j][0] + v[j][1]) + (v[j][2] + v[j][3]); }
        const float mean = wave_sum(s) * (1.0f / D); float s2 = 0.f;
#pragma unroll
        for (int j = 0; j < 8; ++j) { v[j] = v[j] - mean; s2 += (v[j][0] * v[j][0] + v[j][1] * v[j][1]) + (v[j][2] * v[j][2] + v[j][3] * v[j][3]); }
        const float rstd = rsqrtf(wave_sum(s2) * (1.0f / D) + LN_EPS);
#pragma unroll
        for (int j = 0; j < 8; ++j) { const int col = 4 * lane + 256 * j; const f32x4 gv = *(const f32x4*)(gam + col), bv = *(const f32x4*)(bet + col);
            const f32x4 o = v[j] * rstd * gv + bv;
            *(f32x4*)(outf + (size_t)m * D + col) = o;
            if (outb) { u32x2 w; w.x = pk2(o[0], o[1]); w.y = pk2(o[2], o[3]); *(u32x2*)(outb + (size_t)m * D + col) = w; }
            if (outq) *(unsigned*)(outq + (size_t)m * D + col) = pk4_fp8(o[0], o[1], o[2], o[3]); }
    }
}

__device__ __forceinline__ void p15_router(const Params& p, const Ctx& c) {
    unsigned char* ws = c.ws;
    const float* X2 = (const float*)(ws + WS_X2); const float* RW = p.in[I_RW]; const float* RB = p.in[I_RB];
    unsigned* cnt = (unsigned*)(ws + WS_CTL) + CW_CNT; int* LIST = (int*)(ws + WS_LIST); int* ROWI = (int*)(ws + WS_ROWI); float* TOPW = (float*)(ws + WS_TOPW);
    LAS float* scr = (LAS float*)(c.lds + c.wave * 8192);
    const int gw = c.vcu * 8 + c.wave, NGW = c.G * 8, lane = c.lane, li = lane & 31, lk = lane >> 5;
    for (int tb = gw; tb < M / 32; tb += NGW) {
        const int t0 = tb * 32;
        f32x16 acc;
#pragma unroll
        for (int j = 0; j < 16; ++j) acc[j] = 0.f;
        const float* xa = X2 + (size_t)(t0 + li) * D + 4 * lk;
        const float* wb = RW + (size_t)(4 * lk) * 32 + li;
        for (int kb = 0; kb < D / 8; ++kb) {
            const f32x4 a = *(const f32x4*)(xa + 8 * kb);
            const float b0 = wb[(size_t)(8 * kb + 0) * 32], b1 = wb[(size_t)(8 * kb + 1) * 32], b2 = wb[(size_t)(8 * kb + 2) * 32], b3 = wb[(size_t)(8 * kb + 3) * 32];
            acc = __builtin_amdgcn_mfma_f32_32x32x2f32(a[0], b0, acc, 0, 0, 0);
            acc = __builtin_amdgcn_mfma_f32_32x32x2f32(a[1], b1, acc, 0, 0, 0);
            acc = __builtin_amdgcn_mfma_f32_32x32x2f32(a[2], b2, acc, 0, 0, 0);
            acc = __builtin_amdgcn_mfma_f32_32x32x2f32(a[3], b3, acc, 0, 0, 0);
        }
        const float bias = RB[li];
#pragma unroll
        for (int rg = 0; rg < 16; ++rg) { const int row = (rg & 3) + 8 * (rg >> 2) + 4 * lk; scr[row * 33 + li] = acc[rg] + bias; }
        LDS_WAIT(); asm volatile("" ::: "memory");
        if (lane < 32) {
            float lv[32];
#pragma unroll
            for (int e = 0; e < 32; ++e) lv[e] = scr[lane * 33 + e];
            int id[4]; float tv[4];
#pragma unroll
            for (int k = 0; k < 4; ++k) { float best = -3.0e38f; int bi = 0;
#pragma unroll
                for (int e = 0; e < 32; ++e) { const bool tk = lv[e] > best; best = tk ? lv[e] : best; bi = tk ? e : bi; }
                id[k] = bi; tv[k] = best;
#pragma unroll
                for (int e = 0; e < 32; ++e) lv[e] = (e == bi) ? -3.0e38f : lv[e]; }
            const float e1 = __expf(tv[1] - tv[0]), e2 = __expf(tv[2] - tv[0]), e3 = __expf(tv[3] - tv[0]); const float inv = 1.0f / (1.0f + e1 + e2 + e3);
            const float wv[4] = {inv, e1 * inv, e2 * inv, e3 * inv};
            const int t = t0 + lane;
#pragma unroll
            for (int k = 0; k < 4; ++k) { const unsigned slot = __hip_atomic_fetch_add(cnt + id[k], 1u, __ATOMIC_RELAXED, __HIP_MEMORY_SCOPE_AGENT);
                LIST[(size_t)id[k] * CAP + slot] = t; ROWI[(size_t)t * 4 + k] = id[k] * CAP + (int)slot; TOPW[(size_t)t * 4 + k] = wv[k]; }
        }
        LDS_WAIT(); asm volatile("" ::: "memory");
    }
}

__device__ __forceinline__ void moe_table(const Ctx& c, LAS int* tab) {
    if (c.tid == 0) { unsigned* cnt = (unsigned*)(c.ws + WS_CTL) + CW_CNT; int ts = 0;
        for (int e = 0; e < NEXP; ++e) { const int n = (int)__hip_atomic_load(cnt + e, __ATOMIC_RELAXED, __HIP_MEMORY_SCOPE_AGENT); tab[e] = n; tab[32 + e] = ts; ts += (n + 255) >> 8; }
        tab[64] = ts; }
    __syncthreads();
}

__device__ __forceinline__ void p18_combine(const Params& p, const Ctx& c, const LAS int* tab) {
    unsigned char* ws = c.ws;
    const float* X2 = (const float*)(ws + WS_X2); const float* Y = (const float*)(ws + WS_Y); const int* ROWI = (const int*)(ws + WS_ROWI); const float* TOPW = (const float*)(ws + WS_TOPW);
    const float* gam = p.in[I_LN3G]; const float* bet = p.in[I_LN3B];
    const int gw = c.vcu * 8 + c.wave, NGW = c.G * 8, lane = c.lane;
    for (int m = gw; m < M; m += NGW) {
        f32x4 v[8];
        const f32x4* xr = (const f32x4*)(X2 + (size_t)m * D) + lane;
#pragma unroll
        for (int j = 0; j < 8; ++j) v[j] = xr[64 * j] * DN_ALPHA;
#pragma unroll
        for (int k = 0; k < 4; ++k) { const int ri = ROWI[(size_t)m * 4 + k]; const float gt = TOPW[(size_t)m * 4 + k]; const int e = ri >> 14, slot = ri & (CAP - 1);
            const f32x4* yr = (const f32x4*)(Y + ((size_t)tab[32 + e] * 256 + slot) * D) + lane;
#pragma unroll
            for (int j = 0; j < 8; ++j) v[j] = v[j] + yr[64 * j] * gt; }
        float s = 0.f;
#pragma unroll
        for (int j = 0; j < 8; ++j) s += (v[j][0] + v[j][1]) + (v[j][2] + v[j][3]);
        const float mean = wave_sum(s) * (1.0f / D); float s2 = 0.f;
#pragma unroll
        for (int j = 0; j < 8; ++j) { v[j] = v[j] - mean; s2 += (v[j][0] * v[j][0] + v[j][1] * v[j][1]) + (v[j][2] * v[j][2] + v[j][3] * v[j][3]); }
        const float rstd = rsqrtf(wave_sum(s2) * (1.0f / D) + LN_EPS);
#pragma unroll
        for (int j = 0; j < 8; ++j) { const int col = 4 * lane + 256 * j; const f32x4 gv = *(const f32x4*)(gam + col), bv = *(const f32x4*)(bet + col);
            *(f32x4*)(p.out + (size_t)m * D + col) = v[j] * rstd * gv + bv; }
    }
}

constexpr int NPHASE = 19;
__global__ void __launch_bounds__(512, 2) fwd(Params p) {
    extern __shared__ __attribute__((aligned(16))) unsigned char lds_raw[];
    LAS unsigned char* lds = (LAS unsigned char*)lds_raw;
    Ctx c; c.tid = threadIdx.x; c.lane = c.tid & 63; c.wave = __builtin_amdgcn_readfirstlane(c.tid >> 6); c.G = gridDim.x;
    { const int bx = blockIdx.x; c.vcu = (c.G % 8 == 0) ? (bx % 8) * (c.G / 8) + bx / 8 : bx; }
    c.lds = lds; c.ws = p.ws;
    unsigned char* ws = p.ws;
    volatile LAS unsigned* MISC = (volatile LAS unsigned*)(lds + MISC_OFF);
    LAS int* tab = (LAS int*)(lds + MISC_OFF + 1024);
    if (c.tid < 64) MISC[c.tid] = 0u;
    __syncthreads();
    unsigned* ctl = (unsigned*)(ws + WS_CTL);
    XcdBarrier bar; bar.bar = ctl + CW_BAR + p.li * XCD_BAR_WORDS; bar.x = 0; bar.st = MISC + 8;
    if (N_LAUNCH_MODE == 1) bar = xcd_barrier_post(ctl + CW_BAR + p.li * XCD_BAR_WORDS, MISC + 8);
    const int lo = p.ph_lo, hi = p.ph_hi, bx = blockIdx.x;
#ifndef PHMASK
#define PHMASK 0xFFFFFFFFu
#endif
#define IN(k) (((PHMASK >> (k)) & 1u) && lo <= (k) && (k) < hi)
#define SEAM(k) do { if (N_LAUNCH_MODE == 1 && IN((k) + 1)) xcd_barrier(bar); } while (0)

    if (IN(0)) { p0_prologue(p, c); SEAM(0); }

    if (IN(1)) {
        pg8::StaticOrder S; S.init(ws + WS_XB, ws + WS_WIN, M, PC, D, D, c.G, bx);
        pg8::EpiBf16 E{(bf16_t*)(ws + WS_PROJ), PC, 1.0f};
        pg8::gemm_phase<pg8::EpiBf16, pg8::StaticOrder>(lds, pg8::Gemm{D, D, D}, S, E);
        SEAM(1);
    }
    if (IN(2)) { p2_prep(p, c); SEAM(2); }

    if (IN(3)) {
#ifndef P3M
#define P3M 15
#endif
        if (P3M & 1) { pg8::StaticOrder S; S.init(ws + WS_LIN, ws + WS_WUP, M, D, 768, 256, c.G, bx);
          pg8::EpiDecay E{(float*)(ws + WS_DEC), p.in[I_W0]};
          pg8::gemm_phase<pg8::EpiDecay, pg8::StaticOrder>(lds, pg8::Gemm{256, 768, 256}, S, E); }
        if (P3M & 2) { pg8::StaticOrder S; S.init(ws + WS_LIN + 512, ws + WS_AUP, M, D, 768, 256, c.G, bx);
          pg8::EpiIclr E{p.in[I_A0], p.in[I_KK], p.in[I_KA], (const bf16_t*)(ws + WS_KZ), (const float*)(ws + WS_KNORM), (bf16_t*)(ws + WS_KP), (bf16_t*)(ws + WS_AN), (bf16_t*)(ws + WS_BB)};
          pg8::gemm_phase<pg8::EpiIclr, pg8::StaticOrder>(lds, pg8::Gemm{256, 768, 256}, S, E); }
        if (P3M & 4) { pg8::StaticOrder S; S.init(ws + WS_LIN + 1024, ws + WS_GUP, M, D, 768, 256, c.G, bx);
          pg8::EpiBf16 E{(bf16_t*)(ws + WS_GG), D, 1.0f};
          pg8::gemm_phase<pg8::EpiBf16, pg8::StaticOrder>(lds, pg8::Gemm{256, 768, 256}, S, E); }
        if (P3M & 8) { pg8::StaticOrder S; S.init(ws + WS_MEMB, ws + WS_WKV, 1024, 2 * D, D, D, c.G, bx);
          pg8::EpiKV E{(bf16_t*)(ws + WS_KB), (bf16_t*)(ws + WS_VT)};
          pg8::gemm_phase<pg8::EpiKV, pg8::StaticOrder>(lds, pg8::Gemm{D, D, D}, S, E); }
        SEAM(3);
    }
    if (IN(4)) {
        p4_pre(p, c);
        xcd_barrier(bar);
        for (int bh = c.vcu; bh < 128; bh += c.G) p4_seq(p, c, bh);
        p4_queue(p, c, MISC + 16);
        SEAM(4);
    }
    if (IN(5)) { p5_post(p, c); }

    if (IN(6)) {
        pg8::StaticOrder S; S.init(ws + WS_YA, ws + WS_PA, M, D, D, D, c.G, bx);
        pg8::EpiGateA E{(const bf16_t*)(ws + WS_PROJ), (float*)(ws + WS_TMP)};
        pg8::gemm_phase<pg8::EpiGateA, pg8::StaticOrder>(lds, pg8::Gemm{D, D, D}, S, E);
        SEAM(6);
    }
    if (IN(7)) {
        pg8::StaticOrder S; S.init(ws + WS_YB, ws + WS_PB, M, D, 512, 512, c.G, bx);
        pg8::EpiGateB E{(const bf16_t*)(ws + WS_PROJ), (const float*)(ws + WS_TMP), (bf16_t*)(ws + WS_MERGED)};
        pg8::gemm_phase<pg8::EpiGateB, pg8::StaticOrder>(lds, pg8::Gemm{512, 512, 512}, S, E);
        SEAM(7);
    }
    if (IN(8)) {
        pg8::StaticOrder S; S.init(ws + WS_MERGED, ws + WS_WOUT, M, D, D, D, c.G, bx);
        pg8::EpiF32 E{(float*)(ws + WS_T1), D, nullptr, 0, p.in[I_X], DN_ALPHA};
        pg8::gemm_phase<pg8::EpiF32, pg8::StaticOrder>(lds, pg8::Gemm{D, D, D}, S, E);
        SEAM(8);
    }
    if (IN(9)) { ln_rows(c, (const float*)(ws + WS_T1), p.in[I_LN1G], p.in[I_LN1B], (float*)(ws + WS_X1), (bf16_t*)(ws + WS_X1B)); SEAM(9); }

    if (IN(10)) {
        pg8::StaticOrder S; S.init(ws + WS_X1B, ws + WS_WQ, M, D, D, D, c.G, bx);
        pg8::EpiBf16 E{(bf16_t*)(ws + WS_Q), D, 0.04419417382415922f};
        pg8::gemm_phase<pg8::EpiBf16, pg8::StaticOrder>(lds, pg8::Gemm{D, D, D}, S, E);
        SEAM(10);
    }
    if (IN(11)) {
        ScoreOrder S{(const char*)(ws + WS_Q), (const char*)(ws + WS_KB), c.G, bx};
        pg8::EpiSoftmax E{(bf16_t*)(ws + WS_PP)};
        pg8::gemm_phase<pg8::EpiSoftmax, ScoreOrder, false>(lds, pg8::Gemm{512, D, D}, S, E);
        SEAM(11);
    }
    if (IN(12)) {
        PvOrder S{(const char*)(ws + WS_PP), (const char*)(ws + WS_VT), c.G, bx};
        pg8::EpiBf16 E{(bf16_t*)(ws + WS_OC), D, 1.0f};
        pg8::gemm_phase<pg8::EpiBf16, PvOrder>(lds, pg8::Gemm{256, 256, 256}, S, E);
        SEAM(12);
    }
    if (IN(13)) {
        pg8::StaticOrder S; S.init(ws + WS_OC, ws + WS_WO, M, D, D, D, c.G, bx);
        pg8::EpiF32 E{(float*)(ws + WS_T2), D, nullptr, 0, (const float*)(ws + WS_X1), DN_ALPHA};
        pg8::gemm_phase<pg8::EpiF32, pg8::StaticOrder>(lds, pg8::Gemm{D, D, D}, S, E);
        SEAM(13);
    }
    if (IN(14)) { ln_rows(c, (const float*)(ws + WS_T2), p.in[I_LN2G], p.in[I_LN2B], (float*)(ws + WS_X2), nullptr, ws + WS_X2B); SEAM(14); }
    if (IN(15)) { p15_router(p, c); SEAM(15); }

    if (IN(16)) {
        moe_table(c, tab);
        MoeOrder<true, 16> S{tab, (const char*)(ws + WS_X2B), (const char*)(ws + WS_W1), (const int*)(ws + WS_LIST), (size_t)4096 * D, D, c.G, bx};
        pg8::EpiSwiglu E{p.in[I_B1], (bf16_t*)(ws + WS_H)};
        pg8::gemm_phase<pg8::EpiSwiglu, MoeOrder<true, 16>, true, true>(lds, pg8::Gemm{D, D, D}, S, E);
        SEAM(16);
    }
    if (IN(17)) {
        moe_table(c, tab);
        MoeOrder<false, 8> S{tab, (const char*)(ws + WS_H), (const char*)(ws + WS_W2), (const int*)(ws + WS_LIST), (size_t)D * DFF, DFF, c.G, bx};
        pg8::EpiF32 E{(float*)(ws + WS_Y), D, p.in[I_B2], D, nullptr, 0.f};
        pg8::gemm_phase<pg8::EpiF32, MoeOrder<false, 8>, true, true>(lds, pg8::Gemm{DFF, DFF, DFF}, S, E);
        SEAM(17);
    }
    if (IN(18)) { moe_table(c, tab); p18_combine(p, c, tab); }
#undef IN
#undef SEAM
}

extern "C" void kernel_launch(void* const* d_in, const int* in_sizes, int n_in, void* d_out, int out_size, void* d_ws, size_t ws_size, hipStream_t stream) {
    static int grid = 0;
    if (grid == 0) {
        if (n_in != 32 || out_size != M * D || ws_size < WS_END) { fprintf(stderr, "kernel_launch: expected 32 inputs, %d outputs, >= %zu bytes of workspace; got %d, %d, %zu\n", M * D, (size_t)WS_END, n_in, out_size, ws_size); grid = -1; return; }
        int dev = 0, cus = 0, per_cu = 0;
        if (hipGetDevice(&dev) != hipSuccess || hipDeviceGetAttribute(&cus, hipDeviceAttributeMultiprocessorCount, dev) != hipSuccess) { grid = -1; return; }
        if (hipFuncSetAttribute((const void*)fwd, hipFuncAttributeMaxDynamicSharedMemorySize, LDS_BYTES) != hipSuccess) { fprintf(stderr, "kernel_launch: hipFuncSetAttribute failed\n"); grid = -1; return; }
        if (hipOccupancyMaxActiveBlocksPerMultiprocessor(&per_cu, (const void*)fwd, 512, LDS_BYTES) != hipSuccess || per_cu < 1) fprintf(stderr, "kernel_launch: occupancy query reports %d\n", per_cu);
        (void)hipGetLastError();
        grid = cus;
        if (grid != 256) fprintf(stderr, "kernel_launch: %d CUs; this kernel is built for 256\n", grid);
    }
    if (grid < 0) return;
    (void)hipMemsetAsync((char*)d_ws + WS_CTL, 0, CTL_ZERO_BYTES, stream);
    Params p{};
    for (int i = 0; i < 32; ++i) p.in[i] = (const float*)d_in[i];
    p.out = (float*)d_out; p.ws = (unsigned char*)d_ws;
#if defined(TIMING_REPEAT_LO)
    { const int cuts[4][2] = {{0, TIMING_REPEAT_HI}, {TIMING_REPEAT_LO, TIMING_REPEAT_HI}, {TIMING_REPEAT_HI, NPHASE}, {0, 0}};
      for (int li = 0; li < 3; ++li) { if (cuts[li][0] >= cuts[li][1]) continue; p.ph_lo = cuts[li][0]; p.ph_hi = cuts[li][1]; p.li = li; hipLaunchKernelGGL(fwd, dim3(grid), dim3(512), LDS_BYTES, stream, p); } }
#else
    if (N_LAUNCH_MODE == 1) { p.ph_lo = 0; p.ph_hi = NPHASE; hipLaunchKernelGGL(fwd, dim3(grid), dim3(512), LDS_BYTES, stream, p); }
    else for (int k = 0; k < NPHASE; ++k) { p.ph_lo = k; p.ph_hi = k + 1; hipLaunchKernelGGL(fwd, dim3(grid), dim3(512), LDS_BYTES, stream, p); }
#endif
}
```

```cpp
#include <hip/hip_runtime.h>
#include <cstdio>
#include <cstdint>

#define LAS __attribute__((address_space(3)))
#define GAS __attribute__((address_space(1)))
typedef unsigned short bf16_t;
typedef short bf16x8 __attribute__((ext_vector_type(8)));
typedef float f32x4 __attribute__((ext_vector_type(4)));
typedef float f32x2 __attribute__((ext_vector_type(2)));
typedef float f32x16 __attribute__((ext_vector_type(16)));
typedef unsigned u32x4 __attribute__((ext_vector_type(4)));
typedef unsigned u32x2 __attribute__((ext_vector_type(2)));

#ifndef N_LAUNCH_MODE
#define N_LAUNCH_MODE 1
#endif

constexpr int M = 16384, D = 2048, SEQ = 4096, NBATCH = 4;
constexpr int RWC = 6592;
constexpr int PC = 15360;
constexpr int ATT0 = 6656, GATE0 = 11264;
constexpr int NEXP = 32, DFF = 2048, CAP = 16384;
constexpr int HROWS = 65536 + 32 * 256;
constexpr float LN_EPS = 1e-5f, GN_EPS = 64e-5f;
constexpr float DN_ALPHA = 1.189207115002721f;

__device__ __forceinline__ float bf2f(unsigned v) { return __uint_as_float(v << 16); }
__device__ __forceinline__ unsigned f2bf(float f) { unsigned u = __float_as_uint(f); return (u + 0x7fffu + ((u >> 16) & 1u)) >> 16; }
__device__ __forceinline__ unsigned pk2(float lo, float hi) { return f2bf(lo) | (f2bf(hi) << 16); }
typedef int v4i __attribute__((ext_vector_type(4)));
typedef int v8i __attribute__((ext_vector_type(8)));
__device__ __forceinline__ unsigned pk4_fp8(float a, float b, float c, float d) { int r = __builtin_amdgcn_cvt_pk_fp8_f32(a, b, 0, false); r = __builtin_amdgcn_cvt_pk_fp8_f32(c, d, r, true); return (unsigned)r; }
__device__ __forceinline__ float sigmoidf_(float x) { return 1.0f / (1.0f + __expf(-x)); }
__device__ __forceinline__ float wave_sum(float v) {
#pragma unroll
    for (int o = 1; o < 64; o <<= 1) v += __shfl_xor(v, o);
    return v;
}
#define LDS_WAIT() asm volatile("s_waitcnt lgkmcnt(0)" ::: "memory")
#define VM_WAIT() asm volatile("s_waitcnt vmcnt(0)" ::: "memory")

namespace pg8 {
#define PG8_LAS __attribute__((address_space(3)))
constexpr int BM = 256, BK = 64, HALF = 128, HTB = HALF * BK * 2, STAGE_BYTES = 8 * HTB, NXCD = 8, WGM = 8;

__host__ __device__ __forceinline__ int lds_byte(int r, int c) { const int st = (r >> 4) * 2 + (c >> 5), rr = r & 15, cc = c & 31, ob = rr * 64 + cc * 2; return st * 1024 + (ob ^ (((ob >> 9) & 1) << 5)); }
__host__ __device__ __forceinline__ void stage_rc(int b, int& R, int& C) { const int st = b / 1024, sb = b % 1024, swz = sb ^ (((sb >> 9) & 1) << 5); R = (st >> 1) * 16 + swz / 64; C = (st & 1) * 32 + (swz % 64) / 2; }
__host__ __device__ __forceinline__ int perm32(int rho) { const int n = rho >> 4, i = rho & 15; return 8 * (i >> 2) + 4 * n + (i & 3); }

struct Unit { const char* A; const char* B; int orow, ocol, aux, aux2, valid; };
struct Gemm { int K, lda, ldb; };

struct StaticOrder {
    static constexpr bool GATHER = false;
    const char* A; const char* Bt; size_t ta, tb;
    int nM, nN, nwg, G, c;
    __device__ void init(const void* A_, const void* Bt_, int M_, int N_, int lda, int ldb, int G_, int c_) { A = (const char*)A_; Bt = (const char*)Bt_; ta = (size_t)BM * lda * 2; tb = (size_t)BM * ldb * 2; nM = M_ / BM; nN = N_ / BM; nwg = nM * nN; G = G_; c = c_; }
    __device__ bool next(int i, Unit& u) const {
        const long L = (long)i * G + c; if (c < 0 || L >= nwg) return false;
        int wgid = (int)L; { const int q = nwg / NXCD, r = nwg % NXCD, xcd = wgid % NXCD, off = wgid / NXCD; wgid = (xcd < r ? xcd * (q + 1) : r * (q + 1) + (xcd - r) * q) + off; }
        const int nig = WGM * nN, gid = wgid / nig, fm = gid * WGM, gsz = (nM - fm) < WGM ? (nM - fm) : WGM;
        const int pm = fm + ((wgid % nig) % gsz), pn = (wgid % nig) / gsz;
        u.A = A + (size_t)pm * ta; u.B = Bt + (size_t)pn * tb; u.orow = pm * BM; u.ocol = pn * BM; u.aux = 0; u.aux2 = 0; u.valid = BM; return true;
    }
    __device__ __forceinline__ const int* rows(const Unit&) const { return nullptr; }
};

__device__ __forceinline__ unsigned cvt_pk_bf16(float lo, float hi) { unsigned r; asm volatile("v_cvt_pk_bf16_f32 %0, %1, %2" : "=v"(r) : "v"(lo), "v"(hi)); return r; }

template <class Epi, class Sched, bool ALIGN_EPI = true, bool FP8 = false>
__device__ __forceinline__ void gemm_phase(PG8_LAS unsigned char* lds, const Gemm g, const Sched& S, const Epi& E) {
    const int tid = threadIdx.x, wid = __builtin_amdgcn_readfirstlane(tid >> 6), lane = tid & 63, wr = wid >> 2, wc = wid & 3, fr = lane & 15, fq = lane >> 4;
    constexpr int ES = FP8 ? 1 : 2;
    int sclW = 0, sclX = 0;
    if constexpr (FP8) { asm volatile("v_mov_b32 %0, 0x79797979\n\tv_mov_b32 %1, 0x7f7f7f7f" : "=v"(sclW), "=v"(sclX)); }
    const int K = g.K, nt = K * ES / (BK * 2);
    unsigned voffA[2], voffB[2]; int Rr[2], Cc[2];
#pragma unroll
    for (int i = 0; i < 2; ++i) { int R, C; stage_rc(tid * 16 + i * 8192, R, C); const int Rb = Epi::PERM ? ((R & ~31) + perm32(R & 31)) : R; Rr[i] = R; Cc[i] = C;
        voffA[i] = (unsigned)(R * g.lda * ES + C * 2); voffB[i] = (unsigned)(Rb * g.ldb * ES + C * 2); }
    const size_t kstep = (size_t)(BK * 2);
    const size_t hstepA = (size_t)HALF * g.lda * ES, hstepB = (size_t)HALF * g.ldb * ES;
    const unsigned ldsw = (unsigned)wid * 1024u;
    const int aoff = lds_byte(wr * 64 + fr, fq * 8), boff = lds_byte(wc * 32 + fr, fq * 8);
    unsigned vAc[2][2], vAn[2][2];
#define PG8_SA(b, h) (((b) * 2 + (h)) * HTB)
#define PG8_SB(b, h) ((4 + (b) * 2 + (h)) * HTB)
#define PG8_STAGE(bufoff, gbase, voff) do { _Pragma("unroll") for (int _i = 0; _i < 2; ++_i) \
        __builtin_amdgcn_global_load_lds((const unsigned*)((const char*)(gbase) + (voff)[_i]), (PG8_LAS unsigned*)(lds + (bufoff) + ldsw + _i * 8192), 16, 0, 0); } while (0)
#define PG8_STAGE_A(bufoff, kbase, h, nx) do { if constexpr (Sched::GATHER) { unsigned _v[2] = {(nx) ? vAn[h][0] : vAc[h][0], (nx) ? vAn[h][1] : vAc[h][1]}; PG8_STAGE(bufoff, kbase, _v); } \
        else { PG8_STAGE(bufoff, (kbase) + (h) * hstepA, voffA); } } while (0)
#define PG8_GOFF(u, v) do { const int* _rw = S.rows(u); _Pragma("unroll") for (int _h = 0; _h < 2; ++_h) _Pragma("unroll") for (int _i = 0; _i < 2; ++_i) { const int _r = Rr[_i] + _h * HALF; \
        const int _tk = _r < (u).valid ? _rw[_r] : 0; v[_h][_i] = (unsigned)(_tk * g.lda * ES + Cc[_i] * 2); } } while (0)
#define PG8_LDA(dst, b, h) do { _Pragma("unroll") for (int m = 0; m < 4; ++m) _Pragma("unroll") for (int k = 0; k < 2; ++k) dst[m][k] = *(const PG8_LAS bf16x8*)(lds + PG8_SA(b, h) + aoff + m * 2048 + k * 1024); } while (0)
#define PG8_LDB(dst, b, h) do { _Pragma("unroll") for (int n = 0; n < 2; ++n) _Pragma("unroll") for (int k = 0; k < 2; ++k) dst[n][k] = *(const PG8_LAS bf16x8*)(lds + PG8_SB(b, h) + boff + n * 2048 + k * 1024); } while (0)
#define PG8_MMA(ai, bj, At, Bt) do { __builtin_amdgcn_s_setprio(1); _Pragma("unroll") for (int m = 0; m < 4; ++m) _Pragma("unroll") for (int n = 0; n < 2; ++n) { \
        if constexpr (FP8) { const v4i _b0 = __builtin_bit_cast(v4i, Bt[n][0]), _b1 = __builtin_bit_cast(v4i, Bt[n][1]), _a0 = __builtin_bit_cast(v4i, At[m][0]), _a1 = __builtin_bit_cast(v4i, At[m][1]); \
            const v8i _bb = __builtin_shufflevector(_b0, _b1, 0, 1, 2, 3, 4, 5, 6, 7), _aa = __builtin_shufflevector(_a0, _a1, 0, 1, 2, 3, 4, 5, 6, 7); \
            asm volatile("v_mfma_scale_f32_16x16x128_f8f6f4 %0, %1, %2, %0, %3, %4 op_sel_hi:[0,0,0]" : "+v"(acc[ai][bj][m][n]) : "v"(_bb), "v"(_aa), "v"(sclW), "v"(sclX)); } \
        else { _Pragma("unroll") for (int k = 0; k < 2; ++k) acc[ai][bj][m][n] = __builtin_amdgcn_mfma_f32_16x16x32_bf16(Bt[n][k], At[m][k], acc[ai][bj][m][n], 0, 0, 0); } } \
        __builtin_amdgcn_s_setprio(0); } while (0)
#define PG8_WAIT_V(n) asm volatile("s_waitcnt vmcnt(" #n ")" ::: "memory")
#define PG8_WAIT_L(n) asm volatile("s_waitcnt lgkmcnt(" #n ")" ::: "memory")
#define PG8_BAR __builtin_amdgcn_s_barrier()
#define PG8_SCHED __builtin_amdgcn_sched_barrier(0)
    Unit cur, nxt; int ui = 0;
    if (!S.next(0, cur)) return;
    f32x4 acc[2][2][4][2];
#pragma unroll
    for (int a = 0; a < 2; ++a)
#pragma unroll
        for (int b = 0; b < 2; ++b)
#pragma unroll
            for (int m = 0; m < 4; ++m)
#pragma unroll
                for (int n = 0; n < 2; ++n) acc[a][b][m][n] = (f32x4){0.f, 0.f, 0.f, 0.f};
    bf16x8 At[4][2], B0[2][2], B1[2][2];
    const char* cA = cur.A; const char* cB = cur.B;
    if constexpr (Sched::GATHER) { PG8_GOFF(cur, vAc); PG8_WAIT_V(0); }
    PG8_STAGE(PG8_SB(0, 0), cB, voffB); PG8_STAGE(PG8_SB(0, 1), cB + hstepB, voffB); PG8_STAGE_A(PG8_SA(0, 0), cA, 0, false); PG8_STAGE_A(PG8_SA(0, 1), cA, 1, false);
    if (wr == 1) PG8_BAR;
    PG8_WAIT_V(2); PG8_BAR;
    PG8_STAGE(PG8_SB(1, 0), cB + kstep, voffB); PG8_STAGE_A(PG8_SA(1, 0), cA + kstep, 0, false); PG8_STAGE(PG8_SB(1, 1), cB + hstepB + kstep, voffB);
    PG8_WAIT_V(6); PG8_BAR;
    for (;;) {
        const bool has_next = S.next(ui + 1, nxt);
        const char* nA = has_next ? nxt.A : cA; const char* nB = has_next ? nxt.B : cB;
        if constexpr (Sched::GATHER) { if (has_next) { PG8_GOFF(nxt, vAn); } else {
#pragma unroll
            for (int h = 0; h < 2; ++h)
#pragma unroll
                for (int i = 0; i < 2; ++i) vAn[h][i] = vAc[h][i]; } }
#pragma nounroll
        for (int t = 0; t < nt; t += 2) {
            const bool last = (t == nt - 2);
            const char* a1 = cA + (size_t)(t + 1) * kstep;
            const char* a2 = last ? nA : cA + (size_t)(t + 2) * kstep; const char* b2 = last ? nB : cB + (size_t)(t + 2) * kstep;
            const char* a3 = a2 + kstep; const char* b3 = b2 + kstep;
            PG8_LDB(B0, 0, 0); PG8_LDB(B1, 0, 1); PG8_SCHED; PG8_LDA(At, 0, 0); PG8_STAGE_A(PG8_SA(1, 1), a1, 1, false);
            PG8_WAIT_V(8); PG8_WAIT_L(0); PG8_BAR; PG8_MMA(0, 0, At, B0); PG8_MMA(0, 1, At, B1); PG8_BAR; PG8_SCHED;
            PG8_LDA(At, 0, 1); PG8_STAGE(PG8_SB(0, 0), b2, voffB); PG8_STAGE(PG8_SB(0, 1), b2 + hstepB, voffB); PG8_STAGE_A(PG8_SA(0, 0), a2, 0, last);
            PG8_WAIT_V(8); PG8_WAIT_L(0); PG8_BAR; PG8_MMA(1, 0, At, B0); PG8_MMA(1, 1, At, B1); PG8_BAR; PG8_SCHED;
            PG8_LDB(B0, 1, 0); PG8_LDB(B1, 1, 1); PG8_SCHED; PG8_LDA(At, 1, 0); PG8_STAGE_A(PG8_SA(0, 1), a2, 1, last);
            PG8_WAIT_V(8); PG8_WAIT_L(0); PG8_BAR; PG8_MMA(0, 0, At, B0); PG8_MMA(0, 1, At, B1); PG8_BAR; PG8_SCHED;
            PG8_LDA(At, 1, 1); PG8_STAGE(PG8_SB(1, 0), b3, voffB); PG8_STAGE(PG8_SB(1, 1), b3 + hstepB, voffB); PG8_STAGE_A(PG8_SA(1, 0), a3, 0, last);
            PG8_WAIT_V(8); PG8_WAIT_L(0); PG8_BAR; PG8_MMA(1, 0, At, B0); PG8_MMA(1, 1, At, B1); PG8_BAR; PG8_SCHED;
        }
        if constexpr (ALIGN_EPI) { if (wr == 0) PG8_BAR; }
        if constexpr (FP8) asm volatile("s_nop 15\n\ts_nop 15" ::: "memory");
        if constexpr (!Epi::AFTER_DRAIN) { int l2 = lane; asm volatile("" : "+v"(l2));
            E(acc, cur, wr, wc, l2 & 15, l2 >> 4); }
        if (!has_next) break;
#pragma unroll
        for (int a = 0; a < 2; ++a)
#pragma unroll
            for (int b = 0; b < 2; ++b)
#pragma unroll
                for (int m = 0; m < 4; ++m)
#pragma unroll
                    for (int n = 0; n < 2; ++n) acc[a][b][m][n] = (f32x4){0.f, 0.f, 0.f, 0.f};
        cur = nxt; cA = nA; cB = nB; ++ui;
        if constexpr (Sched::GATHER) {
#pragma unroll
            for (int h = 0; h < 2; ++h)
#pragma unroll
                for (int i = 0; i < 2; ++i) vAc[h][i] = vAn[h][i]; }
        if constexpr (ALIGN_EPI) { if (wr == 1) PG8_BAR; }
    }
    PG8_WAIT_V(0);
    if constexpr (!ALIGN_EPI) { if (wr == 0) PG8_BAR; }
    PG8_BAR;
    if constexpr (Epi::AFTER_DRAIN) { E.fused(acc, cur, wr, wc, fr, fq, lds, wid, lane); }
#undef PG8_SA
#undef PG8_SB
#undef PG8_STAGE
#undef PG8_STAGE_A
#undef PG8_GOFF
#undef PG8_LDA
#undef PG8_LDB
#undef PG8_MMA
#undef PG8_WAIT_V
#undef PG8_WAIT_L
#undef PG8_BAR
#undef PG8_SCHED
}

#define EPI_LOOP_AI_M for (int ai = 0; ai < 2; ++ai) _Pragma("unroll") for (int m = 0; m < 4; ++m)

struct EpiF32 {
    static constexpr bool PERM = false, AFTER_DRAIN = false;
    float* C; int ldc; const float* bias; int bstride; const float* res; float alpha;
    __device__ __forceinline__ void operator()(const f32x4 (&acc)[2][2][4][2], const Unit& u, int wr, int wc, int fr, int fq) const {
        const int row0 = u.orow + wr * 64 + fr, col0 = u.ocol + wc * 32 + 4 * fq;
        f32x4 bv[2][2];
#pragma unroll
        for (int bj = 0; bj < 2; ++bj)
#pragma unroll
            for (int n = 0; n < 2; ++n) bv[bj][n] = bias ? *(const f32x4*)(bias + (size_t)u.aux * bstride + col0 + bj * HALF + n * 16) : (f32x4){0.f, 0.f, 0.f, 0.f};
#pragma unroll
        EPI_LOOP_AI_M { const size_t off = (size_t)(row0 + ai * HALF + m * 16) * ldc + col0;
#pragma unroll
            for (int bj = 0; bj < 2; ++bj)
#pragma unroll
                for (int n = 0; n < 2; ++n) { f32x4 v = acc[ai][bj][m][n] + bv[bj][n];
                    if (res) { const f32x4 rv = *(const f32x4*)(res + off + bj * HALF + n * 16); v = v + rv * alpha; }
                    *(f32x4*)(C + off + bj * HALF + n * 16) = v; }
            asm volatile("" ::: "memory"); }
    }
};
struct EpiBf16 {
    static constexpr bool PERM = true, AFTER_DRAIN = false;
    bf16_t* O; int ldc; float scale;
    __device__ __forceinline__ void operator()(const f32x4 (&acc)[2][2][4][2], const Unit& u, int wr, int wc, int fr, int fq) const {
        const int row0 = u.orow + wr * 64 + fr, col0 = u.ocol + wc * 32 + 8 * fq;
#pragma unroll
        EPI_LOOP_AI_M { bf16_t* rowp = O + (size_t)(row0 + ai * HALF + m * 16) * ldc + col0;
#pragma unroll
            for (int bj = 0; bj < 2; ++bj) { const f32x4 v0 = acc[ai][bj][m][0] * scale, v1 = acc[ai][bj][m][1] * scale;
                u32x4 w; w.x = cvt_pk_bf16(v0[0], v0[1]); w.y = cvt_pk_bf16(v0[2], v0[3]); w.z = cvt_pk_bf16(v1[0], v1[1]); w.w = cvt_pk_bf16(v1[2], v1[3]);
                *(u32x4*)(rowp + bj * HALF) = w; } }
    }
};
struct EpiKV {
    static constexpr bool PERM = true, AFTER_DRAIN = false;
    bf16_t* KB; bf16_t* VT;
    __device__ __forceinline__ void operator()(const f32x4 (&acc)[2][2][4][2], const Unit& u, int wr, int wc, int fr, int fq) const {
        const int row0 = u.orow + wr * 64 + fr, col0 = u.ocol + wc * 32 + 8 * fq;
#pragma unroll
        EPI_LOOP_AI_M { const int row = row0 + ai * HALF + m * 16;
#pragma unroll
            for (int bj = 0; bj < 2; ++bj) { const f32x4 v0 = acc[ai][bj][m][0], v1 = acc[ai][bj][m][1]; const int col = col0 + bj * HALF;
                if (u.ocol < 2048) { u32x4 w; w.x = cvt_pk_bf16(v0[0], v0[1]); w.y = cvt_pk_bf16(v0[2], v0[3]); w.z = cvt_pk_bf16(v1[0], v1[1]); w.w = cvt_pk_bf16(v1[2], v1[3]);
                    *(u32x4*)(KB + (size_t)row * 2048 + col) = w; }
                else { const int b = row >> 8, key = row & 255, c = col - 2048, h = c >> 9, d = c & 511; bf16_t* p = VT + ((size_t)((b * 4 + h) * 512 + d)) * 256 + key;
#pragma unroll
                    for (int j = 0; j < 4; ++j) { p[(size_t)j * 256] = (bf16_t)f2bf(v0[j]); p[(size_t)(4 + j) * 256] = (bf16_t)f2bf(v1[j]); } } } }
    }
};
struct EpiDecay {
    static constexpr bool PERM = false, AFTER_DRAIN = false;
    float* DEC; const float* w0;
    __device__ __forceinline__ void operator()(const f32x4 (&acc)[2][2][4][2], const Unit& u, int wr, int wc, int fr, int fq) const {
        const int row0 = u.orow + wr * 64 + fr, col0 = u.ocol + wc * 32 + 4 * fq;
        f32x4 bv[2][2];
#pragma unroll
        for (int bj = 0; bj < 2; ++bj)
#pragma unroll
            for (int n = 0; n < 2; ++n) bv[bj][n] = *(const f32x4*)(w0 + col0 + bj * HALF + n * 16);
#pragma unroll
        EPI_LOOP_AI_M { const size_t off = (size_t)(row0 + ai * HALF + m * 16) * D + col0;
#pragma unroll
            for (int bj = 0; bj < 2; ++bj)
#pragma unroll
                for (int n = 0; n < 2; ++n) { const f32x4 x = acc[ai][bj][m][n] + bv[bj][n]; f32x4 o;
#pragma unroll
                    for (int j = 0; j < 4; ++j) o[j] = __expf(-0.6065306597126334f * sigmoidf_(x[j]));
                    *(f32x4*)(DEC + off + bj * HALF + n * 16) = o; } }
    }
};
struct EpiIclr {
    static constexpr bool PERM = false, AFTER_DRAIN = false;
    const float* a0; const float* k_k; const float* k_a; const bf16_t* KZ; const float* KNORM; bf16_t* KP; bf16_t* AN; bf16_t* BB;
    __device__ __forceinline__ void operator()(const f32x4 (&acc)[2][2][4][2], const Unit& u, int wr, int wc, int fr, int fq) const {
        const int row0 = u.orow + wr * 64 + fr, col0 = u.ocol + wc * 32 + 4 * fq;
#pragma unroll
        for (int bj = 0; bj < 2; ++bj)
#pragma unroll
            for (int n = 0; n < 2; ++n) { const int col = col0 + bj * HALF + n * 16;
                const f32x4 a0v = *(const f32x4*)(a0 + col), kkv = *(const f32x4*)(k_k + col), kav = *(const f32x4*)(k_a + col);
#pragma unroll
                EPI_LOOP_AI_M { const int row = row0 + ai * HALF + m * 16; const size_t off = (size_t)row * D + col;
                    const u32x2 kzw = *(const u32x2*)(KZ + off); const f32x4 kz = (f32x4){bf2f(kzw.x & 0xffffu), bf2f(kzw.x >> 16), bf2f(kzw.y & 0xffffu), bf2f(kzw.y >> 16)};
                    const float nr = KNORM[(size_t)row * 32 + (col >> 6)]; const float inv = 1.0f / fmaxf(nr, 1e-12f);
                    const f32x4 x = acc[ai][bj][m][n] + a0v; f32x4 kp, an, bb;
#pragma unroll
                    for (int j = 0; j < 4; ++j) { const float a = sigmoidf_(x[j]); const float kk = kz[j] * kkv[j] * inv; kp[j] = kz[j] * (1.0f + (a - 1.0f) * kav[j]); bb[j] = kk * a; an[j] = -kk; }
                    *(u32x2*)(KP + off) = (u32x2){pk2(kp[0], kp[1]), pk2(kp[2], kp[3])}; *(u32x2*)(AN + off) = (u32x2){pk2(an[0], an[1]), pk2(an[2], an[3])}; *(u32x2*)(BB + off) = (u32x2){pk2(bb[0], bb[1]), pk2(bb[2], bb[3])}; }
                asm volatile("" ::: "memory"); }
    }
};
struct EpiGateA {
    static constexpr bool PERM = false, AFTER_DRAIN = false;
    const bf16_t* PROJ; float* TMP;
    __device__ __forceinline__ void operator()(const f32x4 (&acc)[2][2][4][2], const Unit& u, int wr, int wc, int fr, int fq) const {
        const int row0 = u.orow + wr * 64 + fr, col0 = u.ocol + wc * 32 + 4 * fq;
#pragma unroll
        EPI_LOOP_AI_M { const int row = row0 + ai * HALF + m * 16;
#pragma unroll
            for (int bj = 0; bj < 2; ++bj)
#pragma unroll
                for (int n = 0; n < 2; ++n) { const int col = col0 + bj * HALF + n * 16; const u32x2 gv = *(const u32x2*)(PROJ + (size_t)row * PC + GATE0 + col);
                    const f32x4 a = acc[ai][bj][m][n]; f32x4 o;
                    o[0] = a[0] * sigmoidf_(bf2f(gv.x & 0xffffu)); o[1] = a[1] * sigmoidf_(bf2f(gv.x >> 16)); o[2] = a[2] * sigmoidf_(bf2f(gv.y & 0xffffu)); o[3] = a[3] * sigmoidf_(bf2f(gv.y >> 16));
                    *(f32x4*)(TMP + (size_t)row * D + col) = o; } }
    }
};
struct EpiGateB {
    static constexpr bool PERM = true, AFTER_DRAIN = false;
    const bf16_t* PROJ; const float* TMP; bf16_t* MERGED;
    __device__ __forceinline__ void operator()(const f32x4 (&acc)[2][2][4][2], const Unit& u, int wr, int wc, int fr, int fq) const {
        const int row0 = u.orow + wr * 64 + fr, col0 = u.ocol + wc * 32 + 8 * fq;
#pragma unroll
        EPI_LOOP_AI_M { const int row = row0 + ai * HALF + m * 16;
#pragma unroll
            for (int bj = 0; bj < 2; ++bj) { const int col = col0 + bj * HALF; const u32x4 gv = *(const u32x4*)(PROJ + (size_t)row * PC + GATE0 + 2048 + col);
                const f32x4 t0 = *(const f32x4*)(TMP + (size_t)row * D + col), t1 = *(const f32x4*)(TMP + (size_t)row * D + col + 4);
                const f32x4 a0 = acc[ai][bj][m][0], a1 = acc[ai][bj][m][1]; f32x4 o0, o1;
                o0[0] = t0[0] + a0[0] * sigmoidf_(bf2f(gv.x & 0xffffu)); o0[1] = t0[1] + a0[1] * sigmoidf_(bf2f(gv.x >> 16)); o0[2] = t0[2] + a0[2] * sigmoidf_(bf2f(gv.y & 0xffffu)); o0[3] = t0[3] + a0[3] * sigmoidf_(bf2f(gv.y >> 16));
                o1[0] = t1[0] + a1[0] * sigmoidf_(bf2f(gv.z & 0xffffu)); o1[1] = t1[1] + a1[1] * sigmoidf_(bf2f(gv.z >> 16)); o1[2] = t1[2] + a1[2] * sigmoidf_(bf2f(gv.w & 0xffffu)); o1[3] = t1[3] + a1[3] * sigmoidf_(bf2f(gv.w >> 16));
                u32x4 w; w.x = cvt_pk_bf16(o0[0], o0[1]); w.y = cvt_pk_bf16(o0[2], o0[3]); w.z = cvt_pk_bf16(o1[0], o1[1]); w.w = cvt_pk_bf16(o1[2], o1[3]);
                *(u32x4*)(MERGED + (size_t)row * D + col) = w; }
            asm volatile("" ::: "memory"); }
    }
};
struct EpiSwiglu {
    static constexpr bool PERM = true, AFTER_DRAIN = false;
    const float* b1; bf16_t* H;
    __device__ __forceinline__ float sw(float g, float l) const { g = fminf(g, 7.0f); l = fminf(fmaxf(l, -7.0f), 7.0f); return g * sigmoidf_(1.702f * g) * (l + 1.0f); }
    __device__ __forceinline__ void operator()(const f32x4 (&acc)[2][2][4][2], const Unit& u, int wr, int wc, int fr, int fq) const {
        const int row0 = u.orow + wr * 64 + fr, col0 = u.ocol + wc * 32 + 8 * fq;
        f32x4 bv[2][2];
#pragma unroll
        for (int bj = 0; bj < 2; ++bj)
#pragma unroll
            for (int n = 0; n < 2; ++n) bv[bj][n] = *(const f32x4*)(b1 + (size_t)u.aux * 4096 + col0 + bj * HALF + 4 * n);
#pragma unroll
        EPI_LOOP_AI_M { const int row = row0 + ai * HALF + m * 16;
#pragma unroll
            for (int bj = 0; bj < 2; ++bj) { const f32x4 v0 = acc[ai][bj][m][0] + bv[bj][0], v1 = acc[ai][bj][m][1] + bv[bj][1];
                *(unsigned*)((unsigned char*)H + (size_t)row * DFF + ((col0 + bj * HALF) >> 1)) = pk4_fp8(sw(v0[0], v0[1]), sw(v0[2], v0[3]), sw(v1[0], v1[1]), sw(v1[2], v1[3])); } }
    }
};
struct EpiSoftmax {
    static constexpr bool PERM = true, AFTER_DRAIN = true;
    bf16_t* PP;
    __device__ __forceinline__ void fused(f32x4 (&acc)[2][2][4][2], const Unit& u, int wr, int wc, int fr, int fq, PG8_LAS unsigned char* lds, int wid, int lane) const {
        PG8_LAS float* P1 = (PG8_LAS float*)lds;
        PG8_LAS float* P2 = (PG8_LAS float*)(lds + 4096);
        float mx[2][4];
#pragma unroll
        EPI_LOOP_AI_M { float v = -3.0e38f;
#pragma unroll
            for (int bj = 0; bj < 2; ++bj)
#pragma unroll
                for (int n = 0; n < 2; ++n) { const f32x4 x = acc[ai][bj][m][n]; v = fmaxf(v, fmaxf(fmaxf(x[0], x[1]), fmaxf(x[2], x[3]))); }
            v = fmaxf(v, __shfl_xor(v, 16)); v = fmaxf(v, __shfl_xor(v, 32));
            if (fq == 0) P1[(ai * HALF + wr * 64 + m * 16 + fr) * 4 + wc] = v; }
        asm volatile("s_waitcnt lgkmcnt(0)" ::: "memory"); __builtin_amdgcn_s_barrier(); asm volatile("" ::: "memory");
#pragma unroll
        EPI_LOOP_AI_M { const f32x4 t = *(const PG8_LAS f32x4*)(P1 + (ai * HALF + wr * 64 + m * 16 + fr) * 4); mx[ai][m] = fmaxf(fmaxf(t[0], t[1]), fmaxf(t[2], t[3])); }
#pragma unroll
        EPI_LOOP_AI_M { float s = 0.f;
#pragma unroll
            for (int bj = 0; bj < 2; ++bj)
#pragma unroll
                for (int n = 0; n < 2; ++n) { f32x4 x = acc[ai][bj][m][n];
#pragma unroll
                    for (int j = 0; j < 4; ++j) { x[j] = __expf(x[j] - mx[ai][m]); s += x[j]; }
                    acc[ai][bj][m][n] = x; }
            s += __shfl_xor(s, 16); s += __shfl_xor(s, 32);
            if (fq == 0) P2[(ai * HALF + wr * 64 + m * 16 + fr) * 4 + wc] = s; }
        asm volatile("s_waitcnt lgkmcnt(0)" ::: "memory"); __builtin_amdgcn_s_barrier(); asm volatile("" ::: "memory");
        const int row0 = u.orow + wr * 64 + fr, col0 = wc * 32 + 8 * fq;
#pragma unroll
        EPI_LOOP_AI_M { const f32x4 t = *(const PG8_LAS f32x4*)(P2 + (ai * HALF + wr * 64 + m * 16 + fr) * 4); const float inv = 1.0f / ((t[0] + t[1]) + (t[2] + t[3]));
            bf16_t* rowp = PP + (size_t)(row0 + ai * HALF + m * 16) * 256 + col0;
#pragma unroll
            for (int bj = 0; bj < 2; ++bj) { const f32x4 v0 = acc[ai][bj][m][0] * inv, v1 = acc[ai][bj][m][1] * inv;
                u32x4 w; w.x = cvt_pk_bf16(v0[0], v0[1]); w.y = cvt_pk_bf16(v0[2], v0[3]); w.z = cvt_pk_bf16(v1[0], v1[1]); w.w = cvt_pk_bf16(v1[2], v1[3]);
                *(u32x4*)(rowp + bj * HALF) = w; } }
        asm volatile("s_waitcnt lgkmcnt(0)" ::: "memory"); __builtin_amdgcn_s_barrier(); asm volatile("" ::: "memory");
    }
};
}

constexpr size_t MiB = 1u << 20;
constexpr size_t al256(size_t x) { return (x + 255) & ~(size_t)255; }
constexpr size_t WS_CTL = 0, CTL_ZERO_BYTES = 1 * MiB;
constexpr size_t WS_WIN = 1 * MiB;
constexpr size_t WS_WUP = WS_WIN + (size_t)PC * D * 2;
constexpr size_t WS_AUP = WS_WUP + (size_t)D * 256 * 2;
constexpr size_t WS_GUP = WS_AUP + (size_t)D * 256 * 2;
constexpr size_t WS_PA = WS_GUP + (size_t)D * 256 * 2;
constexpr size_t WS_PB = WS_PA + (size_t)D * D * 2;
constexpr size_t WS_WOUT = WS_PB + (size_t)D * 512 * 2;
constexpr size_t WS_WQ = WS_WOUT + (size_t)D * D * 2;
constexpr size_t WS_WKV = WS_WQ + (size_t)D * D * 2;
constexpr size_t WS_WO = WS_WKV + (size_t)2 * D * D * 2;
constexpr size_t WS_W1 = WS_WO + (size_t)D * D * 2;
constexpr size_t WS_W2 = WS_W1 + (size_t)NEXP * 4096 * D * 2;
constexpr size_t WS_XB = WS_W2 + (size_t)NEXP * D * DFF * 2;
constexpr size_t WS_MEMB = WS_XB + (size_t)M * D * 2;
constexpr size_t WS_ROT = WS_MEMB + (size_t)1024 * D * 2;
constexpr size_t WS_KB = WS_ROT + (size_t)2 * SEQ * 32 * 4;
constexpr size_t WS_VT = WS_KB + (size_t)1024 * D * 2;
constexpr size_t WS_YA = WS_VT + (size_t)1024 * D * 2;
constexpr size_t WS_YB = WS_YA + (size_t)M * D * 2;
constexpr size_t WS_TMP = WS_YB + (size_t)M * 512 * 2;
constexpr size_t WS_MERGED = WS_TMP + (size_t)M * D * 4;
constexpr size_t WS_E = WS_MERGED + (size_t)M * D * 2;
constexpr size_t WS_PROJ = WS_E;
constexpr size_t WS_RZ = WS_PROJ + (size_t)M * PC * 2;
constexpr size_t WS_KZ = WS_RZ + (size_t)M * D * 4;
constexpr size_t WS_VZ = WS_KZ + (size_t)M * D * 4;
constexpr size_t WS_DEC = WS_VZ + (size_t)M * D * 4;
constexpr size_t WS_KP = WS_DEC + (size_t)M * D * 4;
constexpr size_t WS_AN = WS_KP + (size_t)M * D * 4;
constexpr size_t WS_BB = WS_AN + (size_t)M * D * 4;
constexpr size_t WS_GG = WS_BB + (size_t)M * D * 4;
constexpr size_t WS_YS = WS_GG + (size_t)M * D * 4;
constexpr size_t WS_VR = WS_YS + 4 * MiB;
constexpr size_t WS_AO = WS_YS + (size_t)M * D * 4;
constexpr size_t WS_LSE = WS_AO + (size_t)3 * M * 512 * 4;
constexpr size_t WS_QR = WS_LSE + (size_t)3 * M * 8 * 4;
constexpr size_t WS_KR = WS_QR + (size_t)M * 1536 * 2;
constexpr size_t WS_LIN = WS_KR + (size_t)M * 1536 * 2;
constexpr size_t WS_KNORM = WS_LIN + (size_t)M * 768 * 2;
constexpr size_t WS_F = WS_KNORM + (size_t)M * 32 * 4;
constexpr size_t WS_E_END = WS_F + (size_t)128 * 128 * 96 * 96 * 2;
constexpr size_t WS_T1 = WS_E;
constexpr size_t WS_X1 = WS_T1 + (size_t)M * D * 4;
constexpr size_t WS_X1B = WS_X1 + (size_t)M * D * 4;
constexpr size_t WS_Q = WS_X1B + (size_t)M * D * 2;
constexpr size_t WS_PP = WS_Q + (size_t)M * D * 2;
constexpr size_t WS_OC = WS_PP + (size_t)16 * SEQ * 256 * 2;
constexpr size_t WS_T2 = WS_OC + (size_t)M * D * 2;
constexpr size_t WS_X2 = WS_T2 + (size_t)M * D * 4;
constexpr size_t WS_X2B = WS_X2 + (size_t)M * D * 4;
constexpr size_t WS_LIST = WS_X2B + (size_t)M * D * 2;
constexpr size_t WS_ROWI = WS_LIST + (size_t)NEXP * CAP * 4;
constexpr size_t WS_TOPW = WS_ROWI + (size_t)M * 4 * 4;
constexpr size_t WS_H = WS_TOPW + (size_t)M * 4 * 4;
constexpr size_t WS_Y = WS_H + (size_t)HROWS * DFF * 2;
constexpr size_t WS_L_END = WS_Y + (size_t)HROWS * D * 4;
constexpr size_t WS_END = (WS_E_END > WS_L_END ? WS_E_END : WS_L_END);
static_assert(WS_END <= (size_t)4090 * MiB, "workspace map exceeds 4 x largest input");
constexpr int CW_TMO = 0, CW_CNT = 64  , CW_Q = 128  , CW_BAR = 4096;

constexpr int RING_BYTES = 131072, MISC_OFF = RING_BYTES, LDS_BYTES = 147456;

#define XB_TMO      128
#define XB_XCNT(j)  (256  + 64 * (j))
#define XB_XSUB(j)  (1280 + 64 * (j))
#define XB_XGEN(j)  (2304 + 64 * (j))
#define XB_TOP      3328
#define XB_TOPGEN   3392
#define XCD_BAR_WORDS 3456
#define XB_SPIN_CAP (1u << 18)
__device__ __forceinline__ unsigned xb_ld(unsigned* p)              { return __hip_atomic_load(p, __ATOMIC_RELAXED, __HIP_MEMORY_SCOPE_AGENT); }
__device__ __forceinline__ unsigned xb_add(unsigned* p, unsigned v) { return __hip_atomic_fetch_add(p, v, __ATOMIC_RELAXED, __HIP_MEMORY_SCOPE_AGENT); }
__device__ __forceinline__ unsigned xb_xcc_id() { return (unsigned)__builtin_amdgcn_s_getreg((3 << 11) | 20) & 0xFu; }
#define XB_SPIN(cond, bar) do { unsigned _sp = 0; while (cond) { __builtin_amdgcn_s_sleep(1); \
    if ((++_sp & 255u) == 0u) { if (xb_ld(&(bar)[XB_TMO])) break; if (_sp > XB_SPIN_CAP) { atomicAdd(&(bar)[XB_TMO], 1u); break; } } } } while (0)
struct XcdBarrier { unsigned* bar; unsigned x; volatile LAS unsigned* st; };
__device__ __forceinline__ XcdBarrier xcd_barrier_post(unsigned* bar, volatile LAS unsigned* st) {
    XcdBarrier b; b.bar = bar; b.x = xb_xcc_id(); b.st = st;
    if (threadIdx.x == 0) (void)xb_add(&bar[XB_XCNT(b.x)], 1u);
    return b;
}
__device__ __forceinline__ void xcd_barrier_complete(unsigned* bar, unsigned x, unsigned& nloc, unsigned& nx) {
    const unsigned G = gridDim.x * gridDim.y * gridDim.z;
    unsigned sum, cnt, mine, sp = 0u;
    for (;;) {
        sum = 0u; cnt = 0u; mine = 0u;
#pragma unroll
        for (unsigned j = 0; j < 16; ++j) { const unsigned c = xb_ld(&bar[XB_XCNT(j)]); sum += c; cnt += (c > 0u) ? 1u : 0u; mine = (j == x) ? c : mine; }
        if (sum == G) break;
        __builtin_amdgcn_s_sleep(1);
        if ((++sp & 255u) == 0u) { if (xb_ld(&bar[XB_TMO])) break; if (sp > XB_SPIN_CAP) { atomicAdd(&bar[XB_TMO], 1u); break; } }
    }
    nloc = mine > 0u ? mine : 1u; nx = cnt > 0u ? cnt : 1u;
}
__device__ __forceinline__ void xcd_barrier(const XcdBarrier& b) {
    asm volatile("s_waitcnt vmcnt(0)" ::: "memory");
    __syncthreads();
    if (threadIdx.x == 0) {
        unsigned* bar = b.bar;
        __builtin_amdgcn_s_waitcnt(0);
        unsigned nloc = b.st[0], nx = b.st[1];
        if (nloc == 0u) { xcd_barrier_complete(bar, b.x, nloc, nx); b.st[0] = nloc; b.st[1] = nx; }
        const unsigned old = xb_add(&bar[XB_XSUB(b.x)], 1u);
        const unsigned gen = old / nloc;
        if (old + 1u == (gen + 1u) * nloc) {
            __builtin_amdgcn_fence(__ATOMIC_RELEASE, "agent");
            asm volatile("s_waitcnt vmcnt(0)" ::: "memory");
            const unsigned og = xb_add(&bar[XB_TOP], 1u);
            const unsigned tg = og / nx;
            if (og + 1u == (tg + 1u) * nx) xb_add(&bar[XB_TOPGEN], 1u);
            else XB_SPIN(xb_ld(&bar[XB_TOPGEN]) == tg, bar);
            __builtin_amdgcn_fence(__ATOMIC_ACQUIRE, "agent");
            xb_add(&bar[XB_XGEN(b.x)], 1u);
            asm volatile("s_waitcnt vmcnt(0)" ::: "memory");
        } else {
            XB_SPIN(xb_ld(&bar[XB_XGEN(b.x)]) == gen, bar);
            __builtin_amdgcn_fence(__ATOMIC_ACQUIRE, "agent");
            asm volatile("s_waitcnt vmcnt(0)" ::: "memory");
        }
    }
    __syncthreads();
}

struct Params {
    const float* in[32];
    float* out; unsigned char* ws;
    int ph_lo, ph_hi, li, pad;
};
enum { I_X = 0, I_MEM, I_WIN, I_MIX, I_W0, I_WUP, I_A0, I_AUP, I_GUP, I_KK, I_KA, I_RK, I_LNXG, I_LNXB, I_PA, I_PB, I_WOUT, I_LN1G, I_LN1B, I_WQ, I_WKV, I_WO, I_LN2G, I_LN2B,
       I_RW, I_RB, I_W1, I_B1, I_W2, I_B2, I_LN3G, I_LN3B };

struct ScoreOrder {
    static constexpr bool GATHER = false;
    const char* Q; const char* KB; int G, c;
    __device__ bool next(int i, pg8::Unit& u) const {
        const int L = i * G + c; if (L >= 256) return false;
        const int bh = L >> 4, pm = L & 15, b = bh >> 2, h = bh & 3;
        u.A = Q + ((size_t)(b * SEQ + 256 * pm) * D + h * 512) * 2; u.B = KB + ((size_t)(b * 256) * D + h * 512) * 2;
        u.orow = bh * SEQ + 256 * pm; u.ocol = 0; u.aux = 0; u.aux2 = 0; u.valid = 256; return true;
    }
    __device__ __forceinline__ const int* rows(const pg8::Unit&) const { return nullptr; }
};
struct PvOrder {
    static constexpr bool GATHER = false;
    const char* PP; const char* VT; int G, c;
    __device__ bool next(int i, pg8::Unit& u) const {
        const int L = i * G + c; if (L >= 512) return false;
        const int bh = L >> 5, pm = (L >> 1) & 15, pn = L & 1, b = bh >> 2, h = bh & 3;
        u.A = PP + ((size_t)(bh * SEQ + 256 * pm) * 256) * 2; u.B = VT + ((size_t)(bh * 512 + 256 * pn) * 256) * 2;
        u.orow = b * SEQ + 256 * pm; u.ocol = h * 512 + 256 * pn; u.aux = 0; u.aux2 = 0; u.valid = 256; return true;
    }
    __device__ __forceinline__ const int* rows(const pg8::Unit&) const { return nullptr; }
};
template <bool GATHER_, int NT  > struct MoeOrder {
    static constexpr bool GATHER = GATHER_;
    const LAS int* tab; const char* A; const char* W; const int* list; size_t wexp  ; int ldb; int G, c;
    __device__ bool next(int i, pg8::Unit& u) const {
        constexpr int RPR = 256 / NT;
        const int rt = i * RPR + (c % RPR), pn = c / RPR, T = __builtin_amdgcn_readfirstlane(tab[64]);
        if (c >= 256 || rt >= T) return false;
        int e = 0;
        for (int j = 1; j < NEXP; ++j) e = (rt >= __builtin_amdgcn_readfirstlane(tab[32 + j])) ? j : e;
        const int lt = rt - __builtin_amdgcn_readfirstlane(tab[32 + e]), cnt = __builtin_amdgcn_readfirstlane(tab[e]);
        u.aux = e; u.aux2 = lt; u.valid = min(256, cnt - 256 * lt); u.orow = 256 * rt; u.ocol = 256 * pn;
        u.B = W + (size_t)e * wexp + (size_t)(256 * pn) * ldb;
        u.A = GATHER_ ? A : A + (size_t)(256 * rt) * DFF;
        return true;
    }
    __device__ __forceinline__ const int* rows(const pg8::Unit& u) const { return list + (size_t)u.aux * CAP + 256 * u.aux2; }
};

struct Ctx { int tid, lane, wave, vcu, G; LAS unsigned char* lds; unsigned char* ws; };

__device__ __forceinline__ void tr_item(const float* W, int ldw, int Ksrc, int sc0, bf16_t* WT, int ldt, int n0, int k0, LAS float* scr, int lane) {
#pragma unroll 8
    for (int i = 0; i < 32; ++i) { const int kk = 2 * i + (lane >> 5); float v = 0.f; if (sc0 >= 0 && (k0 + kk) < Ksrc) v = W[(size_t)(k0 + kk) * ldw + sc0 + (lane & 31)]; scr[kk * 33 + (lane & 31)] = v; }
    LDS_WAIT(); asm volatile("" ::: "memory");
    const int c = lane & 7;
#pragma unroll
    for (int j = 0; j < 4; ++j) { const int n = (lane >> 3) + 8 * j; const LAS float* s = scr + (8 * c) * 33 + n;
        u32x4 o; o.x = pk2(s[0 * 33], s[1 * 33]); o.y = pk2(s[2 * 33], s[3 * 33]); o.z = pk2(s[4 * 33], s[5 * 33]); o.w = pk2(s[6 * 33], s[7 * 33]);
        *(u32x4*)(WT + (size_t)(n0 + n) * ldt + k0 + 8 * c) = o; }
    LDS_WAIT(); asm volatile("" ::: "memory");
}
__device__ __forceinline__ void tr_job(const float* W, int N, int Ksrc, int Kdst, bf16_t* WT, int item, LAS float* scr, int lane) {
    const int nblk = N / 32, kb = item / nblk, nb = item % nblk;
    tr_item(W, N, Ksrc, 32 * nb, WT, Kdst, 32 * nb, 64 * kb, scr, lane);
}
__device__ __forceinline__ void p0_prologue(const Params& p, const Ctx& c) {
    LAS float* scr = (LAS float*)(c.lds + c.wave * 16384);
    const int gw = c.vcu * 8 + c.wave, NGW = c.G * 8;
    unsigned char* ws = c.ws;
    constexpr int I_WINJ = 32 * 480, I_LORA = 4 * 64, I_SQ = 32 * 64, I_PBJ = 8 * 64, I_KVJ = 32 * 128, I_W1E = 32 * 128, I_W2E = 32 * 64;
    constexpr int NITEMS = I_WINJ + 3 * I_LORA + 4 * I_SQ + I_PBJ + I_KVJ;
    for (int it = gw; it < NITEMS; it += NGW) {
        int r = it;
        if (r < I_WINJ) { const int kb = r / 480, nb = r % 480; const int sc0 = nb < 206 ? 32 * nb : (nb < 208 ? -1 : 32 * nb - 64);
            tr_item(p.in[I_WIN], 15296, D, sc0, (bf16_t*)(ws + WS_WIN), D, 32 * nb, 64 * kb, scr, c.lane); continue; } r -= I_WINJ;
        if (r < I_LORA) { tr_job(p.in[I_WUP], D, 96, 256, (bf16_t*)(ws + WS_WUP), r, scr, c.lane); continue; } r -= I_LORA;
        if (r < I_LORA) { tr_job(p.in[I_AUP], D, 96, 256, (bf16_t*)(ws + WS_AUP), r, scr, c.lane); continue; } r -= I_LORA;
        if (r < I_LORA) { tr_job(p.in[I_GUP], D, 256, 256, (bf16_t*)(ws + WS_GUP), r, scr, c.lane); continue; } r -= I_LORA;
        if (r < I_SQ) { tr_job(p.in[I_PA], D, D, D, (bf16_t*)(ws + WS_PA), r, scr, c.lane); continue; } r -= I_SQ;
        if (r < I_PBJ) { tr_job(p.in[I_PB], D, 512, 512, (bf16_t*)(ws + WS_PB), r, scr, c.lane); continue; } r -= I_PBJ;
        if (r < I_SQ) { tr_job(p.in[I_WOUT], D, D, D, (bf16_t*)(ws + WS_WOUT), r, scr, c.lane); continue; } r -= I_SQ;
        if (r < I_SQ) { tr_job(p.in[I_WQ], D, D, D, (bf16_t*)(ws + WS_WQ), r, scr, c.lane); continue; } r -= I_SQ;
        if (r < I_KVJ) { tr_job(p.in[I_WKV], 2 * D, D, D, (bf16_t*)(ws + WS_WKV), r, scr, c.lane); continue; } r -= I_KVJ;
        { tr_job(p.in[I_WO], D, D, D, (bf16_t*)(ws + WS_WO), r, scr, c.lane); }
    }
    const size_t gt = (size_t)c.vcu * 512 + c.tid, NT = (size_t)c.G * 512;
    for (size_t i = gt; i < (size_t)M * D / 8; i += NT) { const f32x4 a = ((const f32x4*)p.in[I_X])[2 * i], b = ((const f32x4*)p.in[I_X])[2 * i + 1];
        u32x4 o; o.x = pk2(a[0], a[1]); o.y = pk2(a[2], a[3]); o.z = pk2(b[0], b[1]); o.w = pk2(b[2], b[3]); ((u32x4*)(ws + WS_XB))[i] = o; }
    for (size_t i = gt; i < (size_t)1024 * D / 8; i += NT) { const f32x4 a = ((const f32x4*)p.in[I_MEM])[2 * i], b = ((const f32x4*)p.in[I_MEM])[2 * i + 1];
        u32x4 o; o.x = pk2(a[0], a[1]); o.y = pk2(a[2], a[3]); o.z = pk2(b[0], b[1]); o.w = pk2(b[2], b[3]); ((u32x4*)(ws + WS_MEMB))[i] = o; }
    float* rc = (float*)(ws + WS_ROT); float* rs = rc + SEQ * 32;
    for (size_t i = gt; i < (size_t)SEQ * 32; i += NT) { const int pos = (int)(i >> 5), j = (int)(i & 31);
        const double inv = exp(-(double)j * (9.210340371976184 / 32.0)); const double ang = (double)pos * inv; rc[i] = (float)cos(ang); rs[i] = (float)sin(ang); }
}

__device__ __forceinline__ void tr_store8(unsigned char* WT8, int ldt, int n0, int k0, const LAS float* scr, int lane) {
    const int c = lane & 3;
#pragma unroll
    for (int j = 0; j < 2; ++j) { const int n = (lane >> 2) + 16 * j; const LAS float* sp = scr + (16 * c) * 33 + n; u32x4 o;
        o.x = pk4_fp8(sp[0 * 33] * 64.f, sp[1 * 33] * 64.f, sp[2 * 33] * 64.f, sp[3 * 33] * 64.f); o.y = pk4_fp8(sp[4 * 33] * 64.f, sp[5 * 33] * 64.f, sp[6 * 33] * 64.f, sp[7 * 33] * 64.f);
        o.z = pk4_fp8(sp[8 * 33] * 64.f, sp[9 * 33] * 64.f, sp[10 * 33] * 64.f, sp[11 * 33] * 64.f); o.w = pk4_fp8(sp[12 * 33] * 64.f, sp[13 * 33] * 64.f, sp[14 * 33] * 64.f, sp[15 * 33] * 64.f);
        *(u32x4*)(WT8 + (size_t)(n0 + n) * ldt + k0 + 16 * c) = o; }
}
__device__ __forceinline__ void tr_item8(const float* W, int ldw, unsigned char* WT8, int ldt, int n0, int k0, LAS float* scr, int lane) {
#pragma unroll 8
    for (int i = 0; i < 32; ++i) { const int kk = 2 * i + (lane >> 5); scr[kk * 33 + (lane & 31)] = W[(size_t)(k0 + kk) * ldw + n0 + (lane & 31)]; }
    LDS_WAIT(); asm volatile("" ::: "memory");
    tr_store8(WT8, ldt, n0, k0, scr, lane);
    LDS_WAIT(); asm volatile("" ::: "memory");
}
__device__ __forceinline__ void tr_issue(const float* W, int ldw, int n0, int k0, int lane, float (&cv)[32]) {
#pragma unroll
    for (int i = 0; i < 32; ++i) cv[i] = W[(size_t)(k0 + 2 * i + (lane >> 5)) * ldw + n0 + (lane & 31)];
}
__device__ __forceinline__ void tr_finish(const float (&cv)[32], unsigned char* WT8, int ldt, int n0, int k0, LAS float* scr, int lane) {
#pragma unroll
    for (int i = 0; i < 32; ++i) scr[(2 * i + (lane >> 5)) * 33 + (lane & 31)] = cv[i];
    LDS_WAIT(); asm volatile("" ::: "memory");
    tr_store8(WT8, ldt, n0, k0, scr, lane);
    LDS_WAIT(); asm volatile("" ::: "memory");
}
constexpr int MOE_W1E = 32 * 128, MOE_W2E = 32 * 64, MOE_CONV_GROUPS = (NEXP * MOE_W2E) / 8;
__device__ __forceinline__ void conv_group(const Params& p, const Ctx& c, int gi) {
    LAS float* scr = (LAS float*)(c.lds + c.wave * 16384);
    unsigned char* ws = c.ws;
    const int r = gi * 8 + c.wave;
    { const int e = r / MOE_W2E, it = r % MOE_W2E, kb = it >> 6, nb = it & 63; tr_item8(p.in[I_W2] + (size_t)e * DFF * D, D, ws + WS_W2 + (size_t)e * D * DFF, DFF, 32 * nb, 64 * kb, scr, c.lane); }
}

__device__ __forceinline__ void p2_prep(const Params& p, const Ctx& c) {
    unsigned char* ws = c.ws;
    const bf16_t* PROJ = (const bf16_t*)(ws + WS_PROJ);
    const float* mix = p.in[I_MIX]; const float* k_k = p.in[I_KK];
    bf16_t* RZ = (bf16_t*)(ws + WS_RZ); bf16_t* KZ = (bf16_t*)(ws + WS_KZ); bf16_t* VZ = (bf16_t*)(ws + WS_VZ);
    bf16_t* LIN = (bf16_t*)(ws + WS_LIN); float* KNORM = (float*)(ws + WS_KNORM);
    bf16_t* QR = (bf16_t*)(ws + WS_QR); bf16_t* KR = (bf16_t*)(ws + WS_KR); bf16_t* VR = (bf16_t*)(ws + WS_VR);
    const float* rc = (const float*)(ws + WS_ROT); const float* rs = rc + SEQ * 32;
    for (int t = c.vcu; t < M; t += c.G) {
        const int pos = t & (SEQ - 1);
        const bf16_t* cur = PROJ + (size_t)t * PC;
        for (int ch = c.tid; ch < 824; ch += 512) {
            const u32x4 cv = *(const u32x4*)(cur + 8 * ch); u32x4 pv = (u32x4){0u, 0u, 0u, 0u}; if (pos > 0) pv = *(const u32x4*)(cur - PC + 8 * ch);
            const f32x4 m0 = *(const f32x4*)(mix + 8 * ch), m1 = *(const f32x4*)(mix + 8 * ch + 4);
            float z[8];
            { const unsigned cw[4] = {cv.x, cv.y, cv.z, cv.w}, pw[4] = {pv.x, pv.y, pv.z, pv.w};
              const float mm[8] = {m0[0], m0[1], m0[2], m0[3], m1[0], m1[1], m1[2], m1[3]};
#pragma unroll
              for (int j = 0; j < 4; ++j) { const float c0 = bf2f(cw[j] & 0xffffu), c1 = bf2f(cw[j] >> 16), q0 = bf2f(pw[j] & 0xffffu), q1 = bf2f(pw[j] >> 16);
                  z[2 * j] = c0 + (q0 - c0) * mm[2 * j]; z[2 * j + 1] = c1 + (q1 - c1) * mm[2 * j + 1]; } }
            if (ch < 768) {
                bf16_t* dst = (ch < 256 ? RZ : (ch < 512 ? KZ : VZ)) + (size_t)t * D + 8 * (ch & 255);
                { u32x4 w8; w8.x = pk2(z[0], z[1]); w8.y = pk2(z[2], z[3]); w8.z = pk2(z[4], z[5]); w8.w = pk2(z[6], z[7]); *(u32x4*)dst = w8; }
                if (ch >= 256 && ch < 512) {
                    const int col = 8 * (ch - 256); const f32x4 k0 = *(const f32x4*)(k_k + col), k1 = *(const f32x4*)(k_k + col + 4);
                    float s = 0.f;
#pragma unroll
                    for (int j = 0; j < 4; ++j) { const float a = z[j] * k0[j], b = z[4 + j] * k1[j]; s += a * a + b * b; }
                    s += __shfl_xor(s, 1); s += __shfl_xor(s, 2); s += __shfl_xor(s, 4);
                    if ((ch & 7) == 0) KNORM[(size_t)t * 32 + ((ch - 256) >> 3)] = sqrtf(s);
                }
            } else {
                float o[8]; int dcol;
                if (ch < 780) { dcol = 8 * (ch - 768);
#pragma unroll
                    for (int j = 0; j < 8; ++j) o[j] = tanhf(z[j]); }
                else if (ch < 792) { dcol = 256 + 8 * (ch - 780);
#pragma unroll
                    for (int j = 0; j < 8; ++j) o[j] = z[j]; }
                else { dcol = 512 + 8 * (ch - 792);
#pragma unroll
                    for (int j = 0; j < 8; ++j) o[j] = sigmoidf_(z[j]); }
                u32x4 w; w.x = pk2(o[0], o[1]); w.y = pk2(o[2], o[3]); w.z = pk2(o[4], o[5]); w.w = pk2(o[6], o[7]);
                *(u32x4*)(LIN + (size_t)t * 768 + dcol) = w;
            }
        }
        if (c.tid < 40) { const int dcol = (c.tid < 20) ? 96 + 8 * c.tid : 352 + 8 * (c.tid - 20); *(u32x4*)(LIN + (size_t)t * 768 + dcol) = (u32x4){0u, 0u, 0u, 0u}; }
        if (c.tid >= 64 && c.tid < 64 + 192) { const int w = c.tid - 64, which = w / 96, hh = (w % 96) >> 2, e0 = (w & 3) * 8;
            const bf16_t* src = cur + ATT0 + which * 1536 + hh * 64 + e0;
            const u32x4 a = *(const u32x4*)src, b = *(const u32x4*)(src + 32);
            const f32x4 c0 = *(const f32x4*)(rc + pos * 32 + e0), c1 = *(const f32x4*)(rc + pos * 32 + e0 + 4), s0 = *(const f32x4*)(rs + pos * 32 + e0), s1 = *(const f32x4*)(rs + pos * 32 + e0 + 4);
            const unsigned aw[4] = {a.x, a.y, a.z, a.w}, bw[4] = {b.x, b.y, b.z, b.w}; float o1[8], o2[8];
#pragma unroll
            for (int j = 0; j < 8; ++j) { const float t1 = bf2f((aw[j >> 1] >> (16 * (j & 1))) & 0xffffu), t2 = bf2f((bw[j >> 1] >> (16 * (j & 1))) & 0xffffu);
                const float cs = j < 4 ? c0[j & 3] : c1[j & 3], sn = j < 4 ? s0[j & 3] : s1[j & 3]; o1[j] = t1 * cs - t2 * sn; o2[j] = t2 * cs + t1 * sn; }
            const int dl_ = hh < 8 ? 1 : (hh < 16 ? 4 : 16); const int prm = (pos % dl_) * (SEQ / dl_) + pos / dl_;
            bf16_t* dst = (which ? KR : QR) + ((size_t)((t >> 12) * 24 + hh) * SEQ + prm) * 64 + e0;
            u32x4 w1; w1.x = pk2(o1[0], o1[1]); w1.y = pk2(o1[2], o1[3]); w1.z = pk2(o1[4], o1[5]); w1.w = pk2(o1[6], o1[7]);
            u32x4 w2; w2.x = pk2(o2[0], o2[1]); w2.y = pk2(o2[2], o2[3]); w2.z = pk2(o2[4], o2[5]); w2.w = pk2(o2[6], o2[7]);
            *(u32x4*)dst = w1; *(u32x4*)(dst + 32) = w2; }
        if (c.tid >= 256 && c.tid < 256 + 192) { const int w = c.tid - 256, hh = w >> 3, e0 = (w & 7) * 8;
            const int dl_ = hh < 8 ? 1 : (hh < 16 ? 4 : 16); const int prm = (pos % dl_) * (SEQ / dl_) + pos / dl_;
            *(u32x4*)(VR + ((size_t)((t >> 12) * 24 + hh) * SEQ + prm) * 64 + e0) = *(const u32x4*)(cur + ATT0 + 2 * 1536 + hh * 64 + e0); }
    }
}

#define DPP_ADD(x, ctrl) ((x) + __builtin_bit_cast(float, __builtin_amdgcn_update_dpp(0, __builtin_bit_cast(int, (x)), (ctrl), 0xF, 0xF, true)))
__device__ __forceinline__ float wave_sum_dpp(float x) {
    x = DPP_ADD(x, 0xB1); x = DPP_ADD(x, 0x4E); x = DPP_ADD(x, 0x141); x = DPP_ADD(x, 0x140);
    const int xi = __builtin_bit_cast(int, x);
    return (__builtin_bit_cast(float, __builtin_amdgcn_readlane(xi, 0)) + __builtin_bit_cast(float, __builtin_amdgcn_readlane(xi, 16))) +
           (__builtin_bit_cast(float, __builtin_amdgcn_readlane(xi, 32)) + __builtin_bit_cast(float, __builtin_amdgcn_readlane(xi, 48)));
}
__device__ __forceinline__ f32x4 tile_mm(const LAS bf16_t* A, int pa, const LAS bf16_t* Bt, int pb, int ks, int fr, int fq, f32x4 acc) {
    for (int k = 0; k < ks; ++k) { const bf16x8 a = *(const LAS bf16x8*)(A + fr * pa + 32 * k + 8 * fq), b = *(const LAS bf16x8*)(Bt + fr * pb + 32 * k + 8 * fq);
        acc = __builtin_amdgcn_mfma_f32_16x16x32_bf16(a, b, acc, 0, 0, 0); }
    return acc;
}
__device__ __forceinline__ u32x2 pack4(f32x4 v) { u32x2 w; w.x = pk2(v[0], v[1]); w.y = pk2(v[2], v[3]); return w; }
constexpr int SC_C = 32, SC_NCH = SEQ / SC_C, SC_F = 96;
constexpr int PL_X1 = 0, PL_X2 = 9216, PL_AL = 18432, PL_HT = 26112, PL_ET = 33792, PL_LBT = 53760, PL_TT = 58368, PL_GI = 60928, PL_RAW = 68608, PL_TF = 109568, PL_XB = 114176, PL_END = 115264;
#define LBAR() do { asm volatile("s_waitcnt lgkmcnt(0)" ::: "memory"); __builtin_amdgcn_s_barrier(); asm volatile("" ::: "memory"); } while (0)
__device__ __forceinline__ void p4_pre(const Params& p, const Ctx& c) {
    unsigned char* ws = c.ws;
    const bf16_t* RZ = (const bf16_t*)(ws + WS_RZ); const float* DEC = (const float*)(ws + WS_DEC); const bf16_t* KP = (const bf16_t*)(ws + WS_KP);
    const bf16_t* AN = (const bf16_t*)(ws + WS_AN); const bf16_t* BB = (const bf16_t*)(ws + WS_BB);
    bf16_t* FG = (bf16_t*)(ws + WS_F); float* BON = (float*)(ws + WS_YS);
    const float* rkp = p.in[I_RK];
    LAS bf16_t* X1 = (LAS bf16_t*)(c.lds + PL_X1); LAS bf16_t* X2 = (LAS bf16_t*)(c.lds + PL_X2); LAS bf16_t* AL = (LAS bf16_t*)(c.lds + PL_AL); LAS bf16_t* HT = (LAS bf16_t*)(c.lds + PL_HT);
    LAS bf16_t* ET = (LAS bf16_t*)(c.lds + PL_ET); LAS float* LBT = (LAS float*)(c.lds + PL_LBT); LAS bf16_t* TT = (LAS bf16_t*)(c.lds + PL_TT); LAS bf16_t* GI = (LAS bf16_t*)(c.lds + PL_GI);
    LAS float* RAW = (LAS float*)(c.lds + PL_RAW);
    LAS float* TF = (LAS float*)(c.lds + PL_TF);
    LAS float* XB = (LAS float*)(c.lds + PL_XB);
    int tid_ = c.tid; asm volatile("" : "+v"(tid_));
    const int tid = tid_, lane = tid & 63, w = __builtin_amdgcn_readfirstlane(tid >> 6), fr = lane & 15, fq = lane >> 4;
    const int ls = tid >> 4, lc4 = 4 * (tid & 15);
    f32x4 pfd; u32x2 pfb[4];
#define PRE_LOAD(TASK) do { const int bh_ = (TASK) >> 7, ch_ = (TASK) & (SC_NCH - 1); const size_t o_ = ((size_t)(bh_ >> 5) * SEQ + (size_t)ch_ * SC_C + ls) * D + (bh_ & 31) * 64 + lc4; \
        pfb[0] = *(const u32x2*)(RZ + o_); pfd = *(const f32x4*)(DEC + o_); pfb[1] = *(const u32x2*)(KP + o_); pfb[2] = *(const u32x2*)(AN + o_); pfb[3] = *(const u32x2*)(BB + o_); } while (0)
#define PRE_UNPK(w_) ((f32x4){bf2f((w_).x & 0xffffu), bf2f((w_).x >> 16), bf2f((w_).y & 0xffffu), bf2f((w_).y >> 16)})
    if (c.vcu < 128 * SC_NCH) PRE_LOAD(c.vcu);
    const bool bgconv = (c.G == 256);
    LAS float* cscr = (LAS float*)(c.lds + w * 8448);
    int tix = 0;
    for (int task = c.vcu; task < 128 * SC_NCH; task += c.G, ++tix) {
        *(LAS f32x4*)(RAW + (0 * 32 + ls) * 64 + lc4) = PRE_UNPK(pfb[0]); *(LAS f32x4*)(RAW + (1 * 32 + ls) * 64 + lc4) = pfd; *(LAS f32x4*)(RAW + (2 * 32 + ls) * 64 + lc4) = PRE_UNPK(pfb[1]);
        *(LAS f32x4*)(RAW + (3 * 32 + ls) * 64 + lc4) = PRE_UNPK(pfb[2]); *(LAS f32x4*)(RAW + (4 * 32 + ls) * 64 + lc4) = PRE_UNPK(pfb[3]);
        const int bh = task >> 7, chn = task & (SC_NCH - 1); const float rkv = rkp[(bh & 31) * 64 + lane];
        float* bon = BON + ((size_t)(bh >> 5) * SEQ + (size_t)chn * SC_C) * 32 + (bh & 31);
        if (task + c.G < 128 * SC_NCH) PRE_LOAD(task + c.G);
        float cv[32]; int ce = 0, cn0 = 0, ck0 = 0;
        if (bgconv) { const int item = (c.vcu * 64 + tix) * 8 + w; ce = item >> 12; const int rem = item & 4095; ck0 = 64 * (rem >> 7); cn0 = 32 * (rem & 127);
            tr_issue(p.in[I_W1] + (size_t)ce * D * 4096, 4096, cn0, ck0, lane, cv); }
        LBAR();
        *(LAS u32x4*)(ET + (32 + (tid >> 3)) * 104 + 8 * (tid & 7)) = (u32x4){0u, 0u, 0u, 0u};
        float g = 1.f, gprev[4], gcur[4];
#pragma unroll
        for (int s = 0; s < SC_C; ++s) { const float wv = RAW[(32 + s) * 64 + lane]; if ((s >> 2) == w) gprev[s & 3] = g; g *= wv; if ((s >> 2) == w) gcur[s & 3] = g; }
        const float gC = g;
        f32x4 ah4, bg4, kg4;
#pragma unroll
        for (int qn = 0; qn < 4; ++qn) { const int s = 4 * w + qn;
            const float rr = RAW[(0 + s) * 64 + lane], kk = RAW[(64 + s) * 64 + lane], aa = RAW[(96 + s) * 64 + lane], bb = RAW[(128 + s) * 64 + lane]; const float ig = 1.0f / gcur[qn];
            const float ah = aa * gprev[qn], bt = bb * ig, kt = kk * ig, rh = rr * gcur[qn];
            X1[s * 72 + lane] = (bf16_t)f2bf(bt); X1[(32 + s) * 72 + lane] = (bf16_t)f2bf(kt); X2[s * 72 + lane] = (bf16_t)f2bf(ah); X2[(32 + s) * 72 + lane] = (bf16_t)f2bf(rh);
            ET[s * 104 + lane] = (bf16_t)f2bf(rh); ah4[qn] = ah; bg4[qn] = bt * gC; kg4[qn] = kt * gC;
            const float bsum = wave_sum_dpp(rr * kk * rkv); if (lane == 0) bon[(size_t)s * 32] = bsum; }
        *(LAS u32x2*)(AL + lane * 40 + 4 * w) = pack4(ah4); *(LAS u32x2*)(HT + (32 + lane) * 40 + 4 * w) = pack4(bg4); *(LAS u32x2*)(ET + (32 + lane) * 104 + 64 + 4 * w) = pack4(kg4);
        LBAR();
        if (w == 0) ET[(32 + lane) * 104 + lane] = (bf16_t)f2bf(gC);
        { const int mt = w >> 1;
#pragma unroll
          for (int u = 0; u < 2; ++u) { const int nt = 2 * (w & 1) + u;
            f32x4 acc = tile_mm(X1 + 16 * mt * 72, 72, X2 + 16 * nt * 72, 72, 2, fr, fq, (f32x4){0.f, 0.f, 0.f, 0.f});
            const int n = 16 * nt + fr, m0 = 16 * mt + 4 * fq;
            if (mt < 2) { if (nt < 2) { const int t = n; f32x4 o;
#pragma unroll
                    for (int e = 0; e < 4; ++e) o[e] = (m0 + e < t) ? acc[e] : 0.f;
                    *(LAS f32x4*)(LBT + t * 36 + m0) = o; }
                else { const int t = n - 32; f32x4 o;
#pragma unroll
                    for (int e = 0; e < 4; ++e) o[e] = (m0 + e <= t) ? acc[e] : 0.f;
                    *(LAS u32x2*)(HT + t * 40 + m0) = pack4(o); } }
            else { const int s0 = m0 - 32;
                if (nt < 2) { const int t = n;
#pragma unroll
                    for (int e = 0; e < 4; ++e) AL[(64 + s0 + e) * 40 + t] = (bf16_t)f2bf((s0 + e < t) ? acc[e] : 0.f); }
                else { const int t = n - 32; f32x4 o;
#pragma unroll
                    for (int e = 0; e < 4; ++e) o[e] = (s0 + e <= t) ? acc[e] : 0.f;
                    *(LAS u32x2*)(ET + t * 104 + 64 + s0) = pack4(o); } } } }
        LBAR();
        if (tid < 32) { const int hb = 16 * (tid >> 4), sl = tid & 15; float Tr[16];
#pragma unroll
            for (int t = 0; t < 16; ++t) { float a0 = (sl == t) ? 1.f : 0.f, a1 = 0.f, a2 = 0.f, a3 = 0.f;
#pragma unroll
                for (int m4 = 0; m4 < (t + 3) / 4; ++m4) { const f32x4 l = *(const LAS f32x4*)(LBT + (hb + t) * 36 + hb + 4 * m4);
                    if (4 * m4 + 0 < t) a0 += Tr[4 * m4 + 0] * l[0]; if (4 * m4 + 1 < t) a1 += Tr[4 * m4 + 1] * l[1]; if (4 * m4 + 2 < t) a2 += Tr[4 * m4 + 2] * l[2]; if (4 * m4 + 3 < t) a3 += Tr[4 * m4 + 3] * l[3]; }
                Tr[t] = (a0 + a1) + (a2 + a3); TF[(hb + sl) * 36 + hb + t] = Tr[t]; TT[(hb + t) * 40 + hb + sl] = (bf16_t)f2bf(Tr[t]);
                if (hb) TT[t * 40 + hb + sl] = 0; } }
        LBAR();
        if (tid < 256) { const int m = tid >> 4, tl = tid & 15; float x = 0.f;
#pragma unroll
            for (int n = 0; n < 16; ++n) x += LBT[(16 + n) * 36 + m] * TF[(16 + n) * 36 + 16 + tl];
            XB[m * 17 + tl] = x; }
        LBAR();
        if (tid < 256) { const int sr = tid >> 4, tl = tid & 15; float x = 0.f;
#pragma unroll
            for (int m = 0; m < 16; ++m) x += TF[sr * 36 + m] * XB[m * 17 + tl];
            TT[(16 + tl) * 40 + sr] = (bf16_t)f2bf(x); }
        LBAR();
        for (int id = w; id < 12; id += 8) { const int tt = id / 6, nt = id % 6;
            const f32x4 acc = tile_mm(TT + 16 * tt * 40, 40, AL + 16 * nt * 40, 40, 1, fr, fq, (f32x4){0.f, 0.f, 0.f, 0.f});
            *(LAS u32x2*)(GI + (16 * nt + fr) * 40 + 16 * tt + 4 * fq) = pack4(acc); }
        LBAR();
        for (int id = w; id < 36; id += 8) { const int nt = id / 6, mt = id % 6;
            const f32x4 acc = tile_mm(GI + 16 * nt * 40, 40, HT + 16 * mt * 40, 40, 1, fr, fq, (f32x4){0.f, 0.f, 0.f, 0.f});
            LAS u32x2* ep = (LAS u32x2*)(ET + (16 * mt + fr) * 104 + 16 * nt + 4 * fq); const u32x2 ev = *ep;
            f32x4 o; o[0] = acc[0] + bf2f(ev.x & 0xffffu); o[1] = acc[1] + bf2f(ev.x >> 16); o[2] = acc[2] + bf2f(ev.y & 0xffffu); o[3] = acc[3] + bf2f(ev.y >> 16);
            *ep = pack4(o); }
        LBAR();
        { bf16_t* fg = FG + (size_t)task * (SC_F * SC_F);
          for (int idx = tid; idx < 96 * 12; idx += 512) { const int row = idx / 12, pc = idx % 12; *(u32x4*)(fg + row * 96 + 8 * pc) = *(const LAS u32x4*)(ET + row * 104 + 8 * pc); } }
        LBAR();
        if (bgconv) tr_finish(cv, ws + WS_W1 + (size_t)ce * 4096 * D, D, cn0, ck0, cscr, lane);
    }
    if (!bgconv) {
        LBAR();
        for (int r = c.vcu * 8 + w; r < NEXP * MOE_W1E; r += c.G * 8) { const int e = r >> 12, rem = r & 4095; tr_item8(p.in[I_W1] + (size_t)e * D * 4096, 4096, ws + WS_W1 + (size_t)e * 4096 * D, D, 32 * (rem & 127), 64 * (rem >> 7), cscr, lane); }
    }
    LBAR();
#undef PRE_LOAD
#undef PRE_UNPK
}
constexpr int SQ_BI = 0, SQ_BI_SZ = 64 * 104 * 2, SQ_YL = 2 * SQ_BI_SZ, SQ_YL_SZ = 32 * 64 * 4;
struct SeqSet { bf16x8 af[3][3]; u32x2 vimg; float bon[4]; bf16_t g[4]; };
__device__ __forceinline__ void p4_seq(const Params& p, const Ctx& c, int bh) {
    unsigned char* ws = c.ws;
    const bf16_t* VZ = (const bf16_t*)(ws + WS_VZ); const bf16_t* GG = (const bf16_t*)(ws + WS_GG); const float* BON = (const float*)(ws + WS_YS);
    const bf16_t* FG = (const bf16_t*)(ws + WS_F) + (size_t)bh * SC_NCH * (SC_F * SC_F);
    bf16_t* YA = (bf16_t*)(ws + WS_YA);
    int tid_ = c.tid; asm volatile("" : "+v"(tid_));
    const int tid = tid_, lane = tid & 63, w = __builtin_amdgcn_readfirstlane(tid >> 6), fr = lane & 15, fq = lane >> 4;
    const int b = bh >> 5, h = bh & 31;
    const size_t base = (size_t)b * SEQ * D + h * 64;
    const int nt = w & 3, mg = w >> 2;
    const float lg = p.in[I_LNXG][h * 64 + lane], lb = p.in[I_LNXB][h * 64 + lane];
    LAS bf16_t* BI = (LAS bf16_t*)(c.lds + SQ_BI); LAS float* YL = (LAS float*)(c.lds + SQ_YL);
    const int vs = tid >> 4, vi4 = 4 * (tid & 15);
#define SEQ_LOAD(SET, CHN) do { const bf16_t* fp = FG + (size_t)(CHN) * (SC_F * SC_F); _Pragma("unroll") for (int mi = 0; mi < 3; ++mi) _Pragma("unroll") for (int ks = 0; ks < 3; ++ks) \
            SET.af[mi][ks] = *(const bf16x8*)(fp + (16 * (3 * mg + mi) + fr) * SC_F + 32 * ks + 8 * fq); \
        SET.vimg = *(const u32x2*)(VZ + base + (size_t)((CHN) * SC_C + vs) * D + vi4); \
        _Pragma("unroll") for (int e = 0; e < 4; ++e) { const size_t tk = (size_t)b * SEQ + (size_t)((CHN) * SC_C + 4 * w + e); SET.g[e] = GG[tk * D + h * 64 + lane]; SET.bon[e] = BON[tk * 32 + h]; } } while (0)
#define SEQ_BODY(CH, CUR, NXT, NX2) do { const int ch = (CH), cb = ch & 1; \
        const LAS bf16_t* bi = BI + cb * (64 * 104); LAS bf16_t* bo = BI + (cb ^ 1) * (64 * 104); LAS float* yl = YL + cb * (32 * 64); \
        if (ch + 2 < SC_NCH) SEQ_LOAD(NX2, ch + 2); \
        bf16x8 bfr[3]; _Pragma("unroll") for (int ks = 0; ks < 3; ++ks) bfr[ks] = *(const LAS bf16x8*)(bi + (16 * nt + fr) * 104 + 32 * ks + 8 * fq); \
        f32x4 acc[3]; _Pragma("unroll") for (int mi = 0; mi < 3; ++mi) { acc[mi] = (f32x4){0.f, 0.f, 0.f, 0.f}; \
            _Pragma("unroll") for (int ks = 0; ks < 3; ++ks) acc[mi] = __builtin_amdgcn_mfma_f32_16x16x32_bf16(CUR.af[mi][ks], bfr[ks], acc[mi], 0, 0, 0); } \
        _Pragma("unroll") for (int mi = 0; mi < 3; ++mi) { const int mt = 3 * mg + mi; \
            if (mt < 2) { _Pragma("unroll") for (int e = 0; e < 4; ++e) yl[(16 * mt + 4 * fq + e) * 64 + 16 * nt + fr] = acc[mi][e]; } \
            else *(LAS u32x2*)(bo + (16 * nt + fr) * 104 + 16 * (mt - 2) + 4 * fq) = pack4(acc[mi]); } \
        if (ch + 1 < SC_NCH) { bo[(vi4 + 0) * 104 + 64 + vs] = (bf16_t)(NXT.vimg.x & 0xffffu); bo[(vi4 + 1) * 104 + 64 + vs] = (bf16_t)(NXT.vimg.x >> 16); \
            bo[(vi4 + 2) * 104 + 64 + vs] = (bf16_t)(NXT.vimg.y & 0xffffu); bo[(vi4 + 3) * 104 + 64 + vs] = (bf16_t)(NXT.vimg.y >> 16); } \
        LBAR(); \
        _Pragma("unroll") for (int e = 0; e < 4; ++e) { const int s = 4 * w + e; const float y = yl[s * 64 + lane]; \
            const float mu = wave_sum_dpp(y) * (1.0f / 64.0f); const float dl = y - mu; const float var = wave_sum_dpp(dl * dl) * (1.0f / 64.0f); \
            const float yn = dl * rsqrtf(var + GN_EPS) * lg + lb; const float bonus = CUR.bon[e] * bf2f(bi[lane * 104 + 64 + s]); \
            YA[base + (size_t)(ch * SC_C + s) * D + lane] = (bf16_t)f2bf((yn + bonus) * bf2f(CUR.g[e])); } } while (0)
    SeqSet sa, sb, sc;
    SEQ_LOAD(sa, 0); SEQ_LOAD(sb, 1);
    for (int idx = tid; idx < 64 * 8; idx += 512) *(LAS u32x4*)(BI + (idx >> 3) * 104 + 8 * (idx & 7)) = (u32x4){0u, 0u, 0u, 0u};
    BI[(vi4 + 0) * 104 + 64 + vs] = (bf16_t)(sa.vimg.x & 0xffffu); BI[(vi4 + 1) * 104 + 64 + vs] = (bf16_t)(sa.vimg.x >> 16);
    BI[(vi4 + 2) * 104 + 64 + vs] = (bf16_t)(sa.vimg.y & 0xffffu); BI[(vi4 + 3) * 104 + 64 + vs] = (bf16_t)(sa.vimg.y >> 16);
    LBAR();
    for (int c0 = 0; c0 < SC_NCH; c0 += 3) {
        SEQ_BODY(c0, sa, sb, sc);
        if (c0 + 1 < SC_NCH) SEQ_BODY(c0 + 1, sb, sc, sa);
        if (c0 + 2 < SC_NCH) SEQ_BODY(c0 + 2, sc, sa, sb);
    }
    LBAR();
#undef SEQ_LOAD
#undef SEQ_BODY
}

__device__ __forceinline__ void p4_attn_task(const Ctx& c, int task) {
    unsigned char* ws = c.ws;
    const bf16_t* QR = (const bf16_t*)(ws + WS_QR); const bf16_t* KR = (const bf16_t*)(ws + WS_KR); const bf16_t* VR = (const bf16_t*)(ws + WS_VR);
    float* AO = (float*)(ws + WS_AO); float* LSE = (float*)(ws + WS_LSE);
    constexpr int VP = 280;
    LAS bf16_t* Vt = (LAS bf16_t*)c.lds;
    const int combo = task & 31, hh = (task >> 5) % 24, b = task / (32 * 24);
    const int g = hh >> 3, h = hh & 7;
    const int dil = g == 0 ? 1 : (g == 1 ? 4 : 16), nblk = 32 / dil;
    const int res = combo / nblk, blk = combo % nblk;
    int tid_ = c.tid; asm volatile("" : "+v"(tid_));
    const int tid = tid_, lane = tid & 63, w = __builtin_amdgcn_readfirstlane(tid >> 6);
    const int qq = lane & 15, g4 = lane >> 4, r0 = 16 * w;
    const size_t rowb = (size_t)(b * 24 + hh) * SEQ + (size_t)res * (SEQ / dil) + (size_t)blk * 128;
    bf16x8 qf[2], kf[9][2];
#pragma unroll
    for (int ks = 0; ks < 2; ++ks) qf[ks] = *(const bf16x8*)(QR + (rowb + r0 + qq) * 64 + 32 * ks + 8 * g4);
#pragma unroll
    for (int kt = 0; kt < 9; ++kt) { const bool kv = (blk > 0) || (w + kt >= 8);
#pragma unroll
        for (int ks = 0; ks < 2; ++ks) { kf[kt][ks] = (bf16x8){0, 0, 0, 0, 0, 0, 0, 0};
            if (kv) kf[kt][ks] = *(const bf16x8*)(KR + (rowb - 128 + 16 * (w + kt) + qq) * 64 + 32 * ks + 8 * g4); } }
    const int vki = tid >> 1, vdh = tid & 1;
    u32x4 vv[4];
    if (blk > 0 || vki >= 128) {
#pragma unroll
        for (int j = 0; j < 4; ++j) vv[j] = *(const u32x4*)(VR + (rowb - 128 + vki) * 64 + 32 * vdh + 8 * j); }
    else {
#pragma unroll
        for (int j = 0; j < 4; ++j) vv[j] = (u32x4){0u, 0u, 0u, 0u}; }
    __syncthreads();
#pragma unroll
    for (int j = 0; j < 4; ++j) { const unsigned wv[4] = {vv[j].x, vv[j].y, vv[j].z, vv[j].w};
#pragma unroll
        for (int e = 0; e < 8; ++e) Vt[(32 * vdh + 8 * j + e) * VP + vki] = (bf16_t)((wv[e >> 1] >> (16 * (e & 1))) & 0xffffu); }
    if (tid < 64) {
#pragma unroll
        for (int e = 0; e < 24; ++e) Vt[tid * VP + 256 + e] = 0; }
    f32x4 sc[10];
#pragma unroll
    for (int kt = 0; kt < 9; ++kt) { f32x4 a = (f32x4){0.f, 0.f, 0.f, 0.f};
#pragma unroll
        for (int ks = 0; ks < 2; ++ks) a = __builtin_amdgcn_mfma_f32_16x16x32_bf16(kf[kt][ks], qf[ks], a, 0, 0, 0);
        sc[kt] = a; }
    const int r = r0 + qq;
    float mx = -3.0e38f;
#pragma unroll
    for (int kt = 0; kt < 9; ++kt)
#pragma unroll
        for (int j = 0; j < 4; ++j) { const int ki = 16 * (w + kt) + 4 * g4 + j; const bool ok = (ki >= r) && (ki <= r + 128) && (blk > 0 || ki >= 128);
            const float sv = ok ? sc[kt][j] * 0.125f : -1.0e30f; sc[kt][j] = sv; mx = fmaxf(mx, sv); }
    mx = fmaxf(mx, __shfl_xor(mx, 16)); mx = fmaxf(mx, __shfl_xor(mx, 32));
    float den = 0.f;
#pragma unroll
    for (int kt = 0; kt < 9; ++kt)
#pragma unroll
        for (int j = 0; j < 4; ++j) { const float pexp = __expf(sc[kt][j] - mx); sc[kt][j] = pexp; den += pexp; }
    den += __shfl_xor(den, 16); den += __shfl_xor(den, 32);
    sc[9] = (f32x4){0.f, 0.f, 0.f, 0.f};
    __syncthreads();
    f32x4 oacc[4];
#pragma unroll
    for (int dt = 0; dt < 4; ++dt) oacc[dt] = (f32x4){0.f, 0.f, 0.f, 0.f};
#pragma unroll
    for (int cidx = 0; cidx < 5; ++cidx) {
        const f32x4 p0 = sc[2 * cidx], p1 = sc[2 * cidx + 1];
        u32x4 pw; pw.x = pk2(p0[0], p0[1]); pw.y = pk2(p0[2], p0[3]); pw.z = pk2(p1[0], p1[1]); pw.w = pk2(p1[2], p1[3]);
        const bf16x8 pf = __builtin_bit_cast(bf16x8, pw);
        const int kbase = 16 * (w + 2 * cidx) + 4 * g4;
#pragma unroll
        for (int dt = 0; dt < 4; ++dt) { const LAS bf16_t* vp = Vt + (16 * dt + qq) * VP + kbase;
            const u32x2 lo = *(const LAS u32x2*)vp, hi = *(const LAS u32x2*)(vp + 16);
            u32x4 vw; vw.x = lo.x; vw.y = lo.y; vw.z = hi.x; vw.w = hi.y;
            oacc[dt] = __builtin_amdgcn_mfma_f32_16x16x32_bf16(__builtin_bit_cast(bf16x8, vw), pf, oacc[dt], 0, 0, 0); }
    }
    const float inv = 1.0f / den;
    const size_t tok = (size_t)b * SEQ + (size_t)(blk * 128 + r) * dil + res;
#pragma unroll
    for (int dt = 0; dt < 4; ++dt) *(f32x4*)(AO + ((size_t)g * M + tok) * 512 + h * 64 + 16 * dt + 4 * g4) = oacc[dt] * inv;
    if (g4 == 0) LSE[((size_t)g * M + tok) * 8 + h] = mx + __logf(den);
}

constexpr int Q_ATT = 3072, Q_TOTAL = Q_ATT + MOE_CONV_GROUPS;
__device__ __forceinline__ void p4_queue(const Params& p, const Ctx& c, volatile LAS unsigned* qslot) {
    unsigned* qc = (unsigned*)(c.ws + WS_CTL) + CW_Q;
    for (;;) {
        __syncthreads();
        if (c.tid == 0) qslot[0] = __hip_atomic_fetch_add(qc, 1u, __ATOMIC_RELAXED, __HIP_MEMORY_SCOPE_AGENT);
        __syncthreads();
        const unsigned it = qslot[0];
        if (it >= (unsigned)Q_TOTAL) break;
        if (it < (unsigned)Q_ATT) p4_attn_task(c, (int)it); else conv_group(p, c, (int)it - Q_ATT);
    }
}

__device__ __forceinline__ void p5_post(const Params& p, const Ctx& c) {
    unsigned char* ws = c.ws;
    const float* AO = (const float*)(ws + WS_AO); const float* LSE = (const float*)(ws + WS_LSE);
    bf16_t* YB = (bf16_t*)(ws + WS_YB);
    const int gw = c.vcu * 8 + c.wave, NGW = c.G * 8, lane = c.lane;
    for (int it = gw; it < M * 8; it += NGW) {
        const int t = it >> 3, h = it & 7;
        const float l0 = LSE[((size_t)0 * M + t) * 8 + h], l1 = LSE[((size_t)1 * M + t) * 8 + h], l2 = LSE[((size_t)2 * M + t) * 8 + h];
        const float mxl = fmaxf(l0, fmaxf(l1, l2)); const float e0 = __expf(l0 - mxl), e1 = __expf(l1 - mxl), e2 = __expf(l2 - mxl); const float inv = 1.0f / (e0 + e1 + e2);
        const size_t o = (size_t)t * 512 + h * 64 + lane;
        const float v = (e0 * AO[o] + e1 * AO[(size_t)M * 512 + o] + e2 * AO[(size_t)2 * M * 512 + o]) * inv;
        YB[o] = (bf16_t)f2bf(v);
    }
}

__device__ __forceinline__ void ln_rows(const Ctx& c, const float* in, const float* gam, const float* bet, float* outf, bf16_t* outb, unsigned char* outq = nullptr) {
    const int gw = c.vcu * 8 + c.wave, NGW = c.G * 8, lane = c.lane;
    for (int m = gw; m < M; m += NGW) {
        const f32x4* xr = (const f32x4*)(in + (size_t)m * D) + lane;
        f32x4 v[8]; float s = 0.f;
#pragma unroll
        for (int j = 0; j < 8; ++j) { v[j] = xr[64 * j]; s += (v[j][0] + v[j][1]) + (v[j][2] + v[j][3]); }
        const float mean = wave_sum(s) * (1.0f / D); float s2 = 0.f;
#pragma unroll
        for (int j = 0; j < 8; ++j) { v[j] = v[j] - mean; s2 += (v[j][0] * v[j][0] + v[j][1] * v[j][1]) + (v[j][2] * v[j][2] + v[j][3] * v[j][3]); }
        const float rstd = rsqrtf(wave_sum(s2) * (1.0f / D) + LN_EPS);
#pragma unroll
        for (int j = 0; j < 8; ++j) { const int col = 4 * lane + 256 * j; const f32x4 gv = *(const f32x4*)(gam + col), bv = *(const f32x4*)(bet + col);
            const f32x4 o = v[j] * rstd * gv + bv;
            *(f32x4*)(outf + (size_t)m * D + col) = o;
            if (outb) { u32x2 w; w.x = pk2(o[0], o[1]); w.y = pk2(o[2], o[3]); *(u32x2*)(outb + (size_t)m * D + col) = w; }
            if (outq) *(unsigned*)(outq + (size_t)m * D + col) = pk4_fp8(o[0], o[1], o[2], o[3]); }
    }
}

__device__ __forceinline__ void p15_router(const Params& p, const Ctx& c) {
    unsigned char* ws = c.ws;
    const float* X2 = (const float*)(ws + WS_X2); const float* RW = p.in[I_RW]; const float* RB = p.in[I_RB];
    unsigned* cnt = (unsigned*)(ws + WS_CTL) + CW_CNT; int* LIST = (int*)(ws + WS_LIST); int* ROWI = (int*)(ws + WS_ROWI); float* TOPW = (float*)(ws + WS_TOPW);
    LAS float* scr = (LAS float*)(c.lds + c.wave * 8192);
    const int gw = c.vcu * 8 + c.wave, NGW = c.G * 8, lane = c.lane, li = lane & 31, lk = lane >> 5;
    for (int tb = gw; tb < M / 32; tb += NGW) {
        const int t0 = tb * 32;
        f32x16 acc;
#pragma unroll
        for (int j = 0; j < 16; ++j) acc[j] = 0.f;
        const float* xa = X2 + (size_t)(t0 + li) * D + 4 * lk;
        const float* wb = RW + (size_t)(4 * lk) * 32 + li;
        for (int kb = 0; kb < D / 8; ++kb) {
            const f32x4 a = *(const f32x4*)(xa + 8 * kb);
            const float b0 = wb[(size_t)(8 * kb + 0) * 32], b1 = wb[(size_t)(8 * kb + 1) * 32], b2 = wb[(size_t)(8 * kb + 2) * 32], b3 = wb[(size_t)(8 * kb + 3) * 32];
            acc = __builtin_amdgcn_mfma_f32_32x32x2f32(a[0], b0, acc, 0, 0, 0);
            acc = __builtin_amdgcn_mfma_f32_32x32x2f32(a[1], b1, acc, 0, 0, 0);
            acc = __builtin_amdgcn_mfma_f32_32x32x2f32(a[2], b2, acc, 0, 0, 0);
            acc = __builtin_amdgcn_mfma_f32_32x32x2f32(a[3], b3, acc, 0, 0, 0);
        }
        const float bias = RB[li];
#pragma unroll
        for (int rg = 0; rg < 16; ++rg) { const int row = (rg & 3) + 8 * (rg >> 2) + 4 * lk; scr[row * 33 + li] = acc[rg] + bias; }
        LDS_WAIT(); asm volatile("" ::: "memory");
        if (lane < 32) {
            float lv[32];
#pragma unroll
            for (int e = 0; e < 32; ++e) lv[e] = scr[lane * 33 + e];
            int id[4]; float tv[4];
#pragma unroll
            for (int k = 0; k < 4; ++k) { float best = -3.0e38f; int bi = 0;
#pragma unroll
                for (int e = 0; e < 32; ++e) { const bool tk = lv[e] > best; best = tk ? lv[e] : best; bi = tk ? e : bi; }
                id[k] = bi; tv[k] = best;
#pragma unroll
                for (int e = 0; e < 32; ++e) lv[e] = (e == bi) ? -3.0e38f : lv[e]; }
            const float e1 = __expf(tv[1] - tv[0]), e2 = __expf(tv[2] - tv[0]), e3 = __expf(tv[3] - tv[0]); const float inv = 1.0f / (1.0f + e1 + e2 + e3);
            const float wv[4] = {inv, e1 * inv, e2 * inv, e3 * inv};
            const int t = t0 + lane;
#pragma unroll
            for (int k = 0; k < 4; ++k) { const unsigned slot = __hip_atomic_fetch_add(cnt + id[k], 1u, __ATOMIC_RELAXED, __HIP_MEMORY_SCOPE_AGENT);
                LIST[(size_t)id[k] * CAP + slot] = t; ROWI[(size_t)t * 4 + k] = id[k] * CAP + (int)slot; TOPW[(size_t)t * 4 + k] = wv[k]; }
        }
        LDS_WAIT(); asm volatile("" ::: "memory");
    }
}

__device__ __forceinline__ void moe_table(const Ctx& c, LAS int* tab) {
    if (c.tid == 0) { unsigned* cnt = (unsigned*)(c.ws + WS_CTL) + CW_CNT; int ts = 0;
        for (int e = 0; e < NEXP; ++e) { const int n = (int)__hip_atomic_load(cnt + e, __ATOMIC_RELAXED, __HIP_MEMORY_SCOPE_AGENT); tab[e] = n; tab[32 + e] = ts; ts += (n + 255) >> 8; }
        tab[64] = ts; }
    __syncthreads();
}

__device__ __forceinline__ void p18_combine(const Params& p, const Ctx& c, const LAS int* tab) {
    unsigned char* ws = c.ws;
    const float* X2 = (const float*)(ws + WS_X2); const float* Y = (const float*)(ws + WS_Y); const int* ROWI = (const int*)(ws + WS_ROWI); const float* TOPW = (const float*)(ws + WS_TOPW);
    const float* gam = p.in[I_LN3G]; const float* bet = p.in[I_LN3B];
    const int gw = c.vcu * 8 + c.wave, NGW = c.G * 8, lane = c.lane;
    for (int m = gw; m < M; m += NGW) {
        f32x4 v[8];
        const f32x4* xr = (const f32x4*)(X2 + (size_t)m * D) + lane;
#pragma unroll
        for (int j = 0; j < 8; ++j) v[j] = xr[64 * j] * DN_ALPHA;
#pragma unroll
        for (int k = 0; k < 4; ++k) { const int ri = ROWI[(size_t)m * 4 + k]; const float gt = TOPW[(size_t)m * 4 + k]; const int e = ri >> 14, slot = ri & (CAP - 1);
            const f32x4* yr = (const f32x4*)(Y + ((size_t)tab[32 + e] * 256 + slot) * D) + lane;
#pragma unroll
            for (int j = 0; j < 8; ++j) v[j] = v[j] + yr[64 * j] * gt; }
        float s = 0.f;
#pragma unroll
        for (int j = 0; j < 8; ++j) s += (v[j][0] + v[j][1]) + (v[j][2] + v[j][3]);
        const float mean = wave_sum(s) * (1.0f / D); float s2 = 0.f;
#pragma unroll
        for (int j = 0; j < 8; ++j) { v[j] = v[j] - mean; s2 += (v[j][0] * v[j][0] + v[j][1] * v[j][1]) + (v[j][2] * v[j][2] + v[j][3] * v[j][3]); }
        const float rstd = rsqrtf(wave_sum(s2) * (1.0f / D) + LN_EPS);
#pragma unroll
        for (int j = 0; j < 8; ++j) { const int col = 4 * lane + 256 * j; const f32x4 gv = *(const f32x4*)(gam + col), bv = *(const f32x4*)(bet + col);
            *(f32x4*)(p.out + (size_t)m * D + col) = v[j] * rstd * gv + bv; }
    }
}

constexpr int NPHASE = 19;
__global__ void __launch_bounds__(512, 2) fwd(Params p) {
    extern __shared__ __attribute__((aligned(16))) unsigned char lds_raw[];
    LAS unsigned char* lds = (LAS unsigned char*)lds_raw;
    Ctx c; c.tid = threadIdx.x; c.lane = c.tid & 63; c.wave = __builtin_amdgcn_readfirstlane(c.tid >> 6); c.G = gridDim.x;
    { const int bx = blockIdx.x; c.vcu = (c.G % 8 == 0) ? (bx % 8) * (c.G / 8) + bx / 8 : bx; }
    c.lds = lds; c.ws = p.ws;
    unsigned char* ws = p.ws;
    volatile LAS unsigned* MISC = (volatile LAS unsigned*)(lds + MISC_OFF);
    LAS int* tab = (LAS int*)(lds + MISC_OFF + 1024);
    if (c.tid < 64) MISC[c.tid] = 0u;
    __syncthreads();
    unsigned* ctl = (unsigned*)(ws + WS_CTL);
    XcdBarrier bar; bar.bar = ctl + CW_BAR + p.li * XCD_BAR_WORDS; bar.x = 0; bar.st = MISC + 8;
    if (N_LAUNCH_MODE == 1) bar = xcd_barrier_post(ctl + CW_BAR + p.li * XCD_BAR_WORDS, MISC + 8);
    const int lo = p.ph_lo, hi = p.ph_hi, bx = blockIdx.x;
#ifndef PHMASK
#define PHMASK 0xFFFFFFFFu
#endif
#define IN(k) (((PHMASK >> (k)) & 1u) && lo <= (k) && (k) < hi)
#define SEAM(k) do { if (N_LAUNCH_MODE == 1 && IN((k) + 1)) xcd_barrier(bar); } while (0)

    if (IN(0)) { p0_prologue(p, c); SEAM(0); }

    if (IN(1)) {
        pg8::StaticOrder S; S.init(ws + WS_XB, ws + WS_WIN, M, PC, D, D, c.G, bx);
        pg8::EpiBf16 E{(bf16_t*)(ws + WS_PROJ), PC, 1.0f};
        pg8::gemm_phase<pg8::EpiBf16, pg8::StaticOrder>(lds, pg8::Gemm{D, D, D}, S, E);
        SEAM(1);
    }
    if (IN(2)) { p2_prep(p, c); SEAM(2); }

    if (IN(3)) {
#ifndef P3M
#define P3M 15
#endif
        if (P3M & 1) { pg8::StaticOrder S; S.init(ws + WS_LIN, ws + WS_WUP, M, D, 768, 256, c.G, bx);
          pg8::EpiDecay E{(float*)(ws + WS_DEC), p.in[I_W0]};
          pg8::gemm_phase<pg8::EpiDecay, pg8::StaticOrder>(lds, pg8::Gemm{256, 768, 256}, S, E); }
        if (P3M & 2) { pg8::StaticOrder S; S.init(ws + WS_LIN + 512, ws + WS_AUP, M, D, 768, 256, c.G, bx);
          pg8::EpiIclr E{p.in[I_A0], p.in[I_KK], p.in[I_KA], (const bf16_t*)(ws + WS_KZ), (const float*)(ws + WS_KNORM), (bf16_t*)(ws + WS_KP), (bf16_t*)(ws + WS_AN), (bf16_t*)(ws + WS_BB)};
          pg8::gemm_phase<pg8::EpiIclr, pg8::StaticOrder>(lds, pg8::Gemm{256, 768, 256}, S, E); }
        if (P3M & 4) { pg8::StaticOrder S; S.init(ws + WS_LIN + 1024, ws + WS_GUP, M, D, 768, 256, c.G, bx);
          pg8::EpiBf16 E{(bf16_t*)(ws + WS_GG), D, 1.0f};
          pg8::gemm_phase<pg8::EpiBf16, pg8::StaticOrder>(lds, pg8::Gemm{256, 768, 256}, S, E); }
        if (P3M & 8) { pg8::StaticOrder S; S.init(ws + WS_MEMB, ws + WS_WKV, 1024, 2 * D, D, D, c.G, bx);
          pg8::EpiKV E{(bf16_t*)(ws + WS_KB), (bf16_t*)(ws + WS_VT)};
          pg8::gemm_phase<pg8::EpiKV, pg8::StaticOrder>(lds, pg8::Gemm{D, D, D}, S, E); }
        SEAM(3);
    }
    if (IN(4)) {
        p4_pre(p, c);
        xcd_barrier(bar);
        for (int bh = c.vcu; bh < 128; bh += c.G) p4_seq(p, c, bh);
        p4_queue(p, c, MISC + 16);
        SEAM(4);
    }
    if (IN(5)) { p5_post(p, c); }

    if (IN(6)) {
        pg8::StaticOrder S; S.init(ws + WS_YA, ws + WS_PA, M, D, D, D, c.G, bx);
        pg8::EpiGateA E{(const bf16_t*)(ws + WS_PROJ), (float*)(ws + WS_TMP)};
        pg8::gemm_phase<pg8::EpiGateA, pg8::StaticOrder>(lds, pg8::Gemm{D, D, D}, S, E);
        SEAM(6);
    }
    if (IN(7)) {
        pg8::StaticOrder S; S.init(ws + WS_YB, ws + WS_PB, M, D, 512, 512, c.G, bx);
        pg8::EpiGateB E{(const bf16_t*)(ws + WS_PROJ), (const float*)(ws + WS_TMP), (bf16_t*)(ws + WS_MERGED)};
        pg8::gemm_phase<pg8::EpiGateB, pg8::StaticOrder>(lds, pg8::Gemm{512, 512, 512}, S, E);
        SEAM(7);
    }
    if (IN(8)) {
        pg8::StaticOrder S; S.init(ws + WS_MERGED, ws + WS_WOUT, M, D, D, D, c.G, bx);
        pg8::EpiF32 E{(float*)(ws + WS_T1), D, nullptr, 0, p.in[I_X], DN_ALPHA};
        pg8::gemm_phase<pg8::EpiF32, pg8::StaticOrder>(lds, pg8::Gemm{D, D, D}, S, E);
        SEAM(8);
    }
    if (IN(9)) { ln_rows(c, (const float*)(ws + WS_T1), p.in[I_LN1G], p.in[I_LN1B], (float*)(ws + WS_X1), (bf16_t*)(ws + WS_X1B)); SEAM(9); }

    if (IN(10)) {
        pg8::StaticOrder S; S.init(ws + WS_X1B, ws + WS_WQ, M, D, D, D, c.G, bx);
        pg8::EpiBf16 E{(bf16_t*)(ws + WS_Q), D, 0.04419417382415922f};
        pg8::gemm_phase<pg8::EpiBf16, pg8::StaticOrder>(lds, pg8::Gemm{D, D, D}, S, E);
        SEAM(10);
    }
    if (IN(11)) {
        ScoreOrder S{(const char*)(ws + WS_Q), (const char*)(ws + WS_KB), c.G, bx};
        pg8::EpiSoftmax E{(bf16_t*)(ws + WS_PP)};
        pg8::gemm_phase<pg8::EpiSoftmax, ScoreOrder, false>(lds, pg8::Gemm{512, D, D}, S, E);
        SEAM(11);
    }
    if (IN(12)) {
        PvOrder S{(const char*)(ws + WS_PP), (const char*)(ws + WS_VT), c.G, bx};
        pg8::EpiBf16 E{(bf16_t*)(ws + WS_OC), D, 1.0f};
        pg8::gemm_phase<pg8::EpiBf16, PvOrder>(lds, pg8::Gemm{256, 256, 256}, S, E);
        SEAM(12);
    }
    if (IN(13)) {
        pg8::StaticOrder S; S.init(ws + WS_OC, ws + WS_WO, M, D, D, D, c.G, bx);
        pg8::EpiF32 E{(float*)(ws + WS_T2), D, nullptr, 0, (const float*)(ws + WS_X1), DN_ALPHA};
        pg8::gemm_phase<pg8::EpiF32, pg8::StaticOrder>(lds, pg8::Gemm{D, D, D}, S, E);
        SEAM(13);
    }
    if (IN(14)) { ln_rows(c, (const float*)(ws + WS_T2), p.in[I_LN2G], p.in[I_LN2B], (float*)(ws + WS_X2), nullptr, ws + WS_X2B); SEAM(14); }
    if (IN(15)) { p15_router(p, c); SEAM(15); }

    if (IN(16)) {
        moe_table(c, tab);
        MoeOrder<true, 16> S{tab, (const char*)(ws + WS_X2B), (const char*)(ws + WS_W1), (const int*)(ws + WS_LIST), (size_t)4096 * D, D, c.G, bx};
        pg8::EpiSwiglu E{p.in[I_B1], (bf16_t*)(ws + WS_H)};
        pg8::gemm_phase<pg8::EpiSwiglu, MoeOrder<true, 16>, true, true>(lds, pg8::Gemm{D, D, D}, S, E);
        SEAM(16);
    }
    if (IN(17)) {
        moe_table(c, tab);
        MoeOrder<false, 8> S{tab, (const char*)(ws + WS_H), (const char*)(ws + WS_W2), (const int*)(ws + WS_LIST), (size_t)D * DFF, DFF, c.G, bx};
        pg8::EpiF32 E{(float*)(ws + WS_Y), D, p.in[I_B2], D, nullptr, 0.f};
        pg8::gemm_phase<pg8::EpiF32, MoeOrder<false, 8>, true, true>(lds, pg8::Gemm{DFF, DFF, DFF}, S, E);
        SEAM(17);
    }
    if (IN(18)) { moe_table(c, tab); p18_combine(p, c, tab); }
#undef IN
#undef SEAM
}

extern "C" void kernel_launch(void* const* d_in, const int* in_sizes, int n_in, void* d_out, int out_size, void* d_ws, size_t ws_size, hipStream_t stream) {
    static int grid = 0;
    if (grid == 0) {
        if (n_in != 32 || out_size != M * D || ws_size < WS_END) { fprintf(stderr, "kernel_launch: expected 32 inputs, %d outputs, >= %zu bytes of workspace; got %d, %d, %zu\n", M * D, (size_t)WS_END, n_in, out_size, ws_size); grid = -1; return; }
        int dev = 0, cus = 0, per_cu = 0;
        if (hipGetDevice(&dev) != hipSuccess || hipDeviceGetAttribute(&cus, hipDeviceAttributeMultiprocessorCount, dev) != hipSuccess) { grid = -1; return; }
        if (hipFuncSetAttribute((const void*)fwd, hipFuncAttributeMaxDynamicSharedMemorySize, LDS_BYTES) != hipSuccess) { fprintf(stderr, "kernel_launch: hipFuncSetAttribute failed\n"); grid = -1; return; }
        if (hipOccupancyMaxActiveBlocksPerMultiprocessor(&per_cu, (const void*)fwd, 512, LDS_BYTES) != hipSuccess || per_cu < 1) fprintf(stderr, "kernel_launch: occupancy query reports %d\n", per_cu);
        (void)hipGetLastError();
        grid = cus;
        if (grid != 256) fprintf(stderr, "kernel_launch: %d CUs; this kernel is built for 256\n", grid);
    }
    if (grid < 0) return;
    (void)hipMemsetAsync((char*)d_ws + WS_CTL, 0, CTL_ZERO_BYTES, stream);
    Params p{};
    for (int i = 0; i < 32; ++i) p.in[i] = (const float*)d_in[i];
    p.out = (float*)d_out; p.ws = (unsigned char*)d_ws;
#if defined(TIMING_REPEAT_LO)
    { const int cuts[4][2] = {{0, TIMING_REPEAT_HI}, {TIMING_REPEAT_LO, TIMING_REPEAT_HI}, {TIMING_REPEAT_HI, NPHASE}, {0, 0}};
      for (int li = 0; li < 3; ++li) { if (cuts[li][0] >= cuts[li][1]) continue; p.ph_lo = cuts[li][0]; p.ph_hi = cuts[li][1]; p.li = li; hipLaunchKernelGGL(fwd, dim3(grid), dim3(512), LDS_BYTES, stream, p); } }
#else
    if (N_LAUNCH_MODE == 1) { p.ph_lo = 0; p.ph_hi = NPHASE; hipLaunchKernelGGL(fwd, dim3(grid), dim3(512), LDS_BYTES, stream, p); }
    else for (int k = 0; k < NPHASE; ++k) { p.ph_lo = k; p.ph_hi = k + 1; hipLaunchKernelGGL(fwd, dim3(grid), dim3(512), LDS_BYTES, stream, p); }
#endif
}
```

```cpp
#include <hip/hip_runtime.h>
#include <cstdio>
#include <cstdint>

#define LAS __attribute__((address_space(3)))
#define GAS __attribute__((address_space(1)))
typedef unsigned short bf16_t;
typedef short bf16x8 __attribute__((ext_vector_type(8)));
typedef float f32x4 __attribute__((ext_vector_type(4)));
typedef float f32x2 __attribute__((ext_vector_type(2)));
typedef float f32x16 __attribute__((ext_vector_type(16)));
typedef unsigned u32x4 __attribute__((ext_vector_type(4)));
typedef unsigned u32x2 __attribute__((ext_vector_type(2)));

#ifndef N_LAUNCH_MODE
#define N_LAUNCH_MODE 1
#endif

constexpr int M = 16384, D = 2048, SEQ = 4096, NBATCH = 4;
constexpr int RWC = 6592;
constexpr int PC = 15360;
constexpr int ATT0 = 6656, GATE0 = 11264;
constexpr int NEXP = 32, DFF = 2048, CAP = 16384;
constexpr int HROWS = 65536 + 32 * 256;
constexpr float LN_EPS = 1e-5f, GN_EPS = 64e-5f;
constexpr float DN_ALPHA = 1.189207115002721f;

__device__ __forceinline__ float bf2f(unsigned v) { return __uint_as_float(v << 16); }
__device__ __forceinline__ unsigned f2bf(float f) { unsigned u = __float_as_uint(f); return (u + 0x7fffu + ((u >> 16) & 1u)) >> 16; }
__device__ __forceinline__ unsigned pk2(float lo, float hi) { return f2bf(lo) | (f2bf(hi) << 16); }
typedef int v4i __attribute__((ext_vector_type(4)));
typedef int v8i __attribute__((ext_vector_type(8)));
__device__ __forceinline__ unsigned pk4_fp8(float a, float b, float c, float d) { int r = __builtin_amdgcn_cvt_pk_fp8_f32(a, b, 0, false); r = __builtin_amdgcn_cvt_pk_fp8_f32(c, d, r, true); return (unsigned)r; }
__device__ __forceinline__ float sigmoidf_(float x) { return 1.0f / (1.0f + __expf(-x)); }
__device__ __forceinline__ float wave_sum(float v) {
#pragma unroll
    for (int o = 1; o < 64; o <<= 1) v += __shfl_xor(v, o);
    return v;
}
#define LDS_WAIT() asm volatile("s_waitcnt lgkmcnt(0)" ::: "memory")
#define VM_WAIT() asm volatile("s_waitcnt vmcnt(0)" ::: "memory")

namespace pg8 {
#define PG8_LAS __attribute__((address_space(3)))
constexpr int BM = 256, BK = 64, HALF = 128, HTB = HALF * BK * 2, STAGE_BYTES = 8 * HTB, NXCD = 8, WGM = 8;

__host__ __device__ __forceinline__ int lds_byte(int r, int c) { const int st = (r >> 4) * 2 + (c >> 5), rr = r & 15, cc = c & 31, ob = rr * 64 + cc * 2; return st * 1024 + (ob ^ (((ob >> 9) & 1) << 5)); }
__host__ __device__ __forceinline__ void stage_rc(int b, int& R, int& C) { const int st = b / 1024, sb = b % 1024, swz = sb ^ (((sb >> 9) & 1) << 5); R = (st >> 1) * 16 + swz / 64; C = (st & 1) * 32 + (swz % 64) / 2; }
__host__ __device__ __forceinline__ int perm32(int rho) { const int n = rho >> 4, i = rho & 15; return 8 * (i >> 2) + 4 * n + (i & 3); }

struct Unit { const char* A; const char* B; int orow, ocol, aux, aux2, valid; };
struct Gemm { int K, lda, ldb; };

struct StaticOrder {
    static constexpr bool GATHER = false;
    const char* A; const char* Bt; size_t ta, tb;
    int nM, nN, nwg, G, c;
    __device__ void init(const void* A_, const void* Bt_, int M_, int N_, int lda, int ldb, int G_, int c_) { A = (const char*)A_; Bt = (const char*)Bt_; ta = (size_t)BM * lda * 2; tb = (size_t)BM * ldb * 2; nM = M_ / BM; nN = N_ / BM; nwg = nM * nN; G = G_; c = c_; }
    __device__ bool next(int i, Unit& u) const {
        const long L = (long)i * G + c; if (c < 0 || L >= nwg) return false;
        int wgid = (int)L; { const int q = nwg / NXCD, r = nwg % NXCD, xcd = wgid % NXCD, off = wgid / NXCD; wgid = (xcd < r ? xcd * (q + 1) : r * (q + 1) + (xcd - r) * q) + off; }
        const int nig = WGM * nN, gid = wgid / nig, fm = gid * WGM, gsz = (nM - fm) < WGM ? (nM - fm) : WGM;
        const int pm = fm + ((wgid % nig) % gsz), pn = (wgid % nig) / gsz;
        u.A = A + (size_t)pm * ta; u.B = Bt + (size_t)pn * tb; u.orow = pm * BM; u.ocol = pn * BM; u.aux = 0; u.aux2 = 0; u.valid = BM; return true;
    }
    __device__ __forceinline__ const int* rows(const Unit&) const { return nullptr; }
};

__device__ __forceinline__ unsigned cvt_pk_bf16(float lo, float hi) { unsigned r; asm volatile("v_cvt_pk_bf16_f32 %0, %1, %2" : "=v"(r) : "v"(lo), "v"(hi)); return r; }

template <class Epi, class Sched, bool ALIGN_EPI = true, bool FP8 = false>
__device__ __forceinline__ void gemm_phase(PG8_LAS unsigned char* lds, const Gemm g, const Sched& S, const Epi& E) {
    const int tid = threadIdx.x, wid = __builtin_amdgcn_readfirstlane(tid >> 6), lane = tid & 63, wr = wid >> 2, wc = wid & 3, fr = lane & 15, fq = lane >> 4;
    constexpr int ES = FP8 ? 1 : 2;
    int sclW = 0, sclX = 0;
    if constexpr (FP8) { asm volatile("v_mov_b32 %0, 0x79797979\n\tv_mov_b32 %1, 0x7f7f7f7f" : "=v"(sclW), "=v"(sclX)); }
    const int K = g.K, nt = K * ES / (BK * 2);
    unsigned voffA[2], voffB[2]; int Rr[2], Cc[2];
#pragma unroll
    for (int i = 0; i < 2; ++i) { int R, C; stage_rc(tid * 16 + i * 8192, R, C); const int Rb = Epi::PERM ? ((R & ~31) + perm32(R & 31)) : R; Rr[i] = R; Cc[i] = C;
        voffA[i] = (unsigned)(R * g.lda * ES + C * 2); voffB[i] = (unsigned)(Rb * g.ldb * ES + C * 2); }
    const size_t kstep = (size_t)(BK * 2);
    const size_t hstepA = (size_t)HALF * g.lda * ES, hstepB = (size_t)HALF * g.ldb * ES;
    const unsigned ldsw = (unsigned)wid * 1024u;
    const int aoff = lds_byte(wr * 64 + fr, fq * 8), boff = lds_byte(wc * 32 + fr, fq * 8);
    unsigned vAc[2][2], vAn[2][2];
#define PG8_SA(b, h) (((b) * 2 + (h)) * HTB)
#define PG8_SB(b, h) ((4 + (b) * 2 + (h)) * HTB)
#define PG8_STAGE(bufoff, gbase, voff) do { _Pragma("unroll") for (int _i = 0; _i < 2; ++_i) \
        __builtin_amdgcn_global_load_lds((const unsigned*)((const char*)(gbase) + (voff)[_i]), (PG8_LAS unsigned*)(lds + (bufoff) + ldsw + _i * 8192), 16, 0, 0); } while (0)
#define PG8_STAGE_A(bufoff, kbase, h, nx) do { if constexpr (Sched::GATHER) { unsigned _v[2] = {(nx) ? vAn[h][0] : vAc[h][0], (nx) ? vAn[h][1] : vAc[h][1]}; PG8_STAGE(bufoff, kbase, _v); } \
        else { PG8_STAGE(bufoff, (kbase) + (h) * hstepA, voffA); } } while (0)
#define PG8_GOFF(u, v) do { const int* _rw = S.rows(u); _Pragma("unroll") for (int _h = 0; _h < 2; ++_h) _Pragma("unroll") for (int _i = 0; _i < 2; ++_i) { const int _r = Rr[_i] + _h * HALF; \
        const int _tk = _r < (u).valid ? _rw[_r] : 0; v[_h][_i] = (unsigned)(_tk * g.lda * ES + Cc[_i] * 2); } } while (0)
#define PG8_LDA(dst, b, h) do { _Pragma("unroll") for (int m = 0; m < 4; ++m) _Pragma("unroll") for (int k = 0; k < 2; ++k) dst[m][k] = *(const PG8_LAS bf16x8*)(lds + PG8_SA(b, h) + aoff + m * 2048 + k * 1024); } while (0)
#define PG8_LDB(dst, b, h) do { _Pragma("unroll") for (int n = 0; n < 2; ++n) _Pragma("unroll") for (int k = 0; k < 2; ++k) dst[n][k] = *(const PG8_LAS bf16x8*)(lds + PG8_SB(b, h) + boff + n * 2048 + k * 1024); } while (0)
#define PG8_MMA(ai, bj, At, Bt) do { __builtin_amdgcn_s_setprio(1); _Pragma("unroll") for (int m = 0; m < 4; ++m) _Pragma("unroll") for (int n = 0; n < 2; ++n) { \
        if constexpr (FP8) { const v4i _b0 = __builtin_bit_cast(v4i, Bt[n][0]), _b1 = __builtin_bit_cast(v4i, Bt[n][1]), _a0 = __builtin_bit_cast(v4i, At[m][0]), _a1 = __builtin_bit_cast(v4i, At[m][1]); \
            const v8i _bb = __builtin_shufflevector(_b0, _b1, 0, 1, 2, 3, 4, 5, 6, 7), _aa = __builtin_shufflevector(_a0, _a1, 0, 1, 2, 3, 4, 5, 6, 7); \
            asm volatile("v_mfma_scale_f32_16x16x128_f8f6f4 %0, %1, %2, %0, %3, %4 op_sel_hi:[0,0,0]" : "+v"(acc[ai][bj][m][n]) : "v"(_bb), "v"(_aa), "v"(sclW), "v"(sclX)); } \
        else { _Pragma("unroll") for (int k = 0; k < 2; ++k) acc[ai][bj][m][n] = __builtin_amdgcn_mfma_f32_16x16x32_bf16(Bt[n][k], At[m][k], acc[ai][bj][m][n], 0, 0, 0); } } \
        __builtin_amdgcn_s_setprio(0); } while (0)
#define PG8_WAIT_V(n) asm volatile("s_waitcnt vmcnt(" #n ")" ::: "memory")
#define PG8_WAIT_L(n) asm volatile("s_waitcnt lgkmcnt(" #n ")" ::: "memory")
#define PG8_BAR __builtin_amdgcn_s_barrier()
#define PG8_SCHED __builtin_amdgcn_sched_barrier(0)
    Unit cur, nxt; int ui = 0;
    if (!S.next(0, cur)) return;
    f32x4 acc[2][2][4][2];
#pragma unroll
    for (int a = 0; a < 2; ++a)
#pragma unroll
        for (int b = 0; b < 2; ++b)
#pragma unroll
            for (int m = 0; m < 4; ++m)
#pragma unroll
                for (int n = 0; n < 2; ++n) acc[a][b][m][n] = (f32x4){0.f, 0.f, 0.f, 0.f};
    bf16x8 At[4][2], B0[2][2], B1[2][2];
    const char* cA = cur.A; const char* cB = cur.B;
    if constexpr (Sched::GATHER) { PG8_GOFF(cur, vAc); PG8_WAIT_V(0); }
    PG8_STAGE(PG8_SB(0, 0), cB, voffB); PG8_STAGE(PG8_SB(0, 1), cB + hstepB, voffB); PG8_STAGE_A(PG8_SA(0, 0), cA, 0, false); PG8_STAGE_A(PG8_SA(0, 1), cA, 1, false);
    if (wr == 1) PG8_BAR;
    PG8_WAIT_V(2); PG8_BAR;
    PG8_STAGE(PG8_SB(1, 0), cB + kstep, voffB); PG8_STAGE_A(PG8_SA(1, 0), cA + kstep, 0, false); PG8_STAGE(PG8_SB(1, 1), cB + hstepB + kstep, voffB);
    PG8_WAIT_V(6); PG8_BAR;
    for (;;) {
        const bool has_next = S.next(ui + 1, nxt);
        const char* nA = has_next ? nxt.A : cA; const char* nB = has_next ? nxt.B : cB;
        if constexpr (Sched::GATHER) { if (has_next) { PG8_GOFF(nxt, vAn); } else {
#pragma unroll
            for (int h = 0; h < 2; ++h)
#pragma unroll
                for (int i = 0; i < 2; ++i) vAn[h][i] = vAc[h][i]; } }
#pragma nounroll
        for (int t = 0; t < nt; t += 2) {
            const bool last = (t == nt - 2);
            const char* a1 = cA + (size_t)(t + 1) * kstep;
            const char* a2 = last ? nA : cA + (size_t)(t + 2) * kstep; const char* b2 = last ? nB : cB + (size_t)(t + 2) * kstep;
            const char* a3 = a2 + kstep; const char* b3 = b2 + kstep;
            PG8_LDB(B0, 0, 0); PG8_LDB(B1, 0, 1); PG8_SCHED; PG8_LDA(At, 0, 0); PG8_STAGE_A(PG8_SA(1, 1), a1, 1, false);
            PG8_WAIT_V(8); PG8_WAIT_L(0); PG8_BAR; PG8_MMA(0, 0, At, B0); PG8_MMA(0, 1, At, B1); PG8_BAR; PG8_SCHED;
            PG8_LDA(At, 0, 1); PG8_STAGE(PG8_SB(0, 0), b2, voffB); PG8_STAGE(PG8_SB(0, 1), b2 + hstepB, voffB); PG8_STAGE_A(PG8_SA(0, 0), a2, 0, last);
            PG8_WAIT_V(8); PG8_WAIT_L(0); PG8_BAR; PG8_MMA(1, 0, At, B0); PG8_MMA(1, 1, At, B1); PG8_BAR; PG8_SCHED;
            PG8_LDB(B0, 1, 0); PG8_LDB(B1, 1, 1); PG8_SCHED; PG8_LDA(At, 1, 0); PG8_STAGE_A(PG8_SA(0, 1), a2, 1, last);
            PG8_WAIT_V(8); PG8_WAIT_L(0); PG8_BAR; PG8_MMA(0, 0, At, B0); PG8_MMA(0, 1, At, B1); PG8_BAR; PG8_SCHED;
            PG8_LDA(At, 1, 1); PG8_STAGE(PG8_SB(1, 0), b3, voffB); PG8_STAGE(PG8_SB(1, 1), b3 + hstepB, voffB); PG8_STAGE_A(PG8_SA(1, 0), a3, 0, last);
            PG8_WAIT_V(8); PG8_WAIT_L(0); PG8_BAR; PG8_MMA(1, 0, At, B0); PG8_MMA(1, 1, At, B1); PG8_BAR; PG8_SCHED;
        }
        if constexpr (ALIGN_EPI) { if (wr == 0) PG8_BAR; }
        if constexpr (FP8) asm volatile("s_nop 15\n\ts_nop 15" ::: "memory");
        if constexpr (!Epi::AFTER_DRAIN) { int l2 = lane; asm volatile("" : "+v"(l2));
            E(acc, cur, wr, wc, l2 & 15, l2 >> 4); }
        if (!has_next) break;
#pragma unroll
        for (int a = 0; a < 2; ++a)
#pragma unroll
            for (int b = 0; b < 2; ++b)
#pragma unroll
                for (int m = 0; m < 4; ++m)
#pragma unroll
                    for (int n = 0; n < 2; ++n) acc[a][b][m][n] = (f32x4){0.f, 0.f, 0.f, 0.f};
        cur = nxt; cA = nA; cB = nB; ++ui;
        if constexpr (Sched::GATHER) {
#pragma unroll
            for (int h = 0; h < 2; ++h)
#pragma unroll
                for (int i = 0; i < 2; ++i) vAc[h][i] = vAn[h][i]; }
        if constexpr (ALIGN_EPI) { if (wr == 1) PG8_BAR; }
    }
    PG8_WAIT_V(0);
    if constexpr (!ALIGN_EPI) { if (wr == 0) PG8_BAR; }
    PG8_BAR;
    if constexpr (Epi::AFTER_DRAIN) { E.fused(acc, cur, wr, wc, fr, fq, lds, wid, lane); }
#undef PG8_SA
#undef PG8_SB
#undef PG8_STAGE
#undef PG8_STAGE_A
#undef PG8_GOFF
#undef PG8_LDA
#undef PG8_LDB
#undef PG8_MMA
#undef PG8_WAIT_V
#undef PG8_WAIT_L
#undef PG8_BAR
#undef PG8_SCHED
}

#define EPI_LOOP_AI_M for (int ai = 0; ai < 2; ++ai) _Pragma("unroll") for (int m = 0; m < 4; ++m)

struct EpiF32 {
    static constexpr bool PERM = false, AFTER_DRAIN = false;
    float* C; int ldc; const float* bias; int bstride; const float* res; float alpha;
    __device__ __forceinline__ void operator()(const f32x4 (&acc)[2][2][4][2], const Unit& u, int wr, int wc, int fr, int fq) const {
        const int row0 = u.orow + wr * 64 + fr, col0 = u.ocol + wc * 32 + 4 * fq;
        f32x4 bv[2][2];
#pragma unroll
        for (int bj = 0; bj < 2; ++bj)
#pragma unroll
            for (int n = 0; n < 2; ++n) bv[bj][n] = bias ? *(const f32x4*)(bias + (size_t)u.aux * bstride + col0 + bj * HALF + n * 16) : (f32x4){0.f, 0.f, 0.f, 0.f};
#pragma unroll
        EPI_LOOP_AI_M { const size_t off = (size_t)(row0 + ai * HALF + m * 16) * ldc + col0;
#pragma unroll
            for (int bj = 0; bj < 2; ++bj)
#pragma unroll
                for (int n = 0; n < 2; ++n) { f32x4 v = acc[ai][bj][m][n] + bv[bj][n];
                    if (res) { const f32x4 rv = *(const f32x4*)(res + off + bj * HALF + n * 16); v = v + rv * alpha; }
                    *(f32x4*)(C + off + bj * HALF + n * 16) = v; }
            asm volatile("" ::: "memory"); }
    }
};
struct EpiBf16 {
    static constexpr bool PERM = true, AFTER_DRAIN = false;
    bf16_t* O; int ldc; float scale;
    __device__ __forceinline__ void operator()(const f32x4 (&acc)[2][2][4][2], const Unit& u, int wr, int wc, int fr, int fq) const {
        const int row0 = u.orow + wr * 64 + fr, col0 = u.ocol + wc * 32 + 8 * fq;
#pragma unroll
        EPI_LOOP_AI_M { bf16_t* rowp = O + (size_t)(row0 + ai * HALF + m * 16) * ldc + col0;
#pragma unroll
            for (int bj = 0; bj < 2; ++bj) { const f32x4 v0 = acc[ai][bj][m][0] * scale, v1 = acc[ai][bj][m][1] * scale;
                u32x4 w; w.x = cvt_pk_bf16(v0[0], v0[1]); w.y = cvt_pk_bf16(v0[2], v0[3]); w.z = cvt_pk_bf16(v1[0], v1[1]); w.w = cvt_pk_bf16(v1[2], v1[3]);
                *(u32x4*)(rowp + bj * HALF) = w; } }
    }
};
struct EpiBf16Bias {
    static constexpr bool PERM = true, AFTER_DRAIN = false;
    bf16_t* O; int ldc; const float* bias; int bstride;
    __device__ __forceinline__ void operator()(const f32x4 (&acc)[2][2][4][2], const Unit& u, int wr, int wc, int fr, int fq) const {
        const int row0 = u.orow + wr * 64 + fr, col0 = u.ocol + wc * 32 + 8 * fq;
        f32x4 bv[2][2];
#pragma unroll
        for (int bj = 0; bj < 2; ++bj)
#pragma unroll
            for (int n = 0; n < 2; ++n) bv[bj][n] = *(const f32x4*)(bias + (size_t)u.aux * bstride + col0 + bj * HALF + 4 * n);
#pragma unroll
        EPI_LOOP_AI_M { bf16_t* rowp = O + (size_t)(row0 + ai * HALF + m * 16) * ldc + col0;
#pragma unroll
            for (int bj = 0; bj < 2; ++bj) { const f32x4 v0 = acc[ai][bj][m][0] + bv[bj][0], v1 = acc[ai][bj][m][1] + bv[bj][1];
                u32x4 w; w.x = cvt_pk_bf16(v0[0], v0[1]); w.y = cvt_pk_bf16(v0[2], v0[3]); w.z = cvt_pk_bf16(v1[0], v1[1]); w.w = cvt_pk_bf16(v1[2], v1[3]);
                *(u32x4*)(rowp + bj * HALF) = w; } }
    }
};
struct EpiKV {
    static constexpr bool PERM = true, AFTER_DRAIN = false;
    bf16_t* KB; bf16_t* VT;
    __device__ __forceinline__ void operator()(const f32x4 (&acc)[2][2][4][2], const Unit& u, int wr, int wc, int fr, int fq) const {
        const int row0 = u.orow + wr * 64 + fr, col0 = u.ocol + wc * 32 + 8 * fq;
#pragma unroll
        EPI_LOOP_AI_M { const int row = row0 + ai * HALF + m * 16;
#pragma unroll
            for (int bj = 0; bj < 2; ++bj) { const f32x4 v0 = acc[ai][bj][m][0], v1 = acc[ai][bj][m][1]; const int col = col0 + bj * HALF;
                if (u.ocol < 2048) { u32x4 w; w.x = cvt_pk_bf16(v0[0], v0[1]); w.y = cvt_pk_bf16(v0[2], v0[3]); w.z = cvt_pk_bf16(v1[0], v1[1]); w.w = cvt_pk_bf16(v1[2], v1[3]);
                    *(u32x4*)(KB + (size_t)row * 2048 + col) = w; }
                else { const int b = row >> 8, key = row & 255, c = col - 2048, h = c >> 9, d = c & 511; bf16_t* p = VT + ((size_t)((b * 4 + h) * 512 + d)) * 256 + key;
#pragma unroll
                    for (int j = 0; j < 4; ++j) { p[(size_t)j * 256] = (bf16_t)f2bf(v0[j]); p[(size_t)(4 + j) * 256] = (bf16_t)f2bf(v1[j]); } } } }
    }
};
struct EpiDecay {
    static constexpr bool PERM = false, AFTER_DRAIN = false;
    float* DEC; const float* w0;
    __device__ __forceinline__ void operator()(const f32x4 (&acc)[2][2][4][2], const Unit& u, int wr, int wc, int fr, int fq) const {
        const int row0 = u.orow + wr * 64 + fr, col0 = u.ocol + wc * 32 + 4 * fq;
        f32x4 bv[2][2];
#pragma unroll
        for (int bj = 0; bj < 2; ++bj)
#pragma unroll
            for (int n = 0; n < 2; ++n) bv[bj][n] = *(const f32x4*)(w0 + col0 + bj * HALF + n * 16);
#pragma unroll
        EPI_LOOP_AI_M { const size_t off = (size_t)(row0 + ai * HALF + m * 16) * D + col0;
#pragma unroll
            for (int bj = 0; bj < 2; ++bj)
#pragma unroll
                for (int n = 0; n < 2; ++n) { const f32x4 x = acc[ai][bj][m][n] + bv[bj][n]; f32x4 o;
#pragma unroll
                    for (int j = 0; j < 4; ++j) o[j] = __expf(-0.6065306597126334f * sigmoidf_(x[j]));
                    *(f32x4*)(DEC + off + bj * HALF + n * 16) = o; } }
    }
};
struct EpiIclr {
    static constexpr bool PERM = false, AFTER_DRAIN = false;
    const float* a0; const float* k_k; const float* k_a; const bf16_t* KZ; const float* KNORM; bf16_t* KP; bf16_t* AN; bf16_t* BB;
    __device__ __forceinline__ void operator()(const f32x4 (&acc)[2][2][4][2], const Unit& u, int wr, int wc, int fr, int fq) const {
        const int row0 = u.orow + wr * 64 + fr, col0 = u.ocol + wc * 32 + 4 * fq;
#pragma unroll
        for (int bj = 0; bj < 2; ++bj)
#pragma unroll
            for (int n = 0; n < 2; ++n) { const int col = col0 + bj * HALF + n * 16;
                const f32x4 a0v = *(const f32x4*)(a0 + col), kkv = *(const f32x4*)(k_k + col), kav = *(const f32x4*)(k_a + col);
#pragma unroll
                EPI_LOOP_AI_M { const int row = row0 + ai * HALF + m * 16; const size_t off = (size_t)row * D + col;
                    const u32x2 kzw = *(const u32x2*)(KZ + off); const f32x4 kz = (f32x4){bf2f(kzw.x & 0xffffu), bf2f(kzw.x >> 16), bf2f(kzw.y & 0xffffu), bf2f(kzw.y >> 16)};
                    const float nr = KNORM[(size_t)row * 32 + (col >> 6)]; const float inv = 1.0f / fmaxf(nr, 1e-12f);
                    const f32x4 x = acc[ai][bj][m][n] + a0v; f32x4 kp, an, bb;
#pragma unroll
                    for (int j = 0; j < 4; ++j) { const float a = sigmoidf_(x[j]); const float kk = kz[j] * kkv[j] * inv; kp[j] = kz[j] * (1.0f + (a - 1.0f) * kav[j]); bb[j] = kk * a; an[j] = -kk; }
                    *(u32x2*)(KP + off) = (u32x2){pk2(kp[0], kp[1]), pk2(kp[2], kp[3])}; *(u32x2*)(AN + off) = (u32x2){pk2(an[0], an[1]), pk2(an[2], an[3])}; *(u32x2*)(BB + off) = (u32x2){pk2(bb[0], bb[1]), pk2(bb[2], bb[3])}; }
                asm volatile("" ::: "memory"); }
    }
};
struct EpiGateA {
    static constexpr bool PERM = false, AFTER_DRAIN = false;
    const bf16_t* PROJ; float* TMP;
    __device__ __forceinline__ void operator()(const f32x4 (&acc)[2][2][4][2], const Unit& u, int wr, int wc, int fr, int fq) const {
        const int row0 = u.orow + wr * 64 + fr, col0 = u.ocol + wc * 32 + 4 * fq;
#pragma unroll
        EPI_LOOP_AI_M { const int row = row0 + ai * HALF + m * 16;
#pragma unroll
            for (int bj = 0; bj < 2; ++bj)
#pragma unroll
                for (int n = 0; n < 2; ++n) { const int col = col0 + bj * HALF + n * 16; const u32x2 gv = *(const u32x2*)(PROJ + (size_t)row * PC + GATE0 + col);
                    const f32x4 a = acc[ai][bj][m][n]; f32x4 o;
                    o[0] = a[0] * sigmoidf_(bf2f(gv.x & 0xffffu)); o[1] = a[1] * sigmoidf_(bf2f(gv.x >> 16)); o[2] = a[2] * sigmoidf_(bf2f(gv.y & 0xffffu)); o[3] = a[3] * sigmoidf_(bf2f(gv.y >> 16));
                    *(f32x4*)(TMP + (size_t)row * D + col) = o; } }
    }
};
struct EpiGateB {
    static constexpr bool PERM = true, AFTER_DRAIN = false;
    const bf16_t* PROJ; const float* TMP; bf16_t* MERGED;
    __device__ __forceinline__ void operator()(const f32x4 (&acc)[2][2][4][2], const Unit& u, int wr, int wc, int fr, int fq) const {
        const int row0 = u.orow + wr * 64 + fr, col0 = u.ocol + wc * 32 + 8 * fq;
#pragma unroll
        EPI_LOOP_AI_M { const int row = row0 + ai * HALF + m * 16;
#pragma unroll
            for (int bj = 0; bj < 2; ++bj) { const int col = col0 + bj * HALF; const u32x4 gv = *(const u32x4*)(PROJ + (size_t)row * PC + GATE0 + 2048 + col);
                const f32x4 t0 = *(const f32x4*)(TMP + (size_t)row * D + col), t1 = *(const f32x4*)(TMP + (size_t)row * D + col + 4);
                const f32x4 a0 = acc[ai][bj][m][0], a1 = acc[ai][bj][m][1]; f32x4 o0, o1;
                o0[0] = t0[0] + a0[0] * sigmoidf_(bf2f(gv.x & 0xffffu)); o0[1] = t0[1] + a0[1] * sigmoidf_(bf2f(gv.x >> 16)); o0[2] = t0[2] + a0[2] * sigmoidf_(bf2f(gv.y & 0xffffu)); o0[3] = t0[3] + a0[3] * sigmoidf_(bf2f(gv.y >> 16));
                o1[0] = t1[0] + a1[0] * sigmoidf_(bf2f(gv.z & 0xffffu)); o1[1] = t1[1] + a1[1] * sigmoidf_(bf2f(gv.z >> 16)); o1[2] = t1[2] + a1[2] * sigmoidf_(bf2f(gv.w & 0xffffu)); o1[3] = t1[3] + a1[3] * sigmoidf_(bf2f(gv.w >> 16));
                u32x4 w; w.x = cvt_pk_bf16(o0[0], o0[1]); w.y = cvt_pk_bf16(o0[2], o0[3]); w.z = cvt_pk_bf16(o1[0], o1[1]); w.w = cvt_pk_bf16(o1[2], o1[3]);
                *(u32x4*)(MERGED + (size_t)row * D + col) = w; }
            asm volatile("" ::: "memory"); }
    }
};
struct EpiSwiglu {
    static constexpr bool PERM = true, AFTER_DRAIN = false;
    const float* b1; bf16_t* H;
    __device__ __forceinline__ float sw(float g, float l) const { g = fminf(g, 7.0f); l = fminf(fmaxf(l, -7.0f), 7.0f); return g * sigmoidf_(1.702f * g) * (l + 1.0f); }
    __device__ __forceinline__ void operator()(const f32x4 (&acc)[2][2][4][2], const Unit& u, int wr, int wc, int fr, int fq) const {
        const int row0 = u.orow + wr * 64 + fr, col0 = u.ocol + wc * 32 + 8 * fq;
        f32x4 bv[2][2];
#pragma unroll
        for (int bj = 0; bj < 2; ++bj)
#pragma unroll
            for (int n = 0; n < 2; ++n) bv[bj][n] = *(const f32x4*)(b1 + (size_t)u.aux * 4096 + col0 + bj * HALF + 4 * n);
#pragma unroll
        EPI_LOOP_AI_M { const int row = row0 + ai * HALF + m * 16;
#pragma unroll
            for (int bj = 0; bj < 2; ++bj) { const f32x4 v0 = acc[ai][bj][m][0] + bv[bj][0], v1 = acc[ai][bj][m][1] + bv[bj][1];
                *(unsigned*)((unsigned char*)H + (size_t)row * DFF + ((col0 + bj * HALF) >> 1)) = pk4_fp8(sw(v0[0], v0[1]), sw(v0[2], v0[3]), sw(v1[0], v1[1]), sw(v1[2], v1[3])); } }
    }
};
struct EpiSoftmax {
    static constexpr bool PERM = true, AFTER_DRAIN = true;
    bf16_t* PP;
    __device__ __forceinline__ void fused(f32x4 (&acc)[2][2][4][2], const Unit& u, int wr, int wc, int fr, int fq, PG8_LAS unsigned char* lds, int wid, int lane) const {
        PG8_LAS float* P1 = (PG8_LAS float*)lds;
        PG8_LAS float* P2 = (PG8_LAS float*)(lds + 4096);
        float mx[2][4];
#pragma unroll
        EPI_LOOP_AI_M { float v = -3.0e38f;
#pragma unroll
            for (int bj = 0; bj < 2; ++bj)
#pragma unroll
                for (int n = 0; n < 2; ++n) { const f32x4 x = acc[ai][bj][m][n]; v = fmaxf(v, fmaxf(fmaxf(x[0], x[1]), fmaxf(x[2], x[3]))); }
            v = fmaxf(v, __shfl_xor(v, 16)); v = fmaxf(v, __shfl_xor(v, 32));
            if (fq == 0) P1[(ai * HALF + wr * 64 + m * 16 + fr) * 4 + wc] = v; }
        asm volatile("s_waitcnt lgkmcnt(0)" ::: "memory"); __builtin_amdgcn_s_barrier(); asm volatile("" ::: "memory");
#pragma unroll
        EPI_LOOP_AI_M { const f32x4 t = *(const PG8_LAS f32x4*)(P1 + (ai * HALF + wr * 64 + m * 16 + fr) * 4); mx[ai][m] = fmaxf(fmaxf(t[0], t[1]), fmaxf(t[2], t[3])); }
#pragma unroll
        EPI_LOOP_AI_M { float s = 0.f;
#pragma unroll
            for (int bj = 0; bj < 2; ++bj)
#pragma unroll
                for (int n = 0; n < 2; ++n) { f32x4 x = acc[ai][bj][m][n];
#pragma unroll
                    for (int j = 0; j < 4; ++j) { x[j] = __expf(x[j] - mx[ai][m]); s += x[j]; }
                    acc[ai][bj][m][n] = x; }
            s += __shfl_xor(s, 16); s += __shfl_xor(s, 32);
            if (fq == 0) P2[(ai * HALF + wr * 64 + m * 16 + fr) * 4 + wc] = s; }
        asm volatile("s_waitcnt lgkmcnt(0)" ::: "memory"); __builtin_amdgcn_s_barrier(); asm volatile("" ::: "memory");
        const int row0 = u.orow + wr * 64 + fr, col0 = wc * 32 + 8 * fq;
#pragma unroll
        EPI_LOOP_AI_M { const f32x4 t = *(const PG8_LAS f32x4*)(P2 + (ai * HALF + wr * 64 + m * 16 + fr) * 4); const float inv = 1.0f / ((t[0] + t[1]) + (t[2] + t[3]));
            bf16_t* rowp = PP + (size_t)(row0 + ai * HALF + m * 16) * 256 + col0;
#pragma unroll
            for (int bj = 0; bj < 2; ++bj) { const f32x4 v0 = acc[ai][bj][m][0] * inv, v1 = acc[ai][bj][m][1] * inv;
                u32x4 w; w.x = cvt_pk_bf16(v0[0], v0[1]); w.y = cvt_pk_bf16(v0[2], v0[3]); w.z = cvt_pk_bf16(v1[0], v1[1]); w.w = cvt_pk_bf16(v1[2], v1[3]);
                *(u32x4*)(rowp + bj * HALF) = w; } }
        asm volatile("s_waitcnt lgkmcnt(0)" ::: "memory"); __builtin_amdgcn_s_barrier(); asm volatile("" ::: "memory");
    }
};
}

constexpr size_t MiB = 1u << 20;
constexpr size_t al256(size_t x) { return (x + 255) & ~(size_t)255; }
constexpr size_t WS_CTL = 0, CTL_ZERO_BYTES = 1 * MiB;
constexpr size_t WS_WIN = 1 * MiB;
constexpr size_t WS_WUP = WS_WIN + (size_t)PC * D * 2;
constexpr size_t WS_AUP = WS_WUP + (size_t)D * 256 * 2;
constexpr size_t WS_GUP = WS_AUP + (size_t)D * 256 * 2;
constexpr size_t WS_PA = WS_GUP + (size_t)D * 256 * 2;
constexpr size_t WS_PB = WS_PA + (size_t)D * D * 2;
constexpr size_t WS_WOUT = WS_PB + (size_t)D * 512 * 2;
constexpr size_t WS_WQ = WS_WOUT + (size_t)D * D * 2;
constexpr size_t WS_WKV = WS_WQ + (size_t)D * D * 2;
constexpr size_t WS_WO = WS_WKV + (size_t)2 * D * D * 2;
constexpr size_t WS_W1 = WS_WO + (size_t)D * D * 2;
constexpr size_t WS_W2 = WS_W1 + (size_t)NEXP * 4096 * D * 2;
constexpr size_t WS_XB = WS_W2 + (size_t)NEXP * D * DFF * 2;
constexpr size_t WS_MEMB = WS_XB + (size_t)M * D * 2;
constexpr size_t WS_ROT = WS_MEMB + (size_t)1024 * D * 2;
constexpr size_t WS_KB = WS_ROT + (size_t)2 * SEQ * 32 * 4;
constexpr size_t WS_VT = WS_KB + (size_t)1024 * D * 2;
constexpr size_t WS_YA = WS_VT + (size_t)1024 * D * 2;
constexpr size_t WS_YB = WS_YA + (size_t)M * D * 2;
constexpr size_t WS_TMP = WS_YB + (size_t)M * 512 * 2;
constexpr size_t WS_MERGED = WS_TMP + (size_t)M * D * 4;
constexpr size_t WS_E = WS_MERGED + (size_t)M * D * 2;
constexpr size_t WS_PROJ = WS_E;
constexpr size_t WS_RZ = WS_PROJ + (size_t)M * PC * 2;
constexpr size_t WS_KZ = WS_RZ + (size_t)M * D * 4;
constexpr size_t WS_VZ = WS_KZ + (size_t)M * D * 4;
constexpr size_t WS_DEC = WS_VZ + (size_t)M * D * 4;
constexpr size_t WS_KP = WS_DEC + (size_t)M * D * 4;
constexpr size_t WS_AN = WS_KP + (size_t)M * D * 4;
constexpr size_t WS_BB = WS_AN + (size_t)M * D * 4;
constexpr size_t WS_GG = WS_BB + (size_t)M * D * 4;
constexpr size_t WS_YS = WS_GG + (size_t)M * D * 4;
constexpr size_t WS_VR = WS_YS + 4 * MiB;
constexpr size_t WS_AO = WS_YS + (size_t)M * D * 4;
constexpr size_t WS_LSE = WS_AO + (size_t)3 * M * 512 * 4;
constexpr size_t WS_QR = WS_LSE + (size_t)3 * M * 8 * 4;
constexpr size_t WS_KR = WS_QR + (size_t)M * 1536 * 2;
constexpr size_t WS_LIN = WS_KR + (size_t)M * 1536 * 2;
constexpr size_t WS_KNORM = WS_LIN + (size_t)M * 768 * 2;
constexpr size_t WS_F = WS_KNORM + (size_t)M * 32 * 4;
constexpr size_t WS_E_END = WS_F + (size_t)128 * 128 * 96 * 96 * 2;
constexpr size_t WS_T1 = WS_E;
constexpr size_t WS_X1 = WS_T1 + (size_t)M * D * 4;
constexpr size_t WS_X1B = WS_X1 + (size_t)M * D * 4;
constexpr size_t WS_Q = WS_X1B + (size_t)M * D * 2;
constexpr size_t WS_PP = WS_Q + (size_t)M * D * 2;
constexpr size_t WS_OC = WS_PP + (size_t)16 * SEQ * 256 * 2;
constexpr size_t WS_T2 = WS_OC + (size_t)M * D * 2;
constexpr size_t WS_X2 = WS_T2 + (size_t)M * D * 4;
constexpr size_t WS_X2B = WS_X2 + (size_t)M * D * 4;
constexpr size_t WS_LIST = WS_X2B + (size_t)M * D * 2;
constexpr size_t WS_ROWI = WS_LIST + (size_t)NEXP * CAP * 4;
constexpr size_t WS_TOPW = WS_ROWI + (size_t)M * 4 * 4;
constexpr size_t WS_H = WS_TOPW + (size_t)M * 4 * 4;
constexpr size_t WS_Y = WS_H + (size_t)HROWS * DFF * 2;
constexpr size_t WS_L_END = WS_Y + (size_t)HROWS * D * 4;
constexpr size_t WS_END = (WS_E_END > WS_L_END ? WS_E_END : WS_L_END);
static_assert(WS_END <= (size_t)4090 * MiB, "workspace map exceeds 4 x largest input");
constexpr int CW_TMO = 0, CW_CNT = 64  , CW_Q = 128  , CW_BAR = 4096;

constexpr int RING_BYTES = 131072, MISC_OFF = RING_BYTES, LDS_BYTES = 147456;

#define XB_TMO      128
#define XB_XCNT(j)  (256  + 64 * (j))
#define XB_XSUB(j)  (1280 + 64 * (j))
#define XB_XGEN(j)  (2304 + 64 * (j))
#define XB_TOP      3328
#define XB_TOPGEN   3392
#define XCD_BAR_WORDS 3456
#define XB_SPIN_CAP (1u << 18)
__device__ __forceinline__ unsigned xb_ld(unsigned* p)              { return __hip_atomic_load(p, __ATOMIC_RELAXED, __HIP_MEMORY_SCOPE_AGENT); }
__device__ __forceinline__ unsigned xb_add(unsigned* p, unsigned v) { return __hip_atomic_fetch_add(p, v, __ATOMIC_RELAXED, __HIP_MEMORY_SCOPE_AGENT); }
__device__ __forceinline__ unsigned xb_xcc_id() { return (unsigned)__builtin_amdgcn_s_getreg((3 << 11) | 20) & 0xFu; }
#define XB_SPIN(cond, bar) do { unsigned _sp = 0; while (cond) { __builtin_amdgcn_s_sleep(1); \
    if ((++_sp & 255u) == 0u) { if (xb_ld(&(bar)[XB_TMO])) break; if (_sp > XB_SPIN_CAP) { atomicAdd(&(bar)[XB_TMO], 1u); break; } } } } while (0)
struct XcdBarrier { unsigned* bar; unsigned x; volatile LAS unsigned* st; };
__device__ __forceinline__ XcdBarrier xcd_barrier_post(unsigned* bar, volatile LAS unsigned* st) {
    XcdBarrier b; b.bar = bar; b.x = xb_xcc_id(); b.st = st;
    if (threadIdx.x == 0) (void)xb_add(&bar[XB_XCNT(b.x)], 1u);
    return b;
}
__device__ __forceinline__ void xcd_barrier_complete(unsigned* bar, unsigned x, unsigned& nloc, unsigned& nx) {
    const unsigned G = gridDim.x * gridDim.y * gridDim.z;
    unsigned sum, cnt, mine, sp = 0u;
    for (;;) {
        sum = 0u; cnt = 0u; mine = 0u;
#pragma unroll
        for (unsigned j = 0; j < 16; ++j) { const unsigned c = xb_ld(&bar[XB_XCNT(j)]); sum += c; cnt += (c > 0u) ? 1u : 0u; mine = (j == x) ? c : mine; }
        if (sum == G) break;
        __builtin_amdgcn_s_sleep(1);
        if ((++sp & 255u) == 0u) { if (xb_ld(&bar[XB_TMO])) break; if (sp > XB_SPIN_CAP) { atomicAdd(&bar[XB_TMO], 1u); break; } }
    }
    nloc = mine > 0u ? mine : 1u; nx = cnt > 0u ? cnt : 1u;
}
__device__ __forceinline__ void xcd_barrier(const XcdBarrier& b) {
    asm volatile("s_waitcnt vmcnt(0)" ::: "memory");
    __syncthreads();
    if (threadIdx.x == 0) {
        unsigned* bar = b.bar;
        __builtin_amdgcn_s_waitcnt(0);
        unsigned nloc = b.st[0], nx = b.st[1];
        if (nloc == 0u) { xcd_barrier_complete(bar, b.x, nloc, nx); b.st[0] = nloc; b.st[1] = nx; }
        const unsigned old = xb_add(&bar[XB_XSUB(b.x)], 1u);
        const unsigned gen = old / nloc;
        if (old + 1u == (gen + 1u) * nloc) {
            __builtin_amdgcn_fence(__ATOMIC_RELEASE, "agent");
            asm volatile("s_waitcnt vmcnt(0)" ::: "memory");
            const unsigned og = xb_add(&bar[XB_TOP], 1u);
            const unsigned tg = og / nx;
            if (og + 1u == (tg + 1u) * nx) xb_add(&bar[XB_TOPGEN], 1u);
            else XB_SPIN(xb_ld(&bar[XB_TOPGEN]) == tg, bar);
            __builtin_amdgcn_fence(__ATOMIC_ACQUIRE, "agent");
            xb_add(&bar[XB_XGEN(b.x)], 1u);
            asm volatile("s_waitcnt vmcnt(0)" ::: "memory");
        } else {
            XB_SPIN(xb_ld(&bar[XB_XGEN(b.x)]) == gen, bar);
            __builtin_amdgcn_fence(__ATOMIC_ACQUIRE, "agent");
            asm volatile("s_waitcnt vmcnt(0)" ::: "memory");
        }
    }
    __syncthreads();
}

struct Params {
    const float* in[32];
    float* out; unsigned char* ws;
    int ph_lo, ph_hi, li, pad;
};
enum { I_X = 0, I_MEM, I_WIN, I_MIX, I_W0, I_WUP, I_A0, I_AUP, I_GUP, I_KK, I_KA, I_RK, I_LNXG, I_LNXB, I_PA, I_PB, I_WOUT, I_LN1G, I_LN1B, I_WQ, I_WKV, I_WO, I_LN2G, I_LN2B,
       I_RW, I_RB, I_W1, I_B1, I_W2, I_B2, I_LN3G, I_LN3B };

struct ScoreOrder {
    static constexpr bool GATHER = false;
    const char* Q; const char* KB; int G, c;
    __device__ bool next(int i, pg8::Unit& u) const {
        const int L = i * G + c; if (L >= 256) return false;
        const int bh = L >> 4, pm = L & 15, b = bh >> 2, h = bh & 3;
        u.A = Q + ((size_t)(b * SEQ + 256 * pm) * D + h * 512) * 2; u.B = KB + ((size_t)(b * 256) * D + h * 512) * 2;
        u.orow = bh * SEQ + 256 * pm; u.ocol = 0; u.aux = 0; u.aux2 = 0; u.valid = 256; return true;
    }
    __device__ __forceinline__ const int* rows(const pg8::Unit&) const { return nullptr; }
};
struct PvOrder {
    static constexpr bool GATHER = false;
    const char* PP; const char* VT; int G, c;
    __device__ bool next(int i, pg8::Unit& u) const {
        const int L = i * G + c; if (L >= 512) return false;
        const int bh = L >> 5, pm = (L >> 1) & 15, pn = L & 1, b = bh >> 2, h = bh & 3;
        u.A = PP + ((size_t)(bh * SEQ + 256 * pm) * 256) * 2; u.B = VT + ((size_t)(bh * 512 + 256 * pn) * 256) * 2;
        u.orow = b * SEQ + 256 * pm; u.ocol = h * 512 + 256 * pn; u.aux = 0; u.aux2 = 0; u.valid = 256; return true;
    }
    __device__ __forceinline__ const int* rows(const pg8::Unit&) const { return nullptr; }
};
template <bool GATHER_, int NT  > struct MoeOrder {
    static constexpr bool GATHER = GATHER_;
    const LAS int* tab; const char* A; const char* W; const int* list; size_t wexp  ; int ldb; int G, c;
    __device__ bool next(int i, pg8::Unit& u) const {
        constexpr int RPR = 256 / NT;
        const int rt = i * RPR + (c % RPR), pn = c / RPR, T = __builtin_amdgcn_readfirstlane(tab[64]);
        if (c >= 256 || rt >= T) return false;
        int e = 0;
        for (int j = 1; j < NEXP; ++j) e = (rt >= __builtin_amdgcn_readfirstlane(tab[32 + j])) ? j : e;
        const int lt = rt - __builtin_amdgcn_readfirstlane(tab[32 + e]), cnt = __builtin_amdgcn_readfirstlane(tab[e]);
        u.aux = e; u.aux2 = lt; u.valid = min(256, cnt - 256 * lt); u.orow = 256 * rt; u.ocol = 256 * pn;
        u.B = W + (size_t)e * wexp + (size_t)(256 * pn) * ldb;
        u.A = GATHER_ ? A : A + (size_t)(256 * rt) * DFF;
        return true;
    }
    __device__ __forceinline__ const int* rows(const pg8::Unit& u) const { return list + (size_t)u.aux * CAP + 256 * u.aux2; }
};

struct Ctx { int tid, lane, wave, vcu, G; LAS unsigned char* lds; unsigned char* ws; };

__device__ __forceinline__ void tr_item(const float* W, int ldw, int Ksrc, int sc0, bf16_t* WT, int ldt, int n0, int k0, LAS float* scr, int lane) {
#pragma unroll 8
    for (int i = 0; i < 32; ++i) { const int kk = 2 * i + (lane >> 5); float v = 0.f; if (sc0 >= 0 && (k0 + kk) < Ksrc) v = W[(size_t)(k0 + kk) * ldw + sc0 + (lane & 31)]; scr[kk * 33 + (lane & 31)] = v; }
    LDS_WAIT(); asm volatile("" ::: "memory");
    const int c = lane & 7;
#pragma unroll
    for (int j = 0; j < 4; ++j) { const int n = (lane >> 3) + 8 * j; const LAS float* s = scr + (8 * c) * 33 + n;
        u32x4 o; o.x = pk2(s[0 * 33], s[1 * 33]); o.y = pk2(s[2 * 33], s[3 * 33]); o.z = pk2(s[4 * 33], s[5 * 33]); o.w = pk2(s[6 * 33], s[7 * 33]);
        *(u32x4*)(WT + (size_t)(n0 + n) * ldt + k0 + 8 * c) = o; }
    LDS_WAIT(); asm volatile("" ::: "memory");
}
__device__ __forceinline__ void tr_job(const float* W, int N, int Ksrc, int Kdst, bf16_t* WT, int item, LAS float* scr, int lane) {
    const int nblk = N / 32, kb = item / nblk, nb = item % nblk;
    tr_item(W, N, Ksrc, 32 * nb, WT, Kdst, 32 * nb, 64 * kb, scr, lane);
}
__device__ __forceinline__ void p0_prologue(const Params& p, const Ctx& c) {
    LAS float* scr = (LAS float*)(c.lds + c.wave * 16384);
    const int gw = c.vcu * 8 + c.wave, NGW = c.G * 8;
    unsigned char* ws = c.ws;
    constexpr int I_WINJ = 32 * 480, I_LORA = 4 * 64, I_SQ = 32 * 64, I_PBJ = 8 * 64, I_KVJ = 32 * 128, I_W1E = 32 * 128, I_W2E = 32 * 64;
    constexpr int NITEMS = I_WINJ + 3 * I_LORA + 4 * I_SQ + I_PBJ + I_KVJ;
    for (int it = gw; it < NITEMS; it += NGW) {
        int r = it;
        if (r < I_WINJ) { const int kb = r / 480, nb = r % 480; const int sc0 = nb < 206 ? 32 * nb : (nb < 208 ? -1 : 32 * nb - 64);
            tr_item(p.in[I_WIN], 15296, D, sc0, (bf16_t*)(ws + WS_WIN), D, 32 * nb, 64 * kb, scr, c.lane); continue; } r -= I_WINJ;
        if (r < I_LORA) { tr_job(p.in[I_WUP], D, 96, 256, (bf16_t*)(ws + WS_WUP), r, scr, c.lane); continue; } r -= I_LORA;
        if (r < I_LORA) { tr_job(p.in[I_AUP], D, 96, 256, (bf16_t*)(ws + WS_AUP), r, scr, c.lane); continue; } r -= I_LORA;
        if (r < I_LORA) { tr_job(p.in[I_GUP], D, 256, 256, (bf16_t*)(ws + WS_GUP), r, scr, c.lane); continue; } r -= I_LORA;
        if (r < I_SQ) { tr_job(p.in[I_PA], D, D, D, (bf16_t*)(ws + WS_PA), r, scr, c.lane); continue; } r -= I_SQ;
        if (r < I_PBJ) { tr_job(p.in[I_PB], D, 512, 512, (bf16_t*)(ws + WS_PB), r, scr, c.lane); continue; } r -= I_PBJ;
        if (r < I_SQ) { tr_job(p.in[I_WOUT], D, D, D, (bf16_t*)(ws + WS_WOUT), r, scr, c.lane); continue; } r -= I_SQ;
        if (r < I_SQ) { tr_job(p.in[I_WQ], D, D, D, (bf16_t*)(ws + WS_WQ), r, scr, c.lane); continue; } r -= I_SQ;
        if (r < I_KVJ) { tr_job(p.in[I_WKV], 2 * D, D, D, (bf16_t*)(ws + WS_WKV), r, scr, c.lane); continue; } r -= I_KVJ;
        { tr_job(p.in[I_WO], D, D, D, (bf16_t*)(ws + WS_WO), r, scr, c.lane); }
    }
    const size_t gt = (size_t)c.vcu * 512 + c.tid, NT = (size_t)c.G * 512;
    for (size_t i = gt; i < (size_t)M * D / 8; i += NT) { const f32x4 a = ((const f32x4*)p.in[I_X])[2 * i], b = ((const f32x4*)p.in[I_X])[2 * i + 1];
        u32x4 o; o.x = pk2(a[0], a[1]); o.y = pk2(a[2], a[3]); o.z = pk2(b[0], b[1]); o.w = pk2(b[2], b[3]); ((u32x4*)(ws + WS_XB))[i] = o; }
    for (size_t i = gt; i < (size_t)1024 * D / 8; i += NT) { const f32x4 a = ((const f32x4*)p.in[I_MEM])[2 * i], b = ((const f32x4*)p.in[I_MEM])[2 * i + 1];
        u32x4 o; o.x = pk2(a[0], a[1]); o.y = pk2(a[2], a[3]); o.z = pk2(b[0], b[1]); o.w = pk2(b[2], b[3]); ((u32x4*)(ws + WS_MEMB))[i] = o; }
    float* rc = (float*)(ws + WS_ROT); float* rs = rc + SEQ * 32;
    for (size_t i = gt; i < (size_t)SEQ * 32; i += NT) { const int pos = (int)(i >> 5), j = (int)(i & 31);
        const double inv = exp(-(double)j * (9.210340371976184 / 32.0)); const double ang = (double)pos * inv; rc[i] = (float)cos(ang); rs[i] = (float)sin(ang); }
}

__device__ __forceinline__ void tr_store8(unsigned char* WT8, int ldt, int n0, int k0, const LAS float* scr, int lane) {
    const int c = lane & 3;
#pragma unroll
    for (int j = 0; j < 2; ++j) { const int n = (lane >> 2) + 16 * j; const LAS float* sp = scr + (16 * c) * 33 + n; u32x4 o;
        o.x = pk4_fp8(sp[0 * 33] * 64.f, sp[1 * 33] * 64.f, sp[2 * 33] * 64.f, sp[3 * 33] * 64.f); o.y = pk4_fp8(sp[4 * 33] * 64.f, sp[5 * 33] * 64.f, sp[6 * 33] * 64.f, sp[7 * 33] * 64.f);
        o.z = pk4_fp8(sp[8 * 33] * 64.f, sp[9 * 33] * 64.f, sp[10 * 33] * 64.f, sp[11 * 33] * 64.f); o.w = pk4_fp8(sp[12 * 33] * 64.f, sp[13 * 33] * 64.f, sp[14 * 33] * 64.f, sp[15 * 33] * 64.f);
        *(u32x4*)(WT8 + (size_t)(n0 + n) * ldt + k0 + 16 * c) = o; }
}
__device__ __forceinline__ void tr_item8(const float* W, int ldw, unsigned char* WT8, int ldt, int n0, int k0, LAS float* scr, int lane) {
#pragma unroll 8
    for (int i = 0; i < 32; ++i) { const int kk = 2 * i + (lane >> 5); scr[kk * 33 + (lane & 31)] = W[(size_t)(k0 + kk) * ldw + n0 + (lane & 31)]; }
    LDS_WAIT(); asm volatile("" ::: "memory");
    tr_store8(WT8, ldt, n0, k0, scr, lane);
    LDS_WAIT(); asm volatile("" ::: "memory");
}
__device__ __forceinline__ void tr_issue(const float* W, int ldw, int n0, int k0, int lane, float (&cv)[32]) {
#pragma unroll
    for (int i = 0; i < 32; ++i) cv[i] = W[(size_t)(k0 + 2 * i + (lane >> 5)) * ldw + n0 + (lane & 31)];
}
__device__ __forceinline__ void tr_finish(const float (&cv)[32], unsigned char* WT8, int ldt, int n0, int k0, LAS float* scr, int lane) {
#pragma unroll
    for (int i = 0; i < 32; ++i) scr[(2 * i + (lane >> 5)) * 33 + (lane & 31)] = cv[i];
    LDS_WAIT(); asm volatile("" ::: "memory");
    tr_store8(WT8, ldt, n0, k0, scr, lane);
    LDS_WAIT(); asm volatile("" ::: "memory");
}
constexpr int MOE_W1E = 32 * 128, MOE_W2E = 32 * 64, MOE_CONV_GROUPS = (NEXP * MOE_W2E) / 8;
__device__ __forceinline__ void conv_group(const Params& p, const Ctx& c, int gi) {
    LAS float* scr = (LAS float*)(c.lds + c.wave * 16384);
    unsigned char* ws = c.ws;
    const int r = gi * 8 + c.wave;
    { const int e = r / MOE_W2E, it = r % MOE_W2E, kb = it >> 6, nb = it & 63; tr_item8(p.in[I_W2] + (size_t)e * DFF * D, D, ws + WS_W2 + (size_t)e * D * DFF, DFF, 32 * nb, 64 * kb, scr, c.lane); }
}

__device__ __forceinline__ void p2_prep(const Params& p, const Ctx& c) {
    unsigned char* ws = c.ws;
    const bf16_t* PROJ = (const bf16_t*)(ws + WS_PROJ);
    const float* mix = p.in[I_MIX]; const float* k_k = p.in[I_KK];
    bf16_t* RZ = (bf16_t*)(ws + WS_RZ); bf16_t* KZ = (bf16_t*)(ws + WS_KZ); bf16_t* VZ = (bf16_t*)(ws + WS_VZ);
    bf16_t* LIN = (bf16_t*)(ws + WS_LIN); float* KNORM = (float*)(ws + WS_KNORM);
    bf16_t* QR = (bf16_t*)(ws + WS_QR); bf16_t* KR = (bf16_t*)(ws + WS_KR); bf16_t* VR = (bf16_t*)(ws + WS_VR);
    const float* rc = (const float*)(ws + WS_ROT); const float* rs = rc + SEQ * 32;
    for (int t = c.vcu; t < M; t += c.G) {
        const int pos = t & (SEQ - 1);
        const bf16_t* cur = PROJ + (size_t)t * PC;
        for (int ch = c.tid; ch < 824; ch += 512) {
            const u32x4 cv = *(const u32x4*)(cur + 8 * ch); u32x4 pv = (u32x4){0u, 0u, 0u, 0u}; if (pos > 0) pv = *(const u32x4*)(cur - PC + 8 * ch);
            const f32x4 m0 = *(const f32x4*)(mix + 8 * ch), m1 = *(const f32x4*)(mix + 8 * ch + 4);
            float z[8];
            { const unsigned cw[4] = {cv.x, cv.y, cv.z, cv.w}, pw[4] = {pv.x, pv.y, pv.z, pv.w};
              const float mm[8] = {m0[0], m0[1], m0[2], m0[3], m1[0], m1[1], m1[2], m1[3]};
#pragma unroll
              for (int j = 0; j < 4; ++j) { const float c0 = bf2f(cw[j] & 0xffffu), c1 = bf2f(cw[j] >> 16), q0 = bf2f(pw[j] & 0xffffu), q1 = bf2f(pw[j] >> 16);
                  z[2 * j] = c0 + (q0 - c0) * mm[2 * j]; z[2 * j + 1] = c1 + (q1 - c1) * mm[2 * j + 1]; } }
            if (ch < 768) {
                bf16_t* dst = (ch < 256 ? RZ : (ch < 512 ? KZ : VZ)) + (size_t)t * D + 8 * (ch & 255);
                { u32x4 w8; w8.x = pk2(z[0], z[1]); w8.y = pk2(z[2], z[3]); w8.z = pk2(z[4], z[5]); w8.w = pk2(z[6], z[7]); *(u32x4*)dst = w8; }
                if (ch >= 256 && ch < 512) {
                    const int col = 8 * (ch - 256); const f32x4 k0 = *(const f32x4*)(k_k + col), k1 = *(const f32x4*)(k_k + col + 4);
                    float s = 0.f;
#pragma unroll
                    for (int j = 0; j < 4; ++j) { const float a = z[j] * k0[j], b = z[4 + j] * k1[j]; s += a * a + b * b; }
                    s += __shfl_xor(s, 1); s += __shfl_xor(s, 2); s += __shfl_xor(s, 4);
                    if ((ch & 7) == 0) KNORM[(size_t)t * 32 + ((ch - 256) >> 3)] = sqrtf(s);
                }
            } else {
                float o[8]; int dcol;
                if (ch < 780) { dcol = 8 * (ch - 768);
#pragma unroll
                    for (int j = 0; j < 8; ++j) o[j] = tanhf(z[j]); }
                else if (ch < 792) { dcol = 256 + 8 * (ch - 780);
#pragma unroll
                    for (int j = 0; j < 8; ++j) o[j] = z[j]; }
                else { dcol = 512 + 8 * (ch - 792);
#pragma unroll
                    for (int j = 0; j < 8; ++j) o[j] = sigmoidf_(z[j]); }
                u32x4 w; w.x = pk2(o[0], o[1]); w.y = pk2(o[2], o[3]); w.z = pk2(o[4], o[5]); w.w = pk2(o[6], o[7]);
                *(u32x4*)(LIN + (size_t)t * 768 + dcol) = w;
            }
        }
        if (c.tid < 40) { const int dcol = (c.tid < 20) ? 96 + 8 * c.tid : 352 + 8 * (c.tid - 20); *(u32x4*)(LIN + (size_t)t * 768 + dcol) = (u32x4){0u, 0u, 0u, 0u}; }
        if (c.tid >= 64 && c.tid < 64 + 192) { const int w = c.tid - 64, which = w / 96, hh = (w % 96) >> 2, e0 = (w & 3) * 8;
            const bf16_t* src = cur + ATT0 + which * 1536 + hh * 64 + e0;
            const u32x4 a = *(const u32x4*)src, b = *(const u32x4*)(src + 32);
            const f32x4 c0 = *(const f32x4*)(rc + pos * 32 + e0), c1 = *(const f32x4*)(rc + pos * 32 + e0 + 4), s0 = *(const f32x4*)(rs + pos * 32 + e0), s1 = *(const f32x4*)(rs + pos * 32 + e0 + 4);
            const unsigned aw[4] = {a.x, a.y, a.z, a.w}, bw[4] = {b.x, b.y, b.z, b.w}; float o1[8], o2[8];
#pragma unroll
            for (int j = 0; j < 8; ++j) { const float t1 = bf2f((aw[j >> 1] >> (16 * (j & 1))) & 0xffffu), t2 = bf2f((bw[j >> 1] >> (16 * (j & 1))) & 0xffffu);
                const float cs = j < 4 ? c0[j & 3] : c1[j & 3], sn = j < 4 ? s0[j & 3] : s1[j & 3]; o1[j] = t1 * cs - t2 * sn; o2[j] = t2 * cs + t1 * sn; }
            const int dl_ = hh < 8 ? 1 : (hh < 16 ? 4 : 16); const int prm = (pos % dl_) * (SEQ / dl_) + pos / dl_;
            bf16_t* dst = (which ? KR : QR) + ((size_t)((t >> 12) * 24 + hh) * SEQ + prm) * 64 + e0;
            u32x4 w1; w1.x = pk2(o1[0], o1[1]); w1.y = pk2(o1[2], o1[3]); w1.z = pk2(o1[4], o1[5]); w1.w = pk2(o1[6], o1[7]);
            u32x4 w2; w2.x = pk2(o2[0], o2[1]); w2.y = pk2(o2[2], o2[3]); w2.z = pk2(o2[4], o2[5]); w2.w = pk2(o2[6], o2[7]);
            *(u32x4*)dst = w1; *(u32x4*)(dst + 32) = w2; }
        if (c.tid >= 256 && c.tid < 256 + 192) { const int w = c.tid - 256, hh = w >> 3, e0 = (w & 7) * 8;
            const int dl_ = hh < 8 ? 1 : (hh < 16 ? 4 : 16); const int prm = (pos % dl_) * (SEQ / dl_) + pos / dl_;
            *(u32x4*)(VR + ((size_t)((t >> 12) * 24 + hh) * SEQ + prm) * 64 + e0) = *(const u32x4*)(cur + ATT0 + 2 * 1536 + hh * 64 + e0); }
    }
}

#define DPP_ADD(x, ctrl) ((x) + __builtin_bit_cast(float, __builtin_amdgcn_update_dpp(0, __builtin_bit_cast(int, (x)), (ctrl), 0xF, 0xF, true)))
__device__ __forceinline__ float wave_sum_dpp(float x) {
    x = DPP_ADD(x, 0xB1); x = DPP_ADD(x, 0x4E); x = DPP_ADD(x, 0x141); x = DPP_ADD(x, 0x140);
    const int xi = __builtin_bit_cast(int, x);
    return (__builtin_bit_cast(float, __builtin_amdgcn_readlane(xi, 0)) + __builtin_bit_cast(float, __builtin_amdgcn_readlane(xi, 16))) +
           (__builtin_bit_cast(float, __builtin_amdgcn_readlane(xi, 32)) + __builtin_bit_cast(float, __builtin_amdgcn_readlane(xi, 48)));
}
__device__ __forceinline__ f32x4 tile_mm(const LAS bf16_t* A, int pa, const LAS bf16_t* Bt, int pb, int ks, int fr, int fq, f32x4 acc) {
    for (int k = 0; k < ks; ++k) { const bf16x8 a = *(const LAS bf16x8*)(A + fr * pa + 32 * k + 8 * fq), b = *(const LAS bf16x8*)(Bt + fr * pb + 32 * k + 8 * fq);
        acc = __builtin_amdgcn_mfma_f32_16x16x32_bf16(a, b, acc, 0, 0, 0); }
    return acc;
}
__device__ __forceinline__ u32x2 pack4(f32x4 v) { u32x2 w; w.x = pk2(v[0], v[1]); w.y = pk2(v[2], v[3]); return w; }
constexpr int SC_C = 32, SC_NCH = SEQ / SC_C, SC_F = 96;
constexpr int PL_X1 = 0, PL_X2 = 9216, PL_AL = 18432, PL_HT = 26112, PL_ET = 33792, PL_LBT = 53760, PL_TT = 58368, PL_GI = 60928, PL_RAW = 68608, PL_TF = 109568, PL_XB = 114176, PL_END = 115264;
#define LBAR() do { asm volatile("s_waitcnt lgkmcnt(0)" ::: "memory"); __builtin_amdgcn_s_barrier(); asm volatile("" ::: "memory"); } while (0)
__device__ __forceinline__ void p4_pre(const Params& p, const Ctx& c) {
    unsigned char* ws = c.ws;
    const bf16_t* RZ = (const bf16_t*)(ws + WS_RZ); const float* DEC = (const float*)(ws + WS_DEC); const bf16_t* KP = (const bf16_t*)(ws + WS_KP);
    const bf16_t* AN = (const bf16_t*)(ws + WS_AN); const bf16_t* BB = (const bf16_t*)(ws + WS_BB);
    bf16_t* FG = (bf16_t*)(ws + WS_F); float* BON = (float*)(ws + WS_YS);
    const float* rkp = p.in[I_RK];
    LAS bf16_t* X1 = (LAS bf16_t*)(c.lds + PL_X1); LAS bf16_t* X2 = (LAS bf16_t*)(c.lds + PL_X2); LAS bf16_t* AL = (LAS bf16_t*)(c.lds + PL_AL); LAS bf16_t* HT = (LAS bf16_t*)(c.lds + PL_HT);
    LAS bf16_t* ET = (LAS bf16_t*)(c.lds + PL_ET); LAS float* LBT = (LAS float*)(c.lds + PL_LBT); LAS bf16_t* TT = (LAS bf16_t*)(c.lds + PL_TT); LAS bf16_t* GI = (LAS bf16_t*)(c.lds + PL_GI);
    LAS float* RAW = (LAS float*)(c.lds + PL_RAW);
    LAS float* TF = (LAS float*)(c.lds + PL_TF);
    LAS float* XB = (LAS float*)(c.lds + PL_XB);
    int tid_ = c.tid; asm volatile("" : "+v"(tid_));
    const int tid = tid_, lane = tid & 63, w = __builtin_amdgcn_readfirstlane(tid >> 6), fr = lane & 15, fq = lane >> 4;
    const int ls = tid >> 4, lc4 = 4 * (tid & 15);
    f32x4 pfd; u32x2 pfb[4];
#define PRE_LOAD(TASK) do { const int bh_ = (TASK) >> 7, ch_ = (TASK) & (SC_NCH - 1); const size_t o_ = ((size_t)(bh_ >> 5) * SEQ + (size_t)ch_ * SC_C + ls) * D + (bh_ & 31) * 64 + lc4; \
        pfb[0] = *(const u32x2*)(RZ + o_); pfd = *(const f32x4*)(DEC + o_); pfb[1] = *(const u32x2*)(KP + o_); pfb[2] = *(const u32x2*)(AN + o_); pfb[3] = *(const u32x2*)(BB + o_); } while (0)
#define PRE_UNPK(w_) ((f32x4){bf2f((w_).x & 0xffffu), bf2f((w_).x >> 16), bf2f((w_).y & 0xffffu), bf2f((w_).y >> 16)})
    if (c.vcu < 128 * SC_NCH) PRE_LOAD(c.vcu);
    const bool bgconv = (c.G == 256);
    LAS float* cscr = (LAS float*)(c.lds + w * 8448);
    int tix = 0;
    for (int task = c.vcu; task < 128 * SC_NCH; task += c.G, ++tix) {
        *(LAS f32x4*)(RAW + (0 * 32 + ls) * 64 + lc4) = PRE_UNPK(pfb[0]); *(LAS f32x4*)(RAW + (1 * 32 + ls) * 64 + lc4) = pfd; *(LAS f32x4*)(RAW + (2 * 32 + ls) * 64 + lc4) = PRE_UNPK(pfb[1]);
        *(LAS f32x4*)(RAW + (3 * 32 + ls) * 64 + lc4) = PRE_UNPK(pfb[2]); *(LAS f32x4*)(RAW + (4 * 32 + ls) * 64 + lc4) = PRE_UNPK(pfb[3]);
        const int bh = task >> 7, chn = task & (SC_NCH - 1); const float rkv = rkp[(bh & 31) * 64 + lane];
        float* bon = BON + ((size_t)(bh >> 5) * SEQ + (size_t)chn * SC_C) * 32 + (bh & 31);
        if (task + c.G < 128 * SC_NCH) PRE_LOAD(task + c.G);
        float cv[32]; int ce = 0, cn0 = 0, ck0 = 0;
        if (bgconv) { const int item = (c.vcu * 64 + tix) * 8 + w; ce = item >> 12; const int rem = item & 4095; ck0 = 64 * (rem >> 7); cn0 = 32 * (rem & 127);
            tr_issue(p.in[I_W1] + (size_t)ce * D * 4096, 4096, cn0, ck0, lane, cv); }
        LBAR();
        *(LAS u32x4*)(ET + (32 + (tid >> 3)) * 104 + 8 * (tid & 7)) = (u32x4){0u, 0u, 0u, 0u};
        float g = 1.f, gprev[4], gcur[4];
#pragma unroll
        for (int s = 0; s < SC_C; ++s) { const float wv = RAW[(32 + s) * 64 + lane]; if ((s >> 2) == w) gprev[s & 3] = g; g *= wv; if ((s >> 2) == w) gcur[s & 3] = g; }
        const float gC = g;
        f32x4 ah4, bg4, kg4;
#pragma unroll
        for (int qn = 0; qn < 4; ++qn) { const int s = 4 * w + qn;
            const float rr = RAW[(0 + s) * 64 + lane], kk = RAW[(64 + s) * 64 + lane], aa = RAW[(96 + s) * 64 + lane], bb = RAW[(128 + s) * 64 + lane]; const float ig = 1.0f / gcur[qn];
            const float ah = aa * gprev[qn], bt = bb * ig, kt = kk * ig, rh = rr * gcur[qn];
            X1[s * 72 + lane] = (bf16_t)f2bf(bt); X1[(32 + s) * 72 + lane] = (bf16_t)f2bf(kt); X2[s * 72 + lane] = (bf16_t)f2bf(ah); X2[(32 + s) * 72 + lane] = (bf16_t)f2bf(rh);
            ET[s * 104 + lane] = (bf16_t)f2bf(rh); ah4[qn] = ah; bg4[qn] = bt * gC; kg4[qn] = kt * gC;
            const float bsum = wave_sum_dpp(rr * kk * rkv); if (lane == 0) bon[(size_t)s * 32] = bsum; }
        *(LAS u32x2*)(AL + lane * 40 + 4 * w) = pack4(ah4); *(LAS u32x2*)(HT + (32 + lane) * 40 + 4 * w) = pack4(bg4); *(LAS u32x2*)(ET + (32 + lane) * 104 + 64 + 4 * w) = pack4(kg4);
        LBAR();
        if (w == 0) ET[(32 + lane) * 104 + lane] = (bf16_t)f2bf(gC);
        { const int mt = w >> 1;
#pragma unroll
          for (int u = 0; u < 2; ++u) { const int nt = 2 * (w & 1) + u;
            f32x4 acc = tile_mm(X1 + 16 * mt * 72, 72, X2 + 16 * nt * 72, 72, 2, fr, fq, (f32x4){0.f, 0.f, 0.f, 0.f});
            const int n = 16 * nt + fr, m0 = 16 * mt + 4 * fq;
            if (mt < 2) { if (nt < 2) { const int t = n; f32x4 o;
#pragma unroll
                    for (int e = 0; e < 4; ++e) o[e] = (m0 + e < t) ? acc[e] : 0.f;
                    *(LAS f32x4*)(LBT + t * 36 + m0) = o; }
                else { const int t = n - 32; f32x4 o;
#pragma unroll
                    for (int e = 0; e < 4; ++e) o[e] = (m0 + e <= t) ? acc[e] : 0.f;
                    *(LAS u32x2*)(HT + t * 40 + m0) = pack4(o); } }
            else { const int s0 = m0 - 32;
                if (nt < 2) { const int t = n;
#pragma unroll
                    for (int e = 0; e < 4; ++e) AL[(64 + s0 + e) * 40 + t] = (bf16_t)f2bf((s0 + e < t) ? acc[e] : 0.f); }
                else { const int t = n - 32; f32x4 o;
#pragma unroll
                    for (int e = 0; e < 4; ++e) o[e] = (s0 + e <= t) ? acc[e] : 0.f;
                    *(LAS u32x2*)(ET + t * 104 + 64 + s0) = pack4(o); } } } }
        LBAR();
        if (tid < 32) { const int hb = 16 * (tid >> 4), sl = tid & 15; float Tr[16];
#pragma unroll
            for (int t = 0; t < 16; ++t) { float a0 = (sl == t) ? 1.f : 0.f, a1 = 0.f, a2 = 0.f, a3 = 0.f;
#pragma unroll
                for (int m4 = 0; m4 < (t + 3) / 4; ++m4) { const f32x4 l = *(const LAS f32x4*)(LBT + (hb + t) * 36 + hb + 4 * m4);
                    if (4 * m4 + 0 < t) a0 += Tr[4 * m4 + 0] * l[0]; if (4 * m4 + 1 < t) a1 += Tr[4 * m4 + 1] * l[1]; if (4 * m4 + 2 < t) a2 += Tr[4 * m4 + 2] * l[2]; if (4 * m4 + 3 < t) a3 += Tr[4 * m4 + 3] * l[3]; }
                Tr[t] = (a0 + a1) + (a2 + a3); TF[(hb + sl) * 36 + hb + t] = Tr[t]; TT[(hb + t) * 40 + hb + sl] = (bf16_t)f2bf(Tr[t]);
                if (hb) TT[t * 40 + hb + sl] = 0; } }
        LBAR();
        if (tid < 256) { const int m = tid >> 4, tl = tid & 15; float x = 0.f;
#pragma unroll
            for (int n = 0; n < 16; ++n) x += LBT[(16 + n) * 36 + m] * TF[(16 + n) * 36 + 16 + tl];
            XB[m * 17 + tl] = x; }
        LBAR();
        if (tid < 256) { const int sr = tid >> 4, tl = tid & 15; float x = 0.f;
#pragma unroll
            for (int m = 0; m < 16; ++m) x += TF[sr * 36 + m] * XB[m * 17 + tl];
            TT[(16 + tl) * 40 + sr] = (bf16_t)f2bf(x); }
        LBAR();
        for (int id = w; id < 12; id += 8) { const int tt = id / 6, nt = id % 6;
            const f32x4 acc = tile_mm(TT + 16 * tt * 40, 40, AL + 16 * nt * 40, 40, 1, fr, fq, (f32x4){0.f, 0.f, 0.f, 0.f});
            *(LAS u32x2*)(GI + (16 * nt + fr) * 40 + 16 * tt + 4 * fq) = pack4(acc); }
        LBAR();
        for (int id = w; id < 36; id += 8) { const int nt = id / 6, mt = id % 6;
            const f32x4 acc = tile_mm(GI + 16 * nt * 40, 40, HT + 16 * mt * 40, 40, 1, fr, fq, (f32x4){0.f, 0.f, 0.f, 0.f});
            LAS u32x2* ep = (LAS u32x2*)(ET + (16 * mt + fr) * 104 + 16 * nt + 4 * fq); const u32x2 ev = *ep;
            f32x4 o; o[0] = acc[0] + bf2f(ev.x & 0xffffu); o[1] = acc[1] + bf2f(ev.x >> 16); o[2] = acc[2] + bf2f(ev.y & 0xffffu); o[3] = acc[3] + bf2f(ev.y >> 16);
            *ep = pack4(o); }
        LBAR();
        { bf16_t* fg = FG + (size_t)task * (SC_F * SC_F);
          for (int idx = tid; idx < 96 * 12; idx += 512) { const int row = idx / 12, pc = idx % 12; *(u32x4*)(fg + row * 96 + 8 * pc) = *(const LAS u32x4*)(ET + row * 104 + 8 * pc); } }
        LBAR();
        if (bgconv) tr_finish(cv, ws + WS_W1 + (size_t)ce * 4096 * D, D, cn0, ck0, cscr, lane);
    }
    if (!bgconv) {
        LBAR();
        for (int r = c.vcu * 8 + w; r < NEXP * MOE_W1E; r += c.G * 8) { const int e = r >> 12, rem = r & 4095; tr_item8(p.in[I_W1] + (size_t)e * D * 4096, 4096, ws + WS_W1 + (size_t)e * 4096 * D, D, 32 * (rem & 127), 64 * (rem >> 7), cscr, lane); }
    }
    LBAR();
#undef PRE_LOAD
#undef PRE_UNPK
}
constexpr int SQ_BI = 0, SQ_BI_SZ = 64 * 104 * 2, SQ_YL = 2 * SQ_BI_SZ, SQ_YL_SZ = 32 * 64 * 4;
struct SeqSet { bf16x8 af[3][3]; u32x2 vimg, gimg; float bon; };
__device__ __forceinline__ void p4_seq(const Params& p, const Ctx& c, int bh) {
    unsigned char* ws = c.ws;
    const bf16_t* VZ = (const bf16_t*)(ws + WS_VZ); const bf16_t* GG = (const bf16_t*)(ws + WS_GG); const float* BON = (const float*)(ws + WS_YS);
    const bf16_t* FG = (const bf16_t*)(ws + WS_F) + (size_t)bh * SC_NCH * (SC_F * SC_F);
    bf16_t* YA = (bf16_t*)(ws + WS_YA);
    int tid_ = c.tid; asm volatile("" : "+v"(tid_));
    const int tid = tid_, lane = tid & 63, w = __builtin_amdgcn_readfirstlane(tid >> 6), fr = lane & 15, fq = lane >> 4;
    const int b = bh >> 5, h = bh & 31;
    const size_t base = (size_t)b * SEQ * D + h * 64;
    const int nt = w & 3, mg = w >> 2;
    LAS bf16_t* BI = (LAS bf16_t*)(c.lds + SQ_BI); LAS float* YL = (LAS float*)(c.lds + SQ_YL);
    const int vs = tid >> 4, vi4 = 4 * (tid & 15);
    const f32x4 lg4 = *(const f32x4*)(p.in[I_LNXG] + h * 64 + vi4), lb4 = *(const f32x4*)(p.in[I_LNXB] + h * 64 + vi4);
#define SEQ_LOAD(SET, CHN) do { const int chn_ = (CHN) < SC_NCH ? (CHN) : SC_NCH - 1; const bf16_t* fp = FG + (size_t)chn_ * (SC_F * SC_F); const size_t tk_ = (size_t)b * SEQ + (size_t)(chn_ * SC_C + vs); \
        asm volatile("global_load_dwordx2 %0, %1, off" : "=v"(SET.vimg) : "v"(VZ + tk_ * D + h * 64 + vi4) : "memory"); \
        _Pragma("unroll") for (int mi = 0; mi < 3; ++mi) _Pragma("unroll") for (int ks = 0; ks < 3; ++ks) \
            asm volatile("global_load_dwordx4 %0, %1, off" : "=v"(SET.af[mi][ks]) : "v"(fp + (16 * (3 * mg + mi) + fr) * SC_F + 32 * ks + 8 * fq) : "memory"); \
        asm volatile("global_load_dwordx2 %0, %1, off" : "=v"(SET.gimg) : "v"(GG + tk_ * D + h * 64 + vi4) : "memory"); \
        asm volatile("global_load_dword %0, %1, off" : "=v"(SET.bon) : "v"(BON + tk_ * 32 + h) : "memory"); } while (0)
#define SEQ_WAIT_AF(SET, N) asm volatile("s_waitcnt vmcnt(" #N ")" : "+v"(SET.af[0][0]), "+v"(SET.af[0][1]), "+v"(SET.af[0][2]), "+v"(SET.af[1][0]), "+v"(SET.af[1][1]), "+v"(SET.af[1][2]), \
        "+v"(SET.af[2][0]), "+v"(SET.af[2][1]), "+v"(SET.af[2][2]) :: "memory")
#define SEQ_WAIT_V(SET, N) asm volatile("s_waitcnt vmcnt(" #N ")" : "+v"(SET.vimg) :: "memory")
#define SEQ_WAIT_G(SET, N) asm volatile("s_waitcnt vmcnt(" #N ")" : "+v"(SET.gimg), "+v"(SET.bon), "+v"(SET.vimg) :: "memory")
#define SEQ_BODY(CH, CUR, NXT, NX2) do { const int ch = (CH), cb = ch & 1; \
        const LAS bf16_t* bi = BI + cb * (64 * 104); LAS bf16_t* bo = BI + (cb ^ 1) * (64 * 104); LAS float* yl = YL + cb * (32 * 64); \
        SEQ_LOAD(NX2, ch + 2); \
        bf16x8 bfr[3]; _Pragma("unroll") for (int ks = 0; ks < 3; ++ks) bfr[ks] = *(const LAS bf16x8*)(bi + (16 * nt + fr) * 104 + 32 * ks + 8 * fq); \
        SEQ_WAIT_AF(CUR, 28); \
        f32x4 acc[3]; _Pragma("unroll") for (int mi = 0; mi < 3; ++mi) { acc[mi] = (f32x4){0.f, 0.f, 0.f, 0.f}; \
            _Pragma("unroll") for (int ks = 0; ks < 3; ++ks) acc[mi] = __builtin_amdgcn_mfma_f32_16x16x32_bf16(CUR.af[mi][ks], bfr[ks], acc[mi], 0, 0, 0); } \
        _Pragma("unroll") for (int mi = 0; mi < 3; ++mi) { const int mt = 3 * mg + mi; \
            if (mt < 2) { _Pragma("unroll") for (int e = 0; e < 4; ++e) yl[(16 * mt + 4 * fq + e) * 64 + 16 * nt + fr] = acc[mi][e]; } \
            else *(LAS u32x2*)(bo + (16 * nt + fr) * 104 + 16 * (mt - 2) + 4 * fq) = pack4(acc[mi]); } \
        SEQ_WAIT_V(NXT, 24); \
        if (ch + 1 < SC_NCH) { bo[(vi4 + 0) * 104 + 64 + vs] = (bf16_t)(NXT.vimg.x & 0xffffu); bo[(vi4 + 1) * 104 + 64 + vs] = (bf16_t)(NXT.vimg.x >> 16); \
            bo[(vi4 + 2) * 104 + 64 + vs] = (bf16_t)(NXT.vimg.y & 0xffffu); bo[(vi4 + 3) * 104 + 64 + vs] = (bf16_t)(NXT.vimg.y >> 16); } \
        LBAR(); \
        SEQ_WAIT_G(CUR, 24); \
        { const f32x4 y4 = *(const LAS f32x4*)(yl + vs * 64 + vi4); float sm = (y4[0] + y4[1]) + (y4[2] + y4[3]); \
          sm = DPP_ADD(sm, 0xB1); sm = DPP_ADD(sm, 0x4E); sm = DPP_ADD(sm, 0x141); sm = DPP_ADD(sm, 0x140);     \
          const float mu = sm * (1.0f / 64.0f); const f32x4 d4 = y4 - mu; float q = (d4[0] * d4[0] + d4[1] * d4[1]) + (d4[2] * d4[2] + d4[3] * d4[3]); \
          q = DPP_ADD(q, 0xB1); q = DPP_ADD(q, 0x4E); q = DPP_ADD(q, 0x141); q = DPP_ADD(q, 0x140); \
          const float rstd = rsqrtf(q * (1.0f / 64.0f) + GN_EPS); \
          const float v0 = bf2f(CUR.vimg.x & 0xffffu), v1 = bf2f(CUR.vimg.x >> 16), v2 = bf2f(CUR.vimg.y & 0xffffu), v3 = bf2f(CUR.vimg.y >> 16); \
          const float g0 = bf2f(CUR.gimg.x & 0xffffu), g1 = bf2f(CUR.gimg.x >> 16), g2 = bf2f(CUR.gimg.y & 0xffffu), g3 = bf2f(CUR.gimg.y >> 16); \
          const float o0 = (d4[0] * rstd * lg4[0] + lb4[0] + CUR.bon * v0) * g0, o1 = (d4[1] * rstd * lg4[1] + lb4[1] + CUR.bon * v1) * g1; \
          const float o2 = (d4[2] * rstd * lg4[2] + lb4[2] + CUR.bon * v2) * g2, o3 = (d4[3] * rstd * lg4[3] + lb4[3] + CUR.bon * v3) * g3; \
          *(u32x2*)(YA + base + (size_t)(ch * SC_C + vs) * D + vi4) = (u32x2){pk2(o0, o1), pk2(o2, o3)}; } } while (0)
    SeqSet sa, sb, sc;
    SEQ_LOAD(sa, 0); SEQ_LOAD(sb, 1);
    SEQ_WAIT_V(sa, 0);
    for (int idx = tid; idx < 64 * 8; idx += 512) *(LAS u32x4*)(BI + (idx >> 3) * 104 + 8 * (idx & 7)) = (u32x4){0u, 0u, 0u, 0u};
    BI[(vi4 + 0) * 104 + 64 + vs] = (bf16_t)(sa.vimg.x & 0xffffu); BI[(vi4 + 1) * 104 + 64 + vs] = (bf16_t)(sa.vimg.x >> 16);
    BI[(vi4 + 2) * 104 + 64 + vs] = (bf16_t)(sa.vimg.y & 0xffffu); BI[(vi4 + 3) * 104 + 64 + vs] = (bf16_t)(sa.vimg.y >> 16);
    LBAR();
    for (int c0 = 0; c0 < SC_NCH; c0 += 3) {
        SEQ_BODY(c0, sa, sb, sc);
        if (c0 + 1 < SC_NCH) SEQ_BODY(c0 + 1, sb, sc, sa);
        if (c0 + 2 < SC_NCH) SEQ_BODY(c0 + 2, sc, sa, sb);
    }
    asm volatile("s_waitcnt vmcnt(0)" ::: "memory");
    LBAR();
#undef SEQ_LOAD
#undef SEQ_BODY
#undef SEQ_WAIT_AF
#undef SEQ_WAIT_V
#undef SEQ_WAIT_G
}

__device__ __forceinline__ void p4_attn_task(const Ctx& c, int task) {
    unsigned char* ws = c.ws;
    const bf16_t* QR = (const bf16_t*)(ws + WS_QR); const bf16_t* KR = (const bf16_t*)(ws + WS_KR); const bf16_t* VR = (const bf16_t*)(ws + WS_VR);
    float* AO = (float*)(ws + WS_AO); float* LSE = (float*)(ws + WS_LSE);
    constexpr int VP = 280;
    LAS bf16_t* Vt = (LAS bf16_t*)c.lds;
    const int combo = task & 31, hh = (task >> 5) % 24, b = task / (32 * 24);
    const int g = hh >> 3, h = hh & 7;
    const int dil = g == 0 ? 1 : (g == 1 ? 4 : 16), nblk = 32 / dil;
    const int res = combo / nblk, blk = combo % nblk;
    int tid_ = c.tid; asm volatile("" : "+v"(tid_));
    const int tid = tid_, lane = tid & 63, w = __builtin_amdgcn_readfirstlane(tid >> 6);
    const int qq = lane & 15, g4 = lane >> 4, r0 = 16 * w;
    const size_t rowb = (size_t)(b * 24 + hh) * SEQ + (size_t)res * (SEQ / dil) + (size_t)blk * 128;
    bf16x8 qf[2], kf[9][2];
#pragma unroll
    for (int ks = 0; ks < 2; ++ks) qf[ks] = *(const bf16x8*)(QR + (rowb + r0 + qq) * 64 + 32 * ks + 8 * g4);
#pragma unroll
    for (int kt = 0; kt < 9; ++kt) { const bool kv = (blk > 0) || (w + kt >= 8);
#pragma unroll
        for (int ks = 0; ks < 2; ++ks) { kf[kt][ks] = (bf16x8){0, 0, 0, 0, 0, 0, 0, 0};
            if (kv) kf[kt][ks] = *(const bf16x8*)(KR + (rowb - 128 + 16 * (w + kt) + qq) * 64 + 32 * ks + 8 * g4); } }
    const int vki = tid >> 1, vdh = tid & 1;
    u32x4 vv[4];
    if (blk > 0 || vki >= 128) {
#pragma unroll
        for (int j = 0; j < 4; ++j) vv[j] = *(const u32x4*)(VR + (rowb - 128 + vki) * 64 + 32 * vdh + 8 * j); }
    else {
#pragma unroll
        for (int j = 0; j < 4; ++j) vv[j] = (u32x4){0u, 0u, 0u, 0u}; }
    __syncthreads();
#pragma unroll
    for (int j = 0; j < 4; ++j) { const unsigned wv[4] = {vv[j].x, vv[j].y, vv[j].z, vv[j].w};
#pragma unroll
        for (int e = 0; e < 8; ++e) Vt[(32 * vdh + 8 * j + e) * VP + vki] = (bf16_t)((wv[e >> 1] >> (16 * (e & 1))) & 0xffffu); }
    if (tid < 64) {
#pragma unroll
        for (int e = 0; e < 24; ++e) Vt[tid * VP + 256 + e] = 0; }
    f32x4 sc[10];
#pragma unroll
    for (int kt = 0; kt < 9; ++kt) { f32x4 a = (f32x4){0.f, 0.f, 0.f, 0.f};
#pragma unroll
        for (int ks = 0; ks < 2; ++ks) a = __builtin_amdgcn_mfma_f32_16x16x32_bf16(kf[kt][ks], qf[ks], a, 0, 0, 0);
        sc[kt] = a; }
    const int r = r0 + qq;
    float mx = -3.0e38f;
#pragma unroll
    for (int kt = 0; kt < 9; ++kt)
#pragma unroll
        for (int j = 0; j < 4; ++j) { const int ki = 16 * (w + kt) + 4 * g4 + j; const bool ok = (ki >= r) && (ki <= r + 128) && (blk > 0 || ki >= 128);
            const float sv = ok ? sc[kt][j] * 0.125f : -1.0e30f; sc[kt][j] = sv; mx = fmaxf(mx, sv); }
    mx = fmaxf(mx, __shfl_xor(mx, 16)); mx = fmaxf(mx, __shfl_xor(mx, 32));
    float den = 0.f;
#pragma unroll
    for (int kt = 0; kt < 9; ++kt)
#pragma unroll
        for (int j = 0; j < 4; ++j) { const float pexp = __expf(sc[kt][j] - mx); sc[kt][j] = pexp; den += pexp; }
    den += __shfl_xor(den, 16); den += __shfl_xor(den, 32);
    sc[9] = (f32x4){0.f, 0.f, 0.f, 0.f};
    __syncthreads();
    f32x4 oacc[4];
#pragma unroll
    for (int dt = 0; dt < 4; ++dt) oacc[dt] = (f32x4){0.f, 0.f, 0.f, 0.f};
#pragma unroll
    for (int cidx = 0; cidx < 5; ++cidx) {
        const f32x4 p0 = sc[2 * cidx], p1 = sc[2 * cidx + 1];
        u32x4 pw; pw.x = pk2(p0[0], p0[1]); pw.y = pk2(p0[2], p0[3]); pw.z = pk2(p1[0], p1[1]); pw.w = pk2(p1[2], p1[3]);
        const bf16x8 pf = __builtin_bit_cast(bf16x8, pw);
        const int kbase = 16 * (w + 2 * cidx) + 4 * g4;
#pragma unroll
        for (int dt = 0; dt < 4; ++dt) { const LAS bf16_t* vp = Vt + (16 * dt + qq) * VP + kbase;
            const u32x2 lo = *(const LAS u32x2*)vp, hi = *(const LAS u32x2*)(vp + 16);
            u32x4 vw; vw.x = lo.x; vw.y = lo.y; vw.z = hi.x; vw.w = hi.y;
            oacc[dt] = __builtin_amdgcn_mfma_f32_16x16x32_bf16(__builtin_bit_cast(bf16x8, vw), pf, oacc[dt], 0, 0, 0); }
    }
    const float inv = 1.0f / den;
    const size_t tok = (size_t)b * SEQ + (size_t)(blk * 128 + r) * dil + res;
#pragma unroll
    for (int dt = 0; dt < 4; ++dt) *(f32x4*)(AO + ((size_t)g * M + tok) * 512 + h * 64 + 16 * dt + 4 * g4) = oacc[dt] * inv;
    if (g4 == 0) LSE[((size_t)g * M + tok) * 8 + h] = mx + __logf(den);
}

constexpr int Q_ATT = 3072, Q_TOTAL = Q_ATT + MOE_CONV_GROUPS;
__device__ __forceinline__ void p4_queue(const Params& p, const Ctx& c, volatile LAS unsigned* qslot) {
    unsigned* qc = (unsigned*)(c.ws + WS_CTL) + CW_Q;
    for (;;) {
        __syncthreads();
        if (c.tid == 0) qslot[0] = __hip_atomic_fetch_add(qc, 1u, __ATOMIC_RELAXED, __HIP_MEMORY_SCOPE_AGENT);
        __syncthreads();
        const unsigned it = qslot[0];
        if (it >= (unsigned)Q_TOTAL) break;
        if (it < (unsigned)Q_ATT) p4_attn_task(c, (int)it); else conv_group(p, c, (int)it - Q_ATT);
    }
}

__device__ __forceinline__ void p5_post(const Params& p, const Ctx& c) {
    unsigned char* ws = c.ws;
    const float* AO = (const float*)(ws + WS_AO); const float* LSE = (const float*)(ws + WS_LSE);
    bf16_t* YB = (bf16_t*)(ws + WS_YB);
    const int gw = c.vcu * 8 + c.wave, NGW = c.G * 8, lane = c.lane;
    for (int it = gw; it < M * 8; it += NGW) {
        const int t = it >> 3, h = it & 7;
        const float l0 = LSE[((size_t)0 * M + t) * 8 + h], l1 = LSE[((size_t)1 * M + t) * 8 + h], l2 = LSE[((size_t)2 * M + t) * 8 + h];
        const float mxl = fmaxf(l0, fmaxf(l1, l2)); const float e0 = __expf(l0 - mxl), e1 = __expf(l1 - mxl), e2 = __expf(l2 - mxl); const float inv = 1.0f / (e0 + e1 + e2);
        const size_t o = (size_t)t * 512 + h * 64 + lane;
        const float v = (e0 * AO[o] + e1 * AO[(size_t)M * 512 + o] + e2 * AO[(size_t)2 * M * 512 + o]) * inv;
        YB[o] = (bf16_t)f2bf(v);
    }
}

__device__ __forceinline__ void ln_rows(const Ctx& c, const float* in, const float* gam, const float* bet, float* outf, bf16_t* outb, unsigned char* outq = nullptr) {
    const int gw = c.vcu * 8 + c.wave, NGW = c.G * 8, lane = c.lane;
    for (int m = gw; m < M; m += NGW) {
        const f32x4* xr = (const f32x4*)(in + (size_t)m * D) + lane;
        f32x4 v[8]; float s = 0.f;
#pragma unroll
        for (int j = 0; j < 8; ++j) { v[j] = xr[64 * j]; s += (v[j][0] + v[j][1]) + (v[j][2] + v[j][3]); }
        const float mean = wave_sum(s) * (1.0f / D); float s2 = 0.f;
#pragma unroll
        for (int j = 0; j < 8; ++j) { v[j] = v[j] - mean; s2 += (v[j][0] * v[j][0] + v[j][1] * v[j][1]) + (v[j][2] * v[j][2] + v[j][3] * v[j][3]); }
        const float rstd = rsqrtf(wave_sum(s2) * (1.0f / D) + LN_EPS);
#pragma unroll
        for (int j = 0; j < 8; ++j) { const int col = 4 * lane + 256 * j; const f32x4 gv = *(const f32x4*)(gam + col), bv = *(const f32x4*)(bet + col);
            const f32x4 o = v[j] * rstd * gv + bv;
            *(f32x4*)(outf + (size_t)m * D + col) = o;
            if (outb) { u32x2 w; w.x = pk2(o[0], o[1]); w.y = pk2(o[2], o[3]); *(u32x2*)(outb + (size_t)m * D + col) = w; }
            if (outq) *(unsigned*)(outq + (size_t)m * D + col) = pk4_fp8(o[0], o[1], o[2], o[3]); }
    }
}

__device__ __forceinline__ void p15_router(const Params& p, const Ctx& c) {
    unsigned char* ws = c.ws;
    const float* X2 = (const float*)(ws + WS_X2); const float* RW = p.in[I_RW]; const float* RB = p.in[I_RB];
    unsigned* cnt = (unsigned*)(ws + WS_CTL) + CW_CNT; int* LIST = (int*)(ws + WS_LIST); int* ROWI = (int*)(ws + WS_ROWI); float* TOPW = (float*)(ws + WS_TOPW);
    LAS float* scr = (LAS float*)(c.lds + c.wave * 8192);
    const int gw = c.vcu * 8 + c.wave, NGW = c.G * 8, lane = c.lane, li = lane & 31, lk = lane >> 5;
    for (int tb = gw; tb < M / 32; tb += NGW) {
        const int t0 = tb * 32;
        f32x16 acc;
#pragma unroll
        for (int j = 0; j < 16; ++j) acc[j] = 0.f;
        const float* xa = X2 + (size_t)(t0 + li) * D + 4 * lk;
        const float* wb = RW + (size_t)(4 * lk) * 32 + li;
        for (int kb = 0; kb < D / 8; ++kb) {
            const f32x4 a = *(const f32x4*)(xa + 8 * kb);
            const float b0 = wb[(size_t)(8 * kb + 0) * 32], b1 = wb[(size_t)(8 * kb + 1) * 32], b2 = wb[(size_t)(8 * kb + 2) * 32], b3 = wb[(size_t)(8 * kb + 3) * 32];
            acc = __builtin_amdgcn_mfma_f32_32x32x2f32(a[0], b0, acc, 0, 0, 0);
            acc = __builtin_amdgcn_mfma_f32_32x32x2f32(a[1], b1, acc, 0, 0, 0);
            acc = __builtin_amdgcn_mfma_f32_32x32x2f32(a[2], b2, acc, 0, 0, 0);
            acc = __builtin_amdgcn_mfma_f32_32x32x2f32(a[3], b3, acc, 0, 0, 0);
        }
        const float bias = RB[li];
#pragma unroll
        for (int rg = 0; rg < 16; ++rg) { const int row = (rg & 3) + 8 * (rg >> 2) + 4 * lk; scr[row * 33 + li] = acc[rg] + bias; }
        LDS_WAIT(); asm volatile("" ::: "memory");
        if (lane < 32) {
            float lv[32];
#pragma unroll
            for (int e = 0; e < 32; ++e) lv[e] = scr[lane * 33 + e];
            int id[4]; float tv[4];
#pragma unroll
            for (int k = 0; k < 4; ++k) { float best = -3.0e38f; int bi = 0;
#pragma unroll
                for (int e = 0; e < 32; ++e) { const bool tk = lv[e] > best; best = tk ? lv[e] : best; bi = tk ? e : bi; }
                id[k] = bi; tv[k] = best;
#pragma unroll
                for (int e = 0; e < 32; ++e) lv[e] = (e == bi) ? -3.0e38f : lv[e]; }
            const float e1 = __expf(tv[1] - tv[0]), e2 = __expf(tv[2] - tv[0]), e3 = __expf(tv[3] - tv[0]); const float inv = 1.0f / (1.0f + e1 + e2 + e3);
            const float wv[4] = {inv, e1 * inv, e2 * inv, e3 * inv};
            const int t = t0 + lane;
#pragma unroll
            for (int k = 0; k < 4; ++k) { const unsigned slot = __hip_atomic_fetch_add(cnt + id[k], 1u, __ATOMIC_RELAXED, __HIP_MEMORY_SCOPE_AGENT);
                LIST[(size_t)id[k] * CAP + slot] = t; ROWI[(size_t)t * 4 + k] = id[k] * CAP + (int)slot; TOPW[(size_t)t * 4 + k] = wv[k]; }
        }
        LDS_WAIT(); asm volatile("" ::: "memory");
    }
}

__device__ __forceinline__ void moe_table(const Ctx& c, LAS int* tab) {
    if (c.tid == 0) { unsigned* cnt = (unsigned*)(c.ws + WS_CTL) + CW_CNT; int ts = 0;
        for (int e = 0; e < NEXP; ++e) { const int n = (int)__hip_atomic_load(cnt + e, __ATOMIC_RELAXED, __HIP_MEMORY_SCOPE_AGENT); tab[e] = n; tab[32 + e] = ts; ts += (n + 255) >> 8; }
        tab[64] = ts; }
    __syncthreads();
}

__device__ __forceinline__ void p18_combine(const Params& p, const Ctx& c, const LAS int* tab) {
    unsigned char* ws = c.ws;
    const float* X2 = (const float*)(ws + WS_X2); const bf16_t* Y = (const bf16_t*)(ws + WS_Y); const int* ROWI = (const int*)(ws + WS_ROWI); const float* TOPW = (const float*)(ws + WS_TOPW);
    const float* gam = p.in[I_LN3G]; const float* bet = p.in[I_LN3B];
    const int gw = c.vcu * 8 + c.wave, NGW = c.G * 8, lane = c.lane;
    for (int m = gw; m < M; m += NGW) {
        f32x4 v[8];
        const f32x4* xr = (const f32x4*)(X2 + (size_t)m * D) + lane;
#pragma unroll
        for (int j = 0; j < 8; ++j) v[j] = xr[64 * j] * DN_ALPHA;
#pragma unroll
        for (int k = 0; k < 4; ++k) { const int ri = ROWI[(size_t)m * 4 + k]; const float gt = TOPW[(size_t)m * 4 + k]; const int e = ri >> 14, slot = ri & (CAP - 1);
            const u32x2* yr = (const u32x2*)(Y + ((size_t)tab[32 + e] * 256 + slot) * D) + lane;
#pragma unroll
            for (int j = 0; j < 8; ++j) { const u32x2 yw = yr[64 * j]; v[j] = v[j] + (f32x4){bf2f(yw.x & 0xffffu), bf2f(yw.x >> 16), bf2f(yw.y & 0xffffu), bf2f(yw.y >> 16)} * gt; } }
        float s = 0.f;
#pragma unroll
        for (int j = 0; j < 8; ++j) s += (v[j][0] + v[j][1]) + (v[j][2] + v[j][3]);
        const float mean = wave_sum(s) * (1.0f / D); float s2 = 0.f;
#pragma unroll
        for (int j = 0; j < 8; ++j) { v[j] = v[j] - mean; s2 += (v[j][0] * v[j][0] + v[j][1] * v[j][1]) + (v[j][2] * v[j][2] + v[j][3] * v[j][3]); }
        const float rstd = rsqrtf(wave_sum(s2) * (1.0f / D) + LN_EPS);
#pragma unroll
        for (int j = 0; j < 8; ++j) { const int col = 4 * lane + 256 * j; const f32x4 gv = *(const f32x4*)(gam + col), bv = *(const f32x4*)(bet + col);
            *(f32x4*)(p.out + (size_t)m * D + col) = v[j] * rstd * gv + bv; }
    }
}

constexpr int NPHASE = 19;
__global__ void __launch_bounds__(512, 2) fwd(Params p) {
    extern __shared__ __attribute__((aligned(16))) unsigned char lds_raw[];
    LAS unsigned char* lds = (LAS unsigned char*)lds_raw;
    Ctx c; c.tid = threadIdx.x; c.lane = c.tid & 63; c.wave = __builtin_amdgcn_readfirstlane(c.tid >> 6); c.G = gridDim.x;
    { const int bx = blockIdx.x; c.vcu = (c.G % 8 == 0) ? (bx % 8) * (c.G / 8) + bx / 8 : bx; }
    c.lds = lds; c.ws = p.ws;
    unsigned char* ws = p.ws;
    volatile LAS unsigned* MISC = (volatile LAS unsigned*)(lds + MISC_OFF);
    LAS int* tab = (LAS int*)(lds + MISC_OFF + 1024);
    if (c.tid < 64) MISC[c.tid] = 0u;
    __syncthreads();
    unsigned* ctl = (unsigned*)(ws + WS_CTL);
    XcdBarrier bar; bar.bar = ctl + CW_BAR + p.li * XCD_BAR_WORDS; bar.x = 0; bar.st = MISC + 8;
    if (N_LAUNCH_MODE == 1) bar = xcd_barrier_post(ctl + CW_BAR + p.li * XCD_BAR_WORDS, MISC + 8);
    const int lo = p.ph_lo, hi = p.ph_hi, bx = blockIdx.x;
#ifndef PHMASK
#define PHMASK 0xFFFFFFFFu
#endif
#define IN(k) (((PHMASK >> (k)) & 1u) && lo <= (k) && (k) < hi)
#define SEAM(k) do { if (N_LAUNCH_MODE == 1 && IN((k) + 1)) xcd_barrier(bar); } while (0)

    if (IN(0)) { p0_prologue(p, c); SEAM(0); }

    if (IN(1)) {
        pg8::StaticOrder S; S.init(ws + WS_XB, ws + WS_WIN, M, PC, D, D, c.G, bx);
        pg8::EpiBf16 E{(bf16_t*)(ws + WS_PROJ), PC, 1.0f};
        pg8::gemm_phase<pg8::EpiBf16, pg8::StaticOrder>(lds, pg8::Gemm{D, D, D}, S, E);
        SEAM(1);
    }
    if (IN(2)) { p2_prep(p, c); SEAM(2); }

    if (IN(3)) {
#ifndef P3M
#define P3M 15
#endif
        if (P3M & 1) { pg8::StaticOrder S; S.init(ws + WS_LIN, ws + WS_WUP, M, D, 768, 256, c.G, bx);
          pg8::EpiDecay E{(float*)(ws + WS_DEC), p.in[I_W0]};
          pg8::gemm_phase<pg8::EpiDecay, pg8::StaticOrder>(lds, pg8::Gemm{256, 768, 256}, S, E); }
        if (P3M & 2) { pg8::StaticOrder S; S.init(ws + WS_LIN + 512, ws + WS_AUP, M, D, 768, 256, c.G, bx);
          pg8::EpiIclr E{p.in[I_A0], p.in[I_KK], p.in[I_KA], (const bf16_t*)(ws + WS_KZ), (const float*)(ws + WS_KNORM), (bf16_t*)(ws + WS_KP), (bf16_t*)(ws + WS_AN), (bf16_t*)(ws + WS_BB)};
          pg8::gemm_phase<pg8::EpiIclr, pg8::StaticOrder>(lds, pg8::Gemm{256, 768, 256}, S, E); }
        if (P3M & 4) { pg8::StaticOrder S; S.init(ws + WS_LIN + 1024, ws + WS_GUP, M, D, 768, 256, c.G, bx);
          pg8::EpiBf16 E{(bf16_t*)(ws + WS_GG), D, 1.0f};
          pg8::gemm_phase<pg8::EpiBf16, pg8::StaticOrder>(lds, pg8::Gemm{256, 768, 256}, S, E); }
        if (P3M & 8) { pg8::StaticOrder S; S.init(ws + WS_MEMB, ws + WS_WKV, 1024, 2 * D, D, D, c.G, bx);
          pg8::EpiKV E{(bf16_t*)(ws + WS_KB), (bf16_t*)(ws + WS_VT)};
          pg8::gemm_phase<pg8::EpiKV, pg8::StaticOrder>(lds, pg8::Gemm{D, D, D}, S, E); }
        SEAM(3);
    }
    if (IN(4)) {
        p4_pre(p, c);
        xcd_barrier(bar);
        for (int bh = c.vcu; bh < 128; bh += c.G) p4_seq(p, c, bh);
        p4_queue(p, c, MISC + 16);
        SEAM(4);
    }
    if (IN(5)) { p5_post(p, c); }

    if (IN(6)) {
        pg8::StaticOrder S; S.init(ws + WS_YA, ws + WS_PA, M, D, D, D, c.G, bx);
        pg8::EpiGateA E{(const bf16_t*)(ws + WS_PROJ), (float*)(ws + WS_TMP)};
        pg8::gemm_phase<pg8::EpiGateA, pg8::StaticOrder>(lds, pg8::Gemm{D, D, D}, S, E);
        SEAM(6);
    }
    if (IN(7)) {
        pg8::StaticOrder S; S.init(ws + WS_YB, ws + WS_PB, M, D, 512, 512, c.G, bx);
        pg8::EpiGateB E{(const bf16_t*)(ws + WS_PROJ), (const float*)(ws + WS_TMP), (bf16_t*)(ws + WS_MERGED)};
        pg8::gemm_phase<pg8::EpiGateB, pg8::StaticOrder>(lds, pg8::Gemm{512, 512, 512}, S, E);
        SEAM(7);
    }
    if (IN(8)) {
        pg8::StaticOrder S; S.init(ws + WS_MERGED, ws + WS_WOUT, M, D, D, D, c.G, bx);
        pg8::EpiF32 E{(float*)(ws + WS_T1), D, nullptr, 0, p.in[I_X], DN_ALPHA};
        pg8::gemm_phase<pg8::EpiF32, pg8::StaticOrder>(lds, pg8::Gemm{D, D, D}, S, E);
        SEAM(8);
    }
    if (IN(9)) { ln_rows(c, (const float*)(ws + WS_T1), p.in[I_LN1G], p.in[I_LN1B], (float*)(ws + WS_X1), (bf16_t*)(ws + WS_X1B)); SEAM(9); }

    if (IN(10)) {
        pg8::StaticOrder S; S.init(ws + WS_X1B, ws + WS_WQ, M, D, D, D, c.G, bx);
        pg8::EpiBf16 E{(bf16_t*)(ws + WS_Q), D, 0.04419417382415922f};
        pg8::gemm_phase<pg8::EpiBf16, pg8::StaticOrder>(lds, pg8::Gemm{D, D, D}, S, E);
        SEAM(10);
    }
    if (IN(11)) {
        ScoreOrder S{(const char*)(ws + WS_Q), (const char*)(ws + WS_KB), c.G, bx};
        pg8::EpiSoftmax E{(bf16_t*)(ws + WS_PP)};
        pg8::gemm_phase<pg8::EpiSoftmax, ScoreOrder, false>(lds, pg8::Gemm{512, D, D}, S, E);
        SEAM(11);
    }
    if (IN(12)) {
        PvOrder S{(const char*)(ws + WS_PP), (const char*)(ws + WS_VT), c.G, bx};
        pg8::EpiBf16 E{(bf16_t*)(ws + WS_OC), D, 1.0f};
        pg8::gemm_phase<pg8::EpiBf16, PvOrder>(lds, pg8::Gemm{256, 256, 256}, S, E);
        SEAM(12);
    }
    if (IN(13)) {
        pg8::StaticOrder S; S.init(ws + WS_OC, ws + WS_WO, M, D, D, D, c.G, bx);
        pg8::EpiF32 E{(float*)(ws + WS_T2), D, nullptr, 0, (const float*)(ws + WS_X1), DN_ALPHA};
        pg8::gemm_phase<pg8::EpiF32, pg8::StaticOrder>(lds, pg8::Gemm{D, D, D}, S, E);
        SEAM(13);
    }
    if (IN(14)) { ln_rows(c, (const float*)(ws + WS_T2), p.in[I_LN2G], p.in[I_LN2B], (float*)(ws + WS_X2), nullptr, ws + WS_X2B); SEAM(14); }
    if (IN(15)) { p15_router(p, c); SEAM(15); }

    if (IN(16)) {
        moe_table(c, tab);
        MoeOrder<true, 16> S{tab, (const char*)(ws + WS_X2B), (const char*)(ws + WS_W1), (const int*)(ws + WS_LIST), (size_t)4096 * D, D, c.G, bx};
        pg8::EpiSwiglu E{p.in[I_B1], (bf16_t*)(ws + WS_H)};
        pg8::gemm_phase<pg8::EpiSwiglu, MoeOrder<true, 16>, true, true>(lds, pg8::Gemm{D, D, D}, S, E);
        SEAM(16);
    }
    if (IN(17)) {
        moe_table(c, tab);
        MoeOrder<false, 8> S{tab, (const char*)(ws + WS_H), (const char*)(ws + WS_W2), (const int*)(ws + WS_LIST), (size_t)D * DFF, DFF, c.G, bx};
        pg8::EpiBf16Bias E{(bf16_t*)(ws + WS_Y), D, p.in[I_B2], D};
        pg8::gemm_phase<pg8::EpiBf16Bias, MoeOrder<false, 8>, true, true>(lds, pg8::Gemm{DFF, DFF, DFF}, S, E);
        SEAM(17);
    }
    if (IN(18)) { moe_table(c, tab); p18_combine(p, c, tab); }
#undef IN
#undef SEAM
}

extern "C" void kernel_launch(void* const* d_in, const int* in_sizes, int n_in, void* d_out, int out_size, void* d_ws, size_t ws_size, hipStream_t stream) {
    static int grid = 0;
    if (grid == 0) {
        if (n_in != 32 || out_size != M * D || ws_size < WS_END) { fprintf(stderr, "kernel_launch: expected 32 inputs, %d outputs, >= %zu bytes of workspace; got %d, %d, %zu\n", M * D, (size_t)WS_END, n_in, out_size, ws_size); grid = -1; return; }
        int dev = 0, cus = 0, per_cu = 0;
        if (hipGetDevice(&dev) != hipSuccess || hipDeviceGetAttribute(&cus, hipDeviceAttributeMultiprocessorCount, dev) != hipSuccess) { grid = -1; return; }
        if (hipFuncSetAttribute((const void*)fwd, hipFuncAttributeMaxDynamicSharedMemorySize, LDS_BYTES) != hipSuccess) { fprintf(stderr, "kernel_launch: hipFuncSetAttribute failed\n"); grid = -1; return; }
        if (hipOccupancyMaxActiveBlocksPerMultiprocessor(&per_cu, (const void*)fwd, 512, LDS_BYTES) != hipSuccess || per_cu < 1) fprintf(stderr, "kernel_launch: occupancy query reports %d\n", per_cu);
        (void)hipGetLastError();
        grid = cus;
        if (grid != 256) fprintf(stderr, "kernel_launch: %d CUs; this kernel is built for 256\n", grid);
    }
    if (grid < 0) return;
    (void)hipMemsetAsync((char*)d_ws + WS_CTL, 0, CTL_ZERO_BYTES, stream);
    Params p{};
    for (int i = 0; i < 32; ++i) p.in[i] = (const float*)d_in[i];
    p.out = (float*)d_out; p.ws = (unsigned char*)d_ws;
#if defined(TIMING_REPEAT_LO)
    { const int cuts[4][2] = {{0, TIMING_REPEAT_HI}, {TIMING_REPEAT_LO, TIMING_REPEAT_HI}, {TIMING_REPEAT_HI, NPHASE}, {0, 0}};
      for (int li = 0; li < 3; ++li) { if (cuts[li][0] >= cuts[li][1]) continue; p.ph_lo = cuts[li][0]; p.ph_hi = cuts[li][1]; p.li = li; hipLaunchKernelGGL(fwd, dim3(grid), dim3(512), LDS_BYTES, stream, p); } }
#else
    if (N_LAUNCH_MODE == 1) { p.ph_lo = 0; p.ph_hi = NPHASE; hipLaunchKernelGGL(fwd, dim3(grid), dim3(512), LDS_BYTES, stream, p); }
    else for (int k = 0; k < NPHASE; ++k) { p.ph_lo = k; p.ph_hi = k + 1; hipLaunchKernelGGL(fwd, dim3(grid), dim3(512), LDS_BYTES, stream, p); }
#endif
}
```

```cpp
#include <hip/hip_runtime.h>
#include <cstdio>
#include <cstdint>

#define LAS __attribute__((address_space(3)))
#define GAS __attribute__((address_space(1)))
typedef unsigned short bf16_t;
typedef short bf16x8 __attribute__((ext_vector_type(8)));
typedef float f32x4 __attribute__((ext_vector_type(4)));
typedef float f32x2 __attribute__((ext_vector_type(2)));
typedef float f32x16 __attribute__((ext_vector_type(16)));
typedef unsigned u32x4 __attribute__((ext_vector_type(4)));
typedef unsigned u32x2 __attribute__((ext_vector_type(2)));

#ifndef N_LAUNCH_MODE
#define N_LAUNCH_MODE 1
#endif

constexpr int M = 16384, D = 2048, SEQ = 4096, NBATCH = 4;
constexpr int RWC = 6592;
constexpr int PC = 15360;
constexpr int ATT0 = 6656, GATE0 = 11264;
constexpr int NEXP = 32, DFF = 2048, CAP = 16384;
constexpr int HROWS = 65536 + 32 * 256;
constexpr float LN_EPS = 1e-5f, GN_EPS = 64e-5f;
constexpr float DN_ALPHA = 1.189207115002721f;

__device__ __forceinline__ float bf2f(unsigned v) { return __uint_as_float(v << 16); }
__device__ __forceinline__ unsigned f2bf(float f) { unsigned u = __float_as_uint(f); return (u + 0x7fffu + ((u >> 16) & 1u)) >> 16; }
__device__ __forceinline__ unsigned pk2(float lo, float hi) { return f2bf(lo) | (f2bf(hi) << 16); }
typedef int v4i __attribute__((ext_vector_type(4)));
typedef int v8i __attribute__((ext_vector_type(8)));
__device__ __forceinline__ unsigned pk4_fp8(float a, float b, float c, float d) { int r = __builtin_amdgcn_cvt_pk_fp8_f32(a, b, 0, false); r = __builtin_amdgcn_cvt_pk_fp8_f32(c, d, r, true); return (unsigned)r; }
__device__ __forceinline__ float sigmoidf_(float x) { return 1.0f / (1.0f + __expf(-x)); }
__device__ __forceinline__ float wave_sum(float v) {
#pragma unroll
    for (int o = 1; o < 64; o <<= 1) v += __shfl_xor(v, o);
    return v;
}
#define LDS_WAIT() asm volatile("s_waitcnt lgkmcnt(0)" ::: "memory")
#define VM_WAIT() asm volatile("s_waitcnt vmcnt(0)" ::: "memory")

namespace pg8 {
#define PG8_LAS __attribute__((address_space(3)))
constexpr int BM = 256, BK = 64, HALF = 128, HTB = HALF * BK * 2, STAGE_BYTES = 8 * HTB, NXCD = 8, WGM = 8;

__host__ __device__ __forceinline__ int lds_byte(int r, int c) { const int st = (r >> 4) * 2 + (c >> 5), rr = r & 15, cc = c & 31, ob = rr * 64 + cc * 2; return st * 1024 + (ob ^ (((ob >> 9) & 1) << 5)); }
__host__ __device__ __forceinline__ void stage_rc(int b, int& R, int& C) { const int st = b / 1024, sb = b % 1024, swz = sb ^ (((sb >> 9) & 1) << 5); R = (st >> 1) * 16 + swz / 64; C = (st & 1) * 32 + (swz % 64) / 2; }
__host__ __device__ __forceinline__ int perm32(int rho) { const int n = rho >> 4, i = rho & 15; return 8 * (i >> 2) + 4 * n + (i & 3); }

struct Unit { const char* A; const char* B; int orow, ocol, aux, aux2, valid; };
struct Gemm { int K, lda, ldb; };

struct StaticOrder {
    static constexpr bool GATHER = false;
    const char* A; const char* Bt; size_t ta, tb;
    int nM, nN, nwg, G, c;
    __device__ void init(const void* A_, const void* Bt_, int M_, int N_, int lda, int ldb, int G_, int c_) { A = (const char*)A_; Bt = (const char*)Bt_; ta = (size_t)BM * lda * 2; tb = (size_t)BM * ldb * 2; nM = M_ / BM; nN = N_ / BM; nwg = nM * nN; G = G_; c = c_; }
    __device__ bool next(int i, Unit& u) const {
        const long L = (long)i * G + c; if (c < 0 || L >= nwg) return false;
        int wgid = (int)L; { const int q = nwg / NXCD, r = nwg % NXCD, xcd = wgid % NXCD, off = wgid / NXCD; wgid = (xcd < r ? xcd * (q + 1) : r * (q + 1) + (xcd - r) * q) + off; }
        const int nig = WGM * nN, gid = wgid / nig, fm = gid * WGM, gsz = (nM - fm) < WGM ? (nM - fm) : WGM;
        const int pm = fm + ((wgid % nig) % gsz), pn = (wgid % nig) / gsz;
        u.A = A + (size_t)pm * ta; u.B = Bt + (size_t)pn * tb; u.orow = pm * BM; u.ocol = pn * BM; u.aux = 0; u.aux2 = 0; u.valid = BM; return true;
    }
    __device__ __forceinline__ const int* rows(const Unit&) const { return nullptr; }
};

__device__ __forceinline__ unsigned cvt_pk_bf16(float lo, float hi) { unsigned r; asm volatile("v_cvt_pk_bf16_f32 %0, %1, %2" : "=v"(r) : "v"(lo), "v"(hi)); return r; }

template <class Epi, class Sched, bool ALIGN_EPI = true, bool FP8 = false>
__device__ __forceinline__ void gemm_phase(PG8_LAS unsigned char* lds, const Gemm g, const Sched& S, const Epi& E) {
    const int tid = threadIdx.x, wid = __builtin_amdgcn_readfirstlane(tid >> 6), lane = tid & 63, wr = wid >> 2, wc = wid & 3, fr = lane & 15, fq = lane >> 4;
    constexpr int ES = FP8 ? 1 : 2;
    int sclW = 0, sclX = 0;
    if constexpr (FP8) { asm volatile("v_mov_b32 %0, 0x79797979\n\tv_mov_b32 %1, 0x7f7f7f7f" : "=v"(sclW), "=v"(sclX)); }
    const int K = g.K, nt = K * ES / (BK * 2);
    unsigned voffA[2], voffB[2]; int Rr[2], Cc[2];
#pragma unroll
    for (int i = 0; i < 2; ++i) { int R, C; stage_rc(tid * 16 + i * 8192, R, C); const int Rb = Epi::PERM ? ((R & ~31) + perm32(R & 31)) : R; Rr[i] = R; Cc[i] = C;
        voffA[i] = (unsigned)(R * g.lda * ES + C * 2); voffB[i] = (unsigned)(Rb * g.ldb * ES + C * 2); }
    const size_t kstep = (size_t)(BK * 2);
    const size_t hstepA = (size_t)HALF * g.lda * ES, hstepB = (size_t)HALF * g.ldb * ES;
    const unsigned ldsw = (unsigned)wid * 1024u;
    const int aoff = lds_byte(wr * 64 + fr, fq * 8), boff = lds_byte(wc * 32 + fr, fq * 8);
    unsigned vAc[2][2], vAn[2][2];
#define PG8_SA(b, h) (((b) * 2 + (h)) * HTB)
#define PG8_SB(b, h) ((4 + (b) * 2 + (h)) * HTB)
#define PG8_STAGE(bufoff, gbase, voff) do { _Pragma("unroll") for (int _i = 0; _i < 2; ++_i) \
        __builtin_amdgcn_global_load_lds((const unsigned*)((const char*)(gbase) + (voff)[_i]), (PG8_LAS unsigned*)(lds + (bufoff) + ldsw + _i * 8192), 16, 0, 0); } while (0)
#define PG8_STAGE_A(bufoff, kbase, h, nx) do { if constexpr (Sched::GATHER) { unsigned _v[2] = {(nx) ? vAn[h][0] : vAc[h][0], (nx) ? vAn[h][1] : vAc[h][1]}; PG8_STAGE(bufoff, kbase, _v); } \
        else { PG8_STAGE(bufoff, (kbase) + (h) * hstepA, voffA); } } while (0)
#define PG8_GOFF(u, v) do { const int* _rw = S.rows(u); _Pragma("unroll") for (int _h = 0; _h < 2; ++_h) _Pragma("unroll") for (int _i = 0; _i < 2; ++_i) { const int _r = Rr[_i] + _h * HALF; \
        const int _tk = _r < (u).valid ? _rw[_r] : 0; v[_h][_i] = (unsigned)(_tk * g.lda * ES + Cc[_i] * 2); } } while (0)
#define PG8_LDA(dst, b, h) do { _Pragma("unroll") for (int m = 0; m < 4; ++m) _Pragma("unroll") for (int k = 0; k < 2; ++k) dst[m][k] = *(const PG8_LAS bf16x8*)(lds + PG8_SA(b, h) + aoff + m * 2048 + k * 1024); } while (0)
#define PG8_LDB(dst, b, h) do { _Pragma("unroll") for (int n = 0; n < 2; ++n) _Pragma("unroll") for (int k = 0; k < 2; ++k) dst[n][k] = *(const PG8_LAS bf16x8*)(lds + PG8_SB(b, h) + boff + n * 2048 + k * 1024); } while (0)
#define PG8_MMA(ai, bj, At, Bt) do { __builtin_amdgcn_s_setprio(1); _Pragma("unroll") for (int m = 0; m < 4; ++m) _Pragma("unroll") for (int n = 0; n < 2; ++n) { \
        if constexpr (FP8) { const v4i _b0 = __builtin_bit_cast(v4i, Bt[n][0]), _b1 = __builtin_bit_cast(v4i, Bt[n][1]), _a0 = __builtin_bit_cast(v4i, At[m][0]), _a1 = __builtin_bit_cast(v4i, At[m][1]); \
            const v8i _bb = __builtin_shufflevector(_b0, _b1, 0, 1, 2, 3, 4, 5, 6, 7), _aa = __builtin_shufflevector(_a0, _a1, 0, 1, 2, 3, 4, 5, 6, 7); \
            asm volatile("v_mfma_scale_f32_16x16x128_f8f6f4 %0, %1, %2, %0, %3, %4 op_sel_hi:[0,0,0]" : "+v"(acc[ai][bj][m][n]) : "v"(_bb), "v"(_aa), "v"(sclW), "v"(sclX)); } \
        else { _Pragma("unroll") for (int k = 0; k < 2; ++k) acc[ai][bj][m][n] = __builtin_amdgcn_mfma_f32_16x16x32_bf16(Bt[n][k], At[m][k], acc[ai][bj][m][n], 0, 0, 0); } } \
        __builtin_amdgcn_s_setprio(0); } while (0)
#define PG8_WAIT_V(n) asm volatile("s_waitcnt vmcnt(" #n ")" ::: "memory")
#define PG8_WAIT_L(n) asm volatile("s_waitcnt lgkmcnt(" #n ")" ::: "memory")
#define PG8_BAR __builtin_amdgcn_s_barrier()
#define PG8_SCHED __builtin_amdgcn_sched_barrier(0)
    Unit cur, nxt; int ui = 0;
    if (!S.next(0, cur)) return;
    f32x4 acc[2][2][4][2];
#pragma unroll
    for (int a = 0; a < 2; ++a)
#pragma unroll
        for (int b = 0; b < 2; ++b)
#pragma unroll
            for (int m = 0; m < 4; ++m)
#pragma unroll
                for (int n = 0; n < 2; ++n) acc[a][b][m][n] = (f32x4){0.f, 0.f, 0.f, 0.f};
    bf16x8 At[4][2], B0[2][2], B1[2][2];
    const char* cA = cur.A; const char* cB = cur.B;
    if constexpr (Sched::GATHER) { PG8_GOFF(cur, vAc); PG8_WAIT_V(0); }
    PG8_STAGE(PG8_SB(0, 0), cB, voffB); PG8_STAGE(PG8_SB(0, 1), cB + hstepB, voffB); PG8_STAGE_A(PG8_SA(0, 0), cA, 0, false); PG8_STAGE_A(PG8_SA(0, 1), cA, 1, false);
    if (wr == 1) PG8_BAR;
    PG8_WAIT_V(2); PG8_BAR;
    PG8_STAGE(PG8_SB(1, 0), cB + kstep, voffB); PG8_STAGE_A(PG8_SA(1, 0), cA + kstep, 0, false); PG8_STAGE(PG8_SB(1, 1), cB + hstepB + kstep, voffB);
    PG8_WAIT_V(6); PG8_BAR;
    for (;;) {
        const bool has_next = S.next(ui + 1, nxt);
        const char* nA = has_next ? nxt.A : cA; const char* nB = has_next ? nxt.B : cB;
        if constexpr (Sched::GATHER) { if (has_next) { PG8_GOFF(nxt, vAn); } else {
#pragma unroll
            for (int h = 0; h < 2; ++h)
#pragma unroll
                for (int i = 0; i < 2; ++i) vAn[h][i] = vAc[h][i]; } }
#pragma nounroll
        for (int t = 0; t < nt; t += 2) {
            const bool last = (t == nt - 2);
            const char* a1 = cA + (size_t)(t + 1) * kstep;
            const char* a2 = last ? nA : cA + (size_t)(t + 2) * kstep; const char* b2 = last ? nB : cB + (size_t)(t + 2) * kstep;
            const char* a3 = a2 + kstep; const char* b3 = b2 + kstep;
            PG8_LDB(B0, 0, 0); PG8_LDB(B1, 0, 1); PG8_SCHED; PG8_LDA(At, 0, 0); PG8_STAGE_A(PG8_SA(1, 1), a1, 1, false);
            PG8_WAIT_V(8); PG8_WAIT_L(0); PG8_BAR; PG8_MMA(0, 0, At, B0); PG8_MMA(0, 1, At, B1); PG8_BAR; PG8_SCHED;
            PG8_LDA(At, 0, 1); PG8_STAGE(PG8_SB(0, 0), b2, voffB); PG8_STAGE(PG8_SB(0, 1), b2 + hstepB, voffB); PG8_STAGE_A(PG8_SA(0, 0), a2, 0, last);
            PG8_WAIT_V(8); PG8_WAIT_L(0); PG8_BAR; PG8_MMA(1, 0, At, B0); PG8_MMA(1, 1, At, B1); PG8_BAR; PG8_SCHED;
            PG8_LDB(B0, 1, 0); PG8_LDB(B1, 1, 1); PG8_SCHED; PG8_LDA(At, 1, 0); PG8_STAGE_A(PG8_SA(0, 1), a2, 1, last);
            PG8_WAIT_V(8); PG8_WAIT_L(0); PG8_BAR; PG8_MMA(0, 0, At, B0); PG8_MMA(0, 1, At, B1); PG8_BAR; PG8_SCHED;
            PG8_LDA(At, 1, 1); PG8_STAGE(PG8_SB(1, 0), b3, voffB); PG8_STAGE(PG8_SB(1, 1), b3 + hstepB, voffB); PG8_STAGE_A(PG8_SA(1, 0), a3, 0, last);
            PG8_WAIT_V(8); PG8_WAIT_L(0); PG8_BAR; PG8_MMA(1, 0, At, B0); PG8_MMA(1, 1, At, B1); PG8_BAR; PG8_SCHED;
        }
        if constexpr (ALIGN_EPI) { if (wr == 0) PG8_BAR; }
        if constexpr (FP8) asm volatile("s_nop 15\n\ts_nop 15" ::: "memory");
        if constexpr (!Epi::AFTER_DRAIN) { int l2 = lane; asm volatile("" : "+v"(l2));
            E(acc, cur, wr, wc, l2 & 15, l2 >> 4); }
        if (!has_next) break;
#pragma unroll
        for (int a = 0; a < 2; ++a)
#pragma unroll
            for (int b = 0; b < 2; ++b)
#pragma unroll
                for (int m = 0; m < 4; ++m)
#pragma unroll
                    for (int n = 0; n < 2; ++n) acc[a][b][m][n] = (f32x4){0.f, 0.f, 0.f, 0.f};
        cur = nxt; cA = nA; cB = nB; ++ui;
        if constexpr (Sched::GATHER) {
#pragma unroll
            for (int h = 0; h < 2; ++h)
#pragma unroll
                for (int i = 0; i < 2; ++i) vAc[h][i] = vAn[h][i]; }
        if constexpr (ALIGN_EPI) { if (wr == 1) PG8_BAR; }
    }
    PG8_WAIT_V(0);
    if constexpr (!ALIGN_EPI) { if (wr == 0) PG8_BAR; }
    PG8_BAR;
    if constexpr (Epi::AFTER_DRAIN) { E.fused(acc, cur, wr, wc, fr, fq, lds, wid, lane); }
#undef PG8_SA
#undef PG8_SB
#undef PG8_STAGE
#undef PG8_STAGE_A
#undef PG8_GOFF
#undef PG8_LDA
#undef PG8_LDB
#undef PG8_MMA
#undef PG8_WAIT_V
#undef PG8_WAIT_L
#undef PG8_BAR
#undef PG8_SCHED
}

#define EPI_LOOP_AI_M for (int ai = 0; ai < 2; ++ai) _Pragma("unroll") for (int m = 0; m < 4; ++m)

struct EpiF32 {
    static constexpr bool PERM = false, AFTER_DRAIN = false;
    float* C; int ldc; const float* bias; int bstride; const float* res; float alpha;
    __device__ __forceinline__ void operator()(const f32x4 (&acc)[2][2][4][2], const Unit& u, int wr, int wc, int fr, int fq) const {
        const int row0 = u.orow + wr * 64 + fr, col0 = u.ocol + wc * 32 + 4 * fq;
        f32x4 bv[2][2];
#pragma unroll
        for (int bj = 0; bj < 2; ++bj)
#pragma unroll
            for (int n = 0; n < 2; ++n) bv[bj][n] = bias ? *(const f32x4*)(bias + (size_t)u.aux * bstride + col0 + bj * HALF + n * 16) : (f32x4){0.f, 0.f, 0.f, 0.f};
#pragma unroll
        EPI_LOOP_AI_M { const size_t off = (size_t)(row0 + ai * HALF + m * 16) * ldc + col0;
#pragma unroll
            for (int bj = 0; bj < 2; ++bj)
#pragma unroll
                for (int n = 0; n < 2; ++n) { f32x4 v = acc[ai][bj][m][n] + bv[bj][n];
                    if (res) { const f32x4 rv = *(const f32x4*)(res + off + bj * HALF + n * 16); v = v + rv * alpha; }
                    *(f32x4*)(C + off + bj * HALF + n * 16) = v; }
            asm volatile("" ::: "memory"); }
    }
};
struct EpiBf16 {
    static constexpr bool PERM = true, AFTER_DRAIN = false;
    bf16_t* O; int ldc; float scale;
    __device__ __forceinline__ void operator()(const f32x4 (&acc)[2][2][4][2], const Unit& u, int wr, int wc, int fr, int fq) const {
        const int row0 = u.orow + wr * 64 + fr, col0 = u.ocol + wc * 32 + 8 * fq;
#pragma unroll
        EPI_LOOP_AI_M { bf16_t* rowp = O + (size_t)(row0 + ai * HALF + m * 16) * ldc + col0;
#pragma unroll
            for (int bj = 0; bj < 2; ++bj) { const f32x4 v0 = acc[ai][bj][m][0] * scale, v1 = acc[ai][bj][m][1] * scale;
                u32x4 w; w.x = cvt_pk_bf16(v0[0], v0[1]); w.y = cvt_pk_bf16(v0[2], v0[3]); w.z = cvt_pk_bf16(v1[0], v1[1]); w.w = cvt_pk_bf16(v1[2], v1[3]);
                *(u32x4*)(rowp + bj * HALF) = w; } }
    }
};
struct EpiBf16Bias {
    static constexpr bool PERM = true, AFTER_DRAIN = false;
    bf16_t* O; int ldc; const float* bias; int bstride;
    __device__ __forceinline__ void operator()(const f32x4 (&acc)[2][2][4][2], const Unit& u, int wr, int wc, int fr, int fq) const {
        const int row0 = u.orow + wr * 64 + fr, col0 = u.ocol + wc * 32 + 8 * fq;
        f32x4 bv[2][2];
#pragma unroll
        for (int bj = 0; bj < 2; ++bj)
#pragma unroll
            for (int n = 0; n < 2; ++n) bv[bj][n] = *(const f32x4*)(bias + (size_t)u.aux * bstride + col0 + bj * HALF + 4 * n);
#pragma unroll
        EPI_LOOP_AI_M { bf16_t* rowp = O + (size_t)(row0 + ai * HALF + m * 16) * ldc + col0;
#pragma unroll
            for (int bj = 0; bj < 2; ++bj) { const f32x4 v0 = acc[ai][bj][m][0] + bv[bj][0], v1 = acc[ai][bj][m][1] + bv[bj][1];
                u32x4 w; w.x = cvt_pk_bf16(v0[0], v0[1]); w.y = cvt_pk_bf16(v0[2], v0[3]); w.z = cvt_pk_bf16(v1[0], v1[1]); w.w = cvt_pk_bf16(v1[2], v1[3]);
                *(u32x4*)(rowp + bj * HALF) = w; } }
    }
};
struct EpiKV {
    static constexpr bool PERM = true, AFTER_DRAIN = false;
    bf16_t* KB; bf16_t* VT;
    __device__ __forceinline__ void operator()(const f32x4 (&acc)[2][2][4][2], const Unit& u, int wr, int wc, int fr, int fq) const {
        const int row0 = u.orow + wr * 64 + fr, col0 = u.ocol + wc * 32 + 8 * fq;
#pragma unroll
        EPI_LOOP_AI_M { const int row = row0 + ai * HALF + m * 16;
#pragma unroll
            for (int bj = 0; bj < 2; ++bj) { const f32x4 v0 = acc[ai][bj][m][0], v1 = acc[ai][bj][m][1]; const int col = col0 + bj * HALF;
                if (u.ocol < 2048) { u32x4 w; w.x = cvt_pk_bf16(v0[0], v0[1]); w.y = cvt_pk_bf16(v0[2], v0[3]); w.z = cvt_pk_bf16(v1[0], v1[1]); w.w = cvt_pk_bf16(v1[2], v1[3]);
                    *(u32x4*)(KB + (size_t)row * 2048 + col) = w; }
                else { const int b = row >> 8, key = row & 255, c = col - 2048, h = c >> 9, d = c & 511; bf16_t* p = VT + ((size_t)((b * 4 + h) * 512 + d)) * 256 + key;
#pragma unroll
                    for (int j = 0; j < 4; ++j) { p[(size_t)j * 256] = (bf16_t)f2bf(v0[j]); p[(size_t)(4 + j) * 256] = (bf16_t)f2bf(v1[j]); } } } }
    }
};
struct EpiDecay {
    static constexpr bool PERM = false, AFTER_DRAIN = false;
    float* DEC; const float* w0;
    __device__ __forceinline__ void operator()(const f32x4 (&acc)[2][2][4][2], const Unit& u, int wr, int wc, int fr, int fq) const {
        const int row0 = u.orow + wr * 64 + fr, col0 = u.ocol + wc * 32 + 4 * fq;
        f32x4 bv[2][2];
#pragma unroll
        for (int bj = 0; bj < 2; ++bj)
#pragma unroll
            for (int n = 0; n < 2; ++n) bv[bj][n] = *(const f32x4*)(w0 + col0 + bj * HALF + n * 16);
#pragma unroll
        EPI_LOOP_AI_M { const size_t off = (size_t)(row0 + ai * HALF + m * 16) * D + col0;
#pragma unroll
            for (int bj = 0; bj < 2; ++bj)
#pragma unroll
                for (int n = 0; n < 2; ++n) { const f32x4 x = acc[ai][bj][m][n] + bv[bj][n]; f32x4 o;
#pragma unroll
                    for (int j = 0; j < 4; ++j) o[j] = __expf(-0.6065306597126334f * sigmoidf_(x[j]));
                    *(f32x4*)(DEC + off + bj * HALF + n * 16) = o; } }
    }
};
struct EpiIclr {
    static constexpr bool PERM = true, AFTER_DRAIN = false;
    const float* a0; const float* k_k; const float* k_a; const bf16_t* KZ; const float* KNORM; bf16_t* KP; bf16_t* AN; bf16_t* BB;
    __device__ __forceinline__ void operator()(const f32x4 (&acc)[2][2][4][2], const Unit& u, int wr, int wc, int fr, int fq) const {
        const int row0 = u.orow + wr * 64 + fr, col0 = u.ocol + wc * 32 + 8 * fq;
#pragma unroll
        for (int bj = 0; bj < 2; ++bj) { const int col = col0 + bj * HALF;
            const f32x4 a00 = *(const f32x4*)(a0 + col), a01 = *(const f32x4*)(a0 + col + 4), kk0 = *(const f32x4*)(k_k + col), kk1 = *(const f32x4*)(k_k + col + 4), ka0 = *(const f32x4*)(k_a + col), ka1 = *(const f32x4*)(k_a + col + 4);
#pragma unroll
            EPI_LOOP_AI_M { const int row = row0 + ai * HALF + m * 16; const size_t off = (size_t)row * D + col;
                const u32x4 kzw = *(const u32x4*)(KZ + off); const float nr = KNORM[(size_t)row * 32 + (col >> 6)]; const float inv = 1.0f / fmaxf(nr, 1e-12f);
                const unsigned kw[4] = {kzw.x, kzw.y, kzw.z, kzw.w};
                float kp[8], an[8], bb[8];
#pragma unroll
                for (int j = 0; j < 8; ++j) { const float kz = bf2f((kw[j >> 1] >> (16 * (j & 1))) & 0xffffu);
                    const float x = (j < 4 ? acc[ai][bj][m][0][j & 3] + a00[j & 3] : acc[ai][bj][m][1][j & 3] + a01[j & 3]);
                    const float kkc = j < 4 ? kk0[j & 3] : kk1[j & 3], kac = j < 4 ? ka0[j & 3] : ka1[j & 3];
                    const float a = sigmoidf_(x); const float kk = kz * kkc * inv; kp[j] = kz * (1.0f + (a - 1.0f) * kac); bb[j] = kk * a; an[j] = -kk; }
                *(u32x4*)(KP + off) = (u32x4){cvt_pk_bf16(kp[0], kp[1]), cvt_pk_bf16(kp[2], kp[3]), cvt_pk_bf16(kp[4], kp[5]), cvt_pk_bf16(kp[6], kp[7])};
                *(u32x4*)(AN + off) = (u32x4){cvt_pk_bf16(an[0], an[1]), cvt_pk_bf16(an[2], an[3]), cvt_pk_bf16(an[4], an[5]), cvt_pk_bf16(an[6], an[7])};
                *(u32x4*)(BB + off) = (u32x4){cvt_pk_bf16(bb[0], bb[1]), cvt_pk_bf16(bb[2], bb[3]), cvt_pk_bf16(bb[4], bb[5]), cvt_pk_bf16(bb[6], bb[7])}; }
            asm volatile("" ::: "memory"); }
    }
};
struct EpiGateA {
    static constexpr bool PERM = false, AFTER_DRAIN = false;
    const bf16_t* PROJ; float* TMP;
    __device__ __forceinline__ void operator()(const f32x4 (&acc)[2][2][4][2], const Unit& u, int wr, int wc, int fr, int fq) const {
        const int row0 = u.orow + wr * 64 + fr, col0 = u.ocol + wc * 32 + 4 * fq;
#pragma unroll
        EPI_LOOP_AI_M { const int row = row0 + ai * HALF + m * 16;
#pragma unroll
            for (int bj = 0; bj < 2; ++bj)
#pragma unroll
                for (int n = 0; n < 2; ++n) { const int col = col0 + bj * HALF + n * 16; const u32x2 gv = *(const u32x2*)(PROJ + (size_t)row * PC + GATE0 + col);
                    const f32x4 a = acc[ai][bj][m][n]; f32x4 o;
                    o[0] = a[0] * sigmoidf_(bf2f(gv.x & 0xffffu)); o[1] = a[1] * sigmoidf_(bf2f(gv.x >> 16)); o[2] = a[2] * sigmoidf_(bf2f(gv.y & 0xffffu)); o[3] = a[3] * sigmoidf_(bf2f(gv.y >> 16));
                    *(f32x4*)(TMP + (size_t)row * D + col) = o; } }
    }
};
struct EpiGateB {
    static constexpr bool PERM = true, AFTER_DRAIN = false;
    const bf16_t* PROJ; const float* TMP; bf16_t* MERGED;
    __device__ __forceinline__ void operator()(const f32x4 (&acc)[2][2][4][2], const Unit& u, int wr, int wc, int fr, int fq) const {
        const int row0 = u.orow + wr * 64 + fr, col0 = u.ocol + wc * 32 + 8 * fq;
#pragma unroll
        EPI_LOOP_AI_M { const int row = row0 + ai * HALF + m * 16;
#pragma unroll
            for (int bj = 0; bj < 2; ++bj) { const int col = col0 + bj * HALF; const u32x4 gv = *(const u32x4*)(PROJ + (size_t)row * PC + GATE0 + 2048 + col);
                const f32x4 t0 = *(const f32x4*)(TMP + (size_t)row * D + col), t1 = *(const f32x4*)(TMP + (size_t)row * D + col + 4);
                const f32x4 a0 = acc[ai][bj][m][0], a1 = acc[ai][bj][m][1]; f32x4 o0, o1;
                o0[0] = t0[0] + a0[0] * sigmoidf_(bf2f(gv.x & 0xffffu)); o0[1] = t0[1] + a0[1] * sigmoidf_(bf2f(gv.x >> 16)); o0[2] = t0[2] + a0[2] * sigmoidf_(bf2f(gv.y & 0xffffu)); o0[3] = t0[3] + a0[3] * sigmoidf_(bf2f(gv.y >> 16));
                o1[0] = t1[0] + a1[0] * sigmoidf_(bf2f(gv.z & 0xffffu)); o1[1] = t1[1] + a1[1] * sigmoidf_(bf2f(gv.z >> 16)); o1[2] = t1[2] + a1[2] * sigmoidf_(bf2f(gv.w & 0xffffu)); o1[3] = t1[3] + a1[3] * sigmoidf_(bf2f(gv.w >> 16));
                u32x4 w; w.x = cvt_pk_bf16(o0[0], o0[1]); w.y = cvt_pk_bf16(o0[2], o0[3]); w.z = cvt_pk_bf16(o1[0], o1[1]); w.w = cvt_pk_bf16(o1[2], o1[3]);
                *(u32x4*)(MERGED + (size_t)row * D + col) = w; }
            asm volatile("" ::: "memory"); }
    }
};
struct EpiSwiglu {
    static constexpr bool PERM = true, AFTER_DRAIN = false;
    const float* b1; bf16_t* H;
    __device__ __forceinline__ float sw(float g, float l) const { g = fminf(g, 7.0f); l = fminf(fmaxf(l, -7.0f), 7.0f); return g * sigmoidf_(1.702f * g) * (l + 1.0f); }
    __device__ __forceinline__ void operator()(const f32x4 (&acc)[2][2][4][2], const Unit& u, int wr, int wc, int fr, int fq) const {
        const int row0 = u.orow + wr * 64 + fr, col0 = u.ocol + wc * 32 + 8 * fq;
        f32x4 bv[2][2];
#pragma unroll
        for (int bj = 0; bj < 2; ++bj)
#pragma unroll
            for (int n = 0; n < 2; ++n) bv[bj][n] = *(const f32x4*)(b1 + (size_t)u.aux * 4096 + col0 + bj * HALF + 4 * n);
#pragma unroll
        EPI_LOOP_AI_M { const int row = row0 + ai * HALF + m * 16;
#pragma unroll
            for (int bj = 0; bj < 2; ++bj) { const f32x4 v0 = acc[ai][bj][m][0] + bv[bj][0], v1 = acc[ai][bj][m][1] + bv[bj][1];
                *(unsigned*)((unsigned char*)H + (size_t)row * DFF + ((col0 + bj * HALF) >> 1)) = pk4_fp8(sw(v0[0], v0[1]), sw(v0[2], v0[3]), sw(v1[0], v1[1]), sw(v1[2], v1[3])); } }
    }
};
struct EpiSoftmax {
    static constexpr bool PERM = true, AFTER_DRAIN = true;
    bf16_t* PP;
    __device__ __forceinline__ void fused(f32x4 (&acc)[2][2][4][2], const Unit& u, int wr, int wc, int fr, int fq, PG8_LAS unsigned char* lds, int wid, int lane) const {
        PG8_LAS float* P1 = (PG8_LAS float*)lds;
        PG8_LAS float* P2 = (PG8_LAS float*)(lds + 4096);
        float mx[2][4];
#pragma unroll
        EPI_LOOP_AI_M { float v = -3.0e38f;
#pragma unroll
            for (int bj = 0; bj < 2; ++bj)
#pragma unroll
                for (int n = 0; n < 2; ++n) { const f32x4 x = acc[ai][bj][m][n]; v = fmaxf(v, fmaxf(fmaxf(x[0], x[1]), fmaxf(x[2], x[3]))); }
            v = fmaxf(v, __shfl_xor(v, 16)); v = fmaxf(v, __shfl_xor(v, 32));
            if (fq == 0) P1[(ai * HALF + wr * 64 + m * 16 + fr) * 4 + wc] = v; }
        asm volatile("s_waitcnt lgkmcnt(0)" ::: "memory"); __builtin_amdgcn_s_barrier(); asm volatile("" ::: "memory");
#pragma unroll
        EPI_LOOP_AI_M { const f32x4 t = *(const PG8_LAS f32x4*)(P1 + (ai * HALF + wr * 64 + m * 16 + fr) * 4); mx[ai][m] = fmaxf(fmaxf(t[0], t[1]), fmaxf(t[2], t[3])); }
#pragma unroll
        EPI_LOOP_AI_M { float s = 0.f;
#pragma unroll
            for (int bj = 0; bj < 2; ++bj)
#pragma unroll
                for (int n = 0; n < 2; ++n) { f32x4 x = acc[ai][bj][m][n];
#pragma unroll
                    for (int j = 0; j < 4; ++j) { x[j] = __expf(x[j] - mx[ai][m]); s += x[j]; }
                    acc[ai][bj][m][n] = x; }
            s += __shfl_xor(s, 16); s += __shfl_xor(s, 32);
            if (fq == 0) P2[(ai * HALF + wr * 64 + m * 16 + fr) * 4 + wc] = s; }
        asm volatile("s_waitcnt lgkmcnt(0)" ::: "memory"); __builtin_amdgcn_s_barrier(); asm volatile("" ::: "memory");
        const int row0 = u.orow + wr * 64 + fr, col0 = wc * 32 + 8 * fq;
#pragma unroll
        EPI_LOOP_AI_M { const f32x4 t = *(const PG8_LAS f32x4*)(P2 + (ai * HALF + wr * 64 + m * 16 + fr) * 4); const float inv = 1.0f / ((t[0] + t[1]) + (t[2] + t[3]));
            bf16_t* rowp = PP + (size_t)(row0 + ai * HALF + m * 16) * 256 + col0;
#pragma unroll
            for (int bj = 0; bj < 2; ++bj) { const f32x4 v0 = acc[ai][bj][m][0] * inv, v1 = acc[ai][bj][m][1] * inv;
                u32x4 w; w.x = cvt_pk_bf16(v0[0], v0[1]); w.y = cvt_pk_bf16(v0[2], v0[3]); w.z = cvt_pk_bf16(v1[0], v1[1]); w.w = cvt_pk_bf16(v1[2], v1[3]);
                *(u32x4*)(rowp + bj * HALF) = w; } }
        asm volatile("s_waitcnt lgkmcnt(0)" ::: "memory"); __builtin_amdgcn_s_barrier(); asm volatile("" ::: "memory");
    }
};
}

constexpr size_t MiB = 1u << 20;
constexpr size_t al256(size_t x) { return (x + 255) & ~(size_t)255; }
constexpr size_t WS_CTL = 0, CTL_ZERO_BYTES = 1 * MiB;
constexpr size_t WS_WIN = 1 * MiB;
constexpr size_t WS_WUP = WS_WIN + (size_t)PC * D * 2;
constexpr size_t WS_AUP = WS_WUP + (size_t)D * 256 * 2;
constexpr size_t WS_GUP = WS_AUP + (size_t)D * 256 * 2;
constexpr size_t WS_PA = WS_GUP + (size_t)D * 256 * 2;
constexpr size_t WS_PB = WS_PA + (size_t)D * D * 2;
constexpr size_t WS_WOUT = WS_PB + (size_t)D * 512 * 2;
constexpr size_t WS_WQ = WS_WOUT + (size_t)D * D * 2;
constexpr size_t WS_WKV = WS_WQ + (size_t)D * D * 2;
constexpr size_t WS_WO = WS_WKV + (size_t)2 * D * D * 2;
constexpr size_t WS_W1 = WS_WO + (size_t)D * D * 2;
constexpr size_t WS_W2 = WS_W1 + (size_t)NEXP * 4096 * D * 2;
constexpr size_t WS_XB = WS_W2 + (size_t)NEXP * D * DFF * 2;
constexpr size_t WS_MEMB = WS_XB + (size_t)M * D * 2;
constexpr size_t WS_ROT = WS_MEMB + (size_t)1024 * D * 2;
constexpr size_t WS_KB = WS_ROT + (size_t)2 * SEQ * 32 * 4;
constexpr size_t WS_VT = WS_KB + (size_t)1024 * D * 2;
constexpr size_t WS_YA = WS_VT + (size_t)1024 * D * 2;
constexpr size_t WS_YB = WS_YA + (size_t)M * D * 2;
constexpr size_t WS_TMP = WS_YB + (size_t)M * 512 * 2;
constexpr size_t WS_MERGED = WS_TMP + (size_t)M * D * 4;
constexpr size_t WS_E = WS_MERGED + (size_t)M * D * 2;
constexpr size_t WS_PROJ = WS_E;
constexpr size_t WS_RZ = WS_PROJ + (size_t)M * PC * 2;
constexpr size_t WS_KZ = WS_RZ + (size_t)M * D * 4;
constexpr size_t WS_VZ = WS_KZ + (size_t)M * D * 4;
constexpr size_t WS_DEC = WS_VZ + (size_t)M * D * 4;
constexpr size_t WS_KP = WS_DEC + (size_t)M * D * 4;
constexpr size_t WS_AN = WS_KP + (size_t)M * D * 4;
constexpr size_t WS_BB = WS_AN + (size_t)M * D * 4;
constexpr size_t WS_GG = WS_BB + (size_t)M * D * 4;
constexpr size_t WS_YS = WS_GG + (size_t)M * D * 4;
constexpr size_t WS_VR = WS_YS + 4 * MiB;
constexpr size_t WS_AO = WS_YS + (size_t)M * D * 4;
constexpr size_t WS_LSE = WS_AO + (size_t)3 * M * 512 * 4;
constexpr size_t WS_QR = WS_LSE + (size_t)3 * M * 8 * 4;
constexpr size_t WS_KR = WS_QR + (size_t)M * 1536 * 2;
constexpr size_t WS_LIN = WS_KR + (size_t)M * 1536 * 2;
constexpr size_t WS_KNORM = WS_LIN + (size_t)M * 768 * 2;
constexpr size_t WS_F = WS_KNORM + (size_t)M * 32 * 4;
constexpr size_t WS_E_END = WS_F + (size_t)128 * 128 * 96 * 96 * 2;
constexpr size_t WS_T1 = WS_E;
constexpr size_t WS_X1 = WS_T1 + (size_t)M * D * 4;
constexpr size_t WS_X1B = WS_X1 + (size_t)M * D * 4;
constexpr size_t WS_Q = WS_X1B + (size_t)M * D * 2;
constexpr size_t WS_PP = WS_Q + (size_t)M * D * 2;
constexpr size_t WS_OC = WS_PP + (size_t)16 * SEQ * 256 * 2;
constexpr size_t WS_T2 = WS_OC + (size_t)M * D * 2;
constexpr size_t WS_X2 = WS_T2 + (size_t)M * D * 4;
constexpr size_t WS_X2B = WS_X2 + (size_t)M * D * 4;
constexpr size_t WS_LIST = WS_X2B + (size_t)M * D * 2;
constexpr size_t WS_ROWI = WS_LIST + (size_t)NEXP * CAP * 4;
constexpr size_t WS_TOPW = WS_ROWI + (size_t)M * 4 * 4;
constexpr size_t WS_H = WS_TOPW + (size_t)M * 4 * 4;
constexpr size_t WS_Y = WS_H + (size_t)HROWS * DFF * 2;
constexpr size_t WS_L_END = WS_Y + (size_t)HROWS * D * 4;
constexpr size_t WS_END = (WS_E_END > WS_L_END ? WS_E_END : WS_L_END);
static_assert(WS_END <= (size_t)4090 * MiB, "workspace map exceeds 4 x largest input");
constexpr int CW_TMO = 0, CW_CNT = 64  , CW_Q = 128  , CW_BAR = 4096;

constexpr int RING_BYTES = 131072, MISC_OFF = RING_BYTES, LDS_BYTES = 147456;

#define XB_TMO      128
#define XB_XCNT(j)  (256  + 64 * (j))
#define XB_XSUB(j)  (1280 + 64 * (j))
#define XB_XGEN(j)  (2304 + 64 * (j))
#define XB_TOP      3328
#define XB_TOPGEN   3392
#define XCD_BAR_WORDS 3456
#define XB_SPIN_CAP (1u << 18)
__device__ __forceinline__ unsigned xb_ld(unsigned* p)              { return __hip_atomic_load(p, __ATOMIC_RELAXED, __HIP_MEMORY_SCOPE_AGENT); }
__device__ __forceinline__ unsigned xb_add(unsigned* p, unsigned v) { return __hip_atomic_fetch_add(p, v, __ATOMIC_RELAXED, __HIP_MEMORY_SCOPE_AGENT); }
__device__ __forceinline__ unsigned xb_xcc_id() { return (unsigned)__builtin_amdgcn_s_getreg((3 << 11) | 20) & 0xFu; }
#define XB_SPIN(cond, bar) do { unsigned _sp = 0; while (cond) { __builtin_amdgcn_s_sleep(1); \
    if ((++_sp & 255u) == 0u) { if (xb_ld(&(bar)[XB_TMO])) break; if (_sp > XB_SPIN_CAP) { atomicAdd(&(bar)[XB_TMO], 1u); break; } } } } while (0)
struct XcdBarrier { unsigned* bar; unsigned x; volatile LAS unsigned* st; };
__device__ __forceinline__ XcdBarrier xcd_barrier_post(unsigned* bar, volatile LAS unsigned* st) {
    XcdBarrier b; b.bar = bar; b.x = xb_xcc_id(); b.st = st;
    if (threadIdx.x == 0) (void)xb_add(&bar[XB_XCNT(b.x)], 1u);
    return b;
}
__device__ __forceinline__ void xcd_barrier_complete(unsigned* bar, unsigned x, unsigned& nloc, unsigned& nx) {
    const unsigned G = gridDim.x * gridDim.y * gridDim.z;
    unsigned sum, cnt, mine, sp = 0u;
    for (;;) {
        sum = 0u; cnt = 0u; mine = 0u;
#pragma unroll
        for (unsigned j = 0; j < 16; ++j) { const unsigned c = xb_ld(&bar[XB_XCNT(j)]); sum += c; cnt += (c > 0u) ? 1u : 0u; mine = (j == x) ? c : mine; }
        if (sum == G) break;
        __builtin_amdgcn_s_sleep(1);
        if ((++sp & 255u) == 0u) { if (xb_ld(&bar[XB_TMO])) break; if (sp > XB_SPIN_CAP) { atomicAdd(&bar[XB_TMO], 1u); break; } }
    }
    nloc = mine > 0u ? mine : 1u; nx = cnt > 0u ? cnt : 1u;
}
__device__ __forceinline__ void xcd_barrier(const XcdBarrier& b) {
    asm volatile("s_waitcnt vmcnt(0)" ::: "memory");
    __syncthreads();
    if (threadIdx.x == 0) {
        unsigned* bar = b.bar;
        __builtin_amdgcn_s_waitcnt(0);
        unsigned nloc = b.st[0], nx = b.st[1];
        if (nloc == 0u) { xcd_barrier_complete(bar, b.x, nloc, nx); b.st[0] = nloc; b.st[1] = nx; }
        const unsigned old = xb_add(&bar[XB_XSUB(b.x)], 1u);
        const unsigned gen = old / nloc;
        if (old + 1u == (gen + 1u) * nloc) {
            __builtin_amdgcn_fence(__ATOMIC_RELEASE, "agent");
            asm volatile("s_waitcnt vmcnt(0)" ::: "memory");
            const unsigned og = xb_add(&bar[XB_TOP], 1u);
            const unsigned tg = og / nx;
            if (og + 1u == (tg + 1u) * nx) xb_add(&bar[XB_TOPGEN], 1u);
            else XB_SPIN(xb_ld(&bar[XB_TOPGEN]) == tg, bar);
            __builtin_amdgcn_fence(__ATOMIC_ACQUIRE, "agent");
            xb_add(&bar[XB_XGEN(b.x)], 1u);
            asm volatile("s_waitcnt vmcnt(0)" ::: "memory");
        } else {
            XB_SPIN(xb_ld(&bar[XB_XGEN(b.x)]) == gen, bar);
            __builtin_amdgcn_fence(__ATOMIC_ACQUIRE, "agent");
            asm volatile("s_waitcnt vmcnt(0)" ::: "memory");
        }
    }
    __syncthreads();
}

struct Params {
    const float* in[32];
    float* out; unsigned char* ws;
    int ph_lo, ph_hi, li, pad;
};
enum { I_X = 0, I_MEM, I_WIN, I_MIX, I_W0, I_WUP, I_A0, I_AUP, I_GUP, I_KK, I_KA, I_RK, I_LNXG, I_LNXB, I_PA, I_PB, I_WOUT, I_LN1G, I_LN1B, I_WQ, I_WKV, I_WO, I_LN2G, I_LN2B,
       I_RW, I_RB, I_W1, I_B1, I_W2, I_B2, I_LN3G, I_LN3B };

struct ScoreOrder {
    static constexpr bool GATHER = false;
    const char* Q; const char* KB; int G, c;
    __device__ bool next(int i, pg8::Unit& u) const {
        const int L = i * G + c; if (L >= 256) return false;
        const int bh = L >> 4, pm = L & 15, b = bh >> 2, h = bh & 3;
        u.A = Q + ((size_t)(b * SEQ + 256 * pm) * D + h * 512) * 2; u.B = KB + ((size_t)(b * 256) * D + h * 512) * 2;
        u.orow = bh * SEQ + 256 * pm; u.ocol = 0; u.aux = 0; u.aux2 = 0; u.valid = 256; return true;
    }
    __device__ __forceinline__ const int* rows(const pg8::Unit&) const { return nullptr; }
};
struct PvOrder {
    static constexpr bool GATHER = false;
    const char* PP; const char* VT; int G, c;
    __device__ bool next(int i, pg8::Unit& u) const {
        const int L = i * G + c; if (L >= 512) return false;
        const int bh = L >> 5, pm = (L >> 1) & 15, pn = L & 1, b = bh >> 2, h = bh & 3;
        u.A = PP + ((size_t)(bh * SEQ + 256 * pm) * 256) * 2; u.B = VT + ((size_t)(bh * 512 + 256 * pn) * 256) * 2;
        u.orow = b * SEQ + 256 * pm; u.ocol = h * 512 + 256 * pn; u.aux = 0; u.aux2 = 0; u.valid = 256; return true;
    }
    __device__ __forceinline__ const int* rows(const pg8::Unit&) const { return nullptr; }
};
template <bool GATHER_, int NT  > struct MoeOrder {
    static constexpr bool GATHER = GATHER_;
    const LAS int* tab; const char* A; const char* W; const int* list; size_t wexp  ; int ldb; int G, c;
    __device__ bool next(int i, pg8::Unit& u) const {
        constexpr int RPR = 256 / NT;
        const int rt = i * RPR + (c % RPR), pn = c / RPR, T = __builtin_amdgcn_readfirstlane(tab[64]);
        if (c >= 256 || rt >= T) return false;
        int e = 0;
        for (int j = 1; j < NEXP; ++j) e = (rt >= __builtin_amdgcn_readfirstlane(tab[32 + j])) ? j : e;
        const int lt = rt - __builtin_amdgcn_readfirstlane(tab[32 + e]), cnt = __builtin_amdgcn_readfirstlane(tab[e]);
        u.aux = e; u.aux2 = lt; u.valid = min(256, cnt - 256 * lt); u.orow = 256 * rt; u.ocol = 256 * pn;
        u.B = W + (size_t)e * wexp + (size_t)(256 * pn) * ldb;
        u.A = GATHER_ ? A : A + (size_t)(256 * rt) * DFF;
        return true;
    }
    __device__ __forceinline__ const int* rows(const pg8::Unit& u) const { return list + (size_t)u.aux * CAP + 256 * u.aux2; }
};

struct Ctx { int tid, lane, wave, vcu, G; LAS unsigned char* lds; unsigned char* ws; };

__device__ __forceinline__ void tr_item(const float* W, int ldw, int Ksrc, int sc0, bf16_t* WT, int ldt, int n0, int k0, LAS float* scr, int lane) {
#pragma unroll 8
    for (int i = 0; i < 32; ++i) { const int kk = 2 * i + (lane >> 5); float v = 0.f; if (sc0 >= 0 && (k0 + kk) < Ksrc) v = W[(size_t)(k0 + kk) * ldw + sc0 + (lane & 31)]; scr[kk * 33 + (lane & 31)] = v; }
    LDS_WAIT(); asm volatile("" ::: "memory");
    const int c = lane & 7;
#pragma unroll
    for (int j = 0; j < 4; ++j) { const int n = (lane >> 3) + 8 * j; const LAS float* s = scr + (8 * c) * 33 + n;
        u32x4 o; o.x = pk2(s[0 * 33], s[1 * 33]); o.y = pk2(s[2 * 33], s[3 * 33]); o.z = pk2(s[4 * 33], s[5 * 33]); o.w = pk2(s[6 * 33], s[7 * 33]);
        *(u32x4*)(WT + (size_t)(n0 + n) * ldt + k0 + 8 * c) = o; }
    LDS_WAIT(); asm volatile("" ::: "memory");
}
__device__ __forceinline__ void tr_job(const float* W, int N, int Ksrc, int Kdst, bf16_t* WT, int item, LAS float* scr, int lane) {
    const int nblk = N / 32, kb = item / nblk, nb = item % nblk;
    tr_item(W, N, Ksrc, 32 * nb, WT, Kdst, 32 * nb, 64 * kb, scr, lane);
}
__device__ __forceinline__ void p0_prologue(const Params& p, const Ctx& c) {
    LAS float* scr = (LAS float*)(c.lds + c.wave * 16384);
    const int gw = c.vcu * 8 + c.wave, NGW = c.G * 8;
    unsigned char* ws = c.ws;
    constexpr int I_WINJ = 32 * 480, I_LORA = 4 * 64, I_SQ = 32 * 64, I_PBJ = 8 * 64, I_KVJ = 32 * 128, I_W1E = 32 * 128, I_W2E = 32 * 64;
    constexpr int NITEMS = I_WINJ + 3 * I_LORA + 4 * I_SQ + I_PBJ + I_KVJ;
    for (int it = gw; it < NITEMS; it += NGW) {
        int r = it;
        if (r < I_WINJ) { const int kb = r / 480, nb = r % 480; const int sc0 = nb < 206 ? 32 * nb : (nb < 208 ? -1 : 32 * nb - 64);
            tr_item(p.in[I_WIN], 15296, D, sc0, (bf16_t*)(ws + WS_WIN), D, 32 * nb, 64 * kb, scr, c.lane); continue; } r -= I_WINJ;
        if (r < I_LORA) { tr_job(p.in[I_WUP], D, 96, 256, (bf16_t*)(ws + WS_WUP), r, scr, c.lane); continue; } r -= I_LORA;
        if (r < I_LORA) { tr_job(p.in[I_AUP], D, 96, 256, (bf16_t*)(ws + WS_AUP), r, scr, c.lane); continue; } r -= I_LORA;
        if (r < I_LORA) { tr_job(p.in[I_GUP], D, 256, 256, (bf16_t*)(ws + WS_GUP), r, scr, c.lane); continue; } r -= I_LORA;
        if (r < I_SQ) { tr_job(p.in[I_PA], D, D, D, (bf16_t*)(ws + WS_PA), r, scr, c.lane); continue; } r -= I_SQ;
        if (r < I_PBJ) { tr_job(p.in[I_PB], D, 512, 512, (bf16_t*)(ws + WS_PB), r, scr, c.lane); continue; } r -= I_PBJ;
        if (r < I_SQ) { tr_job(p.in[I_WOUT], D, D, D, (bf16_t*)(ws + WS_WOUT), r, scr, c.lane); continue; } r -= I_SQ;
        if (r < I_SQ) { tr_job(p.in[I_WQ], D, D, D, (bf16_t*)(ws + WS_WQ), r, scr, c.lane); continue; } r -= I_SQ;
        if (r < I_KVJ) { tr_job(p.in[I_WKV], 2 * D, D, D, (bf16_t*)(ws + WS_WKV), r, scr, c.lane); continue; } r -= I_KVJ;
        { tr_job(p.in[I_WO], D, D, D, (bf16_t*)(ws + WS_WO), r, scr, c.lane); }
    }
    const size_t gt = (size_t)c.vcu * 512 + c.tid, NT = (size_t)c.G * 512;
    for (size_t i = gt; i < (size_t)M * D / 8; i += NT) { const f32x4 a = ((const f32x4*)p.in[I_X])[2 * i], b = ((const f32x4*)p.in[I_X])[2 * i + 1];
        u32x4 o; o.x = pk2(a[0], a[1]); o.y = pk2(a[2], a[3]); o.z = pk2(b[0], b[1]); o.w = pk2(b[2], b[3]); ((u32x4*)(ws + WS_XB))[i] = o; }
    for (size_t i = gt; i < (size_t)1024 * D / 8; i += NT) { const f32x4 a = ((const f32x4*)p.in[I_MEM])[2 * i], b = ((const f32x4*)p.in[I_MEM])[2 * i + 1];
        u32x4 o; o.x = pk2(a[0], a[1]); o.y = pk2(a[2], a[3]); o.z = pk2(b[0], b[1]); o.w = pk2(b[2], b[3]); ((u32x4*)(ws + WS_MEMB))[i] = o; }
    float* rc = (float*)(ws + WS_ROT); float* rs = rc + SEQ * 32;
    for (size_t i = gt; i < (size_t)SEQ * 32; i += NT) { const int pos = (int)(i >> 5), j = (int)(i & 31);
        const double inv = exp(-(double)j * (9.210340371976184 / 32.0)); const double ang = (double)pos * inv; rc[i] = (float)cos(ang); rs[i] = (float)sin(ang); }
}

__device__ __forceinline__ void tr_store8(unsigned char* WT8, int ldt, int n0, int k0, const LAS float* scr, int lane) {
    const int c = lane & 3;
#pragma unroll
    for (int j = 0; j < 2; ++j) { const int n = (lane >> 2) + 16 * j; const LAS float* sp = scr + (16 * c) * 33 + n; u32x4 o;
        o.x = pk4_fp8(sp[0 * 33] * 64.f, sp[1 * 33] * 64.f, sp[2 * 33] * 64.f, sp[3 * 33] * 64.f); o.y = pk4_fp8(sp[4 * 33] * 64.f, sp[5 * 33] * 64.f, sp[6 * 33] * 64.f, sp[7 * 33] * 64.f);
        o.z = pk4_fp8(sp[8 * 33] * 64.f, sp[9 * 33] * 64.f, sp[10 * 33] * 64.f, sp[11 * 33] * 64.f); o.w = pk4_fp8(sp[12 * 33] * 64.f, sp[13 * 33] * 64.f, sp[14 * 33] * 64.f, sp[15 * 33] * 64.f);
        *(u32x4*)(WT8 + (size_t)(n0 + n) * ldt + k0 + 16 * c) = o; }
}
__device__ __forceinline__ void tr_item8(const float* W, int ldw, unsigned char* WT8, int ldt, int n0, int k0, LAS float* scr, int lane) {
#pragma unroll 8
    for (int i = 0; i < 32; ++i) { const int kk = 2 * i + (lane >> 5); scr[kk * 33 + (lane & 31)] = W[(size_t)(k0 + kk) * ldw + n0 + (lane & 31)]; }
    LDS_WAIT(); asm volatile("" ::: "memory");
    tr_store8(WT8, ldt, n0, k0, scr, lane);
    LDS_WAIT(); asm volatile("" ::: "memory");
}
__device__ __forceinline__ void tr_issue(const float* W, int ldw, int n0, int k0, int lane, float (&cv)[32]) {
#pragma unroll
    for (int i = 0; i < 32; ++i) cv[i] = W[(size_t)(k0 + 2 * i + (lane >> 5)) * ldw + n0 + (lane & 31)];
}
__device__ __forceinline__ void tr_finish(const float (&cv)[32], unsigned char* WT8, int ldt, int n0, int k0, LAS float* scr, int lane) {
#pragma unroll
    for (int i = 0; i < 32; ++i) scr[(2 * i + (lane >> 5)) * 33 + (lane & 31)] = cv[i];
    LDS_WAIT(); asm volatile("" ::: "memory");
    tr_store8(WT8, ldt, n0, k0, scr, lane);
    LDS_WAIT(); asm volatile("" ::: "memory");
}
constexpr int MOE_W1E = 32 * 128, MOE_W2E = 32 * 64, MOE_CONV_GROUPS = (NEXP * MOE_W2E) / 8;
__device__ __forceinline__ void conv_group(const Params& p, const Ctx& c, int gi) {
    LAS float* scr = (LAS float*)(c.lds + c.wave * 16384);
    unsigned char* ws = c.ws;
    const int r = gi * 8 + c.wave;
    { const int e = r / MOE_W2E, it = r % MOE_W2E, kb = it >> 6, nb = it & 63; tr_item8(p.in[I_W2] + (size_t)e * DFF * D, D, ws + WS_W2 + (size_t)e * D * DFF, DFF, 32 * nb, 64 * kb, scr, c.lane); }
}

#define DPP_ADD(x, ctrl) ((x) + __builtin_bit_cast(float, __builtin_amdgcn_update_dpp(0, __builtin_bit_cast(int, (x)), (ctrl), 0xF, 0xF, true)))
struct P2Tok { u32x4 cv0, pv0, cv1, pv1, ra, rb, vv; f32x4 c0, c1, s0, s1; };
__device__ __forceinline__ void p2_prep(const Params& p, const Ctx& c) {
    unsigned char* ws = c.ws;
    const bf16_t* PROJ = (const bf16_t*)(ws + WS_PROJ);
    const float* mix = p.in[I_MIX]; const float* k_k = p.in[I_KK];
    bf16_t* RZ = (bf16_t*)(ws + WS_RZ); bf16_t* KZ = (bf16_t*)(ws + WS_KZ); bf16_t* VZ = (bf16_t*)(ws + WS_VZ);
    bf16_t* LIN = (bf16_t*)(ws + WS_LIN); float* KNORM = (float*)(ws + WS_KNORM);
    bf16_t* QR = (bf16_t*)(ws + WS_QR); bf16_t* KR = (bf16_t*)(ws + WS_KR); bf16_t* VR = (bf16_t*)(ws + WS_VR);
    const float* rc = (const float*)(ws + WS_ROT); const float* rs = rc + SEQ * 32;
    int tid_ = c.tid; asm volatile("" : "+v"(tid_));
    const int tid = tid_;
    const int ch0 = tid, ch1 = tid + 512; const bool has1 = ch1 < 824;
    const f32x4 m00 = *(const f32x4*)(mix + 8 * ch0), m01 = *(const f32x4*)(mix + 8 * ch0 + 4);
    f32x4 m10 = (f32x4){0.f, 0.f, 0.f, 0.f}, m11 = m10; if (has1) { m10 = *(const f32x4*)(mix + 8 * ch1); m11 = *(const f32x4*)(mix + 8 * ch1 + 4); }
    f32x4 kk0 = (f32x4){0.f, 0.f, 0.f, 0.f}, kk1 = kk0; if (tid >= 256) { kk0 = *(const f32x4*)(k_k + 8 * (tid - 256)); kk1 = *(const f32x4*)(k_k + 8 * (tid - 256) + 4); }
    const bool rot = tid >= 64 && tid < 256, vcp = tid >= 256 && tid < 448;
    const int rw = tid - 64, which = rw / 96, rhh = (rw % 96) >> 2, re0 = (rw & 3) * 8;
    const int vhh = (tid - 256) >> 3, ve0 = ((tid - 256) & 7) * 8;
#define P2_LOAD(T, t_) do { const int pos_ = (t_) & (SEQ - 1); const bf16_t* cur_ = PROJ + (size_t)(t_) * PC; const u32x4 z4_ = (u32x4){0u, 0u, 0u, 0u}; \
        T.cv0 = *(const u32x4*)(cur_ + 8 * ch0); T.pv0 = pos_ > 0 ? *(const u32x4*)(cur_ - PC + 8 * ch0) : z4_; \
        if (has1) { T.cv1 = *(const u32x4*)(cur_ + 8 * ch1); T.pv1 = pos_ > 0 ? *(const u32x4*)(cur_ - PC + 8 * ch1) : z4_; } \
        if (rot) { const bf16_t* src_ = cur_ + ATT0 + which * 1536 + rhh * 64 + re0; T.ra = *(const u32x4*)src_; T.rb = *(const u32x4*)(src_ + 32); \
            T.c0 = *(const f32x4*)(rc + pos_ * 32 + re0); T.c1 = *(const f32x4*)(rc + pos_ * 32 + re0 + 4); T.s0 = *(const f32x4*)(rs + pos_ * 32 + re0); T.s1 = *(const f32x4*)(rs + pos_ * 32 + re0 + 4); } \
        if (vcp) T.vv = *(const u32x4*)(cur_ + ATT0 + 2 * 1536 + vhh * 64 + ve0); } while (0)
#define P2_SHIFT(z, cv, pv, ma, mb) do { const unsigned cw[4] = {cv.x, cv.y, cv.z, cv.w}, pw[4] = {pv.x, pv.y, pv.z, pv.w}; const float mm[8] = {ma[0], ma[1], ma[2], ma[3], mb[0], mb[1], mb[2], mb[3]}; \
        _Pragma("unroll") for (int j = 0; j < 4; ++j) { const float c0_ = bf2f(cw[j] & 0xffffu), c1_ = bf2f(cw[j] >> 16), q0_ = bf2f(pw[j] & 0xffffu), q1_ = bf2f(pw[j] >> 16); \
            z[2 * j] = c0_ + (q0_ - c0_) * mm[2 * j]; z[2 * j + 1] = c1_ + (q1_ - c1_) * mm[2 * j + 1]; } } while (0)
#define P2_PROC(T, t_) do { const int t = (t_), pos = t & (SEQ - 1); \
        { float z[8]; P2_SHIFT(z, T.cv0, T.pv0, m00, m01);            \
          bf16_t* dst = (tid < 256 ? RZ : KZ) + (size_t)t * D + 8 * (tid & 255); \
          { u32x4 w8; w8.x = pk2(z[0], z[1]); w8.y = pk2(z[2], z[3]); w8.z = pk2(z[4], z[5]); w8.w = pk2(z[6], z[7]); *(u32x4*)dst = w8; } \
          if (tid >= 256) { float sq = 0.f; _Pragma("unroll") for (int j = 0; j < 4; ++j) { const float a_ = z[j] * kk0[j], b_ = z[4 + j] * kk1[j]; sq += a_ * a_ + b_ * b_; } \
              sq = DPP_ADD(sq, 0xB1); sq = DPP_ADD(sq, 0x4E); sq = DPP_ADD(sq, 0x141);                   \
              if ((tid & 7) == 0) KNORM[(size_t)t * 32 + ((tid - 256) >> 3)] = sqrtf(sq); } } \
        if (has1) { float z[8]; P2_SHIFT(z, T.cv1, T.pv1, m10, m11);    \
          if (ch1 < 768) { u32x4 w8; w8.x = pk2(z[0], z[1]); w8.y = pk2(z[2], z[3]); w8.z = pk2(z[4], z[5]); w8.w = pk2(z[6], z[7]); *(u32x4*)(VZ + (size_t)t * D + 8 * (ch1 - 512)) = w8; } \
          else { float o[8]; int dcol; \
              if (ch1 < 780) { dcol = 8 * (ch1 - 768); _Pragma("unroll") for (int j = 0; j < 8; ++j) o[j] = tanhf(z[j]); } \
              else if (ch1 < 792) { dcol = 256 + 8 * (ch1 - 780); _Pragma("unroll") for (int j = 0; j < 8; ++j) o[j] = z[j]; } \
              else { dcol = 512 + 8 * (ch1 - 792); _Pragma("unroll") for (int j = 0; j < 8; ++j) o[j] = sigmoidf_(z[j]); } \
              u32x4 w; w.x = pk2(o[0], o[1]); w.y = pk2(o[2], o[3]); w.z = pk2(o[4], o[5]); w.w = pk2(o[6], o[7]); *(u32x4*)(LIN + (size_t)t * 768 + dcol) = w; } } \
        if (tid >= 448 && tid < 488) { const int q_ = tid - 448; const int dcol = (q_ < 20) ? 96 + 8 * q_ : 352 + 8 * (q_ - 20); *(u32x4*)(LIN + (size_t)t * 768 + dcol) = (u32x4){0u, 0u, 0u, 0u}; } \
        if (rot) { const unsigned aw[4] = {T.ra.x, T.ra.y, T.ra.z, T.ra.w}, bw[4] = {T.rb.x, T.rb.y, T.rb.z, T.rb.w}; float o1[8], o2[8]; \
            _Pragma("unroll") for (int j = 0; j < 8; ++j) { const float t1 = bf2f((aw[j >> 1] >> (16 * (j & 1))) & 0xffffu), t2 = bf2f((bw[j >> 1] >> (16 * (j & 1))) & 0xffffu); \
                const float cs = j < 4 ? T.c0[j & 3] : T.c1[j & 3], sn = j < 4 ? T.s0[j & 3] : T.s1[j & 3]; o1[j] = t1 * cs - t2 * sn; o2[j] = t2 * cs + t1 * sn; } \
            const int dl_ = rhh < 8 ? 1 : (rhh < 16 ? 4 : 16); const int prm = (pos % dl_) * (SEQ / dl_) + pos / dl_; \
            bf16_t* dst = (which ? KR : QR) + ((size_t)((t >> 12) * 24 + rhh) * SEQ + prm) * 64 + re0; \
            u32x4 w1; w1.x = pk2(o1[0], o1[1]); w1.y = pk2(o1[2], o1[3]); w1.z = pk2(o1[4], o1[5]); w1.w = pk2(o1[6], o1[7]); \
            u32x4 w2; w2.x = pk2(o2[0], o2[1]); w2.y = pk2(o2[2], o2[3]); w2.z = pk2(o2[4], o2[5]); w2.w = pk2(o2[6], o2[7]); \
            *(u32x4*)dst = w1; *(u32x4*)(dst + 32) = w2; } \
        if (vcp) { const int dl_ = vhh < 8 ? 1 : (vhh < 16 ? 4 : 16); const int prm = (pos % dl_) * (SEQ / dl_) + pos / dl_; \
            *(u32x4*)(VR + ((size_t)((t >> 12) * 24 + vhh) * SEQ + prm) * 64 + ve0) = T.vv; } } while (0)
    P2Tok ta, tb;
    int tq = c.vcu;
    if (tq < M) P2_LOAD(ta, tq);
    for (; tq < M; tq += 2 * c.G) {
        if (tq + c.G < M) P2_LOAD(tb, tq + c.G);
        P2_PROC(ta, tq);
        if (tq + 2 * c.G < M) P2_LOAD(ta, tq + 2 * c.G);
        if (tq + c.G < M) P2_PROC(tb, tq + c.G);
    }
#undef P2_LOAD
#undef P2_SHIFT
#undef P2_PROC
}

__device__ __forceinline__ float wave_sum_dpp(float x) {
    x = DPP_ADD(x, 0xB1); x = DPP_ADD(x, 0x4E); x = DPP_ADD(x, 0x141); x = DPP_ADD(x, 0x140);
    const int xi = __builtin_bit_cast(int, x);
    return (__builtin_bit_cast(float, __builtin_amdgcn_readlane(xi, 0)) + __builtin_bit_cast(float, __builtin_amdgcn_readlane(xi, 16))) +
           (__builtin_bit_cast(float, __builtin_amdgcn_readlane(xi, 32)) + __builtin_bit_cast(float, __builtin_amdgcn_readlane(xi, 48)));
}
__device__ __forceinline__ f32x4 tile_mm(const LAS bf16_t* A, int pa, const LAS bf16_t* Bt, int pb, int ks, int fr, int fq, f32x4 acc) {
    for (int k = 0; k < ks; ++k) { const bf16x8 a = *(const LAS bf16x8*)(A + fr * pa + 32 * k + 8 * fq), b = *(const LAS bf16x8*)(Bt + fr * pb + 32 * k + 8 * fq);
        acc = __builtin_amdgcn_mfma_f32_16x16x32_bf16(a, b, acc, 0, 0, 0); }
    return acc;
}
__device__ __forceinline__ u32x2 pack4(f32x4 v) { u32x2 w; w.x = pk2(v[0], v[1]); w.y = pk2(v[2], v[3]); return w; }
constexpr int SC_C = 32, SC_NCH = SEQ / SC_C, SC_F = 96;
constexpr int PL_X1 = 0, PL_X2 = 9216, PL_AL = 18432, PL_HT = 26112, PL_ET = 33792, PL_LBT = 53760, PL_TT = 58368, PL_GI = 60928, PL_RAW = 68608, PL_TF = 109568, PL_XB = 114176, PL_END = 115264;
#define LBAR() do { asm volatile("s_waitcnt lgkmcnt(0)" ::: "memory"); __builtin_amdgcn_s_barrier(); asm volatile("" ::: "memory"); } while (0)
__device__ __forceinline__ void p4_pre(const Params& p, const Ctx& c) {
    unsigned char* ws = c.ws;
    const bf16_t* RZ = (const bf16_t*)(ws + WS_RZ); const float* DEC = (const float*)(ws + WS_DEC); const bf16_t* KP = (const bf16_t*)(ws + WS_KP);
    const bf16_t* AN = (const bf16_t*)(ws + WS_AN); const bf16_t* BB = (const bf16_t*)(ws + WS_BB);
    bf16_t* FG = (bf16_t*)(ws + WS_F); float* BON = (float*)(ws + WS_YS);
    const float* rkp = p.in[I_RK];
    LAS bf16_t* X1 = (LAS bf16_t*)(c.lds + PL_X1); LAS bf16_t* X2 = (LAS bf16_t*)(c.lds + PL_X2); LAS bf16_t* AL = (LAS bf16_t*)(c.lds + PL_AL); LAS bf16_t* HT = (LAS bf16_t*)(c.lds + PL_HT);
    LAS bf16_t* ET = (LAS bf16_t*)(c.lds + PL_ET); LAS float* LBT = (LAS float*)(c.lds + PL_LBT); LAS bf16_t* TT = (LAS bf16_t*)(c.lds + PL_TT); LAS bf16_t* GI = (LAS bf16_t*)(c.lds + PL_GI);
    LAS float* RAW = (LAS float*)(c.lds + PL_RAW);
    LAS float* TF = (LAS float*)(c.lds + PL_TF);
    LAS float* XB = (LAS float*)(c.lds + PL_XB);
    int tid_ = c.tid; asm volatile("" : "+v"(tid_));
    const int tid = tid_, lane = tid & 63, w = __builtin_amdgcn_readfirstlane(tid >> 6), fr = lane & 15, fq = lane >> 4;
    const int ls = tid >> 4, lc4 = 4 * (tid & 15);
    f32x4 pfd; u32x2 pfb[4];
#define PRE_LOAD(TASK) do { const int bh_ = (TASK) >> 7, ch_ = (TASK) & (SC_NCH - 1); const size_t o_ = ((size_t)(bh_ >> 5) * SEQ + (size_t)ch_ * SC_C + ls) * D + (bh_ & 31) * 64 + lc4; \
        pfb[0] = *(const u32x2*)(RZ + o_); pfd = *(const f32x4*)(DEC + o_); pfb[1] = *(const u32x2*)(KP + o_); pfb[2] = *(const u32x2*)(AN + o_); pfb[3] = *(const u32x2*)(BB + o_); } while (0)
#define PRE_UNPK(w_) ((f32x4){bf2f((w_).x & 0xffffu), bf2f((w_).x >> 16), bf2f((w_).y & 0xffffu), bf2f((w_).y >> 16)})
    if (c.vcu < 128 * SC_NCH) PRE_LOAD(c.vcu);
    const bool bgconv = (c.G == 256);
    LAS float* cscr = (LAS float*)(c.lds + w * 8448);
    int tix = 0;
    for (int task = c.vcu; task < 128 * SC_NCH; task += c.G, ++tix) {
        *(LAS f32x4*)(RAW + (0 * 32 + ls) * 64 + lc4) = PRE_UNPK(pfb[0]); *(LAS f32x4*)(RAW + (1 * 32 + ls) * 64 + lc4) = pfd; *(LAS f32x4*)(RAW + (2 * 32 + ls) * 64 + lc4) = PRE_UNPK(pfb[1]);
        *(LAS f32x4*)(RAW + (3 * 32 + ls) * 64 + lc4) = PRE_UNPK(pfb[2]); *(LAS f32x4*)(RAW + (4 * 32 + ls) * 64 + lc4) = PRE_UNPK(pfb[3]);
        const int bh = task >> 7, chn = task & (SC_NCH - 1); const float rkv = rkp[(bh & 31) * 64 + lane];
        float* bon = BON + ((size_t)(bh >> 5) * SEQ + (size_t)chn * SC_C) * 32 + (bh & 31);
        if (task + c.G < 128 * SC_NCH) PRE_LOAD(task + c.G);
        float cv[32]; int ce = 0, cn0 = 0, ck0 = 0;
        if (bgconv) { const int item = (c.vcu * 64 + tix) * 8 + w; ce = item >> 12; const int rem = item & 4095; ck0 = 64 * (rem >> 7); cn0 = 32 * (rem & 127);
            tr_issue(p.in[I_W1] + (size_t)ce * D * 4096, 4096, cn0, ck0, lane, cv); }
        LBAR();
        *(LAS u32x4*)(ET + (32 + (tid >> 3)) * 104 + 8 * (tid & 7)) = (u32x4){0u, 0u, 0u, 0u};
        float g = 1.f, gprev[4], gcur[4];
#pragma unroll
        for (int s = 0; s < SC_C; ++s) { const float wv = RAW[(32 + s) * 64 + lane]; if ((s >> 2) == w) gprev[s & 3] = g; g *= wv; if ((s >> 2) == w) gcur[s & 3] = g; }
        const float gC = g;
        f32x4 ah4, bg4, kg4;
#pragma unroll
        for (int qn = 0; qn < 4; ++qn) { const int s = 4 * w + qn;
            const float rr = RAW[(0 + s) * 64 + lane], kk = RAW[(64 + s) * 64 + lane], aa = RAW[(96 + s) * 64 + lane], bb = RAW[(128 + s) * 64 + lane]; const float ig = 1.0f / gcur[qn];
            const float ah = aa * gprev[qn], bt = bb * ig, kt = kk * ig, rh = rr * gcur[qn];
            X1[s * 72 + lane] = (bf16_t)f2bf(bt); X1[(32 + s) * 72 + lane] = (bf16_t)f2bf(kt); X2[s * 72 + lane] = (bf16_t)f2bf(ah); X2[(32 + s) * 72 + lane] = (bf16_t)f2bf(rh);
            ET[s * 104 + lane] = (bf16_t)f2bf(rh); ah4[qn] = ah; bg4[qn] = bt * gC; kg4[qn] = kt * gC;
            const float bsum = wave_sum_dpp(rr * kk * rkv); if (lane == 0) bon[(size_t)s * 32] = bsum; }
        *(LAS u32x2*)(AL + lane * 40 + 4 * w) = pack4(ah4); *(LAS u32x2*)(HT + (32 + lane) * 40 + 4 * w) = pack4(bg4); *(LAS u32x2*)(ET + (32 + lane) * 104 + 64 + 4 * w) = pack4(kg4);
        LBAR();
        if (w == 0) ET[(32 + lane) * 104 + lane] = (bf16_t)f2bf(gC);
        { const int mt = w >> 1;
#pragma unroll
          for (int u = 0; u < 2; ++u) { const int nt = 2 * (w & 1) + u;
            f32x4 acc = tile_mm(X1 + 16 * mt * 72, 72, X2 + 16 * nt * 72, 72, 2, fr, fq, (f32x4){0.f, 0.f, 0.f, 0.f});
            const int n = 16 * nt + fr, m0 = 16 * mt + 4 * fq;
            if (mt < 2) { if (nt < 2) { const int t = n; f32x4 o;
#pragma unroll
                    for (int e = 0; e < 4; ++e) o[e] = (m0 + e < t) ? acc[e] : 0.f;
                    *(LAS f32x4*)(LBT + t * 36 + m0) = o; }
                else { const int t = n - 32; f32x4 o;
#pragma unroll
                    for (int e = 0; e < 4; ++e) o[e] = (m0 + e <= t) ? acc[e] : 0.f;
                    *(LAS u32x2*)(HT + t * 40 + m0) = pack4(o); } }
            else { const int s0 = m0 - 32;
                if (nt < 2) { const int t = n;
#pragma unroll
                    for (int e = 0; e < 4; ++e) AL[(64 + s0 + e) * 40 + t] = (bf16_t)f2bf((s0 + e < t) ? acc[e] : 0.f); }
                else { const int t = n - 32; f32x4 o;
#pragma unroll
                    for (int e = 0; e < 4; ++e) o[e] = (s0 + e <= t) ? acc[e] : 0.f;
                    *(LAS u32x2*)(ET + t * 104 + 64 + s0) = pack4(o); } } } }
        LBAR();
        if (tid < 32) { const int hb = 16 * (tid >> 4), sl = tid & 15; float Tr[16];
#pragma unroll
            for (int t = 0; t < 16; ++t) { float a0 = (sl == t) ? 1.f : 0.f, a1 = 0.f, a2 = 0.f, a3 = 0.f;
#pragma unroll
                for (int m4 = 0; m4 < (t + 3) / 4; ++m4) { const f32x4 l = *(const LAS f32x4*)(LBT + (hb + t) * 36 + hb + 4 * m4);
                    if (4 * m4 + 0 < t) a0 += Tr[4 * m4 + 0] * l[0]; if (4 * m4 + 1 < t) a1 += Tr[4 * m4 + 1] * l[1]; if (4 * m4 + 2 < t) a2 += Tr[4 * m4 + 2] * l[2]; if (4 * m4 + 3 < t) a3 += Tr[4 * m4 + 3] * l[3]; }
                Tr[t] = (a0 + a1) + (a2 + a3); TF[(hb + sl) * 36 + hb + t] = Tr[t]; TT[(hb + t) * 40 + hb + sl] = (bf16_t)f2bf(Tr[t]);
                if (hb) TT[t * 40 + hb + sl] = 0; } }
        LBAR();
        if (tid < 256) { const int m = tid >> 4, tl = tid & 15; float x = 0.f;
#pragma unroll
            for (int n = 0; n < 16; ++n) x += LBT[(16 + n) * 36 + m] * TF[(16 + n) * 36 + 16 + tl];
            XB[m * 17 + tl] = x; }
        LBAR();
        if (tid < 256) { const int sr = tid >> 4, tl = tid & 15; float x = 0.f;
#pragma unroll
            for (int m = 0; m < 16; ++m) x += TF[sr * 36 + m] * XB[m * 17 + tl];
            TT[(16 + tl) * 40 + sr] = (bf16_t)f2bf(x); }
        LBAR();
        for (int id = w; id < 12; id += 8) { const int tt = id / 6, nt = id % 6;
            const f32x4 acc = tile_mm(TT + 16 * tt * 40, 40, AL + 16 * nt * 40, 40, 1, fr, fq, (f32x4){0.f, 0.f, 0.f, 0.f});
            *(LAS u32x2*)(GI + (16 * nt + fr) * 40 + 16 * tt + 4 * fq) = pack4(acc); }
        LBAR();
        for (int id = w; id < 36; id += 8) { const int nt = id / 6, mt = id % 6;
            const f32x4 acc = tile_mm(GI + 16 * nt * 40, 40, HT + 16 * mt * 40, 40, 1, fr, fq, (f32x4){0.f, 0.f, 0.f, 0.f});
            LAS u32x2* ep = (LAS u32x2*)(ET + (16 * mt + fr) * 104 + 16 * nt + 4 * fq); const u32x2 ev = *ep;
            f32x4 o; o[0] = acc[0] + bf2f(ev.x & 0xffffu); o[1] = acc[1] + bf2f(ev.x >> 16); o[2] = acc[2] + bf2f(ev.y & 0xffffu); o[3] = acc[3] + bf2f(ev.y >> 16);
            *ep = pack4(o); }
        LBAR();
        { bf16_t* fg = FG + (size_t)task * (SC_F * SC_F);
          for (int idx = tid; idx < 96 * 12; idx += 512) { const int row = idx / 12, pc = idx % 12; *(u32x4*)(fg + row * 96 + 8 * pc) = *(const LAS u32x4*)(ET + row * 104 + 8 * pc); } }
        LBAR();
        if (bgconv) tr_finish(cv, ws + WS_W1 + (size_t)ce * 4096 * D, D, cn0, ck0, cscr, lane);
    }
    if (!bgconv) {
        LBAR();
        for (int r = c.vcu * 8 + w; r < NEXP * MOE_W1E; r += c.G * 8) { const int e = r >> 12, rem = r & 4095; tr_item8(p.in[I_W1] + (size_t)e * D * 4096, 4096, ws + WS_W1 + (size_t)e * 4096 * D, D, 32 * (rem & 127), 64 * (rem >> 7), cscr, lane); }
    }
    LBAR();
#undef PRE_LOAD
#undef PRE_UNPK
}
constexpr int SQ_BI = 0, SQ_BI_SZ = 64 * 104 * 2, SQ_YL = 2 * SQ_BI_SZ, SQ_YL_SZ = 32 * 64 * 4;
struct SeqSet { bf16x8 af[3][3]; u32x2 vimg, gimg; float bon; };
__device__ __forceinline__ void p4_seq(const Params& p, const Ctx& c, int bh) {
    unsigned char* ws = c.ws;
    const bf16_t* VZ = (const bf16_t*)(ws + WS_VZ); const bf16_t* GG = (const bf16_t*)(ws + WS_GG); const float* BON = (const float*)(ws + WS_YS);
    const bf16_t* FG = (const bf16_t*)(ws + WS_F) + (size_t)bh * SC_NCH * (SC_F * SC_F);
    bf16_t* YA = (bf16_t*)(ws + WS_YA);
    int tid_ = c.tid; asm volatile("" : "+v"(tid_));
    const int tid = tid_, lane = tid & 63, w = __builtin_amdgcn_readfirstlane(tid >> 6), fr = lane & 15, fq = lane >> 4;
    const int b = bh >> 5, h = bh & 31;
    const size_t base = (size_t)b * SEQ * D + h * 64;
    const int nt = w & 3, mg = w >> 2;
    LAS bf16_t* BI = (LAS bf16_t*)(c.lds + SQ_BI); LAS float* YL = (LAS float*)(c.lds + SQ_YL);
    const int vs = tid >> 4, vi4 = 4 * (tid & 15);
    const f32x4 lg4 = *(const f32x4*)(p.in[I_LNXG] + h * 64 + vi4), lb4 = *(const f32x4*)(p.in[I_LNXB] + h * 64 + vi4);
#define SEQ_LOAD(SET, CHN) do { const int chn_ = (CHN) < SC_NCH ? (CHN) : SC_NCH - 1; const bf16_t* fp = FG + (size_t)chn_ * (SC_F * SC_F); const size_t tk_ = (size_t)b * SEQ + (size_t)(chn_ * SC_C + vs); \
        asm volatile("global_load_dwordx2 %0, %1, off" : "=v"(SET.vimg) : "v"(VZ + tk_ * D + h * 64 + vi4) : "memory"); \
        _Pragma("unroll") for (int mi = 0; mi < 3; ++mi) _Pragma("unroll") for (int ks = 0; ks < 3; ++ks) \
            asm volatile("global_load_dwordx4 %0, %1, off" : "=v"(SET.af[mi][ks]) : "v"(fp + (16 * (3 * mg + mi) + fr) * SC_F + 32 * ks + 8 * fq) : "memory"); \
        asm volatile("global_load_dwordx2 %0, %1, off" : "=v"(SET.gimg) : "v"(GG + tk_ * D + h * 64 + vi4) : "memory"); \
        asm volatile("global_load_dword %0, %1, off" : "=v"(SET.bon) : "v"(BON + tk_ * 32 + h) : "memory"); } while (0)
#define SEQ_WAIT_AF(SET, N) asm volatile("s_waitcnt vmcnt(" #N ")" : "+v"(SET.af[0][0]), "+v"(SET.af[0][1]), "+v"(SET.af[0][2]), "+v"(SET.af[1][0]), "+v"(SET.af[1][1]), "+v"(SET.af[1][2]), \
        "+v"(SET.af[2][0]), "+v"(SET.af[2][1]), "+v"(SET.af[2][2]) :: "memory")
#define SEQ_WAIT_V(SET, N) asm volatile("s_waitcnt vmcnt(" #N ")" : "+v"(SET.vimg) :: "memory")
#define SEQ_WAIT_G(SET, N) asm volatile("s_waitcnt vmcnt(" #N ")" : "+v"(SET.gimg), "+v"(SET.bon), "+v"(SET.vimg) :: "memory")
#define SEQ_BODY(CH, CUR, NXT, NX2) do { const int ch = (CH), cb = ch & 1; \
        const LAS bf16_t* bi = BI + cb * (64 * 104); LAS bf16_t* bo = BI + (cb ^ 1) * (64 * 104); LAS float* yl = YL + cb * (32 * 64); \
        SEQ_LOAD(NX2, ch + 2); \
        bf16x8 bfr[3]; _Pragma("unroll") for (int ks = 0; ks < 3; ++ks) bfr[ks] = *(const LAS bf16x8*)(bi + (16 * nt + fr) * 104 + 32 * ks + 8 * fq); \
        SEQ_WAIT_AF(CUR, 28); \
        f32x4 acc[3]; _Pragma("unroll") for (int mi = 0; mi < 3; ++mi) { acc[mi] = (f32x4){0.f, 0.f, 0.f, 0.f}; \
            _Pragma("unroll") for (int ks = 0; ks < 3; ++ks) acc[mi] = __builtin_amdgcn_mfma_f32_16x16x32_bf16(CUR.af[mi][ks], bfr[ks], acc[mi], 0, 0, 0); } \
        _Pragma("unroll") for (int mi = 0; mi < 3; ++mi) { const int mt = 3 * mg + mi; \
            if (mt < 2) { _Pragma("unroll") for (int e = 0; e < 4; ++e) yl[(16 * mt + 4 * fq + e) * 64 + 16 * nt + fr] = acc[mi][e]; } \
            else *(LAS u32x2*)(bo + (16 * nt + fr) * 104 + 16 * (mt - 2) + 4 * fq) = pack4(acc[mi]); } \
        SEQ_WAIT_V(NXT, 24); \
        if (ch + 1 < SC_NCH) { bo[(vi4 + 0) * 104 + 64 + vs] = (bf16_t)(NXT.vimg.x & 0xffffu); bo[(vi4 + 1) * 104 + 64 + vs] = (bf16_t)(NXT.vimg.x >> 16); \
            bo[(vi4 + 2) * 104 + 64 + vs] = (bf16_t)(NXT.vimg.y & 0xffffu); bo[(vi4 + 3) * 104 + 64 + vs] = (bf16_t)(NXT.vimg.y >> 16); } \
        LBAR(); \
        SEQ_WAIT_G(CUR, 24); \
        { const f32x4 y4 = *(const LAS f32x4*)(yl + vs * 64 + vi4); float sm = (y4[0] + y4[1]) + (y4[2] + y4[3]); \
          sm = DPP_ADD(sm, 0xB1); sm = DPP_ADD(sm, 0x4E); sm = DPP_ADD(sm, 0x141); sm = DPP_ADD(sm, 0x140);     \
          const float mu = sm * (1.0f / 64.0f); const f32x4 d4 = y4 - mu; float q = (d4[0] * d4[0] + d4[1] * d4[1]) + (d4[2] * d4[2] + d4[3] * d4[3]); \
          q = DPP_ADD(q, 0xB1); q = DPP_ADD(q, 0x4E); q = DPP_ADD(q, 0x141); q = DPP_ADD(q, 0x140); \
          const float rstd = rsqrtf(q * (1.0f / 64.0f) + GN_EPS); \
          const float v0 = bf2f(CUR.vimg.x & 0xffffu), v1 = bf2f(CUR.vimg.x >> 16), v2 = bf2f(CUR.vimg.y & 0xffffu), v3 = bf2f(CUR.vimg.y >> 16); \
          const float g0 = bf2f(CUR.gimg.x & 0xffffu), g1 = bf2f(CUR.gimg.x >> 16), g2 = bf2f(CUR.gimg.y & 0xffffu), g3 = bf2f(CUR.gimg.y >> 16); \
          const float o0 = (d4[0] * rstd * lg4[0] + lb4[0] + CUR.bon * v0) * g0, o1 = (d4[1] * rstd * lg4[1] + lb4[1] + CUR.bon * v1) * g1; \
          const float o2 = (d4[2] * rstd * lg4[2] + lb4[2] + CUR.bon * v2) * g2, o3 = (d4[3] * rstd * lg4[3] + lb4[3] + CUR.bon * v3) * g3; \
          *(u32x2*)(YA + base + (size_t)(ch * SC_C + vs) * D + vi4) = (u32x2){pk2(o0, o1), pk2(o2, o3)}; } } while (0)
    SeqSet sa, sb, sc;
    SEQ_LOAD(sa, 0); SEQ_LOAD(sb, 1);
    SEQ_WAIT_V(sa, 0);
    for (int idx = tid; idx < 64 * 8; idx += 512) *(LAS u32x4*)(BI + (idx >> 3) * 104 + 8 * (idx & 7)) = (u32x4){0u, 0u, 0u, 0u};
    BI[(vi4 + 0) * 104 + 64 + vs] = (bf16_t)(sa.vimg.x & 0xffffu); BI[(vi4 + 1) * 104 + 64 + vs] = (bf16_t)(sa.vimg.x >> 16);
    BI[(vi4 + 2) * 104 + 64 + vs] = (bf16_t)(sa.vimg.y & 0xffffu); BI[(vi4 + 3) * 104 + 64 + vs] = (bf16_t)(sa.vimg.y >> 16);
    LBAR();
    for (int c0 = 0; c0 < SC_NCH; c0 += 3) {
        SEQ_BODY(c0, sa, sb, sc);
        if (c0 + 1 < SC_NCH) SEQ_BODY(c0 + 1, sb, sc, sa);
        if (c0 + 2 < SC_NCH) SEQ_BODY(c0 + 2, sc, sa, sb);
    }
    asm volatile("s_waitcnt vmcnt(0)" ::: "memory");
    LBAR();
#undef SEQ_LOAD
#undef SEQ_BODY
#undef SEQ_WAIT_AF
#undef SEQ_WAIT_V
#undef SEQ_WAIT_G
}

__device__ __forceinline__ void p4_attn_task(const Ctx& c, int task) {
    unsigned char* ws = c.ws;
    const bf16_t* QR = (const bf16_t*)(ws + WS_QR); const bf16_t* KR = (const bf16_t*)(ws + WS_KR); const bf16_t* VR = (const bf16_t*)(ws + WS_VR);
    float* AO = (float*)(ws + WS_AO); float* LSE = (float*)(ws + WS_LSE);
    constexpr int VP = 280;
    LAS bf16_t* Vt = (LAS bf16_t*)c.lds;
    const int combo = task & 31, hh = (task >> 5) % 24, b = task / (32 * 24);
    const int g = hh >> 3, h = hh & 7;
    const int dil = g == 0 ? 1 : (g == 1 ? 4 : 16), nblk = 32 / dil;
    const int res = combo / nblk, blk = combo % nblk;
    int tid_ = c.tid; asm volatile("" : "+v"(tid_));
    const int tid = tid_, lane = tid & 63, w = __builtin_amdgcn_readfirstlane(tid >> 6);
    const int qq = lane & 15, g4 = lane >> 4, r0 = 16 * w;
    const size_t rowb = (size_t)(b * 24 + hh) * SEQ + (size_t)res * (SEQ / dil) + (size_t)blk * 128;
    bf16x8 qf[2], kf[9][2];
#pragma unroll
    for (int ks = 0; ks < 2; ++ks) qf[ks] = *(const bf16x8*)(QR + (rowb + r0 + qq) * 64 + 32 * ks + 8 * g4);
#pragma unroll
    for (int kt = 0; kt < 9; ++kt) { const bool kv = (blk > 0) || (w + kt >= 8);
#pragma unroll
        for (int ks = 0; ks < 2; ++ks) { kf[kt][ks] = (bf16x8){0, 0, 0, 0, 0, 0, 0, 0};
            if (kv) kf[kt][ks] = *(const bf16x8*)(KR + (rowb - 128 + 16 * (w + kt) + qq) * 64 + 32 * ks + 8 * g4); } }
    const int vki = tid >> 1, vdh = tid & 1;
    u32x4 vv[4];
    if (blk > 0 || vki >= 128) {
#pragma unroll
        for (int j = 0; j < 4; ++j) vv[j] = *(const u32x4*)(VR + (rowb - 128 + vki) * 64 + 32 * vdh + 8 * j); }
    else {
#pragma unroll
        for (int j = 0; j < 4; ++j) vv[j] = (u32x4){0u, 0u, 0u, 0u}; }
    __syncthreads();
#pragma unroll
    for (int j = 0; j < 4; ++j) { const unsigned wv[4] = {vv[j].x, vv[j].y, vv[j].z, vv[j].w};
#pragma unroll
        for (int e = 0; e < 8; ++e) Vt[(32 * vdh + 8 * j + e) * VP + vki] = (bf16_t)((wv[e >> 1] >> (16 * (e & 1))) & 0xffffu); }
    if (tid < 64) {
#pragma unroll
        for (int e = 0; e < 24; ++e) Vt[tid * VP + 256 + e] = 0; }
    f32x4 sc[10];
#pragma unroll
    for (int kt = 0; kt < 9; ++kt) { f32x4 a = (f32x4){0.f, 0.f, 0.f, 0.f};
#pragma unroll
        for (int ks = 0; ks < 2; ++ks) a = __builtin_amdgcn_mfma_f32_16x16x32_bf16(kf[kt][ks], qf[ks], a, 0, 0, 0);
        sc[kt] = a; }
    const int r = r0 + qq;
    float mx = -3.0e38f;
#pragma unroll
    for (int kt = 0; kt < 9; ++kt)
#pragma unroll
        for (int j = 0; j < 4; ++j) { const int ki = 16 * (w + kt) + 4 * g4 + j; const bool ok = (ki >= r) && (ki <= r + 128) && (blk > 0 || ki >= 128);
            const float sv = ok ? sc[kt][j] * 0.125f : -1.0e30f; sc[kt][j] = sv; mx = fmaxf(mx, sv); }
    mx = fmaxf(mx, __shfl_xor(mx, 16)); mx = fmaxf(mx, __shfl_xor(mx, 32));
    float den = 0.f;
#pragma unroll
    for (int kt = 0; kt < 9; ++kt)
#pragma unroll
        for (int j = 0; j < 4; ++j) { const float pexp = __expf(sc[kt][j] - mx); sc[kt][j] = pexp; den += pexp; }
    den += __shfl_xor(den, 16); den += __shfl_xor(den, 32);
    sc[9] = (f32x4){0.f, 0.f, 0.f, 0.f};
    __syncthreads();
    f32x4 oacc[4];
#pragma unroll
    for (int dt = 0; dt < 4; ++dt) oacc[dt] = (f32x4){0.f, 0.f, 0.f, 0.f};
#pragma unroll
    for (int cidx = 0; cidx < 5; ++cidx) {
        const f32x4 p0 = sc[2 * cidx], p1 = sc[2 * cidx + 1];
        u32x4 pw; pw.x = pk2(p0[0], p0[1]); pw.y = pk2(p0[2], p0[3]); pw.z = pk2(p1[0], p1[1]); pw.w = pk2(p1[2], p1[3]);
        const bf16x8 pf = __builtin_bit_cast(bf16x8, pw);
        const int kbase = 16 * (w + 2 * cidx) + 4 * g4;
#pragma unroll
        for (int dt = 0; dt < 4; ++dt) { const LAS bf16_t* vp = Vt + (16 * dt + qq) * VP + kbase;
            const u32x2 lo = *(const LAS u32x2*)vp, hi = *(const LAS u32x2*)(vp + 16);
            u32x4 vw; vw.x = lo.x; vw.y = lo.y; vw.z = hi.x; vw.w = hi.y;
            oacc[dt] = __builtin_amdgcn_mfma_f32_16x16x32_bf16(__builtin_bit_cast(bf16x8, vw), pf, oacc[dt], 0, 0, 0); }
    }
    const float inv = 1.0f / den;
    const size_t tok = (size_t)b * SEQ + (size_t)(blk * 128 + r) * dil + res;
#pragma unroll
    for (int dt = 0; dt < 4; ++dt) *(f32x4*)(AO + ((size_t)g * M + tok) * 512 + h * 64 + 16 * dt + 4 * g4) = oacc[dt] * inv;
    if (g4 == 0) LSE[((size_t)g * M + tok) * 8 + h] = mx + __logf(den);
}

constexpr int Q_ATT = 3072, Q_TOTAL = Q_ATT + MOE_CONV_GROUPS;
__device__ __forceinline__ void p4_queue(const Params& p, const Ctx& c, volatile LAS unsigned* qslot) {
    unsigned* qc = (unsigned*)(c.ws + WS_CTL) + CW_Q;
    for (;;) {
        __syncthreads();
        if (c.tid == 0) qslot[0] = __hip_atomic_fetch_add(qc, 1u, __ATOMIC_RELAXED, __HIP_MEMORY_SCOPE_AGENT);
        __syncthreads();
        const unsigned it = qslot[0];
        if (it >= (unsigned)Q_TOTAL) break;
        if (it < (unsigned)Q_ATT) p4_attn_task(c, (int)it); else conv_group(p, c, (int)it - Q_ATT);
    }
}

__device__ __forceinline__ void p5_post(const Params& p, const Ctx& c) {
    unsigned char* ws = c.ws;
    const float* AO = (const float*)(ws + WS_AO); const float* LSE = (const float*)(ws + WS_LSE);
    bf16_t* YB = (bf16_t*)(ws + WS_YB);
    const int gw = c.vcu * 8 + c.wave, NGW = c.G * 8, lane = c.lane;
    for (int it = gw; it < M * 8; it += NGW) {
        const int t = it >> 3, h = it & 7;
        const float l0 = LSE[((size_t)0 * M + t) * 8 + h], l1 = LSE[((size_t)1 * M + t) * 8 + h], l2 = LSE[((size_t)2 * M + t) * 8 + h];
        const float mxl = fmaxf(l0, fmaxf(l1, l2)); const float e0 = __expf(l0 - mxl), e1 = __expf(l1 - mxl), e2 = __expf(l2 - mxl); const float inv = 1.0f / (e0 + e1 + e2);
        const size_t o = (size_t)t * 512 + h * 64 + lane;
        const float v = (e0 * AO[o] + e1 * AO[(size_t)M * 512 + o] + e2 * AO[(size_t)2 * M * 512 + o]) * inv;
        YB[o] = (bf16_t)f2bf(v);
    }
}

__device__ __forceinline__ void ln_rows(const Ctx& c, const float* in, const float* gam, const float* bet, float* outf, bf16_t* outb, unsigned char* outq = nullptr) {
    const int gw = c.vcu * 8 + c.wave, NGW = c.G * 8, lane = c.lane;
    for (int m = gw; m < M; m += NGW) {
        const f32x4* xr = (const f32x4*)(in + (size_t)m * D) + lane;
        f32x4 v[8]; float s = 0.f;
#pragma unroll
        for (int j = 0; j < 8; ++j) { v[j] = xr[64 * j]; s += (v[j][0] + v[j][1]) + (v[j][2] + v[j][3]); }
        const float mean = wave_sum(s) * (1.0f / D); float s2 = 0.f;
#pragma unroll
        for (int j = 0; j < 8; ++j) { v[j] = v[j] - mean; s2 += (v[j][0] * v[j][0] + v[j][1] * v[j][1]) + (v[j][2] * v[j][2] + v[j][3] * v[j][3]); }
        const float rstd = rsqrtf(wave_sum(s2) * (1.0f / D) + LN_EPS);
#pragma unroll
        for (int j = 0; j < 8; ++j) { const int col = 4 * lane + 256 * j; const f32x4 gv = *(const f32x4*)(gam + col), bv = *(const f32x4*)(bet + col);
            const f32x4 o = v[j] * rstd * gv + bv;
            *(f32x4*)(outf + (size_t)m * D + col) = o;
            if (outb) { u32x2 w; w.x = pk2(o[0], o[1]); w.y = pk2(o[2], o[3]); *(u32x2*)(outb + (size_t)m * D + col) = w; }
            if (outq) *(unsigned*)(outq + (size_t)m * D + col) = pk4_fp8(o[0], o[1], o[2], o[3]); }
    }
}

__device__ __forceinline__ void p15_router(const Params& p, const Ctx& c) {
    unsigned char* ws = c.ws;
    const float* X2 = (const float*)(ws + WS_X2); const float* RW = p.in[I_RW]; const float* RB = p.in[I_RB];
    unsigned* cnt = (unsigned*)(ws + WS_CTL) + CW_CNT; int* LIST = (int*)(ws + WS_LIST); int* ROWI = (int*)(ws + WS_ROWI); float* TOPW = (float*)(ws + WS_TOPW);
    LAS float* scr = (LAS float*)(c.lds + c.wave * 8192);
    const int gw = c.vcu * 8 + c.wave, NGW = c.G * 8, lane = c.lane, li = lane & 31, lk = lane >> 5;
    for (int tb = gw; tb < M / 32; tb += NGW) {
        const int t0 = tb * 32;
        f32x16 acc;
#pragma unroll
        for (int j = 0; j < 16; ++j) acc[j] = 0.f;
        const float* xa = X2 + (size_t)(t0 + li) * D + 4 * lk;
        const float* wb = RW + (size_t)(4 * lk) * 32 + li;
        for (int kb = 0; kb < D / 8; ++kb) {
            const f32x4 a = *(const f32x4*)(xa + 8 * kb);
            const float b0 = wb[(size_t)(8 * kb + 0) * 32], b1 = wb[(size_t)(8 * kb + 1) * 32], b2 = wb[(size_t)(8 * kb + 2) * 32], b3 = wb[(size_t)(8 * kb + 3) * 32];
            acc = __builtin_amdgcn_mfma_f32_32x32x2f32(a[0], b0, acc, 0, 0, 0);
            acc = __builtin_amdgcn_mfma_f32_32x32x2f32(a[1], b1, acc, 0, 0, 0);
            acc = __builtin_amdgcn_mfma_f32_32x32x2f32(a[2], b2, acc, 0, 0, 0);
            acc = __builtin_amdgcn_mfma_f32_32x32x2f32(a[3], b3, acc, 0, 0, 0);
        }
        const float bias = RB[li];
#pragma unroll
        for (int rg = 0; rg < 16; ++rg) { const int row = (rg & 3) + 8 * (rg >> 2) + 4 * lk; scr[row * 33 + li] = acc[rg] + bias; }
        LDS_WAIT(); asm volatile("" ::: "memory");
        if (lane < 32) {
            float lv[32];
#pragma unroll
            for (int e = 0; e < 32; ++e) lv[e] = scr[lane * 33 + e];
            int id[4]; float tv[4];
#pragma unroll
            for (int k = 0; k < 4; ++k) { float best = -3.0e38f; int bi = 0;
#pragma unroll
                for (int e = 0; e < 32; ++e) { const bool tk = lv[e] > best; best = tk ? lv[e] : best; bi = tk ? e : bi; }
                id[k] = bi; tv[k] = best;
#pragma unroll
                for (int e = 0; e < 32; ++e) lv[e] = (e == bi) ? -3.0e38f : lv[e]; }
            const float e1 = __expf(tv[1] - tv[0]), e2 = __expf(tv[2] - tv[0]), e3 = __expf(tv[3] - tv[0]); const float inv = 1.0f / (1.0f + e1 + e2 + e3);
            const float wv[4] = {inv, e1 * inv, e2 * inv, e3 * inv};
            const int t = t0 + lane;
#pragma unroll
            for (int k = 0; k < 4; ++k) { const unsigned slot = __hip_atomic_fetch_add(cnt + id[k], 1u, __ATOMIC_RELAXED, __HIP_MEMORY_SCOPE_AGENT);
                LIST[(size_t)id[k] * CAP + slot] = t; ROWI[(size_t)t * 4 + k] = id[k] * CAP + (int)slot; TOPW[(size_t)t * 4 + k] = wv[k]; }
        }
        LDS_WAIT(); asm volatile("" ::: "memory");
    }
}

__device__ __forceinline__ void moe_table(const Ctx& c, LAS int* tab) {
    if (c.tid == 0) { unsigned* cnt = (unsigned*)(c.ws + WS_CTL) + CW_CNT; int ts = 0;
        for (int e = 0; e < NEXP; ++e) { const int n = (int)__hip_atomic_load(cnt + e, __ATOMIC_RELAXED, __HIP_MEMORY_SCOPE_AGENT); tab[e] = n; tab[32 + e] = ts; ts += (n + 255) >> 8; }
        tab[64] = ts; }
    __syncthreads();
}

__device__ __forceinline__ void p18_combine(const Params& p, const Ctx& c, const LAS int* tab) {
    unsigned char* ws = c.ws;
    const float* X2 = (const float*)(ws + WS_X2); const bf16_t* Y = (const bf16_t*)(ws + WS_Y); const int* ROWI = (const int*)(ws + WS_ROWI); const float* TOPW = (const float*)(ws + WS_TOPW);
    const float* gam = p.in[I_LN3G]; const float* bet = p.in[I_LN3B];
    const int gw = c.vcu * 8 + c.wave, NGW = c.G * 8, lane = c.lane;
    for (int m = gw; m < M; m += NGW) {
        f32x4 v[8];
        const f32x4* xr = (const f32x4*)(X2 + (size_t)m * D) + lane;
#pragma unroll
        for (int j = 0; j < 8; ++j) v[j] = xr[64 * j] * DN_ALPHA;
#pragma unroll
        for (int k = 0; k < 4; ++k) { const int ri = ROWI[(size_t)m * 4 + k]; const float gt = TOPW[(size_t)m * 4 + k]; const int e = ri >> 14, slot = ri & (CAP - 1);
            const u32x2* yr = (const u32x2*)(Y + ((size_t)tab[32 + e] * 256 + slot) * D) + lane;
#pragma unroll
            for (int j = 0; j < 8; ++j) { const u32x2 yw = yr[64 * j]; v[j] = v[j] + (f32x4){bf2f(yw.x & 0xffffu), bf2f(yw.x >> 16), bf2f(yw.y & 0xffffu), bf2f(yw.y >> 16)} * gt; } }
        float s = 0.f;
#pragma unroll
        for (int j = 0; j < 8; ++j) s += (v[j][0] + v[j][1]) + (v[j][2] + v[j][3]);
        const float mean = wave_sum(s) * (1.0f / D); float s2 = 0.f;
#pragma unroll
        for (int j = 0; j < 8; ++j) { v[j] = v[j] - mean; s2 += (v[j][0] * v[j][0] + v[j][1] * v[j][1]) + (v[j][2] * v[j][2] + v[j][3] * v[j][3]); }
        const float rstd = rsqrtf(wave_sum(s2) * (1.0f / D) + LN_EPS);
#pragma unroll
        for (int j = 0; j < 8; ++j) { const int col = 4 * lane + 256 * j; const f32x4 gv = *(const f32x4*)(gam + col), bv = *(const f32x4*)(bet + col);
            *(f32x4*)(p.out + (size_t)m * D + col) = v[j] * rstd * gv + bv; }
    }
}

constexpr int NPHASE = 19;
__global__ void __launch_bounds__(512, 2) fwd(Params p) {
    extern __shared__ __attribute__((aligned(16))) unsigned char lds_raw[];
    LAS unsigned char* lds = (LAS unsigned char*)lds_raw;
    Ctx c; c.tid = threadIdx.x; c.lane = c.tid & 63; c.wave = __builtin_amdgcn_readfirstlane(c.tid >> 6); c.G = gridDim.x;
    { const int bx = blockIdx.x; c.vcu = (c.G % 8 == 0) ? (bx % 8) * (c.G / 8) + bx / 8 : bx; }
    c.lds = lds; c.ws = p.ws;
    unsigned char* ws = p.ws;
    volatile LAS unsigned* MISC = (volatile LAS unsigned*)(lds + MISC_OFF);
    LAS int* tab = (LAS int*)(lds + MISC_OFF + 1024);
    if (c.tid < 64) MISC[c.tid] = 0u;
    __syncthreads();
    unsigned* ctl = (unsigned*)(ws + WS_CTL);
    XcdBarrier bar; bar.bar = ctl + CW_BAR + p.li * XCD_BAR_WORDS; bar.x = 0; bar.st = MISC + 8;
    if (N_LAUNCH_MODE == 1) bar = xcd_barrier_post(ctl + CW_BAR + p.li * XCD_BAR_WORDS, MISC + 8);
    const int lo = p.ph_lo, hi = p.ph_hi, bx = blockIdx.x;
#ifndef PHMASK
#define PHMASK 0xFFFFFFFFu
#endif
#define IN(k) (((PHMASK >> (k)) & 1u) && lo <= (k) && (k) < hi)
#define SEAM(k) do { if (N_LAUNCH_MODE == 1 && IN((k) + 1)) xcd_barrier(bar); } while (0)

    if (IN(0)) { p0_prologue(p, c); SEAM(0); }

    if (IN(1)) {
        pg8::StaticOrder S; S.init(ws + WS_XB, ws + WS_WIN, M, PC, D, D, c.G, bx);
        pg8::EpiBf16 E{(bf16_t*)(ws + WS_PROJ), PC, 1.0f};
        pg8::gemm_phase<pg8::EpiBf16, pg8::StaticOrder>(lds, pg8::Gemm{D, D, D}, S, E);
        SEAM(1);
    }
    if (IN(2)) { p2_prep(p, c); SEAM(2); }

    if (IN(3)) {
#ifndef P3M
#define P3M 15
#endif
        if (P3M & 1) { pg8::StaticOrder S; S.init(ws + WS_LIN, ws + WS_WUP, M, D, 768, 256, c.G, bx);
          pg8::EpiDecay E{(float*)(ws + WS_DEC), p.in[I_W0]};
          pg8::gemm_phase<pg8::EpiDecay, pg8::StaticOrder>(lds, pg8::Gemm{256, 768, 256}, S, E); }
        if (P3M & 2) { pg8::StaticOrder S; S.init(ws + WS_LIN + 512, ws + WS_AUP, M, D, 768, 256, c.G, bx);
          pg8::EpiIclr E{p.in[I_A0], p.in[I_KK], p.in[I_KA], (const bf16_t*)(ws + WS_KZ), (const float*)(ws + WS_KNORM), (bf16_t*)(ws + WS_KP), (bf16_t*)(ws + WS_AN), (bf16_t*)(ws + WS_BB)};
          pg8::gemm_phase<pg8::EpiIclr, pg8::StaticOrder>(lds, pg8::Gemm{256, 768, 256}, S, E); }
        if (P3M & 4) { pg8::StaticOrder S; S.init(ws + WS_LIN + 1024, ws + WS_GUP, M, D, 768, 256, c.G, bx);
          pg8::EpiBf16 E{(bf16_t*)(ws + WS_GG), D, 1.0f};
          pg8::gemm_phase<pg8::EpiBf16, pg8::StaticOrder>(lds, pg8::Gemm{256, 768, 256}, S, E); }
        if (P3M & 8) { pg8::StaticOrder S; S.init(ws + WS_MEMB, ws + WS_WKV, 1024, 2 * D, D, D, c.G, bx);
          pg8::EpiKV E{(bf16_t*)(ws + WS_KB), (bf16_t*)(ws + WS_VT)};
          pg8::gemm_phase<pg8::EpiKV, pg8::StaticOrder>(lds, pg8::Gemm{D, D, D}, S, E); }
        SEAM(3);
    }
    if (IN(4)) {
        p4_pre(p, c);
        xcd_barrier(bar);
        for (int bh = c.vcu; bh < 128; bh += c.G) p4_seq(p, c, bh);
        p4_queue(p, c, MISC + 16);
        SEAM(4);
    }
    if (IN(5)) { p5_post(p, c); }

    if (IN(6)) {
        pg8::StaticOrder S; S.init(ws + WS_YA, ws + WS_PA, M, D, D, D, c.G, bx);
        pg8::EpiGateA E{(const bf16_t*)(ws + WS_PROJ), (float*)(ws + WS_TMP)};
        pg8::gemm_phase<pg8::EpiGateA, pg8::StaticOrder>(lds, pg8::Gemm{D, D, D}, S, E);
        SEAM(6);
    }
    if (IN(7)) {
        pg8::StaticOrder S; S.init(ws + WS_YB, ws + WS_PB, M, D, 512, 512, c.G, bx);
        pg8::EpiGateB E{(const bf16_t*)(ws + WS_PROJ), (const float*)(ws + WS_TMP), (bf16_t*)(ws + WS_MERGED)};
        pg8::gemm_phase<pg8::EpiGateB, pg8::StaticOrder>(lds, pg8::Gemm{512, 512, 512}, S, E);
        SEAM(7);
    }
    if (IN(8)) {
        pg8::StaticOrder S; S.init(ws + WS_MERGED, ws + WS_WOUT, M, D, D, D, c.G, bx);
        pg8::EpiF32 E{(float*)(ws + WS_T1), D, nullptr, 0, p.in[I_X], DN_ALPHA};
        pg8::gemm_phase<pg8::EpiF32, pg8::StaticOrder>(lds, pg8::Gemm{D, D, D}, S, E);
        SEAM(8);
    }
    if (IN(9)) { ln_rows(c, (const float*)(ws + WS_T1), p.in[I_LN1G], p.in[I_LN1B], (float*)(ws + WS_X1), (bf16_t*)(ws + WS_X1B)); SEAM(9); }

    if (IN(10)) {
        pg8::StaticOrder S; S.init(ws + WS_X1B, ws + WS_WQ, M, D, D, D, c.G, bx);
        pg8::EpiBf16 E{(bf16_t*)(ws + WS_Q), D, 0.04419417382415922f};
        pg8::gemm_phase<pg8::EpiBf16, pg8::StaticOrder>(lds, pg8::Gemm{D, D, D}, S, E);
        SEAM(10);
    }
    if (IN(11)) {
        ScoreOrder S{(const char*)(ws + WS_Q), (const char*)(ws + WS_KB), c.G, bx};
        pg8::EpiSoftmax E{(bf16_t*)(ws + WS_PP)};
        pg8::gemm_phase<pg8::EpiSoftmax, ScoreOrder, false>(lds, pg8::Gemm{512, D, D}, S, E);
        SEAM(11);
    }
    if (IN(12)) {
        PvOrder S{(const char*)(ws + WS_PP), (const char*)(ws + WS_VT), c.G, bx};
        pg8::EpiBf16 E{(bf16_t*)(ws + WS_OC), D, 1.0f};
        pg8::gemm_phase<pg8::EpiBf16, PvOrder>(lds, pg8::Gemm{256, 256, 256}, S, E);
        SEAM(12);
    }
    if (IN(13)) {
        pg8::StaticOrder S; S.init(ws + WS_OC, ws + WS_WO, M, D, D, D, c.G, bx);
        pg8::EpiF32 E{(float*)(ws + WS_T2), D, nullptr, 0, (const float*)(ws + WS_X1), DN_ALPHA};
        pg8::gemm_phase<pg8::EpiF32, pg8::StaticOrder>(lds, pg8::Gemm{D, D, D}, S, E);
        SEAM(13);
    }
    if (IN(14)) { ln_rows(c, (const float*)(ws + WS_T2), p.in[I_LN2G], p.in[I_LN2B], (float*)(ws + WS_X2), nullptr, ws + WS_X2B); SEAM(14); }
    if (IN(15)) { p15_router(p, c); SEAM(15); }

    if (IN(16)) {
        moe_table(c, tab);
        MoeOrder<true, 16> S{tab, (const char*)(ws + WS_X2B), (const char*)(ws + WS_W1), (const int*)(ws + WS_LIST), (size_t)4096 * D, D, c.G, bx};
        pg8::EpiSwiglu E{p.in[I_B1], (bf16_t*)(ws + WS_H)};
        pg8::gemm_phase<pg8::EpiSwiglu, MoeOrder<true, 16>, true, true>(lds, pg8::Gemm{D, D, D}, S, E);
        SEAM(16);
    }
    if (IN(17)) {
        moe_table(c, tab);
        MoeOrder<false, 8> S{tab, (const char*)(ws + WS_H), (const char*)(ws + WS_W2), (const int*)(ws + WS_LIST), (size_t)D * DFF, DFF, c.G, bx};
        pg8::EpiBf16Bias E{(bf16_t*)(ws + WS_Y), D, p.in[I_B2], D};
        pg8::gemm_phase<pg8::EpiBf16Bias, MoeOrder<false, 8>, true, true>(lds, pg8::Gemm{DFF, DFF, DFF}, S, E);
        SEAM(17);
    }
    if (IN(18)) { moe_table(c, tab); p18_combine(p, c, tab); }
#undef IN
#undef SEAM
}

extern "C" void kernel_launch(void* const* d_in, const int* in_sizes, int n_in, void* d_out, int out_size, void* d_ws, size_t ws_size, hipStream_t stream) {
    static int grid = 0;
    if (grid == 0) {
        if (n_in != 32 || out_size != M * D || ws_size < WS_END) { fprintf(stderr, "kernel_launch: expected 32 inputs, %d outputs, >= %zu bytes of workspace; got %d, %d, %zu\n", M * D, (size_t)WS_END, n_in, out_size, ws_size); grid = -1; return; }
        int dev = 0, cus = 0, per_cu = 0;
        if (hipGetDevice(&dev) != hipSuccess || hipDeviceGetAttribute(&cus, hipDeviceAttributeMultiprocessorCount, dev) != hipSuccess) { grid = -1; return; }
        if (hipFuncSetAttribute((const void*)fwd, hipFuncAttributeMaxDynamicSharedMemorySize, LDS_BYTES) != hipSuccess) { fprintf(stderr, "kernel_launch: hipFuncSetAttribute failed\n"); grid = -1; return; }
        if (hipOccupancyMaxActiveBlocksPerMultiprocessor(&per_cu, (const void*)fwd, 512, LDS_BYTES) != hipSuccess || per_cu < 1) fprintf(stderr, "kernel_launch: occupancy query reports %d\n", per_cu);
        (void)hipGetLastError();
        grid = cus;
        if (grid != 256) fprintf(stderr, "kernel_launch: %d CUs; this kernel is built for 256\n", grid);
    }
    if (grid < 0) return;
    (void)hipMemsetAsync((char*)d_ws + WS_CTL, 0, CTL_ZERO_BYTES, stream);
    Params p{};
    for (int i = 0; i < 32; ++i) p.in[i] = (const float*)d_in[i];
    p.out = (float*)d_out; p.ws = (unsigned char*)d_ws;
#if defined(TIMING_REPEAT_LO)
    { const int cuts[4][2] = {{0, TIMING_REPEAT_HI}, {TIMING_REPEAT_LO, TIMING_REPEAT_HI}, {TIMING_REPEAT_HI, NPHASE}, {0, 0}};
      for (int li = 0; li < 3; ++li) { if (cuts[li][0] >= cuts[li][1]) continue; p.ph_lo = cuts[li][0]; p.ph_hi = cuts[li][1]; p.li = li; hipLaunchKernelGGL(fwd, dim3(grid), dim3(512), LDS_BYTES, stream, p); } }
#else
    if (N_LAUNCH_MODE == 1) { p.ph_lo = 0; p.ph_hi = NPHASE; hipLaunchKernelGGL(fwd, dim3(grid), dim3(512), LDS_BYTES, stream, p); }
    else for (int k = 0; k < NPHASE; ++k) { p.ph_lo = k; p.ph_hi = k + 1; hipLaunchKernelGGL(fwd, dim3(grid), dim3(512), LDS_BYTES, stream, p); }
#endif
}
```

```cpp
#include <hip/hip_runtime.h>
#include <cstdio>
#include <cstdint>

#define LAS __attribute__((address_space(3)))
#define GAS __attribute__((address_space(1)))
typedef unsigned short bf16_t;
typedef short bf16x8 __attribute__((ext_vector_type(8)));
typedef float f32x4 __attribute__((ext_vector_type(4)));
typedef float f32x2 __attribute__((ext_vector_type(2)));
typedef float f32x16 __attribute__((ext_vector_type(16)));
typedef unsigned u32x4 __attribute__((ext_vector_type(4)));
typedef unsigned u32x2 __attribute__((ext_vector_type(2)));

#ifndef N_LAUNCH_MODE
#define N_LAUNCH_MODE 1
#endif

constexpr int M = 16384, D = 2048, SEQ = 4096, NBATCH = 4;
constexpr int RWC = 6592;
constexpr int PC = 15360;
constexpr int ATT0 = 6656, GATE0 = 11264;
constexpr int NEXP = 32, DFF = 2048, CAP = 16384;
constexpr int HROWS = 65536 + 32 * 256;
constexpr float LN_EPS = 1e-5f, GN_EPS = 64e-5f;
constexpr float DN_ALPHA = 1.189207115002721f;

__device__ __forceinline__ float bf2f(unsigned v) { return __uint_as_float(v << 16); }
__device__ __forceinline__ unsigned f2bf(float f) { unsigned u = __float_as_uint(f); return (u + 0x7fffu + ((u >> 16) & 1u)) >> 16; }
__device__ __forceinline__ unsigned pk2(float lo, float hi) { return f2bf(lo) | (f2bf(hi) << 16); }
typedef int v4i __attribute__((ext_vector_type(4)));
typedef int v8i __attribute__((ext_vector_type(8)));
__device__ __forceinline__ unsigned pk4_fp8(float a, float b, float c, float d) { int r = __builtin_amdgcn_cvt_pk_fp8_f32(a, b, 0, false); r = __builtin_amdgcn_cvt_pk_fp8_f32(c, d, r, true); return (unsigned)r; }
__device__ __forceinline__ float sigmoidf_(float x) { return 1.0f / (1.0f + __expf(-x)); }
__device__ __forceinline__ float wave_sum(float v) {
#pragma unroll
    for (int o = 1; o < 64; o <<= 1) v += __shfl_xor(v, o);
    return v;
}
#define LDS_WAIT() asm volatile("s_waitcnt lgkmcnt(0)" ::: "memory")
#define VM_WAIT() asm volatile("s_waitcnt vmcnt(0)" ::: "memory")

namespace pg8 {
#define PG8_LAS __attribute__((address_space(3)))
constexpr int BM = 256, BK = 64, HALF = 128, HTB = HALF * BK * 2, STAGE_BYTES = 8 * HTB, NXCD = 8, WGM = 8;

__host__ __device__ __forceinline__ int lds_byte(int r, int c) { const int st = (r >> 4) * 2 + (c >> 5), rr = r & 15, cc = c & 31, ob = rr * 64 + cc * 2; return st * 1024 + (ob ^ (((ob >> 9) & 1) << 5)); }
__host__ __device__ __forceinline__ void stage_rc(int b, int& R, int& C) { const int st = b / 1024, sb = b % 1024, swz = sb ^ (((sb >> 9) & 1) << 5); R = (st >> 1) * 16 + swz / 64; C = (st & 1) * 32 + (swz % 64) / 2; }
__host__ __device__ __forceinline__ int perm32(int rho) { const int n = rho >> 4, i = rho & 15; return 8 * (i >> 2) + 4 * n + (i & 3); }

struct Unit { const char* A; const char* B; int orow, ocol, aux, aux2, valid; };
struct Gemm { int K, lda, ldb; };

struct StaticOrder {
    static constexpr bool GATHER = false;
    const char* A; const char* Bt; size_t ta, tb;
    int nM, nN, nwg, G, c;
    __device__ void init(const void* A_, const void* Bt_, int M_, int N_, int lda, int ldb, int G_, int c_) { A = (const char*)A_; Bt = (const char*)Bt_; ta = (size_t)BM * lda * 2; tb = (size_t)BM * ldb * 2; nM = M_ / BM; nN = N_ / BM; nwg = nM * nN; G = G_; c = c_; }
    __device__ bool next(int i, Unit& u) const {
        const long L = (long)i * G + c; if (c < 0 || L >= nwg) return false;
        int wgid = (int)L; { const int q = nwg / NXCD, r = nwg % NXCD, xcd = wgid % NXCD, off = wgid / NXCD; wgid = (xcd < r ? xcd * (q + 1) : r * (q + 1) + (xcd - r) * q) + off; }
        const int nig = WGM * nN, gid = wgid / nig, fm = gid * WGM, gsz = (nM - fm) < WGM ? (nM - fm) : WGM;
        const int pm = fm + ((wgid % nig) % gsz), pn = (wgid % nig) / gsz;
        u.A = A + (size_t)pm * ta; u.B = Bt + (size_t)pn * tb; u.orow = pm * BM; u.ocol = pn * BM; u.aux = 0; u.aux2 = 0; u.valid = BM; return true;
    }
    __device__ __forceinline__ const int* rows(const Unit&) const { return nullptr; }
};

__device__ __forceinline__ unsigned cvt_pk_bf16(float lo, float hi) { unsigned r; asm volatile("v_cvt_pk_bf16_f32 %0, %1, %2" : "=v"(r) : "v"(lo), "v"(hi)); return r; }

template <class Epi, class Sched, bool ALIGN_EPI = true, bool FP8 = false>
__device__ __forceinline__ void gemm_phase(PG8_LAS unsigned char* lds, const Gemm g, const Sched& S, const Epi& E) {
    const int tid = threadIdx.x, wid = __builtin_amdgcn_readfirstlane(tid >> 6), lane = tid & 63, wr = wid >> 2, wc = wid & 3, fr = lane & 15, fq = lane >> 4;
    constexpr int ES = FP8 ? 1 : 2;
    int sclW = 0, sclX = 0;
    if constexpr (FP8) { asm volatile("v_mov_b32 %0, 0x79797979\n\tv_mov_b32 %1, 0x7f7f7f7f" : "=v"(sclW), "=v"(sclX)); }
    const int K = g.K, nt = K * ES / (BK * 2);
    unsigned voffA[2], voffB[2]; int Rr[2], Cc[2];
#pragma unroll
    for (int i = 0; i < 2; ++i) { int R, C; stage_rc(tid * 16 + i * 8192, R, C); const int Rb = Epi::PERM ? ((R & ~31) + perm32(R & 31)) : R; Rr[i] = R; Cc[i] = C;
        voffA[i] = (unsigned)(R * g.lda * ES + C * 2); voffB[i] = (unsigned)(Rb * g.ldb * ES + C * 2); }
    const size_t kstep = (size_t)(BK * 2);
    const size_t hstepA = (size_t)HALF * g.lda * ES, hstepB = (size_t)HALF * g.ldb * ES;
    const unsigned ldsw = (unsigned)wid * 1024u;
    const int aoff = lds_byte(wr * 64 + fr, fq * 8), boff = lds_byte(wc * 32 + fr, fq * 8);
    unsigned vAc[2][2], vAn[2][2];
#define PG8_SA(b, h) (((b) * 2 + (h)) * HTB)
#define PG8_SB(b, h) ((4 + (b) * 2 + (h)) * HTB)
#define PG8_STAGE(bufoff, gbase, voff) do { _Pragma("unroll") for (int _i = 0; _i < 2; ++_i) \
        __builtin_amdgcn_global_load_lds((const unsigned*)((const char*)(gbase) + (voff)[_i]), (PG8_LAS unsigned*)(lds + (bufoff) + ldsw + _i * 8192), 16, 0, 0); } while (0)
#define PG8_STAGE_A(bufoff, kbase, h, nx) do { if constexpr (Sched::GATHER) { unsigned _v[2] = {(nx) ? vAn[h][0] : vAc[h][0], (nx) ? vAn[h][1] : vAc[h][1]}; PG8_STAGE(bufoff, kbase, _v); } \
        else { PG8_STAGE(bufoff, (kbase) + (h) * hstepA, voffA); } } while (0)
#define PG8_GOFF(u, v) do { const int* _rw = S.rows(u); _Pragma("unroll") for (int _h = 0; _h < 2; ++_h) _Pragma("unroll") for (int _i = 0; _i < 2; ++_i) { const int _r = Rr[_i] + _h * HALF; \
        const int _tk = _r < (u).valid ? _rw[_r] : 0; v[_h][_i] = (unsigned)(_tk * g.lda * ES + Cc[_i] * 2); } } while (0)
#define PG8_LDA(dst, b, h) do { _Pragma("unroll") for (int m = 0; m < 4; ++m) _Pragma("unroll") for (int k = 0; k < 2; ++k) dst[m][k] = *(const PG8_LAS bf16x8*)(lds + PG8_SA(b, h) + aoff + m * 2048 + k * 1024); } while (0)
#define PG8_LDB(dst, b, h) do { _Pragma("unroll") for (int n = 0; n < 2; ++n) _Pragma("unroll") for (int k = 0; k < 2; ++k) dst[n][k] = *(const PG8_LAS bf16x8*)(lds + PG8_SB(b, h) + boff + n * 2048 + k * 1024); } while (0)
#define PG8_MMA(ai, bj, At, Bt) do { __builtin_amdgcn_s_setprio(1); _Pragma("unroll") for (int m = 0; m < 4; ++m) _Pragma("unroll") for (int n = 0; n < 2; ++n) { \
        if constexpr (FP8) { const v4i _b0 = __builtin_bit_cast(v4i, Bt[n][0]), _b1 = __builtin_bit_cast(v4i, Bt[n][1]), _a0 = __builtin_bit_cast(v4i, At[m][0]), _a1 = __builtin_bit_cast(v4i, At[m][1]); \
            const v8i _bb = __builtin_shufflevector(_b0, _b1, 0, 1, 2, 3, 4, 5, 6, 7), _aa = __builtin_shufflevector(_a0, _a1, 0, 1, 2, 3, 4, 5, 6, 7); \
            asm volatile("v_mfma_scale_f32_16x16x128_f8f6f4 %0, %1, %2, %0, %3, %4 op_sel_hi:[0,0,0]" : "+v"(acc[ai][bj][m][n]) : "v"(_bb), "v"(_aa), "v"(sclW), "v"(sclX)); } \
        else { _Pragma("unroll") for (int k = 0; k < 2; ++k) acc[ai][bj][m][n] = __builtin_amdgcn_mfma_f32_16x16x32_bf16(Bt[n][k], At[m][k], acc[ai][bj][m][n], 0, 0, 0); } } \
        __builtin_amdgcn_s_setprio(0); } while (0)
#define PG8_WAIT_V(n) asm volatile("s_waitcnt vmcnt(" #n ")" ::: "memory")
#define PG8_WAIT_L(n) asm volatile("s_waitcnt lgkmcnt(" #n ")" ::: "memory")
#define PG8_BAR __builtin_amdgcn_s_barrier()
#define PG8_SCHED __builtin_amdgcn_sched_barrier(0)
    Unit cur, nxt; int ui = 0;
    if (!S.next(0, cur)) return;
    f32x4 acc[2][2][4][2];
#pragma unroll
    for (int a = 0; a < 2; ++a)
#pragma unroll
        for (int b = 0; b < 2; ++b)
#pragma unroll
            for (int m = 0; m < 4; ++m)
#pragma unroll
                for (int n = 0; n < 2; ++n) acc[a][b][m][n] = (f32x4){0.f, 0.f, 0.f, 0.f};
    bf16x8 At[4][2], B0[2][2], B1[2][2];
    const char* cA = cur.A; const char* cB = cur.B;
    if constexpr (Sched::GATHER) { PG8_GOFF(cur, vAc); PG8_WAIT_V(0); }
    PG8_STAGE(PG8_SB(0, 0), cB, voffB); PG8_STAGE(PG8_SB(0, 1), cB + hstepB, voffB); PG8_STAGE_A(PG8_SA(0, 0), cA, 0, false); PG8_STAGE_A(PG8_SA(0, 1), cA, 1, false);
    if (wr == 1) PG8_BAR;
    PG8_WAIT_V(2); PG8_BAR;
    PG8_STAGE(PG8_SB(1, 0), cB + kstep, voffB); PG8_STAGE_A(PG8_SA(1, 0), cA + kstep, 0, false); PG8_STAGE(PG8_SB(1, 1), cB + hstepB + kstep, voffB);
    PG8_WAIT_V(6); PG8_BAR;
    for (;;) {
        const bool has_next = S.next(ui + 1, nxt);
        const char* nA = has_next ? nxt.A : cA; const char* nB = has_next ? nxt.B : cB;
        if constexpr (Sched::GATHER) { if (has_next) { PG8_GOFF(nxt, vAn); } else {
#pragma unroll
            for (int h = 0; h < 2; ++h)
#pragma unroll
                for (int i = 0; i < 2; ++i) vAn[h][i] = vAc[h][i]; } }
#pragma nounroll
        for (int t = 0; t < nt; t += 2) {
            const bool last = (t == nt - 2);
            const char* a1 = cA + (size_t)(t + 1) * kstep;
            const char* a2 = last ? nA : cA + (size_t)(t + 2) * kstep; const char* b2 = last ? nB : cB + (size_t)(t + 2) * kstep;
            const char* a3 = a2 + kstep; const char* b3 = b2 + kstep;
            PG8_LDB(B0, 0, 0); PG8_LDB(B1, 0, 1); PG8_SCHED; PG8_LDA(At, 0, 0); PG8_STAGE_A(PG8_SA(1, 1), a1, 1, false);
            PG8_WAIT_V(8); PG8_WAIT_L(0); PG8_BAR; PG8_MMA(0, 0, At, B0); PG8_MMA(0, 1, At, B1); PG8_BAR; PG8_SCHED;
            PG8_LDA(At, 0, 1); PG8_STAGE(PG8_SB(0, 0), b2, voffB); PG8_STAGE(PG8_SB(0, 1), b2 + hstepB, voffB); PG8_STAGE_A(PG8_SA(0, 0), a2, 0, last);
            PG8_WAIT_V(8); PG8_WAIT_L(0); PG8_BAR; PG8_MMA(1, 0, At, B0); PG8_MMA(1, 1, At, B1); PG8_BAR; PG8_SCHED;
            PG8_LDB(B0, 1, 0); PG8_LDB(B1, 1, 1); PG8_SCHED; PG8_LDA(At, 1, 0); PG8_STAGE_A(PG8_SA(0, 1), a2, 1, last);
            PG8_WAIT_V(8); PG8_WAIT_L(0); PG8_BAR; PG8_MMA(0, 0, At, B0); PG8_MMA(0, 1, At, B1); PG8_BAR; PG8_SCHED;
            PG8_LDA(At, 1, 1); PG8_STAGE(PG8_SB(1, 0), b3, voffB); PG8_STAGE(PG8_SB(1, 1), b3 + hstepB, voffB); PG8_STAGE_A(PG8_SA(1, 0), a3, 0, last);
            PG8_WAIT_V(8); PG8_WAIT_L(0); PG8_BAR; PG8_MMA(1, 0, At, B0); PG8_MMA(1, 1, At, B1); PG8_BAR; PG8_SCHED;
        }
        if constexpr (ALIGN_EPI) { if (wr == 0) PG8_BAR; }
        if constexpr (FP8) asm volatile("s_nop 15\n\ts_nop 15" ::: "memory");
        if constexpr (!Epi::AFTER_DRAIN) { int l2 = lane; asm volatile("" : "+v"(l2));
            E(acc, cur, wr, wc, l2 & 15, l2 >> 4); }
        if (!has_next) break;
#pragma unroll
        for (int a = 0; a < 2; ++a)
#pragma unroll
            for (int b = 0; b < 2; ++b)
#pragma unroll
                for (int m = 0; m < 4; ++m)
#pragma unroll
                    for (int n = 0; n < 2; ++n) acc[a][b][m][n] = (f32x4){0.f, 0.f, 0.f, 0.f};
        cur = nxt; cA = nA; cB = nB; ++ui;
        if constexpr (Sched::GATHER) {
#pragma unroll
            for (int h = 0; h < 2; ++h)
#pragma unroll
                for (int i = 0; i < 2; ++i) vAc[h][i] = vAn[h][i]; }
        if constexpr (ALIGN_EPI) { if (wr == 1) PG8_BAR; }
    }
    PG8_WAIT_V(0);
    if constexpr (!ALIGN_EPI) { if (wr == 0) PG8_BAR; }
    PG8_BAR;
    if constexpr (Epi::AFTER_DRAIN) { E.fused(acc, cur, wr, wc, fr, fq, lds, wid, lane); }
#undef PG8_SA
#undef PG8_SB
#undef PG8_STAGE
#undef PG8_STAGE_A
#undef PG8_GOFF
#undef PG8_LDA
#undef PG8_LDB
#undef PG8_MMA
#undef PG8_WAIT_V
#undef PG8_WAIT_L
#undef PG8_BAR
#undef PG8_SCHED
}

#define EPI_LOOP_AI_M for (int ai = 0; ai < 2; ++ai) _Pragma("unroll") for (int m = 0; m < 4; ++m)

struct EpiF32 {
    static constexpr bool PERM = false, AFTER_DRAIN = false;
    float* C; int ldc; const float* bias; int bstride; const float* res; float alpha;
    __device__ __forceinline__ void operator()(const f32x4 (&acc)[2][2][4][2], const Unit& u, int wr, int wc, int fr, int fq) const {
        const int row0 = u.orow + wr * 64 + fr, col0 = u.ocol + wc * 32 + 4 * fq;
        f32x4 bv[2][2];
#pragma unroll
        for (int bj = 0; bj < 2; ++bj)
#pragma unroll
            for (int n = 0; n < 2; ++n) bv[bj][n] = bias ? *(const f32x4*)(bias + (size_t)u.aux * bstride + col0 + bj * HALF + n * 16) : (f32x4){0.f, 0.f, 0.f, 0.f};
#pragma unroll
        EPI_LOOP_AI_M { const size_t off = (size_t)(row0 + ai * HALF + m * 16) * ldc + col0;
#pragma unroll
            for (int bj = 0; bj < 2; ++bj)
#pragma unroll
                for (int n = 0; n < 2; ++n) { f32x4 v = acc[ai][bj][m][n] + bv[bj][n];
                    if (res) { const f32x4 rv = *(const f32x4*)(res + off + bj * HALF + n * 16); v = v + rv * alpha; }
                    *(f32x4*)(C + off + bj * HALF + n * 16) = v; }
            asm volatile("" ::: "memory"); }
    }
};
struct EpiBf16 {
    static constexpr bool PERM = true, AFTER_DRAIN = false;
    bf16_t* O; int ldc; float scale;
    __device__ __forceinline__ void operator()(const f32x4 (&acc)[2][2][4][2], const Unit& u, int wr, int wc, int fr, int fq) const {
        const int row0 = u.orow + wr * 64 + fr, col0 = u.ocol + wc * 32 + 8 * fq;
#pragma unroll
        EPI_LOOP_AI_M { bf16_t* rowp = O + (size_t)(row0 + ai * HALF + m * 16) * ldc + col0;
#pragma unroll
            for (int bj = 0; bj < 2; ++bj) { const f32x4 v0 = acc[ai][bj][m][0] * scale, v1 = acc[ai][bj][m][1] * scale;
                u32x4 w; w.x = cvt_pk_bf16(v0[0], v0[1]); w.y = cvt_pk_bf16(v0[2], v0[3]); w.z = cvt_pk_bf16(v1[0], v1[1]); w.w = cvt_pk_bf16(v1[2], v1[3]);
                *(u32x4*)(rowp + bj * HALF) = w; } }
    }
};
struct EpiBf16Bias {
    static constexpr bool PERM = true, AFTER_DRAIN = false;
    bf16_t* O; int ldc; const float* bias; int bstride;
    __device__ __forceinline__ void operator()(const f32x4 (&acc)[2][2][4][2], const Unit& u, int wr, int wc, int fr, int fq) const {
        const int row0 = u.orow + wr * 64 + fr, col0 = u.ocol + wc * 32 + 8 * fq;
        f32x4 bv[2][2];
#pragma unroll
        for (int bj = 0; bj < 2; ++bj)
#pragma unroll
            for (int n = 0; n < 2; ++n) bv[bj][n] = *(const f32x4*)(bias + (size_t)u.aux * bstride + col0 + bj * HALF + 4 * n);
#pragma unroll
        EPI_LOOP_AI_M { bf16_t* rowp = O + (size_t)(row0 + ai * HALF + m * 16) * ldc + col0;
#pragma unroll
            for (int bj = 0; bj < 2; ++bj) { const f32x4 v0 = acc[ai][bj][m][0] + bv[bj][0], v1 = acc[ai][bj][m][1] + bv[bj][1];
                u32x4 w; w.x = cvt_pk_bf16(v0[0], v0[1]); w.y = cvt_pk_bf16(v0[2], v0[3]); w.z = cvt_pk_bf16(v1[0], v1[1]); w.w = cvt_pk_bf16(v1[2], v1[3]);
                *(u32x4*)(rowp + bj * HALF) = w; } }
    }
};
struct EpiKV {
    static constexpr bool PERM = true, AFTER_DRAIN = false;
    bf16_t* KB; bf16_t* VT;
    __device__ __forceinline__ void operator()(const f32x4 (&acc)[2][2][4][2], const Unit& u, int wr, int wc, int fr, int fq) const {
        const int row0 = u.orow + wr * 64 + fr, col0 = u.ocol + wc * 32 + 8 * fq;
#pragma unroll
        EPI_LOOP_AI_M { const int row = row0 + ai * HALF + m * 16;
#pragma unroll
            for (int bj = 0; bj < 2; ++bj) { const f32x4 v0 = acc[ai][bj][m][0], v1 = acc[ai][bj][m][1]; const int col = col0 + bj * HALF;
                if (u.ocol < 2048) { u32x4 w; w.x = cvt_pk_bf16(v0[0], v0[1]); w.y = cvt_pk_bf16(v0[2], v0[3]); w.z = cvt_pk_bf16(v1[0], v1[1]); w.w = cvt_pk_bf16(v1[2], v1[3]);
                    *(u32x4*)(KB + (size_t)row * 2048 + col) = w; }
                else { const int b = row >> 8, key = row & 255, c = col - 2048, h = c >> 9, d = c & 511; bf16_t* p = VT + ((size_t)((b * 4 + h) * 512 + d)) * 256 + key;
#pragma unroll
                    for (int j = 0; j < 4; ++j) { p[(size_t)j * 256] = (bf16_t)f2bf(v0[j]); p[(size_t)(4 + j) * 256] = (bf16_t)f2bf(v1[j]); } } } }
    }
};
struct EpiDecay {
    static constexpr bool PERM = false, AFTER_DRAIN = false;
    float* DEC; const float* w0;
    __device__ __forceinline__ void operator()(const f32x4 (&acc)[2][2][4][2], const Unit& u, int wr, int wc, int fr, int fq) const {
        const int row0 = u.orow + wr * 64 + fr, col0 = u.ocol + wc * 32 + 4 * fq;
        f32x4 bv[2][2];
#pragma unroll
        for (int bj = 0; bj < 2; ++bj)
#pragma unroll
            for (int n = 0; n < 2; ++n) bv[bj][n] = *(const f32x4*)(w0 + col0 + bj * HALF + n * 16);
#pragma unroll
        EPI_LOOP_AI_M { const size_t off = (size_t)(row0 + ai * HALF + m * 16) * D + col0;
#pragma unroll
            for (int bj = 0; bj < 2; ++bj)
#pragma unroll
                for (int n = 0; n < 2; ++n) { const f32x4 x = acc[ai][bj][m][n] + bv[bj][n]; f32x4 o;
#pragma unroll
                    for (int j = 0; j < 4; ++j) o[j] = __expf(-0.6065306597126334f * sigmoidf_(x[j]));
                    *(f32x4*)(DEC + off + bj * HALF + n * 16) = o; } }
    }
};
struct EpiIclr {
    static constexpr bool PERM = true, AFTER_DRAIN = false;
    const float* a0; const float* k_k; const float* k_a; const bf16_t* KZ; const float* KNORM; bf16_t* KP; bf16_t* AN; bf16_t* BB;
    __device__ __forceinline__ void operator()(const f32x4 (&acc)[2][2][4][2], const Unit& u, int wr, int wc, int fr, int fq) const {
        const int row0 = u.orow + wr * 64 + fr, col0 = u.ocol + wc * 32 + 8 * fq;
#pragma unroll
        for (int bj = 0; bj < 2; ++bj) { const int col = col0 + bj * HALF;
            const f32x4 a00 = *(const f32x4*)(a0 + col), a01 = *(const f32x4*)(a0 + col + 4), kk0 = *(const f32x4*)(k_k + col), kk1 = *(const f32x4*)(k_k + col + 4), ka0 = *(const f32x4*)(k_a + col), ka1 = *(const f32x4*)(k_a + col + 4);
#pragma unroll
            EPI_LOOP_AI_M { const int row = row0 + ai * HALF + m * 16; const size_t off = (size_t)row * D + col;
                const u32x4 kzw = *(const u32x4*)(KZ + off); const float nr = KNORM[(size_t)row * 32 + (col >> 6)]; const float inv = 1.0f / fmaxf(nr, 1e-12f);
                const unsigned kw[4] = {kzw.x, kzw.y, kzw.z, kzw.w};
                float kp[8], an[8], bb[8];
#pragma unroll
                for (int j = 0; j < 8; ++j) { const float kz = bf2f((kw[j >> 1] >> (16 * (j & 1))) & 0xffffu);
                    const float x = (j < 4 ? acc[ai][bj][m][0][j & 3] + a00[j & 3] : acc[ai][bj][m][1][j & 3] + a01[j & 3]);
                    const float kkc = j < 4 ? kk0[j & 3] : kk1[j & 3], kac = j < 4 ? ka0[j & 3] : ka1[j & 3];
                    const float a = sigmoidf_(x); const float kk = kz * kkc * inv; kp[j] = kz * (1.0f + (a - 1.0f) * kac); bb[j] = kk * a; an[j] = -kk; }
                *(u32x4*)(KP + off) = (u32x4){cvt_pk_bf16(kp[0], kp[1]), cvt_pk_bf16(kp[2], kp[3]), cvt_pk_bf16(kp[4], kp[5]), cvt_pk_bf16(kp[6], kp[7])};
                *(u32x4*)(AN + off) = (u32x4){cvt_pk_bf16(an[0], an[1]), cvt_pk_bf16(an[2], an[3]), cvt_pk_bf16(an[4], an[5]), cvt_pk_bf16(an[6], an[7])};
                *(u32x4*)(BB + off) = (u32x4){cvt_pk_bf16(bb[0], bb[1]), cvt_pk_bf16(bb[2], bb[3]), cvt_pk_bf16(bb[4], bb[5]), cvt_pk_bf16(bb[6], bb[7])}; }
            asm volatile("" ::: "memory"); }
    }
};
struct EpiGateA {
    static constexpr bool PERM = false, AFTER_DRAIN = false;
    const bf16_t* PROJ; float* TMP;
    __device__ __forceinline__ void operator()(const f32x4 (&acc)[2][2][4][2], const Unit& u, int wr, int wc, int fr, int fq) const {
        const int row0 = u.orow + wr * 64 + fr, col0 = u.ocol + wc * 32 + 4 * fq;
#pragma unroll
        EPI_LOOP_AI_M { const int row = row0 + ai * HALF + m * 16;
#pragma unroll
            for (int bj = 0; bj < 2; ++bj)
#pragma unroll
                for (int n = 0; n < 2; ++n) { const int col = col0 + bj * HALF + n * 16; const u32x2 gv = *(const u32x2*)(PROJ + (size_t)row * PC + GATE0 + col);
                    const f32x4 a = acc[ai][bj][m][n]; f32x4 o;
                    o[0] = a[0] * sigmoidf_(bf2f(gv.x & 0xffffu)); o[1] = a[1] * sigmoidf_(bf2f(gv.x >> 16)); o[2] = a[2] * sigmoidf_(bf2f(gv.y & 0xffffu)); o[3] = a[3] * sigmoidf_(bf2f(gv.y >> 16));
                    *(f32x4*)(TMP + (size_t)row * D + col) = o; } }
    }
};
struct EpiGateB {
    static constexpr bool PERM = true, AFTER_DRAIN = false;
    const bf16_t* PROJ; const float* TMP; bf16_t* MERGED;
    __device__ __forceinline__ void operator()(const f32x4 (&acc)[2][2][4][2], const Unit& u, int wr, int wc, int fr, int fq) const {
        const int row0 = u.orow + wr * 64 + fr, col0 = u.ocol + wc * 32 + 8 * fq;
#pragma unroll
        EPI_LOOP_AI_M { const int row = row0 + ai * HALF + m * 16;
#pragma unroll
            for (int bj = 0; bj < 2; ++bj) { const int col = col0 + bj * HALF; const u32x4 gv = *(const u32x4*)(PROJ + (size_t)row * PC + GATE0 + 2048 + col);
                const f32x4 t0 = *(const f32x4*)(TMP + (size_t)row * D + col), t1 = *(const f32x4*)(TMP + (size_t)row * D + col + 4);
                const f32x4 a0 = acc[ai][bj][m][0], a1 = acc[ai][bj][m][1]; f32x4 o0, o1;
                o0[0] = t0[0] + a0[0] * sigmoidf_(bf2f(gv.x & 0xffffu)); o0[1] = t0[1] + a0[1] * sigmoidf_(bf2f(gv.x >> 16)); o0[2] = t0[2] + a0[2] * sigmoidf_(bf2f(gv.y & 0xffffu)); o0[3] = t0[3] + a0[3] * sigmoidf_(bf2f(gv.y >> 16));
                o1[0] = t1[0] + a1[0] * sigmoidf_(bf2f(gv.z & 0xffffu)); o1[1] = t1[1] + a1[1] * sigmoidf_(bf2f(gv.z >> 16)); o1[2] = t1[2] + a1[2] * sigmoidf_(bf2f(gv.w & 0xffffu)); o1[3] = t1[3] + a1[3] * sigmoidf_(bf2f(gv.w >> 16));
                u32x4 w; w.x = cvt_pk_bf16(o0[0], o0[1]); w.y = cvt_pk_bf16(o0[2], o0[3]); w.z = cvt_pk_bf16(o1[0], o1[1]); w.w = cvt_pk_bf16(o1[2], o1[3]);
                *(u32x4*)(MERGED + (size_t)row * D + col) = w; }
            asm volatile("" ::: "memory"); }
    }
};
struct EpiSwiglu {
    static constexpr bool PERM = true, AFTER_DRAIN = false;
    const float* b1; bf16_t* H;
    __device__ __forceinline__ float sw(float g, float l) const { g = fminf(g, 7.0f); l = fminf(fmaxf(l, -7.0f), 7.0f); return g * sigmoidf_(1.702f * g) * (l + 1.0f); }
    __device__ __forceinline__ void operator()(const f32x4 (&acc)[2][2][4][2], const Unit& u, int wr, int wc, int fr, int fq) const {
        const int row0 = u.orow + wr * 64 + fr, col0 = u.ocol + wc * 32 + 8 * fq;
        f32x4 bv[2][2];
#pragma unroll
        for (int bj = 0; bj < 2; ++bj)
#pragma unroll
            for (int n = 0; n < 2; ++n) bv[bj][n] = *(const f32x4*)(b1 + (size_t)u.aux * 4096 + col0 + bj * HALF + 4 * n);
#pragma unroll
        EPI_LOOP_AI_M { const int row = row0 + ai * HALF + m * 16;
#pragma unroll
            for (int bj = 0; bj < 2; ++bj) { const f32x4 v0 = acc[ai][bj][m][0] + bv[bj][0], v1 = acc[ai][bj][m][1] + bv[bj][1];
                *(unsigned*)((unsigned char*)H + (size_t)row * DFF + ((col0 + bj * HALF) >> 1)) = pk4_fp8(sw(v0[0], v0[1]), sw(v0[2], v0[3]), sw(v1[0], v1[1]), sw(v1[2], v1[3])); } }
    }
};
struct EpiSoftmax {
    static constexpr bool PERM = true, AFTER_DRAIN = true;
    bf16_t* PP;
    __device__ __forceinline__ void fused(f32x4 (&acc)[2][2][4][2], const Unit& u, int wr, int wc, int fr, int fq, PG8_LAS unsigned char* lds, int wid, int lane) const {
        PG8_LAS float* P1 = (PG8_LAS float*)lds;
        PG8_LAS float* P2 = (PG8_LAS float*)(lds + 4096);
        float mx[2][4];
#pragma unroll
        EPI_LOOP_AI_M { float v = -3.0e38f;
#pragma unroll
            for (int bj = 0; bj < 2; ++bj)
#pragma unroll
                for (int n = 0; n < 2; ++n) { const f32x4 x = acc[ai][bj][m][n]; v = fmaxf(v, fmaxf(fmaxf(x[0], x[1]), fmaxf(x[2], x[3]))); }
            v = fmaxf(v, __shfl_xor(v, 16)); v = fmaxf(v, __shfl_xor(v, 32));
            if (fq == 0) P1[(ai * HALF + wr * 64 + m * 16 + fr) * 4 + wc] = v; }
        asm volatile("s_waitcnt lgkmcnt(0)" ::: "memory"); __builtin_amdgcn_s_barrier(); asm volatile("" ::: "memory");
#pragma unroll
        EPI_LOOP_AI_M { const f32x4 t = *(const PG8_LAS f32x4*)(P1 + (ai * HALF + wr * 64 + m * 16 + fr) * 4); mx[ai][m] = fmaxf(fmaxf(t[0], t[1]), fmaxf(t[2], t[3])); }
#pragma unroll
        EPI_LOOP_AI_M { float s = 0.f;
#pragma unroll
            for (int bj = 0; bj < 2; ++bj)
#pragma unroll
                for (int n = 0; n < 2; ++n) { f32x4 x = acc[ai][bj][m][n];
#pragma unroll
                    for (int j = 0; j < 4; ++j) { x[j] = __expf(x[j] - mx[ai][m]); s += x[j]; }
                    acc[ai][bj][m][n] = x; }
            s += __shfl_xor(s, 16); s += __shfl_xor(s, 32);
            if (fq == 0) P2[(ai * HALF + wr * 64 + m * 16 + fr) * 4 + wc] = s; }
        asm volatile("s_waitcnt lgkmcnt(0)" ::: "memory"); __builtin_amdgcn_s_barrier(); asm volatile("" ::: "memory");
        const int row0 = u.orow + wr * 64 + fr, col0 = wc * 32 + 8 * fq;
#pragma unroll
        EPI_LOOP_AI_M { const f32x4 t = *(const PG8_LAS f32x4*)(P2 + (ai * HALF + wr * 64 + m * 16 + fr) * 4); const float inv = 1.0f / ((t[0] + t[1]) + (t[2] + t[3]));
            bf16_t* rowp = PP + (size_t)(row0 + ai * HALF + m * 16) * 256 + col0;
#pragma unroll
            for (int bj = 0; bj < 2; ++bj) { const f32x4 v0 = acc[ai][bj][m][0] * inv, v1 = acc[ai][bj][m][1] * inv;
                u32x4 w; w.x = cvt_pk_bf16(v0[0], v0[1]); w.y = cvt_pk_bf16(v0[2], v0[3]); w.z = cvt_pk_bf16(v1[0], v1[1]); w.w = cvt_pk_bf16(v1[2], v1[3]);
                *(u32x4*)(rowp + bj * HALF) = w; } }
        asm volatile("s_waitcnt lgkmcnt(0)" ::: "memory"); __builtin_amdgcn_s_barrier(); asm volatile("" ::: "memory");
    }
};
}

constexpr size_t MiB = 1u << 20;
constexpr size_t al256(size_t x) { return (x + 255) & ~(size_t)255; }
constexpr size_t WS_CTL = 0, CTL_ZERO_BYTES = 1 * MiB;
constexpr size_t WS_WIN = 1 * MiB;
constexpr size_t WS_WUP = WS_WIN + (size_t)PC * D * 2;
constexpr size_t WS_AUP = WS_WUP + (size_t)D * 256 * 2;
constexpr size_t WS_GUP = WS_AUP + (size_t)D * 256 * 2;
constexpr size_t WS_PA = WS_GUP + (size_t)D * 256 * 2;
constexpr size_t WS_PB = WS_PA + (size_t)D * D * 2;
constexpr size_t WS_WOUT = WS_PB + (size_t)D * 512 * 2;
constexpr size_t WS_WQ = WS_WOUT + (size_t)D * D * 2;
constexpr size_t WS_WKV = WS_WQ + (size_t)D * D * 2;
constexpr size_t WS_WO = WS_WKV + (size_t)2 * D * D * 2;
constexpr size_t WS_W1 = WS_WO + (size_t)D * D * 2;
constexpr size_t WS_W2 = WS_W1 + (size_t)NEXP * 4096 * D * 2;
constexpr size_t WS_XB = WS_W2 + (size_t)NEXP * D * DFF * 2;
constexpr size_t WS_MEMB = WS_XB + (size_t)M * D * 2;
constexpr size_t WS_ROT = WS_MEMB + (size_t)1024 * D * 2;
constexpr size_t WS_KB = WS_ROT + (size_t)2 * SEQ * 32 * 4;
constexpr size_t WS_VT = WS_KB + (size_t)1024 * D * 2;
constexpr size_t WS_YA = WS_VT + (size_t)1024 * D * 2;
constexpr size_t WS_YB = WS_YA + (size_t)M * D * 2;
constexpr size_t WS_TMP = WS_YB + (size_t)M * 512 * 2;
constexpr size_t WS_MERGED = WS_TMP + (size_t)M * D * 4;
constexpr size_t WS_E = WS_MERGED + (size_t)M * D * 2;
constexpr size_t WS_PROJ = WS_E;
constexpr size_t WS_RZ = WS_PROJ + (size_t)M * PC * 2;
constexpr size_t WS_KZ = WS_RZ + (size_t)M * D * 4;
constexpr size_t WS_VZ = WS_KZ + (size_t)M * D * 4;
constexpr size_t WS_DEC = WS_VZ + (size_t)M * D * 4;
constexpr size_t WS_KP = WS_DEC + (size_t)M * D * 4;
constexpr size_t WS_AN = WS_KP + (size_t)M * D * 4;
constexpr size_t WS_BB = WS_AN + (size_t)M * D * 4;
constexpr size_t WS_GG = WS_BB + (size_t)M * D * 4;
constexpr size_t WS_YS = WS_GG + (size_t)M * D * 4;
constexpr size_t WS_VR = WS_YS + 4 * MiB;
constexpr size_t WS_AO = WS_YS + (size_t)M * D * 4;
constexpr size_t WS_LSE = WS_AO + (size_t)3 * M * 512 * 4;
constexpr size_t WS_QR = WS_LSE + (size_t)3 * M * 8 * 4;
constexpr size_t WS_KR = WS_QR + (size_t)M * 1536 * 2;
constexpr size_t WS_LIN = WS_KR + (size_t)M * 1536 * 2;
constexpr size_t WS_KNORM = WS_LIN + (size_t)M * 768 * 2;
constexpr size_t WS_F = WS_KNORM + (size_t)M * 32 * 4;
constexpr size_t WS_E_END = WS_F + (size_t)128 * 128 * 96 * 96 * 2;
constexpr size_t WS_T1 = WS_E;
constexpr size_t WS_X1 = WS_T1 + (size_t)M * D * 4;
constexpr size_t WS_X1B = WS_X1 + (size_t)M * D * 4;
constexpr size_t WS_Q = WS_X1B + (size_t)M * D * 2;
constexpr size_t WS_PP = WS_Q + (size_t)M * D * 2;
constexpr size_t WS_OC = WS_PP + (size_t)16 * SEQ * 256 * 2;
constexpr size_t WS_T2 = WS_OC + (size_t)M * D * 2;
constexpr size_t WS_X2 = WS_T2 + (size_t)M * D * 4;
constexpr size_t WS_X2B = WS_X2 + (size_t)M * D * 4;
constexpr size_t WS_LIST = WS_X2B + (size_t)M * D * 2;
constexpr size_t WS_ROWI = WS_LIST + (size_t)NEXP * CAP * 4;
constexpr size_t WS_TOPW = WS_ROWI + (size_t)M * 4 * 4;
constexpr size_t WS_H = WS_TOPW + (size_t)M * 4 * 4;
constexpr size_t WS_Y = WS_H + (size_t)HROWS * DFF * 2;
constexpr size_t WS_L_END = WS_Y + (size_t)HROWS * D * 4;
constexpr size_t WS_END = (WS_E_END > WS_L_END ? WS_E_END : WS_L_END);
static_assert(WS_END <= (size_t)4090 * MiB, "workspace map exceeds 4 x largest input");
constexpr int CW_TMO = 0, CW_CNT = 64  , CW_Q = 128  , CW_BAR = 4096;

constexpr int RING_BYTES = 131072, MISC_OFF = RING_BYTES, LDS_BYTES = 147456;

#define XB_TMO      128
#define XB_XCNT(j)  (256  + 64 * (j))
#define XB_XSUB(j)  (1280 + 64 * (j))
#define XB_XGEN(j)  (2304 + 64 * (j))
#define XB_TOP      3328
#define XB_TOPGEN   3392
#define XCD_BAR_WORDS 3456
#define XB_SPIN_CAP (1u << 18)
__device__ __forceinline__ unsigned xb_ld(unsigned* p)              { return __hip_atomic_load(p, __ATOMIC_RELAXED, __HIP_MEMORY_SCOPE_AGENT); }
__device__ __forceinline__ unsigned xb_add(unsigned* p, unsigned v) { return __hip_atomic_fetch_add(p, v, __ATOMIC_RELAXED, __HIP_MEMORY_SCOPE_AGENT); }
__device__ __forceinline__ unsigned xb_xcc_id() { return (unsigned)__builtin_amdgcn_s_getreg((3 << 11) | 20) & 0xFu; }
#define XB_SPIN(cond, bar) do { unsigned _sp = 0; while (cond) { __builtin_amdgcn_s_sleep(1); \
    if ((++_sp & 255u) == 0u) { if (xb_ld(&(bar)[XB_TMO])) break; if (_sp > XB_SPIN_CAP) { atomicAdd(&(bar)[XB_TMO], 1u); break; } } } } while (0)
struct XcdBarrier { unsigned* bar; unsigned x; volatile LAS unsigned* st; };
__device__ __forceinline__ XcdBarrier xcd_barrier_post(unsigned* bar, volatile LAS unsigned* st) {
    XcdBarrier b; b.bar = bar; b.x = xb_xcc_id(); b.st = st;
    if (threadIdx.x == 0) (void)xb_add(&bar[XB_XCNT(b.x)], 1u);
    return b;
}
__device__ __forceinline__ void xcd_barrier_complete(unsigned* bar, unsigned x, unsigned& nloc, unsigned& nx) {
    const unsigned G = gridDim.x * gridDim.y * gridDim.z;
    unsigned sum, cnt, mine, sp = 0u;
    for (;;) {
        sum = 0u; cnt = 0u; mine = 0u;
#pragma unroll
        for (unsigned j = 0; j < 16; ++j) { const unsigned c = xb_ld(&bar[XB_XCNT(j)]); sum += c; cnt += (c > 0u) ? 1u : 0u; mine = (j == x) ? c : mine; }
        if (sum == G) break;
        __builtin_amdgcn_s_sleep(1);
        if ((++sp & 255u) == 0u) { if (xb_ld(&bar[XB_TMO])) break; if (sp > XB_SPIN_CAP) { atomicAdd(&bar[XB_TMO], 1u); break; } }
    }
    nloc = mine > 0u ? mine : 1u; nx = cnt > 0u ? cnt : 1u;
}
__device__ __forceinline__ void xcd_barrier(const XcdBarrier& b) {
    asm volatile("s_waitcnt vmcnt(0)" ::: "memory");
    __syncthreads();
    if (threadIdx.x == 0) {
        unsigned* bar = b.bar;
        __builtin_amdgcn_s_waitcnt(0);
        unsigned nloc = b.st[0], nx = b.st[1];
        if (nloc == 0u) { xcd_barrier_complete(bar, b.x, nloc, nx); b.st[0] = nloc; b.st[1] = nx; }
        const unsigned old = xb_add(&bar[XB_XSUB(b.x)], 1u);
        const unsigned gen = old / nloc;
        if (old + 1u == (gen + 1u) * nloc) {
            __builtin_amdgcn_fence(__ATOMIC_RELEASE, "agent");
            asm volatile("s_waitcnt vmcnt(0)" ::: "memory");
            const unsigned og = xb_add(&bar[XB_TOP], 1u);
            const unsigned tg = og / nx;
            if (og + 1u == (tg + 1u) * nx) xb_add(&bar[XB_TOPGEN], 1u);
            else XB_SPIN(xb_ld(&bar[XB_TOPGEN]) == tg, bar);
            __builtin_amdgcn_fence(__ATOMIC_ACQUIRE, "agent");
            xb_add(&bar[XB_XGEN(b.x)], 1u);
            asm volatile("s_waitcnt vmcnt(0)" ::: "memory");
        } else {
            XB_SPIN(xb_ld(&bar[XB_XGEN(b.x)]) == gen, bar);
            __builtin_amdgcn_fence(__ATOMIC_ACQUIRE, "agent");
            asm volatile("s_waitcnt vmcnt(0)" ::: "memory");
        }
    }
    __syncthreads();
}

struct Params {
    const float* in[32];
    float* out; unsigned char* ws;
    int ph_lo, ph_hi, li, pad;
};
enum { I_X = 0, I_MEM, I_WIN, I_MIX, I_W0, I_WUP, I_A0, I_AUP, I_GUP, I_KK, I_KA, I_RK, I_LNXG, I_LNXB, I_PA, I_PB, I_WOUT, I_LN1G, I_LN1B, I_WQ, I_WKV, I_WO, I_LN2G, I_LN2B,
       I_RW, I_RB, I_W1, I_B1, I_W2, I_B2, I_LN3G, I_LN3B };

struct ScoreOrder {
    static constexpr bool GATHER = false;
    const char* Q; const char* KB; int G, c;
    __device__ bool next(int i, pg8::Unit& u) const {
        const int L = i * G + c; if (L >= 256) return false;
        const int bh = L >> 4, pm = L & 15, b = bh >> 2, h = bh & 3;
        u.A = Q + ((size_t)(b * SEQ + 256 * pm) * D + h * 512) * 2; u.B = KB + ((size_t)(b * 256) * D + h * 512) * 2;
        u.orow = bh * SEQ + 256 * pm; u.ocol = 0; u.aux = 0; u.aux2 = 0; u.valid = 256; return true;
    }
    __device__ __forceinline__ const int* rows(const pg8::Unit&) const { return nullptr; }
};
struct PvOrder {
    static constexpr bool GATHER = false;
    const char* PP; const char* VT; int G, c;
    __device__ bool next(int i, pg8::Unit& u) const {
        const int L = i * G + c; if (L >= 512) return false;
        const int bh = L >> 5, pm = (L >> 1) & 15, pn = L & 1, b = bh >> 2, h = bh & 3;
        u.A = PP + ((size_t)(bh * SEQ + 256 * pm) * 256) * 2; u.B = VT + ((size_t)(bh * 512 + 256 * pn) * 256) * 2;
        u.orow = b * SEQ + 256 * pm; u.ocol = h * 512 + 256 * pn; u.aux = 0; u.aux2 = 0; u.valid = 256; return true;
    }
    __device__ __forceinline__ const int* rows(const pg8::Unit&) const { return nullptr; }
};
template <bool GATHER_, int NT  > struct MoeOrder {
    static constexpr bool GATHER = GATHER_;
    const LAS int* tab; const char* A; const char* W; const int* list; size_t wexp  ; int ldb; int G, c;
    __device__ bool next(int i, pg8::Unit& u) const {
        constexpr int RPR = 256 / NT;
        const int rt = i * RPR + (c % RPR), pn = c / RPR, T = __builtin_amdgcn_readfirstlane(tab[64]);
        if (c >= 256 || rt >= T) return false;
        int e = 0;
        for (int j = 1; j < NEXP; ++j) e = (rt >= __builtin_amdgcn_readfirstlane(tab[32 + j])) ? j : e;
        const int lt = rt - __builtin_amdgcn_readfirstlane(tab[32 + e]), cnt = __builtin_amdgcn_readfirstlane(tab[e]);
        u.aux = e; u.aux2 = lt; u.valid = min(256, cnt - 256 * lt); u.orow = 256 * rt; u.ocol = 256 * pn;
        u.B = W + (size_t)e * wexp + (size_t)(256 * pn) * ldb;
        u.A = GATHER_ ? A : A + (size_t)(256 * rt) * DFF;
        return true;
    }
    __device__ __forceinline__ const int* rows(const pg8::Unit& u) const { return list + (size_t)u.aux * CAP + 256 * u.aux2; }
};

struct Ctx { int tid, lane, wave, vcu, G; LAS unsigned char* lds; unsigned char* ws; };

__device__ __forceinline__ void cv_issue(const float* W, int ldw, int Ksrc, int sc0, int k0, int lane, float (&cv)[32]) {
    const int kb = k0 + 32 * (lane >> 5); const bool ok = sc0 >= 0 && kb < Ksrc;
    const float* src = W + (ok ? (size_t)kb * ldw + sc0 + (lane & 31) : (size_t)0);
#pragma unroll
    for (int i = 0; i < 32; ++i) { const float v = src[(size_t)i * ldw]; cv[i] = ok ? v : 0.f; }
}
__device__ __forceinline__ void cv_store16(const float (&cv)[32], bf16_t* WT, int ldt, int n0, int k0, int lane) {
    u32x4* dst = (u32x4*)(WT + (size_t)(n0 + (lane & 31)) * ldt + k0 + 32 * (lane >> 5));
#pragma unroll
    for (int j = 0; j < 4; ++j) dst[j] = (u32x4){pk2(cv[8 * j], cv[8 * j + 1]), pk2(cv[8 * j + 2], cv[8 * j + 3]), pk2(cv[8 * j + 4], cv[8 * j + 5]), pk2(cv[8 * j + 6], cv[8 * j + 7])};
}
__device__ __forceinline__ void cv_store8(const float (&cv)[32], unsigned char* WT8, int ldt, int n0, int k0, int lane) {
    u32x4* dst = (u32x4*)(WT8 + (size_t)(n0 + (lane & 31)) * ldt + k0 + 32 * (lane >> 5));
#pragma unroll
    for (int j = 0; j < 2; ++j) dst[j] = (u32x4){pk4_fp8(cv[16 * j] * 64.f, cv[16 * j + 1] * 64.f, cv[16 * j + 2] * 64.f, cv[16 * j + 3] * 64.f), pk4_fp8(cv[16 * j + 4] * 64.f, cv[16 * j + 5] * 64.f, cv[16 * j + 6] * 64.f, cv[16 * j + 7] * 64.f),
        pk4_fp8(cv[16 * j + 8] * 64.f, cv[16 * j + 9] * 64.f, cv[16 * j + 10] * 64.f, cv[16 * j + 11] * 64.f), pk4_fp8(cv[16 * j + 12] * 64.f, cv[16 * j + 13] * 64.f, cv[16 * j + 14] * 64.f, cv[16 * j + 15] * 64.f)};
}
struct CvJob { const float* W; bf16_t* WT; int ldw, Ksrc, sc0, ldt, n0, k0; };
__device__ __forceinline__ CvJob p0_job(const Params& p, unsigned char* ws, int it) {
    constexpr int I_WINJ = 32 * 480, I_LORA = 4 * 64, I_SQ = 32 * 64, I_PBJ = 8 * 64, I_KVJ = 32 * 128;
    CvJob j; int r = it;
#define P0_PLAIN(SRC, DST, N_, KS_, KD_) { const int nblk = (N_) / 32, kb = r / nblk, nb = r % nblk; j.W = p.in[SRC]; j.WT = (bf16_t*)(ws + (DST)); j.ldw = (N_); j.Ksrc = (KS_); j.sc0 = 32 * nb; j.ldt = (KD_); j.n0 = 32 * nb; j.k0 = 64 * kb; return j; }
    if (r < I_WINJ) { const int kb = r / 480, nb = r % 480; j.W = p.in[I_WIN]; j.WT = (bf16_t*)(ws + WS_WIN); j.ldw = 15296; j.Ksrc = D; j.sc0 = nb < 206 ? 32 * nb : (nb < 208 ? -1 : 32 * nb - 64); j.ldt = D; j.n0 = 32 * nb; j.k0 = 64 * kb; return j; } r -= I_WINJ;
    if (r < I_LORA) P0_PLAIN(I_WUP, WS_WUP, D, 96, 256) r -= I_LORA;
    if (r < I_LORA) P0_PLAIN(I_AUP, WS_AUP, D, 96, 256) r -= I_LORA;
    if (r < I_LORA) P0_PLAIN(I_GUP, WS_GUP, D, 256, 256) r -= I_LORA;
    if (r < I_SQ) P0_PLAIN(I_PA, WS_PA, D, D, D) r -= I_SQ;
    if (r < I_PBJ) P0_PLAIN(I_PB, WS_PB, D, 512, 512) r -= I_PBJ;
    if (r < I_SQ) P0_PLAIN(I_WOUT, WS_WOUT, D, D, D) r -= I_SQ;
    if (r < I_SQ) P0_PLAIN(I_WQ, WS_WQ, D, D, D) r -= I_SQ;
    if (r < I_KVJ) P0_PLAIN(I_WKV, WS_WKV, 2 * D, D, D) r -= I_KVJ;
    P0_PLAIN(I_WO, WS_WO, D, D, D)
#undef P0_PLAIN
}
__device__ __forceinline__ void p0_prologue(const Params& p, const Ctx& c) {
    const int gw = c.vcu * 8 + c.wave, NGW = c.G * 8;
    unsigned char* ws = c.ws;
    constexpr int NITEMS = 32 * 480 + 3 * (4 * 64) + 4 * (32 * 64) + 8 * 64 + 32 * 128;
    { float ca[32], cb[32]; CvJob ja, jb; int it = gw;
      if (it < NITEMS) { ja = p0_job(p, ws, it); cv_issue(ja.W, ja.ldw, ja.Ksrc, ja.sc0, ja.k0, c.lane, ca); }
      for (; it < NITEMS; it += 2 * NGW) {
          if (it + NGW < NITEMS) { jb = p0_job(p, ws, it + NGW); cv_issue(jb.W, jb.ldw, jb.Ksrc, jb.sc0, jb.k0, c.lane, cb); }
          cv_store16(ca, ja.WT, ja.ldt, ja.n0, ja.k0, c.lane);
          if (it + 2 * NGW < NITEMS) { ja = p0_job(p, ws, it + 2 * NGW); cv_issue(ja.W, ja.ldw, ja.Ksrc, ja.sc0, ja.k0, c.lane, ca); }
          if (it + NGW < NITEMS) cv_store16(cb, jb.WT, jb.ldt, jb.n0, jb.k0, c.lane);
      } }
    const size_t gt = (size_t)c.vcu * 512 + c.tid, NT = (size_t)c.G * 512;
    for (size_t i = gt; i < (size_t)M * D / 8; i += NT) { const f32x4 a = ((const f32x4*)p.in[I_X])[2 * i], b = ((const f32x4*)p.in[I_X])[2 * i + 1];
        u32x4 o; o.x = pk2(a[0], a[1]); o.y = pk2(a[2], a[3]); o.z = pk2(b[0], b[1]); o.w = pk2(b[2], b[3]); ((u32x4*)(ws + WS_XB))[i] = o; }
    for (size_t i = gt; i < (size_t)1024 * D / 8; i += NT) { const f32x4 a = ((const f32x4*)p.in[I_MEM])[2 * i], b = ((const f32x4*)p.in[I_MEM])[2 * i + 1];
        u32x4 o; o.x = pk2(a[0], a[1]); o.y = pk2(a[2], a[3]); o.z = pk2(b[0], b[1]); o.w = pk2(b[2], b[3]); ((u32x4*)(ws + WS_MEMB))[i] = o; }
    float* rc = (float*)(ws + WS_ROT); float* rs = rc + SEQ * 32;
    for (size_t i = gt; i < (size_t)SEQ * 32; i += NT) { const int pos = (int)(i >> 5), j = (int)(i & 31);
        const double inv = exp(-(double)j * (9.210340371976184 / 32.0)); const double ang = (double)pos * inv; rc[i] = (float)cos(ang); rs[i] = (float)sin(ang); }
}

constexpr int MOE_W1E = 32 * 128, MOE_W2E = 32 * 64, MOE_CONV_GROUPS = (NEXP * MOE_W2E) / 8;
__device__ __forceinline__ void conv_group(const Params& p, const Ctx& c, int gi) {
    unsigned char* ws = c.ws;
    const int r = gi * 8 + c.wave;
    const int e = r / MOE_W2E, it = r % MOE_W2E, kb = it >> 6, nb = it & 63;
    float cv[32]; cv_issue(p.in[I_W2] + (size_t)e * DFF * D, D, DFF, 32 * nb, 64 * kb, c.lane, cv);
    cv_store8(cv, ws + WS_W2 + (size_t)e * D * DFF, DFF, 32 * nb, 64 * kb, c.lane);
}

#define DPP_ADD(x, ctrl) ((x) + __builtin_bit_cast(float, __builtin_amdgcn_update_dpp(0, __builtin_bit_cast(int, (x)), (ctrl), 0xF, 0xF, true)))
struct P2Tok { u32x4 cv0, pv0, cv1, pv1, ra, rb, vv; f32x4 c0, c1, s0, s1; };
__device__ __forceinline__ void p2_prep(const Params& p, const Ctx& c) {
    unsigned char* ws = c.ws;
    const bf16_t* PROJ = (const bf16_t*)(ws + WS_PROJ);
    const float* mix = p.in[I_MIX]; const float* k_k = p.in[I_KK];
    bf16_t* RZ = (bf16_t*)(ws + WS_RZ); bf16_t* KZ = (bf16_t*)(ws + WS_KZ); bf16_t* VZ = (bf16_t*)(ws + WS_VZ);
    bf16_t* LIN = (bf16_t*)(ws + WS_LIN); float* KNORM = (float*)(ws + WS_KNORM);
    bf16_t* QR = (bf16_t*)(ws + WS_QR); bf16_t* KR = (bf16_t*)(ws + WS_KR); bf16_t* VR = (bf16_t*)(ws + WS_VR);
    const float* rc = (const float*)(ws + WS_ROT); const float* rs = rc + SEQ * 32;
    int tid_ = c.tid; asm volatile("" : "+v"(tid_));
    const int tid = tid_;
    const int ch0 = tid, ch1 = tid + 512; const bool has1 = ch1 < 824;
    const f32x4 m00 = *(const f32x4*)(mix + 8 * ch0), m01 = *(const f32x4*)(mix + 8 * ch0 + 4);
    f32x4 m10 = (f32x4){0.f, 0.f, 0.f, 0.f}, m11 = m10; if (has1) { m10 = *(const f32x4*)(mix + 8 * ch1); m11 = *(const f32x4*)(mix + 8 * ch1 + 4); }
    f32x4 kk0 = (f32x4){0.f, 0.f, 0.f, 0.f}, kk1 = kk0; if (tid >= 256) { kk0 = *(const f32x4*)(k_k + 8 * (tid - 256)); kk1 = *(const f32x4*)(k_k + 8 * (tid - 256) + 4); }
    const bool rot = tid >= 64 && tid < 256, vcp = tid >= 256 && tid < 448;
    const int rw = tid - 64, which = rw / 96, rhh = (rw % 96) >> 2, re0 = (rw & 3) * 8;
    const int vhh = (tid - 256) >> 3, ve0 = ((tid - 256) & 7) * 8;
#define P2_LOAD(T, t_) do { const int pos_ = (t_) & (SEQ - 1); const bf16_t* cur_ = PROJ + (size_t)(t_) * PC; const u32x4 z4_ = (u32x4){0u, 0u, 0u, 0u}; \
        T.cv0 = *(const u32x4*)(cur_ + 8 * ch0); T.pv0 = pos_ > 0 ? *(const u32x4*)(cur_ - PC + 8 * ch0) : z4_; \
        if (has1) { T.cv1 = *(const u32x4*)(cur_ + 8 * ch1); T.pv1 = pos_ > 0 ? *(const u32x4*)(cur_ - PC + 8 * ch1) : z4_; } \
        if (rot) { const bf16_t* src_ = cur_ + ATT0 + which * 1536 + rhh * 64 + re0; T.ra = *(const u32x4*)src_; T.rb = *(const u32x4*)(src_ + 32); \
            T.c0 = *(const f32x4*)(rc + pos_ * 32 + re0); T.c1 = *(const f32x4*)(rc + pos_ * 32 + re0 + 4); T.s0 = *(const f32x4*)(rs + pos_ * 32 + re0); T.s1 = *(const f32x4*)(rs + pos_ * 32 + re0 + 4); } \
        if (vcp) T.vv = *(const u32x4*)(cur_ + ATT0 + 2 * 1536 + vhh * 64 + ve0); } while (0)
#define P2_SHIFT(z, cv, pv, ma, mb) do { const unsigned cw[4] = {cv.x, cv.y, cv.z, cv.w}, pw[4] = {pv.x, pv.y, pv.z, pv.w}; const float mm[8] = {ma[0], ma[1], ma[2], ma[3], mb[0], mb[1], mb[2], mb[3]}; \
        _Pragma("unroll") for (int j = 0; j < 4; ++j) { const float c0_ = bf2f(cw[j] & 0xffffu), c1_ = bf2f(cw[j] >> 16), q0_ = bf2f(pw[j] & 0xffffu), q1_ = bf2f(pw[j] >> 16); \
            z[2 * j] = c0_ + (q0_ - c0_) * mm[2 * j]; z[2 * j + 1] = c1_ + (q1_ - c1_) * mm[2 * j + 1]; } } while (0)
#define P2_PROC(T, t_) do { const int t = (t_), pos = t & (SEQ - 1); \
        { float z[8]; P2_SHIFT(z, T.cv0, T.pv0, m00, m01);            \
          bf16_t* dst = (tid < 256 ? RZ : KZ) + (size_t)t * D + 8 * (tid & 255); \
          { u32x4 w8; w8.x = pk2(z[0], z[1]); w8.y = pk2(z[2], z[3]); w8.z = pk2(z[4], z[5]); w8.w = pk2(z[6], z[7]); *(u32x4*)dst = w8; } \
          if (tid >= 256) { float sq = 0.f; _Pragma("unroll") for (int j = 0; j < 4; ++j) { const float a_ = z[j] * kk0[j], b_ = z[4 + j] * kk1[j]; sq += a_ * a_ + b_ * b_; } \
              sq = DPP_ADD(sq, 0xB1); sq = DPP_ADD(sq, 0x4E); sq = DPP_ADD(sq, 0x141);                   \
              if ((tid & 7) == 0) KNORM[(size_t)t * 32 + ((tid - 256) >> 3)] = sqrtf(sq); } } \
        if (has1) { float z[8]; P2_SHIFT(z, T.cv1, T.pv1, m10, m11);    \
          if (ch1 < 768) { u32x4 w8; w8.x = pk2(z[0], z[1]); w8.y = pk2(z[2], z[3]); w8.z = pk2(z[4], z[5]); w8.w = pk2(z[6], z[7]); *(u32x4*)(VZ + (size_t)t * D + 8 * (ch1 - 512)) = w8; } \
          else { float o[8]; int dcol; \
              if (ch1 < 780) { dcol = 8 * (ch1 - 768); _Pragma("unroll") for (int j = 0; j < 8; ++j) o[j] = tanhf(z[j]); } \
              else if (ch1 < 792) { dcol = 256 + 8 * (ch1 - 780); _Pragma("unroll") for (int j = 0; j < 8; ++j) o[j] = z[j]; } \
              else { dcol = 512 + 8 * (ch1 - 792); _Pragma("unroll") for (int j = 0; j < 8; ++j) o[j] = sigmoidf_(z[j]); } \
              u32x4 w; w.x = pk2(o[0], o[1]); w.y = pk2(o[2], o[3]); w.z = pk2(o[4], o[5]); w.w = pk2(o[6], o[7]); *(u32x4*)(LIN + (size_t)t * 768 + dcol) = w; } } \
        if (tid >= 448 && tid < 488) { const int q_ = tid - 448; const int dcol = (q_ < 20) ? 96 + 8 * q_ : 352 + 8 * (q_ - 20); *(u32x4*)(LIN + (size_t)t * 768 + dcol) = (u32x4){0u, 0u, 0u, 0u}; } \
        if (rot) { const unsigned aw[4] = {T.ra.x, T.ra.y, T.ra.z, T.ra.w}, bw[4] = {T.rb.x, T.rb.y, T.rb.z, T.rb.w}; float o1[8], o2[8]; \
            _Pragma("unroll") for (int j = 0; j < 8; ++j) { const float t1 = bf2f((aw[j >> 1] >> (16 * (j & 1))) & 0xffffu), t2 = bf2f((bw[j >> 1] >> (16 * (j & 1))) & 0xffffu); \
                const float cs = j < 4 ? T.c0[j & 3] : T.c1[j & 3], sn = j < 4 ? T.s0[j & 3] : T.s1[j & 3]; o1[j] = t1 * cs - t2 * sn; o2[j] = t2 * cs + t1 * sn; } \
            const int dl_ = rhh < 8 ? 1 : (rhh < 16 ? 4 : 16); const int prm = (pos % dl_) * (SEQ / dl_) + pos / dl_; \
            bf16_t* dst = (which ? KR : QR) + ((size_t)((t >> 12) * 24 + rhh) * SEQ + prm) * 64 + re0; \
            u32x4 w1; w1.x = pk2(o1[0], o1[1]); w1.y = pk2(o1[2], o1[3]); w1.z = pk2(o1[4], o1[5]); w1.w = pk2(o1[6], o1[7]); \
            u32x4 w2; w2.x = pk2(o2[0], o2[1]); w2.y = pk2(o2[2], o2[3]); w2.z = pk2(o2[4], o2[5]); w2.w = pk2(o2[6], o2[7]); \
            *(u32x4*)dst = w1; *(u32x4*)(dst + 32) = w2; } \
        if (vcp) { const int dl_ = vhh < 8 ? 1 : (vhh < 16 ? 4 : 16); const int prm = (pos % dl_) * (SEQ / dl_) + pos / dl_; \
            *(u32x4*)(VR + ((size_t)((t >> 12) * 24 + vhh) * SEQ + prm) * 64 + ve0) = T.vv; } } while (0)
    P2Tok ta, tb;
    int tq = c.vcu;
    if (tq < M) P2_LOAD(ta, tq);
    for (; tq < M; tq += 2 * c.G) {
        if (tq + c.G < M) P2_LOAD(tb, tq + c.G);
        P2_PROC(ta, tq);
        if (tq + 2 * c.G < M) P2_LOAD(ta, tq + 2 * c.G);
        if (tq + c.G < M) P2_PROC(tb, tq + c.G);
    }
#undef P2_LOAD
#undef P2_SHIFT
#undef P2_PROC
}

__device__ __forceinline__ float wave_sum_dpp(float x) {
    x = DPP_ADD(x, 0xB1); x = DPP_ADD(x, 0x4E); x = DPP_ADD(x, 0x141); x = DPP_ADD(x, 0x140);
    const int xi = __builtin_bit_cast(int, x);
    return (__builtin_bit_cast(float, __builtin_amdgcn_readlane(xi, 0)) + __builtin_bit_cast(float, __builtin_amdgcn_readlane(xi, 16))) +
           (__builtin_bit_cast(float, __builtin_amdgcn_readlane(xi, 32)) + __builtin_bit_cast(float, __builtin_amdgcn_readlane(xi, 48)));
}
__device__ __forceinline__ f32x4 tile_mm(const LAS bf16_t* A, int pa, const LAS bf16_t* Bt, int pb, int ks, int fr, int fq, f32x4 acc) {
    for (int k = 0; k < ks; ++k) { const bf16x8 a = *(const LAS bf16x8*)(A + fr * pa + 32 * k + 8 * fq), b = *(const LAS bf16x8*)(Bt + fr * pb + 32 * k + 8 * fq);
        acc = __builtin_amdgcn_mfma_f32_16x16x32_bf16(a, b, acc, 0, 0, 0); }
    return acc;
}
__device__ __forceinline__ u32x2 pack4(f32x4 v) { u32x2 w; w.x = pk2(v[0], v[1]); w.y = pk2(v[2], v[3]); return w; }
constexpr int SC_C = 32, SC_NCH = SEQ / SC_C, SC_F = 96;
constexpr int PL_X1 = 0, PL_X2 = 9216, PL_AL = 18432, PL_HT = 26112, PL_ET = 33792, PL_LBT = 53760, PL_TT = 58368, PL_XB = 60928, PL_GI = PL_X1, PL_TF = PL_X2, PL_END = 62016, PL_GRP = 65536;
#define LBAR() do { asm volatile("s_waitcnt lgkmcnt(0)" ::: "memory"); __builtin_amdgcn_s_barrier(); asm volatile("" ::: "memory"); } while (0)
__device__ __forceinline__ void p4_pre(const Params& p, const Ctx& c) {
    unsigned char* ws = c.ws;
    const bf16_t* RZ = (const bf16_t*)(ws + WS_RZ); const float* DEC = (const float*)(ws + WS_DEC); const bf16_t* KP = (const bf16_t*)(ws + WS_KP);
    const bf16_t* AN = (const bf16_t*)(ws + WS_AN); const bf16_t* BB = (const bf16_t*)(ws + WS_BB);
    bf16_t* FG = (bf16_t*)(ws + WS_F); float* BON = (float*)(ws + WS_YS);
    const float* rkp = p.in[I_RK];
    int tid_ = c.tid; asm volatile("" : "+v"(tid_));
    const int tid = tid_, lane = tid & 63, w = __builtin_amdgcn_readfirstlane(tid >> 6), fr = lane & 15, fq = lane >> 4;
    const int grp = w >> 2, tw = w & 3, gtid = tid & 255;
    LAS unsigned char* gl = c.lds + grp * PL_GRP;
    LAS bf16_t* X1 = (LAS bf16_t*)(gl + PL_X1); LAS bf16_t* X2 = (LAS bf16_t*)(gl + PL_X2); LAS bf16_t* AL = (LAS bf16_t*)(gl + PL_AL); LAS bf16_t* HT = (LAS bf16_t*)(gl + PL_HT);
    LAS bf16_t* ET = (LAS bf16_t*)(gl + PL_ET); LAS float* LBT = (LAS float*)(gl + PL_LBT); LAS bf16_t* TT = (LAS bf16_t*)(gl + PL_TT); LAS bf16_t* GI = (LAS bf16_t*)(gl + PL_GI);
    LAS float* TF = (LAS float*)(gl + PL_TF);
    LAS float* XB = (LAS float*)(gl + PL_XB);
    const int npair = (128 * SC_NCH) / (2 * c.G);
    float dcy[32]; unsigned short ir[8], ik[8], ia[8], ib[8];
#define PRE_LOAD(PAIR) do { const int task_ = c.vcu + (2 * (PAIR) + grp) * c.G; const int bh_ = task_ >> 7, ch_ = task_ & (SC_NCH - 1); \
        const size_t o_ = ((size_t)(bh_ >> 5) * SEQ + (size_t)ch_ * SC_C) * D + (bh_ & 31) * 64 + lane; \
        _Pragma("unroll") for (int s_ = 0; s_ < 32; ++s_) dcy[s_] = DEC[o_ + (size_t)s_ * D]; \
        _Pragma("unroll") for (int q_ = 0; q_ < 8; ++q_) { const size_t oo_ = o_ + (size_t)(8 * tw + q_) * D; ir[q_] = RZ[oo_]; ik[q_] = KP[oo_]; ia[q_] = AN[oo_]; ib[q_] = BB[oo_]; } } while (0)
    const bool bgconv = (c.G == 256);
    if (npair > 0) PRE_LOAD(0);
    for (int pr = 0; pr < npair; ++pr) {
        const int task = c.vcu + (2 * pr + grp) * c.G, bh = task >> 7, chn = task & (SC_NCH - 1);
        const float rkv = rkp[(bh & 31) * 64 + lane];
        float* bon = BON + ((size_t)(bh >> 5) * SEQ + (size_t)chn * SC_C) * 32 + (bh & 31);
        float p0 = 1.f, p1 = 1.f, p2 = 1.f, p3 = 1.f, dsel[8];
#pragma unroll
        for (int s = 0; s < 8; ++s) { p0 *= dcy[s]; p1 *= dcy[8 + s]; p2 *= dcy[16 + s]; p3 *= dcy[24 + s];
            dsel[s] = tw == 0 ? dcy[s] : (tw == 1 ? dcy[8 + s] : (tw == 2 ? dcy[16 + s] : dcy[24 + s])); }
        const float gC = (p0 * p1) * (p2 * p3);
        float g = tw == 0 ? 1.f : (tw == 1 ? p0 : (tw == 2 ? p0 * p1 : (p0 * p1) * p2));
        LBAR();
#pragma unroll
        for (int hq = 0; hq < 2; ++hq) { f32x4 ah4, bg4, kg4;
#pragma unroll
            for (int qq = 0; qq < 4; ++qq) { const int qn = 4 * hq + qq, s = 8 * tw + qn;
                const float gp = g; g *= dsel[qn];
                const float rr = bf2f(ir[qn]), kk = bf2f(ik[qn]), aa = bf2f(ia[qn]), bb = bf2f(ib[qn]); const float ig = 1.0f / g;
                const float ah = aa * gp, bt = bb * ig, kt = kk * ig, rh = rr * g;
                X1[s * 72 + lane] = (bf16_t)f2bf(bt); X1[(32 + s) * 72 + lane] = (bf16_t)f2bf(kt); X2[s * 72 + lane] = (bf16_t)f2bf(ah); X2[(32 + s) * 72 + lane] = (bf16_t)f2bf(rh);
                ET[s * 104 + lane] = (bf16_t)f2bf(rh); ah4[qq] = ah; bg4[qq] = bt * gC; kg4[qq] = kt * gC;
                const float bsum = wave_sum_dpp(rr * kk * rkv); if (lane == 0) bon[(size_t)s * 32] = bsum; }
            *(LAS u32x2*)(AL + lane * 40 + 8 * tw + 4 * hq) = pack4(ah4); *(LAS u32x2*)(HT + (32 + lane) * 40 + 8 * tw + 4 * hq) = pack4(bg4); *(LAS u32x2*)(ET + (32 + lane) * 104 + 64 + 8 * tw + 4 * hq) = pack4(kg4); }
        { const int zr = gtid >> 2, zc = 16 * (gtid & 3); LAS u32x4* zp = (LAS u32x4*)(ET + (32 + zr) * 104 + zc); zp[0] = (u32x4){0u, 0u, 0u, 0u}; zp[1] = (u32x4){0u, 0u, 0u, 0u}; }
        if (pr + 1 < npair) PRE_LOAD(pr + 1);
        float cva[32], cvb[32]; int cea = 0, cna = 0, cka = 0, ceb = 0, cnb = 0, ckb = 0;
        if (bgconv) { const int it0 = ((c.vcu * 32 + pr) * 8 + w) * 2;
            cea = it0 >> 12; { const int rem = it0 & 4095; cka = 64 * (rem >> 7); cna = 32 * (rem & 127); }
            ceb = (it0 + 1) >> 12; { const int rem = (it0 + 1) & 4095; ckb = 64 * (rem >> 7); cnb = 32 * (rem & 127); }
            cv_issue(p.in[I_W1] + (size_t)cea * D * 4096, 4096, D, cna, cka, lane, cva); cv_issue(p.in[I_W1] + (size_t)ceb * D * 4096, 4096, D, cnb, ckb, lane, cvb); }
        LBAR();
        if (tw == 0) ET[(32 + lane) * 104 + lane] = (bf16_t)f2bf(gC);
        { const int mt = tw;
#pragma unroll
          for (int nt = 0; nt < 4; ++nt) {
            f32x4 acc = tile_mm(X1 + 16 * mt * 72, 72, X2 + 16 * nt * 72, 72, 2, fr, fq, (f32x4){0.f, 0.f, 0.f, 0.f});
            const int n = 16 * nt + fr, m0 = 16 * mt + 4 * fq;
            if (mt < 2) { if (nt < 2) { const int t = n; f32x4 o;
#pragma unroll
                    for (int e = 0; e < 4; ++e) o[e] = (m0 + e < t) ? acc[e] : 0.f;
                    *(LAS f32x4*)(LBT + t * 36 + m0) = o; }
                else { const int t = n - 32; f32x4 o;
#pragma unroll
                    for (int e = 0; e < 4; ++e) o[e] = (m0 + e <= t) ? acc[e] : 0.f;
                    *(LAS u32x2*)(HT + t * 40 + m0) = pack4(o); } }
            else { const int s0 = m0 - 32;
                if (nt < 2) { const int t = n;
#pragma unroll
                    for (int e = 0; e < 4; ++e) AL[(64 + s0 + e) * 40 + t] = (bf16_t)f2bf((s0 + e < t) ? acc[e] : 0.f); }
                else { const int t = n - 32; f32x4 o;
#pragma unroll
                    for (int e = 0; e < 4; ++e) o[e] = (s0 + e <= t) ? acc[e] : 0.f;
                    *(LAS u32x2*)(ET + t * 104 + 64 + s0) = pack4(o); } } } }
        LBAR();
        if (gtid < 32) { const int hb = 16 * (gtid >> 4), sl = gtid & 15; float Tr[16];
#pragma unroll
            for (int t = 0; t < 16; ++t) { float a0 = (sl == t) ? 1.f : 0.f, a1 = 0.f, a2 = 0.f, a3 = 0.f;
#pragma unroll
                for (int m4 = 0; m4 < (t + 3) / 4; ++m4) { const f32x4 l = *(const LAS f32x4*)(LBT + (hb + t) * 36 + hb + 4 * m4);
                    if (4 * m4 + 0 < t) a0 += Tr[4 * m4 + 0] * l[0]; if (4 * m4 + 1 < t) a1 += Tr[4 * m4 + 1] * l[1]; if (4 * m4 + 2 < t) a2 += Tr[4 * m4 + 2] * l[2]; if (4 * m4 + 3 < t) a3 += Tr[4 * m4 + 3] * l[3]; }
                Tr[t] = (a0 + a1) + (a2 + a3); TF[(hb + sl) * 36 + hb + t] = Tr[t]; TT[(hb + t) * 40 + hb + sl] = (bf16_t)f2bf(Tr[t]);
                if (hb) TT[t * 40 + hb + sl] = 0; } }
        LBAR();
        { const int m = gtid >> 4, tl = gtid & 15; float x = 0.f;
#pragma unroll
            for (int n = 0; n < 16; ++n) x += LBT[(16 + n) * 36 + m] * TF[(16 + n) * 36 + 16 + tl];
            XB[m * 17 + tl] = x; }
        LBAR();
        { const int sr = gtid >> 4, tl = gtid & 15; float x = 0.f;
#pragma unroll
            for (int m = 0; m < 16; ++m) x += TF[sr * 36 + m] * XB[m * 17 + tl];
            TT[(16 + tl) * 40 + sr] = (bf16_t)f2bf(x); }
        LBAR();
        for (int id = tw; id < 12; id += 4) { const int tt = id / 6, nt = id % 6;
            const f32x4 acc = tile_mm(TT + 16 * tt * 40, 40, AL + 16 * nt * 40, 40, 1, fr, fq, (f32x4){0.f, 0.f, 0.f, 0.f});
            *(LAS u32x2*)(GI + (16 * nt + fr) * 40 + 16 * tt + 4 * fq) = pack4(acc); }
        LBAR();
        for (int id = tw; id < 36; id += 4) { const int nt = id / 6, mt = id % 6;
            const f32x4 acc = tile_mm(GI + 16 * nt * 40, 40, HT + 16 * mt * 40, 40, 1, fr, fq, (f32x4){0.f, 0.f, 0.f, 0.f});
            LAS u32x2* ep = (LAS u32x2*)(ET + (16 * mt + fr) * 104 + 16 * nt + 4 * fq); const u32x2 ev = *ep;
            f32x4 o; o[0] = acc[0] + bf2f(ev.x & 0xffffu); o[1] = acc[1] + bf2f(ev.x >> 16); o[2] = acc[2] + bf2f(ev.y & 0xffffu); o[3] = acc[3] + bf2f(ev.y >> 16);
            *ep = pack4(o); }
        LBAR();
        { bf16_t* fg = FG + (size_t)task * (SC_F * SC_F);
          for (int idx = gtid; idx < 96 * 12; idx += 256) { const int row = idx / 12, pc = idx % 12; *(u32x4*)(fg + row * 96 + 8 * pc) = *(const LAS u32x4*)(ET + row * 104 + 8 * pc); } }
        LBAR();
        if (bgconv) { cv_store8(cva, ws + WS_W1 + (size_t)cea * 4096 * D, D, cna, cka, lane); cv_store8(cvb, ws + WS_W1 + (size_t)ceb * 4096 * D, D, cnb, ckb, lane); }
    }
    if (!bgconv) {
        LBAR();
        for (int r = c.vcu * 8 + w; r < NEXP * MOE_W1E; r += c.G * 8) { const int e = r >> 12, rem = r & 4095; float cv[32]; cv_issue(p.in[I_W1] + (size_t)e * D * 4096, 4096, D, 32 * (rem & 127), 64 * (rem >> 7), lane, cv);
            cv_store8(cv, ws + WS_W1 + (size_t)e * 4096 * D, D, 32 * (rem & 127), 64 * (rem >> 7), lane); }
    }
    LBAR();
#undef PRE_LOAD
}
constexpr int SQ_BI = 0, SQ_BI_SZ = 64 * 104 * 2, SQ_YL = 2 * SQ_BI_SZ, SQ_YL_SZ = 32 * 64 * 4;
struct SeqSet { bf16x8 af[3][3]; u32x2 vimg, gimg; float bon; };
__device__ __forceinline__ void p4_seq(const Params& p, const Ctx& c, int bh) {
    unsigned char* ws = c.ws;
    const bf16_t* VZ = (const bf16_t*)(ws + WS_VZ); const bf16_t* GG = (const bf16_t*)(ws + WS_GG); const float* BON = (const float*)(ws + WS_YS);
    const bf16_t* FG = (const bf16_t*)(ws + WS_F) + (size_t)bh * SC_NCH * (SC_F * SC_F);
    bf16_t* YA = (bf16_t*)(ws + WS_YA);
    int tid_ = c.tid; asm volatile("" : "+v"(tid_));
    const int tid = tid_, lane = tid & 63, w = __builtin_amdgcn_readfirstlane(tid >> 6), fr = lane & 15, fq = lane >> 4;
    const int b = bh >> 5, h = bh & 31;
    const size_t base = (size_t)b * SEQ * D + h * 64;
    const int nt = w & 3, mg = w >> 2;
    LAS bf16_t* BI = (LAS bf16_t*)(c.lds + SQ_BI); LAS float* YL = (LAS float*)(c.lds + SQ_YL);
    const int vs = tid >> 4, vi4 = 4 * (tid & 15);
    const f32x4 lg4 = *(const f32x4*)(p.in[I_LNXG] + h * 64 + vi4), lb4 = *(const f32x4*)(p.in[I_LNXB] + h * 64 + vi4);
#define SEQ_LOAD(SET, CHN) do { const int chn_ = (CHN) < SC_NCH ? (CHN) : SC_NCH - 1; const bf16_t* fp = FG + (size_t)chn_ * (SC_F * SC_F); const size_t tk_ = (size_t)b * SEQ + (size_t)(chn_ * SC_C + vs); \
        asm volatile("global_load_dwordx2 %0, %1, off" : "=v"(SET.vimg) : "v"(VZ + tk_ * D + h * 64 + vi4) : "memory"); \
        _Pragma("unroll") for (int mi = 0; mi < 3; ++mi) _Pragma("unroll") for (int ks = 0; ks < 3; ++ks) \
            asm volatile("global_load_dwordx4 %0, %1, off" : "=v"(SET.af[mi][ks]) : "v"(fp + (16 * (3 * mg + mi) + fr) * SC_F + 32 * ks + 8 * fq) : "memory"); \
        asm volatile("global_load_dwordx2 %0, %1, off" : "=v"(SET.gimg) : "v"(GG + tk_ * D + h * 64 + vi4) : "memory"); \
        asm volatile("global_load_dword %0, %1, off" : "=v"(SET.bon) : "v"(BON + tk_ * 32 + h) : "memory"); } while (0)
#define SEQ_WAIT_AF(SET, N) asm volatile("s_waitcnt vmcnt(" #N ")" : "+v"(SET.af[0][0]), "+v"(SET.af[0][1]), "+v"(SET.af[0][2]), "+v"(SET.af[1][0]), "+v"(SET.af[1][1]), "+v"(SET.af[1][2]), \
        "+v"(SET.af[2][0]), "+v"(SET.af[2][1]), "+v"(SET.af[2][2]) :: "memory")
#define SEQ_WAIT_V(SET, N) asm volatile("s_waitcnt vmcnt(" #N ")" : "+v"(SET.vimg) :: "memory")
#define SEQ_WAIT_G(SET, N) asm volatile("s_waitcnt vmcnt(" #N ")" : "+v"(SET.gimg), "+v"(SET.bon), "+v"(SET.vimg) :: "memory")
#define SEQ_BODY(CH, CUR, NXT, NX2) do { const int ch = (CH), cb = ch & 1; \
        const LAS bf16_t* bi = BI + cb * (64 * 104); LAS bf16_t* bo = BI + (cb ^ 1) * (64 * 104); LAS float* yl = YL + cb * (32 * 64); \
        SEQ_LOAD(NX2, ch + 2); \
        bf16x8 bfr[3]; _Pragma("unroll") for (int ks = 0; ks < 3; ++ks) bfr[ks] = *(const LAS bf16x8*)(bi + (16 * nt + fr) * 104 + 32 * ks + 8 * fq); \
        SEQ_WAIT_AF(CUR, 28); \
        f32x4 acc[3]; _Pragma("unroll") for (int mi = 0; mi < 3; ++mi) { acc[mi] = (f32x4){0.f, 0.f, 0.f, 0.f}; \
            _Pragma("unroll") for (int ks = 0; ks < 3; ++ks) acc[mi] = __builtin_amdgcn_mfma_f32_16x16x32_bf16(CUR.af[mi][ks], bfr[ks], acc[mi], 0, 0, 0); } \
        _Pragma("unroll") for (int mi = 0; mi < 3; ++mi) { const int mt = 3 * mg + mi; \
            if (mt < 2) { _Pragma("unroll") for (int e = 0; e < 4; ++e) yl[(16 * mt + 4 * fq + e) * 64 + 16 * nt + fr] = acc[mi][e]; } \
            else *(LAS u32x2*)(bo + (16 * nt + fr) * 104 + 16 * (mt - 2) + 4 * fq) = pack4(acc[mi]); } \
        SEQ_WAIT_V(NXT, 24); \
        if (ch + 1 < SC_NCH) { bo[(vi4 + 0) * 104 + 64 + vs] = (bf16_t)(NXT.vimg.x & 0xffffu); bo[(vi4 + 1) * 104 + 64 + vs] = (bf16_t)(NXT.vimg.x >> 16); \
            bo[(vi4 + 2) * 104 + 64 + vs] = (bf16_t)(NXT.vimg.y & 0xffffu); bo[(vi4 + 3) * 104 + 64 + vs] = (bf16_t)(NXT.vimg.y >> 16); } \
        LBAR(); \
        SEQ_WAIT_G(CUR, 24); \
        { const f32x4 y4 = *(const LAS f32x4*)(yl + vs * 64 + vi4); float sm = (y4[0] + y4[1]) + (y4[2] + y4[3]); \
          sm = DPP_ADD(sm, 0xB1); sm = DPP_ADD(sm, 0x4E); sm = DPP_ADD(sm, 0x141); sm = DPP_ADD(sm, 0x140);     \
          const float mu = sm * (1.0f / 64.0f); const f32x4 d4 = y4 - mu; float q = (d4[0] * d4[0] + d4[1] * d4[1]) + (d4[2] * d4[2] + d4[3] * d4[3]); \
          q = DPP_ADD(q, 0xB1); q = DPP_ADD(q, 0x4E); q = DPP_ADD(q, 0x141); q = DPP_ADD(q, 0x140); \
          const float rstd = rsqrtf(q * (1.0f / 64.0f) + GN_EPS); \
          const float v0 = bf2f(CUR.vimg.x & 0xffffu), v1 = bf2f(CUR.vimg.x >> 16), v2 = bf2f(CUR.vimg.y & 0xffffu), v3 = bf2f(CUR.vimg.y >> 16); \
          const float g0 = bf2f(CUR.gimg.x & 0xffffu), g1 = bf2f(CUR.gimg.x >> 16), g2 = bf2f(CUR.gimg.y & 0xffffu), g3 = bf2f(CUR.gimg.y >> 16); \
          const float o0 = (d4[0] * rstd * lg4[0] + lb4[0] + CUR.bon * v0) * g0, o1 = (d4[1] * rstd * lg4[1] + lb4[1] + CUR.bon * v1) * g1; \
          const float o2 = (d4[2] * rstd * lg4[2] + lb4[2] + CUR.bon * v2) * g2, o3 = (d4[3] * rstd * lg4[3] + lb4[3] + CUR.bon * v3) * g3; \
          *(u32x2*)(YA + base + (size_t)(ch * SC_C + vs) * D + vi4) = (u32x2){pk2(o0, o1), pk2(o2, o3)}; } } while (0)
    SeqSet sa, sb, sc;
    SEQ_LOAD(sa, 0); SEQ_LOAD(sb, 1);
    SEQ_WAIT_V(sa, 0);
    for (int idx = tid; idx < 64 * 8; idx += 512) *(LAS u32x4*)(BI + (idx >> 3) * 104 + 8 * (idx & 7)) = (u32x4){0u, 0u, 0u, 0u};
    BI[(vi4 + 0) * 104 + 64 + vs] = (bf16_t)(sa.vimg.x & 0xffffu); BI[(vi4 + 1) * 104 + 64 + vs] = (bf16_t)(sa.vimg.x >> 16);
    BI[(vi4 + 2) * 104 + 64 + vs] = (bf16_t)(sa.vimg.y & 0xffffu); BI[(vi4 + 3) * 104 + 64 + vs] = (bf16_t)(sa.vimg.y >> 16);
    LBAR();
    for (int c0 = 0; c0 < SC_NCH; c0 += 3) {
        SEQ_BODY(c0, sa, sb, sc);
        if (c0 + 1 < SC_NCH) SEQ_BODY(c0 + 1, sb, sc, sa);
        if (c0 + 2 < SC_NCH) SEQ_BODY(c0 + 2, sc, sa, sb);
    }
    asm volatile("s_waitcnt vmcnt(0)" ::: "memory");
    LBAR();
#undef SEQ_LOAD
#undef SEQ_BODY
#undef SEQ_WAIT_AF
#undef SEQ_WAIT_V
#undef SEQ_WAIT_G
}

__device__ __forceinline__ void p4_attn_task(const Ctx& c, int task) {
    unsigned char* ws = c.ws;
    const bf16_t* QR = (const bf16_t*)(ws + WS_QR); const bf16_t* KR = (const bf16_t*)(ws + WS_KR); const bf16_t* VR = (const bf16_t*)(ws + WS_VR);
    float* AO = (float*)(ws + WS_AO); float* LSE = (float*)(ws + WS_LSE);
    constexpr int VP = 280;
    LAS bf16_t* Vt = (LAS bf16_t*)c.lds;
    const int combo = task & 31, hh = (task >> 5) % 24, b = task / (32 * 24);
    const int g = hh >> 3, h = hh & 7;
    const int dil = g == 0 ? 1 : (g == 1 ? 4 : 16), nblk = 32 / dil;
    const int res = combo / nblk, blk = combo % nblk;
    int tid_ = c.tid; asm volatile("" : "+v"(tid_));
    const int tid = tid_, lane = tid & 63, w = __builtin_amdgcn_readfirstlane(tid >> 6);
    const int qq = lane & 15, g4 = lane >> 4, r0 = 16 * w;
    const size_t rowb = (size_t)(b * 24 + hh) * SEQ + (size_t)res * (SEQ / dil) + (size_t)blk * 128;
    bf16x8 qf[2], kf[9][2];
#pragma unroll
    for (int ks = 0; ks < 2; ++ks) qf[ks] = *(const bf16x8*)(QR + (rowb + r0 + qq) * 64 + 32 * ks + 8 * g4);
#pragma unroll
    for (int kt = 0; kt < 9; ++kt) { const bool kv = (blk > 0) || (w + kt >= 8);
#pragma unroll
        for (int ks = 0; ks < 2; ++ks) { kf[kt][ks] = (bf16x8){0, 0, 0, 0, 0, 0, 0, 0};
            if (kv) kf[kt][ks] = *(const bf16x8*)(KR + (rowb - 128 + 16 * (w + kt) + qq) * 64 + 32 * ks + 8 * g4); } }
    const int vki = tid >> 1, vdh = tid & 1;
    u32x4 vv[4];
    if (blk > 0 || vki >= 128) {
#pragma unroll
        for (int j = 0; j < 4; ++j) vv[j] = *(const u32x4*)(VR + (rowb - 128 + vki) * 64 + 32 * vdh + 8 * j); }
    else {
#pragma unroll
        for (int j = 0; j < 4; ++j) vv[j] = (u32x4){0u, 0u, 0u, 0u}; }
    __syncthreads();
#pragma unroll
    for (int j = 0; j < 4; ++j) { const unsigned wv[4] = {vv[j].x, vv[j].y, vv[j].z, vv[j].w};
#pragma unroll
        for (int e = 0; e < 8; ++e) Vt[(32 * vdh + 8 * j + e) * VP + vki] = (bf16_t)((wv[e >> 1] >> (16 * (e & 1))) & 0xffffu); }
    if (tid < 64) {
#pragma unroll
        for (int e = 0; e < 24; ++e) Vt[tid * VP + 256 + e] = 0; }
    f32x4 sc[10];
#pragma unroll
    for (int kt = 0; kt < 9; ++kt) { f32x4 a = (f32x4){0.f, 0.f, 0.f, 0.f};
#pragma unroll
        for (int ks = 0; ks < 2; ++ks) a = __builtin_amdgcn_mfma_f32_16x16x32_bf16(kf[kt][ks], qf[ks], a, 0, 0, 0);
        sc[kt] = a; }
    const int r = r0 + qq;
    float mx = -3.0e38f;
#pragma unroll
    for (int kt = 0; kt < 9; ++kt)
#pragma unroll
        for (int j = 0; j < 4; ++j) { const int ki = 16 * (w + kt) + 4 * g4 + j; const bool ok = (ki >= r) && (ki <= r + 128) && (blk > 0 || ki >= 128);
            const float sv = ok ? sc[kt][j] * 0.125f : -1.0e30f; sc[kt][j] = sv; mx = fmaxf(mx, sv); }
    mx = fmaxf(mx, __shfl_xor(mx, 16)); mx = fmaxf(mx, __shfl_xor(mx, 32));
    float den = 0.f;
#pragma unroll
    for (int kt = 0; kt < 9; ++kt)
#pragma unroll
        for (int j = 0; j < 4; ++j) { const float pexp = __expf(sc[kt][j] - mx); sc[kt][j] = pexp; den += pexp; }
    den += __shfl_xor(den, 16); den += __shfl_xor(den, 32);
    sc[9] = (f32x4){0.f, 0.f, 0.f, 0.f};
    __syncthreads();
    f32x4 oacc[4];
#pragma unroll
    for (int dt = 0; dt < 4; ++dt) oacc[dt] = (f32x4){0.f, 0.f, 0.f, 0.f};
#pragma unroll
    for (int cidx = 0; cidx < 5; ++cidx) {
        const f32x4 p0 = sc[2 * cidx], p1 = sc[2 * cidx + 1];
        u32x4 pw; pw.x = pk2(p0[0], p0[1]); pw.y = pk2(p0[2], p0[3]); pw.z = pk2(p1[0], p1[1]); pw.w = pk2(p1[2], p1[3]);
        const bf16x8 pf = __builtin_bit_cast(bf16x8, pw);
        const int kbase = 16 * (w + 2 * cidx) + 4 * g4;
#pragma unroll
        for (int dt = 0; dt < 4; ++dt) { const LAS bf16_t* vp = Vt + (16 * dt + qq) * VP + kbase;
            const u32x2 lo = *(const LAS u32x2*)vp, hi = *(const LAS u32x2*)(vp + 16);
            u32x4 vw; vw.x = lo.x; vw.y = lo.y; vw.z = hi.x; vw.w = hi.y;
            oacc[dt] = __builtin_amdgcn_mfma_f32_16x16x32_bf16(__builtin_bit_cast(bf16x8, vw), pf, oacc[dt], 0, 0, 0); }
    }
    const float inv = 1.0f / den;
    const size_t tok = (size_t)b * SEQ + (size_t)(blk * 128 + r) * dil + res;
#pragma unroll
    for (int dt = 0; dt < 4; ++dt) *(f32x4*)(AO + ((size_t)g * M + tok) * 512 + h * 64 + 16 * dt + 4 * g4) = oacc[dt] * inv;
    if (g4 == 0) LSE[((size_t)g * M + tok) * 8 + h] = mx + __logf(den);
}

constexpr int Q_ATT = 3072, Q_TOTAL = Q_ATT + MOE_CONV_GROUPS;
__device__ __forceinline__ void p4_queue(const Params& p, const Ctx& c, volatile LAS unsigned* qslot) {
    unsigned* qc = (unsigned*)(c.ws + WS_CTL) + CW_Q;
    for (;;) {
        __syncthreads();
        if (c.tid == 0) qslot[0] = __hip_atomic_fetch_add(qc, 1u, __ATOMIC_RELAXED, __HIP_MEMORY_SCOPE_AGENT);
        __syncthreads();
        const unsigned it = qslot[0];
        if (it >= (unsigned)Q_TOTAL) break;
        if (it < (unsigned)Q_ATT) p4_attn_task(c, (int)it); else conv_group(p, c, (int)it - Q_ATT);
    }
}

__device__ __forceinline__ void p5_post(const Params& p, const Ctx& c) {
    unsigned char* ws = c.ws;
    const float* AO = (const float*)(ws + WS_AO); const float* LSE = (const float*)(ws + WS_LSE);
    bf16_t* YB = (bf16_t*)(ws + WS_YB);
    const int gw = c.vcu * 8 + c.wave, NGW = c.G * 8, lane = c.lane;
    for (int it = gw; it < M * 8; it += NGW) {
        const int t = it >> 3, h = it & 7;
        const float l0 = LSE[((size_t)0 * M + t) * 8 + h], l1 = LSE[((size_t)1 * M + t) * 8 + h], l2 = LSE[((size_t)2 * M + t) * 8 + h];
        const float mxl = fmaxf(l0, fmaxf(l1, l2)); const float e0 = __expf(l0 - mxl), e1 = __expf(l1 - mxl), e2 = __expf(l2 - mxl); const float inv = 1.0f / (e0 + e1 + e2);
        const size_t o = (size_t)t * 512 + h * 64 + lane;
        const float v = (e0 * AO[o] + e1 * AO[(size_t)M * 512 + o] + e2 * AO[(size_t)2 * M * 512 + o]) * inv;
        YB[o] = (bf16_t)f2bf(v);
    }
}

__device__ __forceinline__ void ln_rows(const Ctx& c, const float* in, const float* gam, const float* bet, float* outf, bf16_t* outb, unsigned char* outq = nullptr) {
    const int gw = c.vcu * 8 + c.wave, NGW = c.G * 8, lane = c.lane;
    for (int m = gw; m < M; m += NGW) {
        const f32x4* xr = (const f32x4*)(in + (size_t)m * D) + lane;
        f32x4 v[8]; float s = 0.f;
#pragma unroll
        for (int j = 0; j < 8; ++j) { v[j] = xr[64 * j]; s += (v[j][0] + v[j][1]) + (v[j][2] + v[j][3]); }
        const float mean = wave_sum(s) * (1.0f / D); float s2 = 0.f;
#pragma unroll
        for (int j = 0; j < 8; ++j) { v[j] = v[j] - mean; s2 += (v[j][0] * v[j][0] + v[j][1] * v[j][1]) + (v[j][2] * v[j][2] + v[j][3] * v[j][3]); }
        const float rstd = rsqrtf(wave_sum(s2) * (1.0f / D) + LN_EPS);
#pragma unroll
        for (int j = 0; j < 8; ++j) { const int col = 4 * lane + 256 * j; const f32x4 gv = *(const f32x4*)(gam + col), bv = *(const f32x4*)(bet + col);
            const f32x4 o = v[j] * rstd * gv + bv;
            *(f32x4*)(outf + (size_t)m * D + col) = o;
            if (outb) { u32x2 w; w.x = pk2(o[0], o[1]); w.y = pk2(o[2], o[3]); *(u32x2*)(outb + (size_t)m * D + col) = w; }
            if (outq) *(unsigned*)(outq + (size_t)m * D + col) = pk4_fp8(o[0], o[1], o[2], o[3]); }
    }
}

__device__ __forceinline__ void p15_router(const Params& p, const Ctx& c) {
    unsigned char* ws = c.ws;
    const float* X2 = (const float*)(ws + WS_X2); const float* RW = p.in[I_RW]; const float* RB = p.in[I_RB];
    unsigned* cnt = (unsigned*)(ws + WS_CTL) + CW_CNT; int* LIST = (int*)(ws + WS_LIST); int* ROWI = (int*)(ws + WS_ROWI); float* TOPW = (float*)(ws + WS_TOPW);
    LAS float* scr = (LAS float*)(c.lds + c.wave * 8192);
    const int gw = c.vcu * 8 + c.wave, NGW = c.G * 8, lane = c.lane, li = lane & 31, lk = lane >> 5;
    for (int tb = gw; tb < M / 32; tb += NGW) {
        const int t0 = tb * 32;
        f32x16 acc;
#pragma unroll
        for (int j = 0; j < 16; ++j) acc[j] = 0.f;
        const float* xa = X2 + (size_t)(t0 + li) * D + 4 * lk;
        const float* wb = RW + (size_t)(4 * lk) * 32 + li;
        for (int kb = 0; kb < D / 8; ++kb) {
            const f32x4 a = *(const f32x4*)(xa + 8 * kb);
            const float b0 = wb[(size_t)(8 * kb + 0) * 32], b1 = wb[(size_t)(8 * kb + 1) * 32], b2 = wb[(size_t)(8 * kb + 2) * 32], b3 = wb[(size_t)(8 * kb + 3) * 32];
            acc = __builtin_amdgcn_mfma_f32_32x32x2f32(a[0], b0, acc, 0, 0, 0);
            acc = __builtin_amdgcn_mfma_f32_32x32x2f32(a[1], b1, acc, 0, 0, 0);
            acc = __builtin_amdgcn_mfma_f32_32x32x2f32(a[2], b2, acc, 0, 0, 0);
            acc = __builtin_amdgcn_mfma_f32_32x32x2f32(a[3], b3, acc, 0, 0, 0);
        }
        const float bias = RB[li];
#pragma unroll
        for (int rg = 0; rg < 16; ++rg) { const int row = (rg & 3) + 8 * (rg >> 2) + 4 * lk; scr[row * 33 + li] = acc[rg] + bias; }
        LDS_WAIT(); asm volatile("" ::: "memory");
        if (lane < 32) {
            float lv[32];
#pragma unroll
            for (int e = 0; e < 32; ++e) lv[e] = scr[lane * 33 + e];
            int id[4]; float tv[4];
#pragma unroll
            for (int k = 0; k < 4; ++k) { float best = -3.0e38f; int bi = 0;
#pragma unroll
                for (int e = 0; e < 32; ++e) { const bool tk = lv[e] > best; best = tk ? lv[e] : best; bi = tk ? e : bi; }
                id[k] = bi; tv[k] = best;
#pragma unroll
                for (int e = 0; e < 32; ++e) lv[e] = (e == bi) ? -3.0e38f : lv[e]; }
            const float e1 = __expf(tv[1] - tv[0]), e2 = __expf(tv[2] - tv[0]), e3 = __expf(tv[3] - tv[0]); const float inv = 1.0f / (1.0f + e1 + e2 + e3);
            const float wv[4] = {inv, e1 * inv, e2 * inv, e3 * inv};
            const int t = t0 + lane;
#pragma unroll
            for (int k = 0; k < 4; ++k) { const unsigned slot = __hip_atomic_fetch_add(cnt + id[k], 1u, __ATOMIC_RELAXED, __HIP_MEMORY_SCOPE_AGENT);
                LIST[(size_t)id[k] * CAP + slot] = t; ROWI[(size_t)t * 4 + k] = id[k] * CAP + (int)slot; TOPW[(size_t)t * 4 + k] = wv[k]; }
        }
        LDS_WAIT(); asm volatile("" ::: "memory");
    }
}

__device__ __forceinline__ void moe_table(const Ctx& c, LAS int* tab) {
    if (c.tid == 0) { unsigned* cnt = (unsigned*)(c.ws + WS_CTL) + CW_CNT; int ts = 0;
        for (int e = 0; e < NEXP; ++e) { const int n = (int)__hip_atomic_load(cnt + e, __ATOMIC_RELAXED, __HIP_MEMORY_SCOPE_AGENT); tab[e] = n; tab[32 + e] = ts; ts += (n + 255) >> 8; }
        tab[64] = ts; }
    __syncthreads();
}

__device__ __forceinline__ void p18_combine(const Params& p, const Ctx& c, const LAS int* tab) {
    unsigned char* ws = c.ws;
    const float* X2 = (const float*)(ws + WS_X2); const bf16_t* Y = (const bf16_t*)(ws + WS_Y); const int* ROWI = (const int*)(ws + WS_ROWI); const float* TOPW = (const float*)(ws + WS_TOPW);
    const float* gam = p.in[I_LN3G]; const float* bet = p.in[I_LN3B];
    const int gw = c.vcu * 8 + c.wave, NGW = c.G * 8, lane = c.lane;
    for (int m = gw; m < M; m += NGW) {
        f32x4 v[8];
        const f32x4* xr = (const f32x4*)(X2 + (size_t)m * D) + lane;
#pragma unroll
        for (int j = 0; j < 8; ++j) v[j] = xr[64 * j] * DN_ALPHA;
#pragma unroll
        for (int k = 0; k < 4; ++k) { const int ri = ROWI[(size_t)m * 4 + k]; const float gt = TOPW[(size_t)m * 4 + k]; const int e = ri >> 14, slot = ri & (CAP - 1);
            const u32x2* yr = (const u32x2*)(Y + ((size_t)tab[32 + e] * 256 + slot) * D) + lane;
#pragma unroll
            for (int j = 0; j < 8; ++j) { const u32x2 yw = yr[64 * j]; v[j] = v[j] + (f32x4){bf2f(yw.x & 0xffffu), bf2f(yw.x >> 16), bf2f(yw.y & 0xffffu), bf2f(yw.y >> 16)} * gt; } }
        float s = 0.f;
#pragma unroll
        for (int j = 0; j < 8; ++j) s += (v[j][0] + v[j][1]) + (v[j][2] + v[j][3]);
        const float mean = wave_sum(s) * (1.0f / D); float s2 = 0.f;
#pragma unroll
        for (int j = 0; j < 8; ++j) { v[j] = v[j] - mean; s2 += (v[j][0] * v[j][0] + v[j][1] * v[j][1]) + (v[j][2] * v[j][2] + v[j][3] * v[j][3]); }
        const float rstd = rsqrtf(wave_sum(s2) * (1.0f / D) + LN_EPS);
#pragma unroll
        for (int j = 0; j < 8; ++j) { const int col = 4 * lane + 256 * j; const f32x4 gv = *(const f32x4*)(gam + col), bv = *(const f32x4*)(bet + col);
            *(f32x4*)(p.out + (size_t)m * D + col) = v[j] * rstd * gv + bv; }
    }
}

constexpr int NPHASE = 19;
__global__ void __launch_bounds__(512, 2) fwd(Params p) {
    extern __shared__ __attribute__((aligned(16))) unsigned char lds_raw[];
    LAS unsigned char* lds = (LAS unsigned char*)lds_raw;
    Ctx c; c.tid = threadIdx.x; c.lane = c.tid & 63; c.wave = __builtin_amdgcn_readfirstlane(c.tid >> 6); c.G = gridDim.x;
    { const int bx = blockIdx.x; c.vcu = (c.G % 8 == 0) ? (bx % 8) * (c.G / 8) + bx / 8 : bx; }
    c.lds = lds; c.ws = p.ws;
    unsigned char* ws = p.ws;
    volatile LAS unsigned* MISC = (volatile LAS unsigned*)(lds + MISC_OFF);
    LAS int* tab = (LAS int*)(lds + MISC_OFF + 1024);
    if (c.tid < 64) MISC[c.tid] = 0u;
    __syncthreads();
    unsigned* ctl = (unsigned*)(ws + WS_CTL);
    XcdBarrier bar; bar.bar = ctl + CW_BAR + p.li * XCD_BAR_WORDS; bar.x = 0; bar.st = MISC + 8;
    if (N_LAUNCH_MODE == 1) bar = xcd_barrier_post(ctl + CW_BAR + p.li * XCD_BAR_WORDS, MISC + 8);
    const int lo = p.ph_lo, hi = p.ph_hi, bx = blockIdx.x;
#ifndef PHMASK
#define PHMASK 0xFFFFFFFFu
#endif
#define IN(k) (((PHMASK >> (k)) & 1u) && lo <= (k) && (k) < hi)
#define SEAM(k) do { if (N_LAUNCH_MODE == 1 && IN((k) + 1)) xcd_barrier(bar); } while (0)

    if (IN(0)) { p0_prologue(p, c); SEAM(0); }

    if (IN(1)) {
        pg8::StaticOrder S; S.init(ws + WS_XB, ws + WS_WIN, M, PC, D, D, c.G, bx);
        pg8::EpiBf16 E{(bf16_t*)(ws + WS_PROJ), PC, 1.0f};
        pg8::gemm_phase<pg8::EpiBf16, pg8::StaticOrder>(lds, pg8::Gemm{D, D, D}, S, E);
        SEAM(1);
    }
    if (IN(2)) { p2_prep(p, c); SEAM(2); }

    if (IN(3)) {
#ifndef P3M
#define P3M 15
#endif
        if (P3M & 1) { pg8::StaticOrder S; S.init(ws + WS_LIN, ws + WS_WUP, M, D, 768, 256, c.G, bx);
          pg8::EpiDecay E{(float*)(ws + WS_DEC), p.in[I_W0]};
          pg8::gemm_phase<pg8::EpiDecay, pg8::StaticOrder>(lds, pg8::Gemm{256, 768, 256}, S, E); }
        if (P3M & 2) { pg8::StaticOrder S; S.init(ws + WS_LIN + 512, ws + WS_AUP, M, D, 768, 256, c.G, bx);
          pg8::EpiIclr E{p.in[I_A0], p.in[I_KK], p.in[I_KA], (const bf16_t*)(ws + WS_KZ), (const float*)(ws + WS_KNORM), (bf16_t*)(ws + WS_KP), (bf16_t*)(ws + WS_AN), (bf16_t*)(ws + WS_BB)};
          pg8::gemm_phase<pg8::EpiIclr, pg8::StaticOrder>(lds, pg8::Gemm{256, 768, 256}, S, E); }
        if (P3M & 4) { pg8::StaticOrder S; S.init(ws + WS_LIN + 1024, ws + WS_GUP, M, D, 768, 256, c.G, bx);
          pg8::EpiBf16 E{(bf16_t*)(ws + WS_GG), D, 1.0f};
          pg8::gemm_phase<pg8::EpiBf16, pg8::StaticOrder>(lds, pg8::Gemm{256, 768, 256}, S, E); }
        if (P3M & 8) { pg8::StaticOrder S; S.init(ws + WS_MEMB, ws + WS_WKV, 1024, 2 * D, D, D, c.G, bx);
          pg8::EpiKV E{(bf16_t*)(ws + WS_KB), (bf16_t*)(ws + WS_VT)};
          pg8::gemm_phase<pg8::EpiKV, pg8::StaticOrder>(lds, pg8::Gemm{D, D, D}, S, E); }
        SEAM(3);
    }
    if (IN(4)) {
        p4_pre(p, c);
        xcd_barrier(bar);
        for (int bh = c.vcu; bh < 128; bh += c.G) p4_seq(p, c, bh);
        p4_queue(p, c, MISC + 16);
        SEAM(4);
    }
    if (IN(5)) { p5_post(p, c); }

    if (IN(6)) {
        pg8::StaticOrder S; S.init(ws + WS_YA, ws + WS_PA, M, D, D, D, c.G, bx);
        pg8::EpiGateA E{(const bf16_t*)(ws + WS_PROJ), (float*)(ws + WS_TMP)};
        pg8::gemm_phase<pg8::EpiGateA, pg8::StaticOrder>(lds, pg8::Gemm{D, D, D}, S, E);
        SEAM(6);
    }
    if (IN(7)) {
        pg8::StaticOrder S; S.init(ws + WS_YB, ws + WS_PB, M, D, 512, 512, c.G, bx);
        pg8::EpiGateB E{(const bf16_t*)(ws + WS_PROJ), (const float*)(ws + WS_TMP), (bf16_t*)(ws + WS_MERGED)};
        pg8::gemm_phase<pg8::EpiGateB, pg8::StaticOrder>(lds, pg8::Gemm{512, 512, 512}, S, E);
        SEAM(7);
    }
    if (IN(8)) {
        pg8::StaticOrder S; S.init(ws + WS_MERGED, ws + WS_WOUT, M, D, D, D, c.G, bx);
        pg8::EpiF32 E{(float*)(ws + WS_T1), D, nullptr, 0, p.in[I_X], DN_ALPHA};
        pg8::gemm_phase<pg8::EpiF32, pg8::StaticOrder>(lds, pg8::Gemm{D, D, D}, S, E);
        SEAM(8);
    }
    if (IN(9)) { ln_rows(c, (const float*)(ws + WS_T1), p.in[I_LN1G], p.in[I_LN1B], (float*)(ws + WS_X1), (bf16_t*)(ws + WS_X1B)); SEAM(9); }

    if (IN(10)) {
        pg8::StaticOrder S; S.init(ws + WS_X1B, ws + WS_WQ, M, D, D, D, c.G, bx);
        pg8::EpiBf16 E{(bf16_t*)(ws + WS_Q), D, 0.04419417382415922f};
        pg8::gemm_phase<pg8::EpiBf16, pg8::StaticOrder>(lds, pg8::Gemm{D, D, D}, S, E);
        SEAM(10);
    }
    if (IN(11)) {
        ScoreOrder S{(const char*)(ws + WS_Q), (const char*)(ws + WS_KB), c.G, bx};
        pg8::EpiSoftmax E{(bf16_t*)(ws + WS_PP)};
        pg8::gemm_phase<pg8::EpiSoftmax, ScoreOrder, false>(lds, pg8::Gemm{512, D, D}, S, E);
        SEAM(11);
    }
    if (IN(12)) {
        PvOrder S{(const char*)(ws + WS_PP), (const char*)(ws + WS_VT), c.G, bx};
        pg8::EpiBf16 E{(bf16_t*)(ws + WS_OC), D, 1.0f};
        pg8::gemm_phase<pg8::EpiBf16, PvOrder>(lds, pg8::Gemm{256, 256, 256}, S, E);
        SEAM(12);
    }
    if (IN(13)) {
        pg8::StaticOrder S; S.init(ws + WS_OC, ws + WS_WO, M, D, D, D, c.G, bx);
        pg8::EpiF32 E{(float*)(ws + WS_T2), D, nullptr, 0, (const float*)(ws + WS_X1), DN_ALPHA};
        pg8::gemm_phase<pg8::EpiF32, pg8::StaticOrder>(lds, pg8::Gemm{D, D, D}, S, E);
        SEAM(13);
    }
    if (IN(14)) { ln_rows(c, (const float*)(ws + WS_T2), p.in[I_LN2G], p.in[I_LN2B], (float*)(ws + WS_X2), nullptr, ws + WS_X2B); SEAM(14); }
    if (IN(15)) { p15_router(p, c); SEAM(15); }

    if (IN(16)) {
        moe_table(c, tab);
        MoeOrder<true, 16> S{tab, (const char*)(ws + WS_X2B), (const char*)(ws + WS_W1), (const int*)(ws + WS_LIST), (size_t)4096 * D, D, c.G, bx};
        pg8::EpiSwiglu E{p.in[I_B1], (bf16_t*)(ws + WS_H)};
        pg8::gemm_phase<pg8::EpiSwiglu, MoeOrder<true, 16>, true, true>(lds, pg8::Gemm{D, D, D}, S, E);
        SEAM(16);
    }
    if (IN(17)) {
        moe_table(c, tab);
        MoeOrder<false, 8> S{tab, (const char*)(ws + WS_H), (const char*)(ws + WS_W2), (const int*)(ws + WS_LIST), (size_t)D * DFF, DFF, c.G, bx};
        pg8::EpiBf16Bias E{(bf16_t*)(ws + WS_Y), D, p.in[I_B2], D};
        pg8::gemm_phase<pg8::EpiBf16Bias, MoeOrder<false, 8>, true, true>(lds, pg8::Gemm{DFF, DFF, DFF}, S, E);
        SEAM(17);
    }
    if (IN(18)) { moe_table(c, tab); p18_combine(p, c, tab); }
#undef IN
#undef SEAM
}

extern "C" void kernel_launch(void* const* d_in, const int* in_sizes, int n_in, void* d_out, int out_size, void* d_ws, size_t ws_size, hipStream_t stream) {
    static int grid = 0;
    if (grid == 0) {
        if (n_in != 32 || out_size != M * D || ws_size < WS_END) { fprintf(stderr, "kernel_launch: expected 32 inputs, %d outputs, >= %zu bytes of workspace; got %d, %d, %zu\n", M * D, (size_t)WS_END, n_in, out_size, ws_size); grid = -1; return; }
        int dev = 0, cus = 0, per_cu = 0;
        if (hipGetDevice(&dev) != hipSuccess || hipDeviceGetAttribute(&cus, hipDeviceAttributeMultiprocessorCount, dev) != hipSuccess) { grid = -1; return; }
        if (hipFuncSetAttribute((const void*)fwd, hipFuncAttributeMaxDynamicSharedMemorySize, LDS_BYTES) != hipSuccess) { fprintf(stderr, "kernel_launch: hipFuncSetAttribute failed\n"); grid = -1; return; }
        if (hipOccupancyMaxActiveBlocksPerMultiprocessor(&per_cu, (const void*)fwd, 512, LDS_BYTES) != hipSuccess || per_cu < 1) fprintf(stderr, "kernel_launch: occupancy query reports %d\n", per_cu);
        (void)hipGetLastError();
        grid = cus;
        if (grid != 256) fprintf(stderr, "kernel_launch: %d CUs; this kernel is built for 256\n", grid);
    }
    if (grid < 0) return;
    (void)hipMemsetAsync((char*)d_ws + WS_CTL, 0, CTL_ZERO_BYTES, stream);
    Params p{};
    for (int i = 0; i < 32; ++i) p.in[i] = (const float*)d_in[i];
    p.out = (float*)d_out; p.ws = (unsigned char*)d_ws;
#if defined(TIMING_REPEAT_LO)
    { const int cuts[4][2] = {{0, TIMING_REPEAT_HI}, {TIMING_REPEAT_LO, TIMING_REPEAT_HI}, {TIMING_REPEAT_HI, NPHASE}, {0, 0}};
      for (int li = 0; li < 3; ++li) { if (cuts[li][0] >= cuts[li][1]) continue; p.ph_lo = cuts[li][0]; p.ph_hi = cuts[li][1]; p.li = li; hipLaunchKernelGGL(fwd, dim3(grid), dim3(512), LDS_BYTES, stream, p); } }
#else
    if (N_LAUNCH_MODE == 1) { p.ph_lo = 0; p.ph_hi = NPHASE; hipLaunchKernelGGL(fwd, dim3(grid), dim3(512), LDS_BYTES, stream, p); }
    else for (int k = 0; k < NPHASE; ++k) { p.ph_lo = k; p.ph_hi = k + 1; hipLaunchKernelGGL(fwd, dim3(grid), dim3(512), LDS_BYTES, stream, p); }
#endif
}
```

```cpp
#include <hip/hip_runtime.h>
#include <cstdio>
#include <cstdint>

#define LAS __attribute__((address_space(3)))
#define GAS __attribute__((address_space(1)))
typedef unsigned short bf16_t;
typedef short bf16x8 __attribute__((ext_vector_type(8)));
typedef float f32x4 __attribute__((ext_vector_type(4)));
typedef float f32x2 __attribute__((ext_vector_type(2)));
typedef float f32x16 __attribute__((ext_vector_type(16)));
typedef unsigned u32x4 __attribute__((ext_vector_type(4)));
typedef unsigned u32x2 __attribute__((ext_vector_type(2)));

#ifndef N_LAUNCH_MODE
#define N_LAUNCH_MODE 1
#endif

constexpr int M = 16384, D = 2048, SEQ = 4096, NBATCH = 4;
constexpr int RWC = 6592;
constexpr int PC = 15360;
constexpr int ATT0 = 6656, GATE0 = 11264;
constexpr int NEXP = 32, DFF = 2048, CAP = 16384;
constexpr int HROWS = 65536 + 32 * 256;
constexpr float LN_EPS = 1e-5f, GN_EPS = 64e-5f;
constexpr float DN_ALPHA = 1.189207115002721f;

__device__ __forceinline__ float bf2f(unsigned v) { return __uint_as_float(v << 16); }
__device__ __forceinline__ unsigned f2bf(float f) { unsigned u = __float_as_uint(f); return (u + 0x7fffu + ((u >> 16) & 1u)) >> 16; }
__device__ __forceinline__ unsigned pk2(float lo, float hi) { return f2bf(lo) | (f2bf(hi) << 16); }
typedef int v4i __attribute__((ext_vector_type(4)));
typedef int v8i __attribute__((ext_vector_type(8)));
__device__ __forceinline__ unsigned pk4_fp8(float a, float b, float c, float d) { int r = __builtin_amdgcn_cvt_pk_fp8_f32(a, b, 0, false); r = __builtin_amdgcn_cvt_pk_fp8_f32(c, d, r, true); return (unsigned)r; }
__device__ __forceinline__ float sigmoidf_(float x) { return 1.0f / (1.0f + __expf(-x)); }
__device__ __forceinline__ float wave_sum(float v) {
#pragma unroll
    for (int o = 1; o < 64; o <<= 1) v += __shfl_xor(v, o);
    return v;
}
#define LDS_WAIT() asm volatile("s_waitcnt lgkmcnt(0)" ::: "memory")
#define VM_WAIT() asm volatile("s_waitcnt vmcnt(0)" ::: "memory")

namespace pg8 {
#define PG8_LAS __attribute__((address_space(3)))
constexpr int BM = 256, BK = 64, HALF = 128, HTB = HALF * BK * 2, STAGE_BYTES = 8 * HTB, NXCD = 8, WGM = 8;

__host__ __device__ __forceinline__ int lds_byte(int r, int c) { const int st = (r >> 4) * 2 + (c >> 5), rr = r & 15, cc = c & 31, ob = rr * 64 + cc * 2; return st * 1024 + (ob ^ (((ob >> 9) & 1) << 5)); }
__host__ __device__ __forceinline__ void stage_rc(int b, int& R, int& C) { const int st = b / 1024, sb = b % 1024, swz = sb ^ (((sb >> 9) & 1) << 5); R = (st >> 1) * 16 + swz / 64; C = (st & 1) * 32 + (swz % 64) / 2; }
__host__ __device__ __forceinline__ int perm32(int rho) { const int n = rho >> 4, i = rho & 15; return 8 * (i >> 2) + 4 * n + (i & 3); }

struct Unit { const char* A; const char* B; int orow, ocol, aux, aux2, valid; };
struct Gemm { int K, lda, ldb; };

struct StaticOrder {
    static constexpr bool GATHER = false;
    const char* A; const char* Bt; size_t ta, tb;
    int nM, nN, nwg, G, c;
    __device__ void init(const void* A_, const void* Bt_, int M_, int N_, int lda, int ldb, int G_, int c_, int esz = 2) { A = (const char*)A_; Bt = (const char*)Bt_; ta = (size_t)BM * lda * esz; tb = (size_t)BM * ldb * esz; nM = M_ / BM; nN = N_ / BM; nwg = nM * nN; G = G_; c = c_; }
    __device__ bool next(int i, Unit& u) const {
        const long L = (long)i * G + c; if (c < 0 || L >= nwg) return false;
        int wgid = (int)L; { const int q = nwg / NXCD, r = nwg % NXCD, xcd = wgid % NXCD, off = wgid / NXCD; wgid = (xcd < r ? xcd * (q + 1) : r * (q + 1) + (xcd - r) * q) + off; }
        const int nig = WGM * nN, gid = wgid / nig, fm = gid * WGM, gsz = (nM - fm) < WGM ? (nM - fm) : WGM;
        const int pm = fm + ((wgid % nig) % gsz), pn = (wgid % nig) / gsz;
        u.A = A + (size_t)pm * ta; u.B = Bt + (size_t)pn * tb; u.orow = pm * BM; u.ocol = pn * BM; u.aux = 0; u.aux2 = 0; u.valid = BM; return true;
    }
    __device__ __forceinline__ const int* rows(const Unit&) const { return nullptr; }
};

__device__ __forceinline__ unsigned cvt_pk_bf16(float lo, float hi) { unsigned r; asm volatile("v_cvt_pk_bf16_f32 %0, %1, %2" : "=v"(r) : "v"(lo), "v"(hi)); return r; }

template <class Epi, class Sched, bool ALIGN_EPI = true, bool FP8 = false>
__device__ __forceinline__ void gemm_phase(PG8_LAS unsigned char* lds, const Gemm g, const Sched& S, const Epi& E) {
    const int tid = threadIdx.x, wid = __builtin_amdgcn_readfirstlane(tid >> 6), lane = tid & 63, wr = wid >> 2, wc = wid & 3, fr = lane & 15, fq = lane >> 4;
    constexpr int ES = FP8 ? 1 : 2;
    int sclW = 0, sclX = 0;
    if constexpr (FP8) { asm volatile("v_mov_b32 %0, 0x79797979\n\tv_mov_b32 %1, 0x7f7f7f7f" : "=v"(sclW), "=v"(sclX)); }
    const int K = g.K, nt = K * ES / (BK * 2);
    unsigned voffA[2], voffB[2]; int Rr[2], Cc[2];
#pragma unroll
    for (int i = 0; i < 2; ++i) { int R, C; stage_rc(tid * 16 + i * 8192, R, C); const int Rb = Epi::PERM ? ((R & ~31) + perm32(R & 31)) : R; Rr[i] = R; Cc[i] = C;
        voffA[i] = (unsigned)(R * g.lda * ES + C * 2); voffB[i] = (unsigned)(Rb * g.ldb * ES + C * 2); }
    const size_t kstep = (size_t)(BK * 2);
    const size_t hstepA = (size_t)HALF * g.lda * ES, hstepB = (size_t)HALF * g.ldb * ES;
    const unsigned ldsw = (unsigned)wid * 1024u;
    const int aoff = lds_byte(wr * 64 + fr, fq * 8), boff = lds_byte(wc * 32 + fr, fq * 8);
    unsigned vAc[2][2], vAn[2][2];
#define PG8_SA(b, h) (((b) * 2 + (h)) * HTB)
#define PG8_SB(b, h) ((4 + (b) * 2 + (h)) * HTB)
#define PG8_STAGE(bufoff, gbase, voff) do { _Pragma("unroll") for (int _i = 0; _i < 2; ++_i) \
        __builtin_amdgcn_global_load_lds((const unsigned*)((const char*)(gbase) + (voff)[_i]), (PG8_LAS unsigned*)(lds + (bufoff) + ldsw + _i * 8192), 16, 0, 0); } while (0)
#define PG8_STAGE_A(bufoff, kbase, h, nx) do { if constexpr (Sched::GATHER) { unsigned _v[2] = {(nx) ? vAn[h][0] : vAc[h][0], (nx) ? vAn[h][1] : vAc[h][1]}; PG8_STAGE(bufoff, kbase, _v); } \
        else { PG8_STAGE(bufoff, (kbase) + (h) * hstepA, voffA); } } while (0)
#define PG8_GOFF(u, v) do { const int* _rw = S.rows(u); _Pragma("unroll") for (int _h = 0; _h < 2; ++_h) _Pragma("unroll") for (int _i = 0; _i < 2; ++_i) { const int _r = Rr[_i] + _h * HALF; \
        const int _tk = _r < (u).valid ? _rw[_r] : 0; v[_h][_i] = (unsigned)(_tk * g.lda * ES + Cc[_i] * 2); } } while (0)
#define PG8_LDA(dst, b, h) do { _Pragma("unroll") for (int m = 0; m < 4; ++m) _Pragma("unroll") for (int k = 0; k < 2; ++k) dst[m][k] = *(const PG8_LAS bf16x8*)(lds + PG8_SA(b, h) + aoff + m * 2048 + k * 1024); } while (0)
#define PG8_LDB(dst, b, h) do { _Pragma("unroll") for (int n = 0; n < 2; ++n) _Pragma("unroll") for (int k = 0; k < 2; ++k) dst[n][k] = *(const PG8_LAS bf16x8*)(lds + PG8_SB(b, h) + boff + n * 2048 + k * 1024); } while (0)
#define PG8_MMA(ai, bj, At, Bt) do { __builtin_amdgcn_s_setprio(1); _Pragma("unroll") for (int m = 0; m < 4; ++m) _Pragma("unroll") for (int n = 0; n < 2; ++n) { \
        if constexpr (FP8) { const v4i _b0 = __builtin_bit_cast(v4i, Bt[n][0]), _b1 = __builtin_bit_cast(v4i, Bt[n][1]), _a0 = __builtin_bit_cast(v4i, At[m][0]), _a1 = __builtin_bit_cast(v4i, At[m][1]); \
            const v8i _bb = __builtin_shufflevector(_b0, _b1, 0, 1, 2, 3, 4, 5, 6, 7), _aa = __builtin_shufflevector(_a0, _a1, 0, 1, 2, 3, 4, 5, 6, 7); \
            asm volatile("v_mfma_scale_f32_16x16x128_f8f6f4 %0, %1, %2, %0, %3, %4 op_sel_hi:[0,0,0]" : "+v"(acc[ai][bj][m][n]) : "v"(_bb), "v"(_aa), "v"(sclW), "v"(sclX)); } \
        else { _Pragma("unroll") for (int k = 0; k < 2; ++k) acc[ai][bj][m][n] = __builtin_amdgcn_mfma_f32_16x16x32_bf16(Bt[n][k], At[m][k], acc[ai][bj][m][n], 0, 0, 0); } } \
        __builtin_amdgcn_s_setprio(0); } while (0)
#define PG8_WAIT_V(n) asm volatile("s_waitcnt vmcnt(" #n ")" ::: "memory")
#define PG8_WAIT_L(n) asm volatile("s_waitcnt lgkmcnt(" #n ")" ::: "memory")
#define PG8_BAR __builtin_amdgcn_s_barrier()
#define PG8_SCHED __builtin_amdgcn_sched_barrier(0)
    Unit cur, nxt; int ui = 0;
    if (!S.next(0, cur)) return;
    f32x4 acc[2][2][4][2];
#pragma unroll
    for (int a = 0; a < 2; ++a)
#pragma unroll
        for (int b = 0; b < 2; ++b)
#pragma unroll
            for (int m = 0; m < 4; ++m)
#pragma unroll
                for (int n = 0; n < 2; ++n) acc[a][b][m][n] = (f32x4){0.f, 0.f, 0.f, 0.f};
    bf16x8 At[4][2], B0[2][2], B1[2][2];
    const char* cA = cur.A; const char* cB = cur.B;
    if constexpr (Sched::GATHER) { PG8_GOFF(cur, vAc); PG8_WAIT_V(0); }
    PG8_STAGE(PG8_SB(0, 0), cB, voffB); PG8_STAGE(PG8_SB(0, 1), cB + hstepB, voffB); PG8_STAGE_A(PG8_SA(0, 0), cA, 0, false); PG8_STAGE_A(PG8_SA(0, 1), cA, 1, false);
    if (wr == 1) PG8_BAR;
    PG8_WAIT_V(2); PG8_BAR;
    PG8_STAGE(PG8_SB(1, 0), cB + kstep, voffB); PG8_STAGE_A(PG8_SA(1, 0), cA + kstep, 0, false); PG8_STAGE(PG8_SB(1, 1), cB + hstepB + kstep, voffB);
    PG8_WAIT_V(6); PG8_BAR;
    for (;;) {
        const bool has_next = S.next(ui + 1, nxt);
        const char* nA = has_next ? nxt.A : cA; const char* nB = has_next ? nxt.B : cB;
        if constexpr (Sched::GATHER) { if (has_next) { PG8_GOFF(nxt, vAn); } else {
#pragma unroll
            for (int h = 0; h < 2; ++h)
#pragma unroll
                for (int i = 0; i < 2; ++i) vAn[h][i] = vAc[h][i]; } }
#pragma nounroll
        for (int t = 0; t < nt; t += 2) {
            const bool last = (t == nt - 2);
            if constexpr (Epi::MID_T >= 0) { if (t == Epi::MID_T) { int l3 = lane; asm volatile("" : "+v"(l3)); E.mid(acc, cur, wr, wc, l3 & 15, l3 >> 4); } }
            const char* a1 = cA + (size_t)(t + 1) * kstep;
            const char* a2 = last ? nA : cA + (size_t)(t + 2) * kstep; const char* b2 = last ? nB : cB + (size_t)(t + 2) * kstep;
            const char* a3 = a2 + kstep; const char* b3 = b2 + kstep;
            PG8_LDB(B0, 0, 0); PG8_LDB(B1, 0, 1); PG8_SCHED; PG8_LDA(At, 0, 0); PG8_STAGE_A(PG8_SA(1, 1), a1, 1, false);
            PG8_WAIT_V(8); PG8_WAIT_L(0); PG8_BAR; PG8_MMA(0, 0, At, B0); PG8_MMA(0, 1, At, B1); PG8_BAR; PG8_SCHED;
            PG8_LDA(At, 0, 1); PG8_STAGE(PG8_SB(0, 0), b2, voffB); PG8_STAGE(PG8_SB(0, 1), b2 + hstepB, voffB); PG8_STAGE_A(PG8_SA(0, 0), a2, 0, last);
            PG8_WAIT_V(8); PG8_WAIT_L(0); PG8_BAR; PG8_MMA(1, 0, At, B0); PG8_MMA(1, 1, At, B1); PG8_BAR; PG8_SCHED;
            PG8_LDB(B0, 1, 0); PG8_LDB(B1, 1, 1); PG8_SCHED; PG8_LDA(At, 1, 0); PG8_STAGE_A(PG8_SA(0, 1), a2, 1, last);
            PG8_WAIT_V(8); PG8_WAIT_L(0); PG8_BAR; PG8_MMA(0, 0, At, B0); PG8_MMA(0, 1, At, B1); PG8_BAR; PG8_SCHED;
            PG8_LDA(At, 1, 1); PG8_STAGE(PG8_SB(1, 0), b3, voffB); PG8_STAGE(PG8_SB(1, 1), b3 + hstepB, voffB); PG8_STAGE_A(PG8_SA(1, 0), a3, 0, last);
            PG8_WAIT_V(8); PG8_WAIT_L(0); PG8_BAR; PG8_MMA(1, 0, At, B0); PG8_MMA(1, 1, At, B1); PG8_BAR; PG8_SCHED;
        }
        if constexpr (ALIGN_EPI) { if (wr == 0) PG8_BAR; }
        if constexpr (FP8) asm volatile("s_nop 15\n\ts_nop 15" ::: "memory");
        if constexpr (!Epi::AFTER_DRAIN) { int l2 = lane; asm volatile("" : "+v"(l2));
            E(acc, cur, wr, wc, l2 & 15, l2 >> 4); }
        if (!has_next) break;
#pragma unroll
        for (int a = 0; a < 2; ++a)
#pragma unroll
            for (int b = 0; b < 2; ++b)
#pragma unroll
                for (int m = 0; m < 4; ++m)
#pragma unroll
                    for (int n = 0; n < 2; ++n) acc[a][b][m][n] = (f32x4){0.f, 0.f, 0.f, 0.f};
        cur = nxt; cA = nA; cB = nB; ++ui;
        if constexpr (Sched::GATHER) {
#pragma unroll
            for (int h = 0; h < 2; ++h)
#pragma unroll
                for (int i = 0; i < 2; ++i) vAc[h][i] = vAn[h][i]; }
        if constexpr (ALIGN_EPI) { if (wr == 1) PG8_BAR; }
    }
    PG8_WAIT_V(0);
    if constexpr (!ALIGN_EPI) { if (wr == 0) PG8_BAR; }
    PG8_BAR;
    if constexpr (Epi::AFTER_DRAIN) { E.fused(acc, cur, wr, wc, fr, fq, lds, wid, lane); }
#undef PG8_SA
#undef PG8_SB
#undef PG8_STAGE
#undef PG8_STAGE_A
#undef PG8_GOFF
#undef PG8_LDA
#undef PG8_LDB
#undef PG8_MMA
#undef PG8_WAIT_V
#undef PG8_WAIT_L
#undef PG8_BAR
#undef PG8_SCHED
}

#define EPI_LOOP_AI_M for (int ai = 0; ai < 2; ++ai) _Pragma("unroll") for (int m = 0; m < 4; ++m)

struct EpiF32 {
    static constexpr bool PERM = false, AFTER_DRAIN = false; static constexpr int MID_T = -1;
    float* C; int ldc; const float* bias; int bstride; const float* res; float alpha;
    __device__ __forceinline__ void operator()(const f32x4 (&acc)[2][2][4][2], const Unit& u, int wr, int wc, int fr, int fq) const {
        const int row0 = u.orow + wr * 64 + fr, col0 = u.ocol + wc * 32 + 4 * fq;
        f32x4 bv[2][2];
#pragma unroll
        for (int bj = 0; bj < 2; ++bj)
#pragma unroll
            for (int n = 0; n < 2; ++n) bv[bj][n] = bias ? *(const f32x4*)(bias + (size_t)u.aux * bstride + col0 + bj * HALF + n * 16) : (f32x4){0.f, 0.f, 0.f, 0.f};
#pragma unroll
        EPI_LOOP_AI_M { const size_t off = (size_t)(row0 + ai * HALF + m * 16) * ldc + col0;
#pragma unroll
            for (int bj = 0; bj < 2; ++bj)
#pragma unroll
                for (int n = 0; n < 2; ++n) { f32x4 v = acc[ai][bj][m][n] + bv[bj][n];
                    if (res) { const f32x4 rv = *(const f32x4*)(res + off + bj * HALF + n * 16); v = v + rv * alpha; }
                    *(f32x4*)(C + off + bj * HALF + n * 16) = v; }
            asm volatile("" ::: "memory"); }
    }
};
struct EpiBf16 {
    static constexpr bool PERM = true, AFTER_DRAIN = false; static constexpr int MID_T = -1;
    bf16_t* O; int ldc; float scale;
    __device__ __forceinline__ void operator()(const f32x4 (&acc)[2][2][4][2], const Unit& u, int wr, int wc, int fr, int fq) const {
        const int row0 = u.orow + wr * 64 + fr, col0 = u.ocol + wc * 32 + 8 * fq;
#pragma unroll
        EPI_LOOP_AI_M { bf16_t* rowp = O + (size_t)(row0 + ai * HALF + m * 16) * ldc + col0;
#pragma unroll
            for (int bj = 0; bj < 2; ++bj) { const f32x4 v0 = acc[ai][bj][m][0] * scale, v1 = acc[ai][bj][m][1] * scale;
                u32x4 w; w.x = cvt_pk_bf16(v0[0], v0[1]); w.y = cvt_pk_bf16(v0[2], v0[3]); w.z = cvt_pk_bf16(v1[0], v1[1]); w.w = cvt_pk_bf16(v1[2], v1[3]);
                *(u32x4*)(rowp + bj * HALF) = w; } }
    }
};
struct EpiBf16Bias {
    static constexpr bool PERM = true, AFTER_DRAIN = false; static constexpr int MID_T = -1;
    bf16_t* O; int ldc; const float* bias; int bstride;
    __device__ __forceinline__ void operator()(const f32x4 (&acc)[2][2][4][2], const Unit& u, int wr, int wc, int fr, int fq) const {
        const int row0 = u.orow + wr * 64 + fr, col0 = u.ocol + wc * 32 + 8 * fq;
        f32x4 bv[2][2];
#pragma unroll
        for (int bj = 0; bj < 2; ++bj)
#pragma unroll
            for (int n = 0; n < 2; ++n) bv[bj][n] = *(const f32x4*)(bias + (size_t)u.aux * bstride + col0 + bj * HALF + 4 * n);
#pragma unroll
        EPI_LOOP_AI_M { bf16_t* rowp = O + (size_t)(row0 + ai * HALF + m * 16) * ldc + col0;
#pragma unroll
            for (int bj = 0; bj < 2; ++bj) { const f32x4 v0 = acc[ai][bj][m][0] + bv[bj][0], v1 = acc[ai][bj][m][1] + bv[bj][1];
                u32x4 w; w.x = cvt_pk_bf16(v0[0], v0[1]); w.y = cvt_pk_bf16(v0[2], v0[3]); w.z = cvt_pk_bf16(v1[0], v1[1]); w.w = cvt_pk_bf16(v1[2], v1[3]);
                *(u32x4*)(rowp + bj * HALF) = w; } }
    }
};
struct EpiKV {
    static constexpr bool PERM = true, AFTER_DRAIN = false; static constexpr int MID_T = -1;
    bf16_t* KB; bf16_t* VT;
    __device__ __forceinline__ void operator()(const f32x4 (&acc)[2][2][4][2], const Unit& u, int wr, int wc, int fr, int fq) const {
        const int row0 = u.orow + wr * 64 + fr, col0 = u.ocol + wc * 32 + 8 * fq;
#pragma unroll
        EPI_LOOP_AI_M { const int row = row0 + ai * HALF + m * 16;
#pragma unroll
            for (int bj = 0; bj < 2; ++bj) { const f32x4 v0 = acc[ai][bj][m][0], v1 = acc[ai][bj][m][1]; const int col = col0 + bj * HALF;
                if (u.ocol < 2048) { u32x4 w; w.x = cvt_pk_bf16(v0[0], v0[1]); w.y = cvt_pk_bf16(v0[2], v0[3]); w.z = cvt_pk_bf16(v1[0], v1[1]); w.w = cvt_pk_bf16(v1[2], v1[3]);
                    *(u32x4*)(KB + (size_t)row * 2048 + col) = w; }
                else { const int b = row >> 8, key = row & 255, c = col - 2048, h = c >> 9, d = c & 511; bf16_t* p = VT + ((size_t)((b * 4 + h) * 512 + d)) * 256 + key;
#pragma unroll
                    for (int j = 0; j < 4; ++j) { p[(size_t)j * 256] = (bf16_t)f2bf(v0[j]); p[(size_t)(4 + j) * 256] = (bf16_t)f2bf(v1[j]); } } } }
    }
};
struct EpiDecay {
    static constexpr bool PERM = false, AFTER_DRAIN = false; static constexpr int MID_T = -1;
    float* DEC; const float* w0;
    __device__ __forceinline__ void operator()(const f32x4 (&acc)[2][2][4][2], const Unit& u, int wr, int wc, int fr, int fq) const {
        const int row0 = u.orow + wr * 64 + fr, col0 = u.ocol + wc * 32 + 4 * fq;
        f32x4 bv[2][2];
#pragma unroll
        for (int bj = 0; bj < 2; ++bj)
#pragma unroll
            for (int n = 0; n < 2; ++n) bv[bj][n] = *(const f32x4*)(w0 + col0 + bj * HALF + n * 16);
#pragma unroll
        EPI_LOOP_AI_M { const size_t off = (size_t)(row0 + ai * HALF + m * 16) * D + col0;
#pragma unroll
            for (int bj = 0; bj < 2; ++bj)
#pragma unroll
                for (int n = 0; n < 2; ++n) { const f32x4 x = acc[ai][bj][m][n] + bv[bj][n]; f32x4 o;
#pragma unroll
                    for (int j = 0; j < 4; ++j) o[j] = __expf(-0.6065306597126334f * sigmoidf_(x[j]));
                    *(f32x4*)(DEC + off + bj * HALF + n * 16) = o; } }
    }
};
struct EpiIclr {
    static constexpr bool PERM = true, AFTER_DRAIN = false; static constexpr int MID_T = -1;
    const float* a0; const float* k_k; const float* k_a; const bf16_t* KZ; const float* KNORM; bf16_t* KP; bf16_t* AN; bf16_t* BB;
    __device__ __forceinline__ void operator()(const f32x4 (&acc)[2][2][4][2], const Unit& u, int wr, int wc, int fr, int fq) const {
        const int row0 = u.orow + wr * 64 + fr, col0 = u.ocol + wc * 32 + 8 * fq;
#pragma unroll
        for (int bj = 0; bj < 2; ++bj) { const int col = col0 + bj * HALF;
            const f32x4 a00 = *(const f32x4*)(a0 + col), a01 = *(const f32x4*)(a0 + col + 4), kk0 = *(const f32x4*)(k_k + col), kk1 = *(const f32x4*)(k_k + col + 4), ka0 = *(const f32x4*)(k_a + col), ka1 = *(const f32x4*)(k_a + col + 4);
#pragma unroll
            EPI_LOOP_AI_M { const int row = row0 + ai * HALF + m * 16; const size_t off = (size_t)row * D + col;
                const u32x4 kzw = *(const u32x4*)(KZ + off); const float nr = KNORM[(size_t)row * 32 + (col >> 6)]; const float inv = 1.0f / fmaxf(nr, 1e-12f);
                const unsigned kw[4] = {kzw.x, kzw.y, kzw.z, kzw.w};
                float kp[8], an[8], bb[8];
#pragma unroll
                for (int j = 0; j < 8; ++j) { const float kz = bf2f((kw[j >> 1] >> (16 * (j & 1))) & 0xffffu);
                    const float x = (j < 4 ? acc[ai][bj][m][0][j & 3] + a00[j & 3] : acc[ai][bj][m][1][j & 3] + a01[j & 3]);
                    const float kkc = j < 4 ? kk0[j & 3] : kk1[j & 3], kac = j < 4 ? ka0[j & 3] : ka1[j & 3];
                    const float a = sigmoidf_(x); const float kk = kz * kkc * inv; kp[j] = kz * (1.0f + (a - 1.0f) * kac); bb[j] = kk * a; an[j] = -kk; }
                *(u32x4*)(KP + off) = (u32x4){cvt_pk_bf16(kp[0], kp[1]), cvt_pk_bf16(kp[2], kp[3]), cvt_pk_bf16(kp[4], kp[5]), cvt_pk_bf16(kp[6], kp[7])};
                *(u32x4*)(AN + off) = (u32x4){cvt_pk_bf16(an[0], an[1]), cvt_pk_bf16(an[2], an[3]), cvt_pk_bf16(an[4], an[5]), cvt_pk_bf16(an[6], an[7])};
                *(u32x4*)(BB + off) = (u32x4){cvt_pk_bf16(bb[0], bb[1]), cvt_pk_bf16(bb[2], bb[3]), cvt_pk_bf16(bb[4], bb[5]), cvt_pk_bf16(bb[6], bb[7])}; }
            asm volatile("" ::: "memory"); }
    }
};
struct EpiGateFused {
    static constexpr bool PERM = true, AFTER_DRAIN = false; static constexpr int MID_T = 32;
    const bf16_t* PROJ; bf16_t* MERGED;
    __device__ __forceinline__ void mid(f32x4 (&acc)[2][2][4][2], const Unit& u, int wr, int wc, int fr, int fq) const {
        const int row0 = u.orow + wr * 64 + fr, col0 = u.ocol + wc * 32 + 8 * fq;
#pragma unroll
        EPI_LOOP_AI_M { const int row = row0 + ai * HALF + m * 16;
#pragma unroll
            for (int bj = 0; bj < 2; ++bj) { const int col = col0 + bj * HALF;
                const u32x4 g1v = *(const u32x4*)(PROJ + (size_t)row * PC + GATE0 + col), g2v = *(const u32x4*)(PROJ + (size_t)row * PC + GATE0 + 2048 + col);
                const unsigned w1[4] = {g1v.x, g1v.y, g1v.z, g1v.w}, w2[4] = {g2v.x, g2v.y, g2v.z, g2v.w};
#pragma unroll
                for (int j = 0; j < 8; ++j) { const float x1 = bf2f((w1[j >> 1] >> (16 * (j & 1))) & 0xffffu), x2 = fmaxf(bf2f((w2[j >> 1] >> (16 * (j & 1))) & 0xffffu), -60.0f);
                    const float ratio = (1.0f + __expf(-x2)) / (1.0f + __expf(-x1));
                    if (j < 4) acc[ai][bj][m][0][j & 3] *= ratio; else acc[ai][bj][m][1][j & 3] *= ratio; } }
            asm volatile("" ::: "memory"); }
    }
    __device__ __forceinline__ void operator()(const f32x4 (&acc)[2][2][4][2], const Unit& u, int wr, int wc, int fr, int fq) const {
        const int row0 = u.orow + wr * 64 + fr, col0 = u.ocol + wc * 32 + 8 * fq;
#pragma unroll
        EPI_LOOP_AI_M { const int row = row0 + ai * HALF + m * 16;
#pragma unroll
            for (int bj = 0; bj < 2; ++bj) { const int col = col0 + bj * HALF; const u32x4 gv = *(const u32x4*)(PROJ + (size_t)row * PC + GATE0 + 2048 + col);
                const unsigned w2[4] = {gv.x, gv.y, gv.z, gv.w}; float o[8];
#pragma unroll
                for (int j = 0; j < 8; ++j) { const float x2 = fmaxf(bf2f((w2[j >> 1] >> (16 * (j & 1))) & 0xffffu), -60.0f); o[j] = (j < 4 ? acc[ai][bj][m][0][j & 3] : acc[ai][bj][m][1][j & 3]) * sigmoidf_(x2); }
                u32x4 w; w.x = cvt_pk_bf16(o[0], o[1]); w.y = cvt_pk_bf16(o[2], o[3]); w.z = cvt_pk_bf16(o[4], o[5]); w.w = cvt_pk_bf16(o[6], o[7]);
                *(u32x4*)(MERGED + (size_t)row * D + col) = w; }
            asm volatile("" ::: "memory"); }
    }
};
struct EpiSwiglu {
    static constexpr bool PERM = true, AFTER_DRAIN = false; static constexpr int MID_T = -1;
    const float* b1; bf16_t* H;
    __device__ __forceinline__ float sw(float g, float l) const { g = fminf(g, 7.0f); l = fminf(fmaxf(l, -7.0f), 7.0f); return g * sigmoidf_(1.702f * g) * (l + 1.0f); }
    __device__ __forceinline__ void operator()(const f32x4 (&acc)[2][2][4][2], const Unit& u, int wr, int wc, int fr, int fq) const {
        const int row0 = u.orow + wr * 64 + fr, col0 = u.ocol + wc * 32 + 8 * fq;
        f32x4 bv[2][2];
#pragma unroll
        for (int bj = 0; bj < 2; ++bj)
#pragma unroll
            for (int n = 0; n < 2; ++n) bv[bj][n] = *(const f32x4*)(b1 + (size_t)u.aux * 4096 + col0 + bj * HALF + 4 * n);
#pragma unroll
        EPI_LOOP_AI_M { const int row = row0 + ai * HALF + m * 16;
#pragma unroll
            for (int bj = 0; bj < 2; ++bj) { const f32x4 v0 = acc[ai][bj][m][0] + bv[bj][0], v1 = acc[ai][bj][m][1] + bv[bj][1];
                *(unsigned*)((unsigned char*)H + (size_t)row * DFF + ((col0 + bj * HALF) >> 1)) = pk4_fp8(sw(v0[0], v0[1]), sw(v0[2], v0[3]), sw(v1[0], v1[1]), sw(v1[2], v1[3])); } }
    }
};
struct EpiSoftmax {
    static constexpr bool PERM = true, AFTER_DRAIN = true; static constexpr int MID_T = -1;
    bf16_t* PP;
    __device__ __forceinline__ void fused(f32x4 (&acc)[2][2][4][2], const Unit& u, int wr, int wc, int fr, int fq, PG8_LAS unsigned char* lds, int wid, int lane) const {
        PG8_LAS float* P1 = (PG8_LAS float*)lds;
        PG8_LAS float* P2 = (PG8_LAS float*)(lds + 4096);
        float mx[2][4];
#pragma unroll
        EPI_LOOP_AI_M { float v = -3.0e38f;
#pragma unroll
            for (int bj = 0; bj < 2; ++bj)
#pragma unroll
                for (int n = 0; n < 2; ++n) { const f32x4 x = acc[ai][bj][m][n]; v = fmaxf(v, fmaxf(fmaxf(x[0], x[1]), fmaxf(x[2], x[3]))); }
            v = fmaxf(v, __shfl_xor(v, 16)); v = fmaxf(v, __shfl_xor(v, 32));
            if (fq == 0) P1[(ai * HALF + wr * 64 + m * 16 + fr) * 4 + wc] = v; }
        asm volatile("s_waitcnt lgkmcnt(0)" ::: "memory"); __builtin_amdgcn_s_barrier(); asm volatile("" ::: "memory");
#pragma unroll
        EPI_LOOP_AI_M { const f32x4 t = *(const PG8_LAS f32x4*)(P1 + (ai * HALF + wr * 64 + m * 16 + fr) * 4); mx[ai][m] = fmaxf(fmaxf(t[0], t[1]), fmaxf(t[2], t[3])); }
#pragma unroll
        EPI_LOOP_AI_M { float s = 0.f;
#pragma unroll
            for (int bj = 0; bj < 2; ++bj)
#pragma unroll
                for (int n = 0; n < 2; ++n) { f32x4 x = acc[ai][bj][m][n];
#pragma unroll
                    for (int j = 0; j < 4; ++j) { x[j] = __expf(x[j] - mx[ai][m]); s += x[j]; }
                    acc[ai][bj][m][n] = x; }
            s += __shfl_xor(s, 16); s += __shfl_xor(s, 32);
            if (fq == 0) P2[(ai * HALF + wr * 64 + m * 16 + fr) * 4 + wc] = s; }
        asm volatile("s_waitcnt lgkmcnt(0)" ::: "memory"); __builtin_amdgcn_s_barrier(); asm volatile("" ::: "memory");
        const int row0 = u.orow + wr * 64 + fr, col0 = wc * 32 + 8 * fq;
#pragma unroll
        EPI_LOOP_AI_M { const f32x4 t = *(const PG8_LAS f32x4*)(P2 + (ai * HALF + wr * 64 + m * 16 + fr) * 4); const float inv = 1.0f / ((t[0] + t[1]) + (t[2] + t[3]));
            bf16_t* rowp = PP + (size_t)(row0 + ai * HALF + m * 16) * 256 + col0;
#pragma unroll
            for (int bj = 0; bj < 2; ++bj) { const f32x4 v0 = acc[ai][bj][m][0] * inv, v1 = acc[ai][bj][m][1] * inv;
                u32x4 w; w.x = cvt_pk_bf16(v0[0], v0[1]); w.y = cvt_pk_bf16(v0[2], v0[3]); w.z = cvt_pk_bf16(v1[0], v1[1]); w.w = cvt_pk_bf16(v1[2], v1[3]);
                *(u32x4*)(rowp + bj * HALF) = w; } }
        asm volatile("s_waitcnt lgkmcnt(0)" ::: "memory"); __builtin_amdgcn_s_barrier(); asm volatile("" ::: "memory");
    }
};
}

constexpr size_t MiB = 1u << 20;
constexpr size_t al256(size_t x) { return (x + 255) & ~(size_t)255; }
constexpr size_t WS_CTL = 0, CTL_ZERO_BYTES = 1 * MiB;
constexpr size_t WS_WIN = 1 * MiB;
constexpr size_t WS_WUP = WS_WIN + (size_t)PC * D * 2;
constexpr size_t WS_AUP = WS_WUP + (size_t)D * 256 * 2;
constexpr size_t WS_GUP = WS_AUP + (size_t)D * 256 * 2;
constexpr size_t WS_PA = WS_GUP + (size_t)D * 256 * 2;
constexpr size_t WS_PB = WS_PA + (size_t)D * D * 2;
constexpr size_t WS_WOUT = WS_PB + (size_t)D * 512 * 2;
constexpr size_t WS_WQ = WS_WOUT + (size_t)D * D * 2;
constexpr size_t WS_WKV = WS_WQ + (size_t)D * D * 2;
constexpr size_t WS_WO = WS_WKV + (size_t)2 * D * D * 2;
constexpr size_t WS_W1 = WS_WO + (size_t)D * D * 2;
constexpr size_t WS_W2 = WS_W1 + (size_t)NEXP * 4096 * D * 2;
constexpr size_t WS_XB = WS_W2 + (size_t)NEXP * D * DFF * 2;
constexpr size_t WS_MEMB = WS_XB + (size_t)M * D * 2;
constexpr size_t WS_ROT = WS_MEMB + (size_t)1024 * D * 2;
constexpr size_t WS_KB = WS_ROT + (size_t)2 * SEQ * 32 * 4;
constexpr size_t WS_VT = WS_KB + (size_t)1024 * D * 2;
constexpr size_t WS_YA = WS_VT + (size_t)1024 * D * 2;
constexpr size_t WS_YB = WS_YA + (size_t)M * D * 2;
constexpr size_t WS_TMP = WS_YB + (size_t)M * 512 * 2;
constexpr size_t WS_MERGED = WS_TMP + (size_t)M * D * 4;
constexpr size_t WS_E = WS_MERGED + (size_t)M * D * 2;
constexpr size_t WS_PROJ = WS_E;
constexpr size_t WS_RZ = WS_PROJ + (size_t)M * PC * 2;
constexpr size_t WS_KZ = WS_RZ + (size_t)M * D * 4;
constexpr size_t WS_VZ = WS_KZ + (size_t)M * D * 4;
constexpr size_t WS_DEC = WS_VZ + (size_t)M * D * 4;
constexpr size_t WS_KP = WS_DEC + (size_t)M * D * 4;
constexpr size_t WS_AN = WS_KP + (size_t)M * D * 4;
constexpr size_t WS_BB = WS_AN + (size_t)M * D * 4;
constexpr size_t WS_GG = WS_BB + (size_t)M * D * 4;
constexpr size_t WS_YS = WS_GG + (size_t)M * D * 4;
constexpr size_t WS_XQ = WS_YS + 60 * MiB;
constexpr size_t WS_WIN8 = WS_YS + 96 * MiB;
constexpr size_t WS_VR = WS_YS + 4 * MiB;
constexpr size_t WS_AO = WS_YS + (size_t)M * D * 4;
constexpr size_t WS_LSE = WS_AO + (size_t)3 * M * 512 * 4;
constexpr size_t WS_QR = WS_LSE + (size_t)3 * M * 8 * 4;
constexpr size_t WS_KR = WS_QR + (size_t)M * 1536 * 2;
constexpr size_t WS_LIN = WS_KR + (size_t)M * 1536 * 2;
constexpr size_t WS_KNORM = WS_LIN + (size_t)M * 768 * 2;
constexpr size_t WS_F = WS_KNORM + (size_t)M * 32 * 4;
constexpr size_t WS_E_END = WS_F + (size_t)128 * 128 * 96 * 96 * 2;
constexpr size_t WS_T1 = WS_E;
constexpr size_t WS_X1 = WS_T1 + (size_t)M * D * 4;
constexpr size_t WS_X1B = WS_X1 + (size_t)M * D * 4;
constexpr size_t WS_Q = WS_X1B + (size_t)M * D * 2;
constexpr size_t WS_PP = WS_Q + (size_t)M * D * 2;
constexpr size_t WS_OC = WS_PP + (size_t)16 * SEQ * 256 * 2;
constexpr size_t WS_T2 = WS_OC + (size_t)M * D * 2;
constexpr size_t WS_X2 = WS_T2 + (size_t)M * D * 4;
constexpr size_t WS_X2B = WS_X2 + (size_t)M * D * 4;
constexpr size_t WS_LIST = WS_X2B + (size_t)M * D * 2;
constexpr size_t WS_ROWI = WS_LIST + (size_t)NEXP * CAP * 4;
constexpr size_t WS_TOPW = WS_ROWI + (size_t)M * 4 * 4;
constexpr size_t WS_H = WS_TOPW + (size_t)M * 4 * 4;
constexpr size_t WS_Y = WS_H + (size_t)HROWS * DFF * 2;
constexpr size_t WS_L_END = WS_Y + (size_t)HROWS * D * 4;
constexpr size_t WS_END = (WS_E_END > WS_L_END ? WS_E_END : WS_L_END);
static_assert(WS_END <= (size_t)4090 * MiB, "workspace map exceeds 4 x largest input");
constexpr int CW_TMO = 0, CW_CNT = 64  , CW_Q = 128  , CW_BAR = 4096;

constexpr int RING_BYTES = 131072, MISC_OFF = RING_BYTES, LDS_BYTES = 147456;

#define XB_TMO      128
#define XB_XCNT(j)  (256  + 64 * (j))
#define XB_XSUB(j)  (1280 + 64 * (j))
#define XB_XGEN(j)  (2304 + 64 * (j))
#define XB_TOP      3328
#define XB_TOPGEN   3392
#define XCD_BAR_WORDS 3456
#define XB_SPIN_CAP (1u << 18)
__device__ __forceinline__ unsigned xb_ld(unsigned* p)              { return __hip_atomic_load(p, __ATOMIC_RELAXED, __HIP_MEMORY_SCOPE_AGENT); }
__device__ __forceinline__ unsigned xb_add(unsigned* p, unsigned v) { return __hip_atomic_fetch_add(p, v, __ATOMIC_RELAXED, __HIP_MEMORY_SCOPE_AGENT); }
__device__ __forceinline__ unsigned xb_xcc_id() { return (unsigned)__builtin_amdgcn_s_getreg((3 << 11) | 20) & 0xFu; }
#define XB_SPIN(cond, bar) do { unsigned _sp = 0; while (cond) { __builtin_amdgcn_s_sleep(1); \
    if ((++_sp & 255u) == 0u) { if (xb_ld(&(bar)[XB_TMO])) break; if (_sp > XB_SPIN_CAP) { atomicAdd(&(bar)[XB_TMO], 1u); break; } } } } while (0)
struct XcdBarrier { unsigned* bar; unsigned x; volatile LAS unsigned* st; };
__device__ __forceinline__ XcdBarrier xcd_barrier_post(unsigned* bar, volatile LAS unsigned* st) {
    XcdBarrier b; b.bar = bar; b.x = xb_xcc_id(); b.st = st;
    if (threadIdx.x == 0) (void)xb_add(&bar[XB_XCNT(b.x)], 1u);
    return b;
}
__device__ __forceinline__ void xcd_barrier_complete(unsigned* bar, unsigned x, unsigned& nloc, unsigned& nx) {
    const unsigned G = gridDim.x * gridDim.y * gridDim.z;
    unsigned sum, cnt, mine, sp = 0u;
    for (;;) {
        sum = 0u; cnt = 0u; mine = 0u;
#pragma unroll
        for (unsigned j = 0; j < 16; ++j) { const unsigned c = xb_ld(&bar[XB_XCNT(j)]); sum += c; cnt += (c > 0u) ? 1u : 0u; mine = (j == x) ? c : mine; }
        if (sum == G) break;
        __builtin_amdgcn_s_sleep(1);
        if ((++sp & 255u) == 0u) { if (xb_ld(&bar[XB_TMO])) break; if (sp > XB_SPIN_CAP) { atomicAdd(&bar[XB_TMO], 1u); break; } }
    }
    nloc = mine > 0u ? mine : 1u; nx = cnt > 0u ? cnt : 1u;
}
__device__ __forceinline__ void xcd_barrier(const XcdBarrier& b) {
    asm volatile("s_waitcnt vmcnt(0)" ::: "memory");
    __syncthreads();
    if (threadIdx.x == 0) {
        unsigned* bar = b.bar;
        __builtin_amdgcn_s_waitcnt(0);
        unsigned nloc = b.st[0], nx = b.st[1];
        if (nloc == 0u) { xcd_barrier_complete(bar, b.x, nloc, nx); b.st[0] = nloc; b.st[1] = nx; }
        const unsigned old = xb_add(&bar[XB_XSUB(b.x)], 1u);
        const unsigned gen = old / nloc;
        if (old + 1u == (gen + 1u) * nloc) {
            __builtin_amdgcn_fence(__ATOMIC_RELEASE, "agent");
            asm volatile("s_waitcnt vmcnt(0)" ::: "memory");
            const unsigned og = xb_add(&bar[XB_TOP], 1u);
            const unsigned tg = og / nx;
            if (og + 1u == (tg + 1u) * nx) xb_add(&bar[XB_TOPGEN], 1u);
            else XB_SPIN(xb_ld(&bar[XB_TOPGEN]) == tg, bar);
            __builtin_amdgcn_fence(__ATOMIC_ACQUIRE, "agent");
            xb_add(&bar[XB_XGEN(b.x)], 1u);
            asm volatile("s_waitcnt vmcnt(0)" ::: "memory");
        } else {
            XB_SPIN(xb_ld(&bar[XB_XGEN(b.x)]) == gen, bar);
            __builtin_amdgcn_fence(__ATOMIC_ACQUIRE, "agent");
            asm volatile("s_waitcnt vmcnt(0)" ::: "memory");
        }
    }
    __syncthreads();
}

struct Params {
    const float* in[32];
    float* out; unsigned char* ws;
    int ph_lo, ph_hi, li, pad;
};
enum { I_X = 0, I_MEM, I_WIN, I_MIX, I_W0, I_WUP, I_A0, I_AUP, I_GUP, I_KK, I_KA, I_RK, I_LNXG, I_LNXB, I_PA, I_PB, I_WOUT, I_LN1G, I_LN1B, I_WQ, I_WKV, I_WO, I_LN2G, I_LN2B,
       I_RW, I_RB, I_W1, I_B1, I_W2, I_B2, I_LN3G, I_LN3B };

struct ScoreOrder {
    static constexpr bool GATHER = false;
    const char* Q; const char* KB; int G, c;
    __device__ bool next(int i, pg8::Unit& u) const {
        const int L = i * G + c; if (L >= 256) return false;
        const int bh = L >> 4, pm = L & 15, b = bh >> 2, h = bh & 3;
        u.A = Q + ((size_t)(b * SEQ + 256 * pm) * D + h * 512) * 2; u.B = KB + ((size_t)(b * 256) * D + h * 512) * 2;
        u.orow = bh * SEQ + 256 * pm; u.ocol = 0; u.aux = 0; u.aux2 = 0; u.valid = 256; return true;
    }
    __device__ __forceinline__ const int* rows(const pg8::Unit&) const { return nullptr; }
};
struct PvOrder {
    static constexpr bool GATHER = false;
    const char* PP; const char* VT; int G, c;
    __device__ bool next(int i, pg8::Unit& u) const {
        const int L = i * G + c; if (L >= 512) return false;
        const int bh = L >> 5, pm = (L >> 1) & 15, pn = L & 1, b = bh >> 2, h = bh & 3;
        u.A = PP + ((size_t)(bh * SEQ + 256 * pm) * 256) * 2; u.B = VT + ((size_t)(bh * 512 + 256 * pn) * 256) * 2;
        u.orow = b * SEQ + 256 * pm; u.ocol = h * 512 + 256 * pn; u.aux = 0; u.aux2 = 0; u.valid = 256; return true;
    }
    __device__ __forceinline__ const int* rows(const pg8::Unit&) const { return nullptr; }
};
template <bool GATHER_, int NT  > struct MoeOrder {
    static constexpr bool GATHER = GATHER_;
    const LAS int* tab; const char* A; const char* W; const int* list; size_t wexp  ; int ldb; int G, c;
    __device__ bool next(int i, pg8::Unit& u) const {
        constexpr int RPR = 256 / NT;
        const int rt = i * RPR + (c % RPR), pn = c / RPR, T = __builtin_amdgcn_readfirstlane(tab[64]);
        if (c >= 256 || rt >= T) return false;
        int e = 0;
        for (int j = 1; j < NEXP; ++j) e = (rt >= __builtin_amdgcn_readfirstlane(tab[32 + j])) ? j : e;
        const int lt = rt - __builtin_amdgcn_readfirstlane(tab[32 + e]), cnt = __builtin_amdgcn_readfirstlane(tab[e]);
        u.aux = e; u.aux2 = lt; u.valid = min(256, cnt - 256 * lt); u.orow = 256 * rt; u.ocol = 256 * pn;
        u.B = W + (size_t)e * wexp + (size_t)(256 * pn) * ldb;
        u.A = GATHER_ ? A : A + (size_t)(256 * rt) * DFF;
        return true;
    }
    __device__ __forceinline__ const int* rows(const pg8::Unit& u) const { return list + (size_t)u.aux * CAP + 256 * u.aux2; }
};

struct Ctx { int tid, lane, wave, vcu, G; LAS unsigned char* lds; unsigned char* ws; };

__device__ __forceinline__ void cv_issue(const float* W, int ldw, int Ksrc, int sc0, int k0, int lane, float (&cv)[32]) {
    const int kb = k0 + 32 * (lane >> 5); const bool ok = sc0 >= 0 && kb < Ksrc;
    const float* src = W + (ok ? (size_t)kb * ldw + sc0 + (lane & 31) : (size_t)0);
#pragma unroll
    for (int i = 0; i < 32; ++i) { const float v = src[(size_t)i * ldw]; cv[i] = ok ? v : 0.f; }
}
__device__ __forceinline__ void cv_store16(const float (&cv)[32], bf16_t* WT, int ldt, int n0, int k0, int lane) {
    u32x4* dst = (u32x4*)(WT + (size_t)(n0 + (lane & 31)) * ldt + k0 + 32 * (lane >> 5));
#pragma unroll
    for (int j = 0; j < 4; ++j) dst[j] = (u32x4){pk2(cv[8 * j], cv[8 * j + 1]), pk2(cv[8 * j + 2], cv[8 * j + 3]), pk2(cv[8 * j + 4], cv[8 * j + 5]), pk2(cv[8 * j + 6], cv[8 * j + 7])};
}
__device__ __forceinline__ void cv_store8(const float (&cv)[32], unsigned char* WT8, int ldt, int n0, int k0, int lane) {
    u32x4* dst = (u32x4*)(WT8 + (size_t)(n0 + (lane & 31)) * ldt + k0 + 32 * (lane >> 5));
#pragma unroll
    for (int j = 0; j < 2; ++j) dst[j] = (u32x4){pk4_fp8(cv[16 * j] * 64.f, cv[16 * j + 1] * 64.f, cv[16 * j + 2] * 64.f, cv[16 * j + 3] * 64.f), pk4_fp8(cv[16 * j + 4] * 64.f, cv[16 * j + 5] * 64.f, cv[16 * j + 6] * 64.f, cv[16 * j + 7] * 64.f),
        pk4_fp8(cv[16 * j + 8] * 64.f, cv[16 * j + 9] * 64.f, cv[16 * j + 10] * 64.f, cv[16 * j + 11] * 64.f), pk4_fp8(cv[16 * j + 12] * 64.f, cv[16 * j + 13] * 64.f, cv[16 * j + 14] * 64.f, cv[16 * j + 15] * 64.f)};
}
struct CvJob { const float* W; bf16_t* WT; int ldw, Ksrc, sc0, ldt, n0, k0, f8, kd; };
__device__ __forceinline__ CvJob p0_job(const Params& p, unsigned char* ws, int it) {
    constexpr int I_WINJ = 32 * 480, I_LORA = 4 * 64, I_SQ = 32 * 64, I_PBJ = 8 * 64, I_KVJ = 32 * 128;
    CvJob j; j.f8 = 0; j.kd = 0; int r = it;
#define P0_PLAIN(SRC, DST, N_, KS_, KD_) { const int nblk = (N_) / 32, kb = r / nblk, nb = r % nblk; j.W = p.in[SRC]; j.WT = (bf16_t*)(ws + (DST)); j.ldw = (N_); j.Ksrc = (KS_); j.sc0 = 32 * nb; j.ldt = (KD_); j.n0 = 32 * nb; j.k0 = 64 * kb; return j; }
    if (r < I_WINJ) { const int kb = r / 480, nb = r % 480; j.W = p.in[I_WIN]; j.WT = (bf16_t*)(ws + WS_WIN); j.ldw = 15296; j.Ksrc = D; j.sc0 = nb < 206 ? 32 * nb : (nb < 208 ? -1 : 32 * nb - 64); j.ldt = D; j.n0 = 32 * nb; j.k0 = 64 * kb;
        if (nb >= GATE0 / 32) { j.f8 = 1; j.WT = (bf16_t*)(ws + WS_WIN8); j.n0 = 32 * nb - GATE0; }
        return j; } r -= I_WINJ;
    if (r < I_LORA) P0_PLAIN(I_WUP, WS_WUP, D, 96, 256) r -= I_LORA;
    if (r < I_LORA) P0_PLAIN(I_AUP, WS_AUP, D, 96, 256) r -= I_LORA;
    if (r < I_LORA) P0_PLAIN(I_GUP, WS_GUP, D, 256, 256) r -= I_LORA;
    if (r < I_SQ) P0_PLAIN(I_PA, WS_PA, D, D, 2560) r -= I_SQ;
    if (r < I_PBJ) { const int kb = r / 64, nb = r % 64; j.W = p.in[I_PB]; j.WT = (bf16_t*)(ws + WS_PA); j.ldw = D; j.Ksrc = 512; j.sc0 = 32 * nb; j.ldt = 2560; j.n0 = 32 * nb; j.k0 = 64 * kb; j.kd = 2048; return j; } r -= I_PBJ;
    if (r < I_SQ) P0_PLAIN(I_WOUT, WS_WOUT, D, D, D) r -= I_SQ;
    if (r < I_SQ) P0_PLAIN(I_WQ, WS_WQ, D, D, D) r -= I_SQ;
    if (r < I_KVJ) P0_PLAIN(I_WKV, WS_WKV, 2 * D, D, D) r -= I_KVJ;
    P0_PLAIN(I_WO, WS_WO, D, D, D)
#undef P0_PLAIN
}
__device__ __forceinline__ void p0_prologue(const Params& p, const Ctx& c) {
    const int gw = c.vcu * 8 + c.wave, NGW = c.G * 8;
    unsigned char* ws = c.ws;
    constexpr int NITEMS = 32 * 480 + 3 * (4 * 64) + 4 * (32 * 64) + 8 * 64 + 32 * 128;
    { float ca[32], cb[32]; CvJob ja, jb; int it = gw;
      if (it < NITEMS) { ja = p0_job(p, ws, it); cv_issue(ja.W, ja.ldw, ja.Ksrc, ja.sc0, ja.k0, c.lane, ca); }
      for (; it < NITEMS; it += 2 * NGW) {
          if (it + NGW < NITEMS) { jb = p0_job(p, ws, it + NGW); cv_issue(jb.W, jb.ldw, jb.Ksrc, jb.sc0, jb.k0, c.lane, cb); }
          if (ja.f8) cv_store8(ca, (unsigned char*)ja.WT, ja.ldt, ja.n0, ja.k0, c.lane); else cv_store16(ca, ja.WT, ja.ldt, ja.n0, ja.k0 + ja.kd, c.lane);
          if (it + 2 * NGW < NITEMS) { ja = p0_job(p, ws, it + 2 * NGW); cv_issue(ja.W, ja.ldw, ja.Ksrc, ja.sc0, ja.k0, c.lane, ca); }
          if (it + NGW < NITEMS) { if (jb.f8) cv_store8(cb, (unsigned char*)jb.WT, jb.ldt, jb.n0, jb.k0, c.lane); else cv_store16(cb, jb.WT, jb.ldt, jb.n0, jb.k0 + jb.kd, c.lane); }
      } }
    const size_t gt = (size_t)c.vcu * 512 + c.tid, NT = (size_t)c.G * 512;
    for (size_t i = gt; i < (size_t)M * D / 8; i += NT) { const f32x4 a = ((const f32x4*)p.in[I_X])[2 * i], b = ((const f32x4*)p.in[I_X])[2 * i + 1];
        u32x4 o; o.x = pk2(a[0], a[1]); o.y = pk2(a[2], a[3]); o.z = pk2(b[0], b[1]); o.w = pk2(b[2], b[3]); ((u32x4*)(ws + WS_XB))[i] = o;
        ((u32x2*)(ws + WS_XQ))[i] = (u32x2){pk4_fp8(a[0], a[1], a[2], a[3]), pk4_fp8(b[0], b[1], b[2], b[3])}; }
    for (size_t i = gt; i < (size_t)1024 * D / 8; i += NT) { const f32x4 a = ((const f32x4*)p.in[I_MEM])[2 * i], b = ((const f32x4*)p.in[I_MEM])[2 * i + 1];
        u32x4 o; o.x = pk2(a[0], a[1]); o.y = pk2(a[2], a[3]); o.z = pk2(b[0], b[1]); o.w = pk2(b[2], b[3]); ((u32x4*)(ws + WS_MEMB))[i] = o; }
    float* rc = (float*)(ws + WS_ROT); float* rs = rc + SEQ * 32;
    for (size_t i = gt; i < (size_t)SEQ * 32; i += NT) { const int pos = (int)(i >> 5), j = (int)(i & 31);
        const double inv = exp(-(double)j * (9.210340371976184 / 32.0)); const double ang = (double)pos * inv; rc[i] = (float)cos(ang); rs[i] = (float)sin(ang); }
}

constexpr int MOE_W1E = 32 * 128, MOE_W2E = 32 * 64, MOE_CONV_GROUPS = (NEXP * MOE_W2E) / 8;
__device__ __forceinline__ void conv_group(const Params& p, const Ctx& c, int gi) {
    unsigned char* ws = c.ws;
    const int r = gi * 8 + c.wave;
    const int e = r / MOE_W2E, it = r % MOE_W2E, kb = it >> 6, nb = it & 63;
    float cv[32]; cv_issue(p.in[I_W2] + (size_t)e * DFF * D, D, DFF, 32 * nb, 64 * kb, c.lane, cv);
    cv_store8(cv, ws + WS_W2 + (size_t)e * D * DFF, DFF, 32 * nb, 64 * kb, c.lane);
}

#define DPP_ADD(x, ctrl) ((x) + __builtin_bit_cast(float, __builtin_amdgcn_update_dpp(0, __builtin_bit_cast(int, (x)), (ctrl), 0xF, 0xF, true)))
struct P2Tok { u32x4 cv0, pv0, cv1, pv1, ra, rb, vv; f32x4 c0, c1, s0, s1; };
__device__ __forceinline__ void p2_prep(const Params& p, const Ctx& c) {
    unsigned char* ws = c.ws;
    const bf16_t* PROJ = (const bf16_t*)(ws + WS_PROJ);
    const float* mix = p.in[I_MIX]; const float* k_k = p.in[I_KK];
    bf16_t* RZ = (bf16_t*)(ws + WS_RZ); bf16_t* KZ = (bf16_t*)(ws + WS_KZ); bf16_t* VZ = (bf16_t*)(ws + WS_VZ);
    bf16_t* LIN = (bf16_t*)(ws + WS_LIN); float* KNORM = (float*)(ws + WS_KNORM);
    bf16_t* QR = (bf16_t*)(ws + WS_QR); bf16_t* KR = (bf16_t*)(ws + WS_KR); bf16_t* VR = (bf16_t*)(ws + WS_VR);
    const float* rc = (const float*)(ws + WS_ROT); const float* rs = rc + SEQ * 32;
    int tid_ = c.tid; asm volatile("" : "+v"(tid_));
    const int tid = tid_;
    const int ch0 = tid, ch1 = tid + 512; const bool has1 = ch1 < 824;
    const f32x4 m00 = *(const f32x4*)(mix + 8 * ch0), m01 = *(const f32x4*)(mix + 8 * ch0 + 4);
    f32x4 m10 = (f32x4){0.f, 0.f, 0.f, 0.f}, m11 = m10; if (has1) { m10 = *(const f32x4*)(mix + 8 * ch1); m11 = *(const f32x4*)(mix + 8 * ch1 + 4); }
    f32x4 kk0 = (f32x4){0.f, 0.f, 0.f, 0.f}, kk1 = kk0; if (tid >= 256) { kk0 = *(const f32x4*)(k_k + 8 * (tid - 256)); kk1 = *(const f32x4*)(k_k + 8 * (tid - 256) + 4); }
    const bool rot = tid >= 64 && tid < 256, vcp = tid >= 256 && tid < 448;
    const int rw = tid - 64, which = rw / 96, rhh = (rw % 96) >> 2, re0 = (rw & 3) * 8;
    const int vhh = (tid - 256) >> 3, ve0 = ((tid - 256) & 7) * 8;
#define P2_LOAD(T, t_) do { const int pos_ = (t_) & (SEQ - 1); const bf16_t* cur_ = PROJ + (size_t)(t_) * PC; const u32x4 z4_ = (u32x4){0u, 0u, 0u, 0u}; \
        T.cv0 = *(const u32x4*)(cur_ + 8 * ch0); T.pv0 = pos_ > 0 ? *(const u32x4*)(cur_ - PC + 8 * ch0) : z4_; \
        if (has1) { T.cv1 = *(const u32x4*)(cur_ + 8 * ch1); T.pv1 = pos_ > 0 ? *(const u32x4*)(cur_ - PC + 8 * ch1) : z4_; } \
        if (rot) { const bf16_t* src_ = cur_ + ATT0 + which * 1536 + rhh * 64 + re0; T.ra = *(const u32x4*)src_; T.rb = *(const u32x4*)(src_ + 32); \
            T.c0 = *(const f32x4*)(rc + pos_ * 32 + re0); T.c1 = *(const f32x4*)(rc + pos_ * 32 + re0 + 4); T.s0 = *(const f32x4*)(rs + pos_ * 32 + re0); T.s1 = *(const f32x4*)(rs + pos_ * 32 + re0 + 4); } \
        if (vcp) T.vv = *(const u32x4*)(cur_ + ATT0 + 2 * 1536 + vhh * 64 + ve0); } while (0)
#define P2_SHIFT(z, cv, pv, ma, mb) do { const unsigned cw[4] = {cv.x, cv.y, cv.z, cv.w}, pw[4] = {pv.x, pv.y, pv.z, pv.w}; const float mm[8] = {ma[0], ma[1], ma[2], ma[3], mb[0], mb[1], mb[2], mb[3]}; \
        _Pragma("unroll") for (int j = 0; j < 4; ++j) { const float c0_ = bf2f(cw[j] & 0xffffu), c1_ = bf2f(cw[j] >> 16), q0_ = bf2f(pw[j] & 0xffffu), q1_ = bf2f(pw[j] >> 16); \
            z[2 * j] = c0_ + (q0_ - c0_) * mm[2 * j]; z[2 * j + 1] = c1_ + (q1_ - c1_) * mm[2 * j + 1]; } } while (0)
#define P2_PROC(T, t_) do { const int t = (t_), pos = t & (SEQ - 1); \
        { float z[8]; P2_SHIFT(z, T.cv0, T.pv0, m00, m01);            \
          bf16_t* dst = (tid < 256 ? RZ : KZ) + (size_t)t * D + 8 * (tid & 255); \
          { u32x4 w8; w8.x = pk2(z[0], z[1]); w8.y = pk2(z[2], z[3]); w8.z = pk2(z[4], z[5]); w8.w = pk2(z[6], z[7]); *(u32x4*)dst = w8; } \
          if (tid >= 256) { float sq = 0.f; _Pragma("unroll") for (int j = 0; j < 4; ++j) { const float a_ = z[j] * kk0[j], b_ = z[4 + j] * kk1[j]; sq += a_ * a_ + b_ * b_; } \
              sq = DPP_ADD(sq, 0xB1); sq = DPP_ADD(sq, 0x4E); sq = DPP_ADD(sq, 0x141);                   \
              if ((tid & 7) == 0) KNORM[(size_t)t * 32 + ((tid - 256) >> 3)] = sqrtf(sq); } } \
        if (has1) { float z[8]; P2_SHIFT(z, T.cv1, T.pv1, m10, m11);    \
          if (ch1 < 768) { u32x4 w8; w8.x = pk2(z[0], z[1]); w8.y = pk2(z[2], z[3]); w8.z = pk2(z[4], z[5]); w8.w = pk2(z[6], z[7]); *(u32x4*)(VZ + (size_t)t * D + 8 * (ch1 - 512)) = w8; } \
          else { float o[8]; int dcol; \
              if (ch1 < 780) { dcol = 8 * (ch1 - 768); _Pragma("unroll") for (int j = 0; j < 8; ++j) o[j] = tanhf(z[j]); } \
              else if (ch1 < 792) { dcol = 256 + 8 * (ch1 - 780); _Pragma("unroll") for (int j = 0; j < 8; ++j) o[j] = z[j]; } \
              else { dcol = 512 + 8 * (ch1 - 792); _Pragma("unroll") for (int j = 0; j < 8; ++j) o[j] = sigmoidf_(z[j]); } \
              u32x4 w; w.x = pk2(o[0], o[1]); w.y = pk2(o[2], o[3]); w.z = pk2(o[4], o[5]); w.w = pk2(o[6], o[7]); *(u32x4*)(LIN + (size_t)t * 768 + dcol) = w; } } \
        if (tid >= 448 && tid < 488) { const int q_ = tid - 448; const int dcol = (q_ < 20) ? 96 + 8 * q_ : 352 + 8 * (q_ - 20); *(u32x4*)(LIN + (size_t)t * 768 + dcol) = (u32x4){0u, 0u, 0u, 0u}; } \
        if (rot) { const unsigned aw[4] = {T.ra.x, T.ra.y, T.ra.z, T.ra.w}, bw[4] = {T.rb.x, T.rb.y, T.rb.z, T.rb.w}; float o1[8], o2[8]; \
            _Pragma("unroll") for (int j = 0; j < 8; ++j) { const float t1 = bf2f((aw[j >> 1] >> (16 * (j & 1))) & 0xffffu), t2 = bf2f((bw[j >> 1] >> (16 * (j & 1))) & 0xffffu); \
                const float cs = j < 4 ? T.c0[j & 3] : T.c1[j & 3], sn = j < 4 ? T.s0[j & 3] : T.s1[j & 3]; o1[j] = t1 * cs - t2 * sn; o2[j] = t2 * cs + t1 * sn; } \
            const int dl_ = rhh < 8 ? 1 : (rhh < 16 ? 4 : 16); const int prm = (pos % dl_) * (SEQ / dl_) + pos / dl_; \
            bf16_t* dst = (which ? KR : QR) + ((size_t)((t >> 12) * 24 + rhh) * SEQ + prm) * 64 + re0; \
            u32x4 w1; w1.x = pk2(o1[0], o1[1]); w1.y = pk2(o1[2], o1[3]); w1.z = pk2(o1[4], o1[5]); w1.w = pk2(o1[6], o1[7]); \
            u32x4 w2; w2.x = pk2(o2[0], o2[1]); w2.y = pk2(o2[2], o2[3]); w2.z = pk2(o2[4], o2[5]); w2.w = pk2(o2[6], o2[7]); \
            *(u32x4*)dst = w1; *(u32x4*)(dst + 32) = w2; } \
        if (vcp) { const int dl_ = vhh < 8 ? 1 : (vhh < 16 ? 4 : 16); const int prm = (pos % dl_) * (SEQ / dl_) + pos / dl_; \
            *(u32x4*)(VR + ((size_t)((t >> 12) * 24 + vhh) * SEQ + prm) * 64 + ve0) = T.vv; } } while (0)
    P2Tok ta, tb;
    int tq = c.vcu;
    if (tq < M) P2_LOAD(ta, tq);
    for (; tq < M; tq += 2 * c.G) {
        if (tq + c.G < M) P2_LOAD(tb, tq + c.G);
        P2_PROC(ta, tq);
        if (tq + 2 * c.G < M) P2_LOAD(ta, tq + 2 * c.G);
        if (tq + c.G < M) P2_PROC(tb, tq + c.G);
    }
#undef P2_LOAD
#undef P2_SHIFT
#undef P2_PROC
}

__device__ __forceinline__ float wave_sum_dpp(float x) {
    x = DPP_ADD(x, 0xB1); x = DPP_ADD(x, 0x4E); x = DPP_ADD(x, 0x141); x = DPP_ADD(x, 0x140);
    const int xi = __builtin_bit_cast(int, x);
    return (__builtin_bit_cast(float, __builtin_amdgcn_readlane(xi, 0)) + __builtin_bit_cast(float, __builtin_amdgcn_readlane(xi, 16))) +
           (__builtin_bit_cast(float, __builtin_amdgcn_readlane(xi, 32)) + __builtin_bit_cast(float, __builtin_amdgcn_readlane(xi, 48)));
}
__device__ __forceinline__ f32x4 tile_mm(const LAS bf16_t* A, int pa, const LAS bf16_t* Bt, int pb, int ks, int fr, int fq, f32x4 acc) {
    for (int k = 0; k < ks; ++k) { const bf16x8 a = *(const LAS bf16x8*)(A + fr * pa + 32 * k + 8 * fq), b = *(const LAS bf16x8*)(Bt + fr * pb + 32 * k + 8 * fq);
        acc = __builtin_amdgcn_mfma_f32_16x16x32_bf16(a, b, acc, 0, 0, 0); }
    return acc;
}
__device__ __forceinline__ u32x2 pack4(f32x4 v) { u32x2 w; w.x = pk2(v[0], v[1]); w.y = pk2(v[2], v[3]); return w; }
constexpr int SC_C = 32, SC_NCH = SEQ / SC_C, SC_F = 96;
constexpr int PL_X1 = 0, PL_X2 = 9216, PL_AL = 18432, PL_HT = 26112, PL_ET = 33792, PL_LBT = 53760, PL_TT = 58368, PL_XB = 60928, PL_GI = PL_X1, PL_TF = PL_X2, PL_END = 62016, PL_GRP = 65536;
#define LBAR() do { asm volatile("s_waitcnt lgkmcnt(0)" ::: "memory"); __builtin_amdgcn_s_barrier(); asm volatile("" ::: "memory"); } while (0)
__device__ __forceinline__ void p4_pre(const Params& p, const Ctx& c) {
    unsigned char* ws = c.ws;
    const bf16_t* RZ = (const bf16_t*)(ws + WS_RZ); const float* DEC = (const float*)(ws + WS_DEC); const bf16_t* KP = (const bf16_t*)(ws + WS_KP);
    const bf16_t* AN = (const bf16_t*)(ws + WS_AN); const bf16_t* BB = (const bf16_t*)(ws + WS_BB);
    bf16_t* FG = (bf16_t*)(ws + WS_F); float* BON = (float*)(ws + WS_YS);
    const float* rkp = p.in[I_RK];
    int tid_ = c.tid; asm volatile("" : "+v"(tid_));
    const int tid = tid_, lane = tid & 63, w = __builtin_amdgcn_readfirstlane(tid >> 6), fr = lane & 15, fq = lane >> 4;
    const int grp = w >> 2, tw = w & 3, gtid = tid & 255;
    LAS unsigned char* gl = c.lds + grp * PL_GRP;
    LAS bf16_t* X1 = (LAS bf16_t*)(gl + PL_X1); LAS bf16_t* X2 = (LAS bf16_t*)(gl + PL_X2); LAS bf16_t* AL = (LAS bf16_t*)(gl + PL_AL); LAS bf16_t* HT = (LAS bf16_t*)(gl + PL_HT);
    LAS bf16_t* ET = (LAS bf16_t*)(gl + PL_ET); LAS float* LBT = (LAS float*)(gl + PL_LBT); LAS bf16_t* TT = (LAS bf16_t*)(gl + PL_TT); LAS bf16_t* GI = (LAS bf16_t*)(gl + PL_GI);
    LAS float* TF = (LAS float*)(gl + PL_TF);
    LAS float* XB = (LAS float*)(gl + PL_XB);
    const int npair = (128 * SC_NCH) / (2 * c.G);
    float dcy[32]; unsigned short ir[8], ik[8], ia[8], ib[8];
#define PRE_LOAD(PAIR) do { const int task_ = c.vcu + (2 * (PAIR) + grp) * c.G; const int bh_ = task_ >> 7, ch_ = task_ & (SC_NCH - 1); \
        const size_t o_ = ((size_t)(bh_ >> 5) * SEQ + (size_t)ch_ * SC_C) * D + (bh_ & 31) * 64 + lane; \
        _Pragma("unroll") for (int s_ = 0; s_ < 32; ++s_) dcy[s_] = DEC[o_ + (size_t)s_ * D]; \
        _Pragma("unroll") for (int q_ = 0; q_ < 8; ++q_) { const size_t oo_ = o_ + (size_t)(8 * tw + q_) * D; ir[q_] = RZ[oo_]; ik[q_] = KP[oo_]; ia[q_] = AN[oo_]; ib[q_] = BB[oo_]; } } while (0)
    const bool bgconv = (c.G == 256);
    if (npair > 0) PRE_LOAD(0);
    for (int pr = 0; pr < npair; ++pr) {
        const int task = c.vcu + (2 * pr + grp) * c.G, bh = task >> 7, chn = task & (SC_NCH - 1);
        const float rkv = rkp[(bh & 31) * 64 + lane];
        float* bon = BON + ((size_t)(bh >> 5) * SEQ + (size_t)chn * SC_C) * 32 + (bh & 31);
        float p0 = 1.f, p1 = 1.f, p2 = 1.f, p3 = 1.f, dsel[8];
#pragma unroll
        for (int s = 0; s < 8; ++s) { p0 *= dcy[s]; p1 *= dcy[8 + s]; p2 *= dcy[16 + s]; p3 *= dcy[24 + s];
            dsel[s] = tw == 0 ? dcy[s] : (tw == 1 ? dcy[8 + s] : (tw == 2 ? dcy[16 + s] : dcy[24 + s])); }
        const float gC = (p0 * p1) * (p2 * p3);
        float g = tw == 0 ? 1.f : (tw == 1 ? p0 : (tw == 2 ? p0 * p1 : (p0 * p1) * p2));
        LBAR();
#pragma unroll
        for (int hq = 0; hq < 2; ++hq) { f32x4 ah4, bg4, kg4;
#pragma unroll
            for (int qq = 0; qq < 4; ++qq) { const int qn = 4 * hq + qq, s = 8 * tw + qn;
                const float gp = g; g *= dsel[qn];
                const float rr = bf2f(ir[qn]), kk = bf2f(ik[qn]), aa = bf2f(ia[qn]), bb = bf2f(ib[qn]); const float ig = 1.0f / g;
                const float ah = aa * gp, bt = bb * ig, kt = kk * ig, rh = rr * g;
                X1[s * 72 + lane] = (bf16_t)f2bf(bt); X1[(32 + s) * 72 + lane] = (bf16_t)f2bf(kt); X2[s * 72 + lane] = (bf16_t)f2bf(ah); X2[(32 + s) * 72 + lane] = (bf16_t)f2bf(rh);
                ET[s * 104 + lane] = (bf16_t)f2bf(rh); ah4[qq] = ah; bg4[qq] = bt * gC; kg4[qq] = kt * gC;
                const float bsum = wave_sum_dpp(rr * kk * rkv); if (lane == 0) bon[(size_t)s * 32] = bsum; }
            *(LAS u32x2*)(AL + lane * 40 + 8 * tw + 4 * hq) = pack4(ah4); *(LAS u32x2*)(HT + (32 + lane) * 40 + 8 * tw + 4 * hq) = pack4(bg4); *(LAS u32x2*)(ET + (32 + lane) * 104 + 64 + 8 * tw + 4 * hq) = pack4(kg4); }
        { const int zr = gtid >> 2, zc = 16 * (gtid & 3); LAS u32x4* zp = (LAS u32x4*)(ET + (32 + zr) * 104 + zc); zp[0] = (u32x4){0u, 0u, 0u, 0u}; zp[1] = (u32x4){0u, 0u, 0u, 0u}; }
        if (pr + 1 < npair) PRE_LOAD(pr + 1);
        float cva[32], cvb[32]; int cea = 0, cna = 0, cka = 0, ceb = 0, cnb = 0, ckb = 0;
        if (bgconv) { const int it0 = ((c.vcu * 32 + pr) * 8 + w) * 2;
            cea = it0 >> 12; { const int rem = it0 & 4095; cka = 64 * (rem >> 7); cna = 32 * (rem & 127); }
            ceb = (it0 + 1) >> 12; { const int rem = (it0 + 1) & 4095; ckb = 64 * (rem >> 7); cnb = 32 * (rem & 127); }
            cv_issue(p.in[I_W1] + (size_t)cea * D * 4096, 4096, D, cna, cka, lane, cva); cv_issue(p.in[I_W1] + (size_t)ceb * D * 4096, 4096, D, cnb, ckb, lane, cvb); }
        LBAR();
        if (tw == 0) ET[(32 + lane) * 104 + lane] = (bf16_t)f2bf(gC);
        { const int mt = tw;
#pragma unroll
          for (int nt = 0; nt < 4; ++nt) {
            f32x4 acc = tile_mm(X1 + 16 * mt * 72, 72, X2 + 16 * nt * 72, 72, 2, fr, fq, (f32x4){0.f, 0.f, 0.f, 0.f});
            const int n = 16 * nt + fr, m0 = 16 * mt + 4 * fq;
            if (mt < 2) { if (nt < 2) { const int t = n; f32x4 o;
#pragma unroll
                    for (int e = 0; e < 4; ++e) o[e] = (m0 + e < t) ? acc[e] : 0.f;
                    *(LAS f32x4*)(LBT + t * 36 + m0) = o; }
                else { const int t = n - 32; f32x4 o;
#pragma unroll
                    for (int e = 0; e < 4; ++e) o[e] = (m0 + e <= t) ? acc[e] : 0.f;
                    *(LAS u32x2*)(HT + t * 40 + m0) = pack4(o); } }
            else { const int s0 = m0 - 32;
                if (nt < 2) { const int t = n;
#pragma unroll
                    for (int e = 0; e < 4; ++e) AL[(64 + s0 + e) * 40 + t] = (bf16_t)f2bf((s0 + e < t) ? acc[e] : 0.f); }
                else { const int t = n - 32; f32x4 o;
#pragma unroll
                    for (int e = 0; e < 4; ++e) o[e] = (s0 + e <= t) ? acc[e] : 0.f;
                    *(LAS u32x2*)(ET + t * 104 + 64 + s0) = pack4(o); } } } }
        LBAR();
        if (gtid < 32) { const int hb = 16 * (gtid >> 4), sl = gtid & 15; float Tr[16];
#pragma unroll
            for (int t = 0; t < 16; ++t) { float a0 = (sl == t) ? 1.f : 0.f, a1 = 0.f, a2 = 0.f, a3 = 0.f;
#pragma unroll
                for (int m4 = 0; m4 < (t + 3) / 4; ++m4) { const f32x4 l = *(const LAS f32x4*)(LBT + (hb + t) * 36 + hb + 4 * m4);
                    if (4 * m4 + 0 < t) a0 += Tr[4 * m4 + 0] * l[0]; if (4 * m4 + 1 < t) a1 += Tr[4 * m4 + 1] * l[1]; if (4 * m4 + 2 < t) a2 += Tr[4 * m4 + 2] * l[2]; if (4 * m4 + 3 < t) a3 += Tr[4 * m4 + 3] * l[3]; }
                Tr[t] = (a0 + a1) + (a2 + a3); TF[(hb + sl) * 36 + hb + t] = Tr[t]; TT[(hb + t) * 40 + hb + sl] = (bf16_t)f2bf(Tr[t]);
                if (hb) TT[t * 40 + hb + sl] = 0; } }
        LBAR();
        { const int m = gtid >> 4, tl = gtid & 15; float x = 0.f;
#pragma unroll
            for (int n = 0; n < 16; ++n) x += LBT[(16 + n) * 36 + m] * TF[(16 + n) * 36 + 16 + tl];
            XB[m * 17 + tl] = x; }
        LBAR();
        { const int sr = gtid >> 4, tl = gtid & 15; float x = 0.f;
#pragma unroll
            for (int m = 0; m < 16; ++m) x += TF[sr * 36 + m] * XB[m * 17 + tl];
            TT[(16 + tl) * 40 + sr] = (bf16_t)f2bf(x); }
        LBAR();
        for (int id = tw; id < 12; id += 4) { const int tt = id / 6, nt = id % 6;
            const f32x4 acc = tile_mm(TT + 16 * tt * 40, 40, AL + 16 * nt * 40, 40, 1, fr, fq, (f32x4){0.f, 0.f, 0.f, 0.f});
            *(LAS u32x2*)(GI + (16 * nt + fr) * 40 + 16 * tt + 4 * fq) = pack4(acc); }
        LBAR();
        for (int id = tw; id < 36; id += 4) { const int nt = id / 6, mt = id % 6;
            const f32x4 acc = tile_mm(GI + 16 * nt * 40, 40, HT + 16 * mt * 40, 40, 1, fr, fq, (f32x4){0.f, 0.f, 0.f, 0.f});
            LAS u32x2* ep = (LAS u32x2*)(ET + (16 * mt + fr) * 104 + 16 * nt + 4 * fq); const u32x2 ev = *ep;
            f32x4 o; o[0] = acc[0] + bf2f(ev.x & 0xffffu); o[1] = acc[1] + bf2f(ev.x >> 16); o[2] = acc[2] + bf2f(ev.y & 0xffffu); o[3] = acc[3] + bf2f(ev.y >> 16);
            *ep = pack4(o); }
        LBAR();
        { bf16_t* fg = FG + (size_t)task * (SC_F * SC_F);
          for (int idx = gtid; idx < 96 * 12; idx += 256) { const int row = idx / 12, pc = idx % 12; *(u32x4*)(fg + row * 96 + 8 * pc) = *(const LAS u32x4*)(ET + row * 104 + 8 * pc); } }
        LBAR();
        if (bgconv) { cv_store8(cva, ws + WS_W1 + (size_t)cea * 4096 * D, D, cna, cka, lane); cv_store8(cvb, ws + WS_W1 + (size_t)ceb * 4096 * D, D, cnb, ckb, lane); }
    }
    if (!bgconv) {
        LBAR();
        for (int r = c.vcu * 8 + w; r < NEXP * MOE_W1E; r += c.G * 8) { const int e = r >> 12, rem = r & 4095; float cv[32]; cv_issue(p.in[I_W1] + (size_t)e * D * 4096, 4096, D, 32 * (rem & 127), 64 * (rem >> 7), lane, cv);
            cv_store8(cv, ws + WS_W1 + (size_t)e * 4096 * D, D, 32 * (rem & 127), 64 * (rem >> 7), lane); }
    }
    LBAR();
#undef PRE_LOAD
}
constexpr int SQ_BI = 0, SQ_BI_SZ = 64 * 104 * 2, SQ_YL = 2 * SQ_BI_SZ, SQ_YL_SZ = 32 * 64 * 4;
struct SeqSet { bf16x8 af[3][3]; u32x2 vimg, gimg; float bon; };
__device__ __forceinline__ void p4_seq(const Params& p, const Ctx& c, int bh) {
    unsigned char* ws = c.ws;
    const bf16_t* VZ = (const bf16_t*)(ws + WS_VZ); const bf16_t* GG = (const bf16_t*)(ws + WS_GG); const float* BON = (const float*)(ws + WS_YS);
    const bf16_t* FG = (const bf16_t*)(ws + WS_F) + (size_t)bh * SC_NCH * (SC_F * SC_F);
    bf16_t* YA = (bf16_t*)(ws + WS_YA);
    int tid_ = c.tid; asm volatile("" : "+v"(tid_));
    const int tid = tid_, lane = tid & 63, w = __builtin_amdgcn_readfirstlane(tid >> 6), fr = lane & 15, fq = lane >> 4;
    const int b = bh >> 5, h = bh & 31;
    const size_t base = (size_t)b * SEQ * D + h * 64;
    const int nt = w & 3, mg = w >> 2;
    LAS bf16_t* BI = (LAS bf16_t*)(c.lds + SQ_BI); LAS float* YL = (LAS float*)(c.lds + SQ_YL);
    const int vs = tid >> 4, vi4 = 4 * (tid & 15);
    const f32x4 lg4 = *(const f32x4*)(p.in[I_LNXG] + h * 64 + vi4), lb4 = *(const f32x4*)(p.in[I_LNXB] + h * 64 + vi4);
#define SEQ_LOAD(SET, CHN) do { const int chn_ = (CHN) < SC_NCH ? (CHN) : SC_NCH - 1; const bf16_t* fp = FG + (size_t)chn_ * (SC_F * SC_F); const size_t tk_ = (size_t)b * SEQ + (size_t)(chn_ * SC_C + vs); \
        asm volatile("global_load_dwordx2 %0, %1, off" : "=v"(SET.vimg) : "v"(VZ + tk_ * D + h * 64 + vi4) : "memory"); \
        _Pragma("unroll") for (int mi = 0; mi < 3; ++mi) _Pragma("unroll") for (int ks = 0; ks < 3; ++ks) \
            asm volatile("global_load_dwordx4 %0, %1, off" : "=v"(SET.af[mi][ks]) : "v"(fp + (16 * (3 * mg + mi) + fr) * SC_F + 32 * ks + 8 * fq) : "memory"); \
        asm volatile("global_load_dwordx2 %0, %1, off" : "=v"(SET.gimg) : "v"(GG + tk_ * D + h * 64 + vi4) : "memory"); \
        asm volatile("global_load_dword %0, %1, off" : "=v"(SET.bon) : "v"(BON + tk_ * 32 + h) : "memory"); } while (0)
#define SEQ_WAIT_AF(SET, N) asm volatile("s_waitcnt vmcnt(" #N ")" : "+v"(SET.af[0][0]), "+v"(SET.af[0][1]), "+v"(SET.af[0][2]), "+v"(SET.af[1][0]), "+v"(SET.af[1][1]), "+v"(SET.af[1][2]), \
        "+v"(SET.af[2][0]), "+v"(SET.af[2][1]), "+v"(SET.af[2][2]) :: "memory")
#define SEQ_WAIT_V(SET, N) asm volatile("s_waitcnt vmcnt(" #N ")" : "+v"(SET.vimg) :: "memory")
#define SEQ_WAIT_G(SET, N) asm volatile("s_waitcnt vmcnt(" #N ")" : "+v"(SET.gimg), "+v"(SET.bon), "+v"(SET.vimg) :: "memory")
#define SEQ_BODY(CH, CUR, NXT, NX2) do { const int ch = (CH), cb = ch & 1; \
        const LAS bf16_t* bi = BI + cb * (64 * 104); LAS bf16_t* bo = BI + (cb ^ 1) * (64 * 104); LAS float* yl = YL + cb * (32 * 64); \
        SEQ_LOAD(NX2, ch + 2); \
        bf16x8 bfr[3]; _Pragma("unroll") for (int ks = 0; ks < 3; ++ks) bfr[ks] = *(const LAS bf16x8*)(bi + (16 * nt + fr) * 104 + 32 * ks + 8 * fq); \
        SEQ_WAIT_AF(CUR, 28); \
        f32x4 acc[3]; _Pragma("unroll") for (int mi = 0; mi < 3; ++mi) { acc[mi] = (f32x4){0.f, 0.f, 0.f, 0.f}; \
            _Pragma("unroll") for (int ks = 0; ks < 3; ++ks) acc[mi] = __builtin_amdgcn_mfma_f32_16x16x32_bf16(CUR.af[mi][ks], bfr[ks], acc[mi], 0, 0, 0); } \
        _Pragma("unroll") for (int mi = 0; mi < 3; ++mi) { const int mt = 3 * mg + mi; \
            if (mt < 2) { _Pragma("unroll") for (int e = 0; e < 4; ++e) yl[(16 * mt + 4 * fq + e) * 64 + 16 * nt + fr] = acc[mi][e]; } \
            else *(LAS u32x2*)(bo + (16 * nt + fr) * 104 + 16 * (mt - 2) + 4 * fq) = pack4(acc[mi]); } \
        SEQ_WAIT_V(NXT, 24); \
        if (ch + 1 < SC_NCH) { bo[(vi4 + 0) * 104 + 64 + vs] = (bf16_t)(NXT.vimg.x & 0xffffu); bo[(vi4 + 1) * 104 + 64 + vs] = (bf16_t)(NXT.vimg.x >> 16); \
            bo[(vi4 + 2) * 104 + 64 + vs] = (bf16_t)(NXT.vimg.y & 0xffffu); bo[(vi4 + 3) * 104 + 64 + vs] = (bf16_t)(NXT.vimg.y >> 16); } \
        LBAR(); \
        SEQ_WAIT_G(CUR, 24); \
        { const f32x4 y4 = *(const LAS f32x4*)(yl + vs * 64 + vi4); float sm = (y4[0] + y4[1]) + (y4[2] + y4[3]); \
          sm = DPP_ADD(sm, 0xB1); sm = DPP_ADD(sm, 0x4E); sm = DPP_ADD(sm, 0x141); sm = DPP_ADD(sm, 0x140);     \
          const float mu = sm * (1.0f / 64.0f); const f32x4 d4 = y4 - mu; float q = (d4[0] * d4[0] + d4[1] * d4[1]) + (d4[2] * d4[2] + d4[3] * d4[3]); \
          q = DPP_ADD(q, 0xB1); q = DPP_ADD(q, 0x4E); q = DPP_ADD(q, 0x141); q = DPP_ADD(q, 0x140); \
          const float rstd = rsqrtf(q * (1.0f / 64.0f) + GN_EPS); \
          const float v0 = bf2f(CUR.vimg.x & 0xffffu), v1 = bf2f(CUR.vimg.x >> 16), v2 = bf2f(CUR.vimg.y & 0xffffu), v3 = bf2f(CUR.vimg.y >> 16); \
          const float g0 = bf2f(CUR.gimg.x & 0xffffu), g1 = bf2f(CUR.gimg.x >> 16), g2 = bf2f(CUR.gimg.y & 0xffffu), g3 = bf2f(CUR.gimg.y >> 16); \
          const float o0 = (d4[0] * rstd * lg4[0] + lb4[0] + CUR.bon * v0) * g0, o1 = (d4[1] * rstd * lg4[1] + lb4[1] + CUR.bon * v1) * g1; \
          const float o2 = (d4[2] * rstd * lg4[2] + lb4[2] + CUR.bon * v2) * g2, o3 = (d4[3] * rstd * lg4[3] + lb4[3] + CUR.bon * v3) * g3; \
          *(u32x2*)(YA + ((size_t)b * SEQ + (size_t)(ch * SC_C + vs)) * 2560 + h * 64 + vi4) = (u32x2){pk2(o0, o1), pk2(o2, o3)}; } } while (0)
    SeqSet sa, sb, sc;
    SEQ_LOAD(sa, 0); SEQ_LOAD(sb, 1);
    SEQ_WAIT_V(sa, 0);
    for (int idx = tid; idx < 64 * 8; idx += 512) *(LAS u32x4*)(BI + (idx >> 3) * 104 + 8 * (idx & 7)) = (u32x4){0u, 0u, 0u, 0u};
    BI[(vi4 + 0) * 104 + 64 + vs] = (bf16_t)(sa.vimg.x & 0xffffu); BI[(vi4 + 1) * 104 + 64 + vs] = (bf16_t)(sa.vimg.x >> 16);
    BI[(vi4 + 2) * 104 + 64 + vs] = (bf16_t)(sa.vimg.y & 0xffffu); BI[(vi4 + 3) * 104 + 64 + vs] = (bf16_t)(sa.vimg.y >> 16);
    LBAR();
    for (int c0 = 0; c0 < SC_NCH; c0 += 3) {
        SEQ_BODY(c0, sa, sb, sc);
        if (c0 + 1 < SC_NCH) SEQ_BODY(c0 + 1, sb, sc, sa);
        if (c0 + 2 < SC_NCH) SEQ_BODY(c0 + 2, sc, sa, sb);
    }
    asm volatile("s_waitcnt vmcnt(0)" ::: "memory");
    LBAR();
#undef SEQ_LOAD
#undef SEQ_BODY
#undef SEQ_WAIT_AF
#undef SEQ_WAIT_V
#undef SEQ_WAIT_G
}

__device__ __forceinline__ void p4_attn_task(const Ctx& c, int task) {
    unsigned char* ws = c.ws;
    const bf16_t* QR = (const bf16_t*)(ws + WS_QR); const bf16_t* KR = (const bf16_t*)(ws + WS_KR); const bf16_t* VR = (const bf16_t*)(ws + WS_VR);
    float* AO = (float*)(ws + WS_AO); float* LSE = (float*)(ws + WS_LSE);
    constexpr int VP = 280;
    LAS bf16_t* Vt = (LAS bf16_t*)c.lds;
    const int combo = task & 31, hh = (task >> 5) % 24, b = task / (32 * 24);
    const int g = hh >> 3, h = hh & 7;
    const int dil = g == 0 ? 1 : (g == 1 ? 4 : 16), nblk = 32 / dil;
    const int res = combo / nblk, blk = combo % nblk;
    int tid_ = c.tid; asm volatile("" : "+v"(tid_));
    const int tid = tid_, lane = tid & 63, w = __builtin_amdgcn_readfirstlane(tid >> 6);
    const int qq = lane & 15, g4 = lane >> 4, r0 = 16 * w;
    const size_t rowb = (size_t)(b * 24 + hh) * SEQ + (size_t)res * (SEQ / dil) + (size_t)blk * 128;
    bf16x8 qf[2], kf[9][2];
#pragma unroll
    for (int ks = 0; ks < 2; ++ks) qf[ks] = *(const bf16x8*)(QR + (rowb + r0 + qq) * 64 + 32 * ks + 8 * g4);
#pragma unroll
    for (int kt = 0; kt < 9; ++kt) { const bool kv = (blk > 0) || (w + kt >= 8);
#pragma unroll
        for (int ks = 0; ks < 2; ++ks) { kf[kt][ks] = (bf16x8){0, 0, 0, 0, 0, 0, 0, 0};
            if (kv) kf[kt][ks] = *(const bf16x8*)(KR + (rowb - 128 + 16 * (w + kt) + qq) * 64 + 32 * ks + 8 * g4); } }
    const int vki = tid >> 1, vdh = tid & 1;
    u32x4 vv[4];
    if (blk > 0 || vki >= 128) {
#pragma unroll
        for (int j = 0; j < 4; ++j) vv[j] = *(const u32x4*)(VR + (rowb - 128 + vki) * 64 + 32 * vdh + 8 * j); }
    else {
#pragma unroll
        for (int j = 0; j < 4; ++j) vv[j] = (u32x4){0u, 0u, 0u, 0u}; }
    __syncthreads();
#pragma unroll
    for (int j = 0; j < 4; ++j) { const unsigned wv[4] = {vv[j].x, vv[j].y, vv[j].z, vv[j].w};
#pragma unroll
        for (int e = 0; e < 8; ++e) Vt[(32 * vdh + 8 * j + e) * VP + vki] = (bf16_t)((wv[e >> 1] >> (16 * (e & 1))) & 0xffffu); }
    if (tid < 64) {
#pragma unroll
        for (int e = 0; e < 24; ++e) Vt[tid * VP + 256 + e] = 0; }
    f32x4 sc[10];
#pragma unroll
    for (int kt = 0; kt < 9; ++kt) { f32x4 a = (f32x4){0.f, 0.f, 0.f, 0.f};
#pragma unroll
        for (int ks = 0; ks < 2; ++ks) a = __builtin_amdgcn_mfma_f32_16x16x32_bf16(kf[kt][ks], qf[ks], a, 0, 0, 0);
        sc[kt] = a; }
    const int r = r0 + qq;
    float mx = -3.0e38f;
#pragma unroll
    for (int kt = 0; kt < 9; ++kt)
#pragma unroll
        for (int j = 0; j < 4; ++j) { const int ki = 16 * (w + kt) + 4 * g4 + j; const bool ok = (ki >= r) && (ki <= r + 128) && (blk > 0 || ki >= 128);
            const float sv = ok ? sc[kt][j] * 0.125f : -1.0e30f; sc[kt][j] = sv; mx = fmaxf(mx, sv); }
    mx = fmaxf(mx, __shfl_xor(mx, 16)); mx = fmaxf(mx, __shfl_xor(mx, 32));
    float den = 0.f;
#pragma unroll
    for (int kt = 0; kt < 9; ++kt)
#pragma unroll
        for (int j = 0; j < 4; ++j) { const float pexp = __expf(sc[kt][j] - mx); sc[kt][j] = pexp; den += pexp; }
    den += __shfl_xor(den, 16); den += __shfl_xor(den, 32);
    sc[9] = (f32x4){0.f, 0.f, 0.f, 0.f};
    __syncthreads();
    f32x4 oacc[4];
#pragma unroll
    for (int dt = 0; dt < 4; ++dt) oacc[dt] = (f32x4){0.f, 0.f, 0.f, 0.f};
#pragma unroll
    for (int cidx = 0; cidx < 5; ++cidx) {
        const f32x4 p0 = sc[2 * cidx], p1 = sc[2 * cidx + 1];
        u32x4 pw; pw.x = pk2(p0[0], p0[1]); pw.y = pk2(p0[2], p0[3]); pw.z = pk2(p1[0], p1[1]); pw.w = pk2(p1[2], p1[3]);
        const bf16x8 pf = __builtin_bit_cast(bf16x8, pw);
        const int kbase = 16 * (w + 2 * cidx) + 4 * g4;
#pragma unroll
        for (int dt = 0; dt < 4; ++dt) { const LAS bf16_t* vp = Vt + (16 * dt + qq) * VP + kbase;
            const u32x2 lo = *(const LAS u32x2*)vp, hi = *(const LAS u32x2*)(vp + 16);
            u32x4 vw; vw.x = lo.x; vw.y = lo.y; vw.z = hi.x; vw.w = hi.y;
            oacc[dt] = __builtin_amdgcn_mfma_f32_16x16x32_bf16(__builtin_bit_cast(bf16x8, vw), pf, oacc[dt], 0, 0, 0); }
    }
    const float inv = 1.0f / den;
    const size_t tok = (size_t)b * SEQ + (size_t)(blk * 128 + r) * dil + res;
#pragma unroll
    for (int dt = 0; dt < 4; ++dt) *(f32x4*)(AO + ((size_t)g * M + tok) * 512 + h * 64 + 16 * dt + 4 * g4) = oacc[dt] * inv;
    if (g4 == 0) LSE[((size_t)g * M + tok) * 8 + h] = mx + __logf(den);
}

constexpr int Q_ATT = 3072, Q_TOTAL = Q_ATT + MOE_CONV_GROUPS;
__device__ __forceinline__ void p4_queue(const Params& p, const Ctx& c, volatile LAS unsigned* qslot) {
    unsigned* qc = (unsigned*)(c.ws + WS_CTL) + CW_Q;
    for (;;) {
        __syncthreads();
        if (c.tid == 0) qslot[0] = __hip_atomic_fetch_add(qc, 1u, __ATOMIC_RELAXED, __HIP_MEMORY_SCOPE_AGENT);
        __syncthreads();
        const unsigned it = qslot[0];
        if (it >= (unsigned)Q_TOTAL) break;
        if (it < (unsigned)Q_ATT) p4_attn_task(c, (int)it); else conv_group(p, c, (int)it - Q_ATT);
    }
}

__device__ __forceinline__ void p5_post(const Params& p, const Ctx& c) {
    unsigned char* ws = c.ws;
    const float* AO = (const float*)(ws + WS_AO); const float* LSE = (const float*)(ws + WS_LSE);
    bf16_t* YB = (bf16_t*)(ws + WS_YA);
    const int gw = c.vcu * 8 + c.wave, NGW = c.G * 8, lane = c.lane;
    for (int it = gw; it < M * 8; it += NGW) {
        const int t = it >> 3, h = it & 7;
        const float l0 = LSE[((size_t)0 * M + t) * 8 + h], l1 = LSE[((size_t)1 * M + t) * 8 + h], l2 = LSE[((size_t)2 * M + t) * 8 + h];
        const float mxl = fmaxf(l0, fmaxf(l1, l2)); const float e0 = __expf(l0 - mxl), e1 = __expf(l1 - mxl), e2 = __expf(l2 - mxl); const float inv = 1.0f / (e0 + e1 + e2);
        const size_t o = (size_t)t * 512 + h * 64 + lane;
        const float v = (e0 * AO[o] + e1 * AO[(size_t)M * 512 + o] + e2 * AO[(size_t)2 * M * 512 + o]) * inv;
        YB[(size_t)t * 2560 + 2048 + h * 64 + lane] = (bf16_t)f2bf(v);
    }
}

__device__ __forceinline__ void ln_rows(const Ctx& c, const float* in, const float* gam, const float* bet, float* outf, bf16_t* outb, unsigned char* outq = nullptr) {
    const int gw = c.vcu * 8 + c.wave, NGW = c.G * 8, lane = c.lane;
    for (int m = gw; m < M; m += NGW) {
        const f32x4* xr = (const f32x4*)(in + (size_t)m * D) + lane;
        f32x4 v[8]; float s = 0.f;
#pragma unroll
        for (int j = 0; j < 8; ++j) { v[j] = xr[64 * j]; s += (v[j][0] + v[j][1]) + (v[j][2] + v[j][3]); }
        const float mean = wave_sum(s) * (1.0f / D); float s2 = 0.f;
#pragma unroll
        for (int j = 0; j < 8; ++j) { v[j] = v[j] - mean; s2 += (v[j][0] * v[j][0] + v[j][1] * v[j][1]) + (v[j][2] * v[j][2] + v[j][3] * v[j][3]); }
        const float rstd = rsqrtf(wave_sum(s2) * (1.0f / D) + LN_EPS);
#pragma unroll
        for (int j = 0; j < 8; ++j) { const int col = 4 * lane + 256 * j; const f32x4 gv = *(const f32x4*)(gam + col), bv = *(const f32x4*)(bet + col);
            const f32x4 o = v[j] * rstd * gv + bv;
            *(f32x4*)(outf + (size_t)m * D + col) = o;
            if (outb) { u32x2 w; w.x = pk2(o[0], o[1]); w.y = pk2(o[2], o[3]); *(u32x2*)(outb + (size_t)m * D + col) = w; }
            if (outq) *(unsigned*)(outq + (size_t)m * D + col) = pk4_fp8(o[0], o[1], o[2], o[3]); }
    }
}

__device__ __forceinline__ void p15_router(const Params& p, const Ctx& c) {
    unsigned char* ws = c.ws;
    const float* X2 = (const float*)(ws + WS_X2); const float* RW = p.in[I_RW]; const float* RB = p.in[I_RB];
    unsigned* cnt = (unsigned*)(ws + WS_CTL) + CW_CNT; int* LIST = (int*)(ws + WS_LIST); int* ROWI = (int*)(ws + WS_ROWI); float* TOPW = (float*)(ws + WS_TOPW);
    LAS float* scr = (LAS float*)(c.lds + c.wave * 8192);
    const int gw = c.vcu * 8 + c.wave, NGW = c.G * 8, lane = c.lane, li = lane & 31, lk = lane >> 5;
    for (int tb = gw; tb < M / 32; tb += NGW) {
        const int t0 = tb * 32;
        f32x16 acc;
#pragma unroll
        for (int j = 0; j < 16; ++j) acc[j] = 0.f;
        const float* xa = X2 + (size_t)(t0 + li) * D + 4 * lk;
        const float* wb = RW + (size_t)(4 * lk) * 32 + li;
        for (int kb = 0; kb < D / 8; ++kb) {
            const f32x4 a = *(const f32x4*)(xa + 8 * kb);
            const float b0 = wb[(size_t)(8 * kb + 0) * 32], b1 = wb[(size_t)(8 * kb + 1) * 32], b2 = wb[(size_t)(8 * kb + 2) * 32], b3 = wb[(size_t)(8 * kb + 3) * 32];
            acc = __builtin_amdgcn_mfma_f32_32x32x2f32(a[0], b0, acc, 0, 0, 0);
            acc = __builtin_amdgcn_mfma_f32_32x32x2f32(a[1], b1, acc, 0, 0, 0);
            acc = __builtin_amdgcn_mfma_f32_32x32x2f32(a[2], b2, acc, 0, 0, 0);
            acc = __builtin_amdgcn_mfma_f32_32x32x2f32(a[3], b3, acc, 0, 0, 0);
        }
        const float bias = RB[li];
#pragma unroll
        for (int rg = 0; rg < 16; ++rg) { const int row = (rg & 3) + 8 * (rg >> 2) + 4 * lk; scr[row * 33 + li] = acc[rg] + bias; }
        LDS_WAIT(); asm volatile("" ::: "memory");
        if (lane < 32) {
            float lv[32];
#pragma unroll
            for (int e = 0; e < 32; ++e) lv[e] = scr[lane * 33 + e];
            int id[4]; float tv[4];
#pragma unroll
            for (int k = 0; k < 4; ++k) { float best = -3.0e38f; int bi = 0;
#pragma unroll
                for (int e = 0; e < 32; ++e) { const bool tk = lv[e] > best; best = tk ? lv[e] : best; bi = tk ? e : bi; }
                id[k] = bi; tv[k] = best;
#pragma unroll
                for (int e = 0; e < 32; ++e) lv[e] = (e == bi) ? -3.0e38f : lv[e]; }
            const float e1 = __expf(tv[1] - tv[0]), e2 = __expf(tv[2] - tv[0]), e3 = __expf(tv[3] - tv[0]); const float inv = 1.0f / (1.0f + e1 + e2 + e3);
            const float wv[4] = {inv, e1 * inv, e2 * inv, e3 * inv};
            const int t = t0 + lane;
#pragma unroll
            for (int k = 0; k < 4; ++k) { const unsigned slot = __hip_atomic_fetch_add(cnt + id[k], 1u, __ATOMIC_RELAXED, __HIP_MEMORY_SCOPE_AGENT);
                LIST[(size_t)id[k] * CAP + slot] = t; ROWI[(size_t)t * 4 + k] = id[k] * CAP + (int)slot; TOPW[(size_t)t * 4 + k] = wv[k]; }
        }
        LDS_WAIT(); asm volatile("" ::: "memory");
    }
}

__device__ __forceinline__ void moe_table(const Ctx& c, LAS int* tab) {
    if (c.tid == 0) { unsigned* cnt = (unsigned*)(c.ws + WS_CTL) + CW_CNT; int ts = 0;
        for (int e = 0; e < NEXP; ++e) { const int n = (int)__hip_atomic_load(cnt + e, __ATOMIC_RELAXED, __HIP_MEMORY_SCOPE_AGENT); tab[e] = n; tab[32 + e] = ts; ts += (n + 255) >> 8; }
        tab[64] = ts; }
    __syncthreads();
}

__device__ __forceinline__ void p18_combine(const Params& p, const Ctx& c, const LAS int* tab) {
    unsigned char* ws = c.ws;
    const float* X2 = (const float*)(ws + WS_X2); const bf16_t* Y = (const bf16_t*)(ws + WS_Y); const int* ROWI = (const int*)(ws + WS_ROWI); const float* TOPW = (const float*)(ws + WS_TOPW);
    const float* gam = p.in[I_LN3G]; const float* bet = p.in[I_LN3B];
    const int gw = c.vcu * 8 + c.wave, NGW = c.G * 8, lane = c.lane;
    for (int m = gw; m < M; m += NGW) {
        f32x4 v[8];
        const f32x4* xr = (const f32x4*)(X2 + (size_t)m * D) + lane;
#pragma unroll
        for (int j = 0; j < 8; ++j) v[j] = xr[64 * j] * DN_ALPHA;
#pragma unroll
        for (int k = 0; k < 4; ++k) { const int ri = ROWI[(size_t)m * 4 + k]; const float gt = TOPW[(size_t)m * 4 + k]; const int e = ri >> 14, slot = ri & (CAP - 1);
            const u32x2* yr = (const u32x2*)(Y + ((size_t)tab[32 + e] * 256 + slot) * D) + lane;
#pragma unroll
            for (int j = 0; j < 8; ++j) { const u32x2 yw = yr[64 * j]; v[j] = v[j] + (f32x4){bf2f(yw.x & 0xffffu), bf2f(yw.x >> 16), bf2f(yw.y & 0xffffu), bf2f(yw.y >> 16)} * gt; } }
        float s = 0.f;
#pragma unroll
        for (int j = 0; j < 8; ++j) s += (v[j][0] + v[j][1]) + (v[j][2] + v[j][3]);
        const float mean = wave_sum(s) * (1.0f / D); float s2 = 0.f;
#pragma unroll
        for (int j = 0; j < 8; ++j) { v[j] = v[j] - mean; s2 += (v[j][0] * v[j][0] + v[j][1] * v[j][1]) + (v[j][2] * v[j][2] + v[j][3] * v[j][3]); }
        const float rstd = rsqrtf(wave_sum(s2) * (1.0f / D) + LN_EPS);
#pragma unroll
        for (int j = 0; j < 8; ++j) { const int col = 4 * lane + 256 * j; const f32x4 gv = *(const f32x4*)(gam + col), bv = *(const f32x4*)(bet + col);
            *(f32x4*)(p.out + (size_t)m * D + col) = v[j] * rstd * gv + bv; }
    }
}

constexpr int NPHASE = 19;
__global__ void __launch_bounds__(512, 2) fwd(Params p) {
    extern __shared__ __attribute__((aligned(16))) unsigned char lds_raw[];
    LAS unsigned char* lds = (LAS unsigned char*)lds_raw;
    Ctx c; c.tid = threadIdx.x; c.lane = c.tid & 63; c.wave = __builtin_amdgcn_readfirstlane(c.tid >> 6); c.G = gridDim.x;
    { const int bx = blockIdx.x; c.vcu = (c.G % 8 == 0) ? (bx % 8) * (c.G / 8) + bx / 8 : bx; }
    c.lds = lds; c.ws = p.ws;
    unsigned char* ws = p.ws;
    volatile LAS unsigned* MISC = (volatile LAS unsigned*)(lds + MISC_OFF);
    LAS int* tab = (LAS int*)(lds + MISC_OFF + 1024);
    if (c.tid < 64) MISC[c.tid] = 0u;
    __syncthreads();
    unsigned* ctl = (unsigned*)(ws + WS_CTL);
    XcdBarrier bar; bar.bar = ctl + CW_BAR + p.li * XCD_BAR_WORDS; bar.x = 0; bar.st = MISC + 8;
    if (N_LAUNCH_MODE == 1) bar = xcd_barrier_post(ctl + CW_BAR + p.li * XCD_BAR_WORDS, MISC + 8);
    const int lo = p.ph_lo, hi = p.ph_hi, bx = blockIdx.x;
#ifndef PHMASK
#define PHMASK 0xFFFFFFFFu
#endif
#define IN(k) (((PHMASK >> (k)) & 1u) && lo <= (k) && (k) < hi)
#define SEAM(k) do { if (N_LAUNCH_MODE == 1 && IN((k) + 1)) xcd_barrier(bar); } while (0)

    if (IN(0)) { p0_prologue(p, c); SEAM(0); }

    if (IN(1)) {
        { pg8::StaticOrder S; S.init(ws + WS_XB, ws + WS_WIN, M, GATE0, D, D, c.G, bx);
          pg8::EpiBf16 E{(bf16_t*)(ws + WS_PROJ), PC, 1.0f};
          pg8::gemm_phase<pg8::EpiBf16, pg8::StaticOrder>(lds, pg8::Gemm{D, D, D}, S, E); }
        { pg8::StaticOrder S; S.init(ws + WS_XQ, ws + WS_WIN8, M, PC - GATE0, D, D, c.G, bx, 1);
          pg8::EpiBf16 E{(bf16_t*)(ws + WS_PROJ) + GATE0, PC, 1.0f};
          pg8::gemm_phase<pg8::EpiBf16, pg8::StaticOrder, true, true>(lds, pg8::Gemm{D, D, D}, S, E); }
        SEAM(1);
    }
    if (IN(2)) { p2_prep(p, c); SEAM(2); }

    if (IN(3)) {
#ifndef P3M
#define P3M 15
#endif
        if (P3M & 1) { pg8::StaticOrder S; S.init(ws + WS_LIN, ws + WS_WUP, M, D, 768, 256, c.G, bx);
          pg8::EpiDecay E{(float*)(ws + WS_DEC), p.in[I_W0]};
          pg8::gemm_phase<pg8::EpiDecay, pg8::StaticOrder>(lds, pg8::Gemm{256, 768, 256}, S, E); }
        if (P3M & 2) { pg8::StaticOrder S; S.init(ws + WS_LIN + 512, ws + WS_AUP, M, D, 768, 256, c.G, bx);
          pg8::EpiIclr E{p.in[I_A0], p.in[I_KK], p.in[I_KA], (const bf16_t*)(ws + WS_KZ), (const float*)(ws + WS_KNORM), (bf16_t*)(ws + WS_KP), (bf16_t*)(ws + WS_AN), (bf16_t*)(ws + WS_BB)};
          pg8::gemm_phase<pg8::EpiIclr, pg8::StaticOrder>(lds, pg8::Gemm{256, 768, 256}, S, E); }
        if (P3M & 4) { pg8::StaticOrder S; S.init(ws + WS_LIN + 1024, ws + WS_GUP, M, D, 768, 256, c.G, bx);
          pg8::EpiBf16 E{(bf16_t*)(ws + WS_GG), D, 1.0f};
          pg8::gemm_phase<pg8::EpiBf16, pg8::StaticOrder>(lds, pg8::Gemm{256, 768, 256}, S, E); }
        if (P3M & 8) { pg8::StaticOrder S; S.init(ws + WS_MEMB, ws + WS_WKV, 1024, 2 * D, D, D, c.G, bx);
          pg8::EpiKV E{(bf16_t*)(ws + WS_KB), (bf16_t*)(ws + WS_VT)};
          pg8::gemm_phase<pg8::EpiKV, pg8::StaticOrder>(lds, pg8::Gemm{D, D, D}, S, E); }
        SEAM(3);
    }
    if (IN(4)) {
        p4_pre(p, c);
        xcd_barrier(bar);
        for (int bh = c.vcu; bh < 128; bh += c.G) p4_seq(p, c, bh);
        p4_queue(p, c, MISC + 16);
        SEAM(4);
    }
    if (IN(5)) { p5_post(p, c); }

    if (IN(6)) {
        pg8::StaticOrder S; S.init(ws + WS_YA, ws + WS_PA, M, D, 2560, 2560, c.G, bx);
        pg8::EpiGateFused E{(const bf16_t*)(ws + WS_PROJ), (bf16_t*)(ws + WS_MERGED)};
        pg8::gemm_phase<pg8::EpiGateFused, pg8::StaticOrder>(lds, pg8::Gemm{2560, 2560, 2560}, S, E);
        SEAM(6);
    }
    if (IN(7)) { }
    if (IN(8)) {
        pg8::StaticOrder S; S.init(ws + WS_MERGED, ws + WS_WOUT, M, D, D, D, c.G, bx);
        pg8::EpiF32 E{(float*)(ws + WS_T1), D, nullptr, 0, p.in[I_X], DN_ALPHA};
        pg8::gemm_phase<pg8::EpiF32, pg8::StaticOrder>(lds, pg8::Gemm{D, D, D}, S, E);
        SEAM(8);
    }
    if (IN(9)) { ln_rows(c, (const float*)(ws + WS_T1), p.in[I_LN1G], p.in[I_LN1B], (float*)(ws + WS_X1), (bf16_t*)(ws + WS_X1B)); SEAM(9); }

    if (IN(10)) {
        pg8::StaticOrder S; S.init(ws + WS_X1B, ws + WS_WQ, M, D, D, D, c.G, bx);
        pg8::EpiBf16 E{(bf16_t*)(ws + WS_Q), D, 0.04419417382415922f};
        pg8::gemm_phase<pg8::EpiBf16, pg8::StaticOrder>(lds, pg8::Gemm{D, D, D}, S, E);
        SEAM(10);
    }
    if (IN(11)) {
        ScoreOrder S{(const char*)(ws + WS_Q), (const char*)(ws + WS_KB), c.G, bx};
        pg8::EpiSoftmax E{(bf16_t*)(ws + WS_PP)};
        pg8::gemm_phase<pg8::EpiSoftmax, ScoreOrder, false>(lds, pg8::Gemm{512, D, D}, S, E);
        SEAM(11);
    }
    if (IN(12)) {
        PvOrder S{(const char*)(ws + WS_PP), (const char*)(ws + WS_VT), c.G, bx};
        pg8::EpiBf16 E{(bf16_t*)(ws + WS_OC), D, 1.0f};
        pg8::gemm_phase<pg8::EpiBf16, PvOrder>(lds, pg8::Gemm{256, 256, 256}, S, E);
        SEAM(12);
    }
    if (IN(13)) {
        pg8::StaticOrder S; S.init(ws + WS_OC, ws + WS_WO, M, D, D, D, c.G, bx);
        pg8::EpiF32 E{(float*)(ws + WS_T2), D, nullptr, 0, (const float*)(ws + WS_X1), DN_ALPHA};
        pg8::gemm_phase<pg8::EpiF32, pg8::StaticOrder>(lds, pg8::Gemm{D, D, D}, S, E);
        SEAM(13);
    }
    if (IN(14)) { ln_rows(c, (const float*)(ws + WS_T2), p.in[I_LN2G], p.in[I_LN2B], (float*)(ws + WS_X2), nullptr, ws + WS_X2B); SEAM(14); }
    if (IN(15)) { p15_router(p, c); SEAM(15); }

    if (IN(16)) {
        moe_table(c, tab);
        MoeOrder<true, 16> S{tab, (const char*)(ws + WS_X2B), (const char*)(ws + WS_W1), (const int*)(ws + WS_LIST), (size_t)4096 * D, D, c.G, bx};
        pg8::EpiSwiglu E{p.in[I_B1], (bf16_t*)(ws + WS_H)};
        pg8::gemm_phase<pg8::EpiSwiglu, MoeOrder<true, 16>, true, true>(lds, pg8::Gemm{D, D, D}, S, E);
        SEAM(16);
    }
    if (IN(17)) {
        moe_table(c, tab);
        MoeOrder<false, 8> S{tab, (const char*)(ws + WS_H), (const char*)(ws + WS_W2), (const int*)(ws + WS_LIST), (size_t)D * DFF, DFF, c.G, bx};
        pg8::EpiBf16Bias E{(bf16_t*)(ws + WS_Y), D, p.in[I_B2], D};
        pg8::gemm_phase<pg8::EpiBf16Bias, MoeOrder<false, 8>, true, true>(lds, pg8::Gemm{DFF, DFF, DFF}, S, E);
        SEAM(17);
    }
    if (IN(18)) { moe_table(c, tab); p18_combine(p, c, tab); }
#undef IN
#undef SEAM
}

extern "C" void kernel_launch(void* const* d_in, const int* in_sizes, int n_in, void* d_out, int out_size, void* d_ws, size_t ws_size, hipStream_t stream) {
    static int grid = 0;
    if (grid == 0) {
        if (n_in != 32 || out_size != M * D || ws_size < WS_END) { fprintf(stderr, "kernel_launch: expected 32 inputs, %d outputs, >= %zu bytes of workspace; got %d, %d, %zu\n", M * D, (size_t)WS_END, n_in, out_size, ws_size); grid = -1; return; }
        int dev = 0, cus = 0, per_cu = 0;
        if (hipGetDevice(&dev) != hipSuccess || hipDeviceGetAttribute(&cus, hipDeviceAttributeMultiprocessorCount, dev) != hipSuccess) { grid = -1; return; }
        if (hipFuncSetAttribute((const void*)fwd, hipFuncAttributeMaxDynamicSharedMemorySize, LDS_BYTES) != hipSuccess) { fprintf(stderr, "kernel_launch: hipFuncSetAttribute failed\n"); grid = -1; return; }
        if (hipOccupancyMaxActiveBlocksPerMultiprocessor(&per_cu, (const void*)fwd, 512, LDS_BYTES) != hipSuccess || per_cu < 1) fprintf(stderr, "kernel_launch: occupancy query reports %d\n", per_cu);
        (void)hipGetLastError();
        grid = cus;
        if (grid != 256) fprintf(stderr, "kernel_launch: %d CUs; this kernel is built for 256\n", grid);
    }
    if (grid < 0) return;
    (void)hipMemsetAsync((char*)d_ws + WS_CTL, 0, CTL_ZERO_BYTES, stream);
    Params p{};
    for (int i = 0; i < 32; ++i) p.in[i] = (const float*)d_in[i];
    p.out = (float*)d_out; p.ws = (unsigned char*)d_ws;
#if defined(TIMING_REPEAT_LO)
    { const int cuts[4][2] = {{0, TIMING_REPEAT_HI}, {TIMING_REPEAT_LO, TIMING_REPEAT_HI}, {TIMING_REPEAT_HI, NPHASE}, {0, 0}};
      for (int li = 0; li < 3; ++li) { if (cuts[li][0] >= cuts[li][1]) continue; p.ph_lo = cuts[li][0]; p.ph_hi = cuts[li][1]; p.li = li; hipLaunchKernelGGL(fwd, dim3(grid), dim3(512), LDS_BYTES, stream, p); } }
#else
    if (N_LAUNCH_MODE == 1) { p.ph_lo = 0; p.ph_hi = NPHASE; hipLaunchKernelGGL(fwd, dim3(grid), dim3(512), LDS_BYTES, stream, p); }
    else for (int k = 0; k < NPHASE; ++k) { p.ph_lo = k; p.ph_hi = k + 1; hipLaunchKernelGGL(fwd, dim3(grid), dim3(512), LDS_BYTES, stream, p); }
#endif
}
```

```cpp
#include <hip/hip_runtime.h>
#include <cstdio>
#include <cstdint>

#define LAS __attribute__((address_space(3)))
#define GAS __attribute__((address_space(1)))
typedef unsigned short bf16_t;
typedef short bf16x8 __attribute__((ext_vector_type(8)));
typedef float f32x4 __attribute__((ext_vector_type(4)));
typedef float f32x2 __attribute__((ext_vector_type(2)));
typedef float f32x16 __attribute__((ext_vector_type(16)));
typedef unsigned u32x4 __attribute__((ext_vector_type(4)));
typedef unsigned u32x2 __attribute__((ext_vector_type(2)));

#ifndef N_LAUNCH_MODE
#define N_LAUNCH_MODE 1
#endif

constexpr int M = 16384, D = 2048, SEQ = 4096, NBATCH = 4;
constexpr int RWC = 6592;
constexpr int PC = 15360;
constexpr int ATTV2 = 6656, ATT0 = 7168, GATE0 = 11264;
constexpr int NEXP = 32, DFF = 2048, CAP = 16384;
constexpr int HROWS = 65536 + 32 * 256;
constexpr float LN_EPS = 1e-5f, GN_EPS = 64e-5f;
constexpr float DN_ALPHA = 1.189207115002721f;

__device__ __forceinline__ float bf2f(unsigned v) { return __uint_as_float(v << 16); }
__device__ __forceinline__ unsigned f2bf(float f) { unsigned u = __float_as_uint(f); return (u + 0x7fffu + ((u >> 16) & 1u)) >> 16; }
__device__ __forceinline__ unsigned pk2(float lo, float hi) { return f2bf(lo) | (f2bf(hi) << 16); }
typedef int v4i __attribute__((ext_vector_type(4)));
typedef int v8i __attribute__((ext_vector_type(8)));
__device__ __forceinline__ unsigned pk4_fp8(float a, float b, float c, float d) { int r = __builtin_amdgcn_cvt_pk_fp8_f32(a, b, 0, false); r = __builtin_amdgcn_cvt_pk_fp8_f32(c, d, r, true); return (unsigned)r; }
__device__ __forceinline__ float sigmoidf_(float x) { return 1.0f / (1.0f + __expf(-x)); }
__device__ __forceinline__ float wave_sum(float v) {
#pragma unroll
    for (int o = 1; o < 64; o <<= 1) v += __shfl_xor(v, o);
    return v;
}
#define LDS_WAIT() asm volatile("s_waitcnt lgkmcnt(0)" ::: "memory")
#define VM_WAIT() asm volatile("s_waitcnt vmcnt(0)" ::: "memory")

namespace pg8 {
#define PG8_LAS __attribute__((address_space(3)))
constexpr int BM = 256, BK = 64, HALF = 128, HTB = HALF * BK * 2, STAGE_BYTES = 8 * HTB, NXCD = 8, WGM = 8;

__host__ __device__ __forceinline__ int lds_byte(int r, int c) { const int st = (r >> 4) * 2 + (c >> 5), rr = r & 15, cc = c & 31, ob = rr * 64 + cc * 2; return st * 1024 + (ob ^ (((ob >> 9) & 1) << 5)); }
__host__ __device__ __forceinline__ void stage_rc(int b, int& R, int& C) { const int st = b / 1024, sb = b % 1024, swz = sb ^ (((sb >> 9) & 1) << 5); R = (st >> 1) * 16 + swz / 64; C = (st & 1) * 32 + (swz % 64) / 2; }
__host__ __device__ __forceinline__ int perm32(int rho) { const int n = rho >> 4, i = rho & 15; return 8 * (i >> 2) + 4 * n + (i & 3); }

struct Unit { const char* A; const char* B; int orow, ocol, aux, aux2, valid; };
struct Gemm { int K, lda, ldb; };

struct StaticOrder {
    static constexpr bool GATHER = false;
    const char* A; const char* Bt; size_t ta, tb;
    int nM, nN, nwg, G, c;
    __device__ void init(const void* A_, const void* Bt_, int M_, int N_, int lda, int ldb, int G_, int c_, int esz = 2) { A = (const char*)A_; Bt = (const char*)Bt_; ta = (size_t)BM * lda * esz; tb = (size_t)BM * ldb * esz; nM = M_ / BM; nN = N_ / BM; nwg = nM * nN; G = G_; c = c_; }
    __device__ bool next(int i, Unit& u) const {
        const long L = (long)i * G + c; if (c < 0 || L >= nwg) return false;
        int wgid = (int)L; { const int q = nwg / NXCD, r = nwg % NXCD, xcd = wgid % NXCD, off = wgid / NXCD; wgid = (xcd < r ? xcd * (q + 1) : r * (q + 1) + (xcd - r) * q) + off; }
        const int nig = WGM * nN, gid = wgid / nig, fm = gid * WGM, gsz = (nM - fm) < WGM ? (nM - fm) : WGM;
        const int pm = fm + ((wgid % nig) % gsz), pn = (wgid % nig) / gsz;
        u.A = A + (size_t)pm * ta; u.B = Bt + (size_t)pn * tb; u.orow = pm * BM; u.ocol = pn * BM; u.aux = 0; u.aux2 = 0; u.valid = BM; return true;
    }
    __device__ __forceinline__ const int* rows(const Unit&) const { return nullptr; }
};

__device__ __forceinline__ unsigned cvt_pk_bf16(float lo, float hi) { unsigned r; asm volatile("v_cvt_pk_bf16_f32 %0, %1, %2" : "=v"(r) : "v"(lo), "v"(hi)); return r; }

template <class Epi, class Sched, bool ALIGN_EPI = true, bool FP8 = false>
__device__ __forceinline__ void gemm_phase(PG8_LAS unsigned char* lds, const Gemm g, const Sched& S, const Epi& E) {
    const int tid = threadIdx.x, wid = __builtin_amdgcn_readfirstlane(tid >> 6), lane = tid & 63, wr = wid >> 2, wc = wid & 3, fr = lane & 15, fq = lane >> 4;
    constexpr int ES = FP8 ? 1 : 2;
    int sclW = 0, sclX = 0;
    if constexpr (FP8) { asm volatile("v_mov_b32 %0, 0x79797979\n\tv_mov_b32 %1, 0x7f7f7f7f" : "=v"(sclW), "=v"(sclX)); }
    const int K = g.K, nt = K * ES / (BK * 2);
    unsigned voffA[2], voffB[2]; int Rr[2], Cc[2];
#pragma unroll
    for (int i = 0; i < 2; ++i) { int R, C; stage_rc(tid * 16 + i * 8192, R, C); const int Rb = Epi::PERM ? ((R & ~31) + perm32(R & 31)) : R; Rr[i] = R; Cc[i] = C;
        voffA[i] = (unsigned)(R * g.lda * ES + C * 2); voffB[i] = (unsigned)(Rb * g.ldb * ES + C * 2); }
    const size_t kstep = (size_t)(BK * 2);
    const size_t hstepA = (size_t)HALF * g.lda * ES, hstepB = (size_t)HALF * g.ldb * ES;
    const unsigned ldsw = (unsigned)wid * 1024u;
    const int aoff = lds_byte(wr * 64 + fr, fq * 8), boff = lds_byte(wc * 32 + fr, fq * 8);
    unsigned vAc[2][2], vAn[2][2];
#define PG8_SA(b, h) (((b) * 2 + (h)) * HTB)
#define PG8_SB(b, h) ((4 + (b) * 2 + (h)) * HTB)
#define PG8_STAGE(bufoff, gbase, voff) do { _Pragma("unroll") for (int _i = 0; _i < 2; ++_i) \
        __builtin_amdgcn_global_load_lds((const unsigned*)((const char*)(gbase) + (voff)[_i]), (PG8_LAS unsigned*)(lds + (bufoff) + ldsw + _i * 8192), 16, 0, 0); } while (0)
#define PG8_STAGE_A(bufoff, kbase, h, nx) do { if constexpr (Sched::GATHER) { unsigned _v[2] = {(nx) ? vAn[h][0] : vAc[h][0], (nx) ? vAn[h][1] : vAc[h][1]}; PG8_STAGE(bufoff, kbase, _v); } \
        else { PG8_STAGE(bufoff, (kbase) + (h) * hstepA, voffA); } } while (0)
#define PG8_GOFF(u, v) do { const int* _rw = S.rows(u); _Pragma("unroll") for (int _h = 0; _h < 2; ++_h) _Pragma("unroll") for (int _i = 0; _i < 2; ++_i) { const int _r = Rr[_i] + _h * HALF; \
        const int _tk = _r < (u).valid ? _rw[_r] : 0; v[_h][_i] = (unsigned)(_tk * g.lda * ES + Cc[_i] * 2); } } while (0)
#define PG8_LDA(dst, b, h) do { _Pragma("unroll") for (int m = 0; m < 4; ++m) _Pragma("unroll") for (int k = 0; k < 2; ++k) dst[m][k] = *(const PG8_LAS bf16x8*)(lds + PG8_SA(b, h) + aoff + m * 2048 + k * 1024); } while (0)
#define PG8_LDB(dst, b, h) do { _Pragma("unroll") for (int n = 0; n < 2; ++n) _Pragma("unroll") for (int k = 0; k < 2; ++k) dst[n][k] = *(const PG8_LAS bf16x8*)(lds + PG8_SB(b, h) + boff + n * 2048 + k * 1024); } while (0)
#define PG8_MMA(ai, bj, At, Bt) do { __builtin_amdgcn_s_setprio(1); _Pragma("unroll") for (int m = 0; m < 4; ++m) _Pragma("unroll") for (int n = 0; n < 2; ++n) { \
        if constexpr (FP8) { const v4i _b0 = __builtin_bit_cast(v4i, Bt[n][0]), _b1 = __builtin_bit_cast(v4i, Bt[n][1]), _a0 = __builtin_bit_cast(v4i, At[m][0]), _a1 = __builtin_bit_cast(v4i, At[m][1]); \
            const v8i _bb = __builtin_shufflevector(_b0, _b1, 0, 1, 2, 3, 4, 5, 6, 7), _aa = __builtin_shufflevector(_a0, _a1, 0, 1, 2, 3, 4, 5, 6, 7); \
            asm volatile("v_mfma_scale_f32_16x16x128_f8f6f4 %0, %1, %2, %0, %3, %4 op_sel_hi:[0,0,0]" : "+v"(acc[ai][bj][m][n]) : "v"(_bb), "v"(_aa), "v"(sclW), "v"(sclX)); } \
        else { _Pragma("unroll") for (int k = 0; k < 2; ++k) acc[ai][bj][m][n] = __builtin_amdgcn_mfma_f32_16x16x32_bf16(Bt[n][k], At[m][k], acc[ai][bj][m][n], 0, 0, 0); } } \
        __builtin_amdgcn_s_setprio(0); } while (0)
#define PG8_WAIT_V(n) asm volatile("s_waitcnt vmcnt(" #n ")" ::: "memory")
#define PG8_WAIT_L(n) asm volatile("s_waitcnt lgkmcnt(" #n ")" ::: "memory")
#define PG8_BAR __builtin_amdgcn_s_barrier()
#define PG8_SCHED __builtin_amdgcn_sched_barrier(0)
    Unit cur, nxt; int ui = 0;
    if (!S.next(0, cur)) return;
    f32x4 acc[2][2][4][2];
#pragma unroll
    for (int a = 0; a < 2; ++a)
#pragma unroll
        for (int b = 0; b < 2; ++b)
#pragma unroll
            for (int m = 0; m < 4; ++m)
#pragma unroll
                for (int n = 0; n < 2; ++n) acc[a][b][m][n] = (f32x4){0.f, 0.f, 0.f, 0.f};
    bf16x8 At[4][2], B0[2][2], B1[2][2];
    const char* cA = cur.A; const char* cB = cur.B;
    if constexpr (Sched::GATHER) { PG8_GOFF(cur, vAc); PG8_WAIT_V(0); }
    PG8_STAGE(PG8_SB(0, 0), cB, voffB); PG8_STAGE(PG8_SB(0, 1), cB + hstepB, voffB); PG8_STAGE_A(PG8_SA(0, 0), cA, 0, false); PG8_STAGE_A(PG8_SA(0, 1), cA, 1, false);
    if (wr == 1) PG8_BAR;
    PG8_WAIT_V(2); PG8_BAR;
    PG8_STAGE(PG8_SB(1, 0), cB + kstep, voffB); PG8_STAGE_A(PG8_SA(1, 0), cA + kstep, 0, false); PG8_STAGE(PG8_SB(1, 1), cB + hstepB + kstep, voffB);
    PG8_WAIT_V(6); PG8_BAR;
    for (;;) {
        const bool has_next = S.next(ui + 1, nxt);
        const char* nA = has_next ? nxt.A : cA; const char* nB = has_next ? nxt.B : cB;
        if constexpr (Sched::GATHER) { if (has_next) { PG8_GOFF(nxt, vAn); } else {
#pragma unroll
            for (int h = 0; h < 2; ++h)
#pragma unroll
                for (int i = 0; i < 2; ++i) vAn[h][i] = vAc[h][i]; } }
#pragma nounroll
        for (int t = 0; t < nt; t += 2) {
            const bool last = (t == nt - 2);
            if constexpr (Epi::MID_T >= 0) { if (t == Epi::MID_T) { int l3 = lane; asm volatile("" : "+v"(l3)); E.mid(acc, cur, wr, wc, l3 & 15, l3 >> 4); } }
            const char* a1 = cA + (size_t)(t + 1) * kstep;
            const char* a2 = last ? nA : cA + (size_t)(t + 2) * kstep; const char* b2 = last ? nB : cB + (size_t)(t + 2) * kstep;
            const char* a3 = a2 + kstep; const char* b3 = b2 + kstep;
            PG8_LDB(B0, 0, 0); PG8_LDB(B1, 0, 1); PG8_SCHED; PG8_LDA(At, 0, 0); PG8_STAGE_A(PG8_SA(1, 1), a1, 1, false);
            PG8_WAIT_V(8); PG8_WAIT_L(0); PG8_BAR; PG8_MMA(0, 0, At, B0); PG8_MMA(0, 1, At, B1); PG8_BAR; PG8_SCHED;
            PG8_LDA(At, 0, 1); PG8_STAGE(PG8_SB(0, 0), b2, voffB); PG8_STAGE(PG8_SB(0, 1), b2 + hstepB, voffB); PG8_STAGE_A(PG8_SA(0, 0), a2, 0, last);
            PG8_WAIT_V(8); PG8_WAIT_L(0); PG8_BAR; PG8_MMA(1, 0, At, B0); PG8_MMA(1, 1, At, B1); PG8_BAR; PG8_SCHED;
            PG8_LDB(B0, 1, 0); PG8_LDB(B1, 1, 1); PG8_SCHED; PG8_LDA(At, 1, 0); PG8_STAGE_A(PG8_SA(0, 1), a2, 1, last);
            PG8_WAIT_V(8); PG8_WAIT_L(0); PG8_BAR; PG8_MMA(0, 0, At, B0); PG8_MMA(0, 1, At, B1); PG8_BAR; PG8_SCHED;
            PG8_LDA(At, 1, 1); PG8_STAGE(PG8_SB(1, 0), b3, voffB); PG8_STAGE(PG8_SB(1, 1), b3 + hstepB, voffB); PG8_STAGE_A(PG8_SA(1, 0), a3, 0, last);
            PG8_WAIT_V(8); PG8_WAIT_L(0); PG8_BAR; PG8_MMA(1, 0, At, B0); PG8_MMA(1, 1, At, B1); PG8_BAR; PG8_SCHED;
        }
        if constexpr (ALIGN_EPI) { if (wr == 0) PG8_BAR; }
        if constexpr (FP8) asm volatile("s_nop 15\n\ts_nop 15" ::: "memory");
        if constexpr (!Epi::AFTER_DRAIN) { int l2 = lane; asm volatile("" : "+v"(l2));
            E(acc, cur, wr, wc, l2 & 15, l2 >> 4); }
        if (!has_next) break;
#pragma unroll
        for (int a = 0; a < 2; ++a)
#pragma unroll
            for (int b = 0; b < 2; ++b)
#pragma unroll
                for (int m = 0; m < 4; ++m)
#pragma unroll
                    for (int n = 0; n < 2; ++n) acc[a][b][m][n] = (f32x4){0.f, 0.f, 0.f, 0.f};
        cur = nxt; cA = nA; cB = nB; ++ui;
        if constexpr (Sched::GATHER) {
#pragma unroll
            for (int h = 0; h < 2; ++h)
#pragma unroll
                for (int i = 0; i < 2; ++i) vAc[h][i] = vAn[h][i]; }
        if constexpr (ALIGN_EPI) { if (wr == 1) PG8_BAR; }
    }
    PG8_WAIT_V(0);
    if constexpr (!ALIGN_EPI) { if (wr == 0) PG8_BAR; }
    PG8_BAR;
    if constexpr (Epi::AFTER_DRAIN) { E.fused(acc, cur, wr, wc, fr, fq, lds, wid, lane); }
#undef PG8_SA
#undef PG8_SB
#undef PG8_STAGE
#undef PG8_STAGE_A
#undef PG8_GOFF
#undef PG8_LDA
#undef PG8_LDB
#undef PG8_MMA
#undef PG8_WAIT_V
#undef PG8_WAIT_L
#undef PG8_BAR
#undef PG8_SCHED
}

#define EPI_LOOP_AI_M for (int ai = 0; ai < 2; ++ai) _Pragma("unroll") for (int m = 0; m < 4; ++m)

struct EpiF32 {
    static constexpr bool PERM = false, AFTER_DRAIN = false; static constexpr int MID_T = -1;
    float* C; int ldc; const float* bias; int bstride; const float* res; float alpha;
    __device__ __forceinline__ void operator()(const f32x4 (&acc)[2][2][4][2], const Unit& u, int wr, int wc, int fr, int fq) const {
        const int row0 = u.orow + wr * 64 + fr, col0 = u.ocol + wc * 32 + 4 * fq;
        f32x4 bv[2][2];
#pragma unroll
        for (int bj = 0; bj < 2; ++bj)
#pragma unroll
            for (int n = 0; n < 2; ++n) bv[bj][n] = bias ? *(const f32x4*)(bias + (size_t)u.aux * bstride + col0 + bj * HALF + n * 16) : (f32x4){0.f, 0.f, 0.f, 0.f};
#pragma unroll
        EPI_LOOP_AI_M { const size_t off = (size_t)(row0 + ai * HALF + m * 16) * ldc + col0;
#pragma unroll
            for (int bj = 0; bj < 2; ++bj)
#pragma unroll
                for (int n = 0; n < 2; ++n) { f32x4 v = acc[ai][bj][m][n] + bv[bj][n];
                    if (res) { const f32x4 rv = *(const f32x4*)(res + off + bj * HALF + n * 16); v = v + rv * alpha; }
                    *(f32x4*)(C + off + bj * HALF + n * 16) = v; }
            asm volatile("" ::: "memory"); }
    }
};
struct EpiBf16 {
    static constexpr bool PERM = true, AFTER_DRAIN = false; static constexpr int MID_T = -1;
    bf16_t* O; int ldc; float scale;
    __device__ __forceinline__ void operator()(const f32x4 (&acc)[2][2][4][2], const Unit& u, int wr, int wc, int fr, int fq) const {
        const int row0 = u.orow + wr * 64 + fr, col0 = u.ocol + wc * 32 + 8 * fq;
#pragma unroll
        EPI_LOOP_AI_M { bf16_t* rowp = O + (size_t)(row0 + ai * HALF + m * 16) * ldc + col0;
#pragma unroll
            for (int bj = 0; bj < 2; ++bj) { const f32x4 v0 = acc[ai][bj][m][0] * scale, v1 = acc[ai][bj][m][1] * scale;
                u32x4 w; w.x = cvt_pk_bf16(v0[0], v0[1]); w.y = cvt_pk_bf16(v0[2], v0[3]); w.z = cvt_pk_bf16(v1[0], v1[1]); w.w = cvt_pk_bf16(v1[2], v1[3]);
                *(u32x4*)(rowp + bj * HALF) = w; } }
    }
};
struct EpiBf16Bias {
    static constexpr bool PERM = true, AFTER_DRAIN = false; static constexpr int MID_T = -1;
    bf16_t* O; int ldc; const float* bias; int bstride;
    __device__ __forceinline__ void operator()(const f32x4 (&acc)[2][2][4][2], const Unit& u, int wr, int wc, int fr, int fq) const {
        const int row0 = u.orow + wr * 64 + fr, col0 = u.ocol + wc * 32 + 8 * fq;
        f32x4 bv[2][2];
#pragma unroll
        for (int bj = 0; bj < 2; ++bj)
#pragma unroll
            for (int n = 0; n < 2; ++n) bv[bj][n] = *(const f32x4*)(bias + (size_t)u.aux * bstride + col0 + bj * HALF + 4 * n);
#pragma unroll
        EPI_LOOP_AI_M { bf16_t* rowp = O + (size_t)(row0 + ai * HALF + m * 16) * ldc + col0;
#pragma unroll
            for (int bj = 0; bj < 2; ++bj) { const f32x4 v0 = acc[ai][bj][m][0] + bv[bj][0], v1 = acc[ai][bj][m][1] + bv[bj][1];
                u32x4 w; w.x = cvt_pk_bf16(v0[0], v0[1]); w.y = cvt_pk_bf16(v0[2], v0[3]); w.z = cvt_pk_bf16(v1[0], v1[1]); w.w = cvt_pk_bf16(v1[2], v1[3]);
                *(u32x4*)(rowp + bj * HALF) = w; } }
    }
};
struct EpiKV {
    static constexpr bool PERM = true, AFTER_DRAIN = false; static constexpr int MID_T = -1;
    bf16_t* KB; bf16_t* VT;
    __device__ __forceinline__ void operator()(const f32x4 (&acc)[2][2][4][2], const Unit& u, int wr, int wc, int fr, int fq) const {
        const int row0 = u.orow + wr * 64 + fr, col0 = u.ocol + wc * 32 + 8 * fq;
#pragma unroll
        EPI_LOOP_AI_M { const int row = row0 + ai * HALF + m * 16;
#pragma unroll
            for (int bj = 0; bj < 2; ++bj) { const f32x4 v0 = acc[ai][bj][m][0], v1 = acc[ai][bj][m][1]; const int col = col0 + bj * HALF;
                if (u.ocol < 2048) { u32x4 w; w.x = cvt_pk_bf16(v0[0], v0[1]); w.y = cvt_pk_bf16(v0[2], v0[3]); w.z = cvt_pk_bf16(v1[0], v1[1]); w.w = cvt_pk_bf16(v1[2], v1[3]);
                    *(u32x4*)(KB + (size_t)row * 2048 + col) = w; }
                else { const int b = row >> 8, key = row & 255, c = col - 2048, h = c >> 9, d = c & 511; bf16_t* p = VT + ((size_t)((b * 4 + h) * 512 + d)) * 256 + key;
#pragma unroll
                    for (int j = 0; j < 4; ++j) { p[(size_t)j * 256] = (bf16_t)f2bf(v0[j]); p[(size_t)(4 + j) * 256] = (bf16_t)f2bf(v1[j]); } } } }
    }
};
struct EpiDecay {
    static constexpr bool PERM = false, AFTER_DRAIN = false; static constexpr int MID_T = -1;
    float* DEC; const float* w0;
    __device__ __forceinline__ void operator()(const f32x4 (&acc)[2][2][4][2], const Unit& u, int wr, int wc, int fr, int fq) const {
        const int row0 = u.orow + wr * 64 + fr, col0 = u.ocol + wc * 32 + 4 * fq;
        f32x4 bv[2][2];
#pragma unroll
        for (int bj = 0; bj < 2; ++bj)
#pragma unroll
            for (int n = 0; n < 2; ++n) bv[bj][n] = *(const f32x4*)(w0 + col0 + bj * HALF + n * 16);
#pragma unroll
        EPI_LOOP_AI_M { const size_t off = (size_t)(row0 + ai * HALF + m * 16) * D + col0;
#pragma unroll
            for (int bj = 0; bj < 2; ++bj)
#pragma unroll
                for (int n = 0; n < 2; ++n) { const f32x4 x = acc[ai][bj][m][n] + bv[bj][n]; f32x4 o;
#pragma unroll
                    for (int j = 0; j < 4; ++j) o[j] = __expf(-0.6065306597126334f * sigmoidf_(x[j]));
                    *(f32x4*)(DEC + off + bj * HALF + n * 16) = o; } }
    }
};
struct EpiIclr {
    static constexpr bool PERM = true, AFTER_DRAIN = false; static constexpr int MID_T = -1;
    const float* a0; const float* k_k; const float* k_a; const bf16_t* KZ; const float* KNORM; bf16_t* KP; bf16_t* AN; bf16_t* BB;
    __device__ __forceinline__ void operator()(const f32x4 (&acc)[2][2][4][2], const Unit& u, int wr, int wc, int fr, int fq) const {
        const int row0 = u.orow + wr * 64 + fr, col0 = u.ocol + wc * 32 + 8 * fq;
#pragma unroll
        for (int bj = 0; bj < 2; ++bj) { const int col = col0 + bj * HALF;
            const f32x4 a00 = *(const f32x4*)(a0 + col), a01 = *(const f32x4*)(a0 + col + 4), kk0 = *(const f32x4*)(k_k + col), kk1 = *(const f32x4*)(k_k + col + 4), ka0 = *(const f32x4*)(k_a + col), ka1 = *(const f32x4*)(k_a + col + 4);
#pragma unroll
            EPI_LOOP_AI_M { const int row = row0 + ai * HALF + m * 16; const size_t off = (size_t)row * D + col;
                const u32x4 kzw = *(const u32x4*)(KZ + off); const float nr = KNORM[(size_t)row * 32 + (col >> 6)]; const float inv = 1.0f / fmaxf(nr, 1e-12f);
                const unsigned kw[4] = {kzw.x, kzw.y, kzw.z, kzw.w};
                float kp[8], an[8], bb[8];
#pragma unroll
                for (int j = 0; j < 8; ++j) { const float kz = bf2f((kw[j >> 1] >> (16 * (j & 1))) & 0xffffu);
                    const float x = (j < 4 ? acc[ai][bj][m][0][j & 3] + a00[j & 3] : acc[ai][bj][m][1][j & 3] + a01[j & 3]);
                    const float kkc = j < 4 ? kk0[j & 3] : kk1[j & 3], kac = j < 4 ? ka0[j & 3] : ka1[j & 3];
                    const float a = sigmoidf_(x); const float kk = kz * kkc * inv; kp[j] = kz * (1.0f + (a - 1.0f) * kac); bb[j] = kk * a; an[j] = -kk; }
                *(u32x4*)(KP + off) = (u32x4){cvt_pk_bf16(kp[0], kp[1]), cvt_pk_bf16(kp[2], kp[3]), cvt_pk_bf16(kp[4], kp[5]), cvt_pk_bf16(kp[6], kp[7])};
                *(u32x4*)(AN + off) = (u32x4){cvt_pk_bf16(an[0], an[1]), cvt_pk_bf16(an[2], an[3]), cvt_pk_bf16(an[4], an[5]), cvt_pk_bf16(an[6], an[7])};
                *(u32x4*)(BB + off) = (u32x4){cvt_pk_bf16(bb[0], bb[1]), cvt_pk_bf16(bb[2], bb[3]), cvt_pk_bf16(bb[4], bb[5]), cvt_pk_bf16(bb[6], bb[7])}; }
            asm volatile("" ::: "memory"); }
    }
};
struct EpiGateFused {
    static constexpr bool PERM = true, AFTER_DRAIN = false; static constexpr int MID_T = 32;
    const bf16_t* PROJ; bf16_t* MERGED;
    __device__ __forceinline__ void mid(f32x4 (&acc)[2][2][4][2], const Unit& u, int wr, int wc, int fr, int fq) const {
        const int row0 = u.orow + wr * 64 + fr, col0 = u.ocol + wc * 32 + 8 * fq;
#pragma unroll
        EPI_LOOP_AI_M { const int row = row0 + ai * HALF + m * 16;
#pragma unroll
            for (int bj = 0; bj < 2; ++bj) { const int col = col0 + bj * HALF;
                const u32x4 g1v = *(const u32x4*)(PROJ + (size_t)row * PC + GATE0 + col), g2v = *(const u32x4*)(PROJ + (size_t)row * PC + GATE0 + 2048 + col);
                const unsigned w1[4] = {g1v.x, g1v.y, g1v.z, g1v.w}, w2[4] = {g2v.x, g2v.y, g2v.z, g2v.w};
#pragma unroll
                for (int j = 0; j < 8; ++j) { const float x1 = bf2f((w1[j >> 1] >> (16 * (j & 1))) & 0xffffu), x2 = fmaxf(bf2f((w2[j >> 1] >> (16 * (j & 1))) & 0xffffu), -60.0f);
                    const float ratio = (1.0f + __expf(-x2)) / (1.0f + __expf(-x1));
                    if (j < 4) acc[ai][bj][m][0][j & 3] *= ratio; else acc[ai][bj][m][1][j & 3] *= ratio; } }
            asm volatile("" ::: "memory"); }
    }
    __device__ __forceinline__ void operator()(const f32x4 (&acc)[2][2][4][2], const Unit& u, int wr, int wc, int fr, int fq) const {
        const int row0 = u.orow + wr * 64 + fr, col0 = u.ocol + wc * 32 + 8 * fq;
#pragma unroll
        EPI_LOOP_AI_M { const int row = row0 + ai * HALF + m * 16;
#pragma unroll
            for (int bj = 0; bj < 2; ++bj) { const int col = col0 + bj * HALF; const u32x4 gv = *(const u32x4*)(PROJ + (size_t)row * PC + GATE0 + 2048 + col);
                const unsigned w2[4] = {gv.x, gv.y, gv.z, gv.w}; float o[8];
#pragma unroll
                for (int j = 0; j < 8; ++j) { const float x2 = fmaxf(bf2f((w2[j >> 1] >> (16 * (j & 1))) & 0xffffu), -60.0f); o[j] = (j < 4 ? acc[ai][bj][m][0][j & 3] : acc[ai][bj][m][1][j & 3]) * sigmoidf_(x2); }
                u32x4 w; w.x = cvt_pk_bf16(o[0], o[1]); w.y = cvt_pk_bf16(o[2], o[3]); w.z = cvt_pk_bf16(o[4], o[5]); w.w = cvt_pk_bf16(o[6], o[7]);
                *(u32x4*)(MERGED + (size_t)row * D + col) = w; }
            asm volatile("" ::: "memory"); }
    }
};
struct EpiSwiglu {
    static constexpr bool PERM = true, AFTER_DRAIN = false; static constexpr int MID_T = -1;
    const float* b1; bf16_t* H;
    __device__ __forceinline__ float sw(float g, float l) const { g = fminf(g, 7.0f); l = fminf(fmaxf(l, -7.0f), 7.0f); return g * sigmoidf_(1.702f * g) * (l + 1.0f); }
    __device__ __forceinline__ void operator()(const f32x4 (&acc)[2][2][4][2], const Unit& u, int wr, int wc, int fr, int fq) const {
        const int row0 = u.orow + wr * 64 + fr, col0 = u.ocol + wc * 32 + 8 * fq;
        f32x4 bv[2][2];
#pragma unroll
        for (int bj = 0; bj < 2; ++bj)
#pragma unroll
            for (int n = 0; n < 2; ++n) bv[bj][n] = *(const f32x4*)(b1 + (size_t)u.aux * 4096 + col0 + bj * HALF + 4 * n);
#pragma unroll
        EPI_LOOP_AI_M { const int row = row0 + ai * HALF + m * 16;
#pragma unroll
            for (int bj = 0; bj < 2; ++bj) { const f32x4 v0 = acc[ai][bj][m][0] + bv[bj][0], v1 = acc[ai][bj][m][1] + bv[bj][1];
                *(unsigned*)((unsigned char*)H + (size_t)row * DFF + ((col0 + bj * HALF) >> 1)) = pk4_fp8(sw(v0[0], v0[1]), sw(v0[2], v0[3]), sw(v1[0], v1[1]), sw(v1[2], v1[3])); } }
    }
};
struct EpiSoftmax {
    static constexpr bool PERM = true, AFTER_DRAIN = true; static constexpr int MID_T = -1;
    bf16_t* PP;
    __device__ __forceinline__ void fused(f32x4 (&acc)[2][2][4][2], const Unit& u, int wr, int wc, int fr, int fq, PG8_LAS unsigned char* lds, int wid, int lane) const {
        PG8_LAS float* P1 = (PG8_LAS float*)lds;
        PG8_LAS float* P2 = (PG8_LAS float*)(lds + 4096);
        float mx[2][4];
#pragma unroll
        EPI_LOOP_AI_M { float v = -3.0e38f;
#pragma unroll
            for (int bj = 0; bj < 2; ++bj)
#pragma unroll
                for (int n = 0; n < 2; ++n) { const f32x4 x = acc[ai][bj][m][n]; v = fmaxf(v, fmaxf(fmaxf(x[0], x[1]), fmaxf(x[2], x[3]))); }
            v = fmaxf(v, __shfl_xor(v, 16)); v = fmaxf(v, __shfl_xor(v, 32));
            if (fq == 0) P1[(ai * HALF + wr * 64 + m * 16 + fr) * 4 + wc] = v; }
        asm volatile("s_waitcnt lgkmcnt(0)" ::: "memory"); __builtin_amdgcn_s_barrier(); asm volatile("" ::: "memory");
#pragma unroll
        EPI_LOOP_AI_M { const f32x4 t = *(const PG8_LAS f32x4*)(P1 + (ai * HALF + wr * 64 + m * 16 + fr) * 4); mx[ai][m] = fmaxf(fmaxf(t[0], t[1]), fmaxf(t[2], t[3])); }
#pragma unroll
        EPI_LOOP_AI_M { float s = 0.f;
#pragma unroll
            for (int bj = 0; bj < 2; ++bj)
#pragma unroll
                for (int n = 0; n < 2; ++n) { f32x4 x = acc[ai][bj][m][n];
#pragma unroll
                    for (int j = 0; j < 4; ++j) { x[j] = __expf(x[j] - mx[ai][m]); s += x[j]; }
                    acc[ai][bj][m][n] = x; }
            s += __shfl_xor(s, 16); s += __shfl_xor(s, 32);
            if (fq == 0) P2[(ai * HALF + wr * 64 + m * 16 + fr) * 4 + wc] = s; }
        asm volatile("s_waitcnt lgkmcnt(0)" ::: "memory"); __builtin_amdgcn_s_barrier(); asm volatile("" ::: "memory");
        const int row0 = u.orow + wr * 64 + fr, col0 = wc * 32 + 8 * fq;
#pragma unroll
        EPI_LOOP_AI_M { const f32x4 t = *(const PG8_LAS f32x4*)(P2 + (ai * HALF + wr * 64 + m * 16 + fr) * 4); const float inv = 1.0f / ((t[0] + t[1]) + (t[2] + t[3]));
            bf16_t* rowp = PP + (size_t)(row0 + ai * HALF + m * 16) * 256 + col0;
#pragma unroll
            for (int bj = 0; bj < 2; ++bj) { const f32x4 v0 = acc[ai][bj][m][0] * inv, v1 = acc[ai][bj][m][1] * inv;
                u32x4 w; w.x = cvt_pk_bf16(v0[0], v0[1]); w.y = cvt_pk_bf16(v0[2], v0[3]); w.z = cvt_pk_bf16(v1[0], v1[1]); w.w = cvt_pk_bf16(v1[2], v1[3]);
                *(u32x4*)(rowp + bj * HALF) = w; } }
        asm volatile("s_waitcnt lgkmcnt(0)" ::: "memory"); __builtin_amdgcn_s_barrier(); asm volatile("" ::: "memory");
    }
};
}

constexpr size_t MiB = 1u << 20;
constexpr size_t al256(size_t x) { return (x + 255) & ~(size_t)255; }
constexpr size_t WS_CTL = 0, CTL_ZERO_BYTES = 1 * MiB;
constexpr size_t WS_WIN = 1 * MiB;
constexpr size_t WS_WUP = WS_WIN + (size_t)PC * D * 2;
constexpr size_t WS_AUP = WS_WUP + (size_t)D * 256 * 2;
constexpr size_t WS_GUP = WS_AUP + (size_t)D * 256 * 2;
constexpr size_t WS_PA = WS_GUP + (size_t)D * 256 * 2;
constexpr size_t WS_PB = WS_PA + (size_t)D * D * 2;
constexpr size_t WS_WOUT = WS_PB + (size_t)D * 512 * 2;
constexpr size_t WS_WQ = WS_WOUT + (size_t)D * D * 2;
constexpr size_t WS_WKV = WS_WQ + (size_t)D * D * 2;
constexpr size_t WS_WO = WS_WKV + (size_t)2 * D * D * 2;
constexpr size_t WS_W1 = WS_WO + (size_t)D * D * 2;
constexpr size_t WS_W2 = WS_W1 + (size_t)NEXP * 4096 * D * 2;
constexpr size_t WS_XB = WS_W2 + (size_t)NEXP * D * DFF * 2;
constexpr size_t WS_MEMB = WS_XB + (size_t)M * D * 2;
constexpr size_t WS_ROT = WS_MEMB + (size_t)1024 * D * 2;
constexpr size_t WS_KB = WS_ROT + (size_t)2 * SEQ * 32 * 4;
constexpr size_t WS_VT = WS_KB + (size_t)1024 * D * 2;
constexpr size_t WS_YA = WS_VT + (size_t)1024 * D * 2;
constexpr size_t WS_YB = WS_YA + (size_t)M * D * 2;
constexpr size_t WS_TMP = WS_YB + (size_t)M * 512 * 2;
constexpr size_t WS_MERGED = WS_TMP + (size_t)M * D * 4;
constexpr size_t WS_E = WS_MERGED + (size_t)M * D * 2;
constexpr size_t WS_PROJ = WS_E;
constexpr size_t WS_RZ = WS_PROJ + (size_t)M * PC * 2;
constexpr size_t WS_KZ = WS_RZ + (size_t)M * D * 4;
constexpr size_t WS_VZ = WS_KZ + (size_t)M * D * 4;
constexpr size_t WS_DEC = WS_VZ + (size_t)M * D * 4;
constexpr size_t WS_KP = WS_DEC + (size_t)M * D * 4;
constexpr size_t WS_AN = WS_KP + (size_t)M * D * 4;
constexpr size_t WS_BB = WS_AN + (size_t)M * D * 4;
constexpr size_t WS_GG = WS_BB + (size_t)M * D * 4;
constexpr size_t WS_YS = WS_GG + (size_t)M * D * 4;
constexpr size_t WS_XQ = WS_YS + 60 * MiB;
constexpr size_t WS_WIN8 = WS_YS + 96 * MiB;
constexpr size_t WS_VR = WS_YS + 4 * MiB;
constexpr size_t WS_AO = WS_YS + (size_t)M * D * 4;
constexpr size_t WS_LSE = WS_AO + (size_t)3 * M * 512 * 4;
constexpr size_t WS_QR = WS_LSE + (size_t)3 * M * 8 * 4;
constexpr size_t WS_KR = WS_QR + (size_t)M * 1536 * 2;
constexpr size_t WS_LIN = WS_KR + (size_t)M * 1536 * 2;
constexpr size_t WS_KNORM = WS_LIN + (size_t)M * 768 * 2;
constexpr size_t WS_F = WS_KNORM + (size_t)M * 32 * 4;
constexpr size_t WS_E_END = WS_F + (size_t)128 * 128 * 96 * 96 * 2;
constexpr size_t WS_T1 = WS_E;
constexpr size_t WS_X1 = WS_T1 + (size_t)M * D * 4;
constexpr size_t WS_X1B = WS_X1 + (size_t)M * D * 4;
constexpr size_t WS_Q = WS_X1B + (size_t)M * D * 2;
constexpr size_t WS_PP = WS_Q + (size_t)M * D * 2;
constexpr size_t WS_OC = WS_PP + (size_t)16 * SEQ * 256 * 2;
constexpr size_t WS_T2 = WS_OC + (size_t)M * D * 2;
constexpr size_t WS_X2 = WS_T2 + (size_t)M * D * 4;
constexpr size_t WS_X2B = WS_X2 + (size_t)M * D * 4;
constexpr size_t WS_LIST = WS_X2B + (size_t)M * D * 2;
constexpr size_t WS_ROWI = WS_LIST + (size_t)NEXP * CAP * 4;
constexpr size_t WS_TOPW = WS_ROWI + (size_t)M * 4 * 4;
constexpr size_t WS_H = WS_TOPW + (size_t)M * 4 * 4;
constexpr size_t WS_Y = WS_H + (size_t)HROWS * DFF * 2;
constexpr size_t WS_L_END = WS_Y + (size_t)HROWS * D * 4;
constexpr size_t WS_END = (WS_E_END > WS_L_END ? WS_E_END : WS_L_END);
static_assert(WS_END <= (size_t)4090 * MiB, "workspace map exceeds 4 x largest input");
constexpr int CW_TMO = 0, CW_CNT = 64  , CW_Q = 128  , CW_BAR = 4096;

constexpr int RING_BYTES = 131072, MISC_OFF = RING_BYTES, LDS_BYTES = 147456;

#define XB_TMO      128
#define XB_XCNT(j)  (256  + 64 * (j))
#define XB_XSUB(j)  (1280 + 64 * (j))
#define XB_XGEN(j)  (2304 + 64 * (j))
#define XB_TOP      3328
#define XB_TOPGEN   3392
#define XCD_BAR_WORDS 3456
#define XB_SPIN_CAP (1u << 18)
__device__ __forceinline__ unsigned xb_ld(unsigned* p)              { return __hip_atomic_load(p, __ATOMIC_RELAXED, __HIP_MEMORY_SCOPE_AGENT); }
__device__ __forceinline__ unsigned xb_add(unsigned* p, unsigned v) { return __hip_atomic_fetch_add(p, v, __ATOMIC_RELAXED, __HIP_MEMORY_SCOPE_AGENT); }
__device__ __forceinline__ unsigned xb_xcc_id() { return (unsigned)__builtin_amdgcn_s_getreg((3 << 11) | 20) & 0xFu; }
#define XB_SPIN(cond, bar) do { unsigned _sp = 0; while (cond) { __builtin_amdgcn_s_sleep(1); \
    if ((++_sp & 255u) == 0u) { if (xb_ld(&(bar)[XB_TMO])) break; if (_sp > XB_SPIN_CAP) { atomicAdd(&(bar)[XB_TMO], 1u); break; } } } } while (0)
struct XcdBarrier { unsigned* bar; unsigned x; volatile LAS unsigned* st; };
__device__ __forceinline__ XcdBarrier xcd_barrier_post(unsigned* bar, volatile LAS unsigned* st) {
    XcdBarrier b; b.bar = bar; b.x = xb_xcc_id(); b.st = st;
    if (threadIdx.x == 0) (void)xb_add(&bar[XB_XCNT(b.x)], 1u);
    return b;
}
__device__ __forceinline__ void xcd_barrier_complete(unsigned* bar, unsigned x, unsigned& nloc, unsigned& nx) {
    const unsigned G = gridDim.x * gridDim.y * gridDim.z;
    unsigned sum, cnt, mine, sp = 0u;
    for (;;) {
        sum = 0u; cnt = 0u; mine = 0u;
#pragma unroll
        for (unsigned j = 0; j < 16; ++j) { const unsigned c = xb_ld(&bar[XB_XCNT(j)]); sum += c; cnt += (c > 0u) ? 1u : 0u; mine = (j == x) ? c : mine; }
        if (sum == G) break;
        __builtin_amdgcn_s_sleep(1);
        if ((++sp & 255u) == 0u) { if (xb_ld(&bar[XB_TMO])) break; if (sp > XB_SPIN_CAP) { atomicAdd(&bar[XB_TMO], 1u); break; } }
    }
    nloc = mine > 0u ? mine : 1u; nx = cnt > 0u ? cnt : 1u;
}
__device__ __forceinline__ void xcd_barrier(const XcdBarrier& b) {
    asm volatile("s_waitcnt vmcnt(0)" ::: "memory");
    __syncthreads();
    if (threadIdx.x == 0) {
        unsigned* bar = b.bar;
        __builtin_amdgcn_s_waitcnt(0);
        unsigned nloc = b.st[0], nx = b.st[1];
        if (nloc == 0u) { xcd_barrier_complete(bar, b.x, nloc, nx); b.st[0] = nloc; b.st[1] = nx; }
        const unsigned old = xb_add(&bar[XB_XSUB(b.x)], 1u);
        const unsigned gen = old / nloc;
        if (old + 1u == (gen + 1u) * nloc) {
            __builtin_amdgcn_fence(__ATOMIC_RELEASE, "agent");
            asm volatile("s_waitcnt vmcnt(0)" ::: "memory");
            const unsigned og = xb_add(&bar[XB_TOP], 1u);
            const unsigned tg = og / nx;
            if (og + 1u == (tg + 1u) * nx) xb_add(&bar[XB_TOPGEN], 1u);
            else XB_SPIN(xb_ld(&bar[XB_TOPGEN]) == tg, bar);
            __builtin_amdgcn_fence(__ATOMIC_ACQUIRE, "agent");
            xb_add(&bar[XB_XGEN(b.x)], 1u);
            asm volatile("s_waitcnt vmcnt(0)" ::: "memory");
        } else {
            XB_SPIN(xb_ld(&bar[XB_XGEN(b.x)]) == gen, bar);
            __builtin_amdgcn_fence(__ATOMIC_ACQUIRE, "agent");
            asm volatile("s_waitcnt vmcnt(0)" ::: "memory");
        }
    }
    __syncthreads();
}

struct Params {
    const float* in[32];
    float* out; unsigned char* ws;
    int ph_lo, ph_hi, li, pad;
};
enum { I_X = 0, I_MEM, I_WIN, I_MIX, I_W0, I_WUP, I_A0, I_AUP, I_GUP, I_KK, I_KA, I_RK, I_LNXG, I_LNXB, I_PA, I_PB, I_WOUT, I_LN1G, I_LN1B, I_WQ, I_WKV, I_WO, I_LN2G, I_LN2B,
       I_RW, I_RB, I_W1, I_B1, I_W2, I_B2, I_LN3G, I_LN3B };

struct ScoreOrder {
    static constexpr bool GATHER = false;
    const char* Q; const char* KB; int G, c;
    __device__ bool next(int i, pg8::Unit& u) const {
        const int L = i * G + c; if (L >= 256) return false;
        const int bh = L >> 4, pm = L & 15, b = bh >> 2, h = bh & 3;
        u.A = Q + ((size_t)(b * SEQ + 256 * pm) * D + h * 512) * 2; u.B = KB + ((size_t)(b * 256) * D + h * 512) * 2;
        u.orow = bh * SEQ + 256 * pm; u.ocol = 0; u.aux = 0; u.aux2 = 0; u.valid = 256; return true;
    }
    __device__ __forceinline__ const int* rows(const pg8::Unit&) const { return nullptr; }
};
struct PvOrder {
    static constexpr bool GATHER = false;
    const char* PP; const char* VT; int G, c;
    __device__ bool next(int i, pg8::Unit& u) const {
        const int L = i * G + c; if (L >= 512) return false;
        const int bh = L >> 5, pm = (L >> 1) & 15, pn = L & 1, b = bh >> 2, h = bh & 3;
        u.A = PP + ((size_t)(bh * SEQ + 256 * pm) * 256) * 2; u.B = VT + ((size_t)(bh * 512 + 256 * pn) * 256) * 2;
        u.orow = b * SEQ + 256 * pm; u.ocol = h * 512 + 256 * pn; u.aux = 0; u.aux2 = 0; u.valid = 256; return true;
    }
    __device__ __forceinline__ const int* rows(const pg8::Unit&) const { return nullptr; }
};
template <bool GATHER_, int NT  > struct MoeOrder {
    static constexpr bool GATHER = GATHER_;
    const LAS int* tab; const char* A; const char* W; const int* list; size_t wexp  ; int ldb; int G, c;
    __device__ bool next(int i, pg8::Unit& u) const {
        constexpr int RPR = 256 / NT;
        const int rt = i * RPR + (c % RPR), pn = c / RPR, T = __builtin_amdgcn_readfirstlane(tab[64]);
        if (c >= 256 || rt >= T) return false;
        int e = 0;
        for (int j = 1; j < NEXP; ++j) e = (rt >= __builtin_amdgcn_readfirstlane(tab[32 + j])) ? j : e;
        const int lt = rt - __builtin_amdgcn_readfirstlane(tab[32 + e]), cnt = __builtin_amdgcn_readfirstlane(tab[e]);
        u.aux = e; u.aux2 = lt; u.valid = min(256, cnt - 256 * lt); u.orow = 256 * rt; u.ocol = 256 * pn;
        u.B = W + (size_t)e * wexp + (size_t)(256 * pn) * ldb;
        u.A = GATHER_ ? A : A + (size_t)(256 * rt) * DFF;
        return true;
    }
    __device__ __forceinline__ const int* rows(const pg8::Unit& u) const { return list + (size_t)u.aux * CAP + 256 * u.aux2; }
};

struct Ctx { int tid, lane, wave, vcu, G; LAS unsigned char* lds; unsigned char* ws; };

__device__ __forceinline__ void cv_issue(const float* W, int ldw, int Ksrc, int sc0, int k0, int lane, float (&cv)[32]) {
    const int kb = k0 + 32 * (lane >> 5); const bool ok = sc0 >= 0 && kb < Ksrc;
    const float* src = W + (ok ? (size_t)kb * ldw + sc0 + (lane & 31) : (size_t)0);
#pragma unroll
    for (int i = 0; i < 32; ++i) { const float v = src[(size_t)i * ldw]; cv[i] = ok ? v : 0.f; }
}
__device__ __forceinline__ void cv_store16(const float (&cv)[32], bf16_t* WT, int ldt, int n0, int k0, int lane) {
    u32x4* dst = (u32x4*)(WT + (size_t)(n0 + (lane & 31)) * ldt + k0 + 32 * (lane >> 5));
#pragma unroll
    for (int j = 0; j < 4; ++j) dst[j] = (u32x4){pk2(cv[8 * j], cv[8 * j + 1]), pk2(cv[8 * j + 2], cv[8 * j + 3]), pk2(cv[8 * j + 4], cv[8 * j + 5]), pk2(cv[8 * j + 6], cv[8 * j + 7])};
}
__device__ __forceinline__ void cv_store8(const float (&cv)[32], unsigned char* WT8, int ldt, int n0, int k0, int lane) {
    u32x4* dst = (u32x4*)(WT8 + (size_t)(n0 + (lane & 31)) * ldt + k0 + 32 * (lane >> 5));
#pragma unroll
    for (int j = 0; j < 2; ++j) dst[j] = (u32x4){pk4_fp8(cv[16 * j] * 64.f, cv[16 * j + 1] * 64.f, cv[16 * j + 2] * 64.f, cv[16 * j + 3] * 64.f), pk4_fp8(cv[16 * j + 4] * 64.f, cv[16 * j + 5] * 64.f, cv[16 * j + 6] * 64.f, cv[16 * j + 7] * 64.f),
        pk4_fp8(cv[16 * j + 8] * 64.f, cv[16 * j + 9] * 64.f, cv[16 * j + 10] * 64.f, cv[16 * j + 11] * 64.f), pk4_fp8(cv[16 * j + 12] * 64.f, cv[16 * j + 13] * 64.f, cv[16 * j + 14] * 64.f, cv[16 * j + 15] * 64.f)};
}
struct CvJob { const float* W; bf16_t* WT; int ldw, Ksrc, sc0, ldt, n0, k0, f8, kd; };
__device__ __forceinline__ CvJob p0_job(const Params& p, unsigned char* ws, int it) {
    constexpr int I_WINJ = 32 * 480, I_LORA = 4 * 64, I_SQ = 32 * 64, I_PBJ = 8 * 64, I_KVJ = 32 * 128;
    CvJob j; j.f8 = 0; j.kd = 0; int r = it;
#define P0_PLAIN(SRC, DST, N_, KS_, KD_) { const int nblk = (N_) / 32, kb = r / nblk, nb = r % nblk; j.W = p.in[SRC]; j.WT = (bf16_t*)(ws + (DST)); j.ldw = (N_); j.Ksrc = (KS_); j.sc0 = 32 * nb; j.ldt = (KD_); j.n0 = 32 * nb; j.k0 = 64 * kb; return j; }
    if (r < I_WINJ) { const int kb = r / 480, nb = r % 480; j.W = p.in[I_WIN]; j.WT = (bf16_t*)(ws + WS_WIN); j.ldw = 15296; j.Ksrc = D; const int n_ = 32 * nb;
        j.sc0 = n_ < RWC ? n_ : (n_ < ATTV2 ? -1 : (n_ < ATT0 ? RWC + 4096 + (n_ - ATTV2) : (n_ < GATE0 ? RWC + (n_ - ATT0) : n_ - 64))); j.ldt = D; j.n0 = n_; j.k0 = 64 * kb;
        if (n_ >= ATT0) { j.f8 = 1; j.WT = (bf16_t*)(ws + WS_WIN8); j.n0 = n_ - ATT0; }
        return j; } r -= I_WINJ;
    if (r < I_LORA) P0_PLAIN(I_WUP, WS_WUP, D, 96, 256) r -= I_LORA;
    if (r < I_LORA) P0_PLAIN(I_AUP, WS_AUP, D, 96, 256) r -= I_LORA;
    if (r < I_LORA) P0_PLAIN(I_GUP, WS_GUP, D, 256, 256) r -= I_LORA;
    if (r < I_SQ) P0_PLAIN(I_PA, WS_PA, D, D, 2560) r -= I_SQ;
    if (r < I_PBJ) { const int kb = r / 64, nb = r % 64; j.W = p.in[I_PB]; j.WT = (bf16_t*)(ws + WS_PA); j.ldw = D; j.Ksrc = 512; j.sc0 = 32 * nb; j.ldt = 2560; j.n0 = 32 * nb; j.k0 = 64 * kb; j.kd = 2048; return j; } r -= I_PBJ;
    if (r < I_SQ) P0_PLAIN(I_WOUT, WS_WOUT, D, D, D) r -= I_SQ;
    if (r < I_SQ) P0_PLAIN(I_WQ, WS_WQ, D, D, D) r -= I_SQ;
    if (r < I_KVJ) P0_PLAIN(I_WKV, WS_WKV, 2 * D, D, D) r -= I_KVJ;
    P0_PLAIN(I_WO, WS_WO, D, D, D)
#undef P0_PLAIN
}
__device__ __forceinline__ void p0_prologue(const Params& p, const Ctx& c) {
    const int gw = c.vcu * 8 + c.wave, NGW = c.G * 8;
    unsigned char* ws = c.ws;
    constexpr int NITEMS = 32 * 480 + 3 * (4 * 64) + 4 * (32 * 64) + 8 * 64 + 32 * 128;
    { float ca[32], cb[32]; CvJob ja, jb; int it = gw;
      if (it < NITEMS) { ja = p0_job(p, ws, it); cv_issue(ja.W, ja.ldw, ja.Ksrc, ja.sc0, ja.k0, c.lane, ca); }
      for (; it < NITEMS; it += 2 * NGW) {
          if (it + NGW < NITEMS) { jb = p0_job(p, ws, it + NGW); cv_issue(jb.W, jb.ldw, jb.Ksrc, jb.sc0, jb.k0, c.lane, cb); }
          if (ja.f8) cv_store8(ca, (unsigned char*)ja.WT, ja.ldt, ja.n0, ja.k0, c.lane); else cv_store16(ca, ja.WT, ja.ldt, ja.n0, ja.k0 + ja.kd, c.lane);
          if (it + 2 * NGW < NITEMS) { ja = p0_job(p, ws, it + 2 * NGW); cv_issue(ja.W, ja.ldw, ja.Ksrc, ja.sc0, ja.k0, c.lane, ca); }
          if (it + NGW < NITEMS) { if (jb.f8) cv_store8(cb, (unsigned char*)jb.WT, jb.ldt, jb.n0, jb.k0, c.lane); else cv_store16(cb, jb.WT, jb.ldt, jb.n0, jb.k0 + jb.kd, c.lane); }
      } }
    const size_t gt = (size_t)c.vcu * 512 + c.tid, NT = (size_t)c.G * 512;
    for (size_t i = gt; i < (size_t)M * D / 8; i += NT) { const f32x4 a = ((const f32x4*)p.in[I_X])[2 * i], b = ((const f32x4*)p.in[I_X])[2 * i + 1];
        u32x4 o; o.x = pk2(a[0], a[1]); o.y = pk2(a[2], a[3]); o.z = pk2(b[0], b[1]); o.w = pk2(b[2], b[3]); ((u32x4*)(ws + WS_XB))[i] = o;
        ((u32x2*)(ws + WS_XQ))[i] = (u32x2){pk4_fp8(a[0], a[1], a[2], a[3]), pk4_fp8(b[0], b[1], b[2], b[3])}; }
    for (size_t i = gt; i < (size_t)1024 * D / 8; i += NT) { const f32x4 a = ((const f32x4*)p.in[I_MEM])[2 * i], b = ((const f32x4*)p.in[I_MEM])[2 * i + 1];
        u32x4 o; o.x = pk2(a[0], a[1]); o.y = pk2(a[2], a[3]); o.z = pk2(b[0], b[1]); o.w = pk2(b[2], b[3]); ((u32x4*)(ws + WS_MEMB))[i] = o; }
    float* rc = (float*)(ws + WS_ROT); float* rs = rc + SEQ * 32;
    for (size_t i = gt; i < (size_t)SEQ * 32; i += NT) { const int pos = (int)(i >> 5), j = (int)(i & 31);
        const double inv = exp(-(double)j * (9.210340371976184 / 32.0)); const double ang = (double)pos * inv; rc[i] = (float)cos(ang); rs[i] = (float)sin(ang); }
}

constexpr int MOE_W1E = 32 * 128, MOE_W2E = 32 * 64, MOE_CONV_GROUPS = (NEXP * MOE_W2E) / 8;
__device__ __forceinline__ void conv_group(const Params& p, const Ctx& c, int gi) {
    unsigned char* ws = c.ws;
    const int r = gi * 8 + c.wave;
    const int e = r / MOE_W2E, it = r % MOE_W2E, kb = it >> 6, nb = it & 63;
    float cv[32]; cv_issue(p.in[I_W2] + (size_t)e * DFF * D, D, DFF, 32 * nb, 64 * kb, c.lane, cv);
    cv_store8(cv, ws + WS_W2 + (size_t)e * D * DFF, DFF, 32 * nb, 64 * kb, c.lane);
}

#define DPP_ADD(x, ctrl) ((x) + __builtin_bit_cast(float, __builtin_amdgcn_update_dpp(0, __builtin_bit_cast(int, (x)), (ctrl), 0xF, 0xF, true)))
struct P2Tok { u32x4 cv0, pv0, cv1, pv1, ra, rb, vv; f32x4 c0, c1, s0, s1; };
__device__ __forceinline__ void p2_prep(const Params& p, const Ctx& c) {
    unsigned char* ws = c.ws;
    const bf16_t* PROJ = (const bf16_t*)(ws + WS_PROJ);
    const float* mix = p.in[I_MIX]; const float* k_k = p.in[I_KK];
    bf16_t* RZ = (bf16_t*)(ws + WS_RZ); bf16_t* KZ = (bf16_t*)(ws + WS_KZ); bf16_t* VZ = (bf16_t*)(ws + WS_VZ);
    bf16_t* LIN = (bf16_t*)(ws + WS_LIN); float* KNORM = (float*)(ws + WS_KNORM);
    bf16_t* QR = (bf16_t*)(ws + WS_QR); bf16_t* KR = (bf16_t*)(ws + WS_KR); bf16_t* VR = (bf16_t*)(ws + WS_VR);
    const float* rc = (const float*)(ws + WS_ROT); const float* rs = rc + SEQ * 32;
    int tid_ = c.tid; asm volatile("" : "+v"(tid_));
    const int tid = tid_;
    const int ch0 = tid, ch1 = tid + 512; const bool has1 = ch1 < 824;
    const f32x4 m00 = *(const f32x4*)(mix + 8 * ch0), m01 = *(const f32x4*)(mix + 8 * ch0 + 4);
    f32x4 m10 = (f32x4){0.f, 0.f, 0.f, 0.f}, m11 = m10; if (has1) { m10 = *(const f32x4*)(mix + 8 * ch1); m11 = *(const f32x4*)(mix + 8 * ch1 + 4); }
    f32x4 kk0 = (f32x4){0.f, 0.f, 0.f, 0.f}, kk1 = kk0; if (tid >= 256) { kk0 = *(const f32x4*)(k_k + 8 * (tid - 256)); kk1 = *(const f32x4*)(k_k + 8 * (tid - 256) + 4); }
    const bool rot = tid >= 64 && tid < 256, vcp = tid >= 256 && tid < 448;
    const int rw = tid - 64, which = rw / 96, rhh = (rw % 96) >> 2, re0 = (rw & 3) * 8;
    const int vhh = (tid - 256) >> 3, ve0 = ((tid - 256) & 7) * 8;
#define P2_LOAD(T, t_) do { const int pos_ = (t_) & (SEQ - 1); const bf16_t* cur_ = PROJ + (size_t)(t_) * PC; const u32x4 z4_ = (u32x4){0u, 0u, 0u, 0u}; \
        T.cv0 = *(const u32x4*)(cur_ + 8 * ch0); T.pv0 = pos_ > 0 ? *(const u32x4*)(cur_ - PC + 8 * ch0) : z4_; \
        if (has1) { T.cv1 = *(const u32x4*)(cur_ + 8 * ch1); T.pv1 = pos_ > 0 ? *(const u32x4*)(cur_ - PC + 8 * ch1) : z4_; } \
        if (rot) { const bf16_t* src_ = cur_ + ATT0 + which * 1536 + rhh * 64 + re0; T.ra = *(const u32x4*)src_; T.rb = *(const u32x4*)(src_ + 32); \
            T.c0 = *(const f32x4*)(rc + pos_ * 32 + re0); T.c1 = *(const f32x4*)(rc + pos_ * 32 + re0 + 4); T.s0 = *(const f32x4*)(rs + pos_ * 32 + re0); T.s1 = *(const f32x4*)(rs + pos_ * 32 + re0 + 4); } \
        if (vcp) { const int ao_ = 2 * 1536 + vhh * 64 + ve0; T.vv = *(const u32x4*)(cur_ + (ao_ < 4096 ? ATT0 + ao_ : ATTV2 + ao_ - 4096)); } } while (0)
#define P2_SHIFT(z, cv, pv, ma, mb) do { const unsigned cw[4] = {cv.x, cv.y, cv.z, cv.w}, pw[4] = {pv.x, pv.y, pv.z, pv.w}; const float mm[8] = {ma[0], ma[1], ma[2], ma[3], mb[0], mb[1], mb[2], mb[3]}; \
        _Pragma("unroll") for (int j = 0; j < 4; ++j) { const float c0_ = bf2f(cw[j] & 0xffffu), c1_ = bf2f(cw[j] >> 16), q0_ = bf2f(pw[j] & 0xffffu), q1_ = bf2f(pw[j] >> 16); \
            z[2 * j] = c0_ + (q0_ - c0_) * mm[2 * j]; z[2 * j + 1] = c1_ + (q1_ - c1_) * mm[2 * j + 1]; } } while (0)
#define P2_PROC(T, t_) do { const int t = (t_), pos = t & (SEQ - 1); \
        { float z[8]; P2_SHIFT(z, T.cv0, T.pv0, m00, m01);            \
          bf16_t* dst = (tid < 256 ? RZ : KZ) + (size_t)t * D + 8 * (tid & 255); \
          { u32x4 w8; w8.x = pk2(z[0], z[1]); w8.y = pk2(z[2], z[3]); w8.z = pk2(z[4], z[5]); w8.w = pk2(z[6], z[7]); *(u32x4*)dst = w8; } \
          if (tid >= 256) { float sq = 0.f; _Pragma("unroll") for (int j = 0; j < 4; ++j) { const float a_ = z[j] * kk0[j], b_ = z[4 + j] * kk1[j]; sq += a_ * a_ + b_ * b_; } \
              sq = DPP_ADD(sq, 0xB1); sq = DPP_ADD(sq, 0x4E); sq = DPP_ADD(sq, 0x141);                   \
              if ((tid & 7) == 0) KNORM[(size_t)t * 32 + ((tid - 256) >> 3)] = sqrtf(sq); } } \
        if (has1) { float z[8]; P2_SHIFT(z, T.cv1, T.pv1, m10, m11);    \
          if (ch1 < 768) { u32x4 w8; w8.x = pk2(z[0], z[1]); w8.y = pk2(z[2], z[3]); w8.z = pk2(z[4], z[5]); w8.w = pk2(z[6], z[7]); *(u32x4*)(VZ + (size_t)t * D + 8 * (ch1 - 512)) = w8; } \
          else { float o[8]; int dcol; \
              if (ch1 < 780) { dcol = 8 * (ch1 - 768); _Pragma("unroll") for (int j = 0; j < 8; ++j) o[j] = tanhf(z[j]); } \
              else if (ch1 < 792) { dcol = 256 + 8 * (ch1 - 780); _Pragma("unroll") for (int j = 0; j < 8; ++j) o[j] = z[j]; } \
              else { dcol = 512 + 8 * (ch1 - 792); _Pragma("unroll") for (int j = 0; j < 8; ++j) o[j] = sigmoidf_(z[j]); } \
              u32x4 w; w.x = pk2(o[0], o[1]); w.y = pk2(o[2], o[3]); w.z = pk2(o[4], o[5]); w.w = pk2(o[6], o[7]); *(u32x4*)(LIN + (size_t)t * 768 + dcol) = w; } } \
        if (tid >= 448 && tid < 488) { const int q_ = tid - 448; const int dcol = (q_ < 20) ? 96 + 8 * q_ : 352 + 8 * (q_ - 20); *(u32x4*)(LIN + (size_t)t * 768 + dcol) = (u32x4){0u, 0u, 0u, 0u}; } \
        if (rot) { const unsigned aw[4] = {T.ra.x, T.ra.y, T.ra.z, T.ra.w}, bw[4] = {T.rb.x, T.rb.y, T.rb.z, T.rb.w}; float o1[8], o2[8]; \
            _Pragma("unroll") for (int j = 0; j < 8; ++j) { const float t1 = bf2f((aw[j >> 1] >> (16 * (j & 1))) & 0xffffu), t2 = bf2f((bw[j >> 1] >> (16 * (j & 1))) & 0xffffu); \
                const float cs = j < 4 ? T.c0[j & 3] : T.c1[j & 3], sn = j < 4 ? T.s0[j & 3] : T.s1[j & 3]; o1[j] = t1 * cs - t2 * sn; o2[j] = t2 * cs + t1 * sn; } \
            const int dl_ = rhh < 8 ? 1 : (rhh < 16 ? 4 : 16); const int prm = (pos % dl_) * (SEQ / dl_) + pos / dl_; \
            bf16_t* dst = (which ? KR : QR) + ((size_t)((t >> 12) * 24 + rhh) * SEQ + prm) * 64 + re0; \
            u32x4 w1; w1.x = pk2(o1[0], o1[1]); w1.y = pk2(o1[2], o1[3]); w1.z = pk2(o1[4], o1[5]); w1.w = pk2(o1[6], o1[7]); \
            u32x4 w2; w2.x = pk2(o2[0], o2[1]); w2.y = pk2(o2[2], o2[3]); w2.z = pk2(o2[4], o2[5]); w2.w = pk2(o2[6], o2[7]); \
            *(u32x4*)dst = w1; *(u32x4*)(dst + 32) = w2; } \
        if (vcp) { const int dl_ = vhh < 8 ? 1 : (vhh < 16 ? 4 : 16); const int prm = (pos % dl_) * (SEQ / dl_) + pos / dl_; \
            *(u32x4*)(VR + ((size_t)((t >> 12) * 24 + vhh) * SEQ + prm) * 64 + ve0) = T.vv; } } while (0)
    P2Tok ta, tb;
    int tq = c.vcu;
    if (tq < M) P2_LOAD(ta, tq);
    for (; tq < M; tq += 2 * c.G) {
        if (tq + c.G < M) P2_LOAD(tb, tq + c.G);
        P2_PROC(ta, tq);
        if (tq + 2 * c.G < M) P2_LOAD(ta, tq + 2 * c.G);
        if (tq + c.G < M) P2_PROC(tb, tq + c.G);
    }
#undef P2_LOAD
#undef P2_SHIFT
#undef P2_PROC
}

__device__ __forceinline__ float wave_sum_dpp(float x) {
    x = DPP_ADD(x, 0xB1); x = DPP_ADD(x, 0x4E); x = DPP_ADD(x, 0x141); x = DPP_ADD(x, 0x140);
    const int xi = __builtin_bit_cast(int, x);
    return (__builtin_bit_cast(float, __builtin_amdgcn_readlane(xi, 0)) + __builtin_bit_cast(float, __builtin_amdgcn_readlane(xi, 16))) +
           (__builtin_bit_cast(float, __builtin_amdgcn_readlane(xi, 32)) + __builtin_bit_cast(float, __builtin_amdgcn_readlane(xi, 48)));
}
__device__ __forceinline__ f32x4 tile_mm(const LAS bf16_t* A, int pa, const LAS bf16_t* Bt, int pb, int ks, int fr, int fq, f32x4 acc) {
    for (int k = 0; k < ks; ++k) { const bf16x8 a = *(const LAS bf16x8*)(A + fr * pa + 32 * k + 8 * fq), b = *(const LAS bf16x8*)(Bt + fr * pb + 32 * k + 8 * fq);
        acc = __builtin_amdgcn_mfma_f32_16x16x32_bf16(a, b, acc, 0, 0, 0); }
    return acc;
}
__device__ __forceinline__ u32x2 pack4(f32x4 v) { u32x2 w; w.x = pk2(v[0], v[1]); w.y = pk2(v[2], v[3]); return w; }
constexpr int SC_C = 32, SC_NCH = SEQ / SC_C, SC_F = 96;
constexpr int PL_X1 = 0, PL_X2 = 9216, PL_AL = 18432, PL_HT = 26112, PL_ET = 33792, PL_LBT = 53760, PL_TT = 58368, PL_XB = 60928, PL_GI = PL_X1, PL_TF = PL_X2, PL_END = 62016, PL_GRP = 65536;
#define LBAR() do { asm volatile("s_waitcnt lgkmcnt(0)" ::: "memory"); __builtin_amdgcn_s_barrier(); asm volatile("" ::: "memory"); } while (0)
__device__ __forceinline__ void p4_pre(const Params& p, const Ctx& c) {
    unsigned char* ws = c.ws;
    const bf16_t* RZ = (const bf16_t*)(ws + WS_RZ); const float* DEC = (const float*)(ws + WS_DEC); const bf16_t* KP = (const bf16_t*)(ws + WS_KP);
    const bf16_t* AN = (const bf16_t*)(ws + WS_AN); const bf16_t* BB = (const bf16_t*)(ws + WS_BB);
    bf16_t* FG = (bf16_t*)(ws + WS_F); float* BON = (float*)(ws + WS_YS);
    const float* rkp = p.in[I_RK];
    int tid_ = c.tid; asm volatile("" : "+v"(tid_));
    const int tid = tid_, lane = tid & 63, w = __builtin_amdgcn_readfirstlane(tid >> 6), fr = lane & 15, fq = lane >> 4;
    const int grp = w >> 2, tw = w & 3, gtid = tid & 255;
    LAS unsigned char* gl = c.lds + grp * PL_GRP;
    LAS bf16_t* X1 = (LAS bf16_t*)(gl + PL_X1); LAS bf16_t* X2 = (LAS bf16_t*)(gl + PL_X2); LAS bf16_t* AL = (LAS bf16_t*)(gl + PL_AL); LAS bf16_t* HT = (LAS bf16_t*)(gl + PL_HT);
    LAS bf16_t* ET = (LAS bf16_t*)(gl + PL_ET); LAS float* LBT = (LAS float*)(gl + PL_LBT); LAS bf16_t* TT = (LAS bf16_t*)(gl + PL_TT); LAS bf16_t* GI = (LAS bf16_t*)(gl + PL_GI);
    LAS float* TF = (LAS float*)(gl + PL_TF);
    LAS float* XB = (LAS float*)(gl + PL_XB);
    const int npair = (128 * SC_NCH) / (2 * c.G);
    float dcy[32]; unsigned short ir[8], ik[8], ia[8], ib[8];
#define PRE_LOAD(PAIR) do { const int task_ = c.vcu + (2 * (PAIR) + grp) * c.G; const int bh_ = task_ >> 7, ch_ = task_ & (SC_NCH - 1); \
        const size_t o_ = ((size_t)(bh_ >> 5) * SEQ + (size_t)ch_ * SC_C) * D + (bh_ & 31) * 64 + lane; \
        _Pragma("unroll") for (int s_ = 0; s_ < 32; ++s_) dcy[s_] = DEC[o_ + (size_t)s_ * D]; \
        _Pragma("unroll") for (int q_ = 0; q_ < 8; ++q_) { const size_t oo_ = o_ + (size_t)(8 * tw + q_) * D; ir[q_] = RZ[oo_]; ik[q_] = KP[oo_]; ia[q_] = AN[oo_]; ib[q_] = BB[oo_]; } } while (0)
    const bool bgconv = (c.G == 256);
    if (npair > 0) PRE_LOAD(0);
    for (int pr = 0; pr < npair; ++pr) {
        const int task = c.vcu + (2 * pr + grp) * c.G, bh = task >> 7, chn = task & (SC_NCH - 1);
        const float rkv = rkp[(bh & 31) * 64 + lane];
        float* bon = BON + ((size_t)(bh >> 5) * SEQ + (size_t)chn * SC_C) * 32 + (bh & 31);
        float p0 = 1.f, p1 = 1.f, p2 = 1.f, p3 = 1.f, dsel[8];
#pragma unroll
        for (int s = 0; s < 8; ++s) { p0 *= dcy[s]; p1 *= dcy[8 + s]; p2 *= dcy[16 + s]; p3 *= dcy[24 + s];
            dsel[s] = tw == 0 ? dcy[s] : (tw == 1 ? dcy[8 + s] : (tw == 2 ? dcy[16 + s] : dcy[24 + s])); }
        const float gC = (p0 * p1) * (p2 * p3);
        float g = tw == 0 ? 1.f : (tw == 1 ? p0 : (tw == 2 ? p0 * p1 : (p0 * p1) * p2));
        LBAR();
#pragma unroll
        for (int hq = 0; hq < 2; ++hq) { f32x4 ah4, bg4, kg4;
#pragma unroll
            for (int qq = 0; qq < 4; ++qq) { const int qn = 4 * hq + qq, s = 8 * tw + qn;
                const float gp = g; g *= dsel[qn];
                const float rr = bf2f(ir[qn]), kk = bf2f(ik[qn]), aa = bf2f(ia[qn]), bb = bf2f(ib[qn]); const float ig = 1.0f / g;
                const float ah = aa * gp, bt = bb * ig, kt = kk * ig, rh = rr * g;
                X1[s * 72 + lane] = (bf16_t)f2bf(bt); X1[(32 + s) * 72 + lane] = (bf16_t)f2bf(kt); X2[s * 72 + lane] = (bf16_t)f2bf(ah); X2[(32 + s) * 72 + lane] = (bf16_t)f2bf(rh);
                ET[s * 104 + lane] = (bf16_t)f2bf(rh); ah4[qq] = ah; bg4[qq] = bt * gC; kg4[qq] = kt * gC;
                const float bsum = wave_sum_dpp(rr * kk * rkv); if (lane == 0) bon[(size_t)s * 32] = bsum; }
            *(LAS u32x2*)(AL + lane * 40 + 8 * tw + 4 * hq) = pack4(ah4); *(LAS u32x2*)(HT + (32 + lane) * 40 + 8 * tw + 4 * hq) = pack4(bg4); *(LAS u32x2*)(ET + (32 + lane) * 104 + 64 + 8 * tw + 4 * hq) = pack4(kg4); }
        { const int zr = gtid >> 2, zc = 16 * (gtid & 3); LAS u32x4* zp = (LAS u32x4*)(ET + (32 + zr) * 104 + zc); zp[0] = (u32x4){0u, 0u, 0u, 0u}; zp[1] = (u32x4){0u, 0u, 0u, 0u}; }
        if (pr + 1 < npair) PRE_LOAD(pr + 1);
        float cva[32], cvb[32]; int cea = 0, cna = 0, cka = 0, ceb = 0, cnb = 0, ckb = 0;
        if (bgconv) { const int it0 = ((c.vcu * 32 + pr) * 8 + w) * 2;
            cea = it0 >> 12; { const int rem = it0 & 4095; cka = 64 * (rem >> 7); cna = 32 * (rem & 127); }
            ceb = (it0 + 1) >> 12; { const int rem = (it0 + 1) & 4095; ckb = 64 * (rem >> 7); cnb = 32 * (rem & 127); }
            cv_issue(p.in[I_W1] + (size_t)cea * D * 4096, 4096, D, cna, cka, lane, cva); cv_issue(p.in[I_W1] + (size_t)ceb * D * 4096, 4096, D, cnb, ckb, lane, cvb); }
        LBAR();
        if (tw == 0) ET[(32 + lane) * 104 + lane] = (bf16_t)f2bf(gC);
        { const int mt = tw;
#pragma unroll
          for (int nt = 0; nt < 4; ++nt) {
            f32x4 acc = tile_mm(X1 + 16 * mt * 72, 72, X2 + 16 * nt * 72, 72, 2, fr, fq, (f32x4){0.f, 0.f, 0.f, 0.f});
            const int n = 16 * nt + fr, m0 = 16 * mt + 4 * fq;
            if (mt < 2) { if (nt < 2) { const int t = n; f32x4 o;
#pragma unroll
                    for (int e = 0; e < 4; ++e) o[e] = (m0 + e < t) ? acc[e] : 0.f;
                    *(LAS f32x4*)(LBT + t * 36 + m0) = o; }
                else { const int t = n - 32; f32x4 o;
#pragma unroll
                    for (int e = 0; e < 4; ++e) o[e] = (m0 + e <= t) ? acc[e] : 0.f;
                    *(LAS u32x2*)(HT + t * 40 + m0) = pack4(o); } }
            else { const int s0 = m0 - 32;
                if (nt < 2) { const int t = n;
#pragma unroll
                    for (int e = 0; e < 4; ++e) AL[(64 + s0 + e) * 40 + t] = (bf16_t)f2bf((s0 + e < t) ? acc[e] : 0.f); }
                else { const int t = n - 32; f32x4 o;
#pragma unroll
                    for (int e = 0; e < 4; ++e) o[e] = (s0 + e <= t) ? acc[e] : 0.f;
                    *(LAS u32x2*)(ET + t * 104 + 64 + s0) = pack4(o); } } } }
        LBAR();
        if (gtid < 32) { const int hb = 16 * (gtid >> 4), sl = gtid & 15; float Tr[16];
#pragma unroll
            for (int t = 0; t < 16; ++t) { float a0 = (sl == t) ? 1.f : 0.f, a1 = 0.f, a2 = 0.f, a3 = 0.f;
#pragma unroll
                for (int m4 = 0; m4 < (t + 3) / 4; ++m4) { const f32x4 l = *(const LAS f32x4*)(LBT + (hb + t) * 36 + hb + 4 * m4);
                    if (4 * m4 + 0 < t) a0 += Tr[4 * m4 + 0] * l[0]; if (4 * m4 + 1 < t) a1 += Tr[4 * m4 + 1] * l[1]; if (4 * m4 + 2 < t) a2 += Tr[4 * m4 + 2] * l[2]; if (4 * m4 + 3 < t) a3 += Tr[4 * m4 + 3] * l[3]; }
                Tr[t] = (a0 + a1) + (a2 + a3); TF[(hb + sl) * 36 + hb + t] = Tr[t]; TT[(hb + t) * 40 + hb + sl] = (bf16_t)f2bf(Tr[t]);
                if (hb) TT[t * 40 + hb + sl] = 0; } }
        LBAR();
        { const int m = gtid >> 4, tl = gtid & 15; float x = 0.f;
#pragma unroll
            for (int n = 0; n < 16; ++n) x += LBT[(16 + n) * 36 + m] * TF[(16 + n) * 36 + 16 + tl];
            XB[m * 17 + tl] = x; }
        LBAR();
        { const int sr = gtid >> 4, tl = gtid & 15; float x = 0.f;
#pragma unroll
            for (int m = 0; m < 16; ++m) x += TF[sr * 36 + m] * XB[m * 17 + tl];
            TT[(16 + tl) * 40 + sr] = (bf16_t)f2bf(x); }
        LBAR();
        for (int id = tw; id < 12; id += 4) { const int tt = id / 6, nt = id % 6;
            const f32x4 acc = tile_mm(TT + 16 * tt * 40, 40, AL + 16 * nt * 40, 40, 1, fr, fq, (f32x4){0.f, 0.f, 0.f, 0.f});
            *(LAS u32x2*)(GI + (16 * nt + fr) * 40 + 16 * tt + 4 * fq) = pack4(acc); }
        LBAR();
        for (int id = tw; id < 36; id += 4) { const int nt = id / 6, mt = id % 6;
            const f32x4 acc = tile_mm(GI + 16 * nt * 40, 40, HT + 16 * mt * 40, 40, 1, fr, fq, (f32x4){0.f, 0.f, 0.f, 0.f});
            LAS u32x2* ep = (LAS u32x2*)(ET + (16 * mt + fr) * 104 + 16 * nt + 4 * fq); const u32x2 ev = *ep;
            f32x4 o; o[0] = acc[0] + bf2f(ev.x & 0xffffu); o[1] = acc[1] + bf2f(ev.x >> 16); o[2] = acc[2] + bf2f(ev.y & 0xffffu); o[3] = acc[3] + bf2f(ev.y >> 16);
            *ep = pack4(o); }
        LBAR();
        { bf16_t* fg = FG + (size_t)task * (SC_F * SC_F);
          for (int idx = gtid; idx < 96 * 12; idx += 256) { const int row = idx / 12, pc = idx % 12; *(u32x4*)(fg + row * 96 + 8 * pc) = *(const LAS u32x4*)(ET + row * 104 + 8 * pc); } }
        LBAR();
        if (bgconv) { cv_store8(cva, ws + WS_W1 + (size_t)cea * 4096 * D, D, cna, cka, lane); cv_store8(cvb, ws + WS_W1 + (size_t)ceb * 4096 * D, D, cnb, ckb, lane); }
    }
    if (!bgconv) {
        LBAR();
        for (int r = c.vcu * 8 + w; r < NEXP * MOE_W1E; r += c.G * 8) { const int e = r >> 12, rem = r & 4095; float cv[32]; cv_issue(p.in[I_W1] + (size_t)e * D * 4096, 4096, D, 32 * (rem & 127), 64 * (rem >> 7), lane, cv);
            cv_store8(cv, ws + WS_W1 + (size_t)e * 4096 * D, D, 32 * (rem & 127), 64 * (rem >> 7), lane); }
    }
    LBAR();
#undef PRE_LOAD
}
constexpr int SQ_BI = 0, SQ_BI_SZ = 64 * 104 * 2, SQ_YL = 2 * SQ_BI_SZ, SQ_YL_SZ = 32 * 64 * 4;
struct SeqSet { bf16x8 af[3][3]; u32x2 vimg, gimg; float bon; };
__device__ __forceinline__ void p4_seq(const Params& p, const Ctx& c, int bh) {
    unsigned char* ws = c.ws;
    const bf16_t* VZ = (const bf16_t*)(ws + WS_VZ); const bf16_t* GG = (const bf16_t*)(ws + WS_GG); const float* BON = (const float*)(ws + WS_YS);
    const bf16_t* FG = (const bf16_t*)(ws + WS_F) + (size_t)bh * SC_NCH * (SC_F * SC_F);
    bf16_t* YA = (bf16_t*)(ws + WS_YA);
    int tid_ = c.tid; asm volatile("" : "+v"(tid_));
    const int tid = tid_, lane = tid & 63, w = __builtin_amdgcn_readfirstlane(tid >> 6), fr = lane & 15, fq = lane >> 4;
    const int b = bh >> 5, h = bh & 31;
    const size_t base = (size_t)b * SEQ * D + h * 64;
    const int nt = w & 3, mg = w >> 2;
    LAS bf16_t* BI = (LAS bf16_t*)(c.lds + SQ_BI); LAS float* YL = (LAS float*)(c.lds + SQ_YL);
    const int vs = tid >> 4, vi4 = 4 * (tid & 15);
    const f32x4 lg4 = *(const f32x4*)(p.in[I_LNXG] + h * 64 + vi4), lb4 = *(const f32x4*)(p.in[I_LNXB] + h * 64 + vi4);
#define SEQ_LOAD(SET, CHN) do { const int chn_ = (CHN) < SC_NCH ? (CHN) : SC_NCH - 1; const bf16_t* fp = FG + (size_t)chn_ * (SC_F * SC_F); const size_t tk_ = (size_t)b * SEQ + (size_t)(chn_ * SC_C + vs); \
        asm volatile("global_load_dwordx2 %0, %1, off" : "=v"(SET.vimg) : "v"(VZ + tk_ * D + h * 64 + vi4) : "memory"); \
        _Pragma("unroll") for (int mi = 0; mi < 3; ++mi) _Pragma("unroll") for (int ks = 0; ks < 3; ++ks) \
            asm volatile("global_load_dwordx4 %0, %1, off" : "=v"(SET.af[mi][ks]) : "v"(fp + (16 * (3 * mg + mi) + fr) * SC_F + 32 * ks + 8 * fq) : "memory"); \
        asm volatile("global_load_dwordx2 %0, %1, off" : "=v"(SET.gimg) : "v"(GG + tk_ * D + h * 64 + vi4) : "memory"); \
        asm volatile("global_load_dword %0, %1, off" : "=v"(SET.bon) : "v"(BON + tk_ * 32 + h) : "memory"); } while (0)
#define SEQ_WAIT_AF(SET, N) asm volatile("s_waitcnt vmcnt(" #N ")" : "+v"(SET.af[0][0]), "+v"(SET.af[0][1]), "+v"(SET.af[0][2]), "+v"(SET.af[1][0]), "+v"(SET.af[1][1]), "+v"(SET.af[1][2]), \
        "+v"(SET.af[2][0]), "+v"(SET.af[2][1]), "+v"(SET.af[2][2]) :: "memory")
#define SEQ_WAIT_V(SET, N) asm volatile("s_waitcnt vmcnt(" #N ")" : "+v"(SET.vimg) :: "memory")
#define SEQ_WAIT_G(SET, N) asm volatile("s_waitcnt vmcnt(" #N ")" : "+v"(SET.gimg), "+v"(SET.bon), "+v"(SET.vimg) :: "memory")
#define SEQ_BODY(CH, CUR, NXT, NX2) do { const int ch = (CH), cb = ch & 1; \
        const LAS bf16_t* bi = BI + cb * (64 * 104); LAS bf16_t* bo = BI + (cb ^ 1) * (64 * 104); LAS float* yl = YL + cb * (32 * 64); \
        SEQ_LOAD(NX2, ch + 2); \
        bf16x8 bfr[3]; _Pragma("unroll") for (int ks = 0; ks < 3; ++ks) bfr[ks] = *(const LAS bf16x8*)(bi + (16 * nt + fr) * 104 + 32 * ks + 8 * fq); \
        SEQ_WAIT_AF(CUR, 28); \
        f32x4 acc[3]; _Pragma("unroll") for (int mi = 0; mi < 3; ++mi) { acc[mi] = (f32x4){0.f, 0.f, 0.f, 0.f}; \
            _Pragma("unroll") for (int ks = 0; ks < 3; ++ks) acc[mi] = __builtin_amdgcn_mfma_f32_16x16x32_bf16(CUR.af[mi][ks], bfr[ks], acc[mi], 0, 0, 0); } \
        _Pragma("unroll") for (int mi = 0; mi < 3; ++mi) { const int mt = 3 * mg + mi; \
            if (mt < 2) { _Pragma("unroll") for (int e = 0; e < 4; ++e) yl[(16 * mt + 4 * fq + e) * 64 + 16 * nt + fr] = acc[mi][e]; } \
            else *(LAS u32x2*)(bo + (16 * nt + fr) * 104 + 16 * (mt - 2) + 4 * fq) = pack4(acc[mi]); } \
        SEQ_WAIT_V(NXT, 24); \
        if (ch + 1 < SC_NCH) { bo[(vi4 + 0) * 104 + 64 + vs] = (bf16_t)(NXT.vimg.x & 0xffffu); bo[(vi4 + 1) * 104 + 64 + vs] = (bf16_t)(NXT.vimg.x >> 16); \
            bo[(vi4 + 2) * 104 + 64 + vs] = (bf16_t)(NXT.vimg.y & 0xffffu); bo[(vi4 + 3) * 104 + 64 + vs] = (bf16_t)(NXT.vimg.y >> 16); } \
        LBAR(); \
        SEQ_WAIT_G(CUR, 24); \
        { const f32x4 y4 = *(const LAS f32x4*)(yl + vs * 64 + vi4); float sm = (y4[0] + y4[1]) + (y4[2] + y4[3]); \
          sm = DPP_ADD(sm, 0xB1); sm = DPP_ADD(sm, 0x4E); sm = DPP_ADD(sm, 0x141); sm = DPP_ADD(sm, 0x140);     \
          const float mu = sm * (1.0f / 64.0f); const f32x4 d4 = y4 - mu; float q = (d4[0] * d4[0] + d4[1] * d4[1]) + (d4[2] * d4[2] + d4[3] * d4[3]); \
          q = DPP_ADD(q, 0xB1); q = DPP_ADD(q, 0x4E); q = DPP_ADD(q, 0x141); q = DPP_ADD(q, 0x140); \
          const float rstd = rsqrtf(q * (1.0f / 64.0f) + GN_EPS); \
          const float v0 = bf2f(CUR.vimg.x & 0xffffu), v1 = bf2f(CUR.vimg.x >> 16), v2 = bf2f(CUR.vimg.y & 0xffffu), v3 = bf2f(CUR.vimg.y >> 16); \
          const float g0 = bf2f(CUR.gimg.x & 0xffffu), g1 = bf2f(CUR.gimg.x >> 16), g2 = bf2f(CUR.gimg.y & 0xffffu), g3 = bf2f(CUR.gimg.y >> 16); \
          const float o0 = (d4[0] * rstd * lg4[0] + lb4[0] + CUR.bon * v0) * g0, o1 = (d4[1] * rstd * lg4[1] + lb4[1] + CUR.bon * v1) * g1; \
          const float o2 = (d4[2] * rstd * lg4[2] + lb4[2] + CUR.bon * v2) * g2, o3 = (d4[3] * rstd * lg4[3] + lb4[3] + CUR.bon * v3) * g3; \
          *(u32x2*)(YA + ((size_t)b * SEQ + (size_t)(ch * SC_C + vs)) * 2560 + h * 64 + vi4) = (u32x2){pk2(o0, o1), pk2(o2, o3)}; } } while (0)
    SeqSet sa, sb, sc;
    SEQ_LOAD(sa, 0); SEQ_LOAD(sb, 1);
    SEQ_WAIT_V(sa, 0);
    for (int idx = tid; idx < 64 * 8; idx += 512) *(LAS u32x4*)(BI + (idx >> 3) * 104 + 8 * (idx & 7)) = (u32x4){0u, 0u, 0u, 0u};
    BI[(vi4 + 0) * 104 + 64 + vs] = (bf16_t)(sa.vimg.x & 0xffffu); BI[(vi4 + 1) * 104 + 64 + vs] = (bf16_t)(sa.vimg.x >> 16);
    BI[(vi4 + 2) * 104 + 64 + vs] = (bf16_t)(sa.vimg.y & 0xffffu); BI[(vi4 + 3) * 104 + 64 + vs] = (bf16_t)(sa.vimg.y >> 16);
    LBAR();
    for (int c0 = 0; c0 < SC_NCH; c0 += 3) {
        SEQ_BODY(c0, sa, sb, sc);
        if (c0 + 1 < SC_NCH) SEQ_BODY(c0 + 1, sb, sc, sa);
        if (c0 + 2 < SC_NCH) SEQ_BODY(c0 + 2, sc, sa, sb);
    }
    asm volatile("s_waitcnt vmcnt(0)" ::: "memory");
    LBAR();
#undef SEQ_LOAD
#undef SEQ_BODY
#undef SEQ_WAIT_AF
#undef SEQ_WAIT_V
#undef SEQ_WAIT_G
}

__device__ __forceinline__ void p4_attn_task(const Ctx& c, int task) {
    unsigned char* ws = c.ws;
    const bf16_t* QR = (const bf16_t*)(ws + WS_QR); const bf16_t* KR = (const bf16_t*)(ws + WS_KR); const bf16_t* VR = (const bf16_t*)(ws + WS_VR);
    float* AO = (float*)(ws + WS_AO); float* LSE = (float*)(ws + WS_LSE);
    constexpr int VP = 280;
    LAS bf16_t* Vt = (LAS bf16_t*)c.lds;
    const int combo = task & 31, hh = (task >> 5) % 24, b = task / (32 * 24);
    const int g = hh >> 3, h = hh & 7;
    const int dil = g == 0 ? 1 : (g == 1 ? 4 : 16), nblk = 32 / dil;
    const int res = combo / nblk, blk = combo % nblk;
    int tid_ = c.tid; asm volatile("" : "+v"(tid_));
    const int tid = tid_, lane = tid & 63, w = __builtin_amdgcn_readfirstlane(tid >> 6);
    const int qq = lane & 15, g4 = lane >> 4, r0 = 16 * w;
    const size_t rowb = (size_t)(b * 24 + hh) * SEQ + (size_t)res * (SEQ / dil) + (size_t)blk * 128;
    bf16x8 qf[2], kf[9][2];
#pragma unroll
    for (int ks = 0; ks < 2; ++ks) qf[ks] = *(const bf16x8*)(QR + (rowb + r0 + qq) * 64 + 32 * ks + 8 * g4);
#pragma unroll
    for (int kt = 0; kt < 9; ++kt) { const bool kv = (blk > 0) || (w + kt >= 8);
#pragma unroll
        for (int ks = 0; ks < 2; ++ks) { kf[kt][ks] = (bf16x8){0, 0, 0, 0, 0, 0, 0, 0};
            if (kv) kf[kt][ks] = *(const bf16x8*)(KR + (rowb - 128 + 16 * (w + kt) + qq) * 64 + 32 * ks + 8 * g4); } }
    const int vki = tid >> 1, vdh = tid & 1;
    u32x4 vv[4];
    if (blk > 0 || vki >= 128) {
#pragma unroll
        for (int j = 0; j < 4; ++j) vv[j] = *(const u32x4*)(VR + (rowb - 128 + vki) * 64 + 32 * vdh + 8 * j); }
    else {
#pragma unroll
        for (int j = 0; j < 4; ++j) vv[j] = (u32x4){0u, 0u, 0u, 0u}; }
    __syncthreads();
#pragma unroll
    for (int j = 0; j < 4; ++j) { const unsigned wv[4] = {vv[j].x, vv[j].y, vv[j].z, vv[j].w};
#pragma unroll
        for (int e = 0; e < 8; ++e) Vt[(32 * vdh + 8 * j + e) * VP + vki] = (bf16_t)((wv[e >> 1] >> (16 * (e & 1))) & 0xffffu); }
    if (tid < 64) {
#pragma unroll
        for (int e = 0; e < 24; ++e) Vt[tid * VP + 256 + e] = 0; }
    f32x4 sc[10];
#pragma unroll
    for (int kt = 0; kt < 9; ++kt) { f32x4 a = (f32x4){0.f, 0.f, 0.f, 0.f};
#pragma unroll
        for (int ks = 0; ks < 2; ++ks) a = __builtin_amdgcn_mfma_f32_16x16x32_bf16(kf[kt][ks], qf[ks], a, 0, 0, 0);
        sc[kt] = a; }
    const int r = r0 + qq;
    float mx = -3.0e38f;
#pragma unroll
    for (int kt = 0; kt < 9; ++kt)
#pragma unroll
        for (int j = 0; j < 4; ++j) { const int ki = 16 * (w + kt) + 4 * g4 + j; const bool ok = (ki >= r) && (ki <= r + 128) && (blk > 0 || ki >= 128);
            const float sv = ok ? sc[kt][j] * 0.125f : -1.0e30f; sc[kt][j] = sv; mx = fmaxf(mx, sv); }
    mx = fmaxf(mx, __shfl_xor(mx, 16)); mx = fmaxf(mx, __shfl_xor(mx, 32));
    float den = 0.f;
#pragma unroll
    for (int kt = 0; kt < 9; ++kt)
#pragma unroll
        for (int j = 0; j < 4; ++j) { const float pexp = __expf(sc[kt][j] - mx); sc[kt][j] = pexp; den += pexp; }
    den += __shfl_xor(den, 16); den += __shfl_xor(den, 32);
    sc[9] = (f32x4){0.f, 0.f, 0.f, 0.f};
    __syncthreads();
    f32x4 oacc[4];
#pragma unroll
    for (int dt = 0; dt < 4; ++dt) oacc[dt] = (f32x4){0.f, 0.f, 0.f, 0.f};
#pragma unroll
    for (int cidx = 0; cidx < 5; ++cidx) {
        const f32x4 p0 = sc[2 * cidx], p1 = sc[2 * cidx + 1];
        u32x4 pw; pw.x = pk2(p0[0], p0[1]); pw.y = pk2(p0[2], p0[3]); pw.z = pk2(p1[0], p1[1]); pw.w = pk2(p1[2], p1[3]);
        const bf16x8 pf = __builtin_bit_cast(bf16x8, pw);
        const int kbase = 16 * (w + 2 * cidx) + 4 * g4;
#pragma unroll
        for (int dt = 0; dt < 4; ++dt) { const LAS bf16_t* vp = Vt + (16 * dt + qq) * VP + kbase;
            const u32x2 lo = *(const LAS u32x2*)vp, hi = *(const LAS u32x2*)(vp + 16);
            u32x4 vw; vw.x = lo.x; vw.y = lo.y; vw.z = hi.x; vw.w = hi.y;
            oacc[dt] = __builtin_amdgcn_mfma_f32_16x16x32_bf16(__builtin_bit_cast(bf16x8, vw), pf, oacc[dt], 0, 0, 0); }
    }
    const float inv = 1.0f / den;
    const size_t tok = (size_t)b * SEQ + (size_t)(blk * 128 + r) * dil + res;
#pragma unroll
    for (int dt = 0; dt < 4; ++dt) *(f32x4*)(AO + ((size_t)g * M + tok) * 512 + h * 64 + 16 * dt + 4 * g4) = oacc[dt] * inv;
    if (g4 == 0) LSE[((size_t)g * M + tok) * 8 + h] = mx + __logf(den);
}

struct KvUnitOrder {
    static constexpr bool GATHER = false;
    const char* A; const char* Bt; int q;
    __device__ bool next(int i, pg8::Unit& u) const {
        if (i != 0) return false;
        const int pm = q & 3, pn = q >> 2;
        u.A = A + (size_t)pm * 256 * D * 2; u.B = Bt + (size_t)pn * 256 * D * 2; u.orow = 256 * pm; u.ocol = 256 * pn; u.aux = 0; u.aux2 = 0; u.valid = 256; return true;
    }
    __device__ __forceinline__ const int* rows(const pg8::Unit&) const { return nullptr; }
};
constexpr int Q_KV = 64, Q_ATT = 3072, Q_TOTAL = Q_KV + Q_ATT + MOE_CONV_GROUPS;
__device__ __forceinline__ void p4_queue(const Params& p, const Ctx& c, volatile LAS unsigned* qslot) {
    unsigned* qc = (unsigned*)(c.ws + WS_CTL) + CW_Q;
    for (;;) {
        __syncthreads();
        if (c.tid == 0) qslot[0] = __hip_atomic_fetch_add(qc, 1u, __ATOMIC_RELAXED, __HIP_MEMORY_SCOPE_AGENT);
        __syncthreads();
        const unsigned it = qslot[0];
        if (it >= (unsigned)Q_TOTAL) break;
        if (it < (unsigned)Q_KV) { const int qi = __builtin_amdgcn_readfirstlane((int)it);
            KvUnitOrder S{(const char*)(c.ws + WS_MEMB), (const char*)(c.ws + WS_WKV), qi};
            pg8::EpiKV E{(bf16_t*)(c.ws + WS_KB), (bf16_t*)(c.ws + WS_VT)};
            pg8::gemm_phase<pg8::EpiKV, KvUnitOrder>(c.lds, pg8::Gemm{D, D, D}, S, E); }
        else if (it < (unsigned)(Q_KV + Q_ATT)) p4_attn_task(c, (int)it - Q_KV); else conv_group(p, c, (int)it - Q_KV - Q_ATT);
    }
}

__device__ __forceinline__ void p5_post(const Params& p, const Ctx& c) {
    unsigned char* ws = c.ws;
    const float* AO = (const float*)(ws + WS_AO); const float* LSE = (const float*)(ws + WS_LSE);
    bf16_t* YB = (bf16_t*)(ws + WS_YA);
    const int gw = c.vcu * 8 + c.wave, NGW = c.G * 8, lane = c.lane;
    for (int it = gw; it < M * 8; it += NGW) {
        const int t = it >> 3, h = it & 7;
        const float l0 = LSE[((size_t)0 * M + t) * 8 + h], l1 = LSE[((size_t)1 * M + t) * 8 + h], l2 = LSE[((size_t)2 * M + t) * 8 + h];
        const float mxl = fmaxf(l0, fmaxf(l1, l2)); const float e0 = __expf(l0 - mxl), e1 = __expf(l1 - mxl), e2 = __expf(l2 - mxl); const float inv = 1.0f / (e0 + e1 + e2);
        const size_t o = (size_t)t * 512 + h * 64 + lane;
        const float v = (e0 * AO[o] + e1 * AO[(size_t)M * 512 + o] + e2 * AO[(size_t)2 * M * 512 + o]) * inv;
        YB[(size_t)t * 2560 + 2048 + h * 64 + lane] = (bf16_t)f2bf(v);
    }
}

__device__ __forceinline__ void ln_rows(const Ctx& c, const float* in, const float* gam, const float* bet, float* outf, bf16_t* outb, unsigned char* outq = nullptr) {
    const int gw = c.vcu * 8 + c.wave, NGW = c.G * 8, lane = c.lane;
    for (int m = gw; m < M; m += NGW) {
        const f32x4* xr = (const f32x4*)(in + (size_t)m * D) + lane;
        f32x4 v[8]; float s = 0.f;
#pragma unroll
        for (int j = 0; j < 8; ++j) { v[j] = xr[64 * j]; s += (v[j][0] + v[j][1]) + (v[j][2] + v[j][3]); }
        const float mean = wave_sum(s) * (1.0f / D); float s2 = 0.f;
#pragma unroll
        for (int j = 0; j < 8; ++j) { v[j] = v[j] - mean; s2 += (v[j][0] * v[j][0] + v[j][1] * v[j][1]) + (v[j][2] * v[j][2] + v[j][3] * v[j][3]); }
        const float rstd = rsqrtf(wave_sum(s2) * (1.0f / D) + LN_EPS);
#pragma unroll
        for (int j = 0; j < 8; ++j) { const int col = 4 * lane + 256 * j; const f32x4 gv = *(const f32x4*)(gam + col), bv = *(const f32x4*)(bet + col);
            const f32x4 o = v[j] * rstd * gv + bv;
            *(f32x4*)(outf + (size_t)m * D + col) = o;
            if (outb) { u32x2 w; w.x = pk2(o[0], o[1]); w.y = pk2(o[2], o[3]); *(u32x2*)(outb + (size_t)m * D + col) = w; }
            if (outq) *(unsigned*)(outq + (size_t)m * D + col) = pk4_fp8(o[0], o[1], o[2], o[3]); }
    }
}

__device__ __forceinline__ void p15_router(const Params& p, const Ctx& c) {
    unsigned char* ws = c.ws;
    const float* X2 = (const float*)(ws + WS_X2); const float* RW = p.in[I_RW]; const float* RB = p.in[I_RB];
    unsigned* cnt = (unsigned*)(ws + WS_CTL) + CW_CNT; int* LIST = (int*)(ws + WS_LIST); int* ROWI = (int*)(ws + WS_ROWI); float* TOPW = (float*)(ws + WS_TOPW);
    LAS float* scr = (LAS float*)(c.lds + c.wave * 8192);
    const int gw = c.vcu * 8 + c.wave, NGW = c.G * 8, lane = c.lane, li = lane & 31, lk = lane >> 5;
    for (int tb = gw; tb < M / 32; tb += NGW) {
        const int t0 = tb * 32;
        f32x16 acc;
#pragma unroll
        for (int j = 0; j < 16; ++j) acc[j] = 0.f;
        const float* xa = X2 + (size_t)(t0 + li) * D + 4 * lk;
        const float* wb = RW + (size_t)(4 * lk) * 32 + li;
        for (int kb = 0; kb < D / 8; ++kb) {
            const f32x4 a = *(const f32x4*)(xa + 8 * kb);
            const float b0 = wb[(size_t)(8 * kb + 0) * 32], b1 = wb[(size_t)(8 * kb + 1) * 32], b2 = wb[(size_t)(8 * kb + 2) * 32], b3 = wb[(size_t)(8 * kb + 3) * 32];
            acc = __builtin_amdgcn_mfma_f32_32x32x2f32(a[0], b0, acc, 0, 0, 0);
            acc = __builtin_amdgcn_mfma_f32_32x32x2f32(a[1], b1, acc, 0, 0, 0);
            acc = __builtin_amdgcn_mfma_f32_32x32x2f32(a[2], b2, acc, 0, 0, 0);
            acc = __builtin_amdgcn_mfma_f32_32x32x2f32(a[3], b3, acc, 0, 0, 0);
        }
        const float bias = RB[li];
#pragma unroll
        for (int rg = 0; rg < 16; ++rg) { const int row = (rg & 3) + 8 * (rg >> 2) + 4 * lk; scr[row * 33 + li] = acc[rg] + bias; }
        LDS_WAIT(); asm volatile("" ::: "memory");
        if (lane < 32) {
            float lv[32];
#pragma unroll
            for (int e = 0; e < 32; ++e) lv[e] = scr[lane * 33 + e];
            int id[4]; float tv[4];
#pragma unroll
            for (int k = 0; k < 4; ++k) { float best = -3.0e38f; int bi = 0;
#pragma unroll
                for (int e = 0; e < 32; ++e) { const bool tk = lv[e] > best; best = tk ? lv[e] : best; bi = tk ? e : bi; }
                id[k] = bi; tv[k] = best;
#pragma unroll
                for (int e = 0; e < 32; ++e) lv[e] = (e == bi) ? -3.0e38f : lv[e]; }
            const float e1 = __expf(tv[1] - tv[0]), e2 = __expf(tv[2] - tv[0]), e3 = __expf(tv[3] - tv[0]); const float inv = 1.0f / (1.0f + e1 + e2 + e3);
            const float wv[4] = {inv, e1 * inv, e2 * inv, e3 * inv};
            const int t = t0 + lane;
#pragma unroll
            for (int k = 0; k < 4; ++k) { const unsigned slot = __hip_atomic_fetch_add(cnt + id[k], 1u, __ATOMIC_RELAXED, __HIP_MEMORY_SCOPE_AGENT);
                LIST[(size_t)id[k] * CAP + slot] = t; ROWI[(size_t)t * 4 + k] = id[k] * CAP + (int)slot; TOPW[(size_t)t * 4 + k] = wv[k]; }
        }
        LDS_WAIT(); asm volatile("" ::: "memory");
    }
}

__device__ __forceinline__ void moe_table(const Ctx& c, LAS int* tab) {
    if (c.tid == 0) { unsigned* cnt = (unsigned*)(c.ws + WS_CTL) + CW_CNT; int ts = 0;
        for (int e = 0; e < NEXP; ++e) { const int n = (int)__hip_atomic_load(cnt + e, __ATOMIC_RELAXED, __HIP_MEMORY_SCOPE_AGENT); tab[e] = n; tab[32 + e] = ts; ts += (n + 255) >> 8; }
        tab[64] = ts; }
    __syncthreads();
}

__device__ __forceinline__ void p18_combine(const Params& p, const Ctx& c, const LAS int* tab) {
    unsigned char* ws = c.ws;
    const float* X2 = (const float*)(ws + WS_X2); const bf16_t* Y = (const bf16_t*)(ws + WS_Y); const int* ROWI = (const int*)(ws + WS_ROWI); const float* TOPW = (const float*)(ws + WS_TOPW);
    const float* gam = p.in[I_LN3G]; const float* bet = p.in[I_LN3B];
    const int gw = c.vcu * 8 + c.wave, NGW = c.G * 8, lane = c.lane;
    for (int m = gw; m < M; m += NGW) {
        f32x4 v[8];
        const f32x4* xr = (const f32x4*)(X2 + (size_t)m * D) + lane;
#pragma unroll
        for (int j = 0; j < 8; ++j) v[j] = xr[64 * j] * DN_ALPHA;
#pragma unroll
        for (int k = 0; k < 4; ++k) { const int ri = ROWI[(size_t)m * 4 + k]; const float gt = TOPW[(size_t)m * 4 + k]; const int e = ri >> 14, slot = ri & (CAP - 1);
            const u32x2* yr = (const u32x2*)(Y + ((size_t)tab[32 + e] * 256 + slot) * D) + lane;
#pragma unroll
            for (int j = 0; j < 8; ++j) { const u32x2 yw = yr[64 * j]; v[j] = v[j] + (f32x4){bf2f(yw.x & 0xffffu), bf2f(yw.x >> 16), bf2f(yw.y & 0xffffu), bf2f(yw.y >> 16)} * gt; } }
        float s = 0.f;
#pragma unroll
        for (int j = 0; j < 8; ++j) s += (v[j][0] + v[j][1]) + (v[j][2] + v[j][3]);
        const float mean = wave_sum(s) * (1.0f / D); float s2 = 0.f;
#pragma unroll
        for (int j = 0; j < 8; ++j) { v[j] = v[j] - mean; s2 += (v[j][0] * v[j][0] + v[j][1] * v[j][1]) + (v[j][2] * v[j][2] + v[j][3] * v[j][3]); }
        const float rstd = rsqrtf(wave_sum(s2) * (1.0f / D) + LN_EPS);
#pragma unroll
        for (int j = 0; j < 8; ++j) { const int col = 4 * lane + 256 * j; const f32x4 gv = *(const f32x4*)(gam + col), bv = *(const f32x4*)(bet + col);
            *(f32x4*)(p.out + (size_t)m * D + col) = v[j] * rstd * gv + bv; }
    }
}

constexpr int NPHASE = 19;
__global__ void __launch_bounds__(512, 2) fwd(Params p) {
    extern __shared__ __attribute__((aligned(16))) unsigned char lds_raw[];
    LAS unsigned char* lds = (LAS unsigned char*)lds_raw;
    Ctx c; c.tid = threadIdx.x; c.lane = c.tid & 63; c.wave = __builtin_amdgcn_readfirstlane(c.tid >> 6); c.G = gridDim.x;
    { const int bx = blockIdx.x; c.vcu = (c.G % 8 == 0) ? (bx % 8) * (c.G / 8) + bx / 8 : bx; }
    c.lds = lds; c.ws = p.ws;
    unsigned char* ws = p.ws;
    volatile LAS unsigned* MISC = (volatile LAS unsigned*)(lds + MISC_OFF);
    LAS int* tab = (LAS int*)(lds + MISC_OFF + 1024);
    if (c.tid < 64) MISC[c.tid] = 0u;
    __syncthreads();
    unsigned* ctl = (unsigned*)(ws + WS_CTL);
    XcdBarrier bar; bar.bar = ctl + CW_BAR + p.li * XCD_BAR_WORDS; bar.x = 0; bar.st = MISC + 8;
    if (N_LAUNCH_MODE == 1) bar = xcd_barrier_post(ctl + CW_BAR + p.li * XCD_BAR_WORDS, MISC + 8);
    const int lo = p.ph_lo, hi = p.ph_hi, bx = blockIdx.x;
#ifndef PHMASK
#define PHMASK 0xFFFFFFFFu
#endif
#define IN(k) (((PHMASK >> (k)) & 1u) && lo <= (k) && (k) < hi)
#define SEAM(k) do { if (N_LAUNCH_MODE == 1 && IN((k) + 1)) xcd_barrier(bar); } while (0)

    if (IN(0)) { p0_prologue(p, c); SEAM(0); }

    if (IN(1)) {
        { pg8::StaticOrder S; S.init(ws + WS_XB, ws + WS_WIN, M, ATT0, D, D, c.G, bx);
          pg8::EpiBf16 E{(bf16_t*)(ws + WS_PROJ), PC, 1.0f};
          pg8::gemm_phase<pg8::EpiBf16, pg8::StaticOrder>(lds, pg8::Gemm{D, D, D}, S, E); }
        { pg8::StaticOrder S; S.init(ws + WS_XQ, ws + WS_WIN8, M, PC - ATT0, D, D, c.G, bx, 1);
          pg8::EpiBf16 E{(bf16_t*)(ws + WS_PROJ) + ATT0, PC, 1.0f};
          pg8::gemm_phase<pg8::EpiBf16, pg8::StaticOrder, true, true>(lds, pg8::Gemm{D, D, D}, S, E); }
        SEAM(1);
    }
    if (IN(2)) { p2_prep(p, c); SEAM(2); }

    if (IN(3)) {
#ifndef P3M
#define P3M 15
#endif
        if (P3M & 1) { pg8::StaticOrder S; S.init(ws + WS_LIN, ws + WS_WUP, M, D, 768, 256, c.G, bx);
          pg8::EpiDecay E{(float*)(ws + WS_DEC), p.in[I_W0]};
          pg8::gemm_phase<pg8::EpiDecay, pg8::StaticOrder>(lds, pg8::Gemm{256, 768, 256}, S, E); }
        if (P3M & 2) { pg8::StaticOrder S; S.init(ws + WS_LIN + 512, ws + WS_AUP, M, D, 768, 256, c.G, bx);
          pg8::EpiIclr E{p.in[I_A0], p.in[I_KK], p.in[I_KA], (const bf16_t*)(ws + WS_KZ), (const float*)(ws + WS_KNORM), (bf16_t*)(ws + WS_KP), (bf16_t*)(ws + WS_AN), (bf16_t*)(ws + WS_BB)};
          pg8::gemm_phase<pg8::EpiIclr, pg8::StaticOrder>(lds, pg8::Gemm{256, 768, 256}, S, E); }
        if (P3M & 4) { pg8::StaticOrder S; S.init(ws + WS_LIN + 1024, ws + WS_GUP, M, D, 768, 256, c.G, bx);
          pg8::EpiBf16 E{(bf16_t*)(ws + WS_GG), D, 1.0f};
          pg8::gemm_phase<pg8::EpiBf16, pg8::StaticOrder>(lds, pg8::Gemm{256, 768, 256}, S, E); }
        SEAM(3);
    }
    if (IN(4)) {
        p4_pre(p, c);
        xcd_barrier(bar);
        for (int bh = c.vcu; bh < 128; bh += c.G) p4_seq(p, c, bh);
        p4_queue(p, c, MISC + 16);
        SEAM(4);
    }
    if (IN(5)) { p5_post(p, c); }

    if (IN(6)) {
        pg8::StaticOrder S; S.init(ws + WS_YA, ws + WS_PA, M, D, 2560, 2560, c.G, bx);
        pg8::EpiGateFused E{(const bf16_t*)(ws + WS_PROJ), (bf16_t*)(ws + WS_MERGED)};
        pg8::gemm_phase<pg8::EpiGateFused, pg8::StaticOrder>(lds, pg8::Gemm{2560, 2560, 2560}, S, E);
        SEAM(6);
    }
    if (IN(7)) { }
    if (IN(8)) {
        pg8::StaticOrder S; S.init(ws + WS_MERGED, ws + WS_WOUT, M, D, D, D, c.G, bx);
        pg8::EpiF32 E{(float*)(ws + WS_T1), D, nullptr, 0, p.in[I_X], DN_ALPHA};
        pg8::gemm_phase<pg8::EpiF32, pg8::StaticOrder>(lds, pg8::Gemm{D, D, D}, S, E);
        SEAM(8);
    }
    if (IN(9)) { ln_rows(c, (const float*)(ws + WS_T1), p.in[I_LN1G], p.in[I_LN1B], (float*)(ws + WS_X1), (bf16_t*)(ws + WS_X1B)); SEAM(9); }

    if (IN(10)) {
        pg8::StaticOrder S; S.init(ws + WS_X1B, ws + WS_WQ, M, D, D, D, c.G, bx);
        pg8::EpiBf16 E{(bf16_t*)(ws + WS_Q), D, 0.04419417382415922f};
        pg8::gemm_phase<pg8::EpiBf16, pg8::StaticOrder>(lds, pg8::Gemm{D, D, D}, S, E);
        SEAM(10);
    }
    if (IN(11)) {
        ScoreOrder S{(const char*)(ws + WS_Q), (const char*)(ws + WS_KB), c.G, bx};
        pg8::EpiSoftmax E{(bf16_t*)(ws + WS_PP)};
        pg8::gemm_phase<pg8::EpiSoftmax, ScoreOrder, false>(lds, pg8::Gemm{512, D, D}, S, E);
        SEAM(11);
    }
    if (IN(12)) {
        PvOrder S{(const char*)(ws + WS_PP), (const char*)(ws + WS_VT), c.G, bx};
        pg8::EpiBf16 E{(bf16_t*)(ws + WS_OC), D, 1.0f};
        pg8::gemm_phase<pg8::EpiBf16, PvOrder>(lds, pg8::Gemm{256, 256, 256}, S, E);
        SEAM(12);
    }
    if (IN(13)) {
        pg8::StaticOrder S; S.init(ws + WS_OC, ws + WS_WO, M, D, D, D, c.G, bx);
        pg8::EpiF32 E{(float*)(ws + WS_T2), D, nullptr, 0, (const float*)(ws + WS_X1), DN_ALPHA};
        pg8::gemm_phase<pg8::EpiF32, pg8::StaticOrder>(lds, pg8::Gemm{D, D, D}, S, E);
        SEAM(13);
    }
    if (IN(14)) { ln_rows(c, (const float*)(ws + WS_T2), p.in[I_LN2G], p.in[I_LN2B], (float*)(ws + WS_X2), nullptr, ws + WS_X2B); SEAM(14); }
    if (IN(15)) { p15_router(p, c); SEAM(15); }

    if (IN(16)) {
        moe_table(c, tab);
        MoeOrder<true, 16> S{tab, (const char*)(ws + WS_X2B), (const char*)(ws + WS_W1), (const int*)(ws + WS_LIST), (size_t)4096 * D, D, c.G, bx};
        pg8::EpiSwiglu E{p.in[I_B1], (bf16_t*)(ws + WS_H)};
        pg8::gemm_phase<pg8::EpiSwiglu, MoeOrder<true, 16>, true, true>(lds, pg8::Gemm{D, D, D}, S, E);
        SEAM(16);
    }
    if (IN(17)) {
        moe_table(c, tab);
        MoeOrder<false, 8> S{tab, (const char*)(ws + WS_H), (const char*)(ws + WS_W2), (const int*)(ws + WS_LIST), (size_t)D * DFF, DFF, c.G, bx};
        pg8::EpiBf16Bias E{(bf16_t*)(ws + WS_Y), D, p.in[I_B2], D};
        pg8::gemm_phase<pg8::EpiBf16Bias, MoeOrder<false, 8>, true, true>(lds, pg8::Gemm{DFF, DFF, DFF}, S, E);
        SEAM(17);
    }
    if (IN(18)) { moe_table(c, tab); p18_combine(p, c, tab); }
#undef IN
#undef SEAM
}

extern "C" void kernel_launch(void* const* d_in, const int* in_sizes, int n_in, void* d_out, int out_size, void* d_ws, size_t ws_size, hipStream_t stream) {
    static int grid = 0;
    if (grid == 0) {
        if (n_in != 32 || out_size != M * D || ws_size < WS_END) { fprintf(stderr, "kernel_launch: expected 32 inputs, %d outputs, >= %zu bytes of workspace; got %d, %d, %zu\n", M * D, (size_t)WS_END, n_in, out_size, ws_size); grid = -1; return; }
        int dev = 0, cus = 0, per_cu = 0;
        if (hipGetDevice(&dev) != hipSuccess || hipDeviceGetAttribute(&cus, hipDeviceAttributeMultiprocessorCount, dev) != hipSuccess) { grid = -1; return; }
        if (hipFuncSetAttribute((const void*)fwd, hipFuncAttributeMaxDynamicSharedMemorySize, LDS_BYTES) != hipSuccess) { fprintf(stderr, "kernel_launch: hipFuncSetAttribute failed\n"); grid = -1; return; }
        if (hipOccupancyMaxActiveBlocksPerMultiprocessor(&per_cu, (const void*)fwd, 512, LDS_BYTES) != hipSuccess || per_cu < 1) fprintf(stderr, "kernel_launch: occupancy query reports %d\n", per_cu);
        (void)hipGetLastError();
        grid = cus;
        if (grid != 256) fprintf(stderr, "kernel_launch: %d CUs; this kernel is built for 256\n", grid);
    }
    if (grid < 0) return;
    (void)hipMemsetAsync((char*)d_ws + WS_CTL, 0, CTL_ZERO_BYTES, stream);
    Params p{};
    for (int i = 0; i < 32; ++i) p.in[i] = (const float*)d_in[i];
    p.out = (float*)d_out; p.ws = (unsigned char*)d_ws;
#if defined(TIMING_REPEAT_LO)
    { const int cuts[4][2] = {{0, TIMING_REPEAT_HI}, {TIMING_REPEAT_LO, TIMING_REPEAT_HI}, {TIMING_REPEAT_HI, NPHASE}, {0, 0}};
      for (int li = 0; li < 3; ++li) { if (cuts[li][0] >= cuts[li][1]) continue; p.ph_lo = cuts[li][0]; p.ph_hi = cuts[li][1]; p.li = li; hipLaunchKernelGGL(fwd, dim3(grid), dim3(512), LDS_BYTES, stream, p); } }
#else
    if (N_LAUNCH_MODE == 1) { p.ph_lo = 0; p.ph_hi = NPHASE; hipLaunchKernelGGL(fwd, dim3(grid), dim3(512), LDS_BYTES, stream, p); }
    else for (int k = 0; k < NPHASE; ++k) { p.ph_lo = k; p.ph_hi = k + 1; hipLaunchKernelGGL(fwd, dim3(grid), dim3(512), LDS_BYTES, stream, p); }
#endif
}
```

```cpp
#include <hip/hip_runtime.h>
#include <cstdio>
#include <cstdint>

#define LAS __attribute__((address_space(3)))
#define GAS __attribute__((address_space(1)))
typedef unsigned short bf16_t;
typedef short bf16x8 __attribute__((ext_vector_type(8)));
typedef float f32x4 __attribute__((ext_vector_type(4)));
typedef float f32x2 __attribute__((ext_vector_type(2)));
typedef float f32x16 __attribute__((ext_vector_type(16)));
typedef unsigned u32x4 __attribute__((ext_vector_type(4)));
typedef unsigned u32x2 __attribute__((ext_vector_type(2)));

#ifndef N_LAUNCH_MODE
#define N_LAUNCH_MODE 1
#endif

constexpr int M = 16384, D = 2048, SEQ = 4096, NBATCH = 4;
constexpr int RWC = 6592;
constexpr int PC = 15360;
constexpr int ATTV2 = 6656, ATT0 = 7168, GATE0 = 11264;
constexpr int NEXP = 32, DFF = 2048, CAP = 16384;
constexpr int HROWS = 65536 + 32 * 256;
constexpr float LN_EPS = 1e-5f, GN_EPS = 64e-5f;
constexpr float DN_ALPHA = 1.189207115002721f;

__device__ __forceinline__ float bf2f(unsigned v) { return __uint_as_float(v << 16); }
__device__ __forceinline__ unsigned f2bf(float f) { unsigned u = __float_as_uint(f); return (u + 0x7fffu + ((u >> 16) & 1u)) >> 16; }
__device__ __forceinline__ unsigned pk2(float lo, float hi) { return f2bf(lo) | (f2bf(hi) << 16); }
typedef int v4i __attribute__((ext_vector_type(4)));
typedef int v8i __attribute__((ext_vector_type(8)));
__device__ __forceinline__ unsigned pk4_fp8(float a, float b, float c, float d) { int r = __builtin_amdgcn_cvt_pk_fp8_f32(a, b, 0, false); r = __builtin_amdgcn_cvt_pk_fp8_f32(c, d, r, true); return (unsigned)r; }
__device__ __forceinline__ float sigmoidf_(float x) { return 1.0f / (1.0f + __expf(-x)); }
__device__ __forceinline__ float wave_sum(float v) {
#pragma unroll
    for (int o = 1; o < 64; o <<= 1) v += __shfl_xor(v, o);
    return v;
}
#define LDS_WAIT() asm volatile("s_waitcnt lgkmcnt(0)" ::: "memory")
#define VM_WAIT() asm volatile("s_waitcnt vmcnt(0)" ::: "memory")

namespace pg8 {
#define PG8_LAS __attribute__((address_space(3)))
constexpr int BM = 256, BK = 64, HALF = 128, HTB = HALF * BK * 2, STAGE_BYTES = 8 * HTB, NXCD = 8, WGM = 8;

__host__ __device__ __forceinline__ int lds_byte(int r, int c) { const int st = (r >> 4) * 2 + (c >> 5), rr = r & 15, cc = c & 31, ob = rr * 64 + cc * 2; return st * 1024 + (ob ^ (((ob >> 9) & 1) << 5)); }
__host__ __device__ __forceinline__ void stage_rc(int b, int& R, int& C) { const int st = b / 1024, sb = b % 1024, swz = sb ^ (((sb >> 9) & 1) << 5); R = (st >> 1) * 16 + swz / 64; C = (st & 1) * 32 + (swz % 64) / 2; }
__host__ __device__ __forceinline__ int perm32(int rho) { const int n = rho >> 4, i = rho & 15; return 8 * (i >> 2) + 4 * n + (i & 3); }

struct Unit { const char* A; const char* B; int orow, ocol, aux, aux2, valid; };
struct Gemm { int K, lda, ldb; };

struct StaticOrder {
    static constexpr bool GATHER = false;
    const char* A; const char* Bt; size_t ta, tb;
    int nM, nN, nwg, G, c;
    __device__ void init(const void* A_, const void* Bt_, int M_, int N_, int lda, int ldb, int G_, int c_, int esz = 2) { A = (const char*)A_; Bt = (const char*)Bt_; ta = (size_t)BM * lda * esz; tb = (size_t)BM * ldb * esz; nM = M_ / BM; nN = N_ / BM; nwg = nM * nN; G = G_; c = c_; }
    __device__ bool next(int i, Unit& u) const {
        const long L = (long)i * G + c; if (c < 0 || L >= nwg) return false;
        int wgid = (int)L; { const int q = nwg / NXCD, r = nwg % NXCD, xcd = wgid % NXCD, off = wgid / NXCD; wgid = (xcd < r ? xcd * (q + 1) : r * (q + 1) + (xcd - r) * q) + off; }
        const int nig = WGM * nN, gid = wgid / nig, fm = gid * WGM, gsz = (nM - fm) < WGM ? (nM - fm) : WGM;
        const int pm = fm + ((wgid % nig) % gsz), pn = (wgid % nig) / gsz;
        u.A = A + (size_t)pm * ta; u.B = Bt + (size_t)pn * tb; u.orow = pm * BM; u.ocol = pn * BM; u.aux = 0; u.aux2 = 0; u.valid = BM; return true;
    }
    __device__ __forceinline__ const int* rows(const Unit&) const { return nullptr; }
};

__device__ __forceinline__ unsigned cvt_pk_bf16(float lo, float hi) { unsigned r; asm volatile("v_cvt_pk_bf16_f32 %0, %1, %2" : "=v"(r) : "v"(lo), "v"(hi)); return r; }

template <class Epi, class Sched, bool ALIGN_EPI = true, bool FP8 = false>
__device__ __forceinline__ void gemm_phase(PG8_LAS unsigned char* lds, const Gemm g, const Sched& S, const Epi& E) {
    const int tid = threadIdx.x, wid = __builtin_amdgcn_readfirstlane(tid >> 6), lane = tid & 63, wr = wid >> 2, wc = wid & 3, fr = lane & 15, fq = lane >> 4;
    constexpr int ES = FP8 ? 1 : 2;
    int sclW = 0, sclX = 0;
    if constexpr (FP8) { asm volatile("v_mov_b32 %0, 0x79797979\n\tv_mov_b32 %1, 0x7f7f7f7f" : "=v"(sclW), "=v"(sclX)); }
    const int K = g.K, nt = K * ES / (BK * 2);
    unsigned voffA[2], voffB[2]; int Rr[2], Cc[2];
#pragma unroll
    for (int i = 0; i < 2; ++i) { int R, C; stage_rc(tid * 16 + i * 8192, R, C); const int Rb = Epi::PERM ? ((R & ~31) + perm32(R & 31)) : R; Rr[i] = R; Cc[i] = C;
        voffA[i] = (unsigned)(R * g.lda * ES + C * 2); voffB[i] = (unsigned)(Rb * g.ldb * ES + C * 2); }
    const size_t kstep = (size_t)(BK * 2);
    const size_t hstepA = (size_t)HALF * g.lda * ES, hstepB = (size_t)HALF * g.ldb * ES;
    const unsigned ldsw = (unsigned)wid * 1024u;
    const int aoff = lds_byte(wr * 64 + fr, fq * 8), boff = lds_byte(wc * 32 + fr, fq * 8);
    unsigned vAc[2][2], vAn[2][2];
#define PG8_SA(b, h) (((b) * 2 + (h)) * HTB)
#define PG8_SB(b, h) ((4 + (b) * 2 + (h)) * HTB)
#define PG8_STAGE(bufoff, gbase, voff) do { _Pragma("unroll") for (int _i = 0; _i < 2; ++_i) \
        __builtin_amdgcn_global_load_lds((const unsigned*)((const char*)(gbase) + (voff)[_i]), (PG8_LAS unsigned*)(lds + (bufoff) + ldsw + _i * 8192), 16, 0, 0); } while (0)
#define PG8_STAGE_A(bufoff, kbase, h, nx) do { if constexpr (Sched::GATHER) { unsigned _v[2] = {(nx) ? vAn[h][0] : vAc[h][0], (nx) ? vAn[h][1] : vAc[h][1]}; PG8_STAGE(bufoff, kbase, _v); } \
        else { PG8_STAGE(bufoff, (kbase) + (h) * hstepA, voffA); } } while (0)
#define PG8_GOFF(u, v) do { const int* _rw = S.rows(u); _Pragma("unroll") for (int _h = 0; _h < 2; ++_h) _Pragma("unroll") for (int _i = 0; _i < 2; ++_i) { const int _r = Rr[_i] + _h * HALF; \
        const int _tk = _r < (u).valid ? _rw[_r] : 0; v[_h][_i] = (unsigned)(_tk * g.lda * ES + Cc[_i] * 2); } } while (0)
#define PG8_LDA(dst, b, h) do { _Pragma("unroll") for (int m = 0; m < 4; ++m) _Pragma("unroll") for (int k = 0; k < 2; ++k) dst[m][k] = *(const PG8_LAS bf16x8*)(lds + PG8_SA(b, h) + aoff + m * 2048 + k * 1024); } while (0)
#define PG8_LDB(dst, b, h) do { _Pragma("unroll") for (int n = 0; n < 2; ++n) _Pragma("unroll") for (int k = 0; k < 2; ++k) dst[n][k] = *(const PG8_LAS bf16x8*)(lds + PG8_SB(b, h) + boff + n * 2048 + k * 1024); } while (0)
#define PG8_MMA(ai, bj, At, Bt) do { __builtin_amdgcn_s_setprio(1); _Pragma("unroll") for (int m = 0; m < 4; ++m) _Pragma("unroll") for (int n = 0; n < 2; ++n) { \
        if constexpr (FP8) { const v4i _b0 = __builtin_bit_cast(v4i, Bt[n][0]), _b1 = __builtin_bit_cast(v4i, Bt[n][1]), _a0 = __builtin_bit_cast(v4i, At[m][0]), _a1 = __builtin_bit_cast(v4i, At[m][1]); \
            const v8i _bb = __builtin_shufflevector(_b0, _b1, 0, 1, 2, 3, 4, 5, 6, 7), _aa = __builtin_shufflevector(_a0, _a1, 0, 1, 2, 3, 4, 5, 6, 7); \
            asm volatile("v_mfma_scale_f32_16x16x128_f8f6f4 %0, %1, %2, %0, %3, %4 op_sel_hi:[0,0,0]" : "+v"(acc[ai][bj][m][n]) : "v"(_bb), "v"(_aa), "v"(sclW), "v"(sclX)); } \
        else { _Pragma("unroll") for (int k = 0; k < 2; ++k) acc[ai][bj][m][n] = __builtin_amdgcn_mfma_f32_16x16x32_bf16(Bt[n][k], At[m][k], acc[ai][bj][m][n], 0, 0, 0); } } \
        __builtin_amdgcn_s_setprio(0); } while (0)
#define PG8_WAIT_V(n) asm volatile("s_waitcnt vmcnt(" #n ")" ::: "memory")
#define PG8_WAIT_L(n) asm volatile("s_waitcnt lgkmcnt(" #n ")" ::: "memory")
#define PG8_BAR __builtin_amdgcn_s_barrier()
#define PG8_SCHED __builtin_amdgcn_sched_barrier(0)
    Unit cur, nxt; int ui = 0;
    if (!S.next(0, cur)) return;
    f32x4 acc[2][2][4][2];
#pragma unroll
    for (int a = 0; a < 2; ++a)
#pragma unroll
        for (int b = 0; b < 2; ++b)
#pragma unroll
            for (int m = 0; m < 4; ++m)
#pragma unroll
                for (int n = 0; n < 2; ++n) acc[a][b][m][n] = (f32x4){0.f, 0.f, 0.f, 0.f};
    bf16x8 At[4][2], B0[2][2], B1[2][2];
    const char* cA = cur.A; const char* cB = cur.B;
    if constexpr (Sched::GATHER) { PG8_GOFF(cur, vAc); PG8_WAIT_V(0); }
    PG8_STAGE(PG8_SB(0, 0), cB, voffB); PG8_STAGE(PG8_SB(0, 1), cB + hstepB, voffB); PG8_STAGE_A(PG8_SA(0, 0), cA, 0, false); PG8_STAGE_A(PG8_SA(0, 1), cA, 1, false);
    if (wr == 1) PG8_BAR;
    PG8_WAIT_V(2); PG8_BAR;
    PG8_STAGE(PG8_SB(1, 0), cB + kstep, voffB); PG8_STAGE_A(PG8_SA(1, 0), cA + kstep, 0, false); PG8_STAGE(PG8_SB(1, 1), cB + hstepB + kstep, voffB);
    PG8_WAIT_V(6); PG8_BAR;
    for (;;) {
        const bool has_next = S.next(ui + 1, nxt);
        const char* nA = has_next ? nxt.A : cA; const char* nB = has_next ? nxt.B : cB;
        if constexpr (Sched::GATHER) { if (has_next) { PG8_GOFF(nxt, vAn); } else {
#pragma unroll
            for (int h = 0; h < 2; ++h)
#pragma unroll
                for (int i = 0; i < 2; ++i) vAn[h][i] = vAc[h][i]; } }
#pragma nounroll
        for (int t = 0; t < nt; t += 2) {
            const bool last = (t == nt - 2);
            if constexpr (Epi::MID_T >= 0) { if (t == Epi::MID_T) { int l3 = lane; asm volatile("" : "+v"(l3)); E.mid(acc, cur, wr, wc, l3 & 15, l3 >> 4); } }
            const char* a1 = cA + (size_t)(t + 1) * kstep;
            const char* a2 = last ? nA : cA + (size_t)(t + 2) * kstep; const char* b2 = last ? nB : cB + (size_t)(t + 2) * kstep;
            const char* a3 = a2 + kstep; const char* b3 = b2 + kstep;
            PG8_LDB(B0, 0, 0); PG8_LDB(B1, 0, 1); PG8_SCHED; PG8_LDA(At, 0, 0); PG8_STAGE_A(PG8_SA(1, 1), a1, 1, false);
            PG8_WAIT_V(8); PG8_WAIT_L(0); PG8_BAR; PG8_MMA(0, 0, At, B0); PG8_MMA(0, 1, At, B1); PG8_BAR; PG8_SCHED;
            PG8_LDA(At, 0, 1); PG8_STAGE(PG8_SB(0, 0), b2, voffB); PG8_STAGE(PG8_SB(0, 1), b2 + hstepB, voffB); PG8_STAGE_A(PG8_SA(0, 0), a2, 0, last);
            PG8_WAIT_V(8); PG8_WAIT_L(0); PG8_BAR; PG8_MMA(1, 0, At, B0); PG8_MMA(1, 1, At, B1); PG8_BAR; PG8_SCHED;
            PG8_LDB(B0, 1, 0); PG8_LDB(B1, 1, 1); PG8_SCHED; PG8_LDA(At, 1, 0); PG8_STAGE_A(PG8_SA(0, 1), a2, 1, last);
            PG8_WAIT_V(8); PG8_WAIT_L(0); PG8_BAR; PG8_MMA(0, 0, At, B0); PG8_MMA(0, 1, At, B1); PG8_BAR; PG8_SCHED;
            PG8_LDA(At, 1, 1); PG8_STAGE(PG8_SB(1, 0), b3, voffB); PG8_STAGE(PG8_SB(1, 1), b3 + hstepB, voffB); PG8_STAGE_A(PG8_SA(1, 0), a3, 0, last);
            PG8_WAIT_V(8); PG8_WAIT_L(0); PG8_BAR; PG8_MMA(1, 0, At, B0); PG8_MMA(1, 1, At, B1); PG8_BAR; PG8_SCHED;
        }
        if constexpr (ALIGN_EPI) { if (wr == 0) PG8_BAR; }
        if constexpr (FP8) asm volatile("s_nop 15\n\ts_nop 15" ::: "memory");
        if constexpr (!Epi::AFTER_DRAIN) { int l2 = lane; asm volatile("" : "+v"(l2));
            E(acc, cur, wr, wc, l2 & 15, l2 >> 4); }
        if (!has_next) break;
#pragma unroll
        for (int a = 0; a < 2; ++a)
#pragma unroll
            for (int b = 0; b < 2; ++b)
#pragma unroll
                for (int m = 0; m < 4; ++m)
#pragma unroll
                    for (int n = 0; n < 2; ++n) acc[a][b][m][n] = (f32x4){0.f, 0.f, 0.f, 0.f};
        cur = nxt; cA = nA; cB = nB; ++ui;
        if constexpr (Sched::GATHER) {
#pragma unroll
            for (int h = 0; h < 2; ++h)
#pragma unroll
                for (int i = 0; i < 2; ++i) vAc[h][i] = vAn[h][i]; }
        if constexpr (ALIGN_EPI) { if (wr == 1) PG8_BAR; }
    }
    PG8_WAIT_V(0);
    if constexpr (!ALIGN_EPI) { if (wr == 0) PG8_BAR; }
    PG8_BAR;
    if constexpr (Epi::AFTER_DRAIN) { E.fused(acc, cur, wr, wc, fr, fq, lds, wid, lane); }
#undef PG8_SA
#undef PG8_SB
#undef PG8_STAGE
#undef PG8_STAGE_A
#undef PG8_GOFF
#undef PG8_LDA
#undef PG8_LDB
#undef PG8_MMA
#undef PG8_WAIT_V
#undef PG8_WAIT_L
#undef PG8_BAR
#undef PG8_SCHED
}

#define EPI_LOOP_AI_M for (int ai = 0; ai < 2; ++ai) _Pragma("unroll") for (int m = 0; m < 4; ++m)

struct EpiF32 {
    static constexpr bool PERM = false, AFTER_DRAIN = false; static constexpr int MID_T = -1;
    float* C; int ldc; const float* bias; int bstride; const float* res; float alpha;
    __device__ __forceinline__ void operator()(const f32x4 (&acc)[2][2][4][2], const Unit& u, int wr, int wc, int fr, int fq) const {
        const int row0 = u.orow + wr * 64 + fr, col0 = u.ocol + wc * 32 + 4 * fq;
        f32x4 bv[2][2];
#pragma unroll
        for (int bj = 0; bj < 2; ++bj)
#pragma unroll
            for (int n = 0; n < 2; ++n) bv[bj][n] = bias ? *(const f32x4*)(bias + (size_t)u.aux * bstride + col0 + bj * HALF + n * 16) : (f32x4){0.f, 0.f, 0.f, 0.f};
#pragma unroll
        EPI_LOOP_AI_M { const size_t off = (size_t)(row0 + ai * HALF + m * 16) * ldc + col0;
#pragma unroll
            for (int bj = 0; bj < 2; ++bj)
#pragma unroll
                for (int n = 0; n < 2; ++n) { f32x4 v = acc[ai][bj][m][n] + bv[bj][n];
                    if (res) { const f32x4 rv = *(const f32x4*)(res + off + bj * HALF + n * 16); v = v + rv * alpha; }
                    *(f32x4*)(C + off + bj * HALF + n * 16) = v; }
            asm volatile("" ::: "memory"); }
    }
};
struct EpiResLn {
    static constexpr bool PERM = false, AFTER_DRAIN = false; static constexpr int MID_T = -1;
    float* C; const float* T; const f32x2* stats; const float* gam; const float* bet; float alpha;
    __device__ __forceinline__ void operator()(const f32x4 (&acc)[2][2][4][2], const Unit& u, int wr, int wc, int fr, int fq) const {
        const int row0 = u.orow + wr * 64 + fr, col0 = u.ocol + wc * 32 + 4 * fq;
        f32x4 gv[2][2], bv[2][2];
#pragma unroll
        for (int bj = 0; bj < 2; ++bj)
#pragma unroll
            for (int n = 0; n < 2; ++n) { gv[bj][n] = *(const f32x4*)(gam + col0 + bj * HALF + n * 16) * alpha; bv[bj][n] = *(const f32x4*)(bet + col0 + bj * HALF + n * 16) * alpha; }
#pragma unroll
        EPI_LOOP_AI_M { const int row = row0 + ai * HALF + m * 16; const size_t off = (size_t)row * D + col0; const f32x2 st = stats[row];
#pragma unroll
            for (int bj = 0; bj < 2; ++bj)
#pragma unroll
                for (int n = 0; n < 2; ++n) { const f32x4 tv = *(const f32x4*)(T + off + bj * HALF + n * 16);
                    *(f32x4*)(C + off + bj * HALF + n * 16) = acc[ai][bj][m][n] + ((tv - st.x) * st.y) * gv[bj][n] + bv[bj][n]; }
            asm volatile("" ::: "memory"); }
    }
};
struct EpiBf16 {
    static constexpr bool PERM = true, AFTER_DRAIN = false; static constexpr int MID_T = -1;
    bf16_t* O; int ldc; float scale;
    __device__ __forceinline__ void operator()(const f32x4 (&acc)[2][2][4][2], const Unit& u, int wr, int wc, int fr, int fq) const {
        const int row0 = u.orow + wr * 64 + fr, col0 = u.ocol + wc * 32 + 8 * fq;
#pragma unroll
        EPI_LOOP_AI_M { bf16_t* rowp = O + (size_t)(row0 + ai * HALF + m * 16) * ldc + col0;
#pragma unroll
            for (int bj = 0; bj < 2; ++bj) { const f32x4 v0 = acc[ai][bj][m][0] * scale, v1 = acc[ai][bj][m][1] * scale;
                u32x4 w; w.x = cvt_pk_bf16(v0[0], v0[1]); w.y = cvt_pk_bf16(v0[2], v0[3]); w.z = cvt_pk_bf16(v1[0], v1[1]); w.w = cvt_pk_bf16(v1[2], v1[3]);
                *(u32x4*)(rowp + bj * HALF) = w; } }
    }
};
struct EpiBf16Bias {
    static constexpr bool PERM = true, AFTER_DRAIN = false; static constexpr int MID_T = -1;
    bf16_t* O; int ldc; const float* bias; int bstride;
    __device__ __forceinline__ void operator()(const f32x4 (&acc)[2][2][4][2], const Unit& u, int wr, int wc, int fr, int fq) const {
        const int row0 = u.orow + wr * 64 + fr, col0 = u.ocol + wc * 32 + 8 * fq;
        f32x4 bv[2][2];
#pragma unroll
        for (int bj = 0; bj < 2; ++bj)
#pragma unroll
            for (int n = 0; n < 2; ++n) bv[bj][n] = *(const f32x4*)(bias + (size_t)u.aux * bstride + col0 + bj * HALF + 4 * n);
#pragma unroll
        EPI_LOOP_AI_M { bf16_t* rowp = O + (size_t)(row0 + ai * HALF + m * 16) * ldc + col0;
#pragma unroll
            for (int bj = 0; bj < 2; ++bj) { const f32x4 v0 = acc[ai][bj][m][0] + bv[bj][0], v1 = acc[ai][bj][m][1] + bv[bj][1];
                u32x4 w; w.x = cvt_pk_bf16(v0[0], v0[1]); w.y = cvt_pk_bf16(v0[2], v0[3]); w.z = cvt_pk_bf16(v1[0], v1[1]); w.w = cvt_pk_bf16(v1[2], v1[3]);
                *(u32x4*)(rowp + bj * HALF) = w; } }
    }
};
struct EpiKV {
    static constexpr bool PERM = true, AFTER_DRAIN = false; static constexpr int MID_T = -1;
    bf16_t* KB; bf16_t* VT;
    __device__ __forceinline__ void operator()(const f32x4 (&acc)[2][2][4][2], const Unit& u, int wr, int wc, int fr, int fq) const {
        const int row0 = u.orow + wr * 64 + fr, col0 = u.ocol + wc * 32 + 8 * fq;
#pragma unroll
        EPI_LOOP_AI_M { const int row = row0 + ai * HALF + m * 16;
#pragma unroll
            for (int bj = 0; bj < 2; ++bj) { const f32x4 v0 = acc[ai][bj][m][0], v1 = acc[ai][bj][m][1]; const int col = col0 + bj * HALF;
                if (u.ocol < 2048) { u32x4 w; w.x = cvt_pk_bf16(v0[0], v0[1]); w.y = cvt_pk_bf16(v0[2], v0[3]); w.z = cvt_pk_bf16(v1[0], v1[1]); w.w = cvt_pk_bf16(v1[2], v1[3]);
                    *(u32x4*)(KB + (size_t)row * 2048 + col) = w; }
                else { const int b = row >> 8, key = row & 255, c = col - 2048, h = c >> 9, d = c & 511; bf16_t* p = VT + ((size_t)((b * 4 + h) * 512 + d)) * 256 + key;
#pragma unroll
                    for (int j = 0; j < 4; ++j) { p[(size_t)j * 256] = (bf16_t)f2bf(v0[j]); p[(size_t)(4 + j) * 256] = (bf16_t)f2bf(v1[j]); } } } }
    }
};
struct EpiDecay {
    static constexpr bool PERM = false, AFTER_DRAIN = false; static constexpr int MID_T = -1;
    float* DEC; const float* w0;
    __device__ __forceinline__ void operator()(const f32x4 (&acc)[2][2][4][2], const Unit& u, int wr, int wc, int fr, int fq) const {
        const int row0 = u.orow + wr * 64 + fr, col0 = u.ocol + wc * 32 + 4 * fq;
        f32x4 bv[2][2];
#pragma unroll
        for (int bj = 0; bj < 2; ++bj)
#pragma unroll
            for (int n = 0; n < 2; ++n) bv[bj][n] = *(const f32x4*)(w0 + col0 + bj * HALF + n * 16);
#pragma unroll
        EPI_LOOP_AI_M { const size_t off = (size_t)(row0 + ai * HALF + m * 16) * D + col0;
#pragma unroll
            for (int bj = 0; bj < 2; ++bj)
#pragma unroll
                for (int n = 0; n < 2; ++n) { const f32x4 x = acc[ai][bj][m][n] + bv[bj][n]; f32x4 o;
#pragma unroll
                    for (int j = 0; j < 4; ++j) o[j] = __expf(-0.6065306597126334f * sigmoidf_(x[j]));
                    *(f32x4*)(DEC + off + bj * HALF + n * 16) = o; } }
    }
};
struct EpiIclr {
    static constexpr bool PERM = true, AFTER_DRAIN = false; static constexpr int MID_T = -1;
    const float* a0; const float* k_k; const float* k_a; const bf16_t* KZ; const float* KNORM; bf16_t* KP; bf16_t* AN; bf16_t* BB;
    __device__ __forceinline__ void operator()(const f32x4 (&acc)[2][2][4][2], const Unit& u, int wr, int wc, int fr, int fq) const {
        const int row0 = u.orow + wr * 64 + fr, col0 = u.ocol + wc * 32 + 8 * fq;
#pragma unroll
        for (int bj = 0; bj < 2; ++bj) { const int col = col0 + bj * HALF;
            const f32x4 a00 = *(const f32x4*)(a0 + col), a01 = *(const f32x4*)(a0 + col + 4), kk0 = *(const f32x4*)(k_k + col), kk1 = *(const f32x4*)(k_k + col + 4), ka0 = *(const f32x4*)(k_a + col), ka1 = *(const f32x4*)(k_a + col + 4);
#pragma unroll
            EPI_LOOP_AI_M { const int row = row0 + ai * HALF + m * 16; const size_t off = (size_t)row * D + col;
                const u32x4 kzw = *(const u32x4*)(KZ + off); const float nr = KNORM[(size_t)row * 32 + (col >> 6)]; const float inv = 1.0f / fmaxf(nr, 1e-12f);
                const unsigned kw[4] = {kzw.x, kzw.y, kzw.z, kzw.w};
                float kp[8], an[8], bb[8];
#pragma unroll
                for (int j = 0; j < 8; ++j) { const float kz = bf2f((kw[j >> 1] >> (16 * (j & 1))) & 0xffffu);
                    const float x = (j < 4 ? acc[ai][bj][m][0][j & 3] + a00[j & 3] : acc[ai][bj][m][1][j & 3] + a01[j & 3]);
                    const float kkc = j < 4 ? kk0[j & 3] : kk1[j & 3], kac = j < 4 ? ka0[j & 3] : ka1[j & 3];
                    const float a = sigmoidf_(x); const float kk = kz * kkc * inv; kp[j] = kz * (1.0f + (a - 1.0f) * kac); bb[j] = kk * a; an[j] = -kk; }
                *(u32x4*)(KP + off) = (u32x4){cvt_pk_bf16(kp[0], kp[1]), cvt_pk_bf16(kp[2], kp[3]), cvt_pk_bf16(kp[4], kp[5]), cvt_pk_bf16(kp[6], kp[7])};
                *(u32x4*)(AN + off) = (u32x4){cvt_pk_bf16(an[0], an[1]), cvt_pk_bf16(an[2], an[3]), cvt_pk_bf16(an[4], an[5]), cvt_pk_bf16(an[6], an[7])};
                *(u32x4*)(BB + off) = (u32x4){cvt_pk_bf16(bb[0], bb[1]), cvt_pk_bf16(bb[2], bb[3]), cvt_pk_bf16(bb[4], bb[5]), cvt_pk_bf16(bb[6], bb[7])}; }
            asm volatile("" ::: "memory"); }
    }
};
struct EpiGateFused {
    static constexpr bool PERM = true, AFTER_DRAIN = false; static constexpr int MID_T = 32;
    const bf16_t* PROJ; bf16_t* MERGED;
    __device__ __forceinline__ void mid(f32x4 (&acc)[2][2][4][2], const Unit& u, int wr, int wc, int fr, int fq) const {
        const int row0 = u.orow + wr * 64 + fr, col0 = u.ocol + wc * 32 + 8 * fq;
#pragma unroll
        EPI_LOOP_AI_M { const int row = row0 + ai * HALF + m * 16;
#pragma unroll
            for (int bj = 0; bj < 2; ++bj) { const int col = col0 + bj * HALF;
                const u32x4 g1v = *(const u32x4*)(PROJ + (size_t)row * PC + GATE0 + col), g2v = *(const u32x4*)(PROJ + (size_t)row * PC + GATE0 + 2048 + col);
                const unsigned w1[4] = {g1v.x, g1v.y, g1v.z, g1v.w}, w2[4] = {g2v.x, g2v.y, g2v.z, g2v.w};
#pragma unroll
                for (int j = 0; j < 8; ++j) { const float x1 = bf2f((w1[j >> 1] >> (16 * (j & 1))) & 0xffffu), x2 = fmaxf(bf2f((w2[j >> 1] >> (16 * (j & 1))) & 0xffffu), -60.0f);
                    const float ratio = (1.0f + __expf(-x2)) / (1.0f + __expf(-x1));
                    if (j < 4) acc[ai][bj][m][0][j & 3] *= ratio; else acc[ai][bj][m][1][j & 3] *= ratio; } }
            asm volatile("" ::: "memory"); }
    }
    __device__ __forceinline__ void operator()(const f32x4 (&acc)[2][2][4][2], const Unit& u, int wr, int wc, int fr, int fq) const {
        const int row0 = u.orow + wr * 64 + fr, col0 = u.ocol + wc * 32 + 8 * fq;
#pragma unroll
        EPI_LOOP_AI_M { const int row = row0 + ai * HALF + m * 16;
#pragma unroll
            for (int bj = 0; bj < 2; ++bj) { const int col = col0 + bj * HALF; const u32x4 gv = *(const u32x4*)(PROJ + (size_t)row * PC + GATE0 + 2048 + col);
                const unsigned w2[4] = {gv.x, gv.y, gv.z, gv.w}; float o[8];
#pragma unroll
                for (int j = 0; j < 8; ++j) { const float x2 = fmaxf(bf2f((w2[j >> 1] >> (16 * (j & 1))) & 0xffffu), -60.0f); o[j] = (j < 4 ? acc[ai][bj][m][0][j & 3] : acc[ai][bj][m][1][j & 3]) * sigmoidf_(x2); }
                u32x4 w; w.x = cvt_pk_bf16(o[0], o[1]); w.y = cvt_pk_bf16(o[2], o[3]); w.z = cvt_pk_bf16(o[4], o[5]); w.w = cvt_pk_bf16(o[6], o[7]);
                *(u32x4*)(MERGED + (size_t)row * D + col) = w; }
            asm volatile("" ::: "memory"); }
    }
};
struct EpiSwiglu {
    static constexpr bool PERM = true, AFTER_DRAIN = false; static constexpr int MID_T = -1;
    const float* b1; bf16_t* H;
    __device__ __forceinline__ float sw(float g, float l) const { g = fminf(g, 7.0f); l = fminf(fmaxf(l, -7.0f), 7.0f); return g * sigmoidf_(1.702f * g) * (l + 1.0f); }
    __device__ __forceinline__ void operator()(const f32x4 (&acc)[2][2][4][2], const Unit& u, int wr, int wc, int fr, int fq) const {
        const int row0 = u.orow + wr * 64 + fr, col0 = u.ocol + wc * 32 + 8 * fq;
        f32x4 bv[2][2];
#pragma unroll
        for (int bj = 0; bj < 2; ++bj)
#pragma unroll
            for (int n = 0; n < 2; ++n) bv[bj][n] = *(const f32x4*)(b1 + (size_t)u.aux * 4096 + col0 + bj * HALF + 4 * n);
#pragma unroll
        EPI_LOOP_AI_M { const int row = row0 + ai * HALF + m * 16;
#pragma unroll
            for (int bj = 0; bj < 2; ++bj) { const f32x4 v0 = acc[ai][bj][m][0] + bv[bj][0], v1 = acc[ai][bj][m][1] + bv[bj][1];
                *(unsigned*)((unsigned char*)H + (size_t)row * DFF + ((col0 + bj * HALF) >> 1)) = pk4_fp8(sw(v0[0], v0[1]), sw(v0[2], v0[3]), sw(v1[0], v1[1]), sw(v1[2], v1[3])); } }
    }
};
struct EpiSoftmax {
    static constexpr bool PERM = true, AFTER_DRAIN = true; static constexpr int MID_T = -1;
    bf16_t* PP;
    __device__ __forceinline__ void fused(f32x4 (&acc)[2][2][4][2], const Unit& u, int wr, int wc, int fr, int fq, PG8_LAS unsigned char* lds, int wid, int lane) const {
        PG8_LAS float* P1 = (PG8_LAS float*)lds;
        PG8_LAS float* P2 = (PG8_LAS float*)(lds + 4096);
        float mx[2][4];
#pragma unroll
        EPI_LOOP_AI_M { float v = -3.0e38f;
#pragma unroll
            for (int bj = 0; bj < 2; ++bj)
#pragma unroll
                for (int n = 0; n < 2; ++n) { const f32x4 x = acc[ai][bj][m][n]; v = fmaxf(v, fmaxf(fmaxf(x[0], x[1]), fmaxf(x[2], x[3]))); }
            v = fmaxf(v, __shfl_xor(v, 16)); v = fmaxf(v, __shfl_xor(v, 32));
            if (fq == 0) P1[(ai * HALF + wr * 64 + m * 16 + fr) * 4 + wc] = v; }
        asm volatile("s_waitcnt lgkmcnt(0)" ::: "memory"); __builtin_amdgcn_s_barrier(); asm volatile("" ::: "memory");
#pragma unroll
        EPI_LOOP_AI_M { const f32x4 t = *(const PG8_LAS f32x4*)(P1 + (ai * HALF + wr * 64 + m * 16 + fr) * 4); mx[ai][m] = fmaxf(fmaxf(t[0], t[1]), fmaxf(t[2], t[3])); }
#pragma unroll
        EPI_LOOP_AI_M { float s = 0.f;
#pragma unroll
            for (int bj = 0; bj < 2; ++bj)
#pragma unroll
                for (int n = 0; n < 2; ++n) { f32x4 x = acc[ai][bj][m][n];
#pragma unroll
                    for (int j = 0; j < 4; ++j) { x[j] = __expf(x[j] - mx[ai][m]); s += x[j]; }
                    acc[ai][bj][m][n] = x; }
            s += __shfl_xor(s, 16); s += __shfl_xor(s, 32);
            if (fq == 0) P2[(ai * HALF + wr * 64 + m * 16 + fr) * 4 + wc] = s; }
        asm volatile("s_waitcnt lgkmcnt(0)" ::: "memory"); __builtin_amdgcn_s_barrier(); asm volatile("" ::: "memory");
        const int row0 = u.orow + wr * 64 + fr, col0 = wc * 32 + 8 * fq;
#pragma unroll
        EPI_LOOP_AI_M { const f32x4 t = *(const PG8_LAS f32x4*)(P2 + (ai * HALF + wr * 64 + m * 16 + fr) * 4); const float inv = 1.0f / ((t[0] + t[1]) + (t[2] + t[3]));
            bf16_t* rowp = PP + (size_t)(row0 + ai * HALF + m * 16) * 256 + col0;
#pragma unroll
            for (int bj = 0; bj < 2; ++bj) { const f32x4 v0 = acc[ai][bj][m][0] * inv, v1 = acc[ai][bj][m][1] * inv;
                u32x4 w; w.x = cvt_pk_bf16(v0[0], v0[1]); w.y = cvt_pk_bf16(v0[2], v0[3]); w.z = cvt_pk_bf16(v1[0], v1[1]); w.w = cvt_pk_bf16(v1[2], v1[3]);
                *(u32x4*)(rowp + bj * HALF) = w; } }
        asm volatile("s_waitcnt lgkmcnt(0)" ::: "memory"); __builtin_amdgcn_s_barrier(); asm volatile("" ::: "memory");
    }
};
}

constexpr size_t MiB = 1u << 20;
constexpr size_t al256(size_t x) { return (x + 255) & ~(size_t)255; }
constexpr size_t WS_CTL = 0, CTL_ZERO_BYTES = 1 * MiB;
constexpr size_t WS_WIN = 1 * MiB;
constexpr size_t WS_WUP = WS_WIN + (size_t)PC * D * 2;
constexpr size_t WS_AUP = WS_WUP + (size_t)D * 256 * 2;
constexpr size_t WS_GUP = WS_AUP + (size_t)D * 256 * 2;
constexpr size_t WS_PA = WS_GUP + (size_t)D * 256 * 2;
constexpr size_t WS_PB = WS_PA + (size_t)D * D * 2;
constexpr size_t WS_WOUT = WS_PB + (size_t)D * 512 * 2;
constexpr size_t WS_WQ = WS_WOUT + (size_t)D * D * 2;
constexpr size_t WS_WKV = WS_WQ + (size_t)D * D * 2;
constexpr size_t WS_WO = WS_WKV + (size_t)2 * D * D * 2;
constexpr size_t WS_W1 = WS_WO + (size_t)D * D * 2;
constexpr size_t WS_W2 = WS_W1 + (size_t)NEXP * 4096 * D * 2;
constexpr size_t WS_XB = WS_W2 + (size_t)NEXP * D * DFF * 2;
constexpr size_t WS_MEMB = WS_XB + (size_t)M * D * 2;
constexpr size_t WS_ROT = WS_MEMB + (size_t)1024 * D * 2;
constexpr size_t WS_KB = WS_ROT + (size_t)2 * SEQ * 32 * 4;
constexpr size_t WS_VT = WS_KB + (size_t)1024 * D * 2;
constexpr size_t WS_YA = WS_VT + (size_t)1024 * D * 2;
constexpr size_t WS_YB = WS_YA + (size_t)M * D * 2;
constexpr size_t WS_TMP = WS_YB + (size_t)M * 512 * 2;
constexpr size_t WS_MERGED = WS_TMP + (size_t)M * D * 4;
constexpr size_t WS_E = WS_MERGED + (size_t)M * D * 2;
constexpr size_t WS_PROJ = WS_E;
constexpr size_t WS_RZ = WS_PROJ + (size_t)M * PC * 2;
constexpr size_t WS_KZ = WS_RZ + (size_t)M * D * 4;
constexpr size_t WS_VZ = WS_KZ + (size_t)M * D * 4;
constexpr size_t WS_DEC = WS_VZ + (size_t)M * D * 4;
constexpr size_t WS_KP = WS_DEC + (size_t)M * D * 4;
constexpr size_t WS_AN = WS_KP + (size_t)M * D * 4;
constexpr size_t WS_BB = WS_AN + (size_t)M * D * 4;
constexpr size_t WS_GG = WS_BB + (size_t)M * D * 4;
constexpr size_t WS_YS = WS_GG + (size_t)M * D * 4;
constexpr size_t WS_XQ = WS_YS + 60 * MiB;
constexpr size_t WS_WIN8 = WS_YS + 96 * MiB;
constexpr size_t WS_ST1 = WS_YS + 112 * MiB, WS_ST2 = WS_YS + 113 * MiB;
constexpr size_t WS_VR = WS_YS + 4 * MiB;
constexpr size_t WS_AO = WS_YS + (size_t)M * D * 4;
constexpr size_t WS_LSE = WS_AO + (size_t)3 * M * 512 * 4;
constexpr size_t WS_QR = WS_LSE + (size_t)3 * M * 8 * 4;
constexpr size_t WS_KR = WS_QR + (size_t)M * 1536 * 2;
constexpr size_t WS_LIN = WS_KR + (size_t)M * 1536 * 2;
constexpr size_t WS_KNORM = WS_LIN + (size_t)M * 768 * 2;
constexpr size_t WS_F = WS_KNORM + (size_t)M * 32 * 4;
constexpr size_t WS_E_END = WS_F + (size_t)128 * 128 * 96 * 96 * 2;
constexpr size_t WS_T1 = WS_E;
constexpr size_t WS_X1 = WS_T1 + (size_t)M * D * 4;
constexpr size_t WS_X1B = WS_X1 + (size_t)M * D * 4;
constexpr size_t WS_Q = WS_X1B + (size_t)M * D * 2;
constexpr size_t WS_PP = WS_Q + (size_t)M * D * 2;
constexpr size_t WS_OC = WS_PP + (size_t)16 * SEQ * 256 * 2;
constexpr size_t WS_T2 = WS_OC + (size_t)M * D * 2;
constexpr size_t WS_X2 = WS_T2 + (size_t)M * D * 4;
constexpr size_t WS_X2B = WS_X2 + (size_t)M * D * 4;
constexpr size_t WS_LIST = WS_X2B + (size_t)M * D * 2;
constexpr size_t WS_ROWI = WS_LIST + (size_t)NEXP * CAP * 4;
constexpr size_t WS_TOPW = WS_ROWI + (size_t)M * 4 * 4;
constexpr size_t WS_H = WS_TOPW + (size_t)M * 4 * 4;
constexpr size_t WS_Y = WS_H + (size_t)HROWS * DFF * 2;
constexpr size_t WS_L_END = WS_Y + (size_t)HROWS * D * 4;
constexpr size_t WS_END = (WS_E_END > WS_L_END ? WS_E_END : WS_L_END);
static_assert(WS_END <= (size_t)4090 * MiB, "workspace map exceeds 4 x largest input");
constexpr int CW_TMO = 0, CW_CNT = 64  , CW_Q = 128  , CW_BAR = 4096;

constexpr int RING_BYTES = 131072, MISC_OFF = RING_BYTES, LDS_BYTES = 147456;

#define XB_TMO      128
#define XB_XCNT(j)  (256  + 64 * (j))
#define XB_XSUB(j)  (1280 + 64 * (j))
#define XB_XGEN(j)  (2304 + 64 * (j))
#define XB_TOP      3328
#define XB_TOPGEN   3392
#define XCD_BAR_WORDS 3456
#define XB_SPIN_CAP (1u << 18)
__device__ __forceinline__ unsigned xb_ld(unsigned* p)              { return __hip_atomic_load(p, __ATOMIC_RELAXED, __HIP_MEMORY_SCOPE_AGENT); }
__device__ __forceinline__ unsigned xb_add(unsigned* p, unsigned v) { return __hip_atomic_fetch_add(p, v, __ATOMIC_RELAXED, __HIP_MEMORY_SCOPE_AGENT); }
__device__ __forceinline__ unsigned xb_xcc_id() { return (unsigned)__builtin_amdgcn_s_getreg((3 << 11) | 20) & 0xFu; }
#define XB_SPIN(cond, bar) do { unsigned _sp = 0; while (cond) { __builtin_amdgcn_s_sleep(1); \
    if ((++_sp & 255u) == 0u) { if (xb_ld(&(bar)[XB_TMO])) break; if (_sp > XB_SPIN_CAP) { atomicAdd(&(bar)[XB_TMO], 1u); break; } } } } while (0)
struct XcdBarrier { unsigned* bar; unsigned x; volatile LAS unsigned* st; };
__device__ __forceinline__ XcdBarrier xcd_barrier_post(unsigned* bar, volatile LAS unsigned* st) {
    XcdBarrier b; b.bar = bar; b.x = xb_xcc_id(); b.st = st;
    if (threadIdx.x == 0) (void)xb_add(&bar[XB_XCNT(b.x)], 1u);
    return b;
}
__device__ __forceinline__ void xcd_barrier_complete(unsigned* bar, unsigned x, unsigned& nloc, unsigned& nx) {
    const unsigned G = gridDim.x * gridDim.y * gridDim.z;
    unsigned sum, cnt, mine, sp = 0u;
    for (;;) {
        sum = 0u; cnt = 0u; mine = 0u;
#pragma unroll
        for (unsigned j = 0; j < 16; ++j) { const unsigned c = xb_ld(&bar[XB_XCNT(j)]); sum += c; cnt += (c > 0u) ? 1u : 0u; mine = (j == x) ? c : mine; }
        if (sum == G) break;
        __builtin_amdgcn_s_sleep(1);
        if ((++sp & 255u) == 0u) { if (xb_ld(&bar[XB_TMO])) break; if (sp > XB_SPIN_CAP) { atomicAdd(&bar[XB_TMO], 1u); break; } }
    }
    nloc = mine > 0u ? mine : 1u; nx = cnt > 0u ? cnt : 1u;
}
__device__ __forceinline__ void xcd_barrier(const XcdBarrier& b) {
    asm volatile("s_waitcnt vmcnt(0)" ::: "memory");
    __syncthreads();
    if (threadIdx.x == 0) {
        unsigned* bar = b.bar;
        __builtin_amdgcn_s_waitcnt(0);
        unsigned nloc = b.st[0], nx = b.st[1];
        if (nloc == 0u) { xcd_barrier_complete(bar, b.x, nloc, nx); b.st[0] = nloc; b.st[1] = nx; }
        const unsigned old = xb_add(&bar[XB_XSUB(b.x)], 1u);
        const unsigned gen = old / nloc;
        if (old + 1u == (gen + 1u) * nloc) {
            __builtin_amdgcn_fence(__ATOMIC_RELEASE, "agent");
            asm volatile("s_waitcnt vmcnt(0)" ::: "memory");
            const unsigned og = xb_add(&bar[XB_TOP], 1u);
            const unsigned tg = og / nx;
            if (og + 1u == (tg + 1u) * nx) xb_add(&bar[XB_TOPGEN], 1u);
            else XB_SPIN(xb_ld(&bar[XB_TOPGEN]) == tg, bar);
            __builtin_amdgcn_fence(__ATOMIC_ACQUIRE, "agent");
            xb_add(&bar[XB_XGEN(b.x)], 1u);
            asm volatile("s_waitcnt vmcnt(0)" ::: "memory");
        } else {
            XB_SPIN(xb_ld(&bar[XB_XGEN(b.x)]) == gen, bar);
            __builtin_amdgcn_fence(__ATOMIC_ACQUIRE, "agent");
            asm volatile("s_waitcnt vmcnt(0)" ::: "memory");
        }
    }
    __syncthreads();
}

struct Params {
    const float* in[32];
    float* out; unsigned char* ws;
    int ph_lo, ph_hi, li, pad;
};
enum { I_X = 0, I_MEM, I_WIN, I_MIX, I_W0, I_WUP, I_A0, I_AUP, I_GUP, I_KK, I_KA, I_RK, I_LNXG, I_LNXB, I_PA, I_PB, I_WOUT, I_LN1G, I_LN1B, I_WQ, I_WKV, I_WO, I_LN2G, I_LN2B,
       I_RW, I_RB, I_W1, I_B1, I_W2, I_B2, I_LN3G, I_LN3B };

struct ScoreOrder {
    static constexpr bool GATHER = false;
    const char* Q; const char* KB; int G, c;
    __device__ bool next(int i, pg8::Unit& u) const {
        const int L = i * G + c; if (L >= 256) return false;
        const int bh = L >> 4, pm = L & 15, b = bh >> 2, h = bh & 3;
        u.A = Q + ((size_t)(b * SEQ + 256 * pm) * D + h * 512) * 2; u.B = KB + ((size_t)(b * 256) * D + h * 512) * 2;
        u.orow = bh * SEQ + 256 * pm; u.ocol = 0; u.aux = 0; u.aux2 = 0; u.valid = 256; return true;
    }
    __device__ __forceinline__ const int* rows(const pg8::Unit&) const { return nullptr; }
};
struct PvOrder {
    static constexpr bool GATHER = false;
    const char* PP; const char* VT; int G, c;
    __device__ bool next(int i, pg8::Unit& u) const {
        const int L = i * G + c; if (L >= 512) return false;
        const int bh = L >> 5, pm = (L >> 1) & 15, pn = L & 1, b = bh >> 2, h = bh & 3;
        u.A = PP + ((size_t)(bh * SEQ + 256 * pm) * 256) * 2; u.B = VT + ((size_t)(bh * 512 + 256 * pn) * 256) * 2;
        u.orow = b * SEQ + 256 * pm; u.ocol = h * 512 + 256 * pn; u.aux = 0; u.aux2 = 0; u.valid = 256; return true;
    }
    __device__ __forceinline__ const int* rows(const pg8::Unit&) const { return nullptr; }
};
template <bool GATHER_, int NT  > struct MoeOrder {
    static constexpr bool GATHER = GATHER_;
    const LAS int* tab; const char* A; const char* W; const int* list; size_t wexp  ; int ldb; int G, c;
    __device__ bool next(int i, pg8::Unit& u) const {
        constexpr int RPR = 256 / NT;
        const int rt = i * RPR + (c % RPR), pn = c / RPR, T = __builtin_amdgcn_readfirstlane(tab[64]);
        if (c >= 256 || rt >= T) return false;
        int e = 0;
        for (int j = 1; j < NEXP; ++j) e = (rt >= __builtin_amdgcn_readfirstlane(tab[32 + j])) ? j : e;
        const int lt = rt - __builtin_amdgcn_readfirstlane(tab[32 + e]), cnt = __builtin_amdgcn_readfirstlane(tab[e]);
        u.aux = e; u.aux2 = lt; u.valid = min(256, cnt - 256 * lt); u.orow = 256 * rt; u.ocol = 256 * pn;
        u.B = W + (size_t)e * wexp + (size_t)(256 * pn) * ldb;
        u.A = GATHER_ ? A : A + (size_t)(256 * rt) * DFF;
        return true;
    }
    __device__ __forceinline__ const int* rows(const pg8::Unit& u) const { return list + (size_t)u.aux * CAP + 256 * u.aux2; }
};

struct Ctx { int tid, lane, wave, vcu, G; LAS unsigned char* lds; unsigned char* ws; };

__device__ __forceinline__ void cv_issue(const float* W, int ldw, int Ksrc, int sc0, int k0, int lane, float (&cv)[32]) {
    const int kb = k0 + 32 * (lane >> 5); const bool ok = sc0 >= 0 && kb < Ksrc;
    const float* src = W + (ok ? (size_t)kb * ldw + sc0 + (lane & 31) : (size_t)0);
#pragma unroll
    for (int i = 0; i < 32; ++i) { const float v = src[(size_t)i * ldw]; cv[i] = ok ? v : 0.f; }
}
__device__ __forceinline__ void cv_store16(const float (&cv)[32], bf16_t* WT, int ldt, int n0, int k0, int lane) {
    u32x4* dst = (u32x4*)(WT + (size_t)(n0 + (lane & 31)) * ldt + k0 + 32 * (lane >> 5));
#pragma unroll
    for (int j = 0; j < 4; ++j) dst[j] = (u32x4){pk2(cv[8 * j], cv[8 * j + 1]), pk2(cv[8 * j + 2], cv[8 * j + 3]), pk2(cv[8 * j + 4], cv[8 * j + 5]), pk2(cv[8 * j + 6], cv[8 * j + 7])};
}
__device__ __forceinline__ void cv_store8(const float (&cv)[32], unsigned char* WT8, int ldt, int n0, int k0, int lane) {
    u32x4* dst = (u32x4*)(WT8 + (size_t)(n0 + (lane & 31)) * ldt + k0 + 32 * (lane >> 5));
#pragma unroll
    for (int j = 0; j < 2; ++j) dst[j] = (u32x4){pk4_fp8(cv[16 * j] * 64.f, cv[16 * j + 1] * 64.f, cv[16 * j + 2] * 64.f, cv[16 * j + 3] * 64.f), pk4_fp8(cv[16 * j + 4] * 64.f, cv[16 * j + 5] * 64.f, cv[16 * j + 6] * 64.f, cv[16 * j + 7] * 64.f),
        pk4_fp8(cv[16 * j + 8] * 64.f, cv[16 * j + 9] * 64.f, cv[16 * j + 10] * 64.f, cv[16 * j + 11] * 64.f), pk4_fp8(cv[16 * j + 12] * 64.f, cv[16 * j + 13] * 64.f, cv[16 * j + 14] * 64.f, cv[16 * j + 15] * 64.f)};
}
struct CvJob { const float* W; bf16_t* WT; int ldw, Ksrc, sc0, ldt, n0, k0, f8, kd; };
__device__ __forceinline__ CvJob p0_job(const Params& p, unsigned char* ws, int it) {
    constexpr int I_WINJ = 32 * 480, I_LORA = 4 * 64, I_SQ = 32 * 64, I_PBJ = 8 * 64, I_KVJ = 32 * 128;
    CvJob j; j.f8 = 0; j.kd = 0; int r = it;
#define P0_PLAIN_F8(SRC, DST, N_, KS_, KD_) { const int nblk = (N_) / 32, kb = r / nblk, nb = r % nblk; j.W = p.in[SRC]; j.WT = (bf16_t*)(ws + (DST)); j.ldw = (N_); j.Ksrc = (KS_); j.sc0 = 32 * nb; j.ldt = (KD_); j.n0 = 32 * nb; j.k0 = 64 * kb; j.f8 = 1; return j; }
#define P0_PLAIN(SRC, DST, N_, KS_, KD_) { const int nblk = (N_) / 32, kb = r / nblk, nb = r % nblk; j.W = p.in[SRC]; j.WT = (bf16_t*)(ws + (DST)); j.ldw = (N_); j.Ksrc = (KS_); j.sc0 = 32 * nb; j.ldt = (KD_); j.n0 = 32 * nb; j.k0 = 64 * kb; return j; }
    if (r < I_WINJ) { const int kb = r / 480, nb = r % 480; j.W = p.in[I_WIN]; j.WT = (bf16_t*)(ws + WS_WIN); j.ldw = 15296; j.Ksrc = D; const int n_ = 32 * nb;
        j.sc0 = n_ < RWC ? n_ : (n_ < ATTV2 ? -1 : (n_ < ATT0 ? RWC + 4096 + (n_ - ATTV2) : (n_ < GATE0 ? RWC + (n_ - ATT0) : n_ - 64))); j.ldt = D; j.n0 = n_; j.k0 = 64 * kb;
        if (n_ >= ATT0) { j.f8 = 1; j.WT = (bf16_t*)(ws + WS_WIN8); j.n0 = n_ - ATT0; }
        return j; } r -= I_WINJ;
    if (r < I_LORA) P0_PLAIN(I_WUP, WS_WUP, D, 96, 256) r -= I_LORA;
    if (r < I_LORA) P0_PLAIN(I_AUP, WS_AUP, D, 96, 256) r -= I_LORA;
    if (r < I_LORA) P0_PLAIN(I_GUP, WS_GUP, D, 256, 256) r -= I_LORA;
    if (r < I_SQ) P0_PLAIN(I_PA, WS_PA, D, D, 2560) r -= I_SQ;
    if (r < I_PBJ) { const int kb = r / 64, nb = r % 64; j.W = p.in[I_PB]; j.WT = (bf16_t*)(ws + WS_PA); j.ldw = D; j.Ksrc = 512; j.sc0 = 32 * nb; j.ldt = 2560; j.n0 = 32 * nb; j.k0 = 64 * kb; j.kd = 2048; return j; } r -= I_PBJ;
    if (r < I_SQ) P0_PLAIN(I_WOUT, WS_WOUT, D, D, D) r -= I_SQ;
    if (r < I_SQ) { P0_PLAIN_F8(I_WQ, WS_WQ, D, D, D) } r -= I_SQ;
    if (r < I_KVJ) P0_PLAIN(I_WKV, WS_WKV, 2 * D, D, D) r -= I_KVJ;
    P0_PLAIN(I_WO, WS_WO, D, D, D)
#undef P0_PLAIN
#undef P0_PLAIN_F8
}
__device__ __forceinline__ void p0_prologue(const Params& p, const Ctx& c) {
    const int gw = c.vcu * 8 + c.wave, NGW = c.G * 8;
    unsigned char* ws = c.ws;
    constexpr int NITEMS = 32 * 480 + 3 * (4 * 64) + 4 * (32 * 64) + 8 * 64 + 32 * 128;
    { float ca[32], cb[32]; CvJob ja, jb; int it = gw;
      if (it < NITEMS) { ja = p0_job(p, ws, it); cv_issue(ja.W, ja.ldw, ja.Ksrc, ja.sc0, ja.k0, c.lane, ca); }
      for (; it < NITEMS; it += 2 * NGW) {
          if (it + NGW < NITEMS) { jb = p0_job(p, ws, it + NGW); cv_issue(jb.W, jb.ldw, jb.Ksrc, jb.sc0, jb.k0, c.lane, cb); }
          if (ja.f8) cv_store8(ca, (unsigned char*)ja.WT, ja.ldt, ja.n0, ja.k0, c.lane); else cv_store16(ca, ja.WT, ja.ldt, ja.n0, ja.k0 + ja.kd, c.lane);
          if (it + 2 * NGW < NITEMS) { ja = p0_job(p, ws, it + 2 * NGW); cv_issue(ja.W, ja.ldw, ja.Ksrc, ja.sc0, ja.k0, c.lane, ca); }
          if (it + NGW < NITEMS) { if (jb.f8) cv_store8(cb, (unsigned char*)jb.WT, jb.ldt, jb.n0, jb.k0, c.lane); else cv_store16(cb, jb.WT, jb.ldt, jb.n0, jb.k0 + jb.kd, c.lane); }
      } }
    const size_t gt = (size_t)c.vcu * 512 + c.tid, NT = (size_t)c.G * 512;
    for (size_t i = gt; i < (size_t)M * D / 8; i += NT) { const f32x4 a = ((const f32x4*)p.in[I_X])[2 * i], b = ((const f32x4*)p.in[I_X])[2 * i + 1];
        u32x4 o; o.x = pk2(a[0], a[1]); o.y = pk2(a[2], a[3]); o.z = pk2(b[0], b[1]); o.w = pk2(b[2], b[3]); ((u32x4*)(ws + WS_XB))[i] = o;
        ((u32x2*)(ws + WS_XQ))[i] = (u32x2){pk4_fp8(a[0], a[1], a[2], a[3]), pk4_fp8(b[0], b[1], b[2], b[3])}; }
    for (size_t i = gt; i < (size_t)1024 * D / 8; i += NT) { const f32x4 a = ((const f32x4*)p.in[I_MEM])[2 * i], b = ((const f32x4*)p.in[I_MEM])[2 * i + 1];
        u32x4 o; o.x = pk2(a[0], a[1]); o.y = pk2(a[2], a[3]); o.z = pk2(b[0], b[1]); o.w = pk2(b[2], b[3]); ((u32x4*)(ws + WS_MEMB))[i] = o; }
    float* rc = (float*)(ws + WS_ROT); float* rs = rc + SEQ * 32;
    for (size_t i = gt; i < (size_t)SEQ * 32; i += NT) { const int pos = (int)(i >> 5), j = (int)(i & 31);
        const double inv = exp(-(double)j * (9.210340371976184 / 32.0)); const double ang = (double)pos * inv; rc[i] = (float)cos(ang); rs[i] = (float)sin(ang); }
}

constexpr int MOE_W1E = 32 * 128, MOE_W2E = 32 * 64, MOE_CONV_GROUPS = (NEXP * MOE_W2E) / 8;
__device__ __forceinline__ void conv_group(const Params& p, const Ctx& c, int gi) {
    unsigned char* ws = c.ws;
    const int r = gi * 8 + c.wave;
    const int e = r / MOE_W2E, it = r % MOE_W2E, kb = it >> 6, nb = it & 63;
    float cv[32]; cv_issue(p.in[I_W2] + (size_t)e * DFF * D, D, DFF, 32 * nb, 64 * kb, c.lane, cv);
    cv_store8(cv, ws + WS_W2 + (size_t)e * D * DFF, DFF, 32 * nb, 64 * kb, c.lane);
}

#define DPP_ADD(x, ctrl) ((x) + __builtin_bit_cast(float, __builtin_amdgcn_update_dpp(0, __builtin_bit_cast(int, (x)), (ctrl), 0xF, 0xF, true)))
struct P2Tok { u32x4 cv0, pv0, cv1, pv1, ra, rb, vv; f32x4 c0, c1, s0, s1; };
__device__ __forceinline__ void p2_prep(const Params& p, const Ctx& c) {
    unsigned char* ws = c.ws;
    const bf16_t* PROJ = (const bf16_t*)(ws + WS_PROJ);
    const float* mix = p.in[I_MIX]; const float* k_k = p.in[I_KK];
    bf16_t* RZ = (bf16_t*)(ws + WS_RZ); bf16_t* KZ = (bf16_t*)(ws + WS_KZ); bf16_t* VZ = (bf16_t*)(ws + WS_VZ);
    bf16_t* LIN = (bf16_t*)(ws + WS_LIN); float* KNORM = (float*)(ws + WS_KNORM);
    bf16_t* QR = (bf16_t*)(ws + WS_QR); bf16_t* KR = (bf16_t*)(ws + WS_KR); bf16_t* VR = (bf16_t*)(ws + WS_VR);
    const float* rc = (const float*)(ws + WS_ROT); const float* rs = rc + SEQ * 32;
    int tid_ = c.tid; asm volatile("" : "+v"(tid_));
    const int tid = tid_;
    const int ch0 = tid, ch1 = tid + 512; const bool has1 = ch1 < 824;
    const f32x4 m00 = *(const f32x4*)(mix + 8 * ch0), m01 = *(const f32x4*)(mix + 8 * ch0 + 4);
    f32x4 m10 = (f32x4){0.f, 0.f, 0.f, 0.f}, m11 = m10; if (has1) { m10 = *(const f32x4*)(mix + 8 * ch1); m11 = *(const f32x4*)(mix + 8 * ch1 + 4); }
    f32x4 kk0 = (f32x4){0.f, 0.f, 0.f, 0.f}, kk1 = kk0; if (tid >= 256) { kk0 = *(const f32x4*)(k_k + 8 * (tid - 256)); kk1 = *(const f32x4*)(k_k + 8 * (tid - 256) + 4); }
    const bool rot = tid >= 64 && tid < 256, vcp = tid >= 256 && tid < 448;
    const int rw = tid - 64, which = rw / 96, rhh = (rw % 96) >> 2, re0 = (rw & 3) * 8;
    const int vhh = (tid - 256) >> 3, ve0 = ((tid - 256) & 7) * 8;
#define P2_LOAD(T, t_) do { const int pos_ = (t_) & (SEQ - 1); const bf16_t* cur_ = PROJ + (size_t)(t_) * PC; const u32x4 z4_ = (u32x4){0u, 0u, 0u, 0u}; \
        T.cv0 = *(const u32x4*)(cur_ + 8 * ch0); T.pv0 = pos_ > 0 ? *(const u32x4*)(cur_ - PC + 8 * ch0) : z4_; \
        if (has1) { T.cv1 = *(const u32x4*)(cur_ + 8 * ch1); T.pv1 = pos_ > 0 ? *(const u32x4*)(cur_ - PC + 8 * ch1) : z4_; } \
        if (rot) { const bf16_t* src_ = cur_ + ATT0 + which * 1536 + rhh * 64 + re0; T.ra = *(const u32x4*)src_; T.rb = *(const u32x4*)(src_ + 32); \
            T.c0 = *(const f32x4*)(rc + pos_ * 32 + re0); T.c1 = *(const f32x4*)(rc + pos_ * 32 + re0 + 4); T.s0 = *(const f32x4*)(rs + pos_ * 32 + re0); T.s1 = *(const f32x4*)(rs + pos_ * 32 + re0 + 4); } \
        if (vcp) { const int ao_ = 2 * 1536 + vhh * 64 + ve0; T.vv = *(const u32x4*)(cur_ + (ao_ < 4096 ? ATT0 + ao_ : ATTV2 + ao_ - 4096)); } } while (0)
#define P2_SHIFT(z, cv, pv, ma, mb) do { const unsigned cw[4] = {cv.x, cv.y, cv.z, cv.w}, pw[4] = {pv.x, pv.y, pv.z, pv.w}; const float mm[8] = {ma[0], ma[1], ma[2], ma[3], mb[0], mb[1], mb[2], mb[3]}; \
        _Pragma("unroll") for (int j = 0; j < 4; ++j) { const float c0_ = bf2f(cw[j] & 0xffffu), c1_ = bf2f(cw[j] >> 16), q0_ = bf2f(pw[j] & 0xffffu), q1_ = bf2f(pw[j] >> 16); \
            z[2 * j] = c0_ + (q0_ - c0_) * mm[2 * j]; z[2 * j + 1] = c1_ + (q1_ - c1_) * mm[2 * j + 1]; } } while (0)
#define P2_PROC(T, t_) do { const int t = (t_), pos = t & (SEQ - 1); \
        { float z[8]; P2_SHIFT(z, T.cv0, T.pv0, m00, m01);            \
          bf16_t* dst = (tid < 256 ? RZ : KZ) + (size_t)t * D + 8 * (tid & 255); \
          { u32x4 w8; w8.x = pk2(z[0], z[1]); w8.y = pk2(z[2], z[3]); w8.z = pk2(z[4], z[5]); w8.w = pk2(z[6], z[7]); *(u32x4*)dst = w8; } \
          if (tid >= 256) { float sq = 0.f; _Pragma("unroll") for (int j = 0; j < 4; ++j) { const float a_ = z[j] * kk0[j], b_ = z[4 + j] * kk1[j]; sq += a_ * a_ + b_ * b_; } \
              sq = DPP_ADD(sq, 0xB1); sq = DPP_ADD(sq, 0x4E); sq = DPP_ADD(sq, 0x141);                   \
              if ((tid & 7) == 0) KNORM[(size_t)t * 32 + ((tid - 256) >> 3)] = sqrtf(sq); } } \
        if (has1) { float z[8]; P2_SHIFT(z, T.cv1, T.pv1, m10, m11);    \
          if (ch1 < 768) { u32x4 w8; w8.x = pk2(z[0], z[1]); w8.y = pk2(z[2], z[3]); w8.z = pk2(z[4], z[5]); w8.w = pk2(z[6], z[7]); *(u32x4*)(VZ + (size_t)t * D + 8 * (ch1 - 512)) = w8; } \
          else { float o[8]; int dcol; \
              if (ch1 < 780) { dcol = 8 * (ch1 - 768); _Pragma("unroll") for (int j = 0; j < 8; ++j) o[j] = tanhf(z[j]); } \
              else if (ch1 < 792) { dcol = 256 + 8 * (ch1 - 780); _Pragma("unroll") for (int j = 0; j < 8; ++j) o[j] = z[j]; } \
              else { dcol = 512 + 8 * (ch1 - 792); _Pragma("unroll") for (int j = 0; j < 8; ++j) o[j] = sigmoidf_(z[j]); } \
              u32x4 w; w.x = pk2(o[0], o[1]); w.y = pk2(o[2], o[3]); w.z = pk2(o[4], o[5]); w.w = pk2(o[6], o[7]); *(u32x4*)(LIN + (size_t)t * 768 + dcol) = w; } } \
        if (tid >= 448 && tid < 488) { const int q_ = tid - 448; const int dcol = (q_ < 20) ? 96 + 8 * q_ : 352 + 8 * (q_ - 20); *(u32x4*)(LIN + (size_t)t * 768 + dcol) = (u32x4){0u, 0u, 0u, 0u}; } \
        if (rot) { const unsigned aw[4] = {T.ra.x, T.ra.y, T.ra.z, T.ra.w}, bw[4] = {T.rb.x, T.rb.y, T.rb.z, T.rb.w}; float o1[8], o2[8]; \
            _Pragma("unroll") for (int j = 0; j < 8; ++j) { const float t1 = bf2f((aw[j >> 1] >> (16 * (j & 1))) & 0xffffu), t2 = bf2f((bw[j >> 1] >> (16 * (j & 1))) & 0xffffu); \
                const float cs = j < 4 ? T.c0[j & 3] : T.c1[j & 3], sn = j < 4 ? T.s0[j & 3] : T.s1[j & 3]; o1[j] = t1 * cs - t2 * sn; o2[j] = t2 * cs + t1 * sn; } \
            const int dl_ = rhh < 8 ? 1 : (rhh < 16 ? 4 : 16); const int prm = (pos % dl_) * (SEQ / dl_) + pos / dl_; \
            bf16_t* dst = (which ? KR : QR) + ((size_t)((t >> 12) * 24 + rhh) * SEQ + prm) * 64 + re0; \
            u32x4 w1; w1.x = pk2(o1[0], o1[1]); w1.y = pk2(o1[2], o1[3]); w1.z = pk2(o1[4], o1[5]); w1.w = pk2(o1[6], o1[7]); \
            u32x4 w2; w2.x = pk2(o2[0], o2[1]); w2.y = pk2(o2[2], o2[3]); w2.z = pk2(o2[4], o2[5]); w2.w = pk2(o2[6], o2[7]); \
            *(u32x4*)dst = w1; *(u32x4*)(dst + 32) = w2; } \
        if (vcp) { const int dl_ = vhh < 8 ? 1 : (vhh < 16 ? 4 : 16); const int prm = (pos % dl_) * (SEQ / dl_) + pos / dl_; \
            *(u32x4*)(VR + ((size_t)((t >> 12) * 24 + vhh) * SEQ + prm) * 64 + ve0) = T.vv; } } while (0)
    P2Tok ta, tb;
    int tq = c.vcu;
    if (tq < M) P2_LOAD(ta, tq);
    for (; tq < M; tq += 2 * c.G) {
        if (tq + c.G < M) P2_LOAD(tb, tq + c.G);
        P2_PROC(ta, tq);
        if (tq + 2 * c.G < M) P2_LOAD(ta, tq + 2 * c.G);
        if (tq + c.G < M) P2_PROC(tb, tq + c.G);
    }
#undef P2_LOAD
#undef P2_SHIFT
#undef P2_PROC
}

__device__ __forceinline__ float wave_sum_dpp(float x) {
    x = DPP_ADD(x, 0xB1); x = DPP_ADD(x, 0x4E); x = DPP_ADD(x, 0x141); x = DPP_ADD(x, 0x140);
    const int xi = __builtin_bit_cast(int, x);
    return (__builtin_bit_cast(float, __builtin_amdgcn_readlane(xi, 0)) + __builtin_bit_cast(float, __builtin_amdgcn_readlane(xi, 16))) +
           (__builtin_bit_cast(float, __builtin_amdgcn_readlane(xi, 32)) + __builtin_bit_cast(float, __builtin_amdgcn_readlane(xi, 48)));
}
__device__ __forceinline__ f32x4 tile_mm(const LAS bf16_t* A, int pa, const LAS bf16_t* Bt, int pb, int ks, int fr, int fq, f32x4 acc) {
    for (int k = 0; k < ks; ++k) { const bf16x8 a = *(const LAS bf16x8*)(A + fr * pa + 32 * k + 8 * fq), b = *(const LAS bf16x8*)(Bt + fr * pb + 32 * k + 8 * fq);
        acc = __builtin_amdgcn_mfma_f32_16x16x32_bf16(a, b, acc, 0, 0, 0); }
    return acc;
}
__device__ __forceinline__ u32x2 pack4(f32x4 v) { u32x2 w; w.x = pk2(v[0], v[1]); w.y = pk2(v[2], v[3]); return w; }
constexpr int SC_C = 32, SC_NCH = SEQ / SC_C, SC_F = 96;
constexpr int PL_X1 = 0, PL_X2 = 9216, PL_AL = 18432, PL_HT = 26112, PL_ET = 33792, PL_LBT = 53760, PL_TT = 58368, PL_XB = 60928, PL_GI = PL_X1, PL_TF = PL_X2, PL_END = 62016, PL_GRP = 65536;
#define LBAR() do { asm volatile("s_waitcnt lgkmcnt(0)" ::: "memory"); __builtin_amdgcn_s_barrier(); asm volatile("" ::: "memory"); } while (0)
__device__ __forceinline__ void p4_pre(const Params& p, const Ctx& c) {
    unsigned char* ws = c.ws;
    const bf16_t* RZ = (const bf16_t*)(ws + WS_RZ); const float* DEC = (const float*)(ws + WS_DEC); const bf16_t* KP = (const bf16_t*)(ws + WS_KP);
    const bf16_t* AN = (const bf16_t*)(ws + WS_AN); const bf16_t* BB = (const bf16_t*)(ws + WS_BB);
    bf16_t* FG = (bf16_t*)(ws + WS_F); float* BON = (float*)(ws + WS_YS);
    const float* rkp = p.in[I_RK];
    int tid_ = c.tid; asm volatile("" : "+v"(tid_));
    const int tid = tid_, lane = tid & 63, w = __builtin_amdgcn_readfirstlane(tid >> 6), fr = lane & 15, fq = lane >> 4;
    const int grp = w >> 2, tw = w & 3, gtid = tid & 255;
    LAS unsigned char* gl = c.lds + grp * PL_GRP;
    LAS bf16_t* X1 = (LAS bf16_t*)(gl + PL_X1); LAS bf16_t* X2 = (LAS bf16_t*)(gl + PL_X2); LAS bf16_t* AL = (LAS bf16_t*)(gl + PL_AL); LAS bf16_t* HT = (LAS bf16_t*)(gl + PL_HT);
    LAS bf16_t* ET = (LAS bf16_t*)(gl + PL_ET); LAS float* LBT = (LAS float*)(gl + PL_LBT); LAS bf16_t* TT = (LAS bf16_t*)(gl + PL_TT); LAS bf16_t* GI = (LAS bf16_t*)(gl + PL_GI);
    LAS float* TF = (LAS float*)(gl + PL_TF);
    LAS float* XB = (LAS float*)(gl + PL_XB);
    const int npair = (128 * SC_NCH) / (2 * c.G);
    float dcy[32]; unsigned short ir[8], ik[8], ia[8], ib[8];
#define PRE_LOAD(PAIR) do { const int task_ = c.vcu + (2 * (PAIR) + grp) * c.G; const int bh_ = task_ >> 7, ch_ = task_ & (SC_NCH - 1); \
        const size_t o_ = ((size_t)(bh_ >> 5) * SEQ + (size_t)ch_ * SC_C) * D + (bh_ & 31) * 64 + lane; \
        _Pragma("unroll") for (int s_ = 0; s_ < 32; ++s_) dcy[s_] = DEC[o_ + (size_t)s_ * D]; \
        _Pragma("unroll") for (int q_ = 0; q_ < 8; ++q_) { const size_t oo_ = o_ + (size_t)(8 * tw + q_) * D; ir[q_] = RZ[oo_]; ik[q_] = KP[oo_]; ia[q_] = AN[oo_]; ib[q_] = BB[oo_]; } } while (0)
    const bool bgconv = (c.G == 256);
    if (npair > 0) PRE_LOAD(0);
    for (int pr = 0; pr < npair; ++pr) {
        const int task = c.vcu + (2 * pr + grp) * c.G, bh = task >> 7, chn = task & (SC_NCH - 1);
        const float rkv = rkp[(bh & 31) * 64 + lane];
        float* bon = BON + ((size_t)(bh >> 5) * SEQ + (size_t)chn * SC_C) * 32 + (bh & 31);
        float p0 = 1.f, p1 = 1.f, p2 = 1.f, p3 = 1.f, dsel[8];
#pragma unroll
        for (int s = 0; s < 8; ++s) { p0 *= dcy[s]; p1 *= dcy[8 + s]; p2 *= dcy[16 + s]; p3 *= dcy[24 + s];
            dsel[s] = tw == 0 ? dcy[s] : (tw == 1 ? dcy[8 + s] : (tw == 2 ? dcy[16 + s] : dcy[24 + s])); }
        const float gC = (p0 * p1) * (p2 * p3);
        float g = tw == 0 ? 1.f : (tw == 1 ? p0 : (tw == 2 ? p0 * p1 : (p0 * p1) * p2));
        LBAR();
#pragma unroll
        for (int hq = 0; hq < 2; ++hq) { f32x4 ah4, bg4, kg4;
#pragma unroll
            for (int qq = 0; qq < 4; ++qq) { const int qn = 4 * hq + qq, s = 8 * tw + qn;
                const float gp = g; g *= dsel[qn];
                const float rr = bf2f(ir[qn]), kk = bf2f(ik[qn]), aa = bf2f(ia[qn]), bb = bf2f(ib[qn]); const float ig = 1.0f / g;
                const float ah = aa * gp, bt = bb * ig, kt = kk * ig, rh = rr * g;
                X1[s * 72 + lane] = (bf16_t)f2bf(bt); X1[(32 + s) * 72 + lane] = (bf16_t)f2bf(kt); X2[s * 72 + lane] = (bf16_t)f2bf(ah); X2[(32 + s) * 72 + lane] = (bf16_t)f2bf(rh);
                ET[s * 104 + lane] = (bf16_t)f2bf(rh); ah4[qq] = ah; bg4[qq] = bt * gC; kg4[qq] = kt * gC;
                const float bsum = wave_sum_dpp(rr * kk * rkv); if (lane == 0) bon[(size_t)s * 32] = bsum; }
            *(LAS u32x2*)(AL + lane * 40 + 8 * tw + 4 * hq) = pack4(ah4); *(LAS u32x2*)(HT + (32 + lane) * 40 + 8 * tw + 4 * hq) = pack4(bg4); *(LAS u32x2*)(ET + (32 + lane) * 104 + 64 + 8 * tw + 4 * hq) = pack4(kg4); }
        { const int zr = gtid >> 2, zc = 16 * (gtid & 3); LAS u32x4* zp = (LAS u32x4*)(ET + (32 + zr) * 104 + zc); zp[0] = (u32x4){0u, 0u, 0u, 0u}; zp[1] = (u32x4){0u, 0u, 0u, 0u}; }
        if (pr + 1 < npair) PRE_LOAD(pr + 1);
        float cva[32], cvb[32]; int cea = 0, cna = 0, cka = 0, ceb = 0, cnb = 0, ckb = 0;
        if (bgconv) { const int it0 = ((c.vcu * 32 + pr) * 8 + w) * 2;
            cea = it0 >> 12; { const int rem = it0 & 4095; cka = 64 * (rem >> 7); cna = 32 * (rem & 127); }
            ceb = (it0 + 1) >> 12; { const int rem = (it0 + 1) & 4095; ckb = 64 * (rem >> 7); cnb = 32 * (rem & 127); }
            cv_issue(p.in[I_W1] + (size_t)cea * D * 4096, 4096, D, cna, cka, lane, cva); cv_issue(p.in[I_W1] + (size_t)ceb * D * 4096, 4096, D, cnb, ckb, lane, cvb); }
        LBAR();
        if (tw == 0) ET[(32 + lane) * 104 + lane] = (bf16_t)f2bf(gC);
        { const int mt = tw;
#pragma unroll
          for (int nt = 0; nt < 4; ++nt) {
            f32x4 acc = tile_mm(X1 + 16 * mt * 72, 72, X2 + 16 * nt * 72, 72, 2, fr, fq, (f32x4){0.f, 0.f, 0.f, 0.f});
            const int n = 16 * nt + fr, m0 = 16 * mt + 4 * fq;
            if (mt < 2) { if (nt < 2) { const int t = n; f32x4 o;
#pragma unroll
                    for (int e = 0; e < 4; ++e) o[e] = (m0 + e < t) ? acc[e] : 0.f;
                    *(LAS f32x4*)(LBT + t * 36 + m0) = o; }
                else { const int t = n - 32; f32x4 o;
#pragma unroll
                    for (int e = 0; e < 4; ++e) o[e] = (m0 + e <= t) ? acc[e] : 0.f;
                    *(LAS u32x2*)(HT + t * 40 + m0) = pack4(o); } }
            else { const int s0 = m0 - 32;
                if (nt < 2) { const int t = n;
#pragma unroll
                    for (int e = 0; e < 4; ++e) AL[(64 + s0 + e) * 40 + t] = (bf16_t)f2bf((s0 + e < t) ? acc[e] : 0.f); }
                else { const int t = n - 32; f32x4 o;
#pragma unroll
                    for (int e = 0; e < 4; ++e) o[e] = (s0 + e <= t) ? acc[e] : 0.f;
                    *(LAS u32x2*)(ET + t * 104 + 64 + s0) = pack4(o); } } } }
        LBAR();
        if (gtid < 32) { const int hb = 16 * (gtid >> 4), sl = gtid & 15; float Tr[16];
#pragma unroll
            for (int t = 0; t < 16; ++t) { float a0 = (sl == t) ? 1.f : 0.f, a1 = 0.f, a2 = 0.f, a3 = 0.f;
#pragma unroll
                for (int m4 = 0; m4 < (t + 3) / 4; ++m4) { const f32x4 l = *(const LAS f32x4*)(LBT + (hb + t) * 36 + hb + 4 * m4);
                    if (4 * m4 + 0 < t) a0 += Tr[4 * m4 + 0] * l[0]; if (4 * m4 + 1 < t) a1 += Tr[4 * m4 + 1] * l[1]; if (4 * m4 + 2 < t) a2 += Tr[4 * m4 + 2] * l[2]; if (4 * m4 + 3 < t) a3 += Tr[4 * m4 + 3] * l[3]; }
                Tr[t] = (a0 + a1) + (a2 + a3); TF[(hb + sl) * 36 + hb + t] = Tr[t]; TT[(hb + t) * 40 + hb + sl] = (bf16_t)f2bf(Tr[t]);
                if (hb) TT[t * 40 + hb + sl] = 0; } }
        LBAR();
        { const int m = gtid >> 4, tl = gtid & 15; float x = 0.f;
#pragma unroll
            for (int n = 0; n < 16; ++n) x += LBT[(16 + n) * 36 + m] * TF[(16 + n) * 36 + 16 + tl];
            XB[m * 17 + tl] = x; }
        LBAR();
        { const int sr = gtid >> 4, tl = gtid & 15; float x = 0.f;
#pragma unroll
            for (int m = 0; m < 16; ++m) x += TF[sr * 36 + m] * XB[m * 17 + tl];
            TT[(16 + tl) * 40 + sr] = (bf16_t)f2bf(x); }
        LBAR();
        for (int id = tw; id < 12; id += 4) { const int tt = id / 6, nt = id % 6;
            const f32x4 acc = tile_mm(TT + 16 * tt * 40, 40, AL + 16 * nt * 40, 40, 1, fr, fq, (f32x4){0.f, 0.f, 0.f, 0.f});
            *(LAS u32x2*)(GI + (16 * nt + fr) * 40 + 16 * tt + 4 * fq) = pack4(acc); }
        LBAR();
        for (int id = tw; id < 36; id += 4) { const int nt = id / 6, mt = id % 6;
            const f32x4 acc = tile_mm(GI + 16 * nt * 40, 40, HT + 16 * mt * 40, 40, 1, fr, fq, (f32x4){0.f, 0.f, 0.f, 0.f});
            LAS u32x2* ep = (LAS u32x2*)(ET + (16 * mt + fr) * 104 + 16 * nt + 4 * fq); const u32x2 ev = *ep;
            f32x4 o; o[0] = acc[0] + bf2f(ev.x & 0xffffu); o[1] = acc[1] + bf2f(ev.x >> 16); o[2] = acc[2] + bf2f(ev.y & 0xffffu); o[3] = acc[3] + bf2f(ev.y >> 16);
            *ep = pack4(o); }
        LBAR();
        { bf16_t* fg = FG + (size_t)task * (SC_F * SC_F);
          for (int idx = gtid; idx < 96 * 12; idx += 256) { const int row = idx / 12, pc = idx % 12; *(u32x4*)(fg + row * 96 + 8 * pc) = *(const LAS u32x4*)(ET + row * 104 + 8 * pc); } }
        LBAR();
        if (bgconv) { cv_store8(cva, ws + WS_W1 + (size_t)cea * 4096 * D, D, cna, cka, lane); cv_store8(cvb, ws + WS_W1 + (size_t)ceb * 4096 * D, D, cnb, ckb, lane); }
    }
    if (!bgconv) {
        LBAR();
        for (int r = c.vcu * 8 + w; r < NEXP * MOE_W1E; r += c.G * 8) { const int e = r >> 12, rem = r & 4095; float cv[32]; cv_issue(p.in[I_W1] + (size_t)e * D * 4096, 4096, D, 32 * (rem & 127), 64 * (rem >> 7), lane, cv);
            cv_store8(cv, ws + WS_W1 + (size_t)e * 4096 * D, D, 32 * (rem & 127), 64 * (rem >> 7), lane); }
    }
    LBAR();
#undef PRE_LOAD
}
constexpr int SQ_BI = 0, SQ_BI_SZ = 64 * 104 * 2, SQ_YL = 2 * SQ_BI_SZ, SQ_YL_SZ = 32 * 64 * 4;
struct SeqSet { bf16x8 af[3][3]; u32x2 vimg, gimg; float bon; };
__device__ __forceinline__ void p4_seq(const Params& p, const Ctx& c, int bh) {
    unsigned char* ws = c.ws;
    const bf16_t* VZ = (const bf16_t*)(ws + WS_VZ); const bf16_t* GG = (const bf16_t*)(ws + WS_GG); const float* BON = (const float*)(ws + WS_YS);
    const bf16_t* FG = (const bf16_t*)(ws + WS_F) + (size_t)bh * SC_NCH * (SC_F * SC_F);
    bf16_t* YA = (bf16_t*)(ws + WS_YA);
    int tid_ = c.tid; asm volatile("" : "+v"(tid_));
    const int tid = tid_, lane = tid & 63, w = __builtin_amdgcn_readfirstlane(tid >> 6), fr = lane & 15, fq = lane >> 4;
    const int b = bh >> 5, h = bh & 31;
    const size_t base = (size_t)b * SEQ * D + h * 64;
    const int nt = w & 3, mg = w >> 2;
    LAS bf16_t* BI = (LAS bf16_t*)(c.lds + SQ_BI); LAS float* YL = (LAS float*)(c.lds + SQ_YL);
    const int vs = tid >> 4, vi4 = 4 * (tid & 15);
    const f32x4 lg4 = *(const f32x4*)(p.in[I_LNXG] + h * 64 + vi4), lb4 = *(const f32x4*)(p.in[I_LNXB] + h * 64 + vi4);
#define SEQ_LOAD(SET, CHN) do { const int chn_ = (CHN) < SC_NCH ? (CHN) : SC_NCH - 1; const bf16_t* fp = FG + (size_t)chn_ * (SC_F * SC_F); const size_t tk_ = (size_t)b * SEQ + (size_t)(chn_ * SC_C + vs); \
        asm volatile("global_load_dwordx2 %0, %1, off" : "=v"(SET.vimg) : "v"(VZ + tk_ * D + h * 64 + vi4) : "memory"); \
        _Pragma("unroll") for (int mi = 0; mi < 3; ++mi) _Pragma("unroll") for (int ks = 0; ks < 3; ++ks) \
            asm volatile("global_load_dwordx4 %0, %1, off" : "=v"(SET.af[mi][ks]) : "v"(fp + (16 * (3 * mg + mi) + fr) * SC_F + 32 * ks + 8 * fq) : "memory"); \
        asm volatile("global_load_dwordx2 %0, %1, off" : "=v"(SET.gimg) : "v"(GG + tk_ * D + h * 64 + vi4) : "memory"); \
        asm volatile("global_load_dword %0, %1, off" : "=v"(SET.bon) : "v"(BON + tk_ * 32 + h) : "memory"); } while (0)
#define SEQ_WAIT_AF(SET, N) asm volatile("s_waitcnt vmcnt(" #N ")" : "+v"(SET.af[0][0]), "+v"(SET.af[0][1]), "+v"(SET.af[0][2]), "+v"(SET.af[1][0]), "+v"(SET.af[1][1]), "+v"(SET.af[1][2]), \
        "+v"(SET.af[2][0]), "+v"(SET.af[2][1]), "+v"(SET.af[2][2]) :: "memory")
#define SEQ_WAIT_V(SET, N) asm volatile("s_waitcnt vmcnt(" #N ")" : "+v"(SET.vimg) :: "memory")
#define SEQ_WAIT_G(SET, N) asm volatile("s_waitcnt vmcnt(" #N ")" : "+v"(SET.gimg), "+v"(SET.bon), "+v"(SET.vimg) :: "memory")
#define SEQ_BODY(CH, CUR, NXT, NX2) do { const int ch = (CH), cb = ch & 1; \
        const LAS bf16_t* bi = BI + cb * (64 * 104); LAS bf16_t* bo = BI + (cb ^ 1) * (64 * 104); LAS float* yl = YL + cb * (32 * 64); \
        SEQ_LOAD(NX2, ch + 2); \
        bf16x8 bfr[3]; _Pragma("unroll") for (int ks = 0; ks < 3; ++ks) bfr[ks] = *(const LAS bf16x8*)(bi + (16 * nt + fr) * 104 + 32 * ks + 8 * fq); \
        SEQ_WAIT_AF(CUR, 28); \
        f32x4 acc[3]; _Pragma("unroll") for (int mi = 0; mi < 3; ++mi) { acc[mi] = (f32x4){0.f, 0.f, 0.f, 0.f}; \
            _Pragma("unroll") for (int ks = 0; ks < 3; ++ks) acc[mi] = __builtin_amdgcn_mfma_f32_16x16x32_bf16(CUR.af[mi][ks], bfr[ks], acc[mi], 0, 0, 0); } \
        _Pragma("unroll") for (int mi = 0; mi < 3; ++mi) { const int mt = 3 * mg + mi; \
            if (mt < 2) { _Pragma("unroll") for (int e = 0; e < 4; ++e) yl[(16 * mt + 4 * fq + e) * 64 + 16 * nt + fr] = acc[mi][e]; } \
            else *(LAS u32x2*)(bo + (16 * nt + fr) * 104 + 16 * (mt - 2) + 4 * fq) = pack4(acc[mi]); } \
        SEQ_WAIT_V(NXT, 24); \
        if (ch + 1 < SC_NCH) { bo[(vi4 + 0) * 104 + 64 + vs] = (bf16_t)(NXT.vimg.x & 0xffffu); bo[(vi4 + 1) * 104 + 64 + vs] = (bf16_t)(NXT.vimg.x >> 16); \
            bo[(vi4 + 2) * 104 + 64 + vs] = (bf16_t)(NXT.vimg.y & 0xffffu); bo[(vi4 + 3) * 104 + 64 + vs] = (bf16_t)(NXT.vimg.y >> 16); } \
        LBAR(); \
        SEQ_WAIT_G(CUR, 24); \
        { const f32x4 y4 = *(const LAS f32x4*)(yl + vs * 64 + vi4); float sm = (y4[0] + y4[1]) + (y4[2] + y4[3]); \
          sm = DPP_ADD(sm, 0xB1); sm = DPP_ADD(sm, 0x4E); sm = DPP_ADD(sm, 0x141); sm = DPP_ADD(sm, 0x140);     \
          const float mu = sm * (1.0f / 64.0f); const f32x4 d4 = y4 - mu; float q = (d4[0] * d4[0] + d4[1] * d4[1]) + (d4[2] * d4[2] + d4[3] * d4[3]); \
          q = DPP_ADD(q, 0xB1); q = DPP_ADD(q, 0x4E); q = DPP_ADD(q, 0x141); q = DPP_ADD(q, 0x140); \
          const float rstd = rsqrtf(q * (1.0f / 64.0f) + GN_EPS); \
          const float v0 = bf2f(CUR.vimg.x & 0xffffu), v1 = bf2f(CUR.vimg.x >> 16), v2 = bf2f(CUR.vimg.y & 0xffffu), v3 = bf2f(CUR.vimg.y >> 16); \
          const float g0 = bf2f(CUR.gimg.x & 0xffffu), g1 = bf2f(CUR.gimg.x >> 16), g2 = bf2f(CUR.gimg.y & 0xffffu), g3 = bf2f(CUR.gimg.y >> 16); \
          const float o0 = (d4[0] * rstd * lg4[0] + lb4[0] + CUR.bon * v0) * g0, o1 = (d4[1] * rstd * lg4[1] + lb4[1] + CUR.bon * v1) * g1; \
          const float o2 = (d4[2] * rstd * lg4[2] + lb4[2] + CUR.bon * v2) * g2, o3 = (d4[3] * rstd * lg4[3] + lb4[3] + CUR.bon * v3) * g3; \
          *(u32x2*)(YA + ((size_t)b * SEQ + (size_t)(ch * SC_C + vs)) * 2560 + h * 64 + vi4) = (u32x2){pk2(o0, o1), pk2(o2, o3)}; } } while (0)
    SeqSet sa, sb, sc;
    SEQ_LOAD(sa, 0); SEQ_LOAD(sb, 1);
    SEQ_WAIT_V(sa, 0);
    for (int idx = tid; idx < 64 * 8; idx += 512) *(LAS u32x4*)(BI + (idx >> 3) * 104 + 8 * (idx & 7)) = (u32x4){0u, 0u, 0u, 0u};
    BI[(vi4 + 0) * 104 + 64 + vs] = (bf16_t)(sa.vimg.x & 0xffffu); BI[(vi4 + 1) * 104 + 64 + vs] = (bf16_t)(sa.vimg.x >> 16);
    BI[(vi4 + 2) * 104 + 64 + vs] = (bf16_t)(sa.vimg.y & 0xffffu); BI[(vi4 + 3) * 104 + 64 + vs] = (bf16_t)(sa.vimg.y >> 16);
    LBAR();
    for (int c0 = 0; c0 < SC_NCH; c0 += 3) {
        SEQ_BODY(c0, sa, sb, sc);
        if (c0 + 1 < SC_NCH) SEQ_BODY(c0 + 1, sb, sc, sa);
        if (c0 + 2 < SC_NCH) SEQ_BODY(c0 + 2, sc, sa, sb);
    }
    asm volatile("s_waitcnt vmcnt(0)" ::: "memory");
    LBAR();
#undef SEQ_LOAD
#undef SEQ_BODY
#undef SEQ_WAIT_AF
#undef SEQ_WAIT_V
#undef SEQ_WAIT_G
}

__device__ __forceinline__ void p4_attn_task(const Ctx& c, int task) {
    unsigned char* ws = c.ws;
    const bf16_t* QR = (const bf16_t*)(ws + WS_QR); const bf16_t* KR = (const bf16_t*)(ws + WS_KR); const bf16_t* VR = (const bf16_t*)(ws + WS_VR);
    float* AO = (float*)(ws + WS_AO); float* LSE = (float*)(ws + WS_LSE);
    constexpr int VP = 280;
    LAS bf16_t* Vt = (LAS bf16_t*)c.lds;
    const int combo = task & 31, hh = (task >> 5) % 24, b = task / (32 * 24);
    const int g = hh >> 3, h = hh & 7;
    const int dil = g == 0 ? 1 : (g == 1 ? 4 : 16), nblk = 32 / dil;
    const int res = combo / nblk, blk = combo % nblk;
    int tid_ = c.tid; asm volatile("" : "+v"(tid_));
    const int tid = tid_, lane = tid & 63, w = __builtin_amdgcn_readfirstlane(tid >> 6);
    const int qq = lane & 15, g4 = lane >> 4, r0 = 16 * w;
    const size_t rowb = (size_t)(b * 24 + hh) * SEQ + (size_t)res * (SEQ / dil) + (size_t)blk * 128;
    bf16x8 qf[2], kf[9][2];
#pragma unroll
    for (int ks = 0; ks < 2; ++ks) qf[ks] = *(const bf16x8*)(QR + (rowb + r0 + qq) * 64 + 32 * ks + 8 * g4);
#pragma unroll
    for (int kt = 0; kt < 9; ++kt) { const bool kv = (blk > 0) || (w + kt >= 8);
#pragma unroll
        for (int ks = 0; ks < 2; ++ks) { kf[kt][ks] = (bf16x8){0, 0, 0, 0, 0, 0, 0, 0};
            if (kv) kf[kt][ks] = *(const bf16x8*)(KR + (rowb - 128 + 16 * (w + kt) + qq) * 64 + 32 * ks + 8 * g4); } }
    const int vki = tid >> 1, vdh = tid & 1;
    u32x4 vv[4];
    if (blk > 0 || vki >= 128) {
#pragma unroll
        for (int j = 0; j < 4; ++j) vv[j] = *(const u32x4*)(VR + (rowb - 128 + vki) * 64 + 32 * vdh + 8 * j); }
    else {
#pragma unroll
        for (int j = 0; j < 4; ++j) vv[j] = (u32x4){0u, 0u, 0u, 0u}; }
    __syncthreads();
#pragma unroll
    for (int j = 0; j < 4; ++j) { const unsigned wv[4] = {vv[j].x, vv[j].y, vv[j].z, vv[j].w};
#pragma unroll
        for (int e = 0; e < 8; ++e) Vt[(32 * vdh + 8 * j + e) * VP + vki] = (bf16_t)((wv[e >> 1] >> (16 * (e & 1))) & 0xffffu); }
    if (tid < 64) {
#pragma unroll
        for (int e = 0; e < 24; ++e) Vt[tid * VP + 256 + e] = 0; }
    f32x4 sc[10];
#pragma unroll
    for (int kt = 0; kt < 9; ++kt) { f32x4 a = (f32x4){0.f, 0.f, 0.f, 0.f};
#pragma unroll
        for (int ks = 0; ks < 2; ++ks) a = __builtin_amdgcn_mfma_f32_16x16x32_bf16(kf[kt][ks], qf[ks], a, 0, 0, 0);
        sc[kt] = a; }
    const int r = r0 + qq;
    float mx = -3.0e38f;
#pragma unroll
    for (int kt = 0; kt < 9; ++kt)
#pragma unroll
        for (int j = 0; j < 4; ++j) { const int ki = 16 * (w + kt) + 4 * g4 + j; const bool ok = (ki >= r) && (ki <= r + 128) && (blk > 0 || ki >= 128);
            const float sv = ok ? sc[kt][j] * 0.125f : -1.0e30f; sc[kt][j] = sv; mx = fmaxf(mx, sv); }
    mx = fmaxf(mx, __shfl_xor(mx, 16)); mx = fmaxf(mx, __shfl_xor(mx, 32));
    float den = 0.f;
#pragma unroll
    for (int kt = 0; kt < 9; ++kt)
#pragma unroll
        for (int j = 0; j < 4; ++j) { const float pexp = __expf(sc[kt][j] - mx); sc[kt][j] = pexp; den += pexp; }
    den += __shfl_xor(den, 16); den += __shfl_xor(den, 32);
    sc[9] = (f32x4){0.f, 0.f, 0.f, 0.f};
    __syncthreads();
    f32x4 oacc[4];
#pragma unroll
    for (int dt = 0; dt < 4; ++dt) oacc[dt] = (f32x4){0.f, 0.f, 0.f, 0.f};
#pragma unroll
    for (int cidx = 0; cidx < 5; ++cidx) {
        const f32x4 p0 = sc[2 * cidx], p1 = sc[2 * cidx + 1];
        u32x4 pw; pw.x = pk2(p0[0], p0[1]); pw.y = pk2(p0[2], p0[3]); pw.z = pk2(p1[0], p1[1]); pw.w = pk2(p1[2], p1[3]);
        const bf16x8 pf = __builtin_bit_cast(bf16x8, pw);
        const int kbase = 16 * (w + 2 * cidx) + 4 * g4;
#pragma unroll
        for (int dt = 0; dt < 4; ++dt) { const LAS bf16_t* vp = Vt + (16 * dt + qq) * VP + kbase;
            const u32x2 lo = *(const LAS u32x2*)vp, hi = *(const LAS u32x2*)(vp + 16);
            u32x4 vw; vw.x = lo.x; vw.y = lo.y; vw.z = hi.x; vw.w = hi.y;
            oacc[dt] = __builtin_amdgcn_mfma_f32_16x16x32_bf16(__builtin_bit_cast(bf16x8, vw), pf, oacc[dt], 0, 0, 0); }
    }
    const float inv = 1.0f / den;
    const size_t tok = (size_t)b * SEQ + (size_t)(blk * 128 + r) * dil + res;
#pragma unroll
    for (int dt = 0; dt < 4; ++dt) *(f32x4*)(AO + ((size_t)g * M + tok) * 512 + h * 64 + 16 * dt + 4 * g4) = oacc[dt] * inv;
    if (g4 == 0) LSE[((size_t)g * M + tok) * 8 + h] = mx + __logf(den);
}

struct KvUnitOrder {
    static constexpr bool GATHER = false;
    const char* A; const char* Bt; int q;
    __device__ bool next(int i, pg8::Unit& u) const {
        if (i != 0) return false;
        const int pm = q & 3, pn = q >> 2;
        u.A = A + (size_t)pm * 256 * D * 2; u.B = Bt + (size_t)pn * 256 * D * 2; u.orow = 256 * pm; u.ocol = 256 * pn; u.aux = 0; u.aux2 = 0; u.valid = 256; return true;
    }
    __device__ __forceinline__ const int* rows(const pg8::Unit&) const { return nullptr; }
};
constexpr int Q_KV = 64, Q_ATT = 3072, Q_TOTAL = Q_KV + Q_ATT + MOE_CONV_GROUPS;
__device__ __forceinline__ void p4_queue(const Params& p, const Ctx& c, volatile LAS unsigned* qslot) {
    unsigned* qc = (unsigned*)(c.ws + WS_CTL) + CW_Q;
    for (;;) {
        __syncthreads();
        if (c.tid == 0) qslot[0] = __hip_atomic_fetch_add(qc, 1u, __ATOMIC_RELAXED, __HIP_MEMORY_SCOPE_AGENT);
        __syncthreads();
        const unsigned it = qslot[0];
        if (it >= (unsigned)Q_TOTAL) break;
        if (it < (unsigned)Q_KV) { const int qi = __builtin_amdgcn_readfirstlane((int)it);
            KvUnitOrder S{(const char*)(c.ws + WS_MEMB), (const char*)(c.ws + WS_WKV), qi};
            pg8::EpiKV E{(bf16_t*)(c.ws + WS_KB), (bf16_t*)(c.ws + WS_VT)};
            pg8::gemm_phase<pg8::EpiKV, KvUnitOrder>(c.lds, pg8::Gemm{D, D, D}, S, E); }
        else if (it < (unsigned)(Q_KV + Q_ATT)) p4_attn_task(c, (int)it - Q_KV); else conv_group(p, c, (int)it - Q_KV - Q_ATT);
    }
}

__device__ __forceinline__ void p5_post(const Params& p, const Ctx& c) {
    unsigned char* ws = c.ws;
    const float* AO = (const float*)(ws + WS_AO); const float* LSE = (const float*)(ws + WS_LSE);
    bf16_t* YB = (bf16_t*)(ws + WS_YA);
    const int gw = c.vcu * 8 + c.wave, NGW = c.G * 8, lane = c.lane;
    for (int it = gw; it < M * 8; it += NGW) {
        const int t = it >> 3, h = it & 7;
        const float l0 = LSE[((size_t)0 * M + t) * 8 + h], l1 = LSE[((size_t)1 * M + t) * 8 + h], l2 = LSE[((size_t)2 * M + t) * 8 + h];
        const float mxl = fmaxf(l0, fmaxf(l1, l2)); const float e0 = __expf(l0 - mxl), e1 = __expf(l1 - mxl), e2 = __expf(l2 - mxl); const float inv = 1.0f / (e0 + e1 + e2);
        const size_t o = (size_t)t * 512 + h * 64 + lane;
        const float v = (e0 * AO[o] + e1 * AO[(size_t)M * 512 + o] + e2 * AO[(size_t)2 * M * 512 + o]) * inv;
        YB[(size_t)t * 2560 + 2048 + h * 64 + lane] = (bf16_t)f2bf(v);
    }
}

__device__ __forceinline__ void ln_rows(const Ctx& c, const float* in, const float* gam, const float* bet, float* outf, f32x2* stats, unsigned char* outq) {
    const int gw = c.vcu * 8 + c.wave, NGW = c.G * 8, lane = c.lane;
    for (int m = gw; m < M; m += NGW) {
        const f32x4* xr = (const f32x4*)(in + (size_t)m * D) + lane;
        f32x4 v[8]; float s = 0.f;
#pragma unroll
        for (int j = 0; j < 8; ++j) { v[j] = xr[64 * j]; s += (v[j][0] + v[j][1]) + (v[j][2] + v[j][3]); }
        const float mean = wave_sum(s) * (1.0f / D); float s2 = 0.f;
#pragma unroll
        for (int j = 0; j < 8; ++j) { v[j] = v[j] - mean; s2 += (v[j][0] * v[j][0] + v[j][1] * v[j][1]) + (v[j][2] * v[j][2] + v[j][3] * v[j][3]); }
        const float rstd = rsqrtf(wave_sum(s2) * (1.0f / D) + LN_EPS);
        if (stats && lane == 0) stats[m] = (f32x2){mean, rstd};
#pragma unroll
        for (int j = 0; j < 8; ++j) { const int col = 4 * lane + 256 * j; const f32x4 gv = *(const f32x4*)(gam + col), bv = *(const f32x4*)(bet + col);
            const f32x4 o = v[j] * rstd * gv + bv;
            if (outf) *(f32x4*)(outf + (size_t)m * D + col) = o;
            if (outq) *(unsigned*)(outq + (size_t)m * D + col) = pk4_fp8(o[0], o[1], o[2], o[3]); }
    }
}

__device__ __forceinline__ void p15_router(const Params& p, const Ctx& c) {
    unsigned char* ws = c.ws;
    const float* T2 = (const float*)(ws + WS_T2); const f32x2* ST2 = (const f32x2*)(ws + WS_ST2); const float* g2 = p.in[I_LN2G]; const float* b2 = p.in[I_LN2B]; const float* RW = p.in[I_RW]; const float* RB = p.in[I_RB];
    unsigned* cnt = (unsigned*)(ws + WS_CTL) + CW_CNT; int* LIST = (int*)(ws + WS_LIST); int* ROWI = (int*)(ws + WS_ROWI); float* TOPW = (float*)(ws + WS_TOPW);
    LAS float* scr = (LAS float*)(c.lds + c.wave * 8192);
    const int gw = c.vcu * 8 + c.wave, NGW = c.G * 8, lane = c.lane, li = lane & 31, lk = lane >> 5;
    for (int tb = gw; tb < M / 32; tb += NGW) {
        const int t0 = tb * 32;
        f32x16 acc;
#pragma unroll
        for (int j = 0; j < 16; ++j) acc[j] = 0.f;
        const float* xa = T2 + (size_t)(t0 + li) * D + 4 * lk; const f32x2 st = ST2[t0 + li];
        const float* wb = RW + (size_t)(4 * lk) * 32 + li;
        for (int kb = 0; kb < D / 8; ++kb) {
            const f32x4 a = ((*(const f32x4*)(xa + 8 * kb) - st.x) * st.y) * *(const f32x4*)(g2 + 8 * kb + 4 * lk) + *(const f32x4*)(b2 + 8 * kb + 4 * lk);
            const float b0 = wb[(size_t)(8 * kb + 0) * 32], b1 = wb[(size_t)(8 * kb + 1) * 32], b2 = wb[(size_t)(8 * kb + 2) * 32], b3 = wb[(size_t)(8 * kb + 3) * 32];
            acc = __builtin_amdgcn_mfma_f32_32x32x2f32(a[0], b0, acc, 0, 0, 0);
            acc = __builtin_amdgcn_mfma_f32_32x32x2f32(a[1], b1, acc, 0, 0, 0);
            acc = __builtin_amdgcn_mfma_f32_32x32x2f32(a[2], b2, acc, 0, 0, 0);
            acc = __builtin_amdgcn_mfma_f32_32x32x2f32(a[3], b3, acc, 0, 0, 0);
        }
        const float bias = RB[li];
#pragma unroll
        for (int rg = 0; rg < 16; ++rg) { const int row = (rg & 3) + 8 * (rg >> 2) + 4 * lk; scr[row * 33 + li] = acc[rg] + bias; }
        LDS_WAIT(); asm volatile("" ::: "memory");
        if (lane < 32) {
            float lv[32];
#pragma unroll
            for (int e = 0; e < 32; ++e) lv[e] = scr[lane * 33 + e];
            int id[4]; float tv[4];
#pragma unroll
            for (int k = 0; k < 4; ++k) { float best = -3.0e38f; int bi = 0;
#pragma unroll
                for (int e = 0; e < 32; ++e) { const bool tk = lv[e] > best; best = tk ? lv[e] : best; bi = tk ? e : bi; }
                id[k] = bi; tv[k] = best;
#pragma unroll
                for (int e = 0; e < 32; ++e) lv[e] = (e == bi) ? -3.0e38f : lv[e]; }
            const float e1 = __expf(tv[1] - tv[0]), e2 = __expf(tv[2] - tv[0]), e3 = __expf(tv[3] - tv[0]); const float inv = 1.0f / (1.0f + e1 + e2 + e3);
            const float wv[4] = {inv, e1 * inv, e2 * inv, e3 * inv};
            const int t = t0 + lane;
#pragma unroll
            for (int k = 0; k < 4; ++k) { const unsigned slot = __hip_atomic_fetch_add(cnt + id[k], 1u, __ATOMIC_RELAXED, __HIP_MEMORY_SCOPE_AGENT);
                LIST[(size_t)id[k] * CAP + slot] = t; ROWI[(size_t)t * 4 + k] = id[k] * CAP + (int)slot; TOPW[(size_t)t * 4 + k] = wv[k]; }
        }
        LDS_WAIT(); asm volatile("" ::: "memory");
    }
}

__device__ __forceinline__ void moe_table(const Ctx& c, LAS int* tab) {
    if (c.tid == 0) { unsigned* cnt = (unsigned*)(c.ws + WS_CTL) + CW_CNT; int ts = 0;
        for (int e = 0; e < NEXP; ++e) { const int n = (int)__hip_atomic_load(cnt + e, __ATOMIC_RELAXED, __HIP_MEMORY_SCOPE_AGENT); tab[e] = n; tab[32 + e] = ts; ts += (n + 255) >> 8; }
        tab[64] = ts; }
    __syncthreads();
}

__device__ __forceinline__ void p18_combine(const Params& p, const Ctx& c, const LAS int* tab) {
    unsigned char* ws = c.ws;
    const float* T2 = (const float*)(ws + WS_T2); const f32x2* ST2 = (const f32x2*)(ws + WS_ST2); const float* g2 = p.in[I_LN2G]; const float* b2 = p.in[I_LN2B]; const bf16_t* Y = (const bf16_t*)(ws + WS_Y); const int* ROWI = (const int*)(ws + WS_ROWI); const float* TOPW = (const float*)(ws + WS_TOPW);
    const float* gam = p.in[I_LN3G]; const float* bet = p.in[I_LN3B];
    const int gw = c.vcu * 8 + c.wave, NGW = c.G * 8, lane = c.lane;
    for (int m = gw; m < M; m += NGW) {
        f32x4 v[8];
        const f32x4* xr = (const f32x4*)(T2 + (size_t)m * D) + lane; const f32x2 st = ST2[m];
#pragma unroll
        for (int j = 0; j < 8; ++j) { const int col = 4 * lane + 256 * j; v[j] = (((xr[64 * j] - st.x) * st.y) * *(const f32x4*)(g2 + col) + *(const f32x4*)(b2 + col)) * DN_ALPHA; }
#pragma unroll
        for (int k = 0; k < 4; ++k) { const int ri = ROWI[(size_t)m * 4 + k]; const float gt = TOPW[(size_t)m * 4 + k]; const int e = ri >> 14, slot = ri & (CAP - 1);
            const u32x2* yr = (const u32x2*)(Y + ((size_t)tab[32 + e] * 256 + slot) * D) + lane;
#pragma unroll
            for (int j = 0; j < 8; ++j) { const u32x2 yw = yr[64 * j]; v[j] = v[j] + (f32x4){bf2f(yw.x & 0xffffu), bf2f(yw.x >> 16), bf2f(yw.y & 0xffffu), bf2f(yw.y >> 16)} * gt; } }
        float s = 0.f;
#pragma unroll
        for (int j = 0; j < 8; ++j) s += (v[j][0] + v[j][1]) + (v[j][2] + v[j][3]);
        const float mean = wave_sum(s) * (1.0f / D); float s2 = 0.f;
#pragma unroll
        for (int j = 0; j < 8; ++j) { v[j] = v[j] - mean; s2 += (v[j][0] * v[j][0] + v[j][1] * v[j][1]) + (v[j][2] * v[j][2] + v[j][3] * v[j][3]); }
        const float rstd = rsqrtf(wave_sum(s2) * (1.0f / D) + LN_EPS);
#pragma unroll
        for (int j = 0; j < 8; ++j) { const int col = 4 * lane + 256 * j; const f32x4 gv = *(const f32x4*)(gam + col), bv = *(const f32x4*)(bet + col);
            *(f32x4*)(p.out + (size_t)m * D + col) = v[j] * rstd * gv + bv; }
    }
}

constexpr int NPHASE = 19;
__global__ void __launch_bounds__(512, 2) fwd(Params p) {
    extern __shared__ __attribute__((aligned(16))) unsigned char lds_raw[];
    LAS unsigned char* lds = (LAS unsigned char*)lds_raw;
    Ctx c; c.tid = threadIdx.x; c.lane = c.tid & 63; c.wave = __builtin_amdgcn_readfirstlane(c.tid >> 6); c.G = gridDim.x;
    { const int bx = blockIdx.x; c.vcu = (c.G % 8 == 0) ? (bx % 8) * (c.G / 8) + bx / 8 : bx; }
    c.lds = lds; c.ws = p.ws;
    unsigned char* ws = p.ws;
    volatile LAS unsigned* MISC = (volatile LAS unsigned*)(lds + MISC_OFF);
    LAS int* tab = (LAS int*)(lds + MISC_OFF + 1024);
    if (c.tid < 64) MISC[c.tid] = 0u;
    __syncthreads();
    unsigned* ctl = (unsigned*)(ws + WS_CTL);
    XcdBarrier bar; bar.bar = ctl + CW_BAR + p.li * XCD_BAR_WORDS; bar.x = 0; bar.st = MISC + 8;
    if (N_LAUNCH_MODE == 1) bar = xcd_barrier_post(ctl + CW_BAR + p.li * XCD_BAR_WORDS, MISC + 8);
    const int lo = p.ph_lo, hi = p.ph_hi, bx = blockIdx.x;
#ifndef PHMASK
#define PHMASK 0xFFFFFFFFu
#endif
#define IN(k) (((PHMASK >> (k)) & 1u) && lo <= (k) && (k) < hi)
#define SEAM(k) do { if (N_LAUNCH_MODE == 1 && IN((k) + 1)) xcd_barrier(bar); } while (0)

    if (IN(0)) { p0_prologue(p, c); SEAM(0); }

    if (IN(1)) {
        { pg8::StaticOrder S; S.init(ws + WS_XB, ws + WS_WIN, M, ATT0, D, D, c.G, bx);
          pg8::EpiBf16 E{(bf16_t*)(ws + WS_PROJ), PC, 1.0f};
          pg8::gemm_phase<pg8::EpiBf16, pg8::StaticOrder>(lds, pg8::Gemm{D, D, D}, S, E); }
        { pg8::StaticOrder S; S.init(ws + WS_XQ, ws + WS_WIN8, M, PC - ATT0, D, D, c.G, bx, 1);
          pg8::EpiBf16 E{(bf16_t*)(ws + WS_PROJ) + ATT0, PC, 1.0f};
          pg8::gemm_phase<pg8::EpiBf16, pg8::StaticOrder, true, true>(lds, pg8::Gemm{D, D, D}, S, E); }
        SEAM(1);
    }
    if (IN(2)) { p2_prep(p, c); SEAM(2); }

    if (IN(3)) {
#ifndef P3M
#define P3M 15
#endif
        if (P3M & 1) { pg8::StaticOrder S; S.init(ws + WS_LIN, ws + WS_WUP, M, D, 768, 256, c.G, bx);
          pg8::EpiDecay E{(float*)(ws + WS_DEC), p.in[I_W0]};
          pg8::gemm_phase<pg8::EpiDecay, pg8::StaticOrder>(lds, pg8::Gemm{256, 768, 256}, S, E); }
        if (P3M & 2) { pg8::StaticOrder S; S.init(ws + WS_LIN + 512, ws + WS_AUP, M, D, 768, 256, c.G, bx);
          pg8::EpiIclr E{p.in[I_A0], p.in[I_KK], p.in[I_KA], (const bf16_t*)(ws + WS_KZ), (const float*)(ws + WS_KNORM), (bf16_t*)(ws + WS_KP), (bf16_t*)(ws + WS_AN), (bf16_t*)(ws + WS_BB)};
          pg8::gemm_phase<pg8::EpiIclr, pg8::StaticOrder>(lds, pg8::Gemm{256, 768, 256}, S, E); }
        if (P3M & 4) { pg8::StaticOrder S; S.init(ws + WS_LIN + 1024, ws + WS_GUP, M, D, 768, 256, c.G, bx);
          pg8::EpiBf16 E{(bf16_t*)(ws + WS_GG), D, 1.0f};
          pg8::gemm_phase<pg8::EpiBf16, pg8::StaticOrder>(lds, pg8::Gemm{256, 768, 256}, S, E); }
        SEAM(3);
    }
    if (IN(4)) {
        p4_pre(p, c);
        xcd_barrier(bar);
        for (int bh = c.vcu; bh < 128; bh += c.G) p4_seq(p, c, bh);
        p4_queue(p, c, MISC + 16);
        SEAM(4);
    }
    if (IN(5)) { p5_post(p, c); }

    if (IN(6)) {
        pg8::StaticOrder S; S.init(ws + WS_YA, ws + WS_PA, M, D, 2560, 2560, c.G, bx);
        pg8::EpiGateFused E{(const bf16_t*)(ws + WS_PROJ), (bf16_t*)(ws + WS_MERGED)};
        pg8::gemm_phase<pg8::EpiGateFused, pg8::StaticOrder>(lds, pg8::Gemm{2560, 2560, 2560}, S, E);
        SEAM(6);
    }
    if (IN(7)) { }
    if (IN(8)) {
        pg8::StaticOrder S; S.init(ws + WS_MERGED, ws + WS_WOUT, M, D, D, D, c.G, bx);
        pg8::EpiF32 E{(float*)(ws + WS_T1), D, nullptr, 0, p.in[I_X], DN_ALPHA};
        pg8::gemm_phase<pg8::EpiF32, pg8::StaticOrder>(lds, pg8::Gemm{D, D, D}, S, E);
        SEAM(8);
    }
    if (IN(9)) { ln_rows(c, (const float*)(ws + WS_T1), p.in[I_LN1G], p.in[I_LN1B], nullptr, (f32x2*)(ws + WS_ST1), ws + WS_X1B); SEAM(9); }

    if (IN(10)) {
        pg8::StaticOrder S; S.init(ws + WS_X1B, ws + WS_WQ, M, D, D, D, c.G, bx, 1);
        pg8::EpiBf16 E{(bf16_t*)(ws + WS_Q), D, 0.04419417382415922f};
        pg8::gemm_phase<pg8::EpiBf16, pg8::StaticOrder, true, true>(lds, pg8::Gemm{D, D, D}, S, E);
        SEAM(10);
    }
    if (IN(11)) {
        ScoreOrder S{(const char*)(ws + WS_Q), (const char*)(ws + WS_KB), c.G, bx};
        pg8::EpiSoftmax E{(bf16_t*)(ws + WS_PP)};
        pg8::gemm_phase<pg8::EpiSoftmax, ScoreOrder, false>(lds, pg8::Gemm{512, D, D}, S, E);
        SEAM(11);
    }
    if (IN(12)) {
        PvOrder S{(const char*)(ws + WS_PP), (const char*)(ws + WS_VT), c.G, bx};
        pg8::EpiBf16 E{(bf16_t*)(ws + WS_OC), D, 1.0f};
        pg8::gemm_phase<pg8::EpiBf16, PvOrder>(lds, pg8::Gemm{256, 256, 256}, S, E);
        SEAM(12);
    }
    if (IN(13)) {
        pg8::StaticOrder S; S.init(ws + WS_OC, ws + WS_WO, M, D, D, D, c.G, bx);
        pg8::EpiResLn E{(float*)(ws + WS_T2), (const float*)(ws + WS_T1), (const f32x2*)(ws + WS_ST1), p.in[I_LN1G], p.in[I_LN1B], DN_ALPHA};
        pg8::gemm_phase<pg8::EpiResLn, pg8::StaticOrder>(lds, pg8::Gemm{D, D, D}, S, E);
        SEAM(13);
    }
    if (IN(14)) { ln_rows(c, (const float*)(ws + WS_T2), p.in[I_LN2G], p.in[I_LN2B], nullptr, (f32x2*)(ws + WS_ST2), ws + WS_X2B); SEAM(14); }
    if (IN(15)) { p15_router(p, c); SEAM(15); }

    if (IN(16)) {
        moe_table(c, tab);
        MoeOrder<true, 16> S{tab, (const char*)(ws + WS_X2B), (const char*)(ws + WS_W1), (const int*)(ws + WS_LIST), (size_t)4096 * D, D, c.G, bx};
        pg8::EpiSwiglu E{p.in[I_B1], (bf16_t*)(ws + WS_H)};
        pg8::gemm_phase<pg8::EpiSwiglu, MoeOrder<true, 16>, true, true>(lds, pg8::Gemm{D, D, D}, S, E);
        SEAM(16);
    }
    if (IN(17)) {
        moe_table(c, tab);
        MoeOrder<false, 8> S{tab, (const char*)(ws + WS_H), (const char*)(ws + WS_W2), (const int*)(ws + WS_LIST), (size_t)D * DFF, DFF, c.G, bx};
        pg8::EpiBf16Bias E{(bf16_t*)(ws + WS_Y), D, p.in[I_B2], D};
        pg8::gemm_phase<pg8::EpiBf16Bias, MoeOrder<false, 8>, true, true>(lds, pg8::Gemm{DFF, DFF, DFF}, S, E);
        SEAM(17);
    }
    if (IN(18)) { moe_table(c, tab); p18_combine(p, c, tab); }
#undef IN
#undef SEAM
}

extern "C" void kernel_launch(void* const* d_in, const int* in_sizes, int n_in, void* d_out, int out_size, void* d_ws, size_t ws_size, hipStream_t stream) {
    static int grid = 0;
    if (grid == 0) {
        if (n_in != 32 || out_size != M * D || ws_size < WS_END) { fprintf(stderr, "kernel_launch: expected 32 inputs, %d outputs, >= %zu bytes of workspace; got %d, %d, %zu\n", M * D, (size_t)WS_END, n_in, out_size, ws_size); grid = -1; return; }
        int dev = 0, cus = 0, per_cu = 0;
        if (hipGetDevice(&dev) != hipSuccess || hipDeviceGetAttribute(&cus, hipDeviceAttributeMultiprocessorCount, dev) != hipSuccess) { grid = -1; return; }
        if (hipFuncSetAttribute((const void*)fwd, hipFuncAttributeMaxDynamicSharedMemorySize, LDS_BYTES) != hipSuccess) { fprintf(stderr, "kernel_launch: hipFuncSetAttribute failed\n"); grid = -1; return; }
        if (hipOccupancyMaxActiveBlocksPerMultiprocessor(&per_cu, (const void*)fwd, 512, LDS_BYTES) != hipSuccess || per_cu < 1) fprintf(stderr, "kernel_launch: occupancy query reports %d\n", per_cu);
        (void)hipGetLastError();
        grid = cus;
        if (grid != 256) fprintf(stderr, "kernel_launch: %d CUs; this kernel is built for 256\n", grid);
    }
    if (grid < 0) return;
    (void)hipMemsetAsync((char*)d_ws + WS_CTL, 0, CTL_ZERO_BYTES, stream);
    Params p{};
    for (int i = 0; i < 32; ++i) p.in[i] = (const float*)d_in[i];
    p.out = (float*)d_out; p.ws = (unsigned char*)d_ws;
#if defined(TIMING_REPEAT_LO)
    { const int cuts[4][2] = {{0, TIMING_REPEAT_HI}, {TIMING_REPEAT_LO, TIMING_REPEAT_HI}, {TIMING_REPEAT_HI, NPHASE}, {0, 0}};
      for (int li = 0; li < 3; ++li) { if (cuts[li][0] >= cuts[li][1]) continue; p.ph_lo = cuts[li][0]; p.ph_hi = cuts[li][1]; p.li = li; hipLaunchKernelGGL(fwd, dim3(grid), dim3(512), LDS_BYTES, stream, p); } }
#else
    if (N_LAUNCH_MODE == 1) { p.ph_lo = 0; p.ph_hi = NPHASE; hipLaunchKernelGGL(fwd, dim3(grid), dim3(512), LDS_BYTES, stream, p); }
    else for (int k = 0; k < NPHASE; ++k) { p.ph_lo = k; p.ph_hi = k + 1; hipLaunchKernelGGL(fwd, dim3(grid), dim3(512), LDS_BYTES, stream, p); }
#endif
}
```

```cpp
#include <hip/hip_runtime.h>
#include <cstdio>
#include <cstdint>

#define LAS __attribute__((address_space(3)))
#define GAS __attribute__((address_space(1)))
typedef unsigned short bf16_t;
typedef short bf16x8 __attribute__((ext_vector_type(8)));
typedef float f32x4 __attribute__((ext_vector_type(4)));
typedef float f32x2 __attribute__((ext_vector_type(2)));
typedef float f32x16 __attribute__((ext_vector_type(16)));
typedef unsigned u32x4 __attribute__((ext_vector_type(4)));
typedef unsigned u32x2 __attribute__((ext_vector_type(2)));

#ifndef N_LAUNCH_MODE
#define N_LAUNCH_MODE 1
#endif

constexpr int M = 16384, D = 2048, SEQ = 4096, NBATCH = 4;
constexpr int RWC = 6592;
constexpr int PC = 15360;
constexpr int ATTV2 = 6656, ATT0 = 7168, GATE0 = 11264;
constexpr int NEXP = 32, DFF = 2048, CAP = 16384;
constexpr int HROWS = 65536 + 32 * 256;
constexpr float LN_EPS = 1e-5f, GN_EPS = 64e-5f;
constexpr float DN_ALPHA = 1.189207115002721f;

__device__ __forceinline__ float bf2f(unsigned v) { return __uint_as_float(v << 16); }
typedef __bf16 bf16x2_t __attribute__((ext_vector_type(2)));
__device__ __forceinline__ unsigned pk2(float lo, float hi) { const bf16x2_t r = __builtin_convertvector((f32x2){lo, hi}, bf16x2_t); return __builtin_bit_cast(unsigned, r); }
__device__ __forceinline__ unsigned f2bf(float f) { return pk2(f, 0.f) & 0xffffu; }
typedef int v4i __attribute__((ext_vector_type(4)));
typedef int v8i __attribute__((ext_vector_type(8)));
__device__ __forceinline__ unsigned pk4_fp8(float a, float b, float c, float d) { int r = __builtin_amdgcn_cvt_pk_fp8_f32(a, b, 0, false); r = __builtin_amdgcn_cvt_pk_fp8_f32(c, d, r, true); return (unsigned)r; }
__device__ __forceinline__ float sigmoidf_(float x) { return __builtin_amdgcn_rcpf(1.0f + __expf(-x)); }
__device__ __forceinline__ float wave_sum(float v) {
#pragma unroll
    for (int o = 1; o < 64; o <<= 1) v += __shfl_xor(v, o);
    return v;
}
#define LDS_WAIT() asm volatile("s_waitcnt lgkmcnt(0)" ::: "memory")
#define VM_WAIT() asm volatile("s_waitcnt vmcnt(0)" ::: "memory")

namespace pg8 {
#define PG8_LAS __attribute__((address_space(3)))
constexpr int BM = 256, BK = 64, HALF = 128, HTB = HALF * BK * 2, STAGE_BYTES = 8 * HTB, NXCD = 8, WGM = 8;

__host__ __device__ __forceinline__ int lds_byte(int r, int c) { const int st = (r >> 4) * 2 + (c >> 5), rr = r & 15, cc = c & 31, ob = rr * 64 + cc * 2; return st * 1024 + (ob ^ (((ob >> 9) & 1) << 5)); }
__host__ __device__ __forceinline__ void stage_rc(int b, int& R, int& C) { const int st = b / 1024, sb = b % 1024, swz = sb ^ (((sb >> 9) & 1) << 5); R = (st >> 1) * 16 + swz / 64; C = (st & 1) * 32 + (swz % 64) / 2; }
__host__ __device__ __forceinline__ int perm32(int rho) { const int n = rho >> 4, i = rho & 15; return 8 * (i >> 2) + 4 * n + (i & 3); }

struct Unit { const char* A; const char* B; int orow, ocol, aux, aux2, valid; };
struct Gemm { int K, lda, ldb; };

struct StaticOrder {
    static constexpr bool GATHER = false;
    const char* A; const char* Bt; size_t ta, tb;
    int nM, nN, nwg, G, c;
    __device__ void init(const void* A_, const void* Bt_, int M_, int N_, int lda, int ldb, int G_, int c_, int esz = 2) { A = (const char*)A_; Bt = (const char*)Bt_; ta = (size_t)BM * lda * esz; tb = (size_t)BM * ldb * esz; nM = M_ / BM; nN = N_ / BM; nwg = nM * nN; G = G_; c = c_; }
    __device__ bool next(int i, Unit& u) const {
        const long L = (long)i * G + c; if (c < 0 || L >= nwg) return false;
        int wgid = (int)L; { const int q = nwg / NXCD, r = nwg % NXCD, xcd = wgid % NXCD, off = wgid / NXCD; wgid = (xcd < r ? xcd * (q + 1) : r * (q + 1) + (xcd - r) * q) + off; }
        const int nig = WGM * nN, gid = wgid / nig, fm = gid * WGM, gsz = (nM - fm) < WGM ? (nM - fm) : WGM;
        const int pm = fm + ((wgid % nig) % gsz), pn = (wgid % nig) / gsz;
        u.A = A + (size_t)pm * ta; u.B = Bt + (size_t)pn * tb; u.orow = pm * BM; u.ocol = pn * BM; u.aux = 0; u.aux2 = 0; u.valid = BM; return true;
    }
    __device__ __forceinline__ const int* rows(const Unit&) const { return nullptr; }
};

__device__ __forceinline__ unsigned cvt_pk_bf16(float lo, float hi) { return ::pk2(lo, hi); }

template <class Epi, class Sched, bool ALIGN_EPI = true, bool FP8 = false>
__device__ __forceinline__ void gemm_phase(PG8_LAS unsigned char* lds, const Gemm g, const Sched& S, const Epi& E) {
    const int tid = threadIdx.x, wid = __builtin_amdgcn_readfirstlane(tid >> 6), lane = tid & 63, wr = wid >> 2, wc = wid & 3, fr = lane & 15, fq = lane >> 4;
    constexpr int ES = FP8 ? 1 : 2;
    int sclW = 0, sclX = 0;
    if constexpr (FP8) { asm volatile("v_mov_b32 %0, 0x79797979\n\tv_mov_b32 %1, 0x7f7f7f7f" : "=v"(sclW), "=v"(sclX)); }
    const int K = g.K, nt = K * ES / (BK * 2);
    unsigned voffA[2], voffB[2]; int Rr[2], Cc[2];
#pragma unroll
    for (int i = 0; i < 2; ++i) { int R, C; stage_rc(tid * 16 + i * 8192, R, C); const int Rb = Epi::PERM ? ((R & ~31) + perm32(R & 31)) : R; Rr[i] = R; Cc[i] = C;
        voffA[i] = (unsigned)(R * g.lda * ES + C * 2); voffB[i] = (unsigned)(Rb * g.ldb * ES + C * 2); }
    const size_t kstep = (size_t)(BK * 2);
    const size_t hstepA = (size_t)HALF * g.lda * ES, hstepB = (size_t)HALF * g.ldb * ES;
    const unsigned ldsw = (unsigned)wid * 1024u;
    const int aoff = lds_byte(wr * 64 + fr, fq * 8), boff = lds_byte(wc * 32 + fr, fq * 8);
    unsigned vAc[2][2], vAn[2][2];
#define PG8_SA(b, h) (((b) * 2 + (h)) * HTB)
#define PG8_SB(b, h) ((4 + (b) * 2 + (h)) * HTB)
#define PG8_STAGE(bufoff, gbase, voff) do { _Pragma("unroll") for (int _i = 0; _i < 2; ++_i) \
        __builtin_amdgcn_global_load_lds((const unsigned*)((const char*)(gbase) + (voff)[_i]), (PG8_LAS unsigned*)(lds + (bufoff) + ldsw + _i * 8192), 16, 0, 0); } while (0)
#define PG8_STAGE_A(bufoff, kbase, h, nx) do { if constexpr (Sched::GATHER) { unsigned _v[2] = {(nx) ? vAn[h][0] : vAc[h][0], (nx) ? vAn[h][1] : vAc[h][1]}; PG8_STAGE(bufoff, kbase, _v); } \
        else { PG8_STAGE(bufoff, (kbase) + (h) * hstepA, voffA); } } while (0)
#define PG8_GOFF(u, v) do { const int* _rw = S.rows(u); _Pragma("unroll") for (int _h = 0; _h < 2; ++_h) _Pragma("unroll") for (int _i = 0; _i < 2; ++_i) { const int _r = Rr[_i] + _h * HALF; \
        const int _tk = _r < (u).valid ? _rw[_r] : 0; v[_h][_i] = (unsigned)(_tk * g.lda * ES + Cc[_i] * 2); } } while (0)
#define PG8_LDA(dst, b, h) do { _Pragma("unroll") for (int m = 0; m < 4; ++m) _Pragma("unroll") for (int k = 0; k < 2; ++k) dst[m][k] = *(const PG8_LAS bf16x8*)(lds + PG8_SA(b, h) + aoff + m * 2048 + k * 1024); } while (0)
#define PG8_LDB(dst, b, h) do { _Pragma("unroll") for (int n = 0; n < 2; ++n) _Pragma("unroll") for (int k = 0; k < 2; ++k) dst[n][k] = *(const PG8_LAS bf16x8*)(lds + PG8_SB(b, h) + boff + n * 2048 + k * 1024); } while (0)
#define PG8_MMA(ai, bj, At, Bt) do { __builtin_amdgcn_s_setprio(1); _Pragma("unroll") for (int m = 0; m < 4; ++m) _Pragma("unroll") for (int n = 0; n < 2; ++n) { \
        if constexpr (FP8) { const v4i _b0 = __builtin_bit_cast(v4i, Bt[n][0]), _b1 = __builtin_bit_cast(v4i, Bt[n][1]), _a0 = __builtin_bit_cast(v4i, At[m][0]), _a1 = __builtin_bit_cast(v4i, At[m][1]); \
            const v8i _bb = __builtin_shufflevector(_b0, _b1, 0, 1, 2, 3, 4, 5, 6, 7), _aa = __builtin_shufflevector(_a0, _a1, 0, 1, 2, 3, 4, 5, 6, 7); \
            asm volatile("v_mfma_scale_f32_16x16x128_f8f6f4 %0, %1, %2, %0, %3, %4 op_sel_hi:[0,0,0]" : "+v"(acc[ai][bj][m][n]) : "v"(_bb), "v"(_aa), "v"(sclW), "v"(sclX)); } \
        else { _Pragma("unroll") for (int k = 0; k < 2; ++k) acc[ai][bj][m][n] = __builtin_amdgcn_mfma_f32_16x16x32_bf16(Bt[n][k], At[m][k], acc[ai][bj][m][n], 0, 0, 0); } } \
        __builtin_amdgcn_s_setprio(0); } while (0)
#define PG8_WAIT_V(n) asm volatile("s_waitcnt vmcnt(" #n ")" ::: "memory")
#define PG8_WAIT_L(n) asm volatile("s_waitcnt lgkmcnt(" #n ")" ::: "memory")
#define PG8_BAR __builtin_amdgcn_s_barrier()
#define PG8_SCHED __builtin_amdgcn_sched_barrier(0)
    Unit cur, nxt; int ui = 0;
    if (!S.next(0, cur)) return;
    f32x4 acc[2][2][4][2];
#pragma unroll
    for (int a = 0; a < 2; ++a)
#pragma unroll
        for (int b = 0; b < 2; ++b)
#pragma unroll
            for (int m = 0; m < 4; ++m)
#pragma unroll
                for (int n = 0; n < 2; ++n) acc[a][b][m][n] = (f32x4){0.f, 0.f, 0.f, 0.f};
    bf16x8 At[4][2], B0[2][2], B1[2][2];
    const char* cA = cur.A; const char* cB = cur.B;
    if constexpr (Sched::GATHER) { PG8_GOFF(cur, vAc); PG8_WAIT_V(0); }
    PG8_STAGE(PG8_SB(0, 0), cB, voffB); PG8_STAGE(PG8_SB(0, 1), cB + hstepB, voffB); PG8_STAGE_A(PG8_SA(0, 0), cA, 0, false); PG8_STAGE_A(PG8_SA(0, 1), cA, 1, false);
    if (wr == 1) PG8_BAR;
    PG8_WAIT_V(2); PG8_BAR;
    PG8_STAGE(PG8_SB(1, 0), cB + kstep, voffB); PG8_STAGE_A(PG8_SA(1, 0), cA + kstep, 0, false); PG8_STAGE(PG8_SB(1, 1), cB + hstepB + kstep, voffB);
    PG8_WAIT_V(6); PG8_BAR;
    for (;;) {
        const bool has_next = S.next(ui + 1, nxt);
        const char* nA = has_next ? nxt.A : cA; const char* nB = has_next ? nxt.B : cB;
        if constexpr (Sched::GATHER) { if (has_next) { PG8_GOFF(nxt, vAn); } else {
#pragma unroll
            for (int h = 0; h < 2; ++h)
#pragma unroll
                for (int i = 0; i < 2; ++i) vAn[h][i] = vAc[h][i]; } }
#pragma nounroll
        for (int t = 0; t < nt; t += 2) {
            const bool last = (t == nt - 2);
            if constexpr (Epi::MID_T >= 0) { if (t == Epi::MID_T) { int l3 = lane; asm volatile("" : "+v"(l3)); E.mid(acc, cur, wr, wc, l3 & 15, l3 >> 4); } }
            const char* a1 = cA + (size_t)(t + 1) * kstep;
            const char* a2 = last ? nA : cA + (size_t)(t + 2) * kstep; const char* b2 = last ? nB : cB + (size_t)(t + 2) * kstep;
            const char* a3 = a2 + kstep; const char* b3 = b2 + kstep;
            PG8_LDB(B0, 0, 0); PG8_LDB(B1, 0, 1); PG8_SCHED; PG8_LDA(At, 0, 0); PG8_STAGE_A(PG8_SA(1, 1), a1, 1, false);
            PG8_WAIT_V(8); PG8_WAIT_L(0); PG8_BAR; PG8_MMA(0, 0, At, B0); PG8_MMA(0, 1, At, B1); PG8_BAR; PG8_SCHED;
            PG8_LDA(At, 0, 1); PG8_STAGE(PG8_SB(0, 0), b2, voffB); PG8_STAGE(PG8_SB(0, 1), b2 + hstepB, voffB); PG8_STAGE_A(PG8_SA(0, 0), a2, 0, last);
            PG8_WAIT_V(8); PG8_WAIT_L(0); PG8_BAR; PG8_MMA(1, 0, At, B0); PG8_MMA(1, 1, At, B1); PG8_BAR; PG8_SCHED;
            PG8_LDB(B0, 1, 0); PG8_LDB(B1, 1, 1); PG8_SCHED; PG8_LDA(At, 1, 0); PG8_STAGE_A(PG8_SA(0, 1), a2, 1, last);
            PG8_WAIT_V(8); PG8_WAIT_L(0); PG8_BAR; PG8_MMA(0, 0, At, B0); PG8_MMA(0, 1, At, B1); PG8_BAR; PG8_SCHED;
            PG8_LDA(At, 1, 1); PG8_STAGE(PG8_SB(1, 0), b3, voffB); PG8_STAGE(PG8_SB(1, 1), b3 + hstepB, voffB); PG8_STAGE_A(PG8_SA(1, 0), a3, 0, last);
            PG8_WAIT_V(8); PG8_WAIT_L(0); PG8_BAR; PG8_MMA(1, 0, At, B0); PG8_MMA(1, 1, At, B1); PG8_BAR; PG8_SCHED;
        }
        if constexpr (ALIGN_EPI) { if (wr == 0) PG8_BAR; }
        if constexpr (FP8) asm volatile("s_nop 15\n\ts_nop 15" ::: "memory");
        if constexpr (!Epi::AFTER_DRAIN) { int l2 = lane; asm volatile("" : "+v"(l2));
            E(acc, cur, wr, wc, l2 & 15, l2 >> 4); }
        if (!has_next) break;
#pragma unroll
        for (int a = 0; a < 2; ++a)
#pragma unroll
            for (int b = 0; b < 2; ++b)
#pragma unroll
                for (int m = 0; m < 4; ++m)
#pragma unroll
                    for (int n = 0; n < 2; ++n) acc[a][b][m][n] = (f32x4){0.f, 0.f, 0.f, 0.f};
        cur = nxt; cA = nA; cB = nB; ++ui;
        if constexpr (Sched::GATHER) {
#pragma unroll
            for (int h = 0; h < 2; ++h)
#pragma unroll
                for (int i = 0; i < 2; ++i) vAc[h][i] = vAn[h][i]; }
        if constexpr (ALIGN_EPI) { if (wr == 1) PG8_BAR; }
    }
    PG8_WAIT_V(0);
    if constexpr (!ALIGN_EPI) { if (wr == 0) PG8_BAR; }
    PG8_BAR;
    if constexpr (Epi::AFTER_DRAIN) { E.fused(acc, cur, wr, wc, fr, fq, lds, wid, lane); }
#undef PG8_SA
#undef PG8_SB
#undef PG8_STAGE
#undef PG8_STAGE_A
#undef PG8_GOFF
#undef PG8_LDA
#undef PG8_LDB
#undef PG8_MMA
#undef PG8_WAIT_V
#undef PG8_WAIT_L
#undef PG8_BAR
#undef PG8_SCHED
}

#define EPI_LOOP_AI_M for (int ai = 0; ai < 2; ++ai) _Pragma("unroll") for (int m = 0; m < 4; ++m)

struct EpiF32 {
    static constexpr bool PERM = false, AFTER_DRAIN = false; static constexpr int MID_T = -1;
    float* C; int ldc; const float* bias; int bstride; const float* res; float alpha;
    __device__ __forceinline__ void operator()(const f32x4 (&acc)[2][2][4][2], const Unit& u, int wr, int wc, int fr, int fq) const {
        const int row0 = u.orow + wr * 64 + fr, col0 = u.ocol + wc * 32 + 4 * fq;
        f32x4 bv[2][2];
#pragma unroll
        for (int bj = 0; bj < 2; ++bj)
#pragma unroll
            for (int n = 0; n < 2; ++n) bv[bj][n] = bias ? *(const f32x4*)(bias + (size_t)u.aux * bstride + col0 + bj * HALF + n * 16) : (f32x4){0.f, 0.f, 0.f, 0.f};
#pragma unroll
        EPI_LOOP_AI_M { const size_t off = (size_t)(row0 + ai * HALF + m * 16) * ldc + col0;
#pragma unroll
            for (int bj = 0; bj < 2; ++bj)
#pragma unroll
                for (int n = 0; n < 2; ++n) { f32x4 v = acc[ai][bj][m][n] + bv[bj][n];
                    if (res) { const f32x4 rv = *(const f32x4*)(res + off + bj * HALF + n * 16); v = v + rv * alpha; }
                    *(f32x4*)(C + off + bj * HALF + n * 16) = v; }
            asm volatile("" ::: "memory"); }
    }
};
struct EpiResLn {
    static constexpr bool PERM = false, AFTER_DRAIN = false; static constexpr int MID_T = -1;
    float* C; const float* T; const f32x2* stats; const float* gam; const float* bet; float alpha;
    __device__ __forceinline__ void operator()(const f32x4 (&acc)[2][2][4][2], const Unit& u, int wr, int wc, int fr, int fq) const {
        const int row0 = u.orow + wr * 64 + fr, col0 = u.ocol + wc * 32 + 4 * fq;
        f32x4 gv[2][2], bv[2][2];
#pragma unroll
        for (int bj = 0; bj < 2; ++bj)
#pragma unroll
            for (int n = 0; n < 2; ++n) { gv[bj][n] = *(const f32x4*)(gam + col0 + bj * HALF + n * 16) * alpha; bv[bj][n] = *(const f32x4*)(bet + col0 + bj * HALF + n * 16) * alpha; }
#pragma unroll
        EPI_LOOP_AI_M { const int row = row0 + ai * HALF + m * 16; const size_t off = (size_t)row * D + col0; const f32x2 st = stats[row];
#pragma unroll
            for (int bj = 0; bj < 2; ++bj)
#pragma unroll
                for (int n = 0; n < 2; ++n) { const f32x4 tv = *(const f32x4*)(T + off + bj * HALF + n * 16);
                    *(f32x4*)(C + off + bj * HALF + n * 16) = acc[ai][bj][m][n] + ((tv - st.x) * st.y) * gv[bj][n] + bv[bj][n]; }
            asm volatile("" ::: "memory"); }
    }
};
struct EpiBf16 {
    static constexpr bool PERM = true, AFTER_DRAIN = false; static constexpr int MID_T = -1;
    bf16_t* O; int ldc; float scale;
    __device__ __forceinline__ void operator()(const f32x4 (&acc)[2][2][4][2], const Unit& u, int wr, int wc, int fr, int fq) const {
        const int row0 = u.orow + wr * 64 + fr, col0 = u.ocol + wc * 32 + 8 * fq;
#pragma unroll
        EPI_LOOP_AI_M { bf16_t* rowp = O + (size_t)(row0 + ai * HALF + m * 16) * ldc + col0;
#pragma unroll
            for (int bj = 0; bj < 2; ++bj) { const f32x4 v0 = acc[ai][bj][m][0] * scale, v1 = acc[ai][bj][m][1] * scale;
                u32x4 w; w.x = cvt_pk_bf16(v0[0], v0[1]); w.y = cvt_pk_bf16(v0[2], v0[3]); w.z = cvt_pk_bf16(v1[0], v1[1]); w.w = cvt_pk_bf16(v1[2], v1[3]);
                *(u32x4*)(rowp + bj * HALF) = w; } }
    }
};
struct EpiBf16Bias {
    static constexpr bool PERM = true, AFTER_DRAIN = false; static constexpr int MID_T = -1;
    bf16_t* O; int ldc; const float* bias; int bstride;
    __device__ __forceinline__ void operator()(const f32x4 (&acc)[2][2][4][2], const Unit& u, int wr, int wc, int fr, int fq) const {
        const int row0 = u.orow + wr * 64 + fr, col0 = u.ocol + wc * 32 + 8 * fq;
        f32x4 bv[2][2];
#pragma unroll
        for (int bj = 0; bj < 2; ++bj)
#pragma unroll
            for (int n = 0; n < 2; ++n) bv[bj][n] = *(const f32x4*)(bias + (size_t)u.aux * bstride + col0 + bj * HALF + 4 * n);
#pragma unroll
        EPI_LOOP_AI_M { bf16_t* rowp = O + (size_t)(row0 + ai * HALF + m * 16) * ldc + col0;
#pragma unroll
            for (int bj = 0; bj < 2; ++bj) { const f32x4 v0 = acc[ai][bj][m][0] + bv[bj][0], v1 = acc[ai][bj][m][1] + bv[bj][1];
                u32x4 w; w.x = cvt_pk_bf16(v0[0], v0[1]); w.y = cvt_pk_bf16(v0[2], v0[3]); w.z = cvt_pk_bf16(v1[0], v1[1]); w.w = cvt_pk_bf16(v1[2], v1[3]);
                *(u32x4*)(rowp + bj * HALF) = w; } }
    }
};
struct EpiKV {
    static constexpr bool PERM = true, AFTER_DRAIN = false; static constexpr int MID_T = -1;
    bf16_t* KB; bf16_t* VT;
    __device__ __forceinline__ void operator()(const f32x4 (&acc)[2][2][4][2], const Unit& u, int wr, int wc, int fr, int fq) const {
        const int row0 = u.orow + wr * 64 + fr, col0 = u.ocol + wc * 32 + 8 * fq;
#pragma unroll
        EPI_LOOP_AI_M { const int row = row0 + ai * HALF + m * 16;
#pragma unroll
            for (int bj = 0; bj < 2; ++bj) { const f32x4 v0 = acc[ai][bj][m][0], v1 = acc[ai][bj][m][1]; const int col = col0 + bj * HALF;
                if (u.ocol < 2048) { u32x4 w; w.x = cvt_pk_bf16(v0[0], v0[1]); w.y = cvt_pk_bf16(v0[2], v0[3]); w.z = cvt_pk_bf16(v1[0], v1[1]); w.w = cvt_pk_bf16(v1[2], v1[3]);
                    *(u32x4*)(KB + (size_t)row * 2048 + col) = w; }
                else { const int b = row >> 8, key = row & 255, c = col - 2048, h = c >> 9, d = c & 511; bf16_t* p = VT + ((size_t)((b * 4 + h) * 512 + d)) * 256 + key;
#pragma unroll
                    for (int j = 0; j < 4; ++j) { p[(size_t)j * 256] = (bf16_t)f2bf(v0[j]); p[(size_t)(4 + j) * 256] = (bf16_t)f2bf(v1[j]); } } } }
    }
};
struct EpiDecay {
    static constexpr bool PERM = false, AFTER_DRAIN = false; static constexpr int MID_T = -1;
    float* DEC; const float* w0;
    __device__ __forceinline__ void operator()(const f32x4 (&acc)[2][2][4][2], const Unit& u, int wr, int wc, int fr, int fq) const {
        const int row0 = u.orow + wr * 64 + fr, col0 = u.ocol + wc * 32 + 4 * fq;
        f32x4 bv[2][2];
#pragma unroll
        for (int bj = 0; bj < 2; ++bj)
#pragma unroll
            for (int n = 0; n < 2; ++n) bv[bj][n] = *(const f32x4*)(w0 + col0 + bj * HALF + n * 16);
#pragma unroll
        EPI_LOOP_AI_M { const size_t off = (size_t)(row0 + ai * HALF + m * 16) * D + col0;
#pragma unroll
            for (int bj = 0; bj < 2; ++bj)
#pragma unroll
                for (int n = 0; n < 2; ++n) { const f32x4 x = acc[ai][bj][m][n] + bv[bj][n]; f32x4 o;
#pragma unroll
                    for (int j = 0; j < 4; ++j) o[j] = __expf(-0.6065306597126334f * sigmoidf_(x[j]));
                    *(f32x4*)(DEC + off + bj * HALF + n * 16) = o; } }
    }
};
struct EpiIclr {
    static constexpr bool PERM = true, AFTER_DRAIN = false; static constexpr int MID_T = -1;
    const float* a0; const float* k_k; const float* k_a; const bf16_t* KZ; const float* KNORM; bf16_t* KP; bf16_t* AN; bf16_t* BB;
    __device__ __forceinline__ void operator()(const f32x4 (&acc)[2][2][4][2], const Unit& u, int wr, int wc, int fr, int fq) const {
        const int row0 = u.orow + wr * 64 + fr, col0 = u.ocol + wc * 32 + 8 * fq;
#pragma unroll
        for (int bj = 0; bj < 2; ++bj) { const int col = col0 + bj * HALF;
            const f32x4 a00 = *(const f32x4*)(a0 + col), a01 = *(const f32x4*)(a0 + col + 4), kk0 = *(const f32x4*)(k_k + col), kk1 = *(const f32x4*)(k_k + col + 4), ka0 = *(const f32x4*)(k_a + col), ka1 = *(const f32x4*)(k_a + col + 4);
#pragma unroll
            EPI_LOOP_AI_M { const int row = row0 + ai * HALF + m * 16; const size_t off = (size_t)row * D + col;
                const u32x4 kzw = *(const u32x4*)(KZ + off); const float nr = KNORM[(size_t)row * 32 + (col >> 6)]; const float inv = 1.0f / fmaxf(nr, 1e-12f);
                const unsigned kw[4] = {kzw.x, kzw.y, kzw.z, kzw.w};
                float kp[8], an[8], bb[8];
#pragma unroll
                for (int j = 0; j < 8; ++j) { const float kz = bf2f((kw[j >> 1] >> (16 * (j & 1))) & 0xffffu);
                    const float x = (j < 4 ? acc[ai][bj][m][0][j & 3] + a00[j & 3] : acc[ai][bj][m][1][j & 3] + a01[j & 3]);
                    const float kkc = j < 4 ? kk0[j & 3] : kk1[j & 3], kac = j < 4 ? ka0[j & 3] : ka1[j & 3];
                    const float a = sigmoidf_(x); const float kk = kz * kkc * inv; kp[j] = kz * (1.0f + (a - 1.0f) * kac); bb[j] = kk * a; an[j] = -kk; }
                *(u32x4*)(KP + off) = (u32x4){cvt_pk_bf16(kp[0], kp[1]), cvt_pk_bf16(kp[2], kp[3]), cvt_pk_bf16(kp[4], kp[5]), cvt_pk_bf16(kp[6], kp[7])};
                *(u32x4*)(AN + off) = (u32x4){cvt_pk_bf16(an[0], an[1]), cvt_pk_bf16(an[2], an[3]), cvt_pk_bf16(an[4], an[5]), cvt_pk_bf16(an[6], an[7])};
                *(u32x4*)(BB + off) = (u32x4){cvt_pk_bf16(bb[0], bb[1]), cvt_pk_bf16(bb[2], bb[3]), cvt_pk_bf16(bb[4], bb[5]), cvt_pk_bf16(bb[6], bb[7])}; }
            asm volatile("" ::: "memory"); }
    }
};
struct EpiGateFused {
    static constexpr bool PERM = true, AFTER_DRAIN = false; static constexpr int MID_T = 32;
    const bf16_t* PROJ; bf16_t* MERGED;
    __device__ __forceinline__ void mid(f32x4 (&acc)[2][2][4][2], const Unit& u, int wr, int wc, int fr, int fq) const {
        const int row0 = u.orow + wr * 64 + fr, col0 = u.ocol + wc * 32 + 8 * fq;
#pragma unroll
        EPI_LOOP_AI_M { const int row = row0 + ai * HALF + m * 16;
#pragma unroll
            for (int bj = 0; bj < 2; ++bj) { const int col = col0 + bj * HALF;
                const u32x4 g1v = *(const u32x4*)(PROJ + (size_t)row * PC + GATE0 + col), g2v = *(const u32x4*)(PROJ + (size_t)row * PC + GATE0 + 2048 + col);
                const unsigned w1[4] = {g1v.x, g1v.y, g1v.z, g1v.w}, w2[4] = {g2v.x, g2v.y, g2v.z, g2v.w};
#pragma unroll
                for (int j = 0; j < 8; ++j) { const float x1 = bf2f((w1[j >> 1] >> (16 * (j & 1))) & 0xffffu), x2 = fmaxf(bf2f((w2[j >> 1] >> (16 * (j & 1))) & 0xffffu), -60.0f);
                    const float ratio = (1.0f + __expf(-x2)) * __builtin_amdgcn_rcpf(1.0f + __expf(-x1));
                    if (j < 4) acc[ai][bj][m][0][j & 3] *= ratio; else acc[ai][bj][m][1][j & 3] *= ratio; } }
            asm volatile("" ::: "memory"); }
    }
    __device__ __forceinline__ void operator()(const f32x4 (&acc)[2][2][4][2], const Unit& u, int wr, int wc, int fr, int fq) const {
        const int row0 = u.orow + wr * 64 + fr, col0 = u.ocol + wc * 32 + 8 * fq;
#pragma unroll
        EPI_LOOP_AI_M { const int row = row0 + ai * HALF + m * 16;
#pragma unroll
            for (int bj = 0; bj < 2; ++bj) { const int col = col0 + bj * HALF; const u32x4 gv = *(const u32x4*)(PROJ + (size_t)row * PC + GATE0 + 2048 + col);
                const unsigned w2[4] = {gv.x, gv.y, gv.z, gv.w}; float o[8];
#pragma unroll
                for (int j = 0; j < 8; ++j) { const float x2 = fmaxf(bf2f((w2[j >> 1] >> (16 * (j & 1))) & 0xffffu), -60.0f); o[j] = (j < 4 ? acc[ai][bj][m][0][j & 3] : acc[ai][bj][m][1][j & 3]) * sigmoidf_(x2); }
                u32x4 w; w.x = cvt_pk_bf16(o[0], o[1]); w.y = cvt_pk_bf16(o[2], o[3]); w.z = cvt_pk_bf16(o[4], o[5]); w.w = cvt_pk_bf16(o[6], o[7]);
                *(u32x4*)(MERGED + (size_t)row * D + col) = w; }
            asm volatile("" ::: "memory"); }
    }
};
struct EpiSwiglu {
    static constexpr bool PERM = true, AFTER_DRAIN = false; static constexpr int MID_T = -1;
    const float* b1; bf16_t* H;
    __device__ __forceinline__ float sw(float g, float l) const { g = fminf(g, 7.0f); l = fminf(fmaxf(l, -7.0f), 7.0f); return g * sigmoidf_(1.702f * g) * (l + 1.0f); }
    __device__ __forceinline__ void operator()(const f32x4 (&acc)[2][2][4][2], const Unit& u, int wr, int wc, int fr, int fq) const {
        const int row0 = u.orow + wr * 64 + fr, col0 = u.ocol + wc * 32 + 8 * fq;
        f32x4 bv[2][2];
#pragma unroll
        for (int bj = 0; bj < 2; ++bj)
#pragma unroll
            for (int n = 0; n < 2; ++n) bv[bj][n] = *(const f32x4*)(b1 + (size_t)u.aux * 4096 + col0 + bj * HALF + 4 * n);
#pragma unroll
        EPI_LOOP_AI_M { const int row = row0 + ai * HALF + m * 16;
#pragma unroll
            for (int bj = 0; bj < 2; ++bj) { const f32x4 v0 = acc[ai][bj][m][0] + bv[bj][0], v1 = acc[ai][bj][m][1] + bv[bj][1];
                *(unsigned*)((unsigned char*)H + (size_t)row * DFF + ((col0 + bj * HALF) >> 1)) = pk4_fp8(sw(v0[0], v0[1]), sw(v0[2], v0[3]), sw(v1[0], v1[1]), sw(v1[2], v1[3])); } }
    }
};
struct EpiSoftmax {
    static constexpr bool PERM = true, AFTER_DRAIN = true; static constexpr int MID_T = -1;
    bf16_t* PP;
    __device__ __forceinline__ void fused(f32x4 (&acc)[2][2][4][2], const Unit& u, int wr, int wc, int fr, int fq, PG8_LAS unsigned char* lds, int wid, int lane) const {
        PG8_LAS float* P1 = (PG8_LAS float*)lds;
        PG8_LAS float* P2 = (PG8_LAS float*)(lds + 4096);
        float mx[2][4];
#pragma unroll
        EPI_LOOP_AI_M { float v = -3.0e38f;
#pragma unroll
            for (int bj = 0; bj < 2; ++bj)
#pragma unroll
                for (int n = 0; n < 2; ++n) { const f32x4 x = acc[ai][bj][m][n]; v = fmaxf(v, fmaxf(fmaxf(x[0], x[1]), fmaxf(x[2], x[3]))); }
            v = fmaxf(v, __shfl_xor(v, 16)); v = fmaxf(v, __shfl_xor(v, 32));
            if (fq == 0) P1[(ai * HALF + wr * 64 + m * 16 + fr) * 4 + wc] = v; }
        asm volatile("s_waitcnt lgkmcnt(0)" ::: "memory"); __builtin_amdgcn_s_barrier(); asm volatile("" ::: "memory");
#pragma unroll
        EPI_LOOP_AI_M { const f32x4 t = *(const PG8_LAS f32x4*)(P1 + (ai * HALF + wr * 64 + m * 16 + fr) * 4); mx[ai][m] = fmaxf(fmaxf(t[0], t[1]), fmaxf(t[2], t[3])); }
#pragma unroll
        EPI_LOOP_AI_M { float s = 0.f;
#pragma unroll
            for (int bj = 0; bj < 2; ++bj)
#pragma unroll
                for (int n = 0; n < 2; ++n) { f32x4 x = acc[ai][bj][m][n];
#pragma unroll
                    for (int j = 0; j < 4; ++j) { x[j] = __expf(x[j] - mx[ai][m]); s += x[j]; }
                    acc[ai][bj][m][n] = x; }
            s += __shfl_xor(s, 16); s += __shfl_xor(s, 32);
            if (fq == 0) P2[(ai * HALF + wr * 64 + m * 16 + fr) * 4 + wc] = s; }
        asm volatile("s_waitcnt lgkmcnt(0)" ::: "memory"); __builtin_amdgcn_s_barrier(); asm volatile("" ::: "memory");
        const int row0 = u.orow + wr * 64 + fr, col0 = wc * 32 + 8 * fq;
#pragma unroll
        EPI_LOOP_AI_M { const f32x4 t = *(const PG8_LAS f32x4*)(P2 + (ai * HALF + wr * 64 + m * 16 + fr) * 4); const float inv = 1.0f / ((t[0] + t[1]) + (t[2] + t[3]));
            bf16_t* rowp = PP + (size_t)(row0 + ai * HALF + m * 16) * 256 + col0;
#pragma unroll
            for (int bj = 0; bj < 2; ++bj) { const f32x4 v0 = acc[ai][bj][m][0] * inv, v1 = acc[ai][bj][m][1] * inv;
                u32x4 w; w.x = cvt_pk_bf16(v0[0], v0[1]); w.y = cvt_pk_bf16(v0[2], v0[3]); w.z = cvt_pk_bf16(v1[0], v1[1]); w.w = cvt_pk_bf16(v1[2], v1[3]);
                *(u32x4*)(rowp + bj * HALF) = w; } }
        asm volatile("s_waitcnt lgkmcnt(0)" ::: "memory"); __builtin_amdgcn_s_barrier(); asm volatile("" ::: "memory");
    }
};
}

constexpr size_t MiB = 1u << 20;
constexpr size_t al256(size_t x) { return (x + 255) & ~(size_t)255; }
constexpr size_t WS_CTL = 0, CTL_ZERO_BYTES = 1 * MiB;
constexpr size_t WS_WIN = 1 * MiB;
constexpr size_t WS_WUP = WS_WIN + (size_t)PC * D * 2;
constexpr size_t WS_AUP = WS_WUP + (size_t)D * 256 * 2;
constexpr size_t WS_GUP = WS_AUP + (size_t)D * 256 * 2;
constexpr size_t WS_PA = WS_GUP + (size_t)D * 256 * 2;
constexpr size_t WS_PB = WS_PA + (size_t)D * D * 2;
constexpr size_t WS_WOUT = WS_PB + (size_t)D * 512 * 2;
constexpr size_t WS_WQ = WS_WOUT + (size_t)D * D * 2;
constexpr size_t WS_WKV = WS_WQ + (size_t)D * D * 2;
constexpr size_t WS_WO = WS_WKV + (size_t)2 * D * D * 2;
constexpr size_t WS_W1 = WS_WO + (size_t)D * D * 2;
constexpr size_t WS_W2 = WS_W1 + (size_t)NEXP * 4096 * D * 2;
constexpr size_t WS_XB = WS_W2 + (size_t)NEXP * D * DFF * 2;
constexpr size_t WS_MEMB = WS_XB + (size_t)M * D * 2;
constexpr size_t WS_ROT = WS_MEMB + (size_t)1024 * D * 2;
constexpr size_t WS_KB = WS_ROT + (size_t)2 * SEQ * 32 * 4;
constexpr size_t WS_VT = WS_KB + (size_t)1024 * D * 2;
constexpr size_t WS_YA = WS_VT + (size_t)1024 * D * 2;
constexpr size_t WS_YB = WS_YA + (size_t)M * D * 2;
constexpr size_t WS_TMP = WS_YB + (size_t)M * 512 * 2;
constexpr size_t WS_MERGED = WS_TMP + (size_t)M * D * 4;
constexpr size_t WS_E = WS_MERGED + (size_t)M * D * 2;
constexpr size_t WS_PROJ = WS_E;
constexpr size_t WS_RZ = WS_PROJ + (size_t)M * PC * 2;
constexpr size_t WS_KZ = WS_RZ + (size_t)M * D * 4;
constexpr size_t WS_VZ = WS_KZ + (size_t)M * D * 4;
constexpr size_t WS_DEC = WS_VZ + (size_t)M * D * 4;
constexpr size_t WS_KP = WS_DEC + (size_t)M * D * 4;
constexpr size_t WS_AN = WS_KP + (size_t)M * D * 4;
constexpr size_t WS_BB = WS_AN + (size_t)M * D * 4;
constexpr size_t WS_GG = WS_BB + (size_t)M * D * 4;
constexpr size_t WS_YS = WS_GG + (size_t)M * D * 4;
constexpr size_t WS_XQ = WS_YS + 60 * MiB;
constexpr size_t WS_WIN8 = WS_YS + 96 * MiB;
constexpr size_t WS_ST1 = WS_YS + 112 * MiB, WS_ST2 = WS_YS + 113 * MiB;
constexpr size_t WS_VR = WS_YS + 4 * MiB;
constexpr size_t WS_AO = WS_YS + (size_t)M * D * 4;
constexpr size_t WS_LSE = WS_AO + (size_t)3 * M * 512 * 4;
constexpr size_t WS_QR = WS_LSE + (size_t)3 * M * 8 * 4;
constexpr size_t WS_KR = WS_QR + (size_t)M * 1536 * 2;
constexpr size_t WS_LIN = WS_KR + (size_t)M * 1536 * 2;
constexpr size_t WS_KNORM = WS_LIN + (size_t)M * 768 * 2;
constexpr size_t WS_F = WS_KNORM + (size_t)M * 32 * 4;
constexpr size_t WS_E_END = WS_F + (size_t)128 * 128 * 96 * 96 * 2;
constexpr size_t WS_T1 = WS_E;
constexpr size_t WS_X1 = WS_T1 + (size_t)M * D * 4;
constexpr size_t WS_X1B = WS_X1 + (size_t)M * D * 4;
constexpr size_t WS_Q = WS_X1B + (size_t)M * D * 2;
constexpr size_t WS_PP = WS_Q + (size_t)M * D * 2;
constexpr size_t WS_OC = WS_PP + (size_t)16 * SEQ * 256 * 2;
constexpr size_t WS_T2 = WS_OC + (size_t)M * D * 2;
constexpr size_t WS_X2 = WS_T2 + (size_t)M * D * 4;
constexpr size_t WS_X2B = WS_X2 + (size_t)M * D * 4;
constexpr size_t WS_LIST = WS_X2B + (size_t)M * D * 2;
constexpr size_t WS_ROWI = WS_LIST + (size_t)NEXP * CAP * 4;
constexpr size_t WS_TOPW = WS_ROWI + (size_t)M * 4 * 4;
constexpr size_t WS_H = WS_TOPW + (size_t)M * 4 * 4;
constexpr size_t WS_Y = WS_H + (size_t)HROWS * DFF * 2;
constexpr size_t WS_L_END = WS_Y + (size_t)HROWS * D * 4;
constexpr size_t WS_END = (WS_E_END > WS_L_END ? WS_E_END : WS_L_END);
static_assert(WS_END <= (size_t)4090 * MiB, "workspace map exceeds 4 x largest input");
constexpr int CW_TMO = 0, CW_CNT = 64  , CW_Q = 128  , CW_BAR = 4096;

constexpr int RING_BYTES = 131072, MISC_OFF = RING_BYTES, LDS_BYTES = 147456;

#define XB_TMO      128
#define XB_XCNT(j)  (256  + 64 * (j))
#define XB_XSUB(j)  (1280 + 64 * (j))
#define XB_XGEN(j)  (2304 + 64 * (j))
#define XB_TOP      3328
#define XB_TOPGEN   3392
#define XCD_BAR_WORDS 3456
#define XB_SPIN_CAP (1u << 18)
__device__ __forceinline__ unsigned xb_ld(unsigned* p)              { return __hip_atomic_load(p, __ATOMIC_RELAXED, __HIP_MEMORY_SCOPE_AGENT); }
__device__ __forceinline__ unsigned xb_add(unsigned* p, unsigned v) { return __hip_atomic_fetch_add(p, v, __ATOMIC_RELAXED, __HIP_MEMORY_SCOPE_AGENT); }
__device__ __forceinline__ unsigned xb_xcc_id() { return (unsigned)__builtin_amdgcn_s_getreg((3 << 11) | 20) & 0xFu; }
#define XB_SPIN(cond, bar) do { unsigned _sp = 0; while (cond) { __builtin_amdgcn_s_sleep(1); \
    if ((++_sp & 255u) == 0u) { if (xb_ld(&(bar)[XB_TMO])) break; if (_sp > XB_SPIN_CAP) { atomicAdd(&(bar)[XB_TMO], 1u); break; } } } } while (0)
struct XcdBarrier { unsigned* bar; unsigned x; volatile LAS unsigned* st; };
__device__ __forceinline__ XcdBarrier xcd_barrier_post(unsigned* bar, volatile LAS unsigned* st) {
    XcdBarrier b; b.bar = bar; b.x = xb_xcc_id(); b.st = st;
    if (threadIdx.x == 0) (void)xb_add(&bar[XB_XCNT(b.x)], 1u);
    return b;
}
__device__ __forceinline__ void xcd_barrier_complete(unsigned* bar, unsigned x, unsigned& nloc, unsigned& nx) {
    const unsigned G = gridDim.x * gridDim.y * gridDim.z;
    unsigned sum, cnt, mine, sp = 0u;
    for (;;) {
        sum = 0u; cnt = 0u; mine = 0u;
#pragma unroll
        for (unsigned j = 0; j < 16; ++j) { const unsigned c = xb_ld(&bar[XB_XCNT(j)]); sum += c; cnt += (c > 0u) ? 1u : 0u; mine = (j == x) ? c : mine; }
        if (sum == G) break;
        __builtin_amdgcn_s_sleep(1);
        if ((++sp & 255u) == 0u) { if (xb_ld(&bar[XB_TMO])) break; if (sp > XB_SPIN_CAP) { atomicAdd(&bar[XB_TMO], 1u); break; } }
    }
    nloc = mine > 0u ? mine : 1u; nx = cnt > 0u ? cnt : 1u;
}
__device__ __forceinline__ void xcd_barrier(const XcdBarrier& b) {
    asm volatile("s_waitcnt vmcnt(0)" ::: "memory");
    __syncthreads();
    if (threadIdx.x == 0) {
        unsigned* bar = b.bar;
        __builtin_amdgcn_s_waitcnt(0);
        unsigned nloc = b.st[0], nx = b.st[1];
        if (nloc == 0u) { xcd_barrier_complete(bar, b.x, nloc, nx); b.st[0] = nloc; b.st[1] = nx; }
        const unsigned old = xb_add(&bar[XB_XSUB(b.x)], 1u);
        const unsigned gen = old / nloc;
        if (old + 1u == (gen + 1u) * nloc) {
            __builtin_amdgcn_fence(__ATOMIC_RELEASE, "agent");
            asm volatile("s_waitcnt vmcnt(0)" ::: "memory");
            const unsigned og = xb_add(&bar[XB_TOP], 1u);
            const unsigned tg = og / nx;
            if (og + 1u == (tg + 1u) * nx) xb_add(&bar[XB_TOPGEN], 1u);
            else XB_SPIN(xb_ld(&bar[XB_TOPGEN]) == tg, bar);
            __builtin_amdgcn_fence(__ATOMIC_ACQUIRE, "agent");
            xb_add(&bar[XB_XGEN(b.x)], 1u);
            asm volatile("s_waitcnt vmcnt(0)" ::: "memory");
        } else {
            XB_SPIN(xb_ld(&bar[XB_XGEN(b.x)]) == gen, bar);
            __builtin_amdgcn_fence(__ATOMIC_ACQUIRE, "agent");
            asm volatile("s_waitcnt vmcnt(0)" ::: "memory");
        }
    }
    __syncthreads();
}

struct Params {
    const float* in[32];
    float* out; unsigned char* ws;
    int ph_lo, ph_hi, li, pad;
};
enum { I_X = 0, I_MEM, I_WIN, I_MIX, I_W0, I_WUP, I_A0, I_AUP, I_GUP, I_KK, I_KA, I_RK, I_LNXG, I_LNXB, I_PA, I_PB, I_WOUT, I_LN1G, I_LN1B, I_WQ, I_WKV, I_WO, I_LN2G, I_LN2B,
       I_RW, I_RB, I_W1, I_B1, I_W2, I_B2, I_LN3G, I_LN3B };

struct ScoreOrder {
    static constexpr bool GATHER = false;
    const char* Q; const char* KB; int G, c;
    __device__ bool next(int i, pg8::Unit& u) const {
        const int L = i * G + c; if (L >= 256) return false;
        const int bh = L >> 4, pm = L & 15, b = bh >> 2, h = bh & 3;
        u.A = Q + ((size_t)(b * SEQ + 256 * pm) * D + h * 512) * 2; u.B = KB + ((size_t)(b * 256) * D + h * 512) * 2;
        u.orow = bh * SEQ + 256 * pm; u.ocol = 0; u.aux = 0; u.aux2 = 0; u.valid = 256; return true;
    }
    __device__ __forceinline__ const int* rows(const pg8::Unit&) const { return nullptr; }
};
struct PvOrder {
    static constexpr bool GATHER = false;
    const char* PP; const char* VT; int G, c;
    __device__ bool next(int i, pg8::Unit& u) const {
        const int L = i * G + c; if (L >= 512) return false;
        const int bh = L >> 5, pm = (L >> 1) & 15, pn = L & 1, b = bh >> 2, h = bh & 3;
        u.A = PP + ((size_t)(bh * SEQ + 256 * pm) * 256) * 2; u.B = VT + ((size_t)(bh * 512 + 256 * pn) * 256) * 2;
        u.orow = b * SEQ + 256 * pm; u.ocol = h * 512 + 256 * pn; u.aux = 0; u.aux2 = 0; u.valid = 256; return true;
    }
    __device__ __forceinline__ const int* rows(const pg8::Unit&) const { return nullptr; }
};
template <bool GATHER_, int NT  > struct MoeOrder {
    static constexpr bool GATHER = GATHER_;
    const LAS int* tab; const char* A; const char* W; const int* list; size_t wexp  ; int ldb; int G, c;
    __device__ bool next(int i, pg8::Unit& u) const {
        constexpr int RPR = 256 / NT;
        const int rt = i * RPR + (c % RPR), pn = c / RPR, T = __builtin_amdgcn_readfirstlane(tab[64]);
        if (c >= 256 || rt >= T) return false;
        int e = 0;
        for (int j = 1; j < NEXP; ++j) e = (rt >= __builtin_amdgcn_readfirstlane(tab[32 + j])) ? j : e;
        const int lt = rt - __builtin_amdgcn_readfirstlane(tab[32 + e]), cnt = __builtin_amdgcn_readfirstlane(tab[e]);
        u.aux = e; u.aux2 = lt; u.valid = min(256, cnt - 256 * lt); u.orow = 256 * rt; u.ocol = 256 * pn;
        u.B = W + (size_t)e * wexp + (size_t)(256 * pn) * ldb;
        u.A = GATHER_ ? A : A + (size_t)(256 * rt) * DFF;
        return true;
    }
    __device__ __forceinline__ const int* rows(const pg8::Unit& u) const { return list + (size_t)u.aux * CAP + 256 * u.aux2; }
};

struct Ctx { int tid, lane, wave, vcu, G; LAS unsigned char* lds; unsigned char* ws; };

__device__ __forceinline__ void cv_issue(const float* W, int ldw, int Ksrc, int sc0, int k0, int lane, float (&cv)[32]) {
    const int kb = k0 + 32 * (lane >> 5); const bool ok = sc0 >= 0 && kb < Ksrc;
    const float* src = W + (ok ? (size_t)kb * ldw + sc0 + (lane & 31) : (size_t)0);
#pragma unroll
    for (int i = 0; i < 32; ++i) { const float v = src[(size_t)i * ldw]; cv[i] = ok ? v : 0.f; }
}
__device__ __forceinline__ void cv_store16(const float (&cv)[32], bf16_t* WT, int ldt, int n0, int k0, int lane) {
    u32x4* dst = (u32x4*)(WT + (size_t)(n0 + (lane & 31)) * ldt + k0 + 32 * (lane >> 5));
#pragma unroll
    for (int j = 0; j < 4; ++j) dst[j] = (u32x4){pk2(cv[8 * j], cv[8 * j + 1]), pk2(cv[8 * j + 2], cv[8 * j + 3]), pk2(cv[8 * j + 4], cv[8 * j + 5]), pk2(cv[8 * j + 6], cv[8 * j + 7])};
}
__device__ __forceinline__ void cv_store8(const float (&cv)[32], unsigned char* WT8, int ldt, int n0, int k0, int lane) {
    u32x4* dst = (u32x4*)(WT8 + (size_t)(n0 + (lane & 31)) * ldt + k0 + 32 * (lane >> 5));
#pragma unroll
    for (int j = 0; j < 2; ++j) dst[j] = (u32x4){pk4_fp8(cv[16 * j] * 64.f, cv[16 * j + 1] * 64.f, cv[16 * j + 2] * 64.f, cv[16 * j + 3] * 64.f), pk4_fp8(cv[16 * j + 4] * 64.f, cv[16 * j + 5] * 64.f, cv[16 * j + 6] * 64.f, cv[16 * j + 7] * 64.f),
        pk4_fp8(cv[16 * j + 8] * 64.f, cv[16 * j + 9] * 64.f, cv[16 * j + 10] * 64.f, cv[16 * j + 11] * 64.f), pk4_fp8(cv[16 * j + 12] * 64.f, cv[16 * j + 13] * 64.f, cv[16 * j + 14] * 64.f, cv[16 * j + 15] * 64.f)};
}
struct CvJob { const float* W; bf16_t* WT; int ldw, Ksrc, sc0, ldt, n0, k0, f8, kd; };
__device__ __forceinline__ CvJob p0_job(const Params& p, unsigned char* ws, int it) {
    constexpr int I_WINJ = 32 * 480, I_LORA = 4 * 64, I_SQ = 32 * 64, I_PBJ = 8 * 64, I_KVJ = 32 * 128;
    CvJob j; j.f8 = 0; j.kd = 0; int r = it;
#define P0_PLAIN_F8(SRC, DST, N_, KS_, KD_) { const int nblk = (N_) / 32, kb = r / nblk, nb = r % nblk; j.W = p.in[SRC]; j.WT = (bf16_t*)(ws + (DST)); j.ldw = (N_); j.Ksrc = (KS_); j.sc0 = 32 * nb; j.ldt = (KD_); j.n0 = 32 * nb; j.k0 = 64 * kb; j.f8 = 1; return j; }
#define P0_PLAIN(SRC, DST, N_, KS_, KD_) { const int nblk = (N_) / 32, kb = r / nblk, nb = r % nblk; j.W = p.in[SRC]; j.WT = (bf16_t*)(ws + (DST)); j.ldw = (N_); j.Ksrc = (KS_); j.sc0 = 32 * nb; j.ldt = (KD_); j.n0 = 32 * nb; j.k0 = 64 * kb; return j; }
    if (r < I_WINJ) { const int kb = r / 480, nb = r % 480; j.W = p.in[I_WIN]; j.WT = (bf16_t*)(ws + WS_WIN); j.ldw = 15296; j.Ksrc = D; const int n_ = 32 * nb;
        j.sc0 = n_ < RWC ? n_ : (n_ < ATTV2 ? -1 : (n_ < ATT0 ? RWC + 4096 + (n_ - ATTV2) : (n_ < GATE0 ? RWC + (n_ - ATT0) : n_ - 64))); j.ldt = D; j.n0 = n_; j.k0 = 64 * kb;
        if (n_ >= ATT0) { j.f8 = 1; j.WT = (bf16_t*)(ws + WS_WIN8); j.n0 = n_ - ATT0; }
        return j; } r -= I_WINJ;
    if (r < I_LORA) P0_PLAIN(I_WUP, WS_WUP, D, 96, 256) r -= I_LORA;
    if (r < I_LORA) P0_PLAIN(I_AUP, WS_AUP, D, 96, 256) r -= I_LORA;
    if (r < I_LORA) P0_PLAIN(I_GUP, WS_GUP, D, 256, 256) r -= I_LORA;
    if (r < I_SQ) P0_PLAIN(I_PA, WS_PA, D, D, 2560) r -= I_SQ;
    if (r < I_PBJ) { const int kb = r / 64, nb = r % 64; j.W = p.in[I_PB]; j.WT = (bf16_t*)(ws + WS_PA); j.ldw = D; j.Ksrc = 512; j.sc0 = 32 * nb; j.ldt = 2560; j.n0 = 32 * nb; j.k0 = 64 * kb; j.kd = 2048; return j; } r -= I_PBJ;
    if (r < I_SQ) P0_PLAIN(I_WOUT, WS_WOUT, D, D, D) r -= I_SQ;
    if (r < I_SQ) { P0_PLAIN_F8(I_WQ, WS_WQ, D, D, D) } r -= I_SQ;
    if (r < I_KVJ) P0_PLAIN(I_WKV, WS_WKV, 2 * D, D, D) r -= I_KVJ;
    P0_PLAIN(I_WO, WS_WO, D, D, D)
#undef P0_PLAIN
#undef P0_PLAIN_F8
}
__device__ __forceinline__ void p0_prologue(const Params& p, const Ctx& c) {
    const int gw = c.vcu * 8 + c.wave, NGW = c.G * 8;
    unsigned char* ws = c.ws;
    constexpr int NITEMS = 32 * 480 + 3 * (4 * 64) + 4 * (32 * 64) + 8 * 64 + 32 * 128;
    { float ca[32], cb[32]; CvJob ja, jb; int it = gw;
      if (it < NITEMS) { ja = p0_job(p, ws, it); cv_issue(ja.W, ja.ldw, ja.Ksrc, ja.sc0, ja.k0, c.lane, ca); }
      for (; it < NITEMS; it += 2 * NGW) {
          if (it + NGW < NITEMS) { jb = p0_job(p, ws, it + NGW); cv_issue(jb.W, jb.ldw, jb.Ksrc, jb.sc0, jb.k0, c.lane, cb); }
          if (ja.f8) cv_store8(ca, (unsigned char*)ja.WT, ja.ldt, ja.n0, ja.k0, c.lane); else cv_store16(ca, ja.WT, ja.ldt, ja.n0, ja.k0 + ja.kd, c.lane);
          if (it + 2 * NGW < NITEMS) { ja = p0_job(p, ws, it + 2 * NGW); cv_issue(ja.W, ja.ldw, ja.Ksrc, ja.sc0, ja.k0, c.lane, ca); }
          if (it + NGW < NITEMS) { if (jb.f8) cv_store8(cb, (unsigned char*)jb.WT, jb.ldt, jb.n0, jb.k0, c.lane); else cv_store16(cb, jb.WT, jb.ldt, jb.n0, jb.k0 + jb.kd, c.lane); }
      } }
    const size_t gt = (size_t)c.vcu * 512 + c.tid, NT = (size_t)c.G * 512;
    for (size_t i = gt; i < (size_t)M * D / 8; i += NT) { const f32x4 a = ((const f32x4*)p.in[I_X])[2 * i], b = ((const f32x4*)p.in[I_X])[2 * i + 1];
        u32x4 o; o.x = pk2(a[0], a[1]); o.y = pk2(a[2], a[3]); o.z = pk2(b[0], b[1]); o.w = pk2(b[2], b[3]); ((u32x4*)(ws + WS_XB))[i] = o;
        ((u32x2*)(ws + WS_XQ))[i] = (u32x2){pk4_fp8(a[0], a[1], a[2], a[3]), pk4_fp8(b[0], b[1], b[2], b[3])}; }
    for (size_t i = gt; i < (size_t)1024 * D / 8; i += NT) { const f32x4 a = ((const f32x4*)p.in[I_MEM])[2 * i], b = ((const f32x4*)p.in[I_MEM])[2 * i + 1];
        u32x4 o; o.x = pk2(a[0], a[1]); o.y = pk2(a[2], a[3]); o.z = pk2(b[0], b[1]); o.w = pk2(b[2], b[3]); ((u32x4*)(ws + WS_MEMB))[i] = o; }
    float* rc = (float*)(ws + WS_ROT); float* rs = rc + SEQ * 32;
    for (size_t i = gt; i < (size_t)SEQ * 32; i += NT) { const int pos = (int)(i >> 5), j = (int)(i & 31);
        const double inv = exp(-(double)j * (9.210340371976184 / 32.0)); const double ang = (double)pos * inv; rc[i] = (float)cos(ang); rs[i] = (float)sin(ang); }
}

constexpr int MOE_W1E = 32 * 128, MOE_W2E = 32 * 64, MOE_CONV_GROUPS = (NEXP * MOE_W2E) / 8;
__device__ __forceinline__ void conv_group(const Params& p, const Ctx& c, int gi) {
    unsigned char* ws = c.ws;
    const int r = gi * 8 + c.wave;
    const int e = r / MOE_W2E, it = r % MOE_W2E, kb = it >> 6, nb = it & 63;
    float cv[32]; cv_issue(p.in[I_W2] + (size_t)e * DFF * D, D, DFF, 32 * nb, 64 * kb, c.lane, cv);
    cv_store8(cv, ws + WS_W2 + (size_t)e * D * DFF, DFF, 32 * nb, 64 * kb, c.lane);
}

#define DPP_ADD(x, ctrl) ((x) + __builtin_bit_cast(float, __builtin_amdgcn_update_dpp(0, __builtin_bit_cast(int, (x)), (ctrl), 0xF, 0xF, true)))
struct P2Tok { u32x4 cv0, pv0, cv1, pv1, ra, rb, vv; f32x4 c0, c1, s0, s1; };
__device__ __forceinline__ void p2_prep(const Params& p, const Ctx& c) {
    unsigned char* ws = c.ws;
    const bf16_t* PROJ = (const bf16_t*)(ws + WS_PROJ);
    const float* mix = p.in[I_MIX]; const float* k_k = p.in[I_KK];
    bf16_t* RZ = (bf16_t*)(ws + WS_RZ); bf16_t* KZ = (bf16_t*)(ws + WS_KZ); bf16_t* VZ = (bf16_t*)(ws + WS_VZ);
    bf16_t* LIN = (bf16_t*)(ws + WS_LIN); float* KNORM = (float*)(ws + WS_KNORM);
    bf16_t* QR = (bf16_t*)(ws + WS_QR); bf16_t* KR = (bf16_t*)(ws + WS_KR); bf16_t* VR = (bf16_t*)(ws + WS_VR);
    const float* rc = (const float*)(ws + WS_ROT); const float* rs = rc + SEQ * 32;
    int tid_ = c.tid; asm volatile("" : "+v"(tid_));
    const int tid = tid_;
    const int ch0 = tid, ch1 = tid + 512; const bool has1 = ch1 < 824;
    const f32x4 m00 = *(const f32x4*)(mix + 8 * ch0), m01 = *(const f32x4*)(mix + 8 * ch0 + 4);
    f32x4 m10 = (f32x4){0.f, 0.f, 0.f, 0.f}, m11 = m10; if (has1) { m10 = *(const f32x4*)(mix + 8 * ch1); m11 = *(const f32x4*)(mix + 8 * ch1 + 4); }
    f32x4 kk0 = (f32x4){0.f, 0.f, 0.f, 0.f}, kk1 = kk0; if (tid >= 256) { kk0 = *(const f32x4*)(k_k + 8 * (tid - 256)); kk1 = *(const f32x4*)(k_k + 8 * (tid - 256) + 4); }
    const bool rot = tid >= 64 && tid < 256, vcp = tid >= 256 && tid < 448;
    const int rw = tid - 64, which = rw / 96, rhh = (rw % 96) >> 2, re0 = (rw & 3) * 8;
    const int vhh = (tid - 256) >> 3, ve0 = ((tid - 256) & 7) * 8;
#define P2_LOAD(T, t_) do { const int pos_ = (t_) & (SEQ - 1); const bf16_t* cur_ = PROJ + (size_t)(t_) * PC; const u32x4 z4_ = (u32x4){0u, 0u, 0u, 0u}; \
        T.cv0 = *(const u32x4*)(cur_ + 8 * ch0); T.pv0 = pos_ > 0 ? *(const u32x4*)(cur_ - PC + 8 * ch0) : z4_; \
        if (has1) { T.cv1 = *(const u32x4*)(cur_ + 8 * ch1); T.pv1 = pos_ > 0 ? *(const u32x4*)(cur_ - PC + 8 * ch1) : z4_; } \
        if (rot) { const bf16_t* src_ = cur_ + ATT0 + which * 1536 + rhh * 64 + re0; T.ra = *(const u32x4*)src_; T.rb = *(const u32x4*)(src_ + 32); \
            T.c0 = *(const f32x4*)(rc + pos_ * 32 + re0); T.c1 = *(const f32x4*)(rc + pos_ * 32 + re0 + 4); T.s0 = *(const f32x4*)(rs + pos_ * 32 + re0); T.s1 = *(const f32x4*)(rs + pos_ * 32 + re0 + 4); } \
        if (vcp) { const int ao_ = 2 * 1536 + vhh * 64 + ve0; T.vv = *(const u32x4*)(cur_ + (ao_ < 4096 ? ATT0 + ao_ : ATTV2 + ao_ - 4096)); } } while (0)
#define P2_SHIFT(z, cv, pv, ma, mb) do { const unsigned cw[4] = {cv.x, cv.y, cv.z, cv.w}, pw[4] = {pv.x, pv.y, pv.z, pv.w}; const float mm[8] = {ma[0], ma[1], ma[2], ma[3], mb[0], mb[1], mb[2], mb[3]}; \
        _Pragma("unroll") for (int j = 0; j < 4; ++j) { const float c0_ = bf2f(cw[j] & 0xffffu), c1_ = bf2f(cw[j] >> 16), q0_ = bf2f(pw[j] & 0xffffu), q1_ = bf2f(pw[j] >> 16); \
            z[2 * j] = c0_ + (q0_ - c0_) * mm[2 * j]; z[2 * j + 1] = c1_ + (q1_ - c1_) * mm[2 * j + 1]; } } while (0)
#define P2_PROC(T, t_) do { const int t = (t_), pos = t & (SEQ - 1); \
        { float z[8]; P2_SHIFT(z, T.cv0, T.pv0, m00, m01);            \
          bf16_t* dst = (tid < 256 ? RZ : KZ) + (size_t)t * D + 8 * (tid & 255); \
          { u32x4 w8; w8.x = pk2(z[0], z[1]); w8.y = pk2(z[2], z[3]); w8.z = pk2(z[4], z[5]); w8.w = pk2(z[6], z[7]); *(u32x4*)dst = w8; } \
          if (tid >= 256) { float sq = 0.f; _Pragma("unroll") for (int j = 0; j < 4; ++j) { const float a_ = z[j] * kk0[j], b_ = z[4 + j] * kk1[j]; sq += a_ * a_ + b_ * b_; } \
              sq = DPP_ADD(sq, 0xB1); sq = DPP_ADD(sq, 0x4E); sq = DPP_ADD(sq, 0x141);                   \
              if ((tid & 7) == 0) KNORM[(size_t)t * 32 + ((tid - 256) >> 3)] = sqrtf(sq); } } \
        if (has1) { float z[8]; P2_SHIFT(z, T.cv1, T.pv1, m10, m11);    \
          if (ch1 < 768) { u32x4 w8; w8.x = pk2(z[0], z[1]); w8.y = pk2(z[2], z[3]); w8.z = pk2(z[4], z[5]); w8.w = pk2(z[6], z[7]); *(u32x4*)(VZ + (size_t)t * D + 8 * (ch1 - 512)) = w8; } \
          else { float o[8]; int dcol; \
              if (ch1 < 780) { dcol = 8 * (ch1 - 768); _Pragma("unroll") for (int j = 0; j < 8; ++j) o[j] = tanhf(z[j]); } \
              else if (ch1 < 792) { dcol = 256 + 8 * (ch1 - 780); _Pragma("unroll") for (int j = 0; j < 8; ++j) o[j] = z[j]; } \
              else { dcol = 512 + 8 * (ch1 - 792); _Pragma("unroll") for (int j = 0; j < 8; ++j) o[j] = sigmoidf_(z[j]); } \
              u32x4 w; w.x = pk2(o[0], o[1]); w.y = pk2(o[2], o[3]); w.z = pk2(o[4], o[5]); w.w = pk2(o[6], o[7]); *(u32x4*)(LIN + (size_t)t * 768 + dcol) = w; } } \
        if (tid >= 448 && tid < 488) { const int q_ = tid - 448; const int dcol = (q_ < 20) ? 96 + 8 * q_ : 352 + 8 * (q_ - 20); *(u32x4*)(LIN + (size_t)t * 768 + dcol) = (u32x4){0u, 0u, 0u, 0u}; } \
        if (rot) { const unsigned aw[4] = {T.ra.x, T.ra.y, T.ra.z, T.ra.w}, bw[4] = {T.rb.x, T.rb.y, T.rb.z, T.rb.w}; float o1[8], o2[8]; \
            _Pragma("unroll") for (int j = 0; j < 8; ++j) { const float t1 = bf2f((aw[j >> 1] >> (16 * (j & 1))) & 0xffffu), t2 = bf2f((bw[j >> 1] >> (16 * (j & 1))) & 0xffffu); \
                const float cs = j < 4 ? T.c0[j & 3] : T.c1[j & 3], sn = j < 4 ? T.s0[j & 3] : T.s1[j & 3]; o1[j] = t1 * cs - t2 * sn; o2[j] = t2 * cs + t1 * sn; } \
            const int dl_ = rhh < 8 ? 1 : (rhh < 16 ? 4 : 16); const int prm = (pos % dl_) * (SEQ / dl_) + pos / dl_; \
            bf16_t* dst = (which ? KR : QR) + ((size_t)((t >> 12) * 24 + rhh) * SEQ + prm) * 64 + re0; \
            u32x4 w1; w1.x = pk2(o1[0], o1[1]); w1.y = pk2(o1[2], o1[3]); w1.z = pk2(o1[4], o1[5]); w1.w = pk2(o1[6], o1[7]); \
            u32x4 w2; w2.x = pk2(o2[0], o2[1]); w2.y = pk2(o2[2], o2[3]); w2.z = pk2(o2[4], o2[5]); w2.w = pk2(o2[6], o2[7]); \
            *(u32x4*)dst = w1; *(u32x4*)(dst + 32) = w2; } \
        if (vcp) { const int dl_ = vhh < 8 ? 1 : (vhh < 16 ? 4 : 16); const int prm = (pos % dl_) * (SEQ / dl_) + pos / dl_; \
            *(u32x4*)(VR + ((size_t)((t >> 12) * 24 + vhh) * SEQ + prm) * 64 + ve0) = T.vv; } } while (0)
    P2Tok ta, tb;
    int tq = c.vcu;
    if (tq < M) P2_LOAD(ta, tq);
    for (; tq < M; tq += 2 * c.G) {
        if (tq + c.G < M) P2_LOAD(tb, tq + c.G);
        P2_PROC(ta, tq);
        if (tq + 2 * c.G < M) P2_LOAD(ta, tq + 2 * c.G);
        if (tq + c.G < M) P2_PROC(tb, tq + c.G);
    }
#undef P2_LOAD
#undef P2_SHIFT
#undef P2_PROC
}

__device__ __forceinline__ float wave_sum_dpp(float x) {
    x = DPP_ADD(x, 0xB1); x = DPP_ADD(x, 0x4E); x = DPP_ADD(x, 0x141); x = DPP_ADD(x, 0x140);
    const int xi = __builtin_bit_cast(int, x);
    return (__builtin_bit_cast(float, __builtin_amdgcn_readlane(xi, 0)) + __builtin_bit_cast(float, __builtin_amdgcn_readlane(xi, 16))) +
           (__builtin_bit_cast(float, __builtin_amdgcn_readlane(xi, 32)) + __builtin_bit_cast(float, __builtin_amdgcn_readlane(xi, 48)));
}
__device__ __forceinline__ f32x4 tile_mm(const LAS bf16_t* A, int pa, const LAS bf16_t* Bt, int pb, int ks, int fr, int fq, f32x4 acc) {
    for (int k = 0; k < ks; ++k) { const bf16x8 a = *(const LAS bf16x8*)(A + fr * pa + 32 * k + 8 * fq), b = *(const LAS bf16x8*)(Bt + fr * pb + 32 * k + 8 * fq);
        acc = __builtin_amdgcn_mfma_f32_16x16x32_bf16(a, b, acc, 0, 0, 0); }
    return acc;
}
__device__ __forceinline__ u32x2 pack4(f32x4 v) { u32x2 w; w.x = pk2(v[0], v[1]); w.y = pk2(v[2], v[3]); return w; }
constexpr int SC_C = 32, SC_NCH = SEQ / SC_C, SC_F = 96;
constexpr int PL_X1 = 0, PL_X2 = 9216, PL_AL = 18432, PL_HT = 26112, PL_ET = 33792, PL_LBT = 53760, PL_TT = 58368, PL_XB = 60928, PL_GI = PL_X1, PL_TF = PL_X2, PL_END = 62016, PL_GRP = 65536;
#define LBAR() do { asm volatile("s_waitcnt lgkmcnt(0)" ::: "memory"); __builtin_amdgcn_s_barrier(); asm volatile("" ::: "memory"); } while (0)
__device__ __forceinline__ void p4_pre(const Params& p, const Ctx& c) {
    unsigned char* ws = c.ws;
    const bf16_t* RZ = (const bf16_t*)(ws + WS_RZ); const float* DEC = (const float*)(ws + WS_DEC); const bf16_t* KP = (const bf16_t*)(ws + WS_KP);
    const bf16_t* AN = (const bf16_t*)(ws + WS_AN); const bf16_t* BB = (const bf16_t*)(ws + WS_BB);
    bf16_t* FG = (bf16_t*)(ws + WS_F); float* BON = (float*)(ws + WS_YS);
    const float* rkp = p.in[I_RK];
    int tid_ = c.tid; asm volatile("" : "+v"(tid_));
    const int tid = tid_, lane = tid & 63, w = __builtin_amdgcn_readfirstlane(tid >> 6), fr = lane & 15, fq = lane >> 4;
    const int grp = w >> 2, tw = w & 3, gtid = tid & 255;
    LAS unsigned char* gl = c.lds + grp * PL_GRP;
    LAS bf16_t* X1 = (LAS bf16_t*)(gl + PL_X1); LAS bf16_t* X2 = (LAS bf16_t*)(gl + PL_X2); LAS bf16_t* AL = (LAS bf16_t*)(gl + PL_AL); LAS bf16_t* HT = (LAS bf16_t*)(gl + PL_HT);
    LAS bf16_t* ET = (LAS bf16_t*)(gl + PL_ET); LAS float* LBT = (LAS float*)(gl + PL_LBT); LAS bf16_t* TT = (LAS bf16_t*)(gl + PL_TT); LAS bf16_t* GI = (LAS bf16_t*)(gl + PL_GI);
    LAS float* TF = (LAS float*)(gl + PL_TF);
    LAS float* XB = (LAS float*)(gl + PL_XB);
    const int npair = (128 * SC_NCH) / (2 * c.G);
    float dcy[32]; unsigned short ir[8], ik[8], ia[8], ib[8];
#define PRE_LOAD(PAIR) do { const int task_ = c.vcu + (2 * (PAIR) + grp) * c.G; const int bh_ = task_ >> 7, ch_ = task_ & (SC_NCH - 1); \
        const size_t o_ = ((size_t)(bh_ >> 5) * SEQ + (size_t)ch_ * SC_C) * D + (bh_ & 31) * 64 + lane; \
        _Pragma("unroll") for (int s_ = 0; s_ < 32; ++s_) dcy[s_] = DEC[o_ + (size_t)s_ * D]; \
        _Pragma("unroll") for (int q_ = 0; q_ < 8; ++q_) { const size_t oo_ = o_ + (size_t)(8 * tw + q_) * D; ir[q_] = RZ[oo_]; ik[q_] = KP[oo_]; ia[q_] = AN[oo_]; ib[q_] = BB[oo_]; } } while (0)
    const bool bgconv = (c.G == 256);
    if (npair > 0) PRE_LOAD(0);
    for (int pr = 0; pr < npair; ++pr) {
        const int task = c.vcu + (2 * pr + grp) * c.G, bh = task >> 7, chn = task & (SC_NCH - 1);
        const float rkv = rkp[(bh & 31) * 64 + lane];
        float* bon = BON + ((size_t)(bh >> 5) * SEQ + (size_t)chn * SC_C) * 32 + (bh & 31);
        float p0 = 1.f, p1 = 1.f, p2 = 1.f, p3 = 1.f, dsel[8];
#pragma unroll
        for (int s = 0; s < 8; ++s) { p0 *= dcy[s]; p1 *= dcy[8 + s]; p2 *= dcy[16 + s]; p3 *= dcy[24 + s];
            dsel[s] = tw == 0 ? dcy[s] : (tw == 1 ? dcy[8 + s] : (tw == 2 ? dcy[16 + s] : dcy[24 + s])); }
        const float gC = (p0 * p1) * (p2 * p3);
        float g = tw == 0 ? 1.f : (tw == 1 ? p0 : (tw == 2 ? p0 * p1 : (p0 * p1) * p2));
        LBAR();
#pragma unroll
        for (int hq = 0; hq < 2; ++hq) { f32x4 ah4, bg4, kg4;
#pragma unroll
            for (int qq = 0; qq < 4; ++qq) { const int qn = 4 * hq + qq, s = 8 * tw + qn;
                const float gp = g; g *= dsel[qn];
                const float rr = bf2f(ir[qn]), kk = bf2f(ik[qn]), aa = bf2f(ia[qn]), bb = bf2f(ib[qn]); const float ig = 1.0f / g;
                const float ah = aa * gp, bt = bb * ig, kt = kk * ig, rh = rr * g;
                X1[s * 72 + lane] = (bf16_t)f2bf(bt); X1[(32 + s) * 72 + lane] = (bf16_t)f2bf(kt); X2[s * 72 + lane] = (bf16_t)f2bf(ah); X2[(32 + s) * 72 + lane] = (bf16_t)f2bf(rh);
                ET[s * 104 + lane] = (bf16_t)f2bf(rh); ah4[qq] = ah; bg4[qq] = bt * gC; kg4[qq] = kt * gC;
                const float bsum = wave_sum_dpp(rr * kk * rkv); if (lane == 0) bon[(size_t)s * 32] = bsum; }
            *(LAS u32x2*)(AL + lane * 40 + 8 * tw + 4 * hq) = pack4(ah4); *(LAS u32x2*)(HT + (32 + lane) * 40 + 8 * tw + 4 * hq) = pack4(bg4); *(LAS u32x2*)(ET + (32 + lane) * 104 + 64 + 8 * tw + 4 * hq) = pack4(kg4); }
        { const int zr = gtid >> 2, zc = 16 * (gtid & 3); LAS u32x4* zp = (LAS u32x4*)(ET + (32 + zr) * 104 + zc); zp[0] = (u32x4){0u, 0u, 0u, 0u}; zp[1] = (u32x4){0u, 0u, 0u, 0u}; }
        if (pr + 1 < npair) PRE_LOAD(pr + 1);
        float cva[32], cvb[32]; int cea = 0, cna = 0, cka = 0, ceb = 0, cnb = 0, ckb = 0;
        if (bgconv) { const int it0 = ((c.vcu * 32 + pr) * 8 + w) * 2;
            cea = it0 >> 12; { const int rem = it0 & 4095; cka = 64 * (rem >> 7); cna = 32 * (rem & 127); }
            ceb = (it0 + 1) >> 12; { const int rem = (it0 + 1) & 4095; ckb = 64 * (rem >> 7); cnb = 32 * (rem & 127); }
            cv_issue(p.in[I_W1] + (size_t)cea * D * 4096, 4096, D, cna, cka, lane, cva); cv_issue(p.in[I_W1] + (size_t)ceb * D * 4096, 4096, D, cnb, ckb, lane, cvb); }
        LBAR();
        if (tw == 0) ET[(32 + lane) * 104 + lane] = (bf16_t)f2bf(gC);
        { const int mt = tw;
#pragma unroll
          for (int nt = 0; nt < 4; ++nt) {
            f32x4 acc = tile_mm(X1 + 16 * mt * 72, 72, X2 + 16 * nt * 72, 72, 2, fr, fq, (f32x4){0.f, 0.f, 0.f, 0.f});
            const int n = 16 * nt + fr, m0 = 16 * mt + 4 * fq;
            if (mt < 2) { if (nt < 2) { const int t = n; f32x4 o;
#pragma unroll
                    for (int e = 0; e < 4; ++e) o[e] = (m0 + e < t) ? acc[e] : 0.f;
                    *(LAS f32x4*)(LBT + t * 36 + m0) = o; }
                else { const int t = n - 32; f32x4 o;
#pragma unroll
                    for (int e = 0; e < 4; ++e) o[e] = (m0 + e <= t) ? acc[e] : 0.f;
                    *(LAS u32x2*)(HT + t * 40 + m0) = pack4(o); } }
            else { const int s0 = m0 - 32;
                if (nt < 2) { const int t = n;
#pragma unroll
                    for (int e = 0; e < 4; ++e) AL[(64 + s0 + e) * 40 + t] = (bf16_t)f2bf((s0 + e < t) ? acc[e] : 0.f); }
                else { const int t = n - 32; f32x4 o;
#pragma unroll
                    for (int e = 0; e < 4; ++e) o[e] = (s0 + e <= t) ? acc[e] : 0.f;
                    *(LAS u32x2*)(ET + t * 104 + 64 + s0) = pack4(o); } } } }
        LBAR();
        if (gtid < 32) { const int hb = 16 * (gtid >> 4), sl = gtid & 15; float Tr[16];
#pragma unroll
            for (int t = 0; t < 16; ++t) { float a0 = (sl == t) ? 1.f : 0.f, a1 = 0.f, a2 = 0.f, a3 = 0.f;
#pragma unroll
                for (int m4 = 0; m4 < (t + 3) / 4; ++m4) { const f32x4 l = *(const LAS f32x4*)(LBT + (hb + t) * 36 + hb + 4 * m4);
                    if (4 * m4 + 0 < t) a0 += Tr[4 * m4 + 0] * l[0]; if (4 * m4 + 1 < t) a1 += Tr[4 * m4 + 1] * l[1]; if (4 * m4 + 2 < t) a2 += Tr[4 * m4 + 2] * l[2]; if (4 * m4 + 3 < t) a3 += Tr[4 * m4 + 3] * l[3]; }
                Tr[t] = (a0 + a1) + (a2 + a3); TF[(hb + sl) * 36 + hb + t] = Tr[t]; TT[(hb + t) * 40 + hb + sl] = (bf16_t)f2bf(Tr[t]);
                if (hb) TT[t * 40 + hb + sl] = 0; } }
        LBAR();
        { const int m = gtid >> 4, tl = gtid & 15; float x = 0.f;
#pragma unroll
            for (int n = 0; n < 16; ++n) x += LBT[(16 + n) * 36 + m] * TF[(16 + n) * 36 + 16 + tl];
            XB[m * 17 + tl] = x; }
        LBAR();
        { const int sr = gtid >> 4, tl = gtid & 15; float x = 0.f;
#pragma unroll
            for (int m = 0; m < 16; ++m) x += TF[sr * 36 + m] * XB[m * 17 + tl];
            TT[(16 + tl) * 40 + sr] = (bf16_t)f2bf(x); }
        LBAR();
        for (int id = tw; id < 12; id += 4) { const int tt = id / 6, nt = id % 6;
            const f32x4 acc = tile_mm(TT + 16 * tt * 40, 40, AL + 16 * nt * 40, 40, 1, fr, fq, (f32x4){0.f, 0.f, 0.f, 0.f});
            *(LAS u32x2*)(GI + (16 * nt + fr) * 40 + 16 * tt + 4 * fq) = pack4(acc); }
        LBAR();
        for (int id = tw; id < 36; id += 4) { const int nt = id / 6, mt = id % 6;
            const f32x4 acc = tile_mm(GI + 16 * nt * 40, 40, HT + 16 * mt * 40, 40, 1, fr, fq, (f32x4){0.f, 0.f, 0.f, 0.f});
            LAS u32x2* ep = (LAS u32x2*)(ET + (16 * mt + fr) * 104 + 16 * nt + 4 * fq); const u32x2 ev = *ep;
            f32x4 o; o[0] = acc[0] + bf2f(ev.x & 0xffffu); o[1] = acc[1] + bf2f(ev.x >> 16); o[2] = acc[2] + bf2f(ev.y & 0xffffu); o[3] = acc[3] + bf2f(ev.y >> 16);
            *ep = pack4(o); }
        LBAR();
        { bf16_t* fg = FG + (size_t)task * (SC_F * SC_F);
          for (int idx = gtid; idx < 96 * 12; idx += 256) { const int row = idx / 12, pc = idx % 12; *(u32x4*)(fg + row * 96 + 8 * pc) = *(const LAS u32x4*)(ET + row * 104 + 8 * pc); } }
        LBAR();
        if (bgconv) { cv_store8(cva, ws + WS_W1 + (size_t)cea * 4096 * D, D, cna, cka, lane); cv_store8(cvb, ws + WS_W1 + (size_t)ceb * 4096 * D, D, cnb, ckb, lane); }
    }
    if (!bgconv) {
        LBAR();
        for (int r = c.vcu * 8 + w; r < NEXP * MOE_W1E; r += c.G * 8) { const int e = r >> 12, rem = r & 4095; float cv[32]; cv_issue(p.in[I_W1] + (size_t)e * D * 4096, 4096, D, 32 * (rem & 127), 64 * (rem >> 7), lane, cv);
            cv_store8(cv, ws + WS_W1 + (size_t)e * 4096 * D, D, 32 * (rem & 127), 64 * (rem >> 7), lane); }
    }
    LBAR();
#undef PRE_LOAD
}
constexpr int SQ_BI = 0, SQ_BI_SZ = 64 * 104 * 2, SQ_YL = 2 * SQ_BI_SZ, SQ_YL_SZ = 32 * 64 * 4;
struct SeqSet { bf16x8 af[3][3]; u32x2 vimg, gimg; float bon; };
__device__ __forceinline__ void p4_seq(const Params& p, const Ctx& c, int bh) {
    unsigned char* ws = c.ws;
    const bf16_t* VZ = (const bf16_t*)(ws + WS_VZ); const bf16_t* GG = (const bf16_t*)(ws + WS_GG); const float* BON = (const float*)(ws + WS_YS);
    const bf16_t* FG = (const bf16_t*)(ws + WS_F) + (size_t)bh * SC_NCH * (SC_F * SC_F);
    bf16_t* YA = (bf16_t*)(ws + WS_YA);
    int tid_ = c.tid; asm volatile("" : "+v"(tid_));
    const int tid = tid_, lane = tid & 63, w = __builtin_amdgcn_readfirstlane(tid >> 6), fr = lane & 15, fq = lane >> 4;
    const int b = bh >> 5, h = bh & 31;
    const size_t base = (size_t)b * SEQ * D + h * 64;
    const int nt = w & 3, mg = w >> 2;
    LAS bf16_t* BI = (LAS bf16_t*)(c.lds + SQ_BI); LAS float* YL = (LAS float*)(c.lds + SQ_YL);
    const int vs = tid >> 4, vi4 = 4 * (tid & 15);
    const f32x4 lg4 = *(const f32x4*)(p.in[I_LNXG] + h * 64 + vi4), lb4 = *(const f32x4*)(p.in[I_LNXB] + h * 64 + vi4);
#define SEQ_LOAD(SET, CHN) do { const int chn_ = (CHN) < SC_NCH ? (CHN) : SC_NCH - 1; const bf16_t* fp = FG + (size_t)chn_ * (SC_F * SC_F); const size_t tk_ = (size_t)b * SEQ + (size_t)(chn_ * SC_C + vs); \
        asm volatile("global_load_dwordx2 %0, %1, off" : "=v"(SET.vimg) : "v"(VZ + tk_ * D + h * 64 + vi4) : "memory"); \
        _Pragma("unroll") for (int mi = 0; mi < 3; ++mi) _Pragma("unroll") for (int ks = 0; ks < 3; ++ks) \
            asm volatile("global_load_dwordx4 %0, %1, off" : "=v"(SET.af[mi][ks]) : "v"(fp + (16 * (3 * mg + mi) + fr) * SC_F + 32 * ks + 8 * fq) : "memory"); \
        asm volatile("global_load_dwordx2 %0, %1, off" : "=v"(SET.gimg) : "v"(GG + tk_ * D + h * 64 + vi4) : "memory"); \
        asm volatile("global_load_dword %0, %1, off" : "=v"(SET.bon) : "v"(BON + tk_ * 32 + h) : "memory"); } while (0)
#define SEQ_WAIT_AF(SET, N) asm volatile("s_waitcnt vmcnt(" #N ")" : "+v"(SET.af[0][0]), "+v"(SET.af[0][1]), "+v"(SET.af[0][2]), "+v"(SET.af[1][0]), "+v"(SET.af[1][1]), "+v"(SET.af[1][2]), \
        "+v"(SET.af[2][0]), "+v"(SET.af[2][1]), "+v"(SET.af[2][2]) :: "memory")
#define SEQ_WAIT_V(SET, N) asm volatile("s_waitcnt vmcnt(" #N ")" : "+v"(SET.vimg) :: "memory")
#define SEQ_WAIT_G(SET, N) asm volatile("s_waitcnt vmcnt(" #N ")" : "+v"(SET.gimg), "+v"(SET.bon), "+v"(SET.vimg) :: "memory")
#define SEQ_BODY(CH, CUR, NXT, NX2) do { const int ch = (CH), cb = ch & 1; \
        const LAS bf16_t* bi = BI + cb * (64 * 104); LAS bf16_t* bo = BI + (cb ^ 1) * (64 * 104); LAS float* yl = YL + cb * (32 * 64); \
        SEQ_LOAD(NX2, ch + 2); \
        bf16x8 bfr[3]; _Pragma("unroll") for (int ks = 0; ks < 3; ++ks) bfr[ks] = *(const LAS bf16x8*)(bi + (16 * nt + fr) * 104 + 32 * ks + 8 * fq); \
        SEQ_WAIT_AF(CUR, 28); \
        f32x4 acc[3]; _Pragma("unroll") for (int mi = 0; mi < 3; ++mi) { acc[mi] = (f32x4){0.f, 0.f, 0.f, 0.f}; \
            _Pragma("unroll") for (int ks = 0; ks < 3; ++ks) acc[mi] = __builtin_amdgcn_mfma_f32_16x16x32_bf16(CUR.af[mi][ks], bfr[ks], acc[mi], 0, 0, 0); } \
        _Pragma("unroll") for (int mi = 0; mi < 3; ++mi) { const int mt = 3 * mg + mi; \
            if (mt < 2) { _Pragma("unroll") for (int e = 0; e < 4; ++e) yl[(16 * mt + 4 * fq + e) * 64 + 16 * nt + fr] = acc[mi][e]; } \
            else *(LAS u32x2*)(bo + (16 * nt + fr) * 104 + 16 * (mt - 2) + 4 * fq) = pack4(acc[mi]); } \
        SEQ_WAIT_V(NXT, 24); \
        if (ch + 1 < SC_NCH) { bo[(vi4 + 0) * 104 + 64 + vs] = (bf16_t)(NXT.vimg.x & 0xffffu); bo[(vi4 + 1) * 104 + 64 + vs] = (bf16_t)(NXT.vimg.x >> 16); \
            bo[(vi4 + 2) * 104 + 64 + vs] = (bf16_t)(NXT.vimg.y & 0xffffu); bo[(vi4 + 3) * 104 + 64 + vs] = (bf16_t)(NXT.vimg.y >> 16); } \
        LBAR(); \
        SEQ_WAIT_G(CUR, 24); \
        { const f32x4 y4 = *(const LAS f32x4*)(yl + vs * 64 + vi4); float sm = (y4[0] + y4[1]) + (y4[2] + y4[3]); \
          sm = DPP_ADD(sm, 0xB1); sm = DPP_ADD(sm, 0x4E); sm = DPP_ADD(sm, 0x141); sm = DPP_ADD(sm, 0x140);     \
          const float mu = sm * (1.0f / 64.0f); const f32x4 d4 = y4 - mu; float q = (d4[0] * d4[0] + d4[1] * d4[1]) + (d4[2] * d4[2] + d4[3] * d4[3]); \
          q = DPP_ADD(q, 0xB1); q = DPP_ADD(q, 0x4E); q = DPP_ADD(q, 0x141); q = DPP_ADD(q, 0x140); \
          const float rstd = rsqrtf(q * (1.0f / 64.0f) + GN_EPS); \
          const float v0 = bf2f(CUR.vimg.x & 0xffffu), v1 = bf2f(CUR.vimg.x >> 16), v2 = bf2f(CUR.vimg.y & 0xffffu), v3 = bf2f(CUR.vimg.y >> 16); \
          const float g0 = bf2f(CUR.gimg.x & 0xffffu), g1 = bf2f(CUR.gimg.x >> 16), g2 = bf2f(CUR.gimg.y & 0xffffu), g3 = bf2f(CUR.gimg.y >> 16); \
          const float o0 = (d4[0] * rstd * lg4[0] + lb4[0] + CUR.bon * v0) * g0, o1 = (d4[1] * rstd * lg4[1] + lb4[1] + CUR.bon * v1) * g1; \
          const float o2 = (d4[2] * rstd * lg4[2] + lb4[2] + CUR.bon * v2) * g2, o3 = (d4[3] * rstd * lg4[3] + lb4[3] + CUR.bon * v3) * g3; \
          *(u32x2*)(YA + ((size_t)b * SEQ + (size_t)(ch * SC_C + vs)) * 2560 + h * 64 + vi4) = (u32x2){pk2(o0, o1), pk2(o2, o3)}; } } while (0)
    SeqSet sa, sb, sc;
    SEQ_LOAD(sa, 0); SEQ_LOAD(sb, 1);
    SEQ_WAIT_V(sa, 0);
    for (int idx = tid; idx < 64 * 8; idx += 512) *(LAS u32x4*)(BI + (idx >> 3) * 104 + 8 * (idx & 7)) = (u32x4){0u, 0u, 0u, 0u};
    BI[(vi4 + 0) * 104 + 64 + vs] = (bf16_t)(sa.vimg.x & 0xffffu); BI[(vi4 + 1) * 104 + 64 + vs] = (bf16_t)(sa.vimg.x >> 16);
    BI[(vi4 + 2) * 104 + 64 + vs] = (bf16_t)(sa.vimg.y & 0xffffu); BI[(vi4 + 3) * 104 + 64 + vs] = (bf16_t)(sa.vimg.y >> 16);
    LBAR();
    for (int c0 = 0; c0 < SC_NCH; c0 += 3) {
        SEQ_BODY(c0, sa, sb, sc);
        if (c0 + 1 < SC_NCH) SEQ_BODY(c0 + 1, sb, sc, sa);
        if (c0 + 2 < SC_NCH) SEQ_BODY(c0 + 2, sc, sa, sb);
    }
    asm volatile("s_waitcnt vmcnt(0)" ::: "memory");
    LBAR();
#undef SEQ_LOAD
#undef SEQ_BODY
#undef SEQ_WAIT_AF
#undef SEQ_WAIT_V
#undef SEQ_WAIT_G
}

__device__ __forceinline__ void p4_attn_task(const Ctx& c, int task) {
    unsigned char* ws = c.ws;
    const bf16_t* QR = (const bf16_t*)(ws + WS_QR); const bf16_t* KR = (const bf16_t*)(ws + WS_KR); const bf16_t* VR = (const bf16_t*)(ws + WS_VR);
    float* AO = (float*)(ws + WS_AO); float* LSE = (float*)(ws + WS_LSE);
    constexpr int VP = 280;
    LAS bf16_t* Vt = (LAS bf16_t*)c.lds;
    const int combo = task & 31, hh = (task >> 5) % 24, b = task / (32 * 24);
    const int g = hh >> 3, h = hh & 7;
    const int dil = g == 0 ? 1 : (g == 1 ? 4 : 16), nblk = 32 / dil;
    const int res = combo / nblk, blk = combo % nblk;
    int tid_ = c.tid; asm volatile("" : "+v"(tid_));
    const int tid = tid_, lane = tid & 63, w = __builtin_amdgcn_readfirstlane(tid >> 6);
    const int qq = lane & 15, g4 = lane >> 4, r0 = 16 * w;
    const size_t rowb = (size_t)(b * 24 + hh) * SEQ + (size_t)res * (SEQ / dil) + (size_t)blk * 128;
    bf16x8 qf[2], kf[9][2];
#pragma unroll
    for (int ks = 0; ks < 2; ++ks) qf[ks] = *(const bf16x8*)(QR + (rowb + r0 + qq) * 64 + 32 * ks + 8 * g4);
#pragma unroll
    for (int kt = 0; kt < 9; ++kt) { const bool kv = (blk > 0) || (w + kt >= 8);
#pragma unroll
        for (int ks = 0; ks < 2; ++ks) { kf[kt][ks] = (bf16x8){0, 0, 0, 0, 0, 0, 0, 0};
            if (kv) kf[kt][ks] = *(const bf16x8*)(KR + (rowb - 128 + 16 * (w + kt) + qq) * 64 + 32 * ks + 8 * g4); } }
    const int vki = tid >> 1, vdh = tid & 1;
    u32x4 vv[4];
    if (blk > 0 || vki >= 128) {
#pragma unroll
        for (int j = 0; j < 4; ++j) vv[j] = *(const u32x4*)(VR + (rowb - 128 + vki) * 64 + 32 * vdh + 8 * j); }
    else {
#pragma unroll
        for (int j = 0; j < 4; ++j) vv[j] = (u32x4){0u, 0u, 0u, 0u}; }
    __syncthreads();
#pragma unroll
    for (int j = 0; j < 4; ++j) { const unsigned wv[4] = {vv[j].x, vv[j].y, vv[j].z, vv[j].w};
#pragma unroll
        for (int e = 0; e < 8; ++e) Vt[(32 * vdh + 8 * j + e) * VP + vki] = (bf16_t)((wv[e >> 1] >> (16 * (e & 1))) & 0xffffu); }
    if (tid < 64) {
#pragma unroll
        for (int e = 0; e < 24; ++e) Vt[tid * VP + 256 + e] = 0; }
    f32x4 sc[10];
#pragma unroll
    for (int kt = 0; kt < 9; ++kt) { f32x4 a = (f32x4){0.f, 0.f, 0.f, 0.f};
#pragma unroll
        for (int ks = 0; ks < 2; ++ks) a = __builtin_amdgcn_mfma_f32_16x16x32_bf16(kf[kt][ks], qf[ks], a, 0, 0, 0);
        sc[kt] = a; }
    const int r = r0 + qq;
    float mx = -3.0e38f;
#pragma unroll
    for (int kt = 0; kt < 9; ++kt)
#pragma unroll
        for (int j = 0; j < 4; ++j) { const int ki = 16 * (w + kt) + 4 * g4 + j; const bool ok = (ki >= r) && (ki <= r + 128) && (blk > 0 || ki >= 128);
            const float sv = ok ? sc[kt][j] * 0.125f : -1.0e30f; sc[kt][j] = sv; mx = fmaxf(mx, sv); }
    mx = fmaxf(mx, __shfl_xor(mx, 16)); mx = fmaxf(mx, __shfl_xor(mx, 32));
    float den = 0.f;
#pragma unroll
    for (int kt = 0; kt < 9; ++kt)
#pragma unroll
        for (int j = 0; j < 4; ++j) { const float pexp = __expf(sc[kt][j] - mx); sc[kt][j] = pexp; den += pexp; }
    den += __shfl_xor(den, 16); den += __shfl_xor(den, 32);
    sc[9] = (f32x4){0.f, 0.f, 0.f, 0.f};
    __syncthreads();
    f32x4 oacc[4];
#pragma unroll
    for (int dt = 0; dt < 4; ++dt) oacc[dt] = (f32x4){0.f, 0.f, 0.f, 0.f};
#pragma unroll
    for (int cidx = 0; cidx < 5; ++cidx) {
        const f32x4 p0 = sc[2 * cidx], p1 = sc[2 * cidx + 1];
        u32x4 pw; pw.x = pk2(p0[0], p0[1]); pw.y = pk2(p0[2], p0[3]); pw.z = pk2(p1[0], p1[1]); pw.w = pk2(p1[2], p1[3]);
        const bf16x8 pf = __builtin_bit_cast(bf16x8, pw);
        const int kbase = 16 * (w + 2 * cidx) + 4 * g4;
#pragma unroll
        for (int dt = 0; dt < 4; ++dt) { const LAS bf16_t* vp = Vt + (16 * dt + qq) * VP + kbase;
            const u32x2 lo = *(const LAS u32x2*)vp, hi = *(const LAS u32x2*)(vp + 16);
            u32x4 vw; vw.x = lo.x; vw.y = lo.y; vw.z = hi.x; vw.w = hi.y;
            oacc[dt] = __builtin_amdgcn_mfma_f32_16x16x32_bf16(__builtin_bit_cast(bf16x8, vw), pf, oacc[dt], 0, 0, 0); }
    }
    const float inv = 1.0f / den;
    const size_t tok = (size_t)b * SEQ + (size_t)(blk * 128 + r) * dil + res;
#pragma unroll
    for (int dt = 0; dt < 4; ++dt) *(f32x4*)(AO + ((size_t)g * M + tok) * 512 + h * 64 + 16 * dt + 4 * g4) = oacc[dt] * inv;
    if (g4 == 0) LSE[((size_t)g * M + tok) * 8 + h] = mx + __logf(den);
}

struct KvUnitOrder {
    static constexpr bool GATHER = false;
    const char* A; const char* Bt; int q;
    __device__ bool next(int i, pg8::Unit& u) const {
        if (i != 0) return false;
        const int pm = q & 3, pn = q >> 2;
        u.A = A + (size_t)pm * 256 * D * 2; u.B = Bt + (size_t)pn * 256 * D * 2; u.orow = 256 * pm; u.ocol = 256 * pn; u.aux = 0; u.aux2 = 0; u.valid = 256; return true;
    }
    __device__ __forceinline__ const int* rows(const pg8::Unit&) const { return nullptr; }
};
constexpr int Q_KV = 64, Q_ATT = 3072, Q_TOTAL = Q_KV + Q_ATT + MOE_CONV_GROUPS;
__device__ __forceinline__ void p4_queue(const Params& p, const Ctx& c, volatile LAS unsigned* qslot) {
    unsigned* qc = (unsigned*)(c.ws + WS_CTL) + CW_Q;
    for (;;) {
        __syncthreads();
        if (c.tid == 0) qslot[0] = __hip_atomic_fetch_add(qc, 1u, __ATOMIC_RELAXED, __HIP_MEMORY_SCOPE_AGENT);
        __syncthreads();
        const unsigned it = qslot[0];
        if (it >= (unsigned)Q_TOTAL) break;
        if (it < (unsigned)Q_KV) { const int qi = __builtin_amdgcn_readfirstlane((int)it);
            KvUnitOrder S{(const char*)(c.ws + WS_MEMB), (const char*)(c.ws + WS_WKV), qi};
            pg8::EpiKV E{(bf16_t*)(c.ws + WS_KB), (bf16_t*)(c.ws + WS_VT)};
            pg8::gemm_phase<pg8::EpiKV, KvUnitOrder>(c.lds, pg8::Gemm{D, D, D}, S, E); }
        else if (it < (unsigned)(Q_KV + Q_ATT)) p4_attn_task(c, (int)it - Q_KV); else conv_group(p, c, (int)it - Q_KV - Q_ATT);
    }
}

__device__ __forceinline__ void p5_post(const Params& p, const Ctx& c) {
    unsigned char* ws = c.ws;
    const float* AO = (const float*)(ws + WS_AO); const float* LSE = (const float*)(ws + WS_LSE);
    bf16_t* YB = (bf16_t*)(ws + WS_YA);
    const int gw = c.vcu * 8 + c.wave, NGW = c.G * 8, lane = c.lane;
    for (int it = gw; it < M * 8; it += NGW) {
        const int t = it >> 3, h = it & 7;
        const float l0 = LSE[((size_t)0 * M + t) * 8 + h], l1 = LSE[((size_t)1 * M + t) * 8 + h], l2 = LSE[((size_t)2 * M + t) * 8 + h];
        const float mxl = fmaxf(l0, fmaxf(l1, l2)); const float e0 = __expf(l0 - mxl), e1 = __expf(l1 - mxl), e2 = __expf(l2 - mxl); const float inv = 1.0f / (e0 + e1 + e2);
        const size_t o = (size_t)t * 512 + h * 64 + lane;
        const float v = (e0 * AO[o] + e1 * AO[(size_t)M * 512 + o] + e2 * AO[(size_t)2 * M * 512 + o]) * inv;
        YB[(size_t)t * 2560 + 2048 + h * 64 + lane] = (bf16_t)f2bf(v);
    }
}

__device__ __forceinline__ void ln_rows(const Ctx& c, const float* in, const float* gam, const float* bet, float* outf, f32x2* stats, unsigned char* outq) {
    const int gw = c.vcu * 8 + c.wave, NGW = c.G * 8, lane = c.lane;
    for (int m = gw; m < M; m += NGW) {
        const f32x4* xr = (const f32x4*)(in + (size_t)m * D) + lane;
        f32x4 v[8]; float s = 0.f;
#pragma unroll
        for (int j = 0; j < 8; ++j) { v[j] = xr[64 * j]; s += (v[j][0] + v[j][1]) + (v[j][2] + v[j][3]); }
        const float mean = wave_sum(s) * (1.0f / D); float s2 = 0.f;
#pragma unroll
        for (int j = 0; j < 8; ++j) { v[j] = v[j] - mean; s2 += (v[j][0] * v[j][0] + v[j][1] * v[j][1]) + (v[j][2] * v[j][2] + v[j][3] * v[j][3]); }
        const float rstd = rsqrtf(wave_sum(s2) * (1.0f / D) + LN_EPS);
        if (stats && lane == 0) stats[m] = (f32x2){mean, rstd};
#pragma unroll
        for (int j = 0; j < 8; ++j) { const int col = 4 * lane + 256 * j; const f32x4 gv = *(const f32x4*)(gam + col), bv = *(const f32x4*)(bet + col);
            const f32x4 o = v[j] * rstd * gv + bv;
            if (outf) *(f32x4*)(outf + (size_t)m * D + col) = o;
            if (outq) *(unsigned*)(outq + (size_t)m * D + col) = pk4_fp8(o[0], o[1], o[2], o[3]); }
    }
}

__device__ __forceinline__ void p15_router(const Params& p, const Ctx& c) {
    unsigned char* ws = c.ws;
    const float* T2 = (const float*)(ws + WS_T2); const f32x2* ST2 = (const f32x2*)(ws + WS_ST2); const float* g2 = p.in[I_LN2G]; const float* b2 = p.in[I_LN2B]; const float* RW = p.in[I_RW]; const float* RB = p.in[I_RB];
    unsigned* cnt = (unsigned*)(ws + WS_CTL) + CW_CNT; int* LIST = (int*)(ws + WS_LIST); int* ROWI = (int*)(ws + WS_ROWI); float* TOPW = (float*)(ws + WS_TOPW);
    LAS float* scr = (LAS float*)(c.lds + c.wave * 8192);
    const int gw = c.vcu * 8 + c.wave, NGW = c.G * 8, lane = c.lane, li = lane & 31, lk = lane >> 5;
    for (int tb = gw; tb < M / 32; tb += NGW) {
        const int t0 = tb * 32;
        f32x16 acc;
#pragma unroll
        for (int j = 0; j < 16; ++j) acc[j] = 0.f;
        const float* xa = T2 + (size_t)(t0 + li) * D + 4 * lk; const f32x2 st = ST2[t0 + li];
        const float* wb = RW + (size_t)(4 * lk) * 32 + li;
        for (int kb = 0; kb < D / 8; ++kb) {
            const f32x4 a = ((*(const f32x4*)(xa + 8 * kb) - st.x) * st.y) * *(const f32x4*)(g2 + 8 * kb + 4 * lk) + *(const f32x4*)(b2 + 8 * kb + 4 * lk);
            const float b0 = wb[(size_t)(8 * kb + 0) * 32], b1 = wb[(size_t)(8 * kb + 1) * 32], b2 = wb[(size_t)(8 * kb + 2) * 32], b3 = wb[(size_t)(8 * kb + 3) * 32];
            acc = __builtin_amdgcn_mfma_f32_32x32x2f32(a[0], b0, acc, 0, 0, 0);
            acc = __builtin_amdgcn_mfma_f32_32x32x2f32(a[1], b1, acc, 0, 0, 0);
            acc = __builtin_amdgcn_mfma_f32_32x32x2f32(a[2], b2, acc, 0, 0, 0);
            acc = __builtin_amdgcn_mfma_f32_32x32x2f32(a[3], b3, acc, 0, 0, 0);
        }
        const float bias = RB[li];
#pragma unroll
        for (int rg = 0; rg < 16; ++rg) { const int row = (rg & 3) + 8 * (rg >> 2) + 4 * lk; scr[row * 33 + li] = acc[rg] + bias; }
        LDS_WAIT(); asm volatile("" ::: "memory");
        if (lane < 32) {
            float lv[32];
#pragma unroll
            for (int e = 0; e < 32; ++e) lv[e] = scr[lane * 33 + e];
            int id[4]; float tv[4];
#pragma unroll
            for (int k = 0; k < 4; ++k) { float best = -3.0e38f; int bi = 0;
#pragma unroll
                for (int e = 0; e < 32; ++e) { const bool tk = lv[e] > best; best = tk ? lv[e] : best; bi = tk ? e : bi; }
                id[k] = bi; tv[k] = best;
#pragma unroll
                for (int e = 0; e < 32; ++e) lv[e] = (e == bi) ? -3.0e38f : lv[e]; }
            const float e1 = __expf(tv[1] - tv[0]), e2 = __expf(tv[2] - tv[0]), e3 = __expf(tv[3] - tv[0]); const float inv = 1.0f / (1.0f + e1 + e2 + e3);
            const float wv[4] = {inv, e1 * inv, e2 * inv, e3 * inv};
            const int t = t0 + lane;
#pragma unroll
            for (int k = 0; k < 4; ++k) { const unsigned slot = __hip_atomic_fetch_add(cnt + id[k], 1u, __ATOMIC_RELAXED, __HIP_MEMORY_SCOPE_AGENT);
                LIST[(size_t)id[k] * CAP + slot] = t; ROWI[(size_t)t * 4 + k] = id[k] * CAP + (int)slot; TOPW[(size_t)t * 4 + k] = wv[k]; }
        }
        LDS_WAIT(); asm volatile("" ::: "memory");
    }
}

__device__ __forceinline__ void moe_table(const Ctx& c, LAS int* tab) {
    if (c.tid == 0) { unsigned* cnt = (unsigned*)(c.ws + WS_CTL) + CW_CNT; int ts = 0;
        for (int e = 0; e < NEXP; ++e) { const int n = (int)__hip_atomic_load(cnt + e, __ATOMIC_RELAXED, __HIP_MEMORY_SCOPE_AGENT); tab[e] = n; tab[32 + e] = ts; ts += (n + 255) >> 8; }
        tab[64] = ts; }
    __syncthreads();
}

__device__ __forceinline__ void p18_combine(const Params& p, const Ctx& c, const LAS int* tab) {
    unsigned char* ws = c.ws;
    const float* T2 = (const float*)(ws + WS_T2); const f32x2* ST2 = (const f32x2*)(ws + WS_ST2); const float* g2 = p.in[I_LN2G]; const float* b2 = p.in[I_LN2B]; const bf16_t* Y = (const bf16_t*)(ws + WS_Y); const int* ROWI = (const int*)(ws + WS_ROWI); const float* TOPW = (const float*)(ws + WS_TOPW);
    const float* gam = p.in[I_LN3G]; const float* bet = p.in[I_LN3B];
    const int gw = c.vcu * 8 + c.wave, NGW = c.G * 8, lane = c.lane;
    for (int m = gw; m < M; m += NGW) {
        f32x4 v[8];
        const f32x4* xr = (const f32x4*)(T2 + (size_t)m * D) + lane; const f32x2 st = ST2[m];
#pragma unroll
        for (int j = 0; j < 8; ++j) { const int col = 4 * lane + 256 * j; v[j] = (((xr[64 * j] - st.x) * st.y) * *(const f32x4*)(g2 + col) + *(const f32x4*)(b2 + col)) * DN_ALPHA; }
#pragma unroll
        for (int k = 0; k < 4; ++k) { const int ri = ROWI[(size_t)m * 4 + k]; const float gt = TOPW[(size_t)m * 4 + k]; const int e = ri >> 14, slot = ri & (CAP - 1);
            const u32x2* yr = (const u32x2*)(Y + ((size_t)tab[32 + e] * 256 + slot) * D) + lane;
#pragma unroll
            for (int j = 0; j < 8; ++j) { const u32x2 yw = yr[64 * j]; v[j] = v[j] + (f32x4){bf2f(yw.x & 0xffffu), bf2f(yw.x >> 16), bf2f(yw.y & 0xffffu), bf2f(yw.y >> 16)} * gt; } }
        float s = 0.f;
#pragma unroll
        for (int j = 0; j < 8; ++j) s += (v[j][0] + v[j][1]) + (v[j][2] + v[j][3]);
        const float mean = wave_sum(s) * (1.0f / D); float s2 = 0.f;
#pragma unroll
        for (int j = 0; j < 8; ++j) { v[j] = v[j] - mean; s2 += (v[j][0] * v[j][0] + v[j][1] * v[j][1]) + (v[j][2] * v[j][2] + v[j][3] * v[j][3]); }
        const float rstd = rsqrtf(wave_sum(s2) * (1.0f / D) + LN_EPS);
#pragma unroll
        for (int j = 0; j < 8; ++j) { const int col = 4 * lane + 256 * j; const f32x4 gv = *(const f32x4*)(gam + col), bv = *(const f32x4*)(bet + col);
            *(f32x4*)(p.out + (size_t)m * D + col) = v[j] * rstd * gv + bv; }
    }
}

constexpr int NPHASE = 19;
__global__ void __launch_bounds__(512, 2) fwd(Params p) {
    extern __shared__ __attribute__((aligned(16))) unsigned char lds_raw[];
    LAS unsigned char* lds = (LAS unsigned char*)lds_raw;
    Ctx c; c.tid = threadIdx.x; c.lane = c.tid & 63; c.wave = __builtin_amdgcn_readfirstlane(c.tid >> 6); c.G = gridDim.x;
    { const int bx = blockIdx.x; c.vcu = (c.G % 8 == 0) ? (bx % 8) * (c.G / 8) + bx / 8 : bx; }
    c.lds = lds; c.ws = p.ws;
    unsigned char* ws = p.ws;
    volatile LAS unsigned* MISC = (volatile LAS unsigned*)(lds + MISC_OFF);
    LAS int* tab = (LAS int*)(lds + MISC_OFF + 1024);
    if (c.tid < 64) MISC[c.tid] = 0u;
    __syncthreads();
    unsigned* ctl = (unsigned*)(ws + WS_CTL);
    XcdBarrier bar; bar.bar = ctl + CW_BAR + p.li * XCD_BAR_WORDS; bar.x = 0; bar.st = MISC + 8;
    if (N_LAUNCH_MODE == 1) bar = xcd_barrier_post(ctl + CW_BAR + p.li * XCD_BAR_WORDS, MISC + 8);
    const int lo = p.ph_lo, hi = p.ph_hi, bx = blockIdx.x;
#ifndef PHMASK
#define PHMASK 0xFFFFFFFFu
#endif
#define IN(k) (((PHMASK >> (k)) & 1u) && lo <= (k) && (k) < hi)
#define SEAM(k) do { if (N_LAUNCH_MODE == 1 && IN((k) + 1)) xcd_barrier(bar); } while (0)

    if (IN(0)) { p0_prologue(p, c); SEAM(0); }

    if (IN(1)) {
        { pg8::StaticOrder S; S.init(ws + WS_XB, ws + WS_WIN, M, ATT0, D, D, c.G, bx);
          pg8::EpiBf16 E{(bf16_t*)(ws + WS_PROJ), PC, 1.0f};
          pg8::gemm_phase<pg8::EpiBf16, pg8::StaticOrder>(lds, pg8::Gemm{D, D, D}, S, E); }
        { pg8::StaticOrder S; S.init(ws + WS_XQ, ws + WS_WIN8, M, PC - ATT0, D, D, c.G, bx, 1);
          pg8::EpiBf16 E{(bf16_t*)(ws + WS_PROJ) + ATT0, PC, 1.0f};
          pg8::gemm_phase<pg8::EpiBf16, pg8::StaticOrder, true, true>(lds, pg8::Gemm{D, D, D}, S, E); }
        SEAM(1);
    }
    if (IN(2)) { p2_prep(p, c); SEAM(2); }

    if (IN(3)) {
#ifndef P3M
#define P3M 15
#endif
        if (P3M & 1) { pg8::StaticOrder S; S.init(ws + WS_LIN, ws + WS_WUP, M, D, 768, 256, c.G, bx);
          pg8::EpiDecay E{(float*)(ws + WS_DEC), p.in[I_W0]};
          pg8::gemm_phase<pg8::EpiDecay, pg8::StaticOrder>(lds, pg8::Gemm{256, 768, 256}, S, E); }
        if (P3M & 2) { pg8::StaticOrder S; S.init(ws + WS_LIN + 512, ws + WS_AUP, M, D, 768, 256, c.G, bx);
          pg8::EpiIclr E{p.in[I_A0], p.in[I_KK], p.in[I_KA], (const bf16_t*)(ws + WS_KZ), (const float*)(ws + WS_KNORM), (bf16_t*)(ws + WS_KP), (bf16_t*)(ws + WS_AN), (bf16_t*)(ws + WS_BB)};
          pg8::gemm_phase<pg8::EpiIclr, pg8::StaticOrder>(lds, pg8::Gemm{256, 768, 256}, S, E); }
        if (P3M & 4) { pg8::StaticOrder S; S.init(ws + WS_LIN + 1024, ws + WS_GUP, M, D, 768, 256, c.G, bx);
          pg8::EpiBf16 E{(bf16_t*)(ws + WS_GG), D, 1.0f};
          pg8::gemm_phase<pg8::EpiBf16, pg8::StaticOrder>(lds, pg8::Gemm{256, 768, 256}, S, E); }
        SEAM(3);
    }
    if (IN(4)) {
        p4_pre(p, c);
        xcd_barrier(bar);
        for (int bh = c.vcu; bh < 128; bh += c.G) p4_seq(p, c, bh);
        p4_queue(p, c, MISC + 16);
        SEAM(4);
    }
    if (IN(5)) { p5_post(p, c); }

    if (IN(6)) {
        pg8::StaticOrder S; S.init(ws + WS_YA, ws + WS_PA, M, D, 2560, 2560, c.G, bx);
        pg8::EpiGateFused E{(const bf16_t*)(ws + WS_PROJ), (bf16_t*)(ws + WS_MERGED)};
        pg8::gemm_phase<pg8::EpiGateFused, pg8::StaticOrder>(lds, pg8::Gemm{2560, 2560, 2560}, S, E);
        SEAM(6);
    }
    if (IN(7)) { }
    if (IN(8)) {
        pg8::StaticOrder S; S.init(ws + WS_MERGED, ws + WS_WOUT, M, D, D, D, c.G, bx);
        pg8::EpiF32 E{(float*)(ws + WS_T1), D, nullptr, 0, p.in[I_X], DN_ALPHA};
        pg8::gemm_phase<pg8::EpiF32, pg8::StaticOrder>(lds, pg8::Gemm{D, D, D}, S, E);
        SEAM(8);
    }
    if (IN(9)) { ln_rows(c, (const float*)(ws + WS_T1), p.in[I_LN1G], p.in[I_LN1B], nullptr, (f32x2*)(ws + WS_ST1), ws + WS_X1B); SEAM(9); }

    if (IN(10)) {
        pg8::StaticOrder S; S.init(ws + WS_X1B, ws + WS_WQ, M, D, D, D, c.G, bx, 1);
        pg8::EpiBf16 E{(bf16_t*)(ws + WS_Q), D, 0.04419417382415922f};
        pg8::gemm_phase<pg8::EpiBf16, pg8::StaticOrder, true, true>(lds, pg8::Gemm{D, D, D}, S, E);
        SEAM(10);
    }
    if (IN(11)) {
        ScoreOrder S{(const char*)(ws + WS_Q), (const char*)(ws + WS_KB), c.G, bx};
        pg8::EpiSoftmax E{(bf16_t*)(ws + WS_PP)};
        pg8::gemm_phase<pg8::EpiSoftmax, ScoreOrder, false>(lds, pg8::Gemm{512, D, D}, S, E);
        SEAM(11);
    }
    if (IN(12)) {
        PvOrder S{(const char*)(ws + WS_PP), (const char*)(ws + WS_VT), c.G, bx};
        pg8::EpiBf16 E{(bf16_t*)(ws + WS_OC), D, 1.0f};
        pg8::gemm_phase<pg8::EpiBf16, PvOrder>(lds, pg8::Gemm{256, 256, 256}, S, E);
        SEAM(12);
    }
    if (IN(13)) {
        pg8::StaticOrder S; S.init(ws + WS_OC, ws + WS_WO, M, D, D, D, c.G, bx);
        pg8::EpiResLn E{(float*)(ws + WS_T2), (const float*)(ws + WS_T1), (const f32x2*)(ws + WS_ST1), p.in[I_LN1G], p.in[I_LN1B], DN_ALPHA};
        pg8::gemm_phase<pg8::EpiResLn, pg8::StaticOrder>(lds, pg8::Gemm{D, D, D}, S, E);
        SEAM(13);
    }
    if (IN(14)) { ln_rows(c, (const float*)(ws + WS_T2), p.in[I_LN2G], p.in[I_LN2B], nullptr, (f32x2*)(ws + WS_ST2), ws + WS_X2B); SEAM(14); }
    if (IN(15)) { p15_router(p, c); SEAM(15); }

    if (IN(16)) {
        moe_table(c, tab);
        MoeOrder<true, 16> S{tab, (const char*)(ws + WS_X2B), (const char*)(ws + WS_W1), (const int*)(ws + WS_LIST), (size_t)4096 * D, D, c.G, bx};
        pg8::EpiSwiglu E{p.in[I_B1], (bf16_t*)(ws + WS_H)};
        pg8::gemm_phase<pg8::EpiSwiglu, MoeOrder<true, 16>, true, true>(lds, pg8::Gemm{D, D, D}, S, E);
        SEAM(16);
    }
    if (IN(17)) {
        moe_table(c, tab);
        MoeOrder<false, 8> S{tab, (const char*)(ws + WS_H), (const char*)(ws + WS_W2), (const int*)(ws + WS_LIST), (size_t)D * DFF, DFF, c.G, bx};
        pg8::EpiBf16Bias E{(bf16_t*)(ws + WS_Y), D, p.in[I_B2], D};
        pg8::gemm_phase<pg8::EpiBf16Bias, MoeOrder<false, 8>, true, true>(lds, pg8::Gemm{DFF, DFF, DFF}, S, E);
        SEAM(17);
    }
    if (IN(18)) { moe_table(c, tab); p18_combine(p, c, tab); }
#undef IN
#undef SEAM
}

extern "C" void kernel_launch(void* const* d_in, const int* in_sizes, int n_in, void* d_out, int out_size, void* d_ws, size_t ws_size, hipStream_t stream) {
    static int grid = 0;
    if (grid == 0) {
        if (n_in != 32 || out_size != M * D || ws_size < WS_END) { fprintf(stderr, "kernel_launch: expected 32 inputs, %d outputs, >= %zu bytes of workspace; got %d, %d, %zu\n", M * D, (size_t)WS_END, n_in, out_size, ws_size); grid = -1; return; }
        int dev = 0, cus = 0, per_cu = 0;
        if (hipGetDevice(&dev) != hipSuccess || hipDeviceGetAttribute(&cus, hipDeviceAttributeMultiprocessorCount, dev) != hipSuccess) { grid = -1; return; }
        if (hipFuncSetAttribute((const void*)fwd, hipFuncAttributeMaxDynamicSharedMemorySize, LDS_BYTES) != hipSuccess) { fprintf(stderr, "kernel_launch: hipFuncSetAttribute failed\n"); grid = -1; return; }
        if (hipOccupancyMaxActiveBlocksPerMultiprocessor(&per_cu, (const void*)fwd, 512, LDS_BYTES) != hipSuccess || per_cu < 1) fprintf(stderr, "kernel_launch: occupancy query reports %d\n", per_cu);
        (void)hipGetLastError();
        grid = cus;
        if (grid != 256) fprintf(stderr, "kernel_launch: %d CUs; this kernel is built for 256\n", grid);
    }
    if (grid < 0) return;
    (void)hipMemsetAsync((char*)d_ws + WS_CTL, 0, CTL_ZERO_BYTES, stream);
    Params p{};
    for (int i = 0; i < 32; ++i) p.in[i] = (const float*)d_in[i];
    p.out = (float*)d_out; p.ws = (unsigned char*)d_ws;
#if defined(TIMING_REPEAT_LO)
    { const int cuts[4][2] = {{0, TIMING_REPEAT_HI}, {TIMING_REPEAT_LO, TIMING_REPEAT_HI}, {TIMING_REPEAT_HI, NPHASE}, {0, 0}};
      for (int li = 0; li < 3; ++li) { if (cuts[li][0] >= cuts[li][1]) continue; p.ph_lo = cuts[li][0]; p.ph_hi = cuts[li][1]; p.li = li; hipLaunchKernelGGL(fwd, dim3(grid), dim3(512), LDS_BYTES, stream, p); } }
#else
    if (N_LAUNCH_MODE == 1) { p.ph_lo = 0; p.ph_hi = NPHASE; hipLaunchKernelGGL(fwd, dim3(grid), dim3(512), LDS_BYTES, stream, p); }
    else for (int k = 0; k < NPHASE; ++k) { p.ph_lo = k; p.ph_hi = k + 1; hipLaunchKernelGGL(fwd, dim3(grid), dim3(512), LDS_BYTES, stream, p); }
#endif
}
```

```cpp
#include <hip/hip_runtime.h>
#include <cstdio>
#include <cstdint>

#define LAS __attribute__((address_space(3)))
#define GAS __attribute__((address_space(1)))
typedef unsigned short bf16_t;
typedef short bf16x8 __attribute__((ext_vector_type(8)));
typedef float f32x4 __attribute__((ext_vector_type(4)));
typedef float f32x2 __attribute__((ext_vector_type(2)));
typedef float f32x16 __attribute__((ext_vector_type(16)));
typedef unsigned u32x4 __attribute__((ext_vector_type(4)));
typedef unsigned u32x2 __attribute__((ext_vector_type(2)));

#ifndef N_LAUNCH_MODE
#define N_LAUNCH_MODE 1
#endif

constexpr int M = 16384, D = 2048, SEQ = 4096, NBATCH = 4;
constexpr int RWC = 6592;
constexpr int PC = 15360;
constexpr int ATTV2 = 6656, ATT0 = 7168, GATE0 = 11264;
constexpr int NEXP = 32, DFF = 2048, CAP = 16384;
constexpr int HROWS = 65536 + 32 * 256;
constexpr float LN_EPS = 1e-5f, GN_EPS = 64e-5f;
constexpr float DN_ALPHA = 1.189207115002721f;

__device__ __forceinline__ float bf2f(unsigned v) { return __uint_as_float(v << 16); }
typedef __bf16 bf16x2_t __attribute__((ext_vector_type(2)));
__device__ __forceinline__ unsigned pk2(float lo, float hi) { const bf16x2_t r = __builtin_convertvector((f32x2){lo, hi}, bf16x2_t); return __builtin_bit_cast(unsigned, r); }
__device__ __forceinline__ unsigned f2bf(float f) { return pk2(f, 0.f) & 0xffffu; }
typedef int v4i __attribute__((ext_vector_type(4)));
typedef int v8i __attribute__((ext_vector_type(8)));
__device__ __forceinline__ unsigned pk4_fp8(float a, float b, float c, float d) { int r = __builtin_amdgcn_cvt_pk_fp8_f32(a, b, 0, false); r = __builtin_amdgcn_cvt_pk_fp8_f32(c, d, r, true); return (unsigned)r; }
__device__ __forceinline__ float sigmoidf_(float x) { return __builtin_amdgcn_rcpf(1.0f + __expf(-x)); }
__device__ __forceinline__ float wave_sum(float v) {
#pragma unroll
    for (int o = 1; o < 64; o <<= 1) v += __shfl_xor(v, o);
    return v;
}
#define LDS_WAIT() asm volatile("s_waitcnt lgkmcnt(0)" ::: "memory")
#define VM_WAIT() asm volatile("s_waitcnt vmcnt(0)" ::: "memory")

namespace pg8 {
#define PG8_LAS __attribute__((address_space(3)))
constexpr int BM = 256, BK = 64, HALF = 128, HTB = HALF * BK * 2, STAGE_BYTES = 8 * HTB, NXCD = 8, WGM = 8;

__host__ __device__ __forceinline__ int lds_byte(int r, int c) { const int st = (r >> 4) * 2 + (c >> 5), rr = r & 15, cc = c & 31, ob = rr * 64 + cc * 2; return st * 1024 + (ob ^ (((ob >> 9) & 1) << 5)); }
__host__ __device__ __forceinline__ void stage_rc(int b, int& R, int& C) { const int st = b / 1024, sb = b % 1024, swz = sb ^ (((sb >> 9) & 1) << 5); R = (st >> 1) * 16 + swz / 64; C = (st & 1) * 32 + (swz % 64) / 2; }
__host__ __device__ __forceinline__ int perm32(int rho) { const int n = rho >> 4, i = rho & 15; return 8 * (i >> 2) + 4 * n + (i & 3); }

struct Unit { const char* A; const char* B; int orow, ocol, aux, aux2, valid; };
struct Gemm { int K, lda, ldb; };

struct StaticOrder {
    static constexpr bool GATHER = false;
    const char* A; const char* Bt; size_t ta, tb;
    int nM, nN, nwg, G, c;
    __device__ void init(const void* A_, const void* Bt_, int M_, int N_, int lda, int ldb, int G_, int c_, int esz = 2) { A = (const char*)A_; Bt = (const char*)Bt_; ta = (size_t)BM * lda * esz; tb = (size_t)BM * ldb * esz; nM = M_ / BM; nN = N_ / BM; nwg = nM * nN; G = G_; c = c_; }
    __device__ bool next(int i, Unit& u) const {
        const long L = (long)i * G + c; if (c < 0 || L >= nwg) return false;
        int wgid = (int)L; { const int q = nwg / NXCD, r = nwg % NXCD, xcd = wgid % NXCD, off = wgid / NXCD; wgid = (xcd < r ? xcd * (q + 1) : r * (q + 1) + (xcd - r) * q) + off; }
        const int nig = WGM * nN, gid = wgid / nig, fm = gid * WGM, gsz = (nM - fm) < WGM ? (nM - fm) : WGM;
        const int pm = fm + ((wgid % nig) % gsz), pn = (wgid % nig) / gsz;
        u.A = A + (size_t)pm * ta; u.B = Bt + (size_t)pn * tb; u.orow = pm * BM; u.ocol = pn * BM; u.aux = 0; u.aux2 = 0; u.valid = BM; return true;
    }
    __device__ __forceinline__ const int* rows(const Unit&) const { return nullptr; }
};

__device__ __forceinline__ unsigned cvt_pk_bf16(float lo, float hi) { return ::pk2(lo, hi); }

template <class Epi, class Sched, bool ALIGN_EPI = true, bool FP8 = false>
__device__ __forceinline__ void gemm_phase(PG8_LAS unsigned char* lds, const Gemm g, const Sched& S, const Epi& E) {
    const int tid = threadIdx.x, wid = __builtin_amdgcn_readfirstlane(tid >> 6), lane = tid & 63, wr = wid >> 2, wc = wid & 3, fr = lane & 15, fq = lane >> 4;
    constexpr int ES = FP8 ? 1 : 2;
    int sclW = 0, sclX = 0;
    if constexpr (FP8) { asm volatile("v_mov_b32 %0, 0x79797979\n\tv_mov_b32 %1, 0x7f7f7f7f" : "=v"(sclW), "=v"(sclX)); }
    const int K = g.K, nt = K * ES / (BK * 2);
    unsigned voffA[2], voffB[2]; int Rr[2], Cc[2];
#pragma unroll
    for (int i = 0; i < 2; ++i) { int R, C; stage_rc(tid * 16 + i * 8192, R, C); const int Rb = Epi::PERM ? ((R & ~31) + perm32(R & 31)) : R; Rr[i] = R; Cc[i] = C;
        voffA[i] = (unsigned)(R * g.lda * ES + C * 2); voffB[i] = (unsigned)(Rb * g.ldb * ES + C * 2); }
    const size_t kstep = (size_t)(BK * 2);
    const size_t hstepA = (size_t)HALF * g.lda * ES, hstepB = (size_t)HALF * g.ldb * ES;
    const unsigned ldsw = (unsigned)wid * 1024u;
    const int aoff = lds_byte(wr * 64 + fr, fq * 8), boff = lds_byte(wc * 32 + fr, fq * 8);
    unsigned vAc[2][2], vAn[2][2];
#define PG8_SA(b, h) (((b) * 2 + (h)) * HTB)
#define PG8_SB(b, h) ((4 + (b) * 2 + (h)) * HTB)
#define PG8_STAGE(bufoff, gbase, voff) do { _Pragma("unroll") for (int _i = 0; _i < 2; ++_i) \
        __builtin_amdgcn_global_load_lds((const unsigned*)((const char*)(gbase) + (voff)[_i]), (PG8_LAS unsigned*)(lds + (bufoff) + ldsw + _i * 8192), 16, 0, 0); } while (0)
#define PG8_STAGE_A(bufoff, kbase, h, nx) do { if constexpr (Sched::GATHER) { unsigned _v[2] = {(nx) ? vAn[h][0] : vAc[h][0], (nx) ? vAn[h][1] : vAc[h][1]}; PG8_STAGE(bufoff, kbase, _v); } \
        else { PG8_STAGE(bufoff, (kbase) + (h) * hstepA, voffA); } } while (0)
#define PG8_GOFF(u, v) do { const int* _rw = S.rows(u); _Pragma("unroll") for (int _h = 0; _h < 2; ++_h) _Pragma("unroll") for (int _i = 0; _i < 2; ++_i) { const int _r = Rr[_i] + _h * HALF; \
        const int _tk = _r < (u).valid ? _rw[_r] : 0; v[_h][_i] = (unsigned)(_tk * g.lda * ES + Cc[_i] * 2); } } while (0)
#define PG8_LDA(dst, b, h) do { _Pragma("unroll") for (int m = 0; m < 4; ++m) _Pragma("unroll") for (int k = 0; k < 2; ++k) dst[m][k] = *(const PG8_LAS bf16x8*)(lds + PG8_SA(b, h) + aoff + m * 2048 + k * 1024); } while (0)
#define PG8_LDB(dst, b, h) do { _Pragma("unroll") for (int n = 0; n < 2; ++n) _Pragma("unroll") for (int k = 0; k < 2; ++k) dst[n][k] = *(const PG8_LAS bf16x8*)(lds + PG8_SB(b, h) + boff + n * 2048 + k * 1024); } while (0)
#define PG8_MMA(ai, bj, At, Bt) do { __builtin_amdgcn_s_setprio(1); _Pragma("unroll") for (int m = 0; m < 4; ++m) _Pragma("unroll") for (int n = 0; n < 2; ++n) { \
        if constexpr (FP8) { const v4i _b0 = __builtin_bit_cast(v4i, Bt[n][0]), _b1 = __builtin_bit_cast(v4i, Bt[n][1]), _a0 = __builtin_bit_cast(v4i, At[m][0]), _a1 = __builtin_bit_cast(v4i, At[m][1]); \
            const v8i _bb = __builtin_shufflevector(_b0, _b1, 0, 1, 2, 3, 4, 5, 6, 7), _aa = __builtin_shufflevector(_a0, _a1, 0, 1, 2, 3, 4, 5, 6, 7); \
            asm volatile("v_mfma_scale_f32_16x16x128_f8f6f4 %0, %1, %2, %0, %3, %4 op_sel_hi:[0,0,0]" : "+v"(acc[ai][bj][m][n]) : "v"(_bb), "v"(_aa), "v"(sclW), "v"(sclX)); } \
        else { _Pragma("unroll") for (int k = 0; k < 2; ++k) acc[ai][bj][m][n] = __builtin_amdgcn_mfma_f32_16x16x32_bf16(Bt[n][k], At[m][k], acc[ai][bj][m][n], 0, 0, 0); } } \
        __builtin_amdgcn_s_setprio(0); } while (0)
#define PG8_WAIT_V(n) asm volatile("s_waitcnt vmcnt(" #n ")" ::: "memory")
#define PG8_WAIT_L(n) asm volatile("s_waitcnt lgkmcnt(" #n ")" ::: "memory")
#define PG8_BAR __builtin_amdgcn_s_barrier()
#define PG8_SCHED __builtin_amdgcn_sched_barrier(0)
    Unit cur, nxt; int ui = 0;
    if (!S.next(0, cur)) return;
    f32x4 acc[2][2][4][2];
#pragma unroll
    for (int a = 0; a < 2; ++a)
#pragma unroll
        for (int b = 0; b < 2; ++b)
#pragma unroll
            for (int m = 0; m < 4; ++m)
#pragma unroll
                for (int n = 0; n < 2; ++n) acc[a][b][m][n] = (f32x4){0.f, 0.f, 0.f, 0.f};
    bf16x8 At[4][2], B0[2][2], B1[2][2];
    const char* cA = cur.A; const char* cB = cur.B;
    if constexpr (Sched::GATHER) { PG8_GOFF(cur, vAc); PG8_WAIT_V(0); }
    PG8_STAGE(PG8_SB(0, 0), cB, voffB); PG8_STAGE(PG8_SB(0, 1), cB + hstepB, voffB); PG8_STAGE_A(PG8_SA(0, 0), cA, 0, false); PG8_STAGE_A(PG8_SA(0, 1), cA, 1, false);
    if (wr == 1) PG8_BAR;
    PG8_WAIT_V(2); PG8_BAR;
    PG8_STAGE(PG8_SB(1, 0), cB + kstep, voffB); PG8_STAGE_A(PG8_SA(1, 0), cA + kstep, 0, false); PG8_STAGE(PG8_SB(1, 1), cB + hstepB + kstep, voffB);
    PG8_WAIT_V(6); PG8_BAR;
    for (;;) {
        const bool has_next = S.next(ui + 1, nxt);
        const char* nA = has_next ? nxt.A : cA; const char* nB = has_next ? nxt.B : cB;
        if constexpr (Sched::GATHER) { if (has_next) { PG8_GOFF(nxt, vAn); } else {
#pragma unroll
            for (int h = 0; h < 2; ++h)
#pragma unroll
                for (int i = 0; i < 2; ++i) vAn[h][i] = vAc[h][i]; } }
#pragma nounroll
        for (int t = 0; t < nt; t += 2) {
            const bool last = (t == nt - 2);
            if constexpr (Epi::MID_T >= 0) { if (t == Epi::MID_T) { int l3 = lane; asm volatile("" : "+v"(l3)); E.mid(acc, cur, wr, wc, l3 & 15, l3 >> 4); } }
            const char* a1 = cA + (size_t)(t + 1) * kstep;
            const char* a2 = last ? nA : cA + (size_t)(t + 2) * kstep; const char* b2 = last ? nB : cB + (size_t)(t + 2) * kstep;
            const char* a3 = a2 + kstep; const char* b3 = b2 + kstep;
            PG8_LDB(B0, 0, 0); PG8_LDB(B1, 0, 1); PG8_SCHED; PG8_LDA(At, 0, 0); PG8_STAGE_A(PG8_SA(1, 1), a1, 1, false);
            PG8_WAIT_V(8); PG8_WAIT_L(0); PG8_BAR; PG8_MMA(0, 0, At, B0); PG8_MMA(0, 1, At, B1); PG8_BAR; PG8_SCHED;
            PG8_LDA(At, 0, 1); PG8_STAGE(PG8_SB(0, 0), b2, voffB); PG8_STAGE(PG8_SB(0, 1), b2 + hstepB, voffB); PG8_STAGE_A(PG8_SA(0, 0), a2, 0, last);
            PG8_WAIT_V(8); PG8_WAIT_L(0); PG8_BAR; PG8_MMA(1, 0, At, B0); PG8_MMA(1, 1, At, B1); PG8_BAR; PG8_SCHED;
            PG8_LDB(B0, 1, 0); PG8_LDB(B1, 1, 1); PG8_SCHED; PG8_LDA(At, 1, 0); PG8_STAGE_A(PG8_SA(0, 1), a2, 1, last);
            PG8_WAIT_V(8); PG8_WAIT_L(0); PG8_BAR; PG8_MMA(0, 0, At, B0); PG8_MMA(0, 1, At, B1); PG8_BAR; PG8_SCHED;
            PG8_LDA(At, 1, 1); PG8_STAGE(PG8_SB(1, 0), b3, voffB); PG8_STAGE(PG8_SB(1, 1), b3 + hstepB, voffB); PG8_STAGE_A(PG8_SA(1, 0), a3, 0, last);
            PG8_WAIT_V(8); PG8_WAIT_L(0); PG8_BAR; PG8_MMA(1, 0, At, B0); PG8_MMA(1, 1, At, B1); PG8_BAR; PG8_SCHED;
        }
        if constexpr (ALIGN_EPI) { if (wr == 0) PG8_BAR; }
        if constexpr (FP8) asm volatile("s_nop 15\n\ts_nop 15" ::: "memory");
        if constexpr (!Epi::AFTER_DRAIN) { int l2 = lane; asm volatile("" : "+v"(l2));
            E(acc, cur, wr, wc, l2 & 15, l2 >> 4); }
        if (!has_next) break;
#pragma unroll
        for (int a = 0; a < 2; ++a)
#pragma unroll
            for (int b = 0; b < 2; ++b)
#pragma unroll
                for (int m = 0; m < 4; ++m)
#pragma unroll
                    for (int n = 0; n < 2; ++n) acc[a][b][m][n] = (f32x4){0.f, 0.f, 0.f, 0.f};
        cur = nxt; cA = nA; cB = nB; ++ui;
        if constexpr (Sched::GATHER) {
#pragma unroll
            for (int h = 0; h < 2; ++h)
#pragma unroll
                for (int i = 0; i < 2; ++i) vAc[h][i] = vAn[h][i]; }
        if constexpr (ALIGN_EPI) { if (wr == 1) PG8_BAR; }
    }
    PG8_WAIT_V(0);
    if constexpr (!ALIGN_EPI) { if (wr == 0) PG8_BAR; }
    PG8_BAR;
    if constexpr (Epi::AFTER_DRAIN) { E.fused(acc, cur, wr, wc, fr, fq, lds, wid, lane); }
#undef PG8_SA
#undef PG8_SB
#undef PG8_STAGE
#undef PG8_STAGE_A
#undef PG8_GOFF
#undef PG8_LDA
#undef PG8_LDB
#undef PG8_MMA
#undef PG8_WAIT_V
#undef PG8_WAIT_L
#undef PG8_BAR
#undef PG8_SCHED
}

#define EPI_LOOP_AI_M for (int ai = 0; ai < 2; ++ai) _Pragma("unroll") for (int m = 0; m < 4; ++m)

struct EpiF32 {
    static constexpr bool PERM = false, AFTER_DRAIN = false; static constexpr int MID_T = -1;
    float* C; int ldc; const float* bias; int bstride; const float* res; float alpha;
    __device__ __forceinline__ void operator()(const f32x4 (&acc)[2][2][4][2], const Unit& u, int wr, int wc, int fr, int fq) const {
        const int row0 = u.orow + wr * 64 + fr, col0 = u.ocol + wc * 32 + 4 * fq;
        f32x4 bv[2][2];
#pragma unroll
        for (int bj = 0; bj < 2; ++bj)
#pragma unroll
            for (int n = 0; n < 2; ++n) bv[bj][n] = bias ? *(const f32x4*)(bias + (size_t)u.aux * bstride + col0 + bj * HALF + n * 16) : (f32x4){0.f, 0.f, 0.f, 0.f};
#pragma unroll
        EPI_LOOP_AI_M { const size_t off = (size_t)(row0 + ai * HALF + m * 16) * ldc + col0;
#pragma unroll
            for (int bj = 0; bj < 2; ++bj)
#pragma unroll
                for (int n = 0; n < 2; ++n) { f32x4 v = acc[ai][bj][m][n] + bv[bj][n];
                    if (res) { const f32x4 rv = *(const f32x4*)(res + off + bj * HALF + n * 16); v = v + rv * alpha; }
                    *(f32x4*)(C + off + bj * HALF + n * 16) = v; }
            asm volatile("" ::: "memory"); }
    }
};
struct EpiResLn {
    static constexpr bool PERM = false, AFTER_DRAIN = false; static constexpr int MID_T = -1;
    float* C; const float* T; const f32x2* stats; const float* gam; const float* bet; float alpha;
    __device__ __forceinline__ void operator()(const f32x4 (&acc)[2][2][4][2], const Unit& u, int wr, int wc, int fr, int fq) const {
        const int row0 = u.orow + wr * 64 + fr, col0 = u.ocol + wc * 32 + 4 * fq;
        f32x4 gv[2][2], bv[2][2];
#pragma unroll
        for (int bj = 0; bj < 2; ++bj)
#pragma unroll
            for (int n = 0; n < 2; ++n) { gv[bj][n] = *(const f32x4*)(gam + col0 + bj * HALF + n * 16) * alpha; bv[bj][n] = *(const f32x4*)(bet + col0 + bj * HALF + n * 16) * alpha; }
#pragma unroll
        EPI_LOOP_AI_M { const int row = row0 + ai * HALF + m * 16; const size_t off = (size_t)row * D + col0; const f32x2 st = stats[row];
#pragma unroll
            for (int bj = 0; bj < 2; ++bj)
#pragma unroll
                for (int n = 0; n < 2; ++n) { const f32x4 tv = *(const f32x4*)(T + off + bj * HALF + n * 16);
                    *(f32x4*)(C + off + bj * HALF + n * 16) = acc[ai][bj][m][n] + ((tv - st.x) * st.y) * gv[bj][n] + bv[bj][n]; }
            asm volatile("" ::: "memory"); }
    }
};
struct EpiBf16 {
    static constexpr bool PERM = true, AFTER_DRAIN = false; static constexpr int MID_T = -1;
    bf16_t* O; int ldc; float scale;
    __device__ __forceinline__ void operator()(const f32x4 (&acc)[2][2][4][2], const Unit& u, int wr, int wc, int fr, int fq) const {
        const int row0 = u.orow + wr * 64 + fr, col0 = u.ocol + wc * 32 + 8 * fq;
#pragma unroll
        EPI_LOOP_AI_M { bf16_t* rowp = O + (size_t)(row0 + ai * HALF + m * 16) * ldc + col0;
#pragma unroll
            for (int bj = 0; bj < 2; ++bj) { const f32x4 v0 = acc[ai][bj][m][0] * scale, v1 = acc[ai][bj][m][1] * scale;
                u32x4 w; w.x = cvt_pk_bf16(v0[0], v0[1]); w.y = cvt_pk_bf16(v0[2], v0[3]); w.z = cvt_pk_bf16(v1[0], v1[1]); w.w = cvt_pk_bf16(v1[2], v1[3]);
                *(u32x4*)(rowp + bj * HALF) = w; } }
    }
};
struct EpiBf16Bias {
    static constexpr bool PERM = true, AFTER_DRAIN = false; static constexpr int MID_T = -1;
    bf16_t* O; int ldc; const float* bias; int bstride;
    __device__ __forceinline__ void operator()(const f32x4 (&acc)[2][2][4][2], const Unit& u, int wr, int wc, int fr, int fq) const {
        const int row0 = u.orow + wr * 64 + fr, col0 = u.ocol + wc * 32 + 8 * fq;
        f32x4 bv[2][2];
#pragma unroll
        for (int bj = 0; bj < 2; ++bj)
#pragma unroll
            for (int n = 0; n < 2; ++n) bv[bj][n] = *(const f32x4*)(bias + (size_t)u.aux * bstride + col0 + bj * HALF + 4 * n);
#pragma unroll
        EPI_LOOP_AI_M { bf16_t* rowp = O + (size_t)(row0 + ai * HALF + m * 16) * ldc + col0;
#pragma unroll
            for (int bj = 0; bj < 2; ++bj) { const f32x4 v0 = acc[ai][bj][m][0] + bv[bj][0], v1 = acc[ai][bj][m][1] + bv[bj][1];
                u32x4 w; w.x = cvt_pk_bf16(v0[0], v0[1]); w.y = cvt_pk_bf16(v0[2], v0[3]); w.z = cvt_pk_bf16(v1[0], v1[1]); w.w = cvt_pk_bf16(v1[2], v1[3]);
                *(u32x4*)(rowp + bj * HALF) = w; } }
    }
};
struct EpiKV {
    static constexpr bool PERM = true, AFTER_DRAIN = false; static constexpr int MID_T = -1;
    bf16_t* KB; bf16_t* VT;
    __device__ __forceinline__ void operator()(const f32x4 (&acc)[2][2][4][2], const Unit& u, int wr, int wc, int fr, int fq) const {
        const int row0 = u.orow + wr * 64 + fr, col0 = u.ocol + wc * 32 + 8 * fq;
#pragma unroll
        EPI_LOOP_AI_M { const int row = row0 + ai * HALF + m * 16;
#pragma unroll
            for (int bj = 0; bj < 2; ++bj) { const f32x4 v0 = acc[ai][bj][m][0], v1 = acc[ai][bj][m][1]; const int col = col0 + bj * HALF;
                if (u.ocol < 2048) { u32x4 w; w.x = cvt_pk_bf16(v0[0], v0[1]); w.y = cvt_pk_bf16(v0[2], v0[3]); w.z = cvt_pk_bf16(v1[0], v1[1]); w.w = cvt_pk_bf16(v1[2], v1[3]);
                    *(u32x4*)(KB + (size_t)row * 2048 + col) = w; }
                else { const int b = row >> 8, key = row & 255, c = col - 2048, h = c >> 9, d = c & 511; bf16_t* p = VT + ((size_t)((b * 4 + h) * 512 + d)) * 256 + key;
#pragma unroll
                    for (int j = 0; j < 4; ++j) { p[(size_t)j * 256] = (bf16_t)f2bf(v0[j]); p[(size_t)(4 + j) * 256] = (bf16_t)f2bf(v1[j]); } } } }
    }
};
struct EpiDecay {
    static constexpr bool PERM = true, AFTER_DRAIN = false; static constexpr int MID_T = -1;
    bf16_t* LD; const float* w0;
    __device__ __forceinline__ void operator()(const f32x4 (&acc)[2][2][4][2], const Unit& u, int wr, int wc, int fr, int fq) const {
        const int row0 = u.orow + wr * 64 + fr, col0 = u.ocol + wc * 32 + 8 * fq;
#pragma unroll
        for (int bj = 0; bj < 2; ++bj) { const int col = col0 + bj * HALF; const f32x4 w00 = *(const f32x4*)(w0 + col), w01 = *(const f32x4*)(w0 + col + 4);
#pragma unroll
            EPI_LOOP_AI_M { const f32x4 x0 = acc[ai][bj][m][0] + w00, x1 = acc[ai][bj][m][1] + w01; float o[8];
#pragma unroll
                for (int j = 0; j < 4; ++j) { o[j] = -0.6065306597126334f * sigmoidf_(x0[j]); o[4 + j] = -0.6065306597126334f * sigmoidf_(x1[j]); }
                *(u32x4*)(LD + (size_t)(row0 + ai * HALF + m * 16) * D + col) = (u32x4){cvt_pk_bf16(o[0], o[1]), cvt_pk_bf16(o[2], o[3]), cvt_pk_bf16(o[4], o[5]), cvt_pk_bf16(o[6], o[7])}; } }
    }
};
struct EpiIclr {
    static constexpr bool PERM = true, AFTER_DRAIN = false; static constexpr int MID_T = -1;
    const float* a0; const float* k_k; const float* k_a; const bf16_t* KZ; const float* KNORM; bf16_t* KP; bf16_t* AN; bf16_t* BB;
    __device__ __forceinline__ void operator()(const f32x4 (&acc)[2][2][4][2], const Unit& u, int wr, int wc, int fr, int fq) const {
        const int row0 = u.orow + wr * 64 + fr, col0 = u.ocol + wc * 32 + 8 * fq;
#pragma unroll
        for (int bj = 0; bj < 2; ++bj) { const int col = col0 + bj * HALF;
            const f32x4 a00 = *(const f32x4*)(a0 + col), a01 = *(const f32x4*)(a0 + col + 4), kk0 = *(const f32x4*)(k_k + col), kk1 = *(const f32x4*)(k_k + col + 4), ka0 = *(const f32x4*)(k_a + col), ka1 = *(const f32x4*)(k_a + col + 4);
#pragma unroll
            EPI_LOOP_AI_M { const int row = row0 + ai * HALF + m * 16; const size_t off = (size_t)row * D + col;
                const u32x4 kzw = *(const u32x4*)(KZ + off); const float nr = KNORM[(size_t)row * 32 + (col >> 6)]; const float inv = 1.0f / fmaxf(nr, 1e-12f);
                const unsigned kw[4] = {kzw.x, kzw.y, kzw.z, kzw.w};
                float kp[8], an[8], bb[8];
#pragma unroll
                for (int j = 0; j < 8; ++j) { const float kz = bf2f((kw[j >> 1] >> (16 * (j & 1))) & 0xffffu);
                    const float x = (j < 4 ? acc[ai][bj][m][0][j & 3] + a00[j & 3] : acc[ai][bj][m][1][j & 3] + a01[j & 3]);
                    const float kkc = j < 4 ? kk0[j & 3] : kk1[j & 3], kac = j < 4 ? ka0[j & 3] : ka1[j & 3];
                    const float a = sigmoidf_(x); const float kk = kz * kkc * inv; kp[j] = kz * (1.0f + (a - 1.0f) * kac); bb[j] = kk * a; an[j] = -kk; }
                *(u32x4*)(KP + off) = (u32x4){cvt_pk_bf16(kp[0], kp[1]), cvt_pk_bf16(kp[2], kp[3]), cvt_pk_bf16(kp[4], kp[5]), cvt_pk_bf16(kp[6], kp[7])};
                *(u32x4*)(AN + off) = (u32x4){cvt_pk_bf16(an[0], an[1]), cvt_pk_bf16(an[2], an[3]), cvt_pk_bf16(an[4], an[5]), cvt_pk_bf16(an[6], an[7])};
                *(u32x4*)(BB + off) = (u32x4){cvt_pk_bf16(bb[0], bb[1]), cvt_pk_bf16(bb[2], bb[3]), cvt_pk_bf16(bb[4], bb[5]), cvt_pk_bf16(bb[6], bb[7])}; }
            asm volatile("" ::: "memory"); }
    }
};
struct EpiGateFused {
    static constexpr bool PERM = true, AFTER_DRAIN = false; static constexpr int MID_T = 32;
    const bf16_t* PROJ; bf16_t* MERGED;
    __device__ __forceinline__ void mid(f32x4 (&acc)[2][2][4][2], const Unit& u, int wr, int wc, int fr, int fq) const {
        const int row0 = u.orow + wr * 64 + fr, col0 = u.ocol + wc * 32 + 8 * fq;
#pragma unroll
        EPI_LOOP_AI_M { const int row = row0 + ai * HALF + m * 16;
#pragma unroll
            for (int bj = 0; bj < 2; ++bj) { const int col = col0 + bj * HALF;
                const u32x4 g1v = *(const u32x4*)(PROJ + (size_t)row * PC + GATE0 + col), g2v = *(const u32x4*)(PROJ + (size_t)row * PC + GATE0 + 2048 + col);
                const unsigned w1[4] = {g1v.x, g1v.y, g1v.z, g1v.w}, w2[4] = {g2v.x, g2v.y, g2v.z, g2v.w};
#pragma unroll
                for (int j = 0; j < 8; ++j) { const float x1 = bf2f((w1[j >> 1] >> (16 * (j & 1))) & 0xffffu), x2 = fmaxf(bf2f((w2[j >> 1] >> (16 * (j & 1))) & 0xffffu), -60.0f);
                    const float ratio = (1.0f + __expf(-x2)) * __builtin_amdgcn_rcpf(1.0f + __expf(-x1));
                    if (j < 4) acc[ai][bj][m][0][j & 3] *= ratio; else acc[ai][bj][m][1][j & 3] *= ratio; } }
            asm volatile("" ::: "memory"); }
    }
    __device__ __forceinline__ void operator()(const f32x4 (&acc)[2][2][4][2], const Unit& u, int wr, int wc, int fr, int fq) const {
        const int row0 = u.orow + wr * 64 + fr, col0 = u.ocol + wc * 32 + 8 * fq;
#pragma unroll
        EPI_LOOP_AI_M { const int row = row0 + ai * HALF + m * 16;
#pragma unroll
            for (int bj = 0; bj < 2; ++bj) { const int col = col0 + bj * HALF; const u32x4 gv = *(const u32x4*)(PROJ + (size_t)row * PC + GATE0 + 2048 + col);
                const unsigned w2[4] = {gv.x, gv.y, gv.z, gv.w}; float o[8];
#pragma unroll
                for (int j = 0; j < 8; ++j) { const float x2 = fmaxf(bf2f((w2[j >> 1] >> (16 * (j & 1))) & 0xffffu), -60.0f); o[j] = (j < 4 ? acc[ai][bj][m][0][j & 3] : acc[ai][bj][m][1][j & 3]) * sigmoidf_(x2); }
                u32x4 w; w.x = cvt_pk_bf16(o[0], o[1]); w.y = cvt_pk_bf16(o[2], o[3]); w.z = cvt_pk_bf16(o[4], o[5]); w.w = cvt_pk_bf16(o[6], o[7]);
                *(u32x4*)(MERGED + (size_t)row * D + col) = w; }
            asm volatile("" ::: "memory"); }
    }
};
struct EpiSwiglu {
    static constexpr bool PERM = true, AFTER_DRAIN = false; static constexpr int MID_T = -1;
    const float* b1; bf16_t* H;
    __device__ __forceinline__ float sw(float g, float l) const { g = fminf(g, 7.0f); l = fminf(fmaxf(l, -7.0f), 7.0f); return g * sigmoidf_(1.702f * g) * (l + 1.0f); }
    __device__ __forceinline__ void operator()(const f32x4 (&acc)[2][2][4][2], const Unit& u, int wr, int wc, int fr, int fq) const {
        const int row0 = u.orow + wr * 64 + fr, col0 = u.ocol + wc * 32 + 8 * fq;
        f32x4 bv[2][2];
#pragma unroll
        for (int bj = 0; bj < 2; ++bj)
#pragma unroll
            for (int n = 0; n < 2; ++n) bv[bj][n] = *(const f32x4*)(b1 + (size_t)u.aux * 4096 + col0 + bj * HALF + 4 * n);
#pragma unroll
        EPI_LOOP_AI_M { const int row = row0 + ai * HALF + m * 16;
#pragma unroll
            for (int bj = 0; bj < 2; ++bj) { const f32x4 v0 = acc[ai][bj][m][0] + bv[bj][0], v1 = acc[ai][bj][m][1] + bv[bj][1];
                *(unsigned*)((unsigned char*)H + (size_t)row * DFF + ((col0 + bj * HALF) >> 1)) = pk4_fp8(sw(v0[0], v0[1]), sw(v0[2], v0[3]), sw(v1[0], v1[1]), sw(v1[2], v1[3])); } }
    }
};
struct EpiSoftmax {
    static constexpr bool PERM = true, AFTER_DRAIN = true; static constexpr int MID_T = -1;
    bf16_t* PP;
    __device__ __forceinline__ void fused(f32x4 (&acc)[2][2][4][2], const Unit& u, int wr, int wc, int fr, int fq, PG8_LAS unsigned char* lds, int wid, int lane) const {
        PG8_LAS float* P1 = (PG8_LAS float*)lds;
        PG8_LAS float* P2 = (PG8_LAS float*)(lds + 4096);
        float mx[2][4];
#pragma unroll
        EPI_LOOP_AI_M { float v = -3.0e38f;
#pragma unroll
            for (int bj = 0; bj < 2; ++bj)
#pragma unroll
                for (int n = 0; n < 2; ++n) { const f32x4 x = acc[ai][bj][m][n]; v = fmaxf(v, fmaxf(fmaxf(x[0], x[1]), fmaxf(x[2], x[3]))); }
            v = fmaxf(v, __shfl_xor(v, 16)); v = fmaxf(v, __shfl_xor(v, 32));
            if (fq == 0) P1[(ai * HALF + wr * 64 + m * 16 + fr) * 4 + wc] = v; }
        asm volatile("s_waitcnt lgkmcnt(0)" ::: "memory"); __builtin_amdgcn_s_barrier(); asm volatile("" ::: "memory");
#pragma unroll
        EPI_LOOP_AI_M { const f32x4 t = *(const PG8_LAS f32x4*)(P1 + (ai * HALF + wr * 64 + m * 16 + fr) * 4); mx[ai][m] = fmaxf(fmaxf(t[0], t[1]), fmaxf(t[2], t[3])); }
#pragma unroll
        EPI_LOOP_AI_M { float s = 0.f;
#pragma unroll
            for (int bj = 0; bj < 2; ++bj)
#pragma unroll
                for (int n = 0; n < 2; ++n) { f32x4 x = acc[ai][bj][m][n];
#pragma unroll
                    for (int j = 0; j < 4; ++j) { x[j] = __expf(x[j] - mx[ai][m]); s += x[j]; }
                    acc[ai][bj][m][n] = x; }
            s += __shfl_xor(s, 16); s += __shfl_xor(s, 32);
            if (fq == 0) P2[(ai * HALF + wr * 64 + m * 16 + fr) * 4 + wc] = s; }
        asm volatile("s_waitcnt lgkmcnt(0)" ::: "memory"); __builtin_amdgcn_s_barrier(); asm volatile("" ::: "memory");
        const int row0 = u.orow + wr * 64 + fr, col0 = wc * 32 + 8 * fq;
#pragma unroll
        EPI_LOOP_AI_M { const f32x4 t = *(const PG8_LAS f32x4*)(P2 + (ai * HALF + wr * 64 + m * 16 + fr) * 4); const float inv = 1.0f / ((t[0] + t[1]) + (t[2] + t[3]));
            bf16_t* rowp = PP + (size_t)(row0 + ai * HALF + m * 16) * 256 + col0;
#pragma unroll
            for (int bj = 0; bj < 2; ++bj) { const f32x4 v0 = acc[ai][bj][m][0] * inv, v1 = acc[ai][bj][m][1] * inv;
                u32x4 w; w.x = cvt_pk_bf16(v0[0], v0[1]); w.y = cvt_pk_bf16(v0[2], v0[3]); w.z = cvt_pk_bf16(v1[0], v1[1]); w.w = cvt_pk_bf16(v1[2], v1[3]);
                *(u32x4*)(rowp + bj * HALF) = w; } }
        asm volatile("s_waitcnt lgkmcnt(0)" ::: "memory"); __builtin_amdgcn_s_barrier(); asm volatile("" ::: "memory");
    }
};
}

constexpr size_t MiB = 1u << 20;
constexpr size_t al256(size_t x) { return (x + 255) & ~(size_t)255; }
constexpr size_t WS_CTL = 0, CTL_ZERO_BYTES = 1 * MiB;
constexpr size_t WS_WIN = 1 * MiB;
constexpr size_t WS_WUP = WS_WIN + (size_t)PC * D * 2;
constexpr size_t WS_AUP = WS_WUP + (size_t)D * 256 * 2;
constexpr size_t WS_GUP = WS_AUP + (size_t)D * 256 * 2;
constexpr size_t WS_PA = WS_GUP + (size_t)D * 256 * 2;
constexpr size_t WS_PB = WS_PA + (size_t)D * D * 2;
constexpr size_t WS_WOUT = WS_PB + (size_t)D * 512 * 2;
constexpr size_t WS_WQ = WS_WOUT + (size_t)D * D * 2;
constexpr size_t WS_WKV = WS_WQ + (size_t)D * D * 2;
constexpr size_t WS_WO = WS_WKV + (size_t)2 * D * D * 2;
constexpr size_t WS_W1 = WS_WO + (size_t)D * D * 2;
constexpr size_t WS_W2 = WS_W1 + (size_t)NEXP * 4096 * D * 2;
constexpr size_t WS_XB = WS_W2 + (size_t)NEXP * D * DFF * 2;
constexpr size_t WS_MEMB = WS_XB + (size_t)M * D * 2;
constexpr size_t WS_ROT = WS_MEMB + (size_t)1024 * D * 2;
constexpr size_t WS_KB = WS_ROT + (size_t)2 * SEQ * 32 * 4;
constexpr size_t WS_VT = WS_KB + (size_t)1024 * D * 2;
constexpr size_t WS_YA = WS_VT + (size_t)1024 * D * 2;
constexpr size_t WS_YB = WS_YA + (size_t)M * D * 2;
constexpr size_t WS_TMP = WS_YB + (size_t)M * 512 * 2;
constexpr size_t WS_MERGED = WS_TMP + (size_t)M * D * 4;
constexpr size_t WS_E = WS_MERGED + (size_t)M * D * 2;
constexpr size_t WS_PROJ = WS_E;
constexpr size_t WS_RZ = WS_PROJ + (size_t)M * PC * 2;
constexpr size_t WS_KZ = WS_RZ + (size_t)M * D * 4;
constexpr size_t WS_VZ = WS_KZ + (size_t)M * D * 4;
constexpr size_t WS_DEC = WS_VZ + (size_t)M * D * 4;
constexpr size_t WS_KP = WS_DEC + (size_t)M * D * 4;
constexpr size_t WS_AN = WS_KP + (size_t)M * D * 4;
constexpr size_t WS_BB = WS_AN + (size_t)M * D * 4;
constexpr size_t WS_GG = WS_BB + (size_t)M * D * 4;
constexpr size_t WS_YS = WS_GG + (size_t)M * D * 4;
constexpr size_t WS_XQ = WS_YS + 60 * MiB;
constexpr size_t WS_WIN8 = WS_YS + 96 * MiB;
constexpr size_t WS_ST1 = WS_YS + 112 * MiB, WS_ST2 = WS_YS + 113 * MiB;
constexpr size_t WS_VR = WS_YS + 4 * MiB;
constexpr size_t WS_AO = WS_YS + (size_t)M * D * 4;
constexpr size_t WS_LSE = WS_AO + (size_t)3 * M * 512 * 4;
constexpr size_t WS_QR = WS_LSE + (size_t)3 * M * 8 * 4;
constexpr size_t WS_KR = WS_QR + (size_t)M * 1536 * 2;
constexpr size_t WS_LIN = WS_KR + (size_t)M * 1536 * 2;
constexpr size_t WS_KNORM = WS_LIN + (size_t)M * 768 * 2;
constexpr size_t WS_F = WS_KNORM + (size_t)M * 32 * 4;
constexpr size_t WS_E_END = WS_F + (size_t)128 * 128 * 96 * 96 * 2;
constexpr size_t WS_T1 = WS_E;
constexpr size_t WS_X1 = WS_T1 + (size_t)M * D * 4;
constexpr size_t WS_X1B = WS_X1 + (size_t)M * D * 4;
constexpr size_t WS_Q = WS_X1B + (size_t)M * D * 2;
constexpr size_t WS_PP = WS_Q + (size_t)M * D * 2;
constexpr size_t WS_OC = WS_PP + (size_t)16 * SEQ * 256 * 2;
constexpr size_t WS_T2 = WS_OC + (size_t)M * D * 2;
constexpr size_t WS_X2 = WS_T2 + (size_t)M * D * 4;
constexpr size_t WS_X2B = WS_X2 + (size_t)M * D * 4;
constexpr size_t WS_LIST = WS_X2B + (size_t)M * D * 2;
constexpr size_t WS_ROWI = WS_LIST + (size_t)NEXP * CAP * 4;
constexpr size_t WS_TOPW = WS_ROWI + (size_t)M * 4 * 4;
constexpr size_t WS_H = WS_TOPW + (size_t)M * 4 * 4;
constexpr size_t WS_Y = WS_H + (size_t)HROWS * DFF * 2;
constexpr size_t WS_L_END = WS_Y + (size_t)HROWS * D * 4;
constexpr size_t WS_END = (WS_E_END > WS_L_END ? WS_E_END : WS_L_END);
static_assert(WS_END <= (size_t)4090 * MiB, "workspace map exceeds 4 x largest input");
constexpr int CW_TMO = 0, CW_CNT = 64  , CW_Q = 128  , CW_BAR = 4096;

constexpr int RING_BYTES = 131072, MISC_OFF = RING_BYTES, LDS_BYTES = 147456;

#define XB_TMO      128
#define XB_XCNT(j)  (256  + 64 * (j))
#define XB_XSUB(j)  (1280 + 64 * (j))
#define XB_XGEN(j)  (2304 + 64 * (j))
#define XB_TOP      3328
#define XB_TOPGEN   3392
#define XCD_BAR_WORDS 3456
#define XB_SPIN_CAP (1u << 18)
__device__ __forceinline__ unsigned xb_ld(unsigned* p)              { return __hip_atomic_load(p, __ATOMIC_RELAXED, __HIP_MEMORY_SCOPE_AGENT); }
__device__ __forceinline__ unsigned xb_add(unsigned* p, unsigned v) { return __hip_atomic_fetch_add(p, v, __ATOMIC_RELAXED, __HIP_MEMORY_SCOPE_AGENT); }
__device__ __forceinline__ unsigned xb_xcc_id() { return (unsigned)__builtin_amdgcn_s_getreg((3 << 11) | 20) & 0xFu; }
#define XB_SPIN(cond, bar) do { unsigned _sp = 0; while (cond) { __builtin_amdgcn_s_sleep(1); \
    if ((++_sp & 255u) == 0u) { if (xb_ld(&(bar)[XB_TMO])) break; if (_sp > XB_SPIN_CAP) { atomicAdd(&(bar)[XB_TMO], 1u); break; } } } } while (0)
struct XcdBarrier { unsigned* bar; unsigned x; volatile LAS unsigned* st; };
__device__ __forceinline__ XcdBarrier xcd_barrier_post(unsigned* bar, volatile LAS unsigned* st) {
    XcdBarrier b; b.bar = bar; b.x = xb_xcc_id(); b.st = st;
    if (threadIdx.x == 0) (void)xb_add(&bar[XB_XCNT(b.x)], 1u);
    return b;
}
__device__ __forceinline__ void xcd_barrier_complete(unsigned* bar, unsigned x, unsigned& nloc, unsigned& nx) {
    const unsigned G = gridDim.x * gridDim.y * gridDim.z;
    unsigned sum, cnt, mine, sp = 0u;
    for (;;) {
        sum = 0u; cnt = 0u; mine = 0u;
#pragma unroll
        for (unsigned j = 0; j < 16; ++j) { const unsigned c = xb_ld(&bar[XB_XCNT(j)]); sum += c; cnt += (c > 0u) ? 1u : 0u; mine = (j == x) ? c : mine; }
        if (sum == G) break;
        __builtin_amdgcn_s_sleep(1);
        if ((++sp & 255u) == 0u) { if (xb_ld(&bar[XB_TMO])) break; if (sp > XB_SPIN_CAP) { atomicAdd(&bar[XB_TMO], 1u); break; } }
    }
    nloc = mine > 0u ? mine : 1u; nx = cnt > 0u ? cnt : 1u;
}
__device__ __forceinline__ void xcd_barrier(const XcdBarrier& b) {
    asm volatile("s_waitcnt vmcnt(0)" ::: "memory");
    __syncthreads();
    if (threadIdx.x == 0) {
        unsigned* bar = b.bar;
        __builtin_amdgcn_s_waitcnt(0);
        unsigned nloc = b.st[0], nx = b.st[1];
        if (nloc == 0u) { xcd_barrier_complete(bar, b.x, nloc, nx); b.st[0] = nloc; b.st[1] = nx; }
        const unsigned old = xb_add(&bar[XB_XSUB(b.x)], 1u);
        const unsigned gen = old / nloc;
        if (old + 1u == (gen + 1u) * nloc) {
            __builtin_amdgcn_fence(__ATOMIC_RELEASE, "agent");
            asm volatile("s_waitcnt vmcnt(0)" ::: "memory");
            const unsigned og = xb_add(&bar[XB_TOP], 1u);
            const unsigned tg = og / nx;
            if (og + 1u == (tg + 1u) * nx) xb_add(&bar[XB_TOPGEN], 1u);
            else XB_SPIN(xb_ld(&bar[XB_TOPGEN]) == tg, bar);
            __builtin_amdgcn_fence(__ATOMIC_ACQUIRE, "agent");
            xb_add(&bar[XB_XGEN(b.x)], 1u);
            asm volatile("s_waitcnt vmcnt(0)" ::: "memory");
        } else {
            XB_SPIN(xb_ld(&bar[XB_XGEN(b.x)]) == gen, bar);
            __builtin_amdgcn_fence(__ATOMIC_ACQUIRE, "agent");
            asm volatile("s_waitcnt vmcnt(0)" ::: "memory");
        }
    }
    __syncthreads();
}

struct Params {
    const float* in[32];
    float* out; unsigned char* ws;
    int ph_lo, ph_hi, li, pad;
};
enum { I_X = 0, I_MEM, I_WIN, I_MIX, I_W0, I_WUP, I_A0, I_AUP, I_GUP, I_KK, I_KA, I_RK, I_LNXG, I_LNXB, I_PA, I_PB, I_WOUT, I_LN1G, I_LN1B, I_WQ, I_WKV, I_WO, I_LN2G, I_LN2B,
       I_RW, I_RB, I_W1, I_B1, I_W2, I_B2, I_LN3G, I_LN3B };

struct ScoreOrder {
    static constexpr bool GATHER = false;
    const char* Q; const char* KB; int G, c;
    __device__ bool next(int i, pg8::Unit& u) const {
        const int L = i * G + c; if (L >= 256) return false;
        const int bh = L >> 4, pm = L & 15, b = bh >> 2, h = bh & 3;
        u.A = Q + ((size_t)(b * SEQ + 256 * pm) * D + h * 512) * 2; u.B = KB + ((size_t)(b * 256) * D + h * 512) * 2;
        u.orow = bh * SEQ + 256 * pm; u.ocol = 0; u.aux = 0; u.aux2 = 0; u.valid = 256; return true;
    }
    __device__ __forceinline__ const int* rows(const pg8::Unit&) const { return nullptr; }
};
struct PvOrder {
    static constexpr bool GATHER = false;
    const char* PP; const char* VT; int G, c;
    __device__ bool next(int i, pg8::Unit& u) const {
        const int L = i * G + c; if (L >= 512) return false;
        const int bh = L >> 5, pm = (L >> 1) & 15, pn = L & 1, b = bh >> 2, h = bh & 3;
        u.A = PP + ((size_t)(bh * SEQ + 256 * pm) * 256) * 2; u.B = VT + ((size_t)(bh * 512 + 256 * pn) * 256) * 2;
        u.orow = b * SEQ + 256 * pm; u.ocol = h * 512 + 256 * pn; u.aux = 0; u.aux2 = 0; u.valid = 256; return true;
    }
    __device__ __forceinline__ const int* rows(const pg8::Unit&) const { return nullptr; }
};
template <bool GATHER_, int NT  > struct MoeOrder {
    static constexpr bool GATHER = GATHER_;
    const LAS int* tab; const char* A; const char* W; const int* list; size_t wexp  ; int ldb; int G, c;
    __device__ bool next(int i, pg8::Unit& u) const {
        constexpr int RPR = 256 / NT;
        const int rt = i * RPR + (c % RPR), pn = c / RPR, T = __builtin_amdgcn_readfirstlane(tab[64]);
        if (c >= 256 || rt >= T) return false;
        int e = 0;
        for (int j = 1; j < NEXP; ++j) e = (rt >= __builtin_amdgcn_readfirstlane(tab[32 + j])) ? j : e;
        const int lt = rt - __builtin_amdgcn_readfirstlane(tab[32 + e]), cnt = __builtin_amdgcn_readfirstlane(tab[e]);
        u.aux = e; u.aux2 = lt; u.valid = min(256, cnt - 256 * lt); u.orow = 256 * rt; u.ocol = 256 * pn;
        u.B = W + (size_t)e * wexp + (size_t)(256 * pn) * ldb;
        u.A = GATHER_ ? A : A + (size_t)(256 * rt) * DFF;
        return true;
    }
    __device__ __forceinline__ const int* rows(const pg8::Unit& u) const { return list + (size_t)u.aux * CAP + 256 * u.aux2; }
};

struct Ctx { int tid, lane, wave, vcu, G; LAS unsigned char* lds; unsigned char* ws; };

__device__ __forceinline__ void cv_issue(const float* W, int ldw, int Ksrc, int sc0, int k0, int lane, float (&cv)[32]) {
    const int kb = k0 + 32 * (lane >> 5); const bool ok = sc0 >= 0 && kb < Ksrc;
    const float* src = W + (ok ? (size_t)kb * ldw + sc0 + (lane & 31) : (size_t)0);
#pragma unroll
    for (int i = 0; i < 32; ++i) { const float v = src[(size_t)i * ldw]; cv[i] = ok ? v : 0.f; }
}
__device__ __forceinline__ void cv_store16(const float (&cv)[32], bf16_t* WT, int ldt, int n0, int k0, int lane) {
    u32x4* dst = (u32x4*)(WT + (size_t)(n0 + (lane & 31)) * ldt + k0 + 32 * (lane >> 5));
#pragma unroll
    for (int j = 0; j < 4; ++j) dst[j] = (u32x4){pk2(cv[8 * j], cv[8 * j + 1]), pk2(cv[8 * j + 2], cv[8 * j + 3]), pk2(cv[8 * j + 4], cv[8 * j + 5]), pk2(cv[8 * j + 6], cv[8 * j + 7])};
}
__device__ __forceinline__ void cv_store8(const float (&cv)[32], unsigned char* WT8, int ldt, int n0, int k0, int lane) {
    u32x4* dst = (u32x4*)(WT8 + (size_t)(n0 + (lane & 31)) * ldt + k0 + 32 * (lane >> 5));
#pragma unroll
    for (int j = 0; j < 2; ++j) dst[j] = (u32x4){pk4_fp8(cv[16 * j] * 64.f, cv[16 * j + 1] * 64.f, cv[16 * j + 2] * 64.f, cv[16 * j + 3] * 64.f), pk4_fp8(cv[16 * j + 4] * 64.f, cv[16 * j + 5] * 64.f, cv[16 * j + 6] * 64.f, cv[16 * j + 7] * 64.f),
        pk4_fp8(cv[16 * j + 8] * 64.f, cv[16 * j + 9] * 64.f, cv[16 * j + 10] * 64.f, cv[16 * j + 11] * 64.f), pk4_fp8(cv[16 * j + 12] * 64.f, cv[16 * j + 13] * 64.f, cv[16 * j + 14] * 64.f, cv[16 * j + 15] * 64.f)};
}
struct CvJob { const float* W; bf16_t* WT; int ldw, Ksrc, sc0, ldt, n0, k0, f8, kd; };
__device__ __forceinline__ CvJob p0_job(const Params& p, unsigned char* ws, int it) {
    constexpr int I_WINJ = 32 * 480, I_LORA = 4 * 64, I_SQ = 32 * 64, I_PBJ = 8 * 64, I_KVJ = 32 * 128;
    CvJob j; j.f8 = 0; j.kd = 0; int r = it;
#define P0_PLAIN_F8(SRC, DST, N_, KS_, KD_) { const int nblk = (N_) / 32, kb = r / nblk, nb = r % nblk; j.W = p.in[SRC]; j.WT = (bf16_t*)(ws + (DST)); j.ldw = (N_); j.Ksrc = (KS_); j.sc0 = 32 * nb; j.ldt = (KD_); j.n0 = 32 * nb; j.k0 = 64 * kb; j.f8 = 1; return j; }
#define P0_PLAIN(SRC, DST, N_, KS_, KD_) { const int nblk = (N_) / 32, kb = r / nblk, nb = r % nblk; j.W = p.in[SRC]; j.WT = (bf16_t*)(ws + (DST)); j.ldw = (N_); j.Ksrc = (KS_); j.sc0 = 32 * nb; j.ldt = (KD_); j.n0 = 32 * nb; j.k0 = 64 * kb; return j; }
    if (r < I_WINJ) { const int kb = r / 480, nb = r % 480; j.W = p.in[I_WIN]; j.WT = (bf16_t*)(ws + WS_WIN); j.ldw = 15296; j.Ksrc = D; const int n_ = 32 * nb;
        j.sc0 = n_ < RWC ? n_ : (n_ < ATTV2 ? -1 : (n_ < ATT0 ? RWC + 4096 + (n_ - ATTV2) : (n_ < GATE0 ? RWC + (n_ - ATT0) : n_ - 64))); j.ldt = D; j.n0 = n_; j.k0 = 64 * kb;
        if (n_ >= ATT0) { j.f8 = 1; j.WT = (bf16_t*)(ws + WS_WIN8); j.n0 = n_ - ATT0; }
        return j; } r -= I_WINJ;
    if (r < I_LORA) P0_PLAIN(I_WUP, WS_WUP, D, 96, 256) r -= I_LORA;
    if (r < I_LORA) P0_PLAIN(I_AUP, WS_AUP, D, 96, 256) r -= I_LORA;
    if (r < I_LORA) P0_PLAIN(I_GUP, WS_GUP, D, 256, 256) r -= I_LORA;
    if (r < I_SQ) P0_PLAIN(I_PA, WS_PA, D, D, 2560) r -= I_SQ;
    if (r < I_PBJ) { const int kb = r / 64, nb = r % 64; j.W = p.in[I_PB]; j.WT = (bf16_t*)(ws + WS_PA); j.ldw = D; j.Ksrc = 512; j.sc0 = 32 * nb; j.ldt = 2560; j.n0 = 32 * nb; j.k0 = 64 * kb; j.kd = 2048; return j; } r -= I_PBJ;
    if (r < I_SQ) P0_PLAIN(I_WOUT, WS_WOUT, D, D, D) r -= I_SQ;
    if (r < I_SQ) { P0_PLAIN_F8(I_WQ, WS_WQ, D, D, D) } r -= I_SQ;
    if (r < I_KVJ) P0_PLAIN(I_WKV, WS_WKV, 2 * D, D, D) r -= I_KVJ;
    P0_PLAIN(I_WO, WS_WO, D, D, D)
#undef P0_PLAIN
#undef P0_PLAIN_F8
}
__device__ __forceinline__ void p0_prologue(const Params& p, const Ctx& c) {
    const int gw = c.vcu * 8 + c.wave, NGW = c.G * 8;
    unsigned char* ws = c.ws;
    constexpr int NITEMS = 32 * 480 + 3 * (4 * 64) + 4 * (32 * 64) + 8 * 64 + 32 * 128;
    { float ca[32], cb[32]; CvJob ja, jb; int it = gw;
      if (it < NITEMS) { ja = p0_job(p, ws, it); cv_issue(ja.W, ja.ldw, ja.Ksrc, ja.sc0, ja.k0, c.lane, ca); }
      for (; it < NITEMS; it += 2 * NGW) {
          if (it + NGW < NITEMS) { jb = p0_job(p, ws, it + NGW); cv_issue(jb.W, jb.ldw, jb.Ksrc, jb.sc0, jb.k0, c.lane, cb); }
          if (ja.f8) cv_store8(ca, (unsigned char*)ja.WT, ja.ldt, ja.n0, ja.k0, c.lane); else cv_store16(ca, ja.WT, ja.ldt, ja.n0, ja.k0 + ja.kd, c.lane);
          if (it + 2 * NGW < NITEMS) { ja = p0_job(p, ws, it + 2 * NGW); cv_issue(ja.W, ja.ldw, ja.Ksrc, ja.sc0, ja.k0, c.lane, ca); }
          if (it + NGW < NITEMS) { if (jb.f8) cv_store8(cb, (unsigned char*)jb.WT, jb.ldt, jb.n0, jb.k0, c.lane); else cv_store16(cb, jb.WT, jb.ldt, jb.n0, jb.k0 + jb.kd, c.lane); }
      } }
    const size_t gt = (size_t)c.vcu * 512 + c.tid, NT = (size_t)c.G * 512;
    for (size_t i = gt; i < (size_t)M * D / 8; i += NT) { const f32x4 a = ((const f32x4*)p.in[I_X])[2 * i], b = ((const f32x4*)p.in[I_X])[2 * i + 1];
        u32x4 o; o.x = pk2(a[0], a[1]); o.y = pk2(a[2], a[3]); o.z = pk2(b[0], b[1]); o.w = pk2(b[2], b[3]); ((u32x4*)(ws + WS_XB))[i] = o;
        ((u32x2*)(ws + WS_XQ))[i] = (u32x2){pk4_fp8(a[0], a[1], a[2], a[3]), pk4_fp8(b[0], b[1], b[2], b[3])}; }
    for (size_t i = gt; i < (size_t)1024 * D / 8; i += NT) { const f32x4 a = ((const f32x4*)p.in[I_MEM])[2 * i], b = ((const f32x4*)p.in[I_MEM])[2 * i + 1];
        u32x4 o; o.x = pk2(a[0], a[1]); o.y = pk2(a[2], a[3]); o.z = pk2(b[0], b[1]); o.w = pk2(b[2], b[3]); ((u32x4*)(ws + WS_MEMB))[i] = o; }
    float* rc = (float*)(ws + WS_ROT); float* rs = rc + SEQ * 32;
    for (size_t i = gt; i < (size_t)SEQ * 32; i += NT) { const int pos = (int)(i >> 5), j = (int)(i & 31);
        const double inv = exp(-(double)j * (9.210340371976184 / 32.0)); const double ang = (double)pos * inv; rc[i] = (float)cos(ang); rs[i] = (float)sin(ang); }
}

constexpr int MOE_W1E = 32 * 128, MOE_W2E = 32 * 64, MOE_CONV_GROUPS = (NEXP * MOE_W2E) / 8;
__device__ __forceinline__ void conv_group(const Params& p, const Ctx& c, int gi) {
    unsigned char* ws = c.ws;
    const int r = gi * 8 + c.wave;
    const int e = r / MOE_W2E, it = r % MOE_W2E, kb = it >> 6, nb = it & 63;
    float cv[32]; cv_issue(p.in[I_W2] + (size_t)e * DFF * D, D, DFF, 32 * nb, 64 * kb, c.lane, cv);
    cv_store8(cv, ws + WS_W2 + (size_t)e * D * DFF, DFF, 32 * nb, 64 * kb, c.lane);
}

#define DPP_ADD(x, ctrl) ((x) + __builtin_bit_cast(float, __builtin_amdgcn_update_dpp(0, __builtin_bit_cast(int, (x)), (ctrl), 0xF, 0xF, true)))
struct P2Tok { u32x4 cv0, pv0, cv1, pv1, ra, rb, vv; f32x4 c0, c1, s0, s1; };
__device__ __forceinline__ void p2_prep(const Params& p, const Ctx& c) {
    unsigned char* ws = c.ws;
    const bf16_t* PROJ = (const bf16_t*)(ws + WS_PROJ);
    const float* mix = p.in[I_MIX]; const float* k_k = p.in[I_KK];
    bf16_t* RZ = (bf16_t*)(ws + WS_RZ); bf16_t* KZ = (bf16_t*)(ws + WS_KZ); bf16_t* VZ = (bf16_t*)(ws + WS_VZ);
    bf16_t* LIN = (bf16_t*)(ws + WS_LIN); float* KNORM = (float*)(ws + WS_KNORM);
    bf16_t* QR = (bf16_t*)(ws + WS_QR); bf16_t* KR = (bf16_t*)(ws + WS_KR); bf16_t* VR = (bf16_t*)(ws + WS_VR);
    const float* rc = (const float*)(ws + WS_ROT); const float* rs = rc + SEQ * 32;
    int tid_ = c.tid; asm volatile("" : "+v"(tid_));
    const int tid = tid_;
    const int ch0 = tid, ch1 = tid + 512; const bool has1 = ch1 < 824;
    const f32x4 m00 = *(const f32x4*)(mix + 8 * ch0), m01 = *(const f32x4*)(mix + 8 * ch0 + 4);
    f32x4 m10 = (f32x4){0.f, 0.f, 0.f, 0.f}, m11 = m10; if (has1) { m10 = *(const f32x4*)(mix + 8 * ch1); m11 = *(const f32x4*)(mix + 8 * ch1 + 4); }
    f32x4 kk0 = (f32x4){0.f, 0.f, 0.f, 0.f}, kk1 = kk0; if (tid >= 256) { kk0 = *(const f32x4*)(k_k + 8 * (tid - 256)); kk1 = *(const f32x4*)(k_k + 8 * (tid - 256) + 4); }
    const bool rot = tid >= 64 && tid < 256, vcp = tid >= 256 && tid < 448;
    const int rw = tid - 64, which = rw / 96, rhh = (rw % 96) >> 2, re0 = (rw & 3) * 8;
    const int vhh = (tid - 256) >> 3, ve0 = ((tid - 256) & 7) * 8;
#define P2_LOAD(T, t_) do { const int pos_ = (t_) & (SEQ - 1); const bf16_t* cur_ = PROJ + (size_t)(t_) * PC; const u32x4 z4_ = (u32x4){0u, 0u, 0u, 0u}; \
        T.cv0 = *(const u32x4*)(cur_ + 8 * ch0); T.pv0 = pos_ > 0 ? *(const u32x4*)(cur_ - PC + 8 * ch0) : z4_; \
        if (has1) { T.cv1 = *(const u32x4*)(cur_ + 8 * ch1); T.pv1 = pos_ > 0 ? *(const u32x4*)(cur_ - PC + 8 * ch1) : z4_; } \
        if (rot) { const bf16_t* src_ = cur_ + ATT0 + which * 1536 + rhh * 64 + re0; T.ra = *(const u32x4*)src_; T.rb = *(const u32x4*)(src_ + 32); \
            T.c0 = *(const f32x4*)(rc + pos_ * 32 + re0); T.c1 = *(const f32x4*)(rc + pos_ * 32 + re0 + 4); T.s0 = *(const f32x4*)(rs + pos_ * 32 + re0); T.s1 = *(const f32x4*)(rs + pos_ * 32 + re0 + 4); } \
        if (vcp) { const int ao_ = 2 * 1536 + vhh * 64 + ve0; T.vv = *(const u32x4*)(cur_ + (ao_ < 4096 ? ATT0 + ao_ : ATTV2 + ao_ - 4096)); } } while (0)
#define P2_SHIFT(z, cv, pv, ma, mb) do { const unsigned cw[4] = {cv.x, cv.y, cv.z, cv.w}, pw[4] = {pv.x, pv.y, pv.z, pv.w}; const float mm[8] = {ma[0], ma[1], ma[2], ma[3], mb[0], mb[1], mb[2], mb[3]}; \
        _Pragma("unroll") for (int j = 0; j < 4; ++j) { const float c0_ = bf2f(cw[j] & 0xffffu), c1_ = bf2f(cw[j] >> 16), q0_ = bf2f(pw[j] & 0xffffu), q1_ = bf2f(pw[j] >> 16); \
            z[2 * j] = c0_ + (q0_ - c0_) * mm[2 * j]; z[2 * j + 1] = c1_ + (q1_ - c1_) * mm[2 * j + 1]; } } while (0)
#define P2_PROC(T, t_) do { const int t = (t_), pos = t & (SEQ - 1); \
        { float z[8]; P2_SHIFT(z, T.cv0, T.pv0, m00, m01);            \
          bf16_t* dst = (tid < 256 ? RZ : KZ) + (size_t)t * D + 8 * (tid & 255); \
          { u32x4 w8; w8.x = pk2(z[0], z[1]); w8.y = pk2(z[2], z[3]); w8.z = pk2(z[4], z[5]); w8.w = pk2(z[6], z[7]); *(u32x4*)dst = w8; } \
          if (tid >= 256) { float sq = 0.f; _Pragma("unroll") for (int j = 0; j < 4; ++j) { const float a_ = z[j] * kk0[j], b_ = z[4 + j] * kk1[j]; sq += a_ * a_ + b_ * b_; } \
              sq = DPP_ADD(sq, 0xB1); sq = DPP_ADD(sq, 0x4E); sq = DPP_ADD(sq, 0x141);                   \
              if ((tid & 7) == 0) KNORM[(size_t)t * 32 + ((tid - 256) >> 3)] = sqrtf(sq); } } \
        if (has1) { float z[8]; P2_SHIFT(z, T.cv1, T.pv1, m10, m11);    \
          if (ch1 < 768) { u32x4 w8; w8.x = pk2(z[0], z[1]); w8.y = pk2(z[2], z[3]); w8.z = pk2(z[4], z[5]); w8.w = pk2(z[6], z[7]); *(u32x4*)(VZ + (size_t)t * D + 8 * (ch1 - 512)) = w8; } \
          else { float o[8]; int dcol; \
              if (ch1 < 780) { dcol = 8 * (ch1 - 768); _Pragma("unroll") for (int j = 0; j < 8; ++j) o[j] = tanhf(z[j]); } \
              else if (ch1 < 792) { dcol = 256 + 8 * (ch1 - 780); _Pragma("unroll") for (int j = 0; j < 8; ++j) o[j] = z[j]; } \
              else { dcol = 512 + 8 * (ch1 - 792); _Pragma("unroll") for (int j = 0; j < 8; ++j) o[j] = sigmoidf_(z[j]); } \
              u32x4 w; w.x = pk2(o[0], o[1]); w.y = pk2(o[2], o[3]); w.z = pk2(o[4], o[5]); w.w = pk2(o[6], o[7]); *(u32x4*)(LIN + (size_t)t * 768 + dcol) = w; } } \
        if (tid >= 448 && tid < 488) { const int q_ = tid - 448; const int dcol = (q_ < 20) ? 96 + 8 * q_ : 352 + 8 * (q_ - 20); *(u32x4*)(LIN + (size_t)t * 768 + dcol) = (u32x4){0u, 0u, 0u, 0u}; } \
        if (rot) { const unsigned aw[4] = {T.ra.x, T.ra.y, T.ra.z, T.ra.w}, bw[4] = {T.rb.x, T.rb.y, T.rb.z, T.rb.w}; float o1[8], o2[8]; \
            _Pragma("unroll") for (int j = 0; j < 8; ++j) { const float t1 = bf2f((aw[j >> 1] >> (16 * (j & 1))) & 0xffffu), t2 = bf2f((bw[j >> 1] >> (16 * (j & 1))) & 0xffffu); \
                const float cs = j < 4 ? T.c0[j & 3] : T.c1[j & 3], sn = j < 4 ? T.s0[j & 3] : T.s1[j & 3]; o1[j] = t1 * cs - t2 * sn; o2[j] = t2 * cs + t1 * sn; } \
            const int dl_ = rhh < 8 ? 1 : (rhh < 16 ? 4 : 16); const int prm = (pos % dl_) * (SEQ / dl_) + pos / dl_; \
            bf16_t* dst = (which ? KR : QR) + ((size_t)((t >> 12) * 24 + rhh) * SEQ + prm) * 64 + re0; \
            u32x4 w1; w1.x = pk2(o1[0], o1[1]); w1.y = pk2(o1[2], o1[3]); w1.z = pk2(o1[4], o1[5]); w1.w = pk2(o1[6], o1[7]); \
            u32x4 w2; w2.x = pk2(o2[0], o2[1]); w2.y = pk2(o2[2], o2[3]); w2.z = pk2(o2[4], o2[5]); w2.w = pk2(o2[6], o2[7]); \
            *(u32x4*)dst = w1; *(u32x4*)(dst + 32) = w2; } \
        if (vcp) { const int dl_ = vhh < 8 ? 1 : (vhh < 16 ? 4 : 16); const int prm = (pos % dl_) * (SEQ / dl_) + pos / dl_; \
            *(u32x4*)(VR + ((size_t)((t >> 12) * 24 + vhh) * SEQ + prm) * 64 + ve0) = T.vv; } } while (0)
    P2Tok ta, tb;
    int tq = c.vcu;
    if (tq < M) P2_LOAD(ta, tq);
    for (; tq < M; tq += 2 * c.G) {
        if (tq + c.G < M) P2_LOAD(tb, tq + c.G);
        P2_PROC(ta, tq);
        if (tq + 2 * c.G < M) P2_LOAD(ta, tq + 2 * c.G);
        if (tq + c.G < M) P2_PROC(tb, tq + c.G);
    }
#undef P2_LOAD
#undef P2_SHIFT
#undef P2_PROC
}

__device__ __forceinline__ float wave_sum_dpp(float x) {
    x = DPP_ADD(x, 0xB1); x = DPP_ADD(x, 0x4E); x = DPP_ADD(x, 0x141); x = DPP_ADD(x, 0x140);
    const int xi = __builtin_bit_cast(int, x);
    return (__builtin_bit_cast(float, __builtin_amdgcn_readlane(xi, 0)) + __builtin_bit_cast(float, __builtin_amdgcn_readlane(xi, 16))) +
           (__builtin_bit_cast(float, __builtin_amdgcn_readlane(xi, 32)) + __builtin_bit_cast(float, __builtin_amdgcn_readlane(xi, 48)));
}
__device__ __forceinline__ f32x4 tile_mm(const LAS bf16_t* A, int pa, const LAS bf16_t* Bt, int pb, int ks, int fr, int fq, f32x4 acc) {
    for (int k = 0; k < ks; ++k) { const bf16x8 a = *(const LAS bf16x8*)(A + fr * pa + 32 * k + 8 * fq), b = *(const LAS bf16x8*)(Bt + fr * pb + 32 * k + 8 * fq);
        acc = __builtin_amdgcn_mfma_f32_16x16x32_bf16(a, b, acc, 0, 0, 0); }
    return acc;
}
__device__ __forceinline__ u32x2 pack4(f32x4 v) { u32x2 w; w.x = pk2(v[0], v[1]); w.y = pk2(v[2], v[3]); return w; }
constexpr int SC_C = 32, SC_NCH = SEQ / SC_C, SC_F = 96;
constexpr int PL_X1 = 0, PL_X2 = 9216, PL_AL = 18432, PL_HT = 26112, PL_ET = 33792, PL_LBT = 53760, PL_TT = 58368, PL_XB = 60928, PL_GI = PL_X1, PL_TF = PL_X2, PL_END = 62016, PL_GRP = 65536;
#define LBAR() do { asm volatile("s_waitcnt lgkmcnt(0)" ::: "memory"); __builtin_amdgcn_s_barrier(); asm volatile("" ::: "memory"); } while (0)
__device__ __forceinline__ void p4_pre(const Params& p, const Ctx& c) {
    unsigned char* ws = c.ws;
    const bf16_t* RZ = (const bf16_t*)(ws + WS_RZ); const bf16_t* LDEC = (const bf16_t*)(ws + WS_DEC); const bf16_t* KP = (const bf16_t*)(ws + WS_KP);
    const bf16_t* AN = (const bf16_t*)(ws + WS_AN); const bf16_t* BB = (const bf16_t*)(ws + WS_BB);
    bf16_t* FG = (bf16_t*)(ws + WS_F); float* BON = (float*)(ws + WS_YS);
    const float* rkp = p.in[I_RK];
    int tid_ = c.tid; asm volatile("" : "+v"(tid_));
    const int tid = tid_, lane = tid & 63, w = __builtin_amdgcn_readfirstlane(tid >> 6), fr = lane & 15, fq = lane >> 4;
    const int grp = w >> 2, tw = w & 3, gtid = tid & 255;
    LAS unsigned char* gl = c.lds + grp * PL_GRP;
    LAS bf16_t* X1 = (LAS bf16_t*)(gl + PL_X1); LAS bf16_t* X2 = (LAS bf16_t*)(gl + PL_X2); LAS bf16_t* AL = (LAS bf16_t*)(gl + PL_AL); LAS bf16_t* HT = (LAS bf16_t*)(gl + PL_HT);
    LAS bf16_t* ET = (LAS bf16_t*)(gl + PL_ET); LAS float* LBT = (LAS float*)(gl + PL_LBT); LAS bf16_t* TT = (LAS bf16_t*)(gl + PL_TT); LAS bf16_t* GI = (LAS bf16_t*)(gl + PL_GI);
    LAS float* TF = (LAS float*)(gl + PL_TF);
    LAS float* XB = (LAS float*)(gl + PL_XB);
    const int npair = (128 * SC_NCH) / (2 * c.G);
    unsigned short dcy[32], ir[8], ik[8], ia[8], ib[8];
#define PRE_LOAD(PAIR) do { const int task_ = c.vcu + (2 * (PAIR) + grp) * c.G; const int bh_ = task_ >> 7, ch_ = task_ & (SC_NCH - 1); \
        const size_t o_ = ((size_t)(bh_ >> 5) * SEQ + (size_t)ch_ * SC_C) * D + (bh_ & 31) * 64 + lane; \
        _Pragma("unroll") for (int s_ = 0; s_ < 32; ++s_) dcy[s_] = LDEC[o_ + (size_t)s_ * D]; \
        _Pragma("unroll") for (int q_ = 0; q_ < 8; ++q_) { const size_t oo_ = o_ + (size_t)(8 * tw + q_) * D; ir[q_] = RZ[oo_]; ik[q_] = KP[oo_]; ia[q_] = AN[oo_]; ib[q_] = BB[oo_]; } } while (0)
    const bool bgconv = (c.G == 256);
    if (npair > 0) PRE_LOAD(0);
    for (int pr = 0; pr < npair; ++pr) {
        const int task = c.vcu + (2 * pr + grp) * c.G, bh = task >> 7, chn = task & (SC_NCH - 1);
        const float rkv = rkp[(bh & 31) * 64 + lane];
        float* bon = BON + ((size_t)(bh >> 5) * SEQ + (size_t)chn * SC_C) * 32 + (bh & 31);
        float p0 = 0.f, p1 = 0.f, p2 = 0.f, p3 = 0.f, dsel[8];
#pragma unroll
        for (int s = 0; s < 8; ++s) { const float d0 = bf2f(dcy[s]), d1 = bf2f(dcy[8 + s]), d2 = bf2f(dcy[16 + s]), d3 = bf2f(dcy[24 + s]); p0 += d0; p1 += d1; p2 += d2; p3 += d3;
            dsel[s] = tw == 0 ? d0 : (tw == 1 ? d1 : (tw == 2 ? d2 : d3)); }
        const float gC = __expf((p0 + p1) + (p2 + p3));
        float lg_ = tw == 0 ? 0.f : (tw == 1 ? p0 : (tw == 2 ? p0 + p1 : (p0 + p1) + p2));
        float g = __expf(lg_);
        LBAR();
#pragma unroll
        for (int hq = 0; hq < 2; ++hq) { f32x4 ah4, bg4, kg4;
#pragma unroll
            for (int qq = 0; qq < 4; ++qq) { const int qn = 4 * hq + qq, s = 8 * tw + qn;
                const float gp = g; lg_ += dsel[qn]; g = __expf(lg_);
                const float rr = bf2f(ir[qn]), kk = bf2f(ik[qn]), aa = bf2f(ia[qn]), bb = bf2f(ib[qn]); const float ig = __expf(-lg_);
                const float ah = aa * gp, bt = bb * ig, kt = kk * ig, rh = rr * g;
                X1[s * 72 + lane] = (bf16_t)f2bf(bt); X1[(32 + s) * 72 + lane] = (bf16_t)f2bf(kt); X2[s * 72 + lane] = (bf16_t)f2bf(ah); X2[(32 + s) * 72 + lane] = (bf16_t)f2bf(rh);
                ET[s * 104 + lane] = (bf16_t)f2bf(rh); ah4[qq] = ah; bg4[qq] = bt * gC; kg4[qq] = kt * gC;
                const float bsum = wave_sum_dpp(rr * kk * rkv); if (lane == 0) bon[(size_t)s * 32] = bsum; }
            *(LAS u32x2*)(AL + lane * 40 + 8 * tw + 4 * hq) = pack4(ah4); *(LAS u32x2*)(HT + (32 + lane) * 40 + 8 * tw + 4 * hq) = pack4(bg4); *(LAS u32x2*)(ET + (32 + lane) * 104 + 64 + 8 * tw + 4 * hq) = pack4(kg4); }
        { const int zr = gtid >> 2, zc = 16 * (gtid & 3); LAS u32x4* zp = (LAS u32x4*)(ET + (32 + zr) * 104 + zc); zp[0] = (u32x4){0u, 0u, 0u, 0u}; zp[1] = (u32x4){0u, 0u, 0u, 0u}; }
        if (pr + 1 < npair) PRE_LOAD(pr + 1);
        float cva[32], cvb[32]; int cea = 0, cna = 0, cka = 0, ceb = 0, cnb = 0, ckb = 0;
        if (bgconv) { const int it0 = ((c.vcu * 32 + pr) * 8 + w) * 2;
            cea = it0 >> 12; { const int rem = it0 & 4095; cka = 64 * (rem >> 7); cna = 32 * (rem & 127); }
            ceb = (it0 + 1) >> 12; { const int rem = (it0 + 1) & 4095; ckb = 64 * (rem >> 7); cnb = 32 * (rem & 127); }
            cv_issue(p.in[I_W1] + (size_t)cea * D * 4096, 4096, D, cna, cka, lane, cva); cv_issue(p.in[I_W1] + (size_t)ceb * D * 4096, 4096, D, cnb, ckb, lane, cvb); }
        LBAR();
        if (tw == 0) ET[(32 + lane) * 104 + lane] = (bf16_t)f2bf(gC);
        { const int mt = tw;
#pragma unroll
          for (int nt = 0; nt < 4; ++nt) {
            f32x4 acc = tile_mm(X1 + 16 * mt * 72, 72, X2 + 16 * nt * 72, 72, 2, fr, fq, (f32x4){0.f, 0.f, 0.f, 0.f});
            const int n = 16 * nt + fr, m0 = 16 * mt + 4 * fq;
            if (mt < 2) { if (nt < 2) { const int t = n; f32x4 o;
#pragma unroll
                    for (int e = 0; e < 4; ++e) o[e] = (m0 + e < t) ? acc[e] : 0.f;
                    *(LAS f32x4*)(LBT + t * 36 + m0) = o; }
                else { const int t = n - 32; f32x4 o;
#pragma unroll
                    for (int e = 0; e < 4; ++e) o[e] = (m0 + e <= t) ? acc[e] : 0.f;
                    *(LAS u32x2*)(HT + t * 40 + m0) = pack4(o); } }
            else { const int s0 = m0 - 32;
                if (nt < 2) { const int t = n;
#pragma unroll
                    for (int e = 0; e < 4; ++e) AL[(64 + s0 + e) * 40 + t] = (bf16_t)f2bf((s0 + e < t) ? acc[e] : 0.f); }
                else { const int t = n - 32; f32x4 o;
#pragma unroll
                    for (int e = 0; e < 4; ++e) o[e] = (s0 + e <= t) ? acc[e] : 0.f;
                    *(LAS u32x2*)(ET + t * 104 + 64 + s0) = pack4(o); } } } }
        LBAR();
        if (gtid < 32) { const int hb = 16 * (gtid >> 4), sl = gtid & 15; float Tr[16];
#pragma unroll
            for (int t = 0; t < 16; ++t) { float a0 = (sl == t) ? 1.f : 0.f, a1 = 0.f, a2 = 0.f, a3 = 0.f;
#pragma unroll
                for (int m4 = 0; m4 < (t + 3) / 4; ++m4) { const f32x4 l = *(const LAS f32x4*)(LBT + (hb + t) * 36 + hb + 4 * m4);
                    if (4 * m4 + 0 < t) a0 += Tr[4 * m4 + 0] * l[0]; if (4 * m4 + 1 < t) a1 += Tr[4 * m4 + 1] * l[1]; if (4 * m4 + 2 < t) a2 += Tr[4 * m4 + 2] * l[2]; if (4 * m4 + 3 < t) a3 += Tr[4 * m4 + 3] * l[3]; }
                Tr[t] = (a0 + a1) + (a2 + a3); TF[(hb + sl) * 36 + hb + t] = Tr[t]; TT[(hb + t) * 40 + hb + sl] = (bf16_t)f2bf(Tr[t]);
                if (hb) TT[t * 40 + hb + sl] = 0; } }
        LBAR();
        { const int m = gtid >> 4, tl = gtid & 15; float x = 0.f;
#pragma unroll
            for (int n = 0; n < 16; ++n) x += LBT[(16 + n) * 36 + m] * TF[(16 + n) * 36 + 16 + tl];
            XB[m * 17 + tl] = x; }
        LBAR();
        { const int sr = gtid >> 4, tl = gtid & 15; float x = 0.f;
#pragma unroll
            for (int m = 0; m < 16; ++m) x += TF[sr * 36 + m] * XB[m * 17 + tl];
            TT[(16 + tl) * 40 + sr] = (bf16_t)f2bf(x); }
        LBAR();
        for (int id = tw; id < 12; id += 4) { const int tt = id / 6, nt = id % 6;
            const f32x4 acc = tile_mm(TT + 16 * tt * 40, 40, AL + 16 * nt * 40, 40, 1, fr, fq, (f32x4){0.f, 0.f, 0.f, 0.f});
            *(LAS u32x2*)(GI + (16 * nt + fr) * 40 + 16 * tt + 4 * fq) = pack4(acc); }
        LBAR();
        for (int id = tw; id < 36; id += 4) { const int nt = id / 6, mt = id % 6;
            const f32x4 acc = tile_mm(GI + 16 * nt * 40, 40, HT + 16 * mt * 40, 40, 1, fr, fq, (f32x4){0.f, 0.f, 0.f, 0.f});
            LAS u32x2* ep = (LAS u32x2*)(ET + (16 * mt + fr) * 104 + 16 * nt + 4 * fq); const u32x2 ev = *ep;
            f32x4 o; o[0] = acc[0] + bf2f(ev.x & 0xffffu); o[1] = acc[1] + bf2f(ev.x >> 16); o[2] = acc[2] + bf2f(ev.y & 0xffffu); o[3] = acc[3] + bf2f(ev.y >> 16);
            *ep = pack4(o); }
        LBAR();
        { bf16_t* fg = FG + (size_t)task * (SC_F * SC_F);
          for (int idx = gtid; idx < 96 * 12; idx += 256) { const int row = idx / 12, pc = idx % 12; *(u32x4*)(fg + row * 96 + 8 * pc) = *(const LAS u32x4*)(ET + row * 104 + 8 * pc); } }
        LBAR();
        if (bgconv) { cv_store8(cva, ws + WS_W1 + (size_t)cea * 4096 * D, D, cna, cka, lane); cv_store8(cvb, ws + WS_W1 + (size_t)ceb * 4096 * D, D, cnb, ckb, lane); }
    }
    if (!bgconv) {
        LBAR();
        for (int r = c.vcu * 8 + w; r < NEXP * MOE_W1E; r += c.G * 8) { const int e = r >> 12, rem = r & 4095; float cv[32]; cv_issue(p.in[I_W1] + (size_t)e * D * 4096, 4096, D, 32 * (rem & 127), 64 * (rem >> 7), lane, cv);
            cv_store8(cv, ws + WS_W1 + (size_t)e * 4096 * D, D, 32 * (rem & 127), 64 * (rem >> 7), lane); }
    }
    LBAR();
#undef PRE_LOAD
}
constexpr int SQ_BI = 0, SQ_BI_SZ = 64 * 104 * 2, SQ_YL = 2 * SQ_BI_SZ, SQ_YL_SZ = 32 * 64 * 4;
struct SeqSet { bf16x8 af[3][3]; u32x2 vimg, gimg; float bon; };
__device__ __forceinline__ void p4_seq(const Params& p, const Ctx& c, int bh) {
    unsigned char* ws = c.ws;
    const bf16_t* VZ = (const bf16_t*)(ws + WS_VZ); const bf16_t* GG = (const bf16_t*)(ws + WS_GG); const float* BON = (const float*)(ws + WS_YS);
    const bf16_t* FG = (const bf16_t*)(ws + WS_F) + (size_t)bh * SC_NCH * (SC_F * SC_F);
    bf16_t* YA = (bf16_t*)(ws + WS_YA);
    int tid_ = c.tid; asm volatile("" : "+v"(tid_));
    const int tid = tid_, lane = tid & 63, w = __builtin_amdgcn_readfirstlane(tid >> 6), fr = lane & 15, fq = lane >> 4;
    const int b = bh >> 5, h = bh & 31;
    const size_t base = (size_t)b * SEQ * D + h * 64;
    const int nt = w & 3, mg = w >> 2;
    LAS bf16_t* BI = (LAS bf16_t*)(c.lds + SQ_BI); LAS float* YL = (LAS float*)(c.lds + SQ_YL);
    const int vs = tid >> 4, vi4 = 4 * (tid & 15);
    const f32x4 lg4 = *(const f32x4*)(p.in[I_LNXG] + h * 64 + vi4), lb4 = *(const f32x4*)(p.in[I_LNXB] + h * 64 + vi4);
#define SEQ_LOAD(SET, CHN) do { const int chn_ = (CHN) < SC_NCH ? (CHN) : SC_NCH - 1; const bf16_t* fp = FG + (size_t)chn_ * (SC_F * SC_F); const size_t tk_ = (size_t)b * SEQ + (size_t)(chn_ * SC_C + vs); \
        asm volatile("global_load_dwordx2 %0, %1, off" : "=v"(SET.vimg) : "v"(VZ + tk_ * D + h * 64 + vi4) : "memory"); \
        _Pragma("unroll") for (int mi = 0; mi < 3; ++mi) _Pragma("unroll") for (int ks = 0; ks < 3; ++ks) \
            asm volatile("global_load_dwordx4 %0, %1, off" : "=v"(SET.af[mi][ks]) : "v"(fp + (16 * (3 * mg + mi) + fr) * SC_F + 32 * ks + 8 * fq) : "memory"); \
        asm volatile("global_load_dwordx2 %0, %1, off" : "=v"(SET.gimg) : "v"(GG + tk_ * D + h * 64 + vi4) : "memory"); \
        asm volatile("global_load_dword %0, %1, off" : "=v"(SET.bon) : "v"(BON + tk_ * 32 + h) : "memory"); } while (0)
#define SEQ_WAIT_AF(SET, N) asm volatile("s_waitcnt vmcnt(" #N ")" : "+v"(SET.af[0][0]), "+v"(SET.af[0][1]), "+v"(SET.af[0][2]), "+v"(SET.af[1][0]), "+v"(SET.af[1][1]), "+v"(SET.af[1][2]), \
        "+v"(SET.af[2][0]), "+v"(SET.af[2][1]), "+v"(SET.af[2][2]) :: "memory")
#define SEQ_WAIT_V(SET, N) asm volatile("s_waitcnt vmcnt(" #N ")" : "+v"(SET.vimg) :: "memory")
#define SEQ_WAIT_G(SET, N) asm volatile("s_waitcnt vmcnt(" #N ")" : "+v"(SET.gimg), "+v"(SET.bon), "+v"(SET.vimg) :: "memory")
#define SEQ_BODY(CH, CUR, NXT, NX2) do { const int ch = (CH), cb = ch & 1; \
        const LAS bf16_t* bi = BI + cb * (64 * 104); LAS bf16_t* bo = BI + (cb ^ 1) * (64 * 104); LAS float* yl = YL + cb * (32 * 64); \
        SEQ_LOAD(NX2, ch + 2); \
        bf16x8 bfr[3]; _Pragma("unroll") for (int ks = 0; ks < 3; ++ks) bfr[ks] = *(const LAS bf16x8*)(bi + (16 * nt + fr) * 104 + 32 * ks + 8 * fq); \
        SEQ_WAIT_AF(CUR, 28); \
        f32x4 acc[3]; _Pragma("unroll") for (int mi = 0; mi < 3; ++mi) { acc[mi] = (f32x4){0.f, 0.f, 0.f, 0.f}; \
            _Pragma("unroll") for (int ks = 0; ks < 3; ++ks) acc[mi] = __builtin_amdgcn_mfma_f32_16x16x32_bf16(CUR.af[mi][ks], bfr[ks], acc[mi], 0, 0, 0); } \
        _Pragma("unroll") for (int mi = 0; mi < 3; ++mi) { const int mt = 3 * mg + mi; \
            if (mt < 2) { _Pragma("unroll") for (int e = 0; e < 4; ++e) yl[(16 * mt + 4 * fq + e) * 64 + 16 * nt + fr] = acc[mi][e]; } \
            else *(LAS u32x2*)(bo + (16 * nt + fr) * 104 + 16 * (mt - 2) + 4 * fq) = pack4(acc[mi]); } \
        SEQ_WAIT_V(NXT, 24); \
        if (ch + 1 < SC_NCH) { bo[(vi4 + 0) * 104 + 64 + vs] = (bf16_t)(NXT.vimg.x & 0xffffu); bo[(vi4 + 1) * 104 + 64 + vs] = (bf16_t)(NXT.vimg.x >> 16); \
            bo[(vi4 + 2) * 104 + 64 + vs] = (bf16_t)(NXT.vimg.y & 0xffffu); bo[(vi4 + 3) * 104 + 64 + vs] = (bf16_t)(NXT.vimg.y >> 16); } \
        LBAR(); \
        SEQ_WAIT_G(CUR, 24); \
        { const f32x4 y4 = *(const LAS f32x4*)(yl + vs * 64 + vi4); float sm = (y4[0] + y4[1]) + (y4[2] + y4[3]); \
          sm = DPP_ADD(sm, 0xB1); sm = DPP_ADD(sm, 0x4E); sm = DPP_ADD(sm, 0x141); sm = DPP_ADD(sm, 0x140);     \
          const float mu = sm * (1.0f / 64.0f); const f32x4 d4 = y4 - mu; float q = (d4[0] * d4[0] + d4[1] * d4[1]) + (d4[2] * d4[2] + d4[3] * d4[3]); \
          q = DPP_ADD(q, 0xB1); q = DPP_ADD(q, 0x4E); q = DPP_ADD(q, 0x141); q = DPP_ADD(q, 0x140); \
          const float rstd = rsqrtf(q * (1.0f / 64.0f) + GN_EPS); \
          const float v0 = bf2f(CUR.vimg.x & 0xffffu), v1 = bf2f(CUR.vimg.x >> 16), v2 = bf2f(CUR.vimg.y & 0xffffu), v3 = bf2f(CUR.vimg.y >> 16); \
          const float g0 = bf2f(CUR.gimg.x & 0xffffu), g1 = bf2f(CUR.gimg.x >> 16), g2 = bf2f(CUR.gimg.y & 0xffffu), g3 = bf2f(CUR.gimg.y >> 16); \
          const float o0 = (d4[0] * rstd * lg4[0] + lb4[0] + CUR.bon * v0) * g0, o1 = (d4[1] * rstd * lg4[1] + lb4[1] + CUR.bon * v1) * g1; \
          const float o2 = (d4[2] * rstd * lg4[2] + lb4[2] + CUR.bon * v2) * g2, o3 = (d4[3] * rstd * lg4[3] + lb4[3] + CUR.bon * v3) * g3; \
          *(u32x2*)(YA + ((size_t)b * SEQ + (size_t)(ch * SC_C + vs)) * 2560 + h * 64 + vi4) = (u32x2){pk2(o0, o1), pk2(o2, o3)}; } } while (0)
    SeqSet sa, sb, sc;
    SEQ_LOAD(sa, 0); SEQ_LOAD(sb, 1);
    SEQ_WAIT_V(sa, 0);
    for (int idx = tid; idx < 64 * 8; idx += 512) *(LAS u32x4*)(BI + (idx >> 3) * 104 + 8 * (idx & 7)) = (u32x4){0u, 0u, 0u, 0u};
    BI[(vi4 + 0) * 104 + 64 + vs] = (bf16_t)(sa.vimg.x & 0xffffu); BI[(vi4 + 1) * 104 + 64 + vs] = (bf16_t)(sa.vimg.x >> 16);
    BI[(vi4 + 2) * 104 + 64 + vs] = (bf16_t)(sa.vimg.y & 0xffffu); BI[(vi4 + 3) * 104 + 64 + vs] = (bf16_t)(sa.vimg.y >> 16);
    LBAR();
    for (int c0 = 0; c0 < SC_NCH; c0 += 3) {
        SEQ_BODY(c0, sa, sb, sc);
        if (c0 + 1 < SC_NCH) SEQ_BODY(c0 + 1, sb, sc, sa);
        if (c0 + 2 < SC_NCH) SEQ_BODY(c0 + 2, sc, sa, sb);
    }
    asm volatile("s_waitcnt vmcnt(0)" ::: "memory");
    LBAR();
#undef SEQ_LOAD
#undef SEQ_BODY
#undef SEQ_WAIT_AF
#undef SEQ_WAIT_V
#undef SEQ_WAIT_G
}

__device__ __forceinline__ void p4_attn_task(const Ctx& c, int task) {
    unsigned char* ws = c.ws;
    const bf16_t* QR = (const bf16_t*)(ws + WS_QR); const bf16_t* KR = (const bf16_t*)(ws + WS_KR); const bf16_t* VR = (const bf16_t*)(ws + WS_VR);
    bf16_t* AO = (bf16_t*)(ws + WS_AO); float* LSE = (float*)(ws + WS_LSE);
    constexpr int VP = 280;
    LAS bf16_t* Vt = (LAS bf16_t*)c.lds;
    const int combo = task & 31, hh = (task >> 5) % 24, b = task / (32 * 24);
    const int g = hh >> 3, h = hh & 7;
    const int dil = g == 0 ? 1 : (g == 1 ? 4 : 16), nblk = 32 / dil;
    const int res = combo / nblk, blk = combo % nblk;
    int tid_ = c.tid; asm volatile("" : "+v"(tid_));
    const int tid = tid_, lane = tid & 63, w = __builtin_amdgcn_readfirstlane(tid >> 6);
    const int qq = lane & 15, g4 = lane >> 4, r0 = 16 * w;
    const size_t rowb = (size_t)(b * 24 + hh) * SEQ + (size_t)res * (SEQ / dil) + (size_t)blk * 128;
    bf16x8 qf[2], kf[9][2];
#pragma unroll
    for (int ks = 0; ks < 2; ++ks) qf[ks] = *(const bf16x8*)(QR + (rowb + r0 + qq) * 64 + 32 * ks + 8 * g4);
#pragma unroll
    for (int kt = 0; kt < 9; ++kt) { const bool kv = (blk > 0) || (w + kt >= 8);
#pragma unroll
        for (int ks = 0; ks < 2; ++ks) { kf[kt][ks] = (bf16x8){0, 0, 0, 0, 0, 0, 0, 0};
            if (kv) kf[kt][ks] = *(const bf16x8*)(KR + (rowb - 128 + 16 * (w + kt) + qq) * 64 + 32 * ks + 8 * g4); } }
    const int vki = tid >> 1, vdh = tid & 1;
    u32x4 vv[4];
    if (blk > 0 || vki >= 128) {
#pragma unroll
        for (int j = 0; j < 4; ++j) vv[j] = *(const u32x4*)(VR + (rowb - 128 + vki) * 64 + 32 * vdh + 8 * j); }
    else {
#pragma unroll
        for (int j = 0; j < 4; ++j) vv[j] = (u32x4){0u, 0u, 0u, 0u}; }
    __syncthreads();
#pragma unroll
    for (int j = 0; j < 4; ++j) { const unsigned wv[4] = {vv[j].x, vv[j].y, vv[j].z, vv[j].w};
#pragma unroll
        for (int e = 0; e < 8; ++e) Vt[(32 * vdh + 8 * j + e) * VP + vki] = (bf16_t)((wv[e >> 1] >> (16 * (e & 1))) & 0xffffu); }
    if (tid < 64) {
#pragma unroll
        for (int e = 0; e < 24; ++e) Vt[tid * VP + 256 + e] = 0; }
    f32x4 sc[10];
#pragma unroll
    for (int kt = 0; kt < 9; ++kt) { f32x4 a = (f32x4){0.f, 0.f, 0.f, 0.f};
#pragma unroll
        for (int ks = 0; ks < 2; ++ks) a = __builtin_amdgcn_mfma_f32_16x16x32_bf16(kf[kt][ks], qf[ks], a, 0, 0, 0);
        sc[kt] = a; }
    const int r = r0 + qq;
    float mx = -3.0e38f;
#pragma unroll
    for (int kt = 0; kt < 9; ++kt)
#pragma unroll
        for (int j = 0; j < 4; ++j) { const int ki = 16 * (w + kt) + 4 * g4 + j; const bool ok = (ki >= r) && (ki <= r + 128) && (blk > 0 || ki >= 128);
            const float sv = ok ? sc[kt][j] * 0.125f : -1.0e30f; sc[kt][j] = sv; mx = fmaxf(mx, sv); }
    mx = fmaxf(mx, __shfl_xor(mx, 16)); mx = fmaxf(mx, __shfl_xor(mx, 32));
    float den = 0.f;
#pragma unroll
    for (int kt = 0; kt < 9; ++kt)
#pragma unroll
        for (int j = 0; j < 4; ++j) { const float pexp = __expf(sc[kt][j] - mx); sc[kt][j] = pexp; den += pexp; }
    den += __shfl_xor(den, 16); den += __shfl_xor(den, 32);
    sc[9] = (f32x4){0.f, 0.f, 0.f, 0.f};
    __syncthreads();
    f32x4 oacc[4];
#pragma unroll
    for (int dt = 0; dt < 4; ++dt) oacc[dt] = (f32x4){0.f, 0.f, 0.f, 0.f};
#pragma unroll
    for (int cidx = 0; cidx < 5; ++cidx) {
        const f32x4 p0 = sc[2 * cidx], p1 = sc[2 * cidx + 1];
        u32x4 pw; pw.x = pk2(p0[0], p0[1]); pw.y = pk2(p0[2], p0[3]); pw.z = pk2(p1[0], p1[1]); pw.w = pk2(p1[2], p1[3]);
        const bf16x8 pf = __builtin_bit_cast(bf16x8, pw);
        const int kbase = 16 * (w + 2 * cidx) + 4 * g4;
#pragma unroll
        for (int dt = 0; dt < 4; ++dt) { const LAS bf16_t* vp = Vt + (16 * dt + qq) * VP + kbase;
            const u32x2 lo = *(const LAS u32x2*)vp, hi = *(const LAS u32x2*)(vp + 16);
            u32x4 vw; vw.x = lo.x; vw.y = lo.y; vw.z = hi.x; vw.w = hi.y;
            oacc[dt] = __builtin_amdgcn_mfma_f32_16x16x32_bf16(__builtin_bit_cast(bf16x8, vw), pf, oacc[dt], 0, 0, 0); }
    }
    const float inv = 1.0f / den;
    const size_t tok = (size_t)b * SEQ + (size_t)(blk * 128 + r) * dil + res;
#pragma unroll
    for (int dt = 0; dt < 4; ++dt) { const f32x4 ov = oacc[dt] * inv; *(u32x2*)(AO + ((size_t)g * M + tok) * 512 + h * 64 + 16 * dt + 4 * g4) = (u32x2){pk2(ov[0], ov[1]), pk2(ov[2], ov[3])}; }
    if (g4 == 0) LSE[((size_t)g * M + tok) * 8 + h] = mx + __logf(den);
}

struct KvUnitOrder {
    static constexpr bool GATHER = false;
    const char* A; const char* Bt; int q;
    __device__ bool next(int i, pg8::Unit& u) const {
        if (i != 0) return false;
        const int pm = q & 3, pn = q >> 2;
        u.A = A + (size_t)pm * 256 * D * 2; u.B = Bt + (size_t)pn * 256 * D * 2; u.orow = 256 * pm; u.ocol = 256 * pn; u.aux = 0; u.aux2 = 0; u.valid = 256; return true;
    }
    __device__ __forceinline__ const int* rows(const pg8::Unit&) const { return nullptr; }
};
constexpr int Q_KV = 64, Q_ATT = 3072, Q_TOTAL = Q_KV + Q_ATT + MOE_CONV_GROUPS;
__device__ __forceinline__ void p4_queue(const Params& p, const Ctx& c, volatile LAS unsigned* qslot) {
    unsigned* qc = (unsigned*)(c.ws + WS_CTL) + CW_Q;
    for (;;) {
        __syncthreads();
        if (c.tid == 0) qslot[0] = __hip_atomic_fetch_add(qc, 1u, __ATOMIC_RELAXED, __HIP_MEMORY_SCOPE_AGENT);
        __syncthreads();
        const unsigned it = qslot[0];
        if (it >= (unsigned)Q_TOTAL) break;
        if (it < (unsigned)Q_KV) { const int qi = __builtin_amdgcn_readfirstlane((int)it);
            KvUnitOrder S{(const char*)(c.ws + WS_MEMB), (const char*)(c.ws + WS_WKV), qi};
            pg8::EpiKV E{(bf16_t*)(c.ws + WS_KB), (bf16_t*)(c.ws + WS_VT)};
            pg8::gemm_phase<pg8::EpiKV, KvUnitOrder>(c.lds, pg8::Gemm{D, D, D}, S, E); }
        else if (it < (unsigned)(Q_KV + Q_ATT)) p4_attn_task(c, (int)it - Q_KV); else conv_group(p, c, (int)it - Q_KV - Q_ATT);
    }
}

__device__ __forceinline__ void p5_post(const Params& p, const Ctx& c) {
    unsigned char* ws = c.ws;
    const bf16_t* AO = (const bf16_t*)(ws + WS_AO); const float* LSE = (const float*)(ws + WS_LSE);
    bf16_t* YB = (bf16_t*)(ws + WS_YA);
    const int gw = c.vcu * 8 + c.wave, NGW = c.G * 8, lane = c.lane;
    for (int it = gw; it < M * 8; it += NGW) {
        const int t = it >> 3, h = it & 7;
        const float l0 = LSE[((size_t)0 * M + t) * 8 + h], l1 = LSE[((size_t)1 * M + t) * 8 + h], l2 = LSE[((size_t)2 * M + t) * 8 + h];
        const float mxl = fmaxf(l0, fmaxf(l1, l2)); const float e0 = __expf(l0 - mxl), e1 = __expf(l1 - mxl), e2 = __expf(l2 - mxl); const float inv = 1.0f / (e0 + e1 + e2);
        const size_t o = (size_t)t * 512 + h * 64 + lane;
        const float v = (e0 * bf2f(AO[o]) + e1 * bf2f(AO[(size_t)M * 512 + o]) + e2 * bf2f(AO[(size_t)2 * M * 512 + o])) * inv;
        YB[(size_t)t * 2560 + 2048 + h * 64 + lane] = (bf16_t)f2bf(v);
    }
}

__device__ __forceinline__ void ln_rows(const Ctx& c, const float* in, const float* gam, const float* bet, float* outf, f32x2* stats, unsigned char* outq) {
    const int gw = c.vcu * 8 + c.wave, NGW = c.G * 8, lane = c.lane;
    for (int m = gw; m < M; m += NGW) {
        const f32x4* xr = (const f32x4*)(in + (size_t)m * D) + lane;
        f32x4 v[8]; float s = 0.f;
#pragma unroll
        for (int j = 0; j < 8; ++j) { v[j] = xr[64 * j]; s += (v[j][0] + v[j][1]) + (v[j][2] + v[j][3]); }
        const float mean = wave_sum(s) * (1.0f / D); float s2 = 0.f;
#pragma unroll
        for (int j = 0; j < 8; ++j) { v[j] = v[j] - mean; s2 += (v[j][0] * v[j][0] + v[j][1] * v[j][1]) + (v[j][2] * v[j][2] + v[j][3] * v[j][3]); }
        const float rstd = rsqrtf(wave_sum(s2) * (1.0f / D) + LN_EPS);
        if (stats && lane == 0) stats[m] = (f32x2){mean, rstd};
#pragma unroll
        for (int j = 0; j < 8; ++j) { const int col = 4 * lane + 256 * j; const f32x4 gv = *(const f32x4*)(gam + col), bv = *(const f32x4*)(bet + col);
            const f32x4 o = v[j] * rstd * gv + bv;
            if (outf) *(f32x4*)(outf + (size_t)m * D + col) = o;
            if (outq) *(unsigned*)(outq + (size_t)m * D + col) = pk4_fp8(o[0], o[1], o[2], o[3]); }
    }
}

__device__ __forceinline__ void p15_router(const Params& p, const Ctx& c) {
    unsigned char* ws = c.ws;
    const float* T2 = (const float*)(ws + WS_T2); const f32x2* ST2 = (const f32x2*)(ws + WS_ST2); const float* g2 = p.in[I_LN2G]; const float* b2 = p.in[I_LN2B]; const float* RW = p.in[I_RW]; const float* RB = p.in[I_RB];
    unsigned* cnt = (unsigned*)(ws + WS_CTL) + CW_CNT; int* LIST = (int*)(ws + WS_LIST); int* ROWI = (int*)(ws + WS_ROWI); float* TOPW = (float*)(ws + WS_TOPW);
    LAS float* scr = (LAS float*)(c.lds + c.wave * 8192);
    const int gw = c.vcu * 8 + c.wave, NGW = c.G * 8, lane = c.lane, li = lane & 31, lk = lane >> 5;
    for (int tb = gw; tb < M / 32; tb += NGW) {
        const int t0 = tb * 32;
        f32x16 acc;
#pragma unroll
        for (int j = 0; j < 16; ++j) acc[j] = 0.f;
        const float* xa = T2 + (size_t)(t0 + li) * D + 4 * lk; const f32x2 st = ST2[t0 + li];
        const float* wb = RW + (size_t)(4 * lk) * 32 + li;
        for (int kb = 0; kb < D / 8; ++kb) {
            const f32x4 a = ((*(const f32x4*)(xa + 8 * kb) - st.x) * st.y) * *(const f32x4*)(g2 + 8 * kb + 4 * lk) + *(const f32x4*)(b2 + 8 * kb + 4 * lk);
            const float b0 = wb[(size_t)(8 * kb + 0) * 32], b1 = wb[(size_t)(8 * kb + 1) * 32], b2 = wb[(size_t)(8 * kb + 2) * 32], b3 = wb[(size_t)(8 * kb + 3) * 32];
            acc = __builtin_amdgcn_mfma_f32_32x32x2f32(a[0], b0, acc, 0, 0, 0);
            acc = __builtin_amdgcn_mfma_f32_32x32x2f32(a[1], b1, acc, 0, 0, 0);
            acc = __builtin_amdgcn_mfma_f32_32x32x2f32(a[2], b2, acc, 0, 0, 0);
            acc = __builtin_amdgcn_mfma_f32_32x32x2f32(a[3], b3, acc, 0, 0, 0);
        }
        const float bias = RB[li];
#pragma unroll
        for (int rg = 0; rg < 16; ++rg) { const int row = (rg & 3) + 8 * (rg >> 2) + 4 * lk; scr[row * 33 + li] = acc[rg] + bias; }
        LDS_WAIT(); asm volatile("" ::: "memory");
        if (lane < 32) {
            float lv[32];
#pragma unroll
            for (int e = 0; e < 32; ++e) lv[e] = scr[lane * 33 + e];
            int id[4]; float tv[4];
#pragma unroll
            for (int k = 0; k < 4; ++k) { float best = -3.0e38f; int bi = 0;
#pragma unroll
                for (int e = 0; e < 32; ++e) { const bool tk = lv[e] > best; best = tk ? lv[e] : best; bi = tk ? e : bi; }
                id[k] = bi; tv[k] = best;
#pragma unroll
                for (int e = 0; e < 32; ++e) lv[e] = (e == bi) ? -3.0e38f : lv[e]; }
            const float e1 = __expf(tv[1] - tv[0]), e2 = __expf(tv[2] - tv[0]), e3 = __expf(tv[3] - tv[0]); const float inv = 1.0f / (1.0f + e1 + e2 + e3);
            const float wv[4] = {inv, e1 * inv, e2 * inv, e3 * inv};
            const int t = t0 + lane;
#pragma unroll
            for (int k = 0; k < 4; ++k) { const unsigned slot = __hip_atomic_fetch_add(cnt + id[k], 1u, __ATOMIC_RELAXED, __HIP_MEMORY_SCOPE_AGENT);
                LIST[(size_t)id[k] * CAP + slot] = t; ROWI[(size_t)t * 4 + k] = id[k] * CAP + (int)slot; TOPW[(size_t)t * 4 + k] = wv[k]; }
        }
        LDS_WAIT(); asm volatile("" ::: "memory");
    }
}

__device__ __forceinline__ void moe_table(const Ctx& c, LAS int* tab) {
    if (c.tid == 0) { unsigned* cnt = (unsigned*)(c.ws + WS_CTL) + CW_CNT; int ts = 0;
        for (int e = 0; e < NEXP; ++e) { const int n = (int)__hip_atomic_load(cnt + e, __ATOMIC_RELAXED, __HIP_MEMORY_SCOPE_AGENT); tab[e] = n; tab[32 + e] = ts; ts += (n + 255) >> 8; }
        tab[64] = ts; }
    __syncthreads();
}

__device__ __forceinline__ void p18_combine(const Params& p, const Ctx& c, const LAS int* tab) {
    unsigned char* ws = c.ws;
    const float* T2 = (const float*)(ws + WS_T2); const f32x2* ST2 = (const f32x2*)(ws + WS_ST2); const float* g2 = p.in[I_LN2G]; const float* b2 = p.in[I_LN2B]; const bf16_t* Y = (const bf16_t*)(ws + WS_Y); const int* ROWI = (const int*)(ws + WS_ROWI); const float* TOPW = (const float*)(ws + WS_TOPW);
    const float* gam = p.in[I_LN3G]; const float* bet = p.in[I_LN3B];
    const int gw = c.vcu * 8 + c.wave, NGW = c.G * 8, lane = c.lane;
    for (int m = gw; m < M; m += NGW) {
        f32x4 v[8];
        const f32x4* xr = (const f32x4*)(T2 + (size_t)m * D) + lane; const f32x2 st = ST2[m];
#pragma unroll
        for (int j = 0; j < 8; ++j) { const int col = 4 * lane + 256 * j; v[j] = (((xr[64 * j] - st.x) * st.y) * *(const f32x4*)(g2 + col) + *(const f32x4*)(b2 + col)) * DN_ALPHA; }
#pragma unroll
        for (int k = 0; k < 4; ++k) { const int ri = ROWI[(size_t)m * 4 + k]; const float gt = TOPW[(size_t)m * 4 + k]; const int e = ri >> 14, slot = ri & (CAP - 1);
            const u32x2* yr = (const u32x2*)(Y + ((size_t)tab[32 + e] * 256 + slot) * D) + lane;
#pragma unroll
            for (int j = 0; j < 8; ++j) { const u32x2 yw = yr[64 * j]; v[j] = v[j] + (f32x4){bf2f(yw.x & 0xffffu), bf2f(yw.x >> 16), bf2f(yw.y & 0xffffu), bf2f(yw.y >> 16)} * gt; } }
        float s = 0.f;
#pragma unroll
        for (int j = 0; j < 8; ++j) s += (v[j][0] + v[j][1]) + (v[j][2] + v[j][3]);
        const float mean = wave_sum(s) * (1.0f / D); float s2 = 0.f;
#pragma unroll
        for (int j = 0; j < 8; ++j) { v[j] = v[j] - mean; s2 += (v[j][0] * v[j][0] + v[j][1] * v[j][1]) + (v[j][2] * v[j][2] + v[j][3] * v[j][3]); }
        const float rstd = rsqrtf(wave_sum(s2) * (1.0f / D) + LN_EPS);
#pragma unroll
        for (int j = 0; j < 8; ++j) { const int col = 4 * lane + 256 * j; const f32x4 gv = *(const f32x4*)(gam + col), bv = *(const f32x4*)(bet + col);
            *(f32x4*)(p.out + (size_t)m * D + col) = v[j] * rstd * gv + bv; }
    }
}

constexpr int NPHASE = 19;
__global__ void __launch_bounds__(512, 2) fwd(Params p) {
    extern __shared__ __attribute__((aligned(16))) unsigned char lds_raw[];
    LAS unsigned char* lds = (LAS unsigned char*)lds_raw;
    Ctx c; c.tid = threadIdx.x; c.lane = c.tid & 63; c.wave = __builtin_amdgcn_readfirstlane(c.tid >> 6); c.G = gridDim.x;
    { const int bx = blockIdx.x; c.vcu = (c.G % 8 == 0) ? (bx % 8) * (c.G / 8) + bx / 8 : bx; }
    c.lds = lds; c.ws = p.ws;
    unsigned char* ws = p.ws;
    volatile LAS unsigned* MISC = (volatile LAS unsigned*)(lds + MISC_OFF);
    LAS int* tab = (LAS int*)(lds + MISC_OFF + 1024);
    if (c.tid < 64) MISC[c.tid] = 0u;
    __syncthreads();
    unsigned* ctl = (unsigned*)(ws + WS_CTL);
    XcdBarrier bar; bar.bar = ctl + CW_BAR + p.li * XCD_BAR_WORDS; bar.x = 0; bar.st = MISC + 8;
    if (N_LAUNCH_MODE == 1) bar = xcd_barrier_post(ctl + CW_BAR + p.li * XCD_BAR_WORDS, MISC + 8);
    const int lo = p.ph_lo, hi = p.ph_hi, bx = blockIdx.x;
#ifndef PHMASK
#define PHMASK 0xFFFFFFFFu
#endif
#define IN(k) (((PHMASK >> (k)) & 1u) && lo <= (k) && (k) < hi)
#define SEAM(k) do { if (N_LAUNCH_MODE == 1 && IN((k) + 1)) xcd_barrier(bar); } while (0)

    if (IN(0)) { p0_prologue(p, c); SEAM(0); }

    if (IN(1)) {
        { pg8::StaticOrder S; S.init(ws + WS_XB, ws + WS_WIN, M, ATT0, D, D, c.G, bx);
          pg8::EpiBf16 E{(bf16_t*)(ws + WS_PROJ), PC, 1.0f};
          pg8::gemm_phase<pg8::EpiBf16, pg8::StaticOrder>(lds, pg8::Gemm{D, D, D}, S, E); }
        { pg8::StaticOrder S; S.init(ws + WS_XQ, ws + WS_WIN8, M, PC - ATT0, D, D, c.G, bx, 1);
          pg8::EpiBf16 E{(bf16_t*)(ws + WS_PROJ) + ATT0, PC, 1.0f};
          pg8::gemm_phase<pg8::EpiBf16, pg8::StaticOrder, true, true>(lds, pg8::Gemm{D, D, D}, S, E); }
        SEAM(1);
    }
    if (IN(2)) { p2_prep(p, c); SEAM(2); }

    if (IN(3)) {
#ifndef P3M
#define P3M 15
#endif
        if (P3M & 1) { pg8::StaticOrder S; S.init(ws + WS_LIN, ws + WS_WUP, M, D, 768, 256, c.G, bx);
          pg8::EpiDecay E{(bf16_t*)(ws + WS_DEC), p.in[I_W0]};
          pg8::gemm_phase<pg8::EpiDecay, pg8::StaticOrder>(lds, pg8::Gemm{256, 768, 256}, S, E); }
        if (P3M & 2) { pg8::StaticOrder S; S.init(ws + WS_LIN + 512, ws + WS_AUP, M, D, 768, 256, c.G, bx);
          pg8::EpiIclr E{p.in[I_A0], p.in[I_KK], p.in[I_KA], (const bf16_t*)(ws + WS_KZ), (const float*)(ws + WS_KNORM), (bf16_t*)(ws + WS_KP), (bf16_t*)(ws + WS_AN), (bf16_t*)(ws + WS_BB)};
          pg8::gemm_phase<pg8::EpiIclr, pg8::StaticOrder>(lds, pg8::Gemm{256, 768, 256}, S, E); }
        if (P3M & 4) { pg8::StaticOrder S; S.init(ws + WS_LIN + 1024, ws + WS_GUP, M, D, 768, 256, c.G, bx);
          pg8::EpiBf16 E{(bf16_t*)(ws + WS_GG), D, 1.0f};
          pg8::gemm_phase<pg8::EpiBf16, pg8::StaticOrder>(lds, pg8::Gemm{256, 768, 256}, S, E); }
        SEAM(3);
    }
    if (IN(4)) {
        p4_pre(p, c);
        xcd_barrier(bar);
        for (int bh = c.vcu; bh < 128; bh += c.G) p4_seq(p, c, bh);
        p4_queue(p, c, MISC + 16);
        SEAM(4);
    }
    if (IN(5)) { p5_post(p, c); }

    if (IN(6)) {
        pg8::StaticOrder S; S.init(ws + WS_YA, ws + WS_PA, M, D, 2560, 2560, c.G, bx);
        pg8::EpiGateFused E{(const bf16_t*)(ws + WS_PROJ), (bf16_t*)(ws + WS_MERGED)};
        pg8::gemm_phase<pg8::EpiGateFused, pg8::StaticOrder>(lds, pg8::Gemm{2560, 2560, 2560}, S, E);
        SEAM(6);
    }
    if (IN(7)) { }
    if (IN(8)) {
        pg8::StaticOrder S; S.init(ws + WS_MERGED, ws + WS_WOUT, M, D, D, D, c.G, bx);
        pg8::EpiF32 E{(float*)(ws + WS_T1), D, nullptr, 0, p.in[I_X], DN_ALPHA};
        pg8::gemm_phase<pg8::EpiF32, pg8::StaticOrder>(lds, pg8::Gemm{D, D, D}, S, E);
        SEAM(8);
    }
    if (IN(9)) { ln_rows(c, (const float*)(ws + WS_T1), p.in[I_LN1G], p.in[I_LN1B], nullptr, (f32x2*)(ws + WS_ST1), ws + WS_X1B); SEAM(9); }

    if (IN(10)) {
        pg8::StaticOrder S; S.init(ws + WS_X1B, ws + WS_WQ, M, D, D, D, c.G, bx, 1);
        pg8::EpiBf16 E{(bf16_t*)(ws + WS_Q), D, 0.04419417382415922f};
        pg8::gemm_phase<pg8::EpiBf16, pg8::StaticOrder, true, true>(lds, pg8::Gemm{D, D, D}, S, E);
        SEAM(10);
    }
    if (IN(11)) {
        ScoreOrder S{(const char*)(ws + WS_Q), (const char*)(ws + WS_KB), c.G, bx};
        pg8::EpiSoftmax E{(bf16_t*)(ws + WS_PP)};
        pg8::gemm_phase<pg8::EpiSoftmax, ScoreOrder, false>(lds, pg8::Gemm{512, D, D}, S, E);
        SEAM(11);
    }
    if (IN(12)) {
        PvOrder S{(const char*)(ws + WS_PP), (const char*)(ws + WS_VT), c.G, bx};
        pg8::EpiBf16 E{(bf16_t*)(ws + WS_OC), D, 1.0f};
        pg8::gemm_phase<pg8::EpiBf16, PvOrder>(lds, pg8::Gemm{256, 256, 256}, S, E);
        SEAM(12);
    }
    if (IN(13)) {
        pg8::StaticOrder S; S.init(ws + WS_OC, ws + WS_WO, M, D, D, D, c.G, bx);
        pg8::EpiResLn E{(float*)(ws + WS_T2), (const float*)(ws + WS_T1), (const f32x2*)(ws + WS_ST1), p.in[I_LN1G], p.in[I_LN1B], DN_ALPHA};
        pg8::gemm_phase<pg8::EpiResLn, pg8::StaticOrder>(lds, pg8::Gemm{D, D, D}, S, E);
        SEAM(13);
    }
    if (IN(14)) { ln_rows(c, (const float*)(ws + WS_T2), p.in[I_LN2G], p.in[I_LN2B], nullptr, (f32x2*)(ws + WS_ST2), ws + WS_X2B); SEAM(14); }
    if (IN(15)) { p15_router(p, c); SEAM(15); }

    if (IN(16)) {
        moe_table(c, tab);
        MoeOrder<true, 16> S{tab, (const char*)(ws + WS_X2B), (const char*)(ws + WS_W1), (const int*)(ws + WS_LIST), (size_t)4096 * D, D, c.G, bx};
        pg8::EpiSwiglu E{p.in[I_B1], (bf16_t*)(ws + WS_H)};
        pg8::gemm_phase<pg8::EpiSwiglu, MoeOrder<true, 16>, true, true>(lds, pg8::Gemm{D, D, D}, S, E);
        SEAM(16);
    }
    if (IN(17)) {
        moe_table(c, tab);
        MoeOrder<false, 8> S{tab, (const char*)(ws + WS_H), (const char*)(ws + WS_W2), (const int*)(ws + WS_LIST), (size_t)D * DFF, DFF, c.G, bx};
        pg8::EpiBf16Bias E{(bf16_t*)(ws + WS_Y), D, p.in[I_B2], D};
        pg8::gemm_phase<pg8::EpiBf16Bias, MoeOrder<false, 8>, true, true>(lds, pg8::Gemm{DFF, DFF, DFF}, S, E);
        SEAM(17);
    }
    if (IN(18)) { moe_table(c, tab); p18_combine(p, c, tab); }
#undef IN
#undef SEAM
}

extern "C" void kernel_launch(void* const* d_in, const int* in_sizes, int n_in, void* d_out, int out_size, void* d_ws, size_t ws_size, hipStream_t stream) {
    static int grid = 0;
    if (grid == 0) {
        if (n_in != 32 || out_size != M * D || ws_size < WS_END) { fprintf(stderr, "kernel_launch: expected 32 inputs, %d outputs, >= %zu bytes of workspace; got %d, %d, %zu\n", M * D, (size_t)WS_END, n_in, out_size, ws_size); grid = -1; return; }
        int dev = 0, cus = 0, per_cu = 0;
        if (hipGetDevice(&dev) != hipSuccess || hipDeviceGetAttribute(&cus, hipDeviceAttributeMultiprocessorCount, dev) != hipSuccess) { grid = -1; return; }
        if (hipFuncSetAttribute((const void*)fwd, hipFuncAttributeMaxDynamicSharedMemorySize, LDS_BYTES) != hipSuccess) { fprintf(stderr, "kernel_launch: hipFuncSetAttribute failed\n"); grid = -1; return; }
        if (hipOccupancyMaxActiveBlocksPerMultiprocessor(&per_cu, (const void*)fwd, 512, LDS_BYTES) != hipSuccess || per_cu < 1) fprintf(stderr, "kernel_launch: occupancy query reports %d\n", per_cu);
        (void)hipGetLastError();
        grid = cus;
        if (grid != 256) fprintf(stderr, "kernel_launch: %d CUs; this kernel is built for 256\n", grid);
    }
    if (grid < 0) return;
    (void)hipMemsetAsync((char*)d_ws + WS_CTL, 0, CTL_ZERO_BYTES, stream);
    Params p{};
    for (int i = 0; i < 32; ++i) p.in[i] = (const float*)d_in[i];
    p.out = (float*)d_out; p.ws = (unsigned char*)d_ws;
#if defined(TIMING_REPEAT_LO)
    { const int cuts[4][2] = {{0, TIMING_REPEAT_HI}, {TIMING_REPEAT_LO, TIMING_REPEAT_HI}, {TIMING_REPEAT_HI, NPHASE}, {0, 0}};
      for (int li = 0; li < 3; ++li) { if (cuts[li][0] >= cuts[li][1]) continue; p.ph_lo = cuts[li][0]; p.ph_hi = cuts[li][1]; p.li = li; hipLaunchKernelGGL(fwd, dim3(grid), dim3(512), LDS_BYTES, stream, p); } }
#else
    if (N_LAUNCH_MODE == 1) { p.ph_lo = 0; p.ph_hi = NPHASE; hipLaunchKernelGGL(fwd, dim3(grid), dim3(512), LDS_BYTES, stream, p); }
    else for (int k = 0; k < NPHASE; ++k) { p.ph_lo = k; p.ph_hi = k + 1; hipLaunchKernelGGL(fwd, dim3(grid), dim3(512), LDS_BYTES, stream, p); }
#endif
}
```

```cpp
#include <hip/hip_runtime.h>
#include <cstdio>
#include <cstdint>

#define LAS __attribute__((address_space(3)))
#define GAS __attribute__((address_space(1)))
typedef unsigned short bf16_t;
typedef short bf16x8 __attribute__((ext_vector_type(8)));
typedef float f32x4 __attribute__((ext_vector_type(4)));
typedef float f32x2 __attribute__((ext_vector_type(2)));
typedef float f32x16 __attribute__((ext_vector_type(16)));
typedef unsigned u32x4 __attribute__((ext_vector_type(4)));
typedef unsigned u32x2 __attribute__((ext_vector_type(2)));

#ifndef N_LAUNCH_MODE
#define N_LAUNCH_MODE 1
#endif

constexpr int M = 16384, D = 2048, SEQ = 4096, NBATCH = 4;
constexpr int RWC = 6592;
constexpr int PC = 15360;
constexpr int ATTV2 = 6656, ATT0 = 7168, GATE0 = 11264;
constexpr int NEXP = 32, DFF = 2048, CAP = 16384;
constexpr int HROWS = 65536 + 32 * 256;
constexpr float LN_EPS = 1e-5f, GN_EPS = 64e-5f;
constexpr float DN_ALPHA = 1.189207115002721f;

__device__ __forceinline__ float bf2f(unsigned v) { return __uint_as_float(v << 16); }
typedef __bf16 bf16x2_t __attribute__((ext_vector_type(2)));
__device__ __forceinline__ unsigned pk2(float lo, float hi) { const bf16x2_t r = __builtin_convertvector((f32x2){lo, hi}, bf16x2_t); return __builtin_bit_cast(unsigned, r); }
__device__ __forceinline__ unsigned f2bf(float f) { return pk2(f, 0.f) & 0xffffu; }
typedef int v4i __attribute__((ext_vector_type(4)));
typedef int v8i __attribute__((ext_vector_type(8)));
__device__ __forceinline__ unsigned pk4_fp8(float a, float b, float c, float d) { int r = __builtin_amdgcn_cvt_pk_fp8_f32(a, b, 0, false); r = __builtin_amdgcn_cvt_pk_fp8_f32(c, d, r, true); return (unsigned)r; }
__device__ __forceinline__ float sigmoidf_(float x) { return __builtin_amdgcn_rcpf(1.0f + __expf(-x)); }
__device__ __forceinline__ float wave_sum(float v) {
#pragma unroll
    for (int o = 1; o < 64; o <<= 1) v += __shfl_xor(v, o);
    return v;
}
#define LDS_WAIT() asm volatile("s_waitcnt lgkmcnt(0)" ::: "memory")
#define VM_WAIT() asm volatile("s_waitcnt vmcnt(0)" ::: "memory")

namespace pg8 {
#define PG8_LAS __attribute__((address_space(3)))
constexpr int BM = 256, BK = 64, HALF = 128, HTB = HALF * BK * 2, STAGE_BYTES = 8 * HTB, NXCD = 8, WGM = 8;

__host__ __device__ __forceinline__ int lds_byte(int r, int c) { const int st = (r >> 4) * 2 + (c >> 5), rr = r & 15, cc = c & 31, ob = rr * 64 + cc * 2; return st * 1024 + (ob ^ (((ob >> 9) & 1) << 5)); }
__host__ __device__ __forceinline__ void stage_rc(int b, int& R, int& C) { const int st = b / 1024, sb = b % 1024, swz = sb ^ (((sb >> 9) & 1) << 5); R = (st >> 1) * 16 + swz / 64; C = (st & 1) * 32 + (swz % 64) / 2; }
__host__ __device__ __forceinline__ int perm32(int rho) { const int n = rho >> 4, i = rho & 15; return 8 * (i >> 2) + 4 * n + (i & 3); }

struct Unit { const char* A; const char* B; int orow, ocol, aux, aux2, valid; };
struct Gemm { int K, lda, ldb; };

struct StaticOrder {
    static constexpr bool GATHER = false;
    const char* A; const char* Bt; size_t ta, tb;
    int nM, nN, nwg, G, c;
    __device__ void init(const void* A_, const void* Bt_, int M_, int N_, int lda, int ldb, int G_, int c_, int esz = 2) { A = (const char*)A_; Bt = (const char*)Bt_; ta = (size_t)BM * lda * esz; tb = (size_t)BM * ldb * esz; nM = M_ / BM; nN = N_ / BM; nwg = nM * nN; G = G_; c = c_; }
    __device__ bool next(int i, Unit& u) const {
        const long L = (long)i * G + c; if (c < 0 || L >= nwg) return false;
        int wgid = (int)L; { const int q = nwg / NXCD, r = nwg % NXCD, xcd = wgid % NXCD, off = wgid / NXCD; wgid = (xcd < r ? xcd * (q + 1) : r * (q + 1) + (xcd - r) * q) + off; }
        const int nig = WGM * nN, gid = wgid / nig, fm = gid * WGM, gsz = (nM - fm) < WGM ? (nM - fm) : WGM;
        const int pm = fm + ((wgid % nig) % gsz), pn = (wgid % nig) / gsz;
        u.A = A + (size_t)pm * ta; u.B = Bt + (size_t)pn * tb; u.orow = pm * BM; u.ocol = pn * BM; u.aux = 0; u.aux2 = 0; u.valid = BM; return true;
    }
    __device__ __forceinline__ const int* rows(const Unit&) const { return nullptr; }
};

__device__ __forceinline__ unsigned cvt_pk_bf16(float lo, float hi) { return ::pk2(lo, hi); }

template <class Epi, class Sched, bool ALIGN_EPI = true, bool FP8 = false>
__device__ __forceinline__ void gemm_phase(PG8_LAS unsigned char* lds, const Gemm g, const Sched& S, const Epi& E) {
    const int tid = threadIdx.x, wid = __builtin_amdgcn_readfirstlane(tid >> 6), lane = tid & 63, wr = wid >> 2, wc = wid & 3, fr = lane & 15, fq = lane >> 4;
    constexpr int ES = FP8 ? 1 : 2;
    int sclW = 0, sclX = 0;
    if constexpr (FP8) { asm volatile("v_mov_b32 %0, 0x79797979\n\tv_mov_b32 %1, 0x7f7f7f7f" : "=v"(sclW), "=v"(sclX)); }
    const int K = g.K, nt = K * ES / (BK * 2);
    unsigned voffA[2], voffB[2]; int Rr[2], Cc[2];
#pragma unroll
    for (int i = 0; i < 2; ++i) { int R, C; stage_rc(tid * 16 + i * 8192, R, C); const int Rb = Epi::PERM ? ((R & ~31) + perm32(R & 31)) : R; Rr[i] = R; Cc[i] = C;
        voffA[i] = (unsigned)(R * g.lda * ES + C * 2); voffB[i] = (unsigned)(Rb * g.ldb * ES + C * 2); }
    const size_t kstep = (size_t)(BK * 2);
    const size_t hstepA = (size_t)HALF * g.lda * ES, hstepB = (size_t)HALF * g.ldb * ES;
    const unsigned ldsw = (unsigned)wid * 1024u;
    const int aoff = lds_byte(wr * 64 + fr, fq * 8), boff = lds_byte(wc * 32 + fr, fq * 8);
    unsigned vAc[2][2], vAn[2][2];
#define PG8_SA(b, h) (((b) * 2 + (h)) * HTB)
#define PG8_SB(b, h) ((4 + (b) * 2 + (h)) * HTB)
#define PG8_STAGE(bufoff, gbase, voff) do { _Pragma("unroll") for (int _i = 0; _i < 2; ++_i) \
        __builtin_amdgcn_global_load_lds((const unsigned*)((const char*)(gbase) + (voff)[_i]), (PG8_LAS unsigned*)(lds + (bufoff) + ldsw + _i * 8192), 16, 0, 0); } while (0)
#define PG8_STAGE_A(bufoff, kbase, h, nx) do { if constexpr (Sched::GATHER) { unsigned _v[2] = {(nx) ? vAn[h][0] : vAc[h][0], (nx) ? vAn[h][1] : vAc[h][1]}; PG8_STAGE(bufoff, kbase, _v); } \
        else { PG8_STAGE(bufoff, (kbase) + (h) * hstepA, voffA); } } while (0)
#define PG8_GOFF(u, v) do { const int* _rw = S.rows(u); _Pragma("unroll") for (int _h = 0; _h < 2; ++_h) _Pragma("unroll") for (int _i = 0; _i < 2; ++_i) { const int _r = Rr[_i] + _h * HALF; \
        const int _tk = _r < (u).valid ? _rw[_r] : 0; v[_h][_i] = (unsigned)(_tk * g.lda * ES + Cc[_i] * 2); } } while (0)
#define PG8_LDA(dst, b, h) do { _Pragma("unroll") for (int m = 0; m < 4; ++m) _Pragma("unroll") for (int k = 0; k < 2; ++k) dst[m][k] = *(const PG8_LAS bf16x8*)(lds + PG8_SA(b, h) + aoff + m * 2048 + k * 1024); } while (0)
#define PG8_LDB(dst, b, h) do { _Pragma("unroll") for (int n = 0; n < 2; ++n) _Pragma("unroll") for (int k = 0; k < 2; ++k) dst[n][k] = *(const PG8_LAS bf16x8*)(lds + PG8_SB(b, h) + boff + n * 2048 + k * 1024); } while (0)
#define PG8_MMA(ai, bj, At, Bt) do { __builtin_amdgcn_s_setprio(1); _Pragma("unroll") for (int m = 0; m < 4; ++m) _Pragma("unroll") for (int n = 0; n < 2; ++n) { \
        if constexpr (FP8) { const v4i _b0 = __builtin_bit_cast(v4i, Bt[n][0]), _b1 = __builtin_bit_cast(v4i, Bt[n][1]), _a0 = __builtin_bit_cast(v4i, At[m][0]), _a1 = __builtin_bit_cast(v4i, At[m][1]); \
            const v8i _bb = __builtin_shufflevector(_b0, _b1, 0, 1, 2, 3, 4, 5, 6, 7), _aa = __builtin_shufflevector(_a0, _a1, 0, 1, 2, 3, 4, 5, 6, 7); \
            asm volatile("v_mfma_scale_f32_16x16x128_f8f6f4 %0, %1, %2, %0, %3, %4 op_sel_hi:[0,0,0]" : "+v"(acc[ai][bj][m][n]) : "v"(_bb), "v"(_aa), "v"(sclW), "v"(sclX)); } \
        else { _Pragma("unroll") for (int k = 0; k < 2; ++k) acc[ai][bj][m][n] = __builtin_amdgcn_mfma_f32_16x16x32_bf16(Bt[n][k], At[m][k], acc[ai][bj][m][n], 0, 0, 0); } } \
        __builtin_amdgcn_s_setprio(0); } while (0)
#define PG8_WAIT_V(n) asm volatile("s_waitcnt vmcnt(" #n ")" ::: "memory")
#define PG8_WAIT_L(n) asm volatile("s_waitcnt lgkmcnt(" #n ")" ::: "memory")
#define PG8_BAR __builtin_amdgcn_s_barrier()
#define PG8_SCHED __builtin_amdgcn_sched_barrier(0)
    Unit cur, nxt; int ui = 0;
    if (!S.next(0, cur)) return;
    f32x4 acc[2][2][4][2];
#pragma unroll
    for (int a = 0; a < 2; ++a)
#pragma unroll
        for (int b = 0; b < 2; ++b)
#pragma unroll
            for (int m = 0; m < 4; ++m)
#pragma unroll
                for (int n = 0; n < 2; ++n) acc[a][b][m][n] = (f32x4){0.f, 0.f, 0.f, 0.f};
    bf16x8 At[4][2], B0[2][2], B1[2][2];
    const char* cA = cur.A; const char* cB = cur.B;
    if constexpr (Sched::GATHER) { PG8_GOFF(cur, vAc); PG8_WAIT_V(0); }
    PG8_STAGE(PG8_SB(0, 0), cB, voffB); PG8_STAGE(PG8_SB(0, 1), cB + hstepB, voffB); PG8_STAGE_A(PG8_SA(0, 0), cA, 0, false); PG8_STAGE_A(PG8_SA(0, 1), cA, 1, false);
    if (wr == 1) PG8_BAR;
    PG8_WAIT_V(2); PG8_BAR;
    PG8_STAGE(PG8_SB(1, 0), cB + kstep, voffB); PG8_STAGE_A(PG8_SA(1, 0), cA + kstep, 0, false); PG8_STAGE(PG8_SB(1, 1), cB + hstepB + kstep, voffB);
    PG8_WAIT_V(6); PG8_BAR;
    for (;;) {
        const bool has_next = S.next(ui + 1, nxt);
        const char* nA = has_next ? nxt.A : cA; const char* nB = has_next ? nxt.B : cB;
        if constexpr (Sched::GATHER) { if (has_next) { PG8_GOFF(nxt, vAn); } else {
#pragma unroll
            for (int h = 0; h < 2; ++h)
#pragma unroll
                for (int i = 0; i < 2; ++i) vAn[h][i] = vAc[h][i]; } }
#pragma nounroll
        for (int t = 0; t < nt; t += 2) {
            const bool last = (t == nt - 2);
            if constexpr (Epi::MID_T >= 0) { if (t == Epi::MID_T) { int l3 = lane; asm volatile("" : "+v"(l3)); E.mid(acc, cur, wr, wc, l3 & 15, l3 >> 4); } }
            const char* a1 = cA + (size_t)(t + 1) * kstep;
            const char* a2 = last ? nA : cA + (size_t)(t + 2) * kstep; const char* b2 = last ? nB : cB + (size_t)(t + 2) * kstep;
            const char* a3 = a2 + kstep; const char* b3 = b2 + kstep;
            PG8_LDB(B0, 0, 0); PG8_LDB(B1, 0, 1); PG8_SCHED; PG8_LDA(At, 0, 0); PG8_STAGE_A(PG8_SA(1, 1), a1, 1, false);
            PG8_WAIT_V(8); PG8_WAIT_L(0); PG8_BAR; PG8_MMA(0, 0, At, B0); PG8_MMA(0, 1, At, B1); PG8_BAR; PG8_SCHED;
            PG8_LDA(At, 0, 1); PG8_STAGE(PG8_SB(0, 0), b2, voffB); PG8_STAGE(PG8_SB(0, 1), b2 + hstepB, voffB); PG8_STAGE_A(PG8_SA(0, 0), a2, 0, last);
            PG8_WAIT_V(8); PG8_WAIT_L(0); PG8_BAR; PG8_MMA(1, 0, At, B0); PG8_MMA(1, 1, At, B1); PG8_BAR; PG8_SCHED;
            PG8_LDB(B0, 1, 0); PG8_LDB(B1, 1, 1); PG8_SCHED; PG8_LDA(At, 1, 0); PG8_STAGE_A(PG8_SA(0, 1), a2, 1, last);
            PG8_WAIT_V(8); PG8_WAIT_L(0); PG8_BAR; PG8_MMA(0, 0, At, B0); PG8_MMA(0, 1, At, B1); PG8_BAR; PG8_SCHED;
            PG8_LDA(At, 1, 1); PG8_STAGE(PG8_SB(1, 0), b3, voffB); PG8_STAGE(PG8_SB(1, 1), b3 + hstepB, voffB); PG8_STAGE_A(PG8_SA(1, 0), a3, 0, last);
            PG8_WAIT_V(8); PG8_WAIT_L(0); PG8_BAR; PG8_MMA(1, 0, At, B0); PG8_MMA(1, 1, At, B1); PG8_BAR; PG8_SCHED;
        }
        if constexpr (ALIGN_EPI) { if (wr == 0) PG8_BAR; }
        if constexpr (FP8) asm volatile("s_nop 15\n\ts_nop 15" ::: "memory");
        if constexpr (!Epi::AFTER_DRAIN) { int l2 = lane; asm volatile("" : "+v"(l2));
            E(acc, cur, wr, wc, l2 & 15, l2 >> 4); }
        if (!has_next) break;
#pragma unroll
        for (int a = 0; a < 2; ++a)
#pragma unroll
            for (int b = 0; b < 2; ++b)
#pragma unroll
                for (int m = 0; m < 4; ++m)
#pragma unroll
                    for (int n = 0; n < 2; ++n) acc[a][b][m][n] = (f32x4){0.f, 0.f, 0.f, 0.f};
        cur = nxt; cA = nA; cB = nB; ++ui;
        if constexpr (Sched::GATHER) {
#pragma unroll
            for (int h = 0; h < 2; ++h)
#pragma unroll
                for (int i = 0; i < 2; ++i) vAc[h][i] = vAn[h][i]; }
        if constexpr (ALIGN_EPI) { if (wr == 1) PG8_BAR; }
    }
    PG8_WAIT_V(0);
    if constexpr (!ALIGN_EPI) { if (wr == 0) PG8_BAR; }
    PG8_BAR;
    if constexpr (Epi::AFTER_DRAIN) { E.fused(acc, cur, wr, wc, fr, fq, lds, wid, lane); }
#undef PG8_SA
#undef PG8_SB
#undef PG8_STAGE
#undef PG8_STAGE_A
#undef PG8_GOFF
#undef PG8_LDA
#undef PG8_LDB
#undef PG8_MMA
#undef PG8_WAIT_V
#undef PG8_WAIT_L
#undef PG8_BAR
#undef PG8_SCHED
}

#define EPI_LOOP_AI_M for (int ai = 0; ai < 2; ++ai) _Pragma("unroll") for (int m = 0; m < 4; ++m)

struct EpiF32 {
    static constexpr bool PERM = false, AFTER_DRAIN = false; static constexpr int MID_T = -1;
    float* C; int ldc; const float* bias; int bstride; const float* res; float alpha;
    __device__ __forceinline__ void operator()(const f32x4 (&acc)[2][2][4][2], const Unit& u, int wr, int wc, int fr, int fq) const {
        const int row0 = u.orow + wr * 64 + fr, col0 = u.ocol + wc * 32 + 4 * fq;
        f32x4 bv[2][2];
#pragma unroll
        for (int bj = 0; bj < 2; ++bj)
#pragma unroll
            for (int n = 0; n < 2; ++n) bv[bj][n] = bias ? *(const f32x4*)(bias + (size_t)u.aux * bstride + col0 + bj * HALF + n * 16) : (f32x4){0.f, 0.f, 0.f, 0.f};
#pragma unroll
        EPI_LOOP_AI_M { const size_t off = (size_t)(row0 + ai * HALF + m * 16) * ldc + col0;
#pragma unroll
            for (int bj = 0; bj < 2; ++bj)
#pragma unroll
                for (int n = 0; n < 2; ++n) { f32x4 v = acc[ai][bj][m][n] + bv[bj][n];
                    if (res) { const f32x4 rv = *(const f32x4*)(res + off + bj * HALF + n * 16); v = v + rv * alpha; }
                    *(f32x4*)(C + off + bj * HALF + n * 16) = v; }
            asm volatile("" ::: "memory"); }
    }
};
struct EpiResLn {
    static constexpr bool PERM = false, AFTER_DRAIN = false; static constexpr int MID_T = -1;
    float* C; const float* T; const f32x2* stats; const float* gam; const float* bet; float alpha;
    __device__ __forceinline__ void operator()(const f32x4 (&acc)[2][2][4][2], const Unit& u, int wr, int wc, int fr, int fq) const {
        const int row0 = u.orow + wr * 64 + fr, col0 = u.ocol + wc * 32 + 4 * fq;
        f32x4 gv[2][2], bv[2][2];
#pragma unroll
        for (int bj = 0; bj < 2; ++bj)
#pragma unroll
            for (int n = 0; n < 2; ++n) { gv[bj][n] = *(const f32x4*)(gam + col0 + bj * HALF + n * 16) * alpha; bv[bj][n] = *(const f32x4*)(bet + col0 + bj * HALF + n * 16) * alpha; }
#pragma unroll
        EPI_LOOP_AI_M { const int row = row0 + ai * HALF + m * 16; const size_t off = (size_t)row * D + col0; const f32x2 st = stats[row];
#pragma unroll
            for (int bj = 0; bj < 2; ++bj)
#pragma unroll
                for (int n = 0; n < 2; ++n) { const f32x4 tv = *(const f32x4*)(T + off + bj * HALF + n * 16);
                    *(f32x4*)(C + off + bj * HALF + n * 16) = acc[ai][bj][m][n] + ((tv - st.x) * st.y) * gv[bj][n] + bv[bj][n]; }
            asm volatile("" ::: "memory"); }
    }
};
struct EpiBf16 {
    static constexpr bool PERM = true, AFTER_DRAIN = false; static constexpr int MID_T = -1;
    bf16_t* O; int ldc; float scale;
    __device__ __forceinline__ void operator()(const f32x4 (&acc)[2][2][4][2], const Unit& u, int wr, int wc, int fr, int fq) const {
        const int row0 = u.orow + wr * 64 + fr, col0 = u.ocol + wc * 32 + 8 * fq;
#pragma unroll
        EPI_LOOP_AI_M { bf16_t* rowp = O + (size_t)(row0 + ai * HALF + m * 16) * ldc + col0;
#pragma unroll
            for (int bj = 0; bj < 2; ++bj) { const f32x4 v0 = acc[ai][bj][m][0] * scale, v1 = acc[ai][bj][m][1] * scale;
                u32x4 w; w.x = cvt_pk_bf16(v0[0], v0[1]); w.y = cvt_pk_bf16(v0[2], v0[3]); w.z = cvt_pk_bf16(v1[0], v1[1]); w.w = cvt_pk_bf16(v1[2], v1[3]);
                *(u32x4*)(rowp + bj * HALF) = w; } }
    }
};
struct EpiBf16Bias {
    static constexpr bool PERM = true, AFTER_DRAIN = false; static constexpr int MID_T = -1;
    bf16_t* O; int ldc; const float* bias; int bstride;
    __device__ __forceinline__ void operator()(const f32x4 (&acc)[2][2][4][2], const Unit& u, int wr, int wc, int fr, int fq) const {
        const int row0 = u.orow + wr * 64 + fr, col0 = u.ocol + wc * 32 + 8 * fq;
        f32x4 bv[2][2];
#pragma unroll
        for (int bj = 0; bj < 2; ++bj)
#pragma unroll
            for (int n = 0; n < 2; ++n) bv[bj][n] = *(const f32x4*)(bias + (size_t)u.aux * bstride + col0 + bj * HALF + 4 * n);
#pragma unroll
        EPI_LOOP_AI_M { bf16_t* rowp = O + (size_t)(row0 + ai * HALF + m * 16) * ldc + col0;
#pragma unroll
            for (int bj = 0; bj < 2; ++bj) { const f32x4 v0 = acc[ai][bj][m][0] + bv[bj][0], v1 = acc[ai][bj][m][1] + bv[bj][1];
                u32x4 w; w.x = cvt_pk_bf16(v0[0], v0[1]); w.y = cvt_pk_bf16(v0[2], v0[3]); w.z = cvt_pk_bf16(v1[0], v1[1]); w.w = cvt_pk_bf16(v1[2], v1[3]);
                *(u32x4*)(rowp + bj * HALF) = w; } }
    }
};
struct EpiKV {
    static constexpr bool PERM = true, AFTER_DRAIN = false; static constexpr int MID_T = -1;
    bf16_t* KB; bf16_t* VT;
    __device__ __forceinline__ void operator()(const f32x4 (&acc)[2][2][4][2], const Unit& u, int wr, int wc, int fr, int fq) const {
        const int row0 = u.orow + wr * 64 + fr, col0 = u.ocol + wc * 32 + 8 * fq;
#pragma unroll
        EPI_LOOP_AI_M { const int row = row0 + ai * HALF + m * 16;
#pragma unroll
            for (int bj = 0; bj < 2; ++bj) { const f32x4 v0 = acc[ai][bj][m][0], v1 = acc[ai][bj][m][1]; const int col = col0 + bj * HALF;
                if (u.ocol < 2048) { u32x4 w; w.x = cvt_pk_bf16(v0[0], v0[1]); w.y = cvt_pk_bf16(v0[2], v0[3]); w.z = cvt_pk_bf16(v1[0], v1[1]); w.w = cvt_pk_bf16(v1[2], v1[3]);
                    *(u32x4*)(KB + (size_t)row * 2048 + col) = w; }
                else { const int b = row >> 8, key = row & 255, c = col - 2048, h = c >> 9, d = c & 511; bf16_t* p = VT + ((size_t)((b * 4 + h) * 512 + d)) * 256 + key;
#pragma unroll
                    for (int j = 0; j < 4; ++j) { p[(size_t)j * 256] = (bf16_t)f2bf(v0[j]); p[(size_t)(4 + j) * 256] = (bf16_t)f2bf(v1[j]); } } } }
    }
};
struct EpiDecay {
    static constexpr bool PERM = true, AFTER_DRAIN = false; static constexpr int MID_T = -1;
    bf16_t* LD; const float* w0;
    __device__ __forceinline__ void operator()(const f32x4 (&acc)[2][2][4][2], const Unit& u, int wr, int wc, int fr, int fq) const {
        const int row0 = u.orow + wr * 64 + fr, col0 = u.ocol + wc * 32 + 8 * fq;
#pragma unroll
        for (int bj = 0; bj < 2; ++bj) { const int col = col0 + bj * HALF; const f32x4 w00 = *(const f32x4*)(w0 + col), w01 = *(const f32x4*)(w0 + col + 4);
#pragma unroll
            EPI_LOOP_AI_M { const f32x4 x0 = acc[ai][bj][m][0] + w00, x1 = acc[ai][bj][m][1] + w01; float o[8];
#pragma unroll
                for (int j = 0; j < 4; ++j) { o[j] = -0.6065306597126334f * sigmoidf_(x0[j]); o[4 + j] = -0.6065306597126334f * sigmoidf_(x1[j]); }
                *(u32x4*)(LD + (size_t)(row0 + ai * HALF + m * 16) * D + col) = (u32x4){cvt_pk_bf16(o[0], o[1]), cvt_pk_bf16(o[2], o[3]), cvt_pk_bf16(o[4], o[5]), cvt_pk_bf16(o[6], o[7])}; } }
    }
};
struct EpiIclr {
    static constexpr bool PERM = true, AFTER_DRAIN = false; static constexpr int MID_T = -1;
    const float* a0; bf16_t* AL;
    __device__ __forceinline__ void operator()(const f32x4 (&acc)[2][2][4][2], const Unit& u, int wr, int wc, int fr, int fq) const {
        const int row0 = u.orow + wr * 64 + fr, col0 = u.ocol + wc * 32 + 8 * fq;
#pragma unroll
        for (int bj = 0; bj < 2; ++bj) { const int col = col0 + bj * HALF; const f32x4 a00 = *(const f32x4*)(a0 + col), a01 = *(const f32x4*)(a0 + col + 4);
#pragma unroll
            EPI_LOOP_AI_M { const f32x4 x0 = acc[ai][bj][m][0] + a00, x1 = acc[ai][bj][m][1] + a01;
                *(u32x4*)(AL + (size_t)(row0 + ai * HALF + m * 16) * D + col) = (u32x4){cvt_pk_bf16(sigmoidf_(x0[0]), sigmoidf_(x0[1])), cvt_pk_bf16(sigmoidf_(x0[2]), sigmoidf_(x0[3])),
                    cvt_pk_bf16(sigmoidf_(x1[0]), sigmoidf_(x1[1])), cvt_pk_bf16(sigmoidf_(x1[2]), sigmoidf_(x1[3]))}; } }
    }
};
struct EpiGateFused {
    static constexpr bool PERM = true, AFTER_DRAIN = false; static constexpr int MID_T = 32;
    const bf16_t* PROJ; bf16_t* MERGED;
    __device__ __forceinline__ void mid(f32x4 (&acc)[2][2][4][2], const Unit& u, int wr, int wc, int fr, int fq) const {
        const int row0 = u.orow + wr * 64 + fr, col0 = u.ocol + wc * 32 + 8 * fq;
#pragma unroll
        EPI_LOOP_AI_M { const int row = row0 + ai * HALF + m * 16;
#pragma unroll
            for (int bj = 0; bj < 2; ++bj) { const int col = col0 + bj * HALF;
                const u32x4 g1v = *(const u32x4*)(PROJ + (size_t)row * PC + GATE0 + col), g2v = *(const u32x4*)(PROJ + (size_t)row * PC + GATE0 + 2048 + col);
                const unsigned w1[4] = {g1v.x, g1v.y, g1v.z, g1v.w}, w2[4] = {g2v.x, g2v.y, g2v.z, g2v.w};
#pragma unroll
                for (int j = 0; j < 8; ++j) { const float x1 = bf2f((w1[j >> 1] >> (16 * (j & 1))) & 0xffffu), x2 = fmaxf(bf2f((w2[j >> 1] >> (16 * (j & 1))) & 0xffffu), -60.0f);
                    const float ratio = (1.0f + __expf(-x2)) * __builtin_amdgcn_rcpf(1.0f + __expf(-x1));
                    if (j < 4) acc[ai][bj][m][0][j & 3] *= ratio; else acc[ai][bj][m][1][j & 3] *= ratio; } }
            asm volatile("" ::: "memory"); }
    }
    __device__ __forceinline__ void operator()(const f32x4 (&acc)[2][2][4][2], const Unit& u, int wr, int wc, int fr, int fq) const {
        const int row0 = u.orow + wr * 64 + fr, col0 = u.ocol + wc * 32 + 8 * fq;
#pragma unroll
        EPI_LOOP_AI_M { const int row = row0 + ai * HALF + m * 16;
#pragma unroll
            for (int bj = 0; bj < 2; ++bj) { const int col = col0 + bj * HALF; const u32x4 gv = *(const u32x4*)(PROJ + (size_t)row * PC + GATE0 + 2048 + col);
                const unsigned w2[4] = {gv.x, gv.y, gv.z, gv.w}; float o[8];
#pragma unroll
                for (int j = 0; j < 8; ++j) { const float x2 = fmaxf(bf2f((w2[j >> 1] >> (16 * (j & 1))) & 0xffffu), -60.0f); o[j] = (j < 4 ? acc[ai][bj][m][0][j & 3] : acc[ai][bj][m][1][j & 3]) * sigmoidf_(x2); }
                u32x4 w; w.x = cvt_pk_bf16(o[0], o[1]); w.y = cvt_pk_bf16(o[2], o[3]); w.z = cvt_pk_bf16(o[4], o[5]); w.w = cvt_pk_bf16(o[6], o[7]);
                *(u32x4*)(MERGED + (size_t)row * D + col) = w; }
            asm volatile("" ::: "memory"); }
    }
};
struct EpiSwiglu {
    static constexpr bool PERM = true, AFTER_DRAIN = false; static constexpr int MID_T = -1;
    const float* b1; bf16_t* H;
    __device__ __forceinline__ float sw(float g, float l) const { g = fminf(g, 7.0f); l = fminf(fmaxf(l, -7.0f), 7.0f); return g * sigmoidf_(1.702f * g) * (l + 1.0f); }
    __device__ __forceinline__ void operator()(const f32x4 (&acc)[2][2][4][2], const Unit& u, int wr, int wc, int fr, int fq) const {
        const int row0 = u.orow + wr * 64 + fr, col0 = u.ocol + wc * 32 + 8 * fq;
        f32x4 bv[2][2];
#pragma unroll
        for (int bj = 0; bj < 2; ++bj)
#pragma unroll
            for (int n = 0; n < 2; ++n) bv[bj][n] = *(const f32x4*)(b1 + (size_t)u.aux * 4096 + col0 + bj * HALF + 4 * n);
#pragma unroll
        EPI_LOOP_AI_M { const int row = row0 + ai * HALF + m * 16;
#pragma unroll
            for (int bj = 0; bj < 2; ++bj) { const f32x4 v0 = acc[ai][bj][m][0] + bv[bj][0], v1 = acc[ai][bj][m][1] + bv[bj][1];
                *(unsigned*)((unsigned char*)H + (size_t)row * DFF + ((col0 + bj * HALF) >> 1)) = pk4_fp8(sw(v0[0], v0[1]), sw(v0[2], v0[3]), sw(v1[0], v1[1]), sw(v1[2], v1[3])); } }
    }
};
struct EpiSoftmax {
    static constexpr bool PERM = true, AFTER_DRAIN = true; static constexpr int MID_T = -1;
    bf16_t* PP;
    __device__ __forceinline__ void fused(f32x4 (&acc)[2][2][4][2], const Unit& u, int wr, int wc, int fr, int fq, PG8_LAS unsigned char* lds, int wid, int lane) const {
        PG8_LAS float* P1 = (PG8_LAS float*)lds;
        PG8_LAS float* P2 = (PG8_LAS float*)(lds + 4096);
        float mx[2][4];
#pragma unroll
        EPI_LOOP_AI_M { float v = -3.0e38f;
#pragma unroll
            for (int bj = 0; bj < 2; ++bj)
#pragma unroll
                for (int n = 0; n < 2; ++n) { const f32x4 x = acc[ai][bj][m][n]; v = fmaxf(v, fmaxf(fmaxf(x[0], x[1]), fmaxf(x[2], x[3]))); }
            v = fmaxf(v, __shfl_xor(v, 16)); v = fmaxf(v, __shfl_xor(v, 32));
            if (fq == 0) P1[(ai * HALF + wr * 64 + m * 16 + fr) * 4 + wc] = v; }
        asm volatile("s_waitcnt lgkmcnt(0)" ::: "memory"); __builtin_amdgcn_s_barrier(); asm volatile("" ::: "memory");
#pragma unroll
        EPI_LOOP_AI_M { const f32x4 t = *(const PG8_LAS f32x4*)(P1 + (ai * HALF + wr * 64 + m * 16 + fr) * 4); mx[ai][m] = fmaxf(fmaxf(t[0], t[1]), fmaxf(t[2], t[3])); }
#pragma unroll
        EPI_LOOP_AI_M { float s = 0.f;
#pragma unroll
            for (int bj = 0; bj < 2; ++bj)
#pragma unroll
                for (int n = 0; n < 2; ++n) { f32x4 x = acc[ai][bj][m][n];
#pragma unroll
                    for (int j = 0; j < 4; ++j) { x[j] = __expf(x[j] - mx[ai][m]); s += x[j]; }
                    acc[ai][bj][m][n] = x; }
            s += __shfl_xor(s, 16); s += __shfl_xor(s, 32);
            if (fq == 0) P2[(ai * HALF + wr * 64 + m * 16 + fr) * 4 + wc] = s; }
        asm volatile("s_waitcnt lgkmcnt(0)" ::: "memory"); __builtin_amdgcn_s_barrier(); asm volatile("" ::: "memory");
        const int row0 = u.orow + wr * 64 + fr, col0 = wc * 32 + 8 * fq;
#pragma unroll
        EPI_LOOP_AI_M { const f32x4 t = *(const PG8_LAS f32x4*)(P2 + (ai * HALF + wr * 64 + m * 16 + fr) * 4); const float inv = 1.0f / ((t[0] + t[1]) + (t[2] + t[3]));
            bf16_t* rowp = PP + (size_t)(row0 + ai * HALF + m * 16) * 256 + col0;
#pragma unroll
            for (int bj = 0; bj < 2; ++bj) { const f32x4 v0 = acc[ai][bj][m][0] * inv, v1 = acc[ai][bj][m][1] * inv;
                u32x4 w; w.x = cvt_pk_bf16(v0[0], v0[1]); w.y = cvt_pk_bf16(v0[2], v0[3]); w.z = cvt_pk_bf16(v1[0], v1[1]); w.w = cvt_pk_bf16(v1[2], v1[3]);
                *(u32x4*)(rowp + bj * HALF) = w; } }
        asm volatile("s_waitcnt lgkmcnt(0)" ::: "memory"); __builtin_amdgcn_s_barrier(); asm volatile("" ::: "memory");
    }
};
}

constexpr size_t MiB = 1u << 20;
constexpr size_t al256(size_t x) { return (x + 255) & ~(size_t)255; }
constexpr size_t WS_CTL = 0, CTL_ZERO_BYTES = 1 * MiB;
constexpr size_t WS_WIN = 1 * MiB;
constexpr size_t WS_WUP = WS_WIN + (size_t)PC * D * 2;
constexpr size_t WS_AUP = WS_WUP + (size_t)D * 256 * 2;
constexpr size_t WS_GUP = WS_AUP + (size_t)D * 256 * 2;
constexpr size_t WS_PA = WS_GUP + (size_t)D * 256 * 2;
constexpr size_t WS_PB = WS_PA + (size_t)D * D * 2;
constexpr size_t WS_WOUT = WS_PB + (size_t)D * 512 * 2;
constexpr size_t WS_WQ = WS_WOUT + (size_t)D * D * 2;
constexpr size_t WS_WKV = WS_WQ + (size_t)D * D * 2;
constexpr size_t WS_WO = WS_WKV + (size_t)2 * D * D * 2;
constexpr size_t WS_W1 = WS_WO + (size_t)D * D * 2;
constexpr size_t WS_W2 = WS_W1 + (size_t)NEXP * 4096 * D * 2;
constexpr size_t WS_XB = WS_W2 + (size_t)NEXP * D * DFF * 2;
constexpr size_t WS_MEMB = WS_XB + (size_t)M * D * 2;
constexpr size_t WS_ROT = WS_MEMB + (size_t)1024 * D * 2;
constexpr size_t WS_KB = WS_ROT + (size_t)2 * SEQ * 32 * 4;
constexpr size_t WS_VT = WS_KB + (size_t)1024 * D * 2;
constexpr size_t WS_YA = WS_VT + (size_t)1024 * D * 2;
constexpr size_t WS_YB = WS_YA + (size_t)M * D * 2;
constexpr size_t WS_TMP = WS_YB + (size_t)M * 512 * 2;
constexpr size_t WS_MERGED = WS_TMP + (size_t)M * D * 4;
constexpr size_t WS_E = WS_MERGED + (size_t)M * D * 2;
constexpr size_t WS_PROJ = WS_E;
constexpr size_t WS_RZ = WS_PROJ + (size_t)M * PC * 2;
constexpr size_t WS_KZ = WS_RZ + (size_t)M * D * 4;
constexpr size_t WS_VZ = WS_KZ + (size_t)M * D * 4;
constexpr size_t WS_DEC = WS_VZ + (size_t)M * D * 4;
constexpr size_t WS_KP = WS_DEC + (size_t)M * D * 4;
constexpr size_t WS_AN = WS_KP + (size_t)M * D * 4;
constexpr size_t WS_BB = WS_AN + (size_t)M * D * 4;
constexpr size_t WS_GG = WS_BB + (size_t)M * D * 4;
constexpr size_t WS_YS = WS_GG + (size_t)M * D * 4;
constexpr size_t WS_XQ = WS_YS + 60 * MiB;
constexpr size_t WS_WIN8 = WS_YS + 96 * MiB;
constexpr size_t WS_ST1 = WS_YS + 112 * MiB, WS_ST2 = WS_YS + 113 * MiB;
constexpr size_t WS_VR = WS_YS + 4 * MiB;
constexpr size_t WS_AO = WS_YS + (size_t)M * D * 4;
constexpr size_t WS_LSE = WS_AO + (size_t)3 * M * 512 * 4;
constexpr size_t WS_QR = WS_LSE + (size_t)3 * M * 8 * 4;
constexpr size_t WS_KR = WS_QR + (size_t)M * 1536 * 2;
constexpr size_t WS_LIN = WS_KR + (size_t)M * 1536 * 2;
constexpr size_t WS_KNORM = WS_LIN + (size_t)M * 768 * 2;
constexpr size_t WS_F = WS_KNORM + (size_t)M * 32 * 4;
constexpr size_t WS_E_END = WS_F + (size_t)128 * 128 * 96 * 96 * 2;
constexpr size_t WS_T1 = WS_E;
constexpr size_t WS_X1 = WS_T1 + (size_t)M * D * 4;
constexpr size_t WS_X1B = WS_X1 + (size_t)M * D * 4;
constexpr size_t WS_Q = WS_X1B + (size_t)M * D * 2;
constexpr size_t WS_PP = WS_Q + (size_t)M * D * 2;
constexpr size_t WS_OC = WS_PP + (size_t)16 * SEQ * 256 * 2;
constexpr size_t WS_T2 = WS_OC + (size_t)M * D * 2;
constexpr size_t WS_X2 = WS_T2 + (size_t)M * D * 4;
constexpr size_t WS_X2B = WS_X2 + (size_t)M * D * 4;
constexpr size_t WS_LIST = WS_X2B + (size_t)M * D * 2;
constexpr size_t WS_ROWI = WS_LIST + (size_t)NEXP * CAP * 4;
constexpr size_t WS_TOPW = WS_ROWI + (size_t)M * 4 * 4;
constexpr size_t WS_H = WS_TOPW + (size_t)M * 4 * 4;
constexpr size_t WS_Y = WS_H + (size_t)HROWS * DFF * 2;
constexpr size_t WS_L_END = WS_Y + (size_t)HROWS * D * 4;
constexpr size_t WS_END = (WS_E_END > WS_L_END ? WS_E_END : WS_L_END);
static_assert(WS_END <= (size_t)4090 * MiB, "workspace map exceeds 4 x largest input");
constexpr int CW_TMO = 0, CW_CNT = 64  , CW_Q = 128  , CW_BAR = 4096;

constexpr int RING_BYTES = 131072, MISC_OFF = RING_BYTES, LDS_BYTES = 147456;

#define XB_TMO      128
#define XB_XCNT(j)  (256  + 64 * (j))
#define XB_XSUB(j)  (1280 + 64 * (j))
#define XB_XGEN(j)  (2304 + 64 * (j))
#define XB_TOP      3328
#define XB_TOPGEN   3392
#define XCD_BAR_WORDS 3456
#define XB_SPIN_CAP (1u << 18)
__device__ __forceinline__ unsigned xb_ld(unsigned* p)              { return __hip_atomic_load(p, __ATOMIC_RELAXED, __HIP_MEMORY_SCOPE_AGENT); }
__device__ __forceinline__ unsigned xb_add(unsigned* p, unsigned v) { return __hip_atomic_fetch_add(p, v, __ATOMIC_RELAXED, __HIP_MEMORY_SCOPE_AGENT); }
__device__ __forceinline__ unsigned xb_xcc_id() { return (unsigned)__builtin_amdgcn_s_getreg((3 << 11) | 20) & 0xFu; }
#define XB_SPIN(cond, bar) do { unsigned _sp = 0; while (cond) { __builtin_amdgcn_s_sleep(1); \
    if ((++_sp & 255u) == 0u) { if (xb_ld(&(bar)[XB_TMO])) break; if (_sp > XB_SPIN_CAP) { atomicAdd(&(bar)[XB_TMO], 1u); break; } } } } while (0)
struct XcdBarrier { unsigned* bar; unsigned x; volatile LAS unsigned* st; };
__device__ __forceinline__ XcdBarrier xcd_barrier_post(unsigned* bar, volatile LAS unsigned* st) {
    XcdBarrier b; b.bar = bar; b.x = xb_xcc_id(); b.st = st;
    if (threadIdx.x == 0) (void)xb_add(&bar[XB_XCNT(b.x)], 1u);
    return b;
}
__device__ __forceinline__ void xcd_barrier_complete(unsigned* bar, unsigned x, unsigned& nloc, unsigned& nx) {
    const unsigned G = gridDim.x * gridDim.y * gridDim.z;
    unsigned sum, cnt, mine, sp = 0u;
    for (;;) {
        sum = 0u; cnt = 0u; mine = 0u;
#pragma unroll
        for (unsigned j = 0; j < 16; ++j) { const unsigned c = xb_ld(&bar[XB_XCNT(j)]); sum += c; cnt += (c > 0u) ? 1u : 0u; mine = (j == x) ? c : mine; }
        if (sum == G) break;
        __builtin_amdgcn_s_sleep(1);
        if ((++sp & 255u) == 0u) { if (xb_ld(&bar[XB_TMO])) break; if (sp > XB_SPIN_CAP) { atomicAdd(&bar[XB_TMO], 1u); break; } }
    }
    nloc = mine > 0u ? mine : 1u; nx = cnt > 0u ? cnt : 1u;
}
__device__ __forceinline__ void xcd_barrier(const XcdBarrier& b) {
    asm volatile("s_waitcnt vmcnt(0)" ::: "memory");
    __syncthreads();
    if (threadIdx.x == 0) {
        unsigned* bar = b.bar;
        __builtin_amdgcn_s_waitcnt(0);
        unsigned nloc = b.st[0], nx = b.st[1];
        if (nloc == 0u) { xcd_barrier_complete(bar, b.x, nloc, nx); b.st[0] = nloc; b.st[1] = nx; }
        const unsigned old = xb_add(&bar[XB_XSUB(b.x)], 1u);
        const unsigned gen = old / nloc;
        if (old + 1u == (gen + 1u) * nloc) {
            __builtin_amdgcn_fence(__ATOMIC_RELEASE, "agent");
            asm volatile("s_waitcnt vmcnt(0)" ::: "memory");
            const unsigned og = xb_add(&bar[XB_TOP], 1u);
            const unsigned tg = og / nx;
            if (og + 1u == (tg + 1u) * nx) xb_add(&bar[XB_TOPGEN], 1u);
            else XB_SPIN(xb_ld(&bar[XB_TOPGEN]) == tg, bar);
            __builtin_amdgcn_fence(__ATOMIC_ACQUIRE, "agent");
            xb_add(&bar[XB_XGEN(b.x)], 1u);
            asm volatile("s_waitcnt vmcnt(0)" ::: "memory");
        } else {
            XB_SPIN(xb_ld(&bar[XB_XGEN(b.x)]) == gen, bar);
            __builtin_amdgcn_fence(__ATOMIC_ACQUIRE, "agent");
            asm volatile("s_waitcnt vmcnt(0)" ::: "memory");
        }
    }
    __syncthreads();
}

struct Params {
    const float* in[32];
    float* out; unsigned char* ws;
    int ph_lo, ph_hi, li, pad;
};
enum { I_X = 0, I_MEM, I_WIN, I_MIX, I_W0, I_WUP, I_A0, I_AUP, I_GUP, I_KK, I_KA, I_RK, I_LNXG, I_LNXB, I_PA, I_PB, I_WOUT, I_LN1G, I_LN1B, I_WQ, I_WKV, I_WO, I_LN2G, I_LN2B,
       I_RW, I_RB, I_W1, I_B1, I_W2, I_B2, I_LN3G, I_LN3B };

struct ScoreOrder {
    static constexpr bool GATHER = false;
    const char* Q; const char* KB; int G, c;
    __device__ bool next(int i, pg8::Unit& u) const {
        const int L = i * G + c; if (L >= 256) return false;
        const int bh = L >> 4, pm = L & 15, b = bh >> 2, h = bh & 3;
        u.A = Q + ((size_t)(b * SEQ + 256 * pm) * D + h * 512) * 2; u.B = KB + ((size_t)(b * 256) * D + h * 512) * 2;
        u.orow = bh * SEQ + 256 * pm; u.ocol = 0; u.aux = 0; u.aux2 = 0; u.valid = 256; return true;
    }
    __device__ __forceinline__ const int* rows(const pg8::Unit&) const { return nullptr; }
};
struct PvOrder {
    static constexpr bool GATHER = false;
    const char* PP; const char* VT; int G, c;
    __device__ bool next(int i, pg8::Unit& u) const {
        const int L = i * G + c; if (L >= 512) return false;
        const int bh = L >> 5, pm = (L >> 1) & 15, pn = L & 1, b = bh >> 2, h = bh & 3;
        u.A = PP + ((size_t)(bh * SEQ + 256 * pm) * 256) * 2; u.B = VT + ((size_t)(bh * 512 + 256 * pn) * 256) * 2;
        u.orow = b * SEQ + 256 * pm; u.ocol = h * 512 + 256 * pn; u.aux = 0; u.aux2 = 0; u.valid = 256; return true;
    }
    __device__ __forceinline__ const int* rows(const pg8::Unit&) const { return nullptr; }
};
template <bool GATHER_, int NT  > struct MoeOrder {
    static constexpr bool GATHER = GATHER_;
    const LAS int* tab; const char* A; const char* W; const int* list; size_t wexp  ; int ldb; int G, c;
    __device__ bool next(int i, pg8::Unit& u) const {
        constexpr int RPR = 256 / NT;
        const int rt = i * RPR + (c % RPR), pn = c / RPR, T = __builtin_amdgcn_readfirstlane(tab[64]);
        if (c >= 256 || rt >= T) return false;
        int e = 0;
        for (int j = 1; j < NEXP; ++j) e = (rt >= __builtin_amdgcn_readfirstlane(tab[32 + j])) ? j : e;
        const int lt = rt - __builtin_amdgcn_readfirstlane(tab[32 + e]), cnt = __builtin_amdgcn_readfirstlane(tab[e]);
        u.aux = e; u.aux2 = lt; u.valid = min(256, cnt - 256 * lt); u.orow = 256 * rt; u.ocol = 256 * pn;
        u.B = W + (size_t)e * wexp + (size_t)(256 * pn) * ldb;
        u.A = GATHER_ ? A : A + (size_t)(256 * rt) * DFF;
        return true;
    }
    __device__ __forceinline__ const int* rows(const pg8::Unit& u) const { return list + (size_t)u.aux * CAP + 256 * u.aux2; }
};

struct Ctx { int tid, lane, wave, vcu, G; LAS unsigned char* lds; unsigned char* ws; };

__device__ __forceinline__ void cv_issue(const float* W, int ldw, int Ksrc, int sc0, int k0, int lane, float (&cv)[32]) {
    const int kb = k0 + 32 * (lane >> 5); const bool ok = sc0 >= 0 && kb < Ksrc;
    const float* src = W + (ok ? (size_t)kb * ldw + sc0 + (lane & 31) : (size_t)0);
#pragma unroll
    for (int i = 0; i < 32; ++i) { const float v = src[(size_t)i * ldw]; cv[i] = ok ? v : 0.f; }
}
__device__ __forceinline__ void cv_store16(const float (&cv)[32], bf16_t* WT, int ldt, int n0, int k0, int lane) {
    u32x4* dst = (u32x4*)(WT + (size_t)(n0 + (lane & 31)) * ldt + k0 + 32 * (lane >> 5));
#pragma unroll
    for (int j = 0; j < 4; ++j) dst[j] = (u32x4){pk2(cv[8 * j], cv[8 * j + 1]), pk2(cv[8 * j + 2], cv[8 * j + 3]), pk2(cv[8 * j + 4], cv[8 * j + 5]), pk2(cv[8 * j + 6], cv[8 * j + 7])};
}
__device__ __forceinline__ void cv_store8(const float (&cv)[32], unsigned char* WT8, int ldt, int n0, int k0, int lane) {
    u32x4* dst = (u32x4*)(WT8 + (size_t)(n0 + (lane & 31)) * ldt + k0 + 32 * (lane >> 5));
#pragma unroll
    for (int j = 0; j < 2; ++j) dst[j] = (u32x4){pk4_fp8(cv[16 * j] * 64.f, cv[16 * j + 1] * 64.f, cv[16 * j + 2] * 64.f, cv[16 * j + 3] * 64.f), pk4_fp8(cv[16 * j + 4] * 64.f, cv[16 * j + 5] * 64.f, cv[16 * j + 6] * 64.f, cv[16 * j + 7] * 64.f),
        pk4_fp8(cv[16 * j + 8] * 64.f, cv[16 * j + 9] * 64.f, cv[16 * j + 10] * 64.f, cv[16 * j + 11] * 64.f), pk4_fp8(cv[16 * j + 12] * 64.f, cv[16 * j + 13] * 64.f, cv[16 * j + 14] * 64.f, cv[16 * j + 15] * 64.f)};
}
struct CvJob { const float* W; bf16_t* WT; int ldw, Ksrc, sc0, ldt, n0, k0, f8, kd; };
__device__ __forceinline__ CvJob p0_job(const Params& p, unsigned char* ws, int it) {
    constexpr int I_WINJ = 32 * 480, I_LORA = 4 * 64, I_SQ = 32 * 64, I_PBJ = 8 * 64, I_KVJ = 32 * 128;
    CvJob j; j.f8 = 0; j.kd = 0; int r = it;
#define P0_PLAIN_F8(SRC, DST, N_, KS_, KD_) { const int nblk = (N_) / 32, kb = r / nblk, nb = r % nblk; j.W = p.in[SRC]; j.WT = (bf16_t*)(ws + (DST)); j.ldw = (N_); j.Ksrc = (KS_); j.sc0 = 32 * nb; j.ldt = (KD_); j.n0 = 32 * nb; j.k0 = 64 * kb; j.f8 = 1; return j; }
#define P0_PLAIN(SRC, DST, N_, KS_, KD_) { const int nblk = (N_) / 32, kb = r / nblk, nb = r % nblk; j.W = p.in[SRC]; j.WT = (bf16_t*)(ws + (DST)); j.ldw = (N_); j.Ksrc = (KS_); j.sc0 = 32 * nb; j.ldt = (KD_); j.n0 = 32 * nb; j.k0 = 64 * kb; return j; }
    if (r < I_WINJ) { const int kb = r / 480, nb = r % 480; j.W = p.in[I_WIN]; j.WT = (bf16_t*)(ws + WS_WIN); j.ldw = 15296; j.Ksrc = D; const int n_ = 32 * nb;
        j.sc0 = n_ < RWC ? n_ : (n_ < ATTV2 ? -1 : (n_ < ATT0 ? RWC + 4096 + (n_ - ATTV2) : (n_ < GATE0 ? RWC + (n_ - ATT0) : n_ - 64))); j.ldt = D; j.n0 = n_; j.k0 = 64 * kb;
        if (n_ >= ATT0) { j.f8 = 1; j.WT = (bf16_t*)(ws + WS_WIN8); j.n0 = n_ - ATT0; }
        return j; } r -= I_WINJ;
    if (r < I_LORA) P0_PLAIN(I_WUP, WS_WUP, D, 96, 256) r -= I_LORA;
    if (r < I_LORA) P0_PLAIN(I_AUP, WS_AUP, D, 96, 256) r -= I_LORA;
    if (r < I_LORA) P0_PLAIN(I_GUP, WS_GUP, D, 256, 256) r -= I_LORA;
    if (r < I_SQ) P0_PLAIN(I_PA, WS_PA, D, D, 2560) r -= I_SQ;
    if (r < I_PBJ) { const int kb = r / 64, nb = r % 64; j.W = p.in[I_PB]; j.WT = (bf16_t*)(ws + WS_PA); j.ldw = D; j.Ksrc = 512; j.sc0 = 32 * nb; j.ldt = 2560; j.n0 = 32 * nb; j.k0 = 64 * kb; j.kd = 2048; return j; } r -= I_PBJ;
    if (r < I_SQ) P0_PLAIN(I_WOUT, WS_WOUT, D, D, D) r -= I_SQ;
    if (r < I_SQ) { P0_PLAIN_F8(I_WQ, WS_WQ, D, D, D) } r -= I_SQ;
    if (r < I_KVJ) P0_PLAIN(I_WKV, WS_WKV, 2 * D, D, D) r -= I_KVJ;
    P0_PLAIN(I_WO, WS_WO, D, D, D)
#undef P0_PLAIN
#undef P0_PLAIN_F8
}
__device__ __forceinline__ void p0_prologue(const Params& p, const Ctx& c) {
    const int gw = c.vcu * 8 + c.wave, NGW = c.G * 8;
    unsigned char* ws = c.ws;
    constexpr int NITEMS = 32 * 480 + 3 * (4 * 64) + 4 * (32 * 64) + 8 * 64 + 32 * 128;
    { float ca[32], cb[32]; CvJob ja, jb; int it = gw;
      if (it < NITEMS) { ja = p0_job(p, ws, it); cv_issue(ja.W, ja.ldw, ja.Ksrc, ja.sc0, ja.k0, c.lane, ca); }
      for (; it < NITEMS; it += 2 * NGW) {
          if (it + NGW < NITEMS) { jb = p0_job(p, ws, it + NGW); cv_issue(jb.W, jb.ldw, jb.Ksrc, jb.sc0, jb.k0, c.lane, cb); }
          if (ja.f8) cv_store8(ca, (unsigned char*)ja.WT, ja.ldt, ja.n0, ja.k0, c.lane); else cv_store16(ca, ja.WT, ja.ldt, ja.n0, ja.k0 + ja.kd, c.lane);
          if (it + 2 * NGW < NITEMS) { ja = p0_job(p, ws, it + 2 * NGW); cv_issue(ja.W, ja.ldw, ja.Ksrc, ja.sc0, ja.k0, c.lane, ca); }
          if (it + NGW < NITEMS) { if (jb.f8) cv_store8(cb, (unsigned char*)jb.WT, jb.ldt, jb.n0, jb.k0, c.lane); else cv_store16(cb, jb.WT, jb.ldt, jb.n0, jb.k0 + jb.kd, c.lane); }
      } }
    const size_t gt = (size_t)c.vcu * 512 + c.tid, NT = (size_t)c.G * 512;
    for (size_t i = gt; i < (size_t)M * D / 8; i += NT) { const f32x4 a = ((const f32x4*)p.in[I_X])[2 * i], b = ((const f32x4*)p.in[I_X])[2 * i + 1];
        u32x4 o; o.x = pk2(a[0], a[1]); o.y = pk2(a[2], a[3]); o.z = pk2(b[0], b[1]); o.w = pk2(b[2], b[3]); ((u32x4*)(ws + WS_XB))[i] = o;
        ((u32x2*)(ws + WS_XQ))[i] = (u32x2){pk4_fp8(a[0], a[1], a[2], a[3]), pk4_fp8(b[0], b[1], b[2], b[3])}; }
    for (size_t i = gt; i < (size_t)1024 * D / 8; i += NT) { const f32x4 a = ((const f32x4*)p.in[I_MEM])[2 * i], b = ((const f32x4*)p.in[I_MEM])[2 * i + 1];
        u32x4 o; o.x = pk2(a[0], a[1]); o.y = pk2(a[2], a[3]); o.z = pk2(b[0], b[1]); o.w = pk2(b[2], b[3]); ((u32x4*)(ws + WS_MEMB))[i] = o; }
    float* rc = (float*)(ws + WS_ROT); float* rs = rc + SEQ * 32;
    for (size_t i = gt; i < (size_t)SEQ * 32; i += NT) { const int pos = (int)(i >> 5), j = (int)(i & 31);
        const double inv = exp(-(double)j * (9.210340371976184 / 32.0)); const double ang = (double)pos * inv; rc[i] = (float)cos(ang); rs[i] = (float)sin(ang); }
}

constexpr int MOE_W1E = 32 * 128, MOE_W2E = 32 * 64, MOE_CONV_GROUPS = (NEXP * MOE_W2E) / 8;
__device__ __forceinline__ void conv_group(const Params& p, const Ctx& c, int gi) {
    unsigned char* ws = c.ws;
    const int r = gi * 8 + c.wave;
    const int e = r / MOE_W2E, it = r % MOE_W2E, kb = it >> 6, nb = it & 63;
    float cv[32]; cv_issue(p.in[I_W2] + (size_t)e * DFF * D, D, DFF, 32 * nb, 64 * kb, c.lane, cv);
    cv_store8(cv, ws + WS_W2 + (size_t)e * D * DFF, DFF, 32 * nb, 64 * kb, c.lane);
}

#define DPP_ADD(x, ctrl) ((x) + __builtin_bit_cast(float, __builtin_amdgcn_update_dpp(0, __builtin_bit_cast(int, (x)), (ctrl), 0xF, 0xF, true)))
struct P2Tok { u32x4 cv0, pv0, cv1, pv1, ra, rb, vv; f32x4 c0, c1, s0, s1; };
__device__ __forceinline__ void p2_prep(const Params& p, const Ctx& c) {
    unsigned char* ws = c.ws;
    const bf16_t* PROJ = (const bf16_t*)(ws + WS_PROJ);
    const float* mix = p.in[I_MIX]; const float* k_k = p.in[I_KK];
    bf16_t* RZ = (bf16_t*)(ws + WS_RZ); bf16_t* KZ = (bf16_t*)(ws + WS_KZ); bf16_t* VZ = (bf16_t*)(ws + WS_VZ);
    bf16_t* LIN = (bf16_t*)(ws + WS_LIN); float* KNORM = (float*)(ws + WS_KNORM);
    bf16_t* QR = (bf16_t*)(ws + WS_QR); bf16_t* KR = (bf16_t*)(ws + WS_KR); bf16_t* VR = (bf16_t*)(ws + WS_VR);
    const float* rc = (const float*)(ws + WS_ROT); const float* rs = rc + SEQ * 32;
    int tid_ = c.tid; asm volatile("" : "+v"(tid_));
    const int tid = tid_;
    const int ch0 = tid, ch1 = tid + 512; const bool has1 = ch1 < 824;
    const f32x4 m00 = *(const f32x4*)(mix + 8 * ch0), m01 = *(const f32x4*)(mix + 8 * ch0 + 4);
    f32x4 m10 = (f32x4){0.f, 0.f, 0.f, 0.f}, m11 = m10; if (has1) { m10 = *(const f32x4*)(mix + 8 * ch1); m11 = *(const f32x4*)(mix + 8 * ch1 + 4); }
    f32x4 kk0 = (f32x4){0.f, 0.f, 0.f, 0.f}, kk1 = kk0; if (tid >= 256) { kk0 = *(const f32x4*)(k_k + 8 * (tid - 256)); kk1 = *(const f32x4*)(k_k + 8 * (tid - 256) + 4); }
    const bool rot = tid >= 64 && tid < 256, vcp = tid >= 256 && tid < 448;
    const int rw = tid - 64, which = rw / 96, rhh = (rw % 96) >> 2, re0 = (rw & 3) * 8;
    const int vhh = (tid - 256) >> 3, ve0 = ((tid - 256) & 7) * 8;
#define P2_LOAD(T, t_) do { const int pos_ = (t_) & (SEQ - 1); const bf16_t* cur_ = PROJ + (size_t)(t_) * PC; const u32x4 z4_ = (u32x4){0u, 0u, 0u, 0u}; \
        T.cv0 = *(const u32x4*)(cur_ + 8 * ch0); T.pv0 = pos_ > 0 ? *(const u32x4*)(cur_ - PC + 8 * ch0) : z4_; \
        if (has1) { T.cv1 = *(const u32x4*)(cur_ + 8 * ch1); T.pv1 = pos_ > 0 ? *(const u32x4*)(cur_ - PC + 8 * ch1) : z4_; } \
        if (rot) { const bf16_t* src_ = cur_ + ATT0 + which * 1536 + rhh * 64 + re0; T.ra = *(const u32x4*)src_; T.rb = *(const u32x4*)(src_ + 32); \
            T.c0 = *(const f32x4*)(rc + pos_ * 32 + re0); T.c1 = *(const f32x4*)(rc + pos_ * 32 + re0 + 4); T.s0 = *(const f32x4*)(rs + pos_ * 32 + re0); T.s1 = *(const f32x4*)(rs + pos_ * 32 + re0 + 4); } \
        if (vcp) { const int ao_ = 2 * 1536 + vhh * 64 + ve0; T.vv = *(const u32x4*)(cur_ + (ao_ < 4096 ? ATT0 + ao_ : ATTV2 + ao_ - 4096)); } } while (0)
#define P2_SHIFT(z, cv, pv, ma, mb) do { const unsigned cw[4] = {cv.x, cv.y, cv.z, cv.w}, pw[4] = {pv.x, pv.y, pv.z, pv.w}; const float mm[8] = {ma[0], ma[1], ma[2], ma[3], mb[0], mb[1], mb[2], mb[3]}; \
        _Pragma("unroll") for (int j = 0; j < 4; ++j) { const float c0_ = bf2f(cw[j] & 0xffffu), c1_ = bf2f(cw[j] >> 16), q0_ = bf2f(pw[j] & 0xffffu), q1_ = bf2f(pw[j] >> 16); \
            z[2 * j] = c0_ + (q0_ - c0_) * mm[2 * j]; z[2 * j + 1] = c1_ + (q1_ - c1_) * mm[2 * j + 1]; } } while (0)
#define P2_PROC(T, t_) do { const int t = (t_), pos = t & (SEQ - 1); \
        { float z[8]; P2_SHIFT(z, T.cv0, T.pv0, m00, m01);            \
          bf16_t* dst = (tid < 256 ? RZ : KZ) + (size_t)t * D + 8 * (tid & 255); \
          { u32x4 w8; w8.x = pk2(z[0], z[1]); w8.y = pk2(z[2], z[3]); w8.z = pk2(z[4], z[5]); w8.w = pk2(z[6], z[7]); *(u32x4*)dst = w8; } \
          if (tid >= 256) { float sq = 0.f; _Pragma("unroll") for (int j = 0; j < 4; ++j) { const float a_ = z[j] * kk0[j], b_ = z[4 + j] * kk1[j]; sq += a_ * a_ + b_ * b_; } \
              sq = DPP_ADD(sq, 0xB1); sq = DPP_ADD(sq, 0x4E); sq = DPP_ADD(sq, 0x141);                   \
              if ((tid & 7) == 0) KNORM[(size_t)t * 32 + ((tid - 256) >> 3)] = sqrtf(sq); } } \
        if (has1) { float z[8]; P2_SHIFT(z, T.cv1, T.pv1, m10, m11);    \
          if (ch1 < 768) { u32x4 w8; w8.x = pk2(z[0], z[1]); w8.y = pk2(z[2], z[3]); w8.z = pk2(z[4], z[5]); w8.w = pk2(z[6], z[7]); *(u32x4*)(VZ + (size_t)t * D + 8 * (ch1 - 512)) = w8; } \
          else { float o[8]; int dcol; \
              if (ch1 < 780) { dcol = 8 * (ch1 - 768); _Pragma("unroll") for (int j = 0; j < 8; ++j) o[j] = tanhf(z[j]); } \
              else if (ch1 < 792) { dcol = 256 + 8 * (ch1 - 780); _Pragma("unroll") for (int j = 0; j < 8; ++j) o[j] = z[j]; } \
              else { dcol = 512 + 8 * (ch1 - 792); _Pragma("unroll") for (int j = 0; j < 8; ++j) o[j] = sigmoidf_(z[j]); } \
              u32x4 w; w.x = pk2(o[0], o[1]); w.y = pk2(o[2], o[3]); w.z = pk2(o[4], o[5]); w.w = pk2(o[6], o[7]); *(u32x4*)(LIN + (size_t)t * 768 + dcol) = w; } } \
        if (tid >= 448 && tid < 488) { const int q_ = tid - 448; const int dcol = (q_ < 20) ? 96 + 8 * q_ : 352 + 8 * (q_ - 20); *(u32x4*)(LIN + (size_t)t * 768 + dcol) = (u32x4){0u, 0u, 0u, 0u}; } \
        if (rot) { const unsigned aw[4] = {T.ra.x, T.ra.y, T.ra.z, T.ra.w}, bw[4] = {T.rb.x, T.rb.y, T.rb.z, T.rb.w}; float o1[8], o2[8]; \
            _Pragma("unroll") for (int j = 0; j < 8; ++j) { const float t1 = bf2f((aw[j >> 1] >> (16 * (j & 1))) & 0xffffu), t2 = bf2f((bw[j >> 1] >> (16 * (j & 1))) & 0xffffu); \
                const float cs = j < 4 ? T.c0[j & 3] : T.c1[j & 3], sn = j < 4 ? T.s0[j & 3] : T.s1[j & 3]; o1[j] = t1 * cs - t2 * sn; o2[j] = t2 * cs + t1 * sn; } \
            const int dl_ = rhh < 8 ? 1 : (rhh < 16 ? 4 : 16); const int prm = (pos % dl_) * (SEQ / dl_) + pos / dl_; \
            bf16_t* dst = (which ? KR : QR) + ((size_t)((t >> 12) * 24 + rhh) * SEQ + prm) * 64 + re0; \
            u32x4 w1; w1.x = pk2(o1[0], o1[1]); w1.y = pk2(o1[2], o1[3]); w1.z = pk2(o1[4], o1[5]); w1.w = pk2(o1[6], o1[7]); \
            u32x4 w2; w2.x = pk2(o2[0], o2[1]); w2.y = pk2(o2[2], o2[3]); w2.z = pk2(o2[4], o2[5]); w2.w = pk2(o2[6], o2[7]); \
            *(u32x4*)dst = w1; *(u32x4*)(dst + 32) = w2; } \
        if (vcp) { const int dl_ = vhh < 8 ? 1 : (vhh < 16 ? 4 : 16); const int prm = (pos % dl_) * (SEQ / dl_) + pos / dl_; \
            *(u32x4*)(VR + ((size_t)((t >> 12) * 24 + vhh) * SEQ + prm) * 64 + ve0) = T.vv; } } while (0)
    P2Tok ta, tb;
    int tq = c.vcu;
    if (tq < M) P2_LOAD(ta, tq);
    for (; tq < M; tq += 2 * c.G) {
        if (tq + c.G < M) P2_LOAD(tb, tq + c.G);
        P2_PROC(ta, tq);
        if (tq + 2 * c.G < M) P2_LOAD(ta, tq + 2 * c.G);
        if (tq + c.G < M) P2_PROC(tb, tq + c.G);
    }
#undef P2_LOAD
#undef P2_SHIFT
#undef P2_PROC
}

__device__ __forceinline__ float wave_sum_dpp(float x) {
    x = DPP_ADD(x, 0xB1); x = DPP_ADD(x, 0x4E); x = DPP_ADD(x, 0x141); x = DPP_ADD(x, 0x140);
    const int xi = __builtin_bit_cast(int, x);
    return (__builtin_bit_cast(float, __builtin_amdgcn_readlane(xi, 0)) + __builtin_bit_cast(float, __builtin_amdgcn_readlane(xi, 16))) +
           (__builtin_bit_cast(float, __builtin_amdgcn_readlane(xi, 32)) + __builtin_bit_cast(float, __builtin_amdgcn_readlane(xi, 48)));
}
__device__ __forceinline__ f32x4 tile_mm(const LAS bf16_t* A, int pa, const LAS bf16_t* Bt, int pb, int ks, int fr, int fq, f32x4 acc) {
    for (int k = 0; k < ks; ++k) { const bf16x8 a = *(const LAS bf16x8*)(A + fr * pa + 32 * k + 8 * fq), b = *(const LAS bf16x8*)(Bt + fr * pb + 32 * k + 8 * fq);
        acc = __builtin_amdgcn_mfma_f32_16x16x32_bf16(a, b, acc, 0, 0, 0); }
    return acc;
}
__device__ __forceinline__ u32x2 pack4(f32x4 v) { u32x2 w; w.x = pk2(v[0], v[1]); w.y = pk2(v[2], v[3]); return w; }
constexpr int SC_C = 32, SC_NCH = SEQ / SC_C, SC_F = 96;
constexpr int PL_X1 = 0, PL_X2 = 9216, PL_AL = 18432, PL_HT = 26112, PL_ET = 33792, PL_LBT = 53760, PL_TT = 58368, PL_XB = 60928, PL_GI = PL_X1, PL_TF = PL_X2, PL_END = 62016, PL_GRP = 65536;
#define LBAR() do { asm volatile("s_waitcnt lgkmcnt(0)" ::: "memory"); __builtin_amdgcn_s_barrier(); asm volatile("" ::: "memory"); } while (0)
__device__ __forceinline__ void p4_pre(const Params& p, const Ctx& c) {
    unsigned char* ws = c.ws;
    const bf16_t* RZ = (const bf16_t*)(ws + WS_RZ); const bf16_t* LDEC = (const bf16_t*)(ws + WS_DEC); const bf16_t* KZ = (const bf16_t*)(ws + WS_KZ);
    const bf16_t* ALP = (const bf16_t*)(ws + WS_AN); const float* KNORM = (const float*)(ws + WS_KNORM); const float* kkp = p.in[I_KK]; const float* kap = p.in[I_KA];
    bf16_t* FG = (bf16_t*)(ws + WS_F); float* BON = (float*)(ws + WS_YS);
    const float* rkp = p.in[I_RK];
    int tid_ = c.tid; asm volatile("" : "+v"(tid_));
    const int tid = tid_, lane = tid & 63, w = __builtin_amdgcn_readfirstlane(tid >> 6), fr = lane & 15, fq = lane >> 4;
    const int grp = w >> 2, tw = w & 3, gtid = tid & 255;
    LAS unsigned char* gl = c.lds + grp * PL_GRP;
    LAS bf16_t* X1 = (LAS bf16_t*)(gl + PL_X1); LAS bf16_t* X2 = (LAS bf16_t*)(gl + PL_X2); LAS bf16_t* AL = (LAS bf16_t*)(gl + PL_AL); LAS bf16_t* HT = (LAS bf16_t*)(gl + PL_HT);
    LAS bf16_t* ET = (LAS bf16_t*)(gl + PL_ET); LAS float* LBT = (LAS float*)(gl + PL_LBT); LAS bf16_t* TT = (LAS bf16_t*)(gl + PL_TT); LAS bf16_t* GI = (LAS bf16_t*)(gl + PL_GI);
    LAS float* TF = (LAS float*)(gl + PL_TF);
    LAS float* XB = (LAS float*)(gl + PL_XB);
    const int npair = (128 * SC_NCH) / (2 * c.G);
    unsigned short dcy[32], ir[8], ik[8], ia[8]; float inr[8];
#define PRE_LOAD(PAIR) do { const int task_ = c.vcu + (2 * (PAIR) + grp) * c.G; const int bh_ = task_ >> 7, ch_ = task_ & (SC_NCH - 1); \
        const size_t o_ = ((size_t)(bh_ >> 5) * SEQ + (size_t)ch_ * SC_C) * D + (bh_ & 31) * 64 + lane; \
        _Pragma("unroll") for (int s_ = 0; s_ < 32; ++s_) dcy[s_] = LDEC[o_ + (size_t)s_ * D]; \
        _Pragma("unroll") for (int q_ = 0; q_ < 8; ++q_) { const size_t oo_ = o_ + (size_t)(8 * tw + q_) * D; ir[q_] = RZ[oo_]; ik[q_] = KZ[oo_]; ia[q_] = ALP[oo_]; \
            inr[q_] = KNORM[((size_t)(bh_ >> 5) * SEQ + (size_t)ch_ * SC_C + 8 * tw + q_) * 32 + (bh_ & 31)]; } } while (0)
    const bool bgconv = (c.G == 256);
    if (npair > 0) PRE_LOAD(0);
    for (int pr = 0; pr < npair; ++pr) {
        const int task = c.vcu + (2 * pr + grp) * c.G, bh = task >> 7, chn = task & (SC_NCH - 1);
        const float rkv = rkp[(bh & 31) * 64 + lane], kkc = kkp[(bh & 31) * 64 + lane], kac = kap[(bh & 31) * 64 + lane];
        float* bon = BON + ((size_t)(bh >> 5) * SEQ + (size_t)chn * SC_C) * 32 + (bh & 31);
        float p0 = 0.f, p1 = 0.f, p2 = 0.f, p3 = 0.f, dsel[8];
#pragma unroll
        for (int s = 0; s < 8; ++s) { const float d0 = bf2f(dcy[s]), d1 = bf2f(dcy[8 + s]), d2 = bf2f(dcy[16 + s]), d3 = bf2f(dcy[24 + s]); p0 += d0; p1 += d1; p2 += d2; p3 += d3;
            dsel[s] = tw == 0 ? d0 : (tw == 1 ? d1 : (tw == 2 ? d2 : d3)); }
        const float gC = __expf((p0 + p1) + (p2 + p3));
        float lg_ = tw == 0 ? 0.f : (tw == 1 ? p0 : (tw == 2 ? p0 + p1 : (p0 + p1) + p2));
        float g = __expf(lg_);
        LBAR();
#pragma unroll
        for (int hq = 0; hq < 2; ++hq) { f32x4 ah4, bg4, kg4;
#pragma unroll
            for (int qq = 0; qq < 4; ++qq) { const int qn = 4 * hq + qq, s = 8 * tw + qn;
                const float gp = g; lg_ += dsel[qn]; g = __expf(lg_);
                const float rr = bf2f(ir[qn]), kz = bf2f(ik[qn]), alp = bf2f(ia[qn]); const float ig = __expf(-lg_);
                const float kn = kz * kkc * __builtin_amdgcn_rcpf(fmaxf(inr[qn], 1e-12f));
                const float kk = kz * (1.0f + (alp - 1.0f) * kac), aa = -kn, bb = kn * alp;
                const float ah = aa * gp, bt = bb * ig, kt = kk * ig, rh = rr * g;
                X1[s * 72 + lane] = (bf16_t)f2bf(bt); X1[(32 + s) * 72 + lane] = (bf16_t)f2bf(kt); X2[s * 72 + lane] = (bf16_t)f2bf(ah); X2[(32 + s) * 72 + lane] = (bf16_t)f2bf(rh);
                ET[s * 104 + lane] = (bf16_t)f2bf(rh); ah4[qq] = ah; bg4[qq] = bt * gC; kg4[qq] = kt * gC;
                const float bsum = wave_sum_dpp(rr * kk * rkv); if (lane == 0) bon[(size_t)s * 32] = bsum; }
            *(LAS u32x2*)(AL + lane * 40 + 8 * tw + 4 * hq) = pack4(ah4); *(LAS u32x2*)(HT + (32 + lane) * 40 + 8 * tw + 4 * hq) = pack4(bg4); *(LAS u32x2*)(ET + (32 + lane) * 104 + 64 + 8 * tw + 4 * hq) = pack4(kg4); }
        { const int zr = gtid >> 2, zc = 16 * (gtid & 3); LAS u32x4* zp = (LAS u32x4*)(ET + (32 + zr) * 104 + zc); zp[0] = (u32x4){0u, 0u, 0u, 0u}; zp[1] = (u32x4){0u, 0u, 0u, 0u}; }
        if (pr + 1 < npair) PRE_LOAD(pr + 1);
        float cva[32], cvb[32]; int cea = 0, cna = 0, cka = 0, ceb = 0, cnb = 0, ckb = 0;
        if (bgconv) { const int it0 = ((c.vcu * 32 + pr) * 8 + w) * 2;
            cea = it0 >> 12; { const int rem = it0 & 4095; cka = 64 * (rem >> 7); cna = 32 * (rem & 127); }
            ceb = (it0 + 1) >> 12; { const int rem = (it0 + 1) & 4095; ckb = 64 * (rem >> 7); cnb = 32 * (rem & 127); }
            cv_issue(p.in[I_W1] + (size_t)cea * D * 4096, 4096, D, cna, cka, lane, cva); cv_issue(p.in[I_W1] + (size_t)ceb * D * 4096, 4096, D, cnb, ckb, lane, cvb); }
        LBAR();
        if (tw == 0) ET[(32 + lane) * 104 + lane] = (bf16_t)f2bf(gC);
        { const int mt = tw;
#pragma unroll
          for (int nt = 0; nt < 4; ++nt) {
            f32x4 acc = tile_mm(X1 + 16 * mt * 72, 72, X2 + 16 * nt * 72, 72, 2, fr, fq, (f32x4){0.f, 0.f, 0.f, 0.f});
            const int n = 16 * nt + fr, m0 = 16 * mt + 4 * fq;
            if (mt < 2) { if (nt < 2) { const int t = n; f32x4 o;
#pragma unroll
                    for (int e = 0; e < 4; ++e) o[e] = (m0 + e < t) ? acc[e] : 0.f;
                    *(LAS f32x4*)(LBT + t * 36 + m0) = o; }
                else { const int t = n - 32; f32x4 o;
#pragma unroll
                    for (int e = 0; e < 4; ++e) o[e] = (m0 + e <= t) ? acc[e] : 0.f;
                    *(LAS u32x2*)(HT + t * 40 + m0) = pack4(o); } }
            else { const int s0 = m0 - 32;
                if (nt < 2) { const int t = n;
#pragma unroll
                    for (int e = 0; e < 4; ++e) AL[(64 + s0 + e) * 40 + t] = (bf16_t)f2bf((s0 + e < t) ? acc[e] : 0.f); }
                else { const int t = n - 32; f32x4 o;
#pragma unroll
                    for (int e = 0; e < 4; ++e) o[e] = (s0 + e <= t) ? acc[e] : 0.f;
                    *(LAS u32x2*)(ET + t * 104 + 64 + s0) = pack4(o); } } } }
        LBAR();
        if (gtid < 32) { const int hb = 16 * (gtid >> 4), sl = gtid & 15; float Tr[16];
#pragma unroll
            for (int t = 0; t < 16; ++t) { float a0 = (sl == t) ? 1.f : 0.f, a1 = 0.f, a2 = 0.f, a3 = 0.f;
#pragma unroll
                for (int m4 = 0; m4 < (t + 3) / 4; ++m4) { const f32x4 l = *(const LAS f32x4*)(LBT + (hb + t) * 36 + hb + 4 * m4);
                    if (4 * m4 + 0 < t) a0 += Tr[4 * m4 + 0] * l[0]; if (4 * m4 + 1 < t) a1 += Tr[4 * m4 + 1] * l[1]; if (4 * m4 + 2 < t) a2 += Tr[4 * m4 + 2] * l[2]; if (4 * m4 + 3 < t) a3 += Tr[4 * m4 + 3] * l[3]; }
                Tr[t] = (a0 + a1) + (a2 + a3); TF[(hb + sl) * 36 + hb + t] = Tr[t]; TT[(hb + t) * 40 + hb + sl] = (bf16_t)f2bf(Tr[t]);
                if (hb) TT[t * 40 + hb + sl] = 0; } }
        LBAR();
        { const int m = gtid >> 4, tl = gtid & 15; float x = 0.f;
#pragma unroll
            for (int n = 0; n < 16; ++n) x += LBT[(16 + n) * 36 + m] * TF[(16 + n) * 36 + 16 + tl];
            XB[m * 17 + tl] = x; }
        LBAR();
        { const int sr = gtid >> 4, tl = gtid & 15; float x = 0.f;
#pragma unroll
            for (int m = 0; m < 16; ++m) x += TF[sr * 36 + m] * XB[m * 17 + tl];
            TT[(16 + tl) * 40 + sr] = (bf16_t)f2bf(x); }
        LBAR();
        for (int id = tw; id < 12; id += 4) { const int tt = id / 6, nt = id % 6;
            const f32x4 acc = tile_mm(TT + 16 * tt * 40, 40, AL + 16 * nt * 40, 40, 1, fr, fq, (f32x4){0.f, 0.f, 0.f, 0.f});
            *(LAS u32x2*)(GI + (16 * nt + fr) * 40 + 16 * tt + 4 * fq) = pack4(acc); }
        LBAR();
        for (int id = tw; id < 36; id += 4) { const int nt = id / 6, mt = id % 6;
            const f32x4 acc = tile_mm(GI + 16 * nt * 40, 40, HT + 16 * mt * 40, 40, 1, fr, fq, (f32x4){0.f, 0.f, 0.f, 0.f});
            LAS u32x2* ep = (LAS u32x2*)(ET + (16 * mt + fr) * 104 + 16 * nt + 4 * fq); const u32x2 ev = *ep;
            f32x4 o; o[0] = acc[0] + bf2f(ev.x & 0xffffu); o[1] = acc[1] + bf2f(ev.x >> 16); o[2] = acc[2] + bf2f(ev.y & 0xffffu); o[3] = acc[3] + bf2f(ev.y >> 16);
            *ep = pack4(o); }
        LBAR();
        { bf16_t* fg = FG + (size_t)task * (SC_F * SC_F);
          for (int idx = gtid; idx < 96 * 12; idx += 256) { const int row = idx / 12, pc = idx % 12; *(u32x4*)(fg + row * 96 + 8 * pc) = *(const LAS u32x4*)(ET + row * 104 + 8 * pc); } }
        LBAR();
        if (bgconv) { cv_store8(cva, ws + WS_W1 + (size_t)cea * 4096 * D, D, cna, cka, lane); cv_store8(cvb, ws + WS_W1 + (size_t)ceb * 4096 * D, D, cnb, ckb, lane); }
    }
    if (!bgconv) {
        LBAR();
        for (int r = c.vcu * 8 + w; r < NEXP * MOE_W1E; r += c.G * 8) { const int e = r >> 12, rem = r & 4095; float cv[32]; cv_issue(p.in[I_W1] + (size_t)e * D * 4096, 4096, D, 32 * (rem & 127), 64 * (rem >> 7), lane, cv);
            cv_store8(cv, ws + WS_W1 + (size_t)e * 4096 * D, D, 32 * (rem & 127), 64 * (rem >> 7), lane); }
    }
    LBAR();
#undef PRE_LOAD
}
constexpr int SQ_BI = 0, SQ_BI_SZ = 64 * 104 * 2, SQ_YL = 2 * SQ_BI_SZ, SQ_YL_SZ = 32 * 64 * 4;
struct SeqSet { bf16x8 af[3][3]; u32x2 vimg, gimg; float bon; };
__device__ __forceinline__ void p4_seq(const Params& p, const Ctx& c, int bh) {
    unsigned char* ws = c.ws;
    const bf16_t* VZ = (const bf16_t*)(ws + WS_VZ); const bf16_t* GG = (const bf16_t*)(ws + WS_GG); const float* BON = (const float*)(ws + WS_YS);
    const bf16_t* FG = (const bf16_t*)(ws + WS_F) + (size_t)bh * SC_NCH * (SC_F * SC_F);
    bf16_t* YA = (bf16_t*)(ws + WS_YA);
    int tid_ = c.tid; asm volatile("" : "+v"(tid_));
    const int tid = tid_, lane = tid & 63, w = __builtin_amdgcn_readfirstlane(tid >> 6), fr = lane & 15, fq = lane >> 4;
    const int b = bh >> 5, h = bh & 31;
    const size_t base = (size_t)b * SEQ * D + h * 64;
    const int nt = w & 3, mg = w >> 2;
    LAS bf16_t* BI = (LAS bf16_t*)(c.lds + SQ_BI); LAS float* YL = (LAS float*)(c.lds + SQ_YL);
    const int vs = tid >> 4, vi4 = 4 * (tid & 15);
    const f32x4 lg4 = *(const f32x4*)(p.in[I_LNXG] + h * 64 + vi4), lb4 = *(const f32x4*)(p.in[I_LNXB] + h * 64 + vi4);
#define SEQ_LOAD(SET, CHN) do { const int chn_ = (CHN) < SC_NCH ? (CHN) : SC_NCH - 1; const bf16_t* fp = FG + (size_t)chn_ * (SC_F * SC_F); const size_t tk_ = (size_t)b * SEQ + (size_t)(chn_ * SC_C + vs); \
        asm volatile("global_load_dwordx2 %0, %1, off" : "=v"(SET.vimg) : "v"(VZ + tk_ * D + h * 64 + vi4) : "memory"); \
        _Pragma("unroll") for (int mi = 0; mi < 3; ++mi) _Pragma("unroll") for (int ks = 0; ks < 3; ++ks) \
            asm volatile("global_load_dwordx4 %0, %1, off" : "=v"(SET.af[mi][ks]) : "v"(fp + (16 * (3 * mg + mi) + fr) * SC_F + 32 * ks + 8 * fq) : "memory"); \
        asm volatile("global_load_dwordx2 %0, %1, off" : "=v"(SET.gimg) : "v"(GG + tk_ * D + h * 64 + vi4) : "memory"); \
        asm volatile("global_load_dword %0, %1, off" : "=v"(SET.bon) : "v"(BON + tk_ * 32 + h) : "memory"); } while (0)
#define SEQ_WAIT_AF(SET, N) asm volatile("s_waitcnt vmcnt(" #N ")" : "+v"(SET.af[0][0]), "+v"(SET.af[0][1]), "+v"(SET.af[0][2]), "+v"(SET.af[1][0]), "+v"(SET.af[1][1]), "+v"(SET.af[1][2]), \
        "+v"(SET.af[2][0]), "+v"(SET.af[2][1]), "+v"(SET.af[2][2]) :: "memory")
#define SEQ_WAIT_V(SET, N) asm volatile("s_waitcnt vmcnt(" #N ")" : "+v"(SET.vimg) :: "memory")
#define SEQ_WAIT_G(SET, N) asm volatile("s_waitcnt vmcnt(" #N ")" : "+v"(SET.gimg), "+v"(SET.bon), "+v"(SET.vimg) :: "memory")
#define SEQ_BODY(CH, CUR, NXT, NX2) do { const int ch = (CH), cb = ch & 1; \
        const LAS bf16_t* bi = BI + cb * (64 * 104); LAS bf16_t* bo = BI + (cb ^ 1) * (64 * 104); LAS float* yl = YL + cb * (32 * 64); \
        SEQ_LOAD(NX2, ch + 2); \
        bf16x8 bfr[3]; _Pragma("unroll") for (int ks = 0; ks < 3; ++ks) bfr[ks] = *(const LAS bf16x8*)(bi + (16 * nt + fr) * 104 + 32 * ks + 8 * fq); \
        SEQ_WAIT_AF(CUR, 28); \
        f32x4 acc[3]; _Pragma("unroll") for (int mi = 0; mi < 3; ++mi) { acc[mi] = (f32x4){0.f, 0.f, 0.f, 0.f}; \
            _Pragma("unroll") for (int ks = 0; ks < 3; ++ks) acc[mi] = __builtin_amdgcn_mfma_f32_16x16x32_bf16(CUR.af[mi][ks], bfr[ks], acc[mi], 0, 0, 0); } \
        _Pragma("unroll") for (int mi = 0; mi < 3; ++mi) { const int mt = 3 * mg + mi; \
            if (mt < 2) { _Pragma("unroll") for (int e = 0; e < 4; ++e) yl[(16 * mt + 4 * fq + e) * 64 + 16 * nt + fr] = acc[mi][e]; } \
            else *(LAS u32x2*)(bo + (16 * nt + fr) * 104 + 16 * (mt - 2) + 4 * fq) = pack4(acc[mi]); } \
        SEQ_WAIT_V(NXT, 24); \
        if (ch + 1 < SC_NCH) { bo[(vi4 + 0) * 104 + 64 + vs] = (bf16_t)(NXT.vimg.x & 0xffffu); bo[(vi4 + 1) * 104 + 64 + vs] = (bf16_t)(NXT.vimg.x >> 16); \
            bo[(vi4 + 2) * 104 + 64 + vs] = (bf16_t)(NXT.vimg.y & 0xffffu); bo[(vi4 + 3) * 104 + 64 + vs] = (bf16_t)(NXT.vimg.y >> 16); } \
        LBAR(); \
        SEQ_WAIT_G(CUR, 24); \
        { const f32x4 y4 = *(const LAS f32x4*)(yl + vs * 64 + vi4); float sm = (y4[0] + y4[1]) + (y4[2] + y4[3]); \
          sm = DPP_ADD(sm, 0xB1); sm = DPP_ADD(sm, 0x4E); sm = DPP_ADD(sm, 0x141); sm = DPP_ADD(sm, 0x140);     \
          const float mu = sm * (1.0f / 64.0f); const f32x4 d4 = y4 - mu; float q = (d4[0] * d4[0] + d4[1] * d4[1]) + (d4[2] * d4[2] + d4[3] * d4[3]); \
          q = DPP_ADD(q, 0xB1); q = DPP_ADD(q, 0x4E); q = DPP_ADD(q, 0x141); q = DPP_ADD(q, 0x140); \
          const float rstd = rsqrtf(q * (1.0f / 64.0f) + GN_EPS); \
          const float v0 = bf2f(CUR.vimg.x & 0xffffu), v1 = bf2f(CUR.vimg.x >> 16), v2 = bf2f(CUR.vimg.y & 0xffffu), v3 = bf2f(CUR.vimg.y >> 16); \
          const float g0 = bf2f(CUR.gimg.x & 0xffffu), g1 = bf2f(CUR.gimg.x >> 16), g2 = bf2f(CUR.gimg.y & 0xffffu), g3 = bf2f(CUR.gimg.y >> 16); \
          const float o0 = (d4[0] * rstd * lg4[0] + lb4[0] + CUR.bon * v0) * g0, o1 = (d4[1] * rstd * lg4[1] + lb4[1] + CUR.bon * v1) * g1; \
          const float o2 = (d4[2] * rstd * lg4[2] + lb4[2] + CUR.bon * v2) * g2, o3 = (d4[3] * rstd * lg4[3] + lb4[3] + CUR.bon * v3) * g3; \
          *(u32x2*)(YA + ((size_t)b * SEQ + (size_t)(ch * SC_C + vs)) * 2560 + h * 64 + vi4) = (u32x2){pk2(o0, o1), pk2(o2, o3)}; } } while (0)
    SeqSet sa, sb, sc;
    SEQ_LOAD(sa, 0); SEQ_LOAD(sb, 1);
    SEQ_WAIT_V(sa, 0);
    for (int idx = tid; idx < 64 * 8; idx += 512) *(LAS u32x4*)(BI + (idx >> 3) * 104 + 8 * (idx & 7)) = (u32x4){0u, 0u, 0u, 0u};
    BI[(vi4 + 0) * 104 + 64 + vs] = (bf16_t)(sa.vimg.x & 0xffffu); BI[(vi4 + 1) * 104 + 64 + vs] = (bf16_t)(sa.vimg.x >> 16);
    BI[(vi4 + 2) * 104 + 64 + vs] = (bf16_t)(sa.vimg.y & 0xffffu); BI[(vi4 + 3) * 104 + 64 + vs] = (bf16_t)(sa.vimg.y >> 16);
    LBAR();
    for (int c0 = 0; c0 < SC_NCH; c0 += 3) {
        SEQ_BODY(c0, sa, sb, sc);
        if (c0 + 1 < SC_NCH) SEQ_BODY(c0 + 1, sb, sc, sa);
        if (c0 + 2 < SC_NCH) SEQ_BODY(c0 + 2, sc, sa, sb);
    }
    asm volatile("s_waitcnt vmcnt(0)" ::: "memory");
    LBAR();
#undef SEQ_LOAD
#undef SEQ_BODY
#undef SEQ_WAIT_AF
#undef SEQ_WAIT_V
#undef SEQ_WAIT_G
}

__device__ __forceinline__ void p4_attn_task(const Ctx& c, int task) {
    unsigned char* ws = c.ws;
    const bf16_t* QR = (const bf16_t*)(ws + WS_QR); const bf16_t* KR = (const bf16_t*)(ws + WS_KR); const bf16_t* VR = (const bf16_t*)(ws + WS_VR);
    bf16_t* AO = (bf16_t*)(ws + WS_AO); float* LSE = (float*)(ws + WS_LSE);
    constexpr int VP = 280;
    LAS bf16_t* Vt = (LAS bf16_t*)c.lds;
    const int combo = task & 31, hh = (task >> 5) % 24, b = task / (32 * 24);
    const int g = hh >> 3, h = hh & 7;
    const int dil = g == 0 ? 1 : (g == 1 ? 4 : 16), nblk = 32 / dil;
    const int res = combo / nblk, blk = combo % nblk;
    int tid_ = c.tid; asm volatile("" : "+v"(tid_));
    const int tid = tid_, lane = tid & 63, w = __builtin_amdgcn_readfirstlane(tid >> 6);
    const int qq = lane & 15, g4 = lane >> 4, r0 = 16 * w;
    const size_t rowb = (size_t)(b * 24 + hh) * SEQ + (size_t)res * (SEQ / dil) + (size_t)blk * 128;
    bf16x8 qf[2], kf[9][2];
#pragma unroll
    for (int ks = 0; ks < 2; ++ks) qf[ks] = *(const bf16x8*)(QR + (rowb + r0 + qq) * 64 + 32 * ks + 8 * g4);
#pragma unroll
    for (int kt = 0; kt < 9; ++kt) { const bool kv = (blk > 0) || (w + kt >= 8);
#pragma unroll
        for (int ks = 0; ks < 2; ++ks) { kf[kt][ks] = (bf16x8){0, 0, 0, 0, 0, 0, 0, 0};
            if (kv) kf[kt][ks] = *(const bf16x8*)(KR + (rowb - 128 + 16 * (w + kt) + qq) * 64 + 32 * ks + 8 * g4); } }
    const int vki = tid >> 1, vdh = tid & 1;
    u32x4 vv[4];
    if (blk > 0 || vki >= 128) {
#pragma unroll
        for (int j = 0; j < 4; ++j) vv[j] = *(const u32x4*)(VR + (rowb - 128 + vki) * 64 + 32 * vdh + 8 * j); }
    else {
#pragma unroll
        for (int j = 0; j < 4; ++j) vv[j] = (u32x4){0u, 0u, 0u, 0u}; }
    __syncthreads();
#pragma unroll
    for (int j = 0; j < 4; ++j) { const unsigned wv[4] = {vv[j].x, vv[j].y, vv[j].z, vv[j].w};
#pragma unroll
        for (int e = 0; e < 8; ++e) Vt[(32 * vdh + 8 * j + e) * VP + vki] = (bf16_t)((wv[e >> 1] >> (16 * (e & 1))) & 0xffffu); }
    if (tid < 64) {
#pragma unroll
        for (int e = 0; e < 24; ++e) Vt[tid * VP + 256 + e] = 0; }
    f32x4 sc[10];
#pragma unroll
    for (int kt = 0; kt < 9; ++kt) { f32x4 a = (f32x4){0.f, 0.f, 0.f, 0.f};
#pragma unroll
        for (int ks = 0; ks < 2; ++ks) a = __builtin_amdgcn_mfma_f32_16x16x32_bf16(kf[kt][ks], qf[ks], a, 0, 0, 0);
        sc[kt] = a; }
    const int r = r0 + qq;
    float mx = -3.0e38f;
#pragma unroll
    for (int kt = 0; kt < 9; ++kt)
#pragma unroll
        for (int j = 0; j < 4; ++j) { const int ki = 16 * (w + kt) + 4 * g4 + j; const bool ok = (ki >= r) && (ki <= r + 128) && (blk > 0 || ki >= 128);
            const float sv = ok ? sc[kt][j] * 0.125f : -1.0e30f; sc[kt][j] = sv; mx = fmaxf(mx, sv); }
    mx = fmaxf(mx, __shfl_xor(mx, 16)); mx = fmaxf(mx, __shfl_xor(mx, 32));
    float den = 0.f;
#pragma unroll
    for (int kt = 0; kt < 9; ++kt)
#pragma unroll
        for (int j = 0; j < 4; ++j) { const float pexp = __expf(sc[kt][j] - mx); sc[kt][j] = pexp; den += pexp; }
    den += __shfl_xor(den, 16); den += __shfl_xor(den, 32);
    sc[9] = (f32x4){0.f, 0.f, 0.f, 0.f};
    __syncthreads();
    f32x4 oacc[4];
#pragma unroll
    for (int dt = 0; dt < 4; ++dt) oacc[dt] = (f32x4){0.f, 0.f, 0.f, 0.f};
#pragma unroll
    for (int cidx = 0; cidx < 5; ++cidx) {
        const f32x4 p0 = sc[2 * cidx], p1 = sc[2 * cidx + 1];
        u32x4 pw; pw.x = pk2(p0[0], p0[1]); pw.y = pk2(p0[2], p0[3]); pw.z = pk2(p1[0], p1[1]); pw.w = pk2(p1[2], p1[3]);
        const bf16x8 pf = __builtin_bit_cast(bf16x8, pw);
        const int kbase = 16 * (w + 2 * cidx) + 4 * g4;
#pragma unroll
        for (int dt = 0; dt < 4; ++dt) { const LAS bf16_t* vp = Vt + (16 * dt + qq) * VP + kbase;
            const u32x2 lo = *(const LAS u32x2*)vp, hi = *(const LAS u32x2*)(vp + 16);
            u32x4 vw; vw.x = lo.x; vw.y = lo.y; vw.z = hi.x; vw.w = hi.y;
            oacc[dt] = __builtin_amdgcn_mfma_f32_16x16x32_bf16(__builtin_bit_cast(bf16x8, vw), pf, oacc[dt], 0, 0, 0); }
    }
    const float inv = 1.0f / den;
    const size_t tok = (size_t)b * SEQ + (size_t)(blk * 128 + r) * dil + res;
#pragma unroll
    for (int dt = 0; dt < 4; ++dt) { const f32x4 ov = oacc[dt] * inv; *(u32x2*)(AO + ((size_t)g * M + tok) * 512 + h * 64 + 16 * dt + 4 * g4) = (u32x2){pk2(ov[0], ov[1]), pk2(ov[2], ov[3])}; }
    if (g4 == 0) LSE[((size_t)g * M + tok) * 8 + h] = mx + __logf(den);
}

struct KvUnitOrder {
    static constexpr bool GATHER = false;
    const char* A; const char* Bt; int q;
    __device__ bool next(int i, pg8::Unit& u) const {
        if (i != 0) return false;
        const int pm = q & 3, pn = q >> 2;
        u.A = A + (size_t)pm * 256 * D * 2; u.B = Bt + (size_t)pn * 256 * D * 2; u.orow = 256 * pm; u.ocol = 256 * pn; u.aux = 0; u.aux2 = 0; u.valid = 256; return true;
    }
    __device__ __forceinline__ const int* rows(const pg8::Unit&) const { return nullptr; }
};
constexpr int Q_KV = 64, Q_ATT = 3072, Q_TOTAL = Q_KV + Q_ATT + MOE_CONV_GROUPS;
__device__ __forceinline__ void p4_queue(const Params& p, const Ctx& c, volatile LAS unsigned* qslot) {
    unsigned* qc = (unsigned*)(c.ws + WS_CTL) + CW_Q;
    for (;;) {
        __syncthreads();
        if (c.tid == 0) qslot[0] = __hip_atomic_fetch_add(qc, 1u, __ATOMIC_RELAXED, __HIP_MEMORY_SCOPE_AGENT);
        __syncthreads();
        const unsigned it = qslot[0];
        if (it >= (unsigned)Q_TOTAL) break;
        if (it < (unsigned)Q_KV) { const int qi = __builtin_amdgcn_readfirstlane((int)it);
            KvUnitOrder S{(const char*)(c.ws + WS_MEMB), (const char*)(c.ws + WS_WKV), qi};
            pg8::EpiKV E{(bf16_t*)(c.ws + WS_KB), (bf16_t*)(c.ws + WS_VT)};
            pg8::gemm_phase<pg8::EpiKV, KvUnitOrder>(c.lds, pg8::Gemm{D, D, D}, S, E); }
        else if (it < (unsigned)(Q_KV + Q_ATT)) p4_attn_task(c, (int)it - Q_KV); else conv_group(p, c, (int)it - Q_KV - Q_ATT);
    }
}

__device__ __forceinline__ void p5_post(const Params& p, const Ctx& c) {
    unsigned char* ws = c.ws;
    const bf16_t* AO = (const bf16_t*)(ws + WS_AO); const float* LSE = (const float*)(ws + WS_LSE);
    bf16_t* YB = (bf16_t*)(ws + WS_YA);
    const int gw = c.vcu * 8 + c.wave, NGW = c.G * 8, lane = c.lane;
    for (int it = gw; it < M * 8; it += NGW) {
        const int t = it >> 3, h = it & 7;
        const float l0 = LSE[((size_t)0 * M + t) * 8 + h], l1 = LSE[((size_t)1 * M + t) * 8 + h], l2 = LSE[((size_t)2 * M + t) * 8 + h];
        const float mxl = fmaxf(l0, fmaxf(l1, l2)); const float e0 = __expf(l0 - mxl), e1 = __expf(l1 - mxl), e2 = __expf(l2 - mxl); const float inv = 1.0f / (e0 + e1 + e2);
        const size_t o = (size_t)t * 512 + h * 64 + lane;
        const float v = (e0 * bf2f(AO[o]) + e1 * bf2f(AO[(size_t)M * 512 + o]) + e2 * bf2f(AO[(size_t)2 * M * 512 + o])) * inv;
        YB[(size_t)t * 2560 + 2048 + h * 64 + lane] = (bf16_t)f2bf(v);
    }
}

__device__ __forceinline__ void ln_rows(const Ctx& c, const float* in, const float* gam, const float* bet, float* outf, f32x2* stats, unsigned char* outq) {
    const int gw = c.vcu * 8 + c.wave, NGW = c.G * 8, lane = c.lane;
    for (int m = gw; m < M; m += NGW) {
        const f32x4* xr = (const f32x4*)(in + (size_t)m * D) + lane;
        f32x4 v[8]; float s = 0.f;
#pragma unroll
        for (int j = 0; j < 8; ++j) { v[j] = xr[64 * j]; s += (v[j][0] + v[j][1]) + (v[j][2] + v[j][3]); }
        const float mean = wave_sum(s) * (1.0f / D); float s2 = 0.f;
#pragma unroll
        for (int j = 0; j < 8; ++j) { v[j] = v[j] - mean; s2 += (v[j][0] * v[j][0] + v[j][1] * v[j][1]) + (v[j][2] * v[j][2] + v[j][3] * v[j][3]); }
        const float rstd = rsqrtf(wave_sum(s2) * (1.0f / D) + LN_EPS);
        if (stats && lane == 0) stats[m] = (f32x2){mean, rstd};
#pragma unroll
        for (int j = 0; j < 8; ++j) { const int col = 4 * lane + 256 * j; const f32x4 gv = *(const f32x4*)(gam + col), bv = *(const f32x4*)(bet + col);
            const f32x4 o = v[j] * rstd * gv + bv;
            if (outf) *(f32x4*)(outf + (size_t)m * D + col) = o;
            if (outq) *(unsigned*)(outq + (size_t)m * D + col) = pk4_fp8(o[0], o[1], o[2], o[3]); }
    }
}

__device__ __forceinline__ void p15_router(const Params& p, const Ctx& c) {
    unsigned char* ws = c.ws;
    const float* T2 = (const float*)(ws + WS_T2); const f32x2* ST2 = (const f32x2*)(ws + WS_ST2); const float* g2 = p.in[I_LN2G]; const float* b2 = p.in[I_LN2B]; const float* RW = p.in[I_RW]; const float* RB = p.in[I_RB];
    unsigned* cnt = (unsigned*)(ws + WS_CTL) + CW_CNT; int* LIST = (int*)(ws + WS_LIST); int* ROWI = (int*)(ws + WS_ROWI); float* TOPW = (float*)(ws + WS_TOPW);
    LAS float* scr = (LAS float*)(c.lds + c.wave * 8192);
    const int gw = c.vcu * 8 + c.wave, NGW = c.G * 8, lane = c.lane, li = lane & 31, lk = lane >> 5;
    for (int tb = gw; tb < M / 32; tb += NGW) {
        const int t0 = tb * 32;
        f32x16 acc;
#pragma unroll
        for (int j = 0; j < 16; ++j) acc[j] = 0.f;
        const float* xa = T2 + (size_t)(t0 + li) * D + 4 * lk; const f32x2 st = ST2[t0 + li];
        const float* wb = RW + (size_t)(4 * lk) * 32 + li;
        for (int kb = 0; kb < D / 8; ++kb) {
            const f32x4 a = ((*(const f32x4*)(xa + 8 * kb) - st.x) * st.y) * *(const f32x4*)(g2 + 8 * kb + 4 * lk) + *(const f32x4*)(b2 + 8 * kb + 4 * lk);
            const float b0 = wb[(size_t)(8 * kb + 0) * 32], b1 = wb[(size_t)(8 * kb + 1) * 32], b2 = wb[(size_t)(8 * kb + 2) * 32], b3 = wb[(size_t)(8 * kb + 3) * 32];
            acc = __builtin_amdgcn_mfma_f32_32x32x2f32(a[0], b0, acc, 0, 0, 0);
            acc = __builtin_amdgcn_mfma_f32_32x32x2f32(a[1], b1, acc, 0, 0, 0);
            acc = __builtin_amdgcn_mfma_f32_32x32x2f32(a[2], b2, acc, 0, 0, 0);
            acc = __builtin_amdgcn_mfma_f32_32x32x2f32(a[3], b3, acc, 0, 0, 0);
        }
        const float bias = RB[li];
#pragma unroll
        for (int rg = 0; rg < 16; ++rg) { const int row = (rg & 3) + 8 * (rg >> 2) + 4 * lk; scr[row * 33 + li] = acc[rg] + bias; }
        LDS_WAIT(); asm volatile("" ::: "memory");
        if (lane < 32) {
            float lv[32];
#pragma unroll
            for (int e = 0; e < 32; ++e) lv[e] = scr[lane * 33 + e];
            int id[4]; float tv[4];
#pragma unroll
            for (int k = 0; k < 4; ++k) { float best = -3.0e38f; int bi = 0;
#pragma unroll
                for (int e = 0; e < 32; ++e) { const bool tk = lv[e] > best; best = tk ? lv[e] : best; bi = tk ? e : bi; }
                id[k] = bi; tv[k] = best;
#pragma unroll
                for (int e = 0; e < 32; ++e) lv[e] = (e == bi) ? -3.0e38f : lv[e]; }
            const float e1 = __expf(tv[1] - tv[0]), e2 = __expf(tv[2] - tv[0]), e3 = __expf(tv[3] - tv[0]); const float inv = 1.0f / (1.0f + e1 + e2 + e3);
            const float wv[4] = {inv, e1 * inv, e2 * inv, e3 * inv};
            const int t = t0 + lane;
#pragma unroll
            for (int k = 0; k < 4; ++k) { const unsigned slot = __hip_atomic_fetch_add(cnt + id[k], 1u, __ATOMIC_RELAXED, __HIP_MEMORY_SCOPE_AGENT);
                LIST[(size_t)id[k] * CAP + slot] = t; ROWI[(size_t)t * 4 + k] = id[k] * CAP + (int)slot; TOPW[(size_t)t * 4 + k] = wv[k]; }
        }
        LDS_WAIT(); asm volatile("" ::: "memory");
    }
}

__device__ __forceinline__ void moe_table(const Ctx& c, LAS int* tab) {
    if (c.tid == 0) { unsigned* cnt = (unsigned*)(c.ws + WS_CTL) + CW_CNT; int ts = 0;
        for (int e = 0; e < NEXP; ++e) { const int n = (int)__hip_atomic_load(cnt + e, __ATOMIC_RELAXED, __HIP_MEMORY_SCOPE_AGENT); tab[e] = n; tab[32 + e] = ts; ts += (n + 255) >> 8; }
        tab[64] = ts; }
    __syncthreads();
}

__device__ __forceinline__ void p18_combine(const Params& p, const Ctx& c, const LAS int* tab) {
    unsigned char* ws = c.ws;
    const float* T2 = (const float*)(ws + WS_T2); const f32x2* ST2 = (const f32x2*)(ws + WS_ST2); const float* g2 = p.in[I_LN2G]; const float* b2 = p.in[I_LN2B]; const bf16_t* Y = (const bf16_t*)(ws + WS_Y); const int* ROWI = (const int*)(ws + WS_ROWI); const float* TOPW = (const float*)(ws + WS_TOPW);
    const float* gam = p.in[I_LN3G]; const float* bet = p.in[I_LN3B];
    const int gw = c.vcu * 8 + c.wave, NGW = c.G * 8, lane = c.lane;
    for (int m = gw; m < M; m += NGW) {
        f32x4 v[8];
        const f32x4* xr = (const f32x4*)(T2 + (size_t)m * D) + lane; const f32x2 st = ST2[m];
#pragma unroll
        for (int j = 0; j < 8; ++j) { const int col = 4 * lane + 256 * j; v[j] = (((xr[64 * j] - st.x) * st.y) * *(const f32x4*)(g2 + col) + *(const f32x4*)(b2 + col)) * DN_ALPHA; }
#pragma unroll
        for (int k = 0; k < 4; ++k) { const int ri = ROWI[(size_t)m * 4 + k]; const float gt = TOPW[(size_t)m * 4 + k]; const int e = ri >> 14, slot = ri & (CAP - 1);
            const u32x2* yr = (const u32x2*)(Y + ((size_t)tab[32 + e] * 256 + slot) * D) + lane;
#pragma unroll
            for (int j = 0; j < 8; ++j) { const u32x2 yw = yr[64 * j]; v[j] = v[j] + (f32x4){bf2f(yw.x & 0xffffu), bf2f(yw.x >> 16), bf2f(yw.y & 0xffffu), bf2f(yw.y >> 16)} * gt; } }
        float s = 0.f;
#pragma unroll
        for (int j = 0; j < 8; ++j) s += (v[j][0] + v[j][1]) + (v[j][2] + v[j][3]);
        const float mean = wave_sum(s) * (1.0f / D); float s2 = 0.f;
#pragma unroll
        for (int j = 0; j < 8; ++j) { v[j] = v[j] - mean; s2 += (v[j][0] * v[j][0] + v[j][1] * v[j][1]) + (v[j][2] * v[j][2] + v[j][3] * v[j][3]); }
        const float rstd = rsqrtf(wave_sum(s2) * (1.0f / D) + LN_EPS);
#pragma unroll
        for (int j = 0; j < 8; ++j) { const int col = 4 * lane + 256 * j; const f32x4 gv = *(const f32x4*)(gam + col), bv = *(const f32x4*)(bet + col);
            *(f32x4*)(p.out + (size_t)m * D + col) = v[j] * rstd * gv + bv; }
    }
}

constexpr int NPHASE = 19;
__global__ void __launch_bounds__(512, 2) fwd(Params p) {
    extern __shared__ __attribute__((aligned(16))) unsigned char lds_raw[];
    LAS unsigned char* lds = (LAS unsigned char*)lds_raw;
    Ctx c; c.tid = threadIdx.x; c.lane = c.tid & 63; c.wave = __builtin_amdgcn_readfirstlane(c.tid >> 6); c.G = gridDim.x;
    { const int bx = blockIdx.x; c.vcu = (c.G % 8 == 0) ? (bx % 8) * (c.G / 8) + bx / 8 : bx; }
    c.lds = lds; c.ws = p.ws;
    unsigned char* ws = p.ws;
    volatile LAS unsigned* MISC = (volatile LAS unsigned*)(lds + MISC_OFF);
    LAS int* tab = (LAS int*)(lds + MISC_OFF + 1024);
    if (c.tid < 64) MISC[c.tid] = 0u;
    __syncthreads();
    unsigned* ctl = (unsigned*)(ws + WS_CTL);
    XcdBarrier bar; bar.bar = ctl + CW_BAR + p.li * XCD_BAR_WORDS; bar.x = 0; bar.st = MISC + 8;
    if (N_LAUNCH_MODE == 1) bar = xcd_barrier_post(ctl + CW_BAR + p.li * XCD_BAR_WORDS, MISC + 8);
    const int lo = p.ph_lo, hi = p.ph_hi, bx = blockIdx.x;
#ifndef PHMASK
#define PHMASK 0xFFFFFFFFu
#endif
#define IN(k) (((PHMASK >> (k)) & 1u) && lo <= (k) && (k) < hi)
#define SEAM(k) do { if (N_LAUNCH_MODE == 1 && IN((k) + 1)) xcd_barrier(bar); } while (0)

    if (IN(0)) { p0_prologue(p, c); SEAM(0); }

    if (IN(1)) {
        { pg8::StaticOrder S; S.init(ws + WS_XB, ws + WS_WIN, M, ATT0, D, D, c.G, bx);
          pg8::EpiBf16 E{(bf16_t*)(ws + WS_PROJ), PC, 1.0f};
          pg8::gemm_phase<pg8::EpiBf16, pg8::StaticOrder>(lds, pg8::Gemm{D, D, D}, S, E); }
        { pg8::StaticOrder S; S.init(ws + WS_XQ, ws + WS_WIN8, M, PC - ATT0, D, D, c.G, bx, 1);
          pg8::EpiBf16 E{(bf16_t*)(ws + WS_PROJ) + ATT0, PC, 1.0f};
          pg8::gemm_phase<pg8::EpiBf16, pg8::StaticOrder, true, true>(lds, pg8::Gemm{D, D, D}, S, E); }
        SEAM(1);
    }
    if (IN(2)) { p2_prep(p, c); SEAM(2); }

    if (IN(3)) {
#ifndef P3M
#define P3M 15
#endif
        if (P3M & 1) { pg8::StaticOrder S; S.init(ws + WS_LIN, ws + WS_WUP, M, D, 768, 256, c.G, bx);
          pg8::EpiDecay E{(bf16_t*)(ws + WS_DEC), p.in[I_W0]};
          pg8::gemm_phase<pg8::EpiDecay, pg8::StaticOrder>(lds, pg8::Gemm{256, 768, 256}, S, E); }
        if (P3M & 2) { pg8::StaticOrder S; S.init(ws + WS_LIN + 512, ws + WS_AUP, M, D, 768, 256, c.G, bx);
          pg8::EpiIclr E{p.in[I_A0], (bf16_t*)(ws + WS_AN)};
          pg8::gemm_phase<pg8::EpiIclr, pg8::StaticOrder>(lds, pg8::Gemm{256, 768, 256}, S, E); }
        if (P3M & 4) { pg8::StaticOrder S; S.init(ws + WS_LIN + 1024, ws + WS_GUP, M, D, 768, 256, c.G, bx);
          pg8::EpiBf16 E{(bf16_t*)(ws + WS_GG), D, 1.0f};
          pg8::gemm_phase<pg8::EpiBf16, pg8::StaticOrder>(lds, pg8::Gemm{256, 768, 256}, S, E); }
        SEAM(3);
    }
    if (IN(4)) {
        p4_pre(p, c);
        xcd_barrier(bar);
        for (int bh = c.vcu; bh < 128; bh += c.G) p4_seq(p, c, bh);
        p4_queue(p, c, MISC + 16);
        SEAM(4);
    }
    if (IN(5)) { p5_post(p, c); }

    if (IN(6)) {
        pg8::StaticOrder S; S.init(ws + WS_YA, ws + WS_PA, M, D, 2560, 2560, c.G, bx);
        pg8::EpiGateFused E{(const bf16_t*)(ws + WS_PROJ), (bf16_t*)(ws + WS_MERGED)};
        pg8::gemm_phase<pg8::EpiGateFused, pg8::StaticOrder>(lds, pg8::Gemm{2560, 2560, 2560}, S, E);
        SEAM(6);
    }
    if (IN(7)) { }
    if (IN(8)) {
        pg8::StaticOrder S; S.init(ws + WS_MERGED, ws + WS_WOUT, M, D, D, D, c.G, bx);
        pg8::EpiF32 E{(float*)(ws + WS_T1), D, nullptr, 0, p.in[I_X], DN_ALPHA};
        pg8::gemm_phase<pg8::EpiF32, pg8::StaticOrder>(lds, pg8::Gemm{D, D, D}, S, E);
        SEAM(8);
    }
    if (IN(9)) { ln_rows(c, (const float*)(ws + WS_T1), p.in[I_LN1G], p.in[I_LN1B], nullptr, (f32x2*)(ws + WS_ST1), ws + WS_X1B); SEAM(9); }

    if (IN(10)) {
        pg8::StaticOrder S; S.init(ws + WS_X1B, ws + WS_WQ, M, D, D, D, c.G, bx, 1);
        pg8::EpiBf16 E{(bf16_t*)(ws + WS_Q), D, 0.04419417382415922f};
        pg8::gemm_phase<pg8::EpiBf16, pg8::StaticOrder, true, true>(lds, pg8::Gemm{D, D, D}, S, E);
        SEAM(10);
    }
    if (IN(11)) {
        ScoreOrder S{(const char*)(ws + WS_Q), (const char*)(ws + WS_KB), c.G, bx};
        pg8::EpiSoftmax E{(bf16_t*)(ws + WS_PP)};
        pg8::gemm_phase<pg8::EpiSoftmax, ScoreOrder, false>(lds, pg8::Gemm{512, D, D}, S, E);
        SEAM(11);
    }
    if (IN(12)) {
        PvOrder S{(const char*)(ws + WS_PP), (const char*)(ws + WS_VT), c.G, bx};
        pg8::EpiBf16 E{(bf16_t*)(ws + WS_OC), D, 1.0f};
        pg8::gemm_phase<pg8::EpiBf16, PvOrder>(lds, pg8::Gemm{256, 256, 256}, S, E);
        SEAM(12);
    }
    if (IN(13)) {
        pg8::StaticOrder S; S.init(ws + WS_OC, ws + WS_WO, M, D, D, D, c.G, bx);
        pg8::EpiResLn E{(float*)(ws + WS_T2), (const float*)(ws + WS_T1), (const f32x2*)(ws + WS_ST1), p.in[I_LN1G], p.in[I_LN1B], DN_ALPHA};
        pg8::gemm_phase<pg8::EpiResLn, pg8::StaticOrder>(lds, pg8::Gemm{D, D, D}, S, E);
        SEAM(13);
    }
    if (IN(14)) { ln_rows(c, (const float*)(ws + WS_T2), p.in[I_LN2G], p.in[I_LN2B], nullptr, (f32x2*)(ws + WS_ST2), ws + WS_X2B); SEAM(14); }
    if (IN(15)) { p15_router(p, c); SEAM(15); }

    if (IN(16)) {
        moe_table(c, tab);
        MoeOrder<true, 16> S{tab, (const char*)(ws + WS_X2B), (const char*)(ws + WS_W1), (const int*)(ws + WS_LIST), (size_t)4096 * D, D, c.G, bx};
        pg8::EpiSwiglu E{p.in[I_B1], (bf16_t*)(ws + WS_H)};
        pg8::gemm_phase<pg8::EpiSwiglu, MoeOrder<true, 16>, true, true>(lds, pg8::Gemm{D, D, D}, S, E);
        SEAM(16);
    }
    if (IN(17)) {
        moe_table(c, tab);
        MoeOrder<false, 8> S{tab, (const char*)(ws + WS_H), (const char*)(ws + WS_W2), (const int*)(ws + WS_LIST), (size_t)D * DFF, DFF, c.G, bx};
        pg8::EpiBf16Bias E{(bf16_t*)(ws + WS_Y), D, p.in[I_B2], D};
        pg8::gemm_phase<pg8::EpiBf16Bias, MoeOrder<false, 8>, true, true>(lds, pg8::Gemm{DFF, DFF, DFF}, S, E);
        SEAM(17);
    }
    if (IN(18)) { moe_table(c, tab); p18_combine(p, c, tab); }
#undef IN
#undef SEAM
}

extern "C" void kernel_launch(void* const* d_in, const int* in_sizes, int n_in, void* d_out, int out_size, void* d_ws, size_t ws_size, hipStream_t stream) {
    static int grid = 0;
    if (grid == 0) {
        if (n_in != 32 || out_size != M * D || ws_size < WS_END) { fprintf(stderr, "kernel_launch: expected 32 inputs, %d outputs, >= %zu bytes of workspace; got %d, %d, %zu\n", M * D, (size_t)WS_END, n_in, out_size, ws_size); grid = -1; return; }
        int dev = 0, cus = 0, per_cu = 0;
        if (hipGetDevice(&dev) != hipSuccess || hipDeviceGetAttribute(&cus, hipDeviceAttributeMultiprocessorCount, dev) != hipSuccess) { grid = -1; return; }
        if (hipFuncSetAttribute((const void*)fwd, hipFuncAttributeMaxDynamicSharedMemorySize, LDS_BYTES) != hipSuccess) { fprintf(stderr, "kernel_launch: hipFuncSetAttribute failed\n"); grid = -1; return; }
        if (hipOccupancyMaxActiveBlocksPerMultiprocessor(&per_cu, (const void*)fwd, 512, LDS_BYTES) != hipSuccess || per_cu < 1) fprintf(stderr, "kernel_launch: occupancy query reports %d\n", per_cu);
        (void)hipGetLastError();
        grid = cus;
        if (grid != 256) fprintf(stderr, "kernel_launch: %d CUs; this kernel is built for 256\n", grid);
    }
    if (grid < 0) return;
    (void)hipMemsetAsync((char*)d_ws + WS_CTL, 0, CTL_ZERO_BYTES, stream);
    Params p{};
    for (int i = 0; i < 32; ++i) p.in[i] = (const float*)d_in[i];
    p.out = (float*)d_out; p.ws = (unsigned char*)d_ws;
#if defined(TIMING_REPEAT_LO)
    { const int cuts[4][2] = {{0, TIMING_REPEAT_HI}, {TIMING_REPEAT_LO, TIMING_REPEAT_HI}, {TIMING_REPEAT_HI, NPHASE}, {0, 0}};
      for (int li = 0; li < 3; ++li) { if (cuts[li][0] >= cuts[li][1]) continue; p.ph_lo = cuts[li][0]; p.ph_hi = cuts[li][1]; p.li = li; hipLaunchKernelGGL(fwd, dim3(grid), dim3(512), LDS_BYTES, stream, p); } }
#else
    if (N_LAUNCH_MODE == 1) { p.ph_lo = 0; p.ph_hi = NPHASE; hipLaunchKernelGGL(fwd, dim3(grid), dim3(512), LDS_BYTES, stream, p); }
    else for (int k = 0; k < NPHASE; ++k) { p.ph_lo = k; p.ph_hi = k + 1; hipLaunchKernelGGL(fwd, dim3(grid), dim3(512), LDS_BYTES, stream, p); }
#endif
}
```

```cpp
#include <hip/hip_runtime.h>
#include <cstdio>
#include <cstdint>

#define LAS __attribute__((address_space(3)))
#define GAS __attribute__((address_space(1)))
typedef unsigned short bf16_t;
typedef short bf16x8 __attribute__((ext_vector_type(8)));
typedef float f32x4 __attribute__((ext_vector_type(4)));
typedef float f32x2 __attribute__((ext_vector_type(2)));
typedef float f32x16 __attribute__((ext_vector_type(16)));
typedef unsigned u32x4 __attribute__((ext_vector_type(4)));
typedef unsigned u32x2 __attribute__((ext_vector_type(2)));

#ifndef N_LAUNCH_MODE
#define N_LAUNCH_MODE 1
#endif

constexpr int M = 16384, D = 2048, SEQ = 4096, NBATCH = 4;
constexpr int RWC = 6592;
constexpr int PC = 15360;
constexpr int ATTV2 = 6656, ATT0 = 7168, GATE0 = 11264;
constexpr int NEXP = 32, DFF = 2048, CAP = 16384;
constexpr int HROWS = 65536 + 32 * 256;
constexpr float LN_EPS = 1e-5f, GN_EPS = 64e-5f;
constexpr float DN_ALPHA = 1.189207115002721f;

__device__ __forceinline__ float bf2f(unsigned v) { return __uint_as_float(v << 16); }
typedef __bf16 bf16x2_t __attribute__((ext_vector_type(2)));
__device__ __forceinline__ unsigned pk2(float lo, float hi) { const bf16x2_t r = __builtin_convertvector((f32x2){lo, hi}, bf16x2_t); return __builtin_bit_cast(unsigned, r); }
__device__ __forceinline__ unsigned f2bf(float f) { return pk2(f, 0.f) & 0xffffu; }
typedef int v4i __attribute__((ext_vector_type(4)));
typedef int v8i __attribute__((ext_vector_type(8)));
__device__ __forceinline__ unsigned pk4_fp8(float a, float b, float c, float d) { int r = __builtin_amdgcn_cvt_pk_fp8_f32(a, b, 0, false); r = __builtin_amdgcn_cvt_pk_fp8_f32(c, d, r, true); return (unsigned)r; }
__device__ __forceinline__ float sigmoidf_(float x) { return __builtin_amdgcn_rcpf(1.0f + __expf(-x)); }
__device__ __forceinline__ float wave_sum(float v) {
#pragma unroll
    for (int o = 1; o < 64; o <<= 1) v += __shfl_xor(v, o);
    return v;
}
#define LDS_WAIT() asm volatile("s_waitcnt lgkmcnt(0)" ::: "memory")
#define VM_WAIT() asm volatile("s_waitcnt vmcnt(0)" ::: "memory")

namespace pg8 {
#define PG8_LAS __attribute__((address_space(3)))
constexpr int BM = 256, BK = 64, HALF = 128, HTB = HALF * BK * 2, STAGE_BYTES = 8 * HTB, NXCD = 8, WGM = 8;

__host__ __device__ __forceinline__ int lds_byte(int r, int c) { const int st = (r >> 4) * 2 + (c >> 5), rr = r & 15, cc = c & 31, ob = rr * 64 + cc * 2; return st * 1024 + (ob ^ (((ob >> 9) & 1) << 5)); }
__host__ __device__ __forceinline__ void stage_rc(int b, int& R, int& C) { const int st = b / 1024, sb = b % 1024, swz = sb ^ (((sb >> 9) & 1) << 5); R = (st >> 1) * 16 + swz / 64; C = (st & 1) * 32 + (swz % 64) / 2; }
__host__ __device__ __forceinline__ int perm32(int rho) { const int n = rho >> 4, i = rho & 15; return 8 * (i >> 2) + 4 * n + (i & 3); }

struct Unit { const char* A; const char* B; int orow, ocol, aux, aux2, valid; };
struct Gemm { int K, lda, ldb; };

struct StaticOrder {
    static constexpr bool GATHER = false;
    const char* A; const char* Bt; size_t ta, tb;
    int nM, nN, nwg, G, c;
    __device__ void init(const void* A_, const void* Bt_, int M_, int N_, int lda, int ldb, int G_, int c_, int esz = 2) { A = (const char*)A_; Bt = (const char*)Bt_; ta = (size_t)BM * lda * esz; tb = (size_t)BM * ldb * esz; nM = M_ / BM; nN = N_ / BM; nwg = nM * nN; G = G_; c = c_; }
    __device__ bool next(int i, Unit& u) const {
        const long L = (long)i * G + c; if (c < 0 || L >= nwg) return false;
        int wgid = (int)L; { const int q = nwg / NXCD, r = nwg % NXCD, xcd = wgid % NXCD, off = wgid / NXCD; wgid = (xcd < r ? xcd * (q + 1) : r * (q + 1) + (xcd - r) * q) + off; }
        const int nig = WGM * nN, gid = wgid / nig, fm = gid * WGM, gsz = (nM - fm) < WGM ? (nM - fm) : WGM;
        const int pm = fm + ((wgid % nig) % gsz), pn = (wgid % nig) / gsz;
        u.A = A + (size_t)pm * ta; u.B = Bt + (size_t)pn * tb; u.orow = pm * BM; u.ocol = pn * BM; u.aux = 0; u.aux2 = 0; u.valid = BM; return true;
    }
    __device__ __forceinline__ const int* rows(const Unit&) const { return nullptr; }
};

__device__ __forceinline__ unsigned cvt_pk_bf16(float lo, float hi) { return ::pk2(lo, hi); }

template <class Epi, class Sched, bool ALIGN_EPI = true, bool FP8 = false>
__device__ __forceinline__ void gemm_phase(PG8_LAS unsigned char* lds, const Gemm g, const Sched& S, const Epi& E) {
    const int tid = threadIdx.x, wid = __builtin_amdgcn_readfirstlane(tid >> 6), lane = tid & 63, wr = wid >> 2, wc = wid & 3, fr = lane & 15, fq = lane >> 4;
    constexpr int ES = FP8 ? 1 : 2;
    int sclW = 0, sclX = 0;
    if constexpr (FP8) { asm volatile("v_mov_b32 %0, 0x79797979\n\tv_mov_b32 %1, 0x7f7f7f7f" : "=v"(sclW), "=v"(sclX)); }
    const int K = g.K, nt = K * ES / (BK * 2);
    unsigned voffA[2], voffB[2]; int Rr[2], Cc[2];
#pragma unroll
    for (int i = 0; i < 2; ++i) { int R, C; stage_rc(tid * 16 + i * 8192, R, C); const int Rb = Epi::PERM ? ((R & ~31) + perm32(R & 31)) : R; Rr[i] = R; Cc[i] = C;
        voffA[i] = (unsigned)(R * g.lda * ES + C * 2); voffB[i] = (unsigned)(Rb * g.ldb * ES + C * 2); }
    const size_t kstep = (size_t)(BK * 2);
    const size_t hstepA = (size_t)HALF * g.lda * ES, hstepB = (size_t)HALF * g.ldb * ES;
    const unsigned ldsw = (unsigned)wid * 1024u;
    const int aoff = lds_byte(wr * 64 + fr, fq * 8), boff = lds_byte(wc * 32 + fr, fq * 8);
    unsigned vAc[2][2], vAn[2][2];
#define PG8_SA(b, h) (((b) * 2 + (h)) * HTB)
#define PG8_SB(b, h) ((4 + (b) * 2 + (h)) * HTB)
#define PG8_STAGE(bufoff, gbase, voff) do { _Pragma("unroll") for (int _i = 0; _i < 2; ++_i) \
        __builtin_amdgcn_global_load_lds((const unsigned*)((const char*)(gbase) + (voff)[_i]), (PG8_LAS unsigned*)(lds + (bufoff) + ldsw + _i * 8192), 16, 0, 0); } while (0)
#define PG8_STAGE_A(bufoff, kbase, h, nx) do { if constexpr (Sched::GATHER) { unsigned _v[2] = {(nx) ? vAn[h][0] : vAc[h][0], (nx) ? vAn[h][1] : vAc[h][1]}; PG8_STAGE(bufoff, kbase, _v); } \
        else { PG8_STAGE(bufoff, (kbase) + (h) * hstepA, voffA); } } while (0)
#define PG8_GOFF(u, v) do { const int* _rw = S.rows(u); _Pragma("unroll") for (int _h = 0; _h < 2; ++_h) _Pragma("unroll") for (int _i = 0; _i < 2; ++_i) { const int _r = Rr[_i] + _h * HALF; \
        const int _tk = _r < (u).valid ? _rw[_r] : 0; v[_h][_i] = (unsigned)(_tk * g.lda * ES + Cc[_i] * 2); } } while (0)
#define PG8_LDA(dst, b, h) do { _Pragma("unroll") for (int m = 0; m < 4; ++m) _Pragma("unroll") for (int k = 0; k < 2; ++k) dst[m][k] = *(const PG8_LAS bf16x8*)(lds + PG8_SA(b, h) + aoff + m * 2048 + k * 1024); } while (0)
#define PG8_LDB(dst, b, h) do { _Pragma("unroll") for (int n = 0; n < 2; ++n) _Pragma("unroll") for (int k = 0; k < 2; ++k) dst[n][k] = *(const PG8_LAS bf16x8*)(lds + PG8_SB(b, h) + boff + n * 2048 + k * 1024); } while (0)
#define PG8_MMA(ai, bj, At, Bt) do { __builtin_amdgcn_s_setprio(1); _Pragma("unroll") for (int m = 0; m < 4; ++m) _Pragma("unroll") for (int n = 0; n < 2; ++n) { \
        if constexpr (FP8) { const v4i _b0 = __builtin_bit_cast(v4i, Bt[n][0]), _b1 = __builtin_bit_cast(v4i, Bt[n][1]), _a0 = __builtin_bit_cast(v4i, At[m][0]), _a1 = __builtin_bit_cast(v4i, At[m][1]); \
            const v8i _bb = __builtin_shufflevector(_b0, _b1, 0, 1, 2, 3, 4, 5, 6, 7), _aa = __builtin_shufflevector(_a0, _a1, 0, 1, 2, 3, 4, 5, 6, 7); \
            asm volatile("v_mfma_scale_f32_16x16x128_f8f6f4 %0, %1, %2, %0, %3, %4 op_sel_hi:[0,0,0]" : "+v"(acc[ai][bj][m][n]) : "v"(_bb), "v"(_aa), "v"(sclW), "v"(sclX)); } \
        else { _Pragma("unroll") for (int k = 0; k < 2; ++k) acc[ai][bj][m][n] = __builtin_amdgcn_mfma_f32_16x16x32_bf16(Bt[n][k], At[m][k], acc[ai][bj][m][n], 0, 0, 0); } } \
        __builtin_amdgcn_s_setprio(0); } while (0)
#define PG8_WAIT_V(n) asm volatile("s_waitcnt vmcnt(" #n ")" ::: "memory")
#define PG8_WAIT_L(n) asm volatile("s_waitcnt lgkmcnt(" #n ")" ::: "memory")
#define PG8_BAR __builtin_amdgcn_s_barrier()
#define PG8_SCHED __builtin_amdgcn_sched_barrier(0)
    Unit cur, nxt; int ui = 0;
    if (!S.next(0, cur)) return;
    f32x4 acc[2][2][4][2];
#pragma unroll
    for (int a = 0; a < 2; ++a)
#pragma unroll
        for (int b = 0; b < 2; ++b)
#pragma unroll
            for (int m = 0; m < 4; ++m)
#pragma unroll
                for (int n = 0; n < 2; ++n) acc[a][b][m][n] = (f32x4){0.f, 0.f, 0.f, 0.f};
    bf16x8 At[4][2], B0[2][2], B1[2][2];
    const char* cA = cur.A; const char* cB = cur.B;
    if constexpr (Sched::GATHER) { PG8_GOFF(cur, vAc); PG8_WAIT_V(0); }
    PG8_STAGE(PG8_SB(0, 0), cB, voffB); PG8_STAGE(PG8_SB(0, 1), cB + hstepB, voffB); PG8_STAGE_A(PG8_SA(0, 0), cA, 0, false); PG8_STAGE_A(PG8_SA(0, 1), cA, 1, false);
    if (wr == 1) PG8_BAR;
    PG8_WAIT_V(2); PG8_BAR;
    PG8_STAGE(PG8_SB(1, 0), cB + kstep, voffB); PG8_STAGE_A(PG8_SA(1, 0), cA + kstep, 0, false); PG8_STAGE(PG8_SB(1, 1), cB + hstepB + kstep, voffB);
    PG8_WAIT_V(6); PG8_BAR;
    for (;;) {
        const bool has_next = S.next(ui + 1, nxt);
        const char* nA = has_next ? nxt.A : cA; const char* nB = has_next ? nxt.B : cB;
        if constexpr (Sched::GATHER) { if (has_next) { PG8_GOFF(nxt, vAn); } else {
#pragma unroll
            for (int h = 0; h < 2; ++h)
#pragma unroll
                for (int i = 0; i < 2; ++i) vAn[h][i] = vAc[h][i]; } }
#pragma nounroll
        for (int t = 0; t < nt; t += 2) {
            const bool last = (t == nt - 2);
            if constexpr (Epi::MID_T >= 0) { if (t == Epi::MID_T) { int l3 = lane; asm volatile("" : "+v"(l3)); E.mid(acc, cur, wr, wc, l3 & 15, l3 >> 4); } }
            const char* a1 = cA + (size_t)(t + 1) * kstep;
            const char* a2 = last ? nA : cA + (size_t)(t + 2) * kstep; const char* b2 = last ? nB : cB + (size_t)(t + 2) * kstep;
            const char* a3 = a2 + kstep; const char* b3 = b2 + kstep;
            PG8_LDB(B0, 0, 0); PG8_LDB(B1, 0, 1); PG8_SCHED; PG8_LDA(At, 0, 0); PG8_STAGE_A(PG8_SA(1, 1), a1, 1, false);
            PG8_WAIT_V(8); PG8_WAIT_L(0); PG8_BAR; PG8_MMA(0, 0, At, B0); PG8_MMA(0, 1, At, B1); PG8_BAR; PG8_SCHED;
            PG8_LDA(At, 0, 1); PG8_STAGE(PG8_SB(0, 0), b2, voffB); PG8_STAGE(PG8_SB(0, 1), b2 + hstepB, voffB); PG8_STAGE_A(PG8_SA(0, 0), a2, 0, last);
            PG8_WAIT_V(8); PG8_WAIT_L(0); PG8_BAR; PG8_MMA(1, 0, At, B0); PG8_MMA(1, 1, At, B1); PG8_BAR; PG8_SCHED;
            PG8_LDB(B0, 1, 0); PG8_LDB(B1, 1, 1); PG8_SCHED; PG8_LDA(At, 1, 0); PG8_STAGE_A(PG8_SA(0, 1), a2, 1, last);
            PG8_WAIT_V(8); PG8_WAIT_L(0); PG8_BAR; PG8_MMA(0, 0, At, B0); PG8_MMA(0, 1, At, B1); PG8_BAR; PG8_SCHED;
            PG8_LDA(At, 1, 1); PG8_STAGE(PG8_SB(1, 0), b3, voffB); PG8_STAGE(PG8_SB(1, 1), b3 + hstepB, voffB); PG8_STAGE_A(PG8_SA(1, 0), a3, 0, last);
            PG8_WAIT_V(8); PG8_WAIT_L(0); PG8_BAR; PG8_MMA(1, 0, At, B0); PG8_MMA(1, 1, At, B1); PG8_BAR; PG8_SCHED;
        }
        if constexpr (ALIGN_EPI) { if (wr == 0) PG8_BAR; }
        if constexpr (FP8) asm volatile("s_nop 15\n\ts_nop 15" ::: "memory");
        if constexpr (!Epi::AFTER_DRAIN) { int l2 = lane; asm volatile("" : "+v"(l2));
            E(acc, cur, wr, wc, l2 & 15, l2 >> 4); }
        if (!has_next) break;
#pragma unroll
        for (int a = 0; a < 2; ++a)
#pragma unroll
            for (int b = 0; b < 2; ++b)
#pragma unroll
                for (int m = 0; m < 4; ++m)
#pragma unroll
                    for (int n = 0; n < 2; ++n) acc[a][b][m][n] = (f32x4){0.f, 0.f, 0.f, 0.f};
        cur = nxt; cA = nA; cB = nB; ++ui;
        if constexpr (Sched::GATHER) {
#pragma unroll
            for (int h = 0; h < 2; ++h)
#pragma unroll
                for (int i = 0; i < 2; ++i) vAc[h][i] = vAn[h][i]; }
        if constexpr (ALIGN_EPI) { if (wr == 1) PG8_BAR; }
    }
    PG8_WAIT_V(0);
    if constexpr (!ALIGN_EPI) { if (wr == 0) PG8_BAR; }
    PG8_BAR;
    if constexpr (Epi::AFTER_DRAIN) { E.fused(acc, cur, wr, wc, fr, fq, lds, wid, lane); }
#undef PG8_SA
#undef PG8_SB
#undef PG8_STAGE
#undef PG8_STAGE_A
#undef PG8_GOFF
#undef PG8_LDA
#undef PG8_LDB
#undef PG8_MMA
#undef PG8_WAIT_V
#undef PG8_WAIT_L
#undef PG8_BAR
#undef PG8_SCHED
}

#define EPI_LOOP_AI_M for (int ai = 0; ai < 2; ++ai) _Pragma("unroll") for (int m = 0; m < 4; ++m)

struct EpiF32 {
    static constexpr bool PERM = false, AFTER_DRAIN = false; static constexpr int MID_T = -1;
    float* C; int ldc; const float* bias; int bstride; const float* res; float alpha;
    __device__ __forceinline__ void operator()(const f32x4 (&acc)[2][2][4][2], const Unit& u, int wr, int wc, int fr, int fq) const {
        const int row0 = u.orow + wr * 64 + fr, col0 = u.ocol + wc * 32 + 4 * fq;
        f32x4 bv[2][2];
#pragma unroll
        for (int bj = 0; bj < 2; ++bj)
#pragma unroll
            for (int n = 0; n < 2; ++n) bv[bj][n] = bias ? *(const f32x4*)(bias + (size_t)u.aux * bstride + col0 + bj * HALF + n * 16) : (f32x4){0.f, 0.f, 0.f, 0.f};
#pragma unroll
        EPI_LOOP_AI_M { const size_t off = (size_t)(row0 + ai * HALF + m * 16) * ldc + col0;
#pragma unroll
            for (int bj = 0; bj < 2; ++bj)
#pragma unroll
                for (int n = 0; n < 2; ++n) { f32x4 v = acc[ai][bj][m][n] + bv[bj][n];
                    if (res) { const f32x4 rv = *(const f32x4*)(res + off + bj * HALF + n * 16); v = v + rv * alpha; }
                    *(f32x4*)(C + off + bj * HALF + n * 16) = v; }
            asm volatile("" ::: "memory"); }
    }
};
struct EpiResLn {
    static constexpr bool PERM = false, AFTER_DRAIN = false; static constexpr int MID_T = -1;
    float* C; const float* T; const f32x2* stats; const float* gam; const float* bet; float alpha;
    __device__ __forceinline__ void operator()(const f32x4 (&acc)[2][2][4][2], const Unit& u, int wr, int wc, int fr, int fq) const {
        const int row0 = u.orow + wr * 64 + fr, col0 = u.ocol + wc * 32 + 4 * fq;
        f32x4 gv[2][2], bv[2][2];
#pragma unroll
        for (int bj = 0; bj < 2; ++bj)
#pragma unroll
            for (int n = 0; n < 2; ++n) { gv[bj][n] = *(const f32x4*)(gam + col0 + bj * HALF + n * 16) * alpha; bv[bj][n] = *(const f32x4*)(bet + col0 + bj * HALF + n * 16) * alpha; }
#pragma unroll
        EPI_LOOP_AI_M { const int row = row0 + ai * HALF + m * 16; const size_t off = (size_t)row * D + col0; const f32x2 st = stats[row];
#pragma unroll
            for (int bj = 0; bj < 2; ++bj)
#pragma unroll
                for (int n = 0; n < 2; ++n) { const f32x4 tv = *(const f32x4*)(T + off + bj * HALF + n * 16);
                    *(f32x4*)(C + off + bj * HALF + n * 16) = acc[ai][bj][m][n] + ((tv - st.x) * st.y) * gv[bj][n] + bv[bj][n]; }
            asm volatile("" ::: "memory"); }
    }
};
struct EpiBf16 {
    static constexpr bool PERM = true, AFTER_DRAIN = false; static constexpr int MID_T = -1;
    bf16_t* O; int ldc; float scale;
    __device__ __forceinline__ void operator()(const f32x4 (&acc)[2][2][4][2], const Unit& u, int wr, int wc, int fr, int fq) const {
        const int row0 = u.orow + wr * 64 + fr, col0 = u.ocol + wc * 32 + 8 * fq;
#pragma unroll
        EPI_LOOP_AI_M { bf16_t* rowp = O + (size_t)(row0 + ai * HALF + m * 16) * ldc + col0;
#pragma unroll
            for (int bj = 0; bj < 2; ++bj) { const f32x4 v0 = acc[ai][bj][m][0] * scale, v1 = acc[ai][bj][m][1] * scale;
                u32x4 w; w.x = cvt_pk_bf16(v0[0], v0[1]); w.y = cvt_pk_bf16(v0[2], v0[3]); w.z = cvt_pk_bf16(v1[0], v1[1]); w.w = cvt_pk_bf16(v1[2], v1[3]);
                *(u32x4*)(rowp + bj * HALF) = w; } }
    }
};
struct EpiBf16Bias {
    static constexpr bool PERM = true, AFTER_DRAIN = false; static constexpr int MID_T = -1;
    bf16_t* O; int ldc; const float* bias; int bstride;
    __device__ __forceinline__ void operator()(const f32x4 (&acc)[2][2][4][2], const Unit& u, int wr, int wc, int fr, int fq) const {
        const int row0 = u.orow + wr * 64 + fr, col0 = u.ocol + wc * 32 + 8 * fq;
        f32x4 bv[2][2];
#pragma unroll
        for (int bj = 0; bj < 2; ++bj)
#pragma unroll
            for (int n = 0; n < 2; ++n) bv[bj][n] = *(const f32x4*)(bias + (size_t)u.aux * bstride + col0 + bj * HALF + 4 * n);
#pragma unroll
        EPI_LOOP_AI_M { bf16_t* rowp = O + (size_t)(row0 + ai * HALF + m * 16) * ldc + col0;
#pragma unroll
            for (int bj = 0; bj < 2; ++bj) { const f32x4 v0 = acc[ai][bj][m][0] + bv[bj][0], v1 = acc[ai][bj][m][1] + bv[bj][1];
                u32x4 w; w.x = cvt_pk_bf16(v0[0], v0[1]); w.y = cvt_pk_bf16(v0[2], v0[3]); w.z = cvt_pk_bf16(v1[0], v1[1]); w.w = cvt_pk_bf16(v1[2], v1[3]);
                *(u32x4*)(rowp + bj * HALF) = w; } }
    }
};
struct EpiKV {
    static constexpr bool PERM = true, AFTER_DRAIN = false; static constexpr int MID_T = -1;
    bf16_t* KB; bf16_t* VT;
    __device__ __forceinline__ void operator()(const f32x4 (&acc)[2][2][4][2], const Unit& u, int wr, int wc, int fr, int fq) const {
        const int row0 = u.orow + wr * 64 + fr, col0 = u.ocol + wc * 32 + 8 * fq;
#pragma unroll
        EPI_LOOP_AI_M { const int row = row0 + ai * HALF + m * 16;
#pragma unroll
            for (int bj = 0; bj < 2; ++bj) { const f32x4 v0 = acc[ai][bj][m][0], v1 = acc[ai][bj][m][1]; const int col = col0 + bj * HALF;
                if (u.ocol < 2048) { u32x4 w; w.x = cvt_pk_bf16(v0[0], v0[1]); w.y = cvt_pk_bf16(v0[2], v0[3]); w.z = cvt_pk_bf16(v1[0], v1[1]); w.w = cvt_pk_bf16(v1[2], v1[3]);
                    *(u32x4*)(KB + (size_t)row * 2048 + col) = w; }
                else { const int b = row >> 8, key = row & 255, c = col - 2048, h = c >> 9, d = c & 511; bf16_t* p = VT + ((size_t)((b * 4 + h) * 512 + d)) * 256 + key;
#pragma unroll
                    for (int j = 0; j < 4; ++j) { p[(size_t)j * 256] = (bf16_t)f2bf(v0[j]); p[(size_t)(4 + j) * 256] = (bf16_t)f2bf(v1[j]); } } } }
    }
};
struct EpiDecay {
    static constexpr bool PERM = true, AFTER_DRAIN = false; static constexpr int MID_T = -1;
    bf16_t* LD; const float* w0;
    __device__ __forceinline__ void operator()(const f32x4 (&acc)[2][2][4][2], const Unit& u, int wr, int wc, int fr, int fq) const {
        const int row0 = u.orow + wr * 64 + fr, col0 = u.ocol + wc * 32 + 8 * fq;
#pragma unroll
        for (int bj = 0; bj < 2; ++bj) { const int col = col0 + bj * HALF; const f32x4 w00 = *(const f32x4*)(w0 + col), w01 = *(const f32x4*)(w0 + col + 4);
#pragma unroll
            EPI_LOOP_AI_M { const f32x4 x0 = acc[ai][bj][m][0] + w00, x1 = acc[ai][bj][m][1] + w01; float o[8];
#pragma unroll
                for (int j = 0; j < 4; ++j) { o[j] = -0.6065306597126334f * sigmoidf_(x0[j]); o[4 + j] = -0.6065306597126334f * sigmoidf_(x1[j]); }
                *(u32x4*)(LD + (size_t)(row0 + ai * HALF + m * 16) * D + col) = (u32x4){cvt_pk_bf16(o[0], o[1]), cvt_pk_bf16(o[2], o[3]), cvt_pk_bf16(o[4], o[5]), cvt_pk_bf16(o[6], o[7])}; } }
    }
};
struct EpiIclr {
    static constexpr bool PERM = true, AFTER_DRAIN = false; static constexpr int MID_T = -1;
    const float* a0; bf16_t* AL;
    __device__ __forceinline__ void operator()(const f32x4 (&acc)[2][2][4][2], const Unit& u, int wr, int wc, int fr, int fq) const {
        const int row0 = u.orow + wr * 64 + fr, col0 = u.ocol + wc * 32 + 8 * fq;
#pragma unroll
        for (int bj = 0; bj < 2; ++bj) { const int col = col0 + bj * HALF; const f32x4 a00 = *(const f32x4*)(a0 + col), a01 = *(const f32x4*)(a0 + col + 4);
#pragma unroll
            EPI_LOOP_AI_M { const f32x4 x0 = acc[ai][bj][m][0] + a00, x1 = acc[ai][bj][m][1] + a01;
                *(u32x4*)(AL + (size_t)(row0 + ai * HALF + m * 16) * D + col) = (u32x4){cvt_pk_bf16(sigmoidf_(x0[0]), sigmoidf_(x0[1])), cvt_pk_bf16(sigmoidf_(x0[2]), sigmoidf_(x0[3])),
                    cvt_pk_bf16(sigmoidf_(x1[0]), sigmoidf_(x1[1])), cvt_pk_bf16(sigmoidf_(x1[2]), sigmoidf_(x1[3]))}; } }
    }
};
struct EpiGateFused {
    static constexpr bool PERM = true, AFTER_DRAIN = false; static constexpr int MID_T = 32;
    const bf16_t* PROJ; bf16_t* MERGED;
    __device__ __forceinline__ void mid(f32x4 (&acc)[2][2][4][2], const Unit& u, int wr, int wc, int fr, int fq) const {
        const int row0 = u.orow + wr * 64 + fr, col0 = u.ocol + wc * 32 + 8 * fq;
#pragma unroll
        EPI_LOOP_AI_M { const int row = row0 + ai * HALF + m * 16;
#pragma unroll
            for (int bj = 0; bj < 2; ++bj) { const int col = col0 + bj * HALF;
                const u32x4 g1v = *(const u32x4*)(PROJ + (size_t)row * PC + GATE0 + col), g2v = *(const u32x4*)(PROJ + (size_t)row * PC + GATE0 + 2048 + col);
                const unsigned w1[4] = {g1v.x, g1v.y, g1v.z, g1v.w}, w2[4] = {g2v.x, g2v.y, g2v.z, g2v.w};
#pragma unroll
                for (int j = 0; j < 8; ++j) { const float x1 = bf2f((w1[j >> 1] >> (16 * (j & 1))) & 0xffffu), x2 = fmaxf(bf2f((w2[j >> 1] >> (16 * (j & 1))) & 0xffffu), -60.0f);
                    const float ratio = (1.0f + __expf(-x2)) * __builtin_amdgcn_rcpf(1.0f + __expf(-x1));
                    if (j < 4) acc[ai][bj][m][0][j & 3] *= ratio; else acc[ai][bj][m][1][j & 3] *= ratio; } }
            asm volatile("" ::: "memory"); }
    }
    __device__ __forceinline__ void operator()(const f32x4 (&acc)[2][2][4][2], const Unit& u, int wr, int wc, int fr, int fq) const {
        const int row0 = u.orow + wr * 64 + fr, col0 = u.ocol + wc * 32 + 8 * fq;
#pragma unroll
        EPI_LOOP_AI_M { const int row = row0 + ai * HALF + m * 16;
#pragma unroll
            for (int bj = 0; bj < 2; ++bj) { const int col = col0 + bj * HALF; const u32x4 gv = *(const u32x4*)(PROJ + (size_t)row * PC + GATE0 + 2048 + col);
                const unsigned w2[4] = {gv.x, gv.y, gv.z, gv.w}; float o[8];
#pragma unroll
                for (int j = 0; j < 8; ++j) { const float x2 = fmaxf(bf2f((w2[j >> 1] >> (16 * (j & 1))) & 0xffffu), -60.0f); o[j] = (j < 4 ? acc[ai][bj][m][0][j & 3] : acc[ai][bj][m][1][j & 3]) * sigmoidf_(x2); }
                u32x4 w; w.x = cvt_pk_bf16(o[0], o[1]); w.y = cvt_pk_bf16(o[2], o[3]); w.z = cvt_pk_bf16(o[4], o[5]); w.w = cvt_pk_bf16(o[6], o[7]);
                *(u32x4*)(MERGED + (size_t)row * D + col) = w; }
            asm volatile("" ::: "memory"); }
    }
};
struct EpiSwiglu {
    static constexpr bool PERM = true, AFTER_DRAIN = false; static constexpr int MID_T = -1;
    const float* b1; bf16_t* H;
    __device__ __forceinline__ float sw(float g, float l) const { g = fminf(g, 7.0f); l = fminf(fmaxf(l, -7.0f), 7.0f); return g * sigmoidf_(1.702f * g) * (l + 1.0f); }
    __device__ __forceinline__ void operator()(const f32x4 (&acc)[2][2][4][2], const Unit& u, int wr, int wc, int fr, int fq) const {
        const int row0 = u.orow + wr * 64 + fr, col0 = u.ocol + wc * 32 + 8 * fq;
        f32x4 bv[2][2];
#pragma unroll
        for (int bj = 0; bj < 2; ++bj)
#pragma unroll
            for (int n = 0; n < 2; ++n) bv[bj][n] = *(const f32x4*)(b1 + (size_t)u.aux * 4096 + col0 + bj * HALF + 4 * n);
#pragma unroll
        EPI_LOOP_AI_M { const int row = row0 + ai * HALF + m * 16;
#pragma unroll
            for (int bj = 0; bj < 2; ++bj) { const f32x4 v0 = acc[ai][bj][m][0] + bv[bj][0], v1 = acc[ai][bj][m][1] + bv[bj][1];
                *(unsigned*)((unsigned char*)H + (size_t)row * DFF + ((col0 + bj * HALF) >> 1)) = pk4_fp8(sw(v0[0], v0[1]), sw(v0[2], v0[3]), sw(v1[0], v1[1]), sw(v1[2], v1[3])); } }
    }
};
struct EpiSoftmax {
    static constexpr bool PERM = true, AFTER_DRAIN = true; static constexpr int MID_T = -1;
    bf16_t* PP;
    __device__ __forceinline__ void fused(f32x4 (&acc)[2][2][4][2], const Unit& u, int wr, int wc, int fr, int fq, PG8_LAS unsigned char* lds, int wid, int lane) const {
        PG8_LAS float* P1 = (PG8_LAS float*)lds;
        PG8_LAS float* P2 = (PG8_LAS float*)(lds + 4096);
        float mx[2][4];
#pragma unroll
        EPI_LOOP_AI_M { float v = -3.0e38f;
#pragma unroll
            for (int bj = 0; bj < 2; ++bj)
#pragma unroll
                for (int n = 0; n < 2; ++n) { const f32x4 x = acc[ai][bj][m][n]; v = fmaxf(v, fmaxf(fmaxf(x[0], x[1]), fmaxf(x[2], x[3]))); }
            v = fmaxf(v, __shfl_xor(v, 16)); v = fmaxf(v, __shfl_xor(v, 32));
            if (fq == 0) P1[(ai * HALF + wr * 64 + m * 16 + fr) * 4 + wc] = v; }
        asm volatile("s_waitcnt lgkmcnt(0)" ::: "memory"); __builtin_amdgcn_s_barrier(); asm volatile("" ::: "memory");
#pragma unroll
        EPI_LOOP_AI_M { const f32x4 t = *(const PG8_LAS f32x4*)(P1 + (ai * HALF + wr * 64 + m * 16 + fr) * 4); mx[ai][m] = fmaxf(fmaxf(t[0], t[1]), fmaxf(t[2], t[3])); }
#pragma unroll
        EPI_LOOP_AI_M { float s = 0.f;
#pragma unroll
            for (int bj = 0; bj < 2; ++bj)
#pragma unroll
                for (int n = 0; n < 2; ++n) { f32x4 x = acc[ai][bj][m][n];
#pragma unroll
                    for (int j = 0; j < 4; ++j) { x[j] = __expf(x[j] - mx[ai][m]); s += x[j]; }
                    acc[ai][bj][m][n] = x; }
            s += __shfl_xor(s, 16); s += __shfl_xor(s, 32);
            if (fq == 0) P2[(ai * HALF + wr * 64 + m * 16 + fr) * 4 + wc] = s; }
        asm volatile("s_waitcnt lgkmcnt(0)" ::: "memory"); __builtin_amdgcn_s_barrier(); asm volatile("" ::: "memory");
        const int row0 = u.orow + wr * 64 + fr, col0 = wc * 32 + 8 * fq;
#pragma unroll
        EPI_LOOP_AI_M { const f32x4 t = *(const PG8_LAS f32x4*)(P2 + (ai * HALF + wr * 64 + m * 16 + fr) * 4); const float inv = 1.0f / ((t[0] + t[1]) + (t[2] + t[3]));
            bf16_t* rowp = PP + (size_t)(row0 + ai * HALF + m * 16) * 256 + col0;
#pragma unroll
            for (int bj = 0; bj < 2; ++bj) { const f32x4 v0 = acc[ai][bj][m][0] * inv, v1 = acc[ai][bj][m][1] * inv;
                u32x4 w; w.x = cvt_pk_bf16(v0[0], v0[1]); w.y = cvt_pk_bf16(v0[2], v0[3]); w.z = cvt_pk_bf16(v1[0], v1[1]); w.w = cvt_pk_bf16(v1[2], v1[3]);
                *(u32x4*)(rowp + bj * HALF) = w; } }
        asm volatile("s_waitcnt lgkmcnt(0)" ::: "memory"); __builtin_amdgcn_s_barrier(); asm volatile("" ::: "memory");
    }
};
}

constexpr size_t MiB = 1u << 20;
constexpr size_t al256(size_t x) { return (x + 255) & ~(size_t)255; }
constexpr size_t WS_CTL = 0, CTL_ZERO_BYTES = 1 * MiB;
constexpr size_t WS_WIN = 1 * MiB;
constexpr size_t WS_WUP = WS_WIN + (size_t)PC * D * 2;
constexpr size_t WS_AUP = WS_WUP + (size_t)D * 256 * 2;
constexpr size_t WS_GUP = WS_AUP + (size_t)D * 256 * 2;
constexpr size_t WS_PA = WS_GUP + (size_t)D * 256 * 2;
constexpr size_t WS_PB = WS_PA + (size_t)D * D * 2;
constexpr size_t WS_WOUT = WS_PB + (size_t)D * 512 * 2;
constexpr size_t WS_WQ = WS_WOUT + (size_t)D * D * 2;
constexpr size_t WS_WKV = WS_WQ + (size_t)D * D * 2;
constexpr size_t WS_WO = WS_WKV + (size_t)2 * D * D * 2;
constexpr size_t WS_W1 = WS_WO + (size_t)D * D * 2;
constexpr size_t WS_W2 = WS_W1 + (size_t)NEXP * 4096 * D * 2;
constexpr size_t WS_XB = WS_W2 + (size_t)NEXP * D * DFF * 2;
constexpr size_t WS_MEMB = WS_XB + (size_t)M * D * 2;
constexpr size_t WS_ROT = WS_MEMB + (size_t)1024 * D * 2;
constexpr size_t WS_KB = WS_ROT + (size_t)2 * SEQ * 32 * 4;
constexpr size_t WS_VT = WS_KB + (size_t)1024 * D * 2;
constexpr size_t WS_YA = WS_VT + (size_t)1024 * D * 2;
constexpr size_t WS_YB = WS_YA + (size_t)M * D * 2;
constexpr size_t WS_TMP = WS_YB + (size_t)M * 512 * 2;
constexpr size_t WS_MERGED = WS_TMP + (size_t)M * D * 4;
constexpr size_t WS_E = WS_MERGED + (size_t)M * D * 2;
constexpr size_t WS_PROJ = WS_E;
constexpr size_t WS_RZ = WS_PROJ + (size_t)M * PC * 2;
constexpr size_t WS_KZ = WS_RZ + (size_t)M * D * 4;
constexpr size_t WS_VZ = WS_KZ + (size_t)M * D * 4;
constexpr size_t WS_DEC = WS_VZ + (size_t)M * D * 4;
constexpr size_t WS_KP = WS_DEC + (size_t)M * D * 4;
constexpr size_t WS_AN = WS_KP + (size_t)M * D * 4;
constexpr size_t WS_BB = WS_AN + (size_t)M * D * 4;
constexpr size_t WS_GG = WS_BB + (size_t)M * D * 4;
constexpr size_t WS_YS = WS_GG + (size_t)M * D * 4;
constexpr size_t WS_XQ = WS_YS + 60 * MiB;
constexpr size_t WS_WIN8 = WS_YS + 96 * MiB;
constexpr size_t WS_ST1 = WS_YS + 112 * MiB, WS_ST2 = WS_YS + 113 * MiB;
constexpr size_t WS_VR = WS_YS + 4 * MiB;
constexpr size_t WS_AO = WS_YS + (size_t)M * D * 4;
constexpr size_t WS_LSE = WS_AO + (size_t)3 * M * 512 * 4;
constexpr size_t WS_QR = WS_LSE + (size_t)3 * M * 8 * 4;
constexpr size_t WS_KR = WS_QR + (size_t)M * 1536 * 2;
constexpr size_t WS_LIN = WS_KR + (size_t)M * 1536 * 2;
constexpr size_t WS_KNORM = WS_LIN + (size_t)M * 768 * 2;
constexpr size_t WS_F = WS_KNORM + (size_t)M * 32 * 4;
constexpr size_t WS_E_END = WS_F + (size_t)128 * 128 * 96 * 96 * 2;
constexpr size_t WS_T1 = WS_E;
constexpr size_t WS_X1 = WS_T1 + (size_t)M * D * 4;
constexpr size_t WS_X1B = WS_X1 + (size_t)M * D * 4;
constexpr size_t WS_Q = WS_X1B + (size_t)M * D * 2;
constexpr size_t WS_PP = WS_Q + (size_t)M * D * 2;
constexpr size_t WS_OC = WS_PP + (size_t)16 * SEQ * 256 * 2;
constexpr size_t WS_T2 = WS_OC + (size_t)M * D * 2;
constexpr size_t WS_X2 = WS_T2 + (size_t)M * D * 4;
constexpr size_t WS_X2B = WS_X2 + (size_t)M * D * 4;
constexpr size_t WS_LIST = WS_X2B + (size_t)M * D * 2;
constexpr size_t WS_ROWI = WS_LIST + (size_t)NEXP * CAP * 4;
constexpr size_t WS_TOPW = WS_ROWI + (size_t)M * 4 * 4;
constexpr size_t WS_H = WS_TOPW + (size_t)M * 4 * 4;
constexpr size_t WS_Y = WS_H + (size_t)HROWS * DFF * 2;
constexpr size_t WS_L_END = WS_Y + (size_t)HROWS * D * 4;
constexpr size_t WS_END = (WS_E_END > WS_L_END ? WS_E_END : WS_L_END);
static_assert(WS_END <= (size_t)4090 * MiB, "workspace map exceeds 4 x largest input");
constexpr int CW_TMO = 0, CW_CNT = 64  , CW_Q = 128  , CW_BAR = 4096;

constexpr int RING_BYTES = 131072, MISC_OFF = RING_BYTES, LDS_BYTES = 147456;

#define XB_TMO      128
#define XB_XCNT(j)  (256  + 64 * (j))
#define XB_XSUB(j)  (1280 + 64 * (j))
#define XB_XGEN(j)  (2304 + 64 * (j))
#define XB_TOP      3328
#define XB_TOPGEN   3392
#define XCD_BAR_WORDS 3456
#define XB_SPIN_CAP (1u << 18)
__device__ __forceinline__ unsigned xb_ld(unsigned* p)              { return __hip_atomic_load(p, __ATOMIC_RELAXED, __HIP_MEMORY_SCOPE_AGENT); }
__device__ __forceinline__ unsigned xb_add(unsigned* p, unsigned v) { return __hip_atomic_fetch_add(p, v, __ATOMIC_RELAXED, __HIP_MEMORY_SCOPE_AGENT); }
__device__ __forceinline__ unsigned xb_xcc_id() { return (unsigned)__builtin_amdgcn_s_getreg((3 << 11) | 20) & 0xFu; }
#define XB_SPIN(cond, bar) do { unsigned _sp = 0; while (cond) { __builtin_amdgcn_s_sleep(1); \
    if ((++_sp & 255u) == 0u) { if (xb_ld(&(bar)[XB_TMO])) break; if (_sp > XB_SPIN_CAP) { atomicAdd(&(bar)[XB_TMO], 1u); break; } } } } while (0)
struct XcdBarrier { unsigned* bar; unsigned x; volatile LAS unsigned* st; };
__device__ __forceinline__ XcdBarrier xcd_barrier_post(unsigned* bar, volatile LAS unsigned* st) {
    XcdBarrier b; b.bar = bar; b.x = xb_xcc_id(); b.st = st;
    if (threadIdx.x == 0) (void)xb_add(&bar[XB_XCNT(b.x)], 1u);
    return b;
}
__device__ __forceinline__ void xcd_barrier_complete(unsigned* bar, unsigned x, unsigned& nloc, unsigned& nx) {
    const unsigned G = gridDim.x * gridDim.y * gridDim.z;
    unsigned sum, cnt, mine, sp = 0u;
    for (;;) {
        sum = 0u; cnt = 0u; mine = 0u;
#pragma unroll
        for (unsigned j = 0; j < 16; ++j) { const unsigned c = xb_ld(&bar[XB_XCNT(j)]); sum += c; cnt += (c > 0u) ? 1u : 0u; mine = (j == x) ? c : mine; }
        if (sum == G) break;
        __builtin_amdgcn_s_sleep(1);
        if ((++sp & 255u) == 0u) { if (xb_ld(&bar[XB_TMO])) break; if (sp > XB_SPIN_CAP) { atomicAdd(&bar[XB_TMO], 1u); break; } }
    }
    nloc = mine > 0u ? mine : 1u; nx = cnt > 0u ? cnt : 1u;
}
__device__ __forceinline__ void xcd_barrier(const XcdBarrier& b) {
    asm volatile("s_waitcnt vmcnt(0)" ::: "memory");
    __syncthreads();
    if (threadIdx.x == 0) {
        unsigned* bar = b.bar;
        __builtin_amdgcn_s_waitcnt(0);
        unsigned nloc = b.st[0], nx = b.st[1];
        if (nloc == 0u) { xcd_barrier_complete(bar, b.x, nloc, nx); b.st[0] = nloc; b.st[1] = nx; }
        const unsigned old = xb_add(&bar[XB_XSUB(b.x)], 1u);
        const unsigned gen = old / nloc;
        if (old + 1u == (gen + 1u) * nloc) {
            __builtin_amdgcn_fence(__ATOMIC_RELEASE, "agent");
            asm volatile("s_waitcnt vmcnt(0)" ::: "memory");
            const unsigned og = xb_add(&bar[XB_TOP], 1u);
            const unsigned tg = og / nx;
            if (og + 1u == (tg + 1u) * nx) xb_add(&bar[XB_TOPGEN], 1u);
            else XB_SPIN(xb_ld(&bar[XB_TOPGEN]) == tg, bar);
            __builtin_amdgcn_fence(__ATOMIC_ACQUIRE, "agent");
            xb_add(&bar[XB_XGEN(b.x)], 1u);
            asm volatile("s_waitcnt vmcnt(0)" ::: "memory");
        } else {
            XB_SPIN(xb_ld(&bar[XB_XGEN(b.x)]) == gen, bar);
            __builtin_amdgcn_fence(__ATOMIC_ACQUIRE, "agent");
            asm volatile("s_waitcnt vmcnt(0)" ::: "memory");
        }
    }
    __syncthreads();
}

struct Params {
    const float* in[32];
    float* out; unsigned char* ws;
    int ph_lo, ph_hi, li, pad;
};
enum { I_X = 0, I_MEM, I_WIN, I_MIX, I_W0, I_WUP, I_A0, I_AUP, I_GUP, I_KK, I_KA, I_RK, I_LNXG, I_LNXB, I_PA, I_PB, I_WOUT, I_LN1G, I_LN1B, I_WQ, I_WKV, I_WO, I_LN2G, I_LN2B,
       I_RW, I_RB, I_W1, I_B1, I_W2, I_B2, I_LN3G, I_LN3B };

struct ScoreOrder {
    static constexpr bool GATHER = false;
    const char* Q; const char* KB; int G, c;
    __device__ bool next(int i, pg8::Unit& u) const {
        const int L = i * G + c; if (L >= 256) return false;
        const int bh = L >> 4, pm = L & 15, b = bh >> 2, h = bh & 3;
        u.A = Q + ((size_t)(b * SEQ + 256 * pm) * D + h * 512) * 2; u.B = KB + ((size_t)(b * 256) * D + h * 512) * 2;
        u.orow = bh * SEQ + 256 * pm; u.ocol = 0; u.aux = 0; u.aux2 = 0; u.valid = 256; return true;
    }
    __device__ __forceinline__ const int* rows(const pg8::Unit&) const { return nullptr; }
};
struct PvOrder {
    static constexpr bool GATHER = false;
    const char* PP; const char* VT; int G, c;
    __device__ bool next(int i, pg8::Unit& u) const {
        const int L = i * G + c; if (L >= 512) return false;
        const int bh = L >> 5, pm = (L >> 1) & 15, pn = L & 1, b = bh >> 2, h = bh & 3;
        u.A = PP + ((size_t)(bh * SEQ + 256 * pm) * 256) * 2; u.B = VT + ((size_t)(bh * 512 + 256 * pn) * 256) * 2;
        u.orow = b * SEQ + 256 * pm; u.ocol = h * 512 + 256 * pn; u.aux = 0; u.aux2 = 0; u.valid = 256; return true;
    }
    __device__ __forceinline__ const int* rows(const pg8::Unit&) const { return nullptr; }
};
template <bool GATHER_, int NT  > struct MoeOrder {
    static constexpr bool GATHER = GATHER_;
    const LAS int* tab; const char* A; const char* W; const int* list; size_t wexp  ; int ldb; int G, c;
    __device__ bool next(int i, pg8::Unit& u) const {
        constexpr int RPR = 256 / NT;
        const int xcd = c & 7, jx = c >> 3;
        const int rtl = (NT == 16) ? (xcd & 1) * 8 + (jx & 7) : (xcd & 3) * 8 + (jx & 7), pn = (NT == 16) ? (xcd >> 1) * 4 + (jx >> 3) : (xcd >> 2) * 4 + (jx >> 3);
        const int rt = i * RPR + rtl, T = __builtin_amdgcn_readfirstlane(tab[64]);
        if (c >= 256 || rt >= T) return false;
        int e = 0;
        for (int j = 1; j < NEXP; ++j) e = (rt >= __builtin_amdgcn_readfirstlane(tab[32 + j])) ? j : e;
        const int lt = rt - __builtin_amdgcn_readfirstlane(tab[32 + e]), cnt = __builtin_amdgcn_readfirstlane(tab[e]);
        u.aux = e; u.aux2 = lt; u.valid = min(256, cnt - 256 * lt); u.orow = 256 * rt; u.ocol = 256 * pn;
        u.B = W + (size_t)e * wexp + (size_t)(256 * pn) * ldb;
        u.A = GATHER_ ? A : A + (size_t)(256 * rt) * DFF;
        return true;
    }
    __device__ __forceinline__ const int* rows(const pg8::Unit& u) const { return list + (size_t)u.aux * CAP + 256 * u.aux2; }
};

struct Ctx { int tid, lane, wave, vcu, G; LAS unsigned char* lds; unsigned char* ws; };

__device__ __forceinline__ void cv_issue(const float* W, int ldw, int Ksrc, int sc0, int k0, int lane, float (&cv)[32]) {
    const int kb = k0 + 32 * (lane >> 5); const bool ok = sc0 >= 0 && kb < Ksrc;
    const float* src = W + (ok ? (size_t)kb * ldw + sc0 + (lane & 31) : (size_t)0);
#pragma unroll
    for (int i = 0; i < 32; ++i) { const float v = src[(size_t)i * ldw]; cv[i] = ok ? v : 0.f; }
}
__device__ __forceinline__ void cv_store16(const float (&cv)[32], bf16_t* WT, int ldt, int n0, int k0, int lane) {
    u32x4* dst = (u32x4*)(WT + (size_t)(n0 + (lane & 31)) * ldt + k0 + 32 * (lane >> 5));
#pragma unroll
    for (int j = 0; j < 4; ++j) dst[j] = (u32x4){pk2(cv[8 * j], cv[8 * j + 1]), pk2(cv[8 * j + 2], cv[8 * j + 3]), pk2(cv[8 * j + 4], cv[8 * j + 5]), pk2(cv[8 * j + 6], cv[8 * j + 7])};
}
__device__ __forceinline__ void cv_store8(const float (&cv)[32], unsigned char* WT8, int ldt, int n0, int k0, int lane) {
    u32x4* dst = (u32x4*)(WT8 + (size_t)(n0 + (lane & 31)) * ldt + k0 + 32 * (lane >> 5));
#pragma unroll
    for (int j = 0; j < 2; ++j) dst[j] = (u32x4){pk4_fp8(cv[16 * j] * 64.f, cv[16 * j + 1] * 64.f, cv[16 * j + 2] * 64.f, cv[16 * j + 3] * 64.f), pk4_fp8(cv[16 * j + 4] * 64.f, cv[16 * j + 5] * 64.f, cv[16 * j + 6] * 64.f, cv[16 * j + 7] * 64.f),
        pk4_fp8(cv[16 * j + 8] * 64.f, cv[16 * j + 9] * 64.f, cv[16 * j + 10] * 64.f, cv[16 * j + 11] * 64.f), pk4_fp8(cv[16 * j + 12] * 64.f, cv[16 * j + 13] * 64.f, cv[16 * j + 14] * 64.f, cv[16 * j + 15] * 64.f)};
}
struct CvJob { const float* W; bf16_t* WT; int ldw, Ksrc, sc0, ldt, n0, k0, f8, kd; };
__device__ __forceinline__ CvJob p0_job(const Params& p, unsigned char* ws, int it) {
    constexpr int I_WINJ = 32 * 480, I_LORA = 4 * 64, I_SQ = 32 * 64, I_PBJ = 8 * 64, I_KVJ = 32 * 128;
    CvJob j; j.f8 = 0; j.kd = 0; int r = it;
#define P0_PLAIN_F8(SRC, DST, N_, KS_, KD_) { const int nblk = (N_) / 32, kb = r / nblk, nb = r % nblk; j.W = p.in[SRC]; j.WT = (bf16_t*)(ws + (DST)); j.ldw = (N_); j.Ksrc = (KS_); j.sc0 = 32 * nb; j.ldt = (KD_); j.n0 = 32 * nb; j.k0 = 64 * kb; j.f8 = 1; return j; }
#define P0_PLAIN(SRC, DST, N_, KS_, KD_) { const int nblk = (N_) / 32, kb = r / nblk, nb = r % nblk; j.W = p.in[SRC]; j.WT = (bf16_t*)(ws + (DST)); j.ldw = (N_); j.Ksrc = (KS_); j.sc0 = 32 * nb; j.ldt = (KD_); j.n0 = 32 * nb; j.k0 = 64 * kb; return j; }
    if (r < I_WINJ) { const int kb = r / 480, nb = r % 480; j.W = p.in[I_WIN]; j.WT = (bf16_t*)(ws + WS_WIN); j.ldw = 15296; j.Ksrc = D; const int n_ = 32 * nb;
        j.sc0 = n_ < RWC ? n_ : (n_ < ATTV2 ? -1 : (n_ < ATT0 ? RWC + 4096 + (n_ - ATTV2) : (n_ < GATE0 ? RWC + (n_ - ATT0) : n_ - 64))); j.ldt = D; j.n0 = n_; j.k0 = 64 * kb;
        if (n_ >= ATT0) { j.f8 = 1; j.WT = (bf16_t*)(ws + WS_WIN8); j.n0 = n_ - ATT0; }
        return j; } r -= I_WINJ;
    if (r < I_LORA) P0_PLAIN(I_WUP, WS_WUP, D, 96, 256) r -= I_LORA;
    if (r < I_LORA) P0_PLAIN(I_AUP, WS_AUP, D, 96, 256) r -= I_LORA;
    if (r < I_LORA) P0_PLAIN(I_GUP, WS_GUP, D, 256, 256) r -= I_LORA;
    if (r < I_SQ) P0_PLAIN(I_PA, WS_PA, D, D, 2560) r -= I_SQ;
    if (r < I_PBJ) { const int kb = r / 64, nb = r % 64; j.W = p.in[I_PB]; j.WT = (bf16_t*)(ws + WS_PA); j.ldw = D; j.Ksrc = 512; j.sc0 = 32 * nb; j.ldt = 2560; j.n0 = 32 * nb; j.k0 = 64 * kb; j.kd = 2048; return j; } r -= I_PBJ;
    if (r < I_SQ) P0_PLAIN(I_WOUT, WS_WOUT, D, D, D) r -= I_SQ;
    if (r < I_SQ) { P0_PLAIN_F8(I_WQ, WS_WQ, D, D, D) } r -= I_SQ;
    if (r < I_KVJ) P0_PLAIN(I_WKV, WS_WKV, 2 * D, D, D) r -= I_KVJ;
    P0_PLAIN(I_WO, WS_WO, D, D, D)
#undef P0_PLAIN
#undef P0_PLAIN_F8
}
__device__ __forceinline__ void p0_prologue(const Params& p, const Ctx& c) {
    const int gw = c.vcu * 8 + c.wave, NGW = c.G * 8;
    unsigned char* ws = c.ws;
    constexpr int NITEMS = 32 * 480 + 3 * (4 * 64) + 4 * (32 * 64) + 8 * 64 + 32 * 128;
    { float ca[32], cb[32]; CvJob ja, jb; int it = gw;
      if (it < NITEMS) { ja = p0_job(p, ws, it); cv_issue(ja.W, ja.ldw, ja.Ksrc, ja.sc0, ja.k0, c.lane, ca); }
      for (; it < NITEMS; it += 2 * NGW) {
          if (it + NGW < NITEMS) { jb = p0_job(p, ws, it + NGW); cv_issue(jb.W, jb.ldw, jb.Ksrc, jb.sc0, jb.k0, c.lane, cb); }
          if (ja.f8) cv_store8(ca, (unsigned char*)ja.WT, ja.ldt, ja.n0, ja.k0, c.lane); else cv_store16(ca, ja.WT, ja.ldt, ja.n0, ja.k0 + ja.kd, c.lane);
          if (it + 2 * NGW < NITEMS) { ja = p0_job(p, ws, it + 2 * NGW); cv_issue(ja.W, ja.ldw, ja.Ksrc, ja.sc0, ja.k0, c.lane, ca); }
          if (it + NGW < NITEMS) { if (jb.f8) cv_store8(cb, (unsigned char*)jb.WT, jb.ldt, jb.n0, jb.k0, c.lane); else cv_store16(cb, jb.WT, jb.ldt, jb.n0, jb.k0 + jb.kd, c.lane); }
      } }
    const size_t gt = (size_t)c.vcu * 512 + c.tid, NT = (size_t)c.G * 512;
    for (size_t i = gt; i < (size_t)M * D / 8; i += NT) { const f32x4 a = ((const f32x4*)p.in[I_X])[2 * i], b = ((const f32x4*)p.in[I_X])[2 * i + 1];
        u32x4 o; o.x = pk2(a[0], a[1]); o.y = pk2(a[2], a[3]); o.z = pk2(b[0], b[1]); o.w = pk2(b[2], b[3]); ((u32x4*)(ws + WS_XB))[i] = o;
        ((u32x2*)(ws + WS_XQ))[i] = (u32x2){pk4_fp8(a[0], a[1], a[2], a[3]), pk4_fp8(b[0], b[1], b[2], b[3])}; }
    for (size_t i = gt; i < (size_t)1024 * D / 8; i += NT) { const f32x4 a = ((const f32x4*)p.in[I_MEM])[2 * i], b = ((const f32x4*)p.in[I_MEM])[2 * i + 1];
        u32x4 o; o.x = pk2(a[0], a[1]); o.y = pk2(a[2], a[3]); o.z = pk2(b[0], b[1]); o.w = pk2(b[2], b[3]); ((u32x4*)(ws + WS_MEMB))[i] = o; }
    float* rc = (float*)(ws + WS_ROT); float* rs = rc + SEQ * 32;
    for (size_t i = gt; i < (size_t)SEQ * 32; i += NT) { const int pos = (int)(i >> 5), j = (int)(i & 31);
        const double inv = exp(-(double)j * (9.210340371976184 / 32.0)); const double ang = (double)pos * inv; rc[i] = (float)cos(ang); rs[i] = (float)sin(ang); }
}

constexpr int MOE_W1E = 32 * 128, MOE_W2E = 32 * 64, MOE_CONV_GROUPS = (NEXP * MOE_W2E) / 8;
__device__ __forceinline__ void conv_group(const Params& p, const Ctx& c, int gi) {
    unsigned char* ws = c.ws;
    const int r = gi * 8 + c.wave;
    const int e = r / MOE_W2E, it = r % MOE_W2E, kb = it >> 6, nb = it & 63;
    float cv[32]; cv_issue(p.in[I_W2] + (size_t)e * DFF * D, D, DFF, 32 * nb, 64 * kb, c.lane, cv);
    cv_store8(cv, ws + WS_W2 + (size_t)e * D * DFF, DFF, 32 * nb, 64 * kb, c.lane);
}

#define DPP_ADD(x, ctrl) ((x) + __builtin_bit_cast(float, __builtin_amdgcn_update_dpp(0, __builtin_bit_cast(int, (x)), (ctrl), 0xF, 0xF, true)))
struct P2Tok { u32x4 cv0, pv0, cv1, pv1, ra, rb, vv; f32x4 c0, c1, s0, s1; };
__device__ __forceinline__ void p2_prep(const Params& p, const Ctx& c) {
    unsigned char* ws = c.ws;
    const bf16_t* PROJ = (const bf16_t*)(ws + WS_PROJ);
    const float* mix = p.in[I_MIX]; const float* k_k = p.in[I_KK];
    bf16_t* RZ = (bf16_t*)(ws + WS_RZ); bf16_t* KZ = (bf16_t*)(ws + WS_KZ); bf16_t* VZ = (bf16_t*)(ws + WS_VZ);
    bf16_t* LIN = (bf16_t*)(ws + WS_LIN); float* KNORM = (float*)(ws + WS_KNORM);
    bf16_t* QR = (bf16_t*)(ws + WS_QR); bf16_t* KR = (bf16_t*)(ws + WS_KR); bf16_t* VR = (bf16_t*)(ws + WS_VR);
    const float* rc = (const float*)(ws + WS_ROT); const float* rs = rc + SEQ * 32;
    int tid_ = c.tid; asm volatile("" : "+v"(tid_));
    const int tid = tid_;
    const int ch0 = tid, ch1 = tid + 512; const bool has1 = ch1 < 824;
    const f32x4 m00 = *(const f32x4*)(mix + 8 * ch0), m01 = *(const f32x4*)(mix + 8 * ch0 + 4);
    f32x4 m10 = (f32x4){0.f, 0.f, 0.f, 0.f}, m11 = m10; if (has1) { m10 = *(const f32x4*)(mix + 8 * ch1); m11 = *(const f32x4*)(mix + 8 * ch1 + 4); }
    f32x4 kk0 = (f32x4){0.f, 0.f, 0.f, 0.f}, kk1 = kk0; if (tid >= 256) { kk0 = *(const f32x4*)(k_k + 8 * (tid - 256)); kk1 = *(const f32x4*)(k_k + 8 * (tid - 256) + 4); }
    const bool rot = tid >= 64 && tid < 256, vcp = tid >= 256 && tid < 448;
    const int rw = tid - 64, which = rw / 96, rhh = (rw % 96) >> 2, re0 = (rw & 3) * 8;
    const int vhh = (tid - 256) >> 3, ve0 = ((tid - 256) & 7) * 8;
#define P2_LOAD(T, t_) do { const int pos_ = (t_) & (SEQ - 1); const bf16_t* cur_ = PROJ + (size_t)(t_) * PC; const u32x4 z4_ = (u32x4){0u, 0u, 0u, 0u}; \
        T.cv0 = *(const u32x4*)(cur_ + 8 * ch0); T.pv0 = pos_ > 0 ? *(const u32x4*)(cur_ - PC + 8 * ch0) : z4_; \
        if (has1) { T.cv1 = *(const u32x4*)(cur_ + 8 * ch1); T.pv1 = pos_ > 0 ? *(const u32x4*)(cur_ - PC + 8 * ch1) : z4_; } \
        if (rot) { const bf16_t* src_ = cur_ + ATT0 + which * 1536 + rhh * 64 + re0; T.ra = *(const u32x4*)src_; T.rb = *(const u32x4*)(src_ + 32); \
            T.c0 = *(const f32x4*)(rc + pos_ * 32 + re0); T.c1 = *(const f32x4*)(rc + pos_ * 32 + re0 + 4); T.s0 = *(const f32x4*)(rs + pos_ * 32 + re0); T.s1 = *(const f32x4*)(rs + pos_ * 32 + re0 + 4); } \
        if (vcp) { const int ao_ = 2 * 1536 + vhh * 64 + ve0; T.vv = *(const u32x4*)(cur_ + (ao_ < 4096 ? ATT0 + ao_ : ATTV2 + ao_ - 4096)); } } while (0)
#define P2_SHIFT(z, cv, pv, ma, mb) do { const unsigned cw[4] = {cv.x, cv.y, cv.z, cv.w}, pw[4] = {pv.x, pv.y, pv.z, pv.w}; const float mm[8] = {ma[0], ma[1], ma[2], ma[3], mb[0], mb[1], mb[2], mb[3]}; \
        _Pragma("unroll") for (int j = 0; j < 4; ++j) { const float c0_ = bf2f(cw[j] & 0xffffu), c1_ = bf2f(cw[j] >> 16), q0_ = bf2f(pw[j] & 0xffffu), q1_ = bf2f(pw[j] >> 16); \
            z[2 * j] = c0_ + (q0_ - c0_) * mm[2 * j]; z[2 * j + 1] = c1_ + (q1_ - c1_) * mm[2 * j + 1]; } } while (0)
#define P2_PROC(T, t_) do { const int t = (t_), pos = t & (SEQ - 1); \
        { float z[8]; P2_SHIFT(z, T.cv0, T.pv0, m00, m01);            \
          bf16_t* dst = (tid < 256 ? RZ : KZ) + (size_t)t * D + 8 * (tid & 255); \
          { u32x4 w8; w8.x = pk2(z[0], z[1]); w8.y = pk2(z[2], z[3]); w8.z = pk2(z[4], z[5]); w8.w = pk2(z[6], z[7]); *(u32x4*)dst = w8; } \
          if (tid >= 256) { float sq = 0.f; _Pragma("unroll") for (int j = 0; j < 4; ++j) { const float a_ = z[j] * kk0[j], b_ = z[4 + j] * kk1[j]; sq += a_ * a_ + b_ * b_; } \
              sq = DPP_ADD(sq, 0xB1); sq = DPP_ADD(sq, 0x4E); sq = DPP_ADD(sq, 0x141);                   \
              if ((tid & 7) == 0) KNORM[(size_t)t * 32 + ((tid - 256) >> 3)] = sqrtf(sq); } } \
        if (has1) { float z[8]; P2_SHIFT(z, T.cv1, T.pv1, m10, m11);    \
          if (ch1 < 768) { u32x4 w8; w8.x = pk2(z[0], z[1]); w8.y = pk2(z[2], z[3]); w8.z = pk2(z[4], z[5]); w8.w = pk2(z[6], z[7]); *(u32x4*)(VZ + (size_t)t * D + 8 * (ch1 - 512)) = w8; } \
          else { float o[8]; int dcol; \
              if (ch1 < 780) { dcol = 8 * (ch1 - 768); _Pragma("unroll") for (int j = 0; j < 8; ++j) o[j] = tanhf(z[j]); } \
              else if (ch1 < 792) { dcol = 256 + 8 * (ch1 - 780); _Pragma("unroll") for (int j = 0; j < 8; ++j) o[j] = z[j]; } \
              else { dcol = 512 + 8 * (ch1 - 792); _Pragma("unroll") for (int j = 0; j < 8; ++j) o[j] = sigmoidf_(z[j]); } \
              u32x4 w; w.x = pk2(o[0], o[1]); w.y = pk2(o[2], o[3]); w.z = pk2(o[4], o[5]); w.w = pk2(o[6], o[7]); *(u32x4*)(LIN + (size_t)t * 768 + dcol) = w; } } \
        if (tid >= 448 && tid < 488) { const int q_ = tid - 448; const int dcol = (q_ < 20) ? 96 + 8 * q_ : 352 + 8 * (q_ - 20); *(u32x4*)(LIN + (size_t)t * 768 + dcol) = (u32x4){0u, 0u, 0u, 0u}; } \
        if (rot) { const unsigned aw[4] = {T.ra.x, T.ra.y, T.ra.z, T.ra.w}, bw[4] = {T.rb.x, T.rb.y, T.rb.z, T.rb.w}; float o1[8], o2[8]; \
            _Pragma("unroll") for (int j = 0; j < 8; ++j) { const float t1 = bf2f((aw[j >> 1] >> (16 * (j & 1))) & 0xffffu), t2 = bf2f((bw[j >> 1] >> (16 * (j & 1))) & 0xffffu); \
                const float cs = j < 4 ? T.c0[j & 3] : T.c1[j & 3], sn = j < 4 ? T.s0[j & 3] : T.s1[j & 3]; o1[j] = t1 * cs - t2 * sn; o2[j] = t2 * cs + t1 * sn; } \
            const int dl_ = rhh < 8 ? 1 : (rhh < 16 ? 4 : 16); const int prm = (pos % dl_) * (SEQ / dl_) + pos / dl_; \
            bf16_t* dst = (which ? KR : QR) + ((size_t)((t >> 12) * 24 + rhh) * SEQ + prm) * 64 + re0; \
            u32x4 w1; w1.x = pk2(o1[0], o1[1]); w1.y = pk2(o1[2], o1[3]); w1.z = pk2(o1[4], o1[5]); w1.w = pk2(o1[6], o1[7]); \
            u32x4 w2; w2.x = pk2(o2[0], o2[1]); w2.y = pk2(o2[2], o2[3]); w2.z = pk2(o2[4], o2[5]); w2.w = pk2(o2[6], o2[7]); \
            *(u32x4*)dst = w1; *(u32x4*)(dst + 32) = w2; } \
        if (vcp) { const int dl_ = vhh < 8 ? 1 : (vhh < 16 ? 4 : 16); const int prm = (pos % dl_) * (SEQ / dl_) + pos / dl_; \
            *(u32x4*)(VR + ((size_t)((t >> 12) * 24 + vhh) * SEQ + prm) * 64 + ve0) = T.vv; } } while (0)
    P2Tok ta, tb;
    int tq = c.vcu;
    if (tq < M) P2_LOAD(ta, tq);
    for (; tq < M; tq += 2 * c.G) {
        if (tq + c.G < M) P2_LOAD(tb, tq + c.G);
        P2_PROC(ta, tq);
        if (tq + 2 * c.G < M) P2_LOAD(ta, tq + 2 * c.G);
        if (tq + c.G < M) P2_PROC(tb, tq + c.G);
    }
#undef P2_LOAD
#undef P2_SHIFT
#undef P2_PROC
}

__device__ __forceinline__ float wave_sum_dpp(float x) {
    x = DPP_ADD(x, 0xB1); x = DPP_ADD(x, 0x4E); x = DPP_ADD(x, 0x141); x = DPP_ADD(x, 0x140);
    const int xi = __builtin_bit_cast(int, x);
    return (__builtin_bit_cast(float, __builtin_amdgcn_readlane(xi, 0)) + __builtin_bit_cast(float, __builtin_amdgcn_readlane(xi, 16))) +
           (__builtin_bit_cast(float, __builtin_amdgcn_readlane(xi, 32)) + __builtin_bit_cast(float, __builtin_amdgcn_readlane(xi, 48)));
}
__device__ __forceinline__ f32x4 tile_mm(const LAS bf16_t* A, int pa, const LAS bf16_t* Bt, int pb, int ks, int fr, int fq, f32x4 acc) {
    for (int k = 0; k < ks; ++k) { const bf16x8 a = *(const LAS bf16x8*)(A + fr * pa + 32 * k + 8 * fq), b = *(const LAS bf16x8*)(Bt + fr * pb + 32 * k + 8 * fq);
        acc = __builtin_amdgcn_mfma_f32_16x16x32_bf16(a, b, acc, 0, 0, 0); }
    return acc;
}
__device__ __forceinline__ u32x2 pack4(f32x4 v) { u32x2 w; w.x = pk2(v[0], v[1]); w.y = pk2(v[2], v[3]); return w; }
constexpr int SC_C = 32, SC_NCH = SEQ / SC_C, SC_F = 96;
constexpr int PL_X1 = 0, PL_X2 = 9216, PL_AL = 18432, PL_HT = 26112, PL_ET = 33792, PL_LBT = 53760, PL_TT = 58368, PL_XB = 60928, PL_GI = PL_X1, PL_TF = PL_X2, PL_END = 62016, PL_GRP = 65536;
#define LBAR() do { asm volatile("s_waitcnt lgkmcnt(0)" ::: "memory"); __builtin_amdgcn_s_barrier(); asm volatile("" ::: "memory"); } while (0)
__device__ __forceinline__ void p4_pre(const Params& p, const Ctx& c) {
    unsigned char* ws = c.ws;
    const bf16_t* RZ = (const bf16_t*)(ws + WS_RZ); const bf16_t* LDEC = (const bf16_t*)(ws + WS_DEC); const bf16_t* KZ = (const bf16_t*)(ws + WS_KZ);
    const bf16_t* ALP = (const bf16_t*)(ws + WS_AN); const float* KNORM = (const float*)(ws + WS_KNORM); const float* kkp = p.in[I_KK]; const float* kap = p.in[I_KA];
    bf16_t* FG = (bf16_t*)(ws + WS_F); float* BON = (float*)(ws + WS_YS);
    const float* rkp = p.in[I_RK];
    int tid_ = c.tid; asm volatile("" : "+v"(tid_));
    const int tid = tid_, lane = tid & 63, w = __builtin_amdgcn_readfirstlane(tid >> 6), fr = lane & 15, fq = lane >> 4;
    const int grp = w >> 2, tw = w & 3, gtid = tid & 255;
    LAS unsigned char* gl = c.lds + grp * PL_GRP;
    LAS bf16_t* X1 = (LAS bf16_t*)(gl + PL_X1); LAS bf16_t* X2 = (LAS bf16_t*)(gl + PL_X2); LAS bf16_t* AL = (LAS bf16_t*)(gl + PL_AL); LAS bf16_t* HT = (LAS bf16_t*)(gl + PL_HT);
    LAS bf16_t* ET = (LAS bf16_t*)(gl + PL_ET); LAS float* LBT = (LAS float*)(gl + PL_LBT); LAS bf16_t* TT = (LAS bf16_t*)(gl + PL_TT); LAS bf16_t* GI = (LAS bf16_t*)(gl + PL_GI);
    LAS float* TF = (LAS float*)(gl + PL_TF);
    LAS float* XB = (LAS float*)(gl + PL_XB);
    const int npair = (128 * SC_NCH) / (2 * c.G);
    unsigned short dcy[32], ir[8], ik[8], ia[8]; float inr[8];
#define PRE_LOAD(PAIR) do { const int task_ = c.vcu + (2 * (PAIR) + grp) * c.G; const int bh_ = task_ >> 7, ch_ = task_ & (SC_NCH - 1); \
        const size_t o_ = ((size_t)(bh_ >> 5) * SEQ + (size_t)ch_ * SC_C) * D + (bh_ & 31) * 64 + lane; \
        _Pragma("unroll") for (int s_ = 0; s_ < 32; ++s_) dcy[s_] = LDEC[o_ + (size_t)s_ * D]; \
        _Pragma("unroll") for (int q_ = 0; q_ < 8; ++q_) { const size_t oo_ = o_ + (size_t)(8 * tw + q_) * D; ir[q_] = RZ[oo_]; ik[q_] = KZ[oo_]; ia[q_] = ALP[oo_]; \
            inr[q_] = KNORM[((size_t)(bh_ >> 5) * SEQ + (size_t)ch_ * SC_C + 8 * tw + q_) * 32 + (bh_ & 31)]; } } while (0)
    const bool bgconv = (c.G == 256);
    if (npair > 0) PRE_LOAD(0);
    for (int pr = 0; pr < npair; ++pr) {
        const int task = c.vcu + (2 * pr + grp) * c.G, bh = task >> 7, chn = task & (SC_NCH - 1);
        const float rkv = rkp[(bh & 31) * 64 + lane], kkc = kkp[(bh & 31) * 64 + lane], kac = kap[(bh & 31) * 64 + lane];
        float* bon = BON + ((size_t)(bh >> 5) * SEQ + (size_t)chn * SC_C) * 32 + (bh & 31);
        float p0 = 0.f, p1 = 0.f, p2 = 0.f, p3 = 0.f, dsel[8];
#pragma unroll
        for (int s = 0; s < 8; ++s) { const float d0 = bf2f(dcy[s]), d1 = bf2f(dcy[8 + s]), d2 = bf2f(dcy[16 + s]), d3 = bf2f(dcy[24 + s]); p0 += d0; p1 += d1; p2 += d2; p3 += d3;
            dsel[s] = tw == 0 ? d0 : (tw == 1 ? d1 : (tw == 2 ? d2 : d3)); }
        const float gC = __expf((p0 + p1) + (p2 + p3));
        float lg_ = tw == 0 ? 0.f : (tw == 1 ? p0 : (tw == 2 ? p0 + p1 : (p0 + p1) + p2));
        float g = __expf(lg_);
        LBAR();
#pragma unroll
        for (int hq = 0; hq < 2; ++hq) { f32x4 ah4, bg4, kg4;
#pragma unroll
            for (int qq = 0; qq < 4; ++qq) { const int qn = 4 * hq + qq, s = 8 * tw + qn;
                const float gp = g; lg_ += dsel[qn]; g = __expf(lg_);
                const float rr = bf2f(ir[qn]), kz = bf2f(ik[qn]), alp = bf2f(ia[qn]); const float ig = __expf(-lg_);
                const float kn = kz * kkc * __builtin_amdgcn_rcpf(fmaxf(inr[qn], 1e-12f));
                const float kk = kz * (1.0f + (alp - 1.0f) * kac), aa = -kn, bb = kn * alp;
                const float ah = aa * gp, bt = bb * ig, kt = kk * ig, rh = rr * g;
                X1[s * 72 + lane] = (bf16_t)f2bf(bt); X1[(32 + s) * 72 + lane] = (bf16_t)f2bf(kt); X2[s * 72 + lane] = (bf16_t)f2bf(ah); X2[(32 + s) * 72 + lane] = (bf16_t)f2bf(rh);
                ET[s * 104 + lane] = (bf16_t)f2bf(rh); ah4[qq] = ah; bg4[qq] = bt * gC; kg4[qq] = kt * gC;
                const float bsum = wave_sum_dpp(rr * kk * rkv); if (lane == 0) bon[(size_t)s * 32] = bsum; }
            *(LAS u32x2*)(AL + lane * 40 + 8 * tw + 4 * hq) = pack4(ah4); *(LAS u32x2*)(HT + (32 + lane) * 40 + 8 * tw + 4 * hq) = pack4(bg4); *(LAS u32x2*)(ET + (32 + lane) * 104 + 64 + 8 * tw + 4 * hq) = pack4(kg4); }
        { const int zr = gtid >> 2, zc = 16 * (gtid & 3); LAS u32x4* zp = (LAS u32x4*)(ET + (32 + zr) * 104 + zc); zp[0] = (u32x4){0u, 0u, 0u, 0u}; zp[1] = (u32x4){0u, 0u, 0u, 0u}; }
        if (pr + 1 < npair) PRE_LOAD(pr + 1);
        float cva[32], cvb[32]; int cea = 0, cna = 0, cka = 0, ceb = 0, cnb = 0, ckb = 0;
        if (bgconv) { const int it0 = ((c.vcu * 32 + pr) * 8 + w) * 2;
            cea = it0 >> 12; { const int rem = it0 & 4095; cka = 64 * (rem >> 7); cna = 32 * (rem & 127); }
            ceb = (it0 + 1) >> 12; { const int rem = (it0 + 1) & 4095; ckb = 64 * (rem >> 7); cnb = 32 * (rem & 127); }
            cv_issue(p.in[I_W1] + (size_t)cea * D * 4096, 4096, D, cna, cka, lane, cva); cv_issue(p.in[I_W1] + (size_t)ceb * D * 4096, 4096, D, cnb, ckb, lane, cvb); }
        LBAR();
        if (tw == 0) ET[(32 + lane) * 104 + lane] = (bf16_t)f2bf(gC);
        { const int mt = tw;
#pragma unroll
          for (int nt = 0; nt < 4; ++nt) {
            f32x4 acc = tile_mm(X1 + 16 * mt * 72, 72, X2 + 16 * nt * 72, 72, 2, fr, fq, (f32x4){0.f, 0.f, 0.f, 0.f});
            const int n = 16 * nt + fr, m0 = 16 * mt + 4 * fq;
            if (mt < 2) { if (nt < 2) { const int t = n; f32x4 o;
#pragma unroll
                    for (int e = 0; e < 4; ++e) o[e] = (m0 + e < t) ? acc[e] : 0.f;
                    *(LAS f32x4*)(LBT + t * 36 + m0) = o; }
                else { const int t = n - 32; f32x4 o;
#pragma unroll
                    for (int e = 0; e < 4; ++e) o[e] = (m0 + e <= t) ? acc[e] : 0.f;
                    *(LAS u32x2*)(HT + t * 40 + m0) = pack4(o); } }
            else { const int s0 = m0 - 32;
                if (nt < 2) { const int t = n;
#pragma unroll
                    for (int e = 0; e < 4; ++e) AL[(64 + s0 + e) * 40 + t] = (bf16_t)f2bf((s0 + e < t) ? acc[e] : 0.f); }
                else { const int t = n - 32; f32x4 o;
#pragma unroll
                    for (int e = 0; e < 4; ++e) o[e] = (s0 + e <= t) ? acc[e] : 0.f;
                    *(LAS u32x2*)(ET + t * 104 + 64 + s0) = pack4(o); } } } }
        LBAR();
        if (gtid < 32) { const int hb = 16 * (gtid >> 4), sl = gtid & 15; float Tr[16];
#pragma unroll
            for (int t = 0; t < 16; ++t) { float a0 = (sl == t) ? 1.f : 0.f, a1 = 0.f, a2 = 0.f, a3 = 0.f;
#pragma unroll
                for (int m4 = 0; m4 < (t + 3) / 4; ++m4) { const f32x4 l = *(const LAS f32x4*)(LBT + (hb + t) * 36 + hb + 4 * m4);
                    if (4 * m4 + 0 < t) a0 += Tr[4 * m4 + 0] * l[0]; if (4 * m4 + 1 < t) a1 += Tr[4 * m4 + 1] * l[1]; if (4 * m4 + 2 < t) a2 += Tr[4 * m4 + 2] * l[2]; if (4 * m4 + 3 < t) a3 += Tr[4 * m4 + 3] * l[3]; }
                Tr[t] = (a0 + a1) + (a2 + a3); TF[(hb + sl) * 36 + hb + t] = Tr[t]; TT[(hb + t) * 40 + hb + sl] = (bf16_t)f2bf(Tr[t]);
                if (hb) TT[t * 40 + hb + sl] = 0; } }
        LBAR();
        { const int m = gtid >> 4, tl = gtid & 15; float x = 0.f;
#pragma unroll
            for (int n = 0; n < 16; ++n) x += LBT[(16 + n) * 36 + m] * TF[(16 + n) * 36 + 16 + tl];
            XB[m * 17 + tl] = x; }
        LBAR();
        { const int sr = gtid >> 4, tl = gtid & 15; float x = 0.f;
#pragma unroll
            for (int m = 0; m < 16; ++m) x += TF[sr * 36 + m] * XB[m * 17 + tl];
            TT[(16 + tl) * 40 + sr] = (bf16_t)f2bf(x); }
        LBAR();
        for (int id = tw; id < 12; id += 4) { const int tt = id / 6, nt = id % 6;
            const f32x4 acc = tile_mm(TT + 16 * tt * 40, 40, AL + 16 * nt * 40, 40, 1, fr, fq, (f32x4){0.f, 0.f, 0.f, 0.f});
            *(LAS u32x2*)(GI + (16 * nt + fr) * 40 + 16 * tt + 4 * fq) = pack4(acc); }
        LBAR();
        for (int id = tw; id < 36; id += 4) { const int nt = id / 6, mt = id % 6;
            const f32x4 acc = tile_mm(GI + 16 * nt * 40, 40, HT + 16 * mt * 40, 40, 1, fr, fq, (f32x4){0.f, 0.f, 0.f, 0.f});
            LAS u32x2* ep = (LAS u32x2*)(ET + (16 * mt + fr) * 104 + 16 * nt + 4 * fq); const u32x2 ev = *ep;
            f32x4 o; o[0] = acc[0] + bf2f(ev.x & 0xffffu); o[1] = acc[1] + bf2f(ev.x >> 16); o[2] = acc[2] + bf2f(ev.y & 0xffffu); o[3] = acc[3] + bf2f(ev.y >> 16);
            *ep = pack4(o); }
        LBAR();
        { bf16_t* fg = FG + (size_t)task * (SC_F * SC_F);
          for (int idx = gtid; idx < 96 * 12; idx += 256) { const int row = idx / 12, pc = idx % 12; *(u32x4*)(fg + row * 96 + 8 * pc) = *(const LAS u32x4*)(ET + row * 104 + 8 * pc); } }
        LBAR();
        if (bgconv) { cv_store8(cva, ws + WS_W1 + (size_t)cea * 4096 * D, D, cna, cka, lane); cv_store8(cvb, ws + WS_W1 + (size_t)ceb * 4096 * D, D, cnb, ckb, lane); }
    }
    if (!bgconv) {
        LBAR();
        for (int r = c.vcu * 8 + w; r < NEXP * MOE_W1E; r += c.G * 8) { const int e = r >> 12, rem = r & 4095; float cv[32]; cv_issue(p.in[I_W1] + (size_t)e * D * 4096, 4096, D, 32 * (rem & 127), 64 * (rem >> 7), lane, cv);
            cv_store8(cv, ws + WS_W1 + (size_t)e * 4096 * D, D, 32 * (rem & 127), 64 * (rem >> 7), lane); }
    }
    LBAR();
#undef PRE_LOAD
}
constexpr int SQ_BI = 0, SQ_BI_SZ = 64 * 104 * 2, SQ_YL = 2 * SQ_BI_SZ, SQ_YL_SZ = 32 * 64 * 4;
struct SeqSet { bf16x8 af[3][3]; u32x2 vimg, gimg; float bon; };
__device__ __forceinline__ void p4_seq(const Params& p, const Ctx& c, int bh) {
    unsigned char* ws = c.ws;
    const bf16_t* VZ = (const bf16_t*)(ws + WS_VZ); const bf16_t* GG = (const bf16_t*)(ws + WS_GG); const float* BON = (const float*)(ws + WS_YS);
    const bf16_t* FG = (const bf16_t*)(ws + WS_F) + (size_t)bh * SC_NCH * (SC_F * SC_F);
    bf16_t* YA = (bf16_t*)(ws + WS_YA);
    int tid_ = c.tid; asm volatile("" : "+v"(tid_));
    const int tid = tid_, lane = tid & 63, w = __builtin_amdgcn_readfirstlane(tid >> 6), fr = lane & 15, fq = lane >> 4;
    const int b = bh >> 5, h = bh & 31;
    const size_t base = (size_t)b * SEQ * D + h * 64;
    const int nt = w & 3, mg = w >> 2;
    LAS bf16_t* BI = (LAS bf16_t*)(c.lds + SQ_BI); LAS float* YL = (LAS float*)(c.lds + SQ_YL);
    const int vs = tid >> 4, vi4 = 4 * (tid & 15);
    const f32x4 lg4 = *(const f32x4*)(p.in[I_LNXG] + h * 64 + vi4), lb4 = *(const f32x4*)(p.in[I_LNXB] + h * 64 + vi4);
#define SEQ_LOAD(SET, CHN) do { const int chn_ = (CHN) < SC_NCH ? (CHN) : SC_NCH - 1; const bf16_t* fp = FG + (size_t)chn_ * (SC_F * SC_F); const size_t tk_ = (size_t)b * SEQ + (size_t)(chn_ * SC_C + vs); \
        asm volatile("global_load_dwordx2 %0, %1, off" : "=v"(SET.vimg) : "v"(VZ + tk_ * D + h * 64 + vi4) : "memory"); \
        _Pragma("unroll") for (int mi = 0; mi < 3; ++mi) _Pragma("unroll") for (int ks = 0; ks < 3; ++ks) \
            asm volatile("global_load_dwordx4 %0, %1, off" : "=v"(SET.af[mi][ks]) : "v"(fp + (16 * (3 * mg + mi) + fr) * SC_F + 32 * ks + 8 * fq) : "memory"); \
        asm volatile("global_load_dwordx2 %0, %1, off" : "=v"(SET.gimg) : "v"(GG + tk_ * D + h * 64 + vi4) : "memory"); \
        asm volatile("global_load_dword %0, %1, off" : "=v"(SET.bon) : "v"(BON + tk_ * 32 + h) : "memory"); } while (0)
#define SEQ_WAIT_AF(SET, N) asm volatile("s_waitcnt vmcnt(" #N ")" : "+v"(SET.af[0][0]), "+v"(SET.af[0][1]), "+v"(SET.af[0][2]), "+v"(SET.af[1][0]), "+v"(SET.af[1][1]), "+v"(SET.af[1][2]), \
        "+v"(SET.af[2][0]), "+v"(SET.af[2][1]), "+v"(SET.af[2][2]) :: "memory")
#define SEQ_WAIT_V(SET, N) asm volatile("s_waitcnt vmcnt(" #N ")" : "+v"(SET.vimg) :: "memory")
#define SEQ_WAIT_G(SET, N) asm volatile("s_waitcnt vmcnt(" #N ")" : "+v"(SET.gimg), "+v"(SET.bon), "+v"(SET.vimg) :: "memory")
#define SEQ_BODY(CH, CUR, NXT, NX2) do { const int ch = (CH), cb = ch & 1; \
        const LAS bf16_t* bi = BI + cb * (64 * 104); LAS bf16_t* bo = BI + (cb ^ 1) * (64 * 104); LAS float* yl = YL + cb * (32 * 64); \
        SEQ_LOAD(NX2, ch + 2); \
        bf16x8 bfr[3]; _Pragma("unroll") for (int ks = 0; ks < 3; ++ks) bfr[ks] = *(const LAS bf16x8*)(bi + (16 * nt + fr) * 104 + 32 * ks + 8 * fq); \
        SEQ_WAIT_AF(CUR, 28); \
        f32x4 acc[3]; _Pragma("unroll") for (int mi = 0; mi < 3; ++mi) { acc[mi] = (f32x4){0.f, 0.f, 0.f, 0.f}; \
            _Pragma("unroll") for (int ks = 0; ks < 3; ++ks) acc[mi] = __builtin_amdgcn_mfma_f32_16x16x32_bf16(CUR.af[mi][ks], bfr[ks], acc[mi], 0, 0, 0); } \
        _Pragma("unroll") for (int mi = 0; mi < 3; ++mi) { const int mt = 3 * mg + mi; \
            if (mt < 2) { _Pragma("unroll") for (int e = 0; e < 4; ++e) yl[(16 * mt + 4 * fq + e) * 64 + 16 * nt + fr] = acc[mi][e]; } \
            else *(LAS u32x2*)(bo + (16 * nt + fr) * 104 + 16 * (mt - 2) + 4 * fq) = pack4(acc[mi]); } \
        SEQ_WAIT_V(NXT, 24); \
        if (ch + 1 < SC_NCH) { bo[(vi4 + 0) * 104 + 64 + vs] = (bf16_t)(NXT.vimg.x & 0xffffu); bo[(vi4 + 1) * 104 + 64 + vs] = (bf16_t)(NXT.vimg.x >> 16); \
            bo[(vi4 + 2) * 104 + 64 + vs] = (bf16_t)(NXT.vimg.y & 0xffffu); bo[(vi4 + 3) * 104 + 64 + vs] = (bf16_t)(NXT.vimg.y >> 16); } \
        LBAR(); \
        SEQ_WAIT_G(CUR, 24); \
        { const f32x4 y4 = *(const LAS f32x4*)(yl + vs * 64 + vi4); float sm = (y4[0] + y4[1]) + (y4[2] + y4[3]); \
          sm = DPP_ADD(sm, 0xB1); sm = DPP_ADD(sm, 0x4E); sm = DPP_ADD(sm, 0x141); sm = DPP_ADD(sm, 0x140);     \
          const float mu = sm * (1.0f / 64.0f); const f32x4 d4 = y4 - mu; float q = (d4[0] * d4[0] + d4[1] * d4[1]) + (d4[2] * d4[2] + d4[3] * d4[3]); \
          q = DPP_ADD(q, 0xB1); q = DPP_ADD(q, 0x4E); q = DPP_ADD(q, 0x141); q = DPP_ADD(q, 0x140); \
          const float rstd = rsqrtf(q * (1.0f / 64.0f) + GN_EPS); \
          const float v0 = bf2f(CUR.vimg.x & 0xffffu), v1 = bf2f(CUR.vimg.x >> 16), v2 = bf2f(CUR.vimg.y & 0xffffu), v3 = bf2f(CUR.vimg.y >> 16); \
          const float g0 = bf2f(CUR.gimg.x & 0xffffu), g1 = bf2f(CUR.gimg.x >> 16), g2 = bf2f(CUR.gimg.y & 0xffffu), g3 = bf2f(CUR.gimg.y >> 16); \
          const float o0 = (d4[0] * rstd * lg4[0] + lb4[0] + CUR.bon * v0) * g0, o1 = (d4[1] * rstd * lg4[1] + lb4[1] + CUR.bon * v1) * g1; \
          const float o2 = (d4[2] * rstd * lg4[2] + lb4[2] + CUR.bon * v2) * g2, o3 = (d4[3] * rstd * lg4[3] + lb4[3] + CUR.bon * v3) * g3; \
          *(u32x2*)(YA + ((size_t)b * SEQ + (size_t)(ch * SC_C + vs)) * 2560 + h * 64 + vi4) = (u32x2){pk2(o0, o1), pk2(o2, o3)}; } } while (0)
    SeqSet sa, sb, sc;
    SEQ_LOAD(sa, 0); SEQ_LOAD(sb, 1);
    SEQ_WAIT_V(sa, 0);
    for (int idx = tid; idx < 64 * 8; idx += 512) *(LAS u32x4*)(BI + (idx >> 3) * 104 + 8 * (idx & 7)) = (u32x4){0u, 0u, 0u, 0u};
    BI[(vi4 + 0) * 104 + 64 + vs] = (bf16_t)(sa.vimg.x & 0xffffu); BI[(vi4 + 1) * 104 + 64 + vs] = (bf16_t)(sa.vimg.x >> 16);
    BI[(vi4 + 2) * 104 + 64 + vs] = (bf16_t)(sa.vimg.y & 0xffffu); BI[(vi4 + 3) * 104 + 64 + vs] = (bf16_t)(sa.vimg.y >> 16);
    LBAR();
    for (int c0 = 0; c0 < SC_NCH; c0 += 3) {
        SEQ_BODY(c0, sa, sb, sc);
        if (c0 + 1 < SC_NCH) SEQ_BODY(c0 + 1, sb, sc, sa);
        if (c0 + 2 < SC_NCH) SEQ_BODY(c0 + 2, sc, sa, sb);
    }
    asm volatile("s_waitcnt vmcnt(0)" ::: "memory");
    LBAR();
#undef SEQ_LOAD
#undef SEQ_BODY
#undef SEQ_WAIT_AF
#undef SEQ_WAIT_V
#undef SEQ_WAIT_G
}

__device__ __forceinline__ void p4_attn_task(const Ctx& c, int task) {
    unsigned char* ws = c.ws;
    const bf16_t* QR = (const bf16_t*)(ws + WS_QR); const bf16_t* KR = (const bf16_t*)(ws + WS_KR); const bf16_t* VR = (const bf16_t*)(ws + WS_VR);
    bf16_t* AO = (bf16_t*)(ws + WS_AO); float* LSE = (float*)(ws + WS_LSE);
    constexpr int VP = 280;
    LAS bf16_t* Vt = (LAS bf16_t*)c.lds;
    const int combo = task & 31, hh = (task >> 5) % 24, b = task / (32 * 24);
    const int g = hh >> 3, h = hh & 7;
    const int dil = g == 0 ? 1 : (g == 1 ? 4 : 16), nblk = 32 / dil;
    const int res = combo / nblk, blk = combo % nblk;
    int tid_ = c.tid; asm volatile("" : "+v"(tid_));
    const int tid = tid_, lane = tid & 63, w = __builtin_amdgcn_readfirstlane(tid >> 6);
    const int qq = lane & 15, g4 = lane >> 4, r0 = 16 * w;
    const size_t rowb = (size_t)(b * 24 + hh) * SEQ + (size_t)res * (SEQ / dil) + (size_t)blk * 128;
    bf16x8 qf[2], kf[9][2];
#pragma unroll
    for (int ks = 0; ks < 2; ++ks) qf[ks] = *(const bf16x8*)(QR + (rowb + r0 + qq) * 64 + 32 * ks + 8 * g4);
#pragma unroll
    for (int kt = 0; kt < 9; ++kt) { const bool kv = (blk > 0) || (w + kt >= 8);
#pragma unroll
        for (int ks = 0; ks < 2; ++ks) { kf[kt][ks] = (bf16x8){0, 0, 0, 0, 0, 0, 0, 0};
            if (kv) kf[kt][ks] = *(const bf16x8*)(KR + (rowb - 128 + 16 * (w + kt) + qq) * 64 + 32 * ks + 8 * g4); } }
    const int vki = tid >> 1, vdh = tid & 1;
    u32x4 vv[4];
    if (blk > 0 || vki >= 128) {
#pragma unroll
        for (int j = 0; j < 4; ++j) vv[j] = *(const u32x4*)(VR + (rowb - 128 + vki) * 64 + 32 * vdh + 8 * j); }
    else {
#pragma unroll
        for (int j = 0; j < 4; ++j) vv[j] = (u32x4){0u, 0u, 0u, 0u}; }
    __syncthreads();
#pragma unroll
    for (int j = 0; j < 4; ++j) { const unsigned wv[4] = {vv[j].x, vv[j].y, vv[j].z, vv[j].w};
#pragma unroll
        for (int e = 0; e < 8; ++e) Vt[(32 * vdh + 8 * j + e) * VP + vki] = (bf16_t)((wv[e >> 1] >> (16 * (e & 1))) & 0xffffu); }
    if (tid < 64) {
#pragma unroll
        for (int e = 0; e < 24; ++e) Vt[tid * VP + 256 + e] = 0; }
    f32x4 sc[10];
#pragma unroll
    for (int kt = 0; kt < 9; ++kt) { f32x4 a = (f32x4){0.f, 0.f, 0.f, 0.f};
#pragma unroll
        for (int ks = 0; ks < 2; ++ks) a = __builtin_amdgcn_mfma_f32_16x16x32_bf16(kf[kt][ks], qf[ks], a, 0, 0, 0);
        sc[kt] = a; }
    const int r = r0 + qq;
    float mx = -3.0e38f;
#pragma unroll
    for (int kt = 0; kt < 9; ++kt)
#pragma unroll
        for (int j = 0; j < 4; ++j) { const int ki = 16 * (w + kt) + 4 * g4 + j; const bool ok = (ki >= r) && (ki <= r + 128) && (blk > 0 || ki >= 128);
            const float sv = ok ? sc[kt][j] * 0.125f : -1.0e30f; sc[kt][j] = sv; mx = fmaxf(mx, sv); }
    mx = fmaxf(mx, __shfl_xor(mx, 16)); mx = fmaxf(mx, __shfl_xor(mx, 32));
    float den = 0.f;
#pragma unroll
    for (int kt = 0; kt < 9; ++kt)
#pragma unroll
        for (int j = 0; j < 4; ++j) { const float pexp = __expf(sc[kt][j] - mx); sc[kt][j] = pexp; den += pexp; }
    den += __shfl_xor(den, 16); den += __shfl_xor(den, 32);
    sc[9] = (f32x4){0.f, 0.f, 0.f, 0.f};
    __syncthreads();
    f32x4 oacc[4];
#pragma unroll
    for (int dt = 0; dt < 4; ++dt) oacc[dt] = (f32x4){0.f, 0.f, 0.f, 0.f};
#pragma unroll
    for (int cidx = 0; cidx < 5; ++cidx) {
        const f32x4 p0 = sc[2 * cidx], p1 = sc[2 * cidx + 1];
        u32x4 pw; pw.x = pk2(p0[0], p0[1]); pw.y = pk2(p0[2], p0[3]); pw.z = pk2(p1[0], p1[1]); pw.w = pk2(p1[2], p1[3]);
        const bf16x8 pf = __builtin_bit_cast(bf16x8, pw);
        const int kbase = 16 * (w + 2 * cidx) + 4 * g4;
#pragma unroll
        for (int dt = 0; dt < 4; ++dt) { const LAS bf16_t* vp = Vt + (16 * dt + qq) * VP + kbase;
            const u32x2 lo = *(const LAS u32x2*)vp, hi = *(const LAS u32x2*)(vp + 16);
            u32x4 vw; vw.x = lo.x; vw.y = lo.y; vw.z = hi.x; vw.w = hi.y;
            oacc[dt] = __builtin_amdgcn_mfma_f32_16x16x32_bf16(__builtin_bit_cast(bf16x8, vw), pf, oacc[dt], 0, 0, 0); }
    }
    const float inv = 1.0f / den;
    const size_t tok = (size_t)b * SEQ + (size_t)(blk * 128 + r) * dil + res;
#pragma unroll
    for (int dt = 0; dt < 4; ++dt) { const f32x4 ov = oacc[dt] * inv; *(u32x2*)(AO + ((size_t)g * M + tok) * 512 + h * 64 + 16 * dt + 4 * g4) = (u32x2){pk2(ov[0], ov[1]), pk2(ov[2], ov[3])}; }
    if (g4 == 0) LSE[((size_t)g * M + tok) * 8 + h] = mx + __logf(den);
}

struct KvUnitOrder {
    static constexpr bool GATHER = false;
    const char* A; const char* Bt; int q;
    __device__ bool next(int i, pg8::Unit& u) const {
        if (i != 0) return false;
        const int pm = q & 3, pn = q >> 2;
        u.A = A + (size_t)pm * 256 * D * 2; u.B = Bt + (size_t)pn * 256 * D * 2; u.orow = 256 * pm; u.ocol = 256 * pn; u.aux = 0; u.aux2 = 0; u.valid = 256; return true;
    }
    __device__ __forceinline__ const int* rows(const pg8::Unit&) const { return nullptr; }
};
constexpr int Q_KV = 64, Q_ATT = 3072, Q_TOTAL = Q_KV + Q_ATT + MOE_CONV_GROUPS;
__device__ __forceinline__ void p4_queue(const Params& p, const Ctx& c, volatile LAS unsigned* qslot) {
    unsigned* qc = (unsigned*)(c.ws + WS_CTL) + CW_Q;
    for (;;) {
        __syncthreads();
        if (c.tid == 0) qslot[0] = __hip_atomic_fetch_add(qc, 1u, __ATOMIC_RELAXED, __HIP_MEMORY_SCOPE_AGENT);
        __syncthreads();
        const unsigned it = qslot[0];
        if (it >= (unsigned)Q_TOTAL) break;
        if (it < (unsigned)Q_KV) { const int qi = __builtin_amdgcn_readfirstlane((int)it);
            KvUnitOrder S{(const char*)(c.ws + WS_MEMB), (const char*)(c.ws + WS_WKV), qi};
            pg8::EpiKV E{(bf16_t*)(c.ws + WS_KB), (bf16_t*)(c.ws + WS_VT)};
            pg8::gemm_phase<pg8::EpiKV, KvUnitOrder>(c.lds, pg8::Gemm{D, D, D}, S, E); }
        else if (it < (unsigned)(Q_KV + Q_ATT)) p4_attn_task(c, (int)it - Q_KV); else conv_group(p, c, (int)it - Q_KV - Q_ATT);
    }
}

__device__ __forceinline__ void p5_post(const Params& p, const Ctx& c) {
    unsigned char* ws = c.ws;
    const bf16_t* AO = (const bf16_t*)(ws + WS_AO); const float* LSE = (const float*)(ws + WS_LSE);
    bf16_t* YB = (bf16_t*)(ws + WS_YA);
    const int gw = c.vcu * 8 + c.wave, NGW = c.G * 8, lane = c.lane;
    for (int it = gw; it < M * 8; it += NGW) {
        const int t = it >> 3, h = it & 7;
        const float l0 = LSE[((size_t)0 * M + t) * 8 + h], l1 = LSE[((size_t)1 * M + t) * 8 + h], l2 = LSE[((size_t)2 * M + t) * 8 + h];
        const float mxl = fmaxf(l0, fmaxf(l1, l2)); const float e0 = __expf(l0 - mxl), e1 = __expf(l1 - mxl), e2 = __expf(l2 - mxl); const float inv = 1.0f / (e0 + e1 + e2);
        const size_t o = (size_t)t * 512 + h * 64 + lane;
        const float v = (e0 * bf2f(AO[o]) + e1 * bf2f(AO[(size_t)M * 512 + o]) + e2 * bf2f(AO[(size_t)2 * M * 512 + o])) * inv;
        YB[(size_t)t * 2560 + 2048 + h * 64 + lane] = (bf16_t)f2bf(v);
    }
}

__device__ __forceinline__ void ln_rows(const Ctx& c, const float* in, const float* gam, const float* bet, float* outf, f32x2* stats, unsigned char* outq) {
    const int gw = c.vcu * 8 + c.wave, NGW = c.G * 8, lane = c.lane;
    for (int m = gw; m < M; m += NGW) {
        const f32x4* xr = (const f32x4*)(in + (size_t)m * D) + lane;
        f32x4 v[8]; float s = 0.f;
#pragma unroll
        for (int j = 0; j < 8; ++j) { v[j] = xr[64 * j]; s += (v[j][0] + v[j][1]) + (v[j][2] + v[j][3]); }
        const float mean = wave_sum(s) * (1.0f / D); float s2 = 0.f;
#pragma unroll
        for (int j = 0; j < 8; ++j) { v[j] = v[j] - mean; s2 += (v[j][0] * v[j][0] + v[j][1] * v[j][1]) + (v[j][2] * v[j][2] + v[j][3] * v[j][3]); }
        const float rstd = rsqrtf(wave_sum(s2) * (1.0f / D) + LN_EPS);
        if (stats && lane == 0) stats[m] = (f32x2){mean, rstd};
#pragma unroll
        for (int j = 0; j < 8; ++j) { const int col = 4 * lane + 256 * j; const f32x4 gv = *(const f32x4*)(gam + col), bv = *(const f32x4*)(bet + col);
            const f32x4 o = v[j] * rstd * gv + bv;
            if (outf) *(f32x4*)(outf + (size_t)m * D + col) = o;
            if (outq) *(unsigned*)(outq + (size_t)m * D + col) = pk4_fp8(o[0], o[1], o[2], o[3]); }
    }
}

__device__ __forceinline__ void p15_router(const Params& p, const Ctx& c) {
    unsigned char* ws = c.ws;
    const float* T2 = (const float*)(ws + WS_T2); const f32x2* ST2 = (const f32x2*)(ws + WS_ST2); const float* g2 = p.in[I_LN2G]; const float* b2 = p.in[I_LN2B]; const float* RW = p.in[I_RW]; const float* RB = p.in[I_RB];
    unsigned* cnt = (unsigned*)(ws + WS_CTL) + CW_CNT; int* LIST = (int*)(ws + WS_LIST); int* ROWI = (int*)(ws + WS_ROWI); float* TOPW = (float*)(ws + WS_TOPW);
    LAS float* scr = (LAS float*)(c.lds + c.wave * 8192);
    const int gw = c.vcu * 8 + c.wave, NGW = c.G * 8, lane = c.lane, li = lane & 31, lk = lane >> 5;
    for (int tb = gw; tb < M / 32; tb += NGW) {
        const int t0 = tb * 32;
        f32x16 acc;
#pragma unroll
        for (int j = 0; j < 16; ++j) acc[j] = 0.f;
        const float* xa = T2 + (size_t)(t0 + li) * D + 4 * lk; const f32x2 st = ST2[t0 + li];
        const float* wb = RW + (size_t)(4 * lk) * 32 + li;
        for (int kb = 0; kb < D / 8; ++kb) {
            const f32x4 a = ((*(const f32x4*)(xa + 8 * kb) - st.x) * st.y) * *(const f32x4*)(g2 + 8 * kb + 4 * lk) + *(const f32x4*)(b2 + 8 * kb + 4 * lk);
            const float b0 = wb[(size_t)(8 * kb + 0) * 32], b1 = wb[(size_t)(8 * kb + 1) * 32], b2 = wb[(size_t)(8 * kb + 2) * 32], b3 = wb[(size_t)(8 * kb + 3) * 32];
            acc = __builtin_amdgcn_mfma_f32_32x32x2f32(a[0], b0, acc, 0, 0, 0);
            acc = __builtin_amdgcn_mfma_f32_32x32x2f32(a[1], b1, acc, 0, 0, 0);
            acc = __builtin_amdgcn_mfma_f32_32x32x2f32(a[2], b2, acc, 0, 0, 0);
            acc = __builtin_amdgcn_mfma_f32_32x32x2f32(a[3], b3, acc, 0, 0, 0);
        }
        const float bias = RB[li];
#pragma unroll
        for (int rg = 0; rg < 16; ++rg) { const int row = (rg & 3) + 8 * (rg >> 2) + 4 * lk; scr[row * 33 + li] = acc[rg] + bias; }
        LDS_WAIT(); asm volatile("" ::: "memory");
        if (lane < 32) {
            float lv[32];
#pragma unroll
            for (int e = 0; e < 32; ++e) lv[e] = scr[lane * 33 + e];
            int id[4]; float tv[4];
#pragma unroll
            for (int k = 0; k < 4; ++k) { float best = -3.0e38f; int bi = 0;
#pragma unroll
                for (int e = 0; e < 32; ++e) { const bool tk = lv[e] > best; best = tk ? lv[e] : best; bi = tk ? e : bi; }
                id[k] = bi; tv[k] = best;
#pragma unroll
                for (int e = 0; e < 32; ++e) lv[e] = (e == bi) ? -3.0e38f : lv[e]; }
            const float e1 = __expf(tv[1] - tv[0]), e2 = __expf(tv[2] - tv[0]), e3 = __expf(tv[3] - tv[0]); const float inv = 1.0f / (1.0f + e1 + e2 + e3);
            const float wv[4] = {inv, e1 * inv, e2 * inv, e3 * inv};
            const int t = t0 + lane;
#pragma unroll
            for (int k = 0; k < 4; ++k) { const unsigned slot = __hip_atomic_fetch_add(cnt + id[k], 1u, __ATOMIC_RELAXED, __HIP_MEMORY_SCOPE_AGENT);
                LIST[(size_t)id[k] * CAP + slot] = t; ROWI[(size_t)t * 4 + k] = id[k] * CAP + (int)slot; TOPW[(size_t)t * 4 + k] = wv[k]; }
        }
        LDS_WAIT(); asm volatile("" ::: "memory");
    }
}

__device__ __forceinline__ void moe_table(const Ctx& c, LAS int* tab) {
    if (c.tid == 0) { unsigned* cnt = (unsigned*)(c.ws + WS_CTL) + CW_CNT; int ts = 0;
        for (int e = 0; e < NEXP; ++e) { const int n = (int)__hip_atomic_load(cnt + e, __ATOMIC_RELAXED, __HIP_MEMORY_SCOPE_AGENT); tab[e] = n; tab[32 + e] = ts; ts += (n + 255) >> 8; }
        tab[64] = ts; }
    __syncthreads();
}

__device__ __forceinline__ void p18_combine(const Params& p, const Ctx& c, const LAS int* tab) {
    unsigned char* ws = c.ws;
    const float* T2 = (const float*)(ws + WS_T2); const f32x2* ST2 = (const f32x2*)(ws + WS_ST2); const float* g2 = p.in[I_LN2G]; const float* b2 = p.in[I_LN2B]; const bf16_t* Y = (const bf16_t*)(ws + WS_Y); const int* ROWI = (const int*)(ws + WS_ROWI); const float* TOPW = (const float*)(ws + WS_TOPW);
    const float* gam = p.in[I_LN3G]; const float* bet = p.in[I_LN3B];
    const int gw = c.vcu * 8 + c.wave, NGW = c.G * 8, lane = c.lane;
    for (int m = gw; m < M; m += NGW) {
        f32x4 v[8];
        const f32x4* xr = (const f32x4*)(T2 + (size_t)m * D) + lane; const f32x2 st = ST2[m];
#pragma unroll
        for (int j = 0; j < 8; ++j) { const int col = 4 * lane + 256 * j; v[j] = (((xr[64 * j] - st.x) * st.y) * *(const f32x4*)(g2 + col) + *(const f32x4*)(b2 + col)) * DN_ALPHA; }
#pragma unroll
        for (int k = 0; k < 4; ++k) { const int ri = ROWI[(size_t)m * 4 + k]; const float gt = TOPW[(size_t)m * 4 + k]; const int e = ri >> 14, slot = ri & (CAP - 1);
            const u32x2* yr = (const u32x2*)(Y + ((size_t)tab[32 + e] * 256 + slot) * D) + lane;
#pragma unroll
            for (int j = 0; j < 8; ++j) { const u32x2 yw = yr[64 * j]; v[j] = v[j] + (f32x4){bf2f(yw.x & 0xffffu), bf2f(yw.x >> 16), bf2f(yw.y & 0xffffu), bf2f(yw.y >> 16)} * gt; } }
        float s = 0.f;
#pragma unroll
        for (int j = 0; j < 8; ++j) s += (v[j][0] + v[j][1]) + (v[j][2] + v[j][3]);
        const float mean = wave_sum(s) * (1.0f / D); float s2 = 0.f;
#pragma unroll
        for (int j = 0; j < 8; ++j) { v[j] = v[j] - mean; s2 += (v[j][0] * v[j][0] + v[j][1] * v[j][1]) + (v[j][2] * v[j][2] + v[j][3] * v[j][3]); }
        const float rstd = rsqrtf(wave_sum(s2) * (1.0f / D) + LN_EPS);
#pragma unroll
        for (int j = 0; j < 8; ++j) { const int col = 4 * lane + 256 * j; const f32x4 gv = *(const f32x4*)(gam + col), bv = *(const f32x4*)(bet + col);
            *(f32x4*)(p.out + (size_t)m * D + col) = v[j] * rstd * gv + bv; }
    }
}

constexpr int NPHASE = 19;
__global__ void __launch_bounds__(512, 2) fwd(Params p) {
    extern __shared__ __attribute__((aligned(16))) unsigned char lds_raw[];
    LAS unsigned char* lds = (LAS unsigned char*)lds_raw;
    Ctx c; c.tid = threadIdx.x; c.lane = c.tid & 63; c.wave = __builtin_amdgcn_readfirstlane(c.tid >> 6); c.G = gridDim.x;
    { const int bx = blockIdx.x; c.vcu = (c.G % 8 == 0) ? (bx % 8) * (c.G / 8) + bx / 8 : bx; }
    c.lds = lds; c.ws = p.ws;
    unsigned char* ws = p.ws;
    volatile LAS unsigned* MISC = (volatile LAS unsigned*)(lds + MISC_OFF);
    LAS int* tab = (LAS int*)(lds + MISC_OFF + 1024);
    if (c.tid < 64) MISC[c.tid] = 0u;
    __syncthreads();
    unsigned* ctl = (unsigned*)(ws + WS_CTL);
    XcdBarrier bar; bar.bar = ctl + CW_BAR + p.li * XCD_BAR_WORDS; bar.x = 0; bar.st = MISC + 8;
    if (N_LAUNCH_MODE == 1) bar = xcd_barrier_post(ctl + CW_BAR + p.li * XCD_BAR_WORDS, MISC + 8);
    const int lo = p.ph_lo, hi = p.ph_hi, bx = blockIdx.x;
#ifndef PHMASK
#define PHMASK 0xFFFFFFFFu
#endif
#define IN(k) (((PHMASK >> (k)) & 1u) && lo <= (k) && (k) < hi)
#define SEAM(k) do { if (N_LAUNCH_MODE == 1 && IN((k) + 1)) xcd_barrier(bar); } while (0)

    if (IN(0)) { p0_prologue(p, c); SEAM(0); }

    if (IN(1)) {
        { pg8::StaticOrder S; S.init(ws + WS_XB, ws + WS_WIN, M, ATT0, D, D, c.G, bx);
          pg8::EpiBf16 E{(bf16_t*)(ws + WS_PROJ), PC, 1.0f};
          pg8::gemm_phase<pg8::EpiBf16, pg8::StaticOrder>(lds, pg8::Gemm{D, D, D}, S, E); }
        { pg8::StaticOrder S; S.init(ws + WS_XQ, ws + WS_WIN8, M, PC - ATT0, D, D, c.G, bx, 1);
          pg8::EpiBf16 E{(bf16_t*)(ws + WS_PROJ) + ATT0, PC, 1.0f};
          pg8::gemm_phase<pg8::EpiBf16, pg8::StaticOrder, true, true>(lds, pg8::Gemm{D, D, D}, S, E); }
        SEAM(1);
    }
    if (IN(2)) { p2_prep(p, c); SEAM(2); }

    if (IN(3)) {
#ifndef P3M
#define P3M 15
#endif
        if (P3M & 1) { pg8::StaticOrder S; S.init(ws + WS_LIN, ws + WS_WUP, M, D, 768, 256, c.G, bx);
          pg8::EpiDecay E{(bf16_t*)(ws + WS_DEC), p.in[I_W0]};
          pg8::gemm_phase<pg8::EpiDecay, pg8::StaticOrder>(lds, pg8::Gemm{256, 768, 256}, S, E); }
        if (P3M & 2) { pg8::StaticOrder S; S.init(ws + WS_LIN + 512, ws + WS_AUP, M, D, 768, 256, c.G, bx);
          pg8::EpiIclr E{p.in[I_A0], (bf16_t*)(ws + WS_AN)};
          pg8::gemm_phase<pg8::EpiIclr, pg8::StaticOrder>(lds, pg8::Gemm{256, 768, 256}, S, E); }
        if (P3M & 4) { pg8::StaticOrder S; S.init(ws + WS_LIN + 1024, ws + WS_GUP, M, D, 768, 256, c.G, bx);
          pg8::EpiBf16 E{(bf16_t*)(ws + WS_GG), D, 1.0f};
          pg8::gemm_phase<pg8::EpiBf16, pg8::StaticOrder>(lds, pg8::Gemm{256, 768, 256}, S, E); }
        SEAM(3);
    }
    if (IN(4)) {
        p4_pre(p, c);
        xcd_barrier(bar);
        for (int bh = c.vcu; bh < 128; bh += c.G) p4_seq(p, c, bh);
        p4_queue(p, c, MISC + 16);
        SEAM(4);
    }
    if (IN(5)) { p5_post(p, c); }

    if (IN(6)) {
        pg8::StaticOrder S; S.init(ws + WS_YA, ws + WS_PA, M, D, 2560, 2560, c.G, bx);
        pg8::EpiGateFused E{(const bf16_t*)(ws + WS_PROJ), (bf16_t*)(ws + WS_MERGED)};
        pg8::gemm_phase<pg8::EpiGateFused, pg8::StaticOrder>(lds, pg8::Gemm{2560, 2560, 2560}, S, E);
        SEAM(6);
    }
    if (IN(7)) { }
    if (IN(8)) {
        pg8::StaticOrder S; S.init(ws + WS_MERGED, ws + WS_WOUT, M, D, D, D, c.G, bx);
        pg8::EpiF32 E{(float*)(ws + WS_T1), D, nullptr, 0, p.in[I_X], DN_ALPHA};
        pg8::gemm_phase<pg8::EpiF32, pg8::StaticOrder>(lds, pg8::Gemm{D, D, D}, S, E);
        SEAM(8);
    }
    if (IN(9)) { ln_rows(c, (const float*)(ws + WS_T1), p.in[I_LN1G], p.in[I_LN1B], nullptr, (f32x2*)(ws + WS_ST1), ws + WS_X1B); SEAM(9); }

    if (IN(10)) {
        pg8::StaticOrder S; S.init(ws + WS_X1B, ws + WS_WQ, M, D, D, D, c.G, bx, 1);
        pg8::EpiBf16 E{(bf16_t*)(ws + WS_Q), D, 0.04419417382415922f};
        pg8::gemm_phase<pg8::EpiBf16, pg8::StaticOrder, true, true>(lds, pg8::Gemm{D, D, D}, S, E);
        SEAM(10);
    }
    if (IN(11)) {
        ScoreOrder S{(const char*)(ws + WS_Q), (const char*)(ws + WS_KB), c.G, bx};
        pg8::EpiSoftmax E{(bf16_t*)(ws + WS_PP)};
        pg8::gemm_phase<pg8::EpiSoftmax, ScoreOrder, false>(lds, pg8::Gemm{512, D, D}, S, E);
        SEAM(11);
    }
    if (IN(12)) {
        PvOrder S{(const char*)(ws + WS_PP), (const char*)(ws + WS_VT), c.G, bx};
        pg8::EpiBf16 E{(bf16_t*)(ws + WS_OC), D, 1.0f};
        pg8::gemm_phase<pg8::EpiBf16, PvOrder>(lds, pg8::Gemm{256, 256, 256}, S, E);
        SEAM(12);
    }
    if (IN(13)) {
        pg8::StaticOrder S; S.init(ws + WS_OC, ws + WS_WO, M, D, D, D, c.G, bx);
        pg8::EpiResLn E{(float*)(ws + WS_T2), (const float*)(ws + WS_T1), (const f32x2*)(ws + WS_ST1), p.in[I_LN1G], p.in[I_LN1B], DN_ALPHA};
        pg8::gemm_phase<pg8::EpiResLn, pg8::StaticOrder>(lds, pg8::Gemm{D, D, D}, S, E);
        SEAM(13);
    }
    if (IN(14)) { ln_rows(c, (const float*)(ws + WS_T2), p.in[I_LN2G], p.in[I_LN2B], nullptr, (f32x2*)(ws + WS_ST2), ws + WS_X2B); SEAM(14); }
    if (IN(15)) { p15_router(p, c); SEAM(15); }

    if (IN(16)) {
        moe_table(c, tab);
        MoeOrder<true, 16> S{tab, (const char*)(ws + WS_X2B), (const char*)(ws + WS_W1), (const int*)(ws + WS_LIST), (size_t)4096 * D, D, c.G, bx};
        pg8::EpiSwiglu E{p.in[I_B1], (bf16_t*)(ws + WS_H)};
        pg8::gemm_phase<pg8::EpiSwiglu, MoeOrder<true, 16>, true, true>(lds, pg8::Gemm{D, D, D}, S, E);
        SEAM(16);
    }
    if (IN(17)) {
        moe_table(c, tab);
        MoeOrder<false, 8> S{tab, (const char*)(ws + WS_H), (const char*)(ws + WS_W2), (const int*)(ws + WS_LIST), (size_t)D * DFF, DFF, c.G, bx};
        pg8::EpiBf16Bias E{(bf16_t*)(ws + WS_Y), D, p.in[I_B2], D};
        pg8::gemm_phase<pg8::EpiBf16Bias, MoeOrder<false, 8>, true, true>(lds, pg8::Gemm{DFF, DFF, DFF}, S, E);
        SEAM(17);
    }
    if (IN(18)) { moe_table(c, tab); p18_combine(p, c, tab); }
#undef IN
#undef SEAM
}

extern "C" void kernel_launch(void* const* d_in, const int* in_sizes, int n_in, void* d_out, int out_size, void* d_ws, size_t ws_size, hipStream_t stream) {
    static int grid = 0;
    if (grid == 0) {
        if (n_in != 32 || out_size != M * D || ws_size < WS_END) { fprintf(stderr, "kernel_launch: expected 32 inputs, %d outputs, >= %zu bytes of workspace; got %d, %d, %zu\n", M * D, (size_t)WS_END, n_in, out_size, ws_size); grid = -1; return; }
        int dev = 0, cus = 0, per_cu = 0;
        if (hipGetDevice(&dev) != hipSuccess || hipDeviceGetAttribute(&cus, hipDeviceAttributeMultiprocessorCount, dev) != hipSuccess) { grid = -1; return; }
        if (hipFuncSetAttribute((const void*)fwd, hipFuncAttributeMaxDynamicSharedMemorySize, LDS_BYTES) != hipSuccess) { fprintf(stderr, "kernel_launch: hipFuncSetAttribute failed\n"); grid = -1; return; }
        if (hipOccupancyMaxActiveBlocksPerMultiprocessor(&per_cu, (const void*)fwd, 512, LDS_BYTES) != hipSuccess || per_cu < 1) fprintf(stderr, "kernel_launch: occupancy query reports %d\n", per_cu);
        (void)hipGetLastError();
        grid = cus;
        if (grid != 256) fprintf(stderr, "kernel_launch: %d CUs; this kernel is built for 256\n", grid);
    }
    if (grid < 0) return;
    (void)hipMemsetAsync((char*)d_ws + WS_CTL, 0, CTL_ZERO_BYTES, stream);
    Params p{};
    for (int i = 0; i < 32; ++i) p.in[i] = (const float*)d_in[i];
    p.out = (float*)d_out; p.ws = (unsigned char*)d_ws;
#if defined(TIMING_REPEAT_LO)
    { const int cuts[4][2] = {{0, TIMING_REPEAT_HI}, {TIMING_REPEAT_LO, TIMING_REPEAT_HI}, {TIMING_REPEAT_HI, NPHASE}, {0, 0}};
      for (int li = 0; li < 3; ++li) { if (cuts[li][0] >= cuts[li][1]) continue; p.ph_lo = cuts[li][0]; p.ph_hi = cuts[li][1]; p.li = li; hipLaunchKernelGGL(fwd, dim3(grid), dim3(512), LDS_BYTES, stream, p); } }
#else
    if (N_LAUNCH_MODE == 1) { p.ph_lo = 0; p.ph_hi = NPHASE; hipLaunchKernelGGL(fwd, dim3(grid), dim3(512), LDS_BYTES, stream, p); }
    else for (int k = 0; k < NPHASE; ++k) { p.ph_lo = k; p.ph_hi = k + 1; hipLaunchKernelGGL(fwd, dim3(grid), dim3(512), LDS_BYTES, stream, p); }
#endif
}
```

```cpp
#include <hip/hip_runtime.h>
#include <cstdio>
#include <cstdint>

#define LAS __attribute__((address_space(3)))
#define GAS __attribute__((address_space(1)))
typedef unsigned short bf16_t;
typedef short bf16x8 __attribute__((ext_vector_type(8)));
typedef float f32x4 __attribute__((ext_vector_type(4)));
typedef float f32x2 __attribute__((ext_vector_type(2)));
typedef float f32x16 __attribute__((ext_vector_type(16)));
typedef unsigned u32x4 __attribute__((ext_vector_type(4)));
typedef unsigned u32x2 __attribute__((ext_vector_type(2)));

#ifndef N_LAUNCH_MODE
#define N_LAUNCH_MODE 1
#endif

constexpr int M = 16384, D = 2048, SEQ = 4096, NBATCH = 4;
constexpr int RWC = 6592;
constexpr int PC = 15360;
constexpr int ATTV2 = 6656, ATT0 = 7168, GATE0 = 11264;
constexpr int NEXP = 32, DFF = 2048, CAP = 16384;
constexpr int HROWS = 65536 + 32 * 256;
constexpr float LN_EPS = 1e-5f, GN_EPS = 64e-5f;
constexpr float DN_ALPHA = 1.189207115002721f;

__device__ __forceinline__ float bf2f(unsigned v) { return __uint_as_float(v << 16); }
typedef __bf16 bf16x2_t __attribute__((ext_vector_type(2)));
__device__ __forceinline__ unsigned pk2(float lo, float hi) { const bf16x2_t r = __builtin_convertvector((f32x2){lo, hi}, bf16x2_t); return __builtin_bit_cast(unsigned, r); }
__device__ __forceinline__ unsigned f2bf(float f) { return pk2(f, 0.f) & 0xffffu; }
typedef int v4i __attribute__((ext_vector_type(4)));
typedef int v8i __attribute__((ext_vector_type(8)));
__device__ __forceinline__ unsigned pk4_fp8(float a, float b, float c, float d) { int r = __builtin_amdgcn_cvt_pk_fp8_f32(a, b, 0, false); r = __builtin_amdgcn_cvt_pk_fp8_f32(c, d, r, true); return (unsigned)r; }
__device__ __forceinline__ float sigmoidf_(float x) { return __builtin_amdgcn_rcpf(1.0f + __expf(-x)); }
__device__ __forceinline__ float wave_sum(float v) {
#pragma unroll
    for (int o = 1; o < 64; o <<= 1) v += __shfl_xor(v, o);
    return v;
}
#define LDS_WAIT() asm volatile("s_waitcnt lgkmcnt(0)" ::: "memory")
#define VM_WAIT() asm volatile("s_waitcnt vmcnt(0)" ::: "memory")

namespace pg8 {
#define PG8_LAS __attribute__((address_space(3)))
constexpr int BM = 256, BK = 64, HALF = 128, HTB = HALF * BK * 2, STAGE_BYTES = 8 * HTB, NXCD = 8, WGM = 8;

__host__ __device__ __forceinline__ int lds_byte(int r, int c) { const int st = (r >> 4) * 2 + (c >> 5), rr = r & 15, cc = c & 31, ob = rr * 64 + cc * 2; return st * 1024 + (ob ^ (((ob >> 9) & 1) << 5)); }
__host__ __device__ __forceinline__ void stage_rc(int b, int& R, int& C) { const int st = b / 1024, sb = b % 1024, swz = sb ^ (((sb >> 9) & 1) << 5); R = (st >> 1) * 16 + swz / 64; C = (st & 1) * 32 + (swz % 64) / 2; }
__host__ __device__ __forceinline__ int perm32(int rho) { const int n = rho >> 4, i = rho & 15; return 8 * (i >> 2) + 4 * n + (i & 3); }

struct Unit { const char* A; const char* B; int orow, ocol, aux, aux2, valid; };
struct Gemm { int K, lda, ldb; };

struct StaticOrder {
    static constexpr bool GATHER = false;
    const char* A; const char* Bt; size_t ta, tb;
    int nM, nN, nwg, G, c;
    __device__ void init(const void* A_, const void* Bt_, int M_, int N_, int lda, int ldb, int G_, int c_, int esz = 2) { A = (const char*)A_; Bt = (const char*)Bt_; ta = (size_t)BM * lda * esz; tb = (size_t)BM * ldb * esz; nM = M_ / BM; nN = N_ / BM; nwg = nM * nN; G = G_; c = c_; }
    __device__ bool next(int i, Unit& u) const {
        const long L = (long)i * G + c; if (c < 0 || L >= nwg) return false;
        int wgid = (int)L; { const int q = nwg / NXCD, r = nwg % NXCD, xcd = wgid % NXCD, off = wgid / NXCD; wgid = (xcd < r ? xcd * (q + 1) : r * (q + 1) + (xcd - r) * q) + off; }
        const int nig = WGM * nN, gid = wgid / nig, fm = gid * WGM, gsz = (nM - fm) < WGM ? (nM - fm) : WGM;
        const int pm = fm + ((wgid % nig) % gsz), pn = (wgid % nig) / gsz;
        u.A = A + (size_t)pm * ta; u.B = Bt + (size_t)pn * tb; u.orow = pm * BM; u.ocol = pn * BM; u.aux = 0; u.aux2 = 0; u.valid = BM; return true;
    }
    __device__ __forceinline__ const int* rows(const Unit&) const { return nullptr; }
};

__device__ __forceinline__ unsigned cvt_pk_bf16(float lo, float hi) { return ::pk2(lo, hi); }

template <class Epi, class Sched, bool ALIGN_EPI = true, bool FP8 = false>
__device__ __forceinline__ void gemm_phase(PG8_LAS unsigned char* lds, const Gemm g, const Sched& S, const Epi& E) {
    const int tid = threadIdx.x, wid = __builtin_amdgcn_readfirstlane(tid >> 6), lane = tid & 63, wr = wid >> 2, wc = wid & 3, fr = lane & 15, fq = lane >> 4;
    constexpr int ES = FP8 ? 1 : 2;
    int sclW = 0, sclX = 0;
    if constexpr (FP8) { asm volatile("v_mov_b32 %0, 0x79797979\n\tv_mov_b32 %1, 0x7f7f7f7f" : "=v"(sclW), "=v"(sclX)); }
    const int K = g.K, nt = K * ES / (BK * 2);
    unsigned voffA[2], voffB[2]; int Rr[2], Cc[2];
#pragma unroll
    for (int i = 0; i < 2; ++i) { int R, C; stage_rc(tid * 16 + i * 8192, R, C); const int Rb = Epi::PERM ? ((R & ~31) + perm32(R & 31)) : R; Rr[i] = R; Cc[i] = C;
        voffA[i] = (unsigned)(R * g.lda * ES + C * 2); voffB[i] = (unsigned)(Rb * g.ldb * ES + C * 2); }
    const size_t kstep = (size_t)(BK * 2);
    const size_t hstepA = (size_t)HALF * g.lda * ES, hstepB = (size_t)HALF * g.ldb * ES;
    const unsigned ldsw = (unsigned)wid * 1024u;
    const int aoff = lds_byte(wr * 64 + fr, fq * 8), boff = lds_byte(wc * 32 + fr, fq * 8);
    unsigned vAc[2][2], vAn[2][2];
#define PG8_SA(b, h) (((b) * 2 + (h)) * HTB)
#define PG8_SB(b, h) ((4 + (b) * 2 + (h)) * HTB)
#define PG8_STAGE(bufoff, gbase, voff) do { _Pragma("unroll") for (int _i = 0; _i < 2; ++_i) \
        __builtin_amdgcn_global_load_lds((const unsigned*)((const char*)(gbase) + (voff)[_i]), (PG8_LAS unsigned*)(lds + (bufoff) + ldsw + _i * 8192), 16, 0, 0); } while (0)
#define PG8_STAGE_A(bufoff, kbase, h, nx) do { if constexpr (Sched::GATHER) { unsigned _v[2] = {(nx) ? vAn[h][0] : vAc[h][0], (nx) ? vAn[h][1] : vAc[h][1]}; PG8_STAGE(bufoff, kbase, _v); } \
        else { PG8_STAGE(bufoff, (kbase) + (h) * hstepA, voffA); } } while (0)
#define PG8_GOFF(u, v) do { const int* _rw = S.rows(u); _Pragma("unroll") for (int _h = 0; _h < 2; ++_h) _Pragma("unroll") for (int _i = 0; _i < 2; ++_i) { const int _r = Rr[_i] + _h * HALF; \
        const int _tk = _r < (u).valid ? _rw[_r] : 0; v[_h][_i] = (unsigned)(_tk * g.lda * ES + Cc[_i] * 2); } } while (0)
#define PG8_LDA(dst, b, h) do { _Pragma("unroll") for (int m = 0; m < 4; ++m) _Pragma("unroll") for (int k = 0; k < 2; ++k) dst[m][k] = *(const PG8_LAS bf16x8*)(lds + PG8_SA(b, h) + aoff + m * 2048 + k * 1024); } while (0)
#define PG8_LDB(dst, b, h) do { _Pragma("unroll") for (int n = 0; n < 2; ++n) _Pragma("unroll") for (int k = 0; k < 2; ++k) dst[n][k] = *(const PG8_LAS bf16x8*)(lds + PG8_SB(b, h) + boff + n * 2048 + k * 1024); } while (0)
#define PG8_MMA(ai, bj, At, Bt) do { __builtin_amdgcn_s_setprio(1); _Pragma("unroll") for (int m = 0; m < 4; ++m) _Pragma("unroll") for (int n = 0; n < 2; ++n) { \
        if constexpr (FP8) { const v4i _b0 = __builtin_bit_cast(v4i, Bt[n][0]), _b1 = __builtin_bit_cast(v4i, Bt[n][1]), _a0 = __builtin_bit_cast(v4i, At[m][0]), _a1 = __builtin_bit_cast(v4i, At[m][1]); \
            const v8i _bb = __builtin_shufflevector(_b0, _b1, 0, 1, 2, 3, 4, 5, 6, 7), _aa = __builtin_shufflevector(_a0, _a1, 0, 1, 2, 3, 4, 5, 6, 7); \
            asm volatile("v_mfma_scale_f32_16x16x128_f8f6f4 %0, %1, %2, %0, %3, %4 op_sel_hi:[0,0,0]" : "+v"(acc[ai][bj][m][n]) : "v"(_bb), "v"(_aa), "v"(sclW), "v"(sclX)); } \
        else { _Pragma("unroll") for (int k = 0; k < 2; ++k) acc[ai][bj][m][n] = __builtin_amdgcn_mfma_f32_16x16x32_bf16(Bt[n][k], At[m][k], acc[ai][bj][m][n], 0, 0, 0); } } \
        __builtin_amdgcn_s_setprio(0); } while (0)
#define PG8_WAIT_V(n) asm volatile("s_waitcnt vmcnt(" #n ")" ::: "memory")
#define PG8_WAIT_L(n) asm volatile("s_waitcnt lgkmcnt(" #n ")" ::: "memory")
#define PG8_BAR __builtin_amdgcn_s_barrier()
#define PG8_SCHED __builtin_amdgcn_sched_barrier(0)
    Unit cur, nxt; int ui = 0;
    if (!S.next(0, cur)) return;
    f32x4 acc[2][2][4][2];
#pragma unroll
    for (int a = 0; a < 2; ++a)
#pragma unroll
        for (int b = 0; b < 2; ++b)
#pragma unroll
            for (int m = 0; m < 4; ++m)
#pragma unroll
                for (int n = 0; n < 2; ++n) acc[a][b][m][n] = (f32x4){0.f, 0.f, 0.f, 0.f};
    bf16x8 At[4][2], B0[2][2], B1[2][2];
    const char* cA = cur.A; const char* cB = cur.B;
    if constexpr (Sched::GATHER) { PG8_GOFF(cur, vAc); PG8_WAIT_V(0); }
    PG8_STAGE(PG8_SB(0, 0), cB, voffB); PG8_STAGE(PG8_SB(0, 1), cB + hstepB, voffB); PG8_STAGE_A(PG8_SA(0, 0), cA, 0, false); PG8_STAGE_A(PG8_SA(0, 1), cA, 1, false);
    if (wr == 1) PG8_BAR;
    PG8_WAIT_V(2); PG8_BAR;
    PG8_STAGE(PG8_SB(1, 0), cB + kstep, voffB); PG8_STAGE_A(PG8_SA(1, 0), cA + kstep, 0, false); PG8_STAGE(PG8_SB(1, 1), cB + hstepB + kstep, voffB);
    PG8_WAIT_V(6); PG8_BAR;
    for (;;) {
        const bool has_next = S.next(ui + 1, nxt);
        const char* nA = has_next ? nxt.A : cA; const char* nB = has_next ? nxt.B : cB;
        if constexpr (Sched::GATHER) { if (has_next) { PG8_GOFF(nxt, vAn); } else {
#pragma unroll
            for (int h = 0; h < 2; ++h)
#pragma unroll
                for (int i = 0; i < 2; ++i) vAn[h][i] = vAc[h][i]; } }
#pragma nounroll
        for (int t = 0; t < nt; t += 2) {
            const bool last = (t == nt - 2);
            if constexpr (Epi::MID_T >= 0) { if (t == Epi::MID_T) { int l3 = lane; asm volatile("" : "+v"(l3)); E.mid(acc, cur, wr, wc, l3 & 15, l3 >> 4); } }
            const char* a1 = cA + (size_t)(t + 1) * kstep;
            const char* a2 = last ? nA : cA + (size_t)(t + 2) * kstep; const char* b2 = last ? nB : cB + (size_t)(t + 2) * kstep;
            const char* a3 = a2 + kstep; const char* b3 = b2 + kstep;
            PG8_LDB(B0, 0, 0); PG8_LDB(B1, 0, 1); PG8_SCHED; PG8_LDA(At, 0, 0); PG8_STAGE_A(PG8_SA(1, 1), a1, 1, false);
            PG8_WAIT_V(8); PG8_WAIT_L(0); PG8_BAR; PG8_MMA(0, 0, At, B0); PG8_MMA(0, 1, At, B1); PG8_BAR; PG8_SCHED;
            PG8_LDA(At, 0, 1); PG8_STAGE(PG8_SB(0, 0), b2, voffB); PG8_STAGE(PG8_SB(0, 1), b2 + hstepB, voffB); PG8_STAGE_A(PG8_SA(0, 0), a2, 0, last);
            PG8_WAIT_V(8); PG8_WAIT_L(0); PG8_BAR; PG8_MMA(1, 0, At, B0); PG8_MMA(1, 1, At, B1); PG8_BAR; PG8_SCHED;
            PG8_LDB(B0, 1, 0); PG8_LDB(B1, 1, 1); PG8_SCHED; PG8_LDA(At, 1, 0); PG8_STAGE_A(PG8_SA(0, 1), a2, 1, last);
            PG8_WAIT_V(8); PG8_WAIT_L(0); PG8_BAR; PG8_MMA(0, 0, At, B0); PG8_MMA(0, 1, At, B1); PG8_BAR; PG8_SCHED;
            PG8_LDA(At, 1, 1); PG8_STAGE(PG8_SB(1, 0), b3, voffB); PG8_STAGE(PG8_SB(1, 1), b3 + hstepB, voffB); PG8_STAGE_A(PG8_SA(1, 0), a3, 0, last);
            PG8_WAIT_V(8); PG8_WAIT_L(0); PG8_BAR; PG8_MMA(1, 0, At, B0); PG8_MMA(1, 1, At, B1); PG8_BAR; PG8_SCHED;
        }
        if constexpr (ALIGN_EPI) { if (wr == 0) PG8_BAR; }
        if constexpr (FP8) asm volatile("s_nop 15\n\ts_nop 15" ::: "memory");
        if constexpr (!Epi::AFTER_DRAIN) { int l2 = lane; asm volatile("" : "+v"(l2));
            E(acc, cur, wr, wc, l2 & 15, l2 >> 4); }
        if (!has_next) break;
#pragma unroll
        for (int a = 0; a < 2; ++a)
#pragma unroll
            for (int b = 0; b < 2; ++b)
#pragma unroll
                for (int m = 0; m < 4; ++m)
#pragma unroll
                    for (int n = 0; n < 2; ++n) acc[a][b][m][n] = (f32x4){0.f, 0.f, 0.f, 0.f};
        cur = nxt; cA = nA; cB = nB; ++ui;
        if constexpr (Sched::GATHER) {
#pragma unroll
            for (int h = 0; h < 2; ++h)
#pragma unroll
                for (int i = 0; i < 2; ++i) vAc[h][i] = vAn[h][i]; }
        if constexpr (ALIGN_EPI) { if (wr == 1) PG8_BAR; }
    }
    PG8_WAIT_V(0);
    if constexpr (!ALIGN_EPI) { if (wr == 0) PG8_BAR; }
    PG8_BAR;
    if constexpr (Epi::AFTER_DRAIN) { E.fused(acc, cur, wr, wc, fr, fq, lds, wid, lane); }
#undef PG8_SA
#undef PG8_SB
#undef PG8_STAGE
#undef PG8_STAGE_A
#undef PG8_GOFF
#undef PG8_LDA
#undef PG8_LDB
#undef PG8_MMA
#undef PG8_WAIT_V
#undef PG8_WAIT_L
#undef PG8_BAR
#undef PG8_SCHED
}

#define EPI_LOOP_AI_M for (int ai = 0; ai < 2; ++ai) _Pragma("unroll") for (int m = 0; m < 4; ++m)

struct EpiF32 {
    static constexpr bool PERM = false, AFTER_DRAIN = false; static constexpr int MID_T = -1;
    float* C; int ldc; const float* bias; int bstride; const float* res; float alpha;
    __device__ __forceinline__ void operator()(const f32x4 (&acc)[2][2][4][2], const Unit& u, int wr, int wc, int fr, int fq) const {
        const int row0 = u.orow + wr * 64 + fr, col0 = u.ocol + wc * 32 + 4 * fq;
        f32x4 bv[2][2];
#pragma unroll
        for (int bj = 0; bj < 2; ++bj)
#pragma unroll
            for (int n = 0; n < 2; ++n) bv[bj][n] = bias ? *(const f32x4*)(bias + (size_t)u.aux * bstride + col0 + bj * HALF + n * 16) : (f32x4){0.f, 0.f, 0.f, 0.f};
#pragma unroll
        EPI_LOOP_AI_M { const size_t off = (size_t)(row0 + ai * HALF + m * 16) * ldc + col0;
#pragma unroll
            for (int bj = 0; bj < 2; ++bj)
#pragma unroll
                for (int n = 0; n < 2; ++n) { f32x4 v = acc[ai][bj][m][n] + bv[bj][n];
                    if (res) { const f32x4 rv = *(const f32x4*)(res + off + bj * HALF + n * 16); v = v + rv * alpha; }
                    *(f32x4*)(C + off + bj * HALF + n * 16) = v; }
            asm volatile("" ::: "memory"); }
    }
};
struct EpiResLn {
    static constexpr bool PERM = false, AFTER_DRAIN = false; static constexpr int MID_T = -1;
    float* C; const float* T; const f32x2* stats; const float* gam; const float* bet; float alpha;
    __device__ __forceinline__ void operator()(const f32x4 (&acc)[2][2][4][2], const Unit& u, int wr, int wc, int fr, int fq) const {
        const int row0 = u.orow + wr * 64 + fr, col0 = u.ocol + wc * 32 + 4 * fq;
        f32x4 gv[2][2], bv[2][2];
#pragma unroll
        for (int bj = 0; bj < 2; ++bj)
#pragma unroll
            for (int n = 0; n < 2; ++n) { gv[bj][n] = *(const f32x4*)(gam + col0 + bj * HALF + n * 16) * alpha; bv[bj][n] = *(const f32x4*)(bet + col0 + bj * HALF + n * 16) * alpha; }
#pragma unroll
        EPI_LOOP_AI_M { const int row = row0 + ai * HALF + m * 16; const size_t off = (size_t)row * D + col0; const f32x2 st = stats[row];
#pragma unroll
            for (int bj = 0; bj < 2; ++bj)
#pragma unroll
                for (int n = 0; n < 2; ++n) { const f32x4 tv = *(const f32x4*)(T + off + bj * HALF + n * 16);
                    *(f32x4*)(C + off + bj * HALF + n * 16) = acc[ai][bj][m][n] + ((tv - st.x) * st.y) * gv[bj][n] + bv[bj][n]; }
            asm volatile("" ::: "memory"); }
    }
};
struct EpiBf16 {
    static constexpr bool PERM = true, AFTER_DRAIN = false; static constexpr int MID_T = -1;
    bf16_t* O; int ldc; float scale;
    __device__ __forceinline__ void operator()(const f32x4 (&acc)[2][2][4][2], const Unit& u, int wr, int wc, int fr, int fq) const {
        const int row0 = u.orow + wr * 64 + fr, col0 = u.ocol + wc * 32 + 8 * fq;
#pragma unroll
        EPI_LOOP_AI_M { bf16_t* rowp = O + (size_t)(row0 + ai * HALF + m * 16) * ldc + col0;
#pragma unroll
            for (int bj = 0; bj < 2; ++bj) { const f32x4 v0 = acc[ai][bj][m][0] * scale, v1 = acc[ai][bj][m][1] * scale;
                u32x4 w; w.x = cvt_pk_bf16(v0[0], v0[1]); w.y = cvt_pk_bf16(v0[2], v0[3]); w.z = cvt_pk_bf16(v1[0], v1[1]); w.w = cvt_pk_bf16(v1[2], v1[3]);
                *(u32x4*)(rowp + bj * HALF) = w; } }
    }
};
struct EpiBf16Bias {
    static constexpr bool PERM = true, AFTER_DRAIN = false; static constexpr int MID_T = -1;
    bf16_t* O; int ldc; const float* bias; int bstride;
    __device__ __forceinline__ void operator()(const f32x4 (&acc)[2][2][4][2], const Unit& u, int wr, int wc, int fr, int fq) const {
        const int row0 = u.orow + wr * 64 + fr, col0 = u.ocol + wc * 32 + 8 * fq;
        f32x4 bv[2][2];
#pragma unroll
        for (int bj = 0; bj < 2; ++bj)
#pragma unroll
            for (int n = 0; n < 2; ++n) bv[bj][n] = *(const f32x4*)(bias + (size_t)u.aux * bstride + col0 + bj * HALF + 4 * n);
#pragma unroll
        EPI_LOOP_AI_M { bf16_t* rowp = O + (size_t)(row0 + ai * HALF + m * 16) * ldc + col0;
#pragma unroll
            for (int bj = 0; bj < 2; ++bj) { const f32x4 v0 = acc[ai][bj][m][0] + bv[bj][0], v1 = acc[ai][bj][m][1] + bv[bj][1];
                u32x4 w; w.x = cvt_pk_bf16(v0[0], v0[1]); w.y = cvt_pk_bf16(v0[2], v0[3]); w.z = cvt_pk_bf16(v1[0], v1[1]); w.w = cvt_pk_bf16(v1[2], v1[3]);
                *(u32x4*)(rowp + bj * HALF) = w; } }
    }
};
struct EpiKV {
    static constexpr bool PERM = true, AFTER_DRAIN = false; static constexpr int MID_T = -1;
    bf16_t* KB; bf16_t* VT;
    __device__ __forceinline__ void operator()(const f32x4 (&acc)[2][2][4][2], const Unit& u, int wr, int wc, int fr, int fq) const {
        const int row0 = u.orow + wr * 64 + fr, col0 = u.ocol + wc * 32 + 8 * fq;
#pragma unroll
        EPI_LOOP_AI_M { const int row = row0 + ai * HALF + m * 16;
#pragma unroll
            for (int bj = 0; bj < 2; ++bj) { const f32x4 v0 = acc[ai][bj][m][0], v1 = acc[ai][bj][m][1]; const int col = col0 + bj * HALF;
                if (u.ocol < 2048) { u32x4 w; w.x = cvt_pk_bf16(v0[0], v0[1]); w.y = cvt_pk_bf16(v0[2], v0[3]); w.z = cvt_pk_bf16(v1[0], v1[1]); w.w = cvt_pk_bf16(v1[2], v1[3]);
                    *(u32x4*)(KB + (size_t)row * 2048 + col) = w; }
                else { const int b = row >> 8, key = row & 255, c = col - 2048, h = c >> 9, d = c & 511; bf16_t* p = VT + ((size_t)((b * 4 + h) * 512 + d)) * 256 + key;
#pragma unroll
                    for (int j = 0; j < 4; ++j) { p[(size_t)j * 256] = (bf16_t)f2bf(v0[j]); p[(size_t)(4 + j) * 256] = (bf16_t)f2bf(v1[j]); } } } }
    }
};
struct EpiDecay {
    static constexpr bool PERM = true, AFTER_DRAIN = false; static constexpr int MID_T = -1;
    bf16_t* LD; const float* w0;
    __device__ __forceinline__ void operator()(const f32x4 (&acc)[2][2][4][2], const Unit& u, int wr, int wc, int fr, int fq) const {
        const int row0 = u.orow + wr * 64 + fr, col0 = u.ocol + wc * 32 + 8 * fq;
#pragma unroll
        for (int bj = 0; bj < 2; ++bj) { const int col = col0 + bj * HALF; const f32x4 w00 = *(const f32x4*)(w0 + col), w01 = *(const f32x4*)(w0 + col + 4);
#pragma unroll
            EPI_LOOP_AI_M { const f32x4 x0 = acc[ai][bj][m][0] + w00, x1 = acc[ai][bj][m][1] + w01; float o[8];
#pragma unroll
                for (int j = 0; j < 4; ++j) { o[j] = -0.6065306597126334f * sigmoidf_(x0[j]); o[4 + j] = -0.6065306597126334f * sigmoidf_(x1[j]); }
                *(u32x4*)(LD + (size_t)(row0 + ai * HALF + m * 16) * D + col) = (u32x4){cvt_pk_bf16(o[0], o[1]), cvt_pk_bf16(o[2], o[3]), cvt_pk_bf16(o[4], o[5]), cvt_pk_bf16(o[6], o[7])}; } }
    }
};
struct EpiIclr {
    static constexpr bool PERM = true, AFTER_DRAIN = false; static constexpr int MID_T = -1;
    const float* a0; bf16_t* AL;
    __device__ __forceinline__ void operator()(const f32x4 (&acc)[2][2][4][2], const Unit& u, int wr, int wc, int fr, int fq) const {
        const int row0 = u.orow + wr * 64 + fr, col0 = u.ocol + wc * 32 + 8 * fq;
#pragma unroll
        for (int bj = 0; bj < 2; ++bj) { const int col = col0 + bj * HALF; const f32x4 a00 = *(const f32x4*)(a0 + col), a01 = *(const f32x4*)(a0 + col + 4);
#pragma unroll
            EPI_LOOP_AI_M { const f32x4 x0 = acc[ai][bj][m][0] + a00, x1 = acc[ai][bj][m][1] + a01;
                *(u32x4*)(AL + (size_t)(row0 + ai * HALF + m * 16) * D + col) = (u32x4){cvt_pk_bf16(sigmoidf_(x0[0]), sigmoidf_(x0[1])), cvt_pk_bf16(sigmoidf_(x0[2]), sigmoidf_(x0[3])),
                    cvt_pk_bf16(sigmoidf_(x1[0]), sigmoidf_(x1[1])), cvt_pk_bf16(sigmoidf_(x1[2]), sigmoidf_(x1[3]))}; } }
    }
};
struct EpiGateFused {
    static constexpr bool PERM = true, AFTER_DRAIN = false; static constexpr int MID_T = 32;
    const bf16_t* PROJ; bf16_t* MERGED;
    __device__ __forceinline__ void mid(f32x4 (&acc)[2][2][4][2], const Unit& u, int wr, int wc, int fr, int fq) const {
        const int row0 = u.orow + wr * 64 + fr, col0 = u.ocol + wc * 32 + 8 * fq;
#pragma unroll
        EPI_LOOP_AI_M { const int row = row0 + ai * HALF + m * 16;
#pragma unroll
            for (int bj = 0; bj < 2; ++bj) { const int col = col0 + bj * HALF;
                const u32x4 g1v = *(const u32x4*)(PROJ + (size_t)row * PC + GATE0 + col), g2v = *(const u32x4*)(PROJ + (size_t)row * PC + GATE0 + 2048 + col);
                const unsigned w1[4] = {g1v.x, g1v.y, g1v.z, g1v.w}, w2[4] = {g2v.x, g2v.y, g2v.z, g2v.w};
#pragma unroll
                for (int j = 0; j < 8; ++j) { const float x1 = bf2f((w1[j >> 1] >> (16 * (j & 1))) & 0xffffu), x2 = fmaxf(bf2f((w2[j >> 1] >> (16 * (j & 1))) & 0xffffu), -60.0f);
                    const float ratio = (1.0f + __expf(-x2)) * __builtin_amdgcn_rcpf(1.0f + __expf(-x1));
                    if (j < 4) acc[ai][bj][m][0][j & 3] *= ratio; else acc[ai][bj][m][1][j & 3] *= ratio; } }
            asm volatile("" ::: "memory"); }
    }
    __device__ __forceinline__ void operator()(const f32x4 (&acc)[2][2][4][2], const Unit& u, int wr, int wc, int fr, int fq) const {
        const int row0 = u.orow + wr * 64 + fr, col0 = u.ocol + wc * 32 + 8 * fq;
#pragma unroll
        EPI_LOOP_AI_M { const int row = row0 + ai * HALF + m * 16;
#pragma unroll
            for (int bj = 0; bj < 2; ++bj) { const int col = col0 + bj * HALF; const u32x4 gv = *(const u32x4*)(PROJ + (size_t)row * PC + GATE0 + 2048 + col);
                const unsigned w2[4] = {gv.x, gv.y, gv.z, gv.w}; float o[8];
#pragma unroll
                for (int j = 0; j < 8; ++j) { const float x2 = fmaxf(bf2f((w2[j >> 1] >> (16 * (j & 1))) & 0xffffu), -60.0f); o[j] = (j < 4 ? acc[ai][bj][m][0][j & 3] : acc[ai][bj][m][1][j & 3]) * sigmoidf_(x2); }
                u32x4 w; w.x = cvt_pk_bf16(o[0], o[1]); w.y = cvt_pk_bf16(o[2], o[3]); w.z = cvt_pk_bf16(o[4], o[5]); w.w = cvt_pk_bf16(o[6], o[7]);
                *(u32x4*)(MERGED + (size_t)row * D + col) = w; }
            asm volatile("" ::: "memory"); }
    }
};
struct EpiSwiglu {
    static constexpr bool PERM = true, AFTER_DRAIN = false; static constexpr int MID_T = -1;
    const float* b1; bf16_t* H;
    __device__ __forceinline__ float sw(float g, float l) const { g = fminf(g, 7.0f); l = fminf(fmaxf(l, -7.0f), 7.0f); return g * sigmoidf_(1.702f * g) * (l + 1.0f); }
    __device__ __forceinline__ void operator()(const f32x4 (&acc)[2][2][4][2], const Unit& u, int wr, int wc, int fr, int fq) const {
        const int row0 = u.orow + wr * 64 + fr, col0 = u.ocol + wc * 32 + 8 * fq;
        f32x4 bv[2][2];
#pragma unroll
        for (int bj = 0; bj < 2; ++bj)
#pragma unroll
            for (int n = 0; n < 2; ++n) bv[bj][n] = *(const f32x4*)(b1 + (size_t)u.aux * 4096 + col0 + bj * HALF + 4 * n);
#pragma unroll
        EPI_LOOP_AI_M { const int row = row0 + ai * HALF + m * 16;
#pragma unroll
            for (int bj = 0; bj < 2; ++bj) { const f32x4 v0 = acc[ai][bj][m][0] + bv[bj][0], v1 = acc[ai][bj][m][1] + bv[bj][1];
                *(unsigned*)((unsigned char*)H + (size_t)row * DFF + ((col0 + bj * HALF) >> 1)) = pk4_fp8(sw(v0[0], v0[1]), sw(v0[2], v0[3]), sw(v1[0], v1[1]), sw(v1[2], v1[3])); } }
    }
};
struct EpiSoftmax {
    static constexpr bool PERM = true, AFTER_DRAIN = true; static constexpr int MID_T = -1;
    bf16_t* PP;
    __device__ __forceinline__ void fused(f32x4 (&acc)[2][2][4][2], const Unit& u, int wr, int wc, int fr, int fq, PG8_LAS unsigned char* lds, int wid, int lane) const {
        PG8_LAS float* P1 = (PG8_LAS float*)lds;
        PG8_LAS float* P2 = (PG8_LAS float*)(lds + 4096);
        float mx[2][4];
#pragma unroll
        EPI_LOOP_AI_M { float v = -3.0e38f;
#pragma unroll
            for (int bj = 0; bj < 2; ++bj)
#pragma unroll
                for (int n = 0; n < 2; ++n) { const f32x4 x = acc[ai][bj][m][n]; v = fmaxf(v, fmaxf(fmaxf(x[0], x[1]), fmaxf(x[2], x[3]))); }
            v = fmaxf(v, __shfl_xor(v, 16)); v = fmaxf(v, __shfl_xor(v, 32));
            if (fq == 0) P1[(ai * HALF + wr * 64 + m * 16 + fr) * 4 + wc] = v; }
        asm volatile("s_waitcnt lgkmcnt(0)" ::: "memory"); __builtin_amdgcn_s_barrier(); asm volatile("" ::: "memory");
#pragma unroll
        EPI_LOOP_AI_M { const f32x4 t = *(const PG8_LAS f32x4*)(P1 + (ai * HALF + wr * 64 + m * 16 + fr) * 4); mx[ai][m] = fmaxf(fmaxf(t[0], t[1]), fmaxf(t[2], t[3])); }
#pragma unroll
        EPI_LOOP_AI_M { float s = 0.f;
#pragma unroll
            for (int bj = 0; bj < 2; ++bj)
#pragma unroll
                for (int n = 0; n < 2; ++n) { f32x4 x = acc[ai][bj][m][n];
#pragma unroll
                    for (int j = 0; j < 4; ++j) { x[j] = __expf(x[j] - mx[ai][m]); s += x[j]; }
                    acc[ai][bj][m][n] = x; }
            s += __shfl_xor(s, 16); s += __shfl_xor(s, 32);
            if (fq == 0) P2[(ai * HALF + wr * 64 + m * 16 + fr) * 4 + wc] = s; }
        asm volatile("s_waitcnt lgkmcnt(0)" ::: "memory"); __builtin_amdgcn_s_barrier(); asm volatile("" ::: "memory");
        const int row0 = u.orow + wr * 64 + fr, col0 = wc * 32 + 8 * fq;
#pragma unroll
        EPI_LOOP_AI_M { const f32x4 t = *(const PG8_LAS f32x4*)(P2 + (ai * HALF + wr * 64 + m * 16 + fr) * 4); const float inv = 1.0f / ((t[0] + t[1]) + (t[2] + t[3]));
            bf16_t* rowp = PP + (size_t)(row0 + ai * HALF + m * 16) * 256 + col0;
#pragma unroll
            for (int bj = 0; bj < 2; ++bj) { const f32x4 v0 = acc[ai][bj][m][0] * inv, v1 = acc[ai][bj][m][1] * inv;
                u32x4 w; w.x = cvt_pk_bf16(v0[0], v0[1]); w.y = cvt_pk_bf16(v0[2], v0[3]); w.z = cvt_pk_bf16(v1[0], v1[1]); w.w = cvt_pk_bf16(v1[2], v1[3]);
                *(u32x4*)(rowp + bj * HALF) = w; } }
        asm volatile("s_waitcnt lgkmcnt(0)" ::: "memory"); __builtin_amdgcn_s_barrier(); asm volatile("" ::: "memory");
    }
};
}

constexpr size_t MiB = 1u << 20;
constexpr size_t al256(size_t x) { return (x + 255) & ~(size_t)255; }
constexpr size_t WS_CTL = 0, CTL_ZERO_BYTES = 1 * MiB;
constexpr size_t WS_WIN = 1 * MiB;
constexpr size_t WS_WUP = WS_WIN + (size_t)PC * D * 2;
constexpr size_t WS_AUP = WS_WUP + (size_t)D * 256 * 2;
constexpr size_t WS_GUP = WS_AUP + (size_t)D * 256 * 2;
constexpr size_t WS_PA = WS_GUP + (size_t)D * 256 * 2;
constexpr size_t WS_PB = WS_PA + (size_t)D * D * 2;
constexpr size_t WS_WOUT = WS_PB + (size_t)D * 512 * 2;
constexpr size_t WS_WQ = WS_WOUT + (size_t)D * D * 2;
constexpr size_t WS_WKV = WS_WQ + (size_t)D * D * 2;
constexpr size_t WS_WO = WS_WKV + (size_t)2 * D * D * 2;
constexpr size_t WS_W1 = WS_WO + (size_t)D * D * 2;
constexpr size_t WS_W2 = WS_W1 + (size_t)NEXP * 4096 * D * 2;
constexpr size_t WS_XB = WS_W2 + (size_t)NEXP * D * DFF * 2;
constexpr size_t WS_MEMB = WS_XB + (size_t)M * D * 2;
constexpr size_t WS_ROT = WS_MEMB + (size_t)1024 * D * 2;
constexpr size_t WS_KB = WS_ROT + (size_t)2 * SEQ * 32 * 4;
constexpr size_t WS_VT = WS_KB + (size_t)1024 * D * 2;
constexpr size_t WS_YA = WS_VT + (size_t)1024 * D * 2;
constexpr size_t WS_YB = WS_YA + (size_t)M * D * 2;
constexpr size_t WS_TMP = WS_YB + (size_t)M * 512 * 2;
constexpr size_t WS_MERGED = WS_TMP + (size_t)M * D * 4;
constexpr size_t WS_E = WS_MERGED + (size_t)M * D * 2;
constexpr size_t WS_PROJ = WS_E;
constexpr size_t WS_RZ = WS_PROJ + (size_t)M * PC * 2;
constexpr size_t WS_KZ = WS_RZ + (size_t)M * D * 4;
constexpr size_t WS_VZ = WS_KZ + (size_t)M * D * 4;
constexpr size_t WS_DEC = WS_VZ + (size_t)M * D * 4;
constexpr size_t WS_KP = WS_DEC + (size_t)M * D * 4;
constexpr size_t WS_AN = WS_KP + (size_t)M * D * 4;
constexpr size_t WS_BB = WS_AN + (size_t)M * D * 4;
constexpr size_t WS_GG = WS_BB + (size_t)M * D * 4;
constexpr size_t WS_YS = WS_GG + (size_t)M * D * 4;
constexpr size_t WS_XQ = WS_YS + 60 * MiB;
constexpr size_t WS_WIN8 = WS_YS + 96 * MiB;
constexpr size_t WS_ST1 = WS_YS + 112 * MiB, WS_ST2 = WS_YS + 113 * MiB;
constexpr size_t WS_VR = WS_YS + 4 * MiB;
constexpr size_t WS_AO = WS_YS + (size_t)M * D * 4;
constexpr size_t WS_LSE = WS_AO + (size_t)3 * M * 512 * 4;
constexpr size_t WS_QR = WS_LSE + (size_t)3 * M * 8 * 4;
constexpr size_t WS_KR = WS_QR + (size_t)M * 1536 * 2;
constexpr size_t WS_LIN = WS_KR + (size_t)M * 1536 * 2;
constexpr size_t WS_KNORM = WS_LIN + (size_t)M * 768 * 2;
constexpr size_t WS_F = WS_KNORM + (size_t)M * 32 * 4;
constexpr size_t WS_E_END = WS_F + (size_t)128 * 128 * 96 * 96 * 2;
constexpr size_t WS_T1 = WS_E;
constexpr size_t WS_X1 = WS_T1 + (size_t)M * D * 4;
constexpr size_t WS_X1B = WS_X1 + (size_t)M * D * 4;
constexpr size_t WS_Q = WS_X1B + (size_t)M * D * 2;
constexpr size_t WS_PP = WS_Q + (size_t)M * D * 2;
constexpr size_t WS_OC = WS_PP + (size_t)16 * SEQ * 256 * 2;
constexpr size_t WS_T2 = WS_OC + (size_t)M * D * 2;
constexpr size_t WS_X2 = WS_T2 + (size_t)M * D * 4;
constexpr size_t WS_X2B = WS_X2 + (size_t)M * D * 4;
constexpr size_t WS_LIST = WS_X2B + (size_t)M * D * 2;
constexpr size_t WS_ROWI = WS_LIST + (size_t)NEXP * CAP * 4;
constexpr size_t WS_TOPW = WS_ROWI + (size_t)M * 4 * 4;
constexpr size_t WS_H = WS_TOPW + (size_t)M * 4 * 4;
constexpr size_t WS_Y = WS_H + (size_t)HROWS * DFF * 2;
constexpr size_t WS_L_END = WS_Y + (size_t)HROWS * D * 4;
constexpr size_t WS_END = (WS_E_END > WS_L_END ? WS_E_END : WS_L_END);
static_assert(WS_END <= (size_t)4090 * MiB, "workspace map exceeds 4 x largest input");
constexpr int CW_TMO = 0, CW_CNT = 64  , CW_Q = 128  , CW_BAR = 4096;

constexpr int RING_BYTES = 131072, MISC_OFF = RING_BYTES, LDS_BYTES = 147456;

#define XB_TMO      128
#define XB_XCNT(j)  (256  + 64 * (j))
#define XB_XSUB(j)  (1280 + 64 * (j))
#define XB_XGEN(j)  (2304 + 64 * (j))
#define XB_TOP      3328
#define XB_TOPGEN   3392
#define XCD_BAR_WORDS 3456
#define XB_SPIN_CAP (1u << 18)
__device__ __forceinline__ unsigned xb_ld(unsigned* p)              { return __hip_atomic_load(p, __ATOMIC_RELAXED, __HIP_MEMORY_SCOPE_AGENT); }
__device__ __forceinline__ unsigned xb_add(unsigned* p, unsigned v) { return __hip_atomic_fetch_add(p, v, __ATOMIC_RELAXED, __HIP_MEMORY_SCOPE_AGENT); }
__device__ __forceinline__ unsigned xb_xcc_id() { return (unsigned)__builtin_amdgcn_s_getreg((3 << 11) | 20) & 0xFu; }
#define XB_SPIN(cond, bar) do { unsigned _sp = 0; while (cond) { __builtin_amdgcn_s_sleep(1); \
    if ((++_sp & 255u) == 0u) { if (xb_ld(&(bar)[XB_TMO])) break; if (_sp > XB_SPIN_CAP) { atomicAdd(&(bar)[XB_TMO], 1u); break; } } } } while (0)
struct XcdBarrier { unsigned* bar; unsigned x; volatile LAS unsigned* st; };
__device__ __forceinline__ XcdBarrier xcd_barrier_post(unsigned* bar, volatile LAS unsigned* st) {
    XcdBarrier b; b.bar = bar; b.x = xb_xcc_id(); b.st = st;
    if (threadIdx.x == 0) (void)xb_add(&bar[XB_XCNT(b.x)], 1u);
    return b;
}
__device__ __forceinline__ void xcd_barrier_complete(unsigned* bar, unsigned x, unsigned& nloc, unsigned& nx) {
    const unsigned G = gridDim.x * gridDim.y * gridDim.z;
    unsigned sum, cnt, mine, sp = 0u;
    for (;;) {
        sum = 0u; cnt = 0u; mine = 0u;
#pragma unroll
        for (unsigned j = 0; j < 16; ++j) { const unsigned c = xb_ld(&bar[XB_XCNT(j)]); sum += c; cnt += (c > 0u) ? 1u : 0u; mine = (j == x) ? c : mine; }
        if (sum == G) break;
        __builtin_amdgcn_s_sleep(1);
        if ((++sp & 255u) == 0u) { if (xb_ld(&bar[XB_TMO])) break; if (sp > XB_SPIN_CAP) { atomicAdd(&bar[XB_TMO], 1u); break; } }
    }
    nloc = mine > 0u ? mine : 1u; nx = cnt > 0u ? cnt : 1u;
}
__device__ __forceinline__ void xcd_barrier(const XcdBarrier& b) {
    asm volatile("s_waitcnt vmcnt(0)" ::: "memory");
    __syncthreads();
    if (threadIdx.x == 0) {
        unsigned* bar = b.bar;
        __builtin_amdgcn_s_waitcnt(0);
        unsigned nloc = b.st[0], nx = b.st[1];
        if (nloc == 0u) { xcd_barrier_complete(bar, b.x, nloc, nx); b.st[0] = nloc; b.st[1] = nx; }
        const unsigned old = xb_add(&bar[XB_XSUB(b.x)], 1u);
        const unsigned gen = old / nloc;
        if (old + 1u == (gen + 1u) * nloc) {
            __builtin_amdgcn_fence(__ATOMIC_RELEASE, "agent");
            asm volatile("s_waitcnt vmcnt(0)" ::: "memory");
            const unsigned og = xb_add(&bar[XB_TOP], 1u);
            const unsigned tg = og / nx;
            if (og + 1u == (tg + 1u) * nx) xb_add(&bar[XB_TOPGEN], 1u);
            else XB_SPIN(xb_ld(&bar[XB_TOPGEN]) == tg, bar);
            __builtin_amdgcn_fence(__ATOMIC_ACQUIRE, "agent");
            xb_add(&bar[XB_XGEN(b.x)], 1u);
            asm volatile("s_waitcnt vmcnt(0)" ::: "memory");
        } else {
            XB_SPIN(xb_ld(&bar[XB_XGEN(b.x)]) == gen, bar);
            __builtin_amdgcn_fence(__ATOMIC_ACQUIRE, "agent");
            asm volatile("s_waitcnt vmcnt(0)" ::: "memory");
        }
    }
    __syncthreads();
}

struct Params {
    const float* in[32];
    float* out; unsigned char* ws;
    int ph_lo, ph_hi, li, pad;
};
enum { I_X = 0, I_MEM, I_WIN, I_MIX, I_W0, I_WUP, I_A0, I_AUP, I_GUP, I_KK, I_KA, I_RK, I_LNXG, I_LNXB, I_PA, I_PB, I_WOUT, I_LN1G, I_LN1B, I_WQ, I_WKV, I_WO, I_LN2G, I_LN2B,
       I_RW, I_RB, I_W1, I_B1, I_W2, I_B2, I_LN3G, I_LN3B };

struct ScoreOrder {
    static constexpr bool GATHER = false;
    const char* Q; const char* KB; int G, c;
    __device__ bool next(int i, pg8::Unit& u) const {
        const int L = i * G + c; if (L >= 256) return false;
        const int bh = L >> 4, pm = L & 15, b = bh >> 2, h = bh & 3;
        u.A = Q + ((size_t)(b * SEQ + 256 * pm) * D + h * 512) * 2; u.B = KB + ((size_t)(b * 256) * D + h * 512) * 2;
        u.orow = bh * SEQ + 256 * pm; u.ocol = 0; u.aux = 0; u.aux2 = 0; u.valid = 256; return true;
    }
    __device__ __forceinline__ const int* rows(const pg8::Unit&) const { return nullptr; }
};
struct PvOrder {
    static constexpr bool GATHER = false;
    const char* PP; const char* VT; int G, c;
    __device__ bool next(int i, pg8::Unit& u) const {
        const int L = i * G + c; if (L >= 512) return false;
        const int bh = L >> 5, pm = (L >> 1) & 15, pn = L & 1, b = bh >> 2, h = bh & 3;
        u.A = PP + ((size_t)(bh * SEQ + 256 * pm) * 256) * 2; u.B = VT + ((size_t)(bh * 512 + 256 * pn) * 256) * 2;
        u.orow = b * SEQ + 256 * pm; u.ocol = h * 512 + 256 * pn; u.aux = 0; u.aux2 = 0; u.valid = 256; return true;
    }
    __device__ __forceinline__ const int* rows(const pg8::Unit&) const { return nullptr; }
};
template <bool GATHER_, int NT  > struct MoeOrder {
    static constexpr bool GATHER = GATHER_;
    const LAS int* tab; const char* A; const char* W; const int* list; size_t wexp  ; int ldb; int G, c;
    __device__ bool next(int i, pg8::Unit& u) const {
        constexpr int RPR = 256 / NT;
        const int xcd = c & 7, jx = c >> 3;
        const int rtl = (NT == 16) ? (xcd & 1) * 8 + (jx & 7) : (xcd & 3) * 8 + (jx & 7), pn = (NT == 16) ? (xcd >> 1) * 4 + (jx >> 3) : (xcd >> 2) * 4 + (jx >> 3);
        const int rt = i * RPR + rtl, T = __builtin_amdgcn_readfirstlane(tab[64]);
        if (c >= 256 || rt >= T) return false;
        int e = 0;
        for (int j = 1; j < NEXP; ++j) e = (rt >= __builtin_amdgcn_readfirstlane(tab[32 + j])) ? j : e;
        const int lt = rt - __builtin_amdgcn_readfirstlane(tab[32 + e]), cnt = __builtin_amdgcn_readfirstlane(tab[e]);
        u.aux = e; u.aux2 = lt; u.valid = min(256, cnt - 256 * lt); u.orow = 256 * rt; u.ocol = 256 * pn;
        u.B = W + (size_t)e * wexp + (size_t)(256 * pn) * ldb;
        u.A = GATHER_ ? A : A + (size_t)(256 * rt) * DFF;
        return true;
    }
    __device__ __forceinline__ const int* rows(const pg8::Unit& u) const { return list + (size_t)u.aux * CAP + 256 * u.aux2; }
};

struct Ctx { int tid, lane, wave, vcu, G; LAS unsigned char* lds; unsigned char* ws; };

__device__ __forceinline__ void cv_issue(const float* W, int ldw, int Ksrc, int sc0, int k0, int lane, float (&cv)[32]) {
    const int kb = k0 + 32 * (lane >> 5); const bool ok = sc0 >= 0 && kb < Ksrc;
    const float* src = W + (ok ? (size_t)kb * ldw + sc0 + (lane & 31) : (size_t)0);
#pragma unroll
    for (int i = 0; i < 32; ++i) { const float v = src[(size_t)i * ldw]; cv[i] = ok ? v : 0.f; }
}
__device__ __forceinline__ void cv_store16(const float (&cv)[32], bf16_t* WT, int ldt, int n0, int k0, int lane) {
    u32x4* dst = (u32x4*)(WT + (size_t)(n0 + (lane & 31)) * ldt + k0 + 32 * (lane >> 5));
#pragma unroll
    for (int j = 0; j < 4; ++j) dst[j] = (u32x4){pk2(cv[8 * j], cv[8 * j + 1]), pk2(cv[8 * j + 2], cv[8 * j + 3]), pk2(cv[8 * j + 4], cv[8 * j + 5]), pk2(cv[8 * j + 6], cv[8 * j + 7])};
}
__device__ __forceinline__ void cv_store8(const float (&cv)[32], unsigned char* WT8, int ldt, int n0, int k0, int lane) {
    u32x4* dst = (u32x4*)(WT8 + (size_t)(n0 + (lane & 31)) * ldt + k0 + 32 * (lane >> 5));
#pragma unroll
    for (int j = 0; j < 2; ++j) dst[j] = (u32x4){pk4_fp8(cv[16 * j] * 64.f, cv[16 * j + 1] * 64.f, cv[16 * j + 2] * 64.f, cv[16 * j + 3] * 64.f), pk4_fp8(cv[16 * j + 4] * 64.f, cv[16 * j + 5] * 64.f, cv[16 * j + 6] * 64.f, cv[16 * j + 7] * 64.f),
        pk4_fp8(cv[16 * j + 8] * 64.f, cv[16 * j + 9] * 64.f, cv[16 * j + 10] * 64.f, cv[16 * j + 11] * 64.f), pk4_fp8(cv[16 * j + 12] * 64.f, cv[16 * j + 13] * 64.f, cv[16 * j + 14] * 64.f, cv[16 * j + 15] * 64.f)};
}
struct CvJob { const float* W; bf16_t* WT; int ldw, Ksrc, sc0, ldt, n0, k0, f8, kd; };
__device__ __forceinline__ CvJob p0_job(const Params& p, unsigned char* ws, int it) {
    constexpr int I_WINJ = 32 * 480, I_LORA = 4 * 64, I_SQ = 32 * 64, I_PBJ = 8 * 64, I_KVJ = 32 * 128;
    CvJob j; j.f8 = 0; j.kd = 0; int r = it;
#define P0_PLAIN_F8(SRC, DST, N_, KS_, KD_) { const int nblk = (N_) / 32, kb = r / nblk, nb = r % nblk; j.W = p.in[SRC]; j.WT = (bf16_t*)(ws + (DST)); j.ldw = (N_); j.Ksrc = (KS_); j.sc0 = 32 * nb; j.ldt = (KD_); j.n0 = 32 * nb; j.k0 = 64 * kb; j.f8 = 1; return j; }
#define P0_PLAIN(SRC, DST, N_, KS_, KD_) { const int nblk = (N_) / 32, kb = r / nblk, nb = r % nblk; j.W = p.in[SRC]; j.WT = (bf16_t*)(ws + (DST)); j.ldw = (N_); j.Ksrc = (KS_); j.sc0 = 32 * nb; j.ldt = (KD_); j.n0 = 32 * nb; j.k0 = 64 * kb; return j; }
    if (r < I_WINJ) { const int kb = r / 480, nb = r % 480; j.W = p.in[I_WIN]; j.WT = (bf16_t*)(ws + WS_WIN); j.ldw = 15296; j.Ksrc = D; const int n_ = 32 * nb;
        j.sc0 = n_ < RWC ? n_ : (n_ < ATTV2 ? -1 : (n_ < ATT0 ? RWC + 4096 + (n_ - ATTV2) : (n_ < GATE0 ? RWC + (n_ - ATT0) : n_ - 64))); j.ldt = D; j.n0 = n_; j.k0 = 64 * kb;
        if (n_ >= ATT0) { j.f8 = 1; j.WT = (bf16_t*)(ws + WS_WIN8); j.n0 = n_ - ATT0; }
        return j; } r -= I_WINJ;
    if (r < I_LORA) P0_PLAIN(I_WUP, WS_WUP, D, 96, 256) r -= I_LORA;
    if (r < I_LORA) P0_PLAIN(I_AUP, WS_AUP, D, 96, 256) r -= I_LORA;
    if (r < I_LORA) P0_PLAIN(I_GUP, WS_GUP, D, 256, 256) r -= I_LORA;
    if (r < I_SQ) P0_PLAIN(I_PA, WS_PA, D, D, 2560) r -= I_SQ;
    if (r < I_PBJ) { const int kb = r / 64, nb = r % 64; j.W = p.in[I_PB]; j.WT = (bf16_t*)(ws + WS_PA); j.ldw = D; j.Ksrc = 512; j.sc0 = 32 * nb; j.ldt = 2560; j.n0 = 32 * nb; j.k0 = 64 * kb; j.kd = 2048; return j; } r -= I_PBJ;
    if (r < I_SQ) P0_PLAIN(I_WOUT, WS_WOUT, D, D, D) r -= I_SQ;
    if (r < I_SQ) { P0_PLAIN_F8(I_WQ, WS_WQ, D, D, D) } r -= I_SQ;
    if (r < I_KVJ) P0_PLAIN(I_WKV, WS_WKV, 2 * D, D, D) r -= I_KVJ;
    P0_PLAIN(I_WO, WS_WO, D, D, D)
#undef P0_PLAIN
#undef P0_PLAIN_F8
}
__device__ __forceinline__ void p0_prologue(const Params& p, const Ctx& c) {
    const int gw = c.vcu * 8 + c.wave, NGW = c.G * 8;
    unsigned char* ws = c.ws;
    constexpr int NITEMS = 32 * 480 + 3 * (4 * 64) + 4 * (32 * 64) + 8 * 64 + 32 * 128;
    { float ca[32], cb[32]; CvJob ja, jb; int it = gw;
      if (it < NITEMS) { ja = p0_job(p, ws, it); cv_issue(ja.W, ja.ldw, ja.Ksrc, ja.sc0, ja.k0, c.lane, ca); }
      for (; it < NITEMS; it += 2 * NGW) {
          if (it + NGW < NITEMS) { jb = p0_job(p, ws, it + NGW); cv_issue(jb.W, jb.ldw, jb.Ksrc, jb.sc0, jb.k0, c.lane, cb); }
          if (ja.f8) cv_store8(ca, (unsigned char*)ja.WT, ja.ldt, ja.n0, ja.k0, c.lane); else cv_store16(ca, ja.WT, ja.ldt, ja.n0, ja.k0 + ja.kd, c.lane);
          if (it + 2 * NGW < NITEMS) { ja = p0_job(p, ws, it + 2 * NGW); cv_issue(ja.W, ja.ldw, ja.Ksrc, ja.sc0, ja.k0, c.lane, ca); }
          if (it + NGW < NITEMS) { if (jb.f8) cv_store8(cb, (unsigned char*)jb.WT, jb.ldt, jb.n0, jb.k0, c.lane); else cv_store16(cb, jb.WT, jb.ldt, jb.n0, jb.k0 + jb.kd, c.lane); }
      } }
    const size_t gt = (size_t)c.vcu * 512 + c.tid, NT = (size_t)c.G * 512;
    for (size_t i = gt; i < (size_t)M * D / 8; i += NT) { const f32x4 a = ((const f32x4*)p.in[I_X])[2 * i], b = ((const f32x4*)p.in[I_X])[2 * i + 1];
        u32x4 o; o.x = pk2(a[0], a[1]); o.y = pk2(a[2], a[3]); o.z = pk2(b[0], b[1]); o.w = pk2(b[2], b[3]); ((u32x4*)(ws + WS_XB))[i] = o;
        ((u32x2*)(ws + WS_XQ))[i] = (u32x2){pk4_fp8(a[0], a[1], a[2], a[3]), pk4_fp8(b[0], b[1], b[2], b[3])}; }
    for (size_t i = gt; i < (size_t)1024 * D / 8; i += NT) { const f32x4 a = ((const f32x4*)p.in[I_MEM])[2 * i], b = ((const f32x4*)p.in[I_MEM])[2 * i + 1];
        u32x4 o; o.x = pk2(a[0], a[1]); o.y = pk2(a[2], a[3]); o.z = pk2(b[0], b[1]); o.w = pk2(b[2], b[3]); ((u32x4*)(ws + WS_MEMB))[i] = o; }
    float* rc = (float*)(ws + WS_ROT); float* rs = rc + SEQ * 32;
    for (size_t i = gt; i < (size_t)SEQ * 32; i += NT) { const int pos = (int)(i >> 5), j = (int)(i & 31);
        const double inv = exp(-(double)j * (9.210340371976184 / 32.0)); const double ang = (double)pos * inv; rc[i] = (float)cos(ang); rs[i] = (float)sin(ang); }
}

constexpr int MOE_W1E = 32 * 128, MOE_W2E = 32 * 64, MOE_CONV_GROUPS = (NEXP * MOE_W2E) / 8;
__device__ __forceinline__ void conv_group(const Params& p, const Ctx& c, int gi) {
    unsigned char* ws = c.ws;
    const int r = gi * 8 + c.wave;
    const int e = r / MOE_W2E, it = r % MOE_W2E, kb = it >> 6, nb = it & 63;
    float cv[32]; cv_issue(p.in[I_W2] + (size_t)e * DFF * D, D, DFF, 32 * nb, 64 * kb, c.lane, cv);
    cv_store8(cv, ws + WS_W2 + (size_t)e * D * DFF, DFF, 32 * nb, 64 * kb, c.lane);
}

#define DPP_ADD(x, ctrl) ((x) + __builtin_bit_cast(float, __builtin_amdgcn_update_dpp(0, __builtin_bit_cast(int, (x)), (ctrl), 0xF, 0xF, true)))
struct P2Tok { u32x4 cv0, pv0, cv1, pv1, ra, rb, vv; f32x4 c0, c1, s0, s1; };
__device__ __forceinline__ void p2_prep(const Params& p, const Ctx& c) {
    unsigned char* ws = c.ws;
    const bf16_t* PROJ = (const bf16_t*)(ws + WS_PROJ);
    const float* mix = p.in[I_MIX]; const float* k_k = p.in[I_KK];
    bf16_t* RZ = (bf16_t*)(ws + WS_RZ); bf16_t* KZ = (bf16_t*)(ws + WS_KZ); bf16_t* VZ = (bf16_t*)(ws + WS_VZ);
    bf16_t* LIN = (bf16_t*)(ws + WS_LIN); float* KNORM = (float*)(ws + WS_KNORM);
    bf16_t* QR = (bf16_t*)(ws + WS_QR); bf16_t* KR = (bf16_t*)(ws + WS_KR); bf16_t* VR = (bf16_t*)(ws + WS_VR);
    const float* rc = (const float*)(ws + WS_ROT); const float* rs = rc + SEQ * 32;
    int tid_ = c.tid; asm volatile("" : "+v"(tid_));
    const int tid = tid_;
    const int ch0 = tid, ch1 = tid + 512; const bool has1 = ch1 < 824;
    const f32x4 m00 = *(const f32x4*)(mix + 8 * ch0), m01 = *(const f32x4*)(mix + 8 * ch0 + 4);
    f32x4 m10 = (f32x4){0.f, 0.f, 0.f, 0.f}, m11 = m10; if (has1) { m10 = *(const f32x4*)(mix + 8 * ch1); m11 = *(const f32x4*)(mix + 8 * ch1 + 4); }
    f32x4 kk0 = (f32x4){0.f, 0.f, 0.f, 0.f}, kk1 = kk0; if (tid >= 256) { kk0 = *(const f32x4*)(k_k + 8 * (tid - 256)); kk1 = *(const f32x4*)(k_k + 8 * (tid - 256) + 4); }
    const bool rot = tid >= 64 && tid < 256, vcp = tid >= 256 && tid < 448;
    const int rw = tid - 64, which = rw / 96, rhh = (rw % 96) >> 2, re0 = (rw & 3) * 8;
    const int vhh = (tid - 256) >> 3, ve0 = ((tid - 256) & 7) * 8;
#define P2_LOAD(T, t_) do { const int pos_ = (t_) & (SEQ - 1); const bf16_t* cur_ = PROJ + (size_t)(t_) * PC; const u32x4 z4_ = (u32x4){0u, 0u, 0u, 0u}; \
        T.cv0 = *(const u32x4*)(cur_ + 8 * ch0); T.pv0 = pos_ > 0 ? *(const u32x4*)(cur_ - PC + 8 * ch0) : z4_; \
        if (has1) { T.cv1 = *(const u32x4*)(cur_ + 8 * ch1); T.pv1 = pos_ > 0 ? *(const u32x4*)(cur_ - PC + 8 * ch1) : z4_; } \
        if (rot) { const bf16_t* src_ = cur_ + ATT0 + which * 1536 + rhh * 64 + re0; T.ra = *(const u32x4*)src_; T.rb = *(const u32x4*)(src_ + 32); \
            T.c0 = *(const f32x4*)(rc + pos_ * 32 + re0); T.c1 = *(const f32x4*)(rc + pos_ * 32 + re0 + 4); T.s0 = *(const f32x4*)(rs + pos_ * 32 + re0); T.s1 = *(const f32x4*)(rs + pos_ * 32 + re0 + 4); } \
        if (vcp) { const int ao_ = 2 * 1536 + vhh * 64 + ve0; T.vv = *(const u32x4*)(cur_ + (ao_ < 4096 ? ATT0 + ao_ : ATTV2 + ao_ - 4096)); } } while (0)
#define P2_SHIFT(z, cv, pv, ma, mb) do { const unsigned cw[4] = {cv.x, cv.y, cv.z, cv.w}, pw[4] = {pv.x, pv.y, pv.z, pv.w}; const float mm[8] = {ma[0], ma[1], ma[2], ma[3], mb[0], mb[1], mb[2], mb[3]}; \
        _Pragma("unroll") for (int j = 0; j < 4; ++j) { const float c0_ = bf2f(cw[j] & 0xffffu), c1_ = bf2f(cw[j] >> 16), q0_ = bf2f(pw[j] & 0xffffu), q1_ = bf2f(pw[j] >> 16); \
            z[2 * j] = c0_ + (q0_ - c0_) * mm[2 * j]; z[2 * j + 1] = c1_ + (q1_ - c1_) * mm[2 * j + 1]; } } while (0)
#define P2_PROC(T, t_) do { const int t = (t_), pos = t & (SEQ - 1); \
        { float z[8]; P2_SHIFT(z, T.cv0, T.pv0, m00, m01);            \
          bf16_t* dst = (tid < 256 ? RZ : KZ) + (size_t)t * D + 8 * (tid & 255); \
          { u32x4 w8; w8.x = pk2(z[0], z[1]); w8.y = pk2(z[2], z[3]); w8.z = pk2(z[4], z[5]); w8.w = pk2(z[6], z[7]); *(u32x4*)dst = w8; } \
          if (tid >= 256) { float sq = 0.f; _Pragma("unroll") for (int j = 0; j < 4; ++j) { const float a_ = z[j] * kk0[j], b_ = z[4 + j] * kk1[j]; sq += a_ * a_ + b_ * b_; } \
              sq = DPP_ADD(sq, 0xB1); sq = DPP_ADD(sq, 0x4E); sq = DPP_ADD(sq, 0x141);                   \
              if ((tid & 7) == 0) KNORM[(size_t)t * 32 + ((tid - 256) >> 3)] = sqrtf(sq); } } \
        if (has1) { float z[8]; P2_SHIFT(z, T.cv1, T.pv1, m10, m11);    \
          if (ch1 < 768) { u32x4 w8; w8.x = pk2(z[0], z[1]); w8.y = pk2(z[2], z[3]); w8.z = pk2(z[4], z[5]); w8.w = pk2(z[6], z[7]); *(u32x4*)(VZ + (size_t)t * D + 8 * (ch1 - 512)) = w8; } \
          else { float o[8]; int dcol; \
              if (ch1 < 780) { dcol = 8 * (ch1 - 768); _Pragma("unroll") for (int j = 0; j < 8; ++j) o[j] = tanhf(z[j]); } \
              else if (ch1 < 792) { dcol = 256 + 8 * (ch1 - 780); _Pragma("unroll") for (int j = 0; j < 8; ++j) o[j] = z[j]; } \
              else { dcol = 512 + 8 * (ch1 - 792); _Pragma("unroll") for (int j = 0; j < 8; ++j) o[j] = sigmoidf_(z[j]); } \
              u32x4 w; w.x = pk2(o[0], o[1]); w.y = pk2(o[2], o[3]); w.z = pk2(o[4], o[5]); w.w = pk2(o[6], o[7]); *(u32x4*)(LIN + (size_t)t * 768 + dcol) = w; } } \
        if (tid >= 448 && tid < 488) { const int q_ = tid - 448; const int dcol = (q_ < 20) ? 96 + 8 * q_ : 352 + 8 * (q_ - 20); *(u32x4*)(LIN + (size_t)t * 768 + dcol) = (u32x4){0u, 0u, 0u, 0u}; } \
        if (rot) { const unsigned aw[4] = {T.ra.x, T.ra.y, T.ra.z, T.ra.w}, bw[4] = {T.rb.x, T.rb.y, T.rb.z, T.rb.w}; float o1[8], o2[8]; \
            _Pragma("unroll") for (int j = 0; j < 8; ++j) { const float t1 = bf2f((aw[j >> 1] >> (16 * (j & 1))) & 0xffffu), t2 = bf2f((bw[j >> 1] >> (16 * (j & 1))) & 0xffffu); \
                const float cs = j < 4 ? T.c0[j & 3] : T.c1[j & 3], sn = j < 4 ? T.s0[j & 3] : T.s1[j & 3]; o1[j] = t1 * cs - t2 * sn; o2[j] = t2 * cs + t1 * sn; } \
            const int dl_ = rhh < 8 ? 1 : (rhh < 16 ? 4 : 16); const int prm = (pos % dl_) * (SEQ / dl_) + pos / dl_; \
            bf16_t* dst = (which ? KR : QR) + ((size_t)((t >> 12) * 24 + rhh) * SEQ + prm) * 64 + re0; \
            u32x4 w1; w1.x = pk2(o1[0], o1[1]); w1.y = pk2(o1[2], o1[3]); w1.z = pk2(o1[4], o1[5]); w1.w = pk2(o1[6], o1[7]); \
            u32x4 w2; w2.x = pk2(o2[0], o2[1]); w2.y = pk2(o2[2], o2[3]); w2.z = pk2(o2[4], o2[5]); w2.w = pk2(o2[6], o2[7]); \
            *(u32x4*)dst = w1; *(u32x4*)(dst + 32) = w2; } \
        if (vcp) { const int dl_ = vhh < 8 ? 1 : (vhh < 16 ? 4 : 16); const int prm = (pos % dl_) * (SEQ / dl_) + pos / dl_; \
            *(u32x4*)(VR + ((size_t)((t >> 12) * 24 + vhh) * SEQ + prm) * 64 + ve0) = T.vv; } } while (0)
    P2Tok ta, tb;
    int tq = c.vcu;
    if (tq < M) P2_LOAD(ta, tq);
    for (; tq < M; tq += 2 * c.G) {
        if (tq + c.G < M) P2_LOAD(tb, tq + c.G);
        P2_PROC(ta, tq);
        if (tq + 2 * c.G < M) P2_LOAD(ta, tq + 2 * c.G);
        if (tq + c.G < M) P2_PROC(tb, tq + c.G);
    }
#undef P2_LOAD
#undef P2_SHIFT
#undef P2_PROC
}

__device__ __forceinline__ float wave_sum_dpp(float x) {
    x = DPP_ADD(x, 0xB1); x = DPP_ADD(x, 0x4E); x = DPP_ADD(x, 0x141); x = DPP_ADD(x, 0x140);
    const int xi = __builtin_bit_cast(int, x);
    return (__builtin_bit_cast(float, __builtin_amdgcn_readlane(xi, 0)) + __builtin_bit_cast(float, __builtin_amdgcn_readlane(xi, 16))) +
           (__builtin_bit_cast(float, __builtin_amdgcn_readlane(xi, 32)) + __builtin_bit_cast(float, __builtin_amdgcn_readlane(xi, 48)));
}
__device__ __forceinline__ f32x4 tile_mm(const LAS bf16_t* A, int pa, const LAS bf16_t* Bt, int pb, int ks, int fr, int fq, f32x4 acc) {
    for (int k = 0; k < ks; ++k) { const bf16x8 a = *(const LAS bf16x8*)(A + fr * pa + 32 * k + 8 * fq), b = *(const LAS bf16x8*)(Bt + fr * pb + 32 * k + 8 * fq);
        acc = __builtin_amdgcn_mfma_f32_16x16x32_bf16(a, b, acc, 0, 0, 0); }
    return acc;
}
__device__ __forceinline__ u32x2 pack4(f32x4 v) { u32x2 w; w.x = pk2(v[0], v[1]); w.y = pk2(v[2], v[3]); return w; }
constexpr int SC_C = 32, SC_NCH = SEQ / SC_C, SC_F = 96;
constexpr int PL_X1 = 0, PL_X2 = 9216, PL_AL = 18432, PL_HT = 26112, PL_ET = 33792, PL_LBT = 53760, PL_TT = 58368, PL_XB = 60928, PL_GI = PL_X1, PL_TF = PL_X2, PL_END = 62016, PL_GRP = 65536;
#define LBAR() do { asm volatile("s_waitcnt lgkmcnt(0)" ::: "memory"); __builtin_amdgcn_s_barrier(); asm volatile("" ::: "memory"); } while (0)
__device__ __forceinline__ void p4_pre(const Params& p, const Ctx& c) {
    unsigned char* ws = c.ws;
    const bf16_t* RZ = (const bf16_t*)(ws + WS_RZ); const bf16_t* LDEC = (const bf16_t*)(ws + WS_DEC); const bf16_t* KZ = (const bf16_t*)(ws + WS_KZ);
    const bf16_t* ALP = (const bf16_t*)(ws + WS_AN); const float* KNORM = (const float*)(ws + WS_KNORM); const float* kkp = p.in[I_KK]; const float* kap = p.in[I_KA];
    bf16_t* FG = (bf16_t*)(ws + WS_F); float* BON = (float*)(ws + WS_YS);
    const float* rkp = p.in[I_RK];
    int tid_ = c.tid; asm volatile("" : "+v"(tid_));
    const int tid = tid_, lane = tid & 63, w = __builtin_amdgcn_readfirstlane(tid >> 6), fr = lane & 15, fq = lane >> 4;
    const int grp = w >> 2, tw = w & 3, gtid = tid & 255;
    LAS unsigned char* gl = c.lds + grp * PL_GRP;
    LAS bf16_t* X1 = (LAS bf16_t*)(gl + PL_X1); LAS bf16_t* X2 = (LAS bf16_t*)(gl + PL_X2); LAS bf16_t* AL = (LAS bf16_t*)(gl + PL_AL); LAS bf16_t* HT = (LAS bf16_t*)(gl + PL_HT);
    LAS bf16_t* ET = (LAS bf16_t*)(gl + PL_ET); LAS float* LBT = (LAS float*)(gl + PL_LBT); LAS bf16_t* TT = (LAS bf16_t*)(gl + PL_TT); LAS bf16_t* GI = (LAS bf16_t*)(gl + PL_GI);
    LAS float* TF = (LAS float*)(gl + PL_TF);
    LAS float* XB = (LAS float*)(gl + PL_XB);
    const int npair = (128 * SC_NCH) / (2 * c.G);
    unsigned short dcy[32], ir[8], ik[8], ia[8]; float inr[8];
#define PRE_LOAD(PAIR) do { const int task_ = c.vcu + (2 * (PAIR) + grp) * c.G; const int bh_ = task_ >> 7, ch_ = task_ & (SC_NCH - 1); \
        const size_t o_ = ((size_t)(bh_ >> 5) * SEQ + (size_t)ch_ * SC_C) * D + (bh_ & 31) * 64 + lane; \
        _Pragma("unroll") for (int s_ = 0; s_ < 32; ++s_) dcy[s_] = LDEC[o_ + (size_t)s_ * D]; \
        _Pragma("unroll") for (int q_ = 0; q_ < 8; ++q_) { const size_t oo_ = o_ + (size_t)(8 * tw + q_) * D; ir[q_] = RZ[oo_]; ik[q_] = KZ[oo_]; ia[q_] = ALP[oo_]; \
            inr[q_] = KNORM[((size_t)(bh_ >> 5) * SEQ + (size_t)ch_ * SC_C + 8 * tw + q_) * 32 + (bh_ & 31)]; } } while (0)
    const bool bgconv = (c.G == 256);
    if (npair > 0) PRE_LOAD(0);
    for (int pr = 0; pr < npair; ++pr) {
        const int task = c.vcu + (2 * pr + grp) * c.G, bh = task >> 7, chn = task & (SC_NCH - 1);
        const float rkv = rkp[(bh & 31) * 64 + lane], kkc = kkp[(bh & 31) * 64 + lane], kac = kap[(bh & 31) * 64 + lane];
        float* bon = BON + ((size_t)(bh >> 5) * SEQ + (size_t)chn * SC_C) * 32 + (bh & 31);
        float p0 = 0.f, p1 = 0.f, p2 = 0.f, p3 = 0.f, dsel[8];
#pragma unroll
        for (int s = 0; s < 8; ++s) { const float d0 = bf2f(dcy[s]), d1 = bf2f(dcy[8 + s]), d2 = bf2f(dcy[16 + s]), d3 = bf2f(dcy[24 + s]); p0 += d0; p1 += d1; p2 += d2; p3 += d3;
            dsel[s] = tw == 0 ? d0 : (tw == 1 ? d1 : (tw == 2 ? d2 : d3)); }
        const float gC = __expf((p0 + p1) + (p2 + p3));
        float lg_ = tw == 0 ? 0.f : (tw == 1 ? p0 : (tw == 2 ? p0 + p1 : (p0 + p1) + p2));
        float g = __expf(lg_);
        LBAR();
#pragma unroll
        for (int hq = 0; hq < 2; ++hq) { f32x4 ah4, bg4, kg4;
#pragma unroll
            for (int qq = 0; qq < 4; ++qq) { const int qn = 4 * hq + qq, s = 8 * tw + qn;
                const float gp = g; lg_ += dsel[qn]; g = __expf(lg_);
                const float rr = bf2f(ir[qn]), kz = bf2f(ik[qn]), alp = bf2f(ia[qn]); const float ig = __expf(-lg_);
                const float kn = kz * kkc * __builtin_amdgcn_rcpf(fmaxf(inr[qn], 1e-12f));
                const float kk = kz * (1.0f + (alp - 1.0f) * kac), aa = -kn, bb = kn * alp;
                const float ah = aa * gp, bt = bb * ig, kt = kk * ig, rh = rr * g;
                X1[s * 72 + lane] = (bf16_t)f2bf(bt); X1[(32 + s) * 72 + lane] = (bf16_t)f2bf(kt); X2[s * 72 + lane] = (bf16_t)f2bf(ah); X2[(32 + s) * 72 + lane] = (bf16_t)f2bf(rh);
                ET[s * 104 + lane] = (bf16_t)f2bf(rh); ah4[qq] = ah; bg4[qq] = bt * gC; kg4[qq] = kt * gC;
                const float bsum = wave_sum_dpp(rr * kk * rkv); if (lane == 0) bon[(size_t)s * 32] = bsum; }
            *(LAS u32x2*)(AL + lane * 40 + 8 * tw + 4 * hq) = pack4(ah4); *(LAS u32x2*)(HT + (32 + lane) * 40 + 8 * tw + 4 * hq) = pack4(bg4); *(LAS u32x2*)(ET + (32 + lane) * 104 + 64 + 8 * tw + 4 * hq) = pack4(kg4); }
        { const int zr = gtid >> 2, zc = 16 * (gtid & 3); LAS u32x4* zp = (LAS u32x4*)(ET + (32 + zr) * 104 + zc); zp[0] = (u32x4){0u, 0u, 0u, 0u}; zp[1] = (u32x4){0u, 0u, 0u, 0u}; }
        if (pr + 1 < npair) PRE_LOAD(pr + 1);
        float cva[32], cvb[32]; int cea = 0, cna = 0, cka = 0, ceb = 0, cnb = 0, ckb = 0;
        if (bgconv) { const int it0 = ((c.vcu * 32 + pr) * 8 + w) * 2;
            cea = it0 >> 12; { const int rem = it0 & 4095; cka = 64 * (rem >> 7); cna = 32 * (rem & 127); }
            ceb = (it0 + 1) >> 12; { const int rem = (it0 + 1) & 4095; ckb = 64 * (rem >> 7); cnb = 32 * (rem & 127); }
            cv_issue(p.in[I_W1] + (size_t)cea * D * 4096, 4096, D, cna, cka, lane, cva); cv_issue(p.in[I_W1] + (size_t)ceb * D * 4096, 4096, D, cnb, ckb, lane, cvb); }
        LBAR();
        if (tw == 0) ET[(32 + lane) * 104 + lane] = (bf16_t)f2bf(gC);
        { const int mt = tw;
#pragma unroll
          for (int nt = 0; nt < 4; ++nt) {
            f32x4 acc = tile_mm(X1 + 16 * mt * 72, 72, X2 + 16 * nt * 72, 72, 2, fr, fq, (f32x4){0.f, 0.f, 0.f, 0.f});
            const int n = 16 * nt + fr, m0 = 16 * mt + 4 * fq;
            if (mt < 2) { if (nt < 2) { const int t = n; f32x4 o;
#pragma unroll
                    for (int e = 0; e < 4; ++e) o[e] = (m0 + e < t) ? acc[e] : 0.f;
                    *(LAS f32x4*)(LBT + t * 36 + m0) = o; }
                else { const int t = n - 32; f32x4 o;
#pragma unroll
                    for (int e = 0; e < 4; ++e) o[e] = (m0 + e <= t) ? acc[e] : 0.f;
                    *(LAS u32x2*)(HT + t * 40 + m0) = pack4(o); } }
            else { const int s0 = m0 - 32;
                if (nt < 2) { const int t = n;
#pragma unroll
                    for (int e = 0; e < 4; ++e) AL[(64 + s0 + e) * 40 + t] = (bf16_t)f2bf((s0 + e < t) ? acc[e] : 0.f); }
                else { const int t = n - 32; f32x4 o;
#pragma unroll
                    for (int e = 0; e < 4; ++e) o[e] = (s0 + e <= t) ? acc[e] : 0.f;
                    *(LAS u32x2*)(ET + t * 104 + 64 + s0) = pack4(o); } } } }
        LBAR();
        if (gtid < 32) { const int hb = 16 * (gtid >> 4), sl = gtid & 15; float Tr[16];
#pragma unroll
            for (int t = 0; t < 16; ++t) { float a0 = (sl == t) ? 1.f : 0.f, a1 = 0.f, a2 = 0.f, a3 = 0.f;
#pragma unroll
                for (int m4 = 0; m4 < (t + 3) / 4; ++m4) { const f32x4 l = *(const LAS f32x4*)(LBT + (hb + t) * 36 + hb + 4 * m4);
                    if (4 * m4 + 0 < t) a0 += Tr[4 * m4 + 0] * l[0]; if (4 * m4 + 1 < t) a1 += Tr[4 * m4 + 1] * l[1]; if (4 * m4 + 2 < t) a2 += Tr[4 * m4 + 2] * l[2]; if (4 * m4 + 3 < t) a3 += Tr[4 * m4 + 3] * l[3]; }
                Tr[t] = (a0 + a1) + (a2 + a3); TF[(hb + sl) * 36 + hb + t] = Tr[t]; TT[(hb + t) * 40 + hb + sl] = (bf16_t)f2bf(Tr[t]);
                if (hb) TT[t * 40 + hb + sl] = 0; } }
        LBAR();
        { const int m = gtid >> 4, tl = gtid & 15; float x = 0.f;
#pragma unroll
            for (int n = 0; n < 16; ++n) x += LBT[(16 + n) * 36 + m] * TF[(16 + n) * 36 + 16 + tl];
            XB[m * 17 + tl] = x; }
        LBAR();
        { const int sr = gtid >> 4, tl = gtid & 15; float x = 0.f;
#pragma unroll
            for (int m = 0; m < 16; ++m) x += TF[sr * 36 + m] * XB[m * 17 + tl];
            TT[(16 + tl) * 40 + sr] = (bf16_t)f2bf(x); }
        LBAR();
        for (int id = tw; id < 12; id += 4) { const int tt = id / 6, nt = id % 6;
            const f32x4 acc = tile_mm(TT + 16 * tt * 40, 40, AL + 16 * nt * 40, 40, 1, fr, fq, (f32x4){0.f, 0.f, 0.f, 0.f});
            *(LAS u32x2*)(GI + (16 * nt + fr) * 40 + 16 * tt + 4 * fq) = pack4(acc); }
        LBAR();
        for (int id = tw; id < 36; id += 4) { const int nt = id / 6, mt = id % 6;
            const f32x4 acc = tile_mm(GI + 16 * nt * 40, 40, HT + 16 * mt * 40, 40, 1, fr, fq, (f32x4){0.f, 0.f, 0.f, 0.f});
            LAS u32x2* ep = (LAS u32x2*)(ET + (16 * mt + fr) * 104 + 16 * nt + 4 * fq); const u32x2 ev = *ep;
            f32x4 o; o[0] = acc[0] + bf2f(ev.x & 0xffffu); o[1] = acc[1] + bf2f(ev.x >> 16); o[2] = acc[2] + bf2f(ev.y & 0xffffu); o[3] = acc[3] + bf2f(ev.y >> 16);
            *ep = pack4(o); }
        LBAR();
        { bf16_t* fg = FG + (size_t)task * (SC_F * SC_F);
          for (int idx = gtid; idx < 96 * 12; idx += 256) { const int row = idx / 12, pc = idx % 12; *(u32x4*)(fg + row * 96 + 8 * pc) = *(const LAS u32x4*)(ET + row * 104 + 8 * pc); } }
        LBAR();
        if (bgconv) { cv_store8(cva, ws + WS_W1 + (size_t)cea * 4096 * D, D, cna, cka, lane); cv_store8(cvb, ws + WS_W1 + (size_t)ceb * 4096 * D, D, cnb, ckb, lane); }
    }
    if (!bgconv) {
        LBAR();
        for (int r = c.vcu * 8 + w; r < NEXP * MOE_W1E; r += c.G * 8) { const int e = r >> 12, rem = r & 4095; float cv[32]; cv_issue(p.in[I_W1] + (size_t)e * D * 4096, 4096, D, 32 * (rem & 127), 64 * (rem >> 7), lane, cv);
            cv_store8(cv, ws + WS_W1 + (size_t)e * 4096 * D, D, 32 * (rem & 127), 64 * (rem >> 7), lane); }
    }
    LBAR();
#undef PRE_LOAD
}
constexpr int SQ_BI = 0, SQ_BI_SZ = 64 * 104 * 2, SQ_YL = 2 * SQ_BI_SZ, SQ_YL_SZ = 32 * 64 * 4;
struct SeqSet { bf16x8 af[3][3]; u32x2 vimg, gimg; float bon; };
__device__ __forceinline__ void p4_seq(const Params& p, const Ctx& c, int bh) {
    unsigned char* ws = c.ws;
    const bf16_t* VZ = (const bf16_t*)(ws + WS_VZ); const bf16_t* GG = (const bf16_t*)(ws + WS_GG); const float* BON = (const float*)(ws + WS_YS);
    const bf16_t* FG = (const bf16_t*)(ws + WS_F) + (size_t)bh * SC_NCH * (SC_F * SC_F);
    bf16_t* YA = (bf16_t*)(ws + WS_YA);
    int tid_ = c.tid; asm volatile("" : "+v"(tid_));
    const int tid = tid_, lane = tid & 63, w = __builtin_amdgcn_readfirstlane(tid >> 6), fr = lane & 15, fq = lane >> 4;
    const int b = bh >> 5, h = bh & 31;
    const size_t base = (size_t)b * SEQ * D + h * 64;
    const int nt = w & 3, mg = w >> 2;
    LAS bf16_t* BI = (LAS bf16_t*)(c.lds + SQ_BI); LAS float* YL = (LAS float*)(c.lds + SQ_YL);
    const int vs = tid >> 4, vi4 = 4 * (tid & 15);
    const f32x4 lg4 = *(const f32x4*)(p.in[I_LNXG] + h * 64 + vi4), lb4 = *(const f32x4*)(p.in[I_LNXB] + h * 64 + vi4);
#define SEQ_LOAD(SET, CHN) do { const int chn_ = (CHN) < SC_NCH ? (CHN) : SC_NCH - 1; const bf16_t* fp = FG + (size_t)chn_ * (SC_F * SC_F); const size_t tk_ = (size_t)b * SEQ + (size_t)(chn_ * SC_C + vs); \
        asm volatile("global_load_dwordx2 %0, %1, off" : "=v"(SET.vimg) : "v"(VZ + tk_ * D + h * 64 + vi4) : "memory"); \
        _Pragma("unroll") for (int mi = 0; mi < 3; ++mi) _Pragma("unroll") for (int ks = 0; ks < 3; ++ks) \
            asm volatile("global_load_dwordx4 %0, %1, off" : "=v"(SET.af[mi][ks]) : "v"(fp + (16 * (3 * mg + mi) + fr) * SC_F + 32 * ks + 8 * fq) : "memory"); \
        asm volatile("global_load_dwordx2 %0, %1, off" : "=v"(SET.gimg) : "v"(GG + tk_ * D + h * 64 + vi4) : "memory"); \
        asm volatile("global_load_dword %0, %1, off" : "=v"(SET.bon) : "v"(BON + tk_ * 32 + h) : "memory"); } while (0)
#define SEQ_WAIT_AF(SET, N) asm volatile("s_waitcnt vmcnt(" #N ")" : "+v"(SET.af[0][0]), "+v"(SET.af[0][1]), "+v"(SET.af[0][2]), "+v"(SET.af[1][0]), "+v"(SET.af[1][1]), "+v"(SET.af[1][2]), \
        "+v"(SET.af[2][0]), "+v"(SET.af[2][1]), "+v"(SET.af[2][2]) :: "memory")
#define SEQ_WAIT_V(SET, N) asm volatile("s_waitcnt vmcnt(" #N ")" : "+v"(SET.vimg) :: "memory")
#define SEQ_WAIT_G(SET, N) asm volatile("s_waitcnt vmcnt(" #N ")" : "+v"(SET.gimg), "+v"(SET.bon), "+v"(SET.vimg) :: "memory")
#define SEQ_BODY(CH, CUR, NXT, NX2) do { const int ch = (CH), cb = ch & 1; \
        const LAS bf16_t* bi = BI + cb * (64 * 104); LAS bf16_t* bo = BI + (cb ^ 1) * (64 * 104); LAS float* yl = YL + cb * (32 * 64); \
        SEQ_LOAD(NX2, ch + 2); \
        bf16x8 bfr[3]; _Pragma("unroll") for (int ks = 0; ks < 3; ++ks) bfr[ks] = *(const LAS bf16x8*)(bi + (16 * nt + fr) * 104 + 32 * ks + 8 * fq); \
        SEQ_WAIT_AF(CUR, 28); \
        f32x4 acc[3]; _Pragma("unroll") for (int mi = 0; mi < 3; ++mi) { acc[mi] = (f32x4){0.f, 0.f, 0.f, 0.f}; \
            _Pragma("unroll") for (int ks = 0; ks < 3; ++ks) acc[mi] = __builtin_amdgcn_mfma_f32_16x16x32_bf16(CUR.af[mi][ks], bfr[ks], acc[mi], 0, 0, 0); } \
        _Pragma("unroll") for (int mi = 0; mi < 3; ++mi) { const int mt = 3 * mg + mi; \
            if (mt < 2) { _Pragma("unroll") for (int e = 0; e < 4; ++e) yl[(16 * mt + 4 * fq + e) * 64 + 16 * nt + fr] = acc[mi][e]; } \
            else *(LAS u32x2*)(bo + (16 * nt + fr) * 104 + 16 * (mt - 2) + 4 * fq) = pack4(acc[mi]); } \
        SEQ_WAIT_V(NXT, 24); \
        if (ch + 1 < SC_NCH) { bo[(vi4 + 0) * 104 + 64 + vs] = (bf16_t)(NXT.vimg.x & 0xffffu); bo[(vi4 + 1) * 104 + 64 + vs] = (bf16_t)(NXT.vimg.x >> 16); \
            bo[(vi4 + 2) * 104 + 64 + vs] = (bf16_t)(NXT.vimg.y & 0xffffu); bo[(vi4 + 3) * 104 + 64 + vs] = (bf16_t)(NXT.vimg.y >> 16); } \
        LBAR(); \
        SEQ_WAIT_G(CUR, 24); \
        { const f32x4 y4 = *(const LAS f32x4*)(yl + vs * 64 + vi4); float sm = (y4[0] + y4[1]) + (y4[2] + y4[3]); \
          sm = DPP_ADD(sm, 0xB1); sm = DPP_ADD(sm, 0x4E); sm = DPP_ADD(sm, 0x141); sm = DPP_ADD(sm, 0x140);     \
          const float mu = sm * (1.0f / 64.0f); const f32x4 d4 = y4 - mu; float q = (d4[0] * d4[0] + d4[1] * d4[1]) + (d4[2] * d4[2] + d4[3] * d4[3]); \
          q = DPP_ADD(q, 0xB1); q = DPP_ADD(q, 0x4E); q = DPP_ADD(q, 0x141); q = DPP_ADD(q, 0x140); \
          const float rstd = rsqrtf(q * (1.0f / 64.0f) + GN_EPS); \
          const float v0 = bf2f(CUR.vimg.x & 0xffffu), v1 = bf2f(CUR.vimg.x >> 16), v2 = bf2f(CUR.vimg.y & 0xffffu), v3 = bf2f(CUR.vimg.y >> 16); \
          const float g0 = bf2f(CUR.gimg.x & 0xffffu), g1 = bf2f(CUR.gimg.x >> 16), g2 = bf2f(CUR.gimg.y & 0xffffu), g3 = bf2f(CUR.gimg.y >> 16); \
          const float o0 = (d4[0] * rstd * lg4[0] + lb4[0] + CUR.bon * v0) * g0, o1 = (d4[1] * rstd * lg4[1] + lb4[1] + CUR.bon * v1) * g1; \
          const float o2 = (d4[2] * rstd * lg4[2] + lb4[2] + CUR.bon * v2) * g2, o3 = (d4[3] * rstd * lg4[3] + lb4[3] + CUR.bon * v3) * g3; \
          *(u32x2*)(YA + ((size_t)b * SEQ + (size_t)(ch * SC_C + vs)) * 2560 + h * 64 + vi4) = (u32x2){pk2(o0, o1), pk2(o2, o3)}; } } while (0)
    SeqSet sa, sb, sc;
    SEQ_LOAD(sa, 0); SEQ_LOAD(sb, 1);
    SEQ_WAIT_V(sa, 0);
    for (int idx = tid; idx < 64 * 8; idx += 512) *(LAS u32x4*)(BI + (idx >> 3) * 104 + 8 * (idx & 7)) = (u32x4){0u, 0u, 0u, 0u};
    BI[(vi4 + 0) * 104 + 64 + vs] = (bf16_t)(sa.vimg.x & 0xffffu); BI[(vi4 + 1) * 104 + 64 + vs] = (bf16_t)(sa.vimg.x >> 16);
    BI[(vi4 + 2) * 104 + 64 + vs] = (bf16_t)(sa.vimg.y & 0xffffu); BI[(vi4 + 3) * 104 + 64 + vs] = (bf16_t)(sa.vimg.y >> 16);
    LBAR();
    for (int c0 = 0; c0 < SC_NCH; c0 += 3) {
        SEQ_BODY(c0, sa, sb, sc);
        if (c0 + 1 < SC_NCH) SEQ_BODY(c0 + 1, sb, sc, sa);
        if (c0 + 2 < SC_NCH) SEQ_BODY(c0 + 2, sc, sa, sb);
    }
    asm volatile("s_waitcnt vmcnt(0)" ::: "memory");
    LBAR();
#undef SEQ_LOAD
#undef SEQ_BODY
#undef SEQ_WAIT_AF
#undef SEQ_WAIT_V
#undef SEQ_WAIT_G
}

__device__ __forceinline__ void p4_attn_task(const Ctx& c, int task) {
    unsigned char* ws = c.ws;
    const bf16_t* QR = (const bf16_t*)(ws + WS_QR); const bf16_t* KR = (const bf16_t*)(ws + WS_KR); const bf16_t* VR = (const bf16_t*)(ws + WS_VR);
    bf16_t* AO = (bf16_t*)(ws + WS_AO); float* LSE = (float*)(ws + WS_LSE);
    constexpr int VP = 280;
    LAS bf16_t* Vt = (LAS bf16_t*)c.lds;
    const int combo = task & 31, hh = (task >> 5) % 24, b = task / (32 * 24);
    const int g = hh >> 3, h = hh & 7;
    const int dil = g == 0 ? 1 : (g == 1 ? 4 : 16), nblk = 32 / dil;
    const int res = combo / nblk, blk = combo % nblk;
    int tid_ = c.tid; asm volatile("" : "+v"(tid_));
    const int tid = tid_, lane = tid & 63, w = __builtin_amdgcn_readfirstlane(tid >> 6);
    const int qq = lane & 15, g4 = lane >> 4, r0 = 16 * w;
    const size_t rowb = (size_t)(b * 24 + hh) * SEQ + (size_t)res * (SEQ / dil) + (size_t)blk * 128;
    bf16x8 qf[2], kf[9][2];
#pragma unroll
    for (int ks = 0; ks < 2; ++ks) qf[ks] = *(const bf16x8*)(QR + (rowb + r0 + qq) * 64 + 32 * ks + 8 * g4);
#pragma unroll
    for (int kt = 0; kt < 9; ++kt) { const bool kv = (blk > 0) || (w + kt >= 8);
#pragma unroll
        for (int ks = 0; ks < 2; ++ks) { kf[kt][ks] = (bf16x8){0, 0, 0, 0, 0, 0, 0, 0};
            if (kv) kf[kt][ks] = *(const bf16x8*)(KR + (rowb - 128 + 16 * (w + kt) + qq) * 64 + 32 * ks + 8 * g4); } }
    const int vki = tid >> 1, vdh = tid & 1;
    u32x4 vv[4];
    if (blk > 0 || vki >= 128) {
#pragma unroll
        for (int j = 0; j < 4; ++j) vv[j] = *(const u32x4*)(VR + (rowb - 128 + vki) * 64 + 32 * vdh + 8 * j); }
    else {
#pragma unroll
        for (int j = 0; j < 4; ++j) vv[j] = (u32x4){0u, 0u, 0u, 0u}; }
    __syncthreads();
#pragma unroll
    for (int j = 0; j < 4; ++j) { const unsigned wv[4] = {vv[j].x, vv[j].y, vv[j].z, vv[j].w};
#pragma unroll
        for (int e = 0; e < 8; ++e) Vt[(32 * vdh + 8 * j + e) * VP + vki] = (bf16_t)((wv[e >> 1] >> (16 * (e & 1))) & 0xffffu); }
    if (tid < 64) {
#pragma unroll
        for (int e = 0; e < 24; ++e) Vt[tid * VP + 256 + e] = 0; }
    f32x4 sc[10];
#pragma unroll
    for (int kt = 0; kt < 9; ++kt) { f32x4 a = (f32x4){0.f, 0.f, 0.f, 0.f};
#pragma unroll
        for (int ks = 0; ks < 2; ++ks) a = __builtin_amdgcn_mfma_f32_16x16x32_bf16(kf[kt][ks], qf[ks], a, 0, 0, 0);
        sc[kt] = a; }
    const int r = r0 + qq;
    float mx = -3.0e38f;
#pragma unroll
    for (int kt = 0; kt < 9; ++kt)
#pragma unroll
        for (int j = 0; j < 4; ++j) { const int ki = 16 * (w + kt) + 4 * g4 + j; const bool ok = (ki >= r) && (ki <= r + 128) && (blk > 0 || ki >= 128);
            const float sv = ok ? sc[kt][j] * 0.125f : -1.0e30f; sc[kt][j] = sv; mx = fmaxf(mx, sv); }
    mx = fmaxf(mx, __shfl_xor(mx, 16)); mx = fmaxf(mx, __shfl_xor(mx, 32));
    float den = 0.f;
#pragma unroll
    for (int kt = 0; kt < 9; ++kt)
#pragma unroll
        for (int j = 0; j < 4; ++j) { const float pexp = __expf(sc[kt][j] - mx); sc[kt][j] = pexp; den += pexp; }
    den += __shfl_xor(den, 16); den += __shfl_xor(den, 32);
    sc[9] = (f32x4){0.f, 0.f, 0.f, 0.f};
    __syncthreads();
    f32x4 oacc[4];
#pragma unroll
    for (int dt = 0; dt < 4; ++dt) oacc[dt] = (f32x4){0.f, 0.f, 0.f, 0.f};
#pragma unroll
    for (int cidx = 0; cidx < 5; ++cidx) {
        const f32x4 p0 = sc[2 * cidx], p1 = sc[2 * cidx + 1];
        u32x4 pw; pw.x = pk2(p0[0], p0[1]); pw.y = pk2(p0[2], p0[3]); pw.z = pk2(p1[0], p1[1]); pw.w = pk2(p1[2], p1[3]);
        const bf16x8 pf = __builtin_bit_cast(bf16x8, pw);
        const int kbase = 16 * (w + 2 * cidx) + 4 * g4;
#pragma unroll
        for (int dt = 0; dt < 4; ++dt) { const LAS bf16_t* vp = Vt + (16 * dt + qq) * VP + kbase;
            const u32x2 lo = *(const LAS u32x2*)vp, hi = *(const LAS u32x2*)(vp + 16);
            u32x4 vw; vw.x = lo.x; vw.y = lo.y; vw.z = hi.x; vw.w = hi.y;
            oacc[dt] = __builtin_amdgcn_mfma_f32_16x16x32_bf16(__builtin_bit_cast(bf16x8, vw), pf, oacc[dt], 0, 0, 0); }
    }
    const float inv = 1.0f / den;
    const size_t tok = (size_t)b * SEQ + (size_t)(blk * 128 + r) * dil + res;
#pragma unroll
    for (int dt = 0; dt < 4; ++dt) { const f32x4 ov = oacc[dt] * inv; *(u32x2*)(AO + ((size_t)g * M + tok) * 512 + h * 64 + 16 * dt + 4 * g4) = (u32x2){pk2(ov[0], ov[1]), pk2(ov[2], ov[3])}; }
    if (g4 == 0) LSE[((size_t)g * M + tok) * 8 + h] = mx + __logf(den);
}

struct KvUnitOrder {
    static constexpr bool GATHER = false;
    const char* A; const char* Bt; int q;
    __device__ bool next(int i, pg8::Unit& u) const {
        if (i != 0) return false;
        const int pm = q & 3, pn = q >> 2;
        u.A = A + (size_t)pm * 256 * D * 2; u.B = Bt + (size_t)pn * 256 * D * 2; u.orow = 256 * pm; u.ocol = 256 * pn; u.aux = 0; u.aux2 = 0; u.valid = 256; return true;
    }
    __device__ __forceinline__ const int* rows(const pg8::Unit&) const { return nullptr; }
};
constexpr int Q_KV = 64, Q_ATT = 3072, Q_TOTAL = Q_KV + Q_ATT + MOE_CONV_GROUPS;
__device__ __forceinline__ void p4_queue(const Params& p, const Ctx& c, volatile LAS unsigned* qslot) {
    unsigned* qc = (unsigned*)(c.ws + WS_CTL) + CW_Q;
    for (;;) {
        __syncthreads();
        if (c.tid == 0) qslot[0] = __hip_atomic_fetch_add(qc, 1u, __ATOMIC_RELAXED, __HIP_MEMORY_SCOPE_AGENT);
        __syncthreads();
        const unsigned it = qslot[0];
        if (it >= (unsigned)Q_TOTAL) break;
        if (it < (unsigned)Q_KV) { const int qi = __builtin_amdgcn_readfirstlane((int)it);
            KvUnitOrder S{(const char*)(c.ws + WS_MEMB), (const char*)(c.ws + WS_WKV), qi};
            pg8::EpiKV E{(bf16_t*)(c.ws + WS_KB), (bf16_t*)(c.ws + WS_VT)};
            pg8::gemm_phase<pg8::EpiKV, KvUnitOrder>(c.lds, pg8::Gemm{D, D, D}, S, E); }
        else if (it < (unsigned)(Q_KV + Q_ATT)) p4_attn_task(c, (int)it - Q_KV); else conv_group(p, c, (int)it - Q_KV - Q_ATT);
    }
}

__device__ __forceinline__ void p5_post(const Params& p, const Ctx& c) {
    unsigned char* ws = c.ws;
    const bf16_t* AO = (const bf16_t*)(ws + WS_AO); const float* LSE = (const float*)(ws + WS_LSE);
    bf16_t* YB = (bf16_t*)(ws + WS_YA);
    const int gw = c.vcu * 8 + c.wave, NGW = c.G * 8, lane = c.lane;
    for (int it = gw; it < M * 8; it += NGW) {
        const int t = it >> 3, h = it & 7;
        const float l0 = LSE[((size_t)0 * M + t) * 8 + h], l1 = LSE[((size_t)1 * M + t) * 8 + h], l2 = LSE[((size_t)2 * M + t) * 8 + h];
        const float mxl = fmaxf(l0, fmaxf(l1, l2)); const float e0 = __expf(l0 - mxl), e1 = __expf(l1 - mxl), e2 = __expf(l2 - mxl); const float inv = 1.0f / (e0 + e1 + e2);
        const size_t o = (size_t)t * 512 + h * 64 + lane;
        const float v = (e0 * bf2f(AO[o]) + e1 * bf2f(AO[(size_t)M * 512 + o]) + e2 * bf2f(AO[(size_t)2 * M * 512 + o])) * inv;
        YB[(size_t)t * 2560 + 2048 + h * 64 + lane] = (bf16_t)f2bf(v);
    }
}

__device__ __forceinline__ void ln_rows(const Ctx& c, const float* in, const float* gam, const float* bet, float* outf, f32x2* stats, unsigned char* outq) {
    const int gw = c.vcu * 8 + c.wave, NGW = c.G * 8, lane = c.lane;
    for (int m = gw; m < M; m += NGW) {
        const f32x4* xr = (const f32x4*)(in + (size_t)m * D) + lane;
        f32x4 v[8]; float s = 0.f;
#pragma unroll
        for (int j = 0; j < 8; ++j) { v[j] = xr[64 * j]; s += (v[j][0] + v[j][1]) + (v[j][2] + v[j][3]); }
        const float mean = wave_sum(s) * (1.0f / D); float s2 = 0.f;
#pragma unroll
        for (int j = 0; j < 8; ++j) { v[j] = v[j] - mean; s2 += (v[j][0] * v[j][0] + v[j][1] * v[j][1]) + (v[j][2] * v[j][2] + v[j][3] * v[j][3]); }
        const float rstd = rsqrtf(wave_sum(s2) * (1.0f / D) + LN_EPS);
        if (stats && lane == 0) stats[m] = (f32x2){mean, rstd};
#pragma unroll
        for (int j = 0; j < 8; ++j) { const int col = 4 * lane + 256 * j; const f32x4 gv = *(const f32x4*)(gam + col), bv = *(const f32x4*)(bet + col);
            const f32x4 o = v[j] * rstd * gv + bv;
            if (outf) *(f32x4*)(outf + (size_t)m * D + col) = o;
            if (outq) *(unsigned*)(outq + (size_t)m * D + col) = pk4_fp8(o[0], o[1], o[2], o[3]); }
    }
}

__device__ __forceinline__ void p15_router(const Params& p, const Ctx& c) {
    unsigned char* ws = c.ws;
    const float* T2 = (const float*)(ws + WS_T2); const f32x2* ST2 = (const f32x2*)(ws + WS_ST2); const float* g2 = p.in[I_LN2G]; const float* b2 = p.in[I_LN2B]; const float* RW = p.in[I_RW]; const float* RB = p.in[I_RB];
    unsigned* cnt = (unsigned*)(ws + WS_CTL) + CW_CNT; int* LIST = (int*)(ws + WS_LIST); int* ROWI = (int*)(ws + WS_ROWI); float* TOPW = (float*)(ws + WS_TOPW);
    const int lane = c.lane, li = lane & 31, lk = lane >> 5, grp = c.wave >> 2, kq = c.wave & 3;
    LAS float* scr = (LAS float*)(c.lds + (grp * 4 + kq) * 4352);
    for (int tbase = 2 * c.vcu; tbase < M / 32; tbase += 2 * c.G) {
        const int tb = tbase + grp, t0 = tb * 32;
        f32x16 acc;
#pragma unroll
        for (int j = 0; j < 16; ++j) acc[j] = 0.f;
        if (tb < M / 32) {
            const float* xa = T2 + (size_t)(t0 + li) * D + 4 * lk; const f32x2 st = ST2[t0 + li];
            const float* wb = RW + (size_t)(4 * lk) * 32 + li;
            for (int kb = 64 * kq; kb < 64 * kq + 64; ++kb) {
                const f32x4 a = ((*(const f32x4*)(xa + 8 * kb) - st.x) * st.y) * *(const f32x4*)(g2 + 8 * kb + 4 * lk) + *(const f32x4*)(b2 + 8 * kb + 4 * lk);
                const float w0 = wb[(size_t)(8 * kb + 0) * 32], w1 = wb[(size_t)(8 * kb + 1) * 32], w2 = wb[(size_t)(8 * kb + 2) * 32], w3 = wb[(size_t)(8 * kb + 3) * 32];
                acc = __builtin_amdgcn_mfma_f32_32x32x2f32(a[0], w0, acc, 0, 0, 0);
                acc = __builtin_amdgcn_mfma_f32_32x32x2f32(a[1], w1, acc, 0, 0, 0);
                acc = __builtin_amdgcn_mfma_f32_32x32x2f32(a[2], w2, acc, 0, 0, 0);
                acc = __builtin_amdgcn_mfma_f32_32x32x2f32(a[3], w3, acc, 0, 0, 0);
            }
        }
#pragma unroll
        for (int rg = 0; rg < 16; ++rg) { const int row = (rg & 3) + 8 * (rg >> 2) + 4 * lk; scr[row * 33 + li] = acc[rg]; }
        __syncthreads();
        if (kq == 0 && lane < 32 && tb < M / 32) {
            float lv[32];
#pragma unroll
            for (int e = 0; e < 32; ++e) lv[e] = ((scr[lane * 33 + e] + scr[1088 + lane * 33 + e]) + (scr[2176 + lane * 33 + e] + scr[3264 + lane * 33 + e])) + RB[e];
            int id[4]; float tv[4];
#pragma unroll
            for (int k = 0; k < 4; ++k) { float best = -3.0e38f; int bi = 0;
#pragma unroll
                for (int e = 0; e < 32; ++e) { const bool tk = lv[e] > best; best = tk ? lv[e] : best; bi = tk ? e : bi; }
                id[k] = bi; tv[k] = best;
#pragma unroll
                for (int e = 0; e < 32; ++e) lv[e] = (e == bi) ? -3.0e38f : lv[e]; }
            const float e1 = __expf(tv[1] - tv[0]), e2 = __expf(tv[2] - tv[0]), e3 = __expf(tv[3] - tv[0]); const float inv = 1.0f / (1.0f + e1 + e2 + e3);
            const float wv[4] = {inv, e1 * inv, e2 * inv, e3 * inv};
            const int t = t0 + lane;
#pragma unroll
            for (int k = 0; k < 4; ++k) { const unsigned slot = __hip_atomic_fetch_add(cnt + id[k], 1u, __ATOMIC_RELAXED, __HIP_MEMORY_SCOPE_AGENT);
                LIST[(size_t)id[k] * CAP + slot] = t; ROWI[(size_t)t * 4 + k] = id[k] * CAP + (int)slot; TOPW[(size_t)t * 4 + k] = wv[k]; }
        }
        __syncthreads();
    }
}

__device__ __forceinline__ void moe_table(const Ctx& c, LAS int* tab) {
    if (c.tid == 0) { unsigned* cnt = (unsigned*)(c.ws + WS_CTL) + CW_CNT; int ts = 0;
        for (int e = 0; e < NEXP; ++e) { const int n = (int)__hip_atomic_load(cnt + e, __ATOMIC_RELAXED, __HIP_MEMORY_SCOPE_AGENT); tab[e] = n; tab[32 + e] = ts; ts += (n + 255) >> 8; }
        tab[64] = ts; }
    __syncthreads();
}

__device__ __forceinline__ void p18_combine(const Params& p, const Ctx& c, const LAS int* tab) {
    unsigned char* ws = c.ws;
    const float* T2 = (const float*)(ws + WS_T2); const f32x2* ST2 = (const f32x2*)(ws + WS_ST2); const float* g2 = p.in[I_LN2G]; const float* b2 = p.in[I_LN2B]; const bf16_t* Y = (const bf16_t*)(ws + WS_Y); const int* ROWI = (const int*)(ws + WS_ROWI); const float* TOPW = (const float*)(ws + WS_TOPW);
    const float* gam = p.in[I_LN3G]; const float* bet = p.in[I_LN3B];
    const int gw = c.vcu * 8 + c.wave, NGW = c.G * 8, lane = c.lane;
    for (int m = gw; m < M; m += NGW) {
        f32x4 v[8];
        const f32x4* xr = (const f32x4*)(T2 + (size_t)m * D) + lane; const f32x2 st = ST2[m];
#pragma unroll
        for (int j = 0; j < 8; ++j) { const int col = 4 * lane + 256 * j; v[j] = (((xr[64 * j] - st.x) * st.y) * *(const f32x4*)(g2 + col) + *(const f32x4*)(b2 + col)) * DN_ALPHA; }
#pragma unroll
        for (int k = 0; k < 4; ++k) { const int ri = ROWI[(size_t)m * 4 + k]; const float gt = TOPW[(size_t)m * 4 + k]; const int e = ri >> 14, slot = ri & (CAP - 1);
            const u32x2* yr = (const u32x2*)(Y + ((size_t)tab[32 + e] * 256 + slot) * D) + lane;
#pragma unroll
            for (int j = 0; j < 8; ++j) { const u32x2 yw = yr[64 * j]; v[j] = v[j] + (f32x4){bf2f(yw.x & 0xffffu), bf2f(yw.x >> 16), bf2f(yw.y & 0xffffu), bf2f(yw.y >> 16)} * gt; } }
        float s = 0.f;
#pragma unroll
        for (int j = 0; j < 8; ++j) s += (v[j][0] + v[j][1]) + (v[j][2] + v[j][3]);
        const float mean = wave_sum(s) * (1.0f / D); float s2 = 0.f;
#pragma unroll
        for (int j = 0; j < 8; ++j) { v[j] = v[j] - mean; s2 += (v[j][0] * v[j][0] + v[j][1] * v[j][1]) + (v[j][2] * v[j][2] + v[j][3] * v[j][3]); }
        const float rstd = rsqrtf(wave_sum(s2) * (1.0f / D) + LN_EPS);
#pragma unroll
        for (int j = 0; j < 8; ++j) { const int col = 4 * lane + 256 * j; const f32x4 gv = *(const f32x4*)(gam + col), bv = *(const f32x4*)(bet + col);
            *(f32x4*)(p.out + (size_t)m * D + col) = v[j] * rstd * gv + bv; }
    }
}

constexpr int NPHASE = 19;
__global__ void __launch_bounds__(512, 2) fwd(Params p) {
    extern __shared__ __attribute__((aligned(16))) unsigned char lds_raw[];
    LAS unsigned char* lds = (LAS unsigned char*)lds_raw;
    Ctx c; c.tid = threadIdx.x; c.lane = c.tid & 63; c.wave = __builtin_amdgcn_readfirstlane(c.tid >> 6); c.G = gridDim.x;
    { const int bx = blockIdx.x; c.vcu = (c.G % 8 == 0) ? (bx % 8) * (c.G / 8) + bx / 8 : bx; }
    c.lds = lds; c.ws = p.ws;
    unsigned char* ws = p.ws;
    volatile LAS unsigned* MISC = (volatile LAS unsigned*)(lds + MISC_OFF);
    LAS int* tab = (LAS int*)(lds + MISC_OFF + 1024);
    if (c.tid < 64) MISC[c.tid] = 0u;
    __syncthreads();
    unsigned* ctl = (unsigned*)(ws + WS_CTL);
    XcdBarrier bar; bar.bar = ctl + CW_BAR + p.li * XCD_BAR_WORDS; bar.x = 0; bar.st = MISC + 8;
    if (N_LAUNCH_MODE == 1) bar = xcd_barrier_post(ctl + CW_BAR + p.li * XCD_BAR_WORDS, MISC + 8);
    const int lo = p.ph_lo, hi = p.ph_hi, bx = blockIdx.x;
#ifndef PHMASK
#define PHMASK 0xFFFFFFFFu
#endif
#define IN(k) (((PHMASK >> (k)) & 1u) && lo <= (k) && (k) < hi)
#define SEAM(k) do { if (N_LAUNCH_MODE == 1 && IN((k) + 1)) xcd_barrier(bar); } while (0)

    if (IN(0)) { p0_prologue(p, c); SEAM(0); }

    if (IN(1)) {
        { pg8::StaticOrder S; S.init(ws + WS_XB, ws + WS_WIN, M, ATT0, D, D, c.G, bx);
          pg8::EpiBf16 E{(bf16_t*)(ws + WS_PROJ), PC, 1.0f};
          pg8::gemm_phase<pg8::EpiBf16, pg8::StaticOrder>(lds, pg8::Gemm{D, D, D}, S, E); }
        { pg8::StaticOrder S; S.init(ws + WS_XQ, ws + WS_WIN8, M, PC - ATT0, D, D, c.G, bx, 1);
          pg8::EpiBf16 E{(bf16_t*)(ws + WS_PROJ) + ATT0, PC, 1.0f};
          pg8::gemm_phase<pg8::EpiBf16, pg8::StaticOrder, true, true>(lds, pg8::Gemm{D, D, D}, S, E); }
        SEAM(1);
    }
    if (IN(2)) { p2_prep(p, c); SEAM(2); }

    if (IN(3)) {
#ifndef P3M
#define P3M 15
#endif
        if (P3M & 1) { pg8::StaticOrder S; S.init(ws + WS_LIN, ws + WS_WUP, M, D, 768, 256, c.G, bx);
          pg8::EpiDecay E{(bf16_t*)(ws + WS_DEC), p.in[I_W0]};
          pg8::gemm_phase<pg8::EpiDecay, pg8::StaticOrder>(lds, pg8::Gemm{256, 768, 256}, S, E); }
        if (P3M & 2) { pg8::StaticOrder S; S.init(ws + WS_LIN + 512, ws + WS_AUP, M, D, 768, 256, c.G, bx);
          pg8::EpiIclr E{p.in[I_A0], (bf16_t*)(ws + WS_AN)};
          pg8::gemm_phase<pg8::EpiIclr, pg8::StaticOrder>(lds, pg8::Gemm{256, 768, 256}, S, E); }
        if (P3M & 4) { pg8::StaticOrder S; S.init(ws + WS_LIN + 1024, ws + WS_GUP, M, D, 768, 256, c.G, bx);
          pg8::EpiBf16 E{(bf16_t*)(ws + WS_GG), D, 1.0f};
          pg8::gemm_phase<pg8::EpiBf16, pg8::StaticOrder>(lds, pg8::Gemm{256, 768, 256}, S, E); }
        SEAM(3);
    }
    if (IN(4)) {
        p4_pre(p, c);
        xcd_barrier(bar);
        for (int bh = c.vcu; bh < 128; bh += c.G) p4_seq(p, c, bh);
        p4_queue(p, c, MISC + 16);
        SEAM(4);
    }
    if (IN(5)) { p5_post(p, c); }

    if (IN(6)) {
        pg8::StaticOrder S; S.init(ws + WS_YA, ws + WS_PA, M, D, 2560, 2560, c.G, bx);
        pg8::EpiGateFused E{(const bf16_t*)(ws + WS_PROJ), (bf16_t*)(ws + WS_MERGED)};
        pg8::gemm_phase<pg8::EpiGateFused, pg8::StaticOrder>(lds, pg8::Gemm{2560, 2560, 2560}, S, E);
        SEAM(6);
    }
    if (IN(7)) { }
    if (IN(8)) {
        pg8::StaticOrder S; S.init(ws + WS_MERGED, ws + WS_WOUT, M, D, D, D, c.G, bx);
        pg8::EpiF32 E{(float*)(ws + WS_T1), D, nullptr, 0, p.in[I_X], DN_ALPHA};
        pg8::gemm_phase<pg8::EpiF32, pg8::StaticOrder>(lds, pg8::Gemm{D, D, D}, S, E);
        SEAM(8);
    }
    if (IN(9)) { ln_rows(c, (const float*)(ws + WS_T1), p.in[I_LN1G], p.in[I_LN1B], nullptr, (f32x2*)(ws + WS_ST1), ws + WS_X1B); SEAM(9); }

    if (IN(10)) {
        pg8::StaticOrder S; S.init(ws + WS_X1B, ws + WS_WQ, M, D, D, D, c.G, bx, 1);
        pg8::EpiBf16 E{(bf16_t*)(ws + WS_Q), D, 0.04419417382415922f};
        pg8::gemm_phase<pg8::EpiBf16, pg8::StaticOrder, true, true>(lds, pg8::Gemm{D, D, D}, S, E);
        SEAM(10);
    }
    if (IN(11)) {
        ScoreOrder S{(const char*)(ws + WS_Q), (const char*)(ws + WS_KB), c.G, bx};
        pg8::EpiSoftmax E{(bf16_t*)(ws + WS_PP)};
        pg8::gemm_phase<pg8::EpiSoftmax, ScoreOrder, false>(lds, pg8::Gemm{512, D, D}, S, E);
        SEAM(11);
    }
    if (IN(12)) {
        PvOrder S{(const char*)(ws + WS_PP), (const char*)(ws + WS_VT), c.G, bx};
        pg8::EpiBf16 E{(bf16_t*)(ws + WS_OC), D, 1.0f};
        pg8::gemm_phase<pg8::EpiBf16, PvOrder>(lds, pg8::Gemm{256, 256, 256}, S, E);
        SEAM(12);
    }
    if (IN(13)) {
        pg8::StaticOrder S; S.init(ws + WS_OC, ws + WS_WO, M, D, D, D, c.G, bx);
        pg8::EpiResLn E{(float*)(ws + WS_T2), (const float*)(ws + WS_T1), (const f32x2*)(ws + WS_ST1), p.in[I_LN1G], p.in[I_LN1B], DN_ALPHA};
        pg8::gemm_phase<pg8::EpiResLn, pg8::StaticOrder>(lds, pg8::Gemm{D, D, D}, S, E);
        SEAM(13);
    }
    if (IN(14)) { ln_rows(c, (const float*)(ws + WS_T2), p.in[I_LN2G], p.in[I_LN2B], nullptr, (f32x2*)(ws + WS_ST2), ws + WS_X2B); SEAM(14); }
    if (IN(15)) { p15_router(p, c); SEAM(15); }

    if (IN(16)) {
        moe_table(c, tab);
        MoeOrder<true, 16> S{tab, (const char*)(ws + WS_X2B), (const char*)(ws + WS_W1), (const int*)(ws + WS_LIST), (size_t)4096 * D, D, c.G, bx};
        pg8::EpiSwiglu E{p.in[I_B1], (bf16_t*)(ws + WS_H)};
        pg8::gemm_phase<pg8::EpiSwiglu, MoeOrder<true, 16>, true, true>(lds, pg8::Gemm{D, D, D}, S, E);
        SEAM(16);
    }
    if (IN(17)) {
        moe_table(c, tab);
        MoeOrder<false, 8> S{tab, (const char*)(ws + WS_H), (const char*)(ws + WS_W2), (const int*)(ws + WS_LIST), (size_t)D * DFF, DFF, c.G, bx};
        pg8::EpiBf16Bias E{(bf16_t*)(ws + WS_Y), D, p.in[I_B2], D};
        pg8::gemm_phase<pg8::EpiBf16Bias, MoeOrder<false, 8>, true, true>(lds, pg8::Gemm{DFF, DFF, DFF}, S, E);
        SEAM(17);
    }
    if (IN(18)) { moe_table(c, tab); p18_combine(p, c, tab); }
#undef IN
#undef SEAM
}

extern "C" void kernel_launch(void* const* d_in, const int* in_sizes, int n_in, void* d_out, int out_size, void* d_ws, size_t ws_size, hipStream_t stream) {
    static int grid = 0;
    if (grid == 0) {
        if (n_in != 32 || out_size != M * D || ws_size < WS_END) { fprintf(stderr, "kernel_launch: expected 32 inputs, %d outputs, >= %zu bytes of workspace; got %d, %d, %zu\n", M * D, (size_t)WS_END, n_in, out_size, ws_size); grid = -1; return; }
        int dev = 0, cus = 0, per_cu = 0;
        if (hipGetDevice(&dev) != hipSuccess || hipDeviceGetAttribute(&cus, hipDeviceAttributeMultiprocessorCount, dev) != hipSuccess) { grid = -1; return; }
        if (hipFuncSetAttribute((const void*)fwd, hipFuncAttributeMaxDynamicSharedMemorySize, LDS_BYTES) != hipSuccess) { fprintf(stderr, "kernel_launch: hipFuncSetAttribute failed\n"); grid = -1; return; }
        if (hipOccupancyMaxActiveBlocksPerMultiprocessor(&per_cu, (const void*)fwd, 512, LDS_BYTES) != hipSuccess || per_cu < 1) fprintf(stderr, "kernel_launch: occupancy query reports %d\n", per_cu);
        (void)hipGetLastError();
        grid = cus;
        if (grid != 256) fprintf(stderr, "kernel_launch: %d CUs; this kernel is built for 256\n", grid);
    }
    if (grid < 0) return;
    (void)hipMemsetAsync((char*)d_ws + WS_CTL, 0, CTL_ZERO_BYTES, stream);
    Params p{};
    for (int i = 0; i < 32; ++i) p.in[i] = (const float*)d_in[i];
    p.out = (float*)d_out; p.ws = (unsigned char*)d_ws;
#if defined(TIMING_REPEAT_LO)
    { const int cuts[4][2] = {{0, TIMING_REPEAT_HI}, {TIMING_REPEAT_LO, TIMING_REPEAT_HI}, {TIMING_REPEAT_HI, NPHASE}, {0, 0}};
      for (int li = 0; li < 3; ++li) { if (cuts[li][0] >= cuts[li][1]) continue; p.ph_lo = cuts[li][0]; p.ph_hi = cuts[li][1]; p.li = li; hipLaunchKernelGGL(fwd, dim3(grid), dim3(512), LDS_BYTES, stream, p); } }
#else
    if (N_LAUNCH_MODE == 1) { p.ph_lo = 0; p.ph_hi = NPHASE; hipLaunchKernelGGL(fwd, dim3(grid), dim3(512), LDS_BYTES, stream, p); }
    else for (int k = 0; k < NPHASE; ++k) { p.ph_lo = k; p.ph_hi = k + 1; hipLaunchKernelGGL(fwd, dim3(grid), dim3(512), LDS_BYTES, stream, p); }
#endif
}
```
